# Optimizing an MI355X kernel written in HIP

```python
import jax, jax.numpy as jnp
from jax import lax
import numpy as np

D_MODEL = 1024
BATCH = 16
SEQ = 4096
DEPTH = 1

ATTN_HEADS = 8
ATTN_KV_HEADS = 2
ATTN_GROUP = ATTN_HEADS // ATTN_KV_HEADS
ATTN_HEAD_DIM = 64
ATTN_WIDTH = ATTN_HEADS * ATTN_HEAD_DIM
KV_WIDTH = ATTN_KV_HEADS * ATTN_HEAD_DIM
WINDOW = 128
ATTN_BLOCK = 128

HGRN_HEADS = 4
HGRN_DK = 128
HGRN_DV = 128
HGRN_WIDTH = HGRN_HEADS * HGRN_DK
HGRN_V_WIDTH = HGRN_HEADS * HGRN_DV
HGRN_CHUNK = 32

N_BRANCHES = 2
IN_WIDTH = ATTN_WIDTH + 2 * KV_WIDTH + 2 * HGRN_WIDTH + 2 * HGRN_V_WIDTH + N_BRANCHES * D_MODEL

PEER_HEADS = 8
PEER_N_KEYS = 128
PEER_N_EXPERTS = PEER_N_KEYS * PEER_N_KEYS
PEER_KEY_DIM = 128
PEER_TOPK = 16
PEER_TOKEN_BLOCK = 128

EPS = 1e-6
MASK_VALUE = -1e30

kernel_name = "hybrid_swa_hgrn2_peer_gated_block"


def rms_norm(x, g):
    xf = x.astype(jnp.float32)
    y = xf * lax.rsqrt(jnp.mean(xf * xf, axis=-1, keepdims=True) + EPS)
    return (y * g.astype(jnp.float32)).astype(x.dtype)


def alibi_slopes():
    return jnp.asarray(2.0 ** (-8.0 * np.arange(1, ATTN_HEADS + 1) / ATTN_HEADS), dtype=jnp.float32)


def split_combined(proj):
    sizes = (ATTN_WIDTH, KV_WIDTH, KV_WIDTH, HGRN_WIDTH, HGRN_WIDTH,
             HGRN_V_WIDTH, HGRN_V_WIDTH, D_MODEL, D_MODEL)
    offsets = np.cumsum(sizes)[:-1].tolist()
    return jnp.split(proj, offsets, axis=-1)


def sliding_window_attention(q, k, v, sinks):
    B, S = q.shape[0], q.shape[1]
    W = ATTN_BLOCK
    nb = S // W
    qb = q.reshape(B, nb, W, ATTN_KV_HEADS, ATTN_GROUP, ATTN_HEAD_DIM)

    def with_prev(t):
        tb = t.reshape(B, nb, W, ATTN_KV_HEADS, ATTN_HEAD_DIM)
        prev = jnp.concatenate([jnp.zeros_like(tb[:, :1]), tb[:, :-1]], axis=1)
        return jnp.concatenate([prev, tb], axis=2)

    kc, vc = with_prev(k), with_prev(v)
    scale = ATTN_HEAD_DIM ** -0.5
    s = jnp.einsum('bnqkgd,bnskd->bnkgqs', qb, kc,
                   preferred_element_type=jnp.float32) * scale
    qpos = jnp.arange(W)[:, None] + W
    kpos = jnp.arange(2 * W)[None, :]
    dist = qpos - kpos
    blk = jnp.arange(nb)[:, None, None]
    valid = (dist >= 0) & (dist < WINDOW) & (blk * W + kpos - W >= 0)
    slopes = alibi_slopes().reshape(ATTN_KV_HEADS, ATTN_GROUP)
    s = s - slopes[:, :, None, None] * dist.astype(jnp.float32)
    s = jnp.where(valid[None, :, None, None], s, MASK_VALUE)
    sink = jnp.broadcast_to(sinks.astype(jnp.float32).reshape(ATTN_KV_HEADS, ATTN_GROUP)[:, :, None, None],
                            s.shape[:-1] + (1,))
    p = jax.nn.softmax(jnp.concatenate([s, sink], axis=-1), axis=-1)[..., :-1]
    o = jnp.einsum('bnkgqs,bnskd->bnqkgd', p.astype(v.dtype), vc)
    return o.reshape(B, S, ATTN_WIDTH)


def hgrn2_recurrence(q, f_logit, i, lower_bound):
    B, S = q.shape[0], q.shape[1]
    C = HGRN_CHUNK
    nc = S // C
    f32 = jnp.float32
    f = lower_bound + (1.0 - lower_bound) * jax.nn.sigmoid(f_logit.astype(f32))
    k = 1.0 - f
    logf = jnp.log(f)

    def chunk(t):
        return t.reshape(B, nc, C, HGRN_HEADS, t.shape[-1])

    qc, kc, lc, vc = chunk(q.astype(f32)), chunk(k), chunk(logf), chunk(i.astype(f32))
    b = jnp.cumsum(lc, axis=2)
    q_dec = qc * jnp.exp(b)
    k_inv = kc * jnp.exp(-b)
    causal = jnp.tril(jnp.ones((C, C), dtype=bool))
    a = jnp.where(causal, jnp.einsum('bnthd,bnshd->bnhts', q_dec, k_inv), 0.0)
    o_intra = jnp.einsum('bnhts,bnshv->bnthv', a, vc)
    b_last = b[:, :, -1:]
    ds = jnp.einsum('bnshd,bnshv->bnhdv', kc * jnp.exp(b_last - b), vc)
    decay = jnp.exp(b_last[:, :, 0])

    def step(state, inp):
        dec, d = inp
        return dec[..., None] * state + d, state

    s0 = jnp.zeros((B, HGRN_HEADS, HGRN_DK, HGRN_DV), f32)
    _, s_prev = lax.scan(step, s0, (jnp.moveaxis(decay, 1, 0), jnp.moveaxis(ds, 1, 0)))
    s_prev = jnp.moveaxis(s_prev, 0, 1)
    o_inter = jnp.einsum('bnthd,bnhdv->bnthv', q_dec, s_prev)
    return (o_intra + o_inter).reshape(B, S, HGRN_HEADS, HGRN_DV)


def peer_layer(h, w_q, keys, u, v):
    B, S = h.shape[0], h.shape[1]
    q = (h @ w_q).reshape(B, S, PEER_HEADS, 2, PEER_KEY_DIM)
    sc = jnp.einsum('bshpd,phnd->bshpn', q, keys).astype(jnp.float32)
    v1, i1 = lax.top_k(sc[..., 0, :], PEER_TOPK)
    v2, i2 = lax.top_k(sc[..., 1, :], PEER_TOPK)
    cand = (v1[..., :, None] + v2[..., None, :]).reshape(B, S, PEER_HEADS, PEER_TOPK * PEER_TOPK)
    cidx = (i1[..., :, None] * PEER_N_KEYS + i2[..., None, :]).reshape(B, S, PEER_HEADS, PEER_TOPK * PEER_TOPK)
    best, pos = lax.top_k(cand, PEER_TOPK)
    idx = jnp.take_along_axis(cidx, pos, axis=-1)
    gates = jax.nn.softmax(best, axis=-1)
    T = B * S
    nblk = T // PEER_TOKEN_BLOCK
    hk = PEER_HEADS * PEER_TOPK
    hb = h.reshape(nblk, PEER_TOKEN_BLOCK, D_MODEL)
    ib = idx.reshape(nblk, PEER_TOKEN_BLOCK, hk)
    gb = gates.reshape(nblk, PEER_TOKEN_BLOCK, hk).astype(h.dtype)

    def expert_block(args):
        ht, it, gt = args
        ue = jnp.take(u, it, axis=0)
        act = jax.nn.gelu(jnp.einsum('tkd,td->tk', ue, ht), approximate=False)
        ve = jnp.take(v, it, axis=0)
        return jnp.einsum('tk,tkd->td', gt * act, ve)

    out = lax.map(expert_block, (hb, ib, gb))
    return out.reshape(B, S, D_MODEL)


def hybrid_layer(x, norm_mix_g, w_in, sinks, lower_bound, hgrn_norm_g, w_attn_proj,
                 w_hgrn_proj, w_out, norm_ffn_g, w_peer_q, peer_keys, peer_u, peer_v):
    B, S = x.shape[0], x.shape[1]
    h = rms_norm(x, norm_mix_g)
    aq, ak, av, hq, hf, hi, hg, ga, gh = split_combined(h @ w_in)
    y_attn = sliding_window_attention(aq.reshape(B, S, ATTN_HEADS, ATTN_HEAD_DIM),
                                      ak.reshape(B, S, ATTN_KV_HEADS, ATTN_HEAD_DIM),
                                      av.reshape(B, S, ATTN_KV_HEADS, ATTN_HEAD_DIM), sinks)
    o = hgrn2_recurrence(jax.nn.silu(hq).reshape(B, S, HGRN_HEADS, HGRN_DK),
                         hf.reshape(B, S, HGRN_HEADS, HGRN_DK),
                         hi.reshape(B, S, HGRN_HEADS, HGRN_DV), lower_bound)
    o = rms_norm(o, hgrn_norm_g).astype(x.dtype) * jax.nn.silu(hg.reshape(B, S, HGRN_HEADS, HGRN_DV))
    y_hgrn = o.reshape(B, S, HGRN_V_WIDTH)
    merged = jax.nn.sigmoid(ga) * (y_attn @ w_attn_proj) + jax.nn.sigmoid(gh) * (y_hgrn @ w_hgrn_proj)
    x = x + merged @ w_out
    x = x + peer_layer(rms_norm(x, norm_ffn_g), w_peer_q, peer_keys, peer_u, peer_v)
    return x


def setup_inputs(seed: int = 0) -> dict:
    key = jax.random.key(seed)
    ks = jax.random.split(key, 16)
    f32 = jnp.float32
    n = jax.random.normal
    return {
        "x": n(ks[0], (BATCH, SEQ, D_MODEL), f32),
        "norm_mix_g": 1.0 + 0.02 * n(ks[1], (DEPTH, D_MODEL), f32),
        "w_in": n(ks[2], (DEPTH, D_MODEL, IN_WIDTH), f32) * D_MODEL ** -0.5,
        "attn_sinks": n(ks[3], (DEPTH, ATTN_HEADS), f32),
        "hgrn_lb_logits": 0.1 * n(ks[4], (DEPTH + 1, HGRN_WIDTH), f32),
        "hgrn_norm_g": 1.0 + 0.02 * n(ks[5], (DEPTH, HGRN_DV), f32),
        "w_attn_proj": n(ks[6], (DEPTH, ATTN_WIDTH, D_MODEL), f32) * ATTN_WIDTH ** -0.5,
        "w_hgrn_proj": n(ks[7], (DEPTH, HGRN_V_WIDTH, D_MODEL), f32) * HGRN_V_WIDTH ** -0.5,
        "w_out": n(ks[8], (DEPTH, D_MODEL, D_MODEL), f32) * D_MODEL ** -0.5,
        "norm_ffn_g": 1.0 + 0.02 * n(ks[9], (DEPTH, D_MODEL), f32),
        "w_peer_q": n(ks[10], (DEPTH, D_MODEL, PEER_HEADS * 2 * PEER_KEY_DIM), f32) * D_MODEL ** -0.5,
        "peer_keys": n(ks[11], (DEPTH, 2, PEER_HEADS, PEER_N_KEYS, PEER_KEY_DIM), f32) * PEER_KEY_DIM ** -0.5,
        "peer_u": n(ks[12], (DEPTH, PEER_N_EXPERTS, D_MODEL), f32) * D_MODEL ** -0.5,
        "peer_v": n(ks[13], (DEPTH, PEER_N_EXPERTS, D_MODEL), f32) * PEER_HEADS ** -0.5,
        "norm_final_g": 1.0 + 0.02 * n(ks[14], (D_MODEL,), f32),
    }


def reference(x, norm_mix_g, w_in, attn_sinks, hgrn_lb_logits, hgrn_norm_g, w_attn_proj,
              w_hgrn_proj, w_out, norm_ffn_g, w_peer_q, peer_keys, peer_u, peer_v, norm_final_g):
    lower_bounds = jnp.cumsum(jax.nn.softmax(hgrn_lb_logits.astype(jnp.float32), axis=0), axis=0)
    for layer in range(DEPTH):
        x = hybrid_layer(x, norm_mix_g[layer], w_in[layer], attn_sinks[layer],
                         lower_bounds[layer].reshape(HGRN_HEADS, HGRN_DK), hgrn_norm_g[layer],
                         w_attn_proj[layer], w_hgrn_proj[layer], w_out[layer], norm_ffn_g[layer],
                         w_peer_q[layer], peer_keys[layer], peer_u[layer], peer_v[layer])
    return rms_norm(x, norm_final_g)
```

```cpp
#include <hip/hip_runtime.h>
#include <hip/hip_cooperative_groups.h>
#include <cstdio>
#include <cstdint>
namespace cg = cooperative_groups;
namespace pg8 {
#define PG8_LAS __attribute__((address_space(3)))
typedef unsigned short bf16_t;
typedef short bf16x8 __attribute__((ext_vector_type(8)));
typedef float f32x4 __attribute__((ext_vector_type(4)));
typedef unsigned u32x4 __attribute__((ext_vector_type(4)));
constexpr int BM = 256, BK = 64, HALF = 128, HTB = HALF * BK * 2  , STAGE_BYTES = 8 * HTB, NXCD = 8, WGM = 8;

__host__ __device__ __forceinline__ int lds_byte(int r, int c) { const int st = (r >> 4) * 2 + (c >> 5), rr = r & 15, cc = c & 31, ob = rr * 64 + cc * 2; return st * 1024 + (ob ^ (((ob >> 9) & 1) << 5)); }
__host__ __device__ __forceinline__ void stage_rc(int b, int& R, int& C) { const int st = b / 1024, sb = b % 1024, swz = sb ^ (((sb >> 9) & 1) << 5); R = (st >> 1) * 16 + swz / 64; C = (st & 1) * 32 + (swz % 64) / 2; }
__host__ __device__ __forceinline__ int perm32(int rho) { const int n = rho >> 4, i = rho & 15; return 8 * (i >> 2) + 4 * n + (i & 3); }

struct Unit { int pm, pn; };
struct Gemm { const bf16_t* A; const bf16_t* Bt; int M, N, K; };

struct StaticOrder {
    int nM, nN, nwg, G, c;
    __host__ __device__ void init(int M, int N, int G_, int c_) { nM = M / BM; nN = N / BM; nwg = nM * nN; G = G_; c = c_; }
    __host__ __device__ bool next(int i, Unit& u) const {
        const long L = (long)i * G + c; if (L >= nwg) return false;
        int wgid = (int)L; { const int q = nwg / NXCD, r = nwg % NXCD, xcd = wgid % NXCD, off = wgid / NXCD; wgid = (xcd < r ? xcd * (q + 1) : r * (q + 1) + (xcd - r) * q) + off; }
        const int nig = WGM * nN, gid = wgid / nig, fm = gid * WGM, gsz = (nM - fm) < WGM ? (nM - fm) : WGM;
        u.pm = fm + ((wgid % nig) % gsz); u.pn = (wgid % nig) / gsz; return true;
    }
    __device__ __forceinline__ void a_ready(const Unit&) const {}
    __device__ __forceinline__ void done(const Unit&) const {}
};

__device__ __forceinline__ unsigned cvt_pk_bf16(float lo, float hi) { unsigned r; asm volatile("v_cvt_pk_bf16_f32 %0, %1, %2" : "=v"(r) : "v"(lo), "v"(hi)); return r; }

template <class Epi, class Sched, bool ALIGN_EPI = false, bool SP2 = false>
__device__ __forceinline__ void gemm_phase(PG8_LAS unsigned char* lds, const Gemm g, const Sched& S, const Epi& E) {
    const int tid = threadIdx.x, wid = __builtin_amdgcn_readfirstlane(tid >> 6), lane = tid & 63, wr = wid >> 2, wc = wid & 3, fr = lane & 15, fq = lane >> 4;
    const int K = g.K, nt = K / BK;
    unsigned voffA[2], voffB[2];
#pragma unroll
    for (int i = 0; i < 2; ++i) { int R, C; stage_rc(tid * 16 + i * 8192, R, C); const int Rb = Epi::PERM ? ((R & ~31) + perm32(R & 31)) : R;
        voffA[i] = (unsigned)(R * K + C) * 2u; voffB[i] = (unsigned)(Rb * K + C) * 2u; }
    const size_t kstep = (size_t)(BK * 2);
    const size_t hstep = (size_t)HALF * K * 2;
    const size_t tstep = 2 * hstep;
    const unsigned ldsw = (unsigned)wid * 1024u;
    const int aoff = lds_byte(wr * 64 + fr, fq * 8), boff = lds_byte(wc * 32 + fr, fq * 8);
#define PG8_SA(b, h) (((b) * 2 + (h)) * HTB)
#define PG8_SB(b, h) ((4 + (b) * 2 + (h)) * HTB)
#define PG8_STAGE(bufoff, gbase, voff) do { _Pragma("unroll") for (int _i = 0; _i < 2; ++_i) \
        __builtin_amdgcn_global_load_lds((const unsigned*)((const char*)(gbase) + (voff)[_i]), (PG8_LAS unsigned*)(lds + (bufoff) + ldsw + _i * 8192), 16, 0, 0); } while (0)
#define PG8_LDA(dst, b, h) do { _Pragma("unroll") for (int m = 0; m < 4; ++m) _Pragma("unroll") for (int k = 0; k < 2; ++k) dst[m][k] = *(const PG8_LAS bf16x8*)(lds + PG8_SA(b, h) + aoff + m * 2048 + k * 1024); } while (0)
#define PG8_LDB(dst, b, h) do { _Pragma("unroll") for (int n = 0; n < 2; ++n) _Pragma("unroll") for (int k = 0; k < 2; ++k) dst[n][k] = *(const PG8_LAS bf16x8*)(lds + PG8_SB(b, h) + boff + n * 2048 + k * 1024); } while (0)
#define PG8_MMA(ai, bj, At, Bt) do { __builtin_amdgcn_s_setprio(1); _Pragma("unroll") for (int m = 0; m < 4; ++m) _Pragma("unroll") for (int n = 0; n < 2; ++n) _Pragma("unroll") for (int k = 0; k < 2; ++k) \
        acc[ai][bj][m][n] = __builtin_amdgcn_mfma_f32_16x16x32_bf16(Bt[n][k], At[m][k], acc[ai][bj][m][n], 0, 0, 0); __builtin_amdgcn_s_setprio(0); } while (0)
#define PG8_WAIT_V(n) asm volatile("s_waitcnt vmcnt(" #n ")" ::: "memory")
#define PG8_WAIT_L(n) asm volatile("s_waitcnt lgkmcnt(" #n ")" ::: "memory")
#define PG8_BAR __builtin_amdgcn_s_barrier()
#define PG8_SCHED __builtin_amdgcn_sched_barrier(0)
    Unit cur, nxt; int ui = 0;
    if (!S.next(0, cur)) return;
    f32x4 acc[2][2][4][2];
#pragma unroll
    for (int a = 0; a < 2; ++a)
#pragma unroll
        for (int b = 0; b < 2; ++b)
#pragma unroll
            for (int m = 0; m < 4; ++m)
#pragma unroll
                for (int n = 0; n < 2; ++n) acc[a][b][m][n] = (f32x4){0.f, 0.f, 0.f, 0.f};
    bf16x8 At[4][2], B0[2][2], B1[2][2];
    const char* cA = (const char*)g.A + (size_t)cur.pm * tstep; const char* cB = (const char*)g.Bt + (size_t)cur.pn * tstep;
    S.a_ready(cur);
    if constexpr (SP2) {
        PG8_STAGE(PG8_SB(0, 0), cB, voffB); PG8_STAGE(PG8_SB(0, 1), cB + hstep, voffB); PG8_STAGE(PG8_SA(0, 0), cA, voffA); PG8_STAGE(PG8_SA(0, 1), cA + hstep, voffA);
        if (wr == 1) PG8_BAR;
        PG8_WAIT_V(2); PG8_BAR;
        PG8_STAGE(PG8_SB(1, 0), cB + kstep, voffB); PG8_STAGE(PG8_SA(1, 0), cA + kstep, voffA); PG8_STAGE(PG8_SB(1, 1), cB + hstep + kstep, voffB);
        PG8_WAIT_V(6); PG8_BAR;
    } else {
        PG8_STAGE(PG8_SB(0, 0), cB, voffB); PG8_STAGE(PG8_SA(0, 0), cA, voffA); PG8_STAGE(PG8_SB(0, 1), cB + hstep, voffB); PG8_STAGE(PG8_SA(0, 1), cA + hstep, voffA);
        if (wr == 1) PG8_BAR;
        PG8_WAIT_V(4); PG8_BAR;
        PG8_STAGE(PG8_SB(1, 0), cB + kstep, voffB); PG8_STAGE(PG8_SA(1, 0), cA + kstep, voffA); PG8_STAGE(PG8_SB(1, 1), cB + hstep + kstep, voffB);
        PG8_WAIT_V(6); PG8_BAR;
    }
    for (;;) {
        const bool has_next = S.next(ui + 1, nxt);
        const char* nA = has_next ? (const char*)g.A + (size_t)nxt.pm * tstep : cA; const char* nB = has_next ? (const char*)g.Bt + (size_t)nxt.pn * tstep : cB;
        for (int t = 0; t < nt; t += 2) {
            const bool last = (t == nt - 2);
            const char* a1 = cA + (size_t)(t + 1) * kstep;
            const char* a2 = last ? nA : cA + (size_t)(t + 2) * kstep; const char* b2 = last ? nB : cB + (size_t)(t + 2) * kstep;
            const char* a3 = a2 + kstep; const char* b3 = b2 + kstep;
            if (last && has_next) S.a_ready(nxt);
            if constexpr (SP2) {
            PG8_LDB(B0, 0, 0); PG8_LDB(B1, 0, 1); PG8_SCHED; PG8_LDA(At, 0, 0); PG8_STAGE(PG8_SA(1, 1), a1 + hstep, voffA);
            PG8_WAIT_V(8); PG8_WAIT_L(0); PG8_BAR; PG8_MMA(0, 0, At, B0); PG8_MMA(0, 1, At, B1); PG8_BAR; PG8_SCHED;
            PG8_LDA(At, 0, 1); PG8_STAGE(PG8_SB(0, 0), b2, voffB); PG8_STAGE(PG8_SB(0, 1), b2 + hstep, voffB); PG8_STAGE(PG8_SA(0, 0), a2, voffA);
            PG8_WAIT_V(8); PG8_WAIT_L(0); PG8_BAR; PG8_MMA(1, 0, At, B0); PG8_MMA(1, 1, At, B1); PG8_BAR; PG8_SCHED;
            PG8_LDB(B0, 1, 0); PG8_LDB(B1, 1, 1); PG8_SCHED; PG8_LDA(At, 1, 0); PG8_STAGE(PG8_SA(0, 1), a2 + hstep, voffA);
            PG8_WAIT_V(8); PG8_WAIT_L(0); PG8_BAR; PG8_MMA(0, 0, At, B0); PG8_MMA(0, 1, At, B1); PG8_BAR; PG8_SCHED;
            PG8_LDA(At, 1, 1); PG8_STAGE(PG8_SB(1, 0), b3, voffB); PG8_STAGE(PG8_SB(1, 1), b3 + hstep, voffB); PG8_STAGE(PG8_SA(1, 0), a3, voffA);
            PG8_WAIT_V(8); PG8_WAIT_L(0); PG8_BAR; PG8_MMA(1, 0, At, B0); PG8_MMA(1, 1, At, B1); PG8_BAR; PG8_SCHED;
            } else {
            PG8_LDB(B0, 0, 0); PG8_SCHED; PG8_LDA(At, 0, 0); PG8_STAGE(PG8_SA(1, 1), a1 + hstep, voffA);
            PG8_WAIT_L(8); PG8_BAR; PG8_WAIT_L(0); PG8_MMA(0, 0, At, B0); PG8_BAR; PG8_SCHED;
            PG8_LDB(B1, 0, 1); PG8_STAGE(PG8_SB(0, 0), b2, voffB);
            PG8_BAR; PG8_WAIT_L(0); PG8_MMA(0, 1, At, B1); PG8_BAR;
            PG8_LDA(At, 0, 1); PG8_STAGE(PG8_SA(0, 0), a2, voffA);
            PG8_BAR; PG8_WAIT_L(0); PG8_MMA(1, 0, At, B0); PG8_BAR; PG8_SCHED;
            PG8_STAGE(PG8_SB(0, 1), b2 + hstep, voffB);
            PG8_WAIT_V(6); PG8_BAR; PG8_MMA(1, 1, At, B1); PG8_BAR;
            PG8_LDB(B0, 1, 0); PG8_SCHED; PG8_LDA(At, 1, 0); PG8_STAGE(PG8_SA(0, 1), a2 + hstep, voffA);
            PG8_WAIT_L(8); PG8_BAR; PG8_WAIT_L(0); PG8_MMA(0, 0, At, B0); PG8_BAR; PG8_SCHED;
            PG8_LDB(B1, 1, 1); PG8_STAGE(PG8_SB(1, 0), b3, voffB);
            PG8_BAR; PG8_WAIT_L(0); PG8_MMA(0, 1, At, B1); PG8_BAR;
            PG8_LDA(At, 1, 1); PG8_STAGE(PG8_SA(1, 0), a3, voffA);
            PG8_BAR; PG8_WAIT_L(0); PG8_MMA(1, 0, At, B0); PG8_BAR; PG8_SCHED;
            PG8_STAGE(PG8_SB(1, 1), b3 + hstep, voffB);
            PG8_WAIT_V(6); PG8_BAR; PG8_MMA(1, 1, At, B1); PG8_BAR;
            }
        }
        if constexpr (ALIGN_EPI) { if (wr == 0) PG8_BAR; }
        if constexpr (!Epi::AFTER_DRAIN) { E(acc, cur, wr, wc, fr, fq); S.done(cur); }
        if (!has_next) break;
#pragma unroll
        for (int a = 0; a < 2; ++a)
#pragma unroll
            for (int b = 0; b < 2; ++b)
#pragma unroll
                for (int m = 0; m < 4; ++m)
#pragma unroll
                    for (int n = 0; n < 2; ++n) acc[a][b][m][n] = (f32x4){0.f, 0.f, 0.f, 0.f};
        cur = nxt; cA = nA; cB = nB; ++ui;
        if constexpr (ALIGN_EPI) { if (wr == 1) PG8_BAR; }
    }
    PG8_WAIT_V(0);
    if constexpr (!ALIGN_EPI) { if (wr == 0) PG8_BAR; }
    PG8_BAR;
    if constexpr (Epi::AFTER_DRAIN) { E.fused(acc, cur, wr, wc, fr, fq, lds, wid, lane); S.done(cur); }
#undef PG8_SA
#undef PG8_SB
#undef PG8_STAGE
#undef PG8_LDA
#undef PG8_LDB
#undef PG8_MMA
#undef PG8_WAIT_V
#undef PG8_WAIT_L
#undef PG8_BAR
#undef PG8_SCHED
}
}

#ifndef MK_FUSED
#define MK_FUSED 0
#endif
#define DI __device__ __forceinline__
#define LAS __attribute__((address_space(3)))
typedef unsigned short bf16_t;
typedef float f32x4 __attribute__((ext_vector_type(4)));
typedef float f32x2 __attribute__((ext_vector_type(2)));
typedef float f32x16 __attribute__((ext_vector_type(16)));
typedef unsigned u32x4 __attribute__((ext_vector_type(4)));
typedef unsigned u32x2 __attribute__((ext_vector_type(2)));
typedef short bf16x8 __attribute__((ext_vector_type(8)));
typedef _Float16 h16x2 __attribute__((ext_vector_type(2)));
typedef _Float16 h16x8 __attribute__((ext_vector_type(8)));

constexpr int BATCH = 16, SEQ = 4096, T = BATCH * SEQ, DM = 1024, NIN = 4864;
constexpr int C_AQ = 0, C_AK = 512, C_AV = 640, C_HQ = 768, C_HF = 1280, C_HI = 1792, C_HG = 2304, C_GA = 2816, C_GH = 3840;
constexpr float EPS = 1e-6f;
constexpr int NTHR = 512;
constexpr int LDS_BYTES = 147456;

constexpr size_t MiB = 1u << 20;
constexpr size_t WS_W1T = 1 * MiB;
constexpr size_t WS_WAPT = 11 * MiB;
constexpr size_t WS_WHPT = 12 * MiB;
constexpr size_t WS_WOUTT = 13 * MiB;
constexpr size_t WS_WQT = 15 * MiB;
constexpr size_t WS_KEYS = 19 * MiB;
constexpr size_t WS_LB = 19 * MiB + 512 * 1024;
constexpr size_t WS_RSTD1 = 20 * MiB;
constexpr size_t WS_SSQ2 = 21 * MiB;
constexpr size_t WS_U16 = 26 * MiB;
constexpr size_t WS_V16 = 58 * MiB;
constexpr size_t WS_XB = 90 * MiB;
constexpr size_t WS_PROJ = 218 * MiB;
constexpr size_t WS_YA = 826 * MiB;
constexpr size_t WS_YH = 890 * MiB;
constexpr size_t WS_END = 954 * MiB;
constexpr size_t WS_X2B = WS_PROJ;
constexpr size_t WS_QP = WS_PROJ + 128 * MiB;
constexpr size_t WS_GIDX = WS_PROJ + 384 * MiB;
constexpr size_t WS_GGATE = WS_PROJ + 400 * MiB;

struct Args { const float* in[15]; float* out; unsigned char* ws; int ph_lo, ph_hi; };

DI unsigned pk_bf16(float lo, float hi) { typedef __bf16 b2 __attribute__((ext_vector_type(2))); f32x2 v = {lo, hi}; b2 b = __builtin_convertvector(v, b2); return __builtin_bit_cast(unsigned, b); }
DI float bflo(unsigned w) { return __uint_as_float(w << 16); }
DI float bfhi(unsigned w) { return __uint_as_float(w & 0xffff0000u); }
DI float sigm(float x) { return 1.f / (1.f + __expf(-x)); }
DI float wave_sum(float v) {
#pragma unroll
    for (int o = 1; o < 64; o <<= 1) v += __shfl_xor(v, o);
    return v;
}
#define LDS_WAIT() asm volatile("s_waitcnt lgkmcnt(0)" ::: "memory")

namespace pg8 {
struct EpiRowScale {
    static constexpr bool PERM = true, AFTER_DRAIN = false;
    bf16_t* O; int ldc; const float* rs;
    __device__ __forceinline__ void operator()(const f32x4 (&acc)[2][2][4][2], const Unit& u, int wr, int wc, int fr, int fq) const {
        const int row0 = u.pm * BM + wr * 64 + fr, col0 = u.pn * BM + wc * 32 + 8 * fq;
#pragma unroll
        for (int ai = 0; ai < 2; ++ai)
#pragma unroll
            for (int m = 0; m < 4; ++m) { const int row = row0 + ai * HALF + m * 16; const float s = rs ? rs[row] : 1.f; bf16_t* rowp = O + (size_t)row * ldc + col0;
#pragma unroll
                for (int bj = 0; bj < 2; ++bj) { const f32x4 v0 = acc[ai][bj][m][0] * s, v1 = acc[ai][bj][m][1] * s;
                    u32x4 w; w.x = pk_bf16(v0[0], v0[1]); w.y = pk_bf16(v0[2], v0[3]); w.z = pk_bf16(v1[0], v1[1]); w.w = pk_bf16(v1[2], v1[3]);
                    *(u32x4*)(rowp + bj * HALF) = w; } }
    }
};
template <bool ADD> struct EpiMerge {
    static constexpr bool PERM = true, AFTER_DRAIN = false;
    bf16_t* O; const bf16_t* gate;
    __device__ __forceinline__ void operator()(const f32x4 (&acc)[2][2][4][2], const Unit& u, int wr, int wc, int fr, int fq) const {
        const int row0 = u.pm * BM + wr * 64 + fr, col0 = u.pn * BM + wc * 32 + 8 * fq;
#pragma unroll
        for (int ai = 0; ai < 2; ++ai)
#pragma unroll
            for (int m = 0; m < 4; ++m) { const int row = row0 + ai * HALF + m * 16; bf16_t* rowp = O + (size_t)row * DM + col0; const bf16_t* gp = gate + (size_t)row * NIN + col0;
#pragma unroll
                for (int bj = 0; bj < 2; ++bj) { const u32x4 g = *(const u32x4*)(gp + bj * HALF);
                    f32x4 v0 = acc[ai][bj][m][0], v1 = acc[ai][bj][m][1];
                    v0[0] *= sigm(bflo(g.x)); v0[1] *= sigm(bfhi(g.x)); v0[2] *= sigm(bflo(g.y)); v0[3] *= sigm(bfhi(g.y));
                    v1[0] *= sigm(bflo(g.z)); v1[1] *= sigm(bfhi(g.z)); v1[2] *= sigm(bflo(g.w)); v1[3] *= sigm(bfhi(g.w));
                    if (ADD) { const u32x4 o = *(const u32x4*)(rowp + bj * HALF);
                        v0[0] += bflo(o.x); v0[1] += bfhi(o.x); v0[2] += bflo(o.y); v0[3] += bfhi(o.y); v1[0] += bflo(o.z); v1[1] += bfhi(o.z); v1[2] += bflo(o.w); v1[3] += bfhi(o.w); }
                    u32x4 w; w.x = pk_bf16(v0[0], v0[1]); w.y = pk_bf16(v0[2], v0[3]); w.z = pk_bf16(v1[0], v1[1]); w.w = pk_bf16(v1[2], v1[3]);
                    *(u32x4*)(rowp + bj * HALF) = w; } }
    }
};
struct EpiX2 {
    static constexpr bool PERM = true, AFTER_DRAIN = false;
    const float* X; float* X2; bf16_t* X2B; float* ssq;
    __device__ __forceinline__ void operator()(const f32x4 (&acc)[2][2][4][2], const Unit& u, int wr, int wc, int fr, int fq) const {
        const int row0 = u.pm * BM + wr * 64 + fr, col0 = u.pn * BM + wc * 32 + 8 * fq;
#pragma unroll
        for (int ai = 0; ai < 2; ++ai)
#pragma unroll
            for (int m = 0; m < 4; ++m) { const int row = row0 + ai * HALF + m * 16; const size_t off = (size_t)row * DM + col0; float ss = 0.f;
#pragma unroll
                for (int bj = 0; bj < 2; ++bj) { const f32x4 x0 = *(const f32x4*)(X + off + bj * HALF), x1 = *(const f32x4*)(X + off + bj * HALF + 4);
                    const f32x4 v0 = acc[ai][bj][m][0] + x0, v1 = acc[ai][bj][m][1] + x1;
                    *(f32x4*)(X2 + off + bj * HALF) = v0; *(f32x4*)(X2 + off + bj * HALF + 4) = v1;
                    u32x4 w; w.x = pk_bf16(v0[0], v0[1]); w.y = pk_bf16(v0[2], v0[3]); w.z = pk_bf16(v1[0], v1[1]); w.w = pk_bf16(v1[2], v1[3]);
                    *(u32x4*)(X2B + off + bj * HALF) = w;
                    ss += (v0[0] * v0[0] + v0[1] * v0[1]) + (v0[2] * v0[2] + v0[3] * v0[3]) + (v1[0] * v1[0] + v1[1] * v1[1]) + (v1[2] * v1[2] + v1[3] * v1[3]); }
                ss += __shfl_xor(ss, 16); ss += __shfl_xor(ss, 32);
                if (fq == 0) ssq[(size_t)row * 16 + u.pn * 4 + wc] = ss; }
    }
};
struct EpiQp {
    static constexpr bool PERM = true, AFTER_DRAIN = false;
    bf16_t* O; const float* ssq;
    __device__ __forceinline__ void operator()(const f32x4 (&acc)[2][2][4][2], const Unit& u, int wr, int wc, int fr, int fq) const {
        const int row0 = u.pm * BM + wr * 64 + fr, col0 = u.pn * BM + wc * 32 + 8 * fq;
#pragma unroll
        for (int ai = 0; ai < 2; ++ai)
#pragma unroll
            for (int m = 0; m < 4; ++m) { const int row = row0 + ai * HALF + m * 16; const f32x4* sp = (const f32x4*)(ssq + (size_t)row * 16);
                const f32x4 a = sp[0], b = sp[1], c = sp[2], d = sp[3];
                const float tot = ((a[0] + a[1]) + (a[2] + a[3])) + ((b[0] + b[1]) + (b[2] + b[3])) + ((c[0] + c[1]) + (c[2] + c[3])) + ((d[0] + d[1]) + (d[2] + d[3]));
                const float s = __builtin_amdgcn_rsqf(tot * (1.f / 1024.f) + EPS); bf16_t* rowp = O + (size_t)row * 2048 + col0;
#pragma unroll
                for (int bj = 0; bj < 2; ++bj) { const f32x4 v0 = acc[ai][bj][m][0] * s, v1 = acc[ai][bj][m][1] * s;
                    u32x4 w; w.x = pk_bf16(v0[0], v0[1]); w.y = pk_bf16(v0[2], v0[3]); w.z = pk_bf16(v1[0], v1[1]); w.w = pk_bf16(v1[2], v1[3]);
                    *(u32x4*)(rowp + bj * HALF) = w; } }
    }
};
}

DI void p0_transpose_item(const float* W, int K, int N, bf16_t* WT, const float* g, int gmask, LAS float* scr, int item, int lane) {
    const int nblk = N / 32, kb = item / nblk, nb = item % nblk, k0 = 64 * kb, n0 = 32 * nb;
#pragma unroll 8
    for (int i = 0; i < 32; ++i) { const int kk = 2 * i + (lane >> 5); float w = W[(size_t)(k0 + kk) * N + n0 + (lane & 31)]; if (g) w *= g[(k0 + kk) & gmask]; scr[kk * 33 + (lane & 31)] = w; }
    LDS_WAIT(); asm volatile("" ::: "memory");
    const int c = lane & 7;
#pragma unroll
    for (int j = 0; j < 4; ++j) { const int n = (lane >> 3) + 8 * j; const LAS float* s = scr + (8 * c) * 33 + n;
        u32x4 o; o.x = pk_bf16(s[0 * 33], s[1 * 33]); o.y = pk_bf16(s[2 * 33], s[3 * 33]); o.z = pk_bf16(s[4 * 33], s[5 * 33]); o.w = pk_bf16(s[6 * 33], s[7 * 33]);
        *(u32x4*)(WT + (size_t)(n0 + n) * K + k0 + 8 * c) = o; }
    LDS_WAIT(); asm volatile("" ::: "memory");
}
DI unsigned pk_f16(float a, float b) { h16x2 v = {(_Float16)a, (_Float16)b}; return __builtin_bit_cast(unsigned, v); }

DI void p0_prologue(const Args& a, LAS unsigned char* lds, int vb, int G) {
    const int tid = threadIdx.x, lane = tid & 63, wave = tid >> 6;
    const int gw = vb * 8 + wave, NGW = G * 8, gt = vb * NTHR + tid, NGT = G * NTHR;
    unsigned char* ws = a.ws;
    LAS float* scr = (LAS float*)(lds + wave * 16384);
    constexpr int I_W1 = 16 * 152, I_AP = 8 * 32, I_HP = 8 * 32, I_OUT = 16 * 32, I_Q = 16 * 64, NITEMS = I_W1 + I_AP + I_HP + I_OUT + I_Q;
    for (int it = gw; it < NITEMS; it += NGW) {
        int r = it;
        if (r < I_W1) { p0_transpose_item(a.in[2], 1024, NIN, (bf16_t*)(ws + WS_W1T), a.in[1], 1023, scr, r, lane); continue; } r -= I_W1;
        if (r < I_AP) { p0_transpose_item(a.in[6], 512, 1024, (bf16_t*)(ws + WS_WAPT), nullptr, 0, scr, r, lane); continue; } r -= I_AP;
        if (r < I_HP) { p0_transpose_item(a.in[7], 512, 1024, (bf16_t*)(ws + WS_WHPT), a.in[5], 127, scr, r, lane); continue; } r -= I_HP;
        if (r < I_OUT) { p0_transpose_item(a.in[8], 1024, 1024, (bf16_t*)(ws + WS_WOUTT), nullptr, 0, scr, r, lane); continue; } r -= I_OUT;
        p0_transpose_item(a.in[10], 1024, 2048, (bf16_t*)(ws + WS_WQT), a.in[9], 1023, scr, r, lane);
    }
    for (int i = gt; i < 2 * 8 * 128 * 128 / 4; i += NGT) { const f32x4 v = ((const f32x4*)a.in[11])[i]; u32x2 o; o.x = pk_bf16(v[0], v[1]); o.y = pk_bf16(v[2], v[3]); ((u32x2*)(ws + WS_KEYS))[i] = o; }
    for (int i = gt; i < 16384 * 1024 / 4; i += NGT) {
        const f32x4 u = ((const f32x4*)a.in[12])[i], g = *(const f32x4*)(a.in[9] + ((i * 4) & 1023)), v = ((const f32x4*)a.in[13])[i];
        u32x2 o; o.x = pk_f16(u[0] * g[0], u[1] * g[1]); o.y = pk_f16(u[2] * g[2], u[3] * g[3]); ((u32x2*)(ws + WS_U16))[i] = o;
        u32x2 p; p.x = pk_f16(v[0], v[1]); p.y = pk_f16(v[2], v[3]); ((u32x2*)(ws + WS_V16))[i] = p;
    }
    for (int row = gw; row < T; row += NGW) {
        const f32x4* xr = (const f32x4*)(a.in[0] + (size_t)row * DM) + lane; f32x4 v[4]; float s = 0.f;
#pragma unroll
        for (int j = 0; j < 4; ++j) { v[j] = xr[64 * j]; s += (v[j][0] * v[j][0] + v[j][1] * v[j][1]) + (v[j][2] * v[j][2] + v[j][3] * v[j][3]); }
        s = wave_sum(s);
        u32x2* o = (u32x2*)(ws + WS_XB + (size_t)row * DM * 2) + lane;
#pragma unroll
        for (int j = 0; j < 4; ++j) { u32x2 w; w.x = pk_bf16(v[j][0], v[j][1]); w.y = pk_bf16(v[j][2], v[j][3]); o[64 * j] = w; }
        if (lane == 0) ((float*)(ws + WS_RSTD1))[row] = __builtin_amdgcn_rsqf(s * (1.f / 1024.f) + EPS);
    }
    if (vb == 0) { const float l0 = a.in[4][tid], l1 = a.in[4][512 + tid]; ((float*)(ws + WS_LB))[tid] = 1.f / (1.f + __expf(l1 - l0)); }
}

DI void attn_unit(const bf16_t* proj, const float* sinks, bf16_t* ya, LAS unsigned char* lds, int b, int tt) {
    const int tid = threadIdx.x, lane = tid & 63, wave = tid >> 6;
    LAS unsigned char* Ks = lds; LAS unsigned char* Vs = lds + 192 * 272;
    for (int c = tid; c < 192 * 16; c += NTHR) { const int jr = c >> 4, ch = c & 15, pos = tt * 64 - 128 + jr; u32x4 kv = {0u, 0u, 0u, 0u}, vv = {0u, 0u, 0u, 0u};
        if (pos >= 0) { const bf16_t* src = proj + (size_t)(b * SEQ + pos) * NIN; kv = *(const u32x4*)(src + C_AK + ch * 8); vv = *(const u32x4*)(src + C_AV + ch * 8); }
        *(LAS u32x4*)(Ks + jr * 272 + ch * 16) = kv; *(LAS u32x4*)(Vs + jr * 272 + ch * 16) = vv; }
    __syncthreads();
    const int h = wave, kvh = h >> 2, pos = tt * 64 + lane; const size_t t = (size_t)b * SEQ + pos;
    float q[64], o[64];
    { const u32x4* qp = (const u32x4*)(proj + t * NIN + C_AQ + h * 64);
#pragma unroll
      for (int c = 0; c < 8; ++c) { const u32x4 w = qp[c]; q[8 * c + 0] = bflo(w.x) * 0.125f; q[8 * c + 1] = bfhi(w.x) * 0.125f; q[8 * c + 2] = bflo(w.y) * 0.125f; q[8 * c + 3] = bfhi(w.y) * 0.125f;
          q[8 * c + 4] = bflo(w.z) * 0.125f; q[8 * c + 5] = bfhi(w.z) * 0.125f; q[8 * c + 6] = bflo(w.w) * 0.125f; q[8 * c + 7] = bfhi(w.w) * 0.125f; } }
#pragma unroll
    for (int d = 0; d < 64; ++d) o[d] = 0.f;
    float m = sinks[h], l = 1.f; const float slope = exp2f(-(float)(h + 1));
    for (int j0 = 0; j0 < 128; j0 += 2) {
        float s[2];
#pragma unroll
        for (int e = 0; e < 2; ++e) { const int j = j0 + e; const LAS unsigned char* kr = Ks + (lane + 128 - j) * 272 + kvh * 128; float acc = 0.f;
#pragma unroll
            for (int c = 0; c < 8; ++c) { const u32x4 w = *(const LAS u32x4*)(kr + c * 16);
                acc += q[8 * c + 0] * bflo(w.x) + q[8 * c + 1] * bfhi(w.x) + q[8 * c + 2] * bflo(w.y) + q[8 * c + 3] * bfhi(w.y) + q[8 * c + 4] * bflo(w.z) + q[8 * c + 5] * bfhi(w.z) + q[8 * c + 6] * bflo(w.w) + q[8 * c + 7] * bfhi(w.w); }
            s[e] = (pos - j >= 0) ? acc - slope * (float)j : -1e30f; }
        asm volatile("" ::: "memory");
        const float mn = fmaxf(m, fmaxf(s[0], s[1])), alpha = __expf(m - mn);
        const float p0 = __expf(s[0] - mn), p1 = __expf(s[1] - mn);
        l = l * alpha + (p0 + p1); m = mn;
        { const LAS unsigned char* vr0 = Vs + (lane + 128 - j0) * 272 + kvh * 128; const LAS unsigned char* vr1 = vr0 - 272;
#pragma unroll
            for (int c = 0; c < 8; ++c) { const u32x4 w = *(const LAS u32x4*)(vr0 + c * 16), x = *(const LAS u32x4*)(vr1 + c * 16);
                o[8 * c + 0] = o[8 * c + 0] * alpha + (p0 * bflo(w.x) + p1 * bflo(x.x)); o[8 * c + 1] = o[8 * c + 1] * alpha + (p0 * bfhi(w.x) + p1 * bfhi(x.x));
                o[8 * c + 2] = o[8 * c + 2] * alpha + (p0 * bflo(w.y) + p1 * bflo(x.y)); o[8 * c + 3] = o[8 * c + 3] * alpha + (p0 * bfhi(w.y) + p1 * bfhi(x.y));
                o[8 * c + 4] = o[8 * c + 4] * alpha + (p0 * bflo(w.z) + p1 * bflo(x.z)); o[8 * c + 5] = o[8 * c + 5] * alpha + (p0 * bfhi(w.z) + p1 * bfhi(x.z));
                o[8 * c + 6] = o[8 * c + 6] * alpha + (p0 * bflo(w.w) + p1 * bflo(x.w)); o[8 * c + 7] = o[8 * c + 7] * alpha + (p0 * bfhi(w.w) + p1 * bfhi(x.w)); } }
        asm volatile("" ::: "memory");
    }
    const float inv = 1.f / l; u32x4* op = (u32x4*)(ya + t * 512 + h * 64);
#pragma unroll
    for (int c = 0; c < 8; ++c) { u32x4 w; w.x = pk_bf16(o[8 * c + 0] * inv, o[8 * c + 1] * inv); w.y = pk_bf16(o[8 * c + 2] * inv, o[8 * c + 3] * inv); w.z = pk_bf16(o[8 * c + 4] * inv, o[8 * c + 5] * inv); w.w = pk_bf16(o[8 * c + 6] * inv, o[8 * c + 7] * inv); op[c] = w; }
    __syncthreads();
}

DI void hgrn_unit(const bf16_t* proj, const float* lbp, bf16_t* yh, LAS unsigned char* lds, int b, int h) {
    const int tid = threadIdx.x;
    LAS float* qs = (LAS float*)lds; LAS float* fs = qs + 2048; LAS float* ks = fs + 2048; LAS float* vs = ks + 2048; LAS float* gs = vs + 2048; LAS float* pos_ = gs + 2048;
    const int dv = tid & 127, dks = tid >> 7;
    float S[32];
#pragma unroll
    for (int d = 0; d < 32; ++d) S[d] = 0.f;
    const int g4 = tid >> 7, ltok = (tid & 127) >> 3, lch = tid & 7;
    const int gcol = (g4 == 0 ? C_HQ : g4 == 1 ? C_HF : g4 == 2 ? C_HI : C_HG) + h * 128 + lch * 16;
    float lb[16];
#pragma unroll
    for (int e = 0; e < 16; ++e) lb[e] = lbp[h * 128 + lch * 16 + e];
    for (int t0 = 0; t0 < SEQ; t0 += 16) {
        { const size_t t = (size_t)b * SEQ + t0 + ltok; const u32x4* src = (const u32x4*)(proj + t * NIN + gcol); const u32x4 w0 = src[0], w1 = src[1];
          float x[16] = {bflo(w0.x), bfhi(w0.x), bflo(w0.y), bfhi(w0.y), bflo(w0.z), bfhi(w0.z), bflo(w0.w), bfhi(w0.w), bflo(w1.x), bfhi(w1.x), bflo(w1.y), bfhi(w1.y), bflo(w1.z), bfhi(w1.z), bflo(w1.w), bfhi(w1.w)};
          const int o = ltok * 128 + lch * 16;
          if (g4 == 0) {
#pragma unroll
              for (int e = 0; e < 16; ++e) qs[o + e] = x[e] * sigm(x[e]);
          } else if (g4 == 1) {
#pragma unroll
              for (int e = 0; e < 16; ++e) { const float f = lb[e] + (1.f - lb[e]) * sigm(x[e]); fs[o + e] = f; ks[o + e] = 1.f - f; }
          } else if (g4 == 2) {
#pragma unroll
              for (int e = 0; e < 16; ++e) vs[o + e] = x[e];
          } else {
#pragma unroll
              for (int e = 0; e < 16; ++e) gs[o + e] = x[e] * sigm(x[e]);
          } }
        __syncthreads();
#pragma unroll 1
        for (int tok = 0; tok < 16; ++tok) {
            const float v = vs[tok * 128 + dv]; float po = 0.f;
#pragma unroll
            for (int d4 = 0; d4 < 8; ++d4) { const int o = tok * 128 + dks * 32 + d4 * 4;
                const f32x4 f = *(const LAS f32x4*)(fs + o), k = *(const LAS f32x4*)(ks + o), q = *(const LAS f32x4*)(qs + o);
#pragma unroll
                for (int e = 0; e < 4; ++e) { S[4 * d4 + e] = f[e] * S[4 * d4 + e] + k[e] * v; po += q[e] * S[4 * d4 + e]; } }
            pos_[(tok * 4 + dks) * 128 + dv] = po;
        }
        __syncthreads();
        { const int tok = tid >> 5, dv4 = (tid & 31) * 4; f32x4 o = {0.f, 0.f, 0.f, 0.f};
#pragma unroll
          for (int s = 0; s < 4; ++s) o += *(const LAS f32x4*)(pos_ + (tok * 4 + s) * 128 + dv4);
          float ss = (o[0] * o[0] + o[1] * o[1]) + (o[2] * o[2] + o[3] * o[3]);
#pragma unroll
          for (int x = 1; x < 32; x <<= 1) ss += __shfl_xor(ss, x);
          const float r = __builtin_amdgcn_rsqf(ss * (1.f / 128.f) + EPS); const f32x4 g = *(const LAS f32x4*)(gs + tok * 128 + dv4);
          u32x2 w; w.x = pk_bf16(o[0] * r * g[0], o[1] * r * g[1]); w.y = pk_bf16(o[2] * r * g[2], o[3] * r * g[3]);
          *(u32x2*)(yh + ((size_t)b * SEQ + t0 + tok) * 512 + h * 128 + dv4) = w; }
        __syncthreads();
    }
}

DI unsigned f2ord(float f) { const unsigned b = __float_as_uint(f); return b ^ ((unsigned)((int)b >> 31) | 0x80000000u); }
DI float ord2f(unsigned k) { const unsigned b = (k & 0x80000000u) ? (k ^ 0x80000000u) : ~k; return __uint_as_float(b); }
#define TK_INS(L, x) do { unsigned t_ = (x); _Pragma("unroll") for (int j_ = 0; j_ < 16; ++j_) { const unsigned hi_ = L[j_] > t_ ? L[j_] : t_; t_ = L[j_] > t_ ? t_ : L[j_]; L[j_] = hi_; } } while (0)
#define MFMA32(a, b, c) __builtin_amdgcn_mfma_f32_32x32x16_bf16((a), (b), (c), 0, 0, 0)

DI void topk_unit(const bf16_t* qp, const bf16_t* keysb, unsigned short* gidx, float* ggate, LAS unsigned char* lds, int tile, int h) {
    const int tid = threadIdx.x, lane = tid & 63, wave = tid >> 6, p = wave & 1, tsub = wave >> 1, r = lane & 31, hh = lane >> 5;
    const int tok0 = tile * 128 + tsub * 32;
    f32x16 acc[4];
#pragma unroll
    for (int kb = 0; kb < 4; ++kb)
#pragma unroll
        for (int i = 0; i < 16; ++i) acc[kb][i] = 0.f;
    const bf16_t* qrow = qp + (size_t)(tok0 + r) * 2048 + h * 256 + p * 128 + 8 * hh;
    const bf16_t* kbase = keysb + ((size_t)(p * 8 + h) * 128 + r) * 128 + 8 * hh;
#pragma unroll
    for (int s = 0; s < 8; ++s) { const bf16x8 bq = *(const bf16x8*)(qrow + 16 * s);
#pragma unroll
        for (int kb = 0; kb < 4; ++kb) { const bf16x8 ak = *(const bf16x8*)(kbase + (size_t)kb * 32 * 128 + 16 * s); acc[kb] = MFMA32(ak, bq, acc[kb]); } }
    unsigned L[16];
#pragma unroll
    for (int j = 0; j < 16; ++j) L[j] = 0u;
#pragma unroll
    for (int kb = 0; kb < 4; ++kb)
#pragma unroll
        for (int i = 0; i < 16; ++i) { const unsigned key = (f2ord(acc[kb][i]) & ~127u) | (unsigned)(32 * kb + (i & 3) + 8 * (i >> 2) + 4 * hh); TK_INS(L, key); }
    { unsigned P[16];
#pragma unroll
      for (int j = 0; j < 16; ++j) P[j] = __shfl_xor(L[j], 32);
#pragma unroll
      for (int j = 0; j < 16; ++j) TK_INS(L, P[j]); }
    LAS unsigned* tk = (LAS unsigned*)lds;
    if (hh == 0) { LAS u32x4* dst = (LAS u32x4*)(tk + ((p * 128 + tsub * 32 + r) * 16));
#pragma unroll
        for (int c = 0; c < 4; ++c) { u32x4 w = {L[4 * c], L[4 * c + 1], L[4 * c + 2], L[4 * c + 3]}; dst[c] = w; } }
    __syncthreads();
    if (tid < 128) {
        unsigned L1[16], L2[16];
        { const LAS u32x4* s1 = (const LAS u32x4*)(tk + tid * 16); const LAS u32x4* s2 = (const LAS u32x4*)(tk + (128 + tid) * 16);
#pragma unroll
          for (int c = 0; c < 4; ++c) { const u32x4 a = s1[c], b = s2[c]; L1[4 * c] = a.x; L1[4 * c + 1] = a.y; L1[4 * c + 2] = a.z; L1[4 * c + 3] = a.w; L2[4 * c] = b.x; L2[4 * c + 1] = b.y; L2[4 * c + 2] = b.z; L2[4 * c + 3] = b.w; } }
        float v1[16], v2[16];
#pragma unroll
        for (int j = 0; j < 16; ++j) { v1[j] = ord2f(L1[j] & ~127u); v2[j] = ord2f(L2[j] & ~127u); }
        unsigned C[16];
#pragma unroll
        for (int j = 0; j < 16; ++j) C[j] = 0u;
#pragma unroll
        for (int i = 0; i < 16; ++i)
#pragma unroll
            for (int j = 0; j < 16; ++j) if ((i + 1) * (j + 1) <= 16) { const unsigned key = (f2ord(v1[i] + v2[j]) & ~255u) | (unsigned)(i * 16 + j); TK_INS(C, key); }
        float sc[16]; unsigned ei[16]; float mx = -1e30f;
#pragma unroll
        for (int q = 0; q < 16; ++q) { const unsigned ij = C[q] & 255u; const unsigned a = tk[tid * 16 + (ij >> 4)], b = tk[(128 + tid) * 16 + (ij & 15u)];
            sc[q] = ord2f(a & ~127u) + ord2f(b & ~127u); ei[q] = (a & 127u) * 128u + (b & 127u); mx = fmaxf(mx, sc[q]); }
        float sum = 0.f;
#pragma unroll
        for (int q = 0; q < 16; ++q) { sc[q] = __expf(sc[q] - mx); sum += sc[q]; }
        const float inv = 1.f / sum; const size_t o = (size_t)(tile * 128 + tid) * 128 + h * 16;
#pragma unroll
        for (int q = 0; q < 16; ++q) { gidx[o + q] = (unsigned short)ei[q]; ggate[o + q] = sc[q] * inv; }
    }
    __syncthreads();
}

DI float dot8(h16x8 a, const h16x2 (&b)[4], float c) {
    const h16x2 a0 = {a[0], a[1]}, a1 = {a[2], a[3]}, a2 = {a[4], a[5]}, a3 = {a[6], a[7]};
    c = __builtin_amdgcn_fdot2(a0, b[0], c, false); c = __builtin_amdgcn_fdot2(a1, b[1], c, false); c = __builtin_amdgcn_fdot2(a2, b[2], c, false); c = __builtin_amdgcn_fdot2(a3, b[3], c, false); return c;
}
DI float gelu_erf(float x) { return 0.5f * x * (1.f + erff(x * 0.70710678118654752f)); }

DI void expert_token(const float* x2row, const float* ssq, const _Float16* u16, const _Float16* v16, const unsigned short* gidx, const float* ggate, const float* gf, float* outrow, int lane) {
    const f32x4 xa0 = *(const f32x4*)(x2row + 8 * lane), xa1 = *(const f32x4*)(x2row + 8 * lane + 4), xb0 = *(const f32x4*)(x2row + 512 + 8 * lane), xb1 = *(const f32x4*)(x2row + 512 + 8 * lane + 4);
    float ss = (lane < 16) ? ssq[lane] : 0.f; ss = wave_sum(ss);
    const float rstd2 = __builtin_amdgcn_rsqf(ss * (1.f / 1024.f) + EPS);
    h16x2 ha[4], hb[4];
    ha[0] = (h16x2){(_Float16)(xa0[0] * rstd2), (_Float16)(xa0[1] * rstd2)}; ha[1] = (h16x2){(_Float16)(xa0[2] * rstd2), (_Float16)(xa0[3] * rstd2)};
    ha[2] = (h16x2){(_Float16)(xa1[0] * rstd2), (_Float16)(xa1[1] * rstd2)}; ha[3] = (h16x2){(_Float16)(xa1[2] * rstd2), (_Float16)(xa1[3] * rstd2)};
    hb[0] = (h16x2){(_Float16)(xb0[0] * rstd2), (_Float16)(xb0[1] * rstd2)}; hb[1] = (h16x2){(_Float16)(xb0[2] * rstd2), (_Float16)(xb0[3] * rstd2)};
    hb[2] = (h16x2){(_Float16)(xb1[0] * rstd2), (_Float16)(xb1[1] * rstd2)}; hb[3] = (h16x2){(_Float16)(xb1[2] * rstd2), (_Float16)(xb1[3] * rstd2)};
    const int id0 = gidx[lane], id1 = gidx[64 + lane]; const float g0 = ggate[lane], g1 = ggate[64 + lane];
    float oa[8], ob[8];
#pragma unroll
    for (int e = 0; e < 8; ++e) { oa[e] = 0.f; ob[e] = 0.f; }
#pragma unroll 1
    for (int bt = 0; bt < 8; ++bt) {
        const int idsel = (bt < 4) ? id0 : id1; const float gsel = (bt < 4) ? g0 : g1; const int lb = (bt & 3) * 16;
        float pr[16];
#pragma unroll
        for (int e = 0; e < 16; ++e) { const int idx = __builtin_amdgcn_readlane(idsel, lb + e); const _Float16* up = u16 + (size_t)idx * 1024;
            const h16x8 ua = *(const h16x8*)(up + 8 * lane), ub = *(const h16x8*)(up + 512 + 8 * lane); pr[e] = dot8(ub, hb, dot8(ua, ha, 0.f)); }
        float q8[8], q4[4], q2[2], q1;
        { const bool up_ = (lane & 32) != 0;
#pragma unroll
          for (int i = 0; i < 8; ++i) { const float keep = up_ ? pr[i + 8] : pr[i], send = up_ ? pr[i] : pr[i + 8]; q8[i] = keep + __shfl_xor(send, 32); } }
        { const bool up_ = (lane & 16) != 0;
#pragma unroll
          for (int i = 0; i < 4; ++i) { const float keep = up_ ? q8[i + 4] : q8[i], send = up_ ? q8[i] : q8[i + 4]; q4[i] = keep + __shfl_xor(send, 16); } }
        { const bool up_ = (lane & 8) != 0;
#pragma unroll
          for (int i = 0; i < 2; ++i) { const float keep = up_ ? q4[i + 2] : q4[i], send = up_ ? q4[i] : q4[i + 2]; q2[i] = keep + __shfl_xor(send, 8); } }
        { const bool up_ = (lane & 4) != 0; const float keep = up_ ? q2[1] : q2[0], send = up_ ? q2[0] : q2[1]; q1 = keep + __shfl_xor(send, 4); }
        q1 += __shfl_xor(q1, 2); q1 += __shfl_xor(q1, 1);
        const float gate = __shfl(gsel, lb + (lane >> 2));
        const float w = gelu_erf(q1) * gate;
#pragma unroll
        for (int e = 0; e < 16; ++e) { const int idx = __builtin_amdgcn_readlane(idsel, lb + e); const float we = __int_as_float(__builtin_amdgcn_readlane(__float_as_int(w), 4 * e)); const _Float16* vp = v16 + (size_t)idx * 1024;
            const h16x8 va = *(const h16x8*)(vp + 8 * lane), vb = *(const h16x8*)(vp + 512 + 8 * lane);
#pragma unroll
            for (int i = 0; i < 8; ++i) { oa[i] += we * (float)va[i]; ob[i] += we * (float)vb[i]; } }
    }
    float y[16] = {xa0[0] + oa[0], xa0[1] + oa[1], xa0[2] + oa[2], xa0[3] + oa[3], xa1[0] + oa[4], xa1[1] + oa[5], xa1[2] + oa[6], xa1[3] + oa[7],
                   xb0[0] + ob[0], xb0[1] + ob[1], xb0[2] + ob[2], xb0[3] + ob[3], xb1[0] + ob[4], xb1[1] + ob[5], xb1[2] + ob[6], xb1[3] + ob[7]};
    float s3 = 0.f;
#pragma unroll
    for (int i = 0; i < 16; ++i) s3 += y[i] * y[i];
    s3 = wave_sum(s3); const float r3 = __builtin_amdgcn_rsqf(s3 * (1.f / 1024.f) + EPS);
    const f32x4 ga0 = *(const f32x4*)(gf + 8 * lane), ga1 = *(const f32x4*)(gf + 8 * lane + 4), gb0 = *(const f32x4*)(gf + 512 + 8 * lane), gb1 = *(const f32x4*)(gf + 512 + 8 * lane + 4);
    *(f32x4*)(outrow + 8 * lane) = (f32x4){y[0] * r3 * ga0[0], y[1] * r3 * ga0[1], y[2] * r3 * ga0[2], y[3] * r3 * ga0[3]};
    *(f32x4*)(outrow + 8 * lane + 4) = (f32x4){y[4] * r3 * ga1[0], y[5] * r3 * ga1[1], y[6] * r3 * ga1[2], y[7] * r3 * ga1[3]};
    *(f32x4*)(outrow + 512 + 8 * lane) = (f32x4){y[8] * r3 * gb0[0], y[9] * r3 * gb0[1], y[10] * r3 * gb0[2], y[11] * r3 * gb0[3]};
    *(f32x4*)(outrow + 512 + 8 * lane + 4) = (f32x4){y[12] * r3 * gb1[0], y[13] * r3 * gb1[1], y[14] * r3 * gb1[2], y[15] * r3 * gb1[3]};
}

constexpr int N_PHASES = 8;
__global__ void __launch_bounds__(NTHR, 2) mk_fwd(Args a) {
    extern __shared__ __attribute__((aligned(16))) unsigned char lds_raw[];
    LAS unsigned char* lds = (LAS unsigned char*)lds_raw;
    cg::grid_group grid = cg::this_grid();
    const int G = gridDim.x, vb = blockIdx.x, tid = threadIdx.x, lane = tid & 63, wave = tid >> 6;
    unsigned char* ws = a.ws;
    const int lo = a.ph_lo, hi = a.ph_hi;
#ifndef PHASE_MASK
#define PHASE_MASK 0xFF
#endif
#define IN(k) (((PHASE_MASK >> (k)) & 1) && lo <= (k) && (k) < hi)
#define SEAM(k) do { if (IN(k) && IN((k) + 1)) grid.sync(); } while (0)
    bf16_t* proj = (bf16_t*)(ws + WS_PROJ);

    if (IN(0)) p0_prologue(a, lds, vb, G);
    SEAM(0);
    if (IN(1)) { pg8::Gemm g{(const bf16_t*)(ws + WS_XB), (const bf16_t*)(ws + WS_W1T), T, NIN, 1024}; pg8::StaticOrder S; S.init(T, NIN, G, vb);
        pg8::EpiRowScale E{proj, NIN, (const float*)(ws + WS_RSTD1)};
        pg8::gemm_phase<pg8::EpiRowScale, pg8::StaticOrder, true, true>(lds, g, S, E); }
    SEAM(1);
    if (IN(2)) {
        const int nh = (G > 64) ? 64 : G;
        if (vb < nh) for (int u = vb; u < 64; u += nh) hgrn_unit(proj, (const float*)(ws + WS_LB), (bf16_t*)(ws + WS_YH), lds, u >> 2, u & 3);
        if (G <= 64 || vb >= 64) { const int a0 = (G > 64) ? vb - 64 : vb, na = (G > 64) ? G - 64 : G;
            for (int u = a0; u < BATCH * (SEQ / 64); u += na) attn_unit(proj, a.in[3], (bf16_t*)(ws + WS_YA), lds, u / (SEQ / 64), u % (SEQ / 64)); }
    }
    SEAM(2);
    if (IN(3)) {
        { pg8::Gemm g{(const bf16_t*)(ws + WS_YA), (const bf16_t*)(ws + WS_WAPT), T, 1024, 512}; pg8::StaticOrder S; S.init(T, 1024, G, vb);
          pg8::EpiMerge<false> E{(bf16_t*)(ws + WS_XB), proj + C_GA};
          pg8::gemm_phase<pg8::EpiMerge<false>, pg8::StaticOrder, true, true>(lds, g, S, E); }
        __syncthreads();
        { pg8::Gemm g{(const bf16_t*)(ws + WS_YH), (const bf16_t*)(ws + WS_WHPT), T, 1024, 512}; pg8::StaticOrder S; S.init(T, 1024, G, vb);
          pg8::EpiMerge<true> E{(bf16_t*)(ws + WS_XB), proj + C_GH};
          pg8::gemm_phase<pg8::EpiMerge<true>, pg8::StaticOrder, true, true>(lds, g, S, E); }
    }
    SEAM(3);
    if (IN(4)) { pg8::Gemm g{(const bf16_t*)(ws + WS_XB), (const bf16_t*)(ws + WS_WOUTT), T, 1024, 1024}; pg8::StaticOrder S; S.init(T, 1024, G, vb);
        pg8::EpiX2 E{a.in[0], a.out, (bf16_t*)(ws + WS_X2B), (float*)(ws + WS_SSQ2)};
        pg8::gemm_phase<pg8::EpiX2, pg8::StaticOrder, true, true>(lds, g, S, E); }
    SEAM(4);
    if (IN(5)) { pg8::Gemm g{(const bf16_t*)(ws + WS_X2B), (const bf16_t*)(ws + WS_WQT), T, 2048, 1024}; pg8::StaticOrder S; S.init(T, 2048, G, vb);
        pg8::EpiQp E{(bf16_t*)(ws + WS_QP), (const float*)(ws + WS_SSQ2)};
        pg8::gemm_phase<pg8::EpiQp, pg8::StaticOrder, true, true>(lds, g, S, E); }
    SEAM(5);
    if (IN(6)) for (int u = vb; u < (T / 128) * 8; u += G) topk_unit((const bf16_t*)(ws + WS_QP), (const bf16_t*)(ws + WS_KEYS), (unsigned short*)(ws + WS_GIDX), (float*)(ws + WS_GGATE), lds, u >> 3, u & 7);
    SEAM(6);
    if (IN(7)) for (int tok = vb * 8 + wave; tok < T; tok += G * 8)
        expert_token(a.out + (size_t)tok * DM, (const float*)(ws + WS_SSQ2) + (size_t)tok * 16, (const _Float16*)(ws + WS_U16), (const _Float16*)(ws + WS_V16),
                     (const unsigned short*)(ws + WS_GIDX) + (size_t)tok * 128, (const float*)(ws + WS_GGATE) + (size_t)tok * 128, a.in[14], a.out + (size_t)tok * DM, lane);
#undef IN
#undef SEAM
}

extern "C" void kernel_launch(void* const* d_in, const int* in_sizes, int n_in, void* d_out, int out_size, void* d_ws, size_t ws_size, hipStream_t stream) {
    static int grid = 0;
    if (grid == 0) {
        if (n_in != 15 || in_sizes[0] != T * DM || out_size != T * DM || ws_size < WS_END) { fprintf(stderr, "kernel_launch: unexpected shapes (n_in %d, in0 %d, out %d, ws %zu)\n", n_in, n_in > 0 ? in_sizes[0] : -1, out_size, ws_size); grid = -1; return; }
        int dev = 0, cus = 0, per_cu = 0;
        hipGetDevice(&dev); hipDeviceGetAttribute(&cus, hipDeviceAttributeMultiprocessorCount, dev);
        if (hipFuncSetAttribute((const void*)mk_fwd, hipFuncAttributeMaxDynamicSharedMemorySize, LDS_BYTES) != hipSuccess) { fprintf(stderr, "kernel_launch: hipFuncSetAttribute failed\n"); grid = -1; return; }
        if (hipOccupancyMaxActiveBlocksPerMultiprocessor(&per_cu, (const void*)mk_fwd, NTHR, LDS_BYTES) != hipSuccess || per_cu < 1) { fprintf(stderr, "kernel_launch: occupancy query says %d blocks per CU\n", per_cu); per_cu = 1; }
        (void)hipGetLastError();
        grid = cus;
    }
    if (grid < 0) return;
    Args a{};
    for (int i = 0; i < 15; ++i) a.in[i] = (const float*)d_in[i];
    a.out = (float*)d_out; a.ws = (unsigned char*)d_ws;
#if MK_FUSED
    a.ph_lo = 0; a.ph_hi = N_PHASES;
    { void* args[] = {&a}; hipError_t e = hipLaunchCooperativeKernel((const void*)mk_fwd, dim3(grid), dim3(NTHR), args, LDS_BYTES, stream);
      if (e != hipSuccess) fprintf(stderr, "kernel_launch: cooperative launch failed: %s (grid %d)\n", hipGetErrorString(e), grid); }
#else
    for (int p = 0; p < N_PHASES; ++p) { a.ph_lo = p; a.ph_hi = p + 1; void* args[] = {&a};
        hipError_t e = hipLaunchCooperativeKernel((const void*)mk_fwd, dim3(grid), dim3(NTHR), args, LDS_BYTES, stream);
        if (e != hipSuccess) { fprintf(stderr, "kernel_launch: launch of phase %d failed: %s (grid %d)\n", p, hipGetErrorString(e), grid); break; } }
#endif
}
```

```cpp
#include <hip/hip_runtime.h>
#include <hip/hip_cooperative_groups.h>
#include <cstdio>
#include <cstdint>
namespace cg = cooperative_groups;
namespace pg8 {
#define PG8_LAS __attribute__((address_space(3)))
typedef unsigned short bf16_t;
typedef short bf16x8 __attribute__((ext_vector_type(8)));
typedef float f32x4 __attribute__((ext_vector_type(4)));
typedef unsigned u32x4 __attribute__((ext_vector_type(4)));
constexpr int BM = 256, BK = 64, HALF = 128, HTB = HALF * BK * 2  , STAGE_BYTES = 8 * HTB, NXCD = 8, WGM = 8;

__host__ __device__ __forceinline__ int lds_byte(int r, int c) { const int st = (r >> 4) * 2 + (c >> 5), rr = r & 15, cc = c & 31, ob = rr * 64 + cc * 2; return st * 1024 + (ob ^ (((ob >> 9) & 1) << 5)); }
__host__ __device__ __forceinline__ void stage_rc(int b, int& R, int& C) { const int st = b / 1024, sb = b % 1024, swz = sb ^ (((sb >> 9) & 1) << 5); R = (st >> 1) * 16 + swz / 64; C = (st & 1) * 32 + (swz % 64) / 2; }
__host__ __device__ __forceinline__ int perm32(int rho) { const int n = rho >> 4, i = rho & 15; return 8 * (i >> 2) + 4 * n + (i & 3); }

struct Unit { int pm, pn; };
struct Gemm { const bf16_t* A; const bf16_t* Bt; int M, N, K; };

struct StaticOrder {
    int nM, nN, nwg, G, c;
    __host__ __device__ void init(int M, int N, int G_, int c_) { nM = M / BM; nN = N / BM; nwg = nM * nN; G = G_; c = c_; }
    __host__ __device__ bool next(int i, Unit& u) const {
        const long L = (long)i * G + c; if (L >= nwg) return false;
        int wgid = (int)L; { const int q = nwg / NXCD, r = nwg % NXCD, xcd = wgid % NXCD, off = wgid / NXCD; wgid = (xcd < r ? xcd * (q + 1) : r * (q + 1) + (xcd - r) * q) + off; }
        const int nig = WGM * nN, gid = wgid / nig, fm = gid * WGM, gsz = (nM - fm) < WGM ? (nM - fm) : WGM;
        u.pm = fm + ((wgid % nig) % gsz); u.pn = (wgid % nig) / gsz; return true;
    }
    __device__ __forceinline__ void a_ready(const Unit&) const {}
    __device__ __forceinline__ void done(const Unit&) const {}
};

__device__ __forceinline__ unsigned cvt_pk_bf16(float lo, float hi) { unsigned r; asm volatile("v_cvt_pk_bf16_f32 %0, %1, %2" : "=v"(r) : "v"(lo), "v"(hi)); return r; }

template <class Epi, class Sched, bool ALIGN_EPI = false, bool SP2 = false>
__device__ __forceinline__ void gemm_phase(PG8_LAS unsigned char* lds, const Gemm g, const Sched& S, const Epi& E) {
    const int tid = threadIdx.x, wid = __builtin_amdgcn_readfirstlane(tid >> 6), lane = tid & 63, wr = wid >> 2, wc = wid & 3, fr = lane & 15, fq = lane >> 4;
    const int K = g.K, nt = K / BK;
    unsigned voffA[2], voffB[2];
#pragma unroll
    for (int i = 0; i < 2; ++i) { int R, C; stage_rc(tid * 16 + i * 8192, R, C); const int Rb = Epi::PERM ? ((R & ~31) + perm32(R & 31)) : R;
        voffA[i] = (unsigned)(R * K + C) * 2u; voffB[i] = (unsigned)(Rb * K + C) * 2u; }
    const size_t kstep = (size_t)(BK * 2);
    const size_t hstep = (size_t)HALF * K * 2;
    const size_t tstep = 2 * hstep;
    const unsigned ldsw = (unsigned)wid * 1024u;
    const int aoff = lds_byte(wr * 64 + fr, fq * 8), boff = lds_byte(wc * 32 + fr, fq * 8);
#define PG8_SA(b, h) (((b) * 2 + (h)) * HTB)
#define PG8_SB(b, h) ((4 + (b) * 2 + (h)) * HTB)
#define PG8_STAGE(bufoff, gbase, voff) do { _Pragma("unroll") for (int _i = 0; _i < 2; ++_i) \
        __builtin_amdgcn_global_load_lds((const unsigned*)((const char*)(gbase) + (voff)[_i]), (PG8_LAS unsigned*)(lds + (bufoff) + ldsw + _i * 8192), 16, 0, 0); } while (0)
#define PG8_LDA(dst, b, h) do { _Pragma("unroll") for (int m = 0; m < 4; ++m) _Pragma("unroll") for (int k = 0; k < 2; ++k) dst[m][k] = *(const PG8_LAS bf16x8*)(lds + PG8_SA(b, h) + aoff + m * 2048 + k * 1024); } while (0)
#define PG8_LDB(dst, b, h) do { _Pragma("unroll") for (int n = 0; n < 2; ++n) _Pragma("unroll") for (int k = 0; k < 2; ++k) dst[n][k] = *(const PG8_LAS bf16x8*)(lds + PG8_SB(b, h) + boff + n * 2048 + k * 1024); } while (0)
#define PG8_MMA(ai, bj, At, Bt) do { __builtin_amdgcn_s_setprio(1); _Pragma("unroll") for (int m = 0; m < 4; ++m) _Pragma("unroll") for (int n = 0; n < 2; ++n) _Pragma("unroll") for (int k = 0; k < 2; ++k) \
        acc[ai][bj][m][n] = __builtin_amdgcn_mfma_f32_16x16x32_bf16(Bt[n][k], At[m][k], acc[ai][bj][m][n], 0, 0, 0); __builtin_amdgcn_s_setprio(0); } while (0)
#define PG8_WAIT_V(n) asm volatile("s_waitcnt vmcnt(" #n ")" ::: "memory")
#define PG8_WAIT_L(n) asm volatile("s_waitcnt lgkmcnt(" #n ")" ::: "memory")
#define PG8_BAR __builtin_amdgcn_s_barrier()
#define PG8_SCHED __builtin_amdgcn_sched_barrier(0)
    Unit cur, nxt; int ui = 0;
    if (!S.next(0, cur)) return;
    f32x4 acc[2][2][4][2];
#pragma unroll
    for (int a = 0; a < 2; ++a)
#pragma unroll
        for (int b = 0; b < 2; ++b)
#pragma unroll
            for (int m = 0; m < 4; ++m)
#pragma unroll
                for (int n = 0; n < 2; ++n) acc[a][b][m][n] = (f32x4){0.f, 0.f, 0.f, 0.f};
    bf16x8 At[4][2], B0[2][2], B1[2][2];
    const char* cA = (const char*)g.A + (size_t)cur.pm * tstep; const char* cB = (const char*)g.Bt + (size_t)cur.pn * tstep;
    S.a_ready(cur);
    if constexpr (SP2) {
        PG8_STAGE(PG8_SB(0, 0), cB, voffB); PG8_STAGE(PG8_SB(0, 1), cB + hstep, voffB); PG8_STAGE(PG8_SA(0, 0), cA, voffA); PG8_STAGE(PG8_SA(0, 1), cA + hstep, voffA);
        if (wr == 1) PG8_BAR;
        PG8_WAIT_V(2); PG8_BAR;
        PG8_STAGE(PG8_SB(1, 0), cB + kstep, voffB); PG8_STAGE(PG8_SA(1, 0), cA + kstep, voffA); PG8_STAGE(PG8_SB(1, 1), cB + hstep + kstep, voffB);
        PG8_WAIT_V(6); PG8_BAR;
    } else {
        PG8_STAGE(PG8_SB(0, 0), cB, voffB); PG8_STAGE(PG8_SA(0, 0), cA, voffA); PG8_STAGE(PG8_SB(0, 1), cB + hstep, voffB); PG8_STAGE(PG8_SA(0, 1), cA + hstep, voffA);
        if (wr == 1) PG8_BAR;
        PG8_WAIT_V(4); PG8_BAR;
        PG8_STAGE(PG8_SB(1, 0), cB + kstep, voffB); PG8_STAGE(PG8_SA(1, 0), cA + kstep, voffA); PG8_STAGE(PG8_SB(1, 1), cB + hstep + kstep, voffB);
        PG8_WAIT_V(6); PG8_BAR;
    }
    for (;;) {
        const bool has_next = S.next(ui + 1, nxt);
        const char* nA = has_next ? (const char*)g.A + (size_t)nxt.pm * tstep : cA; const char* nB = has_next ? (const char*)g.Bt + (size_t)nxt.pn * tstep : cB;
        for (int t = 0; t < nt; t += 2) {
            const bool last = (t == nt - 2);
            const char* a1 = cA + (size_t)(t + 1) * kstep;
            const char* a2 = last ? nA : cA + (size_t)(t + 2) * kstep; const char* b2 = last ? nB : cB + (size_t)(t + 2) * kstep;
            const char* a3 = a2 + kstep; const char* b3 = b2 + kstep;
            if (last && has_next) S.a_ready(nxt);
            if constexpr (SP2) {
            PG8_LDB(B0, 0, 0); PG8_LDB(B1, 0, 1); PG8_SCHED; PG8_LDA(At, 0, 0); PG8_STAGE(PG8_SA(1, 1), a1 + hstep, voffA);
            PG8_WAIT_V(8); PG8_WAIT_L(0); PG8_BAR; PG8_MMA(0, 0, At, B0); PG8_MMA(0, 1, At, B1); PG8_BAR; PG8_SCHED;
            PG8_LDA(At, 0, 1); PG8_STAGE(PG8_SB(0, 0), b2, voffB); PG8_STAGE(PG8_SB(0, 1), b2 + hstep, voffB); PG8_STAGE(PG8_SA(0, 0), a2, voffA);
            PG8_WAIT_V(8); PG8_WAIT_L(0); PG8_BAR; PG8_MMA(1, 0, At, B0); PG8_MMA(1, 1, At, B1); PG8_BAR; PG8_SCHED;
            PG8_LDB(B0, 1, 0); PG8_LDB(B1, 1, 1); PG8_SCHED; PG8_LDA(At, 1, 0); PG8_STAGE(PG8_SA(0, 1), a2 + hstep, voffA);
            PG8_WAIT_V(8); PG8_WAIT_L(0); PG8_BAR; PG8_MMA(0, 0, At, B0); PG8_MMA(0, 1, At, B1); PG8_BAR; PG8_SCHED;
            PG8_LDA(At, 1, 1); PG8_STAGE(PG8_SB(1, 0), b3, voffB); PG8_STAGE(PG8_SB(1, 1), b3 + hstep, voffB); PG8_STAGE(PG8_SA(1, 0), a3, voffA);
            PG8_WAIT_V(8); PG8_WAIT_L(0); PG8_BAR; PG8_MMA(1, 0, At, B0); PG8_MMA(1, 1, At, B1); PG8_BAR; PG8_SCHED;
            } else {
            PG8_LDB(B0, 0, 0); PG8_SCHED; PG8_LDA(At, 0, 0); PG8_STAGE(PG8_SA(1, 1), a1 + hstep, voffA);
            PG8_WAIT_L(8); PG8_BAR; PG8_WAIT_L(0); PG8_MMA(0, 0, At, B0); PG8_BAR; PG8_SCHED;
            PG8_LDB(B1, 0, 1); PG8_STAGE(PG8_SB(0, 0), b2, voffB);
            PG8_BAR; PG8_WAIT_L(0); PG8_MMA(0, 1, At, B1); PG8_BAR;
            PG8_LDA(At, 0, 1); PG8_STAGE(PG8_SA(0, 0), a2, voffA);
            PG8_BAR; PG8_WAIT_L(0); PG8_MMA(1, 0, At, B0); PG8_BAR; PG8_SCHED;
            PG8_STAGE(PG8_SB(0, 1), b2 + hstep, voffB);
            PG8_WAIT_V(6); PG8_BAR; PG8_MMA(1, 1, At, B1); PG8_BAR;
            PG8_LDB(B0, 1, 0); PG8_SCHED; PG8_LDA(At, 1, 0); PG8_STAGE(PG8_SA(0, 1), a2 + hstep, voffA);
            PG8_WAIT_L(8); PG8_BAR; PG8_WAIT_L(0); PG8_MMA(0, 0, At, B0); PG8_BAR; PG8_SCHED;
            PG8_LDB(B1, 1, 1); PG8_STAGE(PG8_SB(1, 0), b3, voffB);
            PG8_BAR; PG8_WAIT_L(0); PG8_MMA(0, 1, At, B1); PG8_BAR;
            PG8_LDA(At, 1, 1); PG8_STAGE(PG8_SA(1, 0), a3, voffA);
            PG8_BAR; PG8_WAIT_L(0); PG8_MMA(1, 0, At, B0); PG8_BAR; PG8_SCHED;
            PG8_STAGE(PG8_SB(1, 1), b3 + hstep, voffB);
            PG8_WAIT_V(6); PG8_BAR; PG8_MMA(1, 1, At, B1); PG8_BAR;
            }
        }
        if constexpr (ALIGN_EPI) { if (wr == 0) PG8_BAR; }
        if constexpr (!Epi::AFTER_DRAIN) { E(acc, cur, wr, wc, fr, fq); S.done(cur); }
        if (!has_next) break;
#pragma unroll
        for (int a = 0; a < 2; ++a)
#pragma unroll
            for (int b = 0; b < 2; ++b)
#pragma unroll
                for (int m = 0; m < 4; ++m)
#pragma unroll
                    for (int n = 0; n < 2; ++n) acc[a][b][m][n] = (f32x4){0.f, 0.f, 0.f, 0.f};
        cur = nxt; cA = nA; cB = nB; ++ui;
        if constexpr (ALIGN_EPI) { if (wr == 1) PG8_BAR; }
    }
    PG8_WAIT_V(0);
    if constexpr (!ALIGN_EPI) { if (wr == 0) PG8_BAR; }
    PG8_BAR;
    if constexpr (Epi::AFTER_DRAIN) { E.fused(acc, cur, wr, wc, fr, fq, lds, wid, lane); S.done(cur); }
#undef PG8_SA
#undef PG8_SB
#undef PG8_STAGE
#undef PG8_LDA
#undef PG8_LDB
#undef PG8_MMA
#undef PG8_WAIT_V
#undef PG8_WAIT_L
#undef PG8_BAR
#undef PG8_SCHED
}
}

#ifndef MK_FUSED
#define MK_FUSED 1
#endif
#define DI __device__ __forceinline__
#define LAS __attribute__((address_space(3)))
typedef unsigned short bf16_t;
typedef float f32x4 __attribute__((ext_vector_type(4)));
typedef float f32x2 __attribute__((ext_vector_type(2)));
typedef float f32x16 __attribute__((ext_vector_type(16)));
typedef unsigned u32x4 __attribute__((ext_vector_type(4)));
typedef unsigned u32x2 __attribute__((ext_vector_type(2)));
typedef short bf16x8 __attribute__((ext_vector_type(8)));
typedef _Float16 h16x2 __attribute__((ext_vector_type(2)));
typedef _Float16 h16x8 __attribute__((ext_vector_type(8)));

constexpr int BATCH = 16, SEQ = 4096, T = BATCH * SEQ, DM = 1024, NIN = 4864;
constexpr int C_AQ = 0, C_AK = 512, C_AV = 640, C_HQ = 768, C_HF = 1280, C_HI = 1792, C_HG = 2304, C_GA = 2816, C_GH = 3840;
constexpr float EPS = 1e-6f;
constexpr int NTHR = 512;
constexpr int LDS_BYTES = 147456;

constexpr size_t MiB = 1u << 20;
constexpr size_t WS_W1T = 1 * MiB;
constexpr size_t WS_WAPT = 11 * MiB;
constexpr size_t WS_WHPT = 12 * MiB;
constexpr size_t WS_WOUTT = 13 * MiB;
constexpr size_t WS_WQT = 15 * MiB;
constexpr size_t WS_KEYS = 19 * MiB;
constexpr size_t WS_LB = 19 * MiB + 512 * 1024;
constexpr size_t WS_RSTD1 = 20 * MiB;
constexpr size_t WS_SSQ2 = 21 * MiB;
constexpr size_t WS_U16 = 26 * MiB;
constexpr size_t WS_V16 = 58 * MiB;
constexpr size_t WS_XB = 90 * MiB;
constexpr size_t WS_PROJ = 218 * MiB;
constexpr size_t WS_YA = 826 * MiB;
constexpr size_t WS_YH = 890 * MiB;
constexpr size_t WS_END = 954 * MiB;
constexpr size_t WS_X2B = WS_PROJ;
constexpr size_t WS_QP = WS_PROJ + 128 * MiB;
constexpr size_t WS_GIDX = WS_PROJ + 384 * MiB;
constexpr size_t WS_GGATE = WS_PROJ + 400 * MiB;

struct Args { const float* in[15]; float* out; unsigned char* ws; int ph_lo, ph_hi; };

DI unsigned pk_bf16(float lo, float hi) { typedef __bf16 b2 __attribute__((ext_vector_type(2))); f32x2 v = {lo, hi}; b2 b = __builtin_convertvector(v, b2); return __builtin_bit_cast(unsigned, b); }
DI float bflo(unsigned w) { return __uint_as_float(w << 16); }
DI float bfhi(unsigned w) { return __uint_as_float(w & 0xffff0000u); }
DI float sigm(float x) { return 1.f / (1.f + __expf(-x)); }
DI float wave_sum(float v) {
#pragma unroll
    for (int o = 1; o < 64; o <<= 1) v += __shfl_xor(v, o);
    return v;
}
#define LDS_WAIT() asm volatile("s_waitcnt lgkmcnt(0)" ::: "memory")

namespace pg8 {
struct EpiRowScale {
    static constexpr bool PERM = true, AFTER_DRAIN = false;
    bf16_t* O; int ldc; const float* rs;
    __device__ __forceinline__ void operator()(const f32x4 (&acc)[2][2][4][2], const Unit& u, int wr, int wc, int fr, int fq) const {
        const int row0 = u.pm * BM + wr * 64 + fr, col0 = u.pn * BM + wc * 32 + 8 * fq;
#pragma unroll
        for (int ai = 0; ai < 2; ++ai)
#pragma unroll
            for (int m = 0; m < 4; ++m) { const int row = row0 + ai * HALF + m * 16; const float s = rs ? rs[row] : 1.f; bf16_t* rowp = O + (size_t)row * ldc + col0;
#pragma unroll
                for (int bj = 0; bj < 2; ++bj) { const f32x4 v0 = acc[ai][bj][m][0] * s, v1 = acc[ai][bj][m][1] * s;
                    u32x4 w; w.x = pk_bf16(v0[0], v0[1]); w.y = pk_bf16(v0[2], v0[3]); w.z = pk_bf16(v1[0], v1[1]); w.w = pk_bf16(v1[2], v1[3]);
                    *(u32x4*)(rowp + bj * HALF) = w; } }
    }
};
template <bool ADD> struct EpiMerge {
    static constexpr bool PERM = true, AFTER_DRAIN = false;
    bf16_t* O; const bf16_t* gate;
    __device__ __forceinline__ void operator()(const f32x4 (&acc)[2][2][4][2], const Unit& u, int wr, int wc, int fr, int fq) const {
        const int row0 = u.pm * BM + wr * 64 + fr, col0 = u.pn * BM + wc * 32 + 8 * fq;
#pragma unroll
        for (int ai = 0; ai < 2; ++ai)
#pragma unroll
            for (int m = 0; m < 4; ++m) { const int row = row0 + ai * HALF + m * 16; bf16_t* rowp = O + (size_t)row * DM + col0; const bf16_t* gp = gate + (size_t)row * NIN + col0;
#pragma unroll
                for (int bj = 0; bj < 2; ++bj) { const u32x4 g = *(const u32x4*)(gp + bj * HALF);
                    f32x4 v0 = acc[ai][bj][m][0], v1 = acc[ai][bj][m][1];
                    v0[0] *= sigm(bflo(g.x)); v0[1] *= sigm(bfhi(g.x)); v0[2] *= sigm(bflo(g.y)); v0[3] *= sigm(bfhi(g.y));
                    v1[0] *= sigm(bflo(g.z)); v1[1] *= sigm(bfhi(g.z)); v1[2] *= sigm(bflo(g.w)); v1[3] *= sigm(bfhi(g.w));
                    if (ADD) { const u32x4 o = *(const u32x4*)(rowp + bj * HALF);
                        v0[0] += bflo(o.x); v0[1] += bfhi(o.x); v0[2] += bflo(o.y); v0[3] += bfhi(o.y); v1[0] += bflo(o.z); v1[1] += bfhi(o.z); v1[2] += bflo(o.w); v1[3] += bfhi(o.w); }
                    u32x4 w; w.x = pk_bf16(v0[0], v0[1]); w.y = pk_bf16(v0[2], v0[3]); w.z = pk_bf16(v1[0], v1[1]); w.w = pk_bf16(v1[2], v1[3]);
                    *(u32x4*)(rowp + bj * HALF) = w; } }
    }
};
struct EpiX2 {
    static constexpr bool PERM = true, AFTER_DRAIN = false;
    const float* X; float* X2; bf16_t* X2B; float* ssq;
    __device__ __forceinline__ void operator()(const f32x4 (&acc)[2][2][4][2], const Unit& u, int wr, int wc, int fr, int fq) const {
        const int row0 = u.pm * BM + wr * 64 + fr, col0 = u.pn * BM + wc * 32 + 8 * fq;
#pragma unroll
        for (int ai = 0; ai < 2; ++ai)
#pragma unroll
            for (int m = 0; m < 4; ++m) { const int row = row0 + ai * HALF + m * 16; const size_t off = (size_t)row * DM + col0; float ss = 0.f;
#pragma unroll
                for (int bj = 0; bj < 2; ++bj) { const f32x4 x0 = *(const f32x4*)(X + off + bj * HALF), x1 = *(const f32x4*)(X + off + bj * HALF + 4);
                    const f32x4 v0 = acc[ai][bj][m][0] + x0, v1 = acc[ai][bj][m][1] + x1;
                    *(f32x4*)(X2 + off + bj * HALF) = v0; *(f32x4*)(X2 + off + bj * HALF + 4) = v1;
                    u32x4 w; w.x = pk_bf16(v0[0], v0[1]); w.y = pk_bf16(v0[2], v0[3]); w.z = pk_bf16(v1[0], v1[1]); w.w = pk_bf16(v1[2], v1[3]);
                    *(u32x4*)(X2B + off + bj * HALF) = w;
                    ss += (v0[0] * v0[0] + v0[1] * v0[1]) + (v0[2] * v0[2] + v0[3] * v0[3]) + (v1[0] * v1[0] + v1[1] * v1[1]) + (v1[2] * v1[2] + v1[3] * v1[3]); }
                ss += __shfl_xor(ss, 16); ss += __shfl_xor(ss, 32);
                if (fq == 0) ssq[(size_t)row * 16 + u.pn * 4 + wc] = ss; }
    }
};
struct EpiQp {
    static constexpr bool PERM = true, AFTER_DRAIN = false;
    bf16_t* O; const float* ssq;
    __device__ __forceinline__ void operator()(const f32x4 (&acc)[2][2][4][2], const Unit& u, int wr, int wc, int fr, int fq) const {
        const int row0 = u.pm * BM + wr * 64 + fr, col0 = u.pn * BM + wc * 32 + 8 * fq;
#pragma unroll
        for (int ai = 0; ai < 2; ++ai)
#pragma unroll
            for (int m = 0; m < 4; ++m) { const int row = row0 + ai * HALF + m * 16; const f32x4* sp = (const f32x4*)(ssq + (size_t)row * 16);
                const f32x4 a = sp[0], b = sp[1], c = sp[2], d = sp[3];
                const float tot = ((a[0] + a[1]) + (a[2] + a[3])) + ((b[0] + b[1]) + (b[2] + b[3])) + ((c[0] + c[1]) + (c[2] + c[3])) + ((d[0] + d[1]) + (d[2] + d[3]));
                const float s = __builtin_amdgcn_rsqf(tot * (1.f / 1024.f) + EPS); bf16_t* rowp = O + (size_t)row * 2048 + col0;
#pragma unroll
                for (int bj = 0; bj < 2; ++bj) { const f32x4 v0 = acc[ai][bj][m][0] * s, v1 = acc[ai][bj][m][1] * s;
                    u32x4 w; w.x = pk_bf16(v0[0], v0[1]); w.y = pk_bf16(v0[2], v0[3]); w.z = pk_bf16(v1[0], v1[1]); w.w = pk_bf16(v1[2], v1[3]);
                    *(u32x4*)(rowp + bj * HALF) = w; } }
    }
};
}

DI void p0_transpose_item(const float* W, int K, int N, bf16_t* WT, const float* g, int gmask, LAS float* scr, int item, int lane) {
    const int nblk = N / 32, kb = item / nblk, nb = item % nblk, k0 = 64 * kb, n0 = 32 * nb;
#pragma unroll 8
    for (int i = 0; i < 32; ++i) { const int kk = 2 * i + (lane >> 5); float w = W[(size_t)(k0 + kk) * N + n0 + (lane & 31)]; if (g) w *= g[(k0 + kk) & gmask]; scr[kk * 33 + (lane & 31)] = w; }
    LDS_WAIT(); asm volatile("" ::: "memory");
    const int c = lane & 7;
#pragma unroll
    for (int j = 0; j < 4; ++j) { const int n = (lane >> 3) + 8 * j; const LAS float* s = scr + (8 * c) * 33 + n;
        u32x4 o; o.x = pk_bf16(s[0 * 33], s[1 * 33]); o.y = pk_bf16(s[2 * 33], s[3 * 33]); o.z = pk_bf16(s[4 * 33], s[5 * 33]); o.w = pk_bf16(s[6 * 33], s[7 * 33]);
        *(u32x4*)(WT + (size_t)(n0 + n) * K + k0 + 8 * c) = o; }
    LDS_WAIT(); asm volatile("" ::: "memory");
}
DI unsigned pk_f16(float a, float b) { h16x2 v = {(_Float16)a, (_Float16)b}; return __builtin_bit_cast(unsigned, v); }

DI void p0_prologue(const Args& a, LAS unsigned char* lds, int vb, int G) {
    const int tid = threadIdx.x, lane = tid & 63, wave = tid >> 6;
    const int gw = vb * 8 + wave, NGW = G * 8, gt = vb * NTHR + tid, NGT = G * NTHR;
    unsigned char* ws = a.ws;
    LAS float* scr = (LAS float*)(lds + wave * 16384);
    constexpr int I_W1 = 16 * 152, I_AP = 8 * 32, I_HP = 8 * 32, I_OUT = 16 * 32, I_Q = 16 * 64, NITEMS = I_W1 + I_AP + I_HP + I_OUT + I_Q;
    for (int it = gw; it < NITEMS; it += NGW) {
        int r = it;
        if (r < I_W1) { p0_transpose_item(a.in[2], 1024, NIN, (bf16_t*)(ws + WS_W1T), a.in[1], 1023, scr, r, lane); continue; } r -= I_W1;
        if (r < I_AP) { p0_transpose_item(a.in[6], 512, 1024, (bf16_t*)(ws + WS_WAPT), nullptr, 0, scr, r, lane); continue; } r -= I_AP;
        if (r < I_HP) { p0_transpose_item(a.in[7], 512, 1024, (bf16_t*)(ws + WS_WHPT), a.in[5], 127, scr, r, lane); continue; } r -= I_HP;
        if (r < I_OUT) { p0_transpose_item(a.in[8], 1024, 1024, (bf16_t*)(ws + WS_WOUTT), nullptr, 0, scr, r, lane); continue; } r -= I_OUT;
        p0_transpose_item(a.in[10], 1024, 2048, (bf16_t*)(ws + WS_WQT), a.in[9], 1023, scr, r, lane);
    }
    for (int i = gt; i < 2 * 8 * 128 * 128 / 4; i += NGT) { const f32x4 v = ((const f32x4*)a.in[11])[i]; u32x2 o; o.x = pk_bf16(v[0], v[1]); o.y = pk_bf16(v[2], v[3]); ((u32x2*)(ws + WS_KEYS))[i] = o; }
    for (int i = gt; i < 16384 * 1024 / 4; i += NGT) {
        const f32x4 u = ((const f32x4*)a.in[12])[i], g = *(const f32x4*)(a.in[9] + ((i * 4) & 1023)), v = ((const f32x4*)a.in[13])[i];
        u32x2 o; o.x = pk_f16(u[0] * g[0], u[1] * g[1]); o.y = pk_f16(u[2] * g[2], u[3] * g[3]); ((u32x2*)(ws + WS_U16))[i] = o;
        u32x2 p; p.x = pk_f16(v[0], v[1]); p.y = pk_f16(v[2], v[3]); ((u32x2*)(ws + WS_V16))[i] = p;
    }
    for (int row = gw; row < T; row += NGW) {
        const f32x4* xr = (const f32x4*)(a.in[0] + (size_t)row * DM) + lane; f32x4 v[4]; float s = 0.f;
#pragma unroll
        for (int j = 0; j < 4; ++j) { v[j] = xr[64 * j]; s += (v[j][0] * v[j][0] + v[j][1] * v[j][1]) + (v[j][2] * v[j][2] + v[j][3] * v[j][3]); }
        s = wave_sum(s);
        u32x2* o = (u32x2*)(ws + WS_XB + (size_t)row * DM * 2) + lane;
#pragma unroll
        for (int j = 0; j < 4; ++j) { u32x2 w; w.x = pk_bf16(v[j][0], v[j][1]); w.y = pk_bf16(v[j][2], v[j][3]); o[64 * j] = w; }
        if (lane == 0) ((float*)(ws + WS_RSTD1))[row] = __builtin_amdgcn_rsqf(s * (1.f / 1024.f) + EPS);
    }
    if (vb == 0) { const float l0 = a.in[4][tid], l1 = a.in[4][512 + tid]; ((float*)(ws + WS_LB))[tid] = 1.f / (1.f + __expf(l1 - l0)); }
}

DI void attn_unit(const bf16_t* proj, const float* sinks, bf16_t* ya, LAS unsigned char* lds, int b, int tt) {
    const int tid = threadIdx.x, lane = tid & 63, wave = tid >> 6;
    LAS unsigned char* Ks = lds; LAS unsigned char* Vs = lds + 192 * 272;
    for (int c = tid; c < 192 * 16; c += NTHR) { const int jr = c >> 4, ch = c & 15, pos = tt * 64 - 128 + jr; u32x4 kv = {0u, 0u, 0u, 0u}, vv = {0u, 0u, 0u, 0u};
        if (pos >= 0) { const bf16_t* src = proj + (size_t)(b * SEQ + pos) * NIN; kv = *(const u32x4*)(src + C_AK + ch * 8); vv = *(const u32x4*)(src + C_AV + ch * 8); }
        *(LAS u32x4*)(Ks + jr * 272 + ch * 16) = kv; *(LAS u32x4*)(Vs + jr * 272 + ch * 16) = vv; }
    __syncthreads();
    const int h = wave, kvh = h >> 2, pos = tt * 64 + lane; const size_t t = (size_t)b * SEQ + pos;
    float q[64], o[64];
    { const u32x4* qp = (const u32x4*)(proj + t * NIN + C_AQ + h * 64);
#pragma unroll
      for (int c = 0; c < 8; ++c) { const u32x4 w = qp[c]; q[8 * c + 0] = bflo(w.x) * 0.125f; q[8 * c + 1] = bfhi(w.x) * 0.125f; q[8 * c + 2] = bflo(w.y) * 0.125f; q[8 * c + 3] = bfhi(w.y) * 0.125f;
          q[8 * c + 4] = bflo(w.z) * 0.125f; q[8 * c + 5] = bfhi(w.z) * 0.125f; q[8 * c + 6] = bflo(w.w) * 0.125f; q[8 * c + 7] = bfhi(w.w) * 0.125f; } }
#pragma unroll
    for (int d = 0; d < 64; ++d) o[d] = 0.f;
    float m = sinks[h], l = 1.f; const float slope = exp2f(-(float)(h + 1));
    for (int j0 = 0; j0 < 128; j0 += 2) {
        float s[2];
#pragma unroll
        for (int e = 0; e < 2; ++e) { const int j = j0 + e; const LAS unsigned char* kr = Ks + (lane + 128 - j) * 272 + kvh * 128; float acc = 0.f;
#pragma unroll
            for (int c = 0; c < 8; ++c) { const u32x4 w = *(const LAS u32x4*)(kr + c * 16);
                acc += q[8 * c + 0] * bflo(w.x) + q[8 * c + 1] * bfhi(w.x) + q[8 * c + 2] * bflo(w.y) + q[8 * c + 3] * bfhi(w.y) + q[8 * c + 4] * bflo(w.z) + q[8 * c + 5] * bfhi(w.z) + q[8 * c + 6] * bflo(w.w) + q[8 * c + 7] * bfhi(w.w); }
            s[e] = (pos - j >= 0) ? acc - slope * (float)j : -1e30f; }
        asm volatile("" ::: "memory");
        const float mn = fmaxf(m, fmaxf(s[0], s[1])), alpha = __expf(m - mn);
        const float p0 = __expf(s[0] - mn), p1 = __expf(s[1] - mn);
        l = l * alpha + (p0 + p1); m = mn;
        { const LAS unsigned char* vr0 = Vs + (lane + 128 - j0) * 272 + kvh * 128; const LAS unsigned char* vr1 = vr0 - 272;
#pragma unroll
            for (int c = 0; c < 8; ++c) { const u32x4 w = *(const LAS u32x4*)(vr0 + c * 16), x = *(const LAS u32x4*)(vr1 + c * 16);
                o[8 * c + 0] = o[8 * c + 0] * alpha + (p0 * bflo(w.x) + p1 * bflo(x.x)); o[8 * c + 1] = o[8 * c + 1] * alpha + (p0 * bfhi(w.x) + p1 * bfhi(x.x));
                o[8 * c + 2] = o[8 * c + 2] * alpha + (p0 * bflo(w.y) + p1 * bflo(x.y)); o[8 * c + 3] = o[8 * c + 3] * alpha + (p0 * bfhi(w.y) + p1 * bfhi(x.y));
                o[8 * c + 4] = o[8 * c + 4] * alpha + (p0 * bflo(w.z) + p1 * bflo(x.z)); o[8 * c + 5] = o[8 * c + 5] * alpha + (p0 * bfhi(w.z) + p1 * bfhi(x.z));
                o[8 * c + 6] = o[8 * c + 6] * alpha + (p0 * bflo(w.w) + p1 * bflo(x.w)); o[8 * c + 7] = o[8 * c + 7] * alpha + (p0 * bfhi(w.w) + p1 * bfhi(x.w)); } }
        asm volatile("" ::: "memory");
    }
    const float inv = 1.f / l; u32x4* op = (u32x4*)(ya + t * 512 + h * 64);
#pragma unroll
    for (int c = 0; c < 8; ++c) { u32x4 w; w.x = pk_bf16(o[8 * c + 0] * inv, o[8 * c + 1] * inv); w.y = pk_bf16(o[8 * c + 2] * inv, o[8 * c + 3] * inv); w.z = pk_bf16(o[8 * c + 4] * inv, o[8 * c + 5] * inv); w.w = pk_bf16(o[8 * c + 6] * inv, o[8 * c + 7] * inv); op[c] = w; }
    __syncthreads();
}

DI void hgrn_unit(const bf16_t* proj, const float* lbp, bf16_t* yh, LAS unsigned char* lds, int b, int h) {
    const int tid = threadIdx.x;
    LAS float* qs = (LAS float*)lds; LAS float* fs = qs + 2048; LAS float* ks = fs + 2048; LAS float* vs = ks + 2048; LAS float* gs = vs + 2048; LAS float* pos_ = gs + 2048;
    const int dv = tid & 127, dks = tid >> 7;
    float S[32];
#pragma unroll
    for (int d = 0; d < 32; ++d) S[d] = 0.f;
    const int g4 = tid >> 7, ltok = (tid & 127) >> 3, lch = tid & 7;
    const int gcol = (g4 == 0 ? C_HQ : g4 == 1 ? C_HF : g4 == 2 ? C_HI : C_HG) + h * 128 + lch * 16;
    float lb[16];
#pragma unroll
    for (int e = 0; e < 16; ++e) lb[e] = lbp[h * 128 + lch * 16 + e];
    for (int t0 = 0; t0 < SEQ; t0 += 16) {
        { const size_t t = (size_t)b * SEQ + t0 + ltok; const u32x4* src = (const u32x4*)(proj + t * NIN + gcol); const u32x4 w0 = src[0], w1 = src[1];
          float x[16] = {bflo(w0.x), bfhi(w0.x), bflo(w0.y), bfhi(w0.y), bflo(w0.z), bfhi(w0.z), bflo(w0.w), bfhi(w0.w), bflo(w1.x), bfhi(w1.x), bflo(w1.y), bfhi(w1.y), bflo(w1.z), bfhi(w1.z), bflo(w1.w), bfhi(w1.w)};
          const int o = ltok * 128 + lch * 16;
          if (g4 == 0) {
#pragma unroll
              for (int e = 0; e < 16; ++e) qs[o + e] = x[e] * sigm(x[e]);
          } else if (g4 == 1) {
#pragma unroll
              for (int e = 0; e < 16; ++e) { const float f = lb[e] + (1.f - lb[e]) * sigm(x[e]); fs[o + e] = f; ks[o + e] = 1.f - f; }
          } else if (g4 == 2) {
#pragma unroll
              for (int e = 0; e < 16; ++e) vs[o + e] = x[e];
          } else {
#pragma unroll
              for (int e = 0; e < 16; ++e) gs[o + e] = x[e] * sigm(x[e]);
          } }
        __syncthreads();
#pragma unroll 1
        for (int tok = 0; tok < 16; ++tok) {
            const float v = vs[tok * 128 + dv]; float po = 0.f;
#pragma unroll
            for (int d4 = 0; d4 < 8; ++d4) { const int o = tok * 128 + dks * 32 + d4 * 4;
                const f32x4 f = *(const LAS f32x4*)(fs + o), k = *(const LAS f32x4*)(ks + o), q = *(const LAS f32x4*)(qs + o);
#pragma unroll
                for (int e = 0; e < 4; ++e) { S[4 * d4 + e] = f[e] * S[4 * d4 + e] + k[e] * v; po += q[e] * S[4 * d4 + e]; } }
            pos_[(tok * 4 + dks) * 128 + dv] = po;
        }
        __syncthreads();
        { const int tok = tid >> 5, dv4 = (tid & 31) * 4; f32x4 o = {0.f, 0.f, 0.f, 0.f};
#pragma unroll
          for (int s = 0; s < 4; ++s) o += *(const LAS f32x4*)(pos_ + (tok * 4 + s) * 128 + dv4);
          float ss = (o[0] * o[0] + o[1] * o[1]) + (o[2] * o[2] + o[3] * o[3]);
#pragma unroll
          for (int x = 1; x < 32; x <<= 1) ss += __shfl_xor(ss, x);
          const float r = __builtin_amdgcn_rsqf(ss * (1.f / 128.f) + EPS); const f32x4 g = *(const LAS f32x4*)(gs + tok * 128 + dv4);
          u32x2 w; w.x = pk_bf16(o[0] * r * g[0], o[1] * r * g[1]); w.y = pk_bf16(o[2] * r * g[2], o[3] * r * g[3]);
          *(u32x2*)(yh + ((size_t)b * SEQ + t0 + tok) * 512 + h * 128 + dv4) = w; }
        __syncthreads();
    }
}

DI unsigned f2ord(float f) { const unsigned b = __float_as_uint(f); return b ^ ((unsigned)((int)b >> 31) | 0x80000000u); }
DI float ord2f(unsigned k) { const unsigned b = (k & 0x80000000u) ? (k ^ 0x80000000u) : ~k; return __uint_as_float(b); }
#define TK_INS(L, x) do { unsigned t_ = (x); _Pragma("unroll") for (int j_ = 0; j_ < 16; ++j_) { const unsigned hi_ = L[j_] > t_ ? L[j_] : t_; t_ = L[j_] > t_ ? t_ : L[j_]; L[j_] = hi_; } } while (0)
#define MFMA32(a, b, c) __builtin_amdgcn_mfma_f32_32x32x16_bf16((a), (b), (c), 0, 0, 0)

DI void topk_unit(const bf16_t* qp, const bf16_t* keysb, unsigned short* gidx, float* ggate, LAS unsigned char* lds, int tile, int h) {
    const int tid = threadIdx.x, lane = tid & 63, wave = tid >> 6, p = wave & 1, tsub = wave >> 1, r = lane & 31, hh = lane >> 5;
    const int tok0 = tile * 128 + tsub * 32;
    f32x16 acc[4];
#pragma unroll
    for (int kb = 0; kb < 4; ++kb)
#pragma unroll
        for (int i = 0; i < 16; ++i) acc[kb][i] = 0.f;
    const bf16_t* qrow = qp + (size_t)(tok0 + r) * 2048 + h * 256 + p * 128 + 8 * hh;
    const bf16_t* kbase = keysb + ((size_t)(p * 8 + h) * 128 + r) * 128 + 8 * hh;
#pragma unroll
    for (int s = 0; s < 8; ++s) { const bf16x8 bq = *(const bf16x8*)(qrow + 16 * s);
#pragma unroll
        for (int kb = 0; kb < 4; ++kb) { const bf16x8 ak = *(const bf16x8*)(kbase + (size_t)kb * 32 * 128 + 16 * s); acc[kb] = MFMA32(ak, bq, acc[kb]); } }
    unsigned L[16];
#pragma unroll
    for (int j = 0; j < 16; ++j) L[j] = 0u;
#pragma unroll
    for (int kb = 0; kb < 4; ++kb)
#pragma unroll
        for (int i = 0; i < 16; ++i) { const unsigned key = (f2ord(acc[kb][i]) & ~127u) | (unsigned)(32 * kb + (i & 3) + 8 * (i >> 2) + 4 * hh); TK_INS(L, key); }
    { unsigned P[16];
#pragma unroll
      for (int j = 0; j < 16; ++j) P[j] = __shfl_xor(L[j], 32);
#pragma unroll
      for (int j = 0; j < 16; ++j) TK_INS(L, P[j]); }
    LAS unsigned* tk = (LAS unsigned*)lds;
    if (hh == 0) { LAS u32x4* dst = (LAS u32x4*)(tk + ((p * 128 + tsub * 32 + r) * 16));
#pragma unroll
        for (int c = 0; c < 4; ++c) { u32x4 w = {L[4 * c], L[4 * c + 1], L[4 * c + 2], L[4 * c + 3]}; dst[c] = w; } }
    __syncthreads();
    if (tid < 128) {
        unsigned L1[16], L2[16];
        { const LAS u32x4* s1 = (const LAS u32x4*)(tk + tid * 16); const LAS u32x4* s2 = (const LAS u32x4*)(tk + (128 + tid) * 16);
#pragma unroll
          for (int c = 0; c < 4; ++c) { const u32x4 a = s1[c], b = s2[c]; L1[4 * c] = a.x; L1[4 * c + 1] = a.y; L1[4 * c + 2] = a.z; L1[4 * c + 3] = a.w; L2[4 * c] = b.x; L2[4 * c + 1] = b.y; L2[4 * c + 2] = b.z; L2[4 * c + 3] = b.w; } }
        float v1[16], v2[16];
#pragma unroll
        for (int j = 0; j < 16; ++j) { v1[j] = ord2f(L1[j] & ~127u); v2[j] = ord2f(L2[j] & ~127u); }
        unsigned C[16];
#pragma unroll
        for (int j = 0; j < 16; ++j) C[j] = 0u;
#pragma unroll
        for (int i = 0; i < 16; ++i)
#pragma unroll
            for (int j = 0; j < 16; ++j) if ((i + 1) * (j + 1) <= 16) { const unsigned key = (f2ord(v1[i] + v2[j]) & ~255u) | (unsigned)(i * 16 + j); TK_INS(C, key); }
        float sc[16]; unsigned ei[16]; float mx = -1e30f;
#pragma unroll
        for (int q = 0; q < 16; ++q) { const unsigned ij = C[q] & 255u; const unsigned a = tk[tid * 16 + (ij >> 4)], b = tk[(128 + tid) * 16 + (ij & 15u)];
            sc[q] = ord2f(a & ~127u) + ord2f(b & ~127u); ei[q] = (a & 127u) * 128u + (b & 127u); mx = fmaxf(mx, sc[q]); }
        float sum = 0.f;
#pragma unroll
        for (int q = 0; q < 16; ++q) { sc[q] = __expf(sc[q] - mx); sum += sc[q]; }
        const float inv = 1.f / sum; const size_t o = (size_t)(tile * 128 + tid) * 128 + h * 16;
#pragma unroll
        for (int q = 0; q < 16; ++q) { gidx[o + q] = (unsigned short)ei[q]; ggate[o + q] = sc[q] * inv; }
    }
    __syncthreads();
}

DI float dot8(h16x8 a, const h16x2 (&b)[4], float c) {
    const h16x2 a0 = {a[0], a[1]}, a1 = {a[2], a[3]}, a2 = {a[4], a[5]}, a3 = {a[6], a[7]};
    c = __builtin_amdgcn_fdot2(a0, b[0], c, false); c = __builtin_amdgcn_fdot2(a1, b[1], c, false); c = __builtin_amdgcn_fdot2(a2, b[2], c, false); c = __builtin_amdgcn_fdot2(a3, b[3], c, false); return c;
}
DI float gelu_erf(float x) { return 0.5f * x * (1.f + erff(x * 0.70710678118654752f)); }

DI void expert_token(const float* x2row, const float* ssq, const _Float16* u16, const _Float16* v16, const unsigned short* gidx, const float* ggate, const float* gf, float* outrow, int lane) {
    const f32x4 xa0 = *(const f32x4*)(x2row + 8 * lane), xa1 = *(const f32x4*)(x2row + 8 * lane + 4), xb0 = *(const f32x4*)(x2row + 512 + 8 * lane), xb1 = *(const f32x4*)(x2row + 512 + 8 * lane + 4);
    float ss = (lane < 16) ? ssq[lane] : 0.f; ss = wave_sum(ss);
    const float rstd2 = __builtin_amdgcn_rsqf(ss * (1.f / 1024.f) + EPS);
    h16x2 ha[4], hb[4];
    ha[0] = (h16x2){(_Float16)(xa0[0] * rstd2), (_Float16)(xa0[1] * rstd2)}; ha[1] = (h16x2){(_Float16)(xa0[2] * rstd2), (_Float16)(xa0[3] * rstd2)};
    ha[2] = (h16x2){(_Float16)(xa1[0] * rstd2), (_Float16)(xa1[1] * rstd2)}; ha[3] = (h16x2){(_Float16)(xa1[2] * rstd2), (_Float16)(xa1[3] * rstd2)};
    hb[0] = (h16x2){(_Float16)(xb0[0] * rstd2), (_Float16)(xb0[1] * rstd2)}; hb[1] = (h16x2){(_Float16)(xb0[2] * rstd2), (_Float16)(xb0[3] * rstd2)};
    hb[2] = (h16x2){(_Float16)(xb1[0] * rstd2), (_Float16)(xb1[1] * rstd2)}; hb[3] = (h16x2){(_Float16)(xb1[2] * rstd2), (_Float16)(xb1[3] * rstd2)};
    const int id0 = gidx[lane], id1 = gidx[64 + lane]; const float g0 = ggate[lane], g1 = ggate[64 + lane];
    float oa[8], ob[8];
#pragma unroll
    for (int e = 0; e < 8; ++e) { oa[e] = 0.f; ob[e] = 0.f; }
#pragma unroll 1
    for (int bt = 0; bt < 8; ++bt) {
        const int idsel = (bt < 4) ? id0 : id1; const float gsel = (bt < 4) ? g0 : g1; const int lb = (bt & 3) * 16;
        float pr[16];
#pragma unroll
        for (int e = 0; e < 16; ++e) { const int idx = __builtin_amdgcn_readlane(idsel, lb + e); const _Float16* up = u16 + (size_t)idx * 1024;
            const h16x8 ua = *(const h16x8*)(up + 8 * lane), ub = *(const h16x8*)(up + 512 + 8 * lane); pr[e] = dot8(ub, hb, dot8(ua, ha, 0.f)); }
        float q8[8], q4[4], q2[2], q1;
        { const bool up_ = (lane & 32) != 0;
#pragma unroll
          for (int i = 0; i < 8; ++i) { const float keep = up_ ? pr[i + 8] : pr[i], send = up_ ? pr[i] : pr[i + 8]; q8[i] = keep + __shfl_xor(send, 32); } }
        { const bool up_ = (lane & 16) != 0;
#pragma unroll
          for (int i = 0; i < 4; ++i) { const float keep = up_ ? q8[i + 4] : q8[i], send = up_ ? q8[i] : q8[i + 4]; q4[i] = keep + __shfl_xor(send, 16); } }
        { const bool up_ = (lane & 8) != 0;
#pragma unroll
          for (int i = 0; i < 2; ++i) { const float keep = up_ ? q4[i + 2] : q4[i], send = up_ ? q4[i] : q4[i + 2]; q2[i] = keep + __shfl_xor(send, 8); } }
        { const bool up_ = (lane & 4) != 0; const float keep = up_ ? q2[1] : q2[0], send = up_ ? q2[0] : q2[1]; q1 = keep + __shfl_xor(send, 4); }
        q1 += __shfl_xor(q1, 2); q1 += __shfl_xor(q1, 1);
        const float gate = __shfl(gsel, lb + (lane >> 2));
        const float w = gelu_erf(q1) * gate;
#pragma unroll
        for (int e = 0; e < 16; ++e) { const int idx = __builtin_amdgcn_readlane(idsel, lb + e); const float we = __int_as_float(__builtin_amdgcn_readlane(__float_as_int(w), 4 * e)); const _Float16* vp = v16 + (size_t)idx * 1024;
            const h16x8 va = *(const h16x8*)(vp + 8 * lane), vb = *(const h16x8*)(vp + 512 + 8 * lane);
#pragma unroll
            for (int i = 0; i < 8; ++i) { oa[i] += we * (float)va[i]; ob[i] += we * (float)vb[i]; } }
    }
    float y[16] = {xa0[0] + oa[0], xa0[1] + oa[1], xa0[2] + oa[2], xa0[3] + oa[3], xa1[0] + oa[4], xa1[1] + oa[5], xa1[2] + oa[6], xa1[3] + oa[7],
                   xb0[0] + ob[0], xb0[1] + ob[1], xb0[2] + ob[2], xb0[3] + ob[3], xb1[0] + ob[4], xb1[1] + ob[5], xb1[2] + ob[6], xb1[3] + ob[7]};
    float s3 = 0.f;
#pragma unroll
    for (int i = 0; i < 16; ++i) s3 += y[i] * y[i];
    s3 = wave_sum(s3); const float r3 = __builtin_amdgcn_rsqf(s3 * (1.f / 1024.f) + EPS);
    const f32x4 ga0 = *(const f32x4*)(gf + 8 * lane), ga1 = *(const f32x4*)(gf + 8 * lane + 4), gb0 = *(const f32x4*)(gf + 512 + 8 * lane), gb1 = *(const f32x4*)(gf + 512 + 8 * lane + 4);
    *(f32x4*)(outrow + 8 * lane) = (f32x4){y[0] * r3 * ga0[0], y[1] * r3 * ga0[1], y[2] * r3 * ga0[2], y[3] * r3 * ga0[3]};
    *(f32x4*)(outrow + 8 * lane + 4) = (f32x4){y[4] * r3 * ga1[0], y[5] * r3 * ga1[1], y[6] * r3 * ga1[2], y[7] * r3 * ga1[3]};
    *(f32x4*)(outrow + 512 + 8 * lane) = (f32x4){y[8] * r3 * gb0[0], y[9] * r3 * gb0[1], y[10] * r3 * gb0[2], y[11] * r3 * gb0[3]};
    *(f32x4*)(outrow + 512 + 8 * lane + 4) = (f32x4){y[12] * r3 * gb1[0], y[13] * r3 * gb1[1], y[14] * r3 * gb1[2], y[15] * r3 * gb1[3]};
}

constexpr int N_PHASES = 8;
__global__ void __launch_bounds__(NTHR, 2) mk_fwd(Args a) {
    extern __shared__ __attribute__((aligned(16))) unsigned char lds_raw[];
    LAS unsigned char* lds = (LAS unsigned char*)lds_raw;
    cg::grid_group grid = cg::this_grid();
    const int G = gridDim.x, vb = blockIdx.x, tid = threadIdx.x, lane = tid & 63, wave = tid >> 6;
    unsigned char* ws = a.ws;
    const int lo = a.ph_lo, hi = a.ph_hi;
#ifndef PHASE_MASK
#define PHASE_MASK 0xFF
#endif
#define IN(k) (((PHASE_MASK >> (k)) & 1) && lo <= (k) && (k) < hi)
#define SEAM(k) do { if (IN(k) && IN((k) + 1)) grid.sync(); } while (0)
    bf16_t* proj = (bf16_t*)(ws + WS_PROJ);

    if (IN(0)) p0_prologue(a, lds, vb, G);
    SEAM(0);
    if (IN(1)) { pg8::Gemm g{(const bf16_t*)(ws + WS_XB), (const bf16_t*)(ws + WS_W1T), T, NIN, 1024}; pg8::StaticOrder S; S.init(T, NIN, G, vb);
        pg8::EpiRowScale E{proj, NIN, (const float*)(ws + WS_RSTD1)};
        pg8::gemm_phase<pg8::EpiRowScale, pg8::StaticOrder, true, true>(lds, g, S, E); }
    SEAM(1);
    if (IN(2)) {
        const int nh = (G > 64) ? 64 : G;
        if (vb < nh) for (int u = vb; u < 64; u += nh) hgrn_unit(proj, (const float*)(ws + WS_LB), (bf16_t*)(ws + WS_YH), lds, u >> 2, u & 3);
        if (G <= 64 || vb >= 64) { const int a0 = (G > 64) ? vb - 64 : vb, na = (G > 64) ? G - 64 : G;
            for (int u = a0; u < BATCH * (SEQ / 64); u += na) attn_unit(proj, a.in[3], (bf16_t*)(ws + WS_YA), lds, u / (SEQ / 64), u % (SEQ / 64)); }
    }
    SEAM(2);
    if (IN(3)) {
        { pg8::Gemm g{(const bf16_t*)(ws + WS_YA), (const bf16_t*)(ws + WS_WAPT), T, 1024, 512}; pg8::StaticOrder S; S.init(T, 1024, G, vb);
          pg8::EpiMerge<false> E{(bf16_t*)(ws + WS_XB), proj + C_GA};
          pg8::gemm_phase<pg8::EpiMerge<false>, pg8::StaticOrder, true, true>(lds, g, S, E); }
        __syncthreads();
        { pg8::Gemm g{(const bf16_t*)(ws + WS_YH), (const bf16_t*)(ws + WS_WHPT), T, 1024, 512}; pg8::StaticOrder S; S.init(T, 1024, G, vb);
          pg8::EpiMerge<true> E{(bf16_t*)(ws + WS_XB), proj + C_GH};
          pg8::gemm_phase<pg8::EpiMerge<true>, pg8::StaticOrder, true, true>(lds, g, S, E); }
    }
    SEAM(3);
    if (IN(4)) { pg8::Gemm g{(const bf16_t*)(ws + WS_XB), (const bf16_t*)(ws + WS_WOUTT), T, 1024, 1024}; pg8::StaticOrder S; S.init(T, 1024, G, vb);
        pg8::EpiX2 E{a.in[0], a.out, (bf16_t*)(ws + WS_X2B), (float*)(ws + WS_SSQ2)};
        pg8::gemm_phase<pg8::EpiX2, pg8::StaticOrder, true, true>(lds, g, S, E); }
    SEAM(4);
    if (IN(5)) { pg8::Gemm g{(const bf16_t*)(ws + WS_X2B), (const bf16_t*)(ws + WS_WQT), T, 2048, 1024}; pg8::StaticOrder S; S.init(T, 2048, G, vb);
        pg8::EpiQp E{(bf16_t*)(ws + WS_QP), (const float*)(ws + WS_SSQ2)};
        pg8::gemm_phase<pg8::EpiQp, pg8::StaticOrder, true, true>(lds, g, S, E); }
    SEAM(5);
    if (IN(6)) for (int u = vb; u < (T / 128) * 8; u += G) topk_unit((const bf16_t*)(ws + WS_QP), (const bf16_t*)(ws + WS_KEYS), (unsigned short*)(ws + WS_GIDX), (float*)(ws + WS_GGATE), lds, u >> 3, u & 7);
    SEAM(6);
    if (IN(7)) for (int tok = vb * 8 + wave; tok < T; tok += G * 8)
        expert_token(a.out + (size_t)tok * DM, (const float*)(ws + WS_SSQ2) + (size_t)tok * 16, (const _Float16*)(ws + WS_U16), (const _Float16*)(ws + WS_V16),
                     (const unsigned short*)(ws + WS_GIDX) + (size_t)tok * 128, (const float*)(ws + WS_GGATE) + (size_t)tok * 128, a.in[14], a.out + (size_t)tok * DM, lane);
#undef IN
#undef SEAM
}

extern "C" void kernel_launch(void* const* d_in, const int* in_sizes, int n_in, void* d_out, int out_size, void* d_ws, size_t ws_size, hipStream_t stream) {
    static int grid = 0;
    if (grid == 0) {
        if (n_in != 15 || in_sizes[0] != T * DM || out_size != T * DM || ws_size < WS_END) { fprintf(stderr, "kernel_launch: unexpected shapes (n_in %d, in0 %d, out %d, ws %zu)\n", n_in, n_in > 0 ? in_sizes[0] : -1, out_size, ws_size); grid = -1; return; }
        int dev = 0, cus = 0, per_cu = 0;
        hipGetDevice(&dev); hipDeviceGetAttribute(&cus, hipDeviceAttributeMultiprocessorCount, dev);
        if (hipFuncSetAttribute((const void*)mk_fwd, hipFuncAttributeMaxDynamicSharedMemorySize, LDS_BYTES) != hipSuccess) { fprintf(stderr, "kernel_launch: hipFuncSetAttribute failed\n"); grid = -1; return; }
        if (hipOccupancyMaxActiveBlocksPerMultiprocessor(&per_cu, (const void*)mk_fwd, NTHR, LDS_BYTES) != hipSuccess || per_cu < 1) { fprintf(stderr, "kernel_launch: occupancy query says %d blocks per CU\n", per_cu); per_cu = 1; }
        (void)hipGetLastError();
        grid = cus;
    }
    if (grid < 0) return;
    Args a{};
    for (int i = 0; i < 15; ++i) a.in[i] = (const float*)d_in[i];
    a.out = (float*)d_out; a.ws = (unsigned char*)d_ws;
#if MK_FUSED
    a.ph_lo = 0; a.ph_hi = N_PHASES;
    { void* args[] = {&a}; hipError_t e = hipLaunchCooperativeKernel((const void*)mk_fwd, dim3(grid), dim3(NTHR), args, LDS_BYTES, stream);
      if (e != hipSuccess) fprintf(stderr, "kernel_launch: cooperative launch failed: %s (grid %d)\n", hipGetErrorString(e), grid); }
#else
    for (int p = 0; p < N_PHASES; ++p) { a.ph_lo = p; a.ph_hi = p + 1; void* args[] = {&a};
        hipError_t e = hipLaunchCooperativeKernel((const void*)mk_fwd, dim3(grid), dim3(NTHR), args, LDS_BYTES, stream);
        if (e != hipSuccess) { fprintf(stderr, "kernel_launch: launch of phase %d failed: %s (grid %d)\n", p, hipGetErrorString(e), grid); break; } }
#endif
}
```

```cpp
#include <hip/hip_runtime.h>
#include <hip/hip_cooperative_groups.h>
#include <cstdio>
#include <cstdint>
namespace cg = cooperative_groups;
namespace pg8 {
#define PG8_LAS __attribute__((address_space(3)))
typedef unsigned short bf16_t;
typedef short bf16x8 __attribute__((ext_vector_type(8)));
typedef float f32x4 __attribute__((ext_vector_type(4)));
typedef unsigned u32x4 __attribute__((ext_vector_type(4)));
constexpr int BM = 256, BK = 64, HALF = 128, HTB = HALF * BK * 2  , STAGE_BYTES = 8 * HTB, NXCD = 8, WGM = 8;

__host__ __device__ __forceinline__ int lds_byte(int r, int c) { const int st = (r >> 4) * 2 + (c >> 5), rr = r & 15, cc = c & 31, ob = rr * 64 + cc * 2; return st * 1024 + (ob ^ (((ob >> 9) & 1) << 5)); }
__host__ __device__ __forceinline__ void stage_rc(int b, int& R, int& C) { const int st = b / 1024, sb = b % 1024, swz = sb ^ (((sb >> 9) & 1) << 5); R = (st >> 1) * 16 + swz / 64; C = (st & 1) * 32 + (swz % 64) / 2; }
__host__ __device__ __forceinline__ int perm32(int rho) { const int n = rho >> 4, i = rho & 15; return 8 * (i >> 2) + 4 * n + (i & 3); }

struct Unit { int pm, pn; };
struct Gemm { const bf16_t* A; const bf16_t* Bt; int M, N, K; };

struct StaticOrder {
    int nM, nN, nwg, G, c;
    __host__ __device__ void init(int M, int N, int G_, int c_) { nM = M / BM; nN = N / BM; nwg = nM * nN; G = G_; c = c_; }
    __host__ __device__ bool next(int i, Unit& u) const {
        const long L = (long)i * G + c; if (L >= nwg) return false;
        int wgid = (int)L; { const int q = nwg / NXCD, r = nwg % NXCD, xcd = wgid % NXCD, off = wgid / NXCD; wgid = (xcd < r ? xcd * (q + 1) : r * (q + 1) + (xcd - r) * q) + off; }
        const int nig = WGM * nN, gid = wgid / nig, fm = gid * WGM, gsz = (nM - fm) < WGM ? (nM - fm) : WGM;
        u.pm = fm + ((wgid % nig) % gsz); u.pn = (wgid % nig) / gsz; return true;
    }
    __device__ __forceinline__ void a_ready(const Unit&) const {}
    __device__ __forceinline__ void done(const Unit&) const {}
};

__device__ __forceinline__ unsigned cvt_pk_bf16(float lo, float hi) { unsigned r; asm volatile("v_cvt_pk_bf16_f32 %0, %1, %2" : "=v"(r) : "v"(lo), "v"(hi)); return r; }

template <class Epi, class Sched, bool ALIGN_EPI = false, bool SP2 = false>
__device__ __forceinline__ void gemm_phase(PG8_LAS unsigned char* lds, const Gemm g, const Sched& S, const Epi& E) {
    const int tid = threadIdx.x, wid = __builtin_amdgcn_readfirstlane(tid >> 6), lane = tid & 63, wr = wid >> 2, wc = wid & 3, fr = lane & 15, fq = lane >> 4;
    const int K = g.K, nt = K / BK;
    unsigned voffA[2], voffB[2];
#pragma unroll
    for (int i = 0; i < 2; ++i) { int R, C; stage_rc(tid * 16 + i * 8192, R, C); const int Rb = Epi::PERM ? ((R & ~31) + perm32(R & 31)) : R;
        voffA[i] = (unsigned)(R * K + C) * 2u; voffB[i] = (unsigned)(Rb * K + C) * 2u; }
    const size_t kstep = (size_t)(BK * 2);
    const size_t hstep = (size_t)HALF * K * 2;
    const size_t tstep = 2 * hstep;
    const unsigned ldsw = (unsigned)wid * 1024u;
    const int aoff = lds_byte(wr * 64 + fr, fq * 8), boff = lds_byte(wc * 32 + fr, fq * 8);
#define PG8_SA(b, h) (((b) * 2 + (h)) * HTB)
#define PG8_SB(b, h) ((4 + (b) * 2 + (h)) * HTB)
#define PG8_STAGE(bufoff, gbase, voff) do { _Pragma("unroll") for (int _i = 0; _i < 2; ++_i) \
        __builtin_amdgcn_global_load_lds((const unsigned*)((const char*)(gbase) + (voff)[_i]), (PG8_LAS unsigned*)(lds + (bufoff) + ldsw + _i * 8192), 16, 0, 0); } while (0)
#define PG8_LDA(dst, b, h) do { _Pragma("unroll") for (int m = 0; m < 4; ++m) _Pragma("unroll") for (int k = 0; k < 2; ++k) dst[m][k] = *(const PG8_LAS bf16x8*)(lds + PG8_SA(b, h) + aoff + m * 2048 + k * 1024); } while (0)
#define PG8_LDB(dst, b, h) do { _Pragma("unroll") for (int n = 0; n < 2; ++n) _Pragma("unroll") for (int k = 0; k < 2; ++k) dst[n][k] = *(const PG8_LAS bf16x8*)(lds + PG8_SB(b, h) + boff + n * 2048 + k * 1024); } while (0)
#define PG8_MMA(ai, bj, At, Bt) do { __builtin_amdgcn_s_setprio(1); _Pragma("unroll") for (int m = 0; m < 4; ++m) _Pragma("unroll") for (int n = 0; n < 2; ++n) _Pragma("unroll") for (int k = 0; k < 2; ++k) \
        acc[ai][bj][m][n] = __builtin_amdgcn_mfma_f32_16x16x32_bf16(Bt[n][k], At[m][k], acc[ai][bj][m][n], 0, 0, 0); __builtin_amdgcn_s_setprio(0); } while (0)
#define PG8_WAIT_V(n) asm volatile("s_waitcnt vmcnt(" #n ")" ::: "memory")
#define PG8_WAIT_L(n) asm volatile("s_waitcnt lgkmcnt(" #n ")" ::: "memory")
#define PG8_BAR __builtin_amdgcn_s_barrier()
#define PG8_SCHED __builtin_amdgcn_sched_barrier(0)
    Unit cur, nxt; int ui = 0;
    if (!S.next(0, cur)) return;
    f32x4 acc[2][2][4][2];
#pragma unroll
    for (int a = 0; a < 2; ++a)
#pragma unroll
        for (int b = 0; b < 2; ++b)
#pragma unroll
            for (int m = 0; m < 4; ++m)
#pragma unroll
                for (int n = 0; n < 2; ++n) acc[a][b][m][n] = (f32x4){0.f, 0.f, 0.f, 0.f};
    bf16x8 At[4][2], B0[2][2], B1[2][2];
    const char* cA = (const char*)g.A + (size_t)cur.pm * tstep; const char* cB = (const char*)g.Bt + (size_t)cur.pn * tstep;
    S.a_ready(cur);
    if constexpr (SP2) {
        PG8_STAGE(PG8_SB(0, 0), cB, voffB); PG8_STAGE(PG8_SB(0, 1), cB + hstep, voffB); PG8_STAGE(PG8_SA(0, 0), cA, voffA); PG8_STAGE(PG8_SA(0, 1), cA + hstep, voffA);
        if (wr == 1) PG8_BAR;
        PG8_WAIT_V(2); PG8_BAR;
        PG8_STAGE(PG8_SB(1, 0), cB + kstep, voffB); PG8_STAGE(PG8_SA(1, 0), cA + kstep, voffA); PG8_STAGE(PG8_SB(1, 1), cB + hstep + kstep, voffB);
        PG8_WAIT_V(6); PG8_BAR;
    } else {
        PG8_STAGE(PG8_SB(0, 0), cB, voffB); PG8_STAGE(PG8_SA(0, 0), cA, voffA); PG8_STAGE(PG8_SB(0, 1), cB + hstep, voffB); PG8_STAGE(PG8_SA(0, 1), cA + hstep, voffA);
        if (wr == 1) PG8_BAR;
        PG8_WAIT_V(4); PG8_BAR;
        PG8_STAGE(PG8_SB(1, 0), cB + kstep, voffB); PG8_STAGE(PG8_SA(1, 0), cA + kstep, voffA); PG8_STAGE(PG8_SB(1, 1), cB + hstep + kstep, voffB);
        PG8_WAIT_V(6); PG8_BAR;
    }
    for (;;) {
        const bool has_next = S.next(ui + 1, nxt);
        const char* nA = has_next ? (const char*)g.A + (size_t)nxt.pm * tstep : cA; const char* nB = has_next ? (const char*)g.Bt + (size_t)nxt.pn * tstep : cB;
        for (int t = 0; t < nt; t += 2) {
            const bool last = (t == nt - 2);
            const char* a1 = cA + (size_t)(t + 1) * kstep;
            const char* a2 = last ? nA : cA + (size_t)(t + 2) * kstep; const char* b2 = last ? nB : cB + (size_t)(t + 2) * kstep;
            const char* a3 = a2 + kstep; const char* b3 = b2 + kstep;
            if (last && has_next) S.a_ready(nxt);
            if constexpr (SP2) {
            PG8_LDB(B0, 0, 0); PG8_LDB(B1, 0, 1); PG8_SCHED; PG8_LDA(At, 0, 0); PG8_STAGE(PG8_SA(1, 1), a1 + hstep, voffA);
            PG8_WAIT_V(8); PG8_WAIT_L(0); PG8_BAR; PG8_MMA(0, 0, At, B0); PG8_MMA(0, 1, At, B1); PG8_BAR; PG8_SCHED;
            PG8_LDA(At, 0, 1); PG8_STAGE(PG8_SB(0, 0), b2, voffB); PG8_STAGE(PG8_SB(0, 1), b2 + hstep, voffB); PG8_STAGE(PG8_SA(0, 0), a2, voffA);
            PG8_WAIT_V(8); PG8_WAIT_L(0); PG8_BAR; PG8_MMA(1, 0, At, B0); PG8_MMA(1, 1, At, B1); PG8_BAR; PG8_SCHED;
            PG8_LDB(B0, 1, 0); PG8_LDB(B1, 1, 1); PG8_SCHED; PG8_LDA(At, 1, 0); PG8_STAGE(PG8_SA(0, 1), a2 + hstep, voffA);
            PG8_WAIT_V(8); PG8_WAIT_L(0); PG8_BAR; PG8_MMA(0, 0, At, B0); PG8_MMA(0, 1, At, B1); PG8_BAR; PG8_SCHED;
            PG8_LDA(At, 1, 1); PG8_STAGE(PG8_SB(1, 0), b3, voffB); PG8_STAGE(PG8_SB(1, 1), b3 + hstep, voffB); PG8_STAGE(PG8_SA(1, 0), a3, voffA);
            PG8_WAIT_V(8); PG8_WAIT_L(0); PG8_BAR; PG8_MMA(1, 0, At, B0); PG8_MMA(1, 1, At, B1); PG8_BAR; PG8_SCHED;
            } else {
            PG8_LDB(B0, 0, 0); PG8_SCHED; PG8_LDA(At, 0, 0); PG8_STAGE(PG8_SA(1, 1), a1 + hstep, voffA);
            PG8_WAIT_L(8); PG8_BAR; PG8_WAIT_L(0); PG8_MMA(0, 0, At, B0); PG8_BAR; PG8_SCHED;
            PG8_LDB(B1, 0, 1); PG8_STAGE(PG8_SB(0, 0), b2, voffB);
            PG8_BAR; PG8_WAIT_L(0); PG8_MMA(0, 1, At, B1); PG8_BAR;
            PG8_LDA(At, 0, 1); PG8_STAGE(PG8_SA(0, 0), a2, voffA);
            PG8_BAR; PG8_WAIT_L(0); PG8_MMA(1, 0, At, B0); PG8_BAR; PG8_SCHED;
            PG8_STAGE(PG8_SB(0, 1), b2 + hstep, voffB);
            PG8_WAIT_V(6); PG8_BAR; PG8_MMA(1, 1, At, B1); PG8_BAR;
            PG8_LDB(B0, 1, 0); PG8_SCHED; PG8_LDA(At, 1, 0); PG8_STAGE(PG8_SA(0, 1), a2 + hstep, voffA);
            PG8_WAIT_L(8); PG8_BAR; PG8_WAIT_L(0); PG8_MMA(0, 0, At, B0); PG8_BAR; PG8_SCHED;
            PG8_LDB(B1, 1, 1); PG8_STAGE(PG8_SB(1, 0), b3, voffB);
            PG8_BAR; PG8_WAIT_L(0); PG8_MMA(0, 1, At, B1); PG8_BAR;
            PG8_LDA(At, 1, 1); PG8_STAGE(PG8_SA(1, 0), a3, voffA);
            PG8_BAR; PG8_WAIT_L(0); PG8_MMA(1, 0, At, B0); PG8_BAR; PG8_SCHED;
            PG8_STAGE(PG8_SB(1, 1), b3 + hstep, voffB);
            PG8_WAIT_V(6); PG8_BAR; PG8_MMA(1, 1, At, B1); PG8_BAR;
            }
        }
        if constexpr (ALIGN_EPI) { if (wr == 0) PG8_BAR; }
        if constexpr (!Epi::AFTER_DRAIN) { E(acc, cur, wr, wc, fr, fq); S.done(cur); }
        if (!has_next) break;
#pragma unroll
        for (int a = 0; a < 2; ++a)
#pragma unroll
            for (int b = 0; b < 2; ++b)
#pragma unroll
                for (int m = 0; m < 4; ++m)
#pragma unroll
                    for (int n = 0; n < 2; ++n) acc[a][b][m][n] = (f32x4){0.f, 0.f, 0.f, 0.f};
        cur = nxt; cA = nA; cB = nB; ++ui;
        if constexpr (ALIGN_EPI) { if (wr == 1) PG8_BAR; }
    }
    PG8_WAIT_V(0);
    if constexpr (!ALIGN_EPI) { if (wr == 0) PG8_BAR; }
    PG8_BAR;
    if constexpr (Epi::AFTER_DRAIN) { E.fused(acc, cur, wr, wc, fr, fq, lds, wid, lane); S.done(cur); }
#undef PG8_SA
#undef PG8_SB
#undef PG8_STAGE
#undef PG8_LDA
#undef PG8_LDB
#undef PG8_MMA
#undef PG8_WAIT_V
#undef PG8_WAIT_L
#undef PG8_BAR
#undef PG8_SCHED
}
}

#ifndef MK_FUSED
#define MK_FUSED 1
#endif
#define DI __device__ __forceinline__
#define LAS __attribute__((address_space(3)))
typedef unsigned short bf16_t;
typedef float f32x4 __attribute__((ext_vector_type(4)));
typedef float f32x2 __attribute__((ext_vector_type(2)));
typedef float f32x16 __attribute__((ext_vector_type(16)));
typedef unsigned u32x4 __attribute__((ext_vector_type(4)));
typedef unsigned u32x2 __attribute__((ext_vector_type(2)));
typedef short bf16x8 __attribute__((ext_vector_type(8)));
typedef _Float16 h16x2 __attribute__((ext_vector_type(2)));
typedef _Float16 h16x8 __attribute__((ext_vector_type(8)));

constexpr int BATCH = 16, SEQ = 4096, T = BATCH * SEQ, DM = 1024, NIN = 4864;
constexpr int C_AQ = 0, C_AK = 512, C_AV = 640, C_HQ = 768, C_HF = 1280, C_HI = 1792, C_HG = 2304, C_GA = 2816, C_GH = 3840;
constexpr float EPS = 1e-6f;
constexpr int NTHR = 512;
constexpr int LDS_BYTES = 147456;

constexpr size_t MiB = 1u << 20;
constexpr size_t WS_W1T = 1 * MiB;
constexpr size_t WS_WAPT = 11 * MiB;
constexpr size_t WS_WHPT = 12 * MiB;
constexpr size_t WS_WOUTT = 13 * MiB;
constexpr size_t WS_WQT = 15 * MiB;
constexpr size_t WS_KEYS = 19 * MiB;
constexpr size_t WS_LB = 19 * MiB + 512 * 1024;
constexpr size_t WS_RSTD1 = 20 * MiB;
constexpr size_t WS_SSQ2 = 21 * MiB;
constexpr size_t WS_U8 = 26 * MiB;
constexpr size_t WS_V8 = 42 * MiB;
constexpr size_t WS_SU = 58 * MiB;
constexpr size_t WS_SV = 58 * MiB + 65536;
constexpr size_t WS_XB = 90 * MiB;
constexpr size_t WS_PROJ = 218 * MiB;
constexpr size_t WS_YA = 826 * MiB;
constexpr size_t WS_YH = 890 * MiB;
constexpr size_t WS_END = 954 * MiB;
constexpr size_t WS_X2B = WS_PROJ;
constexpr size_t WS_QP = WS_PROJ + 128 * MiB;
constexpr size_t WS_GIDX = WS_PROJ + 384 * MiB;
constexpr size_t WS_GGATE = WS_PROJ + 400 * MiB;

struct Args { const float* in[15]; float* out; unsigned char* ws; int ph_lo, ph_hi; };

DI unsigned pk_bf16(float lo, float hi) { typedef __bf16 b2 __attribute__((ext_vector_type(2))); f32x2 v = {lo, hi}; b2 b = __builtin_convertvector(v, b2); return __builtin_bit_cast(unsigned, b); }
DI float bflo(unsigned w) { return __uint_as_float(w << 16); }
DI float bfhi(unsigned w) { return __uint_as_float(w & 0xffff0000u); }
DI float sigm(float x) { return 1.f / (1.f + __expf(-x)); }
DI float wave_sum(float v) {
#pragma unroll
    for (int o = 1; o < 64; o <<= 1) v += __shfl_xor(v, o);
    return v;
}
#define LDS_WAIT() asm volatile("s_waitcnt lgkmcnt(0)" ::: "memory")

namespace pg8 {
struct EpiRowScale {
    static constexpr bool PERM = true, AFTER_DRAIN = false;
    bf16_t* O; int ldc; const float* rs;
    __device__ __forceinline__ void operator()(const f32x4 (&acc)[2][2][4][2], const Unit& u, int wr, int wc, int fr, int fq) const {
        const int row0 = u.pm * BM + wr * 64 + fr, col0 = u.pn * BM + wc * 32 + 8 * fq;
#pragma unroll
        for (int ai = 0; ai < 2; ++ai)
#pragma unroll
            for (int m = 0; m < 4; ++m) { const int row = row0 + ai * HALF + m * 16; const float s = rs ? rs[row] : 1.f; bf16_t* rowp = O + (size_t)row * ldc + col0;
#pragma unroll
                for (int bj = 0; bj < 2; ++bj) { const f32x4 v0 = acc[ai][bj][m][0] * s, v1 = acc[ai][bj][m][1] * s;
                    u32x4 w; w.x = pk_bf16(v0[0], v0[1]); w.y = pk_bf16(v0[2], v0[3]); w.z = pk_bf16(v1[0], v1[1]); w.w = pk_bf16(v1[2], v1[3]);
                    *(u32x4*)(rowp + bj * HALF) = w; } }
    }
};
template <bool ADD> struct EpiMerge {
    static constexpr bool PERM = true, AFTER_DRAIN = false;
    bf16_t* O; const bf16_t* gate;
    __device__ __forceinline__ void operator()(const f32x4 (&acc)[2][2][4][2], const Unit& u, int wr, int wc, int fr, int fq) const {
        const int row0 = u.pm * BM + wr * 64 + fr, col0 = u.pn * BM + wc * 32 + 8 * fq;
#pragma unroll
        for (int ai = 0; ai < 2; ++ai)
#pragma unroll
            for (int m = 0; m < 4; ++m) { const int row = row0 + ai * HALF + m * 16; bf16_t* rowp = O + (size_t)row * DM + col0; const bf16_t* gp = gate + (size_t)row * NIN + col0;
#pragma unroll
                for (int bj = 0; bj < 2; ++bj) { const u32x4 g = *(const u32x4*)(gp + bj * HALF);
                    f32x4 v0 = acc[ai][bj][m][0], v1 = acc[ai][bj][m][1];
                    v0[0] *= sigm(bflo(g.x)); v0[1] *= sigm(bfhi(g.x)); v0[2] *= sigm(bflo(g.y)); v0[3] *= sigm(bfhi(g.y));
                    v1[0] *= sigm(bflo(g.z)); v1[1] *= sigm(bfhi(g.z)); v1[2] *= sigm(bflo(g.w)); v1[3] *= sigm(bfhi(g.w));
                    if (ADD) { const u32x4 o = *(const u32x4*)(rowp + bj * HALF);
                        v0[0] += bflo(o.x); v0[1] += bfhi(o.x); v0[2] += bflo(o.y); v0[3] += bfhi(o.y); v1[0] += bflo(o.z); v1[1] += bfhi(o.z); v1[2] += bflo(o.w); v1[3] += bfhi(o.w); }
                    u32x4 w; w.x = pk_bf16(v0[0], v0[1]); w.y = pk_bf16(v0[2], v0[3]); w.z = pk_bf16(v1[0], v1[1]); w.w = pk_bf16(v1[2], v1[3]);
                    *(u32x4*)(rowp + bj * HALF) = w; } }
    }
};
struct EpiX2 {
    static constexpr bool PERM = true, AFTER_DRAIN = false;
    const float* X; float* X2; bf16_t* X2B; float* ssq;
    __device__ __forceinline__ void operator()(const f32x4 (&acc)[2][2][4][2], const Unit& u, int wr, int wc, int fr, int fq) const {
        const int row0 = u.pm * BM + wr * 64 + fr, col0 = u.pn * BM + wc * 32 + 8 * fq;
#pragma unroll
        for (int ai = 0; ai < 2; ++ai)
#pragma unroll
            for (int m = 0; m < 4; ++m) { const int row = row0 + ai * HALF + m * 16; const size_t off = (size_t)row * DM + col0; float ss = 0.f;
#pragma unroll
                for (int bj = 0; bj < 2; ++bj) { const f32x4 x0 = *(const f32x4*)(X + off + bj * HALF), x1 = *(const f32x4*)(X + off + bj * HALF + 4);
                    const f32x4 v0 = acc[ai][bj][m][0] + x0, v1 = acc[ai][bj][m][1] + x1;
                    *(f32x4*)(X2 + off + bj * HALF) = v0; *(f32x4*)(X2 + off + bj * HALF + 4) = v1;
                    u32x4 w; w.x = pk_bf16(v0[0], v0[1]); w.y = pk_bf16(v0[2], v0[3]); w.z = pk_bf16(v1[0], v1[1]); w.w = pk_bf16(v1[2], v1[3]);
                    *(u32x4*)(X2B + off + bj * HALF) = w;
                    ss += (v0[0] * v0[0] + v0[1] * v0[1]) + (v0[2] * v0[2] + v0[3] * v0[3]) + (v1[0] * v1[0] + v1[1] * v1[1]) + (v1[2] * v1[2] + v1[3] * v1[3]); }
                ss += __shfl_xor(ss, 16); ss += __shfl_xor(ss, 32);
                if (fq == 0) ssq[(size_t)row * 16 + u.pn * 4 + wc] = ss; }
    }
};
struct EpiQp {
    static constexpr bool PERM = true, AFTER_DRAIN = false;
    bf16_t* O; const float* ssq;
    __device__ __forceinline__ void operator()(const f32x4 (&acc)[2][2][4][2], const Unit& u, int wr, int wc, int fr, int fq) const {
        const int row0 = u.pm * BM + wr * 64 + fr, col0 = u.pn * BM + wc * 32 + 8 * fq;
#pragma unroll
        for (int ai = 0; ai < 2; ++ai)
#pragma unroll
            for (int m = 0; m < 4; ++m) { const int row = row0 + ai * HALF + m * 16; const f32x4* sp = (const f32x4*)(ssq + (size_t)row * 16);
                const f32x4 a = sp[0], b = sp[1], c = sp[2], d = sp[3];
                const float tot = ((a[0] + a[1]) + (a[2] + a[3])) + ((b[0] + b[1]) + (b[2] + b[3])) + ((c[0] + c[1]) + (c[2] + c[3])) + ((d[0] + d[1]) + (d[2] + d[3]));
                const float s = __builtin_amdgcn_rsqf(tot * (1.f / 1024.f) + EPS); bf16_t* rowp = O + (size_t)row * 2048 + col0;
#pragma unroll
                for (int bj = 0; bj < 2; ++bj) { const f32x4 v0 = acc[ai][bj][m][0] * s, v1 = acc[ai][bj][m][1] * s;
                    u32x4 w; w.x = pk_bf16(v0[0], v0[1]); w.y = pk_bf16(v0[2], v0[3]); w.z = pk_bf16(v1[0], v1[1]); w.w = pk_bf16(v1[2], v1[3]);
                    *(u32x4*)(rowp + bj * HALF) = w; } }
    }
};
}

DI void p0_transpose_item(const float* W, int K, int N, bf16_t* WT, const float* g, int gmask, LAS float* scr, int item, int lane) {
    const int nblk = N / 32, kb = item / nblk, nb = item % nblk, k0 = 64 * kb, n0 = 32 * nb;
#pragma unroll 8
    for (int i = 0; i < 32; ++i) { const int kk = 2 * i + (lane >> 5); float w = W[(size_t)(k0 + kk) * N + n0 + (lane & 31)]; if (g) w *= g[(k0 + kk) & gmask]; scr[kk * 33 + (lane & 31)] = w; }
    LDS_WAIT(); asm volatile("" ::: "memory");
    const int c = lane & 7;
#pragma unroll
    for (int j = 0; j < 4; ++j) { const int n = (lane >> 3) + 8 * j; const LAS float* s = scr + (8 * c) * 33 + n;
        u32x4 o; o.x = pk_bf16(s[0 * 33], s[1 * 33]); o.y = pk_bf16(s[2 * 33], s[3 * 33]); o.z = pk_bf16(s[4 * 33], s[5 * 33]); o.w = pk_bf16(s[6 * 33], s[7 * 33]);
        *(u32x4*)(WT + (size_t)(n0 + n) * K + k0 + 8 * c) = o; }
    LDS_WAIT(); asm volatile("" ::: "memory");
}
DI unsigned pk_f16(float a, float b) { h16x2 v = {(_Float16)a, (_Float16)b}; return __builtin_bit_cast(unsigned, v); }

DI void p0_prologue(const Args& a, LAS unsigned char* lds, int vb, int G) {
    const int tid = threadIdx.x, lane = tid & 63, wave = tid >> 6;
    const int gw = vb * 8 + wave, NGW = G * 8, gt = vb * NTHR + tid, NGT = G * NTHR;
    unsigned char* ws = a.ws;
    LAS float* scr = (LAS float*)(lds + wave * 16384);
    constexpr int I_W1 = 16 * 152, I_AP = 8 * 32, I_HP = 8 * 32, I_OUT = 16 * 32, I_Q = 16 * 64, NITEMS = I_W1 + I_AP + I_HP + I_OUT + I_Q;
    for (int it = gw; it < NITEMS; it += NGW) {
        int r = it;
        if (r < I_W1) { p0_transpose_item(a.in[2], 1024, NIN, (bf16_t*)(ws + WS_W1T), a.in[1], 1023, scr, r, lane); continue; } r -= I_W1;
        if (r < I_AP) { p0_transpose_item(a.in[6], 512, 1024, (bf16_t*)(ws + WS_WAPT), nullptr, 0, scr, r, lane); continue; } r -= I_AP;
        if (r < I_HP) { p0_transpose_item(a.in[7], 512, 1024, (bf16_t*)(ws + WS_WHPT), a.in[5], 127, scr, r, lane); continue; } r -= I_HP;
        if (r < I_OUT) { p0_transpose_item(a.in[8], 1024, 1024, (bf16_t*)(ws + WS_WOUTT), nullptr, 0, scr, r, lane); continue; } r -= I_OUT;
        p0_transpose_item(a.in[10], 1024, 2048, (bf16_t*)(ws + WS_WQT), a.in[9], 1023, scr, r, lane);
    }
    for (int i = gt; i < 2 * 8 * 128 * 128 / 4; i += NGT) { const f32x4 v = ((const f32x4*)a.in[11])[i]; u32x2 o; o.x = pk_bf16(v[0], v[1]); o.y = pk_bf16(v[2], v[3]); ((u32x2*)(ws + WS_KEYS))[i] = o; }
    for (int it = gw; it < 2 * 16384; it += NGW) {
        const int isv = it >= 16384, e = it & 16383;
        const float* src = (isv ? a.in[13] : a.in[12]) + (size_t)e * 1024 + 16 * lane;
        f32x4 x[4]; float amax = 0.f;
#pragma unroll
        for (int i = 0; i < 4; ++i) { x[i] = *(const f32x4*)(src + 4 * i); if (!isv) x[i] *= *(const f32x4*)(a.in[9] + 16 * lane + 4 * i);
            amax = fmaxf(fmaxf(amax, fmaxf(fabsf(x[i][0]), fabsf(x[i][1]))), fmaxf(fabsf(x[i][2]), fabsf(x[i][3]))); }
#pragma unroll
        for (int o = 1; o < 64; o <<= 1) amax = fmaxf(amax, __shfl_xor(amax, o));
        const float qs = amax > 0.f ? 127.f / amax : 0.f; const int off = isv ? 128 : 0;
        u32x4 w;
#pragma unroll
        for (int i = 0; i < 4; ++i) { const int q0 = (int)rintf(x[i][0] * qs) + off, q1 = (int)rintf(x[i][1] * qs) + off, q2 = (int)rintf(x[i][2] * qs) + off, q3 = (int)rintf(x[i][3] * qs) + off;
            w[i] = (unsigned)(q0 & 255) | ((unsigned)(q1 & 255) << 8) | ((unsigned)(q2 & 255) << 16) | ((unsigned)(q3 & 255) << 24); }
        *(u32x4*)(ws + (isv ? WS_V8 : WS_U8) + (size_t)e * 1024 + 16 * lane) = w;
        if (lane == 0) ((float*)(ws + (isv ? WS_SV : WS_SU)))[e] = amax * (1.f / 127.f);
    }
    for (int row = gw; row < T; row += NGW) {
        const f32x4* xr = (const f32x4*)(a.in[0] + (size_t)row * DM) + lane; f32x4 v[4]; float s = 0.f;
#pragma unroll
        for (int j = 0; j < 4; ++j) { v[j] = xr[64 * j]; s += (v[j][0] * v[j][0] + v[j][1] * v[j][1]) + (v[j][2] * v[j][2] + v[j][3] * v[j][3]); }
        s = wave_sum(s);
        u32x2* o = (u32x2*)(ws + WS_XB + (size_t)row * DM * 2) + lane;
#pragma unroll
        for (int j = 0; j < 4; ++j) { u32x2 w; w.x = pk_bf16(v[j][0], v[j][1]); w.y = pk_bf16(v[j][2], v[j][3]); o[64 * j] = w; }
        if (lane == 0) ((float*)(ws + WS_RSTD1))[row] = __builtin_amdgcn_rsqf(s * (1.f / 1024.f) + EPS);
    }
    if (vb == 0) { const float l0 = a.in[4][tid], l1 = a.in[4][512 + tid]; ((float*)(ws + WS_LB))[tid] = 1.f / (1.f + __expf(l1 - l0)); }
}

DI void attn_unit(const bf16_t* proj, const float* sinks, bf16_t* ya, LAS unsigned char* lds, int b, int tt) {
    const int tid = threadIdx.x, lane = tid & 63, wave = tid >> 6;
    LAS unsigned char* Ks = lds; LAS unsigned char* Vs = lds + 192 * 272;
    for (int c = tid; c < 192 * 16; c += NTHR) { const int jr = c >> 4, ch = c & 15, pos = tt * 64 - 128 + jr; u32x4 kv = {0u, 0u, 0u, 0u}, vv = {0u, 0u, 0u, 0u};
        if (pos >= 0) { const bf16_t* src = proj + (size_t)(b * SEQ + pos) * NIN; kv = *(const u32x4*)(src + C_AK + ch * 8); vv = *(const u32x4*)(src + C_AV + ch * 8); }
        *(LAS u32x4*)(Ks + jr * 272 + ch * 16) = kv; *(LAS u32x4*)(Vs + jr * 272 + ch * 16) = vv; }
    __syncthreads();
    const int h = wave, kvh = h >> 2, pos = tt * 64 + lane; const size_t t = (size_t)b * SEQ + pos;
    float q[64], o[64];
    { const u32x4* qp = (const u32x4*)(proj + t * NIN + C_AQ + h * 64);
#pragma unroll
      for (int c = 0; c < 8; ++c) { const u32x4 w = qp[c]; q[8 * c + 0] = bflo(w.x) * 0.125f; q[8 * c + 1] = bfhi(w.x) * 0.125f; q[8 * c + 2] = bflo(w.y) * 0.125f; q[8 * c + 3] = bfhi(w.y) * 0.125f;
          q[8 * c + 4] = bflo(w.z) * 0.125f; q[8 * c + 5] = bfhi(w.z) * 0.125f; q[8 * c + 6] = bflo(w.w) * 0.125f; q[8 * c + 7] = bfhi(w.w) * 0.125f; } }
#pragma unroll
    for (int d = 0; d < 64; ++d) o[d] = 0.f;
    float m = sinks[h], l = 1.f; const float slope = exp2f(-(float)(h + 1));
    for (int j0 = 0; j0 < 128; j0 += 2) {
        float s[2];
#pragma unroll
        for (int e = 0; e < 2; ++e) { const int j = j0 + e; const LAS unsigned char* kr = Ks + (lane + 128 - j) * 272 + kvh * 128; float acc = 0.f;
#pragma unroll
            for (int c = 0; c < 8; ++c) { const u32x4 w = *(const LAS u32x4*)(kr + c * 16);
                acc += q[8 * c + 0] * bflo(w.x) + q[8 * c + 1] * bfhi(w.x) + q[8 * c + 2] * bflo(w.y) + q[8 * c + 3] * bfhi(w.y) + q[8 * c + 4] * bflo(w.z) + q[8 * c + 5] * bfhi(w.z) + q[8 * c + 6] * bflo(w.w) + q[8 * c + 7] * bfhi(w.w); }
            s[e] = (pos - j >= 0) ? acc - slope * (float)j : -1e30f; }
        asm volatile("" ::: "memory");
        const float mn = fmaxf(m, fmaxf(s[0], s[1])), alpha = __expf(m - mn);
        const float p0 = __expf(s[0] - mn), p1 = __expf(s[1] - mn);
        l = l * alpha + (p0 + p1); m = mn;
        { const LAS unsigned char* vr0 = Vs + (lane + 128 - j0) * 272 + kvh * 128; const LAS unsigned char* vr1 = vr0 - 272;
#pragma unroll
            for (int c = 0; c < 8; ++c) { const u32x4 w = *(const LAS u32x4*)(vr0 + c * 16), x = *(const LAS u32x4*)(vr1 + c * 16);
                o[8 * c + 0] = o[8 * c + 0] * alpha + (p0 * bflo(w.x) + p1 * bflo(x.x)); o[8 * c + 1] = o[8 * c + 1] * alpha + (p0 * bfhi(w.x) + p1 * bfhi(x.x));
                o[8 * c + 2] = o[8 * c + 2] * alpha + (p0 * bflo(w.y) + p1 * bflo(x.y)); o[8 * c + 3] = o[8 * c + 3] * alpha + (p0 * bfhi(w.y) + p1 * bfhi(x.y));
                o[8 * c + 4] = o[8 * c + 4] * alpha + (p0 * bflo(w.z) + p1 * bflo(x.z)); o[8 * c + 5] = o[8 * c + 5] * alpha + (p0 * bfhi(w.z) + p1 * bfhi(x.z));
                o[8 * c + 6] = o[8 * c + 6] * alpha + (p0 * bflo(w.w) + p1 * bflo(x.w)); o[8 * c + 7] = o[8 * c + 7] * alpha + (p0 * bfhi(w.w) + p1 * bfhi(x.w)); } }
        asm volatile("" ::: "memory");
    }
    const float inv = 1.f / l; u32x4* op = (u32x4*)(ya + t * 512 + h * 64);
#pragma unroll
    for (int c = 0; c < 8; ++c) { u32x4 w; w.x = pk_bf16(o[8 * c + 0] * inv, o[8 * c + 1] * inv); w.y = pk_bf16(o[8 * c + 2] * inv, o[8 * c + 3] * inv); w.z = pk_bf16(o[8 * c + 4] * inv, o[8 * c + 5] * inv); w.w = pk_bf16(o[8 * c + 6] * inv, o[8 * c + 7] * inv); op[c] = w; }
    __syncthreads();
}

DI void hgrn_unit(const bf16_t* proj, const float* lbp, bf16_t* yh, LAS unsigned char* lds, int b, int h) {
    const int tid = threadIdx.x;
    LAS float* qs = (LAS float*)lds; LAS float* fs = qs + 2048; LAS float* ks = fs + 2048; LAS float* vs = ks + 2048; LAS float* gs = vs + 2048; LAS float* pos_ = gs + 2048;
    const int dv = tid & 127, dks = tid >> 7;
    float S[32];
#pragma unroll
    for (int d = 0; d < 32; ++d) S[d] = 0.f;
    const int g4 = tid >> 7, ltok = (tid & 127) >> 3, lch = tid & 7;
    const int gcol = (g4 == 0 ? C_HQ : g4 == 1 ? C_HF : g4 == 2 ? C_HI : C_HG) + h * 128 + lch * 16;
    float lb[16];
#pragma unroll
    for (int e = 0; e < 16; ++e) lb[e] = lbp[h * 128 + lch * 16 + e];
    for (int t0 = 0; t0 < SEQ; t0 += 16) {
        { const size_t t = (size_t)b * SEQ + t0 + ltok; const u32x4* src = (const u32x4*)(proj + t * NIN + gcol); const u32x4 w0 = src[0], w1 = src[1];
          float x[16] = {bflo(w0.x), bfhi(w0.x), bflo(w0.y), bfhi(w0.y), bflo(w0.z), bfhi(w0.z), bflo(w0.w), bfhi(w0.w), bflo(w1.x), bfhi(w1.x), bflo(w1.y), bfhi(w1.y), bflo(w1.z), bfhi(w1.z), bflo(w1.w), bfhi(w1.w)};
          const int o = ltok * 128 + lch * 16;
          if (g4 == 0) {
#pragma unroll
              for (int e = 0; e < 16; ++e) qs[o + e] = x[e] * sigm(x[e]);
          } else if (g4 == 1) {
#pragma unroll
              for (int e = 0; e < 16; ++e) { const float f = lb[e] + (1.f - lb[e]) * sigm(x[e]); fs[o + e] = f; ks[o + e] = 1.f - f; }
          } else if (g4 == 2) {
#pragma unroll
              for (int e = 0; e < 16; ++e) vs[o + e] = x[e];
          } else {
#pragma unroll
              for (int e = 0; e < 16; ++e) gs[o + e] = x[e] * sigm(x[e]);
          } }
        __syncthreads();
#pragma unroll 1
        for (int tok = 0; tok < 16; ++tok) {
            const float v = vs[tok * 128 + dv]; float po = 0.f;
#pragma unroll
            for (int d4 = 0; d4 < 8; ++d4) { const int o = tok * 128 + dks * 32 + d4 * 4;
                const f32x4 f = *(const LAS f32x4*)(fs + o), k = *(const LAS f32x4*)(ks + o), q = *(const LAS f32x4*)(qs + o);
#pragma unroll
                for (int e = 0; e < 4; ++e) { S[4 * d4 + e] = f[e] * S[4 * d4 + e] + k[e] * v; po += q[e] * S[4 * d4 + e]; } }
            pos_[(tok * 4 + dks) * 128 + dv] = po;
        }
        __syncthreads();
        { const int tok = tid >> 5, dv4 = (tid & 31) * 4; f32x4 o = {0.f, 0.f, 0.f, 0.f};
#pragma unroll
          for (int s = 0; s < 4; ++s) o += *(const LAS f32x4*)(pos_ + (tok * 4 + s) * 128 + dv4);
          float ss = (o[0] * o[0] + o[1] * o[1]) + (o[2] * o[2] + o[3] * o[3]);
#pragma unroll
          for (int x = 1; x < 32; x <<= 1) ss += __shfl_xor(ss, x);
          const float r = __builtin_amdgcn_rsqf(ss * (1.f / 128.f) + EPS); const f32x4 g = *(const LAS f32x4*)(gs + tok * 128 + dv4);
          u32x2 w; w.x = pk_bf16(o[0] * r * g[0], o[1] * r * g[1]); w.y = pk_bf16(o[2] * r * g[2], o[3] * r * g[3]);
          *(u32x2*)(yh + ((size_t)b * SEQ + t0 + tok) * 512 + h * 128 + dv4) = w; }
        __syncthreads();
    }
}

DI unsigned f2ord(float f) { const unsigned b = __float_as_uint(f); return b ^ ((unsigned)((int)b >> 31) | 0x80000000u); }
DI float ord2f(unsigned k) { const unsigned b = (k & 0x80000000u) ? (k ^ 0x80000000u) : ~k; return __uint_as_float(b); }
#define TK_INS(L, x) do { unsigned t_ = (x); _Pragma("unroll") for (int j_ = 0; j_ < 16; ++j_) { const unsigned hi_ = L[j_] > t_ ? L[j_] : t_; t_ = L[j_] > t_ ? t_ : L[j_]; L[j_] = hi_; } } while (0)
#define MFMA32(a, b, c) __builtin_amdgcn_mfma_f32_32x32x16_bf16((a), (b), (c), 0, 0, 0)

DI void topk_unit(const bf16_t* qp, const bf16_t* keysb, unsigned short* gidx, float* ggate, LAS unsigned char* lds, int tile, int h) {
    const int tid = threadIdx.x, lane = tid & 63, wave = tid >> 6, p = wave & 1, tsub = wave >> 1, r = lane & 31, hh = lane >> 5;
    const int tok0 = tile * 128 + tsub * 32;
    f32x16 acc[4];
#pragma unroll
    for (int kb = 0; kb < 4; ++kb)
#pragma unroll
        for (int i = 0; i < 16; ++i) acc[kb][i] = 0.f;
    const bf16_t* qrow = qp + (size_t)(tok0 + r) * 2048 + h * 256 + p * 128 + 8 * hh;
    const bf16_t* kbase = keysb + ((size_t)(p * 8 + h) * 128 + r) * 128 + 8 * hh;
#pragma unroll
    for (int s = 0; s < 8; ++s) { const bf16x8 bq = *(const bf16x8*)(qrow + 16 * s);
#pragma unroll
        for (int kb = 0; kb < 4; ++kb) { const bf16x8 ak = *(const bf16x8*)(kbase + (size_t)kb * 32 * 128 + 16 * s); acc[kb] = MFMA32(ak, bq, acc[kb]); } }
    unsigned L[16];
#pragma unroll
    for (int j = 0; j < 16; ++j) L[j] = 0u;
#pragma unroll
    for (int kb = 0; kb < 4; ++kb)
#pragma unroll
        for (int i = 0; i < 16; ++i) { const unsigned key = (f2ord(acc[kb][i]) & ~127u) | (unsigned)(32 * kb + (i & 3) + 8 * (i >> 2) + 4 * hh); TK_INS(L, key); }
    { unsigned P[16];
#pragma unroll
      for (int j = 0; j < 16; ++j) P[j] = __shfl_xor(L[j], 32);
#pragma unroll
      for (int j = 0; j < 16; ++j) TK_INS(L, P[j]); }
    LAS unsigned* tk = (LAS unsigned*)lds;
    if (hh == 0) { LAS u32x4* dst = (LAS u32x4*)(tk + ((p * 128 + tsub * 32 + r) * 16));
#pragma unroll
        for (int c = 0; c < 4; ++c) { u32x4 w = {L[4 * c], L[4 * c + 1], L[4 * c + 2], L[4 * c + 3]}; dst[c] = w; } }
    __syncthreads();
    if (tid < 128) {
        unsigned L1[16], L2[16];
        { const LAS u32x4* s1 = (const LAS u32x4*)(tk + tid * 16); const LAS u32x4* s2 = (const LAS u32x4*)(tk + (128 + tid) * 16);
#pragma unroll
          for (int c = 0; c < 4; ++c) { const u32x4 a = s1[c], b = s2[c]; L1[4 * c] = a.x; L1[4 * c + 1] = a.y; L1[4 * c + 2] = a.z; L1[4 * c + 3] = a.w; L2[4 * c] = b.x; L2[4 * c + 1] = b.y; L2[4 * c + 2] = b.z; L2[4 * c + 3] = b.w; } }
        float v1[16], v2[16];
#pragma unroll
        for (int j = 0; j < 16; ++j) { v1[j] = ord2f(L1[j] & ~127u); v2[j] = ord2f(L2[j] & ~127u); }
        unsigned C[16];
#pragma unroll
        for (int j = 0; j < 16; ++j) C[j] = 0u;
#pragma unroll
        for (int i = 0; i < 16; ++i)
#pragma unroll
            for (int j = 0; j < 16; ++j) if ((i + 1) * (j + 1) <= 16) { const unsigned key = (f2ord(v1[i] + v2[j]) & ~255u) | (unsigned)(i * 16 + j); TK_INS(C, key); }
        float sc[16]; unsigned ei[16]; float mx = -1e30f;
#pragma unroll
        for (int q = 0; q < 16; ++q) { const unsigned ij = C[q] & 255u; const unsigned a = tk[tid * 16 + (ij >> 4)], b = tk[(128 + tid) * 16 + (ij & 15u)];
            sc[q] = ord2f(a & ~127u) + ord2f(b & ~127u); ei[q] = (a & 127u) * 128u + (b & 127u); mx = fmaxf(mx, sc[q]); }
        float sum = 0.f;
#pragma unroll
        for (int q = 0; q < 16; ++q) { sc[q] = __expf(sc[q] - mx); sum += sc[q]; }
        const float inv = 1.f / sum; const size_t o = (size_t)(tile * 128 + tid) * 128 + h * 16;
#pragma unroll
        for (int q = 0; q < 16; ++q) { gidx[o + q] = (unsigned short)ei[q]; ggate[o + q] = sc[q] * inv; }
    }
    __syncthreads();
}

DI float gelu_erf(float x) { return 0.5f * x * (1.f + erff(x * 0.70710678118654752f)); }
DI int dot16(u32x4 w, const int (&h)[4]) { int c = __builtin_amdgcn_sdot4((int)w.x, h[0], 0, false); c = __builtin_amdgcn_sdot4((int)w.y, h[1], c, false); c = __builtin_amdgcn_sdot4((int)w.z, h[2], c, false); return __builtin_amdgcn_sdot4((int)w.w, h[3], c, false); }
#define V8_FMA(acc4, word, we) do { acc4[0] += (we) * (float)((word) & 255u); acc4[1] += (we) * (float)(((word) >> 8) & 255u); acc4[2] += (we) * (float)(((word) >> 16) & 255u); acc4[3] += (we) * (float)((word) >> 24); } while (0)

DI void expert_token(const float* x2row, const float* ssq, const unsigned char* u8, const unsigned char* v8, const float* su, const float* sv, const unsigned short* gidx, const float* ggate, const float* gf, float* outrow, int lane) {
    f32x4 x[4]; float amax = 0.f;
#pragma unroll
    for (int i = 0; i < 4; ++i) { x[i] = *(const f32x4*)(x2row + 16 * lane + 4 * i); amax = fmaxf(fmaxf(amax, fmaxf(fabsf(x[i][0]), fabsf(x[i][1]))), fmaxf(fabsf(x[i][2]), fabsf(x[i][3]))); }
    float ss = (lane < 16) ? ssq[lane] : 0.f; ss = wave_sum(ss);
    const float rstd2 = __builtin_amdgcn_rsqf(ss * (1.f / 1024.f) + EPS);
#pragma unroll
    for (int o = 1; o < 64; o <<= 1) amax = fmaxf(amax, __shfl_xor(amax, o));
    amax *= rstd2;
    const float qs = amax > 0.f ? 127.f / amax : 0.f, sh = amax * (1.f / 127.f), xq = rstd2 * qs;
    int hq[4];
#pragma unroll
    for (int i = 0; i < 4; ++i) { const int q0 = (int)rintf(x[i][0] * xq), q1 = (int)rintf(x[i][1] * xq), q2 = (int)rintf(x[i][2] * xq), q3 = (int)rintf(x[i][3] * xq);
        hq[i] = (int)((unsigned)(q0 & 255) | ((unsigned)(q1 & 255) << 8) | ((unsigned)(q2 & 255) << 16) | ((unsigned)(q3 & 255) << 24)); }
    const int id0 = gidx[lane], id1 = gidx[64 + lane]; const float g0 = ggate[lane], g1 = ggate[64 + lane];
    f32x4 o[4]; float wsum = 0.f;
#pragma unroll
    for (int i = 0; i < 4; ++i) o[i] = (f32x4){0.f, 0.f, 0.f, 0.f};
#pragma unroll 1
    for (int bt = 0; bt < 16; ++bt) {
        const int idsel = (bt < 8) ? id0 : id1; const float gsel = (bt < 8) ? g0 : g1; const int lb = (bt & 7) * 8;
        u32x4 ur[8], vr[8];
#pragma unroll
        for (int e = 0; e < 8; ++e) { const int idx = __builtin_amdgcn_readlane(idsel, lb + e); ur[e] = *(const u32x4*)(u8 + (size_t)idx * 1024 + 16 * lane); }
#pragma unroll
        for (int e = 0; e < 8; ++e) { const int idx = __builtin_amdgcn_readlane(idsel, lb + e); vr[e] = *(const u32x4*)(v8 + (size_t)idx * 1024 + 16 * lane); }
        const int myidx = __shfl(idsel, lb + (lane >> 3)); const float mysu = su[myidx], mysv = sv[myidx], gate = __shfl(gsel, lb + (lane >> 3));
        int pr[8];
#pragma unroll
        for (int e = 0; e < 8; ++e) pr[e] = dot16(ur[e], hq);
        int q4[4], q2[2], q1;
        { const bool up_ = (lane & 32) != 0;
#pragma unroll
          for (int i = 0; i < 4; ++i) { const int keep = up_ ? pr[i + 4] : pr[i], send = up_ ? pr[i] : pr[i + 4]; q4[i] = keep + __shfl_xor(send, 32); } }
        { const bool up_ = (lane & 16) != 0;
#pragma unroll
          for (int i = 0; i < 2; ++i) { const int keep = up_ ? q4[i + 2] : q4[i], send = up_ ? q4[i] : q4[i + 2]; q2[i] = keep + __shfl_xor(send, 16); } }
        { const bool up_ = (lane & 8) != 0; const int keep = up_ ? q2[1] : q2[0], send = up_ ? q2[0] : q2[1]; q1 = keep + __shfl_xor(send, 8); }
        q1 += __shfl_xor(q1, 4); q1 += __shfl_xor(q1, 2); q1 += __shfl_xor(q1, 1);
        const float act = (float)q1 * (mysu * sh);
        const float w = gelu_erf(act) * gate * mysv;
#pragma unroll
        for (int e = 0; e < 8; ++e) { const float we = __int_as_float(__builtin_amdgcn_readlane(__float_as_int(w), 8 * e)); wsum += we;
            V8_FMA(o[0], vr[e].x, we); V8_FMA(o[1], vr[e].y, we); V8_FMA(o[2], vr[e].z, we); V8_FMA(o[3], vr[e].w, we); }
    }
    const float corr = 128.f * wsum; float s3 = 0.f;
#pragma unroll
    for (int i = 0; i < 4; ++i) { x[i] += o[i] - corr; s3 += (x[i][0] * x[i][0] + x[i][1] * x[i][1]) + (x[i][2] * x[i][2] + x[i][3] * x[i][3]); }
    s3 = wave_sum(s3); const float r3 = __builtin_amdgcn_rsqf(s3 * (1.f / 1024.f) + EPS);
#pragma unroll
    for (int i = 0; i < 4; ++i) *(f32x4*)(outrow + 16 * lane + 4 * i) = x[i] * r3 * *(const f32x4*)(gf + 16 * lane + 4 * i);
}

constexpr int N_PHASES = 8;
__global__ void __launch_bounds__(NTHR, 2) mk_fwd(Args a) {
    extern __shared__ __attribute__((aligned(16))) unsigned char lds_raw[];
    LAS unsigned char* lds = (LAS unsigned char*)lds_raw;
    cg::grid_group grid = cg::this_grid();
    const int G = gridDim.x, vb = blockIdx.x, tid = threadIdx.x, lane = tid & 63, wave = tid >> 6;
    unsigned char* ws = a.ws;
    const int lo = a.ph_lo, hi = a.ph_hi;
#ifndef PHASE_MASK
#define PHASE_MASK 0xFF
#endif
#define IN(k) (((PHASE_MASK >> (k)) & 1) && lo <= (k) && (k) < hi)
#ifndef REPEAT_MASK
#define REPEAT_MASK 0
#endif
#define REP(k) for (int rep_ = 0; rep_ < (((REPEAT_MASK) >> (k)) & 1) + 1; ++rep_)
#define SEAM(k) do { if (IN(k) && IN((k) + 1)) grid.sync(); } while (0)
    bf16_t* proj = (bf16_t*)(ws + WS_PROJ);

    REP(0) if (IN(0)) p0_prologue(a, lds, vb, G);
    SEAM(0);
    REP(1) if (IN(1)) { pg8::Gemm g{(const bf16_t*)(ws + WS_XB), (const bf16_t*)(ws + WS_W1T), T, NIN, 1024}; pg8::StaticOrder S; S.init(T, NIN, G, vb);
        pg8::EpiRowScale E{proj, NIN, (const float*)(ws + WS_RSTD1)};
        pg8::gemm_phase<pg8::EpiRowScale, pg8::StaticOrder, true, true>(lds, g, S, E); }
    SEAM(1);
    REP(2) if (IN(2)) {
        const int nh = (G > 64) ? 64 : G;
        if (vb < nh) for (int u = vb; u < 64; u += nh) hgrn_unit(proj, (const float*)(ws + WS_LB), (bf16_t*)(ws + WS_YH), lds, u >> 2, u & 3);
        if (G <= 64 || vb >= 64) { const int a0 = (G > 64) ? vb - 64 : vb, na = (G > 64) ? G - 64 : G;
            for (int u = a0; u < BATCH * (SEQ / 64); u += na) attn_unit(proj, a.in[3], (bf16_t*)(ws + WS_YA), lds, u / (SEQ / 64), u % (SEQ / 64)); }
    }
    SEAM(2);
    REP(3) if (IN(3)) {
        { pg8::Gemm g{(const bf16_t*)(ws + WS_YA), (const bf16_t*)(ws + WS_WAPT), T, 1024, 512}; pg8::StaticOrder S; S.init(T, 1024, G, vb);
          pg8::EpiMerge<false> E{(bf16_t*)(ws + WS_XB), proj + C_GA};
          pg8::gemm_phase<pg8::EpiMerge<false>, pg8::StaticOrder, true, true>(lds, g, S, E); }
        __syncthreads();
        { pg8::Gemm g{(const bf16_t*)(ws + WS_YH), (const bf16_t*)(ws + WS_WHPT), T, 1024, 512}; pg8::StaticOrder S; S.init(T, 1024, G, vb);
          pg8::EpiMerge<true> E{(bf16_t*)(ws + WS_XB), proj + C_GH};
          pg8::gemm_phase<pg8::EpiMerge<true>, pg8::StaticOrder, true, true>(lds, g, S, E); }
    }
    SEAM(3);
    REP(4) if (IN(4)) { pg8::Gemm g{(const bf16_t*)(ws + WS_XB), (const bf16_t*)(ws + WS_WOUTT), T, 1024, 1024}; pg8::StaticOrder S; S.init(T, 1024, G, vb);
        pg8::EpiX2 E{a.in[0], a.out, (bf16_t*)(ws + WS_X2B), (float*)(ws + WS_SSQ2)};
        pg8::gemm_phase<pg8::EpiX2, pg8::StaticOrder, true, true>(lds, g, S, E); }
    SEAM(4);
    REP(5) if (IN(5)) { pg8::Gemm g{(const bf16_t*)(ws + WS_X2B), (const bf16_t*)(ws + WS_WQT), T, 2048, 1024}; pg8::StaticOrder S; S.init(T, 2048, G, vb);
        pg8::EpiQp E{(bf16_t*)(ws + WS_QP), (const float*)(ws + WS_SSQ2)};
        pg8::gemm_phase<pg8::EpiQp, pg8::StaticOrder, true, true>(lds, g, S, E); }
    SEAM(5);
    REP(6) if (IN(6)) for (int u = vb; u < (T / 128) * 8; u += G) topk_unit((const bf16_t*)(ws + WS_QP), (const bf16_t*)(ws + WS_KEYS), (unsigned short*)(ws + WS_GIDX), (float*)(ws + WS_GGATE), lds, u >> 3, u & 7);
    SEAM(6);
    REP(7) if (IN(7)) for (int tok = vb * 8 + wave; tok < T; tok += G * 8)
        expert_token(a.out + (size_t)tok * DM, (const float*)(ws + WS_SSQ2) + (size_t)tok * 16, (const unsigned char*)(ws + WS_U8), (const unsigned char*)(ws + WS_V8), (const float*)(ws + WS_SU), (const float*)(ws + WS_SV),
                     (const unsigned short*)(ws + WS_GIDX) + (size_t)tok * 128, (const float*)(ws + WS_GGATE) + (size_t)tok * 128, a.in[14], a.out + (size_t)tok * DM, lane);
#undef IN
#undef SEAM
}

extern "C" void kernel_launch(void* const* d_in, const int* in_sizes, int n_in, void* d_out, int out_size, void* d_ws, size_t ws_size, hipStream_t stream) {
    static int grid = 0;
    if (grid == 0) {
        if (n_in != 15 || in_sizes[0] != T * DM || out_size != T * DM || ws_size < WS_END) { fprintf(stderr, "kernel_launch: unexpected shapes (n_in %d, in0 %d, out %d, ws %zu)\n", n_in, n_in > 0 ? in_sizes[0] : -1, out_size, ws_size); grid = -1; return; }
        int dev = 0, cus = 0, per_cu = 0;
        hipGetDevice(&dev); hipDeviceGetAttribute(&cus, hipDeviceAttributeMultiprocessorCount, dev);
        if (hipFuncSetAttribute((const void*)mk_fwd, hipFuncAttributeMaxDynamicSharedMemorySize, LDS_BYTES) != hipSuccess) { fprintf(stderr, "kernel_launch: hipFuncSetAttribute failed\n"); grid = -1; return; }
        if (hipOccupancyMaxActiveBlocksPerMultiprocessor(&per_cu, (const void*)mk_fwd, NTHR, LDS_BYTES) != hipSuccess || per_cu < 1) { fprintf(stderr, "kernel_launch: occupancy query says %d blocks per CU\n", per_cu); per_cu = 1; }
        (void)hipGetLastError();
        grid = cus;
    }
    if (grid < 0) return;
    Args a{};
    for (int i = 0; i < 15; ++i) a.in[i] = (const float*)d_in[i];
    a.out = (float*)d_out; a.ws = (unsigned char*)d_ws;
#if MK_FUSED
    a.ph_lo = 0; a.ph_hi = N_PHASES;
    { void* args[] = {&a}; hipError_t e = hipLaunchCooperativeKernel((const void*)mk_fwd, dim3(grid), dim3(NTHR), args, LDS_BYTES, stream);
      if (e != hipSuccess) fprintf(stderr, "kernel_launch: cooperative launch failed: %s (grid %d)\n", hipGetErrorString(e), grid); }
#else
    for (int p = 0; p < N_PHASES; ++p) { a.ph_lo = p; a.ph_hi = p + 1; void* args[] = {&a};
        hipError_t e = hipLaunchCooperativeKernel((const void*)mk_fwd, dim3(grid), dim3(NTHR), args, LDS_BYTES, stream);
        if (e != hipSuccess) { fprintf(stderr, "kernel_launch: launch of phase %d failed: %s (grid %d)\n", p, hipGetErrorString(e), grid); break; } }
#endif
}
```

```cpp
#include <hip/hip_runtime.h>
#include <hip/hip_cooperative_groups.h>
#include <cstdio>
#include <cstdint>
namespace cg = cooperative_groups;
namespace pg8 {
#define PG8_LAS __attribute__((address_space(3)))
typedef unsigned short bf16_t;
typedef short bf16x8 __attribute__((ext_vector_type(8)));
typedef float f32x4 __attribute__((ext_vector_type(4)));
typedef unsigned u32x4 __attribute__((ext_vector_type(4)));
constexpr int BM = 256, BK = 64, HALF = 128, HTB = HALF * BK * 2  , STAGE_BYTES = 8 * HTB, NXCD = 8, WGM = 8;

__host__ __device__ __forceinline__ int lds_byte(int r, int c) { const int st = (r >> 4) * 2 + (c >> 5), rr = r & 15, cc = c & 31, ob = rr * 64 + cc * 2; return st * 1024 + (ob ^ (((ob >> 9) & 1) << 5)); }
__host__ __device__ __forceinline__ void stage_rc(int b, int& R, int& C) { const int st = b / 1024, sb = b % 1024, swz = sb ^ (((sb >> 9) & 1) << 5); R = (st >> 1) * 16 + swz / 64; C = (st & 1) * 32 + (swz % 64) / 2; }
__host__ __device__ __forceinline__ int perm32(int rho) { const int n = rho >> 4, i = rho & 15; return 8 * (i >> 2) + 4 * n + (i & 3); }

struct Unit { int pm, pn; };
struct Gemm { const bf16_t* A; const bf16_t* Bt; int M, N, K; };

struct StaticOrder {
    int nM, nN, nwg, G, c;
    __host__ __device__ void init(int M, int N, int G_, int c_) { nM = M / BM; nN = N / BM; nwg = nM * nN; G = G_; c = c_; }
    __host__ __device__ bool next(int i, Unit& u) const {
        const long L = (long)i * G + c; if (L >= nwg) return false;
        int wgid = (int)L; { const int q = nwg / NXCD, r = nwg % NXCD, xcd = wgid % NXCD, off = wgid / NXCD; wgid = (xcd < r ? xcd * (q + 1) : r * (q + 1) + (xcd - r) * q) + off; }
        const int nig = WGM * nN, gid = wgid / nig, fm = gid * WGM, gsz = (nM - fm) < WGM ? (nM - fm) : WGM;
        u.pm = fm + ((wgid % nig) % gsz); u.pn = (wgid % nig) / gsz; return true;
    }
    __device__ __forceinline__ void a_ready(const Unit&) const {}
    __device__ __forceinline__ void done(const Unit&) const {}
};

__device__ __forceinline__ unsigned cvt_pk_bf16(float lo, float hi) { unsigned r; asm volatile("v_cvt_pk_bf16_f32 %0, %1, %2" : "=v"(r) : "v"(lo), "v"(hi)); return r; }

template <class Epi, class Sched, bool ALIGN_EPI = false, bool SP2 = false>
__device__ __forceinline__ void gemm_phase(PG8_LAS unsigned char* lds, const Gemm g, const Sched& S, const Epi& E) {
    int tid_ = threadIdx.x; asm volatile("" : "+v"(tid_));
    const int tid = tid_, wid = __builtin_amdgcn_readfirstlane(tid >> 6), lane = tid & 63, wr = wid >> 2, wc = wid & 3, fr = lane & 15, fq = lane >> 4;
    const int K = g.K, nt = K / BK;
    unsigned voffA[2], voffB[2];
#pragma unroll
    for (int i = 0; i < 2; ++i) { int R, C; stage_rc(tid * 16 + i * 8192, R, C); const int Rb = Epi::PERM ? ((R & ~31) + perm32(R & 31)) : R;
        voffA[i] = (unsigned)(R * K + C) * 2u; voffB[i] = (unsigned)(Rb * K + C) * 2u; }
    const size_t kstep = (size_t)(BK * 2);
    const size_t hstep = (size_t)HALF * K * 2;
    const size_t tstep = 2 * hstep;
    const unsigned ldsw = (unsigned)wid * 1024u;
    const int aoff = lds_byte(wr * 64 + fr, fq * 8), boff = lds_byte(wc * 32 + fr, fq * 8);
#define PG8_SA(b, h) (((b) * 2 + (h)) * HTB)
#define PG8_SB(b, h) ((4 + (b) * 2 + (h)) * HTB)
#define PG8_STAGE(bufoff, gbase, voff) do { _Pragma("unroll") for (int _i = 0; _i < 2; ++_i) \
        __builtin_amdgcn_global_load_lds((const unsigned*)((const char*)(gbase) + (voff)[_i]), (PG8_LAS unsigned*)(lds + (bufoff) + ldsw + _i * 8192), 16, 0, 0); } while (0)
#define PG8_LDA(dst, b, h) do { _Pragma("unroll") for (int m = 0; m < 4; ++m) _Pragma("unroll") for (int k = 0; k < 2; ++k) dst[m][k] = *(const PG8_LAS bf16x8*)(lds + PG8_SA(b, h) + aoff + m * 2048 + k * 1024); } while (0)
#define PG8_LDB(dst, b, h) do { _Pragma("unroll") for (int n = 0; n < 2; ++n) _Pragma("unroll") for (int k = 0; k < 2; ++k) dst[n][k] = *(const PG8_LAS bf16x8*)(lds + PG8_SB(b, h) + boff + n * 2048 + k * 1024); } while (0)
#define PG8_MMA(ai, bj, At, Bt) do { __builtin_amdgcn_s_setprio(1); _Pragma("unroll") for (int m = 0; m < 4; ++m) _Pragma("unroll") for (int n = 0; n < 2; ++n) _Pragma("unroll") for (int k = 0; k < 2; ++k) \
        acc[ai][bj][m][n] = __builtin_amdgcn_mfma_f32_16x16x32_bf16(Bt[n][k], At[m][k], acc[ai][bj][m][n], 0, 0, 0); __builtin_amdgcn_s_setprio(0); } while (0)
#define PG8_WAIT_V(n) asm volatile("s_waitcnt vmcnt(" #n ")" ::: "memory")
#define PG8_WAIT_L(n) asm volatile("s_waitcnt lgkmcnt(" #n ")" ::: "memory")
#define PG8_BAR __builtin_amdgcn_s_barrier()
#define PG8_SCHED __builtin_amdgcn_sched_barrier(0)
    Unit cur, nxt; int ui = 0;
    if (!S.next(0, cur)) return;
    f32x4 acc[2][2][4][2];
#pragma unroll
    for (int a = 0; a < 2; ++a)
#pragma unroll
        for (int b = 0; b < 2; ++b)
#pragma unroll
            for (int m = 0; m < 4; ++m)
#pragma unroll
                for (int n = 0; n < 2; ++n) acc[a][b][m][n] = (f32x4){0.f, 0.f, 0.f, 0.f};
    bf16x8 At[4][2], B0[2][2], B1[2][2];
    const char* cA = (const char*)g.A + (size_t)cur.pm * tstep; const char* cB = (const char*)g.Bt + (size_t)cur.pn * tstep;
    S.a_ready(cur);
    if constexpr (SP2) {
        PG8_STAGE(PG8_SB(0, 0), cB, voffB); PG8_STAGE(PG8_SB(0, 1), cB + hstep, voffB); PG8_STAGE(PG8_SA(0, 0), cA, voffA); PG8_STAGE(PG8_SA(0, 1), cA + hstep, voffA);
        if (wr == 1) PG8_BAR;
        PG8_WAIT_V(2); PG8_BAR;
        PG8_STAGE(PG8_SB(1, 0), cB + kstep, voffB); PG8_STAGE(PG8_SA(1, 0), cA + kstep, voffA); PG8_STAGE(PG8_SB(1, 1), cB + hstep + kstep, voffB);
        PG8_WAIT_V(6); PG8_BAR;
    } else {
        PG8_STAGE(PG8_SB(0, 0), cB, voffB); PG8_STAGE(PG8_SA(0, 0), cA, voffA); PG8_STAGE(PG8_SB(0, 1), cB + hstep, voffB); PG8_STAGE(PG8_SA(0, 1), cA + hstep, voffA);
        if (wr == 1) PG8_BAR;
        PG8_WAIT_V(4); PG8_BAR;
        PG8_STAGE(PG8_SB(1, 0), cB + kstep, voffB); PG8_STAGE(PG8_SA(1, 0), cA + kstep, voffA); PG8_STAGE(PG8_SB(1, 1), cB + hstep + kstep, voffB);
        PG8_WAIT_V(6); PG8_BAR;
    }
    for (;;) {
        const bool has_next = S.next(ui + 1, nxt);
        const char* nA = has_next ? (const char*)g.A + (size_t)nxt.pm * tstep : cA; const char* nB = has_next ? (const char*)g.Bt + (size_t)nxt.pn * tstep : cB;
        for (int t = 0; t < nt; t += 2) {
            const bool last = (t == nt - 2);
            const char* a1 = cA + (size_t)(t + 1) * kstep;
            const char* a2 = last ? nA : cA + (size_t)(t + 2) * kstep; const char* b2 = last ? nB : cB + (size_t)(t + 2) * kstep;
            const char* a3 = a2 + kstep; const char* b3 = b2 + kstep;
            if (last && has_next) S.a_ready(nxt);
            if constexpr (SP2) {
            PG8_LDB(B0, 0, 0); PG8_LDB(B1, 0, 1); PG8_SCHED; PG8_LDA(At, 0, 0); PG8_STAGE(PG8_SA(1, 1), a1 + hstep, voffA);
            PG8_WAIT_V(8); PG8_WAIT_L(0); PG8_BAR; PG8_MMA(0, 0, At, B0); PG8_MMA(0, 1, At, B1); PG8_BAR; PG8_SCHED;
            PG8_LDA(At, 0, 1); PG8_STAGE(PG8_SB(0, 0), b2, voffB); PG8_STAGE(PG8_SB(0, 1), b2 + hstep, voffB); PG8_STAGE(PG8_SA(0, 0), a2, voffA);
            PG8_WAIT_V(8); PG8_WAIT_L(0); PG8_BAR; PG8_MMA(1, 0, At, B0); PG8_MMA(1, 1, At, B1); PG8_BAR; PG8_SCHED;
            PG8_LDB(B0, 1, 0); PG8_LDB(B1, 1, 1); PG8_SCHED; PG8_LDA(At, 1, 0); PG8_STAGE(PG8_SA(0, 1), a2 + hstep, voffA);
            PG8_WAIT_V(8); PG8_WAIT_L(0); PG8_BAR; PG8_MMA(0, 0, At, B0); PG8_MMA(0, 1, At, B1); PG8_BAR; PG8_SCHED;
            PG8_LDA(At, 1, 1); PG8_STAGE(PG8_SB(1, 0), b3, voffB); PG8_STAGE(PG8_SB(1, 1), b3 + hstep, voffB); PG8_STAGE(PG8_SA(1, 0), a3, voffA);
            PG8_WAIT_V(8); PG8_WAIT_L(0); PG8_BAR; PG8_MMA(1, 0, At, B0); PG8_MMA(1, 1, At, B1); PG8_BAR; PG8_SCHED;
            } else {
            PG8_LDB(B0, 0, 0); PG8_SCHED; PG8_LDA(At, 0, 0); PG8_STAGE(PG8_SA(1, 1), a1 + hstep, voffA);
            PG8_WAIT_L(8); PG8_BAR; PG8_WAIT_L(0); PG8_MMA(0, 0, At, B0); PG8_BAR; PG8_SCHED;
            PG8_LDB(B1, 0, 1); PG8_STAGE(PG8_SB(0, 0), b2, voffB);
            PG8_BAR; PG8_WAIT_L(0); PG8_MMA(0, 1, At, B1); PG8_BAR;
            PG8_LDA(At, 0, 1); PG8_STAGE(PG8_SA(0, 0), a2, voffA);
            PG8_BAR; PG8_WAIT_L(0); PG8_MMA(1, 0, At, B0); PG8_BAR; PG8_SCHED;
            PG8_STAGE(PG8_SB(0, 1), b2 + hstep, voffB);
            PG8_WAIT_V(6); PG8_BAR; PG8_MMA(1, 1, At, B1); PG8_BAR;
            PG8_LDB(B0, 1, 0); PG8_SCHED; PG8_LDA(At, 1, 0); PG8_STAGE(PG8_SA(0, 1), a2 + hstep, voffA);
            PG8_WAIT_L(8); PG8_BAR; PG8_WAIT_L(0); PG8_MMA(0, 0, At, B0); PG8_BAR; PG8_SCHED;
            PG8_LDB(B1, 1, 1); PG8_STAGE(PG8_SB(1, 0), b3, voffB);
            PG8_BAR; PG8_WAIT_L(0); PG8_MMA(0, 1, At, B1); PG8_BAR;
            PG8_LDA(At, 1, 1); PG8_STAGE(PG8_SA(1, 0), a3, voffA);
            PG8_BAR; PG8_WAIT_L(0); PG8_MMA(1, 0, At, B0); PG8_BAR; PG8_SCHED;
            PG8_STAGE(PG8_SB(1, 1), b3 + hstep, voffB);
            PG8_WAIT_V(6); PG8_BAR; PG8_MMA(1, 1, At, B1); PG8_BAR;
            }
        }
        if constexpr (ALIGN_EPI) { if (wr == 0) PG8_BAR; }
        if constexpr (!Epi::AFTER_DRAIN) { E(acc, cur, wr, wc, fr, fq); S.done(cur); }
        if (!has_next) break;
#pragma unroll
        for (int a = 0; a < 2; ++a)
#pragma unroll
            for (int b = 0; b < 2; ++b)
#pragma unroll
                for (int m = 0; m < 4; ++m)
#pragma unroll
                    for (int n = 0; n < 2; ++n) acc[a][b][m][n] = (f32x4){0.f, 0.f, 0.f, 0.f};
        cur = nxt; cA = nA; cB = nB; ++ui;
        if constexpr (ALIGN_EPI) { if (wr == 1) PG8_BAR; }
    }
    PG8_WAIT_V(0);
    if constexpr (!ALIGN_EPI) { if (wr == 0) PG8_BAR; }
    PG8_BAR;
    if constexpr (Epi::AFTER_DRAIN) { E.fused(acc, cur, wr, wc, fr, fq, lds, wid, lane); S.done(cur); }
#undef PG8_SA
#undef PG8_SB
#undef PG8_STAGE
#undef PG8_LDA
#undef PG8_LDB
#undef PG8_MMA
#undef PG8_WAIT_V
#undef PG8_WAIT_L
#undef PG8_BAR
#undef PG8_SCHED
}
}

#ifndef MK_FUSED
#define MK_FUSED 1
#endif
#define DI __device__ __forceinline__
#define LAS __attribute__((address_space(3)))
typedef unsigned short bf16_t;
typedef float f32x4 __attribute__((ext_vector_type(4)));
typedef float f32x2 __attribute__((ext_vector_type(2)));
typedef float f32x16 __attribute__((ext_vector_type(16)));
typedef unsigned u32x4 __attribute__((ext_vector_type(4)));
typedef unsigned u32x2 __attribute__((ext_vector_type(2)));
typedef short bf16x8 __attribute__((ext_vector_type(8)));
typedef _Float16 h16x2 __attribute__((ext_vector_type(2)));
typedef _Float16 h16x8 __attribute__((ext_vector_type(8)));

constexpr int BATCH = 16, SEQ = 4096, T = BATCH * SEQ, DM = 1024, NIN = 4864;
constexpr int C_AQ = 0, C_AK = 512, C_AV = 640, C_HQ = 768, C_HF = 1280, C_HI = 1792, C_HG = 2304, C_GA = 2816, C_GH = 3840;
constexpr float EPS = 1e-6f;
constexpr int NTHR = 512;
constexpr int LDS_BYTES = 147456;

constexpr size_t MiB = 1u << 20;
constexpr size_t WS_W1T = 1 * MiB;
constexpr size_t WS_WAPT = 11 * MiB;
constexpr size_t WS_WHPT = 12 * MiB;
constexpr size_t WS_WOUTT = 13 * MiB;
constexpr size_t WS_WQT = 15 * MiB;
constexpr size_t WS_KEYS = 19 * MiB;
constexpr size_t WS_LB = 19 * MiB + 512 * 1024;
constexpr size_t WS_RSTD1 = 20 * MiB;
constexpr size_t WS_SSQ2 = 21 * MiB;
constexpr size_t WS_U8 = 26 * MiB;
constexpr size_t WS_V8 = 42 * MiB;
constexpr size_t WS_SU = 58 * MiB;
constexpr size_t WS_SV = 58 * MiB + 65536;
constexpr size_t WS_DEC = 60 * MiB;
constexpr size_t WS_XB = 90 * MiB;
constexpr size_t WS_PA = 218 * MiB;
constexpr size_t WS_GG = 314 * MiB;
constexpr size_t WS_QD = 570 * MiB;
constexpr size_t WS_KINV = 634 * MiB;
constexpr size_t WS_KENDT = 698 * MiB;
constexpr size_t WS_VT = 762 * MiB;
constexpr size_t WS_GS = 826 * MiB;
constexpr size_t WS_YA = 890 * MiB;
constexpr size_t WS_YH = 954 * MiB;
constexpr size_t WS_END = 1018 * MiB;
constexpr size_t WS_X2B = 218 * MiB;
constexpr size_t WS_QP = 346 * MiB;
constexpr size_t WS_GIDX = 602 * MiB;
constexpr size_t WS_GGATE = 618 * MiB;

struct Args { const float* in[15]; float* out; unsigned char* ws; int ph_lo, ph_hi; };

DI unsigned pk_bf16(float lo, float hi) { typedef __bf16 b2 __attribute__((ext_vector_type(2))); f32x2 v = {lo, hi}; b2 b = __builtin_convertvector(v, b2); return __builtin_bit_cast(unsigned, b); }
DI float bflo(unsigned w) { return __uint_as_float(w << 16); }
DI float bfhi(unsigned w) { return __uint_as_float(w & 0xffff0000u); }
DI float sigm(float x) { return 1.f / (1.f + __expf(-x)); }
DI float wave_sum(float v) {
#pragma unroll
    for (int o = 1; o < 64; o <<= 1) v += __shfl_xor(v, o);
    return v;
}
DI unsigned short bf16_1(float x) { return (unsigned short)(pk_bf16(x, 0.f) & 0xffffu); }
template <int N> DI float dpp_row_shr(float v) { return __int_as_float(__builtin_amdgcn_update_dpp(0, __float_as_int(v), 0x110 + N, 0xf, 0xf, true)); }
DI float scan16(float v) { v += dpp_row_shr<1>(v); v += dpp_row_shr<2>(v); v += dpp_row_shr<4>(v); v += dpp_row_shr<8>(v); return v; }
DI int crow(int reg, int hh) { return (reg & 3) + 8 * (reg >> 2) + 4 * hh; }
#define MFMA32(a, b, c) __builtin_amdgcn_mfma_f32_32x32x16_bf16((a), (b), (c), 0, 0, 0)
#define LDS_WAIT() asm volatile("s_waitcnt lgkmcnt(0)" ::: "memory")

namespace pg8 {
struct Epi1 {
    static constexpr bool PERM = true, AFTER_DRAIN = false;
    const float* rs; bf16_t* pa; bf16_t* gg; bf16_t* qd; bf16_t* kinv; bf16_t* kendT; bf16_t* vT; bf16_t* gs; float* dec; const float* lb;
    __device__ __forceinline__ void operator()(const f32x4 (&acc)[2][2][4][2], const Unit& u, int wr, int wc, int fr, int fq) const {
        asm volatile("" : "+v"(fr), "+v"(fq));
        const int row0 = u.pm * BM + wr * 64 + fr, pn = u.pn;
        if (pn < 3 || pn >= 11) {
            bf16_t* O; int ldc, colt;
            if (pn < 3) { O = pa; ldc = 768; colt = pn * 256; } else { O = gg; ldc = 2048; colt = (pn - 11) * 256; }
            const int col0 = colt + wc * 32 + 8 * fq;
#pragma unroll
            for (int ai = 0; ai < 2; ++ai)
#pragma unroll
                for (int m = 0; m < 4; ++m) { const int row = row0 + ai * HALF + m * 16; const float s = rs[row]; bf16_t* rowp = O + (size_t)row * ldc + col0;
#pragma unroll
                    for (int bj = 0; bj < 2; ++bj) { const f32x4 v0 = acc[ai][bj][m][0] * s, v1 = acc[ai][bj][m][1] * s;
                        u32x4 w; w.x = pk_bf16(v0[0], v0[1]); w.y = pk_bf16(v0[2], v0[3]); w.z = pk_bf16(v1[0], v1[1]); w.w = pk_bf16(v1[2], v1[3]);
                        *(u32x4*)(rowp + bj * HALF) = w; } }
            return;
        }
        const int h = (pn - 3) & 3, c8 = wc * 32 + 8 * fq, bh = (u.pm >> 4) * 4 + h;
        if (pn < 7) {
#pragma unroll
            for (int ai = 0; ai < 2; ++ai) {
                const int tseq0 = (u.pm & 15) * 256 + ai * HALF + wr * 64;
                float rsv[4]; float decv[8];
#pragma unroll
                for (int m = 0; m < 4; ++m) rsv[m] = rs[row0 + ai * HALF + m * 16];
#pragma unroll
                for (int n = 0; n < 2; ++n) {
                    float qdv[4][4], kiv[4][4];
#pragma unroll
                    for (int e = 0; e < 4; ++e) {
                        const int dk = c8 + 4 * n + e; const float lbc = lb[h * 128 + dk];
                        float f[4], p[4];
#pragma unroll
                        for (int m = 0; m < 4; ++m) { const float x = acc[ai][1][m][n][e] * rsv[m]; f[m] = lbc + (1.f - lbc) * sigm(x); p[m] = scan16(__logf(f[m])); }
                        const float t0 = __shfl(p[0], 15, 16), t1 = __shfl(p[1], 15, 16), t2 = __shfl(p[2], 15, 16), t3 = __shfl(p[3], 15, 16);
                        const float bl = (t0 + t1) + (t2 + t3), dc = __expf(bl); decv[4 * n + e] = dc;
                        const float bb[4] = {p[0], p[1] + t0, p[2] + (t0 + t1), p[3] + ((t0 + t1) + t2)};
                        bf16_t* kt = kendT + (size_t)(bh * 128 + dk) * SEQ + tseq0 + fr;
#pragma unroll
                        for (int m = 0; m < 4; ++m) { const float eb = __expf(bb[m]), einv = __builtin_amdgcn_rcpf(eb), k = 1.f - f[m], xq = acc[ai][0][m][n][e] * rsv[m];
                            qdv[m][e] = xq * sigm(xq) * eb; kiv[m][e] = k * einv; kt[16 * m] = bf16_1(k * einv * dc); }
                    }
#pragma unroll
                    for (int m = 0; m < 4; ++m) { const size_t o = (size_t)(row0 + ai * HALF + m * 16) * 512 + h * 128 + c8 + 4 * n;
                        u32x2 w; w.x = pk_bf16(qdv[m][0], qdv[m][1]); w.y = pk_bf16(qdv[m][2], qdv[m][3]); *(u32x2*)(qd + o) = w;
                        u32x2 z; z.x = pk_bf16(kiv[m][0], kiv[m][1]); z.y = pk_bf16(kiv[m][2], kiv[m][3]); *(u32x2*)(kinv + o) = z; }
                }
                if (fr == 0) { float* dp = dec + (size_t)(bh * 64 + (tseq0 >> 6)) * 128 + c8;
                    *(f32x4*)dp = (f32x4){decv[0], decv[1], decv[2], decv[3]}; *(f32x4*)(dp + 4) = (f32x4){decv[4], decv[5], decv[6], decv[7]}; }
            }
        } else {
#pragma unroll
            for (int ai = 0; ai < 2; ++ai) {
                const int tseq0 = (u.pm & 15) * 256 + ai * HALF + wr * 64;
#pragma unroll
                for (int m = 0; m < 4; ++m) { const int row = row0 + ai * HALF + m * 16; const float s = rs[row];
#pragma unroll
                    for (int n = 0; n < 2; ++n)
#pragma unroll
                        for (int e = 0; e < 4; ++e) vT[(size_t)(bh * 128 + c8 + 4 * n + e) * SEQ + tseq0 + 16 * m + fr] = bf16_1(acc[ai][0][m][n][e] * s);
                    f32x4 g0 = acc[ai][1][m][0] * s, g1 = acc[ai][1][m][1] * s;
#pragma unroll
                    for (int e = 0; e < 4; ++e) { g0[e] *= sigm(g0[e]); g1[e] *= sigm(g1[e]); }
                    u32x4 w; w.x = pk_bf16(g0[0], g0[1]); w.y = pk_bf16(g0[2], g0[3]); w.z = pk_bf16(g1[0], g1[1]); w.w = pk_bf16(g1[2], g1[3]);
                    *(u32x4*)(gs + (size_t)row * 512 + h * 128 + c8) = w; }
            }
        }
    }
};
template <bool ADD> struct EpiMerge {
    static constexpr bool PERM = true, AFTER_DRAIN = false;
    bf16_t* O; const bf16_t* gate;
    __device__ __forceinline__ void operator()(const f32x4 (&acc)[2][2][4][2], const Unit& u, int wr, int wc, int fr, int fq) const {
        const int row0 = u.pm * BM + wr * 64 + fr, col0 = u.pn * BM + wc * 32 + 8 * fq;
#pragma unroll
        for (int ai = 0; ai < 2; ++ai)
#pragma unroll
            for (int m = 0; m < 4; ++m) { const int row = row0 + ai * HALF + m * 16; bf16_t* rowp = O + (size_t)row * DM + col0; const bf16_t* gp = gate + (size_t)row * 2048 + col0;
#pragma unroll
                for (int bj = 0; bj < 2; ++bj) { const u32x4 g = *(const u32x4*)(gp + bj * HALF);
                    f32x4 v0 = acc[ai][bj][m][0], v1 = acc[ai][bj][m][1];
                    v0[0] *= sigm(bflo(g.x)); v0[1] *= sigm(bfhi(g.x)); v0[2] *= sigm(bflo(g.y)); v0[3] *= sigm(bfhi(g.y));
                    v1[0] *= sigm(bflo(g.z)); v1[1] *= sigm(bfhi(g.z)); v1[2] *= sigm(bflo(g.w)); v1[3] *= sigm(bfhi(g.w));
                    if (ADD) { const u32x4 o = *(const u32x4*)(rowp + bj * HALF);
                        v0[0] += bflo(o.x); v0[1] += bfhi(o.x); v0[2] += bflo(o.y); v0[3] += bfhi(o.y); v1[0] += bflo(o.z); v1[1] += bfhi(o.z); v1[2] += bflo(o.w); v1[3] += bfhi(o.w); }
                    u32x4 w; w.x = pk_bf16(v0[0], v0[1]); w.y = pk_bf16(v0[2], v0[3]); w.z = pk_bf16(v1[0], v1[1]); w.w = pk_bf16(v1[2], v1[3]);
                    *(u32x4*)(rowp + bj * HALF) = w; } }
    }
};
struct EpiX2 {
    static constexpr bool PERM = true, AFTER_DRAIN = false;
    const float* X; float* X2; bf16_t* X2B; float* ssq;
    __device__ __forceinline__ void operator()(const f32x4 (&acc)[2][2][4][2], const Unit& u, int wr, int wc, int fr, int fq) const {
        const int row0 = u.pm * BM + wr * 64 + fr, col0 = u.pn * BM + wc * 32 + 8 * fq;
#pragma unroll
        for (int ai = 0; ai < 2; ++ai)
#pragma unroll
            for (int m = 0; m < 4; ++m) { const int row = row0 + ai * HALF + m * 16; const size_t off = (size_t)row * DM + col0; float ss = 0.f;
#pragma unroll
                for (int bj = 0; bj < 2; ++bj) { const f32x4 x0 = *(const f32x4*)(X + off + bj * HALF), x1 = *(const f32x4*)(X + off + bj * HALF + 4);
                    const f32x4 v0 = acc[ai][bj][m][0] + x0, v1 = acc[ai][bj][m][1] + x1;
                    *(f32x4*)(X2 + off + bj * HALF) = v0; *(f32x4*)(X2 + off + bj * HALF + 4) = v1;
                    u32x4 w; w.x = pk_bf16(v0[0], v0[1]); w.y = pk_bf16(v0[2], v0[3]); w.z = pk_bf16(v1[0], v1[1]); w.w = pk_bf16(v1[2], v1[3]);
                    *(u32x4*)(X2B + off + bj * HALF) = w;
                    ss += (v0[0] * v0[0] + v0[1] * v0[1]) + (v0[2] * v0[2] + v0[3] * v0[3]) + (v1[0] * v1[0] + v1[1] * v1[1]) + (v1[2] * v1[2] + v1[3] * v1[3]); }
                ss += __shfl_xor(ss, 16); ss += __shfl_xor(ss, 32);
                if (fq == 0) ssq[(size_t)row * 16 + u.pn * 4 + wc] = ss; }
    }
};
struct EpiQp {
    static constexpr bool PERM = true, AFTER_DRAIN = false;
    bf16_t* O; const float* ssq;
    __device__ __forceinline__ void operator()(const f32x4 (&acc)[2][2][4][2], const Unit& u, int wr, int wc, int fr, int fq) const {
        const int row0 = u.pm * BM + wr * 64 + fr, col0 = u.pn * BM + wc * 32 + 8 * fq;
#pragma unroll
        for (int ai = 0; ai < 2; ++ai)
#pragma unroll
            for (int m = 0; m < 4; ++m) { const int row = row0 + ai * HALF + m * 16; const f32x4* sp = (const f32x4*)(ssq + (size_t)row * 16);
                const f32x4 a = sp[0], b = sp[1], c = sp[2], d = sp[3];
                const float tot = ((a[0] + a[1]) + (a[2] + a[3])) + ((b[0] + b[1]) + (b[2] + b[3])) + ((c[0] + c[1]) + (c[2] + c[3])) + ((d[0] + d[1]) + (d[2] + d[3]));
                const float s = __builtin_amdgcn_rsqf(tot * (1.f / 1024.f) + EPS); bf16_t* rowp = O + (size_t)row * 2048 + col0;
#pragma unroll
                for (int bj = 0; bj < 2; ++bj) { const f32x4 v0 = acc[ai][bj][m][0] * s, v1 = acc[ai][bj][m][1] * s;
                    u32x4 w; w.x = pk_bf16(v0[0], v0[1]); w.y = pk_bf16(v0[2], v0[3]); w.z = pk_bf16(v1[0], v1[1]); w.w = pk_bf16(v1[2], v1[3]);
                    *(u32x4*)(rowp + bj * HALF) = w; } }
    }
};
}

DI int w1_src_col(int n) {
    if (n < 768 || n >= 2816) return n;
    if (n < 1792) { const int h = (n - 768) >> 8, r = (n - 768) & 255; return r < 128 ? C_HQ + 128 * h + r : C_HF + 128 * h + (r - 128); }
    const int h = (n - 1792) >> 8, r = (n - 1792) & 255; return r < 128 ? C_HI + 128 * h + r : C_HG + 128 * h + (r - 128);
}
template <bool PERMW1> DI void p0_transpose_item(const float* W, int K, int N, bf16_t* WT, const float* g, int gmask, LAS float* scr, int item, int lane) {
    const int nblk = N / 32, kb = item / nblk, nb = item % nblk, k0 = 64 * kb, n0 = 32 * nb, ns = PERMW1 ? w1_src_col(n0) : n0;
#pragma unroll 8
    for (int i = 0; i < 32; ++i) { const int kk = 2 * i + (lane >> 5); float w = W[(size_t)(k0 + kk) * N + ns + (lane & 31)]; if (g) w *= g[(k0 + kk) & gmask]; scr[kk * 33 + (lane & 31)] = w; }
    LDS_WAIT(); asm volatile("" ::: "memory");
    const int c = lane & 7;
#pragma unroll
    for (int j = 0; j < 4; ++j) { const int n = (lane >> 3) + 8 * j; const LAS float* s = scr + (8 * c) * 33 + n;
        u32x4 o; o.x = pk_bf16(s[0 * 33], s[1 * 33]); o.y = pk_bf16(s[2 * 33], s[3 * 33]); o.z = pk_bf16(s[4 * 33], s[5 * 33]); o.w = pk_bf16(s[6 * 33], s[7 * 33]);
        *(u32x4*)(WT + (size_t)(n0 + n) * K + k0 + 8 * c) = o; }
    LDS_WAIT(); asm volatile("" ::: "memory");
}
DI unsigned pk_f16(float a, float b) { h16x2 v = {(_Float16)a, (_Float16)b}; return __builtin_bit_cast(unsigned, v); }

DI void p0_prologue(const Args& a, LAS unsigned char* lds, int vb, int G) {
    const int tid = threadIdx.x, lane = tid & 63, wave = tid >> 6;
    const int gw = vb * 8 + wave, NGW = G * 8, gt = vb * NTHR + tid, NGT = G * NTHR;
    unsigned char* ws = a.ws;
    LAS float* scr = (LAS float*)(lds + wave * 16384);
    constexpr int I_W1 = 16 * 152, I_AP = 8 * 32, I_HP = 8 * 32, I_OUT = 16 * 32, I_Q = 16 * 64, NITEMS = I_W1 + I_AP + I_HP + I_OUT + I_Q;
    for (int it = gw; it < NITEMS; it += NGW) {
        int r = it;
        if (r < I_W1) { p0_transpose_item<true>(a.in[2], 1024, NIN, (bf16_t*)(ws + WS_W1T), a.in[1], 1023, scr, r, lane); continue; } r -= I_W1;
        if (r < I_AP) { p0_transpose_item<false>(a.in[6], 512, 1024, (bf16_t*)(ws + WS_WAPT), nullptr, 0, scr, r, lane); continue; } r -= I_AP;
        if (r < I_HP) { p0_transpose_item<false>(a.in[7], 512, 1024, (bf16_t*)(ws + WS_WHPT), a.in[5], 127, scr, r, lane); continue; } r -= I_HP;
        if (r < I_OUT) { p0_transpose_item<false>(a.in[8], 1024, 1024, (bf16_t*)(ws + WS_WOUTT), nullptr, 0, scr, r, lane); continue; } r -= I_OUT;
        p0_transpose_item<false>(a.in[10], 1024, 2048, (bf16_t*)(ws + WS_WQT), a.in[9], 1023, scr, r, lane);
    }
    for (int i = gt; i < 2 * 8 * 128 * 128 / 4; i += NGT) { const f32x4 v = ((const f32x4*)a.in[11])[i]; u32x2 o; o.x = pk_bf16(v[0], v[1]); o.y = pk_bf16(v[2], v[3]); ((u32x2*)(ws + WS_KEYS))[i] = o; }
    for (int it = gw; it < 2 * 16384; it += NGW) {
        const int isv = it >= 16384, e = it & 16383;
        const float* src = (isv ? a.in[13] : a.in[12]) + (size_t)e * 1024 + 16 * lane;
        f32x4 x[4]; float amax = 0.f;
#pragma unroll
        for (int i = 0; i < 4; ++i) { x[i] = *(const f32x4*)(src + 4 * i); if (!isv) x[i] *= *(const f32x4*)(a.in[9] + 16 * lane + 4 * i);
            amax = fmaxf(fmaxf(amax, fmaxf(fabsf(x[i][0]), fabsf(x[i][1]))), fmaxf(fabsf(x[i][2]), fabsf(x[i][3]))); }
#pragma unroll
        for (int o = 1; o < 64; o <<= 1) amax = fmaxf(amax, __shfl_xor(amax, o));
        const float qs = amax > 0.f ? 127.f / amax : 0.f; const int off = isv ? 128 : 0;
        u32x4 w;
#pragma unroll
        for (int i = 0; i < 4; ++i) { const int q0 = (int)rintf(x[i][0] * qs) + off, q1 = (int)rintf(x[i][1] * qs) + off, q2 = (int)rintf(x[i][2] * qs) + off, q3 = (int)rintf(x[i][3] * qs) + off;
            w[i] = (unsigned)(q0 & 255) | ((unsigned)(q1 & 255) << 8) | ((unsigned)(q2 & 255) << 16) | ((unsigned)(q3 & 255) << 24); }
        *(u32x4*)(ws + (isv ? WS_V8 : WS_U8) + (size_t)e * 1024 + 16 * lane) = w;
        if (lane == 0) ((float*)(ws + (isv ? WS_SV : WS_SU)))[e] = amax * (1.f / 127.f);
    }
    for (int row = gw; row < T; row += NGW) {
        const f32x4* xr = (const f32x4*)(a.in[0] + (size_t)row * DM) + lane; f32x4 v[4]; float s = 0.f;
#pragma unroll
        for (int j = 0; j < 4; ++j) { v[j] = xr[64 * j]; s += (v[j][0] * v[j][0] + v[j][1] * v[j][1]) + (v[j][2] * v[j][2] + v[j][3] * v[j][3]); }
        s = wave_sum(s);
        u32x2* o = (u32x2*)(ws + WS_XB + (size_t)row * DM * 2) + lane;
#pragma unroll
        for (int j = 0; j < 4; ++j) { u32x2 w; w.x = pk_bf16(v[j][0], v[j][1]); w.y = pk_bf16(v[j][2], v[j][3]); o[64 * j] = w; }
        if (lane == 0) ((float*)(ws + WS_RSTD1))[row] = __builtin_amdgcn_rsqf(s * (1.f / 1024.f) + EPS);
    }
    if (vb == 0) { const float l0 = a.in[4][tid], l1 = a.in[4][512 + tid]; ((float*)(ws + WS_LB))[tid] = 1.f / (1.f + __expf(l1 - l0)); }
}

DI void attn_unit(const bf16_t* pa, const float* sinks, bf16_t* ya, LAS unsigned char* lds, int b, int tt) {
    const int tid = threadIdx.x, lane = tid & 63, wave = tid >> 6;
    LAS unsigned char* Ks = lds; LAS unsigned char* Vs = lds + 192 * 272;
    for (int c = tid; c < 192 * 16; c += NTHR) { const int jr = c >> 4, ch = c & 15, pos = tt * 64 - 128 + jr; u32x4 kv = {0u, 0u, 0u, 0u}, vv = {0u, 0u, 0u, 0u};
        if (pos >= 0) { const bf16_t* src = pa + (size_t)(b * SEQ + pos) * 768; kv = *(const u32x4*)(src + 512 + ch * 8); vv = *(const u32x4*)(src + 640 + ch * 8); }
        *(LAS u32x4*)(Ks + jr * 272 + ch * 16) = kv; *(LAS u32x4*)(Vs + jr * 272 + ch * 16) = vv; }
    __syncthreads();
    const int h = wave, kvh = h >> 2, pos = tt * 64 + lane; const size_t t = (size_t)b * SEQ + pos;
    float q[64], o[64];
    { const u32x4* qp = (const u32x4*)(pa + t * 768 + h * 64);
#pragma unroll
      for (int c = 0; c < 8; ++c) { const u32x4 w = qp[c]; q[8 * c + 0] = bflo(w.x) * 0.125f; q[8 * c + 1] = bfhi(w.x) * 0.125f; q[8 * c + 2] = bflo(w.y) * 0.125f; q[8 * c + 3] = bfhi(w.y) * 0.125f;
          q[8 * c + 4] = bflo(w.z) * 0.125f; q[8 * c + 5] = bfhi(w.z) * 0.125f; q[8 * c + 6] = bflo(w.w) * 0.125f; q[8 * c + 7] = bfhi(w.w) * 0.125f; } }
#pragma unroll
    for (int d = 0; d < 64; ++d) o[d] = 0.f;
    float m = sinks[h], l = 1.f; const float slope = exp2f(-(float)(h + 1));
    for (int j0 = 0; j0 < 128; j0 += 2) {
        float s[2];
#pragma unroll
        for (int e = 0; e < 2; ++e) { const int j = j0 + e; const LAS unsigned char* kr = Ks + (lane + 128 - j) * 272 + kvh * 128; float acc = 0.f;
#pragma unroll
            for (int c = 0; c < 8; ++c) { const u32x4 w = *(const LAS u32x4*)(kr + c * 16);
                acc += q[8 * c + 0] * bflo(w.x) + q[8 * c + 1] * bfhi(w.x) + q[8 * c + 2] * bflo(w.y) + q[8 * c + 3] * bfhi(w.y) + q[8 * c + 4] * bflo(w.z) + q[8 * c + 5] * bfhi(w.z) + q[8 * c + 6] * bflo(w.w) + q[8 * c + 7] * bfhi(w.w); }
            s[e] = (pos - j >= 0) ? acc - slope * (float)j : -1e30f; }
        asm volatile("" ::: "memory");
        const float mn = fmaxf(m, fmaxf(s[0], s[1])), alpha = __expf(m - mn);
        const float p0 = __expf(s[0] - mn), p1 = __expf(s[1] - mn);
        l = l * alpha + (p0 + p1); m = mn;
        { const LAS unsigned char* vr0 = Vs + (lane + 128 - j0) * 272 + kvh * 128; const LAS unsigned char* vr1 = vr0 - 272;
#pragma unroll
            for (int c = 0; c < 8; ++c) { const u32x4 w = *(const LAS u32x4*)(vr0 + c * 16), x = *(const LAS u32x4*)(vr1 + c * 16);
                o[8 * c + 0] = o[8 * c + 0] * alpha + (p0 * bflo(w.x) + p1 * bflo(x.x)); o[8 * c + 1] = o[8 * c + 1] * alpha + (p0 * bfhi(w.x) + p1 * bfhi(x.x));
                o[8 * c + 2] = o[8 * c + 2] * alpha + (p0 * bflo(w.y) + p1 * bflo(x.y)); o[8 * c + 3] = o[8 * c + 3] * alpha + (p0 * bfhi(w.y) + p1 * bfhi(x.y));
                o[8 * c + 4] = o[8 * c + 4] * alpha + (p0 * bflo(w.z) + p1 * bflo(x.z)); o[8 * c + 5] = o[8 * c + 5] * alpha + (p0 * bfhi(w.z) + p1 * bfhi(x.z));
                o[8 * c + 6] = o[8 * c + 6] * alpha + (p0 * bflo(w.w) + p1 * bflo(x.w)); o[8 * c + 7] = o[8 * c + 7] * alpha + (p0 * bfhi(w.w) + p1 * bfhi(x.w)); } }
        asm volatile("" ::: "memory");
    }
    const float inv = 1.f / l; u32x4* op = (u32x4*)(ya + t * 512 + h * 64);
#pragma unroll
    for (int c = 0; c < 8; ++c) { u32x4 w; w.x = pk_bf16(o[8 * c + 0] * inv, o[8 * c + 1] * inv); w.y = pk_bf16(o[8 * c + 2] * inv, o[8 * c + 3] * inv); w.z = pk_bf16(o[8 * c + 4] * inv, o[8 * c + 5] * inv); w.w = pk_bf16(o[8 * c + 6] * inv, o[8 * c + 7] * inv); op[c] = w; }
    __syncthreads();
}

DI void hgrn_ds_unit(const bf16_t* kendT, const bf16_t* vT, bf16_t* dsT, int bh, int c) {
    const int lane = threadIdx.x & 63, wave = threadIdx.x >> 6, r = lane & 31, hh = lane >> 5, i = wave >> 1, j0 = 2 * (wave & 1);
    const bf16_t* ka = kendT + (size_t)(bh * 128 + 32 * i + r) * SEQ + c * 64 + 8 * hh;
    const bf16_t* vb0 = vT + (size_t)(bh * 128 + 32 * j0 + r) * SEQ + c * 64 + 8 * hh; const bf16_t* vb1 = vb0 + (size_t)32 * SEQ;
    f32x16 D0, D1;
#pragma unroll
    for (int q = 0; q < 16; ++q) { D0[q] = 0.f; D1[q] = 0.f; }
#pragma unroll
    for (int ks = 0; ks < 4; ++ks) { const bf16x8 a = *(const bf16x8*)(ka + 16 * ks), b0 = *(const bf16x8*)(vb0 + 16 * ks), b1 = *(const bf16x8*)(vb1 + 16 * ks); D0 = MFMA32(a, b0, D0); D1 = MFMA32(a, b1, D1); }
    const int unit = bh * 64 + c;
    bf16_t* o0 = dsT + (size_t)(unit * 128 + 32 * j0 + r) * 128 + 32 * i + 4 * hh; bf16_t* o1 = o0 + 32 * 128;
#pragma unroll
    for (int g = 0; g < 4; ++g) { u32x2 w; w.x = pk_bf16(D0[4 * g], D0[4 * g + 1]); w.y = pk_bf16(D0[4 * g + 2], D0[4 * g + 3]); *(u32x2*)(o0 + 8 * g) = w;
        u32x2 z; z.x = pk_bf16(D1[4 * g], D1[4 * g + 1]); z.y = pk_bf16(D1[4 * g + 2], D1[4 * g + 3]); *(u32x2*)(o1 + 8 * g) = z; }
}
DI void hgrn_scan(bf16_t* dsT, const float* dec, int vb, int G) {
    for (int idx = vb * NTHR + threadIdx.x; idx < 64 * 128 * 16; idx += G * NTHR) {
        const int dk8 = idx & 15, dv = (idx >> 4) & 127, bh = idx >> 11;
        float S[8];
#pragma unroll
        for (int q = 0; q < 8; ++q) S[q] = 0.f;
        for (int c0 = 0; c0 < 64; c0 += 8) {
            u32x4 ld[8]; f32x4 d0[8], d1[8];
#pragma unroll
            for (int i = 0; i < 8; ++i) { const int c = c0 + i; ld[i] = *(const u32x4*)(dsT + (size_t)((bh * 64 + c) * 128 + dv) * 128 + dk8 * 8);
                const float* dp = dec + (size_t)(bh * 64 + c) * 128 + dk8 * 8; d0[i] = *(const f32x4*)dp; d1[i] = *(const f32x4*)(dp + 4); }
#pragma unroll
            for (int i = 0; i < 8; ++i) { const int c = c0 + i;
                u32x4 w; w.x = pk_bf16(S[0], S[1]); w.y = pk_bf16(S[2], S[3]); w.z = pk_bf16(S[4], S[5]); w.w = pk_bf16(S[6], S[7]);
                *(u32x4*)(dsT + (size_t)((bh * 64 + c) * 128 + dv) * 128 + dk8 * 8) = w;
                S[0] = d0[i][0] * S[0] + bflo(ld[i].x); S[1] = d0[i][1] * S[1] + bfhi(ld[i].x); S[2] = d0[i][2] * S[2] + bflo(ld[i].y); S[3] = d0[i][3] * S[3] + bfhi(ld[i].y);
                S[4] = d1[i][0] * S[4] + bflo(ld[i].z); S[5] = d1[i][1] * S[5] + bfhi(ld[i].z); S[6] = d1[i][2] * S[6] + bflo(ld[i].w); S[7] = d1[i][3] * S[7] + bfhi(ld[i].w); }
        }
    }
}
DI void hgrn_out_unit(const bf16_t* qd, const bf16_t* kinv, const bf16_t* vT, const bf16_t* spT, const bf16_t* gs, bf16_t* yh, LAS unsigned char* lds, int bh, int c) {
    const int tid = threadIdx.x, lane = tid & 63, wave = tid >> 6, r = lane & 31, hh = lane >> 5, tb = wave >> 2, db = wave & 3, b = bh >> 2, h = bh & 3;
    const size_t Tb = (size_t)b * SEQ + c * 64;
    bf16x8 qf[8];
    { const bf16_t* qrow = qd + (Tb + 32 * tb + r) * 512 + h * 128 + 8 * hh;
#pragma unroll
      for (int ks = 0; ks < 8; ++ks) qf[ks] = *(const bf16x8*)(qrow + 16 * ks); }
    f32x16 Z;
#pragma unroll
    for (int q = 0; q < 16; ++q) Z[q] = 0.f;
    { const bf16_t* sp = spT + (size_t)((bh * 64 + c) * 128 + 32 * db + r) * 128 + 8 * hh;
#pragma unroll
      for (int ks = 0; ks < 8; ++ks) { const bf16x8 bs = *(const bf16x8*)(sp + 16 * ks); Z = MFMA32(qf[ks], bs, Z); } }
    const bf16_t* vrow = vT + (size_t)(bh * 128 + 32 * db + r) * SEQ + c * 64 + 4 * hh;
#pragma unroll
    for (int sb = 0; sb < 2; ++sb) if (sb <= tb) {
        f32x16 X;
#pragma unroll
        for (int q = 0; q < 16; ++q) X[q] = 0.f;
        const bf16_t* krow = kinv + (Tb + 32 * sb + r) * 512 + h * 128 + 8 * hh;
#pragma unroll
        for (int ks = 0; ks < 8; ++ks) { const bf16x8 ak = *(const bf16x8*)(krow + 16 * ks); X = MFMA32(ak, qf[ks], X); }
        if (sb == tb) {
#pragma unroll
            for (int q = 0; q < 16; ++q) if (crow(q, hh) > r) X[q] = 0.f;
        }
#pragma unroll
        for (int s2 = 0; s2 < 2; ++s2) {
            u32x4 pa_; pa_.x = pk_bf16(X[8 * s2], X[8 * s2 + 1]); pa_.y = pk_bf16(X[8 * s2 + 2], X[8 * s2 + 3]); pa_.z = pk_bf16(X[8 * s2 + 4], X[8 * s2 + 5]); pa_.w = pk_bf16(X[8 * s2 + 6], X[8 * s2 + 7]);
            const u32x2 v0 = *(const u32x2*)(vrow + 32 * sb + 16 * s2), v1 = *(const u32x2*)(vrow + 32 * sb + 16 * s2 + 8);
            u32x4 pb_; pb_.x = v0.x; pb_.y = v0.y; pb_.z = v1.x; pb_.w = v1.y;
            Z = MFMA32(__builtin_bit_cast(bf16x8, pa_), __builtin_bit_cast(bf16x8, pb_), Z);
        }
    }
    LAS float* zs = (LAS float*)lds;
#pragma unroll
    for (int q = 0; q < 16; ++q) zs[(32 * tb + crow(q, hh)) * 132 + 32 * db + r] = Z[q];
    __syncthreads();
    { const int tok = tid >> 3, d16 = (tid & 7) * 16; f32x4 o[4]; float ss = 0.f;
#pragma unroll
      for (int i = 0; i < 4; ++i) { o[i] = *(const LAS f32x4*)(zs + tok * 132 + d16 + 4 * i); ss += (o[i][0] * o[i][0] + o[i][1] * o[i][1]) + (o[i][2] * o[i][2] + o[i][3] * o[i][3]); }
      ss += __shfl_xor(ss, 1); ss += __shfl_xor(ss, 2); ss += __shfl_xor(ss, 4);
      const float rn = __builtin_amdgcn_rsqf(ss * (1.f / 128.f) + EPS);
      const size_t off = (Tb + tok) * 512 + h * 128 + d16; const u32x4 g0 = *(const u32x4*)(gs + off), g1 = *(const u32x4*)(gs + off + 8);
      u32x4 w0, w1;
      w0.x = pk_bf16(o[0][0] * rn * bflo(g0.x), o[0][1] * rn * bfhi(g0.x)); w0.y = pk_bf16(o[0][2] * rn * bflo(g0.y), o[0][3] * rn * bfhi(g0.y));
      w0.z = pk_bf16(o[1][0] * rn * bflo(g0.z), o[1][1] * rn * bfhi(g0.z)); w0.w = pk_bf16(o[1][2] * rn * bflo(g0.w), o[1][3] * rn * bfhi(g0.w));
      w1.x = pk_bf16(o[2][0] * rn * bflo(g1.x), o[2][1] * rn * bfhi(g1.x)); w1.y = pk_bf16(o[2][2] * rn * bflo(g1.y), o[2][3] * rn * bfhi(g1.y));
      w1.z = pk_bf16(o[3][0] * rn * bflo(g1.z), o[3][1] * rn * bfhi(g1.z)); w1.w = pk_bf16(o[3][2] * rn * bflo(g1.w), o[3][3] * rn * bfhi(g1.w));
      *(u32x4*)(yh + off) = w0; *(u32x4*)(yh + off + 8) = w1; }
    __syncthreads();
}

DI unsigned f2ord(float f) { const unsigned b = __float_as_uint(f); return b ^ ((unsigned)((int)b >> 31) | 0x80000000u); }
DI float ord2f(unsigned k) { const unsigned b = (k & 0x80000000u) ? (k ^ 0x80000000u) : ~k; return __uint_as_float(b); }
#define TK_INS(L, x) do { unsigned t_ = (x); _Pragma("unroll") for (int j_ = 0; j_ < 16; ++j_) { const unsigned hi_ = L[j_] > t_ ? L[j_] : t_; t_ = L[j_] > t_ ? t_ : L[j_]; L[j_] = hi_; } } while (0)

DI void topk_unit(const bf16_t* qp, const bf16_t* keysb, unsigned short* gidx, float* ggate, LAS unsigned char* lds, int tile, int h) {
    const int tid = threadIdx.x, lane = tid & 63, wave = tid >> 6, p = wave & 1, tsub = wave >> 1, r = lane & 31, hh = lane >> 5;
    const int tok0 = tile * 128 + tsub * 32;
    f32x16 acc[4];
#pragma unroll
    for (int kb = 0; kb < 4; ++kb)
#pragma unroll
        for (int i = 0; i < 16; ++i) acc[kb][i] = 0.f;
    const bf16_t* qrow = qp + (size_t)(tok0 + r) * 2048 + h * 256 + p * 128 + 8 * hh;
    const bf16_t* kbase = keysb + ((size_t)(p * 8 + h) * 128 + r) * 128 + 8 * hh;
#pragma unroll
    for (int s = 0; s < 8; ++s) { const bf16x8 bq = *(const bf16x8*)(qrow + 16 * s);
#pragma unroll
        for (int kb = 0; kb < 4; ++kb) { const bf16x8 ak = *(const bf16x8*)(kbase + (size_t)kb * 32 * 128 + 16 * s); acc[kb] = MFMA32(ak, bq, acc[kb]); } }
    unsigned L[16];
#pragma unroll
    for (int j = 0; j < 16; ++j) L[j] = 0u;
#pragma unroll
    for (int kb = 0; kb < 4; ++kb)
#pragma unroll
        for (int i = 0; i < 16; ++i) { const unsigned key = (f2ord(acc[kb][i]) & ~127u) | (unsigned)(32 * kb + (i & 3) + 8 * (i >> 2) + 4 * hh); TK_INS(L, key); }
    { unsigned P[16];
#pragma unroll
      for (int j = 0; j < 16; ++j) P[j] = __shfl_xor(L[j], 32);
#pragma unroll
      for (int j = 0; j < 16; ++j) TK_INS(L, P[j]); }
    LAS unsigned* tk = (LAS unsigned*)lds;
    if (hh == 0) { LAS u32x4* dst = (LAS u32x4*)(tk + ((p * 128 + tsub * 32 + r) * 16));
#pragma unroll
        for (int c = 0; c < 4; ++c) { u32x4 w = {L[4 * c], L[4 * c + 1], L[4 * c + 2], L[4 * c + 3]}; dst[c] = w; } }
    __syncthreads();
    if (tid < 128) {
        unsigned L1[16], L2[16];
        { const LAS u32x4* s1 = (const LAS u32x4*)(tk + tid * 16); const LAS u32x4* s2 = (const LAS u32x4*)(tk + (128 + tid) * 16);
#pragma unroll
          for (int c = 0; c < 4; ++c) { const u32x4 a = s1[c], b = s2[c]; L1[4 * c] = a.x; L1[4 * c + 1] = a.y; L1[4 * c + 2] = a.z; L1[4 * c + 3] = a.w; L2[4 * c] = b.x; L2[4 * c + 1] = b.y; L2[4 * c + 2] = b.z; L2[4 * c + 3] = b.w; } }
        float v1[16], v2[16];
#pragma unroll
        for (int j = 0; j < 16; ++j) { v1[j] = ord2f(L1[j] & ~127u); v2[j] = ord2f(L2[j] & ~127u); }
        unsigned C[16];
#pragma unroll
        for (int j = 0; j < 16; ++j) C[j] = 0u;
#pragma unroll
        for (int i = 0; i < 16; ++i)
#pragma unroll
            for (int j = 0; j < 16; ++j) if ((i + 1) * (j + 1) <= 16) { const unsigned key = (f2ord(v1[i] + v2[j]) & ~255u) | (unsigned)(i * 16 + j); TK_INS(C, key); }
        float sc[16]; unsigned ei[16]; float mx = -1e30f;
#pragma unroll
        for (int q = 0; q < 16; ++q) { const unsigned ij = C[q] & 255u; const unsigned a = tk[tid * 16 + (ij >> 4)], b = tk[(128 + tid) * 16 + (ij & 15u)];
            sc[q] = ord2f(a & ~127u) + ord2f(b & ~127u); ei[q] = (a & 127u) * 128u + (b & 127u); mx = fmaxf(mx, sc[q]); }
        float sum = 0.f;
#pragma unroll
        for (int q = 0; q < 16; ++q) { sc[q] = __expf(sc[q] - mx); sum += sc[q]; }
        const float inv = 1.f / sum; const size_t o = (size_t)(tile * 128 + tid) * 128 + h * 16;
#pragma unroll
        for (int q = 0; q < 16; ++q) { gidx[o + q] = (unsigned short)ei[q]; ggate[o + q] = sc[q] * inv; }
    }
    __syncthreads();
}

DI float gelu_erf(float x) { return 0.5f * x * (1.f + erff(x * 0.70710678118654752f)); }
DI int dot16(u32x4 w, const int (&h)[4]) { int c = __builtin_amdgcn_sdot4((int)w.x, h[0], 0, false); c = __builtin_amdgcn_sdot4((int)w.y, h[1], c, false); c = __builtin_amdgcn_sdot4((int)w.z, h[2], c, false); return __builtin_amdgcn_sdot4((int)w.w, h[3], c, false); }
#define V8_FMA(acc4, word, we) do { acc4[0] += (we) * (float)((word) & 255u); acc4[1] += (we) * (float)(((word) >> 8) & 255u); acc4[2] += (we) * (float)(((word) >> 16) & 255u); acc4[3] += (we) * (float)((word) >> 24); } while (0)

DI void expert_token(const float* x2row, const float* ssq, const unsigned char* u8, const unsigned char* v8, const float* su, const float* sv, const unsigned short* gidx, const float* ggate, const float* gf, float* outrow, int lane) {
    f32x4 x[4]; float amax = 0.f;
#pragma unroll
    for (int i = 0; i < 4; ++i) { x[i] = *(const f32x4*)(x2row + 16 * lane + 4 * i); amax = fmaxf(fmaxf(amax, fmaxf(fabsf(x[i][0]), fabsf(x[i][1]))), fmaxf(fabsf(x[i][2]), fabsf(x[i][3]))); }
    float ss = (lane < 16) ? ssq[lane] : 0.f; ss = wave_sum(ss);
    const float rstd2 = __builtin_amdgcn_rsqf(ss * (1.f / 1024.f) + EPS);
#pragma unroll
    for (int o = 1; o < 64; o <<= 1) amax = fmaxf(amax, __shfl_xor(amax, o));
    amax *= rstd2;
    const float qs = amax > 0.f ? 127.f / amax : 0.f, sh = amax * (1.f / 127.f), xq = rstd2 * qs;
    int hq[4];
#pragma unroll
    for (int i = 0; i < 4; ++i) { const int q0 = (int)rintf(x[i][0] * xq), q1 = (int)rintf(x[i][1] * xq), q2 = (int)rintf(x[i][2] * xq), q3 = (int)rintf(x[i][3] * xq);
        hq[i] = (int)((unsigned)(q0 & 255) | ((unsigned)(q1 & 255) << 8) | ((unsigned)(q2 & 255) << 16) | ((unsigned)(q3 & 255) << 24)); }
    const int id0 = gidx[lane], id1 = gidx[64 + lane]; const float g0 = ggate[lane], g1 = ggate[64 + lane];
    f32x4 o[4]; float wsum = 0.f;
#pragma unroll
    for (int i = 0; i < 4; ++i) o[i] = (f32x4){0.f, 0.f, 0.f, 0.f};
#pragma unroll 1
    for (int bt = 0; bt < 16; ++bt) {
        const int idsel = (bt < 8) ? id0 : id1; const float gsel = (bt < 8) ? g0 : g1; const int lb = (bt & 7) * 8;
        u32x4 ur[8], vr[8];
#pragma unroll
        for (int e = 0; e < 8; ++e) { const int idx = __builtin_amdgcn_readlane(idsel, lb + e); ur[e] = *(const u32x4*)(u8 + (size_t)idx * 1024 + 16 * lane); }
#pragma unroll
        for (int e = 0; e < 8; ++e) { const int idx = __builtin_amdgcn_readlane(idsel, lb + e); vr[e] = *(const u32x4*)(v8 + (size_t)idx * 1024 + 16 * lane); }
        const int myidx = __shfl(idsel, lb + (lane >> 3)); const float mysu = su[myidx], mysv = sv[myidx], gate = __shfl(gsel, lb + (lane >> 3));
        int pr[8];
#pragma unroll
        for (int e = 0; e < 8; ++e) pr[e] = dot16(ur[e], hq);
        int q4[4], q2[2], q1;
        { const bool up_ = (lane & 32) != 0;
#pragma unroll
          for (int i = 0; i < 4; ++i) { const int keep = up_ ? pr[i + 4] : pr[i], send = up_ ? pr[i] : pr[i + 4]; q4[i] = keep + __shfl_xor(send, 32); } }
        { const bool up_ = (lane & 16) != 0;
#pragma unroll
          for (int i = 0; i < 2; ++i) { const int keep = up_ ? q4[i + 2] : q4[i], send = up_ ? q4[i] : q4[i + 2]; q2[i] = keep + __shfl_xor(send, 16); } }
        { const bool up_ = (lane & 8) != 0; const int keep = up_ ? q2[1] : q2[0], send = up_ ? q2[0] : q2[1]; q1 = keep + __shfl_xor(send, 8); }
        q1 += __shfl_xor(q1, 4); q1 += __shfl_xor(q1, 2); q1 += __shfl_xor(q1, 1);
        const float act = (float)q1 * (mysu * sh);
        const float w = gelu_erf(act) * gate * mysv;
#pragma unroll
        for (int e = 0; e < 8; ++e) { const float we = __int_as_float(__builtin_amdgcn_readlane(__float_as_int(w), 8 * e)); wsum += we;
            V8_FMA(o[0], vr[e].x, we); V8_FMA(o[1], vr[e].y, we); V8_FMA(o[2], vr[e].z, we); V8_FMA(o[3], vr[e].w, we); }
    }
    const float corr = 128.f * wsum; float s3 = 0.f;
#pragma unroll
    for (int i = 0; i < 4; ++i) { x[i] += o[i] - corr; s3 += (x[i][0] * x[i][0] + x[i][1] * x[i][1]) + (x[i][2] * x[i][2] + x[i][3] * x[i][3]); }
    s3 = wave_sum(s3); const float r3 = __builtin_amdgcn_rsqf(s3 * (1.f / 1024.f) + EPS);
#pragma unroll
    for (int i = 0; i < 4; ++i) *(f32x4*)(outrow + 16 * lane + 4 * i) = x[i] * r3 * *(const f32x4*)(gf + 16 * lane + 4 * i);
}

#define XB_TMO      128
#define XB_XCNT(j)  (256  + 64 * (j))
#define XB_XSUB(j)  (1280 + 64 * (j))
#define XB_XGEN(j)  (2304 + 64 * (j))
#define XB_TOP      3328
#define XB_TOPGEN   3392
#define XCD_BAR_WORDS 3456
#define XB_SPIN_CAP (1u << 18)

__device__ __forceinline__ unsigned xb_ld(unsigned* p)              { return __hip_atomic_load(p, __ATOMIC_RELAXED, __HIP_MEMORY_SCOPE_AGENT); }
__device__ __forceinline__ unsigned xb_add(unsigned* p, unsigned v) { return __hip_atomic_fetch_add(p, v, __ATOMIC_RELAXED, __HIP_MEMORY_SCOPE_AGENT); }
__device__ __forceinline__ unsigned xb_xcc_id() { return (unsigned)__builtin_amdgcn_s_getreg((3 << 11) | 20) & 0xFu; }
#define XB_SPIN(cond, bar) do { unsigned _sp = 0; while (cond) { __builtin_amdgcn_s_sleep(1); \
    if ((++_sp & 255u) == 0u) { if (xb_ld(&(bar)[XB_TMO])) break; if (_sp > XB_SPIN_CAP) { atomicAdd(&(bar)[XB_TMO], 1u); break; } } } } while (0)

struct XcdBarrier {
    unsigned* bar; unsigned x;
    volatile __attribute__((address_space(3))) unsigned* st;
};

__device__ __forceinline__ XcdBarrier xcd_barrier_post(unsigned* bar, volatile __attribute__((address_space(3))) unsigned* st) {
    XcdBarrier b; b.bar = bar; b.x = xb_xcc_id(); b.st = st;
    if (threadIdx.x == 0) (void)xb_add(&bar[XB_XCNT(b.x)], 1u);
    return b;
}
__device__ __forceinline__ void xcd_barrier_complete(unsigned* bar, unsigned x, unsigned& nloc, unsigned& nx) {
    const unsigned G = gridDim.x * gridDim.y * gridDim.z;
    unsigned sum, cnt, mine, sp = 0u;
    for (;;) {
        sum = 0u; cnt = 0u; mine = 0u;
#pragma unroll
        for (unsigned j = 0; j < 16; ++j) { const unsigned c = xb_ld(&bar[XB_XCNT(j)]); sum += c; cnt += (c > 0u) ? 1u : 0u; mine = (j == x) ? c : mine; }
        if (sum == G) break;
        __builtin_amdgcn_s_sleep(1);
        if ((++sp & 255u) == 0u) { if (xb_ld(&bar[XB_TMO])) break; if (sp > XB_SPIN_CAP) { atomicAdd(&bar[XB_TMO], 1u); break; } }
    }
    nloc = mine > 0u ? mine : 1u; nx = cnt > 0u ? cnt : 1u;
}

__device__ __forceinline__ void xcd_barrier(const XcdBarrier& b) {
    asm volatile("s_waitcnt vmcnt(0)" ::: "memory");
    __syncthreads();
    if (threadIdx.x == 0) {
        unsigned* bar = b.bar;
        __builtin_amdgcn_s_waitcnt(0);
        unsigned nloc = b.st[0], nx = b.st[1];
        if (nloc == 0u) { xcd_barrier_complete(bar, b.x, nloc, nx); b.st[0] = nloc; b.st[1] = nx; }
        const unsigned old = xb_add(&bar[XB_XSUB(b.x)], 1u);
        const unsigned gen = old / nloc;
        if (old + 1u == (gen + 1u) * nloc) {
            __builtin_amdgcn_fence(__ATOMIC_RELEASE, "agent");
            asm volatile("s_waitcnt vmcnt(0)" ::: "memory");
            const unsigned og = xb_add(&bar[XB_TOP], 1u);
            const unsigned tg = og / nx;
            if (og + 1u == (tg + 1u) * nx) xb_add(&bar[XB_TOPGEN], 1u);
            else XB_SPIN(xb_ld(&bar[XB_TOPGEN]) == tg, bar);
            __builtin_amdgcn_fence(__ATOMIC_ACQUIRE, "agent");
            xb_add(&bar[XB_XGEN(b.x)], 1u);
            asm volatile("s_waitcnt vmcnt(0)" ::: "memory");
        } else {
            XB_SPIN(xb_ld(&bar[XB_XGEN(b.x)]) == gen, bar);
            __builtin_amdgcn_fence(__ATOMIC_ACQUIRE, "agent");
            asm volatile("s_waitcnt vmcnt(0)" ::: "memory");
        }
    }
    __syncthreads();
}

constexpr int N_PHASES = 10;
__global__ void __launch_bounds__(NTHR, 2) mk_fwd(Args a) {
    extern __shared__ __attribute__((aligned(16))) unsigned char lds_raw[];
    LAS unsigned char* lds = (LAS unsigned char*)lds_raw;
    cg::grid_group grid = cg::this_grid();
    const int G = gridDim.x, vb = blockIdx.x, tid = threadIdx.x, lane = tid & 63, wave = tid >> 6;
    unsigned char* ws = a.ws;
    const int lo = a.ph_lo, hi = a.ph_hi;
    volatile LAS unsigned* MISC = (volatile LAS unsigned*)(lds + LDS_BYTES - 64);
    if (tid < 16) MISC[tid] = 0u;
    __syncthreads();
    const XcdBarrier bar = xcd_barrier_post((unsigned*)(ws + 4096) + lo * XCD_BAR_WORDS, MISC);
#ifndef PHASE_MASK
#define PHASE_MASK 0xFFFF
#endif
#define IN(k) (((PHASE_MASK >> (k)) & 1) && lo <= (k) && (k) < hi)
#ifndef REPEAT_MASK
#define REPEAT_MASK 0
#endif
#define REP(k) for (int rep_ = 0; rep_ < (((REPEAT_MASK) >> (k)) & 1) + 1; ++rep_)
#define SEAM(k) do { if (IN(k) && IN((k) + 1)) { if ((k) == 0) grid.sync(); else xcd_barrier(bar); } } while (0)
    REP(0) if (IN(0)) p0_prologue(a, lds, vb, G);
    SEAM(0);
    REP(1) if (IN(1)) { pg8::Gemm g{(const bf16_t*)(ws + WS_XB), (const bf16_t*)(ws + WS_W1T), T, NIN, 1024}; pg8::StaticOrder S; S.init(T, NIN, G, vb);
        pg8::Epi1 E{(const float*)(ws + WS_RSTD1), (bf16_t*)(ws + WS_PA), (bf16_t*)(ws + WS_GG), (bf16_t*)(ws + WS_QD), (bf16_t*)(ws + WS_KINV), (bf16_t*)(ws + WS_KENDT), (bf16_t*)(ws + WS_VT), (bf16_t*)(ws + WS_GS),
                    (float*)(ws + WS_DEC), (const float*)(ws + WS_LB)};
        pg8::gemm_phase<pg8::Epi1, pg8::StaticOrder, true, true>(lds, g, S, E); }
    SEAM(1);
    REP(2) if (IN(2)) {
        for (int u = vb; u < 64 * 64; u += G) hgrn_ds_unit((const bf16_t*)(ws + WS_KENDT), (const bf16_t*)(ws + WS_VT), (bf16_t*)(ws + WS_XB), u >> 6, u & 63);
        for (int u = vb; u < BATCH * (SEQ / 64); u += G) attn_unit((const bf16_t*)(ws + WS_PA), a.in[3], (bf16_t*)(ws + WS_YA), lds, u / (SEQ / 64), u % (SEQ / 64));
    }
    SEAM(2);
    REP(3) if (IN(3)) hgrn_scan((bf16_t*)(ws + WS_XB), (const float*)(ws + WS_DEC), vb, G);
    SEAM(3);
    REP(4) if (IN(4)) for (int u = vb; u < 64 * 64; u += G)
        hgrn_out_unit((const bf16_t*)(ws + WS_QD), (const bf16_t*)(ws + WS_KINV), (const bf16_t*)(ws + WS_VT), (const bf16_t*)(ws + WS_XB), (const bf16_t*)(ws + WS_GS), (bf16_t*)(ws + WS_YH), lds, u >> 6, u & 63);
    SEAM(4);
    REP(5) if (IN(5)) {
        { pg8::Gemm g{(const bf16_t*)(ws + WS_YA), (const bf16_t*)(ws + WS_WAPT), T, 1024, 512}; pg8::StaticOrder S; S.init(T, 1024, G, vb);
          pg8::EpiMerge<false> E{(bf16_t*)(ws + WS_XB), (const bf16_t*)(ws + WS_GG)};
          pg8::gemm_phase<pg8::EpiMerge<false>, pg8::StaticOrder, true, true>(lds, g, S, E); }
        __syncthreads();
        { pg8::Gemm g{(const bf16_t*)(ws + WS_YH), (const bf16_t*)(ws + WS_WHPT), T, 1024, 512}; pg8::StaticOrder S; S.init(T, 1024, G, vb);
          pg8::EpiMerge<true> E{(bf16_t*)(ws + WS_XB), (const bf16_t*)(ws + WS_GG) + 1024};
          pg8::gemm_phase<pg8::EpiMerge<true>, pg8::StaticOrder, true, true>(lds, g, S, E); }
    }
    SEAM(5);
    REP(6) if (IN(6)) { pg8::Gemm g{(const bf16_t*)(ws + WS_XB), (const bf16_t*)(ws + WS_WOUTT), T, 1024, 1024}; pg8::StaticOrder S; S.init(T, 1024, G, vb);
        pg8::EpiX2 E{a.in[0], a.out, (bf16_t*)(ws + WS_X2B), (float*)(ws + WS_SSQ2)};
        pg8::gemm_phase<pg8::EpiX2, pg8::StaticOrder, true, true>(lds, g, S, E); }
    SEAM(6);
    REP(7) if (IN(7)) { pg8::Gemm g{(const bf16_t*)(ws + WS_X2B), (const bf16_t*)(ws + WS_WQT), T, 2048, 1024}; pg8::StaticOrder S; S.init(T, 2048, G, vb);
        pg8::EpiQp E{(bf16_t*)(ws + WS_QP), (const float*)(ws + WS_SSQ2)};
        pg8::gemm_phase<pg8::EpiQp, pg8::StaticOrder, true, true>(lds, g, S, E); }
    SEAM(7);
    REP(8) if (IN(8)) for (int u = vb; u < (T / 128) * 8; u += G) topk_unit((const bf16_t*)(ws + WS_QP), (const bf16_t*)(ws + WS_KEYS), (unsigned short*)(ws + WS_GIDX), (float*)(ws + WS_GGATE), lds, u >> 3, u & 7);
    SEAM(8);
    REP(9) if (IN(9)) for (int tok = vb * 8 + wave; tok < T; tok += G * 8)
        expert_token(a.out + (size_t)tok * DM, (const float*)(ws + WS_SSQ2) + (size_t)tok * 16, (const unsigned char*)(ws + WS_U8), (const unsigned char*)(ws + WS_V8), (const float*)(ws + WS_SU), (const float*)(ws + WS_SV),
                     (const unsigned short*)(ws + WS_GIDX) + (size_t)tok * 128, (const float*)(ws + WS_GGATE) + (size_t)tok * 128, a.in[14], a.out + (size_t)tok * DM, lane);
#undef IN
#undef SEAM
}

extern "C" void kernel_launch(void* const* d_in, const int* in_sizes, int n_in, void* d_out, int out_size, void* d_ws, size_t ws_size, hipStream_t stream) {
    static int grid = 0;
    if (grid == 0) {
        if (n_in != 15 || in_sizes[0] != T * DM || out_size != T * DM || ws_size < WS_END) { fprintf(stderr, "kernel_launch: unexpected shapes (n_in %d, in0 %d, out %d, ws %zu)\n", n_in, n_in > 0 ? in_sizes[0] : -1, out_size, ws_size); grid = -1; return; }
        int dev = 0, cus = 0, per_cu = 0;
        hipGetDevice(&dev); hipDeviceGetAttribute(&cus, hipDeviceAttributeMultiprocessorCount, dev);
        if (hipFuncSetAttribute((const void*)mk_fwd, hipFuncAttributeMaxDynamicSharedMemorySize, LDS_BYTES) != hipSuccess) { fprintf(stderr, "kernel_launch: hipFuncSetAttribute failed\n"); grid = -1; return; }
        if (hipOccupancyMaxActiveBlocksPerMultiprocessor(&per_cu, (const void*)mk_fwd, NTHR, LDS_BYTES) != hipSuccess || per_cu < 1) { fprintf(stderr, "kernel_launch: occupancy query says %d blocks per CU\n", per_cu); per_cu = 1; }
        (void)hipGetLastError();
        grid = cus;
    }
    if (grid < 0) return;
    if (hipMemsetAsync(d_ws, 0, 256 * 1024, stream) != hipSuccess) { fprintf(stderr, "kernel_launch: hipMemsetAsync failed\n"); return; }
    Args a{};
    for (int i = 0; i < 15; ++i) a.in[i] = (const float*)d_in[i];
    a.out = (float*)d_out; a.ws = (unsigned char*)d_ws;
#if MK_FUSED
    a.ph_lo = 0; a.ph_hi = N_PHASES;
    { void* args[] = {&a}; hipError_t e = hipLaunchCooperativeKernel((const void*)mk_fwd, dim3(grid), dim3(NTHR), args, LDS_BYTES, stream);
      if (e != hipSuccess) fprintf(stderr, "kernel_launch: cooperative launch failed: %s (grid %d)\n", hipGetErrorString(e), grid); }
#else
    for (int p = 0; p < N_PHASES; ++p) { a.ph_lo = p; a.ph_hi = p + 1; void* args[] = {&a};
        hipError_t e = hipLaunchCooperativeKernel((const void*)mk_fwd, dim3(grid), dim3(NTHR), args, LDS_BYTES, stream);
        if (e != hipSuccess) { fprintf(stderr, "kernel_launch: launch of phase %d failed: %s (grid %d)\n", p, hipGetErrorString(e), grid); break; } }
#endif
}
```

```cpp
#include <hip/hip_runtime.h>
#include <hip/hip_cooperative_groups.h>
#include <cstdio>
#include <cstdint>
namespace cg = cooperative_groups;
namespace pg8 {
#define PG8_LAS __attribute__((address_space(3)))
typedef unsigned short bf16_t;
typedef short bf16x8 __attribute__((ext_vector_type(8)));
typedef float f32x4 __attribute__((ext_vector_type(4)));
typedef unsigned u32x4 __attribute__((ext_vector_type(4)));
constexpr int BM = 256, BK = 64, HALF = 128, HTB = HALF * BK * 2  , STAGE_BYTES = 8 * HTB, NXCD = 8, WGM = 8;

__host__ __device__ __forceinline__ int lds_byte(int r, int c) { const int st = (r >> 4) * 2 + (c >> 5), rr = r & 15, cc = c & 31, ob = rr * 64 + cc * 2; return st * 1024 + (ob ^ (((ob >> 9) & 1) << 5)); }
__host__ __device__ __forceinline__ void stage_rc(int b, int& R, int& C) { const int st = b / 1024, sb = b % 1024, swz = sb ^ (((sb >> 9) & 1) << 5); R = (st >> 1) * 16 + swz / 64; C = (st & 1) * 32 + (swz % 64) / 2; }
__host__ __device__ __forceinline__ int perm32(int rho) { const int n = rho >> 4, i = rho & 15; return 8 * (i >> 2) + 4 * n + (i & 3); }

struct Unit { int pm, pn; };
struct Gemm { const bf16_t* A; const bf16_t* Bt; int M, N, K; };

struct StaticOrder {
    int nM, nN, nwg, G, c;
    __host__ __device__ void init(int M, int N, int G_, int c_) { nM = M / BM; nN = N / BM; nwg = nM * nN; G = G_; c = c_; }
    __host__ __device__ bool next(int i, Unit& u) const {
        const long L = (long)i * G + c; if (L >= nwg) return false;
        int wgid = (int)L; { const int q = nwg / NXCD, r = nwg % NXCD, xcd = wgid % NXCD, off = wgid / NXCD; wgid = (xcd < r ? xcd * (q + 1) : r * (q + 1) + (xcd - r) * q) + off; }
        const int nig = WGM * nN, gid = wgid / nig, fm = gid * WGM, gsz = (nM - fm) < WGM ? (nM - fm) : WGM;
        u.pm = fm + ((wgid % nig) % gsz); u.pn = (wgid % nig) / gsz; return true;
    }
    __device__ __forceinline__ void a_ready(const Unit&) const {}
    __device__ __forceinline__ void done(const Unit&) const {}
};

__device__ __forceinline__ unsigned cvt_pk_bf16(float lo, float hi) { unsigned r; asm volatile("v_cvt_pk_bf16_f32 %0, %1, %2" : "=v"(r) : "v"(lo), "v"(hi)); return r; }

template <class Epi, class Sched, bool ALIGN_EPI = false, bool SP2 = false>
__device__ __forceinline__ void gemm_phase(PG8_LAS unsigned char* lds, const Gemm g, const Sched& S, const Epi& E) {
    int tid_ = threadIdx.x; asm volatile("" : "+v"(tid_));
    const int tid = tid_, wid = __builtin_amdgcn_readfirstlane(tid >> 6), lane = tid & 63, wr = wid >> 2, wc = wid & 3, fr = lane & 15, fq = lane >> 4;
    const int K = g.K, nt = K / BK;
    unsigned voffA[2], voffB[2];
#pragma unroll
    for (int i = 0; i < 2; ++i) { int R, C; stage_rc(tid * 16 + i * 8192, R, C); const int Rb = Epi::PERM ? ((R & ~31) + perm32(R & 31)) : R;
        voffA[i] = (unsigned)(R * K + C) * 2u; voffB[i] = (unsigned)(Rb * K + C) * 2u; }
    const size_t kstep = (size_t)(BK * 2);
    const size_t hstep = (size_t)HALF * K * 2;
    const size_t tstep = 2 * hstep;
    const unsigned ldsw = (unsigned)wid * 1024u;
    const int aoff = lds_byte(wr * 64 + fr, fq * 8), boff = lds_byte(wc * 32 + fr, fq * 8);
#define PG8_SA(b, h) (((b) * 2 + (h)) * HTB)
#define PG8_SB(b, h) ((4 + (b) * 2 + (h)) * HTB)
#define PG8_STAGE(bufoff, gbase, voff) do { _Pragma("unroll") for (int _i = 0; _i < 2; ++_i) \
        __builtin_amdgcn_global_load_lds((const unsigned*)((const char*)(gbase) + (voff)[_i]), (PG8_LAS unsigned*)(lds + (bufoff) + ldsw + _i * 8192), 16, 0, 0); } while (0)
#define PG8_LDA(dst, b, h) do { _Pragma("unroll") for (int m = 0; m < 4; ++m) _Pragma("unroll") for (int k = 0; k < 2; ++k) dst[m][k] = *(const PG8_LAS bf16x8*)(lds + PG8_SA(b, h) + aoff + m * 2048 + k * 1024); } while (0)
#define PG8_LDB(dst, b, h) do { _Pragma("unroll") for (int n = 0; n < 2; ++n) _Pragma("unroll") for (int k = 0; k < 2; ++k) dst[n][k] = *(const PG8_LAS bf16x8*)(lds + PG8_SB(b, h) + boff + n * 2048 + k * 1024); } while (0)
#define PG8_MMA(ai, bj, At, Bt) do { __builtin_amdgcn_s_setprio(1); _Pragma("unroll") for (int m = 0; m < 4; ++m) _Pragma("unroll") for (int n = 0; n < 2; ++n) _Pragma("unroll") for (int k = 0; k < 2; ++k) \
        acc[ai][bj][m][n] = __builtin_amdgcn_mfma_f32_16x16x32_bf16(Bt[n][k], At[m][k], acc[ai][bj][m][n], 0, 0, 0); __builtin_amdgcn_s_setprio(0); } while (0)
#define PG8_WAIT_V(n) asm volatile("s_waitcnt vmcnt(" #n ")" ::: "memory")
#define PG8_WAIT_L(n) asm volatile("s_waitcnt lgkmcnt(" #n ")" ::: "memory")
#define PG8_BAR __builtin_amdgcn_s_barrier()
#define PG8_SCHED __builtin_amdgcn_sched_barrier(0)
    Unit cur, nxt; int ui = 0;
    if (!S.next(0, cur)) return;
    f32x4 acc[2][2][4][2];
#pragma unroll
    for (int a = 0; a < 2; ++a)
#pragma unroll
        for (int b = 0; b < 2; ++b)
#pragma unroll
            for (int m = 0; m < 4; ++m)
#pragma unroll
                for (int n = 0; n < 2; ++n) acc[a][b][m][n] = (f32x4){0.f, 0.f, 0.f, 0.f};
    bf16x8 At[4][2], B0[2][2], B1[2][2];
    const char* cA = (const char*)g.A + (size_t)cur.pm * tstep; const char* cB = (const char*)g.Bt + (size_t)cur.pn * tstep;
    S.a_ready(cur);
    if constexpr (SP2) {
        PG8_STAGE(PG8_SB(0, 0), cB, voffB); PG8_STAGE(PG8_SB(0, 1), cB + hstep, voffB); PG8_STAGE(PG8_SA(0, 0), cA, voffA); PG8_STAGE(PG8_SA(0, 1), cA + hstep, voffA);
        if (wr == 1) PG8_BAR;
        PG8_WAIT_V(2); PG8_BAR;
        PG8_STAGE(PG8_SB(1, 0), cB + kstep, voffB); PG8_STAGE(PG8_SA(1, 0), cA + kstep, voffA); PG8_STAGE(PG8_SB(1, 1), cB + hstep + kstep, voffB);
        PG8_WAIT_V(6); PG8_BAR;
    } else {
        PG8_STAGE(PG8_SB(0, 0), cB, voffB); PG8_STAGE(PG8_SA(0, 0), cA, voffA); PG8_STAGE(PG8_SB(0, 1), cB + hstep, voffB); PG8_STAGE(PG8_SA(0, 1), cA + hstep, voffA);
        if (wr == 1) PG8_BAR;
        PG8_WAIT_V(4); PG8_BAR;
        PG8_STAGE(PG8_SB(1, 0), cB + kstep, voffB); PG8_STAGE(PG8_SA(1, 0), cA + kstep, voffA); PG8_STAGE(PG8_SB(1, 1), cB + hstep + kstep, voffB);
        PG8_WAIT_V(6); PG8_BAR;
    }
    for (;;) {
        const bool has_next = S.next(ui + 1, nxt);
        const char* nA = has_next ? (const char*)g.A + (size_t)nxt.pm * tstep : cA; const char* nB = has_next ? (const char*)g.Bt + (size_t)nxt.pn * tstep : cB;
        for (int t = 0; t < nt; t += 2) {
            const bool last = (t == nt - 2);
            const char* a1 = cA + (size_t)(t + 1) * kstep;
            const char* a2 = last ? nA : cA + (size_t)(t + 2) * kstep; const char* b2 = last ? nB : cB + (size_t)(t + 2) * kstep;
            const char* a3 = a2 + kstep; const char* b3 = b2 + kstep;
            if (last && has_next) S.a_ready(nxt);
            if constexpr (SP2) {
            PG8_LDB(B0, 0, 0); PG8_LDB(B1, 0, 1); PG8_SCHED; PG8_LDA(At, 0, 0); PG8_STAGE(PG8_SA(1, 1), a1 + hstep, voffA);
            PG8_WAIT_V(8); PG8_WAIT_L(0); PG8_BAR; PG8_MMA(0, 0, At, B0); PG8_MMA(0, 1, At, B1); PG8_BAR; PG8_SCHED;
            PG8_LDA(At, 0, 1); PG8_STAGE(PG8_SB(0, 0), b2, voffB); PG8_STAGE(PG8_SB(0, 1), b2 + hstep, voffB); PG8_STAGE(PG8_SA(0, 0), a2, voffA);
            PG8_WAIT_V(8); PG8_WAIT_L(0); PG8_BAR; PG8_MMA(1, 0, At, B0); PG8_MMA(1, 1, At, B1); PG8_BAR; PG8_SCHED;
            PG8_LDB(B0, 1, 0); PG8_LDB(B1, 1, 1); PG8_SCHED; PG8_LDA(At, 1, 0); PG8_STAGE(PG8_SA(0, 1), a2 + hstep, voffA);
            PG8_WAIT_V(8); PG8_WAIT_L(0); PG8_BAR; PG8_MMA(0, 0, At, B0); PG8_MMA(0, 1, At, B1); PG8_BAR; PG8_SCHED;
            PG8_LDA(At, 1, 1); PG8_STAGE(PG8_SB(1, 0), b3, voffB); PG8_STAGE(PG8_SB(1, 1), b3 + hstep, voffB); PG8_STAGE(PG8_SA(1, 0), a3, voffA);
            PG8_WAIT_V(8); PG8_WAIT_L(0); PG8_BAR; PG8_MMA(1, 0, At, B0); PG8_MMA(1, 1, At, B1); PG8_BAR; PG8_SCHED;
            } else {
            PG8_LDB(B0, 0, 0); PG8_SCHED; PG8_LDA(At, 0, 0); PG8_STAGE(PG8_SA(1, 1), a1 + hstep, voffA);
            PG8_WAIT_L(8); PG8_BAR; PG8_WAIT_L(0); PG8_MMA(0, 0, At, B0); PG8_BAR; PG8_SCHED;
            PG8_LDB(B1, 0, 1); PG8_STAGE(PG8_SB(0, 0), b2, voffB);
            PG8_BAR; PG8_WAIT_L(0); PG8_MMA(0, 1, At, B1); PG8_BAR;
            PG8_LDA(At, 0, 1); PG8_STAGE(PG8_SA(0, 0), a2, voffA);
            PG8_BAR; PG8_WAIT_L(0); PG8_MMA(1, 0, At, B0); PG8_BAR; PG8_SCHED;
            PG8_STAGE(PG8_SB(0, 1), b2 + hstep, voffB);
            PG8_WAIT_V(6); PG8_BAR; PG8_MMA(1, 1, At, B1); PG8_BAR;
            PG8_LDB(B0, 1, 0); PG8_SCHED; PG8_LDA(At, 1, 0); PG8_STAGE(PG8_SA(0, 1), a2 + hstep, voffA);
            PG8_WAIT_L(8); PG8_BAR; PG8_WAIT_L(0); PG8_MMA(0, 0, At, B0); PG8_BAR; PG8_SCHED;
            PG8_LDB(B1, 1, 1); PG8_STAGE(PG8_SB(1, 0), b3, voffB);
            PG8_BAR; PG8_WAIT_L(0); PG8_MMA(0, 1, At, B1); PG8_BAR;
            PG8_LDA(At, 1, 1); PG8_STAGE(PG8_SA(1, 0), a3, voffA);
            PG8_BAR; PG8_WAIT_L(0); PG8_MMA(1, 0, At, B0); PG8_BAR; PG8_SCHED;
            PG8_STAGE(PG8_SB(1, 1), b3 + hstep, voffB);
            PG8_WAIT_V(6); PG8_BAR; PG8_MMA(1, 1, At, B1); PG8_BAR;
            }
        }
        if constexpr (ALIGN_EPI) { if (wr == 0) PG8_BAR; }
        if constexpr (!Epi::AFTER_DRAIN) { E(acc, cur, wr, wc, fr, fq); S.done(cur); }
        if (!has_next) break;
#pragma unroll
        for (int a = 0; a < 2; ++a)
#pragma unroll
            for (int b = 0; b < 2; ++b)
#pragma unroll
                for (int m = 0; m < 4; ++m)
#pragma unroll
                    for (int n = 0; n < 2; ++n) acc[a][b][m][n] = (f32x4){0.f, 0.f, 0.f, 0.f};
        cur = nxt; cA = nA; cB = nB; ++ui;
        if constexpr (ALIGN_EPI) { if (wr == 1) PG8_BAR; }
    }
    PG8_WAIT_V(0);
    if constexpr (!ALIGN_EPI) { if (wr == 0) PG8_BAR; }
    PG8_BAR;
    if constexpr (Epi::AFTER_DRAIN) { E.fused(acc, cur, wr, wc, fr, fq, lds, wid, lane); S.done(cur); }
#undef PG8_SA
#undef PG8_SB
#undef PG8_STAGE
#undef PG8_LDA
#undef PG8_LDB
#undef PG8_MMA
#undef PG8_WAIT_V
#undef PG8_WAIT_L
#undef PG8_BAR
#undef PG8_SCHED
}
}

#ifndef MK_FUSED
#define MK_FUSED 1
#endif
#define DI __device__ __forceinline__
#define LAS __attribute__((address_space(3)))
typedef unsigned short bf16_t;
typedef float f32x4 __attribute__((ext_vector_type(4)));
typedef float f32x2 __attribute__((ext_vector_type(2)));
typedef float f32x16 __attribute__((ext_vector_type(16)));
typedef unsigned u32x4 __attribute__((ext_vector_type(4)));
typedef unsigned u32x2 __attribute__((ext_vector_type(2)));
typedef short bf16x8 __attribute__((ext_vector_type(8)));
typedef _Float16 h16x2 __attribute__((ext_vector_type(2)));
typedef _Float16 h16x8 __attribute__((ext_vector_type(8)));

constexpr int BATCH = 16, SEQ = 4096, T = BATCH * SEQ, DM = 1024, NIN = 4864;
constexpr int C_AQ = 0, C_AK = 512, C_AV = 640, C_HQ = 768, C_HF = 1280, C_HI = 1792, C_HG = 2304, C_GA = 2816, C_GH = 3840;
constexpr float EPS = 1e-6f;
constexpr int NTHR = 512;
constexpr int LDS_BYTES = 147456;

constexpr size_t MiB = 1u << 20;
constexpr size_t WS_W1T = 1 * MiB;
constexpr size_t WS_WAPT = 11 * MiB;
constexpr size_t WS_WHPT = 12 * MiB;
constexpr size_t WS_WOUTT = 13 * MiB;
constexpr size_t WS_WQT = 15 * MiB;
constexpr size_t WS_KEYS = 19 * MiB;
constexpr size_t WS_LB = 19 * MiB + 512 * 1024;
constexpr size_t WS_RSTD1 = 20 * MiB;
constexpr size_t WS_SSQ2 = 21 * MiB;
constexpr size_t WS_U8 = 26 * MiB;
constexpr size_t WS_V8 = 42 * MiB;
constexpr size_t WS_SU = 58 * MiB;
constexpr size_t WS_SV = 58 * MiB + 65536;
constexpr size_t WS_DEC = 60 * MiB;
constexpr size_t WS_AVT = 64 * MiB;
constexpr size_t WS_XB = 90 * MiB;
constexpr size_t WS_PA = 218 * MiB;
constexpr size_t WS_GG = 314 * MiB;
constexpr size_t WS_QD = 570 * MiB;
constexpr size_t WS_KINV = 634 * MiB;
constexpr size_t WS_KENDT = 698 * MiB;
constexpr size_t WS_VT = 762 * MiB;
constexpr size_t WS_GS = 826 * MiB;
constexpr size_t WS_YA = 890 * MiB;
constexpr size_t WS_YH = 954 * MiB;
constexpr size_t WS_END = 1018 * MiB;
constexpr size_t WS_X2B = 218 * MiB;
constexpr size_t WS_QP = 346 * MiB;
constexpr size_t WS_GIDX = 602 * MiB;
constexpr size_t WS_GGATE = 618 * MiB;

struct Args { const float* in[15]; float* out; unsigned char* ws; int ph_lo, ph_hi; };

DI unsigned pk_bf16(float lo, float hi) { typedef __bf16 b2 __attribute__((ext_vector_type(2))); f32x2 v = {lo, hi}; b2 b = __builtin_convertvector(v, b2); return __builtin_bit_cast(unsigned, b); }
DI float bflo(unsigned w) { return __uint_as_float(w << 16); }
DI float bfhi(unsigned w) { return __uint_as_float(w & 0xffff0000u); }
DI float sigm(float x) { return 1.f / (1.f + __expf(-x)); }
DI float wave_sum(float v) {
#pragma unroll
    for (int o = 1; o < 64; o <<= 1) v += __shfl_xor(v, o);
    return v;
}
DI unsigned short bf16_1(float x) { return (unsigned short)(pk_bf16(x, 0.f) & 0xffffu); }
template <int N> DI float dpp_row_shr(float v) { return __int_as_float(__builtin_amdgcn_update_dpp(0, __float_as_int(v), 0x110 + N, 0xf, 0xf, true)); }
DI float scan16(float v) { v += dpp_row_shr<1>(v); v += dpp_row_shr<2>(v); v += dpp_row_shr<4>(v); v += dpp_row_shr<8>(v); return v; }
DI int crow(int reg, int hh) { return (reg & 3) + 8 * (reg >> 2) + 4 * hh; }
#define MFMA32(a, b, c) __builtin_amdgcn_mfma_f32_32x32x16_bf16((a), (b), (c), 0, 0, 0)
#define LDS_WAIT() asm volatile("s_waitcnt lgkmcnt(0)" ::: "memory")

namespace pg8 {
struct Epi1 {
    static constexpr bool PERM = true, AFTER_DRAIN = false;
    const float* rs; bf16_t* pa; bf16_t* gg; bf16_t* qd; bf16_t* kinv; bf16_t* kendT; bf16_t* vT; bf16_t* gs; float* dec; const float* lb; bf16_t* avT;
    __device__ __forceinline__ void operator()(const f32x4 (&acc)[2][2][4][2], const Unit& u, int wr, int wc, int fr, int fq) const {
        asm volatile("" : "+v"(fr), "+v"(fq));
        const int row0 = u.pm * BM + wr * 64 + fr, pn = u.pn;
        if (pn == 2) {
            const int c8 = wc * 32 + 8 * fq, tseqb = (u.pm & 15) * 256 + wr * 64 + fr, bb = u.pm >> 4;
#pragma unroll
            for (int ai = 0; ai < 2; ++ai)
#pragma unroll
                for (int m = 0; m < 4; ++m) { const int row = row0 + ai * HALF + m * 16; const float s = rs[row];
                    const f32x4 v0 = acc[ai][0][m][0] * s, v1 = acc[ai][0][m][1] * s;
                    u32x4 w; w.x = pk_bf16(v0[0], v0[1]); w.y = pk_bf16(v0[2], v0[3]); w.z = pk_bf16(v1[0], v1[1]); w.w = pk_bf16(v1[2], v1[3]);
                    *(u32x4*)(pa + (size_t)row * 768 + 512 + c8) = w;
#pragma unroll
                    for (int n = 0; n < 2; ++n)
#pragma unroll
                        for (int e = 0; e < 4; ++e) { const int c = c8 + 4 * n + e; avT[(size_t)((bb * 2 + (c >> 6)) * 64 + (c & 63)) * SEQ + tseqb + ai * HALF + 16 * m] = bf16_1(acc[ai][1][m][n][e] * s); } }
            return;
        }
        if (pn < 3 || pn >= 11) {
            bf16_t* O; int ldc, colt;
            if (pn < 3) { O = pa; ldc = 768; colt = pn * 256; } else { O = gg; ldc = 2048; colt = (pn - 11) * 256; }
            const int col0 = colt + wc * 32 + 8 * fq;
#pragma unroll
            for (int ai = 0; ai < 2; ++ai)
#pragma unroll
                for (int m = 0; m < 4; ++m) { const int row = row0 + ai * HALF + m * 16; const float s = rs[row]; bf16_t* rowp = O + (size_t)row * ldc + col0;
#pragma unroll
                    for (int bj = 0; bj < 2; ++bj) { const f32x4 v0 = acc[ai][bj][m][0] * s, v1 = acc[ai][bj][m][1] * s;
                        u32x4 w; w.x = pk_bf16(v0[0], v0[1]); w.y = pk_bf16(v0[2], v0[3]); w.z = pk_bf16(v1[0], v1[1]); w.w = pk_bf16(v1[2], v1[3]);
                        *(u32x4*)(rowp + bj * HALF) = w; } }
            return;
        }
        const int h = (pn - 3) & 3, c8 = wc * 32 + 8 * fq, bh = (u.pm >> 4) * 4 + h;
        if (pn < 7) {
#pragma unroll
            for (int ai = 0; ai < 2; ++ai) {
                const int tseq0 = (u.pm & 15) * 256 + ai * HALF + wr * 64;
                float rsv[4]; float decv[8];
#pragma unroll
                for (int m = 0; m < 4; ++m) rsv[m] = rs[row0 + ai * HALF + m * 16];
#pragma unroll
                for (int n = 0; n < 2; ++n) {
                    float qdv[4][4], kiv[4][4];
#pragma unroll
                    for (int e = 0; e < 4; ++e) {
                        const int dk = c8 + 4 * n + e; const float lbc = lb[h * 128 + dk];
                        float f[4], p[4];
#pragma unroll
                        for (int m = 0; m < 4; ++m) { const float x = acc[ai][1][m][n][e] * rsv[m]; f[m] = lbc + (1.f - lbc) * sigm(x); p[m] = scan16(__logf(f[m])); }
                        const float t0 = __shfl(p[0], 15, 16), t1 = __shfl(p[1], 15, 16), t2 = __shfl(p[2], 15, 16), t3 = __shfl(p[3], 15, 16);
                        const float bl = (t0 + t1) + (t2 + t3), dc = __expf(bl); decv[4 * n + e] = dc;
                        const float bb[4] = {p[0], p[1] + t0, p[2] + (t0 + t1), p[3] + ((t0 + t1) + t2)};
                        bf16_t* kt = kendT + (size_t)(bh * 128 + dk) * SEQ + tseq0 + fr;
#pragma unroll
                        for (int m = 0; m < 4; ++m) { const float eb = __expf(bb[m]), einv = __builtin_amdgcn_rcpf(eb), k = 1.f - f[m], xq = acc[ai][0][m][n][e] * rsv[m];
                            qdv[m][e] = xq * sigm(xq) * eb; kiv[m][e] = k * einv; kt[16 * m] = bf16_1(k * einv * dc); }
                    }
#pragma unroll
                    for (int m = 0; m < 4; ++m) { const size_t o = (size_t)(row0 + ai * HALF + m * 16) * 512 + h * 128 + c8 + 4 * n;
                        u32x2 w; w.x = pk_bf16(qdv[m][0], qdv[m][1]); w.y = pk_bf16(qdv[m][2], qdv[m][3]); *(u32x2*)(qd + o) = w;
                        u32x2 z; z.x = pk_bf16(kiv[m][0], kiv[m][1]); z.y = pk_bf16(kiv[m][2], kiv[m][3]); *(u32x2*)(kinv + o) = z; }
                }
                if (fr == 0) { float* dp = dec + (size_t)(bh * 64 + (tseq0 >> 6)) * 128 + c8;
                    *(f32x4*)dp = (f32x4){decv[0], decv[1], decv[2], decv[3]}; *(f32x4*)(dp + 4) = (f32x4){decv[4], decv[5], decv[6], decv[7]}; }
            }
        } else {
#pragma unroll
            for (int ai = 0; ai < 2; ++ai) {
                const int tseq0 = (u.pm & 15) * 256 + ai * HALF + wr * 64;
#pragma unroll
                for (int m = 0; m < 4; ++m) { const int row = row0 + ai * HALF + m * 16; const float s = rs[row];
#pragma unroll
                    for (int n = 0; n < 2; ++n)
#pragma unroll
                        for (int e = 0; e < 4; ++e) vT[(size_t)(bh * 128 + c8 + 4 * n + e) * SEQ + tseq0 + 16 * m + fr] = bf16_1(acc[ai][0][m][n][e] * s);
                    f32x4 g0 = acc[ai][1][m][0] * s, g1 = acc[ai][1][m][1] * s;
#pragma unroll
                    for (int e = 0; e < 4; ++e) { g0[e] *= sigm(g0[e]); g1[e] *= sigm(g1[e]); }
                    u32x4 w; w.x = pk_bf16(g0[0], g0[1]); w.y = pk_bf16(g0[2], g0[3]); w.z = pk_bf16(g1[0], g1[1]); w.w = pk_bf16(g1[2], g1[3]);
                    *(u32x4*)(gs + (size_t)row * 512 + h * 128 + c8) = w; }
            }
        }
    }
};
template <bool ADD> struct EpiMerge {
    static constexpr bool PERM = true, AFTER_DRAIN = false;
    bf16_t* O; const bf16_t* gate;
    __device__ __forceinline__ void operator()(const f32x4 (&acc)[2][2][4][2], const Unit& u, int wr, int wc, int fr, int fq) const {
        const int row0 = u.pm * BM + wr * 64 + fr, col0 = u.pn * BM + wc * 32 + 8 * fq;
#pragma unroll
        for (int ai = 0; ai < 2; ++ai)
#pragma unroll
            for (int m = 0; m < 4; ++m) { const int row = row0 + ai * HALF + m * 16; bf16_t* rowp = O + (size_t)row * DM + col0; const bf16_t* gp = gate + (size_t)row * 2048 + col0;
#pragma unroll
                for (int bj = 0; bj < 2; ++bj) { const u32x4 g = *(const u32x4*)(gp + bj * HALF);
                    f32x4 v0 = acc[ai][bj][m][0], v1 = acc[ai][bj][m][1];
                    v0[0] *= sigm(bflo(g.x)); v0[1] *= sigm(bfhi(g.x)); v0[2] *= sigm(bflo(g.y)); v0[3] *= sigm(bfhi(g.y));
                    v1[0] *= sigm(bflo(g.z)); v1[1] *= sigm(bfhi(g.z)); v1[2] *= sigm(bflo(g.w)); v1[3] *= sigm(bfhi(g.w));
                    if (ADD) { const u32x4 o = *(const u32x4*)(rowp + bj * HALF);
                        v0[0] += bflo(o.x); v0[1] += bfhi(o.x); v0[2] += bflo(o.y); v0[3] += bfhi(o.y); v1[0] += bflo(o.z); v1[1] += bfhi(o.z); v1[2] += bflo(o.w); v1[3] += bfhi(o.w); }
                    u32x4 w; w.x = pk_bf16(v0[0], v0[1]); w.y = pk_bf16(v0[2], v0[3]); w.z = pk_bf16(v1[0], v1[1]); w.w = pk_bf16(v1[2], v1[3]);
                    *(u32x4*)(rowp + bj * HALF) = w; } }
    }
};
struct EpiX2 {
    static constexpr bool PERM = true, AFTER_DRAIN = false;
    const float* X; float* X2; bf16_t* X2B; float* ssq;
    __device__ __forceinline__ void operator()(const f32x4 (&acc)[2][2][4][2], const Unit& u, int wr, int wc, int fr, int fq) const {
        const int row0 = u.pm * BM + wr * 64 + fr, col0 = u.pn * BM + wc * 32 + 8 * fq;
#pragma unroll
        for (int ai = 0; ai < 2; ++ai)
#pragma unroll
            for (int m = 0; m < 4; ++m) { const int row = row0 + ai * HALF + m * 16; const size_t off = (size_t)row * DM + col0; float ss = 0.f;
#pragma unroll
                for (int bj = 0; bj < 2; ++bj) { const f32x4 x0 = *(const f32x4*)(X + off + bj * HALF), x1 = *(const f32x4*)(X + off + bj * HALF + 4);
                    const f32x4 v0 = acc[ai][bj][m][0] + x0, v1 = acc[ai][bj][m][1] + x1;
                    *(f32x4*)(X2 + off + bj * HALF) = v0; *(f32x4*)(X2 + off + bj * HALF + 4) = v1;
                    u32x4 w; w.x = pk_bf16(v0[0], v0[1]); w.y = pk_bf16(v0[2], v0[3]); w.z = pk_bf16(v1[0], v1[1]); w.w = pk_bf16(v1[2], v1[3]);
                    *(u32x4*)(X2B + off + bj * HALF) = w;
                    ss += (v0[0] * v0[0] + v0[1] * v0[1]) + (v0[2] * v0[2] + v0[3] * v0[3]) + (v1[0] * v1[0] + v1[1] * v1[1]) + (v1[2] * v1[2] + v1[3] * v1[3]); }
                ss += __shfl_xor(ss, 16); ss += __shfl_xor(ss, 32);
                if (fq == 0) ssq[(size_t)row * 16 + u.pn * 4 + wc] = ss; }
    }
};
struct EpiQp {
    static constexpr bool PERM = true, AFTER_DRAIN = false;
    bf16_t* O; const float* ssq;
    __device__ __forceinline__ void operator()(const f32x4 (&acc)[2][2][4][2], const Unit& u, int wr, int wc, int fr, int fq) const {
        const int row0 = u.pm * BM + wr * 64 + fr, col0 = u.pn * BM + wc * 32 + 8 * fq;
#pragma unroll
        for (int ai = 0; ai < 2; ++ai)
#pragma unroll
            for (int m = 0; m < 4; ++m) { const int row = row0 + ai * HALF + m * 16; const f32x4* sp = (const f32x4*)(ssq + (size_t)row * 16);
                const f32x4 a = sp[0], b = sp[1], c = sp[2], d = sp[3];
                const float tot = ((a[0] + a[1]) + (a[2] + a[3])) + ((b[0] + b[1]) + (b[2] + b[3])) + ((c[0] + c[1]) + (c[2] + c[3])) + ((d[0] + d[1]) + (d[2] + d[3]));
                const float s = __builtin_amdgcn_rsqf(tot * (1.f / 1024.f) + EPS); bf16_t* rowp = O + (size_t)row * 2048 + col0;
#pragma unroll
                for (int bj = 0; bj < 2; ++bj) { const f32x4 v0 = acc[ai][bj][m][0] * s, v1 = acc[ai][bj][m][1] * s;
                    u32x4 w; w.x = pk_bf16(v0[0], v0[1]); w.y = pk_bf16(v0[2], v0[3]); w.z = pk_bf16(v1[0], v1[1]); w.w = pk_bf16(v1[2], v1[3]);
                    *(u32x4*)(rowp + bj * HALF) = w; } }
    }
};
}

DI int w1_src_col(int n) {
    if (n < 768 || n >= 2816) return n;
    if (n < 1792) { const int h = (n - 768) >> 8, r = (n - 768) & 255; return r < 128 ? C_HQ + 128 * h + r : C_HF + 128 * h + (r - 128); }
    const int h = (n - 1792) >> 8, r = (n - 1792) & 255; return r < 128 ? C_HI + 128 * h + r : C_HG + 128 * h + (r - 128);
}
template <bool PERMW1> DI void p0_transpose_item(const float* W, int K, int N, bf16_t* WT, const float* g, int gmask, LAS float* scr, int item, int lane) {
    const int nblk = N / 32, kb = item / nblk, nb = item % nblk, k0 = 64 * kb, n0 = 32 * nb, ns = PERMW1 ? w1_src_col(n0) : n0;
#pragma unroll 8
    for (int i = 0; i < 32; ++i) { const int kk = 2 * i + (lane >> 5); float w = W[(size_t)(k0 + kk) * N + ns + (lane & 31)]; if (g) w *= g[(k0 + kk) & gmask]; scr[kk * 33 + (lane & 31)] = w; }
    LDS_WAIT(); asm volatile("" ::: "memory");
    const int c = lane & 7;
#pragma unroll
    for (int j = 0; j < 4; ++j) { const int n = (lane >> 3) + 8 * j; const LAS float* s = scr + (8 * c) * 33 + n;
        u32x4 o; o.x = pk_bf16(s[0 * 33], s[1 * 33]); o.y = pk_bf16(s[2 * 33], s[3 * 33]); o.z = pk_bf16(s[4 * 33], s[5 * 33]); o.w = pk_bf16(s[6 * 33], s[7 * 33]);
        *(u32x4*)(WT + (size_t)(n0 + n) * K + k0 + 8 * c) = o; }
    LDS_WAIT(); asm volatile("" ::: "memory");
}
DI unsigned pk_f16(float a, float b) { h16x2 v = {(_Float16)a, (_Float16)b}; return __builtin_bit_cast(unsigned, v); }

DI void p0_prologue(const Args& a, LAS unsigned char* lds, int vb, int G) {
    const int tid = threadIdx.x, lane = tid & 63, wave = tid >> 6;
    const int gw = vb * 8 + wave, NGW = G * 8, gt = vb * NTHR + tid, NGT = G * NTHR;
    unsigned char* ws = a.ws;
    LAS float* scr = (LAS float*)(lds + wave * 16384);
    constexpr int I_W1 = 16 * 152, I_AP = 8 * 32, I_HP = 8 * 32, I_OUT = 16 * 32, I_Q = 16 * 64, NITEMS = I_W1 + I_AP + I_HP + I_OUT + I_Q;
    for (int it = gw; it < NITEMS; it += NGW) {
        int r = it;
        if (r < I_W1) { p0_transpose_item<true>(a.in[2], 1024, NIN, (bf16_t*)(ws + WS_W1T), a.in[1], 1023, scr, r, lane); continue; } r -= I_W1;
        if (r < I_AP) { p0_transpose_item<false>(a.in[6], 512, 1024, (bf16_t*)(ws + WS_WAPT), nullptr, 0, scr, r, lane); continue; } r -= I_AP;
        if (r < I_HP) { p0_transpose_item<false>(a.in[7], 512, 1024, (bf16_t*)(ws + WS_WHPT), a.in[5], 127, scr, r, lane); continue; } r -= I_HP;
        if (r < I_OUT) { p0_transpose_item<false>(a.in[8], 1024, 1024, (bf16_t*)(ws + WS_WOUTT), nullptr, 0, scr, r, lane); continue; } r -= I_OUT;
        p0_transpose_item<false>(a.in[10], 1024, 2048, (bf16_t*)(ws + WS_WQT), a.in[9], 1023, scr, r, lane);
    }
    for (int i = gt; i < 2 * 8 * 128 * 128 / 4; i += NGT) { const f32x4 v = ((const f32x4*)a.in[11])[i]; u32x2 o; o.x = pk_bf16(v[0], v[1]); o.y = pk_bf16(v[2], v[3]); ((u32x2*)(ws + WS_KEYS))[i] = o; }
    for (int it = gw; it < 2 * 16384; it += NGW) {
        const int isv = it >= 16384, e = it & 16383;
        const float* src = (isv ? a.in[13] : a.in[12]) + (size_t)e * 1024 + 16 * lane;
        f32x4 x[4]; float amax = 0.f;
#pragma unroll
        for (int i = 0; i < 4; ++i) { x[i] = *(const f32x4*)(src + 4 * i); if (!isv) x[i] *= *(const f32x4*)(a.in[9] + 16 * lane + 4 * i);
            amax = fmaxf(fmaxf(amax, fmaxf(fabsf(x[i][0]), fabsf(x[i][1]))), fmaxf(fabsf(x[i][2]), fabsf(x[i][3]))); }
#pragma unroll
        for (int o = 1; o < 64; o <<= 1) amax = fmaxf(amax, __shfl_xor(amax, o));
        const float qs = amax > 0.f ? 127.f / amax : 0.f; const int off = isv ? 128 : 0;
        u32x4 w;
#pragma unroll
        for (int i = 0; i < 4; ++i) { const int q0 = (int)rintf(x[i][0] * qs) + off, q1 = (int)rintf(x[i][1] * qs) + off, q2 = (int)rintf(x[i][2] * qs) + off, q3 = (int)rintf(x[i][3] * qs) + off;
            w[i] = (unsigned)(q0 & 255) | ((unsigned)(q1 & 255) << 8) | ((unsigned)(q2 & 255) << 16) | ((unsigned)(q3 & 255) << 24); }
        *(u32x4*)(ws + (isv ? WS_V8 : WS_U8) + (size_t)e * 1024 + 16 * lane) = w;
        if (lane == 0) ((float*)(ws + (isv ? WS_SV : WS_SU)))[e] = amax * (1.f / 127.f);
    }
    for (int row = gw; row < T; row += NGW) {
        const f32x4* xr = (const f32x4*)(a.in[0] + (size_t)row * DM) + lane; f32x4 v[4]; float s = 0.f;
#pragma unroll
        for (int j = 0; j < 4; ++j) { v[j] = xr[64 * j]; s += (v[j][0] * v[j][0] + v[j][1] * v[j][1]) + (v[j][2] * v[j][2] + v[j][3] * v[j][3]); }
        s = wave_sum(s);
        u32x2* o = (u32x2*)(ws + WS_XB + (size_t)row * DM * 2) + lane;
#pragma unroll
        for (int j = 0; j < 4; ++j) { u32x2 w; w.x = pk_bf16(v[j][0], v[j][1]); w.y = pk_bf16(v[j][2], v[j][3]); o[64 * j] = w; }
        if (lane == 0) ((float*)(ws + WS_RSTD1))[row] = __builtin_amdgcn_rsqf(s * (1.f / 1024.f) + EPS);
    }
    if (vb == 0) { const float l0 = a.in[4][tid], l1 = a.in[4][512 + tid]; ((float*)(ws + WS_LB))[tid] = 1.f / (1.f + __expf(l1 - l0)); }
}

DI void attn_task(const bf16_t* pa, const bf16_t* avT, const float* sinks, bf16_t* ya, int b, int qb, int h) {
    const int lane = threadIdx.x & 63, r = lane & 31, hh = lane >> 5, kvh = h >> 2;
    const size_t trow = (size_t)b * SEQ + qb * 32 + r;
    constexpr float LOG2E = 1.4426950408889634f;
    bf16x8 qf[4];
    { const bf16_t* qp = pa + trow * 768 + h * 64 + 8 * hh;
#pragma unroll
      for (int s = 0; s < 4; ++s) qf[s] = *(const bf16x8*)(qp + 16 * s); }
    const float slope2 = exp2f(-(float)(h + 1)) * LOG2E, sink2 = sinks[h] * LOG2E, qs = 0.125f * LOG2E;
    f32x16 S[5]; float m = sink2;
#pragma unroll
    for (int i = 0; i < 5; ++i) { const int kb = qb - 4 + i;
        if (kb >= 0) {
#pragma unroll
            for (int q = 0; q < 16; ++q) S[i][q] = 0.f;
            const bf16_t* kp = pa + ((size_t)b * SEQ + kb * 32 + r) * 768 + 512 + kvh * 64 + 8 * hh;
#pragma unroll
            for (int s = 0; s < 4; ++s) S[i] = MFMA32(*(const bf16x8*)(kp + 16 * s), qf[s], S[i]);
#pragma unroll
            for (int q = 0; q < 16; ++q) { const int dist = 32 * (4 - i) + r - crow(q, hh); float v = S[i][q] * qs - slope2 * (float)dist;
                if (i == 0) v = (dist <= 127) ? v : -1e30f;
                if (i == 4) v = (dist >= 0) ? v : -1e30f;
                S[i][q] = v; m = fmaxf(m, v); }
        } }
    m = fmaxf(m, __shfl_xor(m, 32));
    float l = 0.f;
#pragma unroll
    for (int i = 0; i < 5; ++i) if (qb - 4 + i >= 0) {
#pragma unroll
        for (int q = 0; q < 16; ++q) { const float p = __builtin_amdgcn_exp2f(S[i][q] - m); S[i][q] = p; l += p; } }
    l += __shfl_xor(l, 32); l += __builtin_amdgcn_exp2f(sink2 - m);
    f32x16 O[2];
#pragma unroll
    for (int q = 0; q < 16; ++q) { O[0][q] = 0.f; O[1][q] = 0.f; }
#pragma unroll
    for (int i = 0; i < 5; ++i) { const int kb = qb - 4 + i;
        if (kb >= 0) {
#pragma unroll
            for (int s2 = 0; s2 < 2; ++s2) {
                u32x4 pb; pb.x = pk_bf16(S[i][8 * s2], S[i][8 * s2 + 1]); pb.y = pk_bf16(S[i][8 * s2 + 2], S[i][8 * s2 + 3]); pb.z = pk_bf16(S[i][8 * s2 + 4], S[i][8 * s2 + 5]); pb.w = pk_bf16(S[i][8 * s2 + 6], S[i][8 * s2 + 7]);
#pragma unroll
                for (int dt = 0; dt < 2; ++dt) { const bf16_t* vp = avT + (size_t)((b * 2 + kvh) * 64 + 32 * dt + r) * SEQ + kb * 32 + 16 * s2 + 4 * hh;
                    const u32x2 v0 = *(const u32x2*)vp, v1 = *(const u32x2*)(vp + 8); u32x4 av; av.x = v0.x; av.y = v0.y; av.z = v1.x; av.w = v1.y;
                    O[dt] = MFMA32(__builtin_bit_cast(bf16x8, av), __builtin_bit_cast(bf16x8, pb), O[dt]); }
            } } }
    const float inv = 1.f / l;
#pragma unroll
    for (int dt = 0; dt < 2; ++dt)
#pragma unroll
        for (int g = 0; g < 4; ++g) { u32x2 w; w.x = pk_bf16(O[dt][4 * g] * inv, O[dt][4 * g + 1] * inv); w.y = pk_bf16(O[dt][4 * g + 2] * inv, O[dt][4 * g + 3] * inv);
            *(u32x2*)(ya + trow * 512 + h * 64 + 32 * dt + 8 * g + 4 * hh) = w; }
}

DI void hgrn_ds_unit(const bf16_t* kendT, const bf16_t* vT, bf16_t* dsT, int bh, int c) {
    const int lane = threadIdx.x & 63, wave = threadIdx.x >> 6, r = lane & 31, hh = lane >> 5, i = wave >> 1, j0 = 2 * (wave & 1);
    const bf16_t* ka = kendT + (size_t)(bh * 128 + 32 * i + r) * SEQ + c * 64 + 8 * hh;
    const bf16_t* vb0 = vT + (size_t)(bh * 128 + 32 * j0 + r) * SEQ + c * 64 + 8 * hh; const bf16_t* vb1 = vb0 + (size_t)32 * SEQ;
    f32x16 D0, D1;
#pragma unroll
    for (int q = 0; q < 16; ++q) { D0[q] = 0.f; D1[q] = 0.f; }
#pragma unroll
    for (int ks = 0; ks < 4; ++ks) { const bf16x8 a = *(const bf16x8*)(ka + 16 * ks), b0 = *(const bf16x8*)(vb0 + 16 * ks), b1 = *(const bf16x8*)(vb1 + 16 * ks); D0 = MFMA32(a, b0, D0); D1 = MFMA32(a, b1, D1); }
    const int unit = bh * 64 + c;
    bf16_t* o0 = dsT + (size_t)(unit * 128 + 32 * j0 + r) * 128 + 32 * i + 4 * hh; bf16_t* o1 = o0 + 32 * 128;
#pragma unroll
    for (int g = 0; g < 4; ++g) { u32x2 w; w.x = pk_bf16(D0[4 * g], D0[4 * g + 1]); w.y = pk_bf16(D0[4 * g + 2], D0[4 * g + 3]); *(u32x2*)(o0 + 8 * g) = w;
        u32x2 z; z.x = pk_bf16(D1[4 * g], D1[4 * g + 1]); z.y = pk_bf16(D1[4 * g + 2], D1[4 * g + 3]); *(u32x2*)(o1 + 8 * g) = z; }
}
DI void hgrn_scan(bf16_t* dsT, const float* dec, int vb, int G) {
    for (int idx = vb * NTHR + threadIdx.x; idx < 64 * 128 * 16; idx += G * NTHR) {
        const int dk8 = idx & 15, dv = (idx >> 4) & 127, bh = idx >> 11;
        float S[8];
#pragma unroll
        for (int q = 0; q < 8; ++q) S[q] = 0.f;
        for (int c0 = 0; c0 < 64; c0 += 8) {
            u32x4 ld[8]; f32x4 d0[8], d1[8];
#pragma unroll
            for (int i = 0; i < 8; ++i) { const int c = c0 + i; ld[i] = *(const u32x4*)(dsT + (size_t)((bh * 64 + c) * 128 + dv) * 128 + dk8 * 8);
                const float* dp = dec + (size_t)(bh * 64 + c) * 128 + dk8 * 8; d0[i] = *(const f32x4*)dp; d1[i] = *(const f32x4*)(dp + 4); }
#pragma unroll
            for (int i = 0; i < 8; ++i) { const int c = c0 + i;
                u32x4 w; w.x = pk_bf16(S[0], S[1]); w.y = pk_bf16(S[2], S[3]); w.z = pk_bf16(S[4], S[5]); w.w = pk_bf16(S[6], S[7]);
                *(u32x4*)(dsT + (size_t)((bh * 64 + c) * 128 + dv) * 128 + dk8 * 8) = w;
                S[0] = d0[i][0] * S[0] + bflo(ld[i].x); S[1] = d0[i][1] * S[1] + bfhi(ld[i].x); S[2] = d0[i][2] * S[2] + bflo(ld[i].y); S[3] = d0[i][3] * S[3] + bfhi(ld[i].y);
                S[4] = d1[i][0] * S[4] + bflo(ld[i].z); S[5] = d1[i][1] * S[5] + bfhi(ld[i].z); S[6] = d1[i][2] * S[6] + bflo(ld[i].w); S[7] = d1[i][3] * S[7] + bfhi(ld[i].w); }
        }
    }
}
DI void hgrn_out_unit(const bf16_t* qd, const bf16_t* kinv, const bf16_t* vT, const bf16_t* spT, const bf16_t* gs, bf16_t* yh, LAS unsigned char* lds, int bh, int c) {
    const int tid = threadIdx.x, lane = tid & 63, wave = tid >> 6, r = lane & 31, hh = lane >> 5, tb = wave >> 2, db = wave & 3, b = bh >> 2, h = bh & 3;
    const size_t Tb = (size_t)b * SEQ + c * 64;
    bf16x8 qf[8];
    { const bf16_t* qrow = qd + (Tb + 32 * tb + r) * 512 + h * 128 + 8 * hh;
#pragma unroll
      for (int ks = 0; ks < 8; ++ks) qf[ks] = *(const bf16x8*)(qrow + 16 * ks); }
    f32x16 Z;
#pragma unroll
    for (int q = 0; q < 16; ++q) Z[q] = 0.f;
    { const bf16_t* sp = spT + (size_t)((bh * 64 + c) * 128 + 32 * db + r) * 128 + 8 * hh;
#pragma unroll
      for (int ks = 0; ks < 8; ++ks) { const bf16x8 bs = *(const bf16x8*)(sp + 16 * ks); Z = MFMA32(qf[ks], bs, Z); } }
    const bf16_t* vrow = vT + (size_t)(bh * 128 + 32 * db + r) * SEQ + c * 64 + 4 * hh;
#pragma unroll
    for (int sb = 0; sb < 2; ++sb) if (sb <= tb) {
        f32x16 X;
#pragma unroll
        for (int q = 0; q < 16; ++q) X[q] = 0.f;
        const bf16_t* krow = kinv + (Tb + 32 * sb + r) * 512 + h * 128 + 8 * hh;
#pragma unroll
        for (int ks = 0; ks < 8; ++ks) { const bf16x8 ak = *(const bf16x8*)(krow + 16 * ks); X = MFMA32(ak, qf[ks], X); }
        if (sb == tb) {
#pragma unroll
            for (int q = 0; q < 16; ++q) if (crow(q, hh) > r) X[q] = 0.f;
        }
#pragma unroll
        for (int s2 = 0; s2 < 2; ++s2) {
            u32x4 pa_; pa_.x = pk_bf16(X[8 * s2], X[8 * s2 + 1]); pa_.y = pk_bf16(X[8 * s2 + 2], X[8 * s2 + 3]); pa_.z = pk_bf16(X[8 * s2 + 4], X[8 * s2 + 5]); pa_.w = pk_bf16(X[8 * s2 + 6], X[8 * s2 + 7]);
            const u32x2 v0 = *(const u32x2*)(vrow + 32 * sb + 16 * s2), v1 = *(const u32x2*)(vrow + 32 * sb + 16 * s2 + 8);
            u32x4 pb_; pb_.x = v0.x; pb_.y = v0.y; pb_.z = v1.x; pb_.w = v1.y;
            Z = MFMA32(__builtin_bit_cast(bf16x8, pa_), __builtin_bit_cast(bf16x8, pb_), Z);
        }
    }
    LAS float* zs = (LAS float*)lds;
#pragma unroll
    for (int q = 0; q < 16; ++q) zs[(32 * tb + crow(q, hh)) * 132 + 32 * db + r] = Z[q];
    __syncthreads();
    { const int tok = tid >> 3, d16 = (tid & 7) * 16; f32x4 o[4]; float ss = 0.f;
#pragma unroll
      for (int i = 0; i < 4; ++i) { o[i] = *(const LAS f32x4*)(zs + tok * 132 + d16 + 4 * i); ss += (o[i][0] * o[i][0] + o[i][1] * o[i][1]) + (o[i][2] * o[i][2] + o[i][3] * o[i][3]); }
      ss += __shfl_xor(ss, 1); ss += __shfl_xor(ss, 2); ss += __shfl_xor(ss, 4);
      const float rn = __builtin_amdgcn_rsqf(ss * (1.f / 128.f) + EPS);
      const size_t off = (Tb + tok) * 512 + h * 128 + d16; const u32x4 g0 = *(const u32x4*)(gs + off), g1 = *(const u32x4*)(gs + off + 8);
      u32x4 w0, w1;
      w0.x = pk_bf16(o[0][0] * rn * bflo(g0.x), o[0][1] * rn * bfhi(g0.x)); w0.y = pk_bf16(o[0][2] * rn * bflo(g0.y), o[0][3] * rn * bfhi(g0.y));
      w0.z = pk_bf16(o[1][0] * rn * bflo(g0.z), o[1][1] * rn * bfhi(g0.z)); w0.w = pk_bf16(o[1][2] * rn * bflo(g0.w), o[1][3] * rn * bfhi(g0.w));
      w1.x = pk_bf16(o[2][0] * rn * bflo(g1.x), o[2][1] * rn * bfhi(g1.x)); w1.y = pk_bf16(o[2][2] * rn * bflo(g1.y), o[2][3] * rn * bfhi(g1.y));
      w1.z = pk_bf16(o[3][0] * rn * bflo(g1.z), o[3][1] * rn * bfhi(g1.z)); w1.w = pk_bf16(o[3][2] * rn * bflo(g1.w), o[3][3] * rn * bfhi(g1.w));
      *(u32x4*)(yh + off) = w0; *(u32x4*)(yh + off + 8) = w1; }
    __syncthreads();
}

DI unsigned f2ord(float f) { const unsigned b = __float_as_uint(f); return b ^ ((unsigned)((int)b >> 31) | 0x80000000u); }
DI float ord2f(unsigned k) { const unsigned b = (k & 0x80000000u) ? (k ^ 0x80000000u) : ~k; return __uint_as_float(b); }
#define TK_INS(L, x) do { unsigned t_ = (x); _Pragma("unroll") for (int j_ = 0; j_ < 16; ++j_) { const unsigned hi_ = L[j_] > t_ ? L[j_] : t_; t_ = L[j_] > t_ ? t_ : L[j_]; L[j_] = hi_; } } while (0)

DI void topk_unit(const bf16_t* qp, const bf16_t* keysb, unsigned short* gidx, float* ggate, LAS unsigned char* lds, int tile, int h) {
    const int tid = threadIdx.x, lane = tid & 63, wave = tid >> 6, p = wave & 1, tsub = wave >> 1, r = lane & 31, hh = lane >> 5;
    const int tok0 = tile * 128 + tsub * 32;
    f32x16 acc[4];
#pragma unroll
    for (int kb = 0; kb < 4; ++kb)
#pragma unroll
        for (int i = 0; i < 16; ++i) acc[kb][i] = 0.f;
    const bf16_t* qrow = qp + (size_t)(tok0 + r) * 2048 + h * 256 + p * 128 + 8 * hh;
    const bf16_t* kbase = keysb + ((size_t)(p * 8 + h) * 128 + r) * 128 + 8 * hh;
#pragma unroll
    for (int s = 0; s < 8; ++s) { const bf16x8 bq = *(const bf16x8*)(qrow + 16 * s);
#pragma unroll
        for (int kb = 0; kb < 4; ++kb) { const bf16x8 ak = *(const bf16x8*)(kbase + (size_t)kb * 32 * 128 + 16 * s); acc[kb] = MFMA32(ak, bq, acc[kb]); } }
    unsigned L[16];
#pragma unroll
    for (int j = 0; j < 16; ++j) L[j] = 0u;
#pragma unroll
    for (int kb = 0; kb < 4; ++kb)
#pragma unroll
        for (int i = 0; i < 16; ++i) { const unsigned key = (f2ord(acc[kb][i]) & ~127u) | (unsigned)(32 * kb + (i & 3) + 8 * (i >> 2) + 4 * hh); TK_INS(L, key); }
    { unsigned P[16];
#pragma unroll
      for (int j = 0; j < 16; ++j) P[j] = __shfl_xor(L[j], 32);
#pragma unroll
      for (int j = 0; j < 16; ++j) TK_INS(L, P[j]); }
    LAS unsigned* tk = (LAS unsigned*)lds;
    if (hh == 0) { LAS u32x4* dst = (LAS u32x4*)(tk + ((p * 128 + tsub * 32 + r) * 16));
#pragma unroll
        for (int c = 0; c < 4; ++c) { u32x4 w = {L[4 * c], L[4 * c + 1], L[4 * c + 2], L[4 * c + 3]}; dst[c] = w; } }
    __syncthreads();
    if (tid < 128) {
        unsigned L1[16], L2[16];
        { const LAS u32x4* s1 = (const LAS u32x4*)(tk + tid * 16); const LAS u32x4* s2 = (const LAS u32x4*)(tk + (128 + tid) * 16);
#pragma unroll
          for (int c = 0; c < 4; ++c) { const u32x4 a = s1[c], b = s2[c]; L1[4 * c] = a.x; L1[4 * c + 1] = a.y; L1[4 * c + 2] = a.z; L1[4 * c + 3] = a.w; L2[4 * c] = b.x; L2[4 * c + 1] = b.y; L2[4 * c + 2] = b.z; L2[4 * c + 3] = b.w; } }
        float v1[16], v2[16];
#pragma unroll
        for (int j = 0; j < 16; ++j) { v1[j] = ord2f(L1[j] & ~127u); v2[j] = ord2f(L2[j] & ~127u); }
        unsigned C[16];
#pragma unroll
        for (int j = 0; j < 16; ++j) C[j] = 0u;
#pragma unroll
        for (int i = 0; i < 16; ++i)
#pragma unroll
            for (int j = 0; j < 16; ++j) if ((i + 1) * (j + 1) <= 16) { const unsigned key = (f2ord(v1[i] + v2[j]) & ~255u) | (unsigned)(i * 16 + j); TK_INS(C, key); }
        float sc[16]; unsigned ei[16]; float mx = -1e30f;
#pragma unroll
        for (int q = 0; q < 16; ++q) { const unsigned ij = C[q] & 255u; const unsigned a = tk[tid * 16 + (ij >> 4)], b = tk[(128 + tid) * 16 + (ij & 15u)];
            sc[q] = ord2f(a & ~127u) + ord2f(b & ~127u); ei[q] = (a & 127u) * 128u + (b & 127u); mx = fmaxf(mx, sc[q]); }
        float sum = 0.f;
#pragma unroll
        for (int q = 0; q < 16; ++q) { sc[q] = __expf(sc[q] - mx); sum += sc[q]; }
        const float inv = 1.f / sum; const size_t o = (size_t)(tile * 128 + tid) * 128 + h * 16;
#pragma unroll
        for (int q = 0; q < 16; ++q) { gidx[o + q] = (unsigned short)ei[q]; ggate[o + q] = sc[q] * inv; }
    }
    __syncthreads();
}

DI float gelu_erf(float x) { return 0.5f * x * (1.f + erff(x * 0.70710678118654752f)); }
DI int dot16(u32x4 w, const int (&h)[4]) { int c = __builtin_amdgcn_sdot4((int)w.x, h[0], 0, false); c = __builtin_amdgcn_sdot4((int)w.y, h[1], c, false); c = __builtin_amdgcn_sdot4((int)w.z, h[2], c, false); return __builtin_amdgcn_sdot4((int)w.w, h[3], c, false); }
#define V8_FMA(acc4, word, we) do { acc4[0] += (we) * (float)((word) & 255u); acc4[1] += (we) * (float)(((word) >> 8) & 255u); acc4[2] += (we) * (float)(((word) >> 16) & 255u); acc4[3] += (we) * (float)((word) >> 24); } while (0)

DI void expert_token(const float* x2row, const float* ssq, const unsigned char* u8, const unsigned char* v8, const float* su, const float* sv, const unsigned short* gidx, const float* ggate, const float* gf, float* outrow, int lane) {
    f32x4 x[4]; float amax = 0.f;
#pragma unroll
    for (int i = 0; i < 4; ++i) { x[i] = *(const f32x4*)(x2row + 16 * lane + 4 * i); amax = fmaxf(fmaxf(amax, fmaxf(fabsf(x[i][0]), fabsf(x[i][1]))), fmaxf(fabsf(x[i][2]), fabsf(x[i][3]))); }
    float ss = (lane < 16) ? ssq[lane] : 0.f; ss = wave_sum(ss);
    const float rstd2 = __builtin_amdgcn_rsqf(ss * (1.f / 1024.f) + EPS);
#pragma unroll
    for (int o = 1; o < 64; o <<= 1) amax = fmaxf(amax, __shfl_xor(amax, o));
    amax *= rstd2;
    const float qs = amax > 0.f ? 127.f / amax : 0.f, sh = amax * (1.f / 127.f), xq = rstd2 * qs;
    int hq[4];
#pragma unroll
    for (int i = 0; i < 4; ++i) { const int q0 = (int)rintf(x[i][0] * xq), q1 = (int)rintf(x[i][1] * xq), q2 = (int)rintf(x[i][2] * xq), q3 = (int)rintf(x[i][3] * xq);
        hq[i] = (int)((unsigned)(q0 & 255) | ((unsigned)(q1 & 255) << 8) | ((unsigned)(q2 & 255) << 16) | ((unsigned)(q3 & 255) << 24)); }
    const int id0 = gidx[lane], id1 = gidx[64 + lane]; const float g0 = ggate[lane], g1 = ggate[64 + lane];
    f32x4 o[4]; float wsum = 0.f;
#pragma unroll
    for (int i = 0; i < 4; ++i) o[i] = (f32x4){0.f, 0.f, 0.f, 0.f};
#pragma unroll 1
    for (int bt = 0; bt < 16; ++bt) {
        const int idsel = (bt < 8) ? id0 : id1; const float gsel = (bt < 8) ? g0 : g1; const int lb = (bt & 7) * 8;
        u32x4 ur[8], vr[8];
#pragma unroll
        for (int e = 0; e < 8; ++e) { const int idx = __builtin_amdgcn_readlane(idsel, lb + e); ur[e] = *(const u32x4*)(u8 + (size_t)idx * 1024 + 16 * lane); }
#pragma unroll
        for (int e = 0; e < 8; ++e) { const int idx = __builtin_amdgcn_readlane(idsel, lb + e); vr[e] = *(const u32x4*)(v8 + (size_t)idx * 1024 + 16 * lane); }
        const int myidx = __shfl(idsel, lb + (lane >> 3)); const float mysu = su[myidx], mysv = sv[myidx], gate = __shfl(gsel, lb + (lane >> 3));
        int pr[8];
#pragma unroll
        for (int e = 0; e < 8; ++e) pr[e] = dot16(ur[e], hq);
        int q4[4], q2[2], q1;
        { const bool up_ = (lane & 32) != 0;
#pragma unroll
          for (int i = 0; i < 4; ++i) { const int keep = up_ ? pr[i + 4] : pr[i], send = up_ ? pr[i] : pr[i + 4]; q4[i] = keep + __shfl_xor(send, 32); } }
        { const bool up_ = (lane & 16) != 0;
#pragma unroll
          for (int i = 0; i < 2; ++i) { const int keep = up_ ? q4[i + 2] : q4[i], send = up_ ? q4[i] : q4[i + 2]; q2[i] = keep + __shfl_xor(send, 16); } }
        { const bool up_ = (lane & 8) != 0; const int keep = up_ ? q2[1] : q2[0], send = up_ ? q2[0] : q2[1]; q1 = keep + __shfl_xor(send, 8); }
        q1 += __shfl_xor(q1, 4); q1 += __shfl_xor(q1, 2); q1 += __shfl_xor(q1, 1);
        const float act = (float)q1 * (mysu * sh);
        const float w = gelu_erf(act) * gate * mysv;
#pragma unroll
        for (int e = 0; e < 8; ++e) { const float we = __int_as_float(__builtin_amdgcn_readlane(__float_as_int(w), 8 * e)); wsum += we;
            V8_FMA(o[0], vr[e].x, we); V8_FMA(o[1], vr[e].y, we); V8_FMA(o[2], vr[e].z, we); V8_FMA(o[3], vr[e].w, we); }
    }
    const float corr = 128.f * wsum; float s3 = 0.f;
#pragma unroll
    for (int i = 0; i < 4; ++i) { x[i] += o[i] - corr; s3 += (x[i][0] * x[i][0] + x[i][1] * x[i][1]) + (x[i][2] * x[i][2] + x[i][3] * x[i][3]); }
    s3 = wave_sum(s3); const float r3 = __builtin_amdgcn_rsqf(s3 * (1.f / 1024.f) + EPS);
#pragma unroll
    for (int i = 0; i < 4; ++i) *(f32x4*)(outrow + 16 * lane + 4 * i) = x[i] * r3 * *(const f32x4*)(gf + 16 * lane + 4 * i);
}

#define XB_TMO      128
#define XB_XCNT(j)  (256  + 64 * (j))
#define XB_XSUB(j)  (1280 + 64 * (j))
#define XB_XGEN(j)  (2304 + 64 * (j))
#define XB_TOP      3328
#define XB_TOPGEN   3392
#define XCD_BAR_WORDS 3456
#define XB_SPIN_CAP (1u << 18)

__device__ __forceinline__ unsigned xb_ld(unsigned* p)              { return __hip_atomic_load(p, __ATOMIC_RELAXED, __HIP_MEMORY_SCOPE_AGENT); }
__device__ __forceinline__ unsigned xb_add(unsigned* p, unsigned v) { return __hip_atomic_fetch_add(p, v, __ATOMIC_RELAXED, __HIP_MEMORY_SCOPE_AGENT); }
__device__ __forceinline__ unsigned xb_xcc_id() { return (unsigned)__builtin_amdgcn_s_getreg((3 << 11) | 20) & 0xFu; }
#define XB_SPIN(cond, bar) do { unsigned _sp = 0; while (cond) { __builtin_amdgcn_s_sleep(1); \
    if ((++_sp & 255u) == 0u) { if (xb_ld(&(bar)[XB_TMO])) break; if (_sp > XB_SPIN_CAP) { atomicAdd(&(bar)[XB_TMO], 1u); break; } } } } while (0)

struct XcdBarrier {
    unsigned* bar; unsigned x;
    volatile __attribute__((address_space(3))) unsigned* st;
};

__device__ __forceinline__ XcdBarrier xcd_barrier_post(unsigned* bar, volatile __attribute__((address_space(3))) unsigned* st) {
    XcdBarrier b; b.bar = bar; b.x = xb_xcc_id(); b.st = st;
    if (threadIdx.x == 0) (void)xb_add(&bar[XB_XCNT(b.x)], 1u);
    return b;
}
__device__ __forceinline__ void xcd_barrier_complete(unsigned* bar, unsigned x, unsigned& nloc, unsigned& nx) {
    const unsigned G = gridDim.x * gridDim.y * gridDim.z;
    unsigned sum, cnt, mine, sp = 0u;
    for (;;) {
        sum = 0u; cnt = 0u; mine = 0u;
#pragma unroll
        for (unsigned j = 0; j < 16; ++j) { const unsigned c = xb_ld(&bar[XB_XCNT(j)]); sum += c; cnt += (c > 0u) ? 1u : 0u; mine = (j == x) ? c : mine; }
        if (sum == G) break;
        __builtin_amdgcn_s_sleep(1);
        if ((++sp & 255u) == 0u) { if (xb_ld(&bar[XB_TMO])) break; if (sp > XB_SPIN_CAP) { atomicAdd(&bar[XB_TMO], 1u); break; } }
    }
    nloc = mine > 0u ? mine : 1u; nx = cnt > 0u ? cnt : 1u;
}

__device__ __forceinline__ void xcd_barrier(const XcdBarrier& b) {
    asm volatile("s_waitcnt vmcnt(0)" ::: "memory");
    __syncthreads();
    if (threadIdx.x == 0) {
        unsigned* bar = b.bar;
        __builtin_amdgcn_s_waitcnt(0);
        unsigned nloc = b.st[0], nx = b.st[1];
        if (nloc == 0u) { xcd_barrier_complete(bar, b.x, nloc, nx); b.st[0] = nloc; b.st[1] = nx; }
        const unsigned old = xb_add(&bar[XB_XSUB(b.x)], 1u);
        const unsigned gen = old / nloc;
        if (old + 1u == (gen + 1u) * nloc) {
            __builtin_amdgcn_fence(__ATOMIC_RELEASE, "agent");
            asm volatile("s_waitcnt vmcnt(0)" ::: "memory");
            const unsigned og = xb_add(&bar[XB_TOP], 1u);
            const unsigned tg = og / nx;
            if (og + 1u == (tg + 1u) * nx) xb_add(&bar[XB_TOPGEN], 1u);
            else XB_SPIN(xb_ld(&bar[XB_TOPGEN]) == tg, bar);
            __builtin_amdgcn_fence(__ATOMIC_ACQUIRE, "agent");
            xb_add(&bar[XB_XGEN(b.x)], 1u);
            asm volatile("s_waitcnt vmcnt(0)" ::: "memory");
        } else {
            XB_SPIN(xb_ld(&bar[XB_XGEN(b.x)]) == gen, bar);
            __builtin_amdgcn_fence(__ATOMIC_ACQUIRE, "agent");
            asm volatile("s_waitcnt vmcnt(0)" ::: "memory");
        }
    }
    __syncthreads();
}

constexpr int N_PHASES = 10;
__global__ void __launch_bounds__(NTHR, 2) mk_fwd(Args a) {
    extern __shared__ __attribute__((aligned(16))) unsigned char lds_raw[];
    LAS unsigned char* lds = (LAS unsigned char*)lds_raw;
    cg::grid_group grid = cg::this_grid();
    const int G = gridDim.x, vb = blockIdx.x, tid = threadIdx.x, lane = tid & 63, wave = tid >> 6;
    unsigned char* ws = a.ws;
    const int lo = a.ph_lo, hi = a.ph_hi;
    volatile LAS unsigned* MISC = (volatile LAS unsigned*)(lds + LDS_BYTES - 64);
    if (tid < 16) MISC[tid] = 0u;
    __syncthreads();
    const XcdBarrier bar = xcd_barrier_post((unsigned*)(ws + 4096) + lo * XCD_BAR_WORDS, MISC);
#ifndef PHASE_MASK
#define PHASE_MASK 0xFFFF
#endif
#define IN(k) (((PHASE_MASK >> (k)) & 1) && lo <= (k) && (k) < hi)
#ifndef REPEAT_MASK
#define REPEAT_MASK 0
#endif
#define REP(k) for (int rep_ = 0; rep_ < (((REPEAT_MASK) >> (k)) & 1) + 1; ++rep_)
#define SEAM(k) do { if (IN(k) && IN((k) + 1)) { if ((k) == 0) grid.sync(); else xcd_barrier(bar); } } while (0)
    REP(0) if (IN(0)) p0_prologue(a, lds, vb, G);
    SEAM(0);
    REP(1) if (IN(1)) { pg8::Gemm g{(const bf16_t*)(ws + WS_XB), (const bf16_t*)(ws + WS_W1T), T, NIN, 1024}; pg8::StaticOrder S; S.init(T, NIN, G, vb);
        pg8::Epi1 E{(const float*)(ws + WS_RSTD1), (bf16_t*)(ws + WS_PA), (bf16_t*)(ws + WS_GG), (bf16_t*)(ws + WS_QD), (bf16_t*)(ws + WS_KINV), (bf16_t*)(ws + WS_KENDT), (bf16_t*)(ws + WS_VT), (bf16_t*)(ws + WS_GS),
                    (float*)(ws + WS_DEC), (const float*)(ws + WS_LB), (bf16_t*)(ws + WS_AVT)};
        pg8::gemm_phase<pg8::Epi1, pg8::StaticOrder, true, true>(lds, g, S, E); }
    SEAM(1);
    REP(2) if (IN(2)) {
        for (int u = vb; u < 64 * 64; u += G) hgrn_ds_unit((const bf16_t*)(ws + WS_KENDT), (const bf16_t*)(ws + WS_VT), (bf16_t*)(ws + WS_XB), u >> 6, u & 63);
        { const int hw = __builtin_amdgcn_readfirstlane(wave);
          for (int u = vb; u < BATCH * (SEQ / 32); u += G) attn_task((const bf16_t*)(ws + WS_PA), (const bf16_t*)(ws + WS_AVT), a.in[3], (bf16_t*)(ws + WS_YA), u >> 7, u & 127, hw); }
    }
    SEAM(2);
    REP(3) if (IN(3)) hgrn_scan((bf16_t*)(ws + WS_XB), (const float*)(ws + WS_DEC), vb, G);
    SEAM(3);
    REP(4) if (IN(4)) for (int u = vb; u < 64 * 64; u += G)
        hgrn_out_unit((const bf16_t*)(ws + WS_QD), (const bf16_t*)(ws + WS_KINV), (const bf16_t*)(ws + WS_VT), (const bf16_t*)(ws + WS_XB), (const bf16_t*)(ws + WS_GS), (bf16_t*)(ws + WS_YH), lds, u >> 6, u & 63);
    SEAM(4);
    REP(5) if (IN(5)) {
        { pg8::Gemm g{(const bf16_t*)(ws + WS_YA), (const bf16_t*)(ws + WS_WAPT), T, 1024, 512}; pg8::StaticOrder S; S.init(T, 1024, G, vb);
          pg8::EpiMerge<false> E{(bf16_t*)(ws + WS_XB), (const bf16_t*)(ws + WS_GG)};
          pg8::gemm_phase<pg8::EpiMerge<false>, pg8::StaticOrder, true, true>(lds, g, S, E); }
        __syncthreads();
        { pg8::Gemm g{(const bf16_t*)(ws + WS_YH), (const bf16_t*)(ws + WS_WHPT), T, 1024, 512}; pg8::StaticOrder S; S.init(T, 1024, G, vb);
          pg8::EpiMerge<true> E{(bf16_t*)(ws + WS_XB), (const bf16_t*)(ws + WS_GG) + 1024};
          pg8::gemm_phase<pg8::EpiMerge<true>, pg8::StaticOrder, true, true>(lds, g, S, E); }
    }
    SEAM(5);
    REP(6) if (IN(6)) { pg8::Gemm g{(const bf16_t*)(ws + WS_XB), (const bf16_t*)(ws + WS_WOUTT), T, 1024, 1024}; pg8::StaticOrder S; S.init(T, 1024, G, vb);
        pg8::EpiX2 E{a.in[0], a.out, (bf16_t*)(ws + WS_X2B), (float*)(ws + WS_SSQ2)};
        pg8::gemm_phase<pg8::EpiX2, pg8::StaticOrder, true, true>(lds, g, S, E); }
    SEAM(6);
    REP(7) if (IN(7)) { pg8::Gemm g{(const bf16_t*)(ws + WS_X2B), (const bf16_t*)(ws + WS_WQT), T, 2048, 1024}; pg8::StaticOrder S; S.init(T, 2048, G, vb);
        pg8::EpiQp E{(bf16_t*)(ws + WS_QP), (const float*)(ws + WS_SSQ2)};
        pg8::gemm_phase<pg8::EpiQp, pg8::StaticOrder, true, true>(lds, g, S, E); }
    SEAM(7);
    REP(8) if (IN(8)) for (int u = vb; u < (T / 128) * 8; u += G) topk_unit((const bf16_t*)(ws + WS_QP), (const bf16_t*)(ws + WS_KEYS), (unsigned short*)(ws + WS_GIDX), (float*)(ws + WS_GGATE), lds, u >> 3, u & 7);
    SEAM(8);
    REP(9) if (IN(9)) for (int tok = vb * 8 + wave; tok < T; tok += G * 8)
        expert_token(a.out + (size_t)tok * DM, (const float*)(ws + WS_SSQ2) + (size_t)tok * 16, (const unsigned char*)(ws + WS_U8), (const unsigned char*)(ws + WS_V8), (const float*)(ws + WS_SU), (const float*)(ws + WS_SV),
                     (const unsigned short*)(ws + WS_GIDX) + (size_t)tok * 128, (const float*)(ws + WS_GGATE) + (size_t)tok * 128, a.in[14], a.out + (size_t)tok * DM, lane);
#undef IN
#undef SEAM
}

extern "C" void kernel_launch(void* const* d_in, const int* in_sizes, int n_in, void* d_out, int out_size, void* d_ws, size_t ws_size, hipStream_t stream) {
    static int grid = 0;
    if (grid == 0) {
        if (n_in != 15 || in_sizes[0] != T * DM || out_size != T * DM || ws_size < WS_END) { fprintf(stderr, "kernel_launch: unexpected shapes (n_in %d, in0 %d, out %d, ws %zu)\n", n_in, n_in > 0 ? in_sizes[0] : -1, out_size, ws_size); grid = -1; return; }
        int dev = 0, cus = 0, per_cu = 0;
        hipGetDevice(&dev); hipDeviceGetAttribute(&cus, hipDeviceAttributeMultiprocessorCount, dev);
        if (hipFuncSetAttribute((const void*)mk_fwd, hipFuncAttributeMaxDynamicSharedMemorySize, LDS_BYTES) != hipSuccess) { fprintf(stderr, "kernel_launch: hipFuncSetAttribute failed\n"); grid = -1; return; }
        if (hipOccupancyMaxActiveBlocksPerMultiprocessor(&per_cu, (const void*)mk_fwd, NTHR, LDS_BYTES) != hipSuccess || per_cu < 1) { fprintf(stderr, "kernel_launch: occupancy query says %d blocks per CU\n", per_cu); per_cu = 1; }
        (void)hipGetLastError();
        grid = cus;
    }
    if (grid < 0) return;
    if (hipMemsetAsync(d_ws, 0, 256 * 1024, stream) != hipSuccess) { fprintf(stderr, "kernel_launch: hipMemsetAsync failed\n"); return; }
    Args a{};
    for (int i = 0; i < 15; ++i) a.in[i] = (const float*)d_in[i];
    a.out = (float*)d_out; a.ws = (unsigned char*)d_ws;
#if MK_FUSED
    a.ph_lo = 0; a.ph_hi = N_PHASES;
    { void* args[] = {&a}; hipError_t e = hipLaunchCooperativeKernel((const void*)mk_fwd, dim3(grid), dim3(NTHR), args, LDS_BYTES, stream);
      if (e != hipSuccess) fprintf(stderr, "kernel_launch: cooperative launch failed: %s (grid %d)\n", hipGetErrorString(e), grid); }
#else
    for (int p = 0; p < N_PHASES; ++p) { a.ph_lo = p; a.ph_hi = p + 1; void* args[] = {&a};
        hipError_t e = hipLaunchCooperativeKernel((const void*)mk_fwd, dim3(grid), dim3(NTHR), args, LDS_BYTES, stream);
        if (e != hipSuccess) { fprintf(stderr, "kernel_launch: launch of phase %d failed: %s (grid %d)\n", p, hipGetErrorString(e), grid); break; } }
#endif
}
```

```cpp
#include <hip/hip_runtime.h>
#include <hip/hip_cooperative_groups.h>
#include <cstdio>
#include <cstdint>
namespace cg = cooperative_groups;
namespace pg8 {
#define PG8_LAS __attribute__((address_space(3)))
typedef unsigned short bf16_t;
typedef short bf16x8 __attribute__((ext_vector_type(8)));
typedef float f32x4 __attribute__((ext_vector_type(4)));
typedef unsigned u32x4 __attribute__((ext_vector_type(4)));
constexpr int BM = 256, BK = 64, HALF = 128, HTB = HALF * BK * 2  , STAGE_BYTES = 8 * HTB, NXCD = 8, WGM = 8;

__host__ __device__ __forceinline__ int lds_byte(int r, int c) { const int st = (r >> 4) * 2 + (c >> 5), rr = r & 15, cc = c & 31, ob = rr * 64 + cc * 2; return st * 1024 + (ob ^ (((ob >> 9) & 1) << 5)); }
__host__ __device__ __forceinline__ void stage_rc(int b, int& R, int& C) { const int st = b / 1024, sb = b % 1024, swz = sb ^ (((sb >> 9) & 1) << 5); R = (st >> 1) * 16 + swz / 64; C = (st & 1) * 32 + (swz % 64) / 2; }
__host__ __device__ __forceinline__ int perm32(int rho) { const int n = rho >> 4, i = rho & 15; return 8 * (i >> 2) + 4 * n + (i & 3); }

struct Unit { int pm, pn; };
struct Gemm { const bf16_t* A; const bf16_t* Bt; int M, N, K; };

struct StaticOrder {
    int nM, nN, nwg, G, c;
    __host__ __device__ void init(int M, int N, int G_, int c_) { nM = M / BM; nN = N / BM; nwg = nM * nN; G = G_; c = c_; }
    __host__ __device__ bool next(int i, Unit& u) const {
        const long L = (long)i * G + c; if (L >= nwg) return false;
        int wgid = (int)L; { const int q = nwg / NXCD, r = nwg % NXCD, xcd = wgid % NXCD, off = wgid / NXCD; wgid = (xcd < r ? xcd * (q + 1) : r * (q + 1) + (xcd - r) * q) + off; }
        const int nig = WGM * nN, gid = wgid / nig, fm = gid * WGM, gsz = (nM - fm) < WGM ? (nM - fm) : WGM;
        u.pm = fm + ((wgid % nig) % gsz); u.pn = (wgid % nig) / gsz; return true;
    }
    __device__ __forceinline__ void a_ready(const Unit&) const {}
    __device__ __forceinline__ void done(const Unit&) const {}
};

__device__ __forceinline__ unsigned cvt_pk_bf16(float lo, float hi) { unsigned r; asm volatile("v_cvt_pk_bf16_f32 %0, %1, %2" : "=v"(r) : "v"(lo), "v"(hi)); return r; }

template <class Epi, class Sched, bool ALIGN_EPI = false, bool SP2 = false>
__device__ __forceinline__ void gemm_phase(PG8_LAS unsigned char* lds, const Gemm g, const Sched& S, const Epi& E) {
    int tid_ = threadIdx.x; asm volatile("" : "+v"(tid_));
    const int tid = tid_, wid = __builtin_amdgcn_readfirstlane(tid >> 6), lane = tid & 63, wr = wid >> 2, wc = wid & 3, fr = lane & 15, fq = lane >> 4;
    const int K = g.K, nt = K / BK;
    unsigned voffA[2], voffB[2];
#pragma unroll
    for (int i = 0; i < 2; ++i) { int R, C; stage_rc(tid * 16 + i * 8192, R, C); const int Rb = Epi::PERM ? ((R & ~31) + perm32(R & 31)) : R;
        voffA[i] = (unsigned)(R * K + C) * 2u; voffB[i] = (unsigned)(Rb * K + C) * 2u; }
    const size_t kstep = (size_t)(BK * 2);
    const size_t hstep = (size_t)HALF * K * 2;
    const size_t tstep = 2 * hstep;
    const unsigned ldsw = (unsigned)wid * 1024u;
    const int aoff = lds_byte(wr * 64 + fr, fq * 8), boff = lds_byte(wc * 32 + fr, fq * 8);
#define PG8_SA(b, h) (((b) * 2 + (h)) * HTB)
#define PG8_SB(b, h) ((4 + (b) * 2 + (h)) * HTB)
#define PG8_STAGE(bufoff, gbase, voff) do { _Pragma("unroll") for (int _i = 0; _i < 2; ++_i) \
        __builtin_amdgcn_global_load_lds((const unsigned*)((const char*)(gbase) + (voff)[_i]), (PG8_LAS unsigned*)(lds + (bufoff) + ldsw + _i * 8192), 16, 0, 0); } while (0)
#define PG8_LDA(dst, b, h) do { _Pragma("unroll") for (int m = 0; m < 4; ++m) _Pragma("unroll") for (int k = 0; k < 2; ++k) dst[m][k] = *(const PG8_LAS bf16x8*)(lds + PG8_SA(b, h) + aoff + m * 2048 + k * 1024); } while (0)
#define PG8_LDB(dst, b, h) do { _Pragma("unroll") for (int n = 0; n < 2; ++n) _Pragma("unroll") for (int k = 0; k < 2; ++k) dst[n][k] = *(const PG8_LAS bf16x8*)(lds + PG8_SB(b, h) + boff + n * 2048 + k * 1024); } while (0)
#define PG8_MMA(ai, bj, At, Bt) do { __builtin_amdgcn_s_setprio(1); _Pragma("unroll") for (int m = 0; m < 4; ++m) _Pragma("unroll") for (int n = 0; n < 2; ++n) _Pragma("unroll") for (int k = 0; k < 2; ++k) \
        acc[ai][bj][m][n] = __builtin_amdgcn_mfma_f32_16x16x32_bf16(Bt[n][k], At[m][k], acc[ai][bj][m][n], 0, 0, 0); __builtin_amdgcn_s_setprio(0); } while (0)
#define PG8_WAIT_V(n) asm volatile("s_waitcnt vmcnt(" #n ")" ::: "memory")
#define PG8_WAIT_L(n) asm volatile("s_waitcnt lgkmcnt(" #n ")" ::: "memory")
#define PG8_BAR __builtin_amdgcn_s_barrier()
#define PG8_SCHED __builtin_amdgcn_sched_barrier(0)
    Unit cur, nxt; int ui = 0;
    if (!S.next(0, cur)) return;
    f32x4 acc[2][2][4][2];
#pragma unroll
    for (int a = 0; a < 2; ++a)
#pragma unroll
        for (int b = 0; b < 2; ++b)
#pragma unroll
            for (int m = 0; m < 4; ++m)
#pragma unroll
                for (int n = 0; n < 2; ++n) acc[a][b][m][n] = (f32x4){0.f, 0.f, 0.f, 0.f};
    bf16x8 At[4][2], B0[2][2], B1[2][2];
    const char* cA = (const char*)g.A + (size_t)cur.pm * tstep; const char* cB = (const char*)g.Bt + (size_t)cur.pn * tstep;
    S.a_ready(cur);
    if constexpr (SP2) {
        PG8_STAGE(PG8_SB(0, 0), cB, voffB); PG8_STAGE(PG8_SB(0, 1), cB + hstep, voffB); PG8_STAGE(PG8_SA(0, 0), cA, voffA); PG8_STAGE(PG8_SA(0, 1), cA + hstep, voffA);
        if (wr == 1) PG8_BAR;
        PG8_WAIT_V(2); PG8_BAR;
        PG8_STAGE(PG8_SB(1, 0), cB + kstep, voffB); PG8_STAGE(PG8_SA(1, 0), cA + kstep, voffA); PG8_STAGE(PG8_SB(1, 1), cB + hstep + kstep, voffB);
        PG8_WAIT_V(6); PG8_BAR;
    } else {
        PG8_STAGE(PG8_SB(0, 0), cB, voffB); PG8_STAGE(PG8_SA(0, 0), cA, voffA); PG8_STAGE(PG8_SB(0, 1), cB + hstep, voffB); PG8_STAGE(PG8_SA(0, 1), cA + hstep, voffA);
        if (wr == 1) PG8_BAR;
        PG8_WAIT_V(4); PG8_BAR;
        PG8_STAGE(PG8_SB(1, 0), cB + kstep, voffB); PG8_STAGE(PG8_SA(1, 0), cA + kstep, voffA); PG8_STAGE(PG8_SB(1, 1), cB + hstep + kstep, voffB);
        PG8_WAIT_V(6); PG8_BAR;
    }
    for (;;) {
        const bool has_next = S.next(ui + 1, nxt);
        const char* nA = has_next ? (const char*)g.A + (size_t)nxt.pm * tstep : cA; const char* nB = has_next ? (const char*)g.Bt + (size_t)nxt.pn * tstep : cB;
        for (int t = 0; t < nt; t += 2) {
            const bool last = (t == nt - 2);
            const char* a1 = cA + (size_t)(t + 1) * kstep;
            const char* a2 = last ? nA : cA + (size_t)(t + 2) * kstep; const char* b2 = last ? nB : cB + (size_t)(t + 2) * kstep;
            const char* a3 = a2 + kstep; const char* b3 = b2 + kstep;
            if (last && has_next) S.a_ready(nxt);
            if constexpr (SP2) {
            PG8_LDB(B0, 0, 0); PG8_LDB(B1, 0, 1); PG8_SCHED; PG8_LDA(At, 0, 0); PG8_STAGE(PG8_SA(1, 1), a1 + hstep, voffA);
            PG8_WAIT_V(8); PG8_WAIT_L(0); PG8_BAR; PG8_MMA(0, 0, At, B0); PG8_MMA(0, 1, At, B1); PG8_BAR; PG8_SCHED;
            PG8_LDA(At, 0, 1); PG8_STAGE(PG8_SB(0, 0), b2, voffB); PG8_STAGE(PG8_SB(0, 1), b2 + hstep, voffB); PG8_STAGE(PG8_SA(0, 0), a2, voffA);
            PG8_WAIT_V(8); PG8_WAIT_L(0); PG8_BAR; PG8_MMA(1, 0, At, B0); PG8_MMA(1, 1, At, B1); PG8_BAR; PG8_SCHED;
            PG8_LDB(B0, 1, 0); PG8_LDB(B1, 1, 1); PG8_SCHED; PG8_LDA(At, 1, 0); PG8_STAGE(PG8_SA(0, 1), a2 + hstep, voffA);
            PG8_WAIT_V(8); PG8_WAIT_L(0); PG8_BAR; PG8_MMA(0, 0, At, B0); PG8_MMA(0, 1, At, B1); PG8_BAR; PG8_SCHED;
            PG8_LDA(At, 1, 1); PG8_STAGE(PG8_SB(1, 0), b3, voffB); PG8_STAGE(PG8_SB(1, 1), b3 + hstep, voffB); PG8_STAGE(PG8_SA(1, 0), a3, voffA);
            PG8_WAIT_V(8); PG8_WAIT_L(0); PG8_BAR; PG8_MMA(1, 0, At, B0); PG8_MMA(1, 1, At, B1); PG8_BAR; PG8_SCHED;
            } else {
            PG8_LDB(B0, 0, 0); PG8_SCHED; PG8_LDA(At, 0, 0); PG8_STAGE(PG8_SA(1, 1), a1 + hstep, voffA);
            PG8_WAIT_L(8); PG8_BAR; PG8_WAIT_L(0); PG8_MMA(0, 0, At, B0); PG8_BAR; PG8_SCHED;
            PG8_LDB(B1, 0, 1); PG8_STAGE(PG8_SB(0, 0), b2, voffB);
            PG8_BAR; PG8_WAIT_L(0); PG8_MMA(0, 1, At, B1); PG8_BAR;
            PG8_LDA(At, 0, 1); PG8_STAGE(PG8_SA(0, 0), a2, voffA);
            PG8_BAR; PG8_WAIT_L(0); PG8_MMA(1, 0, At, B0); PG8_BAR; PG8_SCHED;
            PG8_STAGE(PG8_SB(0, 1), b2 + hstep, voffB);
            PG8_WAIT_V(6); PG8_BAR; PG8_MMA(1, 1, At, B1); PG8_BAR;
            PG8_LDB(B0, 1, 0); PG8_SCHED; PG8_LDA(At, 1, 0); PG8_STAGE(PG8_SA(0, 1), a2 + hstep, voffA);
            PG8_WAIT_L(8); PG8_BAR; PG8_WAIT_L(0); PG8_MMA(0, 0, At, B0); PG8_BAR; PG8_SCHED;
            PG8_LDB(B1, 1, 1); PG8_STAGE(PG8_SB(1, 0), b3, voffB);
            PG8_BAR; PG8_WAIT_L(0); PG8_MMA(0, 1, At, B1); PG8_BAR;
            PG8_LDA(At, 1, 1); PG8_STAGE(PG8_SA(1, 0), a3, voffA);
            PG8_BAR; PG8_WAIT_L(0); PG8_MMA(1, 0, At, B0); PG8_BAR; PG8_SCHED;
            PG8_STAGE(PG8_SB(1, 1), b3 + hstep, voffB);
            PG8_WAIT_V(6); PG8_BAR; PG8_MMA(1, 1, At, B1); PG8_BAR;
            }
        }
        if constexpr (ALIGN_EPI) { if (wr == 0) PG8_BAR; }
        if constexpr (!Epi::AFTER_DRAIN) { E(acc, cur, wr, wc, fr, fq); S.done(cur); }
        if (!has_next) break;
#pragma unroll
        for (int a = 0; a < 2; ++a)
#pragma unroll
            for (int b = 0; b < 2; ++b)
#pragma unroll
                for (int m = 0; m < 4; ++m)
#pragma unroll
                    for (int n = 0; n < 2; ++n) acc[a][b][m][n] = (f32x4){0.f, 0.f, 0.f, 0.f};
        cur = nxt; cA = nA; cB = nB; ++ui;
        if constexpr (ALIGN_EPI) { if (wr == 1) PG8_BAR; }
    }
    PG8_WAIT_V(0);
    if constexpr (!ALIGN_EPI) { if (wr == 0) PG8_BAR; }
    PG8_BAR;
    if constexpr (Epi::AFTER_DRAIN) { E.fused(acc, cur, wr, wc, fr, fq, lds, wid, lane); S.done(cur); }
#undef PG8_SA
#undef PG8_SB
#undef PG8_STAGE
#undef PG8_LDA
#undef PG8_LDB
#undef PG8_MMA
#undef PG8_WAIT_V
#undef PG8_WAIT_L
#undef PG8_BAR
#undef PG8_SCHED
}
}

#ifndef MK_FUSED
#define MK_FUSED 1
#endif
#define DI __device__ __forceinline__
#define LAS __attribute__((address_space(3)))
typedef unsigned short bf16_t;
typedef float f32x4 __attribute__((ext_vector_type(4)));
typedef float f32x2 __attribute__((ext_vector_type(2)));
typedef float f32x16 __attribute__((ext_vector_type(16)));
typedef unsigned u32x4 __attribute__((ext_vector_type(4)));
typedef unsigned u32x2 __attribute__((ext_vector_type(2)));
typedef short bf16x8 __attribute__((ext_vector_type(8)));
typedef _Float16 h16x2 __attribute__((ext_vector_type(2)));
typedef _Float16 h16x8 __attribute__((ext_vector_type(8)));

constexpr int BATCH = 16, SEQ = 4096, T = BATCH * SEQ, DM = 1024, NIN = 4864;
constexpr int C_AQ = 0, C_AK = 512, C_AV = 640, C_HQ = 768, C_HF = 1280, C_HI = 1792, C_HG = 2304, C_GA = 2816, C_GH = 3840;
constexpr float EPS = 1e-6f;
constexpr int NTHR = 512;
constexpr int LDS_BYTES = 147456;

constexpr size_t MiB = 1u << 20;
constexpr size_t WS_W1T = 1 * MiB;
constexpr size_t WS_WAPT = 11 * MiB;
constexpr size_t WS_WHPT = 12 * MiB;
constexpr size_t WS_WOUTT = 13 * MiB;
constexpr size_t WS_WQT = 15 * MiB;
constexpr size_t WS_KEYS = 19 * MiB;
constexpr size_t WS_LB = 19 * MiB + 512 * 1024;
constexpr size_t WS_RSTD1 = 20 * MiB;
constexpr size_t WS_SSQ2 = 21 * MiB;
constexpr size_t WS_U8 = 26 * MiB;
constexpr size_t WS_V8 = 42 * MiB;
constexpr size_t WS_SU = 58 * MiB;
constexpr size_t WS_SV = 58 * MiB + 65536;
constexpr size_t WS_DEC = 60 * MiB;
constexpr size_t WS_AVT = 64 * MiB;
constexpr size_t WS_XB = 90 * MiB;
constexpr size_t WS_PA = 218 * MiB;
constexpr size_t WS_GG = 314 * MiB;
constexpr size_t WS_QD = 570 * MiB;
constexpr size_t WS_KINV = 634 * MiB;
constexpr size_t WS_KENDT = 698 * MiB;
constexpr size_t WS_VT = 762 * MiB;
constexpr size_t WS_GS = 826 * MiB;
constexpr size_t WS_YA = 890 * MiB;
constexpr size_t WS_YH = 954 * MiB;
constexpr size_t WS_END = 1018 * MiB;
constexpr size_t WS_X2B = 218 * MiB;
constexpr size_t WS_QP = 346 * MiB;
constexpr size_t WS_GIDX = 602 * MiB;
constexpr size_t WS_GGATE = 618 * MiB;

struct Args { const float* in[15]; float* out; unsigned char* ws; int ph_lo, ph_hi; };

DI unsigned pk_bf16(float lo, float hi) { typedef __bf16 b2 __attribute__((ext_vector_type(2))); f32x2 v = {lo, hi}; b2 b = __builtin_convertvector(v, b2); return __builtin_bit_cast(unsigned, b); }
DI float bflo(unsigned w) { return __uint_as_float(w << 16); }
DI float bfhi(unsigned w) { return __uint_as_float(w & 0xffff0000u); }
DI float sigm(float x) { return 1.f / (1.f + __expf(-x)); }
DI float wave_sum(float v) {
#pragma unroll
    for (int o = 1; o < 64; o <<= 1) v += __shfl_xor(v, o);
    return v;
}
DI unsigned short bf16_1(float x) { return (unsigned short)(pk_bf16(x, 0.f) & 0xffffu); }
template <int N> DI float dpp_row_shr(float v) { return __int_as_float(__builtin_amdgcn_update_dpp(0, __float_as_int(v), 0x110 + N, 0xf, 0xf, true)); }
DI float scan16(float v) { v += dpp_row_shr<1>(v); v += dpp_row_shr<2>(v); v += dpp_row_shr<4>(v); v += dpp_row_shr<8>(v); return v; }
DI int crow(int reg, int hh) { return (reg & 3) + 8 * (reg >> 2) + 4 * hh; }
#define MFMA32(a, b, c) __builtin_amdgcn_mfma_f32_32x32x16_bf16((a), (b), (c), 0, 0, 0)
#define LDS_WAIT() asm volatile("s_waitcnt lgkmcnt(0)" ::: "memory")

namespace pg8 {
struct Epi1 {
    static constexpr bool PERM = true, AFTER_DRAIN = false;
    const float* rs; bf16_t* pa; bf16_t* gg; bf16_t* qd; bf16_t* kinv; bf16_t* kendT; bf16_t* vT; bf16_t* gs; float* dec; const float* lb; bf16_t* avT;
    __device__ __forceinline__ void operator()(const f32x4 (&acc)[2][2][4][2], const Unit& u, int wr, int wc, int fr, int fq) const {
        asm volatile("" : "+v"(fr), "+v"(fq));
        const int row0 = u.pm * BM + wr * 64 + fr, pn = u.pn;
        if (pn == 2) {
            const int c8 = wc * 32 + 8 * fq, tseqb = (u.pm & 15) * 256 + wr * 64 + fr, bb = u.pm >> 4;
#pragma unroll
            for (int ai = 0; ai < 2; ++ai)
#pragma unroll
                for (int m = 0; m < 4; ++m) { const int row = row0 + ai * HALF + m * 16; const float s = rs[row];
                    const f32x4 v0 = acc[ai][0][m][0] * s, v1 = acc[ai][0][m][1] * s;
                    u32x4 w; w.x = pk_bf16(v0[0], v0[1]); w.y = pk_bf16(v0[2], v0[3]); w.z = pk_bf16(v1[0], v1[1]); w.w = pk_bf16(v1[2], v1[3]);
                    *(u32x4*)(pa + (size_t)row * 768 + 512 + c8) = w;
#pragma unroll
                    for (int n = 0; n < 2; ++n)
#pragma unroll
                        for (int e = 0; e < 4; ++e) { const int c = c8 + 4 * n + e; avT[(size_t)((bb * 2 + (c >> 6)) * 64 + (c & 63)) * SEQ + tseqb + ai * HALF + 16 * m] = bf16_1(acc[ai][1][m][n][e] * s); } }
            return;
        }
        if (pn < 3 || pn >= 11) {
            bf16_t* O; int ldc, colt;
            if (pn < 3) { O = pa; ldc = 768; colt = pn * 256; } else { O = gg; ldc = 2048; colt = (pn - 11) * 256; }
            const int col0 = colt + wc * 32 + 8 * fq;
#pragma unroll
            for (int ai = 0; ai < 2; ++ai)
#pragma unroll
                for (int m = 0; m < 4; ++m) { const int row = row0 + ai * HALF + m * 16; const float s = rs[row]; bf16_t* rowp = O + (size_t)row * ldc + col0;
#pragma unroll
                    for (int bj = 0; bj < 2; ++bj) { const f32x4 v0 = acc[ai][bj][m][0] * s, v1 = acc[ai][bj][m][1] * s;
                        u32x4 w; w.x = pk_bf16(v0[0], v0[1]); w.y = pk_bf16(v0[2], v0[3]); w.z = pk_bf16(v1[0], v1[1]); w.w = pk_bf16(v1[2], v1[3]);
                        *(u32x4*)(rowp + bj * HALF) = w; } }
            return;
        }
        const int h = (pn - 3) & 3, c8 = wc * 32 + 8 * fq, bh = (u.pm >> 4) * 4 + h;
        if (pn < 7) {
#pragma unroll
            for (int ai = 0; ai < 2; ++ai) {
                const int tseq0 = (u.pm & 15) * 256 + ai * HALF + wr * 64;
                float rsv[4]; float decv[8];
#pragma unroll
                for (int m = 0; m < 4; ++m) rsv[m] = rs[row0 + ai * HALF + m * 16];
#pragma unroll
                for (int n = 0; n < 2; ++n) {
                    float qdv[4][4], kiv[4][4];
#pragma unroll
                    for (int e = 0; e < 4; ++e) {
                        const int dk = c8 + 4 * n + e; const float lbc = lb[h * 128 + dk];
                        float f[4], p[4];
#pragma unroll
                        for (int m = 0; m < 4; ++m) { const float x = acc[ai][1][m][n][e] * rsv[m]; f[m] = lbc + (1.f - lbc) * sigm(x); p[m] = scan16(__logf(f[m])); }
                        const float t0 = __shfl(p[0], 15, 16), t1 = __shfl(p[1], 15, 16), t2 = __shfl(p[2], 15, 16), t3 = __shfl(p[3], 15, 16);
                        const float bl = (t0 + t1) + (t2 + t3), dc = __expf(bl); decv[4 * n + e] = dc;
                        const float bb[4] = {p[0], p[1] + t0, p[2] + (t0 + t1), p[3] + ((t0 + t1) + t2)};
                        bf16_t* kt = kendT + (size_t)(bh * 128 + dk) * SEQ + tseq0 + fr;
#pragma unroll
                        for (int m = 0; m < 4; ++m) { const float eb = __expf(bb[m]), einv = __builtin_amdgcn_rcpf(eb), k = 1.f - f[m], xq = acc[ai][0][m][n][e] * rsv[m];
                            qdv[m][e] = xq * sigm(xq) * eb; kiv[m][e] = k * einv; kt[16 * m] = bf16_1(k * einv * dc); }
                    }
#pragma unroll
                    for (int m = 0; m < 4; ++m) { const size_t o = (size_t)(row0 + ai * HALF + m * 16) * 512 + h * 128 + c8 + 4 * n;
                        u32x2 w; w.x = pk_bf16(qdv[m][0], qdv[m][1]); w.y = pk_bf16(qdv[m][2], qdv[m][3]); *(u32x2*)(qd + o) = w;
                        u32x2 z; z.x = pk_bf16(kiv[m][0], kiv[m][1]); z.y = pk_bf16(kiv[m][2], kiv[m][3]); *(u32x2*)(kinv + o) = z; }
                }
                if (fr == 0) { float* dp = dec + (size_t)(bh * 64 + (tseq0 >> 6)) * 128 + c8;
                    *(f32x4*)dp = (f32x4){decv[0], decv[1], decv[2], decv[3]}; *(f32x4*)(dp + 4) = (f32x4){decv[4], decv[5], decv[6], decv[7]}; }
            }
        } else {
#pragma unroll
            for (int ai = 0; ai < 2; ++ai) {
                const int tseq0 = (u.pm & 15) * 256 + ai * HALF + wr * 64;
#pragma unroll
                for (int m = 0; m < 4; ++m) { const int row = row0 + ai * HALF + m * 16; const float s = rs[row];
#pragma unroll
                    for (int n = 0; n < 2; ++n)
#pragma unroll
                        for (int e = 0; e < 4; ++e) vT[(size_t)(bh * 128 + c8 + 4 * n + e) * SEQ + tseq0 + 16 * m + fr] = bf16_1(acc[ai][0][m][n][e] * s);
                    f32x4 g0 = acc[ai][1][m][0] * s, g1 = acc[ai][1][m][1] * s;
#pragma unroll
                    for (int e = 0; e < 4; ++e) { g0[e] *= sigm(g0[e]); g1[e] *= sigm(g1[e]); }
                    u32x4 w; w.x = pk_bf16(g0[0], g0[1]); w.y = pk_bf16(g0[2], g0[3]); w.z = pk_bf16(g1[0], g1[1]); w.w = pk_bf16(g1[2], g1[3]);
                    *(u32x4*)(gs + (size_t)row * 512 + h * 128 + c8) = w; }
            }
        }
    }
};
template <bool ADD> struct EpiMerge {
    static constexpr bool PERM = true, AFTER_DRAIN = false;
    bf16_t* O; const bf16_t* gate;
    __device__ __forceinline__ void operator()(const f32x4 (&acc)[2][2][4][2], const Unit& u, int wr, int wc, int fr, int fq) const {
        const int row0 = u.pm * BM + wr * 64 + fr, col0 = u.pn * BM + wc * 32 + 8 * fq;
#pragma unroll
        for (int ai = 0; ai < 2; ++ai)
#pragma unroll
            for (int m = 0; m < 4; ++m) { const int row = row0 + ai * HALF + m * 16; bf16_t* rowp = O + (size_t)row * DM + col0; const bf16_t* gp = gate + (size_t)row * 2048 + col0;
#pragma unroll
                for (int bj = 0; bj < 2; ++bj) { const u32x4 g = *(const u32x4*)(gp + bj * HALF);
                    f32x4 v0 = acc[ai][bj][m][0], v1 = acc[ai][bj][m][1];
                    v0[0] *= sigm(bflo(g.x)); v0[1] *= sigm(bfhi(g.x)); v0[2] *= sigm(bflo(g.y)); v0[3] *= sigm(bfhi(g.y));
                    v1[0] *= sigm(bflo(g.z)); v1[1] *= sigm(bfhi(g.z)); v1[2] *= sigm(bflo(g.w)); v1[3] *= sigm(bfhi(g.w));
                    if (ADD) { const u32x4 o = *(const u32x4*)(rowp + bj * HALF);
                        v0[0] += bflo(o.x); v0[1] += bfhi(o.x); v0[2] += bflo(o.y); v0[3] += bfhi(o.y); v1[0] += bflo(o.z); v1[1] += bfhi(o.z); v1[2] += bflo(o.w); v1[3] += bfhi(o.w); }
                    u32x4 w; w.x = pk_bf16(v0[0], v0[1]); w.y = pk_bf16(v0[2], v0[3]); w.z = pk_bf16(v1[0], v1[1]); w.w = pk_bf16(v1[2], v1[3]);
                    *(u32x4*)(rowp + bj * HALF) = w; } }
    }
};
struct EpiX2 {
    static constexpr bool PERM = true, AFTER_DRAIN = false;
    const float* X; bf16_t* X2B; float* ssq;
    __device__ __forceinline__ void operator()(const f32x4 (&acc)[2][2][4][2], const Unit& u, int wr, int wc, int fr, int fq) const {
        const int row0 = u.pm * BM + wr * 64 + fr, col0 = u.pn * BM + wc * 32 + 8 * fq;
#pragma unroll
        for (int ai = 0; ai < 2; ++ai)
#pragma unroll
            for (int m = 0; m < 4; ++m) { const int row = row0 + ai * HALF + m * 16; const size_t off = (size_t)row * DM + col0; float ss = 0.f;
#pragma unroll
                for (int bj = 0; bj < 2; ++bj) { const f32x4 x0 = *(const f32x4*)(X + off + bj * HALF), x1 = *(const f32x4*)(X + off + bj * HALF + 4);
                    const f32x4 v0 = acc[ai][bj][m][0] + x0, v1 = acc[ai][bj][m][1] + x1;
                    u32x4 w; w.x = pk_bf16(v0[0], v0[1]); w.y = pk_bf16(v0[2], v0[3]); w.z = pk_bf16(v1[0], v1[1]); w.w = pk_bf16(v1[2], v1[3]);
                    *(u32x4*)(X2B + off + bj * HALF) = w;
                    ss += (v0[0] * v0[0] + v0[1] * v0[1]) + (v0[2] * v0[2] + v0[3] * v0[3]) + (v1[0] * v1[0] + v1[1] * v1[1]) + (v1[2] * v1[2] + v1[3] * v1[3]); }
                ss += __shfl_xor(ss, 16); ss += __shfl_xor(ss, 32);
                if (fq == 0) ssq[(size_t)row * 16 + u.pn * 4 + wc] = ss; }
    }
};
struct EpiQp {
    static constexpr bool PERM = true, AFTER_DRAIN = false;
    bf16_t* O; const float* ssq;
    __device__ __forceinline__ void operator()(const f32x4 (&acc)[2][2][4][2], const Unit& u, int wr, int wc, int fr, int fq) const {
        const int row0 = u.pm * BM + wr * 64 + fr, col0 = u.pn * BM + wc * 32 + 8 * fq;
#pragma unroll
        for (int ai = 0; ai < 2; ++ai)
#pragma unroll
            for (int m = 0; m < 4; ++m) { const int row = row0 + ai * HALF + m * 16; const f32x4* sp = (const f32x4*)(ssq + (size_t)row * 16);
                const f32x4 a = sp[0], b = sp[1], c = sp[2], d = sp[3];
                const float tot = ((a[0] + a[1]) + (a[2] + a[3])) + ((b[0] + b[1]) + (b[2] + b[3])) + ((c[0] + c[1]) + (c[2] + c[3])) + ((d[0] + d[1]) + (d[2] + d[3]));
                const float s = __builtin_amdgcn_rsqf(tot * (1.f / 1024.f) + EPS); bf16_t* rowp = O + (size_t)row * 2048 + col0;
#pragma unroll
                for (int bj = 0; bj < 2; ++bj) { const f32x4 v0 = acc[ai][bj][m][0] * s, v1 = acc[ai][bj][m][1] * s;
                    u32x4 w; w.x = pk_bf16(v0[0], v0[1]); w.y = pk_bf16(v0[2], v0[3]); w.z = pk_bf16(v1[0], v1[1]); w.w = pk_bf16(v1[2], v1[3]);
                    *(u32x4*)(rowp + bj * HALF) = w; } }
    }
};
}

DI int w1_src_col(int n) {
    if (n < 768 || n >= 2816) return n;
    if (n < 1792) { const int h = (n - 768) >> 8, r = (n - 768) & 255; return r < 128 ? C_HQ + 128 * h + r : C_HF + 128 * h + (r - 128); }
    const int h = (n - 1792) >> 8, r = (n - 1792) & 255; return r < 128 ? C_HI + 128 * h + r : C_HG + 128 * h + (r - 128);
}
template <bool PERMW1> DI void p0_transpose_item(const float* W, int K, int N, bf16_t* WT, const float* g, int gmask, LAS float* scr, int item, int lane) {
    const int nblk = N / 32, kb = item / nblk, nb = item % nblk, k0 = 64 * kb, n0 = 32 * nb, ns = PERMW1 ? w1_src_col(n0) : n0;
#pragma unroll 8
    for (int i = 0; i < 32; ++i) { const int kk = 2 * i + (lane >> 5); float w = W[(size_t)(k0 + kk) * N + ns + (lane & 31)]; if (g) w *= g[(k0 + kk) & gmask]; scr[kk * 33 + (lane & 31)] = w; }
    LDS_WAIT(); asm volatile("" ::: "memory");
    const int c = lane & 7;
#pragma unroll
    for (int j = 0; j < 4; ++j) { const int n = (lane >> 3) + 8 * j; const LAS float* s = scr + (8 * c) * 33 + n;
        u32x4 o; o.x = pk_bf16(s[0 * 33], s[1 * 33]); o.y = pk_bf16(s[2 * 33], s[3 * 33]); o.z = pk_bf16(s[4 * 33], s[5 * 33]); o.w = pk_bf16(s[6 * 33], s[7 * 33]);
        *(u32x4*)(WT + (size_t)(n0 + n) * K + k0 + 8 * c) = o; }
    LDS_WAIT(); asm volatile("" ::: "memory");
}
DI unsigned pk_f16(float a, float b) { h16x2 v = {(_Float16)a, (_Float16)b}; return __builtin_bit_cast(unsigned, v); }

DI void p0_prologue(const Args& a, LAS unsigned char* lds, int vb, int G) {
    const int tid = threadIdx.x, lane = tid & 63, wave = tid >> 6;
    const int gw = vb * 8 + wave, NGW = G * 8, gt = vb * NTHR + tid, NGT = G * NTHR;
    unsigned char* ws = a.ws;
    LAS float* scr = (LAS float*)(lds + wave * 16384);
    constexpr int I_W1 = 16 * 152, I_AP = 8 * 32, I_HP = 8 * 32, I_OUT = 16 * 32, I_Q = 16 * 64, NITEMS = I_W1 + I_AP + I_HP + I_OUT + I_Q;
    for (int it = gw; it < NITEMS; it += NGW) {
        int r = it;
        if (r < I_W1) { p0_transpose_item<true>(a.in[2], 1024, NIN, (bf16_t*)(ws + WS_W1T), a.in[1], 1023, scr, r, lane); continue; } r -= I_W1;
        if (r < I_AP) { p0_transpose_item<false>(a.in[6], 512, 1024, (bf16_t*)(ws + WS_WAPT), nullptr, 0, scr, r, lane); continue; } r -= I_AP;
        if (r < I_HP) { p0_transpose_item<false>(a.in[7], 512, 1024, (bf16_t*)(ws + WS_WHPT), a.in[5], 127, scr, r, lane); continue; } r -= I_HP;
        if (r < I_OUT) { p0_transpose_item<false>(a.in[8], 1024, 1024, (bf16_t*)(ws + WS_WOUTT), nullptr, 0, scr, r, lane); continue; } r -= I_OUT;
        p0_transpose_item<false>(a.in[10], 1024, 2048, (bf16_t*)(ws + WS_WQT), a.in[9], 1023, scr, r, lane);
    }
    for (int i = gt; i < 2 * 8 * 128 * 128 / 4; i += NGT) { const f32x4 v = ((const f32x4*)a.in[11])[i]; u32x2 o; o.x = pk_bf16(v[0], v[1]); o.y = pk_bf16(v[2], v[3]); ((u32x2*)(ws + WS_KEYS))[i] = o; }
    for (int it = gw; it < 2 * 16384; it += NGW) {
        const int isv = it >= 16384, e = it & 16383;
        const float* src = (isv ? a.in[13] : a.in[12]) + (size_t)e * 1024 + 16 * lane;
        f32x4 x[4]; float amax = 0.f;
#pragma unroll
        for (int i = 0; i < 4; ++i) { x[i] = *(const f32x4*)(src + 4 * i); if (!isv) x[i] *= *(const f32x4*)(a.in[9] + 16 * lane + 4 * i);
            amax = fmaxf(fmaxf(amax, fmaxf(fabsf(x[i][0]), fabsf(x[i][1]))), fmaxf(fabsf(x[i][2]), fabsf(x[i][3]))); }
#pragma unroll
        for (int o = 1; o < 64; o <<= 1) amax = fmaxf(amax, __shfl_xor(amax, o));
        const float qs = amax > 0.f ? 127.f / amax : 0.f; const int off = isv ? 128 : 0;
        u32x4 w;
#pragma unroll
        for (int i = 0; i < 4; ++i) { const int q0 = (int)rintf(x[i][0] * qs) + off, q1 = (int)rintf(x[i][1] * qs) + off, q2 = (int)rintf(x[i][2] * qs) + off, q3 = (int)rintf(x[i][3] * qs) + off;
            w[i] = (unsigned)(q0 & 255) | ((unsigned)(q1 & 255) << 8) | ((unsigned)(q2 & 255) << 16) | ((unsigned)(q3 & 255) << 24); }
        *(u32x4*)(ws + (isv ? WS_V8 : WS_U8) + (size_t)e * 1024 + 16 * lane) = w;
        if (lane == 0) ((float*)(ws + (isv ? WS_SV : WS_SU)))[e] = amax * (1.f / 127.f);
    }
    for (int row = gw; row < T; row += NGW) {
        const f32x4* xr = (const f32x4*)(a.in[0] + (size_t)row * DM) + lane; f32x4 v[4]; float s = 0.f;
#pragma unroll
        for (int j = 0; j < 4; ++j) { v[j] = xr[64 * j]; s += (v[j][0] * v[j][0] + v[j][1] * v[j][1]) + (v[j][2] * v[j][2] + v[j][3] * v[j][3]); }
        s = wave_sum(s);
        u32x2* o = (u32x2*)(ws + WS_XB + (size_t)row * DM * 2) + lane;
#pragma unroll
        for (int j = 0; j < 4; ++j) { u32x2 w; w.x = pk_bf16(v[j][0], v[j][1]); w.y = pk_bf16(v[j][2], v[j][3]); o[64 * j] = w; }
        if (lane == 0) ((float*)(ws + WS_RSTD1))[row] = __builtin_amdgcn_rsqf(s * (1.f / 1024.f) + EPS);
    }
    if (vb == 0) { const float l0 = a.in[4][tid], l1 = a.in[4][512 + tid]; ((float*)(ws + WS_LB))[tid] = 1.f / (1.f + __expf(l1 - l0)); }
}

DI void attn_task(const bf16_t* pa, const bf16_t* avT, const float* sinks, bf16_t* ya, int b, int qb, int h) {
    const int lane = threadIdx.x & 63, r = lane & 31, hh = lane >> 5, kvh = h >> 2;
    const size_t trow = (size_t)b * SEQ + qb * 32 + r;
    constexpr float LOG2E = 1.4426950408889634f;
    bf16x8 qf[4];
    { const bf16_t* qp = pa + trow * 768 + h * 64 + 8 * hh;
#pragma unroll
      for (int s = 0; s < 4; ++s) qf[s] = *(const bf16x8*)(qp + 16 * s); }
    const float slope2 = exp2f(-(float)(h + 1)) * LOG2E, sink2 = sinks[h] * LOG2E, qs = 0.125f * LOG2E;
    f32x16 S[5]; float m = sink2;
#pragma unroll
    for (int i = 0; i < 5; ++i) { const int kb = qb - 4 + i;
        if (kb >= 0) {
#pragma unroll
            for (int q = 0; q < 16; ++q) S[i][q] = 0.f;
            const bf16_t* kp = pa + ((size_t)b * SEQ + kb * 32 + r) * 768 + 512 + kvh * 64 + 8 * hh;
#pragma unroll
            for (int s = 0; s < 4; ++s) S[i] = MFMA32(*(const bf16x8*)(kp + 16 * s), qf[s], S[i]);
#pragma unroll
            for (int q = 0; q < 16; ++q) { const int dist = 32 * (4 - i) + r - crow(q, hh); float v = S[i][q] * qs - slope2 * (float)dist;
                if (i == 0) v = (dist <= 127) ? v : -1e30f;
                if (i == 4) v = (dist >= 0) ? v : -1e30f;
                S[i][q] = v; m = fmaxf(m, v); }
        } }
    m = fmaxf(m, __shfl_xor(m, 32));
    float l = 0.f;
#pragma unroll
    for (int i = 0; i < 5; ++i) if (qb - 4 + i >= 0) {
#pragma unroll
        for (int q = 0; q < 16; ++q) { const float p = __builtin_amdgcn_exp2f(S[i][q] - m); S[i][q] = p; l += p; } }
    l += __shfl_xor(l, 32); l += __builtin_amdgcn_exp2f(sink2 - m);
    f32x16 O[2];
#pragma unroll
    for (int q = 0; q < 16; ++q) { O[0][q] = 0.f; O[1][q] = 0.f; }
#pragma unroll
    for (int i = 0; i < 5; ++i) { const int kb = qb - 4 + i;
        if (kb >= 0) {
#pragma unroll
            for (int s2 = 0; s2 < 2; ++s2) {
                u32x4 pb; pb.x = pk_bf16(S[i][8 * s2], S[i][8 * s2 + 1]); pb.y = pk_bf16(S[i][8 * s2 + 2], S[i][8 * s2 + 3]); pb.z = pk_bf16(S[i][8 * s2 + 4], S[i][8 * s2 + 5]); pb.w = pk_bf16(S[i][8 * s2 + 6], S[i][8 * s2 + 7]);
#pragma unroll
                for (int dt = 0; dt < 2; ++dt) { const bf16_t* vp = avT + (size_t)((b * 2 + kvh) * 64 + 32 * dt + r) * SEQ + kb * 32 + 16 * s2 + 4 * hh;
                    const u32x2 v0 = *(const u32x2*)vp, v1 = *(const u32x2*)(vp + 8); u32x4 av; av.x = v0.x; av.y = v0.y; av.z = v1.x; av.w = v1.y;
                    O[dt] = MFMA32(__builtin_bit_cast(bf16x8, av), __builtin_bit_cast(bf16x8, pb), O[dt]); }
            } } }
    const float inv = 1.f / l;
#pragma unroll
    for (int dt = 0; dt < 2; ++dt)
#pragma unroll
        for (int g = 0; g < 4; ++g) { u32x2 w; w.x = pk_bf16(O[dt][4 * g] * inv, O[dt][4 * g + 1] * inv); w.y = pk_bf16(O[dt][4 * g + 2] * inv, O[dt][4 * g + 3] * inv);
            *(u32x2*)(ya + trow * 512 + h * 64 + 32 * dt + 8 * g + 4 * hh) = w; }
}

DI void hgrn_ds_unit(const bf16_t* kendT, const bf16_t* vT, bf16_t* dsT, int bh, int c) {
    const int lane = threadIdx.x & 63, wave = threadIdx.x >> 6, r = lane & 31, hh = lane >> 5, i = wave >> 1, j0 = 2 * (wave & 1);
    const bf16_t* ka = kendT + (size_t)(bh * 128 + 32 * i + r) * SEQ + c * 64 + 8 * hh;
    const bf16_t* vb0 = vT + (size_t)(bh * 128 + 32 * j0 + r) * SEQ + c * 64 + 8 * hh; const bf16_t* vb1 = vb0 + (size_t)32 * SEQ;
    f32x16 D0, D1;
#pragma unroll
    for (int q = 0; q < 16; ++q) { D0[q] = 0.f; D1[q] = 0.f; }
#pragma unroll
    for (int ks = 0; ks < 4; ++ks) { const bf16x8 a = *(const bf16x8*)(ka + 16 * ks), b0 = *(const bf16x8*)(vb0 + 16 * ks), b1 = *(const bf16x8*)(vb1 + 16 * ks); D0 = MFMA32(a, b0, D0); D1 = MFMA32(a, b1, D1); }
    const int unit = bh * 64 + c;
    bf16_t* o0 = dsT + (size_t)(unit * 128 + 32 * j0 + r) * 128 + 32 * i + 4 * hh; bf16_t* o1 = o0 + 32 * 128;
#pragma unroll
    for (int g = 0; g < 4; ++g) { u32x2 w; w.x = pk_bf16(D0[4 * g], D0[4 * g + 1]); w.y = pk_bf16(D0[4 * g + 2], D0[4 * g + 3]); *(u32x2*)(o0 + 8 * g) = w;
        u32x2 z; z.x = pk_bf16(D1[4 * g], D1[4 * g + 1]); z.y = pk_bf16(D1[4 * g + 2], D1[4 * g + 3]); *(u32x2*)(o1 + 8 * g) = z; }
}
DI void hgrn_scan(bf16_t* dsT, const float* dec, int vb, int G) {
    for (int idx = vb * NTHR + threadIdx.x; idx < 64 * 128 * 16; idx += G * NTHR) {
        const int dk8 = idx & 15, dv = (idx >> 4) & 127, bh = idx >> 11;
        float S[8];
#pragma unroll
        for (int q = 0; q < 8; ++q) S[q] = 0.f;
        for (int c0 = 0; c0 < 64; c0 += 8) {
            u32x4 ld[8]; f32x4 d0[8], d1[8];
#pragma unroll
            for (int i = 0; i < 8; ++i) { const int c = c0 + i; ld[i] = *(const u32x4*)(dsT + (size_t)((bh * 64 + c) * 128 + dv) * 128 + dk8 * 8);
                const float* dp = dec + (size_t)(bh * 64 + c) * 128 + dk8 * 8; d0[i] = *(const f32x4*)dp; d1[i] = *(const f32x4*)(dp + 4); }
#pragma unroll
            for (int i = 0; i < 8; ++i) { const int c = c0 + i;
                u32x4 w; w.x = pk_bf16(S[0], S[1]); w.y = pk_bf16(S[2], S[3]); w.z = pk_bf16(S[4], S[5]); w.w = pk_bf16(S[6], S[7]);
                *(u32x4*)(dsT + (size_t)((bh * 64 + c) * 128 + dv) * 128 + dk8 * 8) = w;
                S[0] = d0[i][0] * S[0] + bflo(ld[i].x); S[1] = d0[i][1] * S[1] + bfhi(ld[i].x); S[2] = d0[i][2] * S[2] + bflo(ld[i].y); S[3] = d0[i][3] * S[3] + bfhi(ld[i].y);
                S[4] = d1[i][0] * S[4] + bflo(ld[i].z); S[5] = d1[i][1] * S[5] + bfhi(ld[i].z); S[6] = d1[i][2] * S[6] + bflo(ld[i].w); S[7] = d1[i][3] * S[7] + bfhi(ld[i].w); }
        }
    }
}
DI void hgrn_out_unit(const bf16_t* qd, const bf16_t* kinv, const bf16_t* vT, const bf16_t* spT, const bf16_t* gs, bf16_t* yh, LAS unsigned char* lds, int bh, int c) {
    const int tid = threadIdx.x, lane = tid & 63, wave = tid >> 6, r = lane & 31, hh = lane >> 5, tb = wave >> 2, db = wave & 3, b = bh >> 2, h = bh & 3;
    const size_t Tb = (size_t)b * SEQ + c * 64;
    bf16x8 qf[8];
    { const bf16_t* qrow = qd + (Tb + 32 * tb + r) * 512 + h * 128 + 8 * hh;
#pragma unroll
      for (int ks = 0; ks < 8; ++ks) qf[ks] = *(const bf16x8*)(qrow + 16 * ks); }
    f32x16 Z;
#pragma unroll
    for (int q = 0; q < 16; ++q) Z[q] = 0.f;
    { const bf16_t* sp = spT + (size_t)((bh * 64 + c) * 128 + 32 * db + r) * 128 + 8 * hh;
#pragma unroll
      for (int ks = 0; ks < 8; ++ks) { const bf16x8 bs = *(const bf16x8*)(sp + 16 * ks); Z = MFMA32(qf[ks], bs, Z); } }
    const bf16_t* vrow = vT + (size_t)(bh * 128 + 32 * db + r) * SEQ + c * 64 + 4 * hh;
#pragma unroll
    for (int sb = 0; sb < 2; ++sb) if (sb <= tb) {
        f32x16 X;
#pragma unroll
        for (int q = 0; q < 16; ++q) X[q] = 0.f;
        const bf16_t* krow = kinv + (Tb + 32 * sb + r) * 512 + h * 128 + 8 * hh;
#pragma unroll
        for (int ks = 0; ks < 8; ++ks) { const bf16x8 ak = *(const bf16x8*)(krow + 16 * ks); X = MFMA32(ak, qf[ks], X); }
        if (sb == tb) {
#pragma unroll
            for (int q = 0; q < 16; ++q) if (crow(q, hh) > r) X[q] = 0.f;
        }
#pragma unroll
        for (int s2 = 0; s2 < 2; ++s2) {
            u32x4 pa_; pa_.x = pk_bf16(X[8 * s2], X[8 * s2 + 1]); pa_.y = pk_bf16(X[8 * s2 + 2], X[8 * s2 + 3]); pa_.z = pk_bf16(X[8 * s2 + 4], X[8 * s2 + 5]); pa_.w = pk_bf16(X[8 * s2 + 6], X[8 * s2 + 7]);
            const u32x2 v0 = *(const u32x2*)(vrow + 32 * sb + 16 * s2), v1 = *(const u32x2*)(vrow + 32 * sb + 16 * s2 + 8);
            u32x4 pb_; pb_.x = v0.x; pb_.y = v0.y; pb_.z = v1.x; pb_.w = v1.y;
            Z = MFMA32(__builtin_bit_cast(bf16x8, pa_), __builtin_bit_cast(bf16x8, pb_), Z);
        }
    }
    LAS float* zs = (LAS float*)lds;
#pragma unroll
    for (int q = 0; q < 16; ++q) zs[(32 * tb + crow(q, hh)) * 132 + 32 * db + r] = Z[q];
    __syncthreads();
    { const int tok = tid >> 3, d16 = (tid & 7) * 16; f32x4 o[4]; float ss = 0.f;
#pragma unroll
      for (int i = 0; i < 4; ++i) { o[i] = *(const LAS f32x4*)(zs + tok * 132 + d16 + 4 * i); ss += (o[i][0] * o[i][0] + o[i][1] * o[i][1]) + (o[i][2] * o[i][2] + o[i][3] * o[i][3]); }
      ss += __shfl_xor(ss, 1); ss += __shfl_xor(ss, 2); ss += __shfl_xor(ss, 4);
      const float rn = __builtin_amdgcn_rsqf(ss * (1.f / 128.f) + EPS);
      const size_t off = (Tb + tok) * 512 + h * 128 + d16; const u32x4 g0 = *(const u32x4*)(gs + off), g1 = *(const u32x4*)(gs + off + 8);
      u32x4 w0, w1;
      w0.x = pk_bf16(o[0][0] * rn * bflo(g0.x), o[0][1] * rn * bfhi(g0.x)); w0.y = pk_bf16(o[0][2] * rn * bflo(g0.y), o[0][3] * rn * bfhi(g0.y));
      w0.z = pk_bf16(o[1][0] * rn * bflo(g0.z), o[1][1] * rn * bfhi(g0.z)); w0.w = pk_bf16(o[1][2] * rn * bflo(g0.w), o[1][3] * rn * bfhi(g0.w));
      w1.x = pk_bf16(o[2][0] * rn * bflo(g1.x), o[2][1] * rn * bfhi(g1.x)); w1.y = pk_bf16(o[2][2] * rn * bflo(g1.y), o[2][3] * rn * bfhi(g1.y));
      w1.z = pk_bf16(o[3][0] * rn * bflo(g1.z), o[3][1] * rn * bfhi(g1.z)); w1.w = pk_bf16(o[3][2] * rn * bflo(g1.w), o[3][3] * rn * bfhi(g1.w));
      *(u32x4*)(yh + off) = w0; *(u32x4*)(yh + off + 8) = w1; }
    __syncthreads();
}

DI unsigned f2ord(float f) { const unsigned b = __float_as_uint(f); return b ^ ((unsigned)((int)b >> 31) | 0x80000000u); }
DI float ord2f(unsigned k) { const unsigned b = (k & 0x80000000u) ? (k ^ 0x80000000u) : ~k; return __uint_as_float(b); }
DI void ce_desc(unsigned& a, unsigned& b) { const unsigned hi = a > b ? a : b, lo = a > b ? b : a; a = hi; b = lo; }
DI void sort16_desc(unsigned (&a)[16]) {
#pragma unroll
    for (int k = 2; k <= 16; k <<= 1)
#pragma unroll
        for (int j = k >> 1; j > 0; j >>= 1)
#pragma unroll
            for (int i = 0; i < 16; ++i) { const int l = i ^ j; if (l > i) { if ((i & k) == 0) ce_desc(a[i], a[l]); else ce_desc(a[l], a[i]); } }
}
DI void merge16_desc(unsigned (&a)[16], const unsigned (&b)[16]) {
#pragma unroll
    for (int i = 0; i < 16; ++i) a[i] = a[i] > b[15 - i] ? a[i] : b[15 - i];
#pragma unroll
    for (int j = 8; j > 0; j >>= 1)
#pragma unroll
        for (int i = 0; i < 16; ++i) { const int l = i ^ j; if (l > i) ce_desc(a[i], a[l]); }
}
#define TK_INS(L, x) do { unsigned t_ = (x); _Pragma("unroll") for (int j_ = 0; j_ < 16; ++j_) { const unsigned hi_ = L[j_] > t_ ? L[j_] : t_; t_ = L[j_] > t_ ? t_ : L[j_]; L[j_] = hi_; } } while (0)

DI void topk_unit(const bf16_t* qp, const bf16_t* keysb, unsigned short* gidx, float* ggate, LAS unsigned char* lds, int tile, int hg) {
    const int tid = threadIdx.x, lane = tid & 63, wave = tid >> 6, p = wave & 1, tsub = wave >> 1, r = lane & 31, hh = lane >> 5;
    const int tok0 = tile * 128 + tsub * 32;
    LAS unsigned* tk = (LAS unsigned*)lds;
#pragma unroll 1
    for (int hl = 0; hl < 4; ++hl) {
        const int h = hg * 4 + hl;
        f32x16 acc[4];
#pragma unroll
        for (int kb = 0; kb < 4; ++kb)
#pragma unroll
            for (int i = 0; i < 16; ++i) acc[kb][i] = 0.f;
        const bf16_t* qrow = qp + (size_t)(tok0 + r) * 2048 + h * 256 + p * 128 + 8 * hh;
        const bf16_t* kbase = keysb + ((size_t)(p * 8 + h) * 128 + r) * 128 + 8 * hh;
#pragma unroll
        for (int s = 0; s < 8; ++s) { const bf16x8 bq = *(const bf16x8*)(qrow + 16 * s);
#pragma unroll
            for (int kb = 0; kb < 4; ++kb) { const bf16x8 ak = *(const bf16x8*)(kbase + (size_t)kb * 32 * 128 + 16 * s); acc[kb] = MFMA32(ak, bq, acc[kb]); } }
        unsigned A0[16], A1[16], A2[16], A3[16];
#pragma unroll
        for (int i = 0; i < 16; ++i) { const unsigned ki = (unsigned)(crow(i, hh));
            A0[i] = (f2ord(acc[0][i]) & ~127u) | ki; A1[i] = (f2ord(acc[1][i]) & ~127u) | (32u + ki); A2[i] = (f2ord(acc[2][i]) & ~127u) | (64u + ki); A3[i] = (f2ord(acc[3][i]) & ~127u) | (96u + ki); }
        sort16_desc(A0); sort16_desc(A1); sort16_desc(A2); sort16_desc(A3);
        merge16_desc(A0, A1); merge16_desc(A2, A3); merge16_desc(A0, A2);
#pragma unroll
        for (int j = 0; j < 16; ++j) A1[j] = __shfl_xor(A0[j], 32);
        merge16_desc(A0, A1);
        if (hh == 0) { LAS u32x4* dst = (LAS u32x4*)(tk + (((hl * 2 + p) * 128 + tsub * 32 + r) * 16));
#pragma unroll
            for (int c = 0; c < 4; ++c) { u32x4 w = {A0[4 * c], A0[4 * c + 1], A0[4 * c + 2], A0[4 * c + 3]}; dst[c] = w; } }
    }
    __syncthreads();
    {
        const int tok = tid & 127, hl = tid >> 7, h = hg * 4 + hl;
        const LAS unsigned* t1 = tk + ((hl * 2 + 0) * 128 + tok) * 16; const LAS unsigned* t2 = tk + ((hl * 2 + 1) * 128 + tok) * 16;
        float v1[16], v2[16];
        { const LAS u32x4* s1 = (const LAS u32x4*)t1; const LAS u32x4* s2 = (const LAS u32x4*)t2;
#pragma unroll
          for (int c = 0; c < 4; ++c) { const u32x4 a = s1[c], b = s2[c];
              v1[4 * c] = ord2f(a.x & ~127u); v1[4 * c + 1] = ord2f(a.y & ~127u); v1[4 * c + 2] = ord2f(a.z & ~127u); v1[4 * c + 3] = ord2f(a.w & ~127u);
              v2[4 * c] = ord2f(b.x & ~127u); v2[4 * c + 1] = ord2f(b.y & ~127u); v2[4 * c + 2] = ord2f(b.z & ~127u); v2[4 * c + 3] = ord2f(b.w & ~127u); } }
#define CKEY(i, j) ((f2ord(v1[i] + v2[j]) & ~255u) | (unsigned)((i) * 16 + (j)))
        unsigned C[16], D[16], E[16];
#pragma unroll
        for (int j = 0; j < 16; ++j) C[j] = CKEY(0, j);
#pragma unroll
        for (int j = 0; j < 8; ++j) D[j] = CKEY(1, j);
#pragma unroll
        for (int j = 0; j < 5; ++j) D[8 + j] = CKEY(2, j);
#pragma unroll
        for (int j = 0; j < 3; ++j) D[13 + j] = CKEY(4, j);
#pragma unroll
        for (int j = 0; j < 4; ++j) E[j] = CKEY(3, j);
        E[4] = CKEY(5, 0); E[5] = CKEY(5, 1); E[6] = CKEY(6, 0); E[7] = CKEY(6, 1); E[8] = CKEY(7, 0); E[9] = CKEY(7, 1);
        E[10] = CKEY(8, 0); E[11] = CKEY(9, 0); E[12] = CKEY(10, 0); E[13] = CKEY(11, 0); E[14] = CKEY(12, 0); E[15] = CKEY(13, 0);
        sort16_desc(D); sort16_desc(E);
        TK_INS(E, CKEY(14, 0)); TK_INS(E, CKEY(15, 0));
#undef CKEY
        merge16_desc(C, D); merge16_desc(C, E);
        float sc[16]; unsigned ei[16]; float mx = -1e30f;
#pragma unroll
        for (int q = 0; q < 16; ++q) { const unsigned ij = C[q] & 255u; const unsigned a = t1[ij >> 4], b = t2[ij & 15u];
            sc[q] = ord2f(a & ~127u) + ord2f(b & ~127u); ei[q] = (a & 127u) * 128u + (b & 127u); mx = fmaxf(mx, sc[q]); }
        float sum = 0.f;
#pragma unroll
        for (int q = 0; q < 16; ++q) { sc[q] = __expf(sc[q] - mx); sum += sc[q]; }
        const float inv = 1.f / sum; const size_t o = (size_t)(tile * 128 + tok) * 128 + h * 16;
        u32x4 w0, w1;
        w0.x = ei[0] | (ei[1] << 16); w0.y = ei[2] | (ei[3] << 16); w0.z = ei[4] | (ei[5] << 16); w0.w = ei[6] | (ei[7] << 16);
        w1.x = ei[8] | (ei[9] << 16); w1.y = ei[10] | (ei[11] << 16); w1.z = ei[12] | (ei[13] << 16); w1.w = ei[14] | (ei[15] << 16);
        *(u32x4*)(gidx + o) = w0; *(u32x4*)(gidx + o + 8) = w1;
#pragma unroll
        for (int c = 0; c < 4; ++c) *(f32x4*)(ggate + o + 4 * c) = (f32x4){sc[4 * c] * inv, sc[4 * c + 1] * inv, sc[4 * c + 2] * inv, sc[4 * c + 3] * inv};
    }
    __syncthreads();
}

DI float gelu_erf(float x) { return 0.5f * x * (1.f + erff(x * 0.70710678118654752f)); }
DI int dot16(u32x4 w, const int (&h)[4]) { int c = __builtin_amdgcn_sdot4((int)w.x, h[0], 0, false); c = __builtin_amdgcn_sdot4((int)w.y, h[1], c, false); c = __builtin_amdgcn_sdot4((int)w.z, h[2], c, false); return __builtin_amdgcn_sdot4((int)w.w, h[3], c, false); }
#define V8_FMA(acc4, word, we) do { acc4[0] += (we) * (float)((word) & 255u); acc4[1] += (we) * (float)(((word) >> 8) & 255u); acc4[2] += (we) * (float)(((word) >> 16) & 255u); acc4[3] += (we) * (float)((word) >> 24); } while (0)

DI void expert_token(const bf16_t* x2row, const float* ssq, const unsigned char* u8, const unsigned char* v8, const float* su, const float* sv, const unsigned short* gidx, const float* ggate, const float* gf, float* outrow, int lane) {
    f32x4 x[4]; float amax = 0.f;
#pragma unroll
    for (int i = 0; i < 4; ++i) { const u32x2 w_ = *(const u32x2*)(x2row + 16 * lane + 4 * i); x[i] = (f32x4){bflo(w_.x), bfhi(w_.x), bflo(w_.y), bfhi(w_.y)}; amax = fmaxf(fmaxf(amax, fmaxf(fabsf(x[i][0]), fabsf(x[i][1]))), fmaxf(fabsf(x[i][2]), fabsf(x[i][3]))); }
    float ss = (lane < 16) ? ssq[lane] : 0.f; ss = wave_sum(ss);
    const float rstd2 = __builtin_amdgcn_rsqf(ss * (1.f / 1024.f) + EPS);
#pragma unroll
    for (int o = 1; o < 64; o <<= 1) amax = fmaxf(amax, __shfl_xor(amax, o));
    amax *= rstd2;
    const float qs = amax > 0.f ? 127.f / amax : 0.f, sh = amax * (1.f / 127.f), xq = rstd2 * qs;
    int hq[4];
#pragma unroll
    for (int i = 0; i < 4; ++i) { const int q0 = (int)rintf(x[i][0] * xq), q1 = (int)rintf(x[i][1] * xq), q2 = (int)rintf(x[i][2] * xq), q3 = (int)rintf(x[i][3] * xq);
        hq[i] = (int)((unsigned)(q0 & 255) | ((unsigned)(q1 & 255) << 8) | ((unsigned)(q2 & 255) << 16) | ((unsigned)(q3 & 255) << 24)); }
    const int id0 = gidx[lane], id1 = gidx[64 + lane]; const float g0 = ggate[lane], g1 = ggate[64 + lane];
    f32x4 o[4]; float wsum = 0.f;
#pragma unroll
    for (int i = 0; i < 4; ++i) o[i] = (f32x4){0.f, 0.f, 0.f, 0.f};
#pragma unroll 1
    for (int bt = 0; bt < 16; ++bt) {
        const int idsel = (bt < 8) ? id0 : id1; const float gsel = (bt < 8) ? g0 : g1; const int lb = (bt & 7) * 8;
        u32x4 ur[8], vr[8];
#pragma unroll
        for (int e = 0; e < 8; ++e) { const int idx = __builtin_amdgcn_readlane(idsel, lb + e); ur[e] = *(const u32x4*)(u8 + (size_t)idx * 1024 + 16 * lane); }
#pragma unroll
        for (int e = 0; e < 8; ++e) { const int idx = __builtin_amdgcn_readlane(idsel, lb + e); vr[e] = *(const u32x4*)(v8 + (size_t)idx * 1024 + 16 * lane); }
        const int myidx = __shfl(idsel, lb + (lane >> 3)); const float mysu = su[myidx], mysv = sv[myidx], gate = __shfl(gsel, lb + (lane >> 3));
        int pr[8];
#pragma unroll
        for (int e = 0; e < 8; ++e) pr[e] = dot16(ur[e], hq);
        int q4[4], q2[2], q1;
        { const bool up_ = (lane & 32) != 0;
#pragma unroll
          for (int i = 0; i < 4; ++i) { const int keep = up_ ? pr[i + 4] : pr[i], send = up_ ? pr[i] : pr[i + 4]; q4[i] = keep + __shfl_xor(send, 32); } }
        { const bool up_ = (lane & 16) != 0;
#pragma unroll
          for (int i = 0; i < 2; ++i) { const int keep = up_ ? q4[i + 2] : q4[i], send = up_ ? q4[i] : q4[i + 2]; q2[i] = keep + __shfl_xor(send, 16); } }
        { const bool up_ = (lane & 8) != 0; const int keep = up_ ? q2[1] : q2[0], send = up_ ? q2[0] : q2[1]; q1 = keep + __shfl_xor(send, 8); }
        q1 += __shfl_xor(q1, 4); q1 += __shfl_xor(q1, 2); q1 += __shfl_xor(q1, 1);
        const float act = (float)q1 * (mysu * sh);
        const float w = gelu_erf(act) * gate * mysv;
#pragma unroll
        for (int e = 0; e < 8; ++e) { const float we = __int_as_float(__builtin_amdgcn_readlane(__float_as_int(w), 8 * e)); wsum += we;
            V8_FMA(o[0], vr[e].x, we); V8_FMA(o[1], vr[e].y, we); V8_FMA(o[2], vr[e].z, we); V8_FMA(o[3], vr[e].w, we); }
    }
    const float corr = 128.f * wsum; float s3 = 0.f;
#pragma unroll
    for (int i = 0; i < 4; ++i) { x[i] += o[i] - corr; s3 += (x[i][0] * x[i][0] + x[i][1] * x[i][1]) + (x[i][2] * x[i][2] + x[i][3] * x[i][3]); }
    s3 = wave_sum(s3); const float r3 = __builtin_amdgcn_rsqf(s3 * (1.f / 1024.f) + EPS);
#pragma unroll
    for (int i = 0; i < 4; ++i) *(f32x4*)(outrow + 16 * lane + 4 * i) = x[i] * r3 * *(const f32x4*)(gf + 16 * lane + 4 * i);
}

#define XB_TMO      128
#define XB_XCNT(j)  (256  + 64 * (j))
#define XB_XSUB(j)  (1280 + 64 * (j))
#define XB_XGEN(j)  (2304 + 64 * (j))
#define XB_TOP      3328
#define XB_TOPGEN   3392
#define XCD_BAR_WORDS 3456
#define XB_SPIN_CAP (1u << 18)

__device__ __forceinline__ unsigned xb_ld(unsigned* p)              { return __hip_atomic_load(p, __ATOMIC_RELAXED, __HIP_MEMORY_SCOPE_AGENT); }
__device__ __forceinline__ unsigned xb_add(unsigned* p, unsigned v) { return __hip_atomic_fetch_add(p, v, __ATOMIC_RELAXED, __HIP_MEMORY_SCOPE_AGENT); }
__device__ __forceinline__ unsigned xb_xcc_id() { return (unsigned)__builtin_amdgcn_s_getreg((3 << 11) | 20) & 0xFu; }
#define XB_SPIN(cond, bar) do { unsigned _sp = 0; while (cond) { __builtin_amdgcn_s_sleep(1); \
    if ((++_sp & 255u) == 0u) { if (xb_ld(&(bar)[XB_TMO])) break; if (_sp > XB_SPIN_CAP) { atomicAdd(&(bar)[XB_TMO], 1u); break; } } } } while (0)

struct XcdBarrier {
    unsigned* bar; unsigned x;
    volatile __attribute__((address_space(3))) unsigned* st;
};

__device__ __forceinline__ XcdBarrier xcd_barrier_post(unsigned* bar, volatile __attribute__((address_space(3))) unsigned* st) {
    XcdBarrier b; b.bar = bar; b.x = xb_xcc_id(); b.st = st;
    if (threadIdx.x == 0) (void)xb_add(&bar[XB_XCNT(b.x)], 1u);
    return b;
}
__device__ __forceinline__ void xcd_barrier_complete(unsigned* bar, unsigned x, unsigned& nloc, unsigned& nx) {
    const unsigned G = gridDim.x * gridDim.y * gridDim.z;
    unsigned sum, cnt, mine, sp = 0u;
    for (;;) {
        sum = 0u; cnt = 0u; mine = 0u;
#pragma unroll
        for (unsigned j = 0; j < 16; ++j) { const unsigned c = xb_ld(&bar[XB_XCNT(j)]); sum += c; cnt += (c > 0u) ? 1u : 0u; mine = (j == x) ? c : mine; }
        if (sum == G) break;
        __builtin_amdgcn_s_sleep(1);
        if ((++sp & 255u) == 0u) { if (xb_ld(&bar[XB_TMO])) break; if (sp > XB_SPIN_CAP) { atomicAdd(&bar[XB_TMO], 1u); break; } }
    }
    nloc = mine > 0u ? mine : 1u; nx = cnt > 0u ? cnt : 1u;
}

__device__ __forceinline__ void xcd_barrier(const XcdBarrier& b) {
    asm volatile("s_waitcnt vmcnt(0)" ::: "memory");
    __syncthreads();
    if (threadIdx.x == 0) {
        unsigned* bar = b.bar;
        __builtin_amdgcn_s_waitcnt(0);
        unsigned nloc = b.st[0], nx = b.st[1];
        if (nloc == 0u) { xcd_barrier_complete(bar, b.x, nloc, nx); b.st[0] = nloc; b.st[1] = nx; }
        const unsigned old = xb_add(&bar[XB_XSUB(b.x)], 1u);
        const unsigned gen = old / nloc;
        if (old + 1u == (gen + 1u) * nloc) {
            __builtin_amdgcn_fence(__ATOMIC_RELEASE, "agent");
            asm volatile("s_waitcnt vmcnt(0)" ::: "memory");
            const unsigned og = xb_add(&bar[XB_TOP], 1u);
            const unsigned tg = og / nx;
            if (og + 1u == (tg + 1u) * nx) xb_add(&bar[XB_TOPGEN], 1u);
            else XB_SPIN(xb_ld(&bar[XB_TOPGEN]) == tg, bar);
            __builtin_amdgcn_fence(__ATOMIC_ACQUIRE, "agent");
            xb_add(&bar[XB_XGEN(b.x)], 1u);
            asm volatile("s_waitcnt vmcnt(0)" ::: "memory");
        } else {
            XB_SPIN(xb_ld(&bar[XB_XGEN(b.x)]) == gen, bar);
            __builtin_amdgcn_fence(__ATOMIC_ACQUIRE, "agent");
            asm volatile("s_waitcnt vmcnt(0)" ::: "memory");
        }
    }
    __syncthreads();
}

constexpr int N_PHASES = 10;
__global__ void __launch_bounds__(NTHR, 2) mk_fwd(Args a) {
    extern __shared__ __attribute__((aligned(16))) unsigned char lds_raw[];
    LAS unsigned char* lds = (LAS unsigned char*)lds_raw;
    cg::grid_group grid = cg::this_grid();
    const int G = gridDim.x, vb = blockIdx.x, tid = threadIdx.x, lane = tid & 63, wave = tid >> 6;
    unsigned char* ws = a.ws;
    const int lo = a.ph_lo, hi = a.ph_hi;
    volatile LAS unsigned* MISC = (volatile LAS unsigned*)(lds + LDS_BYTES - 64);
    if (tid < 16) MISC[tid] = 0u;
    __syncthreads();
    const XcdBarrier bar = xcd_barrier_post((unsigned*)(ws + 4096) + lo * XCD_BAR_WORDS, MISC);
#ifndef PHASE_MASK
#define PHASE_MASK 0xFFFF
#endif
#define IN(k) (((PHASE_MASK >> (k)) & 1) && lo <= (k) && (k) < hi)
#ifndef REPEAT_MASK
#define REPEAT_MASK 0
#endif
#define REP(k) for (int rep_ = 0; rep_ < (((REPEAT_MASK) >> (k)) & 1) + 1; ++rep_)
#define SEAM(k) do { if (IN(k) && IN((k) + 1)) { if ((k) == 0) grid.sync(); else xcd_barrier(bar); } } while (0)
    REP(0) if (IN(0)) p0_prologue(a, lds, vb, G);
    SEAM(0);
    REP(1) if (IN(1)) { pg8::Gemm g{(const bf16_t*)(ws + WS_XB), (const bf16_t*)(ws + WS_W1T), T, NIN, 1024}; pg8::StaticOrder S; S.init(T, NIN, G, vb);
        pg8::Epi1 E{(const float*)(ws + WS_RSTD1), (bf16_t*)(ws + WS_PA), (bf16_t*)(ws + WS_GG), (bf16_t*)(ws + WS_QD), (bf16_t*)(ws + WS_KINV), (bf16_t*)(ws + WS_KENDT), (bf16_t*)(ws + WS_VT), (bf16_t*)(ws + WS_GS),
                    (float*)(ws + WS_DEC), (const float*)(ws + WS_LB), (bf16_t*)(ws + WS_AVT)};
        pg8::gemm_phase<pg8::Epi1, pg8::StaticOrder, true, true>(lds, g, S, E); }
    SEAM(1);
    REP(2) if (IN(2)) {
        for (int u = vb; u < 64 * 64; u += G) hgrn_ds_unit((const bf16_t*)(ws + WS_KENDT), (const bf16_t*)(ws + WS_VT), (bf16_t*)(ws + WS_XB), u >> 6, u & 63);
        { const int hw = __builtin_amdgcn_readfirstlane(wave);
          for (int u = vb; u < BATCH * (SEQ / 32); u += G) attn_task((const bf16_t*)(ws + WS_PA), (const bf16_t*)(ws + WS_AVT), a.in[3], (bf16_t*)(ws + WS_YA), u >> 7, u & 127, hw); }
    }
    SEAM(2);
    REP(3) if (IN(3)) hgrn_scan((bf16_t*)(ws + WS_XB), (const float*)(ws + WS_DEC), vb, G);
    SEAM(3);
    REP(4) if (IN(4)) for (int u = vb; u < 64 * 64; u += G)
        hgrn_out_unit((const bf16_t*)(ws + WS_QD), (const bf16_t*)(ws + WS_KINV), (const bf16_t*)(ws + WS_VT), (const bf16_t*)(ws + WS_XB), (const bf16_t*)(ws + WS_GS), (bf16_t*)(ws + WS_YH), lds, u >> 6, u & 63);
    SEAM(4);
    REP(5) if (IN(5)) {
        { pg8::Gemm g{(const bf16_t*)(ws + WS_YA), (const bf16_t*)(ws + WS_WAPT), T, 1024, 512}; pg8::StaticOrder S; S.init(T, 1024, G, vb);
          pg8::EpiMerge<false> E{(bf16_t*)(ws + WS_XB), (const bf16_t*)(ws + WS_GG)};
          pg8::gemm_phase<pg8::EpiMerge<false>, pg8::StaticOrder, true, true>(lds, g, S, E); }
        __syncthreads();
        { pg8::Gemm g{(const bf16_t*)(ws + WS_YH), (const bf16_t*)(ws + WS_WHPT), T, 1024, 512}; pg8::StaticOrder S; S.init(T, 1024, G, vb);
          pg8::EpiMerge<true> E{(bf16_t*)(ws + WS_XB), (const bf16_t*)(ws + WS_GG) + 1024};
          pg8::gemm_phase<pg8::EpiMerge<true>, pg8::StaticOrder, true, true>(lds, g, S, E); }
    }
    SEAM(5);
    REP(6) if (IN(6)) { pg8::Gemm g{(const bf16_t*)(ws + WS_XB), (const bf16_t*)(ws + WS_WOUTT), T, 1024, 1024}; pg8::StaticOrder S; S.init(T, 1024, G, vb);
        pg8::EpiX2 E{a.in[0], (bf16_t*)(ws + WS_X2B), (float*)(ws + WS_SSQ2)};
        pg8::gemm_phase<pg8::EpiX2, pg8::StaticOrder, true, true>(lds, g, S, E); }
    SEAM(6);
    REP(7) if (IN(7)) { pg8::Gemm g{(const bf16_t*)(ws + WS_X2B), (const bf16_t*)(ws + WS_WQT), T, 2048, 1024}; pg8::StaticOrder S; S.init(T, 2048, G, vb);
        pg8::EpiQp E{(bf16_t*)(ws + WS_QP), (const float*)(ws + WS_SSQ2)};
        pg8::gemm_phase<pg8::EpiQp, pg8::StaticOrder, true, true>(lds, g, S, E); }
    SEAM(7);
    REP(8) if (IN(8)) for (int u = vb; u < (T / 128) * 2; u += G) topk_unit((const bf16_t*)(ws + WS_QP), (const bf16_t*)(ws + WS_KEYS), (unsigned short*)(ws + WS_GIDX), (float*)(ws + WS_GGATE), lds, u >> 1, u & 1);
    SEAM(8);
    REP(9) if (IN(9)) for (int tok = vb * 8 + wave; tok < T; tok += G * 8)
        expert_token((const bf16_t*)(ws + WS_X2B) + (size_t)tok * DM, (const float*)(ws + WS_SSQ2) + (size_t)tok * 16, (const unsigned char*)(ws + WS_U8), (const unsigned char*)(ws + WS_V8), (const float*)(ws + WS_SU), (const float*)(ws + WS_SV),
                     (const unsigned short*)(ws + WS_GIDX) + (size_t)tok * 128, (const float*)(ws + WS_GGATE) + (size_t)tok * 128, a.in[14], a.out + (size_t)tok * DM, lane);
#undef IN
#undef SEAM
}

extern "C" void kernel_launch(void* const* d_in, const int* in_sizes, int n_in, void* d_out, int out_size, void* d_ws, size_t ws_size, hipStream_t stream) {
    static int grid = 0;
    if (grid == 0) {
        if (n_in != 15 || in_sizes[0] != T * DM || out_size != T * DM || ws_size < WS_END) { fprintf(stderr, "kernel_launch: unexpected shapes (n_in %d, in0 %d, out %d, ws %zu)\n", n_in, n_in > 0 ? in_sizes[0] : -1, out_size, ws_size); grid = -1; return; }
        int dev = 0, cus = 0, per_cu = 0;
        hipGetDevice(&dev); hipDeviceGetAttribute(&cus, hipDeviceAttributeMultiprocessorCount, dev);
        if (hipFuncSetAttribute((const void*)mk_fwd, hipFuncAttributeMaxDynamicSharedMemorySize, LDS_BYTES) != hipSuccess) { fprintf(stderr, "kernel_launch: hipFuncSetAttribute failed\n"); grid = -1; return; }
        if (hipOccupancyMaxActiveBlocksPerMultiprocessor(&per_cu, (const void*)mk_fwd, NTHR, LDS_BYTES) != hipSuccess || per_cu < 1) { fprintf(stderr, "kernel_launch: occupancy query says %d blocks per CU\n", per_cu); per_cu = 1; }
        (void)hipGetLastError();
        grid = cus;
    }
    if (grid < 0) return;
    if (hipMemsetAsync(d_ws, 0, 256 * 1024, stream) != hipSuccess) { fprintf(stderr, "kernel_launch: hipMemsetAsync failed\n"); return; }
    Args a{};
    for (int i = 0; i < 15; ++i) a.in[i] = (const float*)d_in[i];
    a.out = (float*)d_out; a.ws = (unsigned char*)d_ws;
#if MK_FUSED
    a.ph_lo = 0; a.ph_hi = N_PHASES;
    { void* args[] = {&a}; hipError_t e = hipLaunchCooperativeKernel((const void*)mk_fwd, dim3(grid), dim3(NTHR), args, LDS_BYTES, stream);
      if (e != hipSuccess) fprintf(stderr, "kernel_launch: cooperative launch failed: %s (grid %d)\n", hipGetErrorString(e), grid); }
#else
    for (int p = 0; p < N_PHASES; ++p) { a.ph_lo = p; a.ph_hi = p + 1; void* args[] = {&a};
        hipError_t e = hipLaunchCooperativeKernel((const void*)mk_fwd, dim3(grid), dim3(NTHR), args, LDS_BYTES, stream);
        if (e != hipSuccess) { fprintf(stderr, "kernel_launch: launch of phase %d failed: %s (grid %d)\n", p, hipGetErrorString(e), grid); break; } }
#endif
}
```

```cpp
#include <hip/hip_runtime.h>
#include <hip/hip_cooperative_groups.h>
#include <cstdio>
#include <cstdint>
namespace cg = cooperative_groups;
namespace pg8 {
#define PG8_LAS __attribute__((address_space(3)))
typedef unsigned short bf16_t;
typedef short bf16x8 __attribute__((ext_vector_type(8)));
typedef float f32x4 __attribute__((ext_vector_type(4)));
typedef unsigned u32x4 __attribute__((ext_vector_type(4)));
constexpr int BM = 256, BK = 64, HALF = 128, HTB = HALF * BK * 2  , STAGE_BYTES = 8 * HTB, NXCD = 8, WGM = 8;

__host__ __device__ __forceinline__ int lds_byte(int r, int c) { const int st = (r >> 4) * 2 + (c >> 5), rr = r & 15, cc = c & 31, ob = rr * 64 + cc * 2; return st * 1024 + (ob ^ (((ob >> 9) & 1) << 5)); }
__host__ __device__ __forceinline__ void stage_rc(int b, int& R, int& C) { const int st = b / 1024, sb = b % 1024, swz = sb ^ (((sb >> 9) & 1) << 5); R = (st >> 1) * 16 + swz / 64; C = (st & 1) * 32 + (swz % 64) / 2; }
__host__ __device__ __forceinline__ int perm32(int rho) { const int n = rho >> 4, i = rho & 15; return 8 * (i >> 2) + 4 * n + (i & 3); }

struct Unit { int pm, pn; };
struct Gemm { const bf16_t* A; const bf16_t* Bt; int M, N, K; };

struct StaticOrder {
    int nM, nN, nwg, G, c;
    __host__ __device__ void init(int M, int N, int G_, int c_) { nM = M / BM; nN = N / BM; nwg = nM * nN; G = G_; c = c_; }
    __host__ __device__ bool next(int i, Unit& u) const {
        const long L = (long)i * G + c; if (L >= nwg) return false;
        int wgid = (int)L; { const int q = nwg / NXCD, r = nwg % NXCD, xcd = wgid % NXCD, off = wgid / NXCD; wgid = (xcd < r ? xcd * (q + 1) : r * (q + 1) + (xcd - r) * q) + off; }
        const int nig = WGM * nN, gid = wgid / nig, fm = gid * WGM, gsz = (nM - fm) < WGM ? (nM - fm) : WGM;
        u.pm = fm + ((wgid % nig) % gsz); u.pn = (wgid % nig) / gsz; return true;
    }
    __device__ __forceinline__ void a_ready(const Unit&) const {}
    __device__ __forceinline__ void done(const Unit&) const {}
};

__device__ __forceinline__ unsigned cvt_pk_bf16(float lo, float hi) { unsigned r; asm volatile("v_cvt_pk_bf16_f32 %0, %1, %2" : "=v"(r) : "v"(lo), "v"(hi)); return r; }

template <class Epi, class Sched, bool ALIGN_EPI = false, bool SP2 = false>
__device__ __forceinline__ void gemm_phase(PG8_LAS unsigned char* lds, const Gemm g, const Sched& S, const Epi& E) {
    int tid_ = threadIdx.x; asm volatile("" : "+v"(tid_));
    const int tid = tid_, wid = __builtin_amdgcn_readfirstlane(tid >> 6), lane = tid & 63, wr = wid >> 2, wc = wid & 3, fr = lane & 15, fq = lane >> 4;
    const int K = g.K, nt = K / BK;
    unsigned voffA[2], voffB[2];
#pragma unroll
    for (int i = 0; i < 2; ++i) { int R, C; stage_rc(tid * 16 + i * 8192, R, C); const int Rb = Epi::PERM ? ((R & ~31) + perm32(R & 31)) : R;
        voffA[i] = (unsigned)(R * K + C) * 2u; voffB[i] = (unsigned)(Rb * K + C) * 2u; }
    const size_t kstep = (size_t)(BK * 2);
    const size_t hstep = (size_t)HALF * K * 2;
    const size_t tstep = 2 * hstep;
    const unsigned ldsw = (unsigned)wid * 1024u;
    const int aoff = lds_byte(wr * 64 + fr, fq * 8), boff = lds_byte(wc * 32 + fr, fq * 8);
#define PG8_SA(b, h) (((b) * 2 + (h)) * HTB)
#define PG8_SB(b, h) ((4 + (b) * 2 + (h)) * HTB)
#define PG8_STAGE(bufoff, gbase, voff) do { _Pragma("unroll") for (int _i = 0; _i < 2; ++_i) \
        __builtin_amdgcn_global_load_lds((const unsigned*)((const char*)(gbase) + (voff)[_i]), (PG8_LAS unsigned*)(lds + (bufoff) + ldsw + _i * 8192), 16, 0, 0); } while (0)
#define PG8_LDA(dst, b, h) do { _Pragma("unroll") for (int m = 0; m < 4; ++m) _Pragma("unroll") for (int k = 0; k < 2; ++k) dst[m][k] = *(const PG8_LAS bf16x8*)(lds + PG8_SA(b, h) + aoff + m * 2048 + k * 1024); } while (0)
#define PG8_LDB(dst, b, h) do { _Pragma("unroll") for (int n = 0; n < 2; ++n) _Pragma("unroll") for (int k = 0; k < 2; ++k) dst[n][k] = *(const PG8_LAS bf16x8*)(lds + PG8_SB(b, h) + boff + n * 2048 + k * 1024); } while (0)
#define PG8_MMA(ai, bj, At, Bt) do { __builtin_amdgcn_s_setprio(1); _Pragma("unroll") for (int m = 0; m < 4; ++m) _Pragma("unroll") for (int n = 0; n < 2; ++n) _Pragma("unroll") for (int k = 0; k < 2; ++k) \
        acc[ai][bj][m][n] = __builtin_amdgcn_mfma_f32_16x16x32_bf16(Bt[n][k], At[m][k], acc[ai][bj][m][n], 0, 0, 0); __builtin_amdgcn_s_setprio(0); } while (0)
#define PG8_WAIT_V(n) asm volatile("s_waitcnt vmcnt(" #n ")" ::: "memory")
#define PG8_WAIT_L(n) asm volatile("s_waitcnt lgkmcnt(" #n ")" ::: "memory")
#define PG8_BAR __builtin_amdgcn_s_barrier()
#define PG8_SCHED __builtin_amdgcn_sched_barrier(0)
    Unit cur, nxt; int ui = 0;
    if (!S.next(0, cur)) return;
    f32x4 acc[2][2][4][2];
#pragma unroll
    for (int a = 0; a < 2; ++a)
#pragma unroll
        for (int b = 0; b < 2; ++b)
#pragma unroll
            for (int m = 0; m < 4; ++m)
#pragma unroll
                for (int n = 0; n < 2; ++n) acc[a][b][m][n] = (f32x4){0.f, 0.f, 0.f, 0.f};
    bf16x8 At[4][2], B0[2][2], B1[2][2];
    const char* cA = (const char*)g.A + (size_t)cur.pm * tstep; const char* cB = (const char*)g.Bt + (size_t)cur.pn * tstep;
    S.a_ready(cur);
    if constexpr (SP2) {
        PG8_STAGE(PG8_SB(0, 0), cB, voffB); PG8_STAGE(PG8_SB(0, 1), cB + hstep, voffB); PG8_STAGE(PG8_SA(0, 0), cA, voffA); PG8_STAGE(PG8_SA(0, 1), cA + hstep, voffA);
        if (wr == 1) PG8_BAR;
        PG8_WAIT_V(2); PG8_BAR;
        PG8_STAGE(PG8_SB(1, 0), cB + kstep, voffB); PG8_STAGE(PG8_SA(1, 0), cA + kstep, voffA); PG8_STAGE(PG8_SB(1, 1), cB + hstep + kstep, voffB);
        PG8_WAIT_V(6); PG8_BAR;
    } else {
        PG8_STAGE(PG8_SB(0, 0), cB, voffB); PG8_STAGE(PG8_SA(0, 0), cA, voffA); PG8_STAGE(PG8_SB(0, 1), cB + hstep, voffB); PG8_STAGE(PG8_SA(0, 1), cA + hstep, voffA);
        if (wr == 1) PG8_BAR;
        PG8_WAIT_V(4); PG8_BAR;
        PG8_STAGE(PG8_SB(1, 0), cB + kstep, voffB); PG8_STAGE(PG8_SA(1, 0), cA + kstep, voffA); PG8_STAGE(PG8_SB(1, 1), cB + hstep + kstep, voffB);
        PG8_WAIT_V(6); PG8_BAR;
    }
    for (;;) {
        const bool has_next = S.next(ui + 1, nxt);
        const char* nA = has_next ? (const char*)g.A + (size_t)nxt.pm * tstep : cA; const char* nB = has_next ? (const char*)g.Bt + (size_t)nxt.pn * tstep : cB;
        for (int t = 0; t < nt; t += 2) {
            const bool last = (t == nt - 2);
            const char* a1 = cA + (size_t)(t + 1) * kstep;
            const char* a2 = last ? nA : cA + (size_t)(t + 2) * kstep; const char* b2 = last ? nB : cB + (size_t)(t + 2) * kstep;
            const char* a3 = a2 + kstep; const char* b3 = b2 + kstep;
            if (last && has_next) S.a_ready(nxt);
            if constexpr (SP2) {
            PG8_LDB(B0, 0, 0); PG8_LDB(B1, 0, 1); PG8_SCHED; PG8_LDA(At, 0, 0); PG8_STAGE(PG8_SA(1, 1), a1 + hstep, voffA);
            PG8_WAIT_V(8); PG8_WAIT_L(0); PG8_BAR; PG8_MMA(0, 0, At, B0); PG8_MMA(0, 1, At, B1); PG8_BAR; PG8_SCHED;
            PG8_LDA(At, 0, 1); PG8_STAGE(PG8_SB(0, 0), b2, voffB); PG8_STAGE(PG8_SB(0, 1), b2 + hstep, voffB); PG8_STAGE(PG8_SA(0, 0), a2, voffA);
            PG8_WAIT_V(8); PG8_WAIT_L(0); PG8_BAR; PG8_MMA(1, 0, At, B0); PG8_MMA(1, 1, At, B1); PG8_BAR; PG8_SCHED;
            PG8_LDB(B0, 1, 0); PG8_LDB(B1, 1, 1); PG8_SCHED; PG8_LDA(At, 1, 0); PG8_STAGE(PG8_SA(0, 1), a2 + hstep, voffA);
            PG8_WAIT_V(8); PG8_WAIT_L(0); PG8_BAR; PG8_MMA(0, 0, At, B0); PG8_MMA(0, 1, At, B1); PG8_BAR; PG8_SCHED;
            PG8_LDA(At, 1, 1); PG8_STAGE(PG8_SB(1, 0), b3, voffB); PG8_STAGE(PG8_SB(1, 1), b3 + hstep, voffB); PG8_STAGE(PG8_SA(1, 0), a3, voffA);
            PG8_WAIT_V(8); PG8_WAIT_L(0); PG8_BAR; PG8_MMA(1, 0, At, B0); PG8_MMA(1, 1, At, B1); PG8_BAR; PG8_SCHED;
            } else {
            PG8_LDB(B0, 0, 0); PG8_SCHED; PG8_LDA(At, 0, 0); PG8_STAGE(PG8_SA(1, 1), a1 + hstep, voffA);
            PG8_WAIT_L(8); PG8_BAR; PG8_WAIT_L(0); PG8_MMA(0, 0, At, B0); PG8_BAR; PG8_SCHED;
            PG8_LDB(B1, 0, 1); PG8_STAGE(PG8_SB(0, 0), b2, voffB);
            PG8_BAR; PG8_WAIT_L(0); PG8_MMA(0, 1, At, B1); PG8_BAR;
            PG8_LDA(At, 0, 1); PG8_STAGE(PG8_SA(0, 0), a2, voffA);
            PG8_BAR; PG8_WAIT_L(0); PG8_MMA(1, 0, At, B0); PG8_BAR; PG8_SCHED;
            PG8_STAGE(PG8_SB(0, 1), b2 + hstep, voffB);
            PG8_WAIT_V(6); PG8_BAR; PG8_MMA(1, 1, At, B1); PG8_BAR;
            PG8_LDB(B0, 1, 0); PG8_SCHED; PG8_LDA(At, 1, 0); PG8_STAGE(PG8_SA(0, 1), a2 + hstep, voffA);
            PG8_WAIT_L(8); PG8_BAR; PG8_WAIT_L(0); PG8_MMA(0, 0, At, B0); PG8_BAR; PG8_SCHED;
            PG8_LDB(B1, 1, 1); PG8_STAGE(PG8_SB(1, 0), b3, voffB);
            PG8_BAR; PG8_WAIT_L(0); PG8_MMA(0, 1, At, B1); PG8_BAR;
            PG8_LDA(At, 1, 1); PG8_STAGE(PG8_SA(1, 0), a3, voffA);
            PG8_BAR; PG8_WAIT_L(0); PG8_MMA(1, 0, At, B0); PG8_BAR; PG8_SCHED;
            PG8_STAGE(PG8_SB(1, 1), b3 + hstep, voffB);
            PG8_WAIT_V(6); PG8_BAR; PG8_MMA(1, 1, At, B1); PG8_BAR;
            }
        }
        if constexpr (ALIGN_EPI) { if (wr == 0) PG8_BAR; }
        if constexpr (!Epi::AFTER_DRAIN) { E(acc, cur, wr, wc, fr, fq); S.done(cur); }
        if (!has_next) break;
#pragma unroll
        for (int a = 0; a < 2; ++a)
#pragma unroll
            for (int b = 0; b < 2; ++b)
#pragma unroll
                for (int m = 0; m < 4; ++m)
#pragma unroll
                    for (int n = 0; n < 2; ++n) acc[a][b][m][n] = (f32x4){0.f, 0.f, 0.f, 0.f};
        cur = nxt; cA = nA; cB = nB; ++ui;
        if constexpr (ALIGN_EPI) { if (wr == 1) PG8_BAR; }
    }
    PG8_WAIT_V(0);
    if constexpr (!ALIGN_EPI) { if (wr == 0) PG8_BAR; }
    PG8_BAR;
    if constexpr (Epi::AFTER_DRAIN) { E.fused(acc, cur, wr, wc, fr, fq, lds, wid, lane); S.done(cur); }
#undef PG8_SA
#undef PG8_SB
#undef PG8_STAGE
#undef PG8_LDA
#undef PG8_LDB
#undef PG8_MMA
#undef PG8_WAIT_V
#undef PG8_WAIT_L
#undef PG8_BAR
#undef PG8_SCHED
}
}

#ifndef MK_FUSED
#define MK_FUSED 1
#endif
#define DI __device__ __forceinline__
#define LAS __attribute__((address_space(3)))
typedef unsigned short bf16_t;
typedef float f32x4 __attribute__((ext_vector_type(4)));
typedef float f32x2 __attribute__((ext_vector_type(2)));
typedef float f32x16 __attribute__((ext_vector_type(16)));
typedef unsigned u32x4 __attribute__((ext_vector_type(4)));
typedef unsigned u32x2 __attribute__((ext_vector_type(2)));
typedef short bf16x8 __attribute__((ext_vector_type(8)));
typedef _Float16 h16x2 __attribute__((ext_vector_type(2)));
typedef _Float16 h16x8 __attribute__((ext_vector_type(8)));

constexpr int BATCH = 16, SEQ = 4096, T = BATCH * SEQ, DM = 1024, NIN = 4864;
constexpr int C_AQ = 0, C_AK = 512, C_AV = 640, C_HQ = 768, C_HF = 1280, C_HI = 1792, C_HG = 2304, C_GA = 2816, C_GH = 3840;
constexpr float EPS = 1e-6f;
constexpr int NTHR = 512;
constexpr int LDS_BYTES = 147456;

constexpr size_t MiB = 1u << 20;
constexpr size_t WS_W1T = 1 * MiB;
constexpr size_t WS_WAPT = 11 * MiB;
constexpr size_t WS_WHPT = 12 * MiB;
constexpr size_t WS_WOUTT = 13 * MiB;
constexpr size_t WS_WQT = 15 * MiB;
constexpr size_t WS_KEYS = 19 * MiB;
constexpr size_t WS_LB = 19 * MiB + 512 * 1024;
constexpr size_t WS_RSTD1 = 20 * MiB;
constexpr size_t WS_SSQ2 = 21 * MiB;
constexpr size_t WS_U8 = 26 * MiB;
constexpr size_t WS_V8 = 42 * MiB;
constexpr size_t WS_SU = 58 * MiB;
constexpr size_t WS_SV = 58 * MiB + 65536;
constexpr size_t WS_DEC = 60 * MiB;
constexpr size_t WS_AVT = 64 * MiB;
constexpr size_t WS_XB = 90 * MiB;
constexpr size_t WS_PA = 218 * MiB;
constexpr size_t WS_GG = 314 * MiB;
constexpr size_t WS_QD = 570 * MiB;
constexpr size_t WS_KINV = 634 * MiB;
constexpr size_t WS_KENDT = 698 * MiB;
constexpr size_t WS_VT = 762 * MiB;
constexpr size_t WS_GS = 826 * MiB;
constexpr size_t WS_YA = 890 * MiB;
constexpr size_t WS_YH = 954 * MiB;
constexpr size_t WS_END = 1018 * MiB;
constexpr size_t WS_X2B = 218 * MiB;
constexpr size_t WS_QP = 346 * MiB;
constexpr size_t WS_GIDX = 602 * MiB;
constexpr size_t WS_GGATE = 618 * MiB;

struct Args { const float* in[15]; float* out; unsigned char* ws; int ph_lo, ph_hi; };

DI unsigned pk_bf16(float lo, float hi) { typedef __bf16 b2 __attribute__((ext_vector_type(2))); f32x2 v = {lo, hi}; b2 b = __builtin_convertvector(v, b2); return __builtin_bit_cast(unsigned, b); }
DI float bflo(unsigned w) { return __uint_as_float(w << 16); }
DI float bfhi(unsigned w) { return __uint_as_float(w & 0xffff0000u); }
DI float sigm(float x) { return __builtin_amdgcn_rcpf(1.f + __expf(-x)); }
DI float wave_sum(float v) {
#pragma unroll
    for (int o = 1; o < 64; o <<= 1) v += __shfl_xor(v, o);
    return v;
}
DI unsigned short bf16_1(float x) { return (unsigned short)(pk_bf16(x, 0.f) & 0xffffu); }
template <int N> DI float dpp_row_shr(float v) { return __int_as_float(__builtin_amdgcn_update_dpp(0, __float_as_int(v), 0x110 + N, 0xf, 0xf, true)); }
DI float scan16(float v) { v += dpp_row_shr<1>(v); v += dpp_row_shr<2>(v); v += dpp_row_shr<4>(v); v += dpp_row_shr<8>(v); return v; }
DI int crow(int reg, int hh) { return (reg & 3) + 8 * (reg >> 2) + 4 * hh; }
#define MFMA32(a, b, c) __builtin_amdgcn_mfma_f32_32x32x16_bf16((a), (b), (c), 0, 0, 0)
#define LDS_WAIT() asm volatile("s_waitcnt lgkmcnt(0)" ::: "memory")

namespace pg8 {
struct Epi1 {
    static constexpr bool PERM = true, AFTER_DRAIN = false;
    const float* rs; bf16_t* pa; bf16_t* gg; bf16_t* qd; bf16_t* kinv; bf16_t* kendT; bf16_t* vT; bf16_t* gs; float* dec; const float* lb; bf16_t* avT;
    __device__ __forceinline__ void operator()(const f32x4 (&acc)[2][2][4][2], const Unit& u, int wr, int wc, int fr, int fq) const {
        asm volatile("" : "+v"(fr), "+v"(fq));
        const int row0 = u.pm * BM + wr * 64 + fr, pn = u.pn;
        if (pn == 2) {
            const int c8 = wc * 32 + 8 * fq, tseqb = (u.pm & 15) * 256 + wr * 64 + fr, bb = u.pm >> 4;
#pragma unroll
            for (int ai = 0; ai < 2; ++ai)
#pragma unroll
                for (int m = 0; m < 4; ++m) { const int row = row0 + ai * HALF + m * 16; const float s = rs[row];
                    const f32x4 v0 = acc[ai][0][m][0] * s, v1 = acc[ai][0][m][1] * s;
                    u32x4 w; w.x = pk_bf16(v0[0], v0[1]); w.y = pk_bf16(v0[2], v0[3]); w.z = pk_bf16(v1[0], v1[1]); w.w = pk_bf16(v1[2], v1[3]);
                    *(u32x4*)(pa + (size_t)row * 768 + 512 + c8) = w;
#pragma unroll
                    for (int n = 0; n < 2; ++n)
#pragma unroll
                        for (int e = 0; e < 4; ++e) { const int c = c8 + 4 * n + e; avT[(size_t)((bb * 2 + (c >> 6)) * 64 + (c & 63)) * SEQ + tseqb + ai * HALF + 16 * m] = bf16_1(acc[ai][1][m][n][e] * s); } }
            return;
        }
        if (pn < 3 || pn >= 11) {
            bf16_t* O; int ldc, colt;
            if (pn < 3) { O = pa; ldc = 768; colt = pn * 256; } else { O = gg; ldc = 2048; colt = (pn - 11) * 256; }
            const int col0 = colt + wc * 32 + 8 * fq;
#pragma unroll
            for (int ai = 0; ai < 2; ++ai)
#pragma unroll
                for (int m = 0; m < 4; ++m) { const int row = row0 + ai * HALF + m * 16; const float s = rs[row]; bf16_t* rowp = O + (size_t)row * ldc + col0;
#pragma unroll
                    for (int bj = 0; bj < 2; ++bj) { const f32x4 v0 = acc[ai][bj][m][0] * s, v1 = acc[ai][bj][m][1] * s;
                        u32x4 w; w.x = pk_bf16(v0[0], v0[1]); w.y = pk_bf16(v0[2], v0[3]); w.z = pk_bf16(v1[0], v1[1]); w.w = pk_bf16(v1[2], v1[3]);
                        *(u32x4*)(rowp + bj * HALF) = w; } }
            return;
        }
        const int h = (pn - 3) & 3, c8 = wc * 32 + 8 * fq, bh = (u.pm >> 4) * 4 + h;
        if (pn < 7) {
#pragma unroll
            for (int ai = 0; ai < 2; ++ai) {
                const int tseq0 = (u.pm & 15) * 256 + ai * HALF + wr * 64;
                float rsv[4]; float decv[8];
#pragma unroll
                for (int m = 0; m < 4; ++m) rsv[m] = rs[row0 + ai * HALF + m * 16];
#pragma unroll
                for (int n = 0; n < 2; ++n) {
                    float qdv[4][4], kiv[4][4];
#pragma unroll
                    for (int e = 0; e < 4; ++e) {
                        const int dk = c8 + 4 * n + e; const float lbc = lb[h * 128 + dk];
                        float f[4], p[4];
#pragma unroll
                        for (int m = 0; m < 4; ++m) { const float x = acc[ai][1][m][n][e] * rsv[m]; f[m] = lbc + (1.f - lbc) * sigm(x); p[m] = scan16(__logf(f[m])); }
                        const float t0 = __shfl(p[0], 15, 16), t1 = __shfl(p[1], 15, 16), t2 = __shfl(p[2], 15, 16), t3 = __shfl(p[3], 15, 16);
                        const float bl = (t0 + t1) + (t2 + t3), dc = __expf(bl); decv[4 * n + e] = dc;
                        const float bb[4] = {p[0], p[1] + t0, p[2] + (t0 + t1), p[3] + ((t0 + t1) + t2)};
                        bf16_t* kt = kendT + (size_t)(bh * 128 + dk) * SEQ + tseq0 + fr;
#pragma unroll
                        for (int m = 0; m < 4; ++m) { const float eb = __expf(bb[m]), einv = __builtin_amdgcn_rcpf(eb), k = 1.f - f[m], xq = acc[ai][0][m][n][e] * rsv[m];
                            qdv[m][e] = xq * sigm(xq) * eb; kiv[m][e] = k * einv; kt[16 * m] = bf16_1(k * einv * dc); }
                    }
#pragma unroll
                    for (int m = 0; m < 4; ++m) { const size_t o = (size_t)(row0 + ai * HALF + m * 16) * 512 + h * 128 + c8 + 4 * n;
                        u32x2 w; w.x = pk_bf16(qdv[m][0], qdv[m][1]); w.y = pk_bf16(qdv[m][2], qdv[m][3]); *(u32x2*)(qd + o) = w;
                        u32x2 z; z.x = pk_bf16(kiv[m][0], kiv[m][1]); z.y = pk_bf16(kiv[m][2], kiv[m][3]); *(u32x2*)(kinv + o) = z; }
                }
                if (fr == 0) { float* dp = dec + (size_t)(bh * 64 + (tseq0 >> 6)) * 128 + c8;
                    *(f32x4*)dp = (f32x4){decv[0], decv[1], decv[2], decv[3]}; *(f32x4*)(dp + 4) = (f32x4){decv[4], decv[5], decv[6], decv[7]}; }
            }
        } else {
#pragma unroll
            for (int ai = 0; ai < 2; ++ai) {
                const int tseq0 = (u.pm & 15) * 256 + ai * HALF + wr * 64;
#pragma unroll
                for (int m = 0; m < 4; ++m) { const int row = row0 + ai * HALF + m * 16; const float s = rs[row];
#pragma unroll
                    for (int n = 0; n < 2; ++n)
#pragma unroll
                        for (int e = 0; e < 4; ++e) vT[(size_t)(bh * 128 + c8 + 4 * n + e) * SEQ + tseq0 + 16 * m + fr] = bf16_1(acc[ai][0][m][n][e] * s);
                    f32x4 g0 = acc[ai][1][m][0] * s, g1 = acc[ai][1][m][1] * s;
#pragma unroll
                    for (int e = 0; e < 4; ++e) { g0[e] *= sigm(g0[e]); g1[e] *= sigm(g1[e]); }
                    u32x4 w; w.x = pk_bf16(g0[0], g0[1]); w.y = pk_bf16(g0[2], g0[3]); w.z = pk_bf16(g1[0], g1[1]); w.w = pk_bf16(g1[2], g1[3]);
                    *(u32x4*)(gs + (size_t)row * 512 + h * 128 + c8) = w; }
            }
        }
    }
};
template <bool ADD> struct EpiMerge {
    static constexpr bool PERM = true, AFTER_DRAIN = false;
    bf16_t* O; const bf16_t* gate;
    __device__ __forceinline__ void operator()(const f32x4 (&acc)[2][2][4][2], const Unit& u, int wr, int wc, int fr, int fq) const {
        const int row0 = u.pm * BM + wr * 64 + fr, col0 = u.pn * BM + wc * 32 + 8 * fq;
#pragma unroll
        for (int ai = 0; ai < 2; ++ai)
#pragma unroll
            for (int m = 0; m < 4; ++m) { const int row = row0 + ai * HALF + m * 16; bf16_t* rowp = O + (size_t)row * DM + col0; const bf16_t* gp = gate + (size_t)row * 2048 + col0;
#pragma unroll
                for (int bj = 0; bj < 2; ++bj) { const u32x4 g = *(const u32x4*)(gp + bj * HALF);
                    f32x4 v0 = acc[ai][bj][m][0], v1 = acc[ai][bj][m][1];
                    v0[0] *= sigm(bflo(g.x)); v0[1] *= sigm(bfhi(g.x)); v0[2] *= sigm(bflo(g.y)); v0[3] *= sigm(bfhi(g.y));
                    v1[0] *= sigm(bflo(g.z)); v1[1] *= sigm(bfhi(g.z)); v1[2] *= sigm(bflo(g.w)); v1[3] *= sigm(bfhi(g.w));
                    if (ADD) { const u32x4 o = *(const u32x4*)(rowp + bj * HALF);
                        v0[0] += bflo(o.x); v0[1] += bfhi(o.x); v0[2] += bflo(o.y); v0[3] += bfhi(o.y); v1[0] += bflo(o.z); v1[1] += bfhi(o.z); v1[2] += bflo(o.w); v1[3] += bfhi(o.w); }
                    u32x4 w; w.x = pk_bf16(v0[0], v0[1]); w.y = pk_bf16(v0[2], v0[3]); w.z = pk_bf16(v1[0], v1[1]); w.w = pk_bf16(v1[2], v1[3]);
                    *(u32x4*)(rowp + bj * HALF) = w; } }
    }
};
struct EpiX2 {
    static constexpr bool PERM = true, AFTER_DRAIN = false;
    const float* X; bf16_t* X2B; float* ssq;
    __device__ __forceinline__ void operator()(const f32x4 (&acc)[2][2][4][2], const Unit& u, int wr, int wc, int fr, int fq) const {
        const int row0 = u.pm * BM + wr * 64 + fr, col0 = u.pn * BM + wc * 32 + 8 * fq;
#pragma unroll
        for (int ai = 0; ai < 2; ++ai)
#pragma unroll
            for (int m = 0; m < 4; ++m) { const int row = row0 + ai * HALF + m * 16; const size_t off = (size_t)row * DM + col0; float ss = 0.f;
#pragma unroll
                for (int bj = 0; bj < 2; ++bj) { const f32x4 x0 = *(const f32x4*)(X + off + bj * HALF), x1 = *(const f32x4*)(X + off + bj * HALF + 4);
                    const f32x4 v0 = acc[ai][bj][m][0] + x0, v1 = acc[ai][bj][m][1] + x1;
                    u32x4 w; w.x = pk_bf16(v0[0], v0[1]); w.y = pk_bf16(v0[2], v0[3]); w.z = pk_bf16(v1[0], v1[1]); w.w = pk_bf16(v1[2], v1[3]);
                    *(u32x4*)(X2B + off + bj * HALF) = w;
                    ss += (v0[0] * v0[0] + v0[1] * v0[1]) + (v0[2] * v0[2] + v0[3] * v0[3]) + (v1[0] * v1[0] + v1[1] * v1[1]) + (v1[2] * v1[2] + v1[3] * v1[3]); }
                ss += __shfl_xor(ss, 16); ss += __shfl_xor(ss, 32);
                if (fq == 0) ssq[(size_t)row * 16 + u.pn * 4 + wc] = ss; }
    }
};
struct EpiQp {
    static constexpr bool PERM = true, AFTER_DRAIN = false;
    bf16_t* O; const float* ssq;
    __device__ __forceinline__ void operator()(const f32x4 (&acc)[2][2][4][2], const Unit& u, int wr, int wc, int fr, int fq) const {
        const int row0 = u.pm * BM + wr * 64 + fr, col0 = u.pn * BM + wc * 32 + 8 * fq;
#pragma unroll
        for (int ai = 0; ai < 2; ++ai)
#pragma unroll
            for (int m = 0; m < 4; ++m) { const int row = row0 + ai * HALF + m * 16; const f32x4* sp = (const f32x4*)(ssq + (size_t)row * 16);
                const f32x4 a = sp[0], b = sp[1], c = sp[2], d = sp[3];
                const float tot = ((a[0] + a[1]) + (a[2] + a[3])) + ((b[0] + b[1]) + (b[2] + b[3])) + ((c[0] + c[1]) + (c[2] + c[3])) + ((d[0] + d[1]) + (d[2] + d[3]));
                const float s = __builtin_amdgcn_rsqf(tot * (1.f / 1024.f) + EPS); bf16_t* rowp = O + (size_t)row * 2048 + col0;
#pragma unroll
                for (int bj = 0; bj < 2; ++bj) { const f32x4 v0 = acc[ai][bj][m][0] * s, v1 = acc[ai][bj][m][1] * s;
                    u32x4 w; w.x = pk_bf16(v0[0], v0[1]); w.y = pk_bf16(v0[2], v0[3]); w.z = pk_bf16(v1[0], v1[1]); w.w = pk_bf16(v1[2], v1[3]);
                    *(u32x4*)(rowp + bj * HALF) = w; } }
    }
};
}

DI int w1_src_col(int n) {
    if (n < 768 || n >= 2816) return n;
    if (n < 1792) { const int h = (n - 768) >> 8, r = (n - 768) & 255; return r < 128 ? C_HQ + 128 * h + r : C_HF + 128 * h + (r - 128); }
    const int h = (n - 1792) >> 8, r = (n - 1792) & 255; return r < 128 ? C_HI + 128 * h + r : C_HG + 128 * h + (r - 128);
}
template <bool PERMW1> DI void p0_transpose_item(const float* W, int K, int N, bf16_t* WT, const float* g, int gmask, LAS float* scr, int item, int lane) {
    const int nblk = N / 32, kb = item / nblk, nb = item % nblk, k0 = 64 * kb, n0 = 32 * nb, ns = PERMW1 ? w1_src_col(n0) : n0;
#pragma unroll 8
    for (int i = 0; i < 32; ++i) { const int kk = 2 * i + (lane >> 5); float w = W[(size_t)(k0 + kk) * N + ns + (lane & 31)]; if (g) w *= g[(k0 + kk) & gmask]; scr[kk * 33 + (lane & 31)] = w; }
    LDS_WAIT(); asm volatile("" ::: "memory");
    const int c = lane & 7;
#pragma unroll
    for (int j = 0; j < 4; ++j) { const int n = (lane >> 3) + 8 * j; const LAS float* s = scr + (8 * c) * 33 + n;
        u32x4 o; o.x = pk_bf16(s[0 * 33], s[1 * 33]); o.y = pk_bf16(s[2 * 33], s[3 * 33]); o.z = pk_bf16(s[4 * 33], s[5 * 33]); o.w = pk_bf16(s[6 * 33], s[7 * 33]);
        *(u32x4*)(WT + (size_t)(n0 + n) * K + k0 + 8 * c) = o; }
    LDS_WAIT(); asm volatile("" ::: "memory");
}
DI unsigned pk_f16(float a, float b) { h16x2 v = {(_Float16)a, (_Float16)b}; return __builtin_bit_cast(unsigned, v); }

DI void p0_prologue(const Args& a, LAS unsigned char* lds, int vb, int G) {
    const int tid = threadIdx.x, lane = tid & 63, wave = tid >> 6;
    const int gw = vb * 8 + wave, NGW = G * 8, gt = vb * NTHR + tid, NGT = G * NTHR;
    unsigned char* ws = a.ws;
    LAS float* scr = (LAS float*)(lds + wave * 16384);
    constexpr int I_W1 = 16 * 152, I_AP = 8 * 32, I_HP = 8 * 32, I_OUT = 16 * 32, I_Q = 16 * 64, NITEMS = I_W1 + I_AP + I_HP + I_OUT + I_Q;
    for (int it = gw; it < NITEMS; it += NGW) {
        int r = it;
        if (r < I_W1) { p0_transpose_item<true>(a.in[2], 1024, NIN, (bf16_t*)(ws + WS_W1T), a.in[1], 1023, scr, r, lane); continue; } r -= I_W1;
        if (r < I_AP) { p0_transpose_item<false>(a.in[6], 512, 1024, (bf16_t*)(ws + WS_WAPT), nullptr, 0, scr, r, lane); continue; } r -= I_AP;
        if (r < I_HP) { p0_transpose_item<false>(a.in[7], 512, 1024, (bf16_t*)(ws + WS_WHPT), a.in[5], 127, scr, r, lane); continue; } r -= I_HP;
        if (r < I_OUT) { p0_transpose_item<false>(a.in[8], 1024, 1024, (bf16_t*)(ws + WS_WOUTT), nullptr, 0, scr, r, lane); continue; } r -= I_OUT;
        p0_transpose_item<false>(a.in[10], 1024, 2048, (bf16_t*)(ws + WS_WQT), a.in[9], 1023, scr, r, lane);
    }
    for (int i = gt; i < 2 * 8 * 128 * 128 / 4; i += NGT) { const f32x4 v = ((const f32x4*)a.in[11])[i]; u32x2 o; o.x = pk_bf16(v[0], v[1]); o.y = pk_bf16(v[2], v[3]); ((u32x2*)(ws + WS_KEYS))[i] = o; }
    for (int it = gw; it < 2 * 16384; it += NGW) {
        const int isv = it >= 16384, e = it & 16383;
        const float* src = (isv ? a.in[13] : a.in[12]) + (size_t)e * 1024 + 16 * lane;
        f32x4 x[4]; float amax = 0.f;
#pragma unroll
        for (int i = 0; i < 4; ++i) { x[i] = *(const f32x4*)(src + 4 * i); if (!isv) x[i] *= *(const f32x4*)(a.in[9] + 16 * lane + 4 * i);
            amax = fmaxf(fmaxf(amax, fmaxf(fabsf(x[i][0]), fabsf(x[i][1]))), fmaxf(fabsf(x[i][2]), fabsf(x[i][3]))); }
#pragma unroll
        for (int o = 1; o < 64; o <<= 1) amax = fmaxf(amax, __shfl_xor(amax, o));
        const float qs = amax > 0.f ? 127.f / amax : 0.f; const int off = isv ? 128 : 0;
        u32x4 w;
#pragma unroll
        for (int i = 0; i < 4; ++i) { const int q0 = (int)rintf(x[i][0] * qs) + off, q1 = (int)rintf(x[i][1] * qs) + off, q2 = (int)rintf(x[i][2] * qs) + off, q3 = (int)rintf(x[i][3] * qs) + off;
            w[i] = (unsigned)(q0 & 255) | ((unsigned)(q1 & 255) << 8) | ((unsigned)(q2 & 255) << 16) | ((unsigned)(q3 & 255) << 24); }
        *(u32x4*)(ws + (isv ? WS_V8 : WS_U8) + (size_t)e * 1024 + 16 * lane) = w;
        if (lane == 0) ((float*)(ws + (isv ? WS_SV : WS_SU)))[e] = amax * (1.f / 127.f);
    }
    for (int row = gw; row < T; row += NGW) {
        const f32x4* xr = (const f32x4*)(a.in[0] + (size_t)row * DM) + lane; f32x4 v[4]; float s = 0.f;
#pragma unroll
        for (int j = 0; j < 4; ++j) { v[j] = xr[64 * j]; s += (v[j][0] * v[j][0] + v[j][1] * v[j][1]) + (v[j][2] * v[j][2] + v[j][3] * v[j][3]); }
        s = wave_sum(s);
        u32x2* o = (u32x2*)(ws + WS_XB + (size_t)row * DM * 2) + lane;
#pragma unroll
        for (int j = 0; j < 4; ++j) { u32x2 w; w.x = pk_bf16(v[j][0], v[j][1]); w.y = pk_bf16(v[j][2], v[j][3]); o[64 * j] = w; }
        if (lane == 0) ((float*)(ws + WS_RSTD1))[row] = __builtin_amdgcn_rsqf(s * (1.f / 1024.f) + EPS);
    }
    if (vb == 0) { const float l0 = a.in[4][tid], l1 = a.in[4][512 + tid]; ((float*)(ws + WS_LB))[tid] = 1.f / (1.f + __expf(l1 - l0)); }
}

DI void attn_task(const bf16_t* pa, const bf16_t* avT, const float* sinks, bf16_t* ya, int b, int qb, int h) {
    const int lane = threadIdx.x & 63, r = lane & 31, hh = lane >> 5, kvh = h >> 2;
    const size_t trow = (size_t)b * SEQ + qb * 32 + r;
    constexpr float LOG2E = 1.4426950408889634f;
    bf16x8 qf[4];
    { const bf16_t* qp = pa + trow * 768 + h * 64 + 8 * hh;
#pragma unroll
      for (int s = 0; s < 4; ++s) qf[s] = *(const bf16x8*)(qp + 16 * s); }
    const float slope2 = exp2f(-(float)(h + 1)) * LOG2E, sink2 = sinks[h] * LOG2E, qs = 0.125f * LOG2E;
    f32x16 S[5]; float m = sink2;
#pragma unroll
    for (int i = 0; i < 5; ++i) { const int kb = qb - 4 + i;
        if (kb >= 0) {
#pragma unroll
            for (int q = 0; q < 16; ++q) S[i][q] = 0.f;
            const bf16_t* kp = pa + ((size_t)b * SEQ + kb * 32 + r) * 768 + 512 + kvh * 64 + 8 * hh;
#pragma unroll
            for (int s = 0; s < 4; ++s) S[i] = MFMA32(*(const bf16x8*)(kp + 16 * s), qf[s], S[i]);
#pragma unroll
            for (int q = 0; q < 16; ++q) { const int dist = 32 * (4 - i) + r - crow(q, hh); float v = S[i][q] * qs - slope2 * (float)dist;
                if (i == 0) v = (dist <= 127) ? v : -1e30f;
                if (i == 4) v = (dist >= 0) ? v : -1e30f;
                S[i][q] = v; m = fmaxf(m, v); }
        } }
    m = fmaxf(m, __shfl_xor(m, 32));
    float l = 0.f;
#pragma unroll
    for (int i = 0; i < 5; ++i) if (qb - 4 + i >= 0) {
#pragma unroll
        for (int q = 0; q < 16; ++q) { const float p = __builtin_amdgcn_exp2f(S[i][q] - m); S[i][q] = p; l += p; } }
    l += __shfl_xor(l, 32); l += __builtin_amdgcn_exp2f(sink2 - m);
    f32x16 O[2];
#pragma unroll
    for (int q = 0; q < 16; ++q) { O[0][q] = 0.f; O[1][q] = 0.f; }
#pragma unroll
    for (int i = 0; i < 5; ++i) { const int kb = qb - 4 + i;
        if (kb >= 0) {
#pragma unroll
            for (int s2 = 0; s2 < 2; ++s2) {
                u32x4 pb; pb.x = pk_bf16(S[i][8 * s2], S[i][8 * s2 + 1]); pb.y = pk_bf16(S[i][8 * s2 + 2], S[i][8 * s2 + 3]); pb.z = pk_bf16(S[i][8 * s2 + 4], S[i][8 * s2 + 5]); pb.w = pk_bf16(S[i][8 * s2 + 6], S[i][8 * s2 + 7]);
#pragma unroll
                for (int dt = 0; dt < 2; ++dt) { const bf16_t* vp = avT + (size_t)((b * 2 + kvh) * 64 + 32 * dt + r) * SEQ + kb * 32 + 16 * s2 + 4 * hh;
                    const u32x2 v0 = *(const u32x2*)vp, v1 = *(const u32x2*)(vp + 8); u32x4 av; av.x = v0.x; av.y = v0.y; av.z = v1.x; av.w = v1.y;
                    O[dt] = MFMA32(__builtin_bit_cast(bf16x8, av), __builtin_bit_cast(bf16x8, pb), O[dt]); }
            } } }
    const float inv = 1.f / l;
#pragma unroll
    for (int dt = 0; dt < 2; ++dt)
#pragma unroll
        for (int g = 0; g < 4; ++g) { u32x2 w; w.x = pk_bf16(O[dt][4 * g] * inv, O[dt][4 * g + 1] * inv); w.y = pk_bf16(O[dt][4 * g + 2] * inv, O[dt][4 * g + 3] * inv);
            *(u32x2*)(ya + trow * 512 + h * 64 + 32 * dt + 8 * g + 4 * hh) = w; }
}

DI void hgrn_ds_unit(const bf16_t* kendT, const bf16_t* vT, bf16_t* dsT, int bh, int c) {
    const int lane = threadIdx.x & 63, wave = threadIdx.x >> 6, r = lane & 31, hh = lane >> 5, i = wave >> 1, j0 = 2 * (wave & 1);
    const bf16_t* ka = kendT + (size_t)(bh * 128 + 32 * i + r) * SEQ + c * 64 + 8 * hh;
    const bf16_t* vb0 = vT + (size_t)(bh * 128 + 32 * j0 + r) * SEQ + c * 64 + 8 * hh; const bf16_t* vb1 = vb0 + (size_t)32 * SEQ;
    f32x16 D0, D1;
#pragma unroll
    for (int q = 0; q < 16; ++q) { D0[q] = 0.f; D1[q] = 0.f; }
#pragma unroll
    for (int ks = 0; ks < 4; ++ks) { const bf16x8 a = *(const bf16x8*)(ka + 16 * ks), b0 = *(const bf16x8*)(vb0 + 16 * ks), b1 = *(const bf16x8*)(vb1 + 16 * ks); D0 = MFMA32(a, b0, D0); D1 = MFMA32(a, b1, D1); }
    const int unit = bh * 64 + c;
    bf16_t* o0 = dsT + (size_t)(unit * 128 + 32 * j0 + r) * 128 + 32 * i + 4 * hh; bf16_t* o1 = o0 + 32 * 128;
#pragma unroll
    for (int g = 0; g < 4; ++g) { u32x2 w; w.x = pk_bf16(D0[4 * g], D0[4 * g + 1]); w.y = pk_bf16(D0[4 * g + 2], D0[4 * g + 3]); *(u32x2*)(o0 + 8 * g) = w;
        u32x2 z; z.x = pk_bf16(D1[4 * g], D1[4 * g + 1]); z.y = pk_bf16(D1[4 * g + 2], D1[4 * g + 3]); *(u32x2*)(o1 + 8 * g) = z; }
}
DI void hgrn_scan(bf16_t* dsT, const float* dec, int vb, int G) {
    for (int idx = vb * NTHR + threadIdx.x; idx < 64 * 128 * 16; idx += G * NTHR) {
        const int dk8 = idx & 15, dv = (idx >> 4) & 127, bh = idx >> 11;
        float S[8];
#pragma unroll
        for (int q = 0; q < 8; ++q) S[q] = 0.f;
        for (int c0 = 0; c0 < 64; c0 += 8) {
            u32x4 ld[8]; f32x4 d0[8], d1[8];
#pragma unroll
            for (int i = 0; i < 8; ++i) { const int c = c0 + i; ld[i] = *(const u32x4*)(dsT + (size_t)((bh * 64 + c) * 128 + dv) * 128 + dk8 * 8);
                const float* dp = dec + (size_t)(bh * 64 + c) * 128 + dk8 * 8; d0[i] = *(const f32x4*)dp; d1[i] = *(const f32x4*)(dp + 4); }
#pragma unroll
            for (int i = 0; i < 8; ++i) { const int c = c0 + i;
                u32x4 w; w.x = pk_bf16(S[0], S[1]); w.y = pk_bf16(S[2], S[3]); w.z = pk_bf16(S[4], S[5]); w.w = pk_bf16(S[6], S[7]);
                *(u32x4*)(dsT + (size_t)((bh * 64 + c) * 128 + dv) * 128 + dk8 * 8) = w;
                S[0] = d0[i][0] * S[0] + bflo(ld[i].x); S[1] = d0[i][1] * S[1] + bfhi(ld[i].x); S[2] = d0[i][2] * S[2] + bflo(ld[i].y); S[3] = d0[i][3] * S[3] + bfhi(ld[i].y);
                S[4] = d1[i][0] * S[4] + bflo(ld[i].z); S[5] = d1[i][1] * S[5] + bfhi(ld[i].z); S[6] = d1[i][2] * S[6] + bflo(ld[i].w); S[7] = d1[i][3] * S[7] + bfhi(ld[i].w); }
        }
    }
}
DI void hgrn_out_unit(const bf16_t* qd, const bf16_t* kinv, const bf16_t* vT, const bf16_t* spT, const bf16_t* gs, bf16_t* yh, LAS float* zs, int bh, int c) {
    const int tid = threadIdx.x, lane = tid & 63, wave = __builtin_amdgcn_readfirstlane(tid >> 6), r = lane & 31, hh = lane >> 5, tb = wave >> 2, db = wave & 3, b = bh >> 2, h = bh & 3;
    const size_t Tb = (size_t)b * SEQ + c * 64;
    bf16x8 qf[8], sf[8], kf0[8], kf1[8]; u32x2 vf[2][2][2];
    { const bf16_t* qrow = qd + (Tb + 32 * tb + r) * 512 + h * 128 + 8 * hh; const bf16_t* sp = spT + (size_t)((bh * 64 + c) * 128 + 32 * db + r) * 128 + 8 * hh;
      const bf16_t* k0 = kinv + (Tb + r) * 512 + h * 128 + 8 * hh; const bf16_t* vrow = vT + (size_t)(bh * 128 + 32 * db + r) * SEQ + c * 64 + 4 * hh;
#pragma unroll
      for (int ks = 0; ks < 8; ++ks) { qf[ks] = *(const bf16x8*)(qrow + 16 * ks); sf[ks] = *(const bf16x8*)(sp + 16 * ks); kf0[ks] = *(const bf16x8*)(k0 + 16 * ks); }
      if (tb) {
#pragma unroll
          for (int ks = 0; ks < 8; ++ks) kf1[ks] = *(const bf16x8*)(k0 + 32 * 512 + 16 * ks); }
#pragma unroll
      for (int sb = 0; sb < 2; ++sb)
#pragma unroll
          for (int s2 = 0; s2 < 2; ++s2) if (sb <= tb) { vf[sb][s2][0] = *(const u32x2*)(vrow + 32 * sb + 16 * s2); vf[sb][s2][1] = *(const u32x2*)(vrow + 32 * sb + 16 * s2 + 8); } }
    f32x16 Z;
#pragma unroll
    for (int q = 0; q < 16; ++q) Z[q] = 0.f;
#pragma unroll
    for (int ks = 0; ks < 8; ++ks) Z = MFMA32(qf[ks], sf[ks], Z);
#pragma unroll
    for (int sb = 0; sb < 2; ++sb) if (sb <= tb) {
        f32x16 X;
#pragma unroll
        for (int q = 0; q < 16; ++q) X[q] = 0.f;
#pragma unroll
        for (int ks = 0; ks < 8; ++ks) X = MFMA32(sb ? kf1[ks] : kf0[ks], qf[ks], X);
        if (sb == tb) {
#pragma unroll
            for (int q = 0; q < 16; ++q) if (crow(q, hh) > r) X[q] = 0.f;
        }
#pragma unroll
        for (int s2 = 0; s2 < 2; ++s2) {
            u32x4 pa_; pa_.x = pk_bf16(X[8 * s2], X[8 * s2 + 1]); pa_.y = pk_bf16(X[8 * s2 + 2], X[8 * s2 + 3]); pa_.z = pk_bf16(X[8 * s2 + 4], X[8 * s2 + 5]); pa_.w = pk_bf16(X[8 * s2 + 6], X[8 * s2 + 7]);
            u32x4 pb_; pb_.x = vf[sb][s2][0].x; pb_.y = vf[sb][s2][0].y; pb_.z = vf[sb][s2][1].x; pb_.w = vf[sb][s2][1].y;
            Z = MFMA32(__builtin_bit_cast(bf16x8, pa_), __builtin_bit_cast(bf16x8, pb_), Z);
        }
    }
#pragma unroll
    for (int q = 0; q < 16; ++q) zs[(32 * tb + crow(q, hh)) * 132 + 32 * db + r] = Z[q];
    __syncthreads();
    { const int tok = tid >> 3, d16 = (tid & 7) * 16; f32x4 o[4]; float ss = 0.f;
      const size_t off = (Tb + tok) * 512 + h * 128 + d16; const u32x4 g0 = *(const u32x4*)(gs + off), g1 = *(const u32x4*)(gs + off + 8);
#pragma unroll
      for (int i = 0; i < 4; ++i) { o[i] = *(const LAS f32x4*)(zs + tok * 132 + d16 + 4 * i); ss += (o[i][0] * o[i][0] + o[i][1] * o[i][1]) + (o[i][2] * o[i][2] + o[i][3] * o[i][3]); }
      ss += __shfl_xor(ss, 1); ss += __shfl_xor(ss, 2); ss += __shfl_xor(ss, 4);
      const float rn = __builtin_amdgcn_rsqf(ss * (1.f / 128.f) + EPS);
      u32x4 w0, w1;
      w0.x = pk_bf16(o[0][0] * rn * bflo(g0.x), o[0][1] * rn * bfhi(g0.x)); w0.y = pk_bf16(o[0][2] * rn * bflo(g0.y), o[0][3] * rn * bfhi(g0.y));
      w0.z = pk_bf16(o[1][0] * rn * bflo(g0.z), o[1][1] * rn * bfhi(g0.z)); w0.w = pk_bf16(o[1][2] * rn * bflo(g0.w), o[1][3] * rn * bfhi(g0.w));
      w1.x = pk_bf16(o[2][0] * rn * bflo(g1.x), o[2][1] * rn * bfhi(g1.x)); w1.y = pk_bf16(o[2][2] * rn * bflo(g1.y), o[2][3] * rn * bfhi(g1.y));
      w1.z = pk_bf16(o[3][0] * rn * bflo(g1.z), o[3][1] * rn * bfhi(g1.z)); w1.w = pk_bf16(o[3][2] * rn * bflo(g1.w), o[3][3] * rn * bfhi(g1.w));
      *(u32x4*)(yh + off) = w0; *(u32x4*)(yh + off + 8) = w1; }
}

DI unsigned f2ord(float f) { const unsigned b = __float_as_uint(f); return b ^ ((unsigned)((int)b >> 31) | 0x80000000u); }
DI float ord2f(unsigned k) { const unsigned b = (k & 0x80000000u) ? (k ^ 0x80000000u) : ~k; return __uint_as_float(b); }
DI void ce_desc(unsigned& a, unsigned& b) { const unsigned hi = a > b ? a : b, lo = a > b ? b : a; a = hi; b = lo; }
DI void sort16_desc(unsigned (&a)[16]) {
#pragma unroll
    for (int k = 2; k <= 16; k <<= 1)
#pragma unroll
        for (int j = k >> 1; j > 0; j >>= 1)
#pragma unroll
            for (int i = 0; i < 16; ++i) { const int l = i ^ j; if (l > i) { if ((i & k) == 0) ce_desc(a[i], a[l]); else ce_desc(a[l], a[i]); } }
}
DI void merge16_desc(unsigned (&a)[16], const unsigned (&b)[16]) {
#pragma unroll
    for (int i = 0; i < 16; ++i) a[i] = a[i] > b[15 - i] ? a[i] : b[15 - i];
#pragma unroll
    for (int j = 8; j > 0; j >>= 1)
#pragma unroll
        for (int i = 0; i < 16; ++i) { const int l = i ^ j; if (l > i) ce_desc(a[i], a[l]); }
}
#define TK_INS(L, x) do { unsigned t_ = (x); _Pragma("unroll") for (int j_ = 0; j_ < 16; ++j_) { const unsigned hi_ = L[j_] > t_ ? L[j_] : t_; t_ = L[j_] > t_ ? t_ : L[j_]; L[j_] = hi_; } } while (0)

DI void topk_stage_keys(const bf16_t* keysb, LAS unsigned char* kl, int h) {
    for (int c = threadIdx.x; c < 2 * 128 * 16; c += NTHR) { const int p = c >> 11, row = (c >> 4) & 127, ch = c & 15;
        *(LAS u32x4*)(kl + (p * 128 + row) * 272 + ch * 16) = *(const u32x4*)(keysb + ((size_t)(p * 8 + h) * 128 + row) * 128 + ch * 8); }
}
DI void topk_unit(const bf16_t* qp, const LAS unsigned char* kl, unsigned short* gidx, float* ggate, LAS unsigned* tk, int quad, int h) {
    const int tid = threadIdx.x, lane = tid & 63, wave = tid >> 6, p = wave & 1, tsub = wave >> 1, r = lane & 31, hh = lane >> 5;
#pragma unroll 1
    for (int hl = 0; hl < 4; ++hl) {
        const int tok0 = (quad * 4 + hl) * 128 + tsub * 32;
        f32x16 acc[4];
#pragma unroll
        for (int kb = 0; kb < 4; ++kb)
#pragma unroll
            for (int i = 0; i < 16; ++i) acc[kb][i] = 0.f;
        const bf16_t* qrow = qp + (size_t)(tok0 + r) * 2048 + h * 256 + p * 128 + 8 * hh;
        const LAS unsigned char* kbase = kl + (p * 128 + r) * 272 + 16 * hh;
#pragma unroll
        for (int s = 0; s < 8; ++s) { const bf16x8 bq = *(const bf16x8*)(qrow + 16 * s);
#pragma unroll
            for (int kb = 0; kb < 4; ++kb) { const bf16x8 ak = *(const LAS bf16x8*)(kbase + kb * 32 * 272 + 32 * s); acc[kb] = MFMA32(ak, bq, acc[kb]); } }
        unsigned A0[16], A1[16], A2[16], A3[16];
#pragma unroll
        for (int i = 0; i < 16; ++i) { const unsigned ki = (unsigned)(crow(i, hh));
            A0[i] = (f2ord(acc[0][i]) & ~127u) | ki; A1[i] = (f2ord(acc[1][i]) & ~127u) | (32u + ki); A2[i] = (f2ord(acc[2][i]) & ~127u) | (64u + ki); A3[i] = (f2ord(acc[3][i]) & ~127u) | (96u + ki); }
        sort16_desc(A0); sort16_desc(A1); sort16_desc(A2); sort16_desc(A3);
        merge16_desc(A0, A1); merge16_desc(A2, A3); merge16_desc(A0, A2);
#pragma unroll
        for (int j = 0; j < 16; ++j) A1[j] = __shfl_xor(A0[j], 32);
        merge16_desc(A0, A1);
        if (hh == 0) { LAS u32x4* dst = (LAS u32x4*)(tk + (((hl * 2 + p) * 128 + tsub * 32 + r) * 16));
#pragma unroll
            for (int c = 0; c < 4; ++c) { u32x4 w = {A0[4 * c], A0[4 * c + 1], A0[4 * c + 2], A0[4 * c + 3]}; dst[c] = w; } }
    }
    __syncthreads();
    {
        const int tok = tid & 127, hl = tid >> 7, tile = quad * 4 + hl;
        const LAS unsigned* t1 = tk + ((hl * 2 + 0) * 128 + tok) * 16; const LAS unsigned* t2 = tk + ((hl * 2 + 1) * 128 + tok) * 16;
        float v1[16], v2[16];
        { const LAS u32x4* s1 = (const LAS u32x4*)t1; const LAS u32x4* s2 = (const LAS u32x4*)t2;
#pragma unroll
          for (int c = 0; c < 4; ++c) { const u32x4 a = s1[c], b = s2[c];
              v1[4 * c] = ord2f(a.x & ~127u); v1[4 * c + 1] = ord2f(a.y & ~127u); v1[4 * c + 2] = ord2f(a.z & ~127u); v1[4 * c + 3] = ord2f(a.w & ~127u);
              v2[4 * c] = ord2f(b.x & ~127u); v2[4 * c + 1] = ord2f(b.y & ~127u); v2[4 * c + 2] = ord2f(b.z & ~127u); v2[4 * c + 3] = ord2f(b.w & ~127u); } }
#define CKEY(i, j) ((f2ord(v1[i] + v2[j]) & ~255u) | (unsigned)((i) * 16 + (j)))
        unsigned C[16], D[16], E[16];
#pragma unroll
        for (int j = 0; j < 16; ++j) C[j] = CKEY(0, j);
#pragma unroll
        for (int j = 0; j < 8; ++j) D[j] = CKEY(1, j);
#pragma unroll
        for (int j = 0; j < 5; ++j) D[8 + j] = CKEY(2, j);
#pragma unroll
        for (int j = 0; j < 3; ++j) D[13 + j] = CKEY(4, j);
#pragma unroll
        for (int j = 0; j < 4; ++j) E[j] = CKEY(3, j);
        E[4] = CKEY(5, 0); E[5] = CKEY(5, 1); E[6] = CKEY(6, 0); E[7] = CKEY(6, 1); E[8] = CKEY(7, 0); E[9] = CKEY(7, 1);
        E[10] = CKEY(8, 0); E[11] = CKEY(9, 0); E[12] = CKEY(10, 0); E[13] = CKEY(11, 0); E[14] = CKEY(12, 0); E[15] = CKEY(13, 0);
        sort16_desc(D); sort16_desc(E);
        TK_INS(E, CKEY(14, 0)); TK_INS(E, CKEY(15, 0));
#undef CKEY
        merge16_desc(C, D); merge16_desc(C, E);
        float sc[16]; unsigned ei[16]; float mx = -1e30f;
#pragma unroll
        for (int q = 0; q < 16; ++q) { const unsigned ij = C[q] & 255u; const unsigned a = t1[ij >> 4], b = t2[ij & 15u];
            sc[q] = ord2f(a & ~127u) + ord2f(b & ~127u); ei[q] = (a & 127u) * 128u + (b & 127u); mx = fmaxf(mx, sc[q]); }
        float sum = 0.f;
#pragma unroll
        for (int q = 0; q < 16; ++q) { sc[q] = __expf(sc[q] - mx); sum += sc[q]; }
        const float inv = 1.f / sum; const size_t o = (size_t)(tile * 128 + tok) * 128 + h * 16;
        u32x4 w0, w1;
        w0.x = ei[0] | (ei[1] << 16); w0.y = ei[2] | (ei[3] << 16); w0.z = ei[4] | (ei[5] << 16); w0.w = ei[6] | (ei[7] << 16);
        w1.x = ei[8] | (ei[9] << 16); w1.y = ei[10] | (ei[11] << 16); w1.z = ei[12] | (ei[13] << 16); w1.w = ei[14] | (ei[15] << 16);
        *(u32x4*)(gidx + o) = w0; *(u32x4*)(gidx + o + 8) = w1;
#pragma unroll
        for (int c = 0; c < 4; ++c) *(f32x4*)(ggate + o + 4 * c) = (f32x4){sc[4 * c] * inv, sc[4 * c + 1] * inv, sc[4 * c + 2] * inv, sc[4 * c + 3] * inv};
    }
    __syncthreads();
}

DI float gelu_erf(float x) { return 0.5f * x * (1.f + erff(x * 0.70710678118654752f)); }
DI int dot16(u32x4 w, const int (&h)[4]) { int c = __builtin_amdgcn_sdot4((int)w.x, h[0], 0, false); c = __builtin_amdgcn_sdot4((int)w.y, h[1], c, false); c = __builtin_amdgcn_sdot4((int)w.z, h[2], c, false); return __builtin_amdgcn_sdot4((int)w.w, h[3], c, false); }
#define V8_FMA(acc4, word, we) do { acc4[0] += (we) * (float)((word) & 255u); acc4[1] += (we) * (float)(((word) >> 8) & 255u); acc4[2] += (we) * (float)(((word) >> 16) & 255u); acc4[3] += (we) * (float)((word) >> 24); } while (0)

DI void expert_token(const bf16_t* x2row, const float* ssq, const unsigned char* u8, const unsigned char* v8, const float* su, const float* sv, const unsigned short* gidx, const float* ggate, const float* gf, float* outrow, int lane) {
    f32x4 x[4]; float amax = 0.f;
#pragma unroll
    for (int i = 0; i < 4; ++i) { const u32x2 w_ = *(const u32x2*)(x2row + 16 * lane + 4 * i); x[i] = (f32x4){bflo(w_.x), bfhi(w_.x), bflo(w_.y), bfhi(w_.y)}; amax = fmaxf(fmaxf(amax, fmaxf(fabsf(x[i][0]), fabsf(x[i][1]))), fmaxf(fabsf(x[i][2]), fabsf(x[i][3]))); }
    float ss = (lane < 16) ? ssq[lane] : 0.f; ss = wave_sum(ss);
    const float rstd2 = __builtin_amdgcn_rsqf(ss * (1.f / 1024.f) + EPS);
#pragma unroll
    for (int o = 1; o < 64; o <<= 1) amax = fmaxf(amax, __shfl_xor(amax, o));
    amax *= rstd2;
    const float qs = amax > 0.f ? 127.f / amax : 0.f, sh = amax * (1.f / 127.f), xq = rstd2 * qs;
    int hq[4];
#pragma unroll
    for (int i = 0; i < 4; ++i) { const int q0 = (int)rintf(x[i][0] * xq), q1 = (int)rintf(x[i][1] * xq), q2 = (int)rintf(x[i][2] * xq), q3 = (int)rintf(x[i][3] * xq);
        hq[i] = (int)((unsigned)(q0 & 255) | ((unsigned)(q1 & 255) << 8) | ((unsigned)(q2 & 255) << 16) | ((unsigned)(q3 & 255) << 24)); }
    const int id0 = gidx[lane], id1 = gidx[64 + lane]; const float g0 = ggate[lane], g1 = ggate[64 + lane];
    f32x4 o[4]; float wsum = 0.f;
#pragma unroll
    for (int i = 0; i < 4; ++i) o[i] = (f32x4){0.f, 0.f, 0.f, 0.f};
#pragma unroll 1
    for (int bt = 0; bt < 16; ++bt) {
        const int idsel = (bt < 8) ? id0 : id1; const float gsel = (bt < 8) ? g0 : g1; const int lb = (bt & 7) * 8;
        u32x4 ur[8], vr[8];
#pragma unroll
        for (int e = 0; e < 8; ++e) { const int idx = __builtin_amdgcn_readlane(idsel, lb + e); ur[e] = *(const u32x4*)(u8 + (size_t)idx * 1024 + 16 * lane); }
#pragma unroll
        for (int e = 0; e < 8; ++e) { const int idx = __builtin_amdgcn_readlane(idsel, lb + e); vr[e] = *(const u32x4*)(v8 + (size_t)idx * 1024 + 16 * lane); }
        const int myidx = __shfl(idsel, lb + (lane >> 3)); const float mysu = su[myidx], mysv = sv[myidx], gate = __shfl(gsel, lb + (lane >> 3));
        int pr[8];
#pragma unroll
        for (int e = 0; e < 8; ++e) pr[e] = dot16(ur[e], hq);
        int q4[4], q2[2], q1;
        { const bool up_ = (lane & 32) != 0;
#pragma unroll
          for (int i = 0; i < 4; ++i) { const int keep = up_ ? pr[i + 4] : pr[i], send = up_ ? pr[i] : pr[i + 4]; q4[i] = keep + __shfl_xor(send, 32); } }
        { const bool up_ = (lane & 16) != 0;
#pragma unroll
          for (int i = 0; i < 2; ++i) { const int keep = up_ ? q4[i + 2] : q4[i], send = up_ ? q4[i] : q4[i + 2]; q2[i] = keep + __shfl_xor(send, 16); } }
        { const bool up_ = (lane & 8) != 0; const int keep = up_ ? q2[1] : q2[0], send = up_ ? q2[0] : q2[1]; q1 = keep + __shfl_xor(send, 8); }
        q1 += __shfl_xor(q1, 4); q1 += __shfl_xor(q1, 2); q1 += __shfl_xor(q1, 1);
        const float act = (float)q1 * (mysu * sh);
        const float w = gelu_erf(act) * gate * mysv;
#pragma unroll
        for (int e = 0; e < 8; ++e) { const float we = __int_as_float(__builtin_amdgcn_readlane(__float_as_int(w), 8 * e)); wsum += we;
            V8_FMA(o[0], vr[e].x, we); V8_FMA(o[1], vr[e].y, we); V8_FMA(o[2], vr[e].z, we); V8_FMA(o[3], vr[e].w, we); }
    }
    const float corr = 128.f * wsum; float s3 = 0.f;
#pragma unroll
    for (int i = 0; i < 4; ++i) { x[i] += o[i] - corr; s3 += (x[i][0] * x[i][0] + x[i][1] * x[i][1]) + (x[i][2] * x[i][2] + x[i][3] * x[i][3]); }
    s3 = wave_sum(s3); const float r3 = __builtin_amdgcn_rsqf(s3 * (1.f / 1024.f) + EPS);
#pragma unroll
    for (int i = 0; i < 4; ++i) *(f32x4*)(outrow + 16 * lane + 4 * i) = x[i] * r3 * *(const f32x4*)(gf + 16 * lane + 4 * i);
}

#define XB_TMO      128
#define XB_XCNT(j)  (256  + 64 * (j))
#define XB_XSUB(j)  (1280 + 64 * (j))
#define XB_XGEN(j)  (2304 + 64 * (j))
#define XB_TOP      3328
#define XB_TOPGEN   3392
#define XCD_BAR_WORDS 3456
#define XB_SPIN_CAP (1u << 18)

__device__ __forceinline__ unsigned xb_ld(unsigned* p)              { return __hip_atomic_load(p, __ATOMIC_RELAXED, __HIP_MEMORY_SCOPE_AGENT); }
__device__ __forceinline__ unsigned xb_add(unsigned* p, unsigned v) { return __hip_atomic_fetch_add(p, v, __ATOMIC_RELAXED, __HIP_MEMORY_SCOPE_AGENT); }
__device__ __forceinline__ unsigned xb_xcc_id() { return (unsigned)__builtin_amdgcn_s_getreg((3 << 11) | 20) & 0xFu; }
#define XB_SPIN(cond, bar) do { unsigned _sp = 0; while (cond) { __builtin_amdgcn_s_sleep(1); \
    if ((++_sp & 255u) == 0u) { if (xb_ld(&(bar)[XB_TMO])) break; if (_sp > XB_SPIN_CAP) { atomicAdd(&(bar)[XB_TMO], 1u); break; } } } } while (0)

struct XcdBarrier {
    unsigned* bar; unsigned x;
    volatile __attribute__((address_space(3))) unsigned* st;
};

__device__ __forceinline__ XcdBarrier xcd_barrier_post(unsigned* bar, volatile __attribute__((address_space(3))) unsigned* st) {
    XcdBarrier b; b.bar = bar; b.x = xb_xcc_id(); b.st = st;
    if (threadIdx.x == 0) (void)xb_add(&bar[XB_XCNT(b.x)], 1u);
    return b;
}
__device__ __forceinline__ void xcd_barrier_complete(unsigned* bar, unsigned x, unsigned& nloc, unsigned& nx) {
    const unsigned G = gridDim.x * gridDim.y * gridDim.z;
    unsigned sum, cnt, mine, sp = 0u;
    for (;;) {
        sum = 0u; cnt = 0u; mine = 0u;
#pragma unroll
        for (unsigned j = 0; j < 16; ++j) { const unsigned c = xb_ld(&bar[XB_XCNT(j)]); sum += c; cnt += (c > 0u) ? 1u : 0u; mine = (j == x) ? c : mine; }
        if (sum == G) break;
        __builtin_amdgcn_s_sleep(1);
        if ((++sp & 255u) == 0u) { if (xb_ld(&bar[XB_TMO])) break; if (sp > XB_SPIN_CAP) { atomicAdd(&bar[XB_TMO], 1u); break; } }
    }
    nloc = mine > 0u ? mine : 1u; nx = cnt > 0u ? cnt : 1u;
}

__device__ __forceinline__ void xcd_barrier(const XcdBarrier& b) {
    asm volatile("s_waitcnt vmcnt(0)" ::: "memory");
    __syncthreads();
    if (threadIdx.x == 0) {
        unsigned* bar = b.bar;
        __builtin_amdgcn_s_waitcnt(0);
        unsigned nloc = b.st[0], nx = b.st[1];
        if (nloc == 0u) { xcd_barrier_complete(bar, b.x, nloc, nx); b.st[0] = nloc; b.st[1] = nx; }
        const unsigned old = xb_add(&bar[XB_XSUB(b.x)], 1u);
        const unsigned gen = old / nloc;
        if (old + 1u == (gen + 1u) * nloc) {
            __builtin_amdgcn_fence(__ATOMIC_RELEASE, "agent");
            asm volatile("s_waitcnt vmcnt(0)" ::: "memory");
            const unsigned og = xb_add(&bar[XB_TOP], 1u);
            const unsigned tg = og / nx;
            if (og + 1u == (tg + 1u) * nx) xb_add(&bar[XB_TOPGEN], 1u);
            else XB_SPIN(xb_ld(&bar[XB_TOPGEN]) == tg, bar);
            __builtin_amdgcn_fence(__ATOMIC_ACQUIRE, "agent");
            xb_add(&bar[XB_XGEN(b.x)], 1u);
            asm volatile("s_waitcnt vmcnt(0)" ::: "memory");
        } else {
            XB_SPIN(xb_ld(&bar[XB_XGEN(b.x)]) == gen, bar);
            __builtin_amdgcn_fence(__ATOMIC_ACQUIRE, "agent");
            asm volatile("s_waitcnt vmcnt(0)" ::: "memory");
        }
    }
    __syncthreads();
}

constexpr int N_PHASES = 10;
__global__ void __launch_bounds__(NTHR, 2) mk_fwd(Args a) {
    extern __shared__ __attribute__((aligned(16))) unsigned char lds_raw[];
    LAS unsigned char* lds = (LAS unsigned char*)lds_raw;
    cg::grid_group grid = cg::this_grid();
    const int G = gridDim.x, vb = blockIdx.x, tid = threadIdx.x, lane = tid & 63, wave = tid >> 6;
    unsigned char* ws = a.ws;
    const int lo = a.ph_lo, hi = a.ph_hi;
    volatile LAS unsigned* MISC = (volatile LAS unsigned*)(lds + LDS_BYTES - 64);
    if (tid < 16) MISC[tid] = 0u;
    __syncthreads();
    const XcdBarrier bar = xcd_barrier_post((unsigned*)(ws + 4096) + lo * XCD_BAR_WORDS, MISC);
#ifndef PHASE_MASK
#define PHASE_MASK 0xFFFF
#endif
#define IN(k) (((PHASE_MASK >> (k)) & 1) && lo <= (k) && (k) < hi)
#ifndef REPEAT_MASK
#define REPEAT_MASK 0
#endif
#define REP(k) for (int rep_ = 0; rep_ < (((REPEAT_MASK) >> (k)) & 1) + 1; ++rep_)
#define SEAM(k) do { if (IN(k) && IN((k) + 1)) { if ((k) == 0) grid.sync(); else xcd_barrier(bar); } } while (0)
    REP(0) if (IN(0)) p0_prologue(a, lds, vb, G);
    SEAM(0);
    REP(1) if (IN(1)) { pg8::Gemm g{(const bf16_t*)(ws + WS_XB), (const bf16_t*)(ws + WS_W1T), T, NIN, 1024}; pg8::StaticOrder S; S.init(T, NIN, G, vb);
        pg8::Epi1 E{(const float*)(ws + WS_RSTD1), (bf16_t*)(ws + WS_PA), (bf16_t*)(ws + WS_GG), (bf16_t*)(ws + WS_QD), (bf16_t*)(ws + WS_KINV), (bf16_t*)(ws + WS_KENDT), (bf16_t*)(ws + WS_VT), (bf16_t*)(ws + WS_GS),
                    (float*)(ws + WS_DEC), (const float*)(ws + WS_LB), (bf16_t*)(ws + WS_AVT)};
        pg8::gemm_phase<pg8::Epi1, pg8::StaticOrder, true, true>(lds, g, S, E); }
    SEAM(1);
    REP(2) if (IN(2)) {
        for (int u = vb; u < 64 * 64; u += G) hgrn_ds_unit((const bf16_t*)(ws + WS_KENDT), (const bf16_t*)(ws + WS_VT), (bf16_t*)(ws + WS_XB), u >> 6, u & 63);
        { const int hw = __builtin_amdgcn_readfirstlane(wave);
          for (int u = vb; u < BATCH * (SEQ / 32); u += G) attn_task((const bf16_t*)(ws + WS_PA), (const bf16_t*)(ws + WS_AVT), a.in[3], (bf16_t*)(ws + WS_YA), u >> 7, u & 127, hw); }
    }
    SEAM(2);
    REP(3) if (IN(3)) hgrn_scan((bf16_t*)(ws + WS_XB), (const float*)(ws + WS_DEC), vb, G);
    SEAM(3);
    REP(4) if (IN(4)) { int bsel = 0; for (int u = vb; u < 64 * 64; u += G, bsel ^= 1)
        hgrn_out_unit((const bf16_t*)(ws + WS_QD), (const bf16_t*)(ws + WS_KINV), (const bf16_t*)(ws + WS_VT), (const bf16_t*)(ws + WS_XB), (const bf16_t*)(ws + WS_GS), (bf16_t*)(ws + WS_YH), (LAS float*)(lds + bsel * 34816), u >> 6, u & 63);
        __syncthreads(); }
    SEAM(4);
    REP(5) if (IN(5)) {
        { pg8::Gemm g{(const bf16_t*)(ws + WS_YA), (const bf16_t*)(ws + WS_WAPT), T, 1024, 512}; pg8::StaticOrder S; S.init(T, 1024, G, vb);
          pg8::EpiMerge<false> E{(bf16_t*)(ws + WS_XB), (const bf16_t*)(ws + WS_GG)};
          pg8::gemm_phase<pg8::EpiMerge<false>, pg8::StaticOrder, true, true>(lds, g, S, E); }
        __syncthreads();
        { pg8::Gemm g{(const bf16_t*)(ws + WS_YH), (const bf16_t*)(ws + WS_WHPT), T, 1024, 512}; pg8::StaticOrder S; S.init(T, 1024, G, vb);
          pg8::EpiMerge<true> E{(bf16_t*)(ws + WS_XB), (const bf16_t*)(ws + WS_GG) + 1024};
          pg8::gemm_phase<pg8::EpiMerge<true>, pg8::StaticOrder, true, true>(lds, g, S, E); }
    }
    SEAM(5);
    REP(6) if (IN(6)) { pg8::Gemm g{(const bf16_t*)(ws + WS_XB), (const bf16_t*)(ws + WS_WOUTT), T, 1024, 1024}; pg8::StaticOrder S; S.init(T, 1024, G, vb);
        pg8::EpiX2 E{a.in[0], (bf16_t*)(ws + WS_X2B), (float*)(ws + WS_SSQ2)};
        pg8::gemm_phase<pg8::EpiX2, pg8::StaticOrder, true, true>(lds, g, S, E); }
    SEAM(6);
    REP(7) if (IN(7)) { pg8::Gemm g{(const bf16_t*)(ws + WS_X2B), (const bf16_t*)(ws + WS_WQT), T, 2048, 1024}; pg8::StaticOrder S; S.init(T, 2048, G, vb);
        pg8::EpiQp E{(bf16_t*)(ws + WS_QP), (const float*)(ws + WS_SSQ2)};
        pg8::gemm_phase<pg8::EpiQp, pg8::StaticOrder, true, true>(lds, g, S, E); }
    SEAM(7);
    REP(8) if (IN(8)) { const int per = (1024 + G - 1) / G; int hcur = -1;
        for (int U = vb * per; U < (vb + 1) * per && U < 1024; ++U) { const int h = U >> 7;
            if (h != hcur) { topk_stage_keys((const bf16_t*)(ws + WS_KEYS), lds + 65536, h); hcur = h; __syncthreads(); }
            topk_unit((const bf16_t*)(ws + WS_QP), lds + 65536, (unsigned short*)(ws + WS_GIDX), (float*)(ws + WS_GGATE), (LAS unsigned*)lds, U & 127, h); } }
    SEAM(8);
    REP(9) if (IN(9)) for (int tok = vb * 8 + wave; tok < T; tok += G * 8)
        expert_token((const bf16_t*)(ws + WS_X2B) + (size_t)tok * DM, (const float*)(ws + WS_SSQ2) + (size_t)tok * 16, (const unsigned char*)(ws + WS_U8), (const unsigned char*)(ws + WS_V8), (const float*)(ws + WS_SU), (const float*)(ws + WS_SV),
                     (const unsigned short*)(ws + WS_GIDX) + (size_t)tok * 128, (const float*)(ws + WS_GGATE) + (size_t)tok * 128, a.in[14], a.out + (size_t)tok * DM, lane);
#undef IN
#undef SEAM
}

extern "C" void kernel_launch(void* const* d_in, const int* in_sizes, int n_in, void* d_out, int out_size, void* d_ws, size_t ws_size, hipStream_t stream) {
    static int grid = 0;
    if (grid == 0) {
        if (n_in != 15 || in_sizes[0] != T * DM || out_size != T * DM || ws_size < WS_END) { fprintf(stderr, "kernel_launch: unexpected shapes (n_in %d, in0 %d, out %d, ws %zu)\n", n_in, n_in > 0 ? in_sizes[0] : -1, out_size, ws_size); grid = -1; return; }
        int dev = 0, cus = 0, per_cu = 0;
        hipGetDevice(&dev); hipDeviceGetAttribute(&cus, hipDeviceAttributeMultiprocessorCount, dev);
        if (hipFuncSetAttribute((const void*)mk_fwd, hipFuncAttributeMaxDynamicSharedMemorySize, LDS_BYTES) != hipSuccess) { fprintf(stderr, "kernel_launch: hipFuncSetAttribute failed\n"); grid = -1; return; }
        if (hipOccupancyMaxActiveBlocksPerMultiprocessor(&per_cu, (const void*)mk_fwd, NTHR, LDS_BYTES) != hipSuccess || per_cu < 1) { fprintf(stderr, "kernel_launch: occupancy query says %d blocks per CU\n", per_cu); per_cu = 1; }
        (void)hipGetLastError();
        grid = cus;
    }
    if (grid < 0) return;
    if (hipMemsetAsync(d_ws, 0, 256 * 1024, stream) != hipSuccess) { fprintf(stderr, "kernel_launch: hipMemsetAsync failed\n"); return; }
    Args a{};
    for (int i = 0; i < 15; ++i) a.in[i] = (const float*)d_in[i];
    a.out = (float*)d_out; a.ws = (unsigned char*)d_ws;
#if MK_FUSED
    a.ph_lo = 0; a.ph_hi = N_PHASES;
    { void* args[] = {&a}; hipError_t e = hipLaunchCooperativeKernel((const void*)mk_fwd, dim3(grid), dim3(NTHR), args, LDS_BYTES, stream);
      if (e != hipSuccess) fprintf(stderr, "kernel_launch: cooperative launch failed: %s (grid %d)\n", hipGetErrorString(e), grid); }
#else
    for (int p = 0; p < N_PHASES; ++p) { a.ph_lo = p; a.ph_hi = p + 1; void* args[] = {&a};
        hipError_t e = hipLaunchCooperativeKernel((const void*)mk_fwd, dim3(grid), dim3(NTHR), args, LDS_BYTES, stream);
        if (e != hipSuccess) { fprintf(stderr, "kernel_launch: launch of phase %d failed: %s (grid %d)\n", p, hipGetErrorString(e), grid); break; } }
#endif
}
```

```cpp
#include <hip/hip_runtime.h>
#include <hip/hip_cooperative_groups.h>
#include <cstdio>
#include <cstdint>
namespace cg = cooperative_groups;
namespace pg8 {
#define PG8_LAS __attribute__((address_space(3)))
typedef unsigned short bf16_t;
typedef short bf16x8 __attribute__((ext_vector_type(8)));
typedef float f32x4 __attribute__((ext_vector_type(4)));
typedef unsigned u32x4 __attribute__((ext_vector_type(4)));
constexpr int BM = 256, BK = 64, HALF = 128, HTB = HALF * BK * 2  , STAGE_BYTES = 8 * HTB, NXCD = 8, WGM = 8;

__host__ __device__ __forceinline__ int lds_byte(int r, int c) { const int st = (r >> 4) * 2 + (c >> 5), rr = r & 15, cc = c & 31, ob = rr * 64 + cc * 2; return st * 1024 + (ob ^ (((ob >> 9) & 1) << 5)); }
__host__ __device__ __forceinline__ void stage_rc(int b, int& R, int& C) { const int st = b / 1024, sb = b % 1024, swz = sb ^ (((sb >> 9) & 1) << 5); R = (st >> 1) * 16 + swz / 64; C = (st & 1) * 32 + (swz % 64) / 2; }
__host__ __device__ __forceinline__ int perm32(int rho) { const int n = rho >> 4, i = rho & 15; return 8 * (i >> 2) + 4 * n + (i & 3); }

struct Unit { int pm, pn; };
struct Gemm { const bf16_t* A; const bf16_t* Bt; int M, N, K; };

struct StaticOrder {
    int nM, nN, nwg, G, c;
    __host__ __device__ void init(int M, int N, int G_, int c_) { nM = M / BM; nN = N / BM; nwg = nM * nN; G = G_; c = c_; }
    __host__ __device__ bool next(int i, Unit& u) const {
        const long L = (long)i * G + c; if (L >= nwg) return false;
        int wgid = (int)L; { const int q = nwg / NXCD, r = nwg % NXCD, xcd = wgid % NXCD, off = wgid / NXCD; wgid = (xcd < r ? xcd * (q + 1) : r * (q + 1) + (xcd - r) * q) + off; }
        const int nig = WGM * nN, gid = wgid / nig, fm = gid * WGM, gsz = (nM - fm) < WGM ? (nM - fm) : WGM;
        u.pm = fm + ((wgid % nig) % gsz); u.pn = (wgid % nig) / gsz; return true;
    }
    __device__ __forceinline__ void a_ready(const Unit&) const {}
    __device__ __forceinline__ void done(const Unit&) const {}
};

__device__ __forceinline__ unsigned cvt_pk_bf16(float lo, float hi) { unsigned r; asm volatile("v_cvt_pk_bf16_f32 %0, %1, %2" : "=v"(r) : "v"(lo), "v"(hi)); return r; }

template <class Epi, class Sched, bool ALIGN_EPI = false, bool SP2 = false>
__device__ __forceinline__ void gemm_phase(PG8_LAS unsigned char* lds, const Gemm g, const Sched& S, const Epi& E) {
    int tid_ = threadIdx.x; asm volatile("" : "+v"(tid_));
    const int tid = tid_, wid = __builtin_amdgcn_readfirstlane(tid >> 6), lane = tid & 63, wr = wid >> 2, wc = wid & 3, fr = lane & 15, fq = lane >> 4;
    const int K = g.K, nt = K / BK;
    unsigned voffA[2], voffB[2];
#pragma unroll
    for (int i = 0; i < 2; ++i) { int R, C; stage_rc(tid * 16 + i * 8192, R, C); const int Rb = Epi::PERM ? ((R & ~31) + perm32(R & 31)) : R;
        voffA[i] = (unsigned)(R * K + C) * 2u; voffB[i] = (unsigned)(Rb * K + C) * 2u; }
    const size_t kstep = (size_t)(BK * 2);
    const size_t hstep = (size_t)HALF * K * 2;
    const size_t tstep = 2 * hstep;
    const unsigned ldsw = (unsigned)wid * 1024u;
    const int aoff = lds_byte(wr * 64 + fr, fq * 8), boff = lds_byte(wc * 32 + fr, fq * 8);
#define PG8_SA(b, h) (((b) * 2 + (h)) * HTB)
#define PG8_SB(b, h) ((4 + (b) * 2 + (h)) * HTB)
#define PG8_STAGE(bufoff, gbase, voff) do { _Pragma("unroll") for (int _i = 0; _i < 2; ++_i) \
        __builtin_amdgcn_global_load_lds((const unsigned*)((const char*)(gbase) + (voff)[_i]), (PG8_LAS unsigned*)(lds + (bufoff) + ldsw + _i * 8192), 16, 0, 0); } while (0)
#define PG8_LDA(dst, b, h) do { _Pragma("unroll") for (int m = 0; m < 4; ++m) _Pragma("unroll") for (int k = 0; k < 2; ++k) dst[m][k] = *(const PG8_LAS bf16x8*)(lds + PG8_SA(b, h) + aoff + m * 2048 + k * 1024); } while (0)
#define PG8_LDB(dst, b, h) do { _Pragma("unroll") for (int n = 0; n < 2; ++n) _Pragma("unroll") for (int k = 0; k < 2; ++k) dst[n][k] = *(const PG8_LAS bf16x8*)(lds + PG8_SB(b, h) + boff + n * 2048 + k * 1024); } while (0)
#define PG8_MMA(ai, bj, At, Bt) do { __builtin_amdgcn_s_setprio(1); _Pragma("unroll") for (int m = 0; m < 4; ++m) _Pragma("unroll") for (int n = 0; n < 2; ++n) _Pragma("unroll") for (int k = 0; k < 2; ++k) \
        acc[ai][bj][m][n] = __builtin_amdgcn_mfma_f32_16x16x32_bf16(Bt[n][k], At[m][k], acc[ai][bj][m][n], 0, 0, 0); __builtin_amdgcn_s_setprio(0); } while (0)
#define PG8_WAIT_V(n) asm volatile("s_waitcnt vmcnt(" #n ")" ::: "memory")
#define PG8_WAIT_L(n) asm volatile("s_waitcnt lgkmcnt(" #n ")" ::: "memory")
#define PG8_BAR __builtin_amdgcn_s_barrier()
#define PG8_SCHED __builtin_amdgcn_sched_barrier(0)
    Unit cur, nxt; int ui = 0;
    if (!S.next(0, cur)) return;
    f32x4 acc[2][2][4][2];
#pragma unroll
    for (int a = 0; a < 2; ++a)
#pragma unroll
        for (int b = 0; b < 2; ++b)
#pragma unroll
            for (int m = 0; m < 4; ++m)
#pragma unroll
                for (int n = 0; n < 2; ++n) acc[a][b][m][n] = (f32x4){0.f, 0.f, 0.f, 0.f};
    bf16x8 At[4][2], B0[2][2], B1[2][2];
    const char* cA = (const char*)g.A + (size_t)cur.pm * tstep; const char* cB = (const char*)g.Bt + (size_t)cur.pn * tstep;
    S.a_ready(cur);
    if constexpr (SP2) {
        PG8_STAGE(PG8_SB(0, 0), cB, voffB); PG8_STAGE(PG8_SB(0, 1), cB + hstep, voffB); PG8_STAGE(PG8_SA(0, 0), cA, voffA); PG8_STAGE(PG8_SA(0, 1), cA + hstep, voffA);
        if (wr == 1) PG8_BAR;
        PG8_WAIT_V(2); PG8_BAR;
        PG8_STAGE(PG8_SB(1, 0), cB + kstep, voffB); PG8_STAGE(PG8_SA(1, 0), cA + kstep, voffA); PG8_STAGE(PG8_SB(1, 1), cB + hstep + kstep, voffB);
        PG8_WAIT_V(6); PG8_BAR;
    } else {
        PG8_STAGE(PG8_SB(0, 0), cB, voffB); PG8_STAGE(PG8_SA(0, 0), cA, voffA); PG8_STAGE(PG8_SB(0, 1), cB + hstep, voffB); PG8_STAGE(PG8_SA(0, 1), cA + hstep, voffA);
        if (wr == 1) PG8_BAR;
        PG8_WAIT_V(4); PG8_BAR;
        PG8_STAGE(PG8_SB(1, 0), cB + kstep, voffB); PG8_STAGE(PG8_SA(1, 0), cA + kstep, voffA); PG8_STAGE(PG8_SB(1, 1), cB + hstep + kstep, voffB);
        PG8_WAIT_V(6); PG8_BAR;
    }
    for (;;) {
        const bool has_next = S.next(ui + 1, nxt);
        const char* nA = has_next ? (const char*)g.A + (size_t)nxt.pm * tstep : cA; const char* nB = has_next ? (const char*)g.Bt + (size_t)nxt.pn * tstep : cB;
        for (int t = 0; t < nt; t += 2) {
            const bool last = (t == nt - 2);
            const char* a1 = cA + (size_t)(t + 1) * kstep;
            const char* a2 = last ? nA : cA + (size_t)(t + 2) * kstep; const char* b2 = last ? nB : cB + (size_t)(t + 2) * kstep;
            const char* a3 = a2 + kstep; const char* b3 = b2 + kstep;
            if (last && has_next) S.a_ready(nxt);
            if constexpr (SP2) {
            PG8_LDB(B0, 0, 0); PG8_LDB(B1, 0, 1); PG8_SCHED; PG8_LDA(At, 0, 0); PG8_STAGE(PG8_SA(1, 1), a1 + hstep, voffA);
            PG8_WAIT_V(8); PG8_WAIT_L(0); PG8_BAR; PG8_MMA(0, 0, At, B0); PG8_MMA(0, 1, At, B1); PG8_BAR; PG8_SCHED;
            PG8_LDA(At, 0, 1); PG8_STAGE(PG8_SB(0, 0), b2, voffB); PG8_STAGE(PG8_SB(0, 1), b2 + hstep, voffB); PG8_STAGE(PG8_SA(0, 0), a2, voffA);
            PG8_WAIT_V(8); PG8_WAIT_L(0); PG8_BAR; PG8_MMA(1, 0, At, B0); PG8_MMA(1, 1, At, B1); PG8_BAR; PG8_SCHED;
            PG8_LDB(B0, 1, 0); PG8_LDB(B1, 1, 1); PG8_SCHED; PG8_LDA(At, 1, 0); PG8_STAGE(PG8_SA(0, 1), a2 + hstep, voffA);
            PG8_WAIT_V(8); PG8_WAIT_L(0); PG8_BAR; PG8_MMA(0, 0, At, B0); PG8_MMA(0, 1, At, B1); PG8_BAR; PG8_SCHED;
            PG8_LDA(At, 1, 1); PG8_STAGE(PG8_SB(1, 0), b3, voffB); PG8_STAGE(PG8_SB(1, 1), b3 + hstep, voffB); PG8_STAGE(PG8_SA(1, 0), a3, voffA);
            PG8_WAIT_V(8); PG8_WAIT_L(0); PG8_BAR; PG8_MMA(1, 0, At, B0); PG8_MMA(1, 1, At, B1); PG8_BAR; PG8_SCHED;
            } else {
            PG8_LDB(B0, 0, 0); PG8_SCHED; PG8_LDA(At, 0, 0); PG8_STAGE(PG8_SA(1, 1), a1 + hstep, voffA);
            PG8_WAIT_L(8); PG8_BAR; PG8_WAIT_L(0); PG8_MMA(0, 0, At, B0); PG8_BAR; PG8_SCHED;
            PG8_LDB(B1, 0, 1); PG8_STAGE(PG8_SB(0, 0), b2, voffB);
            PG8_BAR; PG8_WAIT_L(0); PG8_MMA(0, 1, At, B1); PG8_BAR;
            PG8_LDA(At, 0, 1); PG8_STAGE(PG8_SA(0, 0), a2, voffA);
            PG8_BAR; PG8_WAIT_L(0); PG8_MMA(1, 0, At, B0); PG8_BAR; PG8_SCHED;
            PG8_STAGE(PG8_SB(0, 1), b2 + hstep, voffB);
            PG8_WAIT_V(6); PG8_BAR; PG8_MMA(1, 1, At, B1); PG8_BAR;
            PG8_LDB(B0, 1, 0); PG8_SCHED; PG8_LDA(At, 1, 0); PG8_STAGE(PG8_SA(0, 1), a2 + hstep, voffA);
            PG8_WAIT_L(8); PG8_BAR; PG8_WAIT_L(0); PG8_MMA(0, 0, At, B0); PG8_BAR; PG8_SCHED;
            PG8_LDB(B1, 1, 1); PG8_STAGE(PG8_SB(1, 0), b3, voffB);
            PG8_BAR; PG8_WAIT_L(0); PG8_MMA(0, 1, At, B1); PG8_BAR;
            PG8_LDA(At, 1, 1); PG8_STAGE(PG8_SA(1, 0), a3, voffA);
            PG8_BAR; PG8_WAIT_L(0); PG8_MMA(1, 0, At, B0); PG8_BAR; PG8_SCHED;
            PG8_STAGE(PG8_SB(1, 1), b3 + hstep, voffB);
            PG8_WAIT_V(6); PG8_BAR; PG8_MMA(1, 1, At, B1); PG8_BAR;
            }
        }
        if constexpr (ALIGN_EPI) { if (wr == 0) PG8_BAR; }
        if constexpr (!Epi::AFTER_DRAIN) { E(acc, cur, wr, wc, fr, fq); S.done(cur); }
        if (!has_next) break;
#pragma unroll
        for (int a = 0; a < 2; ++a)
#pragma unroll
            for (int b = 0; b < 2; ++b)
#pragma unroll
                for (int m = 0; m < 4; ++m)
#pragma unroll
                    for (int n = 0; n < 2; ++n) acc[a][b][m][n] = (f32x4){0.f, 0.f, 0.f, 0.f};
        cur = nxt; cA = nA; cB = nB; ++ui;
        if constexpr (ALIGN_EPI) { if (wr == 1) PG8_BAR; }
    }
    PG8_WAIT_V(0);
    if constexpr (!ALIGN_EPI) { if (wr == 0) PG8_BAR; }
    PG8_BAR;
    if constexpr (Epi::AFTER_DRAIN) { E.fused(acc, cur, wr, wc, fr, fq, lds, wid, lane); S.done(cur); }
#undef PG8_SA
#undef PG8_SB
#undef PG8_STAGE
#undef PG8_LDA
#undef PG8_LDB
#undef PG8_MMA
#undef PG8_WAIT_V
#undef PG8_WAIT_L
#undef PG8_BAR
#undef PG8_SCHED
}
}

#ifndef MK_FUSED
#define MK_FUSED 1
#endif
#define DI __device__ __forceinline__
#define LAS __attribute__((address_space(3)))
typedef unsigned short bf16_t;
typedef float f32x4 __attribute__((ext_vector_type(4)));
typedef float f32x2 __attribute__((ext_vector_type(2)));
typedef float f32x16 __attribute__((ext_vector_type(16)));
typedef unsigned u32x4 __attribute__((ext_vector_type(4)));
typedef unsigned u32x2 __attribute__((ext_vector_type(2)));
typedef short bf16x8 __attribute__((ext_vector_type(8)));
typedef _Float16 h16x2 __attribute__((ext_vector_type(2)));
typedef _Float16 h16x8 __attribute__((ext_vector_type(8)));

constexpr int BATCH = 16, SEQ = 4096, T = BATCH * SEQ, DM = 1024, NIN = 4864;
constexpr int C_AQ = 0, C_AK = 512, C_AV = 640, C_HQ = 768, C_HF = 1280, C_HI = 1792, C_HG = 2304, C_GA = 2816, C_GH = 3840;
constexpr float EPS = 1e-6f;
constexpr int NTHR = 512;
constexpr int LDS_BYTES = 163840;

constexpr size_t MiB = 1u << 20;
constexpr size_t WS_W1T = 1 * MiB;
constexpr size_t WS_WAPT = 11 * MiB;
constexpr size_t WS_WHPT = 12 * MiB;
constexpr size_t WS_WOUTT = 13 * MiB;
constexpr size_t WS_WQT = 15 * MiB;
constexpr size_t WS_KEYS = 19 * MiB;
constexpr size_t WS_LB = 19 * MiB + 512 * 1024;
constexpr size_t WS_RSTD1 = 20 * MiB;
constexpr size_t WS_SSQ2 = 21 * MiB;
constexpr size_t WS_U8 = 26 * MiB;
constexpr size_t WS_V8 = 42 * MiB;
constexpr size_t WS_SU = 58 * MiB;
constexpr size_t WS_SV = 58 * MiB + 65536;
constexpr size_t WS_DEC = 60 * MiB;
constexpr size_t WS_AVT = 64 * MiB;
constexpr size_t WS_XB = 90 * MiB;
constexpr size_t WS_PA = 218 * MiB;
constexpr size_t WS_GG = 314 * MiB;
constexpr size_t WS_QD = 570 * MiB;
constexpr size_t WS_KINV = 634 * MiB;
constexpr size_t WS_KENDT = 698 * MiB;
constexpr size_t WS_VT = 762 * MiB;
constexpr size_t WS_GS = 826 * MiB;
constexpr size_t WS_YA = 890 * MiB;
constexpr size_t WS_YH = 954 * MiB;
constexpr size_t WS_END = 1018 * MiB;
constexpr size_t WS_X2B = 218 * MiB;
constexpr size_t WS_QP = 346 * MiB;
constexpr size_t WS_GIDX = 602 * MiB;
constexpr size_t WS_GGATE = 618 * MiB;

struct Args { const float* in[15]; float* out; unsigned char* ws; int ph_lo, ph_hi; };

DI unsigned pk_bf16(float lo, float hi) { typedef __bf16 b2 __attribute__((ext_vector_type(2))); f32x2 v = {lo, hi}; b2 b = __builtin_convertvector(v, b2); return __builtin_bit_cast(unsigned, b); }
DI float bflo(unsigned w) { return __uint_as_float(w << 16); }
DI float bfhi(unsigned w) { return __uint_as_float(w & 0xffff0000u); }
DI float sigm(float x) { return __builtin_amdgcn_rcpf(1.f + __expf(-x)); }
DI float wave_sum(float v) {
#pragma unroll
    for (int o = 1; o < 64; o <<= 1) v += __shfl_xor(v, o);
    return v;
}
DI unsigned short bf16_1(float x) { return (unsigned short)(pk_bf16(x, 0.f) & 0xffffu); }
template <int N> DI float dpp_row_shr(float v) { return __int_as_float(__builtin_amdgcn_update_dpp(0, __float_as_int(v), 0x110 + N, 0xf, 0xf, true)); }
DI float scan16(float v) { v += dpp_row_shr<1>(v); v += dpp_row_shr<2>(v); v += dpp_row_shr<4>(v); v += dpp_row_shr<8>(v); return v; }
DI int crow(int reg, int hh) { return (reg & 3) + 8 * (reg >> 2) + 4 * hh; }
#define MFMA32(a, b, c) __builtin_amdgcn_mfma_f32_32x32x16_bf16((a), (b), (c), 0, 0, 0)
#define LDS_WAIT() asm volatile("s_waitcnt lgkmcnt(0)" ::: "memory")

namespace pg8 {
#define TSTORE_WRITE(sl, e, m, x) *(PG8_LAS bf16_t*)((sl) + (4 * fq + (e)) * 144 + (16 * (m) + fr) * 2) = bf16_1(x)
struct Epi1 {
    static constexpr bool PERM = true, AFTER_DRAIN = false;
    const float* rs; bf16_t* pa; bf16_t* gg; bf16_t* qd; bf16_t* kinv; bf16_t* kendT; bf16_t* vT; bf16_t* gs; float* dec; const float* lb; bf16_t* avT; PG8_LAS unsigned char* xl;
    __device__ __forceinline__ void operator()(const f32x4 (&acc)[2][2][4][2], const Unit& u, int wr, int wc, int fr, int fq) const {
        asm volatile("" : "+v"(fr), "+v"(fq));
        const int row0 = u.pm * BM + wr * 64 + fr, pn = u.pn;
        if (pn == 2) {
            const int c8 = wc * 32 + 8 * fq, tseqb = (u.pm & 15) * 256 + wr * 64 + fr, bb = u.pm >> 4;
#pragma unroll
            for (int ai = 0; ai < 2; ++ai)
#pragma unroll
                for (int m = 0; m < 4; ++m) { const int row = row0 + ai * HALF + m * 16; const float s = rs[row];
                    const f32x4 v0 = acc[ai][0][m][0] * s, v1 = acc[ai][0][m][1] * s;
                    u32x4 w; w.x = pk_bf16(v0[0], v0[1]); w.y = pk_bf16(v0[2], v0[3]); w.z = pk_bf16(v1[0], v1[1]); w.w = pk_bf16(v1[2], v1[3]);
                    *(u32x4*)(pa + (size_t)row * 768 + 512 + c8) = w;
                }
            PG8_LAS unsigned char* sl = xl + (wr * 4 + wc) * 2304; const int lane_ = fq * 16 + fr;
#pragma unroll
            for (int ai = 0; ai < 2; ++ai)
#pragma unroll
                for (int n = 0; n < 2; ++n) {
#pragma unroll
                    for (int m = 0; m < 4; ++m) { const float s = rs[row0 + ai * HALF + m * 16];
#pragma unroll
                        for (int e = 0; e < 4; ++e) TSTORE_WRITE(sl, e, m, acc[ai][1][m][n][e] * s); }
                    asm volatile("s_waitcnt lgkmcnt(0)" ::: "memory");
#pragma unroll
                    for (int q = 0; q < 2; ++q) { const int c = lane_ + 64 * q, rw = c >> 3, tc = c & 7, col = wc * 32 + 8 * (rw >> 2) + 4 * n + (rw & 3);
                        const u32x4 w = *(const PG8_LAS u32x4*)(sl + rw * 144 + tc * 16);
                        *(u32x4*)(avT + (size_t)((bb * 2 + (col >> 6)) * 64 + (col & 63)) * SEQ + (u.pm & 15) * 256 + ai * HALF + wr * 64 + 8 * tc) = w; }
                    asm volatile("s_waitcnt lgkmcnt(0)" ::: "memory");
                }
            return;
        }
        if (pn < 3 || pn >= 11) {
            bf16_t* O; int ldc, colt;
            if (pn < 3) { O = pa; ldc = 768; colt = pn * 256; } else { O = gg; ldc = 2048; colt = (pn - 11) * 256; }
            const int col0 = colt + wc * 32 + 8 * fq;
#pragma unroll
            for (int ai = 0; ai < 2; ++ai)
#pragma unroll
                for (int m = 0; m < 4; ++m) { const int row = row0 + ai * HALF + m * 16; const float s = rs[row]; bf16_t* rowp = O + (size_t)row * ldc + col0;
#pragma unroll
                    for (int bj = 0; bj < 2; ++bj) { const f32x4 v0 = acc[ai][bj][m][0] * s, v1 = acc[ai][bj][m][1] * s;
                        u32x4 w; w.x = pk_bf16(v0[0], v0[1]); w.y = pk_bf16(v0[2], v0[3]); w.z = pk_bf16(v1[0], v1[1]); w.w = pk_bf16(v1[2], v1[3]);
                        *(u32x4*)(rowp + bj * HALF) = w; } }
            return;
        }
        PG8_LAS unsigned char* sl = xl + (wr * 4 + wc) * 2304; const int lane_ = fq * 16 + fr;
        const int h = (pn - 3) & 3, c8 = wc * 32 + 8 * fq, bh = (u.pm >> 4) * 4 + h;
        if (pn < 7) {
#pragma unroll
            for (int ai = 0; ai < 2; ++ai) {
                const int tseq0 = (u.pm & 15) * 256 + ai * HALF + wr * 64;
                float rsv[4]; float decv[8];
#pragma unroll
                for (int m = 0; m < 4; ++m) rsv[m] = rs[row0 + ai * HALF + m * 16];
#pragma unroll
                for (int n = 0; n < 2; ++n) {
                    float qdv[4][4], kiv[4][4];
#pragma unroll
                    for (int e = 0; e < 4; ++e) {
                        const int dk = c8 + 4 * n + e; const float lbc = lb[h * 128 + dk];
                        float f[4], p[4];
#pragma unroll
                        for (int m = 0; m < 4; ++m) { const float x = acc[ai][1][m][n][e] * rsv[m]; f[m] = lbc + (1.f - lbc) * sigm(x); p[m] = scan16(__logf(f[m])); }
                        const float t0 = __shfl(p[0], 15, 16), t1 = __shfl(p[1], 15, 16), t2 = __shfl(p[2], 15, 16), t3 = __shfl(p[3], 15, 16);
                        const float bl = (t0 + t1) + (t2 + t3), dc = __expf(bl); decv[4 * n + e] = dc;
                        const float bb[4] = {p[0], p[1] + t0, p[2] + (t0 + t1), p[3] + ((t0 + t1) + t2)};
#pragma unroll
                        for (int m = 0; m < 4; ++m) { const float eb = __expf(bb[m]), einv = __builtin_amdgcn_rcpf(eb), k = 1.f - f[m], xq = acc[ai][0][m][n][e] * rsv[m];
                            qdv[m][e] = xq * sigm(xq) * eb; kiv[m][e] = k * einv; TSTORE_WRITE(sl, e, m, k * einv * dc); }
                    }
#pragma unroll
                    for (int m = 0; m < 4; ++m) { const size_t o = (size_t)(row0 + ai * HALF + m * 16) * 512 + h * 128 + c8 + 4 * n;
                        u32x2 w; w.x = pk_bf16(qdv[m][0], qdv[m][1]); w.y = pk_bf16(qdv[m][2], qdv[m][3]); *(u32x2*)(qd + o) = w;
                        u32x2 z; z.x = pk_bf16(kiv[m][0], kiv[m][1]); z.y = pk_bf16(kiv[m][2], kiv[m][3]); *(u32x2*)(kinv + o) = z; }
                    asm volatile("s_waitcnt lgkmcnt(0)" ::: "memory");
#pragma unroll
                    for (int q = 0; q < 2; ++q) { const int c = lane_ + 64 * q, rw = c >> 3, tc = c & 7, dkr = wc * 32 + 8 * (rw >> 2) + 4 * n + (rw & 3);
                        const u32x4 w = *(const PG8_LAS u32x4*)(sl + rw * 144 + tc * 16);
                        *(u32x4*)(kendT + (size_t)(bh * 128 + dkr) * SEQ + tseq0 + 8 * tc) = w; }
                    asm volatile("s_waitcnt lgkmcnt(0)" ::: "memory");
                }
                if (fr == 0) { float* dp = dec + (size_t)(bh * 64 + (tseq0 >> 6)) * 128 + c8;
                    *(f32x4*)dp = (f32x4){decv[0], decv[1], decv[2], decv[3]}; *(f32x4*)(dp + 4) = (f32x4){decv[4], decv[5], decv[6], decv[7]}; }
            }
        } else {
#pragma unroll
            for (int ai = 0; ai < 2; ++ai) {
                const int tseq0 = (u.pm & 15) * 256 + ai * HALF + wr * 64;
#pragma unroll
                for (int n = 0; n < 2; ++n) {
#pragma unroll
                    for (int m = 0; m < 4; ++m) { const float s = rs[row0 + ai * HALF + m * 16];
#pragma unroll
                        for (int e = 0; e < 4; ++e) TSTORE_WRITE(sl, e, m, acc[ai][0][m][n][e] * s); }
                    asm volatile("s_waitcnt lgkmcnt(0)" ::: "memory");
#pragma unroll
                    for (int q = 0; q < 2; ++q) { const int c = lane_ + 64 * q, rw = c >> 3, tc = c & 7, dvr = wc * 32 + 8 * (rw >> 2) + 4 * n + (rw & 3);
                        const u32x4 w = *(const PG8_LAS u32x4*)(sl + rw * 144 + tc * 16);
                        *(u32x4*)(vT + (size_t)(bh * 128 + dvr) * SEQ + tseq0 + 8 * tc) = w; }
                    asm volatile("s_waitcnt lgkmcnt(0)" ::: "memory");
                }
#pragma unroll
                for (int m = 0; m < 4; ++m) { const int row = row0 + ai * HALF + m * 16; const float s = rs[row];
                    f32x4 g0 = acc[ai][1][m][0] * s, g1 = acc[ai][1][m][1] * s;
#pragma unroll
                    for (int e = 0; e < 4; ++e) { g0[e] *= sigm(g0[e]); g1[e] *= sigm(g1[e]); }
                    u32x4 w; w.x = pk_bf16(g0[0], g0[1]); w.y = pk_bf16(g0[2], g0[3]); w.z = pk_bf16(g1[0], g1[1]); w.w = pk_bf16(g1[2], g1[3]);
                    *(u32x4*)(gs + (size_t)row * 512 + h * 128 + c8) = w; }
            }
        }
    }
};
struct EpiDummy {
    static constexpr bool PERM = true, AFTER_DRAIN = false;
    bf16_t* O; const float* rs;
    __device__ __forceinline__ void operator()(const f32x4 (&acc)[2][2][4][2], const Unit& u, int wr, int wc, int fr, int fq) const {
        asm volatile("" : "+v"(fr), "+v"(fq));
        const int row0 = wr * 64 + fr, col0 = wc * 32 + 8 * fq;
#pragma unroll
        for (int ai = 0; ai < 2; ++ai)
#pragma unroll
            for (int m = 0; m < 4; ++m) { const int row = row0 + ai * HALF + m * 16; const float s = rs[u.pm * BM + row]; bf16_t* rowp = O + (size_t)blockIdx.x * 65536 + (size_t)row * 256 + col0;
#pragma unroll
                for (int bj = 0; bj < 2; ++bj) { const f32x4 v0 = acc[ai][bj][m][0] * s, v1 = acc[ai][bj][m][1] * s;
                    u32x4 w; w.x = pk_bf16(v0[0], v0[1]); w.y = pk_bf16(v0[2], v0[3]); w.z = pk_bf16(v1[0], v1[1]); w.w = pk_bf16(v1[2], v1[3]);
                    *(u32x4*)(rowp + bj * HALF) = w; } }
    }
};
template <bool ADD> struct EpiMerge {
    static constexpr bool PERM = true, AFTER_DRAIN = false;
    bf16_t* O; const bf16_t* gate;
    __device__ __forceinline__ void operator()(const f32x4 (&acc)[2][2][4][2], const Unit& u, int wr, int wc, int fr, int fq) const {
        const int row0 = u.pm * BM + wr * 64 + fr, col0 = u.pn * BM + wc * 32 + 8 * fq;
#pragma unroll
        for (int ai = 0; ai < 2; ++ai)
#pragma unroll
            for (int m = 0; m < 4; ++m) { const int row = row0 + ai * HALF + m * 16; bf16_t* rowp = O + (size_t)row * DM + col0; const bf16_t* gp = gate + (size_t)row * 2048 + col0;
#pragma unroll
                for (int bj = 0; bj < 2; ++bj) { const u32x4 g = *(const u32x4*)(gp + bj * HALF);
                    f32x4 v0 = acc[ai][bj][m][0], v1 = acc[ai][bj][m][1];
                    v0[0] *= sigm(bflo(g.x)); v0[1] *= sigm(bfhi(g.x)); v0[2] *= sigm(bflo(g.y)); v0[3] *= sigm(bfhi(g.y));
                    v1[0] *= sigm(bflo(g.z)); v1[1] *= sigm(bfhi(g.z)); v1[2] *= sigm(bflo(g.w)); v1[3] *= sigm(bfhi(g.w));
                    if (ADD) { const u32x4 o = *(const u32x4*)(rowp + bj * HALF);
                        v0[0] += bflo(o.x); v0[1] += bfhi(o.x); v0[2] += bflo(o.y); v0[3] += bfhi(o.y); v1[0] += bflo(o.z); v1[1] += bfhi(o.z); v1[2] += bflo(o.w); v1[3] += bfhi(o.w); }
                    u32x4 w; w.x = pk_bf16(v0[0], v0[1]); w.y = pk_bf16(v0[2], v0[3]); w.z = pk_bf16(v1[0], v1[1]); w.w = pk_bf16(v1[2], v1[3]);
                    *(u32x4*)(rowp + bj * HALF) = w; } }
    }
};
struct EpiX2 {
    static constexpr bool PERM = true, AFTER_DRAIN = false;
    const float* X; bf16_t* X2B; float* ssq;
    __device__ __forceinline__ void operator()(const f32x4 (&acc)[2][2][4][2], const Unit& u, int wr, int wc, int fr, int fq) const {
        const int row0 = u.pm * BM + wr * 64 + fr, col0 = u.pn * BM + wc * 32 + 8 * fq;
#pragma unroll
        for (int ai = 0; ai < 2; ++ai)
#pragma unroll
            for (int m = 0; m < 4; ++m) { const int row = row0 + ai * HALF + m * 16; const size_t off = (size_t)row * DM + col0; float ss = 0.f;
#pragma unroll
                for (int bj = 0; bj < 2; ++bj) { const f32x4 x0 = *(const f32x4*)(X + off + bj * HALF), x1 = *(const f32x4*)(X + off + bj * HALF + 4);
                    const f32x4 v0 = acc[ai][bj][m][0] + x0, v1 = acc[ai][bj][m][1] + x1;
                    u32x4 w; w.x = pk_bf16(v0[0], v0[1]); w.y = pk_bf16(v0[2], v0[3]); w.z = pk_bf16(v1[0], v1[1]); w.w = pk_bf16(v1[2], v1[3]);
                    *(u32x4*)(X2B + off + bj * HALF) = w;
                    ss += (v0[0] * v0[0] + v0[1] * v0[1]) + (v0[2] * v0[2] + v0[3] * v0[3]) + (v1[0] * v1[0] + v1[1] * v1[1]) + (v1[2] * v1[2] + v1[3] * v1[3]); }
                ss += __shfl_xor(ss, 16); ss += __shfl_xor(ss, 32);
                if (fq == 0) ssq[(size_t)row * 16 + u.pn * 4 + wc] = ss; }
    }
};
struct EpiQp {
    static constexpr bool PERM = true, AFTER_DRAIN = false;
    bf16_t* O; const float* ssq;
    __device__ __forceinline__ void operator()(const f32x4 (&acc)[2][2][4][2], const Unit& u, int wr, int wc, int fr, int fq) const {
        const int row0 = u.pm * BM + wr * 64 + fr, col0 = u.pn * BM + wc * 32 + 8 * fq;
#pragma unroll
        for (int ai = 0; ai < 2; ++ai)
#pragma unroll
            for (int m = 0; m < 4; ++m) { const int row = row0 + ai * HALF + m * 16; const f32x4* sp = (const f32x4*)(ssq + (size_t)row * 16);
                const f32x4 a = sp[0], b = sp[1], c = sp[2], d = sp[3];
                const float tot = ((a[0] + a[1]) + (a[2] + a[3])) + ((b[0] + b[1]) + (b[2] + b[3])) + ((c[0] + c[1]) + (c[2] + c[3])) + ((d[0] + d[1]) + (d[2] + d[3]));
                const float s = __builtin_amdgcn_rsqf(tot * (1.f / 1024.f) + EPS); bf16_t* rowp = O + (size_t)row * 2048 + col0;
#pragma unroll
                for (int bj = 0; bj < 2; ++bj) { const f32x4 v0 = acc[ai][bj][m][0] * s, v1 = acc[ai][bj][m][1] * s;
                    u32x4 w; w.x = pk_bf16(v0[0], v0[1]); w.y = pk_bf16(v0[2], v0[3]); w.z = pk_bf16(v1[0], v1[1]); w.w = pk_bf16(v1[2], v1[3]);
                    *(u32x4*)(rowp + bj * HALF) = w; } }
    }
};
}

DI int w1_src_col(int n) {
    if (n < 768 || n >= 2816) return n;
    if (n < 1792) { const int h = (n - 768) >> 8, r = (n - 768) & 255; return r < 128 ? C_HQ + 128 * h + r : C_HF + 128 * h + (r - 128); }
    const int h = (n - 1792) >> 8, r = (n - 1792) & 255; return r < 128 ? C_HI + 128 * h + r : C_HG + 128 * h + (r - 128);
}
template <bool PERMW1> DI void p0_transpose_item(const float* W, int K, int N, bf16_t* WT, const float* g, int gmask, LAS float* scr, int item, int lane) {
    const int nblk = N / 32, kb = item / nblk, nb = item % nblk, k0 = 64 * kb, n0 = 32 * nb, ns = PERMW1 ? w1_src_col(n0) : n0;
#pragma unroll 8
    for (int i = 0; i < 32; ++i) { const int kk = 2 * i + (lane >> 5); float w = W[(size_t)(k0 + kk) * N + ns + (lane & 31)]; if (g) w *= g[(k0 + kk) & gmask]; scr[kk * 33 + (lane & 31)] = w; }
    LDS_WAIT(); asm volatile("" ::: "memory");
    const int c = lane & 7;
#pragma unroll
    for (int j = 0; j < 4; ++j) { const int n = (lane >> 3) + 8 * j; const LAS float* s = scr + (8 * c) * 33 + n;
        u32x4 o; o.x = pk_bf16(s[0 * 33], s[1 * 33]); o.y = pk_bf16(s[2 * 33], s[3 * 33]); o.z = pk_bf16(s[4 * 33], s[5 * 33]); o.w = pk_bf16(s[6 * 33], s[7 * 33]);
        *(u32x4*)(WT + (size_t)(n0 + n) * K + k0 + 8 * c) = o; }
    LDS_WAIT(); asm volatile("" ::: "memory");
}
DI unsigned pk_f16(float a, float b) { h16x2 v = {(_Float16)a, (_Float16)b}; return __builtin_bit_cast(unsigned, v); }

DI void p0_prologue(const Args& a, LAS unsigned char* lds, int vb, int G) {
    const int tid = threadIdx.x, lane = tid & 63, wave = tid >> 6;
    const int gw = vb * 8 + wave, NGW = G * 8, gt = vb * NTHR + tid, NGT = G * NTHR;
    unsigned char* ws = a.ws;
    LAS float* scr = (LAS float*)(lds + wave * 16384);
    constexpr int I_W1 = 16 * 152, I_AP = 8 * 32, I_HP = 8 * 32, I_OUT = 16 * 32, I_Q = 16 * 64, NITEMS = I_W1 + I_AP + I_HP + I_OUT + I_Q;
    for (int it = gw; it < NITEMS; it += NGW) {
        int r = it;
        if (r < I_W1) { p0_transpose_item<true>(a.in[2], 1024, NIN, (bf16_t*)(ws + WS_W1T), a.in[1], 1023, scr, r, lane); continue; } r -= I_W1;
        if (r < I_AP) { p0_transpose_item<false>(a.in[6], 512, 1024, (bf16_t*)(ws + WS_WAPT), nullptr, 0, scr, r, lane); continue; } r -= I_AP;
        if (r < I_HP) { p0_transpose_item<false>(a.in[7], 512, 1024, (bf16_t*)(ws + WS_WHPT), a.in[5], 127, scr, r, lane); continue; } r -= I_HP;
        if (r < I_OUT) { p0_transpose_item<false>(a.in[8], 1024, 1024, (bf16_t*)(ws + WS_WOUTT), nullptr, 0, scr, r, lane); continue; } r -= I_OUT;
        p0_transpose_item<false>(a.in[10], 1024, 2048, (bf16_t*)(ws + WS_WQT), a.in[9], 1023, scr, r, lane);
    }
    for (int i = gt; i < 2 * 8 * 128 * 128 / 4; i += NGT) { const f32x4 v = ((const f32x4*)a.in[11])[i]; u32x2 o; o.x = pk_bf16(v[0], v[1]); o.y = pk_bf16(v[2], v[3]); ((u32x2*)(ws + WS_KEYS))[i] = o; }
    for (int it = gw; it < 2 * 16384; it += NGW) {
        const int isv = it >= 16384, e = it & 16383;
        const float* src = (isv ? a.in[13] : a.in[12]) + (size_t)e * 1024 + 16 * lane;
        f32x4 x[4]; float amax = 0.f;
#pragma unroll
        for (int i = 0; i < 4; ++i) { x[i] = *(const f32x4*)(src + 4 * i); if (!isv) x[i] *= *(const f32x4*)(a.in[9] + 16 * lane + 4 * i);
            amax = fmaxf(fmaxf(amax, fmaxf(fabsf(x[i][0]), fabsf(x[i][1]))), fmaxf(fabsf(x[i][2]), fabsf(x[i][3]))); }
#pragma unroll
        for (int o = 1; o < 64; o <<= 1) amax = fmaxf(amax, __shfl_xor(amax, o));
        const float qs = amax > 0.f ? 127.f / amax : 0.f; const int off = isv ? 128 : 0;
        u32x4 w;
#pragma unroll
        for (int i = 0; i < 4; ++i) { const int q0 = (int)rintf(x[i][0] * qs) + off, q1 = (int)rintf(x[i][1] * qs) + off, q2 = (int)rintf(x[i][2] * qs) + off, q3 = (int)rintf(x[i][3] * qs) + off;
            w[i] = (unsigned)(q0 & 255) | ((unsigned)(q1 & 255) << 8) | ((unsigned)(q2 & 255) << 16) | ((unsigned)(q3 & 255) << 24); }
        *(u32x4*)(ws + (isv ? WS_V8 : WS_U8) + (size_t)e * 1024 + 16 * lane) = w;
        if (lane == 0) ((float*)(ws + (isv ? WS_SV : WS_SU)))[e] = amax * (1.f / 127.f);
    }
    for (int row = gw; row < T; row += NGW) {
        const f32x4* xr = (const f32x4*)(a.in[0] + (size_t)row * DM) + lane; f32x4 v[4]; float s = 0.f;
#pragma unroll
        for (int j = 0; j < 4; ++j) { v[j] = xr[64 * j]; s += (v[j][0] * v[j][0] + v[j][1] * v[j][1]) + (v[j][2] * v[j][2] + v[j][3] * v[j][3]); }
        s = wave_sum(s);
        u32x2* o = (u32x2*)(ws + WS_XB + (size_t)row * DM * 2) + lane;
#pragma unroll
        for (int j = 0; j < 4; ++j) { u32x2 w; w.x = pk_bf16(v[j][0], v[j][1]); w.y = pk_bf16(v[j][2], v[j][3]); o[64 * j] = w; }
        if (lane == 0) ((float*)(ws + WS_RSTD1))[row] = __builtin_amdgcn_rsqf(s * (1.f / 1024.f) + EPS);
    }
    if (vb == 0) { const float l0 = a.in[4][tid], l1 = a.in[4][512 + tid]; ((float*)(ws + WS_LB))[tid] = 1.f / (1.f + __expf(l1 - l0)); }
}

DI void attn_task(const bf16_t* pa, const bf16_t* avT, const float* sinks, bf16_t* ya, int b, int qb, int h) {
    const int lane = threadIdx.x & 63, r = lane & 31, hh = lane >> 5, kvh = h >> 2;
    const size_t trow = (size_t)b * SEQ + qb * 32 + r;
    constexpr float LOG2E = 1.4426950408889634f;
    bf16x8 qf[4];
    { const bf16_t* qp = pa + trow * 768 + h * 64 + 8 * hh;
#pragma unroll
      for (int s = 0; s < 4; ++s) qf[s] = *(const bf16x8*)(qp + 16 * s); }
    const float slope2 = exp2f(-(float)(h + 1)) * LOG2E, sink2 = sinks[h] * LOG2E, qs = 0.125f * LOG2E;
    f32x16 S[5]; float m = sink2;
#pragma unroll
    for (int i = 0; i < 5; ++i) { const int kb = qb - 4 + i;
        if (kb >= 0) {
#pragma unroll
            for (int q = 0; q < 16; ++q) S[i][q] = 0.f;
            const bf16_t* kp = pa + ((size_t)b * SEQ + kb * 32 + r) * 768 + 512 + kvh * 64 + 8 * hh;
#pragma unroll
            for (int s = 0; s < 4; ++s) S[i] = MFMA32(*(const bf16x8*)(kp + 16 * s), qf[s], S[i]);
#pragma unroll
            for (int q = 0; q < 16; ++q) { const int dist = 32 * (4 - i) + r - crow(q, hh); float v = S[i][q] * qs - slope2 * (float)dist;
                if (i == 0) v = (dist <= 127) ? v : -1e30f;
                if (i == 4) v = (dist >= 0) ? v : -1e30f;
                S[i][q] = v; m = fmaxf(m, v); }
        } }
    m = fmaxf(m, __shfl_xor(m, 32));
    float l = 0.f;
#pragma unroll
    for (int i = 0; i < 5; ++i) if (qb - 4 + i >= 0) {
#pragma unroll
        for (int q = 0; q < 16; ++q) { const float p = __builtin_amdgcn_exp2f(S[i][q] - m); S[i][q] = p; l += p; } }
    l += __shfl_xor(l, 32); l += __builtin_amdgcn_exp2f(sink2 - m);
    f32x16 O[2];
#pragma unroll
    for (int q = 0; q < 16; ++q) { O[0][q] = 0.f; O[1][q] = 0.f; }
#pragma unroll
    for (int i = 0; i < 5; ++i) { const int kb = qb - 4 + i;
        if (kb >= 0) {
#pragma unroll
            for (int s2 = 0; s2 < 2; ++s2) {
                u32x4 pb; pb.x = pk_bf16(S[i][8 * s2], S[i][8 * s2 + 1]); pb.y = pk_bf16(S[i][8 * s2 + 2], S[i][8 * s2 + 3]); pb.z = pk_bf16(S[i][8 * s2 + 4], S[i][8 * s2 + 5]); pb.w = pk_bf16(S[i][8 * s2 + 6], S[i][8 * s2 + 7]);
#pragma unroll
                for (int dt = 0; dt < 2; ++dt) { const bf16_t* vp = avT + (size_t)((b * 2 + kvh) * 64 + 32 * dt + r) * SEQ + kb * 32 + 16 * s2 + 4 * hh;
                    const u32x2 v0 = *(const u32x2*)vp, v1 = *(const u32x2*)(vp + 8); u32x4 av; av.x = v0.x; av.y = v0.y; av.z = v1.x; av.w = v1.y;
                    O[dt] = MFMA32(__builtin_bit_cast(bf16x8, av), __builtin_bit_cast(bf16x8, pb), O[dt]); }
            } } }
    const float inv = 1.f / l;
#pragma unroll
    for (int dt = 0; dt < 2; ++dt)
#pragma unroll
        for (int g = 0; g < 4; ++g) { u32x2 w; w.x = pk_bf16(O[dt][4 * g] * inv, O[dt][4 * g + 1] * inv); w.y = pk_bf16(O[dt][4 * g + 2] * inv, O[dt][4 * g + 3] * inv);
            *(u32x2*)(ya + trow * 512 + h * 64 + 32 * dt + 8 * g + 4 * hh) = w; }
}

DI void hgrn_ds_unit(const bf16_t* kendT, const bf16_t* vT, bf16_t* dsT, int bh, int c) {
    const int lane = threadIdx.x & 63, wave = threadIdx.x >> 6, r = lane & 31, hh = lane >> 5, i = wave >> 1, j0 = 2 * (wave & 1);
    const bf16_t* ka = kendT + (size_t)(bh * 128 + 32 * i + r) * SEQ + c * 64 + 8 * hh;
    const bf16_t* vb0 = vT + (size_t)(bh * 128 + 32 * j0 + r) * SEQ + c * 64 + 8 * hh; const bf16_t* vb1 = vb0 + (size_t)32 * SEQ;
    f32x16 D0, D1;
#pragma unroll
    for (int q = 0; q < 16; ++q) { D0[q] = 0.f; D1[q] = 0.f; }
#pragma unroll
    for (int ks = 0; ks < 4; ++ks) { const bf16x8 a = *(const bf16x8*)(ka + 16 * ks), b0 = *(const bf16x8*)(vb0 + 16 * ks), b1 = *(const bf16x8*)(vb1 + 16 * ks); D0 = MFMA32(a, b0, D0); D1 = MFMA32(a, b1, D1); }
    const int unit = bh * 64 + c;
    bf16_t* o0 = dsT + (size_t)(unit * 128 + 32 * j0 + r) * 128 + 32 * i + 4 * hh; bf16_t* o1 = o0 + 32 * 128;
#pragma unroll
    for (int g = 0; g < 4; ++g) { u32x2 w; w.x = pk_bf16(D0[4 * g], D0[4 * g + 1]); w.y = pk_bf16(D0[4 * g + 2], D0[4 * g + 3]); *(u32x2*)(o0 + 8 * g) = w;
        u32x2 z; z.x = pk_bf16(D1[4 * g], D1[4 * g + 1]); z.y = pk_bf16(D1[4 * g + 2], D1[4 * g + 3]); *(u32x2*)(o1 + 8 * g) = z; }
}
DI void hgrn_scan(bf16_t* dsT, const float* dec, int vb, int G) {
    for (int idx = vb * NTHR + threadIdx.x; idx < 64 * 128 * 16; idx += G * NTHR) {
        const int dk8 = idx & 15, dv = (idx >> 4) & 127, bh = idx >> 11;
        float S[8];
#pragma unroll
        for (int q = 0; q < 8; ++q) S[q] = 0.f;
        for (int c0 = 0; c0 < 64; c0 += 8) {
            u32x4 ld[8]; f32x4 d0[8], d1[8];
#pragma unroll
            for (int i = 0; i < 8; ++i) { const int c = c0 + i; ld[i] = *(const u32x4*)(dsT + (size_t)((bh * 64 + c) * 128 + dv) * 128 + dk8 * 8);
                const float* dp = dec + (size_t)(bh * 64 + c) * 128 + dk8 * 8; d0[i] = *(const f32x4*)dp; d1[i] = *(const f32x4*)(dp + 4); }
#pragma unroll
            for (int i = 0; i < 8; ++i) { const int c = c0 + i;
                u32x4 w; w.x = pk_bf16(S[0], S[1]); w.y = pk_bf16(S[2], S[3]); w.z = pk_bf16(S[4], S[5]); w.w = pk_bf16(S[6], S[7]);
                *(u32x4*)(dsT + (size_t)((bh * 64 + c) * 128 + dv) * 128 + dk8 * 8) = w;
                S[0] = d0[i][0] * S[0] + bflo(ld[i].x); S[1] = d0[i][1] * S[1] + bfhi(ld[i].x); S[2] = d0[i][2] * S[2] + bflo(ld[i].y); S[3] = d0[i][3] * S[3] + bfhi(ld[i].y);
                S[4] = d1[i][0] * S[4] + bflo(ld[i].z); S[5] = d1[i][1] * S[5] + bfhi(ld[i].z); S[6] = d1[i][2] * S[6] + bflo(ld[i].w); S[7] = d1[i][3] * S[7] + bfhi(ld[i].w); }
        }
    }
}
DI void hgrn_out_unit(const bf16_t* qd, const bf16_t* kinv, const bf16_t* vT, const bf16_t* spT, const bf16_t* gs, bf16_t* yh, LAS float* zs, int bh, int c) {
    const int tid = threadIdx.x, lane = tid & 63, wave = __builtin_amdgcn_readfirstlane(tid >> 6), r = lane & 31, hh = lane >> 5, tb = wave >> 2, db = wave & 3, b = bh >> 2, h = bh & 3;
    const size_t Tb = (size_t)b * SEQ + c * 64;
    bf16x8 qf[8], sf[8], kf0[8], kf1[8]; u32x2 vf[2][2][2];
    { const bf16_t* qrow = qd + (Tb + 32 * tb + r) * 512 + h * 128 + 8 * hh; const bf16_t* sp = spT + (size_t)((bh * 64 + c) * 128 + 32 * db + r) * 128 + 8 * hh;
      const bf16_t* k0 = kinv + (Tb + r) * 512 + h * 128 + 8 * hh; const bf16_t* vrow = vT + (size_t)(bh * 128 + 32 * db + r) * SEQ + c * 64 + 4 * hh;
#pragma unroll
      for (int ks = 0; ks < 8; ++ks) { qf[ks] = *(const bf16x8*)(qrow + 16 * ks); sf[ks] = *(const bf16x8*)(sp + 16 * ks); kf0[ks] = *(const bf16x8*)(k0 + 16 * ks); }
      if (tb) {
#pragma unroll
          for (int ks = 0; ks < 8; ++ks) kf1[ks] = *(const bf16x8*)(k0 + 32 * 512 + 16 * ks); }
#pragma unroll
      for (int sb = 0; sb < 2; ++sb)
#pragma unroll
          for (int s2 = 0; s2 < 2; ++s2) if (sb <= tb) { vf[sb][s2][0] = *(const u32x2*)(vrow + 32 * sb + 16 * s2); vf[sb][s2][1] = *(const u32x2*)(vrow + 32 * sb + 16 * s2 + 8); } }
    f32x16 Z;
#pragma unroll
    for (int q = 0; q < 16; ++q) Z[q] = 0.f;
#pragma unroll
    for (int ks = 0; ks < 8; ++ks) Z = MFMA32(qf[ks], sf[ks], Z);
#pragma unroll
    for (int sb = 0; sb < 2; ++sb) if (sb <= tb) {
        f32x16 X;
#pragma unroll
        for (int q = 0; q < 16; ++q) X[q] = 0.f;
#pragma unroll
        for (int ks = 0; ks < 8; ++ks) X = MFMA32(sb ? kf1[ks] : kf0[ks], qf[ks], X);
        if (sb == tb) {
#pragma unroll
            for (int q = 0; q < 16; ++q) if (crow(q, hh) > r) X[q] = 0.f;
        }
#pragma unroll
        for (int s2 = 0; s2 < 2; ++s2) {
            u32x4 pa_; pa_.x = pk_bf16(X[8 * s2], X[8 * s2 + 1]); pa_.y = pk_bf16(X[8 * s2 + 2], X[8 * s2 + 3]); pa_.z = pk_bf16(X[8 * s2 + 4], X[8 * s2 + 5]); pa_.w = pk_bf16(X[8 * s2 + 6], X[8 * s2 + 7]);
            u32x4 pb_; pb_.x = vf[sb][s2][0].x; pb_.y = vf[sb][s2][0].y; pb_.z = vf[sb][s2][1].x; pb_.w = vf[sb][s2][1].y;
            Z = MFMA32(__builtin_bit_cast(bf16x8, pa_), __builtin_bit_cast(bf16x8, pb_), Z);
        }
    }
#pragma unroll
    for (int q = 0; q < 16; ++q) zs[(32 * tb + crow(q, hh)) * 132 + 32 * db + r] = Z[q];
    __syncthreads();
    { const int tok = tid >> 3, d16 = (tid & 7) * 16; f32x4 o[4]; float ss = 0.f;
      const size_t off = (Tb + tok) * 512 + h * 128 + d16; const u32x4 g0 = *(const u32x4*)(gs + off), g1 = *(const u32x4*)(gs + off + 8);
#pragma unroll
      for (int i = 0; i < 4; ++i) { o[i] = *(const LAS f32x4*)(zs + tok * 132 + d16 + 4 * i); ss += (o[i][0] * o[i][0] + o[i][1] * o[i][1]) + (o[i][2] * o[i][2] + o[i][3] * o[i][3]); }
      ss += __shfl_xor(ss, 1); ss += __shfl_xor(ss, 2); ss += __shfl_xor(ss, 4);
      const float rn = __builtin_amdgcn_rsqf(ss * (1.f / 128.f) + EPS);
      u32x4 w0, w1;
      w0.x = pk_bf16(o[0][0] * rn * bflo(g0.x), o[0][1] * rn * bfhi(g0.x)); w0.y = pk_bf16(o[0][2] * rn * bflo(g0.y), o[0][3] * rn * bfhi(g0.y));
      w0.z = pk_bf16(o[1][0] * rn * bflo(g0.z), o[1][1] * rn * bfhi(g0.z)); w0.w = pk_bf16(o[1][2] * rn * bflo(g0.w), o[1][3] * rn * bfhi(g0.w));
      w1.x = pk_bf16(o[2][0] * rn * bflo(g1.x), o[2][1] * rn * bfhi(g1.x)); w1.y = pk_bf16(o[2][2] * rn * bflo(g1.y), o[2][3] * rn * bfhi(g1.y));
      w1.z = pk_bf16(o[3][0] * rn * bflo(g1.z), o[3][1] * rn * bfhi(g1.z)); w1.w = pk_bf16(o[3][2] * rn * bflo(g1.w), o[3][3] * rn * bfhi(g1.w));
      *(u32x4*)(yh + off) = w0; *(u32x4*)(yh + off + 8) = w1; }
}

DI unsigned f2ord(float f) { const unsigned b = __float_as_uint(f); return b ^ ((unsigned)((int)b >> 31) | 0x80000000u); }
DI float ord2f(unsigned k) { const unsigned b = (k & 0x80000000u) ? (k ^ 0x80000000u) : ~k; return __uint_as_float(b); }
DI void ce_desc(unsigned& a, unsigned& b) { const unsigned hi = a > b ? a : b, lo = a > b ? b : a; a = hi; b = lo; }
DI void sort16_desc(unsigned (&a)[16]) {
#pragma unroll
    for (int k = 2; k <= 16; k <<= 1)
#pragma unroll
        for (int j = k >> 1; j > 0; j >>= 1)
#pragma unroll
            for (int i = 0; i < 16; ++i) { const int l = i ^ j; if (l > i) { if ((i & k) == 0) ce_desc(a[i], a[l]); else ce_desc(a[l], a[i]); } }
}
DI void merge16_desc(unsigned (&a)[16], const unsigned (&b)[16]) {
#pragma unroll
    for (int i = 0; i < 16; ++i) a[i] = a[i] > b[15 - i] ? a[i] : b[15 - i];
#pragma unroll
    for (int j = 8; j > 0; j >>= 1)
#pragma unroll
        for (int i = 0; i < 16; ++i) { const int l = i ^ j; if (l > i) ce_desc(a[i], a[l]); }
}
#define TK_INS(L, x) do { unsigned t_ = (x); _Pragma("unroll") for (int j_ = 0; j_ < 16; ++j_) { const unsigned hi_ = L[j_] > t_ ? L[j_] : t_; t_ = L[j_] > t_ ? t_ : L[j_]; L[j_] = hi_; } } while (0)

DI void topk_stage_keys(const bf16_t* keysb, LAS unsigned char* kl, int h) {
    for (int c = threadIdx.x; c < 2 * 128 * 16; c += NTHR) { const int p = c >> 11, row = (c >> 4) & 127, ch = c & 15;
        *(LAS u32x4*)(kl + (p * 128 + row) * 272 + ch * 16) = *(const u32x4*)(keysb + ((size_t)(p * 8 + h) * 128 + row) * 128 + ch * 8); }
}
DI void topk_unit(const bf16_t* qp, const LAS unsigned char* kl, unsigned short* gidx, float* ggate, LAS unsigned* tk, int quad, int h) {
    const int tid = threadIdx.x, lane = tid & 63, wave = tid >> 6, p = wave & 1, tsub = wave >> 1, r = lane & 31, hh = lane >> 5;
#pragma unroll 1
    for (int hl = 0; hl < 4; ++hl) {
        const int tok0 = (quad * 4 + hl) * 128 + tsub * 32;
        f32x16 acc[4];
#pragma unroll
        for (int kb = 0; kb < 4; ++kb)
#pragma unroll
            for (int i = 0; i < 16; ++i) acc[kb][i] = 0.f;
        const bf16_t* qrow = qp + (size_t)(tok0 + r) * 2048 + h * 256 + p * 128 + 8 * hh;
        const LAS unsigned char* kbase = kl + (p * 128 + r) * 272 + 16 * hh;
#pragma unroll
        for (int s = 0; s < 8; ++s) { const bf16x8 bq = *(const bf16x8*)(qrow + 16 * s);
#pragma unroll
            for (int kb = 0; kb < 4; ++kb) { const bf16x8 ak = *(const LAS bf16x8*)(kbase + kb * 32 * 272 + 32 * s); acc[kb] = MFMA32(ak, bq, acc[kb]); } }
        unsigned A0[16], A1[16], A2[16], A3[16];
#pragma unroll
        for (int i = 0; i < 16; ++i) { const unsigned ki = (unsigned)(crow(i, hh));
            A0[i] = (f2ord(acc[0][i]) & ~127u) | ki; A1[i] = (f2ord(acc[1][i]) & ~127u) | (32u + ki); A2[i] = (f2ord(acc[2][i]) & ~127u) | (64u + ki); A3[i] = (f2ord(acc[3][i]) & ~127u) | (96u + ki); }
        sort16_desc(A0); sort16_desc(A1); sort16_desc(A2); sort16_desc(A3);
        merge16_desc(A0, A1); merge16_desc(A2, A3); merge16_desc(A0, A2);
#pragma unroll
        for (int j = 0; j < 16; ++j) A1[j] = __shfl_xor(A0[j], 32);
        merge16_desc(A0, A1);
        if (hh == 0) { LAS u32x4* dst = (LAS u32x4*)(tk + (((hl * 2 + p) * 128 + tsub * 32 + r) * 16));
#pragma unroll
            for (int c = 0; c < 4; ++c) { u32x4 w = {A0[4 * c], A0[4 * c + 1], A0[4 * c + 2], A0[4 * c + 3]}; dst[c] = w; } }
    }
    __syncthreads();
    {
        const int tok = tid & 127, hl = tid >> 7, tile = quad * 4 + hl;
        const LAS unsigned* t1 = tk + ((hl * 2 + 0) * 128 + tok) * 16; const LAS unsigned* t2 = tk + ((hl * 2 + 1) * 128 + tok) * 16;
        float v1[16], v2[16];
        { const LAS u32x4* s1 = (const LAS u32x4*)t1; const LAS u32x4* s2 = (const LAS u32x4*)t2;
#pragma unroll
          for (int c = 0; c < 4; ++c) { const u32x4 a = s1[c], b = s2[c];
              v1[4 * c] = ord2f(a.x & ~127u); v1[4 * c + 1] = ord2f(a.y & ~127u); v1[4 * c + 2] = ord2f(a.z & ~127u); v1[4 * c + 3] = ord2f(a.w & ~127u);
              v2[4 * c] = ord2f(b.x & ~127u); v2[4 * c + 1] = ord2f(b.y & ~127u); v2[4 * c + 2] = ord2f(b.z & ~127u); v2[4 * c + 3] = ord2f(b.w & ~127u); } }
#define CKEY(i, j) ((f2ord(v1[i] + v2[j]) & ~255u) | (unsigned)((i) * 16 + (j)))
        unsigned C[16], D[16], E[16];
#pragma unroll
        for (int j = 0; j < 16; ++j) C[j] = CKEY(0, j);
#pragma unroll
        for (int j = 0; j < 8; ++j) D[j] = CKEY(1, j);
#pragma unroll
        for (int j = 0; j < 5; ++j) D[8 + j] = CKEY(2, j);
#pragma unroll
        for (int j = 0; j < 3; ++j) D[13 + j] = CKEY(4, j);
#pragma unroll
        for (int j = 0; j < 4; ++j) E[j] = CKEY(3, j);
        E[4] = CKEY(5, 0); E[5] = CKEY(5, 1); E[6] = CKEY(6, 0); E[7] = CKEY(6, 1); E[8] = CKEY(7, 0); E[9] = CKEY(7, 1);
        E[10] = CKEY(8, 0); E[11] = CKEY(9, 0); E[12] = CKEY(10, 0); E[13] = CKEY(11, 0); E[14] = CKEY(12, 0); E[15] = CKEY(13, 0);
        sort16_desc(D); sort16_desc(E);
        TK_INS(E, CKEY(14, 0)); TK_INS(E, CKEY(15, 0));
#undef CKEY
        merge16_desc(C, D); merge16_desc(C, E);
        float sc[16]; unsigned ei[16]; float mx = -1e30f;
#pragma unroll
        for (int q = 0; q < 16; ++q) { const unsigned ij = C[q] & 255u; const unsigned a = t1[ij >> 4], b = t2[ij & 15u];
            sc[q] = ord2f(a & ~127u) + ord2f(b & ~127u); ei[q] = (a & 127u) * 128u + (b & 127u); mx = fmaxf(mx, sc[q]); }
        float sum = 0.f;
#pragma unroll
        for (int q = 0; q < 16; ++q) { sc[q] = __expf(sc[q] - mx); sum += sc[q]; }
        const float inv = 1.f / sum; const size_t o = (size_t)(tile * 128 + tok) * 128 + h * 16;
        u32x4 w0, w1;
        w0.x = ei[0] | (ei[1] << 16); w0.y = ei[2] | (ei[3] << 16); w0.z = ei[4] | (ei[5] << 16); w0.w = ei[6] | (ei[7] << 16);
        w1.x = ei[8] | (ei[9] << 16); w1.y = ei[10] | (ei[11] << 16); w1.z = ei[12] | (ei[13] << 16); w1.w = ei[14] | (ei[15] << 16);
        *(u32x4*)(gidx + o) = w0; *(u32x4*)(gidx + o + 8) = w1;
#pragma unroll
        for (int c = 0; c < 4; ++c) *(f32x4*)(ggate + o + 4 * c) = (f32x4){sc[4 * c] * inv, sc[4 * c + 1] * inv, sc[4 * c + 2] * inv, sc[4 * c + 3] * inv};
    }
    __syncthreads();
}

DI float gelu_erf(float x) { return 0.5f * x * (1.f + erff(x * 0.70710678118654752f)); }
DI int dot16(u32x4 w, const int (&h)[4]) { int c = __builtin_amdgcn_sdot4((int)w.x, h[0], 0, false); c = __builtin_amdgcn_sdot4((int)w.y, h[1], c, false); c = __builtin_amdgcn_sdot4((int)w.z, h[2], c, false); return __builtin_amdgcn_sdot4((int)w.w, h[3], c, false); }
#define V8_FMA(acc4, word, we) do { acc4[0] += (we) * (float)((word) & 255u); acc4[1] += (we) * (float)(((word) >> 8) & 255u); acc4[2] += (we) * (float)(((word) >> 16) & 255u); acc4[3] += (we) * (float)((word) >> 24); } while (0)

template <int IDMASK> DI void expert_token(const bf16_t* x2row, const float* ssq, const unsigned char* u8, const unsigned char* v8, const float* su, const float* sv, const unsigned short* gidx, const float* ggate, const float* gf, float* outrow, int lane) {
    f32x4 x[4]; float amax = 0.f;
#pragma unroll
    for (int i = 0; i < 4; ++i) { const u32x2 w_ = *(const u32x2*)(x2row + 16 * lane + 4 * i); x[i] = (f32x4){bflo(w_.x), bfhi(w_.x), bflo(w_.y), bfhi(w_.y)}; amax = fmaxf(fmaxf(amax, fmaxf(fabsf(x[i][0]), fabsf(x[i][1]))), fmaxf(fabsf(x[i][2]), fabsf(x[i][3]))); }
    float ss = (lane < 16) ? ssq[lane] : 0.f; ss = wave_sum(ss);
    const float rstd2 = __builtin_amdgcn_rsqf(ss * (1.f / 1024.f) + EPS);
#pragma unroll
    for (int o = 1; o < 64; o <<= 1) amax = fmaxf(amax, __shfl_xor(amax, o));
    amax *= rstd2;
    const float qs = amax > 0.f ? 127.f / amax : 0.f, sh = amax * (1.f / 127.f), xq = rstd2 * qs;
    int hq[4];
#pragma unroll
    for (int i = 0; i < 4; ++i) { const int q0 = (int)rintf(x[i][0] * xq), q1 = (int)rintf(x[i][1] * xq), q2 = (int)rintf(x[i][2] * xq), q3 = (int)rintf(x[i][3] * xq);
        hq[i] = (int)((unsigned)(q0 & 255) | ((unsigned)(q1 & 255) << 8) | ((unsigned)(q2 & 255) << 16) | ((unsigned)(q3 & 255) << 24)); }
    const int id0 = gidx[lane] & IDMASK, id1 = gidx[64 + lane] & IDMASK; const float g0 = ggate[lane], g1 = ggate[64 + lane];
    f32x4 o[4]; float wsum = 0.f;
#pragma unroll
    for (int i = 0; i < 4; ++i) o[i] = (f32x4){0.f, 0.f, 0.f, 0.f};
#pragma unroll 1
    for (int bt = 0; bt < 16; ++bt) {
        const int idsel = (bt < 8) ? id0 : id1; const float gsel = (bt < 8) ? g0 : g1; const int lb = (bt & 7) * 8;
        u32x4 ur[8], vr[8];
#pragma unroll
        for (int e = 0; e < 8; ++e) { const int idx = __builtin_amdgcn_readlane(idsel, lb + e); ur[e] = *(const u32x4*)(u8 + (size_t)idx * 1024 + 16 * lane); }
#pragma unroll
        for (int e = 0; e < 8; ++e) { const int idx = __builtin_amdgcn_readlane(idsel, lb + e); vr[e] = *(const u32x4*)(v8 + (size_t)idx * 1024 + 16 * lane); }
        const int myidx = __shfl(idsel, lb + (lane >> 3)); const float mysu = su[myidx], mysv = sv[myidx], gate = __shfl(gsel, lb + (lane >> 3));
        int pr[8];
#pragma unroll
        for (int e = 0; e < 8; ++e) pr[e] = dot16(ur[e], hq);
        int q4[4], q2[2], q1;
        { const bool up_ = (lane & 32) != 0;
#pragma unroll
          for (int i = 0; i < 4; ++i) { const int keep = up_ ? pr[i + 4] : pr[i], send = up_ ? pr[i] : pr[i + 4]; q4[i] = keep + __shfl_xor(send, 32); } }
        { const bool up_ = (lane & 16) != 0;
#pragma unroll
          for (int i = 0; i < 2; ++i) { const int keep = up_ ? q4[i + 2] : q4[i], send = up_ ? q4[i] : q4[i + 2]; q2[i] = keep + __shfl_xor(send, 16); } }
        { const bool up_ = (lane & 8) != 0; const int keep = up_ ? q2[1] : q2[0], send = up_ ? q2[0] : q2[1]; q1 = keep + __shfl_xor(send, 8); }
        q1 += __shfl_xor(q1, 4); q1 += __shfl_xor(q1, 2); q1 += __shfl_xor(q1, 1);
        const float act = (float)q1 * (mysu * sh);
        const float w = gelu_erf(act) * gate * mysv;
#pragma unroll
        for (int e = 0; e < 8; ++e) { const float we = __int_as_float(__builtin_amdgcn_readlane(__float_as_int(w), 8 * e)); wsum += we;
            V8_FMA(o[0], vr[e].x, we); V8_FMA(o[1], vr[e].y, we); V8_FMA(o[2], vr[e].z, we); V8_FMA(o[3], vr[e].w, we); }
    }
    const float corr = 128.f * wsum; float s3 = 0.f;
#pragma unroll
    for (int i = 0; i < 4; ++i) { x[i] += o[i] - corr; s3 += (x[i][0] * x[i][0] + x[i][1] * x[i][1]) + (x[i][2] * x[i][2] + x[i][3] * x[i][3]); }
    s3 = wave_sum(s3); const float r3 = __builtin_amdgcn_rsqf(s3 * (1.f / 1024.f) + EPS);
#pragma unroll
    for (int i = 0; i < 4; ++i) *(f32x4*)(outrow + 16 * lane + 4 * i) = x[i] * r3 * *(const f32x4*)(gf + 16 * lane + 4 * i);
}

#define XB_TMO      128
#define XB_XCNT(j)  (256  + 64 * (j))
#define XB_XSUB(j)  (1280 + 64 * (j))
#define XB_XGEN(j)  (2304 + 64 * (j))
#define XB_TOP      3328
#define XB_TOPGEN   3392
#define XCD_BAR_WORDS 3456
#define XB_SPIN_CAP (1u << 18)

__device__ __forceinline__ unsigned xb_ld(unsigned* p)              { return __hip_atomic_load(p, __ATOMIC_RELAXED, __HIP_MEMORY_SCOPE_AGENT); }
__device__ __forceinline__ unsigned xb_add(unsigned* p, unsigned v) { return __hip_atomic_fetch_add(p, v, __ATOMIC_RELAXED, __HIP_MEMORY_SCOPE_AGENT); }
__device__ __forceinline__ unsigned xb_xcc_id() { return (unsigned)__builtin_amdgcn_s_getreg((3 << 11) | 20) & 0xFu; }
#define XB_SPIN(cond, bar) do { unsigned _sp = 0; while (cond) { __builtin_amdgcn_s_sleep(1); \
    if ((++_sp & 255u) == 0u) { if (xb_ld(&(bar)[XB_TMO])) break; if (_sp > XB_SPIN_CAP) { atomicAdd(&(bar)[XB_TMO], 1u); break; } } } } while (0)

struct XcdBarrier {
    unsigned* bar; unsigned x;
    volatile __attribute__((address_space(3))) unsigned* st;
};

__device__ __forceinline__ XcdBarrier xcd_barrier_post(unsigned* bar, volatile __attribute__((address_space(3))) unsigned* st) {
    XcdBarrier b; b.bar = bar; b.x = xb_xcc_id(); b.st = st;
    if (threadIdx.x == 0) (void)xb_add(&bar[XB_XCNT(b.x)], 1u);
    return b;
}
__device__ __forceinline__ void xcd_barrier_complete(unsigned* bar, unsigned x, unsigned& nloc, unsigned& nx) {
    const unsigned G = gridDim.x * gridDim.y * gridDim.z;
    unsigned sum, cnt, mine, sp = 0u;
    for (;;) {
        sum = 0u; cnt = 0u; mine = 0u;
#pragma unroll
        for (unsigned j = 0; j < 16; ++j) { const unsigned c = xb_ld(&bar[XB_XCNT(j)]); sum += c; cnt += (c > 0u) ? 1u : 0u; mine = (j == x) ? c : mine; }
        if (sum == G) break;
        __builtin_amdgcn_s_sleep(1);
        if ((++sp & 255u) == 0u) { if (xb_ld(&bar[XB_TMO])) break; if (sp > XB_SPIN_CAP) { atomicAdd(&bar[XB_TMO], 1u); break; } }
    }
    nloc = mine > 0u ? mine : 1u; nx = cnt > 0u ? cnt : 1u;
}

__device__ __forceinline__ void xcd_barrier(const XcdBarrier& b) {
    asm volatile("s_waitcnt vmcnt(0)" ::: "memory");
    __syncthreads();
    if (threadIdx.x == 0) {
        unsigned* bar = b.bar;
        __builtin_amdgcn_s_waitcnt(0);
        unsigned nloc = b.st[0], nx = b.st[1];
        if (nloc == 0u) { xcd_barrier_complete(bar, b.x, nloc, nx); b.st[0] = nloc; b.st[1] = nx; }
        const unsigned old = xb_add(&bar[XB_XSUB(b.x)], 1u);
        const unsigned gen = old / nloc;
        if (old + 1u == (gen + 1u) * nloc) {
            __builtin_amdgcn_fence(__ATOMIC_RELEASE, "agent");
            asm volatile("s_waitcnt vmcnt(0)" ::: "memory");
            const unsigned og = xb_add(&bar[XB_TOP], 1u);
            const unsigned tg = og / nx;
            if (og + 1u == (tg + 1u) * nx) xb_add(&bar[XB_TOPGEN], 1u);
            else XB_SPIN(xb_ld(&bar[XB_TOPGEN]) == tg, bar);
            __builtin_amdgcn_fence(__ATOMIC_ACQUIRE, "agent");
            xb_add(&bar[XB_XGEN(b.x)], 1u);
            asm volatile("s_waitcnt vmcnt(0)" ::: "memory");
        } else {
            XB_SPIN(xb_ld(&bar[XB_XGEN(b.x)]) == gen, bar);
            __builtin_amdgcn_fence(__ATOMIC_ACQUIRE, "agent");
            asm volatile("s_waitcnt vmcnt(0)" ::: "memory");
        }
    }
    __syncthreads();
}

constexpr int N_PHASES = 10;
__global__ void __launch_bounds__(NTHR, 2) mk_fwd(Args a) {
    extern __shared__ __attribute__((aligned(16))) unsigned char lds_raw[];
    LAS unsigned char* lds = (LAS unsigned char*)lds_raw;
    cg::grid_group grid = cg::this_grid();
    const int G = gridDim.x, vb = blockIdx.x, tid = threadIdx.x, lane = tid & 63, wave = tid >> 6;
    unsigned char* ws = a.ws;
    const int lo = a.ph_lo, hi = a.ph_hi;
    volatile LAS unsigned* MISC = (volatile LAS unsigned*)(lds + LDS_BYTES - 64);
    if (tid < 16) MISC[tid] = 0u;
    __syncthreads();
    const XcdBarrier bar = xcd_barrier_post((unsigned*)(ws + 4096) + lo * XCD_BAR_WORDS, MISC);
#ifndef PHASE_MASK
#define PHASE_MASK 0xFFFF
#endif
#define IN(k) (((PHASE_MASK >> (k)) & 1) && lo <= (k) && (k) < hi)
#ifndef REPEAT_MASK
#define REPEAT_MASK 0
#endif
#define REP(k) for (int rep_ = 0; rep_ < (((REPEAT_MASK) >> (k)) & 1) + 1; ++rep_)
#define SEAM(k) do { if (IN(k) && IN((k) + 1)) { if ((k) == 0) grid.sync(); else xcd_barrier(bar); } } while (0)
    REP(0) if (IN(0)) p0_prologue(a, lds, vb, G);
    SEAM(0);
    REP(1) if (IN(1)) { pg8::Gemm g{(const bf16_t*)(ws + WS_XB), (const bf16_t*)(ws + WS_W1T), T, NIN, 1024}; pg8::StaticOrder S; S.init(T, NIN, G, vb);
        pg8::Epi1 E{(const float*)(ws + WS_RSTD1), (bf16_t*)(ws + WS_PA), (bf16_t*)(ws + WS_GG), (bf16_t*)(ws + WS_QD), (bf16_t*)(ws + WS_KINV), (bf16_t*)(ws + WS_KENDT), (bf16_t*)(ws + WS_VT), (bf16_t*)(ws + WS_GS),
                    (float*)(ws + WS_DEC), (const float*)(ws + WS_LB), (bf16_t*)(ws + WS_AVT), lds + 131072};
        pg8::gemm_phase<pg8::Epi1, pg8::StaticOrder, true, true>(lds, g, S, E); }
#ifdef PROBE_GEMM1_PLAIN
    if (IN(1)) { pg8::Gemm g{(const bf16_t*)(ws + WS_XB), (const bf16_t*)(ws + WS_W1T), T, NIN, 1024}; pg8::StaticOrder S; S.init(T, NIN, G, vb);
        pg8::EpiDummy E{(bf16_t*)(ws + WS_YA), (const float*)(ws + WS_RSTD1)};
        pg8::gemm_phase<pg8::EpiDummy, pg8::StaticOrder, true, true>(lds, g, S, E); }
#endif
    SEAM(1);
    REP(2) if (IN(2)) {
        for (int u = vb; u < 64 * 64; u += G) hgrn_ds_unit((const bf16_t*)(ws + WS_KENDT), (const bf16_t*)(ws + WS_VT), (bf16_t*)(ws + WS_XB), u >> 6, u & 63);
        { const int hw = __builtin_amdgcn_readfirstlane(wave);
          for (int u = vb; u < BATCH * (SEQ / 32); u += G) attn_task((const bf16_t*)(ws + WS_PA), (const bf16_t*)(ws + WS_AVT), a.in[3], (bf16_t*)(ws + WS_YA), u >> 7, u & 127, hw); }
    }
    SEAM(2);
    REP(3) if (IN(3)) hgrn_scan((bf16_t*)(ws + WS_XB), (const float*)(ws + WS_DEC), vb, G);
    SEAM(3);
    REP(4) if (IN(4)) { int bsel = 0; for (int u = vb; u < 64 * 64; u += G, bsel ^= 1)
        hgrn_out_unit((const bf16_t*)(ws + WS_QD), (const bf16_t*)(ws + WS_KINV), (const bf16_t*)(ws + WS_VT), (const bf16_t*)(ws + WS_XB), (const bf16_t*)(ws + WS_GS), (bf16_t*)(ws + WS_YH), (LAS float*)(lds + bsel * 34816), u >> 6, u & 63);
        __syncthreads(); }
    SEAM(4);
    REP(5) if (IN(5)) {
        { pg8::Gemm g{(const bf16_t*)(ws + WS_YA), (const bf16_t*)(ws + WS_WAPT), T, 1024, 512}; pg8::StaticOrder S; S.init(T, 1024, G, vb);
          pg8::EpiMerge<false> E{(bf16_t*)(ws + WS_XB), (const bf16_t*)(ws + WS_GG)};
          pg8::gemm_phase<pg8::EpiMerge<false>, pg8::StaticOrder, true, true>(lds, g, S, E); }
        __syncthreads();
        { pg8::Gemm g{(const bf16_t*)(ws + WS_YH), (const bf16_t*)(ws + WS_WHPT), T, 1024, 512}; pg8::StaticOrder S; S.init(T, 1024, G, vb);
          pg8::EpiMerge<true> E{(bf16_t*)(ws + WS_XB), (const bf16_t*)(ws + WS_GG) + 1024};
          pg8::gemm_phase<pg8::EpiMerge<true>, pg8::StaticOrder, true, true>(lds, g, S, E); }
    }
    SEAM(5);
    REP(6) if (IN(6)) { pg8::Gemm g{(const bf16_t*)(ws + WS_XB), (const bf16_t*)(ws + WS_WOUTT), T, 1024, 1024}; pg8::StaticOrder S; S.init(T, 1024, G, vb);
        pg8::EpiX2 E{a.in[0], (bf16_t*)(ws + WS_X2B), (float*)(ws + WS_SSQ2)};
        pg8::gemm_phase<pg8::EpiX2, pg8::StaticOrder, true, true>(lds, g, S, E); }
    SEAM(6);
    REP(7) if (IN(7)) { pg8::Gemm g{(const bf16_t*)(ws + WS_X2B), (const bf16_t*)(ws + WS_WQT), T, 2048, 1024}; pg8::StaticOrder S; S.init(T, 2048, G, vb);
        pg8::EpiQp E{(bf16_t*)(ws + WS_QP), (const float*)(ws + WS_SSQ2)};
        pg8::gemm_phase<pg8::EpiQp, pg8::StaticOrder, true, true>(lds, g, S, E); }
    SEAM(7);
    REP(8) if (IN(8)) { const int per = (1024 + G - 1) / G; int hcur = -1;
        for (int U = vb * per; U < (vb + 1) * per && U < 1024; ++U) { const int h = U >> 7;
            if (h != hcur) { topk_stage_keys((const bf16_t*)(ws + WS_KEYS), lds + 65536, h); hcur = h; __syncthreads(); }
            topk_unit((const bf16_t*)(ws + WS_QP), lds + 65536, (unsigned short*)(ws + WS_GIDX), (float*)(ws + WS_GGATE), (LAS unsigned*)lds, U & 127, h); } }
    SEAM(8);
    REP(9) if (IN(9)) for (int tok = vb * 8 + wave; tok < T; tok += G * 8)
        expert_token<16383>((const bf16_t*)(ws + WS_X2B) + (size_t)tok * DM, (const float*)(ws + WS_SSQ2) + (size_t)tok * 16, (const unsigned char*)(ws + WS_U8), (const unsigned char*)(ws + WS_V8), (const float*)(ws + WS_SU), (const float*)(ws + WS_SV),
                     (const unsigned short*)(ws + WS_GIDX) + (size_t)tok * 128, (const float*)(ws + WS_GGATE) + (size_t)tok * 128, a.in[14], a.out + (size_t)tok * DM, lane);
#ifdef PROBE_L2_EXPERTS
    if (IN(9)) for (int tok = vb * 8 + wave; tok < T; tok += G * 8)
        expert_token<PROBE_L2_EXPERTS>((const bf16_t*)(ws + WS_X2B) + (size_t)tok * DM, (const float*)(ws + WS_SSQ2) + (size_t)tok * 16, (const unsigned char*)(ws + WS_U8), (const unsigned char*)(ws + WS_V8), (const float*)(ws + WS_SU), (const float*)(ws + WS_SV),
                     (const unsigned short*)(ws + WS_GIDX) + (size_t)tok * 128, (const float*)(ws + WS_GGATE) + (size_t)tok * 128, a.in[14], (float*)(ws + WS_QP) + (size_t)tok * DM, lane);
#endif
#undef IN
#undef SEAM
}

extern "C" void kernel_launch(void* const* d_in, const int* in_sizes, int n_in, void* d_out, int out_size, void* d_ws, size_t ws_size, hipStream_t stream) {
    static int grid = 0;
    if (grid == 0) {
        if (n_in != 15 || in_sizes[0] != T * DM || out_size != T * DM || ws_size < WS_END) { fprintf(stderr, "kernel_launch: unexpected shapes (n_in %d, in0 %d, out %d, ws %zu)\n", n_in, n_in > 0 ? in_sizes[0] : -1, out_size, ws_size); grid = -1; return; }
        int dev = 0, cus = 0, per_cu = 0;
        hipGetDevice(&dev); hipDeviceGetAttribute(&cus, hipDeviceAttributeMultiprocessorCount, dev);
        if (hipFuncSetAttribute((const void*)mk_fwd, hipFuncAttributeMaxDynamicSharedMemorySize, LDS_BYTES) != hipSuccess) { fprintf(stderr, "kernel_launch: hipFuncSetAttribute failed\n"); grid = -1; return; }
        if (hipOccupancyMaxActiveBlocksPerMultiprocessor(&per_cu, (const void*)mk_fwd, NTHR, LDS_BYTES) != hipSuccess || per_cu < 1) { fprintf(stderr, "kernel_launch: occupancy query says %d blocks per CU\n", per_cu); per_cu = 1; }
        (void)hipGetLastError();
        grid = cus;
    }
    if (grid < 0) return;
    if (hipMemsetAsync(d_ws, 0, 256 * 1024, stream) != hipSuccess) { fprintf(stderr, "kernel_launch: hipMemsetAsync failed\n"); return; }
    Args a{};
    for (int i = 0; i < 15; ++i) a.in[i] = (const float*)d_in[i];
    a.out = (float*)d_out; a.ws = (unsigned char*)d_ws;
#if MK_FUSED
    a.ph_lo = 0; a.ph_hi = N_PHASES;
    { void* args[] = {&a}; hipError_t e = hipLaunchCooperativeKernel((const void*)mk_fwd, dim3(grid), dim3(NTHR), args, LDS_BYTES, stream);
      if (e != hipSuccess) fprintf(stderr, "kernel_launch: cooperative launch failed: %s (grid %d)\n", hipGetErrorString(e), grid); }
#else
    for (int p = 0; p < N_PHASES; ++p) { a.ph_lo = p; a.ph_hi = p + 1; void* args[] = {&a};
        hipError_t e = hipLaunchCooperativeKernel((const void*)mk_fwd, dim3(grid), dim3(NTHR), args, LDS_BYTES, stream);
        if (e != hipSuccess) { fprintf(stderr, "kernel_launch: launch of phase %d failed: %s (grid %d)\n", p, hipGetErrorString(e), grid); break; } }
#endif
}
```

```cpp
#include <hip/hip_runtime.h>
#include <hip/hip_cooperative_groups.h>
#include <cstdio>
#include <cstdint>
namespace cg = cooperative_groups;
namespace pg8 {
#define PG8_LAS __attribute__((address_space(3)))
typedef unsigned short bf16_t;
typedef short bf16x8 __attribute__((ext_vector_type(8)));
typedef float f32x4 __attribute__((ext_vector_type(4)));
typedef unsigned u32x4 __attribute__((ext_vector_type(4)));
constexpr int BM = 256, BK = 64, HALF = 128, HTB = HALF * BK * 2  , STAGE_BYTES = 8 * HTB, NXCD = 8, WGM = 8;

__host__ __device__ __forceinline__ int lds_byte(int r, int c) { const int st = (r >> 4) * 2 + (c >> 5), rr = r & 15, cc = c & 31, ob = rr * 64 + cc * 2; return st * 1024 + (ob ^ (((ob >> 9) & 1) << 5)); }
__host__ __device__ __forceinline__ void stage_rc(int b, int& R, int& C) { const int st = b / 1024, sb = b % 1024, swz = sb ^ (((sb >> 9) & 1) << 5); R = (st >> 1) * 16 + swz / 64; C = (st & 1) * 32 + (swz % 64) / 2; }
__host__ __device__ __forceinline__ int perm32(int rho) { const int n = rho >> 4, i = rho & 15; return 8 * (i >> 2) + 4 * n + (i & 3); }

struct Unit { int pm, pn; };
struct Gemm { const bf16_t* A; const bf16_t* Bt; int M, N, K; };

struct StaticOrder {
    int nM, nN, nwg, G, c;
    __host__ __device__ void init(int M, int N, int G_, int c_) { nM = M / BM; nN = N / BM; nwg = nM * nN; G = G_; c = c_; }
    __host__ __device__ bool next(int i, Unit& u) const {
        const long L = (long)i * G + c; if (L >= nwg) return false;
        int wgid = (int)L; { const int q = nwg / NXCD, r = nwg % NXCD, xcd = wgid % NXCD, off = wgid / NXCD; wgid = (xcd < r ? xcd * (q + 1) : r * (q + 1) + (xcd - r) * q) + off; }
        const int nig = WGM * nN, gid = wgid / nig, fm = gid * WGM, gsz = (nM - fm) < WGM ? (nM - fm) : WGM;
        u.pm = fm + ((wgid % nig) % gsz); u.pn = (wgid % nig) / gsz; return true;
    }
    __device__ __forceinline__ void a_ready(const Unit&) const {}
    __device__ __forceinline__ void done(const Unit&) const {}
};

__device__ __forceinline__ unsigned cvt_pk_bf16(float lo, float hi) { unsigned r; asm volatile("v_cvt_pk_bf16_f32 %0, %1, %2" : "=v"(r) : "v"(lo), "v"(hi)); return r; }

template <class Epi, class Sched, bool ALIGN_EPI = false, bool SP2 = false>
__device__ __forceinline__ void gemm_phase(PG8_LAS unsigned char* lds, const Gemm g, const Sched& S, const Epi& E) {
    int tid_ = threadIdx.x; asm volatile("" : "+v"(tid_));
    const int tid = tid_, wid = __builtin_amdgcn_readfirstlane(tid >> 6), lane = tid & 63, wr = wid >> 2, wc = wid & 3, fr = lane & 15, fq = lane >> 4;
    const int K = g.K, nt = K / BK;
    unsigned voffA[2], voffB[2];
#pragma unroll
    for (int i = 0; i < 2; ++i) { int R, C; stage_rc(tid * 16 + i * 8192, R, C); const int Rb = Epi::PERM ? ((R & ~31) + perm32(R & 31)) : R;
        voffA[i] = (unsigned)(R * K + C) * 2u; voffB[i] = (unsigned)(Rb * K + C) * 2u; }
    const size_t kstep = (size_t)(BK * 2);
    const size_t hstep = (size_t)HALF * K * 2;
    const size_t tstep = 2 * hstep;
    const unsigned ldsw = (unsigned)wid * 1024u;
    const int aoff = lds_byte(wr * 64 + fr, fq * 8), boff = lds_byte(wc * 32 + fr, fq * 8);
#define PG8_SA(b, h) (((b) * 2 + (h)) * HTB)
#define PG8_SB(b, h) ((4 + (b) * 2 + (h)) * HTB)
#define PG8_STAGE(bufoff, gbase, voff) do { _Pragma("unroll") for (int _i = 0; _i < 2; ++_i) \
        __builtin_amdgcn_global_load_lds((const unsigned*)((const char*)(gbase) + (voff)[_i]), (PG8_LAS unsigned*)(lds + (bufoff) + ldsw + _i * 8192), 16, 0, 0); } while (0)
#define PG8_LDA(dst, b, h) do { _Pragma("unroll") for (int m = 0; m < 4; ++m) _Pragma("unroll") for (int k = 0; k < 2; ++k) dst[m][k] = *(const PG8_LAS bf16x8*)(lds + PG8_SA(b, h) + aoff + m * 2048 + k * 1024); } while (0)
#define PG8_LDB(dst, b, h) do { _Pragma("unroll") for (int n = 0; n < 2; ++n) _Pragma("unroll") for (int k = 0; k < 2; ++k) dst[n][k] = *(const PG8_LAS bf16x8*)(lds + PG8_SB(b, h) + boff + n * 2048 + k * 1024); } while (0)
#define PG8_MMA(ai, bj, At, Bt) do { __builtin_amdgcn_s_setprio(1); _Pragma("unroll") for (int m = 0; m < 4; ++m) _Pragma("unroll") for (int n = 0; n < 2; ++n) _Pragma("unroll") for (int k = 0; k < 2; ++k) \
        acc[ai][bj][m][n] = __builtin_amdgcn_mfma_f32_16x16x32_bf16(Bt[n][k], At[m][k], acc[ai][bj][m][n], 0, 0, 0); __builtin_amdgcn_s_setprio(0); } while (0)
#define PG8_WAIT_V(n) asm volatile("s_waitcnt vmcnt(" #n ")" ::: "memory")
#define PG8_WAIT_L(n) asm volatile("s_waitcnt lgkmcnt(" #n ")" ::: "memory")
#define PG8_BAR __builtin_amdgcn_s_barrier()
#define PG8_SCHED __builtin_amdgcn_sched_barrier(0)
    Unit cur, nxt; int ui = 0;
    if (!S.next(0, cur)) return;
    f32x4 acc[2][2][4][2];
#pragma unroll
    for (int a = 0; a < 2; ++a)
#pragma unroll
        for (int b = 0; b < 2; ++b)
#pragma unroll
            for (int m = 0; m < 4; ++m)
#pragma unroll
                for (int n = 0; n < 2; ++n) acc[a][b][m][n] = (f32x4){0.f, 0.f, 0.f, 0.f};
    bf16x8 At[4][2], B0[2][2], B1[2][2];
    const char* cA = (const char*)g.A + (size_t)cur.pm * tstep; const char* cB = (const char*)g.Bt + (size_t)cur.pn * tstep;
    S.a_ready(cur);
    if constexpr (SP2) {
        PG8_STAGE(PG8_SB(0, 0), cB, voffB); PG8_STAGE(PG8_SB(0, 1), cB + hstep, voffB); PG8_STAGE(PG8_SA(0, 0), cA, voffA); PG8_STAGE(PG8_SA(0, 1), cA + hstep, voffA);
        if (wr == 1) PG8_BAR;
        PG8_WAIT_V(2); PG8_BAR;
        PG8_STAGE(PG8_SB(1, 0), cB + kstep, voffB); PG8_STAGE(PG8_SA(1, 0), cA + kstep, voffA); PG8_STAGE(PG8_SB(1, 1), cB + hstep + kstep, voffB);
        PG8_WAIT_V(6); PG8_BAR;
    } else {
        PG8_STAGE(PG8_SB(0, 0), cB, voffB); PG8_STAGE(PG8_SA(0, 0), cA, voffA); PG8_STAGE(PG8_SB(0, 1), cB + hstep, voffB); PG8_STAGE(PG8_SA(0, 1), cA + hstep, voffA);
        if (wr == 1) PG8_BAR;
        PG8_WAIT_V(4); PG8_BAR;
        PG8_STAGE(PG8_SB(1, 0), cB + kstep, voffB); PG8_STAGE(PG8_SA(1, 0), cA + kstep, voffA); PG8_STAGE(PG8_SB(1, 1), cB + hstep + kstep, voffB);
        PG8_WAIT_V(6); PG8_BAR;
    }
    for (;;) {
        const bool has_next = S.next(ui + 1, nxt);
        const char* nA = has_next ? (const char*)g.A + (size_t)nxt.pm * tstep : cA; const char* nB = has_next ? (const char*)g.Bt + (size_t)nxt.pn * tstep : cB;
        for (int t = 0; t < nt; t += 2) {
            const bool last = (t == nt - 2);
            const char* a1 = cA + (size_t)(t + 1) * kstep;
            const char* a2 = last ? nA : cA + (size_t)(t + 2) * kstep; const char* b2 = last ? nB : cB + (size_t)(t + 2) * kstep;
            const char* a3 = a2 + kstep; const char* b3 = b2 + kstep;
            if (last && has_next) S.a_ready(nxt);
            if constexpr (SP2) {
            PG8_LDB(B0, 0, 0); PG8_LDB(B1, 0, 1); PG8_SCHED; PG8_LDA(At, 0, 0); PG8_STAGE(PG8_SA(1, 1), a1 + hstep, voffA);
            PG8_WAIT_V(8); PG8_WAIT_L(0); PG8_BAR; PG8_MMA(0, 0, At, B0); PG8_MMA(0, 1, At, B1); PG8_BAR; PG8_SCHED;
            PG8_LDA(At, 0, 1); PG8_STAGE(PG8_SB(0, 0), b2, voffB); PG8_STAGE(PG8_SB(0, 1), b2 + hstep, voffB); PG8_STAGE(PG8_SA(0, 0), a2, voffA);
            PG8_WAIT_V(8); PG8_WAIT_L(0); PG8_BAR; PG8_MMA(1, 0, At, B0); PG8_MMA(1, 1, At, B1); PG8_BAR; PG8_SCHED;
            PG8_LDB(B0, 1, 0); PG8_LDB(B1, 1, 1); PG8_SCHED; PG8_LDA(At, 1, 0); PG8_STAGE(PG8_SA(0, 1), a2 + hstep, voffA);
            PG8_WAIT_V(8); PG8_WAIT_L(0); PG8_BAR; PG8_MMA(0, 0, At, B0); PG8_MMA(0, 1, At, B1); PG8_BAR; PG8_SCHED;
            PG8_LDA(At, 1, 1); PG8_STAGE(PG8_SB(1, 0), b3, voffB); PG8_STAGE(PG8_SB(1, 1), b3 + hstep, voffB); PG8_STAGE(PG8_SA(1, 0), a3, voffA);
            PG8_WAIT_V(8); PG8_WAIT_L(0); PG8_BAR; PG8_MMA(1, 0, At, B0); PG8_MMA(1, 1, At, B1); PG8_BAR; PG8_SCHED;
            } else {
            PG8_LDB(B0, 0, 0); PG8_SCHED; PG8_LDA(At, 0, 0); PG8_STAGE(PG8_SA(1, 1), a1 + hstep, voffA);
            PG8_WAIT_L(8); PG8_BAR; PG8_WAIT_L(0); PG8_MMA(0, 0, At, B0); PG8_BAR; PG8_SCHED;
            PG8_LDB(B1, 0, 1); PG8_STAGE(PG8_SB(0, 0), b2, voffB);
            PG8_BAR; PG8_WAIT_L(0); PG8_MMA(0, 1, At, B1); PG8_BAR;
            PG8_LDA(At, 0, 1); PG8_STAGE(PG8_SA(0, 0), a2, voffA);
            PG8_BAR; PG8_WAIT_L(0); PG8_MMA(1, 0, At, B0); PG8_BAR; PG8_SCHED;
            PG8_STAGE(PG8_SB(0, 1), b2 + hstep, voffB);
            PG8_WAIT_V(6); PG8_BAR; PG8_MMA(1, 1, At, B1); PG8_BAR;
            PG8_LDB(B0, 1, 0); PG8_SCHED; PG8_LDA(At, 1, 0); PG8_STAGE(PG8_SA(0, 1), a2 + hstep, voffA);
            PG8_WAIT_L(8); PG8_BAR; PG8_WAIT_L(0); PG8_MMA(0, 0, At, B0); PG8_BAR; PG8_SCHED;
            PG8_LDB(B1, 1, 1); PG8_STAGE(PG8_SB(1, 0), b3, voffB);
            PG8_BAR; PG8_WAIT_L(0); PG8_MMA(0, 1, At, B1); PG8_BAR;
            PG8_LDA(At, 1, 1); PG8_STAGE(PG8_SA(1, 0), a3, voffA);
            PG8_BAR; PG8_WAIT_L(0); PG8_MMA(1, 0, At, B0); PG8_BAR; PG8_SCHED;
            PG8_STAGE(PG8_SB(1, 1), b3 + hstep, voffB);
            PG8_WAIT_V(6); PG8_BAR; PG8_MMA(1, 1, At, B1); PG8_BAR;
            }
        }
        if constexpr (ALIGN_EPI) { if (wr == 0) PG8_BAR; }
        if constexpr (!Epi::AFTER_DRAIN) { E(acc, cur, wr, wc, fr, fq); S.done(cur); }
        if (!has_next) break;
#pragma unroll
        for (int a = 0; a < 2; ++a)
#pragma unroll
            for (int b = 0; b < 2; ++b)
#pragma unroll
                for (int m = 0; m < 4; ++m)
#pragma unroll
                    for (int n = 0; n < 2; ++n) acc[a][b][m][n] = (f32x4){0.f, 0.f, 0.f, 0.f};
        cur = nxt; cA = nA; cB = nB; ++ui;
        if constexpr (ALIGN_EPI) { if (wr == 1) PG8_BAR; }
    }
    PG8_WAIT_V(0);
    if constexpr (!ALIGN_EPI) { if (wr == 0) PG8_BAR; }
    PG8_BAR;
    if constexpr (Epi::AFTER_DRAIN) { E.fused(acc, cur, wr, wc, fr, fq, lds, wid, lane); S.done(cur); }
#undef PG8_SA
#undef PG8_SB
#undef PG8_STAGE
#undef PG8_LDA
#undef PG8_LDB
#undef PG8_MMA
#undef PG8_WAIT_V
#undef PG8_WAIT_L
#undef PG8_BAR
#undef PG8_SCHED
}
}

#ifndef MK_FUSED
#define MK_FUSED 1
#endif
#define DI __device__ __forceinline__
#define LAS __attribute__((address_space(3)))
typedef unsigned short bf16_t;
typedef float f32x4 __attribute__((ext_vector_type(4)));
typedef float f32x2 __attribute__((ext_vector_type(2)));
typedef float f32x16 __attribute__((ext_vector_type(16)));
typedef unsigned u32x4 __attribute__((ext_vector_type(4)));
typedef unsigned u32x2 __attribute__((ext_vector_type(2)));
typedef short bf16x8 __attribute__((ext_vector_type(8)));
typedef _Float16 h16x2 __attribute__((ext_vector_type(2)));
typedef _Float16 h16x8 __attribute__((ext_vector_type(8)));

constexpr int BATCH = 16, SEQ = 4096, T = BATCH * SEQ, DM = 1024, NIN = 4864;
constexpr int C_AQ = 0, C_AK = 512, C_AV = 640, C_HQ = 768, C_HF = 1280, C_HI = 1792, C_HG = 2304, C_GA = 2816, C_GH = 3840;
constexpr float EPS = 1e-6f;
constexpr int NTHR = 512;
constexpr int LDS_BYTES = 163840;

constexpr size_t MiB = 1u << 20;
constexpr size_t WS_W1T = 1 * MiB;
constexpr size_t WS_WAPT = 11 * MiB;
constexpr size_t WS_WHPT = 12 * MiB;
constexpr size_t WS_WOUTT = 13 * MiB;
constexpr size_t WS_WQT = 15 * MiB;
constexpr size_t WS_KEYS = 19 * MiB;
constexpr size_t WS_LB = 19 * MiB + 512 * 1024;
constexpr size_t WS_RSTD1 = 20 * MiB;
constexpr size_t WS_SSQ2 = 21 * MiB;
constexpr size_t WS_U8 = 26 * MiB;
constexpr size_t WS_V8 = 42 * MiB;
constexpr size_t WS_SU = 58 * MiB;
constexpr size_t WS_SV = 58 * MiB + 65536;
constexpr size_t WS_DEC = 60 * MiB;
constexpr size_t WS_AVT = 64 * MiB;
constexpr size_t WS_XB = 90 * MiB;
constexpr size_t WS_PA = 218 * MiB;
constexpr size_t WS_GG = 314 * MiB;
constexpr size_t WS_QD = 570 * MiB;
constexpr size_t WS_KINV = 634 * MiB;
constexpr size_t WS_KENDT = 698 * MiB;
constexpr size_t WS_VT = 762 * MiB;
constexpr size_t WS_GS = 826 * MiB;
constexpr size_t WS_YA = 890 * MiB;
constexpr size_t WS_YH = 954 * MiB;
constexpr size_t WS_END = 1018 * MiB;
constexpr size_t WS_HQ = 698 * MiB;
constexpr size_t WS_WX = 762 * MiB;
constexpr size_t WS_SH = 60 * MiB;
constexpr size_t WS_SSQ3 = 64 * MiB;
constexpr size_t WS_ACTP = 346 * MiB;
constexpr size_t WS_X2B = 218 * MiB;
constexpr size_t WS_QP = 346 * MiB;
constexpr size_t WS_GIDX = 602 * MiB;
constexpr size_t WS_GGATE = 618 * MiB;

struct Args { const float* in[15]; float* out; unsigned char* ws; int ph_lo, ph_hi; };

DI unsigned pk_bf16(float lo, float hi) { typedef __bf16 b2 __attribute__((ext_vector_type(2))); f32x2 v = {lo, hi}; b2 b = __builtin_convertvector(v, b2); return __builtin_bit_cast(unsigned, b); }
DI float bflo(unsigned w) { return __uint_as_float(w << 16); }
DI float bfhi(unsigned w) { return __uint_as_float(w & 0xffff0000u); }
DI float sigm(float x) { return __builtin_amdgcn_rcpf(1.f + __expf(-x)); }
DI float wave_sum(float v) {
#pragma unroll
    for (int o = 1; o < 64; o <<= 1) v += __shfl_xor(v, o);
    return v;
}
DI unsigned short bf16_1(float x) { return (unsigned short)(pk_bf16(x, 0.f) & 0xffffu); }
template <int N> DI float dpp_row_shr(float v) { return __int_as_float(__builtin_amdgcn_update_dpp(0, __float_as_int(v), 0x110 + N, 0xf, 0xf, true)); }
DI float scan16(float v) { v += dpp_row_shr<1>(v); v += dpp_row_shr<2>(v); v += dpp_row_shr<4>(v); v += dpp_row_shr<8>(v); return v; }
DI int crow(int reg, int hh) { return (reg & 3) + 8 * (reg >> 2) + 4 * hh; }
#define MFMA32(a, b, c) __builtin_amdgcn_mfma_f32_32x32x16_bf16((a), (b), (c), 0, 0, 0)
#define LDS_WAIT() asm volatile("s_waitcnt lgkmcnt(0)" ::: "memory")

namespace pg8 {
#define TSTORE_WRITE(sl, e, m, x) *(PG8_LAS bf16_t*)((sl) + (4 * fq + (e)) * 144 + (16 * (m) + fr) * 2) = bf16_1(x)
struct Epi1 {
    static constexpr bool PERM = true, AFTER_DRAIN = false;
    const float* rs; bf16_t* pa; bf16_t* gg; bf16_t* qd; bf16_t* kinv; bf16_t* kendT; bf16_t* vT; bf16_t* gs; float* dec; const float* lb; bf16_t* avT; PG8_LAS unsigned char* xl;
    __device__ __forceinline__ void operator()(const f32x4 (&acc)[2][2][4][2], const Unit& u, int wr, int wc, int fr, int fq) const {
        asm volatile("" : "+v"(fr), "+v"(fq));
        const int row0 = u.pm * BM + wr * 64 + fr, pn = u.pn;
        if (pn == 2) {
            const int c8 = wc * 32 + 8 * fq, tseqb = (u.pm & 15) * 256 + wr * 64 + fr, bb = u.pm >> 4;
#pragma unroll
            for (int ai = 0; ai < 2; ++ai)
#pragma unroll
                for (int m = 0; m < 4; ++m) { const int row = row0 + ai * HALF + m * 16; const float s = rs[row];
                    const f32x4 v0 = acc[ai][0][m][0] * s, v1 = acc[ai][0][m][1] * s;
                    u32x4 w; w.x = pk_bf16(v0[0], v0[1]); w.y = pk_bf16(v0[2], v0[3]); w.z = pk_bf16(v1[0], v1[1]); w.w = pk_bf16(v1[2], v1[3]);
                    *(u32x4*)(pa + (size_t)row * 768 + 512 + c8) = w;
                }
            PG8_LAS unsigned char* sl = xl + (wr * 4 + wc) * 2304; const int lane_ = fq * 16 + fr;
#pragma unroll
            for (int ai = 0; ai < 2; ++ai)
#pragma unroll
                for (int n = 0; n < 2; ++n) {
#pragma unroll
                    for (int m = 0; m < 4; ++m) { const float s = rs[row0 + ai * HALF + m * 16];
#pragma unroll
                        for (int e = 0; e < 4; ++e) TSTORE_WRITE(sl, e, m, acc[ai][1][m][n][e] * s); }
                    asm volatile("s_waitcnt lgkmcnt(0)" ::: "memory");
#pragma unroll
                    for (int q = 0; q < 2; ++q) { const int c = lane_ + 64 * q, rw = c >> 3, tc = c & 7, col = wc * 32 + 8 * (rw >> 2) + 4 * n + (rw & 3);
                        const u32x4 w = *(const PG8_LAS u32x4*)(sl + rw * 144 + tc * 16);
                        *(u32x4*)(avT + (size_t)((bb * 2 + (col >> 6)) * 64 + (col & 63)) * SEQ + (u.pm & 15) * 256 + ai * HALF + wr * 64 + 8 * tc) = w; }
                    asm volatile("s_waitcnt lgkmcnt(0)" ::: "memory");
                }
            return;
        }
        if (pn < 3 || pn >= 11) {
            bf16_t* O; int ldc, colt;
            if (pn < 3) { O = pa; ldc = 768; colt = pn * 256; } else { O = gg; ldc = 2048; colt = (pn - 11) * 256; }
            const int col0 = colt + wc * 32 + 8 * fq;
#pragma unroll
            for (int ai = 0; ai < 2; ++ai)
#pragma unroll
                for (int m = 0; m < 4; ++m) { const int row = row0 + ai * HALF + m * 16; const float s = rs[row]; bf16_t* rowp = O + (size_t)row * ldc + col0;
#pragma unroll
                    for (int bj = 0; bj < 2; ++bj) { const f32x4 v0 = acc[ai][bj][m][0] * s, v1 = acc[ai][bj][m][1] * s;
                        u32x4 w; w.x = pk_bf16(v0[0], v0[1]); w.y = pk_bf16(v0[2], v0[3]); w.z = pk_bf16(v1[0], v1[1]); w.w = pk_bf16(v1[2], v1[3]);
                        *(u32x4*)(rowp + bj * HALF) = w; } }
            return;
        }
        PG8_LAS unsigned char* sl = xl + (wr * 4 + wc) * 2304; const int lane_ = fq * 16 + fr;
        const int h = (pn - 3) & 3, c8 = wc * 32 + 8 * fq, bh = (u.pm >> 4) * 4 + h;
        if (pn < 7) {
#pragma unroll
            for (int ai = 0; ai < 2; ++ai) {
                const int tseq0 = (u.pm & 15) * 256 + ai * HALF + wr * 64;
                float rsv[4]; float decv[8];
#pragma unroll
                for (int m = 0; m < 4; ++m) rsv[m] = rs[row0 + ai * HALF + m * 16];
#pragma unroll
                for (int n = 0; n < 2; ++n) {
                    float qdv[4][4], kiv[4][4];
#pragma unroll
                    for (int e = 0; e < 4; ++e) {
                        const int dk = c8 + 4 * n + e; const float lbc = lb[h * 128 + dk];
                        float f[4], p[4];
#pragma unroll
                        for (int m = 0; m < 4; ++m) { const float x = acc[ai][1][m][n][e] * rsv[m]; f[m] = lbc + (1.f - lbc) * sigm(x); p[m] = scan16(__logf(f[m])); }
                        const float t0 = __shfl(p[0], 15, 16), t1 = __shfl(p[1], 15, 16), t2 = __shfl(p[2], 15, 16), t3 = __shfl(p[3], 15, 16);
                        const float bl = (t0 + t1) + (t2 + t3), dc = __expf(bl); decv[4 * n + e] = dc;
                        const float bb[4] = {p[0], p[1] + t0, p[2] + (t0 + t1), p[3] + ((t0 + t1) + t2)};
#pragma unroll
                        for (int m = 0; m < 4; ++m) { const float eb = __expf(bb[m]), einv = __builtin_amdgcn_rcpf(eb), k = 1.f - f[m], xq = acc[ai][0][m][n][e] * rsv[m];
                            qdv[m][e] = xq * sigm(xq) * eb; kiv[m][e] = k * einv; TSTORE_WRITE(sl, e, m, k * einv * dc); }
                    }
#pragma unroll
                    for (int m = 0; m < 4; ++m) { const size_t o = (size_t)(row0 + ai * HALF + m * 16) * 512 + h * 128 + c8 + 4 * n;
                        u32x2 w; w.x = pk_bf16(qdv[m][0], qdv[m][1]); w.y = pk_bf16(qdv[m][2], qdv[m][3]); *(u32x2*)(qd + o) = w;
                        u32x2 z; z.x = pk_bf16(kiv[m][0], kiv[m][1]); z.y = pk_bf16(kiv[m][2], kiv[m][3]); *(u32x2*)(kinv + o) = z; }
                    asm volatile("s_waitcnt lgkmcnt(0)" ::: "memory");
#pragma unroll
                    for (int q = 0; q < 2; ++q) { const int c = lane_ + 64 * q, rw = c >> 3, tc = c & 7, dkr = wc * 32 + 8 * (rw >> 2) + 4 * n + (rw & 3);
                        const u32x4 w = *(const PG8_LAS u32x4*)(sl + rw * 144 + tc * 16);
                        *(u32x4*)(kendT + (size_t)(bh * 128 + dkr) * SEQ + tseq0 + 8 * tc) = w; }
                    asm volatile("s_waitcnt lgkmcnt(0)" ::: "memory");
                }
                if (fr == 0) { float* dp = dec + (size_t)(bh * 64 + (tseq0 >> 6)) * 128 + c8;
                    *(f32x4*)dp = (f32x4){decv[0], decv[1], decv[2], decv[3]}; *(f32x4*)(dp + 4) = (f32x4){decv[4], decv[5], decv[6], decv[7]}; }
            }
        } else {
#pragma unroll
            for (int ai = 0; ai < 2; ++ai) {
                const int tseq0 = (u.pm & 15) * 256 + ai * HALF + wr * 64;
#pragma unroll
                for (int n = 0; n < 2; ++n) {
#pragma unroll
                    for (int m = 0; m < 4; ++m) { const float s = rs[row0 + ai * HALF + m * 16];
#pragma unroll
                        for (int e = 0; e < 4; ++e) TSTORE_WRITE(sl, e, m, acc[ai][0][m][n][e] * s); }
                    asm volatile("s_waitcnt lgkmcnt(0)" ::: "memory");
#pragma unroll
                    for (int q = 0; q < 2; ++q) { const int c = lane_ + 64 * q, rw = c >> 3, tc = c & 7, dvr = wc * 32 + 8 * (rw >> 2) + 4 * n + (rw & 3);
                        const u32x4 w = *(const PG8_LAS u32x4*)(sl + rw * 144 + tc * 16);
                        *(u32x4*)(vT + (size_t)(bh * 128 + dvr) * SEQ + tseq0 + 8 * tc) = w; }
                    asm volatile("s_waitcnt lgkmcnt(0)" ::: "memory");
                }
#pragma unroll
                for (int m = 0; m < 4; ++m) { const int row = row0 + ai * HALF + m * 16; const float s = rs[row];
                    f32x4 g0 = acc[ai][1][m][0] * s, g1 = acc[ai][1][m][1] * s;
#pragma unroll
                    for (int e = 0; e < 4; ++e) { g0[e] *= sigm(g0[e]); g1[e] *= sigm(g1[e]); }
                    u32x4 w; w.x = pk_bf16(g0[0], g0[1]); w.y = pk_bf16(g0[2], g0[3]); w.z = pk_bf16(g1[0], g1[1]); w.w = pk_bf16(g1[2], g1[3]);
                    *(u32x4*)(gs + (size_t)row * 512 + h * 128 + c8) = w; }
            }
        }
    }
};
struct EpiDummy {
    static constexpr bool PERM = true, AFTER_DRAIN = false;
    bf16_t* O; const float* rs;
    __device__ __forceinline__ void operator()(const f32x4 (&acc)[2][2][4][2], const Unit& u, int wr, int wc, int fr, int fq) const {
        asm volatile("" : "+v"(fr), "+v"(fq));
        const int row0 = wr * 64 + fr, col0 = wc * 32 + 8 * fq;
#pragma unroll
        for (int ai = 0; ai < 2; ++ai)
#pragma unroll
            for (int m = 0; m < 4; ++m) { const int row = row0 + ai * HALF + m * 16; const float s = rs[u.pm * BM + row]; bf16_t* rowp = O + (size_t)blockIdx.x * 65536 + (size_t)row * 256 + col0;
#pragma unroll
                for (int bj = 0; bj < 2; ++bj) { const f32x4 v0 = acc[ai][bj][m][0] * s, v1 = acc[ai][bj][m][1] * s;
                    u32x4 w; w.x = pk_bf16(v0[0], v0[1]); w.y = pk_bf16(v0[2], v0[3]); w.z = pk_bf16(v1[0], v1[1]); w.w = pk_bf16(v1[2], v1[3]);
                    *(u32x4*)(rowp + bj * HALF) = w; } }
    }
};
template <bool ADD> struct EpiMerge {
    static constexpr bool PERM = true, AFTER_DRAIN = false;
    bf16_t* O; const bf16_t* gate;
    __device__ __forceinline__ void operator()(const f32x4 (&acc)[2][2][4][2], const Unit& u, int wr, int wc, int fr, int fq) const {
        const int row0 = u.pm * BM + wr * 64 + fr, col0 = u.pn * BM + wc * 32 + 8 * fq;
#pragma unroll
        for (int ai = 0; ai < 2; ++ai)
#pragma unroll
            for (int m = 0; m < 4; ++m) { const int row = row0 + ai * HALF + m * 16; bf16_t* rowp = O + (size_t)row * DM + col0; const bf16_t* gp = gate + (size_t)row * 2048 + col0;
#pragma unroll
                for (int bj = 0; bj < 2; ++bj) { const u32x4 g = *(const u32x4*)(gp + bj * HALF);
                    f32x4 v0 = acc[ai][bj][m][0], v1 = acc[ai][bj][m][1];
                    v0[0] *= sigm(bflo(g.x)); v0[1] *= sigm(bfhi(g.x)); v0[2] *= sigm(bflo(g.y)); v0[3] *= sigm(bfhi(g.y));
                    v1[0] *= sigm(bflo(g.z)); v1[1] *= sigm(bfhi(g.z)); v1[2] *= sigm(bflo(g.w)); v1[3] *= sigm(bfhi(g.w));
                    if (ADD) { const u32x4 o = *(const u32x4*)(rowp + bj * HALF);
                        v0[0] += bflo(o.x); v0[1] += bfhi(o.x); v0[2] += bflo(o.y); v0[3] += bfhi(o.y); v1[0] += bflo(o.z); v1[1] += bfhi(o.z); v1[2] += bflo(o.w); v1[3] += bfhi(o.w); }
                    u32x4 w; w.x = pk_bf16(v0[0], v0[1]); w.y = pk_bf16(v0[2], v0[3]); w.z = pk_bf16(v1[0], v1[1]); w.w = pk_bf16(v1[2], v1[3]);
                    *(u32x4*)(rowp + bj * HALF) = w; } }
    }
};
struct EpiX2 {
    static constexpr bool PERM = true, AFTER_DRAIN = false;
    const float* X; bf16_t* X2B; float* ssq;
    __device__ __forceinline__ void operator()(const f32x4 (&acc)[2][2][4][2], const Unit& u, int wr, int wc, int fr, int fq) const {
        const int row0 = u.pm * BM + wr * 64 + fr, col0 = u.pn * BM + wc * 32 + 8 * fq;
#pragma unroll
        for (int ai = 0; ai < 2; ++ai)
#pragma unroll
            for (int m = 0; m < 4; ++m) { const int row = row0 + ai * HALF + m * 16; const size_t off = (size_t)row * DM + col0; float ss = 0.f;
#pragma unroll
                for (int bj = 0; bj < 2; ++bj) { const f32x4 x0 = *(const f32x4*)(X + off + bj * HALF), x1 = *(const f32x4*)(X + off + bj * HALF + 4);
                    const f32x4 v0 = acc[ai][bj][m][0] + x0, v1 = acc[ai][bj][m][1] + x1;
                    u32x4 w; w.x = pk_bf16(v0[0], v0[1]); w.y = pk_bf16(v0[2], v0[3]); w.z = pk_bf16(v1[0], v1[1]); w.w = pk_bf16(v1[2], v1[3]);
                    *(u32x4*)(X2B + off + bj * HALF) = w;
                    ss += (v0[0] * v0[0] + v0[1] * v0[1]) + (v0[2] * v0[2] + v0[3] * v0[3]) + (v1[0] * v1[0] + v1[1] * v1[1]) + (v1[2] * v1[2] + v1[3] * v1[3]); }
                ss += __shfl_xor(ss, 16); ss += __shfl_xor(ss, 32);
                if (fq == 0) ssq[(size_t)row * 16 + u.pn * 4 + wc] = ss; }
    }
};
struct EpiQp {
    static constexpr bool PERM = true, AFTER_DRAIN = false;
    bf16_t* O; const float* ssq;
    __device__ __forceinline__ void operator()(const f32x4 (&acc)[2][2][4][2], const Unit& u, int wr, int wc, int fr, int fq) const {
        const int row0 = u.pm * BM + wr * 64 + fr, col0 = u.pn * BM + wc * 32 + 8 * fq;
#pragma unroll
        for (int ai = 0; ai < 2; ++ai)
#pragma unroll
            for (int m = 0; m < 4; ++m) { const int row = row0 + ai * HALF + m * 16; const f32x4* sp = (const f32x4*)(ssq + (size_t)row * 16);
                const f32x4 a = sp[0], b = sp[1], c = sp[2], d = sp[3];
                const float tot = ((a[0] + a[1]) + (a[2] + a[3])) + ((b[0] + b[1]) + (b[2] + b[3])) + ((c[0] + c[1]) + (c[2] + c[3])) + ((d[0] + d[1]) + (d[2] + d[3]));
                const float s = __builtin_amdgcn_rsqf(tot * (1.f / 1024.f) + EPS); bf16_t* rowp = O + (size_t)row * 2048 + col0;
#pragma unroll
                for (int bj = 0; bj < 2; ++bj) { const f32x4 v0 = acc[ai][bj][m][0] * s, v1 = acc[ai][bj][m][1] * s;
                    u32x4 w; w.x = pk_bf16(v0[0], v0[1]); w.y = pk_bf16(v0[2], v0[3]); w.z = pk_bf16(v1[0], v1[1]); w.w = pk_bf16(v1[2], v1[3]);
                    *(u32x4*)(rowp + bj * HALF) = w; } }
    }
};
}

DI int w1_src_col(int n) {
    if (n < 768 || n >= 2816) return n;
    if (n < 1792) { const int h = (n - 768) >> 8, r = (n - 768) & 255; return r < 128 ? C_HQ + 128 * h + r : C_HF + 128 * h + (r - 128); }
    const int h = (n - 1792) >> 8, r = (n - 1792) & 255; return r < 128 ? C_HI + 128 * h + r : C_HG + 128 * h + (r - 128);
}
template <bool PERMW1> DI void p0_transpose_item(const float* W, int K, int N, bf16_t* WT, const float* g, int gmask, LAS float* scr, int item, int lane) {
    const int nblk = N / 32, kb = item / nblk, nb = item % nblk, k0 = 64 * kb, n0 = 32 * nb, ns = PERMW1 ? w1_src_col(n0) : n0;
#pragma unroll 8
    for (int i = 0; i < 32; ++i) { const int kk = 2 * i + (lane >> 5); float w = W[(size_t)(k0 + kk) * N + ns + (lane & 31)]; if (g) w *= g[(k0 + kk) & gmask]; scr[kk * 33 + (lane & 31)] = w; }
    LDS_WAIT(); asm volatile("" ::: "memory");
    const int c = lane & 7;
#pragma unroll
    for (int j = 0; j < 4; ++j) { const int n = (lane >> 3) + 8 * j; const LAS float* s = scr + (8 * c) * 33 + n;
        u32x4 o; o.x = pk_bf16(s[0 * 33], s[1 * 33]); o.y = pk_bf16(s[2 * 33], s[3 * 33]); o.z = pk_bf16(s[4 * 33], s[5 * 33]); o.w = pk_bf16(s[6 * 33], s[7 * 33]);
        *(u32x4*)(WT + (size_t)(n0 + n) * K + k0 + 8 * c) = o; }
    LDS_WAIT(); asm volatile("" ::: "memory");
}
DI unsigned pk_f16(float a, float b) { h16x2 v = {(_Float16)a, (_Float16)b}; return __builtin_bit_cast(unsigned, v); }

DI void p0_prologue(const Args& a, LAS unsigned char* lds, int vb, int G) {
    const int tid = threadIdx.x, lane = tid & 63, wave = tid >> 6;
    const int gw = vb * 8 + wave, NGW = G * 8, gt = vb * NTHR + tid, NGT = G * NTHR;
    unsigned char* ws = a.ws;
    LAS float* scr = (LAS float*)(lds + wave * 16384);
    constexpr int I_W1 = 16 * 152, I_AP = 8 * 32, I_HP = 8 * 32, I_OUT = 16 * 32, I_Q = 16 * 64, NITEMS = I_W1 + I_AP + I_HP + I_OUT + I_Q;
    for (int it = gw; it < NITEMS; it += NGW) {
        int r = it;
        if (r < I_W1) { p0_transpose_item<true>(a.in[2], 1024, NIN, (bf16_t*)(ws + WS_W1T), a.in[1], 1023, scr, r, lane); continue; } r -= I_W1;
        if (r < I_AP) { p0_transpose_item<false>(a.in[6], 512, 1024, (bf16_t*)(ws + WS_WAPT), nullptr, 0, scr, r, lane); continue; } r -= I_AP;
        if (r < I_HP) { p0_transpose_item<false>(a.in[7], 512, 1024, (bf16_t*)(ws + WS_WHPT), a.in[5], 127, scr, r, lane); continue; } r -= I_HP;
        if (r < I_OUT) { p0_transpose_item<false>(a.in[8], 1024, 1024, (bf16_t*)(ws + WS_WOUTT), nullptr, 0, scr, r, lane); continue; } r -= I_OUT;
        p0_transpose_item<false>(a.in[10], 1024, 2048, (bf16_t*)(ws + WS_WQT), a.in[9], 1023, scr, r, lane);
    }
    for (int i = gt; i < 2 * 8 * 128 * 128 / 4; i += NGT) { const f32x4 v = ((const f32x4*)a.in[11])[i]; u32x2 o; o.x = pk_bf16(v[0], v[1]); o.y = pk_bf16(v[2], v[3]); ((u32x2*)(ws + WS_KEYS))[i] = o; }
    for (int it = gw; it < 2 * 16384; it += NGW) {
        const int isv = it >= 16384, e = it & 16383;
        const float* src = (isv ? a.in[13] : a.in[12]) + (size_t)e * 1024 + 16 * lane;
        f32x4 x[4]; float amax = 0.f;
#pragma unroll
        for (int i = 0; i < 4; ++i) { x[i] = *(const f32x4*)(src + 4 * i); if (!isv) x[i] *= *(const f32x4*)(a.in[9] + 16 * lane + 4 * i);
            amax = fmaxf(fmaxf(amax, fmaxf(fabsf(x[i][0]), fabsf(x[i][1]))), fmaxf(fabsf(x[i][2]), fabsf(x[i][3]))); }
#pragma unroll
        for (int o = 1; o < 64; o <<= 1) amax = fmaxf(amax, __shfl_xor(amax, o));
        const float qs = amax > 0.f ? 127.f / amax : 0.f; const int off = isv ? 128 : 0;
        u32x4 w;
#pragma unroll
        for (int i = 0; i < 4; ++i) { const int q0 = (int)rintf(x[i][0] * qs) + off, q1 = (int)rintf(x[i][1] * qs) + off, q2 = (int)rintf(x[i][2] * qs) + off, q3 = (int)rintf(x[i][3] * qs) + off;
            w[i] = (unsigned)(q0 & 255) | ((unsigned)(q1 & 255) << 8) | ((unsigned)(q2 & 255) << 16) | ((unsigned)(q3 & 255) << 24); }
        *(u32x4*)(ws + (isv ? WS_V8 : WS_U8) + (size_t)e * 1024 + 16 * lane) = w;
        if (lane == 0) ((float*)(ws + (isv ? WS_SV : WS_SU)))[e] = amax * (1.f / 127.f);
    }
    for (int row = gw; row < T; row += NGW) {
        const f32x4* xr = (const f32x4*)(a.in[0] + (size_t)row * DM) + lane; f32x4 v[4]; float s = 0.f;
#pragma unroll
        for (int j = 0; j < 4; ++j) { v[j] = xr[64 * j]; s += (v[j][0] * v[j][0] + v[j][1] * v[j][1]) + (v[j][2] * v[j][2] + v[j][3] * v[j][3]); }
        s = wave_sum(s);
        u32x2* o = (u32x2*)(ws + WS_XB + (size_t)row * DM * 2) + lane;
#pragma unroll
        for (int j = 0; j < 4; ++j) { u32x2 w; w.x = pk_bf16(v[j][0], v[j][1]); w.y = pk_bf16(v[j][2], v[j][3]); o[64 * j] = w; }
        if (lane == 0) ((float*)(ws + WS_RSTD1))[row] = __builtin_amdgcn_rsqf(s * (1.f / 1024.f) + EPS);
    }
    if (vb == 0) { const float l0 = a.in[4][tid], l1 = a.in[4][512 + tid]; ((float*)(ws + WS_LB))[tid] = 1.f / (1.f + __expf(l1 - l0)); }
}

DI void attn_task(const bf16_t* pa, const bf16_t* avT, const float* sinks, bf16_t* ya, int b, int qb, int h) {
    const int lane = threadIdx.x & 63, r = lane & 31, hh = lane >> 5, kvh = h >> 2;
    const size_t trow = (size_t)b * SEQ + qb * 32 + r;
    constexpr float LOG2E = 1.4426950408889634f;
    bf16x8 qf[4];
    { const bf16_t* qp = pa + trow * 768 + h * 64 + 8 * hh;
#pragma unroll
      for (int s = 0; s < 4; ++s) qf[s] = *(const bf16x8*)(qp + 16 * s); }
    const float slope2 = exp2f(-(float)(h + 1)) * LOG2E, sink2 = sinks[h] * LOG2E, qs = 0.125f * LOG2E;
    f32x16 S[5]; float m = sink2;
#pragma unroll
    for (int i = 0; i < 5; ++i) { const int kb = qb - 4 + i;
        if (kb >= 0) {
#pragma unroll
            for (int q = 0; q < 16; ++q) S[i][q] = 0.f;
            const bf16_t* kp = pa + ((size_t)b * SEQ + kb * 32 + r) * 768 + 512 + kvh * 64 + 8 * hh;
#pragma unroll
            for (int s = 0; s < 4; ++s) S[i] = MFMA32(*(const bf16x8*)(kp + 16 * s), qf[s], S[i]);
#pragma unroll
            for (int q = 0; q < 16; ++q) { const int dist = 32 * (4 - i) + r - crow(q, hh); float v = S[i][q] * qs - slope2 * (float)dist;
                if (i == 0) v = (dist <= 127) ? v : -1e30f;
                if (i == 4) v = (dist >= 0) ? v : -1e30f;
                S[i][q] = v; m = fmaxf(m, v); }
        } }
    m = fmaxf(m, __shfl_xor(m, 32));
    float l = 0.f;
#pragma unroll
    for (int i = 0; i < 5; ++i) if (qb - 4 + i >= 0) {
#pragma unroll
        for (int q = 0; q < 16; ++q) { const float p = __builtin_amdgcn_exp2f(S[i][q] - m); S[i][q] = p; l += p; } }
    l += __shfl_xor(l, 32); l += __builtin_amdgcn_exp2f(sink2 - m);
    f32x16 O[2];
#pragma unroll
    for (int q = 0; q < 16; ++q) { O[0][q] = 0.f; O[1][q] = 0.f; }
#pragma unroll
    for (int i = 0; i < 5; ++i) { const int kb = qb - 4 + i;
        if (kb >= 0) {
#pragma unroll
            for (int s2 = 0; s2 < 2; ++s2) {
                u32x4 pb; pb.x = pk_bf16(S[i][8 * s2], S[i][8 * s2 + 1]); pb.y = pk_bf16(S[i][8 * s2 + 2], S[i][8 * s2 + 3]); pb.z = pk_bf16(S[i][8 * s2 + 4], S[i][8 * s2 + 5]); pb.w = pk_bf16(S[i][8 * s2 + 6], S[i][8 * s2 + 7]);
#pragma unroll
                for (int dt = 0; dt < 2; ++dt) { const bf16_t* vp = avT + (size_t)((b * 2 + kvh) * 64 + 32 * dt + r) * SEQ + kb * 32 + 16 * s2 + 4 * hh;
                    const u32x2 v0 = *(const u32x2*)vp, v1 = *(const u32x2*)(vp + 8); u32x4 av; av.x = v0.x; av.y = v0.y; av.z = v1.x; av.w = v1.y;
                    O[dt] = MFMA32(__builtin_bit_cast(bf16x8, av), __builtin_bit_cast(bf16x8, pb), O[dt]); }
            } } }
    const float inv = 1.f / l;
#pragma unroll
    for (int dt = 0; dt < 2; ++dt)
#pragma unroll
        for (int g = 0; g < 4; ++g) { u32x2 w; w.x = pk_bf16(O[dt][4 * g] * inv, O[dt][4 * g + 1] * inv); w.y = pk_bf16(O[dt][4 * g + 2] * inv, O[dt][4 * g + 3] * inv);
            *(u32x2*)(ya + trow * 512 + h * 64 + 32 * dt + 8 * g + 4 * hh) = w; }
}

DI void hgrn_ds_unit(const bf16_t* kendT, const bf16_t* vT, bf16_t* dsT, int bh, int c) {
    const int lane = threadIdx.x & 63, wave = threadIdx.x >> 6, r = lane & 31, hh = lane >> 5, i = wave >> 1, j0 = 2 * (wave & 1);
    const bf16_t* ka = kendT + (size_t)(bh * 128 + 32 * i + r) * SEQ + c * 64 + 8 * hh;
    const bf16_t* vb0 = vT + (size_t)(bh * 128 + 32 * j0 + r) * SEQ + c * 64 + 8 * hh; const bf16_t* vb1 = vb0 + (size_t)32 * SEQ;
    f32x16 D0, D1;
#pragma unroll
    for (int q = 0; q < 16; ++q) { D0[q] = 0.f; D1[q] = 0.f; }
#pragma unroll
    for (int ks = 0; ks < 4; ++ks) { const bf16x8 a = *(const bf16x8*)(ka + 16 * ks), b0 = *(const bf16x8*)(vb0 + 16 * ks), b1 = *(const bf16x8*)(vb1 + 16 * ks); D0 = MFMA32(a, b0, D0); D1 = MFMA32(a, b1, D1); }
    const int unit = bh * 64 + c;
    bf16_t* o0 = dsT + (size_t)(unit * 128 + 32 * j0 + r) * 128 + 32 * i + 4 * hh; bf16_t* o1 = o0 + 32 * 128;
#pragma unroll
    for (int g = 0; g < 4; ++g) { u32x2 w; w.x = pk_bf16(D0[4 * g], D0[4 * g + 1]); w.y = pk_bf16(D0[4 * g + 2], D0[4 * g + 3]); *(u32x2*)(o0 + 8 * g) = w;
        u32x2 z; z.x = pk_bf16(D1[4 * g], D1[4 * g + 1]); z.y = pk_bf16(D1[4 * g + 2], D1[4 * g + 3]); *(u32x2*)(o1 + 8 * g) = z; }
}
DI void hgrn_scan(bf16_t* dsT, const float* dec, int vb, int G) {
    for (int idx = vb * NTHR + threadIdx.x; idx < 64 * 128 * 16; idx += G * NTHR) {
        const int dk8 = idx & 15, dv = (idx >> 4) & 127, bh = idx >> 11;
        float S[8];
#pragma unroll
        for (int q = 0; q < 8; ++q) S[q] = 0.f;
        for (int c0 = 0; c0 < 64; c0 += 8) {
            u32x4 ld[8]; f32x4 d0[8], d1[8];
#pragma unroll
            for (int i = 0; i < 8; ++i) { const int c = c0 + i; ld[i] = *(const u32x4*)(dsT + (size_t)((bh * 64 + c) * 128 + dv) * 128 + dk8 * 8);
                const float* dp = dec + (size_t)(bh * 64 + c) * 128 + dk8 * 8; d0[i] = *(const f32x4*)dp; d1[i] = *(const f32x4*)(dp + 4); }
#pragma unroll
            for (int i = 0; i < 8; ++i) { const int c = c0 + i;
                u32x4 w; w.x = pk_bf16(S[0], S[1]); w.y = pk_bf16(S[2], S[3]); w.z = pk_bf16(S[4], S[5]); w.w = pk_bf16(S[6], S[7]);
                *(u32x4*)(dsT + (size_t)((bh * 64 + c) * 128 + dv) * 128 + dk8 * 8) = w;
                S[0] = d0[i][0] * S[0] + bflo(ld[i].x); S[1] = d0[i][1] * S[1] + bfhi(ld[i].x); S[2] = d0[i][2] * S[2] + bflo(ld[i].y); S[3] = d0[i][3] * S[3] + bfhi(ld[i].y);
                S[4] = d1[i][0] * S[4] + bflo(ld[i].z); S[5] = d1[i][1] * S[5] + bfhi(ld[i].z); S[6] = d1[i][2] * S[6] + bflo(ld[i].w); S[7] = d1[i][3] * S[7] + bfhi(ld[i].w); }
        }
    }
}
DI void hgrn_out_unit(const bf16_t* qd, const bf16_t* kinv, const bf16_t* vT, const bf16_t* spT, const bf16_t* gs, bf16_t* yh, LAS float* zs, int bh, int c) {
    const int tid = threadIdx.x, lane = tid & 63, wave = __builtin_amdgcn_readfirstlane(tid >> 6), r = lane & 31, hh = lane >> 5, tb = wave >> 2, db = wave & 3, b = bh >> 2, h = bh & 3;
    const size_t Tb = (size_t)b * SEQ + c * 64;
    bf16x8 qf[8], sf[8], kf0[8], kf1[8]; u32x2 vf[2][2][2];
    { const bf16_t* qrow = qd + (Tb + 32 * tb + r) * 512 + h * 128 + 8 * hh; const bf16_t* sp = spT + (size_t)((bh * 64 + c) * 128 + 32 * db + r) * 128 + 8 * hh;
      const bf16_t* k0 = kinv + (Tb + r) * 512 + h * 128 + 8 * hh; const bf16_t* vrow = vT + (size_t)(bh * 128 + 32 * db + r) * SEQ + c * 64 + 4 * hh;
#pragma unroll
      for (int ks = 0; ks < 8; ++ks) { qf[ks] = *(const bf16x8*)(qrow + 16 * ks); sf[ks] = *(const bf16x8*)(sp + 16 * ks); kf0[ks] = *(const bf16x8*)(k0 + 16 * ks); }
      if (tb) {
#pragma unroll
          for (int ks = 0; ks < 8; ++ks) kf1[ks] = *(const bf16x8*)(k0 + 32 * 512 + 16 * ks); }
#pragma unroll
      for (int sb = 0; sb < 2; ++sb)
#pragma unroll
          for (int s2 = 0; s2 < 2; ++s2) if (sb <= tb) { vf[sb][s2][0] = *(const u32x2*)(vrow + 32 * sb + 16 * s2); vf[sb][s2][1] = *(const u32x2*)(vrow + 32 * sb + 16 * s2 + 8); } }
    f32x16 Z;
#pragma unroll
    for (int q = 0; q < 16; ++q) Z[q] = 0.f;
#pragma unroll
    for (int ks = 0; ks < 8; ++ks) Z = MFMA32(qf[ks], sf[ks], Z);
#pragma unroll
    for (int sb = 0; sb < 2; ++sb) if (sb <= tb) {
        f32x16 X;
#pragma unroll
        for (int q = 0; q < 16; ++q) X[q] = 0.f;
#pragma unroll
        for (int ks = 0; ks < 8; ++ks) X = MFMA32(sb ? kf1[ks] : kf0[ks], qf[ks], X);
        if (sb == tb) {
#pragma unroll
            for (int q = 0; q < 16; ++q) if (crow(q, hh) > r) X[q] = 0.f;
        }
#pragma unroll
        for (int s2 = 0; s2 < 2; ++s2) {
            u32x4 pa_; pa_.x = pk_bf16(X[8 * s2], X[8 * s2 + 1]); pa_.y = pk_bf16(X[8 * s2 + 2], X[8 * s2 + 3]); pa_.z = pk_bf16(X[8 * s2 + 4], X[8 * s2 + 5]); pa_.w = pk_bf16(X[8 * s2 + 6], X[8 * s2 + 7]);
            u32x4 pb_; pb_.x = vf[sb][s2][0].x; pb_.y = vf[sb][s2][0].y; pb_.z = vf[sb][s2][1].x; pb_.w = vf[sb][s2][1].y;
            Z = MFMA32(__builtin_bit_cast(bf16x8, pa_), __builtin_bit_cast(bf16x8, pb_), Z);
        }
    }
#pragma unroll
    for (int q = 0; q < 16; ++q) zs[(32 * tb + crow(q, hh)) * 132 + 32 * db + r] = Z[q];
    __syncthreads();
    { const int tok = tid >> 3, d16 = (tid & 7) * 16; f32x4 o[4]; float ss = 0.f;
      const size_t off = (Tb + tok) * 512 + h * 128 + d16; const u32x4 g0 = *(const u32x4*)(gs + off), g1 = *(const u32x4*)(gs + off + 8);
#pragma unroll
      for (int i = 0; i < 4; ++i) { o[i] = *(const LAS f32x4*)(zs + tok * 132 + d16 + 4 * i); ss += (o[i][0] * o[i][0] + o[i][1] * o[i][1]) + (o[i][2] * o[i][2] + o[i][3] * o[i][3]); }
      ss += __shfl_xor(ss, 1); ss += __shfl_xor(ss, 2); ss += __shfl_xor(ss, 4);
      const float rn = __builtin_amdgcn_rsqf(ss * (1.f / 128.f) + EPS);
      u32x4 w0, w1;
      w0.x = pk_bf16(o[0][0] * rn * bflo(g0.x), o[0][1] * rn * bfhi(g0.x)); w0.y = pk_bf16(o[0][2] * rn * bflo(g0.y), o[0][3] * rn * bfhi(g0.y));
      w0.z = pk_bf16(o[1][0] * rn * bflo(g0.z), o[1][1] * rn * bfhi(g0.z)); w0.w = pk_bf16(o[1][2] * rn * bflo(g0.w), o[1][3] * rn * bfhi(g0.w));
      w1.x = pk_bf16(o[2][0] * rn * bflo(g1.x), o[2][1] * rn * bfhi(g1.x)); w1.y = pk_bf16(o[2][2] * rn * bflo(g1.y), o[2][3] * rn * bfhi(g1.y));
      w1.z = pk_bf16(o[3][0] * rn * bflo(g1.z), o[3][1] * rn * bfhi(g1.z)); w1.w = pk_bf16(o[3][2] * rn * bflo(g1.w), o[3][3] * rn * bfhi(g1.w));
      *(u32x4*)(yh + off) = w0; *(u32x4*)(yh + off + 8) = w1; }
}

DI unsigned f2ord(float f) { const unsigned b = __float_as_uint(f); return b ^ ((unsigned)((int)b >> 31) | 0x80000000u); }
DI float ord2f(unsigned k) { const unsigned b = (k & 0x80000000u) ? (k ^ 0x80000000u) : ~k; return __uint_as_float(b); }
DI void ce_desc(unsigned& a, unsigned& b) { const unsigned hi = a > b ? a : b, lo = a > b ? b : a; a = hi; b = lo; }
DI void sort16_desc(unsigned (&a)[16]) {
#pragma unroll
    for (int k = 2; k <= 16; k <<= 1)
#pragma unroll
        for (int j = k >> 1; j > 0; j >>= 1)
#pragma unroll
            for (int i = 0; i < 16; ++i) { const int l = i ^ j; if (l > i) { if ((i & k) == 0) ce_desc(a[i], a[l]); else ce_desc(a[l], a[i]); } }
}
DI void merge16_desc(unsigned (&a)[16], const unsigned (&b)[16]) {
#pragma unroll
    for (int i = 0; i < 16; ++i) a[i] = a[i] > b[15 - i] ? a[i] : b[15 - i];
#pragma unroll
    for (int j = 8; j > 0; j >>= 1)
#pragma unroll
        for (int i = 0; i < 16; ++i) { const int l = i ^ j; if (l > i) ce_desc(a[i], a[l]); }
}
#define TK_INS(L, x) do { unsigned t_ = (x); _Pragma("unroll") for (int j_ = 0; j_ < 16; ++j_) { const unsigned hi_ = L[j_] > t_ ? L[j_] : t_; t_ = L[j_] > t_ ? t_ : L[j_]; L[j_] = hi_; } } while (0)

DI void topk_stage_keys(const bf16_t* keysb, LAS unsigned char* kl, int h) {
    for (int c = threadIdx.x; c < 2 * 128 * 16; c += NTHR) { const int p = c >> 11, row = (c >> 4) & 127, ch = c & 15;
        *(LAS u32x4*)(kl + (p * 128 + row) * 272 + ch * 16) = *(const u32x4*)(keysb + ((size_t)(p * 8 + h) * 128 + row) * 128 + ch * 8); }
}
DI void topk_unit(const bf16_t* qp, const LAS unsigned char* kl, unsigned short* gidx, float* ggate, LAS unsigned* tk, int quad, int h) {
    const int tid = threadIdx.x, lane = tid & 63, wave = tid >> 6, p = wave & 1, tsub = wave >> 1, r = lane & 31, hh = lane >> 5;
#pragma unroll 1
    for (int hl = 0; hl < 4; ++hl) {
        const int tok0 = (quad * 4 + hl) * 128 + tsub * 32;
        f32x16 acc[4];
#pragma unroll
        for (int kb = 0; kb < 4; ++kb)
#pragma unroll
            for (int i = 0; i < 16; ++i) acc[kb][i] = 0.f;
        const bf16_t* qrow = qp + (size_t)(tok0 + r) * 2048 + h * 256 + p * 128 + 8 * hh;
        const LAS unsigned char* kbase = kl + (p * 128 + r) * 272 + 16 * hh;
#pragma unroll
        for (int s = 0; s < 8; ++s) { const bf16x8 bq = *(const bf16x8*)(qrow + 16 * s);
#pragma unroll
            for (int kb = 0; kb < 4; ++kb) { const bf16x8 ak = *(const LAS bf16x8*)(kbase + kb * 32 * 272 + 32 * s); acc[kb] = MFMA32(ak, bq, acc[kb]); } }
        unsigned A0[16], A1[16], A2[16], A3[16];
#pragma unroll
        for (int i = 0; i < 16; ++i) { const unsigned ki = (unsigned)(crow(i, hh));
            A0[i] = (f2ord(acc[0][i]) & ~127u) | ki; A1[i] = (f2ord(acc[1][i]) & ~127u) | (32u + ki); A2[i] = (f2ord(acc[2][i]) & ~127u) | (64u + ki); A3[i] = (f2ord(acc[3][i]) & ~127u) | (96u + ki); }
        sort16_desc(A0); sort16_desc(A1); sort16_desc(A2); sort16_desc(A3);
        merge16_desc(A0, A1); merge16_desc(A2, A3); merge16_desc(A0, A2);
#pragma unroll
        for (int j = 0; j < 16; ++j) A1[j] = __shfl_xor(A0[j], 32);
        merge16_desc(A0, A1);
        if (hh == 0) { LAS u32x4* dst = (LAS u32x4*)(tk + (((hl * 2 + p) * 128 + tsub * 32 + r) * 16));
#pragma unroll
            for (int c = 0; c < 4; ++c) { u32x4 w = {A0[4 * c], A0[4 * c + 1], A0[4 * c + 2], A0[4 * c + 3]}; dst[c] = w; } }
    }
    __syncthreads();
    {
        const int tok = tid & 127, hl = tid >> 7, tile = quad * 4 + hl;
        const LAS unsigned* t1 = tk + ((hl * 2 + 0) * 128 + tok) * 16; const LAS unsigned* t2 = tk + ((hl * 2 + 1) * 128 + tok) * 16;
        float v1[16], v2[16];
        { const LAS u32x4* s1 = (const LAS u32x4*)t1; const LAS u32x4* s2 = (const LAS u32x4*)t2;
#pragma unroll
          for (int c = 0; c < 4; ++c) { const u32x4 a = s1[c], b = s2[c];
              v1[4 * c] = ord2f(a.x & ~127u); v1[4 * c + 1] = ord2f(a.y & ~127u); v1[4 * c + 2] = ord2f(a.z & ~127u); v1[4 * c + 3] = ord2f(a.w & ~127u);
              v2[4 * c] = ord2f(b.x & ~127u); v2[4 * c + 1] = ord2f(b.y & ~127u); v2[4 * c + 2] = ord2f(b.z & ~127u); v2[4 * c + 3] = ord2f(b.w & ~127u); } }
#define CKEY(i, j) ((f2ord(v1[i] + v2[j]) & ~255u) | (unsigned)((i) * 16 + (j)))
        unsigned C[16], D[16], E[16];
#pragma unroll
        for (int j = 0; j < 16; ++j) C[j] = CKEY(0, j);
#pragma unroll
        for (int j = 0; j < 8; ++j) D[j] = CKEY(1, j);
#pragma unroll
        for (int j = 0; j < 5; ++j) D[8 + j] = CKEY(2, j);
#pragma unroll
        for (int j = 0; j < 3; ++j) D[13 + j] = CKEY(4, j);
#pragma unroll
        for (int j = 0; j < 4; ++j) E[j] = CKEY(3, j);
        E[4] = CKEY(5, 0); E[5] = CKEY(5, 1); E[6] = CKEY(6, 0); E[7] = CKEY(6, 1); E[8] = CKEY(7, 0); E[9] = CKEY(7, 1);
        E[10] = CKEY(8, 0); E[11] = CKEY(9, 0); E[12] = CKEY(10, 0); E[13] = CKEY(11, 0); E[14] = CKEY(12, 0); E[15] = CKEY(13, 0);
        sort16_desc(D); sort16_desc(E);
        TK_INS(E, CKEY(14, 0)); TK_INS(E, CKEY(15, 0));
#undef CKEY
        merge16_desc(C, D); merge16_desc(C, E);
        float sc[16]; unsigned ei[16]; float mx = -1e30f;
#pragma unroll
        for (int q = 0; q < 16; ++q) { const unsigned ij = C[q] & 255u; const unsigned a = t1[ij >> 4], b = t2[ij & 15u];
            sc[q] = ord2f(a & ~127u) + ord2f(b & ~127u); ei[q] = (a & 127u) * 128u + (b & 127u); mx = fmaxf(mx, sc[q]); }
        float sum = 0.f;
#pragma unroll
        for (int q = 0; q < 16; ++q) { sc[q] = __expf(sc[q] - mx); sum += sc[q]; }
        const float inv = 1.f / sum; const size_t o = (size_t)(tile * 128 + tok) * 128 + h * 16;
        u32x4 w0, w1;
        w0.x = ei[0] | (ei[1] << 16); w0.y = ei[2] | (ei[3] << 16); w0.z = ei[4] | (ei[5] << 16); w0.w = ei[6] | (ei[7] << 16);
        w1.x = ei[8] | (ei[9] << 16); w1.y = ei[10] | (ei[11] << 16); w1.z = ei[12] | (ei[13] << 16); w1.w = ei[14] | (ei[15] << 16);
        *(u32x4*)(gidx + o) = w0; *(u32x4*)(gidx + o + 8) = w1;
#pragma unroll
        for (int c = 0; c < 4; ++c) *(f32x4*)(ggate + o + 4 * c) = (f32x4){sc[4 * c] * inv, sc[4 * c + 1] * inv, sc[4 * c + 2] * inv, sc[4 * c + 3] * inv};
    }
    __syncthreads();
}

DI float gelu_erf(float x) { return 0.5f * x * (1.f + erff(x * 0.70710678118654752f)); }
DI int dot16(u32x4 w, const int (&h)[4]) { int c = __builtin_amdgcn_sdot4((int)w.x, h[0], 0, false); c = __builtin_amdgcn_sdot4((int)w.y, h[1], c, false); c = __builtin_amdgcn_sdot4((int)w.z, h[2], c, false); return __builtin_amdgcn_sdot4((int)w.w, h[3], c, false); }
#define V8_FMA(acc4, word, we) do { acc4[0] += (we) * (float)((word) & 255u); acc4[1] += (we) * (float)(((word) >> 8) & 255u); acc4[2] += (we) * (float)(((word) >> 16) & 255u); acc4[3] += (we) * (float)((word) >> 24); } while (0)

template <int IDMASK> DI void expert_token(const bf16_t* x2row, const float* ssq, const unsigned char* u8, const unsigned char* v8, const float* su, const float* sv, const unsigned short* gidx, const float* ggate, const float* gf, float* outrow, int lane) {
    f32x4 x[4]; float amax = 0.f;
#pragma unroll
    for (int i = 0; i < 4; ++i) { const u32x2 w_ = *(const u32x2*)(x2row + 16 * lane + 4 * i); x[i] = (f32x4){bflo(w_.x), bfhi(w_.x), bflo(w_.y), bfhi(w_.y)}; amax = fmaxf(fmaxf(amax, fmaxf(fabsf(x[i][0]), fabsf(x[i][1]))), fmaxf(fabsf(x[i][2]), fabsf(x[i][3]))); }
    float ss = (lane < 16) ? ssq[lane] : 0.f; ss = wave_sum(ss);
    const float rstd2 = __builtin_amdgcn_rsqf(ss * (1.f / 1024.f) + EPS);
#pragma unroll
    for (int o = 1; o < 64; o <<= 1) amax = fmaxf(amax, __shfl_xor(amax, o));
    amax *= rstd2;
    const float qs = amax > 0.f ? 127.f / amax : 0.f, sh = amax * (1.f / 127.f), xq = rstd2 * qs;
    int hq[4];
#pragma unroll
    for (int i = 0; i < 4; ++i) { const int q0 = (int)rintf(x[i][0] * xq), q1 = (int)rintf(x[i][1] * xq), q2 = (int)rintf(x[i][2] * xq), q3 = (int)rintf(x[i][3] * xq);
        hq[i] = (int)((unsigned)(q0 & 255) | ((unsigned)(q1 & 255) << 8) | ((unsigned)(q2 & 255) << 16) | ((unsigned)(q3 & 255) << 24)); }
    const int id0 = gidx[lane] & IDMASK, id1 = gidx[64 + lane] & IDMASK; const float g0 = ggate[lane], g1 = ggate[64 + lane];
    f32x4 o[4]; float wsum = 0.f;
#pragma unroll
    for (int i = 0; i < 4; ++i) o[i] = (f32x4){0.f, 0.f, 0.f, 0.f};
#pragma unroll 1
    for (int bt = 0; bt < 16; ++bt) {
        const int idsel = (bt < 8) ? id0 : id1; const float gsel = (bt < 8) ? g0 : g1; const int lb = (bt & 7) * 8;
        u32x4 ur[8], vr[8];
#pragma unroll
        for (int e = 0; e < 8; ++e) { const int idx = __builtin_amdgcn_readlane(idsel, lb + e); ur[e] = *(const u32x4*)(u8 + (size_t)idx * 1024 + 16 * lane); }
#pragma unroll
        for (int e = 0; e < 8; ++e) { const int idx = __builtin_amdgcn_readlane(idsel, lb + e); vr[e] = *(const u32x4*)(v8 + (size_t)idx * 1024 + 16 * lane); }
        const int myidx = __shfl(idsel, lb + (lane >> 3)); const float mysu = su[myidx], mysv = sv[myidx], gate = __shfl(gsel, lb + (lane >> 3));
        int pr[8];
#pragma unroll
        for (int e = 0; e < 8; ++e) pr[e] = dot16(ur[e], hq);
        int q4[4], q2[2], q1;
        { const bool up_ = (lane & 32) != 0;
#pragma unroll
          for (int i = 0; i < 4; ++i) { const int keep = up_ ? pr[i + 4] : pr[i], send = up_ ? pr[i] : pr[i + 4]; q4[i] = keep + __shfl_xor(send, 32); } }
        { const bool up_ = (lane & 16) != 0;
#pragma unroll
          for (int i = 0; i < 2; ++i) { const int keep = up_ ? q4[i + 2] : q4[i], send = up_ ? q4[i] : q4[i + 2]; q2[i] = keep + __shfl_xor(send, 16); } }
        { const bool up_ = (lane & 8) != 0; const int keep = up_ ? q2[1] : q2[0], send = up_ ? q2[0] : q2[1]; q1 = keep + __shfl_xor(send, 8); }
        q1 += __shfl_xor(q1, 4); q1 += __shfl_xor(q1, 2); q1 += __shfl_xor(q1, 1);
        const float act = (float)q1 * (mysu * sh);
        const float w = gelu_erf(act) * gate * mysv;
#pragma unroll
        for (int e = 0; e < 8; ++e) { const float we = __int_as_float(__builtin_amdgcn_readlane(__float_as_int(w), 8 * e)); wsum += we;
            V8_FMA(o[0], vr[e].x, we); V8_FMA(o[1], vr[e].y, we); V8_FMA(o[2], vr[e].z, we); V8_FMA(o[3], vr[e].w, we); }
    }
    const float corr = 128.f * wsum; float s3 = 0.f;
#pragma unroll
    for (int i = 0; i < 4; ++i) { x[i] += o[i] - corr; s3 += (x[i][0] * x[i][0] + x[i][1] * x[i][1]) + (x[i][2] * x[i][2] + x[i][3] * x[i][3]); }
    s3 = wave_sum(s3); const float r3 = __builtin_amdgcn_rsqf(s3 * (1.f / 1024.f) + EPS);
#pragma unroll
    for (int i = 0; i < 4; ++i) *(f32x4*)(outrow + 16 * lane + 4 * i) = x[i] * r3 * *(const f32x4*)(gf + 16 * lane + 4 * i);
}

DI void hq_token(const bf16_t* x2row, const float* ssq, unsigned char* hqrow, float* shp, int lane) {
    f32x4 x[4]; float amax = 0.f;
#pragma unroll
    for (int i = 0; i < 4; ++i) { const u32x2 w_ = *(const u32x2*)(x2row + 16 * lane + 4 * i); x[i] = (f32x4){bflo(w_.x), bfhi(w_.x), bflo(w_.y), bfhi(w_.y)}; amax = fmaxf(fmaxf(amax, fmaxf(fabsf(x[i][0]), fabsf(x[i][1]))), fmaxf(fabsf(x[i][2]), fabsf(x[i][3]))); }
    float ss = (lane < 16) ? ssq[lane] : 0.f; ss = wave_sum(ss);
    const float rstd2 = __builtin_amdgcn_rsqf(ss * (1.f / 1024.f) + EPS);
#pragma unroll
    for (int o = 1; o < 64; o <<= 1) amax = fmaxf(amax, __shfl_xor(amax, o));
    amax *= rstd2;
    const float qs = amax > 0.f ? 127.f / amax : 0.f, xq = rstd2 * qs;
    u32x4 w;
#pragma unroll
    for (int i = 0; i < 4; ++i) { const int q0 = (int)rintf(x[i][0] * xq), q1 = (int)rintf(x[i][1] * xq), q2 = (int)rintf(x[i][2] * xq), q3 = (int)rintf(x[i][3] * xq);
        w[i] = (unsigned)(q0 & 255) | ((unsigned)(q1 & 255) << 8) | ((unsigned)(q2 & 255) << 16) | ((unsigned)(q3 & 255) << 24); }
    *(u32x4*)(hqrow + 16 * lane) = w;
    if (lane == 0) *shp = amax * (1.f / 127.f);
}
template <int CTRL> DI int dpp_i(int v) { return __builtin_amdgcn_mov_dpp(v, CTRL, 0xf, 0xf, true); }
template <int CTRL> DI float dpp_f(float v) { return __int_as_float(__builtin_amdgcn_mov_dpp(__float_as_int(v), CTRL, 0xf, 0xf, true)); }
DI float swapadd32(float a, float b) { const auto r = __builtin_amdgcn_permlane32_swap(__float_as_uint(a), __float_as_uint(b), false, false); return __uint_as_float(r[0]) + __uint_as_float(r[1]); }
DI float swapadd16(float a, float b) { const auto r = __builtin_amdgcn_permlane16_swap(__float_as_uint(a), __float_as_uint(b), false, false); return __uint_as_float(r[0]) + __uint_as_float(r[1]); }

struct SMeta { u32x4 i0, i1, a0, a1; };
DI void slice_issue(u32x4 (&r)[16], const SMeta& m, const unsigned char* base) {
    const unsigned iw[8] = {m.i0.x, m.i0.y, m.i0.z, m.i0.w, m.i1.x, m.i1.y, m.i1.z, m.i1.w};
#pragma unroll
    for (int j = 0; j < 16; ++j) { const unsigned idx = (j & 1) ? (iw[j >> 1] >> 16) : (iw[j >> 1] & 0xffffu); r[j] = *(const u32x4*)(base + (size_t)idx * 1024); }
}
DI void slice_u_compute(const SMeta& m, const u32x4 (&r)[16], int* actp, int lane) {
    const int hq[4] = {(int)m.a0.x, (int)m.a0.y, (int)m.a0.z, (int)m.a0.w};
    int part[16];
#pragma unroll
    for (int j = 0; j < 16; ++j) part[j] = dot16(r[j], hq);
    int r8[8], r4[4], r2[2];
    { const bool up_ = (lane & 4) != 0;
#pragma unroll
      for (int i = 0; i < 8; ++i) { const int keep = up_ ? part[i + 8] : part[i], send = up_ ? part[i] : part[i + 8]; r8[i] = keep + dpp_i<0x141>(send); } }
    { const bool up_ = (lane & 2) != 0;
#pragma unroll
      for (int i = 0; i < 4; ++i) { const int keep = up_ ? r8[i + 4] : r8[i], send = up_ ? r8[i] : r8[i + 4]; r4[i] = keep + dpp_i<0x4E>(send); } }
    { const bool up_ = (lane & 1) != 0;
#pragma unroll
      for (int i = 0; i < 2; ++i) { const int keep = up_ ? r4[i + 2] : r4[i], send = up_ ? r4[i] : r4[i + 2]; r2[i] = keep + dpp_i<0xB1>(send); } }
    typedef int i32x2 __attribute__((ext_vector_type(2)));
    *(i32x2*)(actp + 2 * lane) = (i32x2){r2[0], r2[1]};
}
DI void slice_v_compute(const SMeta& m, const u32x4 (&r)[16], const bf16_t* x2row, float* x3row, float* ssq3p, int xs, int lane) {
    const unsigned ww[8] = {m.a0.x, m.a0.y, m.a0.z, m.a0.w, m.a1.x, m.a1.y, m.a1.z, m.a1.w};
    const int col = 16 * (lane & 7) + ((lane >> 5) & 1) * 8 + ((lane >> 4) & 1) * 4 + ((lane >> 3) & 1) * 2;
    const unsigned xw = *(const unsigned*)(x2row + 128 * xs + col);
    f32x4 o[4]; float wsum = 0.f;
#pragma unroll
    for (int i = 0; i < 4; ++i) o[i] = (f32x4){0.f, 0.f, 0.f, 0.f};
#pragma unroll
    for (int j = 0; j < 16; ++j) { const h16x2 wp = __builtin_bit_cast(h16x2, ww[j >> 1]); const float we = (float)((j & 1) ? wp[1] : wp[0]); wsum += we;
        V8_FMA(o[0], r[j].x, we); V8_FMA(o[1], r[j].y, we); V8_FMA(o[2], r[j].z, we); V8_FMA(o[3], r[j].w, we); }
    float a8[8], a4[4], a2[2];
#pragma unroll
    for (int i = 0; i < 8; ++i) a8[i] = swapadd32(o[i >> 2][i & 3], o[2 + (i >> 2)][i & 3]);
#pragma unroll
    for (int i = 0; i < 4; ++i) a4[i] = swapadd16(a8[i], a8[i + 4]);
    { const bool up_ = (lane & 8) != 0;
#pragma unroll
      for (int i = 0; i < 2; ++i) { const float keep = up_ ? a4[i + 2] : a4[i], send = up_ ? a4[i] : a4[i + 2]; a2[i] = keep + dpp_f<0x128>(send); } }
    wsum += dpp_f<0x128>(wsum); wsum = swapadd16(wsum, wsum); wsum = swapadd32(wsum, wsum);
    const float corr = 128.f * wsum, y0 = bflo(xw) + a2[0] - corr, y1 = bfhi(xw) + a2[1] - corr;
    *(f32x2*)(x3row + 128 * xs + col) = (f32x2){y0, y1};
    const float ss = wave_sum(y0 * y0 + y1 * y1);
    if (lane == 0) ssq3p[xs] = ss;
}
template <int MODE> DI void slice_pass(unsigned char* ws, float* out, int xs, int gw_, int nw_, int lane) {
    const int g = lane >> 3, c = lane & 7;
    const unsigned short* gidx = (const unsigned short*)(ws + WS_GIDX) + 16 * g;
    const unsigned char* tab = (MODE == 0 ? (const unsigned char*)(ws + WS_U8) : (const unsigned char*)(ws + WS_V8)) + 128 * xs + 16 * c;
    const unsigned char* hqb = (const unsigned char*)(ws + WS_HQ) + 128 * xs + 16 * c;
    const _Float16* wxb = (const _Float16*)(ws + WS_WX) + 16 * g;
#define S_LOAD(m, tok) do { const unsigned short* ip = gidx + (size_t)(tok) * 128; (m).i0 = *(const u32x4*)ip; (m).i1 = *(const u32x4*)(ip + 8); \
        if (MODE == 0) { (m).a0 = *(const u32x4*)(hqb + (size_t)(tok) * 1024); } else { const _Float16* wp_ = wxb + (size_t)(tok) * 128; (m).a0 = *(const u32x4*)wp_; (m).a1 = *(const u32x4*)(wp_ + 8); } } while (0)
#define S_COMPUTE(m, r, tok) do { if (MODE == 0) slice_u_compute(m, r, (int*)(ws + WS_ACTP) + ((size_t)(tok) * 8 + xs) * 128, lane); \
        else slice_v_compute(m, r, (const bf16_t*)(ws + WS_X2B) + (size_t)(tok) * DM, out + (size_t)(tok) * DM, (float*)(ws + WS_SSQ3) + (size_t)(tok) * 8, xs, lane); } while (0)
    SMeta mA, mB, mN; u32x4 rA[16], rB[16];
    int tok = gw_;
    if (tok >= T) return;
    S_LOAD(mA, tok); slice_issue(rA, mA, tab);
    if (tok + nw_ < T) S_LOAD(mB, tok + nw_);
    for (; tok < T; tok += 2 * nw_) {
        const bool h1 = tok + nw_ < T, h2 = tok + 2 * nw_ < T, h3 = tok + 3 * nw_ < T;
        if (h1) slice_issue(rB, mB, tab);
        if (h2) S_LOAD(mN, tok + 2 * nw_);
        S_COMPUTE(mA, rA, tok);
        if (h1) {
            if (h2) { mA = mN; slice_issue(rA, mA, tab); }
            if (h3) S_LOAD(mN, tok + 3 * nw_);
            S_COMPUTE(mB, rB, tok + nw_);
            if (h3) mB = mN;
        }
    }
#undef S_LOAD
#undef S_COMPUTE
}
DI void expert_w_token(const int* actp, const unsigned short* gidx, const float* ggate, float sh, const float* su, const float* sv, _Float16* wrow, int lane) {
    typedef int i32x2 __attribute__((ext_vector_type(2)));
    i32x2 acc = {0, 0};
#pragma unroll
    for (int x = 0; x < 8; ++x) acc += *(const i32x2*)(actp + x * 128 + 2 * lane);
    const unsigned ii = *(const unsigned*)(gidx + 2 * lane); const f32x2 gt = *(const f32x2*)(ggate + 2 * lane);
    const int e0 = ii & 0xffffu, e1 = ii >> 16;
    const float w0 = gelu_erf((float)acc[0] * (su[e0] * sh)) * gt[0] * sv[e0], w1 = gelu_erf((float)acc[1] * (su[e1] * sh)) * gt[1] * sv[e1];
    *(unsigned*)(wrow + 2 * lane) = pk_f16(w0, w1);
}
DI void final_norm_token(float* row, const float* ssq3p, const float* gf, int lane) {
    float ss = (lane < 8) ? ssq3p[lane] : 0.f; ss = wave_sum(ss);
    const float r3 = __builtin_amdgcn_rsqf(ss * (1.f / 1024.f) + EPS);
#pragma unroll
    for (int i = 0; i < 4; ++i) { f32x4* p = (f32x4*)(row + 256 * i + 4 * lane); *p = *p * r3 * *(const f32x4*)(gf + 256 * i + 4 * lane); }
}

#define XB_TMO      128
#define XB_XCNT(j)  (256  + 64 * (j))
#define XB_XSUB(j)  (1280 + 64 * (j))
#define XB_XGEN(j)  (2304 + 64 * (j))
#define XB_TOP      3328
#define XB_TOPGEN   3392
#define XCD_BAR_WORDS 3456
#define XB_SPIN_CAP (1u << 18)

__device__ __forceinline__ unsigned xb_ld(unsigned* p)              { return __hip_atomic_load(p, __ATOMIC_RELAXED, __HIP_MEMORY_SCOPE_AGENT); }
__device__ __forceinline__ unsigned xb_add(unsigned* p, unsigned v) { return __hip_atomic_fetch_add(p, v, __ATOMIC_RELAXED, __HIP_MEMORY_SCOPE_AGENT); }
__device__ __forceinline__ unsigned xb_xcc_id() { return (unsigned)__builtin_amdgcn_s_getreg((3 << 11) | 20) & 0xFu; }
#define XB_SPIN(cond, bar) do { unsigned _sp = 0; while (cond) { __builtin_amdgcn_s_sleep(1); \
    if ((++_sp & 255u) == 0u) { if (xb_ld(&(bar)[XB_TMO])) break; if (_sp > XB_SPIN_CAP) { atomicAdd(&(bar)[XB_TMO], 1u); break; } } } } while (0)

struct XcdBarrier {
    unsigned* bar; unsigned x;
    volatile __attribute__((address_space(3))) unsigned* st;
};

__device__ __forceinline__ XcdBarrier xcd_barrier_post(unsigned* bar, volatile __attribute__((address_space(3))) unsigned* st) {
    XcdBarrier b; b.bar = bar; b.x = xb_xcc_id(); b.st = st;
    if (threadIdx.x == 0) st[2] = xb_add(&bar[XB_XCNT(b.x)], 1u);
    return b;
}
__device__ __forceinline__ void xcd_barrier_complete(unsigned* bar, unsigned x, unsigned& nloc, unsigned& nx) {
    const unsigned G = gridDim.x * gridDim.y * gridDim.z;
    unsigned sum, cnt, mine, sp = 0u;
    for (;;) {
        sum = 0u; cnt = 0u; mine = 0u;
#pragma unroll
        for (unsigned j = 0; j < 16; ++j) { const unsigned c = xb_ld(&bar[XB_XCNT(j)]); sum += c; cnt += (c > 0u) ? 1u : 0u; mine = (j == x) ? c : mine; }
        if (sum == G) break;
        __builtin_amdgcn_s_sleep(1);
        if ((++sp & 255u) == 0u) { if (xb_ld(&bar[XB_TMO])) break; if (sp > XB_SPIN_CAP) { atomicAdd(&bar[XB_TMO], 1u); break; } }
    }
    nloc = mine > 0u ? mine : 1u; nx = cnt > 0u ? cnt : 1u;
}

__device__ __forceinline__ void xcd_barrier(const XcdBarrier& b) {
    asm volatile("s_waitcnt vmcnt(0)" ::: "memory");
    __syncthreads();
    if (threadIdx.x == 0) {
        unsigned* bar = b.bar;
        __builtin_amdgcn_s_waitcnt(0);
        unsigned nloc = b.st[0], nx = b.st[1];
        if (nloc == 0u) { xcd_barrier_complete(bar, b.x, nloc, nx); b.st[0] = nloc; b.st[1] = nx; }
        const unsigned old = xb_add(&bar[XB_XSUB(b.x)], 1u);
        const unsigned gen = old / nloc;
        if (old + 1u == (gen + 1u) * nloc) {
            __builtin_amdgcn_fence(__ATOMIC_RELEASE, "agent");
            asm volatile("s_waitcnt vmcnt(0)" ::: "memory");
            const unsigned og = xb_add(&bar[XB_TOP], 1u);
            const unsigned tg = og / nx;
            if (og + 1u == (tg + 1u) * nx) xb_add(&bar[XB_TOPGEN], 1u);
            else XB_SPIN(xb_ld(&bar[XB_TOPGEN]) == tg, bar);
            __builtin_amdgcn_fence(__ATOMIC_ACQUIRE, "agent");
            xb_add(&bar[XB_XGEN(b.x)], 1u);
            asm volatile("s_waitcnt vmcnt(0)" ::: "memory");
        } else {
            XB_SPIN(xb_ld(&bar[XB_XGEN(b.x)]) == gen, bar);
            __builtin_amdgcn_fence(__ATOMIC_ACQUIRE, "agent");
            asm volatile("s_waitcnt vmcnt(0)" ::: "memory");
        }
    }
    __syncthreads();
}

constexpr int N_PHASES = 13;
__global__ void __launch_bounds__(NTHR, 2) mk_fwd(Args a) {
    extern __shared__ __attribute__((aligned(16))) unsigned char lds_raw[];
    LAS unsigned char* lds = (LAS unsigned char*)lds_raw;
    cg::grid_group grid = cg::this_grid();
    const int G = gridDim.x, vb = blockIdx.x, tid = threadIdx.x, lane = tid & 63, wave = tid >> 6;
    unsigned char* ws = a.ws;
    const int lo = a.ph_lo, hi = a.ph_hi;
    volatile LAS unsigned* MISC = (volatile LAS unsigned*)(lds + LDS_BYTES - 64);
    if (tid < 16) MISC[tid] = 0u;
    __syncthreads();
    const XcdBarrier bar = xcd_barrier_post((unsigned*)(ws + 4096) + lo * XCD_BAR_WORDS, MISC);
#ifndef PHASE_MASK
#define PHASE_MASK 0xFFFF
#endif
#define IN(k) (((PHASE_MASK >> (k)) & 1) && lo <= (k) && (k) < hi)
#ifndef REPEAT_MASK
#define REPEAT_MASK 0
#endif
#define REP(k) for (int rep_ = 0; rep_ < (((REPEAT_MASK) >> (k)) & 1) + 1; ++rep_)
#define SEAM(k) do { if (IN(k) && IN((k) + 1)) { if ((k) == 0) grid.sync(); else xcd_barrier(bar); } } while (0)
    REP(0) if (IN(0)) p0_prologue(a, lds, vb, G);
    SEAM(0);
    REP(1) if (IN(1)) { pg8::Gemm g{(const bf16_t*)(ws + WS_XB), (const bf16_t*)(ws + WS_W1T), T, NIN, 1024}; pg8::StaticOrder S; S.init(T, NIN, G, vb);
        pg8::Epi1 E{(const float*)(ws + WS_RSTD1), (bf16_t*)(ws + WS_PA), (bf16_t*)(ws + WS_GG), (bf16_t*)(ws + WS_QD), (bf16_t*)(ws + WS_KINV), (bf16_t*)(ws + WS_KENDT), (bf16_t*)(ws + WS_VT), (bf16_t*)(ws + WS_GS),
                    (float*)(ws + WS_DEC), (const float*)(ws + WS_LB), (bf16_t*)(ws + WS_AVT), lds + 131072};
        pg8::gemm_phase<pg8::Epi1, pg8::StaticOrder, true, true>(lds, g, S, E); }
#ifdef PROBE_GEMM1_PLAIN
    if (IN(1)) { pg8::Gemm g{(const bf16_t*)(ws + WS_XB), (const bf16_t*)(ws + WS_W1T), T, NIN, 1024}; pg8::StaticOrder S; S.init(T, NIN, G, vb);
        pg8::EpiDummy E{(bf16_t*)(ws + WS_YA), (const float*)(ws + WS_RSTD1)};
        pg8::gemm_phase<pg8::EpiDummy, pg8::StaticOrder, true, true>(lds, g, S, E); }
#endif
    SEAM(1);
    REP(2) if (IN(2)) {
        for (int u = vb; u < 64 * 64; u += G) hgrn_ds_unit((const bf16_t*)(ws + WS_KENDT), (const bf16_t*)(ws + WS_VT), (bf16_t*)(ws + WS_XB), u >> 6, u & 63);
#ifdef PROBE_DS2
        for (int u = vb; u < 64 * 64; u += G) hgrn_ds_unit((const bf16_t*)(ws + WS_KENDT), (const bf16_t*)(ws + WS_VT), (bf16_t*)(ws + WS_XB), u >> 6, u & 63);
#endif
        { const int hw = __builtin_amdgcn_readfirstlane(wave);
          for (int u = vb; u < BATCH * (SEQ / 32); u += G) attn_task((const bf16_t*)(ws + WS_PA), (const bf16_t*)(ws + WS_AVT), a.in[3], (bf16_t*)(ws + WS_YA), u >> 7, u & 127, hw);
#ifdef PROBE_ATT2
          for (int u = vb; u < BATCH * (SEQ / 32); u += G) attn_task((const bf16_t*)(ws + WS_PA), (const bf16_t*)(ws + WS_AVT), a.in[3], (bf16_t*)(ws + WS_YA), u >> 7, u & 127, hw);
#endif
 }
    }
    SEAM(2);
    REP(3) if (IN(3)) hgrn_scan((bf16_t*)(ws + WS_XB), (const float*)(ws + WS_DEC), vb, G);
    SEAM(3);
    REP(4) if (IN(4)) { int bsel = 0; for (int u = vb; u < 64 * 64; u += G, bsel ^= 1)
        hgrn_out_unit((const bf16_t*)(ws + WS_QD), (const bf16_t*)(ws + WS_KINV), (const bf16_t*)(ws + WS_VT), (const bf16_t*)(ws + WS_XB), (const bf16_t*)(ws + WS_GS), (bf16_t*)(ws + WS_YH), (LAS float*)(lds + bsel * 34816), u >> 6, u & 63);
        __syncthreads(); }
    SEAM(4);
    REP(5) if (IN(5)) {
        { pg8::Gemm g{(const bf16_t*)(ws + WS_YA), (const bf16_t*)(ws + WS_WAPT), T, 1024, 512}; pg8::StaticOrder S; S.init(T, 1024, G, vb);
          pg8::EpiMerge<false> E{(bf16_t*)(ws + WS_XB), (const bf16_t*)(ws + WS_GG)};
          pg8::gemm_phase<pg8::EpiMerge<false>, pg8::StaticOrder, true, true>(lds, g, S, E); }
        __syncthreads();
        { pg8::Gemm g{(const bf16_t*)(ws + WS_YH), (const bf16_t*)(ws + WS_WHPT), T, 1024, 512}; pg8::StaticOrder S; S.init(T, 1024, G, vb);
          pg8::EpiMerge<true> E{(bf16_t*)(ws + WS_XB), (const bf16_t*)(ws + WS_GG) + 1024};
          pg8::gemm_phase<pg8::EpiMerge<true>, pg8::StaticOrder, true, true>(lds, g, S, E); }
    }
    SEAM(5);
    REP(6) if (IN(6)) { pg8::Gemm g{(const bf16_t*)(ws + WS_XB), (const bf16_t*)(ws + WS_WOUTT), T, 1024, 1024}; pg8::StaticOrder S; S.init(T, 1024, G, vb);
        pg8::EpiX2 E{a.in[0], (bf16_t*)(ws + WS_X2B), (float*)(ws + WS_SSQ2)};
        pg8::gemm_phase<pg8::EpiX2, pg8::StaticOrder, true, true>(lds, g, S, E); }
    SEAM(6);
    REP(7) if (IN(7)) { pg8::Gemm g{(const bf16_t*)(ws + WS_X2B), (const bf16_t*)(ws + WS_WQT), T, 2048, 1024}; pg8::StaticOrder S; S.init(T, 2048, G, vb);
        pg8::EpiQp E{(bf16_t*)(ws + WS_QP), (const float*)(ws + WS_SSQ2)};
        pg8::gemm_phase<pg8::EpiQp, pg8::StaticOrder, true, true>(lds, g, S, E); }
    SEAM(7);
    REP(8) if (IN(8)) { const int per = (1024 + G - 1) / G; int hcur = -1;
        for (int U = vb * per; U < (vb + 1) * per && U < 1024; ++U) { const int h = U >> 7;
            if (h != hcur) { topk_stage_keys((const bf16_t*)(ws + WS_KEYS), lds + 65536, h); hcur = h; __syncthreads(); }
            topk_unit((const bf16_t*)(ws + WS_QP), lds + 65536, (unsigned short*)(ws + WS_GIDX), (float*)(ws + WS_GGATE), (LAS unsigned*)lds, U & 127, h); }
        for (int tok = vb * 8 + wave; tok < T; tok += G * 8) hq_token((const bf16_t*)(ws + WS_X2B) + (size_t)tok * DM, (const float*)(ws + WS_SSQ2) + (size_t)tok * 16, (unsigned char*)(ws + WS_HQ) + (size_t)tok * 1024, (float*)(ws + WS_SH) + tok, lane); }
    SEAM(8);
    if (IN(9) || IN(11)) {
        if (tid == 0) {
            unsigned nloc_ = 0, nx_ = 0; xcd_barrier_complete(bar.bar, bar.x, nloc_, nx_);
            unsigned cj[8], tot = 0; bool all = true;
#pragma unroll
            for (int j = 0; j < 8; ++j) { cj[j] = xb_ld(&bar.bar[XB_XCNT(j)]); tot += cj[j]; all = all && cj[j] > 0u; }
            if (all && tot == (unsigned)G && bar.x < 8u) { MISC[4] = bar.x; MISC[5] = MISC[2]; MISC[6] = cj[bar.x & 7u]; }
            else { const unsigned sl_ = (unsigned)vb & 7u; MISC[4] = sl_; MISC[5] = (unsigned)vb >> 3; MISC[6] = ((unsigned)G - sl_ + 7u) >> 3; }
        }
        __syncthreads();
    }
    REP(9) if (IN(9)) slice_pass<0>(ws, a.out, (int)MISC[4], (int)MISC[5] * 8 + __builtin_amdgcn_readfirstlane(wave), (int)MISC[6] * 8, lane);
    SEAM(9);
    REP(10) if (IN(10)) for (int tok = vb * 8 + wave; tok < T; tok += G * 8)
        expert_w_token((const int*)(ws + WS_ACTP) + (size_t)tok * 1024, (const unsigned short*)(ws + WS_GIDX) + (size_t)tok * 128, (const float*)(ws + WS_GGATE) + (size_t)tok * 128, ((const float*)(ws + WS_SH))[tok],
                       (const float*)(ws + WS_SU), (const float*)(ws + WS_SV), (_Float16*)(ws + WS_WX) + (size_t)tok * 128, lane);
    SEAM(10);
    REP(11) if (IN(11)) slice_pass<1>(ws, a.out, (int)MISC[4], (int)MISC[5] * 8 + __builtin_amdgcn_readfirstlane(wave), (int)MISC[6] * 8, lane);
    SEAM(11);
    REP(12) if (IN(12)) for (int tok = vb * 8 + wave; tok < T; tok += G * 8) final_norm_token(a.out + (size_t)tok * DM, (const float*)(ws + WS_SSQ3) + (size_t)tok * 8, a.in[14], lane);
#undef IN
#undef SEAM
}

extern "C" void kernel_launch(void* const* d_in, const int* in_sizes, int n_in, void* d_out, int out_size, void* d_ws, size_t ws_size, hipStream_t stream) {
    static int grid = 0;
    if (grid == 0) {
        if (n_in != 15 || in_sizes[0] != T * DM || out_size != T * DM || ws_size < WS_END) { fprintf(stderr, "kernel_launch: unexpected shapes (n_in %d, in0 %d, out %d, ws %zu)\n", n_in, n_in > 0 ? in_sizes[0] : -1, out_size, ws_size); grid = -1; return; }
        int dev = 0, cus = 0, per_cu = 0;
        hipGetDevice(&dev); hipDeviceGetAttribute(&cus, hipDeviceAttributeMultiprocessorCount, dev);
        if (hipFuncSetAttribute((const void*)mk_fwd, hipFuncAttributeMaxDynamicSharedMemorySize, LDS_BYTES) != hipSuccess) { fprintf(stderr, "kernel_launch: hipFuncSetAttribute failed\n"); grid = -1; return; }
        if (hipOccupancyMaxActiveBlocksPerMultiprocessor(&per_cu, (const void*)mk_fwd, NTHR, LDS_BYTES) != hipSuccess || per_cu < 1) { fprintf(stderr, "kernel_launch: occupancy query says %d blocks per CU\n", per_cu); per_cu = 1; }
        (void)hipGetLastError();
        grid = cus;
    }
    if (grid < 0) return;
    if (hipMemsetAsync(d_ws, 0, 256 * 1024, stream) != hipSuccess) { fprintf(stderr, "kernel_launch: hipMemsetAsync failed\n"); return; }
    Args a{};
    for (int i = 0; i < 15; ++i) a.in[i] = (const float*)d_in[i];
    a.out = (float*)d_out; a.ws = (unsigned char*)d_ws;
#if MK_FUSED
    a.ph_lo = 0; a.ph_hi = N_PHASES;
    { void* args[] = {&a}; hipError_t e = hipLaunchCooperativeKernel((const void*)mk_fwd, dim3(grid), dim3(NTHR), args, LDS_BYTES, stream);
      if (e != hipSuccess) fprintf(stderr, "kernel_launch: cooperative launch failed: %s (grid %d)\n", hipGetErrorString(e), grid); }
#else
    for (int p = 0; p < N_PHASES; ++p) { a.ph_lo = p; a.ph_hi = p + 1; void* args[] = {&a};
        hipError_t e = hipLaunchCooperativeKernel((const void*)mk_fwd, dim3(grid), dim3(NTHR), args, LDS_BYTES, stream);
        if (e != hipSuccess) { fprintf(stderr, "kernel_launch: launch of phase %d failed: %s (grid %d)\n", p, hipGetErrorString(e), grid); break; } }
#endif
}
```

```cpp
#include <hip/hip_runtime.h>
#include <hip/hip_cooperative_groups.h>
#include <cstdio>
#include <cstdint>
namespace cg = cooperative_groups;
namespace pg8 {
#define PG8_LAS __attribute__((address_space(3)))
typedef unsigned short bf16_t;
typedef short bf16x8 __attribute__((ext_vector_type(8)));
typedef float f32x4 __attribute__((ext_vector_type(4)));
typedef unsigned u32x4 __attribute__((ext_vector_type(4)));
constexpr int BM = 256, BK = 64, HALF = 128, HTB = HALF * BK * 2  , STAGE_BYTES = 8 * HTB, NXCD = 8, WGM = 8;

__host__ __device__ __forceinline__ int lds_byte(int r, int c) { const int st = (r >> 4) * 2 + (c >> 5), rr = r & 15, cc = c & 31, ob = rr * 64 + cc * 2; return st * 1024 + (ob ^ (((ob >> 9) & 1) << 5)); }
__host__ __device__ __forceinline__ void stage_rc(int b, int& R, int& C) { const int st = b / 1024, sb = b % 1024, swz = sb ^ (((sb >> 9) & 1) << 5); R = (st >> 1) * 16 + swz / 64; C = (st & 1) * 32 + (swz % 64) / 2; }
__host__ __device__ __forceinline__ int perm32(int rho) { const int n = rho >> 4, i = rho & 15; return 8 * (i >> 2) + 4 * n + (i & 3); }

struct Unit { int pm, pn; };
struct Gemm { const bf16_t* A; const bf16_t* Bt; int M, N, K; };

struct StaticOrder {
    int nM, nN, nwg, G, c;
    __host__ __device__ void init(int M, int N, int G_, int c_) { nM = M / BM; nN = N / BM; nwg = nM * nN; G = G_; c = c_; }
    __host__ __device__ bool next(int i, Unit& u) const {
        const long L = (long)i * G + c; if (L >= nwg) return false;
        int wgid = (int)L; { const int q = nwg / NXCD, r = nwg % NXCD, xcd = wgid % NXCD, off = wgid / NXCD; wgid = (xcd < r ? xcd * (q + 1) : r * (q + 1) + (xcd - r) * q) + off; }
        const int nig = WGM * nN, gid = wgid / nig, fm = gid * WGM, gsz = (nM - fm) < WGM ? (nM - fm) : WGM;
        u.pm = fm + ((wgid % nig) % gsz); u.pn = (wgid % nig) / gsz; return true;
    }
    __device__ __forceinline__ void a_ready(const Unit&) const {}
    __device__ __forceinline__ void done(const Unit&) const {}
};

__device__ __forceinline__ unsigned cvt_pk_bf16(float lo, float hi) { unsigned r; asm volatile("v_cvt_pk_bf16_f32 %0, %1, %2" : "=v"(r) : "v"(lo), "v"(hi)); return r; }

template <class Epi, class Sched, bool ALIGN_EPI = false, bool SP2 = false>
__device__ __forceinline__ void gemm_phase(PG8_LAS unsigned char* lds, const Gemm g, const Sched& S, const Epi& E) {
    int tid_ = threadIdx.x; asm volatile("" : "+v"(tid_));
    const int tid = tid_, wid = __builtin_amdgcn_readfirstlane(tid >> 6), lane = tid & 63, wr = wid >> 2, wc = wid & 3, fr = lane & 15, fq = lane >> 4;
    const int K = g.K, nt = K / BK;
    unsigned voffA[2], voffB[2];
#pragma unroll
    for (int i = 0; i < 2; ++i) { int R, C; stage_rc(tid * 16 + i * 8192, R, C); const int Rb = Epi::PERM ? ((R & ~31) + perm32(R & 31)) : R;
        voffA[i] = (unsigned)(R * K + C) * 2u; voffB[i] = (unsigned)(Rb * K + C) * 2u; }
    const size_t kstep = (size_t)(BK * 2);
    const size_t hstep = (size_t)HALF * K * 2;
    const size_t tstep = 2 * hstep;
    const unsigned ldsw = (unsigned)wid * 1024u;
    const int aoff = lds_byte(wr * 64 + fr, fq * 8), boff = lds_byte(wc * 32 + fr, fq * 8);
#define PG8_SA(b, h) (((b) * 2 + (h)) * HTB)
#define PG8_SB(b, h) ((4 + (b) * 2 + (h)) * HTB)
#define PG8_STAGE(bufoff, gbase, voff) do { _Pragma("unroll") for (int _i = 0; _i < 2; ++_i) \
        __builtin_amdgcn_global_load_lds((const unsigned*)((const char*)(gbase) + (voff)[_i]), (PG8_LAS unsigned*)(lds + (bufoff) + ldsw + _i * 8192), 16, 0, 0); } while (0)
#define PG8_LDA(dst, b, h) do { _Pragma("unroll") for (int m = 0; m < 4; ++m) _Pragma("unroll") for (int k = 0; k < 2; ++k) dst[m][k] = *(const PG8_LAS bf16x8*)(lds + PG8_SA(b, h) + aoff + m * 2048 + k * 1024); } while (0)
#define PG8_LDB(dst, b, h) do { _Pragma("unroll") for (int n = 0; n < 2; ++n) _Pragma("unroll") for (int k = 0; k < 2; ++k) dst[n][k] = *(const PG8_LAS bf16x8*)(lds + PG8_SB(b, h) + boff + n * 2048 + k * 1024); } while (0)
#define PG8_MMA(ai, bj, At, Bt) do { __builtin_amdgcn_s_setprio(1); _Pragma("unroll") for (int m = 0; m < 4; ++m) _Pragma("unroll") for (int n = 0; n < 2; ++n) _Pragma("unroll") for (int k = 0; k < 2; ++k) \
        acc[ai][bj][m][n] = __builtin_amdgcn_mfma_f32_16x16x32_bf16(Bt[n][k], At[m][k], acc[ai][bj][m][n], 0, 0, 0); __builtin_amdgcn_s_setprio(0); } while (0)
#define PG8_WAIT_V(n) asm volatile("s_waitcnt vmcnt(" #n ")" ::: "memory")
#define PG8_WAIT_L(n) asm volatile("s_waitcnt lgkmcnt(" #n ")" ::: "memory")
#define PG8_BAR __builtin_amdgcn_s_barrier()
#define PG8_SCHED __builtin_amdgcn_sched_barrier(0)
    Unit cur, nxt; int ui = 0;
    if (!S.next(0, cur)) return;
    f32x4 acc[2][2][4][2];
#pragma unroll
    for (int a = 0; a < 2; ++a)
#pragma unroll
        for (int b = 0; b < 2; ++b)
#pragma unroll
            for (int m = 0; m < 4; ++m)
#pragma unroll
                for (int n = 0; n < 2; ++n) acc[a][b][m][n] = (f32x4){0.f, 0.f, 0.f, 0.f};
    bf16x8 At[4][2], B0[2][2], B1[2][2];
    const char* cA = (const char*)g.A + (size_t)cur.pm * tstep; const char* cB = (const char*)g.Bt + (size_t)cur.pn * tstep;
    S.a_ready(cur);
    if constexpr (SP2) {
        PG8_STAGE(PG8_SB(0, 0), cB, voffB); PG8_STAGE(PG8_SB(0, 1), cB + hstep, voffB); PG8_STAGE(PG8_SA(0, 0), cA, voffA); PG8_STAGE(PG8_SA(0, 1), cA + hstep, voffA);
        if (wr == 1) PG8_BAR;
        PG8_WAIT_V(2); PG8_BAR;
        PG8_STAGE(PG8_SB(1, 0), cB + kstep, voffB); PG8_STAGE(PG8_SA(1, 0), cA + kstep, voffA); PG8_STAGE(PG8_SB(1, 1), cB + hstep + kstep, voffB);
        PG8_WAIT_V(6); PG8_BAR;
    } else {
        PG8_STAGE(PG8_SB(0, 0), cB, voffB); PG8_STAGE(PG8_SA(0, 0), cA, voffA); PG8_STAGE(PG8_SB(0, 1), cB + hstep, voffB); PG8_STAGE(PG8_SA(0, 1), cA + hstep, voffA);
        if (wr == 1) PG8_BAR;
        PG8_WAIT_V(4); PG8_BAR;
        PG8_STAGE(PG8_SB(1, 0), cB + kstep, voffB); PG8_STAGE(PG8_SA(1, 0), cA + kstep, voffA); PG8_STAGE(PG8_SB(1, 1), cB + hstep + kstep, voffB);
        PG8_WAIT_V(6); PG8_BAR;
    }
    for (;;) {
        const bool has_next = S.next(ui + 1, nxt);
        const char* nA = has_next ? (const char*)g.A + (size_t)nxt.pm * tstep : cA; const char* nB = has_next ? (const char*)g.Bt + (size_t)nxt.pn * tstep : cB;
        for (int t = 0; t < nt; t += 2) {
            const bool last = (t == nt - 2);
            const char* a1 = cA + (size_t)(t + 1) * kstep;
            const char* a2 = last ? nA : cA + (size_t)(t + 2) * kstep; const char* b2 = last ? nB : cB + (size_t)(t + 2) * kstep;
            const char* a3 = a2 + kstep; const char* b3 = b2 + kstep;
            if (last && has_next) S.a_ready(nxt);
            if constexpr (SP2) {
            PG8_LDB(B0, 0, 0); PG8_LDB(B1, 0, 1); PG8_SCHED; PG8_LDA(At, 0, 0); PG8_STAGE(PG8_SA(1, 1), a1 + hstep, voffA);
            PG8_WAIT_V(8); PG8_WAIT_L(0); PG8_BAR; PG8_MMA(0, 0, At, B0); PG8_MMA(0, 1, At, B1); PG8_BAR; PG8_SCHED;
            PG8_LDA(At, 0, 1); PG8_STAGE(PG8_SB(0, 0), b2, voffB); PG8_STAGE(PG8_SB(0, 1), b2 + hstep, voffB); PG8_STAGE(PG8_SA(0, 0), a2, voffA);
            PG8_WAIT_V(8); PG8_WAIT_L(0); PG8_BAR; PG8_MMA(1, 0, At, B0); PG8_MMA(1, 1, At, B1); PG8_BAR; PG8_SCHED;
            PG8_LDB(B0, 1, 0); PG8_LDB(B1, 1, 1); PG8_SCHED; PG8_LDA(At, 1, 0); PG8_STAGE(PG8_SA(0, 1), a2 + hstep, voffA);
            PG8_WAIT_V(8); PG8_WAIT_L(0); PG8_BAR; PG8_MMA(0, 0, At, B0); PG8_MMA(0, 1, At, B1); PG8_BAR; PG8_SCHED;
            PG8_LDA(At, 1, 1); PG8_STAGE(PG8_SB(1, 0), b3, voffB); PG8_STAGE(PG8_SB(1, 1), b3 + hstep, voffB); PG8_STAGE(PG8_SA(1, 0), a3, voffA);
            PG8_WAIT_V(8); PG8_WAIT_L(0); PG8_BAR; PG8_MMA(1, 0, At, B0); PG8_MMA(1, 1, At, B1); PG8_BAR; PG8_SCHED;
            } else {
            PG8_LDB(B0, 0, 0); PG8_SCHED; PG8_LDA(At, 0, 0); PG8_STAGE(PG8_SA(1, 1), a1 + hstep, voffA);
            PG8_WAIT_L(8); PG8_BAR; PG8_WAIT_L(0); PG8_MMA(0, 0, At, B0); PG8_BAR; PG8_SCHED;
            PG8_LDB(B1, 0, 1); PG8_STAGE(PG8_SB(0, 0), b2, voffB);
            PG8_BAR; PG8_WAIT_L(0); PG8_MMA(0, 1, At, B1); PG8_BAR;
            PG8_LDA(At, 0, 1); PG8_STAGE(PG8_SA(0, 0), a2, voffA);
            PG8_BAR; PG8_WAIT_L(0); PG8_MMA(1, 0, At, B0); PG8_BAR; PG8_SCHED;
            PG8_STAGE(PG8_SB(0, 1), b2 + hstep, voffB);
            PG8_WAIT_V(6); PG8_BAR; PG8_MMA(1, 1, At, B1); PG8_BAR;
            PG8_LDB(B0, 1, 0); PG8_SCHED; PG8_LDA(At, 1, 0); PG8_STAGE(PG8_SA(0, 1), a2 + hstep, voffA);
            PG8_WAIT_L(8); PG8_BAR; PG8_WAIT_L(0); PG8_MMA(0, 0, At, B0); PG8_BAR; PG8_SCHED;
            PG8_LDB(B1, 1, 1); PG8_STAGE(PG8_SB(1, 0), b3, voffB);
            PG8_BAR; PG8_WAIT_L(0); PG8_MMA(0, 1, At, B1); PG8_BAR;
            PG8_LDA(At, 1, 1); PG8_STAGE(PG8_SA(1, 0), a3, voffA);
            PG8_BAR; PG8_WAIT_L(0); PG8_MMA(1, 0, At, B0); PG8_BAR; PG8_SCHED;
            PG8_STAGE(PG8_SB(1, 1), b3 + hstep, voffB);
            PG8_WAIT_V(6); PG8_BAR; PG8_MMA(1, 1, At, B1); PG8_BAR;
            }
        }
        if constexpr (ALIGN_EPI) { if (wr == 0) PG8_BAR; }
        if constexpr (!Epi::AFTER_DRAIN) { E(acc, cur, wr, wc, fr, fq); S.done(cur); }
        if (!has_next) break;
#pragma unroll
        for (int a = 0; a < 2; ++a)
#pragma unroll
            for (int b = 0; b < 2; ++b)
#pragma unroll
                for (int m = 0; m < 4; ++m)
#pragma unroll
                    for (int n = 0; n < 2; ++n) acc[a][b][m][n] = (f32x4){0.f, 0.f, 0.f, 0.f};
        cur = nxt; cA = nA; cB = nB; ++ui;
        if constexpr (ALIGN_EPI) { if (wr == 1) PG8_BAR; }
    }
    PG8_WAIT_V(0);
    if constexpr (!ALIGN_EPI) { if (wr == 0) PG8_BAR; }
    PG8_BAR;
    if constexpr (Epi::AFTER_DRAIN) { E.fused(acc, cur, wr, wc, fr, fq, lds, wid, lane); S.done(cur); }
#undef PG8_SA
#undef PG8_SB
#undef PG8_STAGE
#undef PG8_LDA
#undef PG8_LDB
#undef PG8_MMA
#undef PG8_WAIT_V
#undef PG8_WAIT_L
#undef PG8_BAR
#undef PG8_SCHED
}
}

#ifndef MK_FUSED
#define MK_FUSED 1
#endif
#define DI __device__ __forceinline__
#define LAS __attribute__((address_space(3)))
typedef unsigned short bf16_t;
typedef float f32x4 __attribute__((ext_vector_type(4)));
typedef float f32x2 __attribute__((ext_vector_type(2)));
typedef float f32x16 __attribute__((ext_vector_type(16)));
typedef unsigned u32x4 __attribute__((ext_vector_type(4)));
typedef unsigned u32x2 __attribute__((ext_vector_type(2)));
typedef short bf16x8 __attribute__((ext_vector_type(8)));
typedef _Float16 h16x2 __attribute__((ext_vector_type(2)));
typedef _Float16 h16x8 __attribute__((ext_vector_type(8)));

constexpr int BATCH = 16, SEQ = 4096, T = BATCH * SEQ, DM = 1024, NIN = 4864;
constexpr int C_AQ = 0, C_AK = 512, C_AV = 640, C_HQ = 768, C_HF = 1280, C_HI = 1792, C_HG = 2304, C_GA = 2816, C_GH = 3840;
constexpr float EPS = 1e-6f;
constexpr int NTHR = 512;
constexpr int LDS_BYTES = 163840;

constexpr size_t MiB = 1u << 20;
constexpr size_t WS_W1T = 1 * MiB;
constexpr size_t WS_WAPT = 11 * MiB;
constexpr size_t WS_WHPT = 12 * MiB;
constexpr size_t WS_WOUTT = 13 * MiB;
constexpr size_t WS_WQT = 15 * MiB;
constexpr size_t WS_KEYS = 19 * MiB;
constexpr size_t WS_LB = 19 * MiB + 512 * 1024;
constexpr size_t WS_RSTD1 = 20 * MiB;
constexpr size_t WS_SSQ2 = 21 * MiB;
constexpr size_t WS_U8 = 26 * MiB;
constexpr size_t WS_V8 = 42 * MiB;
constexpr size_t WS_SU = 58 * MiB;
constexpr size_t WS_SV = 58 * MiB + 65536;
constexpr size_t WS_DEC = 60 * MiB;
constexpr size_t WS_AVT = 64 * MiB;
constexpr size_t WS_XB = 90 * MiB;
constexpr size_t WS_PA = 218 * MiB;
constexpr size_t WS_GG = 314 * MiB;
constexpr size_t WS_QD = 570 * MiB;
constexpr size_t WS_KINV = 634 * MiB;
constexpr size_t WS_KENDT = 698 * MiB;
constexpr size_t WS_VT = 762 * MiB;
constexpr size_t WS_GS = 826 * MiB;
constexpr size_t WS_YA = 890 * MiB;
constexpr size_t WS_YH = 954 * MiB;
constexpr size_t WS_END = 1018 * MiB;
constexpr size_t WS_HQ = 698 * MiB;
constexpr size_t WS_WX = 762 * MiB;
constexpr size_t WS_SH = 60 * MiB;
constexpr size_t WS_SSQ3 = 64 * MiB;
constexpr size_t WS_ACTP = 346 * MiB;
constexpr size_t WS_X2B = 218 * MiB;
constexpr size_t WS_QP = 346 * MiB;
constexpr size_t WS_GIDX = 602 * MiB;
constexpr size_t WS_GGATE = 618 * MiB;

struct Args { const float* in[15]; float* out; unsigned char* ws; int ph_lo, ph_hi; };

DI unsigned pk_bf16(float lo, float hi) { typedef __bf16 b2 __attribute__((ext_vector_type(2))); f32x2 v = {lo, hi}; b2 b = __builtin_convertvector(v, b2); return __builtin_bit_cast(unsigned, b); }
DI float bflo(unsigned w) { return __uint_as_float(w << 16); }
DI float bfhi(unsigned w) { return __uint_as_float(w & 0xffff0000u); }
DI float sigm(float x) { return __builtin_amdgcn_rcpf(1.f + __expf(-x)); }
DI float wave_sum(float v) {
    v += __int_as_float(__builtin_amdgcn_mov_dpp(__float_as_int(v), 0xB1, 0xf, 0xf, true));
    v += __int_as_float(__builtin_amdgcn_mov_dpp(__float_as_int(v), 0x4E, 0xf, 0xf, true));
    v += __int_as_float(__builtin_amdgcn_mov_dpp(__float_as_int(v), 0x141, 0xf, 0xf, true));
    v += __int_as_float(__builtin_amdgcn_mov_dpp(__float_as_int(v), 0x128, 0xf, 0xf, true));
    { const auto r = __builtin_amdgcn_permlane16_swap(__float_as_uint(v), __float_as_uint(v), false, false); v = __uint_as_float(r[0]) + __uint_as_float(r[1]); }
    { const auto r = __builtin_amdgcn_permlane32_swap(__float_as_uint(v), __float_as_uint(v), false, false); v = __uint_as_float(r[0]) + __uint_as_float(r[1]); }
    return v;
}
DI unsigned short bf16_1(float x) { return (unsigned short)(pk_bf16(x, 0.f) & 0xffffu); }
template <int N> DI float dpp_row_shr(float v) { return __int_as_float(__builtin_amdgcn_update_dpp(0, __float_as_int(v), 0x110 + N, 0xf, 0xf, true)); }
DI float scan16(float v) { v += dpp_row_shr<1>(v); v += dpp_row_shr<2>(v); v += dpp_row_shr<4>(v); v += dpp_row_shr<8>(v); return v; }
DI int crow(int reg, int hh) { return (reg & 3) + 8 * (reg >> 2) + 4 * hh; }
#define MFMA32(a, b, c) __builtin_amdgcn_mfma_f32_32x32x16_bf16((a), (b), (c), 0, 0, 0)
#define LDS_WAIT() asm volatile("s_waitcnt lgkmcnt(0)" ::: "memory")

namespace pg8 {
#define TSTORE_WRITE(sl, e, m, x) *(PG8_LAS bf16_t*)((sl) + (4 * fq + (e)) * 144 + (16 * (m) + fr) * 2) = bf16_1(x)
struct Epi1 {
    static constexpr bool PERM = true, AFTER_DRAIN = false;
    const float* rs; bf16_t* pa; bf16_t* gg; bf16_t* qd; bf16_t* kinv; bf16_t* kendT; bf16_t* vT; bf16_t* gs; float* dec; const float* lb; bf16_t* avT; PG8_LAS unsigned char* xl;
    __device__ __forceinline__ void operator()(const f32x4 (&acc)[2][2][4][2], const Unit& u, int wr, int wc, int fr, int fq) const {
        asm volatile("" : "+v"(fr), "+v"(fq));
        const int row0 = u.pm * BM + wr * 64 + fr, pn = u.pn;
        if (pn == 2) {
            const int c8 = wc * 32 + 8 * fq, tseqb = (u.pm & 15) * 256 + wr * 64 + fr, bb = u.pm >> 4;
#pragma unroll
            for (int ai = 0; ai < 2; ++ai)
#pragma unroll
                for (int m = 0; m < 4; ++m) { const int row = row0 + ai * HALF + m * 16; const float s = rs[row];
                    const f32x4 v0 = acc[ai][0][m][0] * s, v1 = acc[ai][0][m][1] * s;
                    u32x4 w; w.x = pk_bf16(v0[0], v0[1]); w.y = pk_bf16(v0[2], v0[3]); w.z = pk_bf16(v1[0], v1[1]); w.w = pk_bf16(v1[2], v1[3]);
                    *(u32x4*)(pa + (size_t)row * 768 + 512 + c8) = w;
                }
            PG8_LAS unsigned char* sl = xl + (wr * 4 + wc) * 2304; const int lane_ = fq * 16 + fr;
#pragma unroll
            for (int ai = 0; ai < 2; ++ai)
#pragma unroll
                for (int n = 0; n < 2; ++n) {
#pragma unroll
                    for (int m = 0; m < 4; ++m) { const float s = rs[row0 + ai * HALF + m * 16];
#pragma unroll
                        for (int e = 0; e < 4; ++e) TSTORE_WRITE(sl, e, m, acc[ai][1][m][n][e] * s); }
                    asm volatile("s_waitcnt lgkmcnt(0)" ::: "memory");
#pragma unroll
                    for (int q = 0; q < 2; ++q) { const int c = lane_ + 64 * q, rw = c >> 3, tc = c & 7, col = wc * 32 + 8 * (rw >> 2) + 4 * n + (rw & 3);
                        const u32x4 w = *(const PG8_LAS u32x4*)(sl + rw * 144 + tc * 16);
                        *(u32x4*)(avT + (size_t)((bb * 2 + (col >> 6)) * 64 + (col & 63)) * SEQ + (u.pm & 15) * 256 + ai * HALF + wr * 64 + 8 * tc) = w; }
                    asm volatile("s_waitcnt lgkmcnt(0)" ::: "memory");
                }
            return;
        }
        if (pn < 3 || pn >= 11) {
            bf16_t* O; int ldc, colt;
            if (pn < 3) { O = pa; ldc = 768; colt = pn * 256; } else { O = gg; ldc = 2048; colt = (pn - 11) * 256; }
            const int col0 = colt + wc * 32 + 8 * fq;
#pragma unroll
            for (int ai = 0; ai < 2; ++ai)
#pragma unroll
                for (int m = 0; m < 4; ++m) { const int row = row0 + ai * HALF + m * 16; const float s = rs[row]; bf16_t* rowp = O + (size_t)row * ldc + col0;
#pragma unroll
                    for (int bj = 0; bj < 2; ++bj) { const f32x4 v0 = acc[ai][bj][m][0] * s, v1 = acc[ai][bj][m][1] * s;
                        u32x4 w; w.x = pk_bf16(v0[0], v0[1]); w.y = pk_bf16(v0[2], v0[3]); w.z = pk_bf16(v1[0], v1[1]); w.w = pk_bf16(v1[2], v1[3]);
                        *(u32x4*)(rowp + bj * HALF) = w; } }
            return;
        }
        PG8_LAS unsigned char* sl = xl + (wr * 4 + wc) * 2304; const int lane_ = fq * 16 + fr;
        const int h = (pn - 3) & 3, c8 = wc * 32 + 8 * fq, bh = (u.pm >> 4) * 4 + h;
        if (pn < 7) {
#pragma unroll
            for (int ai = 0; ai < 2; ++ai) {
                const int tseq0 = (u.pm & 15) * 256 + ai * HALF + wr * 64;
                float rsv[4]; float decv[8];
#pragma unroll
                for (int m = 0; m < 4; ++m) rsv[m] = rs[row0 + ai * HALF + m * 16];
#pragma unroll
                for (int n = 0; n < 2; ++n) {
                    float qdv[4][4], kiv[4][4];
#pragma unroll
                    for (int e = 0; e < 4; ++e) {
                        const int dk = c8 + 4 * n + e; const float lbc = lb[h * 128 + dk];
                        float f[4], p[4];
#pragma unroll
                        for (int m = 0; m < 4; ++m) { const float x = acc[ai][1][m][n][e] * rsv[m]; f[m] = lbc + (1.f - lbc) * sigm(x); p[m] = scan16(__logf(f[m])); }
                        const float t0 = __shfl(p[0], 15, 16), t1 = __shfl(p[1], 15, 16), t2 = __shfl(p[2], 15, 16), t3 = __shfl(p[3], 15, 16);
                        const float bl = (t0 + t1) + (t2 + t3), dc = __expf(bl); decv[4 * n + e] = dc;
                        const float bb[4] = {p[0], p[1] + t0, p[2] + (t0 + t1), p[3] + ((t0 + t1) + t2)};
#pragma unroll
                        for (int m = 0; m < 4; ++m) { const float eb = __expf(bb[m]), einv = __builtin_amdgcn_rcpf(eb), k = 1.f - f[m], xq = acc[ai][0][m][n][e] * rsv[m];
                            qdv[m][e] = xq * sigm(xq) * eb; kiv[m][e] = k * einv; TSTORE_WRITE(sl, e, m, k * einv * dc); }
                    }
#pragma unroll
                    for (int m = 0; m < 4; ++m) { const size_t o = (size_t)(row0 + ai * HALF + m * 16) * 512 + h * 128 + c8 + 4 * n;
                        u32x2 w; w.x = pk_bf16(qdv[m][0], qdv[m][1]); w.y = pk_bf16(qdv[m][2], qdv[m][3]); *(u32x2*)(qd + o) = w;
                        u32x2 z; z.x = pk_bf16(kiv[m][0], kiv[m][1]); z.y = pk_bf16(kiv[m][2], kiv[m][3]); *(u32x2*)(kinv + o) = z; }
                    asm volatile("s_waitcnt lgkmcnt(0)" ::: "memory");
#pragma unroll
                    for (int q = 0; q < 2; ++q) { const int c = lane_ + 64 * q, rw = c >> 3, tc = c & 7, dkr = wc * 32 + 8 * (rw >> 2) + 4 * n + (rw & 3);
                        const u32x4 w = *(const PG8_LAS u32x4*)(sl + rw * 144 + tc * 16);
                        *(u32x4*)(kendT + (size_t)(bh * 128 + dkr) * SEQ + tseq0 + 8 * tc) = w; }
                    asm volatile("s_waitcnt lgkmcnt(0)" ::: "memory");
                }
                if (fr == 0) { float* dp = dec + (size_t)(bh * 64 + (tseq0 >> 6)) * 128 + c8;
                    *(f32x4*)dp = (f32x4){decv[0], decv[1], decv[2], decv[3]}; *(f32x4*)(dp + 4) = (f32x4){decv[4], decv[5], decv[6], decv[7]}; }
            }
        } else {
#pragma unroll
            for (int ai = 0; ai < 2; ++ai) {
                const int tseq0 = (u.pm & 15) * 256 + ai * HALF + wr * 64;
#pragma unroll
                for (int n = 0; n < 2; ++n) {
#pragma unroll
                    for (int m = 0; m < 4; ++m) { const float s = rs[row0 + ai * HALF + m * 16];
#pragma unroll
                        for (int e = 0; e < 4; ++e) TSTORE_WRITE(sl, e, m, acc[ai][0][m][n][e] * s); }
                    asm volatile("s_waitcnt lgkmcnt(0)" ::: "memory");
#pragma unroll
                    for (int q = 0; q < 2; ++q) { const int c = lane_ + 64 * q, rw = c >> 3, tc = c & 7, dvr = wc * 32 + 8 * (rw >> 2) + 4 * n + (rw & 3);
                        const u32x4 w = *(const PG8_LAS u32x4*)(sl + rw * 144 + tc * 16);
                        *(u32x4*)(vT + (size_t)(bh * 128 + dvr) * SEQ + tseq0 + 8 * tc) = w; }
                    asm volatile("s_waitcnt lgkmcnt(0)" ::: "memory");
                }
#pragma unroll
                for (int m = 0; m < 4; ++m) { const int row = row0 + ai * HALF + m * 16; const float s = rs[row];
                    f32x4 g0 = acc[ai][1][m][0] * s, g1 = acc[ai][1][m][1] * s;
#pragma unroll
                    for (int e = 0; e < 4; ++e) { g0[e] *= sigm(g0[e]); g1[e] *= sigm(g1[e]); }
                    u32x4 w; w.x = pk_bf16(g0[0], g0[1]); w.y = pk_bf16(g0[2], g0[3]); w.z = pk_bf16(g1[0], g1[1]); w.w = pk_bf16(g1[2], g1[3]);
                    *(u32x4*)(gs + (size_t)row * 512 + h * 128 + c8) = w; }
            }
        }
    }
};
struct EpiDummy {
    static constexpr bool PERM = true, AFTER_DRAIN = false;
    bf16_t* O; const float* rs;
    __device__ __forceinline__ void operator()(const f32x4 (&acc)[2][2][4][2], const Unit& u, int wr, int wc, int fr, int fq) const {
        asm volatile("" : "+v"(fr), "+v"(fq));
        const int row0 = wr * 64 + fr, col0 = wc * 32 + 8 * fq;
#pragma unroll
        for (int ai = 0; ai < 2; ++ai)
#pragma unroll
            for (int m = 0; m < 4; ++m) { const int row = row0 + ai * HALF + m * 16; const float s = rs[u.pm * BM + row]; bf16_t* rowp = O + (size_t)blockIdx.x * 65536 + (size_t)row * 256 + col0;
#pragma unroll
                for (int bj = 0; bj < 2; ++bj) { const f32x4 v0 = acc[ai][bj][m][0] * s, v1 = acc[ai][bj][m][1] * s;
                    u32x4 w; w.x = pk_bf16(v0[0], v0[1]); w.y = pk_bf16(v0[2], v0[3]); w.z = pk_bf16(v1[0], v1[1]); w.w = pk_bf16(v1[2], v1[3]);
                    *(u32x4*)(rowp + bj * HALF) = w; } }
    }
};
template <bool ADD> struct EpiMerge {
    static constexpr bool PERM = true, AFTER_DRAIN = false;
    bf16_t* O; const bf16_t* gate;
    __device__ __forceinline__ void operator()(const f32x4 (&acc)[2][2][4][2], const Unit& u, int wr, int wc, int fr, int fq) const {
        const int row0 = u.pm * BM + wr * 64 + fr, col0 = u.pn * BM + wc * 32 + 8 * fq;
#pragma unroll
        for (int ai = 0; ai < 2; ++ai)
#pragma unroll
            for (int m = 0; m < 4; ++m) { const int row = row0 + ai * HALF + m * 16; bf16_t* rowp = O + (size_t)row * DM + col0; const bf16_t* gp = gate + (size_t)row * 2048 + col0;
#pragma unroll
                for (int bj = 0; bj < 2; ++bj) { const u32x4 g = *(const u32x4*)(gp + bj * HALF);
                    f32x4 v0 = acc[ai][bj][m][0], v1 = acc[ai][bj][m][1];
                    v0[0] *= sigm(bflo(g.x)); v0[1] *= sigm(bfhi(g.x)); v0[2] *= sigm(bflo(g.y)); v0[3] *= sigm(bfhi(g.y));
                    v1[0] *= sigm(bflo(g.z)); v1[1] *= sigm(bfhi(g.z)); v1[2] *= sigm(bflo(g.w)); v1[3] *= sigm(bfhi(g.w));
                    if (ADD) { const u32x4 o = *(const u32x4*)(rowp + bj * HALF);
                        v0[0] += bflo(o.x); v0[1] += bfhi(o.x); v0[2] += bflo(o.y); v0[3] += bfhi(o.y); v1[0] += bflo(o.z); v1[1] += bfhi(o.z); v1[2] += bflo(o.w); v1[3] += bfhi(o.w); }
                    u32x4 w; w.x = pk_bf16(v0[0], v0[1]); w.y = pk_bf16(v0[2], v0[3]); w.z = pk_bf16(v1[0], v1[1]); w.w = pk_bf16(v1[2], v1[3]);
                    *(u32x4*)(rowp + bj * HALF) = w; } }
    }
};
struct EpiX2 {
    static constexpr bool PERM = true, AFTER_DRAIN = false;
    const float* X; bf16_t* X2B; float* ssq;
    __device__ __forceinline__ void operator()(const f32x4 (&acc)[2][2][4][2], const Unit& u, int wr, int wc, int fr, int fq) const {
        const int row0 = u.pm * BM + wr * 64 + fr, col0 = u.pn * BM + wc * 32 + 8 * fq;
#pragma unroll
        for (int ai = 0; ai < 2; ++ai)
#pragma unroll
            for (int m = 0; m < 4; ++m) { const int row = row0 + ai * HALF + m * 16; const size_t off = (size_t)row * DM + col0; float ss = 0.f;
#pragma unroll
                for (int bj = 0; bj < 2; ++bj) { const f32x4 x0 = *(const f32x4*)(X + off + bj * HALF), x1 = *(const f32x4*)(X + off + bj * HALF + 4);
                    const f32x4 v0 = acc[ai][bj][m][0] + x0, v1 = acc[ai][bj][m][1] + x1;
                    u32x4 w; w.x = pk_bf16(v0[0], v0[1]); w.y = pk_bf16(v0[2], v0[3]); w.z = pk_bf16(v1[0], v1[1]); w.w = pk_bf16(v1[2], v1[3]);
                    *(u32x4*)(X2B + off + bj * HALF) = w;
                    ss += (v0[0] * v0[0] + v0[1] * v0[1]) + (v0[2] * v0[2] + v0[3] * v0[3]) + (v1[0] * v1[0] + v1[1] * v1[1]) + (v1[2] * v1[2] + v1[3] * v1[3]); }
                ss += __shfl_xor(ss, 16); ss += __shfl_xor(ss, 32);
                if (fq == 0) ssq[(size_t)row * 16 + u.pn * 4 + wc] = ss; }
    }
};
struct EpiQp {
    static constexpr bool PERM = true, AFTER_DRAIN = false;
    bf16_t* O; const float* ssq;
    __device__ __forceinline__ void operator()(const f32x4 (&acc)[2][2][4][2], const Unit& u, int wr, int wc, int fr, int fq) const {
        const int row0 = u.pm * BM + wr * 64 + fr, col0 = u.pn * BM + wc * 32 + 8 * fq;
#pragma unroll
        for (int ai = 0; ai < 2; ++ai)
#pragma unroll
            for (int m = 0; m < 4; ++m) { const int row = row0 + ai * HALF + m * 16; const f32x4* sp = (const f32x4*)(ssq + (size_t)row * 16);
                const f32x4 a = sp[0], b = sp[1], c = sp[2], d = sp[3];
                const float tot = ((a[0] + a[1]) + (a[2] + a[3])) + ((b[0] + b[1]) + (b[2] + b[3])) + ((c[0] + c[1]) + (c[2] + c[3])) + ((d[0] + d[1]) + (d[2] + d[3]));
                const float s = __builtin_amdgcn_rsqf(tot * (1.f / 1024.f) + EPS); bf16_t* rowp = O + (size_t)row * 2048 + col0;
#pragma unroll
                for (int bj = 0; bj < 2; ++bj) { const f32x4 v0 = acc[ai][bj][m][0] * s, v1 = acc[ai][bj][m][1] * s;
                    u32x4 w; w.x = pk_bf16(v0[0], v0[1]); w.y = pk_bf16(v0[2], v0[3]); w.z = pk_bf16(v1[0], v1[1]); w.w = pk_bf16(v1[2], v1[3]);
                    *(u32x4*)(rowp + bj * HALF) = w; } }
    }
};
}

DI int w1_src_col(int n) {
    if (n < 768 || n >= 2816) return n;
    if (n < 1792) { const int h = (n - 768) >> 8, r = (n - 768) & 255; return r < 128 ? C_HQ + 128 * h + r : C_HF + 128 * h + (r - 128); }
    const int h = (n - 1792) >> 8, r = (n - 1792) & 255; return r < 128 ? C_HI + 128 * h + r : C_HG + 128 * h + (r - 128);
}
template <bool PERMW1> DI void p0_transpose_item(const float* W, int K, int N, bf16_t* WT, const float* g, int gmask, LAS float* scr, int item, int lane) {
    const int nblk = N / 32, kb = item / nblk, nb = item % nblk, k0 = 64 * kb, n0 = 32 * nb, ns = PERMW1 ? w1_src_col(n0) : n0;
#pragma unroll 8
    for (int i = 0; i < 32; ++i) { const int kk = 2 * i + (lane >> 5); float w = W[(size_t)(k0 + kk) * N + ns + (lane & 31)]; if (g) w *= g[(k0 + kk) & gmask]; scr[kk * 33 + (lane & 31)] = w; }
    LDS_WAIT(); asm volatile("" ::: "memory");
    const int c = lane & 7;
#pragma unroll
    for (int j = 0; j < 4; ++j) { const int n = (lane >> 3) + 8 * j; const LAS float* s = scr + (8 * c) * 33 + n;
        u32x4 o; o.x = pk_bf16(s[0 * 33], s[1 * 33]); o.y = pk_bf16(s[2 * 33], s[3 * 33]); o.z = pk_bf16(s[4 * 33], s[5 * 33]); o.w = pk_bf16(s[6 * 33], s[7 * 33]);
        *(u32x4*)(WT + (size_t)(n0 + n) * K + k0 + 8 * c) = o; }
    LDS_WAIT(); asm volatile("" ::: "memory");
}
DI unsigned pk_f16(float a, float b) { h16x2 v = {(_Float16)a, (_Float16)b}; return __builtin_bit_cast(unsigned, v); }

DI void p0_prologue(const Args& a, LAS unsigned char* lds, int vb, int G) {
    const int tid = threadIdx.x, lane = tid & 63, wave = tid >> 6;
    const int gw = vb * 8 + wave, NGW = G * 8, gt = vb * NTHR + tid, NGT = G * NTHR;
    unsigned char* ws = a.ws;
    LAS float* scr = (LAS float*)(lds + wave * 16384);
    constexpr int I_W1 = 16 * 152, I_AP = 8 * 32, I_HP = 8 * 32, I_OUT = 16 * 32, I_Q = 16 * 64, NITEMS = I_W1 + I_AP + I_HP + I_OUT + I_Q;
    for (int it = gw; it < NITEMS; it += NGW) {
        int r = it;
        if (r < I_W1) { p0_transpose_item<true>(a.in[2], 1024, NIN, (bf16_t*)(ws + WS_W1T), a.in[1], 1023, scr, r, lane); continue; } r -= I_W1;
        if (r < I_AP) { p0_transpose_item<false>(a.in[6], 512, 1024, (bf16_t*)(ws + WS_WAPT), nullptr, 0, scr, r, lane); continue; } r -= I_AP;
        if (r < I_HP) { p0_transpose_item<false>(a.in[7], 512, 1024, (bf16_t*)(ws + WS_WHPT), a.in[5], 127, scr, r, lane); continue; } r -= I_HP;
        if (r < I_OUT) { p0_transpose_item<false>(a.in[8], 1024, 1024, (bf16_t*)(ws + WS_WOUTT), nullptr, 0, scr, r, lane); continue; } r -= I_OUT;
        p0_transpose_item<false>(a.in[10], 1024, 2048, (bf16_t*)(ws + WS_WQT), a.in[9], 1023, scr, r, lane);
    }
    for (int i = gt; i < 2 * 8 * 128 * 128 / 4; i += NGT) { const f32x4 v = ((const f32x4*)a.in[11])[i]; u32x2 o; o.x = pk_bf16(v[0], v[1]); o.y = pk_bf16(v[2], v[3]); ((u32x2*)(ws + WS_KEYS))[i] = o; }
    for (int it = gw; it < 2 * 16384; it += NGW) {
        const int isv = it >= 16384, e = it & 16383;
        const float* src = (isv ? a.in[13] : a.in[12]) + (size_t)e * 1024 + 16 * lane;
        f32x4 x[4]; float amax = 0.f;
#pragma unroll
        for (int i = 0; i < 4; ++i) { x[i] = *(const f32x4*)(src + 4 * i); if (!isv) x[i] *= *(const f32x4*)(a.in[9] + 16 * lane + 4 * i);
            amax = fmaxf(fmaxf(amax, fmaxf(fabsf(x[i][0]), fabsf(x[i][1]))), fmaxf(fabsf(x[i][2]), fabsf(x[i][3]))); }
#pragma unroll
        for (int o = 1; o < 64; o <<= 1) amax = fmaxf(amax, __shfl_xor(amax, o));
        const float qs = amax > 0.f ? 127.f / amax : 0.f; const int off = isv ? 128 : 0;
        u32x4 w;
#pragma unroll
        for (int i = 0; i < 4; ++i) { const int q0 = (int)rintf(x[i][0] * qs) + off, q1 = (int)rintf(x[i][1] * qs) + off, q2 = (int)rintf(x[i][2] * qs) + off, q3 = (int)rintf(x[i][3] * qs) + off;
            w[i] = (unsigned)(q0 & 255) | ((unsigned)(q1 & 255) << 8) | ((unsigned)(q2 & 255) << 16) | ((unsigned)(q3 & 255) << 24); }
        *(u32x4*)(ws + (isv ? WS_V8 : WS_U8) + (size_t)e * 1024 + 16 * lane) = w;
        if (lane == 0) ((float*)(ws + (isv ? WS_SV : WS_SU)))[e] = amax * (1.f / 127.f);
    }
    for (int row = gw; row < T; row += NGW) {
        const f32x4* xr = (const f32x4*)(a.in[0] + (size_t)row * DM) + lane; f32x4 v[4]; float s = 0.f;
#pragma unroll
        for (int j = 0; j < 4; ++j) { v[j] = xr[64 * j]; s += (v[j][0] * v[j][0] + v[j][1] * v[j][1]) + (v[j][2] * v[j][2] + v[j][3] * v[j][3]); }
        s = wave_sum(s);
        u32x2* o = (u32x2*)(ws + WS_XB + (size_t)row * DM * 2) + lane;
#pragma unroll
        for (int j = 0; j < 4; ++j) { u32x2 w; w.x = pk_bf16(v[j][0], v[j][1]); w.y = pk_bf16(v[j][2], v[j][3]); o[64 * j] = w; }
        if (lane == 0) ((float*)(ws + WS_RSTD1))[row] = __builtin_amdgcn_rsqf(s * (1.f / 1024.f) + EPS);
    }
    if (vb == 0) { const float l0 = a.in[4][tid], l1 = a.in[4][512 + tid]; ((float*)(ws + WS_LB))[tid] = 1.f / (1.f + __expf(l1 - l0)); }
}

DI void attn_task(const bf16_t* pa, const bf16_t* avT, const float* sinks, bf16_t* ya, int b, int qb, int h) {
    const int lane = threadIdx.x & 63, r = lane & 31, hh = lane >> 5, kvh = h >> 2;
    const size_t trow = (size_t)b * SEQ + qb * 32 + r;
    constexpr float LOG2E = 1.4426950408889634f;
    bf16x8 qf[4];
    { const bf16_t* qp = pa + trow * 768 + h * 64 + 8 * hh;
#pragma unroll
      for (int s = 0; s < 4; ++s) qf[s] = *(const bf16x8*)(qp + 16 * s); }
    const float slope2 = exp2f(-(float)(h + 1)) * LOG2E, sink2 = sinks[h] * LOG2E, qs = 0.125f * LOG2E;
    f32x16 S[5]; float m = sink2;
#pragma unroll
    for (int i = 0; i < 5; ++i) { const int kb = qb - 4 + i;
        if (kb >= 0) {
#pragma unroll
            for (int q = 0; q < 16; ++q) S[i][q] = 0.f;
            const bf16_t* kp = pa + ((size_t)b * SEQ + kb * 32 + r) * 768 + 512 + kvh * 64 + 8 * hh;
#pragma unroll
            for (int s = 0; s < 4; ++s) S[i] = MFMA32(*(const bf16x8*)(kp + 16 * s), qf[s], S[i]);
#pragma unroll
            for (int q = 0; q < 16; ++q) { const int dist = 32 * (4 - i) + r - crow(q, hh); float v = S[i][q] * qs - slope2 * (float)dist;
                if (i == 0) v = (dist <= 127) ? v : -1e30f;
                if (i == 4) v = (dist >= 0) ? v : -1e30f;
                S[i][q] = v; m = fmaxf(m, v); }
        } }
    m = fmaxf(m, __shfl_xor(m, 32));
    float l = 0.f;
#pragma unroll
    for (int i = 0; i < 5; ++i) if (qb - 4 + i >= 0) {
#pragma unroll
        for (int q = 0; q < 16; ++q) { const float p = __builtin_amdgcn_exp2f(S[i][q] - m); S[i][q] = p; l += p; } }
    l += __shfl_xor(l, 32); l += __builtin_amdgcn_exp2f(sink2 - m);
    f32x16 O[2];
#pragma unroll
    for (int q = 0; q < 16; ++q) { O[0][q] = 0.f; O[1][q] = 0.f; }
#pragma unroll
    for (int i = 0; i < 5; ++i) { const int kb = qb - 4 + i;
        if (kb >= 0) {
#pragma unroll
            for (int s2 = 0; s2 < 2; ++s2) {
                u32x4 pb; pb.x = pk_bf16(S[i][8 * s2], S[i][8 * s2 + 1]); pb.y = pk_bf16(S[i][8 * s2 + 2], S[i][8 * s2 + 3]); pb.z = pk_bf16(S[i][8 * s2 + 4], S[i][8 * s2 + 5]); pb.w = pk_bf16(S[i][8 * s2 + 6], S[i][8 * s2 + 7]);
#pragma unroll
                for (int dt = 0; dt < 2; ++dt) { const bf16_t* vp = avT + (size_t)((b * 2 + kvh) * 64 + 32 * dt + r) * SEQ + kb * 32 + 16 * s2 + 4 * hh;
                    const u32x2 v0 = *(const u32x2*)vp, v1 = *(const u32x2*)(vp + 8); u32x4 av; av.x = v0.x; av.y = v0.y; av.z = v1.x; av.w = v1.y;
                    O[dt] = MFMA32(__builtin_bit_cast(bf16x8, av), __builtin_bit_cast(bf16x8, pb), O[dt]); }
            } } }
    const float inv = 1.f / l;
#pragma unroll
    for (int dt = 0; dt < 2; ++dt)
#pragma unroll
        for (int g = 0; g < 4; ++g) { u32x2 w; w.x = pk_bf16(O[dt][4 * g] * inv, O[dt][4 * g + 1] * inv); w.y = pk_bf16(O[dt][4 * g + 2] * inv, O[dt][4 * g + 3] * inv);
            *(u32x2*)(ya + trow * 512 + h * 64 + 32 * dt + 8 * g + 4 * hh) = w; }
}

DI void hgrn_ds_unit(const bf16_t* kendT, const bf16_t* vT, bf16_t* dsT, int bh, int c) {
    const int lane = threadIdx.x & 63, wave = threadIdx.x >> 6, r = lane & 31, hh = lane >> 5, i = wave >> 1, j0 = 2 * (wave & 1);
    const bf16_t* ka = kendT + (size_t)(bh * 128 + 32 * i + r) * SEQ + c * 64 + 8 * hh;
    const bf16_t* vb0 = vT + (size_t)(bh * 128 + 32 * j0 + r) * SEQ + c * 64 + 8 * hh; const bf16_t* vb1 = vb0 + (size_t)32 * SEQ;
    f32x16 D0, D1;
#pragma unroll
    for (int q = 0; q < 16; ++q) { D0[q] = 0.f; D1[q] = 0.f; }
#pragma unroll
    for (int ks = 0; ks < 4; ++ks) { const bf16x8 a = *(const bf16x8*)(ka + 16 * ks), b0 = *(const bf16x8*)(vb0 + 16 * ks), b1 = *(const bf16x8*)(vb1 + 16 * ks); D0 = MFMA32(a, b0, D0); D1 = MFMA32(a, b1, D1); }
    const int unit = bh * 64 + c;
    bf16_t* o0 = dsT + (size_t)(unit * 128 + 32 * j0 + r) * 128 + 32 * i + 4 * hh; bf16_t* o1 = o0 + 32 * 128;
#pragma unroll
    for (int g = 0; g < 4; ++g) { u32x2 w; w.x = pk_bf16(D0[4 * g], D0[4 * g + 1]); w.y = pk_bf16(D0[4 * g + 2], D0[4 * g + 3]); *(u32x2*)(o0 + 8 * g) = w;
        u32x2 z; z.x = pk_bf16(D1[4 * g], D1[4 * g + 1]); z.y = pk_bf16(D1[4 * g + 2], D1[4 * g + 3]); *(u32x2*)(o1 + 8 * g) = z; }
}
DI void hgrn_scan(bf16_t* dsT, const float* dec, int vb, int G) {
    for (int idx = vb * NTHR + threadIdx.x; idx < 64 * 128 * 16; idx += G * NTHR) {
        const int dk8 = idx & 15, dv = (idx >> 4) & 127, bh = idx >> 11;
        float S[8];
#pragma unroll
        for (int q = 0; q < 8; ++q) S[q] = 0.f;
        for (int c0 = 0; c0 < 64; c0 += 8) {
            u32x4 ld[8]; f32x4 d0[8], d1[8];
#pragma unroll
            for (int i = 0; i < 8; ++i) { const int c = c0 + i; ld[i] = *(const u32x4*)(dsT + (size_t)((bh * 64 + c) * 128 + dv) * 128 + dk8 * 8);
                const float* dp = dec + (size_t)(bh * 64 + c) * 128 + dk8 * 8; d0[i] = *(const f32x4*)dp; d1[i] = *(const f32x4*)(dp + 4); }
#pragma unroll
            for (int i = 0; i < 8; ++i) { const int c = c0 + i;
                u32x4 w; w.x = pk_bf16(S[0], S[1]); w.y = pk_bf16(S[2], S[3]); w.z = pk_bf16(S[4], S[5]); w.w = pk_bf16(S[6], S[7]);
                *(u32x4*)(dsT + (size_t)((bh * 64 + c) * 128 + dv) * 128 + dk8 * 8) = w;
                S[0] = d0[i][0] * S[0] + bflo(ld[i].x); S[1] = d0[i][1] * S[1] + bfhi(ld[i].x); S[2] = d0[i][2] * S[2] + bflo(ld[i].y); S[3] = d0[i][3] * S[3] + bfhi(ld[i].y);
                S[4] = d1[i][0] * S[4] + bflo(ld[i].z); S[5] = d1[i][1] * S[5] + bfhi(ld[i].z); S[6] = d1[i][2] * S[6] + bflo(ld[i].w); S[7] = d1[i][3] * S[7] + bfhi(ld[i].w); }
        }
    }
}
DI void hgrn_out_unit(const bf16_t* qd, const bf16_t* kinv, const bf16_t* vT, const bf16_t* spT, const bf16_t* gs, bf16_t* yh, LAS float* zs, int bh, int c) {
    const int tid = threadIdx.x, lane = tid & 63, wave = __builtin_amdgcn_readfirstlane(tid >> 6), r = lane & 31, hh = lane >> 5, tb = wave >> 2, db = wave & 3, b = bh >> 2, h = bh & 3;
    const size_t Tb = (size_t)b * SEQ + c * 64;
    bf16x8 qf[8], sf[8], kf0[8], kf1[8]; u32x2 vf[2][2][2];
    { const bf16_t* qrow = qd + (Tb + 32 * tb + r) * 512 + h * 128 + 8 * hh; const bf16_t* sp = spT + (size_t)((bh * 64 + c) * 128 + 32 * db + r) * 128 + 8 * hh;
      const bf16_t* k0 = kinv + (Tb + r) * 512 + h * 128 + 8 * hh; const bf16_t* vrow = vT + (size_t)(bh * 128 + 32 * db + r) * SEQ + c * 64 + 4 * hh;
#pragma unroll
      for (int ks = 0; ks < 8; ++ks) { qf[ks] = *(const bf16x8*)(qrow + 16 * ks); sf[ks] = *(const bf16x8*)(sp + 16 * ks); kf0[ks] = *(const bf16x8*)(k0 + 16 * ks); }
      if (tb) {
#pragma unroll
          for (int ks = 0; ks < 8; ++ks) kf1[ks] = *(const bf16x8*)(k0 + 32 * 512 + 16 * ks); }
#pragma unroll
      for (int sb = 0; sb < 2; ++sb)
#pragma unroll
          for (int s2 = 0; s2 < 2; ++s2) if (sb <= tb) { vf[sb][s2][0] = *(const u32x2*)(vrow + 32 * sb + 16 * s2); vf[sb][s2][1] = *(const u32x2*)(vrow + 32 * sb + 16 * s2 + 8); } }
    f32x16 Z;
#pragma unroll
    for (int q = 0; q < 16; ++q) Z[q] = 0.f;
#pragma unroll
    for (int ks = 0; ks < 8; ++ks) Z = MFMA32(qf[ks], sf[ks], Z);
#pragma unroll
    for (int sb = 0; sb < 2; ++sb) if (sb <= tb) {
        f32x16 X;
#pragma unroll
        for (int q = 0; q < 16; ++q) X[q] = 0.f;
#pragma unroll
        for (int ks = 0; ks < 8; ++ks) X = MFMA32(sb ? kf1[ks] : kf0[ks], qf[ks], X);
        if (sb == tb) {
#pragma unroll
            for (int q = 0; q < 16; ++q) if (crow(q, hh) > r) X[q] = 0.f;
        }
#pragma unroll
        for (int s2 = 0; s2 < 2; ++s2) {
            u32x4 pa_; pa_.x = pk_bf16(X[8 * s2], X[8 * s2 + 1]); pa_.y = pk_bf16(X[8 * s2 + 2], X[8 * s2 + 3]); pa_.z = pk_bf16(X[8 * s2 + 4], X[8 * s2 + 5]); pa_.w = pk_bf16(X[8 * s2 + 6], X[8 * s2 + 7]);
            u32x4 pb_; pb_.x = vf[sb][s2][0].x; pb_.y = vf[sb][s2][0].y; pb_.z = vf[sb][s2][1].x; pb_.w = vf[sb][s2][1].y;
            Z = MFMA32(__builtin_bit_cast(bf16x8, pa_), __builtin_bit_cast(bf16x8, pb_), Z);
        }
    }
#pragma unroll
    for (int q = 0; q < 16; ++q) zs[(32 * tb + crow(q, hh)) * 132 + 32 * db + r] = Z[q];
    __syncthreads();
    { const int tok = tid >> 3, d16 = (tid & 7) * 16; f32x4 o[4]; float ss = 0.f;
      const size_t off = (Tb + tok) * 512 + h * 128 + d16; const u32x4 g0 = *(const u32x4*)(gs + off), g1 = *(const u32x4*)(gs + off + 8);
#pragma unroll
      for (int i = 0; i < 4; ++i) { o[i] = *(const LAS f32x4*)(zs + tok * 132 + d16 + 4 * i); ss += (o[i][0] * o[i][0] + o[i][1] * o[i][1]) + (o[i][2] * o[i][2] + o[i][3] * o[i][3]); }
      ss += __shfl_xor(ss, 1); ss += __shfl_xor(ss, 2); ss += __shfl_xor(ss, 4);
      const float rn = __builtin_amdgcn_rsqf(ss * (1.f / 128.f) + EPS);
      u32x4 w0, w1;
      w0.x = pk_bf16(o[0][0] * rn * bflo(g0.x), o[0][1] * rn * bfhi(g0.x)); w0.y = pk_bf16(o[0][2] * rn * bflo(g0.y), o[0][3] * rn * bfhi(g0.y));
      w0.z = pk_bf16(o[1][0] * rn * bflo(g0.z), o[1][1] * rn * bfhi(g0.z)); w0.w = pk_bf16(o[1][2] * rn * bflo(g0.w), o[1][3] * rn * bfhi(g0.w));
      w1.x = pk_bf16(o[2][0] * rn * bflo(g1.x), o[2][1] * rn * bfhi(g1.x)); w1.y = pk_bf16(o[2][2] * rn * bflo(g1.y), o[2][3] * rn * bfhi(g1.y));
      w1.z = pk_bf16(o[3][0] * rn * bflo(g1.z), o[3][1] * rn * bfhi(g1.z)); w1.w = pk_bf16(o[3][2] * rn * bflo(g1.w), o[3][3] * rn * bfhi(g1.w));
      *(u32x4*)(yh + off) = w0; *(u32x4*)(yh + off + 8) = w1; }
}

DI unsigned f2ord(float f) { const unsigned b = __float_as_uint(f); return b ^ ((unsigned)((int)b >> 31) | 0x80000000u); }
DI float ord2f(unsigned k) { const unsigned b = (k & 0x80000000u) ? (k ^ 0x80000000u) : ~k; return __uint_as_float(b); }
DI void ce_desc(unsigned& a, unsigned& b) { const unsigned hi = a > b ? a : b, lo = a > b ? b : a; a = hi; b = lo; }
DI void sort16_desc(unsigned (&a)[16]) {
#pragma unroll
    for (int k = 2; k <= 16; k <<= 1)
#pragma unroll
        for (int j = k >> 1; j > 0; j >>= 1)
#pragma unroll
            for (int i = 0; i < 16; ++i) { const int l = i ^ j; if (l > i) { if ((i & k) == 0) ce_desc(a[i], a[l]); else ce_desc(a[l], a[i]); } }
}
DI void merge16_desc(unsigned (&a)[16], const unsigned (&b)[16]) {
#pragma unroll
    for (int i = 0; i < 16; ++i) a[i] = a[i] > b[15 - i] ? a[i] : b[15 - i];
#pragma unroll
    for (int j = 8; j > 0; j >>= 1)
#pragma unroll
        for (int i = 0; i < 16; ++i) { const int l = i ^ j; if (l > i) ce_desc(a[i], a[l]); }
}
#define TK_INS(L, x) do { unsigned t_ = (x); _Pragma("unroll") for (int j_ = 0; j_ < 16; ++j_) { const unsigned hi_ = L[j_] > t_ ? L[j_] : t_; t_ = L[j_] > t_ ? t_ : L[j_]; L[j_] = hi_; } } while (0)

DI void topk_stage_keys(const bf16_t* keysb, LAS unsigned char* kl, int h) {
    for (int c = threadIdx.x; c < 2 * 128 * 16; c += NTHR) { const int p = c >> 11, row = (c >> 4) & 127, ch = c & 15;
        *(LAS u32x4*)(kl + (p * 128 + row) * 272 + ch * 16) = *(const u32x4*)(keysb + ((size_t)(p * 8 + h) * 128 + row) * 128 + ch * 8); }
}
DI void topk_unit(const bf16_t* qp, const LAS unsigned char* kl, unsigned short* gidx, float* ggate, LAS unsigned* tk, int quad, int h) {
    const int tid = threadIdx.x, lane = tid & 63, wave = tid >> 6, p = wave & 1, tsub = wave >> 1, r = lane & 31, hh = lane >> 5;
#pragma unroll 1
    for (int hl = 0; hl < 4; ++hl) {
        const int tok0 = (quad * 4 + hl) * 128 + tsub * 32;
        f32x16 acc[4];
#pragma unroll
        for (int kb = 0; kb < 4; ++kb)
#pragma unroll
            for (int i = 0; i < 16; ++i) acc[kb][i] = 0.f;
        const bf16_t* qrow = qp + (size_t)(tok0 + r) * 2048 + h * 256 + p * 128 + 8 * hh;
        const LAS unsigned char* kbase = kl + (p * 128 + r) * 272 + 16 * hh;
#pragma unroll
        for (int s = 0; s < 8; ++s) { const bf16x8 bq = *(const bf16x8*)(qrow + 16 * s);
#pragma unroll
            for (int kb = 0; kb < 4; ++kb) { const bf16x8 ak = *(const LAS bf16x8*)(kbase + kb * 32 * 272 + 32 * s); acc[kb] = MFMA32(ak, bq, acc[kb]); } }
        unsigned A0[16], A1[16], A2[16], A3[16];
#pragma unroll
        for (int i = 0; i < 16; ++i) { const unsigned ki = (unsigned)(crow(i, hh));
            A0[i] = (f2ord(acc[0][i]) & ~127u) | ki; A1[i] = (f2ord(acc[1][i]) & ~127u) | (32u + ki); A2[i] = (f2ord(acc[2][i]) & ~127u) | (64u + ki); A3[i] = (f2ord(acc[3][i]) & ~127u) | (96u + ki); }
        sort16_desc(A0); sort16_desc(A1); sort16_desc(A2); sort16_desc(A3);
        merge16_desc(A0, A1); merge16_desc(A2, A3); merge16_desc(A0, A2);
#pragma unroll
        for (int j = 0; j < 16; ++j) A1[j] = __shfl_xor(A0[j], 32);
        merge16_desc(A0, A1);
        if (hh == 0) { LAS u32x4* dst = (LAS u32x4*)(tk + (((hl * 2 + p) * 128 + tsub * 32 + r) * 16));
#pragma unroll
            for (int c = 0; c < 4; ++c) { u32x4 w = {A0[4 * c], A0[4 * c + 1], A0[4 * c + 2], A0[4 * c + 3]}; dst[c] = w; } }
    }
    __syncthreads();
    {
        const int tok = tid & 127, hl = tid >> 7, tile = quad * 4 + hl;
        const LAS unsigned* t1 = tk + ((hl * 2 + 0) * 128 + tok) * 16; const LAS unsigned* t2 = tk + ((hl * 2 + 1) * 128 + tok) * 16;
        float v1[16], v2[16];
        { const LAS u32x4* s1 = (const LAS u32x4*)t1; const LAS u32x4* s2 = (const LAS u32x4*)t2;
#pragma unroll
          for (int c = 0; c < 4; ++c) { const u32x4 a = s1[c], b = s2[c];
              v1[4 * c] = ord2f(a.x & ~127u); v1[4 * c + 1] = ord2f(a.y & ~127u); v1[4 * c + 2] = ord2f(a.z & ~127u); v1[4 * c + 3] = ord2f(a.w & ~127u);
              v2[4 * c] = ord2f(b.x & ~127u); v2[4 * c + 1] = ord2f(b.y & ~127u); v2[4 * c + 2] = ord2f(b.z & ~127u); v2[4 * c + 3] = ord2f(b.w & ~127u); } }
#define CKEY(i, j) ((f2ord(v1[i] + v2[j]) & ~255u) | (unsigned)((i) * 16 + (j)))
        unsigned C[16], D[16], E[16];
#pragma unroll
        for (int j = 0; j < 16; ++j) C[j] = CKEY(0, j);
#pragma unroll
        for (int j = 0; j < 8; ++j) D[j] = CKEY(1, j);
#pragma unroll
        for (int j = 0; j < 5; ++j) D[8 + j] = CKEY(2, j);
#pragma unroll
        for (int j = 0; j < 3; ++j) D[13 + j] = CKEY(4, j);
#pragma unroll
        for (int j = 0; j < 4; ++j) E[j] = CKEY(3, j);
        E[4] = CKEY(5, 0); E[5] = CKEY(5, 1); E[6] = CKEY(6, 0); E[7] = CKEY(6, 1); E[8] = CKEY(7, 0); E[9] = CKEY(7, 1);
        E[10] = CKEY(8, 0); E[11] = CKEY(9, 0); E[12] = CKEY(10, 0); E[13] = CKEY(11, 0); E[14] = CKEY(12, 0); E[15] = CKEY(13, 0);
        sort16_desc(D); sort16_desc(E);
        TK_INS(E, CKEY(14, 0)); TK_INS(E, CKEY(15, 0));
#undef CKEY
        merge16_desc(C, D); merge16_desc(C, E);
        float sc[16]; unsigned ei[16]; float mx = -1e30f;
#pragma unroll
        for (int q = 0; q < 16; ++q) { const unsigned ij = C[q] & 255u; const unsigned a = t1[ij >> 4], b = t2[ij & 15u];
            sc[q] = ord2f(a & ~127u) + ord2f(b & ~127u); ei[q] = (a & 127u) * 128u + (b & 127u); mx = fmaxf(mx, sc[q]); }
        float sum = 0.f;
#pragma unroll
        for (int q = 0; q < 16; ++q) { sc[q] = __expf(sc[q] - mx); sum += sc[q]; }
        const float inv = 1.f / sum; const size_t o = (size_t)(tile * 128 + tok) * 128 + h * 16;
        u32x4 w0, w1;
        w0.x = ei[0] | (ei[1] << 16); w0.y = ei[2] | (ei[3] << 16); w0.z = ei[4] | (ei[5] << 16); w0.w = ei[6] | (ei[7] << 16);
        w1.x = ei[8] | (ei[9] << 16); w1.y = ei[10] | (ei[11] << 16); w1.z = ei[12] | (ei[13] << 16); w1.w = ei[14] | (ei[15] << 16);
        *(u32x4*)(gidx + o) = w0; *(u32x4*)(gidx + o + 8) = w1;
#pragma unroll
        for (int c = 0; c < 4; ++c) *(f32x4*)(ggate + o + 4 * c) = (f32x4){sc[4 * c] * inv, sc[4 * c + 1] * inv, sc[4 * c + 2] * inv, sc[4 * c + 3] * inv};
    }
    __syncthreads();
}

DI float gelu_erf(float x) { return 0.5f * x * (1.f + erff(x * 0.70710678118654752f)); }
DI int dot16(u32x4 w, const int (&h)[4]) { int c = __builtin_amdgcn_sdot4((int)w.x, h[0], 0, false); c = __builtin_amdgcn_sdot4((int)w.y, h[1], c, false); c = __builtin_amdgcn_sdot4((int)w.z, h[2], c, false); return __builtin_amdgcn_sdot4((int)w.w, h[3], c, false); }
#define V8_FMA(acc4, word, we) do { acc4[0] += (we) * (float)((word) & 255u); acc4[1] += (we) * (float)(((word) >> 8) & 255u); acc4[2] += (we) * (float)(((word) >> 16) & 255u); acc4[3] += (we) * (float)((word) >> 24); } while (0)

template <int IDMASK> DI void expert_token(const bf16_t* x2row, const float* ssq, const unsigned char* u8, const unsigned char* v8, const float* su, const float* sv, const unsigned short* gidx, const float* ggate, const float* gf, float* outrow, int lane) {
    f32x4 x[4]; float amax = 0.f;
#pragma unroll
    for (int i = 0; i < 4; ++i) { const u32x2 w_ = *(const u32x2*)(x2row + 16 * lane + 4 * i); x[i] = (f32x4){bflo(w_.x), bfhi(w_.x), bflo(w_.y), bfhi(w_.y)}; amax = fmaxf(fmaxf(amax, fmaxf(fabsf(x[i][0]), fabsf(x[i][1]))), fmaxf(fabsf(x[i][2]), fabsf(x[i][3]))); }
    float ss = (lane < 16) ? ssq[lane] : 0.f; ss = wave_sum(ss);
    const float rstd2 = __builtin_amdgcn_rsqf(ss * (1.f / 1024.f) + EPS);
#pragma unroll
    for (int o = 1; o < 64; o <<= 1) amax = fmaxf(amax, __shfl_xor(amax, o));
    amax *= rstd2;
    const float qs = amax > 0.f ? 127.f / amax : 0.f, sh = amax * (1.f / 127.f), xq = rstd2 * qs;
    int hq[4];
#pragma unroll
    for (int i = 0; i < 4; ++i) { const int q0 = (int)rintf(x[i][0] * xq), q1 = (int)rintf(x[i][1] * xq), q2 = (int)rintf(x[i][2] * xq), q3 = (int)rintf(x[i][3] * xq);
        hq[i] = (int)((unsigned)(q0 & 255) | ((unsigned)(q1 & 255) << 8) | ((unsigned)(q2 & 255) << 16) | ((unsigned)(q3 & 255) << 24)); }
    const int id0 = gidx[lane] & IDMASK, id1 = gidx[64 + lane] & IDMASK; const float g0 = ggate[lane], g1 = ggate[64 + lane];
    f32x4 o[4]; float wsum = 0.f;
#pragma unroll
    for (int i = 0; i < 4; ++i) o[i] = (f32x4){0.f, 0.f, 0.f, 0.f};
#pragma unroll 1
    for (int bt = 0; bt < 16; ++bt) {
        const int idsel = (bt < 8) ? id0 : id1; const float gsel = (bt < 8) ? g0 : g1; const int lb = (bt & 7) * 8;
        u32x4 ur[8], vr[8];
#pragma unroll
        for (int e = 0; e < 8; ++e) { const int idx = __builtin_amdgcn_readlane(idsel, lb + e); ur[e] = *(const u32x4*)(u8 + (size_t)idx * 1024 + 16 * lane); }
#pragma unroll
        for (int e = 0; e < 8; ++e) { const int idx = __builtin_amdgcn_readlane(idsel, lb + e); vr[e] = *(const u32x4*)(v8 + (size_t)idx * 1024 + 16 * lane); }
        const int myidx = __shfl(idsel, lb + (lane >> 3)); const float mysu = su[myidx], mysv = sv[myidx], gate = __shfl(gsel, lb + (lane >> 3));
        int pr[8];
#pragma unroll
        for (int e = 0; e < 8; ++e) pr[e] = dot16(ur[e], hq);
        int q4[4], q2[2], q1;
        { const bool up_ = (lane & 32) != 0;
#pragma unroll
          for (int i = 0; i < 4; ++i) { const int keep = up_ ? pr[i + 4] : pr[i], send = up_ ? pr[i] : pr[i + 4]; q4[i] = keep + __shfl_xor(send, 32); } }
        { const bool up_ = (lane & 16) != 0;
#pragma unroll
          for (int i = 0; i < 2; ++i) { const int keep = up_ ? q4[i + 2] : q4[i], send = up_ ? q4[i] : q4[i + 2]; q2[i] = keep + __shfl_xor(send, 16); } }
        { const bool up_ = (lane & 8) != 0; const int keep = up_ ? q2[1] : q2[0], send = up_ ? q2[0] : q2[1]; q1 = keep + __shfl_xor(send, 8); }
        q1 += __shfl_xor(q1, 4); q1 += __shfl_xor(q1, 2); q1 += __shfl_xor(q1, 1);
        const float act = (float)q1 * (mysu * sh);
        const float w = gelu_erf(act) * gate * mysv;
#pragma unroll
        for (int e = 0; e < 8; ++e) { const float we = __int_as_float(__builtin_amdgcn_readlane(__float_as_int(w), 8 * e)); wsum += we;
            V8_FMA(o[0], vr[e].x, we); V8_FMA(o[1], vr[e].y, we); V8_FMA(o[2], vr[e].z, we); V8_FMA(o[3], vr[e].w, we); }
    }
    const float corr = 128.f * wsum; float s3 = 0.f;
#pragma unroll
    for (int i = 0; i < 4; ++i) { x[i] += o[i] - corr; s3 += (x[i][0] * x[i][0] + x[i][1] * x[i][1]) + (x[i][2] * x[i][2] + x[i][3] * x[i][3]); }
    s3 = wave_sum(s3); const float r3 = __builtin_amdgcn_rsqf(s3 * (1.f / 1024.f) + EPS);
#pragma unroll
    for (int i = 0; i < 4; ++i) *(f32x4*)(outrow + 16 * lane + 4 * i) = x[i] * r3 * *(const f32x4*)(gf + 16 * lane + 4 * i);
}

DI void hq_token(const bf16_t* x2row, const float* ssq, unsigned char* hqrow, float* shp, int lane) {
    f32x4 x[4]; float amax = 0.f;
#pragma unroll
    for (int i = 0; i < 4; ++i) { const u32x2 w_ = *(const u32x2*)(x2row + 16 * lane + 4 * i); x[i] = (f32x4){bflo(w_.x), bfhi(w_.x), bflo(w_.y), bfhi(w_.y)}; amax = fmaxf(fmaxf(amax, fmaxf(fabsf(x[i][0]), fabsf(x[i][1]))), fmaxf(fabsf(x[i][2]), fabsf(x[i][3]))); }
    float ss = (lane < 16) ? ssq[lane] : 0.f; ss = wave_sum(ss);
    const float rstd2 = __builtin_amdgcn_rsqf(ss * (1.f / 1024.f) + EPS);
#pragma unroll
    for (int o = 1; o < 64; o <<= 1) amax = fmaxf(amax, __shfl_xor(amax, o));
    amax *= rstd2;
    const float qs = amax > 0.f ? 127.f / amax : 0.f, xq = rstd2 * qs;
    u32x4 w;
#pragma unroll
    for (int i = 0; i < 4; ++i) { const int q0 = (int)rintf(x[i][0] * xq), q1 = (int)rintf(x[i][1] * xq), q2 = (int)rintf(x[i][2] * xq), q3 = (int)rintf(x[i][3] * xq);
        w[i] = (unsigned)(q0 & 255) | ((unsigned)(q1 & 255) << 8) | ((unsigned)(q2 & 255) << 16) | ((unsigned)(q3 & 255) << 24); }
    *(u32x4*)(hqrow + 16 * lane) = w;
    if (lane == 0) *shp = amax * (1.f / 127.f);
}
template <int CTRL> DI int dpp_i(int v) { return __builtin_amdgcn_mov_dpp(v, CTRL, 0xf, 0xf, true); }
template <int CTRL> DI float dpp_f(float v) { return __int_as_float(__builtin_amdgcn_mov_dpp(__float_as_int(v), CTRL, 0xf, 0xf, true)); }
DI float swapadd32(float a, float b) { const auto r = __builtin_amdgcn_permlane32_swap(__float_as_uint(a), __float_as_uint(b), false, false); return __uint_as_float(r[0]) + __uint_as_float(r[1]); }
DI float swapadd16(float a, float b) { const auto r = __builtin_amdgcn_permlane16_swap(__float_as_uint(a), __float_as_uint(b), false, false); return __uint_as_float(r[0]) + __uint_as_float(r[1]); }

struct SMeta { u32x4 i0, i1, a0, a1; unsigned xw; };
DI void slice_issue(u32x4 (&r)[16], const SMeta& m, const unsigned char* base) {
    const unsigned iw[8] = {m.i0.x, m.i0.y, m.i0.z, m.i0.w, m.i1.x, m.i1.y, m.i1.z, m.i1.w};
#pragma unroll
    for (int j = 0; j < 16; ++j) { const unsigned idx = (j & 1) ? (iw[j >> 1] >> 16) : (iw[j >> 1] & 0xffffu); r[j] = *(const u32x4*)(base + (size_t)idx * 1024); }
}
DI void slice_u_compute(const SMeta& m, const u32x4 (&r)[16], int* actp, int lane) {
    const int hq[4] = {(int)m.a0.x, (int)m.a0.y, (int)m.a0.z, (int)m.a0.w};
    int part[16];
#pragma unroll
    for (int j = 0; j < 16; ++j) part[j] = dot16(r[j], hq);
    int r8[8], r4[4], r2[2];
    { const bool up_ = (lane & 4) != 0;
#pragma unroll
      for (int i = 0; i < 8; ++i) { const int keep = up_ ? part[i + 8] : part[i], send = up_ ? part[i] : part[i + 8]; r8[i] = keep + dpp_i<0x141>(send); } }
    { const bool up_ = (lane & 2) != 0;
#pragma unroll
      for (int i = 0; i < 4; ++i) { const int keep = up_ ? r8[i + 4] : r8[i], send = up_ ? r8[i] : r8[i + 4]; r4[i] = keep + dpp_i<0x4E>(send); } }
    { const bool up_ = (lane & 1) != 0;
#pragma unroll
      for (int i = 0; i < 2; ++i) { const int keep = up_ ? r4[i + 2] : r4[i], send = up_ ? r4[i] : r4[i + 2]; r2[i] = keep + dpp_i<0xB1>(send); } }
    typedef int i32x2 __attribute__((ext_vector_type(2)));
    *(i32x2*)(actp + 2 * lane) = (i32x2){r2[0], r2[1]};
}
DI void slice_v_compute(const SMeta& m, const u32x4 (&r)[16], float* x3row, float* ssq3p, int xs, int lane) {
    const unsigned ww[8] = {m.a0.x, m.a0.y, m.a0.z, m.a0.w, m.a1.x, m.a1.y, m.a1.z, m.a1.w};
    const int col = 16 * (lane & 7) + ((lane >> 5) & 1) * 8 + ((lane >> 4) & 1) * 4 + ((lane >> 3) & 1) * 2;
    const unsigned xw = m.xw;
    f32x4 o[4]; float wsum = 0.f;
#pragma unroll
    for (int i = 0; i < 4; ++i) o[i] = (f32x4){0.f, 0.f, 0.f, 0.f};
#pragma unroll
    for (int j = 0; j < 16; ++j) { const h16x2 wp = __builtin_bit_cast(h16x2, ww[j >> 1]); const float we = (float)((j & 1) ? wp[1] : wp[0]); wsum += we;
        V8_FMA(o[0], r[j].x, we); V8_FMA(o[1], r[j].y, we); V8_FMA(o[2], r[j].z, we); V8_FMA(o[3], r[j].w, we); }
    float a8[8], a4[4], a2[2];
#pragma unroll
    for (int i = 0; i < 8; ++i) a8[i] = swapadd32(o[i >> 2][i & 3], o[2 + (i >> 2)][i & 3]);
#pragma unroll
    for (int i = 0; i < 4; ++i) a4[i] = swapadd16(a8[i], a8[i + 4]);
    { const bool up_ = (lane & 8) != 0;
#pragma unroll
      for (int i = 0; i < 2; ++i) { const float keep = up_ ? a4[i + 2] : a4[i], send = up_ ? a4[i] : a4[i + 2]; a2[i] = keep + dpp_f<0x128>(send); } }
    wsum += dpp_f<0x128>(wsum); wsum = swapadd16(wsum, wsum); wsum = swapadd32(wsum, wsum);
    const float corr = 128.f * wsum, y0 = bflo(xw) + a2[0] - corr, y1 = bfhi(xw) + a2[1] - corr;
    *(f32x2*)(x3row + 128 * xs + col) = (f32x2){y0, y1};
    const float ss = wave_sum(y0 * y0 + y1 * y1);
    if (lane == 0) ssq3p[xs] = ss;
}
template <int MODE> DI void slice_pass(unsigned char* ws, float* out, int xs, int gw_, int nw_, int lane) {
    const int g = lane >> 3, c = lane & 7;
    const unsigned short* gidx = (const unsigned short*)(ws + WS_GIDX) + 16 * g;
    const unsigned char* tab = (MODE == 0 ? (const unsigned char*)(ws + WS_U8) : (const unsigned char*)(ws + WS_V8)) + 128 * xs + 16 * c;
    const unsigned char* hqb = (const unsigned char*)(ws + WS_HQ) + 128 * xs + 16 * c;
    const _Float16* wxb = (const _Float16*)(ws + WS_WX) + 16 * g;
    const bf16_t* x2b = (const bf16_t*)(ws + WS_X2B) + 128 * xs + 16 * c + ((lane >> 5) & 1) * 8 + ((lane >> 4) & 1) * 4 + ((lane >> 3) & 1) * 2;
#define S_LOAD(m, tok) do { const unsigned short* ip = gidx + (size_t)(tok) * 128; (m).i0 = *(const u32x4*)ip; (m).i1 = *(const u32x4*)(ip + 8); \
        if (MODE == 0) { (m).a0 = *(const u32x4*)(hqb + (size_t)(tok) * 1024); } else { const _Float16* wp_ = wxb + (size_t)(tok) * 128; (m).a0 = *(const u32x4*)wp_; (m).a1 = *(const u32x4*)(wp_ + 8); (m).xw = *(const unsigned*)(x2b + (size_t)(tok) * DM); } } while (0)
#define S_COMPUTE(m, r, tok) do { if (MODE == 0) slice_u_compute(m, r, (int*)(ws + WS_ACTP) + ((size_t)(tok) * 8 + xs) * 128, lane); \
        else slice_v_compute(m, r, out + (size_t)(tok) * DM, (float*)(ws + WS_SSQ3) + (size_t)(tok) * 8, xs, lane); } while (0)
    SMeta mA, mB, mN; u32x4 rA[16], rB[16];
    if (gw_ >= T) return;
    const int n = (T - gw_ + nw_ - 1) / nw_;
#define S_TK(j) (gw_ + ((j) < n ? (j) : n - 1) * nw_)
    S_LOAD(mA, S_TK(0)); slice_issue(rA, mA, tab); S_LOAD(mB, S_TK(1));
    for (int i = 0; i < n; i += 2) {
        slice_issue(rB, mB, tab);
        S_LOAD(mN, S_TK(i + 2));
        S_COMPUTE(mA, rA, S_TK(i));
        mA = mN; slice_issue(rA, mA, tab);
        S_LOAD(mN, S_TK(i + 3));
        if (i + 1 < n) S_COMPUTE(mB, rB, S_TK(i + 1));
        mB = mN;
    }
#undef S_TK
#undef S_LOAD
#undef S_COMPUTE
}
DI void expert_w_token(const int* actp, const unsigned short* gidx, const float* ggate, float sh, const float* su, const float* sv, _Float16* wrow, int lane) {
    typedef int i32x2 __attribute__((ext_vector_type(2)));
    i32x2 acc = {0, 0};
#pragma unroll
    for (int x = 0; x < 8; ++x) acc += *(const i32x2*)(actp + x * 128 + 2 * lane);
    const unsigned ii = *(const unsigned*)(gidx + 2 * lane); const f32x2 gt = *(const f32x2*)(ggate + 2 * lane);
    const int e0 = ii & 0xffffu, e1 = ii >> 16;
    const float w0 = gelu_erf((float)acc[0] * (su[e0] * sh)) * gt[0] * sv[e0], w1 = gelu_erf((float)acc[1] * (su[e1] * sh)) * gt[1] * sv[e1];
    *(unsigned*)(wrow + 2 * lane) = pk_f16(w0, w1);
}
DI void final_norm_token(float* row, const float* ssq3p, const float* gf, int lane) {
    float ss = (lane < 8) ? ssq3p[lane] : 0.f; ss = wave_sum(ss);
    const float r3 = __builtin_amdgcn_rsqf(ss * (1.f / 1024.f) + EPS);
#pragma unroll
    for (int i = 0; i < 4; ++i) { f32x4* p = (f32x4*)(row + 256 * i + 4 * lane); *p = *p * r3 * *(const f32x4*)(gf + 256 * i + 4 * lane); }
}

#define XB_TMO      128
#define XB_XCNT(j)  (256  + 64 * (j))
#define XB_XSUB(j)  (1280 + 64 * (j))
#define XB_XGEN(j)  (2304 + 64 * (j))
#define XB_TOP      3328
#define XB_TOPGEN   3392
#define XCD_BAR_WORDS 3456
#define XB_SPIN_CAP (1u << 18)

__device__ __forceinline__ unsigned xb_ld(unsigned* p)              { return __hip_atomic_load(p, __ATOMIC_RELAXED, __HIP_MEMORY_SCOPE_AGENT); }
__device__ __forceinline__ unsigned xb_add(unsigned* p, unsigned v) { return __hip_atomic_fetch_add(p, v, __ATOMIC_RELAXED, __HIP_MEMORY_SCOPE_AGENT); }
__device__ __forceinline__ unsigned xb_xcc_id() { return (unsigned)__builtin_amdgcn_s_getreg((3 << 11) | 20) & 0xFu; }
#define XB_SPIN(cond, bar) do { unsigned _sp = 0; while (cond) { __builtin_amdgcn_s_sleep(1); \
    if ((++_sp & 255u) == 0u) { if (xb_ld(&(bar)[XB_TMO])) break; if (_sp > XB_SPIN_CAP) { atomicAdd(&(bar)[XB_TMO], 1u); break; } } } } while (0)

struct XcdBarrier {
    unsigned* bar; unsigned x;
    volatile __attribute__((address_space(3))) unsigned* st;
};

__device__ __forceinline__ XcdBarrier xcd_barrier_post(unsigned* bar, volatile __attribute__((address_space(3))) unsigned* st) {
    XcdBarrier b; b.bar = bar; b.x = xb_xcc_id(); b.st = st;
    if (threadIdx.x == 0) st[2] = xb_add(&bar[XB_XCNT(b.x)], 1u);
    return b;
}
__device__ __forceinline__ void xcd_barrier_complete(unsigned* bar, unsigned x, unsigned& nloc, unsigned& nx) {
    const unsigned G = gridDim.x * gridDim.y * gridDim.z;
    unsigned sum, cnt, mine, sp = 0u;
    for (;;) {
        sum = 0u; cnt = 0u; mine = 0u;
#pragma unroll
        for (unsigned j = 0; j < 16; ++j) { const unsigned c = xb_ld(&bar[XB_XCNT(j)]); sum += c; cnt += (c > 0u) ? 1u : 0u; mine = (j == x) ? c : mine; }
        if (sum == G) break;
        __builtin_amdgcn_s_sleep(1);
        if ((++sp & 255u) == 0u) { if (xb_ld(&bar[XB_TMO])) break; if (sp > XB_SPIN_CAP) { atomicAdd(&bar[XB_TMO], 1u); break; } }
    }
    nloc = mine > 0u ? mine : 1u; nx = cnt > 0u ? cnt : 1u;
}

__device__ __forceinline__ void xcd_barrier(const XcdBarrier& b) {
    asm volatile("s_waitcnt vmcnt(0)" ::: "memory");
    __syncthreads();
    if (threadIdx.x == 0) {
        unsigned* bar = b.bar;
        __builtin_amdgcn_s_waitcnt(0);
        unsigned nloc = b.st[0], nx = b.st[1];
        if (nloc == 0u) { xcd_barrier_complete(bar, b.x, nloc, nx); b.st[0] = nloc; b.st[1] = nx; }
        const unsigned old = xb_add(&bar[XB_XSUB(b.x)], 1u);
        const unsigned gen = old / nloc;
        if (old + 1u == (gen + 1u) * nloc) {
            __builtin_amdgcn_fence(__ATOMIC_RELEASE, "agent");
            asm volatile("s_waitcnt vmcnt(0)" ::: "memory");
            const unsigned og = xb_add(&bar[XB_TOP], 1u);
            const unsigned tg = og / nx;
            if (og + 1u == (tg + 1u) * nx) xb_add(&bar[XB_TOPGEN], 1u);
            else XB_SPIN(xb_ld(&bar[XB_TOPGEN]) == tg, bar);
            __builtin_amdgcn_fence(__ATOMIC_ACQUIRE, "agent");
            xb_add(&bar[XB_XGEN(b.x)], 1u);
            asm volatile("s_waitcnt vmcnt(0)" ::: "memory");
        } else {
            XB_SPIN(xb_ld(&bar[XB_XGEN(b.x)]) == gen, bar);
            __builtin_amdgcn_fence(__ATOMIC_ACQUIRE, "agent");
            asm volatile("s_waitcnt vmcnt(0)" ::: "memory");
        }
    }
    __syncthreads();
}

constexpr int N_PHASES = 13;
__global__ void __launch_bounds__(NTHR, 2) mk_fwd(Args a) {
    extern __shared__ __attribute__((aligned(16))) unsigned char lds_raw[];
    LAS unsigned char* lds = (LAS unsigned char*)lds_raw;
    cg::grid_group grid = cg::this_grid();
    const int G = gridDim.x, vb = blockIdx.x, tid = threadIdx.x, lane = tid & 63, wave = tid >> 6;
    unsigned char* ws = a.ws;
    const int lo = a.ph_lo, hi = a.ph_hi;
    volatile LAS unsigned* MISC = (volatile LAS unsigned*)(lds + LDS_BYTES - 64);
    if (tid < 16) MISC[tid] = 0u;
    __syncthreads();
    const XcdBarrier bar = xcd_barrier_post((unsigned*)(ws + 4096) + lo * XCD_BAR_WORDS, MISC);
#ifndef PHASE_MASK
#define PHASE_MASK 0xFFFF
#endif
#define IN(k) (((PHASE_MASK >> (k)) & 1) && lo <= (k) && (k) < hi)
#ifndef REPEAT_MASK
#define REPEAT_MASK 0
#endif
#define REP(k) for (int rep_ = 0; rep_ < (((REPEAT_MASK) >> (k)) & 1) + 1; ++rep_)
#define SEAM(k) do { if (IN(k) && IN((k) + 1)) { if ((k) == 0) grid.sync(); else xcd_barrier(bar); } } while (0)
    REP(0) if (IN(0)) p0_prologue(a, lds, vb, G);
    SEAM(0);
    REP(1) if (IN(1)) { pg8::Gemm g{(const bf16_t*)(ws + WS_XB), (const bf16_t*)(ws + WS_W1T), T, NIN, 1024}; pg8::StaticOrder S; S.init(T, NIN, G, vb);
        pg8::Epi1 E{(const float*)(ws + WS_RSTD1), (bf16_t*)(ws + WS_PA), (bf16_t*)(ws + WS_GG), (bf16_t*)(ws + WS_QD), (bf16_t*)(ws + WS_KINV), (bf16_t*)(ws + WS_KENDT), (bf16_t*)(ws + WS_VT), (bf16_t*)(ws + WS_GS),
                    (float*)(ws + WS_DEC), (const float*)(ws + WS_LB), (bf16_t*)(ws + WS_AVT), lds + 131072};
        pg8::gemm_phase<pg8::Epi1, pg8::StaticOrder, true, true>(lds, g, S, E); }
#ifdef PROBE_GEMM1_PLAIN
    if (IN(1)) { pg8::Gemm g{(const bf16_t*)(ws + WS_XB), (const bf16_t*)(ws + WS_W1T), T, NIN, 1024}; pg8::StaticOrder S; S.init(T, NIN, G, vb);
        pg8::EpiDummy E{(bf16_t*)(ws + WS_YA), (const float*)(ws + WS_RSTD1)};
        pg8::gemm_phase<pg8::EpiDummy, pg8::StaticOrder, true, true>(lds, g, S, E); }
#endif
    SEAM(1);
    REP(2) if (IN(2)) {
        for (int u = vb; u < 64 * 64; u += G) hgrn_ds_unit((const bf16_t*)(ws + WS_KENDT), (const bf16_t*)(ws + WS_VT), (bf16_t*)(ws + WS_XB), u >> 6, u & 63);
#ifdef PROBE_DS2
        for (int u = vb; u < 64 * 64; u += G) hgrn_ds_unit((const bf16_t*)(ws + WS_KENDT), (const bf16_t*)(ws + WS_VT), (bf16_t*)(ws + WS_XB), u >> 6, u & 63);
#endif
        { const int hw = __builtin_amdgcn_readfirstlane(wave);
          for (int u = vb; u < BATCH * (SEQ / 32); u += G) attn_task((const bf16_t*)(ws + WS_PA), (const bf16_t*)(ws + WS_AVT), a.in[3], (bf16_t*)(ws + WS_YA), u >> 7, u & 127, hw);
#ifdef PROBE_ATT2
          for (int u = vb; u < BATCH * (SEQ / 32); u += G) attn_task((const bf16_t*)(ws + WS_PA), (const bf16_t*)(ws + WS_AVT), a.in[3], (bf16_t*)(ws + WS_YA), u >> 7, u & 127, hw);
#endif
 }
    }
    SEAM(2);
    REP(3) if (IN(3)) hgrn_scan((bf16_t*)(ws + WS_XB), (const float*)(ws + WS_DEC), vb, G);
    SEAM(3);
    REP(4) if (IN(4)) { int bsel = 0; for (int u = vb; u < 64 * 64; u += G, bsel ^= 1)
        hgrn_out_unit((const bf16_t*)(ws + WS_QD), (const bf16_t*)(ws + WS_KINV), (const bf16_t*)(ws + WS_VT), (const bf16_t*)(ws + WS_XB), (const bf16_t*)(ws + WS_GS), (bf16_t*)(ws + WS_YH), (LAS float*)(lds + bsel * 34816), u >> 6, u & 63);
        __syncthreads(); }
    SEAM(4);
    REP(5) if (IN(5)) {
        { pg8::Gemm g{(const bf16_t*)(ws + WS_YA), (const bf16_t*)(ws + WS_WAPT), T, 1024, 512}; pg8::StaticOrder S; S.init(T, 1024, G, vb);
          pg8::EpiMerge<false> E{(bf16_t*)(ws + WS_XB), (const bf16_t*)(ws + WS_GG)};
          pg8::gemm_phase<pg8::EpiMerge<false>, pg8::StaticOrder, true, true>(lds, g, S, E); }
        __syncthreads();
        { pg8::Gemm g{(const bf16_t*)(ws + WS_YH), (const bf16_t*)(ws + WS_WHPT), T, 1024, 512}; pg8::StaticOrder S; S.init(T, 1024, G, vb);
          pg8::EpiMerge<true> E{(bf16_t*)(ws + WS_XB), (const bf16_t*)(ws + WS_GG) + 1024};
          pg8::gemm_phase<pg8::EpiMerge<true>, pg8::StaticOrder, true, true>(lds, g, S, E); }
    }
    SEAM(5);
    REP(6) if (IN(6)) { pg8::Gemm g{(const bf16_t*)(ws + WS_XB), (const bf16_t*)(ws + WS_WOUTT), T, 1024, 1024}; pg8::StaticOrder S; S.init(T, 1024, G, vb);
        pg8::EpiX2 E{a.in[0], (bf16_t*)(ws + WS_X2B), (float*)(ws + WS_SSQ2)};
        pg8::gemm_phase<pg8::EpiX2, pg8::StaticOrder, true, true>(lds, g, S, E); }
    SEAM(6);
    REP(7) if (IN(7)) { pg8::Gemm g{(const bf16_t*)(ws + WS_X2B), (const bf16_t*)(ws + WS_WQT), T, 2048, 1024}; pg8::StaticOrder S; S.init(T, 2048, G, vb);
        pg8::EpiQp E{(bf16_t*)(ws + WS_QP), (const float*)(ws + WS_SSQ2)};
        pg8::gemm_phase<pg8::EpiQp, pg8::StaticOrder, true, true>(lds, g, S, E); }
    SEAM(7);
    REP(8) if (IN(8)) { const int per = (1024 + G - 1) / G; int hcur = -1;
        for (int U = vb * per; U < (vb + 1) * per && U < 1024; ++U) { const int h = U >> 7;
            if (h != hcur) { topk_stage_keys((const bf16_t*)(ws + WS_KEYS), lds + 65536, h); hcur = h; __syncthreads(); }
            topk_unit((const bf16_t*)(ws + WS_QP), lds + 65536, (unsigned short*)(ws + WS_GIDX), (float*)(ws + WS_GGATE), (LAS unsigned*)lds, U & 127, h); }
        for (int tok = vb * 8 + wave; tok < T; tok += G * 8) hq_token((const bf16_t*)(ws + WS_X2B) + (size_t)tok * DM, (const float*)(ws + WS_SSQ2) + (size_t)tok * 16, (unsigned char*)(ws + WS_HQ) + (size_t)tok * 1024, (float*)(ws + WS_SH) + tok, lane); }
    SEAM(8);
    if (IN(9) || IN(11)) {
        if (tid == 0) {
            unsigned nloc_ = 0, nx_ = 0; xcd_barrier_complete(bar.bar, bar.x, nloc_, nx_);
            unsigned cj[8], tot = 0; bool all = true;
#pragma unroll
            for (int j = 0; j < 8; ++j) { cj[j] = xb_ld(&bar.bar[XB_XCNT(j)]); tot += cj[j]; all = all && cj[j] > 0u; }
            if (all && tot == (unsigned)G && bar.x < 8u) { MISC[4] = bar.x; MISC[5] = MISC[2]; MISC[6] = cj[bar.x & 7u]; }
            else { const unsigned sl_ = (unsigned)vb & 7u; MISC[4] = sl_; MISC[5] = (unsigned)vb >> 3; MISC[6] = ((unsigned)G - sl_ + 7u) >> 3; }
        }
        __syncthreads();
    }
    REP(9) if (IN(9)) slice_pass<0>(ws, a.out, (int)MISC[4], (int)MISC[5] * 8 + __builtin_amdgcn_readfirstlane(wave), (int)MISC[6] * 8, lane);
    SEAM(9);
    REP(10) if (IN(10)) for (int tok = vb * 8 + wave; tok < T; tok += G * 8)
        expert_w_token((const int*)(ws + WS_ACTP) + (size_t)tok * 1024, (const unsigned short*)(ws + WS_GIDX) + (size_t)tok * 128, (const float*)(ws + WS_GGATE) + (size_t)tok * 128, ((const float*)(ws + WS_SH))[tok],
                       (const float*)(ws + WS_SU), (const float*)(ws + WS_SV), (_Float16*)(ws + WS_WX) + (size_t)tok * 128, lane);
    SEAM(10);
    REP(11) if (IN(11)) slice_pass<1>(ws, a.out, (int)MISC[4], (int)MISC[5] * 8 + __builtin_amdgcn_readfirstlane(wave), (int)MISC[6] * 8, lane);
    SEAM(11);
    REP(12) if (IN(12)) for (int tok = vb * 8 + wave; tok < T; tok += G * 8) final_norm_token(a.out + (size_t)tok * DM, (const float*)(ws + WS_SSQ3) + (size_t)tok * 8, a.in[14], lane);
#undef IN
#undef SEAM
}

extern "C" void kernel_launch(void* const* d_in, const int* in_sizes, int n_in, void* d_out, int out_size, void* d_ws, size_t ws_size, hipStream_t stream) {
    static int grid = 0;
    if (grid == 0) {
        if (n_in != 15 || in_sizes[0] != T * DM || out_size != T * DM || ws_size < WS_END) { fprintf(stderr, "kernel_launch: unexpected shapes (n_in %d, in0 %d, out %d, ws %zu)\n", n_in, n_in > 0 ? in_sizes[0] : -1, out_size, ws_size); grid = -1; return; }
        int dev = 0, cus = 0, per_cu = 0;
        hipGetDevice(&dev); hipDeviceGetAttribute(&cus, hipDeviceAttributeMultiprocessorCount, dev);
        if (hipFuncSetAttribute((const void*)mk_fwd, hipFuncAttributeMaxDynamicSharedMemorySize, LDS_BYTES) != hipSuccess) { fprintf(stderr, "kernel_launch: hipFuncSetAttribute failed\n"); grid = -1; return; }
        if (hipOccupancyMaxActiveBlocksPerMultiprocessor(&per_cu, (const void*)mk_fwd, NTHR, LDS_BYTES) != hipSuccess || per_cu < 1) { fprintf(stderr, "kernel_launch: occupancy query says %d blocks per CU\n", per_cu); per_cu = 1; }
        (void)hipGetLastError();
        grid = cus;
    }
    if (grid < 0) return;
    if (hipMemsetAsync(d_ws, 0, 256 * 1024, stream) != hipSuccess) { fprintf(stderr, "kernel_launch: hipMemsetAsync failed\n"); return; }
    Args a{};
    for (int i = 0; i < 15; ++i) a.in[i] = (const float*)d_in[i];
    a.out = (float*)d_out; a.ws = (unsigned char*)d_ws;
#if MK_FUSED
    a.ph_lo = 0; a.ph_hi = N_PHASES;
    { void* args[] = {&a}; hipError_t e = hipLaunchCooperativeKernel((const void*)mk_fwd, dim3(grid), dim3(NTHR), args, LDS_BYTES, stream);
      if (e != hipSuccess) fprintf(stderr, "kernel_launch: cooperative launch failed: %s (grid %d)\n", hipGetErrorString(e), grid); }
#else
    for (int p = 0; p < N_PHASES; ++p) { a.ph_lo = p; a.ph_hi = p + 1; void* args[] = {&a};
        hipError_t e = hipLaunchCooperativeKernel((const void*)mk_fwd, dim3(grid), dim3(NTHR), args, LDS_BYTES, stream);
        if (e != hipSuccess) { fprintf(stderr, "kernel_launch: launch of phase %d failed: %s (grid %d)\n", p, hipGetErrorString(e), grid); break; } }
#endif
}
```

```cpp
#include <hip/hip_runtime.h>
#include <hip/hip_cooperative_groups.h>
#include <cstdio>
#include <cstdint>
namespace cg = cooperative_groups;
namespace pg8 {
#define PG8_LAS __attribute__((address_space(3)))
typedef unsigned short bf16_t;
typedef short bf16x8 __attribute__((ext_vector_type(8)));
typedef float f32x4 __attribute__((ext_vector_type(4)));
typedef unsigned u32x4 __attribute__((ext_vector_type(4)));
constexpr int BM = 256, BK = 64, HALF = 128, HTB = HALF * BK * 2  , STAGE_BYTES = 8 * HTB, NXCD = 8, WGM = 8;

__host__ __device__ __forceinline__ int lds_byte(int r, int c) { const int st = (r >> 4) * 2 + (c >> 5), rr = r & 15, cc = c & 31, ob = rr * 64 + cc * 2; return st * 1024 + (ob ^ (((ob >> 9) & 1) << 5)); }
__host__ __device__ __forceinline__ void stage_rc(int b, int& R, int& C) { const int st = b / 1024, sb = b % 1024, swz = sb ^ (((sb >> 9) & 1) << 5); R = (st >> 1) * 16 + swz / 64; C = (st & 1) * 32 + (swz % 64) / 2; }
__host__ __device__ __forceinline__ int perm32(int rho) { const int n = rho >> 4, i = rho & 15; return 8 * (i >> 2) + 4 * n + (i & 3); }

struct Unit { int pm, pn; };
struct Gemm { const bf16_t* A; const bf16_t* Bt; int M, N, K; };

struct StaticOrder {
    int nM, nN, nwg, G, c;
    __host__ __device__ void init(int M, int N, int G_, int c_) { nM = M / BM; nN = N / BM; nwg = nM * nN; G = G_; c = c_; }
    __host__ __device__ bool next(int i, Unit& u) const {
        const long L = (long)i * G + c; if (L >= nwg) return false;
        int wgid = (int)L; { const int q = nwg / NXCD, r = nwg % NXCD, xcd = wgid % NXCD, off = wgid / NXCD; wgid = (xcd < r ? xcd * (q + 1) : r * (q + 1) + (xcd - r) * q) + off; }
        const int nig = WGM * nN, gid = wgid / nig, fm = gid * WGM, gsz = (nM - fm) < WGM ? (nM - fm) : WGM;
        u.pm = fm + ((wgid % nig) % gsz); u.pn = (wgid % nig) / gsz; return true;
    }
    __device__ __forceinline__ void a_ready(const Unit&) const {}
    __device__ __forceinline__ void done(const Unit&) const {}
};

__device__ __forceinline__ unsigned cvt_pk_bf16(float lo, float hi) { unsigned r; asm volatile("v_cvt_pk_bf16_f32 %0, %1, %2" : "=v"(r) : "v"(lo), "v"(hi)); return r; }

template <class Epi, class Sched, bool ALIGN_EPI = false, bool SP2 = false>
__device__ __forceinline__ void gemm_phase(PG8_LAS unsigned char* lds, const Gemm g, const Sched& S, const Epi& E) {
    int tid_ = threadIdx.x; asm volatile("" : "+v"(tid_));
    const int tid = tid_, wid = __builtin_amdgcn_readfirstlane(tid >> 6), lane = tid & 63, wr = wid >> 2, wc = wid & 3, fr = lane & 15, fq = lane >> 4;
    const int K = g.K, nt = K / BK;
    unsigned voffA[2], voffB[2];
#pragma unroll
    for (int i = 0; i < 2; ++i) { int R, C; stage_rc(tid * 16 + i * 8192, R, C); const int Rb = Epi::PERM ? ((R & ~31) + perm32(R & 31)) : R;
        voffA[i] = (unsigned)(R * K + C) * 2u; voffB[i] = (unsigned)(Rb * K + C) * 2u; }
    const size_t kstep = (size_t)(BK * 2);
    const size_t hstep = (size_t)HALF * K * 2;
    const size_t tstep = 2 * hstep;
    const unsigned ldsw = (unsigned)wid * 1024u;
    const int aoff = lds_byte(wr * 64 + fr, fq * 8), boff = lds_byte(wc * 32 + fr, fq * 8);
#define PG8_SA(b, h) (((b) * 2 + (h)) * HTB)
#define PG8_SB(b, h) ((4 + (b) * 2 + (h)) * HTB)
#define PG8_STAGE(bufoff, gbase, voff) do { _Pragma("unroll") for (int _i = 0; _i < 2; ++_i) \
        __builtin_amdgcn_global_load_lds((const unsigned*)((const char*)(gbase) + (voff)[_i]), (PG8_LAS unsigned*)(lds + (bufoff) + ldsw + _i * 8192), 16, 0, 0); } while (0)
#define PG8_LDA(dst, b, h) do { _Pragma("unroll") for (int m = 0; m < 4; ++m) _Pragma("unroll") for (int k = 0; k < 2; ++k) dst[m][k] = *(const PG8_LAS bf16x8*)(lds + PG8_SA(b, h) + aoff + m * 2048 + k * 1024); } while (0)
#define PG8_LDB(dst, b, h) do { _Pragma("unroll") for (int n = 0; n < 2; ++n) _Pragma("unroll") for (int k = 0; k < 2; ++k) dst[n][k] = *(const PG8_LAS bf16x8*)(lds + PG8_SB(b, h) + boff + n * 2048 + k * 1024); } while (0)
#define PG8_MMA(ai, bj, At, Bt) do { __builtin_amdgcn_s_setprio(1); _Pragma("unroll") for (int m = 0; m < 4; ++m) _Pragma("unroll") for (int n = 0; n < 2; ++n) _Pragma("unroll") for (int k = 0; k < 2; ++k) \
        acc[ai][bj][m][n] = __builtin_amdgcn_mfma_f32_16x16x32_bf16(Bt[n][k], At[m][k], acc[ai][bj][m][n], 0, 0, 0); __builtin_amdgcn_s_setprio(0); } while (0)
#define PG8_WAIT_V(n) asm volatile("s_waitcnt vmcnt(" #n ")" ::: "memory")
#define PG8_WAIT_L(n) asm volatile("s_waitcnt lgkmcnt(" #n ")" ::: "memory")
#define PG8_BAR __builtin_amdgcn_s_barrier()
#define PG8_SCHED __builtin_amdgcn_sched_barrier(0)
    Unit cur, nxt; int ui = 0;
    if (!S.next(0, cur)) return;
    f32x4 acc[2][2][4][2];
#pragma unroll
    for (int a = 0; a < 2; ++a)
#pragma unroll
        for (int b = 0; b < 2; ++b)
#pragma unroll
            for (int m = 0; m < 4; ++m)
#pragma unroll
                for (int n = 0; n < 2; ++n) acc[a][b][m][n] = (f32x4){0.f, 0.f, 0.f, 0.f};
    bf16x8 At[4][2], B0[2][2], B1[2][2];
    const char* cA = (const char*)g.A + (size_t)cur.pm * tstep; const char* cB = (const char*)g.Bt + (size_t)cur.pn * tstep;
    S.a_ready(cur);
    if constexpr (SP2) {
        PG8_STAGE(PG8_SB(0, 0), cB, voffB); PG8_STAGE(PG8_SB(0, 1), cB + hstep, voffB); PG8_STAGE(PG8_SA(0, 0), cA, voffA); PG8_STAGE(PG8_SA(0, 1), cA + hstep, voffA);
        if (wr == 1) PG8_BAR;
        PG8_WAIT_V(2); PG8_BAR;
        PG8_STAGE(PG8_SB(1, 0), cB + kstep, voffB); PG8_STAGE(PG8_SA(1, 0), cA + kstep, voffA); PG8_STAGE(PG8_SB(1, 1), cB + hstep + kstep, voffB);
        PG8_WAIT_V(6); PG8_BAR;
    } else {
        PG8_STAGE(PG8_SB(0, 0), cB, voffB); PG8_STAGE(PG8_SA(0, 0), cA, voffA); PG8_STAGE(PG8_SB(0, 1), cB + hstep, voffB); PG8_STAGE(PG8_SA(0, 1), cA + hstep, voffA);
        if (wr == 1) PG8_BAR;
        PG8_WAIT_V(4); PG8_BAR;
        PG8_STAGE(PG8_SB(1, 0), cB + kstep, voffB); PG8_STAGE(PG8_SA(1, 0), cA + kstep, voffA); PG8_STAGE(PG8_SB(1, 1), cB + hstep + kstep, voffB);
        PG8_WAIT_V(6); PG8_BAR;
    }
    for (;;) {
        const bool has_next = S.next(ui + 1, nxt);
        const char* nA = has_next ? (const char*)g.A + (size_t)nxt.pm * tstep : cA; const char* nB = has_next ? (const char*)g.Bt + (size_t)nxt.pn * tstep : cB;
        for (int t = 0; t < nt; t += 2) {
            const bool last = (t == nt - 2);
            const char* a1 = cA + (size_t)(t + 1) * kstep;
            const char* a2 = last ? nA : cA + (size_t)(t + 2) * kstep; const char* b2 = last ? nB : cB + (size_t)(t + 2) * kstep;
            const char* a3 = a2 + kstep; const char* b3 = b2 + kstep;
            if (last && has_next) S.a_ready(nxt);
            if constexpr (SP2) {
            PG8_LDB(B0, 0, 0); PG8_LDB(B1, 0, 1); PG8_SCHED; PG8_LDA(At, 0, 0); PG8_STAGE(PG8_SA(1, 1), a1 + hstep, voffA);
            PG8_WAIT_V(8); PG8_WAIT_L(0); PG8_BAR; PG8_MMA(0, 0, At, B0); PG8_MMA(0, 1, At, B1); PG8_BAR; PG8_SCHED;
            PG8_LDA(At, 0, 1); PG8_STAGE(PG8_SB(0, 0), b2, voffB); PG8_STAGE(PG8_SB(0, 1), b2 + hstep, voffB); PG8_STAGE(PG8_SA(0, 0), a2, voffA);
            PG8_WAIT_V(8); PG8_WAIT_L(0); PG8_BAR; PG8_MMA(1, 0, At, B0); PG8_MMA(1, 1, At, B1); PG8_BAR; PG8_SCHED;
            PG8_LDB(B0, 1, 0); PG8_LDB(B1, 1, 1); PG8_SCHED; PG8_LDA(At, 1, 0); PG8_STAGE(PG8_SA(0, 1), a2 + hstep, voffA);
            PG8_WAIT_V(8); PG8_WAIT_L(0); PG8_BAR; PG8_MMA(0, 0, At, B0); PG8_MMA(0, 1, At, B1); PG8_BAR; PG8_SCHED;
            PG8_LDA(At, 1, 1); PG8_STAGE(PG8_SB(1, 0), b3, voffB); PG8_STAGE(PG8_SB(1, 1), b3 + hstep, voffB); PG8_STAGE(PG8_SA(1, 0), a3, voffA);
            PG8_WAIT_V(8); PG8_WAIT_L(0); PG8_BAR; PG8_MMA(1, 0, At, B0); PG8_MMA(1, 1, At, B1); PG8_BAR; PG8_SCHED;
            } else {
            PG8_LDB(B0, 0, 0); PG8_SCHED; PG8_LDA(At, 0, 0); PG8_STAGE(PG8_SA(1, 1), a1 + hstep, voffA);
            PG8_WAIT_L(8); PG8_BAR; PG8_WAIT_L(0); PG8_MMA(0, 0, At, B0); PG8_BAR; PG8_SCHED;
            PG8_LDB(B1, 0, 1); PG8_STAGE(PG8_SB(0, 0), b2, voffB);
            PG8_BAR; PG8_WAIT_L(0); PG8_MMA(0, 1, At, B1); PG8_BAR;
            PG8_LDA(At, 0, 1); PG8_STAGE(PG8_SA(0, 0), a2, voffA);
            PG8_BAR; PG8_WAIT_L(0); PG8_MMA(1, 0, At, B0); PG8_BAR; PG8_SCHED;
            PG8_STAGE(PG8_SB(0, 1), b2 + hstep, voffB);
            PG8_WAIT_V(6); PG8_BAR; PG8_MMA(1, 1, At, B1); PG8_BAR;
            PG8_LDB(B0, 1, 0); PG8_SCHED; PG8_LDA(At, 1, 0); PG8_STAGE(PG8_SA(0, 1), a2 + hstep, voffA);
            PG8_WAIT_L(8); PG8_BAR; PG8_WAIT_L(0); PG8_MMA(0, 0, At, B0); PG8_BAR; PG8_SCHED;
            PG8_LDB(B1, 1, 1); PG8_STAGE(PG8_SB(1, 0), b3, voffB);
            PG8_BAR; PG8_WAIT_L(0); PG8_MMA(0, 1, At, B1); PG8_BAR;
            PG8_LDA(At, 1, 1); PG8_STAGE(PG8_SA(1, 0), a3, voffA);
            PG8_BAR; PG8_WAIT_L(0); PG8_MMA(1, 0, At, B0); PG8_BAR; PG8_SCHED;
            PG8_STAGE(PG8_SB(1, 1), b3 + hstep, voffB);
            PG8_WAIT_V(6); PG8_BAR; PG8_MMA(1, 1, At, B1); PG8_BAR;
            }
        }
        if constexpr (ALIGN_EPI) { if (wr == 0) PG8_BAR; }
        if constexpr (!Epi::AFTER_DRAIN) { E(acc, cur, wr, wc, fr, fq); S.done(cur); }
        if (!has_next) break;
#pragma unroll
        for (int a = 0; a < 2; ++a)
#pragma unroll
            for (int b = 0; b < 2; ++b)
#pragma unroll
                for (int m = 0; m < 4; ++m)
#pragma unroll
                    for (int n = 0; n < 2; ++n) acc[a][b][m][n] = (f32x4){0.f, 0.f, 0.f, 0.f};
        cur = nxt; cA = nA; cB = nB; ++ui;
        if constexpr (ALIGN_EPI) { if (wr == 1) PG8_BAR; }
    }
    PG8_WAIT_V(0);
    if constexpr (!ALIGN_EPI) { if (wr == 0) PG8_BAR; }
    PG8_BAR;
    if constexpr (Epi::AFTER_DRAIN) { E.fused(acc, cur, wr, wc, fr, fq, lds, wid, lane); S.done(cur); }
#undef PG8_SA
#undef PG8_SB
#undef PG8_STAGE
#undef PG8_LDA
#undef PG8_LDB
#undef PG8_MMA
#undef PG8_WAIT_V
#undef PG8_WAIT_L
#undef PG8_BAR
#undef PG8_SCHED
}
}

#ifndef MK_FUSED
#define MK_FUSED 1
#endif
#define DI __device__ __forceinline__
#define LAS __attribute__((address_space(3)))
typedef unsigned short bf16_t;
typedef float f32x4 __attribute__((ext_vector_type(4)));
typedef float f32x2 __attribute__((ext_vector_type(2)));
typedef float f32x16 __attribute__((ext_vector_type(16)));
typedef unsigned u32x4 __attribute__((ext_vector_type(4)));
typedef unsigned u32x2 __attribute__((ext_vector_type(2)));
typedef short bf16x8 __attribute__((ext_vector_type(8)));
typedef _Float16 h16x2 __attribute__((ext_vector_type(2)));
typedef _Float16 h16x8 __attribute__((ext_vector_type(8)));

constexpr int BATCH = 16, SEQ = 4096, T = BATCH * SEQ, DM = 1024, NIN = 4864;
constexpr int C_AQ = 0, C_AK = 512, C_AV = 640, C_HQ = 768, C_HF = 1280, C_HI = 1792, C_HG = 2304, C_GA = 2816, C_GH = 3840;
constexpr float EPS = 1e-6f;
constexpr int NTHR = 512;
constexpr int LDS_BYTES = 163840;

constexpr size_t MiB = 1u << 20;
constexpr size_t WS_W1T = 1 * MiB;
constexpr size_t WS_WAPT = 11 * MiB;
constexpr size_t WS_WHPT = 12 * MiB;
constexpr size_t WS_WOUTT = 13 * MiB;
constexpr size_t WS_WQT = 15 * MiB;
constexpr size_t WS_KEYS = 19 * MiB;
constexpr size_t WS_LB = 19 * MiB + 512 * 1024;
constexpr size_t WS_RSTD1 = 20 * MiB;
constexpr size_t WS_SSQ2 = 21 * MiB;
constexpr size_t WS_U8 = 26 * MiB;
constexpr size_t WS_V8 = 42 * MiB;
constexpr size_t WS_SU = 58 * MiB;
constexpr size_t WS_SV = 58 * MiB + 65536;
constexpr size_t WS_DEC = 60 * MiB;
constexpr size_t WS_AVT = 64 * MiB;
constexpr size_t WS_XB = 90 * MiB;
constexpr size_t WS_PA = 218 * MiB;
constexpr size_t WS_GG = 314 * MiB;
constexpr size_t WS_QD = 570 * MiB;
constexpr size_t WS_KINV = 634 * MiB;
constexpr size_t WS_KENDT = 698 * MiB;
constexpr size_t WS_VT = 762 * MiB;
constexpr size_t WS_GS = 826 * MiB;
constexpr size_t WS_YA = 890 * MiB;
constexpr size_t WS_YH = 954 * MiB;
constexpr size_t WS_END = 1018 * MiB;
constexpr size_t WS_HQ = 698 * MiB;
constexpr size_t WS_WX = 762 * MiB;
constexpr size_t WS_SH = 60 * MiB;
constexpr size_t WS_SSQ3 = 64 * MiB;
constexpr size_t WS_SW = 61 * MiB;
constexpr size_t WS_ACTP = 346 * MiB;
constexpr size_t WS_X2B = 218 * MiB;
constexpr size_t WS_QP = 346 * MiB;
constexpr size_t WS_GIDX = 602 * MiB;
constexpr size_t WS_GGATE = 618 * MiB;

struct Args { const float* in[15]; float* out; unsigned char* ws; int ph_lo, ph_hi; };

DI unsigned pk_bf16(float lo, float hi) { typedef __bf16 b2 __attribute__((ext_vector_type(2))); f32x2 v = {lo, hi}; b2 b = __builtin_convertvector(v, b2); return __builtin_bit_cast(unsigned, b); }
DI float bflo(unsigned w) { return __uint_as_float(w << 16); }
DI float bfhi(unsigned w) { return __uint_as_float(w & 0xffff0000u); }
DI float sigm(float x) { return __builtin_amdgcn_rcpf(1.f + __expf(-x)); }
DI float wave_sum(float v) {
    v += __int_as_float(__builtin_amdgcn_mov_dpp(__float_as_int(v), 0xB1, 0xf, 0xf, true));
    v += __int_as_float(__builtin_amdgcn_mov_dpp(__float_as_int(v), 0x4E, 0xf, 0xf, true));
    v += __int_as_float(__builtin_amdgcn_mov_dpp(__float_as_int(v), 0x141, 0xf, 0xf, true));
    v += __int_as_float(__builtin_amdgcn_mov_dpp(__float_as_int(v), 0x128, 0xf, 0xf, true));
    { const auto r = __builtin_amdgcn_permlane16_swap(__float_as_uint(v), __float_as_uint(v), false, false); v = __uint_as_float(r[0]) + __uint_as_float(r[1]); }
    { const auto r = __builtin_amdgcn_permlane32_swap(__float_as_uint(v), __float_as_uint(v), false, false); v = __uint_as_float(r[0]) + __uint_as_float(r[1]); }
    return v;
}
DI unsigned short bf16_1(float x) { return (unsigned short)(pk_bf16(x, 0.f) & 0xffffu); }
template <int N> DI float dpp_row_shr(float v) { return __int_as_float(__builtin_amdgcn_update_dpp(0, __float_as_int(v), 0x110 + N, 0xf, 0xf, true)); }
DI float scan16(float v) { v += dpp_row_shr<1>(v); v += dpp_row_shr<2>(v); v += dpp_row_shr<4>(v); v += dpp_row_shr<8>(v); return v; }
DI int crow(int reg, int hh) { return (reg & 3) + 8 * (reg >> 2) + 4 * hh; }
#define MFMA32(a, b, c) __builtin_amdgcn_mfma_f32_32x32x16_bf16((a), (b), (c), 0, 0, 0)
#define LDS_WAIT() asm volatile("s_waitcnt lgkmcnt(0)" ::: "memory")

namespace pg8 {
#define TSTORE_WRITE(sl, e, m, x) *(PG8_LAS bf16_t*)((sl) + (4 * fq + (e)) * 144 + (16 * (m) + fr) * 2) = bf16_1(x)
struct Epi1 {
    static constexpr bool PERM = true, AFTER_DRAIN = false;
    const float* rs; bf16_t* pa; bf16_t* gg; bf16_t* qd; bf16_t* kinv; bf16_t* kendT; bf16_t* vT; bf16_t* gs; float* dec; const float* lb; bf16_t* avT; PG8_LAS unsigned char* xl;
    __device__ __forceinline__ void operator()(const f32x4 (&acc)[2][2][4][2], const Unit& u, int wr, int wc, int fr, int fq) const {
        asm volatile("" : "+v"(fr), "+v"(fq));
        const int row0 = u.pm * BM + wr * 64 + fr, pn = u.pn;
        if (pn == 2) {
            const int c8 = wc * 32 + 8 * fq, tseqb = (u.pm & 15) * 256 + wr * 64 + fr, bb = u.pm >> 4;
#pragma unroll
            for (int ai = 0; ai < 2; ++ai)
#pragma unroll
                for (int m = 0; m < 4; ++m) { const int row = row0 + ai * HALF + m * 16; const float s = rs[row];
                    const f32x4 v0 = acc[ai][0][m][0] * s, v1 = acc[ai][0][m][1] * s;
                    u32x4 w; w.x = pk_bf16(v0[0], v0[1]); w.y = pk_bf16(v0[2], v0[3]); w.z = pk_bf16(v1[0], v1[1]); w.w = pk_bf16(v1[2], v1[3]);
                    *(u32x4*)(pa + (size_t)row * 768 + 512 + c8) = w;
                }
            PG8_LAS unsigned char* sl = xl + (wr * 4 + wc) * 2304; const int lane_ = fq * 16 + fr;
#pragma unroll
            for (int ai = 0; ai < 2; ++ai)
#pragma unroll
                for (int n = 0; n < 2; ++n) {
#pragma unroll
                    for (int m = 0; m < 4; ++m) { const float s = rs[row0 + ai * HALF + m * 16];
#pragma unroll
                        for (int e = 0; e < 4; ++e) TSTORE_WRITE(sl, e, m, acc[ai][1][m][n][e] * s); }
                    asm volatile("s_waitcnt lgkmcnt(0)" ::: "memory");
#pragma unroll
                    for (int q = 0; q < 2; ++q) { const int c = lane_ + 64 * q, rw = c >> 3, tc = c & 7, col = wc * 32 + 8 * (rw >> 2) + 4 * n + (rw & 3);
                        const u32x4 w = *(const PG8_LAS u32x4*)(sl + rw * 144 + tc * 16);
                        *(u32x4*)(avT + (size_t)((bb * 2 + (col >> 6)) * 64 + (col & 63)) * SEQ + (u.pm & 15) * 256 + ai * HALF + wr * 64 + 8 * tc) = w; }
                    asm volatile("s_waitcnt lgkmcnt(0)" ::: "memory");
                }
            return;
        }
        if (pn < 3 || pn >= 11) {
            bf16_t* O; int ldc, colt;
            if (pn < 3) { O = pa; ldc = 768; colt = pn * 256; } else { O = gg; ldc = 2048; colt = (pn - 11) * 256; }
            const int col0 = colt + wc * 32 + 8 * fq;
#pragma unroll
            for (int ai = 0; ai < 2; ++ai)
#pragma unroll
                for (int m = 0; m < 4; ++m) { const int row = row0 + ai * HALF + m * 16; const float s = rs[row]; bf16_t* rowp = O + (size_t)row * ldc + col0;
#pragma unroll
                    for (int bj = 0; bj < 2; ++bj) { const f32x4 v0 = acc[ai][bj][m][0] * s, v1 = acc[ai][bj][m][1] * s;
                        u32x4 w; w.x = pk_bf16(v0[0], v0[1]); w.y = pk_bf16(v0[2], v0[3]); w.z = pk_bf16(v1[0], v1[1]); w.w = pk_bf16(v1[2], v1[3]);
                        *(u32x4*)(rowp + bj * HALF) = w; } }
            return;
        }
        PG8_LAS unsigned char* sl = xl + (wr * 4 + wc) * 2304; const int lane_ = fq * 16 + fr;
        const int h = (pn - 3) & 3, c8 = wc * 32 + 8 * fq, bh = (u.pm >> 4) * 4 + h;
        if (pn < 7) {
#pragma unroll
            for (int ai = 0; ai < 2; ++ai) {
                const int tseq0 = (u.pm & 15) * 256 + ai * HALF + wr * 64;
                float rsv[4]; float decv[8];
#pragma unroll
                for (int m = 0; m < 4; ++m) rsv[m] = rs[row0 + ai * HALF + m * 16];
#pragma unroll
                for (int n = 0; n < 2; ++n) {
                    float qdv[4][4], kiv[4][4];
#pragma unroll
                    for (int e = 0; e < 4; ++e) {
                        const int dk = c8 + 4 * n + e; const float lbc = lb[h * 128 + dk];
                        float f[4], p[4];
#pragma unroll
                        for (int m = 0; m < 4; ++m) { const float x = acc[ai][1][m][n][e] * rsv[m]; f[m] = lbc + (1.f - lbc) * sigm(x); p[m] = scan16(__logf(f[m])); }
                        const float t0 = __shfl(p[0], 15, 16), t1 = __shfl(p[1], 15, 16), t2 = __shfl(p[2], 15, 16), t3 = __shfl(p[3], 15, 16);
                        const float bl = (t0 + t1) + (t2 + t3), dc = __expf(bl); decv[4 * n + e] = dc;
                        const float bb[4] = {p[0], p[1] + t0, p[2] + (t0 + t1), p[3] + ((t0 + t1) + t2)};
#pragma unroll
                        for (int m = 0; m < 4; ++m) { const float eb = __expf(bb[m]), einv = __builtin_amdgcn_rcpf(eb), k = 1.f - f[m], xq = acc[ai][0][m][n][e] * rsv[m];
                            qdv[m][e] = xq * sigm(xq) * eb; kiv[m][e] = k * einv; TSTORE_WRITE(sl, e, m, k * einv * dc); }
                    }
#pragma unroll
                    for (int m = 0; m < 4; ++m) { const size_t o = (size_t)(row0 + ai * HALF + m * 16) * 512 + h * 128 + c8 + 4 * n;
                        u32x2 w; w.x = pk_bf16(qdv[m][0], qdv[m][1]); w.y = pk_bf16(qdv[m][2], qdv[m][3]); *(u32x2*)(qd + o) = w;
                        u32x2 z; z.x = pk_bf16(kiv[m][0], kiv[m][1]); z.y = pk_bf16(kiv[m][2], kiv[m][3]); *(u32x2*)(kinv + o) = z; }
                    asm volatile("s_waitcnt lgkmcnt(0)" ::: "memory");
#pragma unroll
                    for (int q = 0; q < 2; ++q) { const int c = lane_ + 64 * q, rw = c >> 3, tc = c & 7, dkr = wc * 32 + 8 * (rw >> 2) + 4 * n + (rw & 3);
                        const u32x4 w = *(const PG8_LAS u32x4*)(sl + rw * 144 + tc * 16);
                        *(u32x4*)(kendT + (size_t)(bh * 128 + dkr) * SEQ + tseq0 + 8 * tc) = w; }
                    asm volatile("s_waitcnt lgkmcnt(0)" ::: "memory");
                }
                if (fr == 0) { float* dp = dec + (size_t)(bh * 64 + (tseq0 >> 6)) * 128 + c8;
                    *(f32x4*)dp = (f32x4){decv[0], decv[1], decv[2], decv[3]}; *(f32x4*)(dp + 4) = (f32x4){decv[4], decv[5], decv[6], decv[7]}; }
            }
        } else {
#pragma unroll
            for (int ai = 0; ai < 2; ++ai) {
                const int tseq0 = (u.pm & 15) * 256 + ai * HALF + wr * 64;
#pragma unroll
                for (int n = 0; n < 2; ++n) {
#pragma unroll
                    for (int m = 0; m < 4; ++m) { const float s = rs[row0 + ai * HALF + m * 16];
#pragma unroll
                        for (int e = 0; e < 4; ++e) TSTORE_WRITE(sl, e, m, acc[ai][0][m][n][e] * s); }
                    asm volatile("s_waitcnt lgkmcnt(0)" ::: "memory");
#pragma unroll
                    for (int q = 0; q < 2; ++q) { const int c = lane_ + 64 * q, rw = c >> 3, tc = c & 7, dvr = wc * 32 + 8 * (rw >> 2) + 4 * n + (rw & 3);
                        const u32x4 w = *(const PG8_LAS u32x4*)(sl + rw * 144 + tc * 16);
                        *(u32x4*)(vT + (size_t)(bh * 128 + dvr) * SEQ + tseq0 + 8 * tc) = w; }
                    asm volatile("s_waitcnt lgkmcnt(0)" ::: "memory");
                }
#pragma unroll
                for (int m = 0; m < 4; ++m) { const int row = row0 + ai * HALF + m * 16; const float s = rs[row];
                    f32x4 g0 = acc[ai][1][m][0] * s, g1 = acc[ai][1][m][1] * s;
#pragma unroll
                    for (int e = 0; e < 4; ++e) { g0[e] *= sigm(g0[e]); g1[e] *= sigm(g1[e]); }
                    u32x4 w; w.x = pk_bf16(g0[0], g0[1]); w.y = pk_bf16(g0[2], g0[3]); w.z = pk_bf16(g1[0], g1[1]); w.w = pk_bf16(g1[2], g1[3]);
                    *(u32x4*)(gs + (size_t)row * 512 + h * 128 + c8) = w; }
            }
        }
    }
};
struct EpiDummy {
    static constexpr bool PERM = true, AFTER_DRAIN = false;
    bf16_t* O; const float* rs;
    __device__ __forceinline__ void operator()(const f32x4 (&acc)[2][2][4][2], const Unit& u, int wr, int wc, int fr, int fq) const {
        asm volatile("" : "+v"(fr), "+v"(fq));
        const int row0 = wr * 64 + fr, col0 = wc * 32 + 8 * fq;
#pragma unroll
        for (int ai = 0; ai < 2; ++ai)
#pragma unroll
            for (int m = 0; m < 4; ++m) { const int row = row0 + ai * HALF + m * 16; const float s = rs[u.pm * BM + row]; bf16_t* rowp = O + (size_t)blockIdx.x * 65536 + (size_t)row * 256 + col0;
#pragma unroll
                for (int bj = 0; bj < 2; ++bj) { const f32x4 v0 = acc[ai][bj][m][0] * s, v1 = acc[ai][bj][m][1] * s;
                    u32x4 w; w.x = pk_bf16(v0[0], v0[1]); w.y = pk_bf16(v0[2], v0[3]); w.z = pk_bf16(v1[0], v1[1]); w.w = pk_bf16(v1[2], v1[3]);
                    *(u32x4*)(rowp + bj * HALF) = w; } }
    }
};
template <bool ADD> struct EpiMerge {
    static constexpr bool PERM = true, AFTER_DRAIN = false;
    bf16_t* O; const bf16_t* gate;
    __device__ __forceinline__ void operator()(const f32x4 (&acc)[2][2][4][2], const Unit& u, int wr, int wc, int fr, int fq) const {
        const int row0 = u.pm * BM + wr * 64 + fr, col0 = u.pn * BM + wc * 32 + 8 * fq;
#pragma unroll
        for (int ai = 0; ai < 2; ++ai)
#pragma unroll
            for (int m = 0; m < 4; ++m) { const int row = row0 + ai * HALF + m * 16; bf16_t* rowp = O + (size_t)row * DM + col0; const bf16_t* gp = gate + (size_t)row * 2048 + col0;
#pragma unroll
                for (int bj = 0; bj < 2; ++bj) { const u32x4 g = *(const u32x4*)(gp + bj * HALF);
                    f32x4 v0 = acc[ai][bj][m][0], v1 = acc[ai][bj][m][1];
                    v0[0] *= sigm(bflo(g.x)); v0[1] *= sigm(bfhi(g.x)); v0[2] *= sigm(bflo(g.y)); v0[3] *= sigm(bfhi(g.y));
                    v1[0] *= sigm(bflo(g.z)); v1[1] *= sigm(bfhi(g.z)); v1[2] *= sigm(bflo(g.w)); v1[3] *= sigm(bfhi(g.w));
                    if (ADD) { const u32x4 o = *(const u32x4*)(rowp + bj * HALF);
                        v0[0] += bflo(o.x); v0[1] += bfhi(o.x); v0[2] += bflo(o.y); v0[3] += bfhi(o.y); v1[0] += bflo(o.z); v1[1] += bfhi(o.z); v1[2] += bflo(o.w); v1[3] += bfhi(o.w); }
                    u32x4 w; w.x = pk_bf16(v0[0], v0[1]); w.y = pk_bf16(v0[2], v0[3]); w.z = pk_bf16(v1[0], v1[1]); w.w = pk_bf16(v1[2], v1[3]);
                    *(u32x4*)(rowp + bj * HALF) = w; } }
    }
};
struct EpiX2 {
    static constexpr bool PERM = true, AFTER_DRAIN = false;
    const float* X; bf16_t* X2B; float* ssq;
    __device__ __forceinline__ void operator()(const f32x4 (&acc)[2][2][4][2], const Unit& u, int wr, int wc, int fr, int fq) const {
        const int row0 = u.pm * BM + wr * 64 + fr, col0 = u.pn * BM + wc * 32 + 8 * fq;
#pragma unroll
        for (int ai = 0; ai < 2; ++ai)
#pragma unroll
            for (int m = 0; m < 4; ++m) { const int row = row0 + ai * HALF + m * 16; const size_t off = (size_t)row * DM + col0; float ss = 0.f;
#pragma unroll
                for (int bj = 0; bj < 2; ++bj) { const f32x4 x0 = *(const f32x4*)(X + off + bj * HALF), x1 = *(const f32x4*)(X + off + bj * HALF + 4);
                    const f32x4 v0 = acc[ai][bj][m][0] + x0, v1 = acc[ai][bj][m][1] + x1;
                    u32x4 w; w.x = pk_bf16(v0[0], v0[1]); w.y = pk_bf16(v0[2], v0[3]); w.z = pk_bf16(v1[0], v1[1]); w.w = pk_bf16(v1[2], v1[3]);
                    *(u32x4*)(X2B + off + bj * HALF) = w;
                    ss += (v0[0] * v0[0] + v0[1] * v0[1]) + (v0[2] * v0[2] + v0[3] * v0[3]) + (v1[0] * v1[0] + v1[1] * v1[1]) + (v1[2] * v1[2] + v1[3] * v1[3]); }
                ss += __shfl_xor(ss, 16); ss += __shfl_xor(ss, 32);
                if (fq == 0) ssq[(size_t)row * 16 + u.pn * 4 + wc] = ss; }
    }
};
struct EpiQp {
    static constexpr bool PERM = true, AFTER_DRAIN = false;
    bf16_t* O; const float* ssq;
    __device__ __forceinline__ void operator()(const f32x4 (&acc)[2][2][4][2], const Unit& u, int wr, int wc, int fr, int fq) const {
        const int row0 = u.pm * BM + wr * 64 + fr, col0 = u.pn * BM + wc * 32 + 8 * fq;
#pragma unroll
        for (int ai = 0; ai < 2; ++ai)
#pragma unroll
            for (int m = 0; m < 4; ++m) { const int row = row0 + ai * HALF + m * 16; const f32x4* sp = (const f32x4*)(ssq + (size_t)row * 16);
                const f32x4 a = sp[0], b = sp[1], c = sp[2], d = sp[3];
                const float tot = ((a[0] + a[1]) + (a[2] + a[3])) + ((b[0] + b[1]) + (b[2] + b[3])) + ((c[0] + c[1]) + (c[2] + c[3])) + ((d[0] + d[1]) + (d[2] + d[3]));
                const float s = __builtin_amdgcn_rsqf(tot * (1.f / 1024.f) + EPS); bf16_t* rowp = O + (size_t)row * 2048 + col0;
#pragma unroll
                for (int bj = 0; bj < 2; ++bj) { const f32x4 v0 = acc[ai][bj][m][0] * s, v1 = acc[ai][bj][m][1] * s;
                    u32x4 w; w.x = pk_bf16(v0[0], v0[1]); w.y = pk_bf16(v0[2], v0[3]); w.z = pk_bf16(v1[0], v1[1]); w.w = pk_bf16(v1[2], v1[3]);
                    *(u32x4*)(rowp + bj * HALF) = w; } }
    }
};
}

DI int w1_src_col(int n) {
    if (n < 768 || n >= 2816) return n;
    if (n < 1792) { const int h = (n - 768) >> 8, r = (n - 768) & 255; return r < 128 ? C_HQ + 128 * h + r : C_HF + 128 * h + (r - 128); }
    const int h = (n - 1792) >> 8, r = (n - 1792) & 255; return r < 128 ? C_HI + 128 * h + r : C_HG + 128 * h + (r - 128);
}
template <bool PERMW1> DI void p0_transpose_item(const float* W, int K, int N, bf16_t* WT, const float* g, int gmask, LAS float* scr, int item, int lane) {
    const int nblk = N / 32, kb = item / nblk, nb = item % nblk, k0 = 64 * kb, n0 = 32 * nb, ns = PERMW1 ? w1_src_col(n0) : n0;
#pragma unroll 8
    for (int i = 0; i < 32; ++i) { const int kk = 2 * i + (lane >> 5); float w = W[(size_t)(k0 + kk) * N + ns + (lane & 31)]; if (g) w *= g[(k0 + kk) & gmask]; scr[kk * 33 + (lane & 31)] = w; }
    LDS_WAIT(); asm volatile("" ::: "memory");
    const int c = lane & 7;
#pragma unroll
    for (int j = 0; j < 4; ++j) { const int n = (lane >> 3) + 8 * j; const LAS float* s = scr + (8 * c) * 33 + n;
        u32x4 o; o.x = pk_bf16(s[0 * 33], s[1 * 33]); o.y = pk_bf16(s[2 * 33], s[3 * 33]); o.z = pk_bf16(s[4 * 33], s[5 * 33]); o.w = pk_bf16(s[6 * 33], s[7 * 33]);
        *(u32x4*)(WT + (size_t)(n0 + n) * K + k0 + 8 * c) = o; }
    LDS_WAIT(); asm volatile("" ::: "memory");
}
DI unsigned pk_f16(float a, float b) { h16x2 v = {(_Float16)a, (_Float16)b}; return __builtin_bit_cast(unsigned, v); }

DI void p0_prologue(const Args& a, LAS unsigned char* lds, int vb, int G) {
    const int tid = threadIdx.x, lane = tid & 63, wave = tid >> 6;
    const int gw = vb * 8 + wave, NGW = G * 8, gt = vb * NTHR + tid, NGT = G * NTHR;
    unsigned char* ws = a.ws;
    LAS float* scr = (LAS float*)(lds + wave * 16384);
    constexpr int I_W1 = 16 * 152, I_AP = 8 * 32, I_HP = 8 * 32, I_OUT = 16 * 32, I_Q = 16 * 64, NITEMS = I_W1 + I_AP + I_HP + I_OUT + I_Q;
    for (int it = gw; it < NITEMS; it += NGW) {
        int r = it;
        if (r < I_W1) { p0_transpose_item<true>(a.in[2], 1024, NIN, (bf16_t*)(ws + WS_W1T), a.in[1], 1023, scr, r, lane); continue; } r -= I_W1;
        if (r < I_AP) { p0_transpose_item<false>(a.in[6], 512, 1024, (bf16_t*)(ws + WS_WAPT), nullptr, 0, scr, r, lane); continue; } r -= I_AP;
        if (r < I_HP) { p0_transpose_item<false>(a.in[7], 512, 1024, (bf16_t*)(ws + WS_WHPT), a.in[5], 127, scr, r, lane); continue; } r -= I_HP;
        if (r < I_OUT) { p0_transpose_item<false>(a.in[8], 1024, 1024, (bf16_t*)(ws + WS_WOUTT), nullptr, 0, scr, r, lane); continue; } r -= I_OUT;
        p0_transpose_item<false>(a.in[10], 1024, 2048, (bf16_t*)(ws + WS_WQT), a.in[9], 1023, scr, r, lane);
    }
    for (int i = gt; i < 2 * 8 * 128 * 128 / 4; i += NGT) { const f32x4 v = ((const f32x4*)a.in[11])[i]; u32x2 o; o.x = pk_bf16(v[0], v[1]); o.y = pk_bf16(v[2], v[3]); ((u32x2*)(ws + WS_KEYS))[i] = o; }
    for (int it = gw; it < 2 * 16384; it += NGW) {
        const int isv = it >= 16384, e = it & 16383;
        const float* src = (isv ? a.in[13] : a.in[12]) + (size_t)e * 1024 + 16 * lane;
        f32x4 x[4]; float amax = 0.f;
#pragma unroll
        for (int i = 0; i < 4; ++i) { x[i] = *(const f32x4*)(src + 4 * i); if (!isv) x[i] *= *(const f32x4*)(a.in[9] + 16 * lane + 4 * i);
            amax = fmaxf(fmaxf(amax, fmaxf(fabsf(x[i][0]), fabsf(x[i][1]))), fmaxf(fabsf(x[i][2]), fabsf(x[i][3]))); }
#pragma unroll
        for (int o = 1; o < 64; o <<= 1) amax = fmaxf(amax, __shfl_xor(amax, o));
        const float qs = amax > 0.f ? 127.f / amax : 0.f; const int off = 0;
        u32x4 w;
#pragma unroll
        for (int i = 0; i < 4; ++i) { const int q0 = (int)rintf(x[i][0] * qs) + off, q1 = (int)rintf(x[i][1] * qs) + off, q2 = (int)rintf(x[i][2] * qs) + off, q3 = (int)rintf(x[i][3] * qs) + off;
            w[i] = (unsigned)(q0 & 255) | ((unsigned)(q1 & 255) << 8) | ((unsigned)(q2 & 255) << 16) | ((unsigned)(q3 & 255) << 24); }
        *(u32x4*)(ws + (isv ? WS_V8 : WS_U8) + (size_t)e * 1024 + 16 * lane) = w;
        if (lane == 0) ((float*)(ws + (isv ? WS_SV : WS_SU)))[e] = amax * (1.f / 127.f);
    }
    for (int row = gw; row < T; row += NGW) {
        const f32x4* xr = (const f32x4*)(a.in[0] + (size_t)row * DM) + lane; f32x4 v[4]; float s = 0.f;
#pragma unroll
        for (int j = 0; j < 4; ++j) { v[j] = xr[64 * j]; s += (v[j][0] * v[j][0] + v[j][1] * v[j][1]) + (v[j][2] * v[j][2] + v[j][3] * v[j][3]); }
        s = wave_sum(s);
        u32x2* o = (u32x2*)(ws + WS_XB + (size_t)row * DM * 2) + lane;
#pragma unroll
        for (int j = 0; j < 4; ++j) { u32x2 w; w.x = pk_bf16(v[j][0], v[j][1]); w.y = pk_bf16(v[j][2], v[j][3]); o[64 * j] = w; }
        if (lane == 0) ((float*)(ws + WS_RSTD1))[row] = __builtin_amdgcn_rsqf(s * (1.f / 1024.f) + EPS);
    }
    if (vb == 0) { const float l0 = a.in[4][tid], l1 = a.in[4][512 + tid]; ((float*)(ws + WS_LB))[tid] = 1.f / (1.f + __expf(l1 - l0)); }
}

DI void attn_task(const bf16_t* pa, const bf16_t* avT, const float* sinks, bf16_t* ya, int b, int qb, int h) {
    const int lane = threadIdx.x & 63, r = lane & 31, hh = lane >> 5, kvh = h >> 2;
    const size_t trow = (size_t)b * SEQ + qb * 32 + r;
    constexpr float LOG2E = 1.4426950408889634f;
    bf16x8 qf[4];
    { const bf16_t* qp = pa + trow * 768 + h * 64 + 8 * hh;
#pragma unroll
      for (int s = 0; s < 4; ++s) qf[s] = *(const bf16x8*)(qp + 16 * s); }
    const float slope2 = exp2f(-(float)(h + 1)) * LOG2E, sink2 = sinks[h] * LOG2E, qs = 0.125f * LOG2E;
    f32x16 S[5]; float m = sink2;
#pragma unroll
    for (int i = 0; i < 5; ++i) { const int kb = qb - 4 + i;
        if (kb >= 0) {
#pragma unroll
            for (int q = 0; q < 16; ++q) S[i][q] = 0.f;
            const bf16_t* kp = pa + ((size_t)b * SEQ + kb * 32 + r) * 768 + 512 + kvh * 64 + 8 * hh;
#pragma unroll
            for (int s = 0; s < 4; ++s) S[i] = MFMA32(*(const bf16x8*)(kp + 16 * s), qf[s], S[i]);
#pragma unroll
            for (int q = 0; q < 16; ++q) { const int dist = 32 * (4 - i) + r - crow(q, hh); float v = S[i][q] * qs - slope2 * (float)dist;
                if (i == 0) v = (dist <= 127) ? v : -1e30f;
                if (i == 4) v = (dist >= 0) ? v : -1e30f;
                S[i][q] = v; m = fmaxf(m, v); }
        } }
    m = fmaxf(m, __shfl_xor(m, 32));
    float l = 0.f;
#pragma unroll
    for (int i = 0; i < 5; ++i) if (qb - 4 + i >= 0) {
#pragma unroll
        for (int q = 0; q < 16; ++q) { const float p = __builtin_amdgcn_exp2f(S[i][q] - m); S[i][q] = p; l += p; } }
    l += __shfl_xor(l, 32); l += __builtin_amdgcn_exp2f(sink2 - m);
    f32x16 O[2];
#pragma unroll
    for (int q = 0; q < 16; ++q) { O[0][q] = 0.f; O[1][q] = 0.f; }
#pragma unroll
    for (int i = 0; i < 5; ++i) { const int kb = qb - 4 + i;
        if (kb >= 0) {
#pragma unroll
            for (int s2 = 0; s2 < 2; ++s2) {
                u32x4 pb; pb.x = pk_bf16(S[i][8 * s2], S[i][8 * s2 + 1]); pb.y = pk_bf16(S[i][8 * s2 + 2], S[i][8 * s2 + 3]); pb.z = pk_bf16(S[i][8 * s2 + 4], S[i][8 * s2 + 5]); pb.w = pk_bf16(S[i][8 * s2 + 6], S[i][8 * s2 + 7]);
#pragma unroll
                for (int dt = 0; dt < 2; ++dt) { const bf16_t* vp = avT + (size_t)((b * 2 + kvh) * 64 + 32 * dt + r) * SEQ + kb * 32 + 16 * s2 + 4 * hh;
                    const u32x2 v0 = *(const u32x2*)vp, v1 = *(const u32x2*)(vp + 8); u32x4 av; av.x = v0.x; av.y = v0.y; av.z = v1.x; av.w = v1.y;
                    O[dt] = MFMA32(__builtin_bit_cast(bf16x8, av), __builtin_bit_cast(bf16x8, pb), O[dt]); }
            } } }
    const float inv = 1.f / l;
#pragma unroll
    for (int dt = 0; dt < 2; ++dt)
#pragma unroll
        for (int g = 0; g < 4; ++g) { u32x2 w; w.x = pk_bf16(O[dt][4 * g] * inv, O[dt][4 * g + 1] * inv); w.y = pk_bf16(O[dt][4 * g + 2] * inv, O[dt][4 * g + 3] * inv);
            *(u32x2*)(ya + trow * 512 + h * 64 + 32 * dt + 8 * g + 4 * hh) = w; }
}

DI void hgrn_ds_unit(const bf16_t* kendT, const bf16_t* vT, bf16_t* dsT, int bh, int c) {
    const int lane = threadIdx.x & 63, wave = threadIdx.x >> 6, r = lane & 31, hh = lane >> 5, i = wave >> 1, j0 = 2 * (wave & 1);
    const bf16_t* ka = kendT + (size_t)(bh * 128 + 32 * i + r) * SEQ + c * 64 + 8 * hh;
    const bf16_t* vb0 = vT + (size_t)(bh * 128 + 32 * j0 + r) * SEQ + c * 64 + 8 * hh; const bf16_t* vb1 = vb0 + (size_t)32 * SEQ;
    f32x16 D0, D1;
#pragma unroll
    for (int q = 0; q < 16; ++q) { D0[q] = 0.f; D1[q] = 0.f; }
#pragma unroll
    for (int ks = 0; ks < 4; ++ks) { const bf16x8 a = *(const bf16x8*)(ka + 16 * ks), b0 = *(const bf16x8*)(vb0 + 16 * ks), b1 = *(const bf16x8*)(vb1 + 16 * ks); D0 = MFMA32(a, b0, D0); D1 = MFMA32(a, b1, D1); }
    const int unit = bh * 64 + c;
    bf16_t* o0 = dsT + (size_t)(unit * 128 + 32 * j0 + r) * 128 + 32 * i + 4 * hh; bf16_t* o1 = o0 + 32 * 128;
#pragma unroll
    for (int g = 0; g < 4; ++g) { u32x2 w; w.x = pk_bf16(D0[4 * g], D0[4 * g + 1]); w.y = pk_bf16(D0[4 * g + 2], D0[4 * g + 3]); *(u32x2*)(o0 + 8 * g) = w;
        u32x2 z; z.x = pk_bf16(D1[4 * g], D1[4 * g + 1]); z.y = pk_bf16(D1[4 * g + 2], D1[4 * g + 3]); *(u32x2*)(o1 + 8 * g) = z; }
}
DI void hgrn_scan(bf16_t* dsT, const float* dec, int vb, int G) {
    for (int idx = vb * NTHR + threadIdx.x; idx < 64 * 128 * 16; idx += G * NTHR) {
        const int dk8 = idx & 15, dv = (idx >> 4) & 127, bh = idx >> 11;
        float S[8];
#pragma unroll
        for (int q = 0; q < 8; ++q) S[q] = 0.f;
        for (int c0 = 0; c0 < 64; c0 += 8) {
            u32x4 ld[8]; f32x4 d0[8], d1[8];
#pragma unroll
            for (int i = 0; i < 8; ++i) { const int c = c0 + i; ld[i] = *(const u32x4*)(dsT + (size_t)((bh * 64 + c) * 128 + dv) * 128 + dk8 * 8);
                const float* dp = dec + (size_t)(bh * 64 + c) * 128 + dk8 * 8; d0[i] = *(const f32x4*)dp; d1[i] = *(const f32x4*)(dp + 4); }
#pragma unroll
            for (int i = 0; i < 8; ++i) { const int c = c0 + i;
                u32x4 w; w.x = pk_bf16(S[0], S[1]); w.y = pk_bf16(S[2], S[3]); w.z = pk_bf16(S[4], S[5]); w.w = pk_bf16(S[6], S[7]);
                *(u32x4*)(dsT + (size_t)((bh * 64 + c) * 128 + dv) * 128 + dk8 * 8) = w;
                S[0] = d0[i][0] * S[0] + bflo(ld[i].x); S[1] = d0[i][1] * S[1] + bfhi(ld[i].x); S[2] = d0[i][2] * S[2] + bflo(ld[i].y); S[3] = d0[i][3] * S[3] + bfhi(ld[i].y);
                S[4] = d1[i][0] * S[4] + bflo(ld[i].z); S[5] = d1[i][1] * S[5] + bfhi(ld[i].z); S[6] = d1[i][2] * S[6] + bflo(ld[i].w); S[7] = d1[i][3] * S[7] + bfhi(ld[i].w); }
        }
    }
}
DI void hgrn_out_unit(const bf16_t* qd, const bf16_t* kinv, const bf16_t* vT, const bf16_t* spT, const bf16_t* gs, bf16_t* yh, LAS float* zs, int bh, int c) {
    const int tid = threadIdx.x, lane = tid & 63, wave = __builtin_amdgcn_readfirstlane(tid >> 6), r = lane & 31, hh = lane >> 5, tb = wave >> 2, db = wave & 3, b = bh >> 2, h = bh & 3;
    const size_t Tb = (size_t)b * SEQ + c * 64;
    bf16x8 qf[8], sf[8], kf0[8], kf1[8]; u32x2 vf[2][2][2];
    { const bf16_t* qrow = qd + (Tb + 32 * tb + r) * 512 + h * 128 + 8 * hh; const bf16_t* sp = spT + (size_t)((bh * 64 + c) * 128 + 32 * db + r) * 128 + 8 * hh;
      const bf16_t* k0 = kinv + (Tb + r) * 512 + h * 128 + 8 * hh; const bf16_t* vrow = vT + (size_t)(bh * 128 + 32 * db + r) * SEQ + c * 64 + 4 * hh;
#pragma unroll
      for (int ks = 0; ks < 8; ++ks) { qf[ks] = *(const bf16x8*)(qrow + 16 * ks); sf[ks] = *(const bf16x8*)(sp + 16 * ks); kf0[ks] = *(const bf16x8*)(k0 + 16 * ks); }
      if (tb) {
#pragma unroll
          for (int ks = 0; ks < 8; ++ks) kf1[ks] = *(const bf16x8*)(k0 + 32 * 512 + 16 * ks); }
#pragma unroll
      for (int sb = 0; sb < 2; ++sb)
#pragma unroll
          for (int s2 = 0; s2 < 2; ++s2) if (sb <= tb) { vf[sb][s2][0] = *(const u32x2*)(vrow + 32 * sb + 16 * s2); vf[sb][s2][1] = *(const u32x2*)(vrow + 32 * sb + 16 * s2 + 8); } }
    f32x16 Z;
#pragma unroll
    for (int q = 0; q < 16; ++q) Z[q] = 0.f;
#pragma unroll
    for (int ks = 0; ks < 8; ++ks) Z = MFMA32(qf[ks], sf[ks], Z);
#pragma unroll
    for (int sb = 0; sb < 2; ++sb) if (sb <= tb) {
        f32x16 X;
#pragma unroll
        for (int q = 0; q < 16; ++q) X[q] = 0.f;
#pragma unroll
        for (int ks = 0; ks < 8; ++ks) X = MFMA32(sb ? kf1[ks] : kf0[ks], qf[ks], X);
        if (sb == tb) {
#pragma unroll
            for (int q = 0; q < 16; ++q) if (crow(q, hh) > r) X[q] = 0.f;
        }
#pragma unroll
        for (int s2 = 0; s2 < 2; ++s2) {
            u32x4 pa_; pa_.x = pk_bf16(X[8 * s2], X[8 * s2 + 1]); pa_.y = pk_bf16(X[8 * s2 + 2], X[8 * s2 + 3]); pa_.z = pk_bf16(X[8 * s2 + 4], X[8 * s2 + 5]); pa_.w = pk_bf16(X[8 * s2 + 6], X[8 * s2 + 7]);
            u32x4 pb_; pb_.x = vf[sb][s2][0].x; pb_.y = vf[sb][s2][0].y; pb_.z = vf[sb][s2][1].x; pb_.w = vf[sb][s2][1].y;
            Z = MFMA32(__builtin_bit_cast(bf16x8, pa_), __builtin_bit_cast(bf16x8, pb_), Z);
        }
    }
#pragma unroll
    for (int q = 0; q < 16; ++q) zs[(32 * tb + crow(q, hh)) * 132 + 32 * db + r] = Z[q];
    __syncthreads();
    { const int tok = tid >> 3, d16 = (tid & 7) * 16; f32x4 o[4]; float ss = 0.f;
      const size_t off = (Tb + tok) * 512 + h * 128 + d16; const u32x4 g0 = *(const u32x4*)(gs + off), g1 = *(const u32x4*)(gs + off + 8);
#pragma unroll
      for (int i = 0; i < 4; ++i) { o[i] = *(const LAS f32x4*)(zs + tok * 132 + d16 + 4 * i); ss += (o[i][0] * o[i][0] + o[i][1] * o[i][1]) + (o[i][2] * o[i][2] + o[i][3] * o[i][3]); }
      ss += __shfl_xor(ss, 1); ss += __shfl_xor(ss, 2); ss += __shfl_xor(ss, 4);
      const float rn = __builtin_amdgcn_rsqf(ss * (1.f / 128.f) + EPS);
      u32x4 w0, w1;
      w0.x = pk_bf16(o[0][0] * rn * bflo(g0.x), o[0][1] * rn * bfhi(g0.x)); w0.y = pk_bf16(o[0][2] * rn * bflo(g0.y), o[0][3] * rn * bfhi(g0.y));
      w0.z = pk_bf16(o[1][0] * rn * bflo(g0.z), o[1][1] * rn * bfhi(g0.z)); w0.w = pk_bf16(o[1][2] * rn * bflo(g0.w), o[1][3] * rn * bfhi(g0.w));
      w1.x = pk_bf16(o[2][0] * rn * bflo(g1.x), o[2][1] * rn * bfhi(g1.x)); w1.y = pk_bf16(o[2][2] * rn * bflo(g1.y), o[2][3] * rn * bfhi(g1.y));
      w1.z = pk_bf16(o[3][0] * rn * bflo(g1.z), o[3][1] * rn * bfhi(g1.z)); w1.w = pk_bf16(o[3][2] * rn * bflo(g1.w), o[3][3] * rn * bfhi(g1.w));
      *(u32x4*)(yh + off) = w0; *(u32x4*)(yh + off + 8) = w1; }
}

DI unsigned f2ord(float f) { const unsigned b = __float_as_uint(f); return b ^ ((unsigned)((int)b >> 31) | 0x80000000u); }
DI float ord2f(unsigned k) { const unsigned b = (k & 0x80000000u) ? (k ^ 0x80000000u) : ~k; return __uint_as_float(b); }
DI void ce_desc(unsigned& a, unsigned& b) { const unsigned hi = a > b ? a : b, lo = a > b ? b : a; a = hi; b = lo; }
DI void sort16_desc(unsigned (&a)[16]) {
#pragma unroll
    for (int k = 2; k <= 16; k <<= 1)
#pragma unroll
        for (int j = k >> 1; j > 0; j >>= 1)
#pragma unroll
            for (int i = 0; i < 16; ++i) { const int l = i ^ j; if (l > i) { if ((i & k) == 0) ce_desc(a[i], a[l]); else ce_desc(a[l], a[i]); } }
}
DI void merge16_desc(unsigned (&a)[16], const unsigned (&b)[16]) {
#pragma unroll
    for (int i = 0; i < 16; ++i) a[i] = a[i] > b[15 - i] ? a[i] : b[15 - i];
#pragma unroll
    for (int j = 8; j > 0; j >>= 1)
#pragma unroll
        for (int i = 0; i < 16; ++i) { const int l = i ^ j; if (l > i) ce_desc(a[i], a[l]); }
}
#define TK_INS(L, x) do { unsigned t_ = (x); _Pragma("unroll") for (int j_ = 0; j_ < 16; ++j_) { const unsigned hi_ = L[j_] > t_ ? L[j_] : t_; t_ = L[j_] > t_ ? t_ : L[j_]; L[j_] = hi_; } } while (0)

DI void topk_stage_keys(const bf16_t* keysb, LAS unsigned char* kl, int h) {
    for (int c = threadIdx.x; c < 2 * 128 * 16; c += NTHR) { const int p = c >> 11, row = (c >> 4) & 127, ch = c & 15;
        *(LAS u32x4*)(kl + (p * 128 + row) * 272 + ch * 16) = *(const u32x4*)(keysb + ((size_t)(p * 8 + h) * 128 + row) * 128 + ch * 8); }
}
DI void topk_unit(const bf16_t* qp, const LAS unsigned char* kl, unsigned short* gidx, float* ggate, LAS unsigned* tk, int quad, int h) {
    const int tid = threadIdx.x, lane = tid & 63, wave = tid >> 6, p = wave & 1, tsub = wave >> 1, r = lane & 31, hh = lane >> 5;
#pragma unroll 1
    for (int hl = 0; hl < 4; ++hl) {
        const int tok0 = (quad * 4 + hl) * 128 + tsub * 32;
        f32x16 acc[4];
#pragma unroll
        for (int kb = 0; kb < 4; ++kb)
#pragma unroll
            for (int i = 0; i < 16; ++i) acc[kb][i] = 0.f;
        const bf16_t* qrow = qp + (size_t)(tok0 + r) * 2048 + h * 256 + p * 128 + 8 * hh;
        const LAS unsigned char* kbase = kl + (p * 128 + r) * 272 + 16 * hh;
#pragma unroll
        for (int s = 0; s < 8; ++s) { const bf16x8 bq = *(const bf16x8*)(qrow + 16 * s);
#pragma unroll
            for (int kb = 0; kb < 4; ++kb) { const bf16x8 ak = *(const LAS bf16x8*)(kbase + kb * 32 * 272 + 32 * s); acc[kb] = MFMA32(ak, bq, acc[kb]); } }
        unsigned A0[16], A1[16], A2[16], A3[16];
#pragma unroll
        for (int i = 0; i < 16; ++i) { const unsigned ki = (unsigned)(crow(i, hh));
            A0[i] = (f2ord(acc[0][i]) & ~127u) | ki; A1[i] = (f2ord(acc[1][i]) & ~127u) | (32u + ki); A2[i] = (f2ord(acc[2][i]) & ~127u) | (64u + ki); A3[i] = (f2ord(acc[3][i]) & ~127u) | (96u + ki); }
        sort16_desc(A0); sort16_desc(A1); sort16_desc(A2); sort16_desc(A3);
        merge16_desc(A0, A1); merge16_desc(A2, A3); merge16_desc(A0, A2);
#pragma unroll
        for (int j = 0; j < 16; ++j) A1[j] = __shfl_xor(A0[j], 32);
        merge16_desc(A0, A1);
        if (hh == 0) { LAS u32x4* dst = (LAS u32x4*)(tk + (((hl * 2 + p) * 128 + tsub * 32 + r) * 16));
#pragma unroll
            for (int c = 0; c < 4; ++c) { u32x4 w = {A0[4 * c], A0[4 * c + 1], A0[4 * c + 2], A0[4 * c + 3]}; dst[c] = w; } }
    }
    __syncthreads();
    {
        const int tok = tid & 127, hl = tid >> 7, tile = quad * 4 + hl;
        const LAS unsigned* t1 = tk + ((hl * 2 + 0) * 128 + tok) * 16; const LAS unsigned* t2 = tk + ((hl * 2 + 1) * 128 + tok) * 16;
        float v1[16], v2[16];
        { const LAS u32x4* s1 = (const LAS u32x4*)t1; const LAS u32x4* s2 = (const LAS u32x4*)t2;
#pragma unroll
          for (int c = 0; c < 4; ++c) { const u32x4 a = s1[c], b = s2[c];
              v1[4 * c] = ord2f(a.x & ~127u); v1[4 * c + 1] = ord2f(a.y & ~127u); v1[4 * c + 2] = ord2f(a.z & ~127u); v1[4 * c + 3] = ord2f(a.w & ~127u);
              v2[4 * c] = ord2f(b.x & ~127u); v2[4 * c + 1] = ord2f(b.y & ~127u); v2[4 * c + 2] = ord2f(b.z & ~127u); v2[4 * c + 3] = ord2f(b.w & ~127u); } }
#define CKEY(i, j) ((f2ord(v1[i] + v2[j]) & ~255u) | (unsigned)((i) * 16 + (j)))
        unsigned C[16], D[16], E[16];
#pragma unroll
        for (int j = 0; j < 16; ++j) C[j] = CKEY(0, j);
#pragma unroll
        for (int j = 0; j < 8; ++j) D[j] = CKEY(1, j);
#pragma unroll
        for (int j = 0; j < 5; ++j) D[8 + j] = CKEY(2, j);
#pragma unroll
        for (int j = 0; j < 3; ++j) D[13 + j] = CKEY(4, j);
#pragma unroll
        for (int j = 0; j < 4; ++j) E[j] = CKEY(3, j);
        E[4] = CKEY(5, 0); E[5] = CKEY(5, 1); E[6] = CKEY(6, 0); E[7] = CKEY(6, 1); E[8] = CKEY(7, 0); E[9] = CKEY(7, 1);
        E[10] = CKEY(8, 0); E[11] = CKEY(9, 0); E[12] = CKEY(10, 0); E[13] = CKEY(11, 0); E[14] = CKEY(12, 0); E[15] = CKEY(13, 0);
        sort16_desc(D); sort16_desc(E);
        TK_INS(E, CKEY(14, 0)); TK_INS(E, CKEY(15, 0));
#undef CKEY
        merge16_desc(C, D); merge16_desc(C, E);
        float sc[16]; unsigned ei[16]; float mx = -1e30f;
#pragma unroll
        for (int q = 0; q < 16; ++q) { const unsigned ij = C[q] & 255u; const unsigned a = t1[ij >> 4], b = t2[ij & 15u];
            sc[q] = ord2f(a & ~127u) + ord2f(b & ~127u); ei[q] = (a & 127u) * 128u + (b & 127u); mx = fmaxf(mx, sc[q]); }
        float sum = 0.f;
#pragma unroll
        for (int q = 0; q < 16; ++q) { sc[q] = __expf(sc[q] - mx); sum += sc[q]; }
        const float inv = 1.f / sum; const size_t o = (size_t)(tile * 128 + tok) * 128 + h * 16;
        u32x4 w0, w1;
        w0.x = ei[0] | (ei[1] << 16); w0.y = ei[2] | (ei[3] << 16); w0.z = ei[4] | (ei[5] << 16); w0.w = ei[6] | (ei[7] << 16);
        w1.x = ei[8] | (ei[9] << 16); w1.y = ei[10] | (ei[11] << 16); w1.z = ei[12] | (ei[13] << 16); w1.w = ei[14] | (ei[15] << 16);
        *(u32x4*)(gidx + o) = w0; *(u32x4*)(gidx + o + 8) = w1;
#pragma unroll
        for (int c = 0; c < 4; ++c) *(f32x4*)(ggate + o + 4 * c) = (f32x4){sc[4 * c] * inv, sc[4 * c + 1] * inv, sc[4 * c + 2] * inv, sc[4 * c + 3] * inv};
    }
    __syncthreads();
}

DI float gelu_erf(float x) { return 0.5f * x * (1.f + erff(x * 0.70710678118654752f)); }
DI int dot16(u32x4 w, const int (&h)[4]) { int c = __builtin_amdgcn_sdot4((int)w.x, h[0], 0, false); c = __builtin_amdgcn_sdot4((int)w.y, h[1], c, false); c = __builtin_amdgcn_sdot4((int)w.z, h[2], c, false); return __builtin_amdgcn_sdot4((int)w.w, h[3], c, false); }
#define V8_FMA(acc4, word, we) do { acc4[0] += (we) * (float)((word) & 255u); acc4[1] += (we) * (float)(((word) >> 8) & 255u); acc4[2] += (we) * (float)(((word) >> 16) & 255u); acc4[3] += (we) * (float)((word) >> 24); } while (0)

template <int IDMASK> DI void expert_token(const bf16_t* x2row, const float* ssq, const unsigned char* u8, const unsigned char* v8, const float* su, const float* sv, const unsigned short* gidx, const float* ggate, const float* gf, float* outrow, int lane) {
    f32x4 x[4]; float amax = 0.f;
#pragma unroll
    for (int i = 0; i < 4; ++i) { const u32x2 w_ = *(const u32x2*)(x2row + 16 * lane + 4 * i); x[i] = (f32x4){bflo(w_.x), bfhi(w_.x), bflo(w_.y), bfhi(w_.y)}; amax = fmaxf(fmaxf(amax, fmaxf(fabsf(x[i][0]), fabsf(x[i][1]))), fmaxf(fabsf(x[i][2]), fabsf(x[i][3]))); }
    float ss = (lane < 16) ? ssq[lane] : 0.f; ss = wave_sum(ss);
    const float rstd2 = __builtin_amdgcn_rsqf(ss * (1.f / 1024.f) + EPS);
#pragma unroll
    for (int o = 1; o < 64; o <<= 1) amax = fmaxf(amax, __shfl_xor(amax, o));
    amax *= rstd2;
    const float qs = amax > 0.f ? 127.f / amax : 0.f, sh = amax * (1.f / 127.f), xq = rstd2 * qs;
    int hq[4];
#pragma unroll
    for (int i = 0; i < 4; ++i) { const int q0 = (int)rintf(x[i][0] * xq), q1 = (int)rintf(x[i][1] * xq), q2 = (int)rintf(x[i][2] * xq), q3 = (int)rintf(x[i][3] * xq);
        hq[i] = (int)((unsigned)(q0 & 255) | ((unsigned)(q1 & 255) << 8) | ((unsigned)(q2 & 255) << 16) | ((unsigned)(q3 & 255) << 24)); }
    const int id0 = gidx[lane] & IDMASK, id1 = gidx[64 + lane] & IDMASK; const float g0 = ggate[lane], g1 = ggate[64 + lane];
    f32x4 o[4]; float wsum = 0.f;
#pragma unroll
    for (int i = 0; i < 4; ++i) o[i] = (f32x4){0.f, 0.f, 0.f, 0.f};
#pragma unroll 1
    for (int bt = 0; bt < 16; ++bt) {
        const int idsel = (bt < 8) ? id0 : id1; const float gsel = (bt < 8) ? g0 : g1; const int lb = (bt & 7) * 8;
        u32x4 ur[8], vr[8];
#pragma unroll
        for (int e = 0; e < 8; ++e) { const int idx = __builtin_amdgcn_readlane(idsel, lb + e); ur[e] = *(const u32x4*)(u8 + (size_t)idx * 1024 + 16 * lane); }
#pragma unroll
        for (int e = 0; e < 8; ++e) { const int idx = __builtin_amdgcn_readlane(idsel, lb + e); vr[e] = *(const u32x4*)(v8 + (size_t)idx * 1024 + 16 * lane); }
        const int myidx = __shfl(idsel, lb + (lane >> 3)); const float mysu = su[myidx], mysv = sv[myidx], gate = __shfl(gsel, lb + (lane >> 3));
        int pr[8];
#pragma unroll
        for (int e = 0; e < 8; ++e) pr[e] = dot16(ur[e], hq);
        int q4[4], q2[2], q1;
        { const bool up_ = (lane & 32) != 0;
#pragma unroll
          for (int i = 0; i < 4; ++i) { const int keep = up_ ? pr[i + 4] : pr[i], send = up_ ? pr[i] : pr[i + 4]; q4[i] = keep + __shfl_xor(send, 32); } }
        { const bool up_ = (lane & 16) != 0;
#pragma unroll
          for (int i = 0; i < 2; ++i) { const int keep = up_ ? q4[i + 2] : q4[i], send = up_ ? q4[i] : q4[i + 2]; q2[i] = keep + __shfl_xor(send, 16); } }
        { const bool up_ = (lane & 8) != 0; const int keep = up_ ? q2[1] : q2[0], send = up_ ? q2[0] : q2[1]; q1 = keep + __shfl_xor(send, 8); }
        q1 += __shfl_xor(q1, 4); q1 += __shfl_xor(q1, 2); q1 += __shfl_xor(q1, 1);
        const float act = (float)q1 * (mysu * sh);
        const float w = gelu_erf(act) * gate * mysv;
#pragma unroll
        for (int e = 0; e < 8; ++e) { const float we = __int_as_float(__builtin_amdgcn_readlane(__float_as_int(w), 8 * e)); wsum += we;
            V8_FMA(o[0], vr[e].x, we); V8_FMA(o[1], vr[e].y, we); V8_FMA(o[2], vr[e].z, we); V8_FMA(o[3], vr[e].w, we); }
    }
    const float corr = 128.f * wsum; float s3 = 0.f;
#pragma unroll
    for (int i = 0; i < 4; ++i) { x[i] += o[i] - corr; s3 += (x[i][0] * x[i][0] + x[i][1] * x[i][1]) + (x[i][2] * x[i][2] + x[i][3] * x[i][3]); }
    s3 = wave_sum(s3); const float r3 = __builtin_amdgcn_rsqf(s3 * (1.f / 1024.f) + EPS);
#pragma unroll
    for (int i = 0; i < 4; ++i) *(f32x4*)(outrow + 16 * lane + 4 * i) = x[i] * r3 * *(const f32x4*)(gf + 16 * lane + 4 * i);
}

DI void hq_token(const bf16_t* x2row, const float* ssq, unsigned char* hqrow, float* shp, int lane) {
    f32x4 x[4]; float amax = 0.f;
#pragma unroll
    for (int i = 0; i < 4; ++i) { const u32x2 w_ = *(const u32x2*)(x2row + 16 * lane + 4 * i); x[i] = (f32x4){bflo(w_.x), bfhi(w_.x), bflo(w_.y), bfhi(w_.y)}; amax = fmaxf(fmaxf(amax, fmaxf(fabsf(x[i][0]), fabsf(x[i][1]))), fmaxf(fabsf(x[i][2]), fabsf(x[i][3]))); }
    float ss = (lane < 16) ? ssq[lane] : 0.f; ss = wave_sum(ss);
    const float rstd2 = __builtin_amdgcn_rsqf(ss * (1.f / 1024.f) + EPS);
#pragma unroll
    for (int o = 1; o < 64; o <<= 1) amax = fmaxf(amax, __shfl_xor(amax, o));
    amax *= rstd2;
    const float qs = amax > 0.f ? 127.f / amax : 0.f, xq = rstd2 * qs;
    u32x4 w;
#pragma unroll
    for (int i = 0; i < 4; ++i) { const int q0 = (int)rintf(x[i][0] * xq), q1 = (int)rintf(x[i][1] * xq), q2 = (int)rintf(x[i][2] * xq), q3 = (int)rintf(x[i][3] * xq);
        w[i] = (unsigned)(q0 & 255) | ((unsigned)(q1 & 255) << 8) | ((unsigned)(q2 & 255) << 16) | ((unsigned)(q3 & 255) << 24); }
    *(u32x4*)(hqrow + 16 * lane) = w;
    if (lane == 0) *shp = amax * (1.f / 127.f);
}
template <int CTRL> DI int dpp_i(int v) { return __builtin_amdgcn_mov_dpp(v, CTRL, 0xf, 0xf, true); }
template <int CTRL> DI float dpp_f(float v) { return __int_as_float(__builtin_amdgcn_mov_dpp(__float_as_int(v), CTRL, 0xf, 0xf, true)); }
DI float swapadd32(float a, float b) { const auto r = __builtin_amdgcn_permlane32_swap(__float_as_uint(a), __float_as_uint(b), false, false); return __uint_as_float(r[0]) + __uint_as_float(r[1]); }
DI float swapadd16(float a, float b) { const auto r = __builtin_amdgcn_permlane16_swap(__float_as_uint(a), __float_as_uint(b), false, false); return __uint_as_float(r[0]) + __uint_as_float(r[1]); }

struct SMeta { u32x4 i0, i1, a0, a1; unsigned xw; };
DI void slice_issue(u32x4 (&r)[16], const SMeta& m, const unsigned char* base) {
    const unsigned iw[8] = {m.i0.x, m.i0.y, m.i0.z, m.i0.w, m.i1.x, m.i1.y, m.i1.z, m.i1.w};
#pragma unroll
    for (int j = 0; j < 16; ++j) { const unsigned idx = (j & 1) ? (iw[j >> 1] >> 16) : (iw[j >> 1] & 0xffffu); r[j] = *(const u32x4*)(base + (size_t)idx * 1024); }
}
DI void slice_u_compute(const SMeta& m, const u32x4 (&r)[16], int* actp, int lane) {
    const int hq[4] = {(int)m.a0.x, (int)m.a0.y, (int)m.a0.z, (int)m.a0.w};
    int part[16];
#pragma unroll
    for (int j = 0; j < 16; ++j) part[j] = dot16(r[j], hq);
    int r8[8], r4[4], r2[2];
    { const bool up_ = (lane & 4) != 0;
#pragma unroll
      for (int i = 0; i < 8; ++i) { const int keep = up_ ? part[i + 8] : part[i], send = up_ ? part[i] : part[i + 8]; r8[i] = keep + dpp_i<0x141>(send); } }
    { const bool up_ = (lane & 2) != 0;
#pragma unroll
      for (int i = 0; i < 4; ++i) { const int keep = up_ ? r8[i + 4] : r8[i], send = up_ ? r8[i] : r8[i + 4]; r4[i] = keep + dpp_i<0x4E>(send); } }
    { const bool up_ = (lane & 1) != 0;
#pragma unroll
      for (int i = 0; i < 2; ++i) { const int keep = up_ ? r4[i + 2] : r4[i], send = up_ ? r4[i] : r4[i + 2]; r2[i] = keep + dpp_i<0xB1>(send); } }
    typedef int i32x2 __attribute__((ext_vector_type(2)));
    *(i32x2*)(actp + 2 * lane) = (i32x2){r2[0], r2[1]};
}
DI int swapadd32i(int a, int b) { const auto r = __builtin_amdgcn_permlane32_swap((unsigned)a, (unsigned)b, false, false); return (int)r[0] + (int)r[1]; }
DI int swapadd16i(int a, int b) { const auto r = __builtin_amdgcn_permlane16_swap((unsigned)a, (unsigned)b, false, false); return (int)r[0] + (int)r[1]; }
DI void slice_v_compute(const SMeta& m, const u32x4 (&r)[16], float* x3row, float* ssq3p, int xs, int lane) {
    const int wq[4] = {(int)m.a0.x, (int)m.a0.y, (int)m.a0.z, (int)m.a0.w};
    const float sw = __uint_as_float(m.a1.x);
    const int col = 16 * (lane & 7) + ((lane >> 5) & 1) * 8 + ((lane >> 4) & 1) * 4 + ((lane >> 3) & 1) * 2;
    int o[16];
#pragma unroll
    for (int i = 0; i < 16; ++i) o[i] = 0;
#pragma unroll
    for (int q = 0; q < 4; ++q)
#pragma unroll
        for (int p = 0; p < 4; ++p) {
            const unsigned d0 = r[4 * q][p], d1 = r[4 * q + 1][p], d2 = r[4 * q + 2][p], d3 = r[4 * q + 3][p];
            const unsigned t0 = __builtin_amdgcn_perm(d1, d0, 0x05010400u), t1 = __builtin_amdgcn_perm(d1, d0, 0x07030602u), t2 = __builtin_amdgcn_perm(d3, d2, 0x05010400u), t3 = __builtin_amdgcn_perm(d3, d2, 0x07030602u);
            const unsigned e0 = __builtin_amdgcn_perm(t2, t0, 0x05040100u), e1 = __builtin_amdgcn_perm(t2, t0, 0x07060302u), e2 = __builtin_amdgcn_perm(t3, t1, 0x05040100u), e3 = __builtin_amdgcn_perm(t3, t1, 0x07060302u);
            o[4 * p] = __builtin_amdgcn_sdot4((int)e0, wq[q], o[4 * p], false); o[4 * p + 1] = __builtin_amdgcn_sdot4((int)e1, wq[q], o[4 * p + 1], false);
            o[4 * p + 2] = __builtin_amdgcn_sdot4((int)e2, wq[q], o[4 * p + 2], false); o[4 * p + 3] = __builtin_amdgcn_sdot4((int)e3, wq[q], o[4 * p + 3], false);
        }
    int a8[8], a4[4], a2[2];
#pragma unroll
    for (int i = 0; i < 8; ++i) a8[i] = swapadd32i(o[i], o[8 + i]);
#pragma unroll
    for (int i = 0; i < 4; ++i) a4[i] = swapadd16i(a8[i], a8[i + 4]);
    { const bool up_ = (lane & 8) != 0;
#pragma unroll
      for (int i = 0; i < 2; ++i) { const int keep = up_ ? a4[i + 2] : a4[i], send = up_ ? a4[i] : a4[i + 2]; a2[i] = keep + dpp_i<0x128>(send); } }
    const float y0 = bflo(m.xw) + (float)a2[0] * sw, y1 = bfhi(m.xw) + (float)a2[1] * sw;
    *(f32x2*)(x3row + 128 * xs + col) = (f32x2){y0, y1};
    const float ss = wave_sum(y0 * y0 + y1 * y1);
    if (lane == 0) ssq3p[xs] = ss;
}
template <int MODE> DI void slice_pass(unsigned char* ws, float* out, int xs, int gw_, int nw_, int lane) {
    const int g = lane >> 3, c = lane & 7;
    const unsigned short* gidx = (const unsigned short*)(ws + WS_GIDX) + 16 * g;
    const unsigned char* tab = (MODE == 0 ? (const unsigned char*)(ws + WS_U8) : (const unsigned char*)(ws + WS_V8)) + 128 * xs + 16 * c;
    const unsigned char* hqb = (const unsigned char*)(ws + WS_HQ) + 128 * xs + 16 * c;
    const unsigned char* wxb = (const unsigned char*)(ws + WS_WX) + 16 * g;
    const bf16_t* x2b = (const bf16_t*)(ws + WS_X2B) + 128 * xs + 16 * c + ((lane >> 5) & 1) * 8 + ((lane >> 4) & 1) * 4 + ((lane >> 3) & 1) * 2;
#define S_LOAD(m, tok) do { const unsigned short* ip = gidx + (size_t)(tok) * 128; (m).i0 = *(const u32x4*)ip; (m).i1 = *(const u32x4*)(ip + 8); \
        if (MODE == 0) { (m).a0 = *(const u32x4*)(hqb + (size_t)(tok) * 1024); } else { (m).a0 = *(const u32x4*)(wxb + (size_t)(tok) * 128); (m).a1.x = __float_as_uint(((const float*)(ws + WS_SW))[tok]); (m).xw = *(const unsigned*)(x2b + (size_t)(tok) * DM); } } while (0)
#define S_COMPUTE(m, r, tok) do { if (MODE == 0) slice_u_compute(m, r, (int*)(ws + WS_ACTP) + ((size_t)(tok) * 8 + xs) * 128, lane); \
        else slice_v_compute(m, r, out + (size_t)(tok) * DM, (float*)(ws + WS_SSQ3) + (size_t)(tok) * 8, xs, lane); } while (0)
    SMeta mA, mB, mN; u32x4 rA[16], rB[16];
    if (gw_ >= T) return;
    const int n = (T - gw_ + nw_ - 1) / nw_;
#define S_TK(j) (gw_ + ((j) < n ? (j) : n - 1) * nw_)
    S_LOAD(mA, S_TK(0)); slice_issue(rA, mA, tab); S_LOAD(mB, S_TK(1));
    for (int i = 0; i < n; i += 2) {
        slice_issue(rB, mB, tab);
        S_LOAD(mN, S_TK(i + 2));
        S_COMPUTE(mA, rA, S_TK(i));
        mA = mN; slice_issue(rA, mA, tab);
        S_LOAD(mN, S_TK(i + 3));
        if (i + 1 < n) S_COMPUTE(mB, rB, S_TK(i + 1));
        mB = mN;
    }
#undef S_TK
#undef S_LOAD
#undef S_COMPUTE
}
DI void expert_w_token(const int* actp, const unsigned short* gidx, const float* ggate, float sh, const float* su, const float* sv, unsigned char* wrow, float* swp, int lane) {
    typedef int i32x2 __attribute__((ext_vector_type(2)));
    i32x2 acc = {0, 0};
#pragma unroll
    for (int x = 0; x < 8; ++x) acc += *(const i32x2*)(actp + x * 128 + 2 * lane);
    const unsigned ii = *(const unsigned*)(gidx + 2 * lane); const f32x2 gt = *(const f32x2*)(ggate + 2 * lane);
    const int e0 = ii & 0xffffu, e1 = ii >> 16;
    const float w0 = gelu_erf((float)acc[0] * (su[e0] * sh)) * gt[0] * sv[e0], w1 = gelu_erf((float)acc[1] * (su[e1] * sh)) * gt[1] * sv[e1];
    float amax = fmaxf(fabsf(w0), fabsf(w1));
    amax = fmaxf(amax, dpp_f<0xB1>(amax)); amax = fmaxf(amax, dpp_f<0x4E>(amax)); amax = fmaxf(amax, dpp_f<0x141>(amax)); amax = fmaxf(amax, dpp_f<0x128>(amax));
    { const auto r = __builtin_amdgcn_permlane16_swap(__float_as_uint(amax), __float_as_uint(amax), false, false); amax = fmaxf(__uint_as_float(r[0]), __uint_as_float(r[1])); }
    { const auto r = __builtin_amdgcn_permlane32_swap(__float_as_uint(amax), __float_as_uint(amax), false, false); amax = fmaxf(__uint_as_float(r[0]), __uint_as_float(r[1])); }
    const float qs = amax > 0.f ? 127.f / amax : 0.f;
    const int q0 = (int)rintf(w0 * qs), q1 = (int)rintf(w1 * qs);
    *(unsigned short*)(wrow + 2 * lane) = (unsigned short)((q0 & 255) | ((q1 & 255) << 8));
    if (lane == 0) *swp = amax * (1.f / 127.f);
}
DI void final_norm_token(float* row, const float* ssq3p, const float* gf, int lane) {
    float ss = (lane < 8) ? ssq3p[lane] : 0.f; ss = wave_sum(ss);
    const float r3 = __builtin_amdgcn_rsqf(ss * (1.f / 1024.f) + EPS);
#pragma unroll
    for (int i = 0; i < 4; ++i) { f32x4* p = (f32x4*)(row + 256 * i + 4 * lane); *p = *p * r3 * *(const f32x4*)(gf + 256 * i + 4 * lane); }
}

#define XB_TMO      128
#define XB_XCNT(j)  (256  + 64 * (j))
#define XB_XSUB(j)  (1280 + 64 * (j))
#define XB_XGEN(j)  (2304 + 64 * (j))
#define XB_TOP      3328
#define XB_TOPGEN   3392
#define XCD_BAR_WORDS 3456
#define XB_SPIN_CAP (1u << 18)

__device__ __forceinline__ unsigned xb_ld(unsigned* p)              { return __hip_atomic_load(p, __ATOMIC_RELAXED, __HIP_MEMORY_SCOPE_AGENT); }
__device__ __forceinline__ unsigned xb_add(unsigned* p, unsigned v) { return __hip_atomic_fetch_add(p, v, __ATOMIC_RELAXED, __HIP_MEMORY_SCOPE_AGENT); }
__device__ __forceinline__ unsigned xb_xcc_id() { return (unsigned)__builtin_amdgcn_s_getreg((3 << 11) | 20) & 0xFu; }
#define XB_SPIN(cond, bar) do { unsigned _sp = 0; while (cond) { __builtin_amdgcn_s_sleep(1); \
    if ((++_sp & 255u) == 0u) { if (xb_ld(&(bar)[XB_TMO])) break; if (_sp > XB_SPIN_CAP) { atomicAdd(&(bar)[XB_TMO], 1u); break; } } } } while (0)

struct XcdBarrier {
    unsigned* bar; unsigned x;
    volatile __attribute__((address_space(3))) unsigned* st;
};

__device__ __forceinline__ XcdBarrier xcd_barrier_post(unsigned* bar, volatile __attribute__((address_space(3))) unsigned* st) {
    XcdBarrier b; b.bar = bar; b.x = xb_xcc_id(); b.st = st;
    if (threadIdx.x == 0) st[2] = xb_add(&bar[XB_XCNT(b.x)], 1u);
    return b;
}
__device__ __forceinline__ void xcd_barrier_complete(unsigned* bar, unsigned x, unsigned& nloc, unsigned& nx) {
    const unsigned G = gridDim.x * gridDim.y * gridDim.z;
    unsigned sum, cnt, mine, sp = 0u;
    for (;;) {
        sum = 0u; cnt = 0u; mine = 0u;
#pragma unroll
        for (unsigned j = 0; j < 16; ++j) { const unsigned c = xb_ld(&bar[XB_XCNT(j)]); sum += c; cnt += (c > 0u) ? 1u : 0u; mine = (j == x) ? c : mine; }
        if (sum == G) break;
        __builtin_amdgcn_s_sleep(1);
        if ((++sp & 255u) == 0u) { if (xb_ld(&bar[XB_TMO])) break; if (sp > XB_SPIN_CAP) { atomicAdd(&bar[XB_TMO], 1u); break; } }
    }
    nloc = mine > 0u ? mine : 1u; nx = cnt > 0u ? cnt : 1u;
}

__device__ __forceinline__ void xcd_barrier(const XcdBarrier& b) {
    asm volatile("s_waitcnt vmcnt(0)" ::: "memory");
    __syncthreads();
    if (threadIdx.x == 0) {
        unsigned* bar = b.bar;
        __builtin_amdgcn_s_waitcnt(0);
        unsigned nloc = b.st[0], nx = b.st[1];
        if (nloc == 0u) { xcd_barrier_complete(bar, b.x, nloc, nx); b.st[0] = nloc; b.st[1] = nx; }
        const unsigned old = xb_add(&bar[XB_XSUB(b.x)], 1u);
        const unsigned gen = old / nloc;
        if (old + 1u == (gen + 1u) * nloc) {
            __builtin_amdgcn_fence(__ATOMIC_RELEASE, "agent");
            asm volatile("s_waitcnt vmcnt(0)" ::: "memory");
            const unsigned og = xb_add(&bar[XB_TOP], 1u);
            const unsigned tg = og / nx;
            if (og + 1u == (tg + 1u) * nx) xb_add(&bar[XB_TOPGEN], 1u);
            else XB_SPIN(xb_ld(&bar[XB_TOPGEN]) == tg, bar);
            __builtin_amdgcn_fence(__ATOMIC_ACQUIRE, "agent");
            xb_add(&bar[XB_XGEN(b.x)], 1u);
            asm volatile("s_waitcnt vmcnt(0)" ::: "memory");
        } else {
            XB_SPIN(xb_ld(&bar[XB_XGEN(b.x)]) == gen, bar);
            __builtin_amdgcn_fence(__ATOMIC_ACQUIRE, "agent");
            asm volatile("s_waitcnt vmcnt(0)" ::: "memory");
        }
    }
    __syncthreads();
}

constexpr int N_PHASES = 13;
__global__ void __launch_bounds__(NTHR, 2) mk_fwd(Args a) {
    extern __shared__ __attribute__((aligned(16))) unsigned char lds_raw[];
    LAS unsigned char* lds = (LAS unsigned char*)lds_raw;
    cg::grid_group grid = cg::this_grid();
    const int G = gridDim.x, vb = blockIdx.x, tid = threadIdx.x, lane = tid & 63, wave = tid >> 6;
    unsigned char* ws = a.ws;
    const int lo = a.ph_lo, hi = a.ph_hi;
    volatile LAS unsigned* MISC = (volatile LAS unsigned*)(lds + LDS_BYTES - 64);
    if (tid < 16) MISC[tid] = 0u;
    __syncthreads();
    const XcdBarrier bar = xcd_barrier_post((unsigned*)(ws + 4096) + lo * XCD_BAR_WORDS, MISC);
#ifndef PHASE_MASK
#define PHASE_MASK 0xFFFF
#endif
#define IN(k) (((PHASE_MASK >> (k)) & 1) && lo <= (k) && (k) < hi)
#ifndef REPEAT_MASK
#define REPEAT_MASK 0
#endif
#define REP(k) for (int rep_ = 0; rep_ < (((REPEAT_MASK) >> (k)) & 1) + 1; ++rep_)
#define SEAM(k) do { if (IN(k) && IN((k) + 1)) { if ((k) == 0) grid.sync(); else xcd_barrier(bar); } } while (0)
    REP(0) if (IN(0)) p0_prologue(a, lds, vb, G);
    SEAM(0);
    REP(1) if (IN(1)) { pg8::Gemm g{(const bf16_t*)(ws + WS_XB), (const bf16_t*)(ws + WS_W1T), T, NIN, 1024}; pg8::StaticOrder S; S.init(T, NIN, G, vb);
        pg8::Epi1 E{(const float*)(ws + WS_RSTD1), (bf16_t*)(ws + WS_PA), (bf16_t*)(ws + WS_GG), (bf16_t*)(ws + WS_QD), (bf16_t*)(ws + WS_KINV), (bf16_t*)(ws + WS_KENDT), (bf16_t*)(ws + WS_VT), (bf16_t*)(ws + WS_GS),
                    (float*)(ws + WS_DEC), (const float*)(ws + WS_LB), (bf16_t*)(ws + WS_AVT), lds + 131072};
        pg8::gemm_phase<pg8::Epi1, pg8::StaticOrder, true, true>(lds, g, S, E); }
#ifdef PROBE_GEMM1_PLAIN
    if (IN(1)) { pg8::Gemm g{(const bf16_t*)(ws + WS_XB), (const bf16_t*)(ws + WS_W1T), T, NIN, 1024}; pg8::StaticOrder S; S.init(T, NIN, G, vb);
        pg8::EpiDummy E{(bf16_t*)(ws + WS_YA), (const float*)(ws + WS_RSTD1)};
        pg8::gemm_phase<pg8::EpiDummy, pg8::StaticOrder, true, true>(lds, g, S, E); }
#endif
    SEAM(1);
    REP(2) if (IN(2)) {
        for (int u = vb; u < 64 * 64; u += G) hgrn_ds_unit((const bf16_t*)(ws + WS_KENDT), (const bf16_t*)(ws + WS_VT), (bf16_t*)(ws + WS_XB), u >> 6, u & 63);
#ifdef PROBE_DS2
        for (int u = vb; u < 64 * 64; u += G) hgrn_ds_unit((const bf16_t*)(ws + WS_KENDT), (const bf16_t*)(ws + WS_VT), (bf16_t*)(ws + WS_XB), u >> 6, u & 63);
#endif
        { const int hw = __builtin_amdgcn_readfirstlane(wave);
          for (int u = vb; u < BATCH * (SEQ / 32); u += G) attn_task((const bf16_t*)(ws + WS_PA), (const bf16_t*)(ws + WS_AVT), a.in[3], (bf16_t*)(ws + WS_YA), u >> 7, u & 127, hw);
#ifdef PROBE_ATT2
          for (int u = vb; u < BATCH * (SEQ / 32); u += G) attn_task((const bf16_t*)(ws + WS_PA), (const bf16_t*)(ws + WS_AVT), a.in[3], (bf16_t*)(ws + WS_YA), u >> 7, u & 127, hw);
#endif
 }
    }
    SEAM(2);
    REP(3) if (IN(3)) hgrn_scan((bf16_t*)(ws + WS_XB), (const float*)(ws + WS_DEC), vb, G);
    SEAM(3);
    REP(4) if (IN(4)) { int bsel = 0; for (int u = vb; u < 64 * 64; u += G, bsel ^= 1)
        hgrn_out_unit((const bf16_t*)(ws + WS_QD), (const bf16_t*)(ws + WS_KINV), (const bf16_t*)(ws + WS_VT), (const bf16_t*)(ws + WS_XB), (const bf16_t*)(ws + WS_GS), (bf16_t*)(ws + WS_YH), (LAS float*)(lds + bsel * 34816), u >> 6, u & 63);
        __syncthreads(); }
    SEAM(4);
    REP(5) if (IN(5)) {
        { pg8::Gemm g{(const bf16_t*)(ws + WS_YA), (const bf16_t*)(ws + WS_WAPT), T, 1024, 512}; pg8::StaticOrder S; S.init(T, 1024, G, vb);
          pg8::EpiMerge<false> E{(bf16_t*)(ws + WS_XB), (const bf16_t*)(ws + WS_GG)};
          pg8::gemm_phase<pg8::EpiMerge<false>, pg8::StaticOrder, true, true>(lds, g, S, E); }
        __syncthreads();
        { pg8::Gemm g{(const bf16_t*)(ws + WS_YH), (const bf16_t*)(ws + WS_WHPT), T, 1024, 512}; pg8::StaticOrder S; S.init(T, 1024, G, vb);
          pg8::EpiMerge<true> E{(bf16_t*)(ws + WS_XB), (const bf16_t*)(ws + WS_GG) + 1024};
          pg8::gemm_phase<pg8::EpiMerge<true>, pg8::StaticOrder, true, true>(lds, g, S, E); }
    }
    SEAM(5);
    REP(6) if (IN(6)) { pg8::Gemm g{(const bf16_t*)(ws + WS_XB), (const bf16_t*)(ws + WS_WOUTT), T, 1024, 1024}; pg8::StaticOrder S; S.init(T, 1024, G, vb);
        pg8::EpiX2 E{a.in[0], (bf16_t*)(ws + WS_X2B), (float*)(ws + WS_SSQ2)};
        pg8::gemm_phase<pg8::EpiX2, pg8::StaticOrder, true, true>(lds, g, S, E); }
    SEAM(6);
    REP(7) if (IN(7)) { pg8::Gemm g{(const bf16_t*)(ws + WS_X2B), (const bf16_t*)(ws + WS_WQT), T, 2048, 1024}; pg8::StaticOrder S; S.init(T, 2048, G, vb);
        pg8::EpiQp E{(bf16_t*)(ws + WS_QP), (const float*)(ws + WS_SSQ2)};
        pg8::gemm_phase<pg8::EpiQp, pg8::StaticOrder, true, true>(lds, g, S, E); }
    SEAM(7);
    REP(8) if (IN(8)) { const int per = (1024 + G - 1) / G; int hcur = -1;
        for (int U = vb * per; U < (vb + 1) * per && U < 1024; ++U) { const int h = U >> 7;
            if (h != hcur) { topk_stage_keys((const bf16_t*)(ws + WS_KEYS), lds + 65536, h); hcur = h; __syncthreads(); }
            topk_unit((const bf16_t*)(ws + WS_QP), lds + 65536, (unsigned short*)(ws + WS_GIDX), (float*)(ws + WS_GGATE), (LAS unsigned*)lds, U & 127, h); }
        for (int tok = vb * 8 + wave; tok < T; tok += G * 8) hq_token((const bf16_t*)(ws + WS_X2B) + (size_t)tok * DM, (const float*)(ws + WS_SSQ2) + (size_t)tok * 16, (unsigned char*)(ws + WS_HQ) + (size_t)tok * 1024, (float*)(ws + WS_SH) + tok, lane); }
    SEAM(8);
    if (IN(9) || IN(11)) {
        if (tid == 0) {
            unsigned nloc_ = 0, nx_ = 0; xcd_barrier_complete(bar.bar, bar.x, nloc_, nx_);
            unsigned cj[8], tot = 0; bool all = true;
#pragma unroll
            for (int j = 0; j < 8; ++j) { cj[j] = xb_ld(&bar.bar[XB_XCNT(j)]); tot += cj[j]; all = all && cj[j] > 0u; }
            if (all && tot == (unsigned)G && bar.x < 8u) { MISC[4] = bar.x; MISC[5] = MISC[2]; MISC[6] = cj[bar.x & 7u]; }
            else { const unsigned sl_ = (unsigned)vb & 7u; MISC[4] = sl_; MISC[5] = (unsigned)vb >> 3; MISC[6] = ((unsigned)G - sl_ + 7u) >> 3; }
        }
        __syncthreads();
    }
    REP(9) if (IN(9)) slice_pass<0>(ws, a.out, (int)MISC[4], (int)MISC[5] * 8 + __builtin_amdgcn_readfirstlane(wave), (int)MISC[6] * 8, lane);
    SEAM(9);
    REP(10) if (IN(10)) for (int tok = vb * 8 + wave; tok < T; tok += G * 8)
        expert_w_token((const int*)(ws + WS_ACTP) + (size_t)tok * 1024, (const unsigned short*)(ws + WS_GIDX) + (size_t)tok * 128, (const float*)(ws + WS_GGATE) + (size_t)tok * 128, ((const float*)(ws + WS_SH))[tok],
                       (const float*)(ws + WS_SU), (const float*)(ws + WS_SV), (unsigned char*)(ws + WS_WX) + (size_t)tok * 128, (float*)(ws + WS_SW) + tok, lane);
    SEAM(10);
    REP(11) if (IN(11)) slice_pass<1>(ws, a.out, (int)MISC[4], (int)MISC[5] * 8 + __builtin_amdgcn_readfirstlane(wave), (int)MISC[6] * 8, lane);
    SEAM(11);
    REP(12) if (IN(12)) for (int tok = vb * 8 + wave; tok < T; tok += G * 8) final_norm_token(a.out + (size_t)tok * DM, (const float*)(ws + WS_SSQ3) + (size_t)tok * 8, a.in[14], lane);
#undef IN
#undef SEAM
}

extern "C" void kernel_launch(void* const* d_in, const int* in_sizes, int n_in, void* d_out, int out_size, void* d_ws, size_t ws_size, hipStream_t stream) {
    static int grid = 0;
    if (grid == 0) {
        if (n_in != 15 || in_sizes[0] != T * DM || out_size != T * DM || ws_size < WS_END) { fprintf(stderr, "kernel_launch: unexpected shapes (n_in %d, in0 %d, out %d, ws %zu)\n", n_in, n_in > 0 ? in_sizes[0] : -1, out_size, ws_size); grid = -1; return; }
        int dev = 0, cus = 0, per_cu = 0;
        hipGetDevice(&dev); hipDeviceGetAttribute(&cus, hipDeviceAttributeMultiprocessorCount, dev);
        if (hipFuncSetAttribute((const void*)mk_fwd, hipFuncAttributeMaxDynamicSharedMemorySize, LDS_BYTES) != hipSuccess) { fprintf(stderr, "kernel_launch: hipFuncSetAttribute failed\n"); grid = -1; return; }
        if (hipOccupancyMaxActiveBlocksPerMultiprocessor(&per_cu, (const void*)mk_fwd, NTHR, LDS_BYTES) != hipSuccess || per_cu < 1) { fprintf(stderr, "kernel_launch: occupancy query says %d blocks per CU\n", per_cu); per_cu = 1; }
        (void)hipGetLastError();
        grid = cus;
    }
    if (grid < 0) return;
    if (hipMemsetAsync(d_ws, 0, 256 * 1024, stream) != hipSuccess) { fprintf(stderr, "kernel_launch: hipMemsetAsync failed\n"); return; }
    Args a{};
    for (int i = 0; i < 15; ++i) a.in[i] = (const float*)d_in[i];
    a.out = (float*)d_out; a.ws = (unsigned char*)d_ws;
#if MK_FUSED
    a.ph_lo = 0; a.ph_hi = N_PHASES;
    { void* args[] = {&a}; hipError_t e = hipLaunchCooperativeKernel((const void*)mk_fwd, dim3(grid), dim3(NTHR), args, LDS_BYTES, stream);
      if (e != hipSuccess) fprintf(stderr, "kernel_launch: cooperative launch failed: %s (grid %d)\n", hipGetErrorString(e), grid); }
#else
    for (int p = 0; p < N_PHASES; ++p) { a.ph_lo = p; a.ph_hi = p + 1; void* args[] = {&a};
        hipError_t e = hipLaunchCooperativeKernel((const void*)mk_fwd, dim3(grid), dim3(NTHR), args, LDS_BYTES, stream);
        if (e != hipSuccess) { fprintf(stderr, "kernel_launch: launch of phase %d failed: %s (grid %d)\n", p, hipGetErrorString(e), grid); break; } }
#endif
}
```

```cpp
#include <hip/hip_runtime.h>
#include <hip/hip_cooperative_groups.h>
#include <cstdio>
#include <cstdint>
namespace cg = cooperative_groups;
namespace pg8 {
#define PG8_LAS __attribute__((address_space(3)))
typedef unsigned short bf16_t;
typedef short bf16x8 __attribute__((ext_vector_type(8)));
typedef float f32x4 __attribute__((ext_vector_type(4)));
typedef unsigned u32x4 __attribute__((ext_vector_type(4)));
constexpr int BM = 256, BK = 64, HALF = 128, HTB = HALF * BK * 2  , STAGE_BYTES = 8 * HTB, NXCD = 8, WGM = 8;

__host__ __device__ __forceinline__ int lds_byte(int r, int c) { const int st = (r >> 4) * 2 + (c >> 5), rr = r & 15, cc = c & 31, ob = rr * 64 + cc * 2; return st * 1024 + (ob ^ (((ob >> 9) & 1) << 5)); }
__host__ __device__ __forceinline__ void stage_rc(int b, int& R, int& C) { const int st = b / 1024, sb = b % 1024, swz = sb ^ (((sb >> 9) & 1) << 5); R = (st >> 1) * 16 + swz / 64; C = (st & 1) * 32 + (swz % 64) / 2; }
__host__ __device__ __forceinline__ int perm32(int rho) { const int n = rho >> 4, i = rho & 15; return 8 * (i >> 2) + 4 * n + (i & 3); }

struct Unit { int pm, pn; };
struct Gemm { const bf16_t* A; const bf16_t* Bt; int M, N, K; };

struct StaticOrder {
    int nM, nN, nwg, G, c;
    __host__ __device__ void init(int M, int N, int G_, int c_) { nM = M / BM; nN = N / BM; nwg = nM * nN; G = G_; c = c_; }
    __host__ __device__ bool next(int i, Unit& u) const {
        const long L = (long)i * G + c; if (L >= nwg) return false;
        int wgid = (int)L; { const int q = nwg / NXCD, r = nwg % NXCD, xcd = wgid % NXCD, off = wgid / NXCD; wgid = (xcd < r ? xcd * (q + 1) : r * (q + 1) + (xcd - r) * q) + off; }
        const int nig = WGM * nN, gid = wgid / nig, fm = gid * WGM, gsz = (nM - fm) < WGM ? (nM - fm) : WGM;
        u.pm = fm + ((wgid % nig) % gsz); u.pn = (wgid % nig) / gsz; return true;
    }
    __device__ __forceinline__ void a_ready(const Unit&) const {}
    __device__ __forceinline__ void done(const Unit&) const {}
};

__device__ __forceinline__ unsigned cvt_pk_bf16(float lo, float hi) { unsigned r; asm volatile("v_cvt_pk_bf16_f32 %0, %1, %2" : "=v"(r) : "v"(lo), "v"(hi)); return r; }

template <class Epi, class Sched, bool ALIGN_EPI = false, bool SP2 = false>
__device__ __forceinline__ void gemm_phase(PG8_LAS unsigned char* lds, const Gemm g, const Sched& S, const Epi& E) {
    int tid_ = threadIdx.x; asm volatile("" : "+v"(tid_));
    const int tid = tid_, wid = __builtin_amdgcn_readfirstlane(tid >> 6), lane = tid & 63, wr = wid >> 2, wc = wid & 3, fr = lane & 15, fq = lane >> 4;
    const int K = g.K, nt = K / BK;
    unsigned voffA[2], voffB[2];
#pragma unroll
    for (int i = 0; i < 2; ++i) { int R, C; stage_rc(tid * 16 + i * 8192, R, C); const int Rb = Epi::PERM ? ((R & ~31) + perm32(R & 31)) : R;
        voffA[i] = (unsigned)(R * K + C) * 2u; voffB[i] = (unsigned)(Rb * K + C) * 2u; }
    const size_t kstep = (size_t)(BK * 2);
    const size_t hstep = (size_t)HALF * K * 2;
    const size_t tstep = 2 * hstep;
    const unsigned ldsw = (unsigned)wid * 1024u;
    const int aoff = lds_byte(wr * 64 + fr, fq * 8), boff = lds_byte(wc * 32 + fr, fq * 8);
#define PG8_SA(b, h) (((b) * 2 + (h)) * HTB)
#define PG8_SB(b, h) ((4 + (b) * 2 + (h)) * HTB)
#define PG8_STAGE(bufoff, gbase, voff) do { _Pragma("unroll") for (int _i = 0; _i < 2; ++_i) \
        __builtin_amdgcn_global_load_lds((const unsigned*)((const char*)(gbase) + (voff)[_i]), (PG8_LAS unsigned*)(lds + (bufoff) + ldsw + _i * 8192), 16, 0, 0); } while (0)
#define PG8_LDA(dst, b, h) do { _Pragma("unroll") for (int m = 0; m < 4; ++m) _Pragma("unroll") for (int k = 0; k < 2; ++k) dst[m][k] = *(const PG8_LAS bf16x8*)(lds + PG8_SA(b, h) + aoff + m * 2048 + k * 1024); } while (0)
#define PG8_LDB(dst, b, h) do { _Pragma("unroll") for (int n = 0; n < 2; ++n) _Pragma("unroll") for (int k = 0; k < 2; ++k) dst[n][k] = *(const PG8_LAS bf16x8*)(lds + PG8_SB(b, h) + boff + n * 2048 + k * 1024); } while (0)
#define PG8_MMA(ai, bj, At, Bt) do { __builtin_amdgcn_s_setprio(1); _Pragma("unroll") for (int m = 0; m < 4; ++m) _Pragma("unroll") for (int n = 0; n < 2; ++n) _Pragma("unroll") for (int k = 0; k < 2; ++k) \
        acc[ai][bj][m][n] = __builtin_amdgcn_mfma_f32_16x16x32_bf16(Bt[n][k], At[m][k], acc[ai][bj][m][n], 0, 0, 0); __builtin_amdgcn_s_setprio(0); } while (0)
#define PG8_WAIT_V(n) asm volatile("s_waitcnt vmcnt(" #n ")" ::: "memory")
#define PG8_WAIT_L(n) asm volatile("s_waitcnt lgkmcnt(" #n ")" ::: "memory")
#define PG8_BAR __builtin_amdgcn_s_barrier()
#define PG8_SCHED __builtin_amdgcn_sched_barrier(0)
    Unit cur, nxt; int ui = 0;
    if (!S.next(0, cur)) return;
    f32x4 acc[2][2][4][2];
#pragma unroll
    for (int a = 0; a < 2; ++a)
#pragma unroll
        for (int b = 0; b < 2; ++b)
#pragma unroll
            for (int m = 0; m < 4; ++m)
#pragma unroll
                for (int n = 0; n < 2; ++n) acc[a][b][m][n] = (f32x4){0.f, 0.f, 0.f, 0.f};
    bf16x8 At[4][2], B0[2][2], B1[2][2];
    const char* cA = (const char*)g.A + (size_t)cur.pm * tstep; const char* cB = (const char*)g.Bt + (size_t)cur.pn * tstep;
    S.a_ready(cur);
    if constexpr (SP2) {
        PG8_STAGE(PG8_SB(0, 0), cB, voffB); PG8_STAGE(PG8_SB(0, 1), cB + hstep, voffB); PG8_STAGE(PG8_SA(0, 0), cA, voffA); PG8_STAGE(PG8_SA(0, 1), cA + hstep, voffA);
        if (wr == 1) PG8_BAR;
        PG8_WAIT_V(2); PG8_BAR;
        PG8_STAGE(PG8_SB(1, 0), cB + kstep, voffB); PG8_STAGE(PG8_SA(1, 0), cA + kstep, voffA); PG8_STAGE(PG8_SB(1, 1), cB + hstep + kstep, voffB);
        PG8_WAIT_V(6); PG8_BAR;
    } else {
        PG8_STAGE(PG8_SB(0, 0), cB, voffB); PG8_STAGE(PG8_SA(0, 0), cA, voffA); PG8_STAGE(PG8_SB(0, 1), cB + hstep, voffB); PG8_STAGE(PG8_SA(0, 1), cA + hstep, voffA);
        if (wr == 1) PG8_BAR;
        PG8_WAIT_V(4); PG8_BAR;
        PG8_STAGE(PG8_SB(1, 0), cB + kstep, voffB); PG8_STAGE(PG8_SA(1, 0), cA + kstep, voffA); PG8_STAGE(PG8_SB(1, 1), cB + hstep + kstep, voffB);
        PG8_WAIT_V(6); PG8_BAR;
    }
    for (;;) {
        const bool has_next = S.next(ui + 1, nxt);
        const char* nA = has_next ? (const char*)g.A + (size_t)nxt.pm * tstep : cA; const char* nB = has_next ? (const char*)g.Bt + (size_t)nxt.pn * tstep : cB;
        for (int t = 0; t < nt; t += 2) {
            const bool last = (t == nt - 2);
            const char* a1 = cA + (size_t)(t + 1) * kstep;
            const char* a2 = last ? nA : cA + (size_t)(t + 2) * kstep; const char* b2 = last ? nB : cB + (size_t)(t + 2) * kstep;
            const char* a3 = a2 + kstep; const char* b3 = b2 + kstep;
            if (last && has_next) S.a_ready(nxt);
            if constexpr (SP2) {
            PG8_LDB(B0, 0, 0); PG8_LDB(B1, 0, 1); PG8_SCHED; PG8_LDA(At, 0, 0); PG8_STAGE(PG8_SA(1, 1), a1 + hstep, voffA);
            PG8_WAIT_V(8); PG8_WAIT_L(0); PG8_BAR; PG8_MMA(0, 0, At, B0); PG8_MMA(0, 1, At, B1); PG8_BAR; PG8_SCHED;
            PG8_LDA(At, 0, 1); PG8_STAGE(PG8_SB(0, 0), b2, voffB); PG8_STAGE(PG8_SB(0, 1), b2 + hstep, voffB); PG8_STAGE(PG8_SA(0, 0), a2, voffA);
            PG8_WAIT_V(8); PG8_WAIT_L(0); PG8_BAR; PG8_MMA(1, 0, At, B0); PG8_MMA(1, 1, At, B1); PG8_BAR; PG8_SCHED;
            PG8_LDB(B0, 1, 0); PG8_LDB(B1, 1, 1); PG8_SCHED; PG8_LDA(At, 1, 0); PG8_STAGE(PG8_SA(0, 1), a2 + hstep, voffA);
            PG8_WAIT_V(8); PG8_WAIT_L(0); PG8_BAR; PG8_MMA(0, 0, At, B0); PG8_MMA(0, 1, At, B1); PG8_BAR; PG8_SCHED;
            PG8_LDA(At, 1, 1); PG8_STAGE(PG8_SB(1, 0), b3, voffB); PG8_STAGE(PG8_SB(1, 1), b3 + hstep, voffB); PG8_STAGE(PG8_SA(1, 0), a3, voffA);
            PG8_WAIT_V(8); PG8_WAIT_L(0); PG8_BAR; PG8_MMA(1, 0, At, B0); PG8_MMA(1, 1, At, B1); PG8_BAR; PG8_SCHED;
            } else {
            PG8_LDB(B0, 0, 0); PG8_SCHED; PG8_LDA(At, 0, 0); PG8_STAGE(PG8_SA(1, 1), a1 + hstep, voffA);
            PG8_WAIT_L(8); PG8_BAR; PG8_WAIT_L(0); PG8_MMA(0, 0, At, B0); PG8_BAR; PG8_SCHED;
            PG8_LDB(B1, 0, 1); PG8_STAGE(PG8_SB(0, 0), b2, voffB);
            PG8_BAR; PG8_WAIT_L(0); PG8_MMA(0, 1, At, B1); PG8_BAR;
            PG8_LDA(At, 0, 1); PG8_STAGE(PG8_SA(0, 0), a2, voffA);
            PG8_BAR; PG8_WAIT_L(0); PG8_MMA(1, 0, At, B0); PG8_BAR; PG8_SCHED;
            PG8_STAGE(PG8_SB(0, 1), b2 + hstep, voffB);
            PG8_WAIT_V(6); PG8_BAR; PG8_MMA(1, 1, At, B1); PG8_BAR;
            PG8_LDB(B0, 1, 0); PG8_SCHED; PG8_LDA(At, 1, 0); PG8_STAGE(PG8_SA(0, 1), a2 + hstep, voffA);
            PG8_WAIT_L(8); PG8_BAR; PG8_WAIT_L(0); PG8_MMA(0, 0, At, B0); PG8_BAR; PG8_SCHED;
            PG8_LDB(B1, 1, 1); PG8_STAGE(PG8_SB(1, 0), b3, voffB);
            PG8_BAR; PG8_WAIT_L(0); PG8_MMA(0, 1, At, B1); PG8_BAR;
            PG8_LDA(At, 1, 1); PG8_STAGE(PG8_SA(1, 0), a3, voffA);
            PG8_BAR; PG8_WAIT_L(0); PG8_MMA(1, 0, At, B0); PG8_BAR; PG8_SCHED;
            PG8_STAGE(PG8_SB(1, 1), b3 + hstep, voffB);
            PG8_WAIT_V(6); PG8_BAR; PG8_MMA(1, 1, At, B1); PG8_BAR;
            }
        }
        if constexpr (ALIGN_EPI) { if (wr == 0) PG8_BAR; }
        if constexpr (!Epi::AFTER_DRAIN) { E(acc, cur, wr, wc, fr, fq); S.done(cur); }
        if (!has_next) break;
#pragma unroll
        for (int a = 0; a < 2; ++a)
#pragma unroll
            for (int b = 0; b < 2; ++b)
#pragma unroll
                for (int m = 0; m < 4; ++m)
#pragma unroll
                    for (int n = 0; n < 2; ++n) acc[a][b][m][n] = (f32x4){0.f, 0.f, 0.f, 0.f};
        cur = nxt; cA = nA; cB = nB; ++ui;
        if constexpr (ALIGN_EPI) { if (wr == 1) PG8_BAR; }
    }
    PG8_WAIT_V(0);
    if constexpr (!ALIGN_EPI) { if (wr == 0) PG8_BAR; }
    PG8_BAR;
    if constexpr (Epi::AFTER_DRAIN) { E.fused(acc, cur, wr, wc, fr, fq, lds, wid, lane); S.done(cur); }
#undef PG8_SA
#undef PG8_SB
#undef PG8_STAGE
#undef PG8_LDA
#undef PG8_LDB
#undef PG8_MMA
#undef PG8_WAIT_V
#undef PG8_WAIT_L
#undef PG8_BAR
#undef PG8_SCHED
}
}

#ifndef MK_FUSED
#define MK_FUSED 1
#endif
#define DI __device__ __forceinline__
#define LAS __attribute__((address_space(3)))
typedef unsigned short bf16_t;
typedef float f32x4 __attribute__((ext_vector_type(4)));
typedef float f32x2 __attribute__((ext_vector_type(2)));
typedef float f32x16 __attribute__((ext_vector_type(16)));
typedef unsigned u32x4 __attribute__((ext_vector_type(4)));
typedef unsigned u32x2 __attribute__((ext_vector_type(2)));
typedef short bf16x8 __attribute__((ext_vector_type(8)));
typedef _Float16 h16x2 __attribute__((ext_vector_type(2)));
typedef _Float16 h16x8 __attribute__((ext_vector_type(8)));

constexpr int BATCH = 16, SEQ = 4096, T = BATCH * SEQ, DM = 1024, NIN = 4864;
constexpr int C_AQ = 0, C_AK = 512, C_AV = 640, C_HQ = 768, C_HF = 1280, C_HI = 1792, C_HG = 2304, C_GA = 2816, C_GH = 3840;
constexpr float EPS = 1e-6f;
constexpr int NTHR = 512;
constexpr int LDS_BYTES = 163840;

constexpr size_t MiB = 1u << 20;
constexpr size_t WS_W1T = 1 * MiB;
constexpr size_t WS_WAPT = 11 * MiB;
constexpr size_t WS_WHPT = 12 * MiB;
constexpr size_t WS_WOUTT = 13 * MiB;
constexpr size_t WS_WQT = 15 * MiB;
constexpr size_t WS_KEYS = 19 * MiB;
constexpr size_t WS_LB = 19 * MiB + 512 * 1024;
constexpr size_t WS_RSTD1 = 20 * MiB;
constexpr size_t WS_SSQ2 = 21 * MiB;
constexpr size_t WS_U8 = 26 * MiB;
constexpr size_t WS_V8 = 42 * MiB;
constexpr size_t WS_SU = 58 * MiB;
constexpr size_t WS_SV = 58 * MiB + 65536;
constexpr size_t WS_DEC = 60 * MiB;
constexpr size_t WS_AVT = 64 * MiB;
constexpr size_t WS_XB = 90 * MiB;
constexpr size_t WS_PA = 218 * MiB;
constexpr size_t WS_GG = 314 * MiB;
constexpr size_t WS_QD = 570 * MiB;
constexpr size_t WS_KINV = 634 * MiB;
constexpr size_t WS_KENDT = 698 * MiB;
constexpr size_t WS_VT = 762 * MiB;
constexpr size_t WS_GS = 826 * MiB;
constexpr size_t WS_YA = 890 * MiB;
constexpr size_t WS_YH = 954 * MiB;
constexpr size_t WS_END = 1018 * MiB;
constexpr size_t WS_HQ = 698 * MiB;
constexpr size_t WS_WX = 762 * MiB;
constexpr size_t WS_SH = 60 * MiB;
constexpr size_t WS_SSQ3 = 64 * MiB;
constexpr size_t WS_SW = 61 * MiB;
constexpr size_t WS_ACTP = 346 * MiB;
constexpr size_t WS_X2B = 218 * MiB;
constexpr size_t WS_QP = 346 * MiB;
constexpr size_t WS_GIDX = 602 * MiB;
constexpr size_t WS_GGATE = 618 * MiB;

struct Args { const float* in[15]; float* out; unsigned char* ws; int ph_lo, ph_hi; };

DI unsigned pk_bf16(float lo, float hi) { typedef __bf16 b2 __attribute__((ext_vector_type(2))); f32x2 v = {lo, hi}; b2 b = __builtin_convertvector(v, b2); return __builtin_bit_cast(unsigned, b); }
DI float bflo(unsigned w) { return __uint_as_float(w << 16); }
DI float bfhi(unsigned w) { return __uint_as_float(w & 0xffff0000u); }
DI float sigm(float x) { return __builtin_amdgcn_rcpf(1.f + __expf(-x)); }
DI float wave_sum(float v) {
    v += __int_as_float(__builtin_amdgcn_mov_dpp(__float_as_int(v), 0xB1, 0xf, 0xf, true));
    v += __int_as_float(__builtin_amdgcn_mov_dpp(__float_as_int(v), 0x4E, 0xf, 0xf, true));
    v += __int_as_float(__builtin_amdgcn_mov_dpp(__float_as_int(v), 0x141, 0xf, 0xf, true));
    v += __int_as_float(__builtin_amdgcn_mov_dpp(__float_as_int(v), 0x128, 0xf, 0xf, true));
    { const auto r = __builtin_amdgcn_permlane16_swap(__float_as_uint(v), __float_as_uint(v), false, false); v = __uint_as_float(r[0]) + __uint_as_float(r[1]); }
    { const auto r = __builtin_amdgcn_permlane32_swap(__float_as_uint(v), __float_as_uint(v), false, false); v = __uint_as_float(r[0]) + __uint_as_float(r[1]); }
    return v;
}
DI unsigned short bf16_1(float x) { return (unsigned short)(pk_bf16(x, 0.f) & 0xffffu); }
template <int N> DI float dpp_row_shr(float v) { return __int_as_float(__builtin_amdgcn_update_dpp(0, __float_as_int(v), 0x110 + N, 0xf, 0xf, true)); }
DI float rowsum16(float v) { v += __int_as_float(__builtin_amdgcn_mov_dpp(__float_as_int(v), 0xB1, 0xf, 0xf, true)); v += __int_as_float(__builtin_amdgcn_mov_dpp(__float_as_int(v), 0x4E, 0xf, 0xf, true));
    v += __int_as_float(__builtin_amdgcn_mov_dpp(__float_as_int(v), 0x141, 0xf, 0xf, true)); v += __int_as_float(__builtin_amdgcn_mov_dpp(__float_as_int(v), 0x128, 0xf, 0xf, true)); return v; }
DI float scan16(float v) { v += dpp_row_shr<1>(v); v += dpp_row_shr<2>(v); v += dpp_row_shr<4>(v); v += dpp_row_shr<8>(v); return v; }
DI int crow(int reg, int hh) { return (reg & 3) + 8 * (reg >> 2) + 4 * hh; }
#define MFMA32(a, b, c) __builtin_amdgcn_mfma_f32_32x32x16_bf16((a), (b), (c), 0, 0, 0)
#define LDS_WAIT() asm volatile("s_waitcnt lgkmcnt(0)" ::: "memory")

namespace pg8 {
#define TSTORE_WRITE(sl, e, m, x) *(PG8_LAS bf16_t*)((sl) + (4 * fq + (e)) * 144 + (16 * (m) + fr) * 2) = bf16_1(x)
struct Epi1 {
    static constexpr bool PERM = true, AFTER_DRAIN = false;
    const float* rs; bf16_t* pa; bf16_t* gg; bf16_t* qd; bf16_t* kinv; bf16_t* kendT; bf16_t* vT; bf16_t* gs; float* dec; const float* lb; bf16_t* avT; PG8_LAS unsigned char* xl;
    __device__ __forceinline__ void operator()(const f32x4 (&acc)[2][2][4][2], const Unit& u, int wr, int wc, int fr, int fq) const {
        asm volatile("" : "+v"(fr), "+v"(fq));
        const int row0 = u.pm * BM + wr * 64 + fr, pn = u.pn;
        if (pn == 2) {
            const int c8 = wc * 32 + 8 * fq, tseqb = (u.pm & 15) * 256 + wr * 64 + fr, bb = u.pm >> 4;
#pragma unroll
            for (int ai = 0; ai < 2; ++ai)
#pragma unroll
                for (int m = 0; m < 4; ++m) { const int row = row0 + ai * HALF + m * 16; const float s = rs[row];
                    const f32x4 v0 = acc[ai][0][m][0] * s, v1 = acc[ai][0][m][1] * s;
                    u32x4 w; w.x = pk_bf16(v0[0], v0[1]); w.y = pk_bf16(v0[2], v0[3]); w.z = pk_bf16(v1[0], v1[1]); w.w = pk_bf16(v1[2], v1[3]);
                    *(u32x4*)(pa + (size_t)row * 768 + 512 + c8) = w;
                }
            PG8_LAS unsigned char* sl = xl + (wr * 4 + wc) * 2304; const int lane_ = fq * 16 + fr;
#pragma unroll
            for (int ai = 0; ai < 2; ++ai)
#pragma unroll
                for (int n = 0; n < 2; ++n) {
#pragma unroll
                    for (int m = 0; m < 4; ++m) { const float s = rs[row0 + ai * HALF + m * 16];
#pragma unroll
                        for (int e = 0; e < 4; ++e) TSTORE_WRITE(sl, e, m, acc[ai][1][m][n][e] * s); }
                    asm volatile("s_waitcnt lgkmcnt(0)" ::: "memory");
#pragma unroll
                    for (int q = 0; q < 2; ++q) { const int c = lane_ + 64 * q, rw = c >> 3, tc = c & 7, col = wc * 32 + 8 * (rw >> 2) + 4 * n + (rw & 3);
                        const u32x4 w = *(const PG8_LAS u32x4*)(sl + rw * 144 + tc * 16);
                        *(u32x4*)(avT + (size_t)((bb * 2 + (col >> 6)) * 64 + (col & 63)) * SEQ + (u.pm & 15) * 256 + ai * HALF + wr * 64 + 8 * tc) = w; }
                    asm volatile("s_waitcnt lgkmcnt(0)" ::: "memory");
                }
            return;
        }
        if (pn < 3 || pn >= 11) {
            bf16_t* O; int ldc, colt;
            if (pn < 3) { O = pa; ldc = 768; colt = pn * 256; } else { O = gg; ldc = 2048; colt = (pn - 11) * 256; }
            const int col0 = colt + wc * 32 + 8 * fq;
#pragma unroll
            for (int ai = 0; ai < 2; ++ai)
#pragma unroll
                for (int m = 0; m < 4; ++m) { const int row = row0 + ai * HALF + m * 16; const float s = rs[row]; bf16_t* rowp = O + (size_t)row * ldc + col0;
#pragma unroll
                    for (int bj = 0; bj < 2; ++bj) { const f32x4 v0 = acc[ai][bj][m][0] * s, v1 = acc[ai][bj][m][1] * s;
                        u32x4 w; w.x = pk_bf16(v0[0], v0[1]); w.y = pk_bf16(v0[2], v0[3]); w.z = pk_bf16(v1[0], v1[1]); w.w = pk_bf16(v1[2], v1[3]);
                        *(u32x4*)(rowp + bj * HALF) = w; } }
            return;
        }
        PG8_LAS unsigned char* sl = xl + (wr * 4 + wc) * 2304; const int lane_ = fq * 16 + fr;
        const int h = (pn - 3) & 3, c8 = wc * 32 + 8 * fq, bh = (u.pm >> 4) * 4 + h;
        if (pn < 7) {
#pragma unroll
            for (int ai = 0; ai < 2; ++ai)
#pragma unroll
                for (int m = 0; m < 4; ++m) { const int row = row0 + ai * HALF + m * 16; const float s = rs[row]; const size_t o = (size_t)row * 512 + h * 128 + c8;
#pragma unroll
                    for (int bj = 0; bj < 2; ++bj) { const f32x4 v0 = acc[ai][bj][m][0] * s, v1 = acc[ai][bj][m][1] * s;
                        u32x4 w; w.x = pk_bf16(v0[0], v0[1]); w.y = pk_bf16(v0[2], v0[3]); w.z = pk_bf16(v1[0], v1[1]); w.w = pk_bf16(v1[2], v1[3]);
                        *(u32x4*)((bj ? kinv : qd) + o) = w; } }
        } else {
#pragma unroll
            for (int ai = 0; ai < 2; ++ai) {
                const int tseq0 = (u.pm & 15) * 256 + ai * HALF + wr * 64;
#pragma unroll
                for (int n = 0; n < 2; ++n) {
#pragma unroll
                    for (int m = 0; m < 4; ++m) { const float s = rs[row0 + ai * HALF + m * 16];
#pragma unroll
                        for (int e = 0; e < 4; ++e) TSTORE_WRITE(sl, e, m, acc[ai][0][m][n][e] * s); }
                    asm volatile("s_waitcnt lgkmcnt(0)" ::: "memory");
#pragma unroll
                    for (int q = 0; q < 2; ++q) { const int c = lane_ + 64 * q, rw = c >> 3, tc = c & 7, dvr = wc * 32 + 8 * (rw >> 2) + 4 * n + (rw & 3);
                        const u32x4 w = *(const PG8_LAS u32x4*)(sl + rw * 144 + tc * 16);
                        *(u32x4*)(vT + (size_t)(bh * 128 + dvr) * SEQ + tseq0 + 8 * tc) = w; }
                    asm volatile("s_waitcnt lgkmcnt(0)" ::: "memory");
                }
#pragma unroll
                for (int m = 0; m < 4; ++m) { const int row = row0 + ai * HALF + m * 16; const float s = rs[row];
                    f32x4 g0 = acc[ai][1][m][0] * s, g1 = acc[ai][1][m][1] * s;
#pragma unroll
                    for (int e = 0; e < 4; ++e) { g0[e] *= sigm(g0[e]); g1[e] *= sigm(g1[e]); }
                    u32x4 w; w.x = pk_bf16(g0[0], g0[1]); w.y = pk_bf16(g0[2], g0[3]); w.z = pk_bf16(g1[0], g1[1]); w.w = pk_bf16(g1[2], g1[3]);
                    *(u32x4*)(gs + (size_t)row * 512 + h * 128 + c8) = w; }
            }
        }
    }
};
struct EpiDummy {
    static constexpr bool PERM = true, AFTER_DRAIN = false;
    bf16_t* O; const float* rs;
    __device__ __forceinline__ void operator()(const f32x4 (&acc)[2][2][4][2], const Unit& u, int wr, int wc, int fr, int fq) const {
        asm volatile("" : "+v"(fr), "+v"(fq));
        const int row0 = wr * 64 + fr, col0 = wc * 32 + 8 * fq;
#pragma unroll
        for (int ai = 0; ai < 2; ++ai)
#pragma unroll
            for (int m = 0; m < 4; ++m) { const int row = row0 + ai * HALF + m * 16; const float s = rs[u.pm * BM + row]; bf16_t* rowp = O + (size_t)blockIdx.x * 65536 + (size_t)row * 256 + col0;
#pragma unroll
                for (int bj = 0; bj < 2; ++bj) { const f32x4 v0 = acc[ai][bj][m][0] * s, v1 = acc[ai][bj][m][1] * s;
                    u32x4 w; w.x = pk_bf16(v0[0], v0[1]); w.y = pk_bf16(v0[2], v0[3]); w.z = pk_bf16(v1[0], v1[1]); w.w = pk_bf16(v1[2], v1[3]);
                    *(u32x4*)(rowp + bj * HALF) = w; } }
    }
};
template <bool ADD> struct EpiMerge {
    static constexpr bool PERM = true, AFTER_DRAIN = false;
    bf16_t* O; const bf16_t* gate;
    __device__ __forceinline__ void operator()(const f32x4 (&acc)[2][2][4][2], const Unit& u, int wr, int wc, int fr, int fq) const {
        const int row0 = u.pm * BM + wr * 64 + fr, col0 = u.pn * BM + wc * 32 + 8 * fq;
#pragma unroll
        for (int ai = 0; ai < 2; ++ai)
#pragma unroll
            for (int m = 0; m < 4; ++m) { const int row = row0 + ai * HALF + m * 16; bf16_t* rowp = O + (size_t)row * DM + col0; const bf16_t* gp = gate + (size_t)row * 2048 + col0;
#pragma unroll
                for (int bj = 0; bj < 2; ++bj) { const u32x4 g = *(const u32x4*)(gp + bj * HALF);
                    f32x4 v0 = acc[ai][bj][m][0], v1 = acc[ai][bj][m][1];
                    v0[0] *= sigm(bflo(g.x)); v0[1] *= sigm(bfhi(g.x)); v0[2] *= sigm(bflo(g.y)); v0[3] *= sigm(bfhi(g.y));
                    v1[0] *= sigm(bflo(g.z)); v1[1] *= sigm(bfhi(g.z)); v1[2] *= sigm(bflo(g.w)); v1[3] *= sigm(bfhi(g.w));
                    if (ADD) { const u32x4 o = *(const u32x4*)(rowp + bj * HALF);
                        v0[0] += bflo(o.x); v0[1] += bfhi(o.x); v0[2] += bflo(o.y); v0[3] += bfhi(o.y); v1[0] += bflo(o.z); v1[1] += bfhi(o.z); v1[2] += bflo(o.w); v1[3] += bfhi(o.w); }
                    u32x4 w; w.x = pk_bf16(v0[0], v0[1]); w.y = pk_bf16(v0[2], v0[3]); w.z = pk_bf16(v1[0], v1[1]); w.w = pk_bf16(v1[2], v1[3]);
                    *(u32x4*)(rowp + bj * HALF) = w; } }
    }
};
struct EpiX2 {
    static constexpr bool PERM = true, AFTER_DRAIN = false;
    const float* X; bf16_t* X2B; float* ssq;
    __device__ __forceinline__ void operator()(const f32x4 (&acc)[2][2][4][2], const Unit& u, int wr, int wc, int fr, int fq) const {
        const int row0 = u.pm * BM + wr * 64 + fr, col0 = u.pn * BM + wc * 32 + 8 * fq;
#pragma unroll
        for (int ai = 0; ai < 2; ++ai)
#pragma unroll
            for (int m = 0; m < 4; ++m) { const int row = row0 + ai * HALF + m * 16; const size_t off = (size_t)row * DM + col0; float ss = 0.f;
#pragma unroll
                for (int bj = 0; bj < 2; ++bj) { const f32x4 x0 = *(const f32x4*)(X + off + bj * HALF), x1 = *(const f32x4*)(X + off + bj * HALF + 4);
                    const f32x4 v0 = acc[ai][bj][m][0] + x0, v1 = acc[ai][bj][m][1] + x1;
                    u32x4 w; w.x = pk_bf16(v0[0], v0[1]); w.y = pk_bf16(v0[2], v0[3]); w.z = pk_bf16(v1[0], v1[1]); w.w = pk_bf16(v1[2], v1[3]);
                    *(u32x4*)(X2B + off + bj * HALF) = w;
                    ss += (v0[0] * v0[0] + v0[1] * v0[1]) + (v0[2] * v0[2] + v0[3] * v0[3]) + (v1[0] * v1[0] + v1[1] * v1[1]) + (v1[2] * v1[2] + v1[3] * v1[3]); }
                ss += __shfl_xor(ss, 16); ss += __shfl_xor(ss, 32);
                if (fq == 0) ssq[(size_t)row * 16 + u.pn * 4 + wc] = ss; }
    }
};
struct EpiQp {
    static constexpr bool PERM = true, AFTER_DRAIN = false;
    bf16_t* O; const float* ssq;
    __device__ __forceinline__ void operator()(const f32x4 (&acc)[2][2][4][2], const Unit& u, int wr, int wc, int fr, int fq) const {
        const int row0 = u.pm * BM + wr * 64 + fr, col0 = u.pn * BM + wc * 32 + 8 * fq;
#pragma unroll
        for (int ai = 0; ai < 2; ++ai)
#pragma unroll
            for (int m = 0; m < 4; ++m) { const int row = row0 + ai * HALF + m * 16; const f32x4* sp = (const f32x4*)(ssq + (size_t)row * 16);
                const f32x4 a = sp[0], b = sp[1], c = sp[2], d = sp[3];
                const float tot = ((a[0] + a[1]) + (a[2] + a[3])) + ((b[0] + b[1]) + (b[2] + b[3])) + ((c[0] + c[1]) + (c[2] + c[3])) + ((d[0] + d[1]) + (d[2] + d[3]));
                const float s = __builtin_amdgcn_rsqf(tot * (1.f / 1024.f) + EPS); bf16_t* rowp = O + (size_t)row * 2048 + col0;
#pragma unroll
                for (int bj = 0; bj < 2; ++bj) { const f32x4 v0 = acc[ai][bj][m][0] * s, v1 = acc[ai][bj][m][1] * s;
                    u32x4 w; w.x = pk_bf16(v0[0], v0[1]); w.y = pk_bf16(v0[2], v0[3]); w.z = pk_bf16(v1[0], v1[1]); w.w = pk_bf16(v1[2], v1[3]);
                    *(u32x4*)(rowp + bj * HALF) = w; } }
    }
};
}

DI int w1_src_col(int n) {
    if (n < 768 || n >= 2816) return n;
    if (n < 1792) { const int h = (n - 768) >> 8, r = (n - 768) & 255; return r < 128 ? C_HQ + 128 * h + r : C_HF + 128 * h + (r - 128); }
    const int h = (n - 1792) >> 8, r = (n - 1792) & 255; return r < 128 ? C_HI + 128 * h + r : C_HG + 128 * h + (r - 128);
}
template <bool PERMW1> DI void p0_transpose_item(const float* W, int K, int N, bf16_t* WT, const float* g, int gmask, LAS float* scr, int item, int lane) {
    const int nblk = N / 32, kb = item / nblk, nb = item % nblk, k0 = 64 * kb, n0 = 32 * nb, ns = PERMW1 ? w1_src_col(n0) : n0;
#pragma unroll 8
    for (int i = 0; i < 32; ++i) { const int kk = 2 * i + (lane >> 5); float w = W[(size_t)(k0 + kk) * N + ns + (lane & 31)]; if (g) w *= g[(k0 + kk) & gmask]; scr[kk * 33 + (lane & 31)] = w; }
    LDS_WAIT(); asm volatile("" ::: "memory");
    const int c = lane & 7;
#pragma unroll
    for (int j = 0; j < 4; ++j) { const int n = (lane >> 3) + 8 * j; const LAS float* s = scr + (8 * c) * 33 + n;
        u32x4 o; o.x = pk_bf16(s[0 * 33], s[1 * 33]); o.y = pk_bf16(s[2 * 33], s[3 * 33]); o.z = pk_bf16(s[4 * 33], s[5 * 33]); o.w = pk_bf16(s[6 * 33], s[7 * 33]);
        *(u32x4*)(WT + (size_t)(n0 + n) * K + k0 + 8 * c) = o; }
    LDS_WAIT(); asm volatile("" ::: "memory");
}
DI unsigned pk_f16(float a, float b) { h16x2 v = {(_Float16)a, (_Float16)b}; return __builtin_bit_cast(unsigned, v); }

DI void p0_prologue(const Args& a, LAS unsigned char* lds, int vb, int G) {
    const int tid = threadIdx.x, lane = tid & 63, wave = tid >> 6;
    const int gw = vb * 8 + wave, NGW = G * 8, gt = vb * NTHR + tid, NGT = G * NTHR;
    unsigned char* ws = a.ws;
    LAS float* scr = (LAS float*)(lds + wave * 16384);
    constexpr int I_W1 = 16 * 152, I_AP = 8 * 32, I_HP = 8 * 32, I_OUT = 16 * 32, I_Q = 16 * 64, NITEMS = I_W1 + I_AP + I_HP + I_OUT + I_Q;
    for (int it = gw; it < NITEMS; it += NGW) {
        int r = it;
        if (r < I_W1) { p0_transpose_item<true>(a.in[2], 1024, NIN, (bf16_t*)(ws + WS_W1T), a.in[1], 1023, scr, r, lane); continue; } r -= I_W1;
        if (r < I_AP) { p0_transpose_item<false>(a.in[6], 512, 1024, (bf16_t*)(ws + WS_WAPT), nullptr, 0, scr, r, lane); continue; } r -= I_AP;
        if (r < I_HP) { p0_transpose_item<false>(a.in[7], 512, 1024, (bf16_t*)(ws + WS_WHPT), a.in[5], 127, scr, r, lane); continue; } r -= I_HP;
        if (r < I_OUT) { p0_transpose_item<false>(a.in[8], 1024, 1024, (bf16_t*)(ws + WS_WOUTT), nullptr, 0, scr, r, lane); continue; } r -= I_OUT;
        p0_transpose_item<false>(a.in[10], 1024, 2048, (bf16_t*)(ws + WS_WQT), a.in[9], 1023, scr, r, lane);
    }
    for (int i = gt; i < 2 * 8 * 128 * 128 / 4; i += NGT) { const f32x4 v = ((const f32x4*)a.in[11])[i]; u32x2 o; o.x = pk_bf16(v[0], v[1]); o.y = pk_bf16(v[2], v[3]); ((u32x2*)(ws + WS_KEYS))[i] = o; }
    for (int it = gw; it < 2 * 16384; it += NGW) {
        const int isv = it >= 16384, e = it & 16383;
        const float* src = (isv ? a.in[13] : a.in[12]) + (size_t)e * 1024 + 16 * lane;
        f32x4 x[4]; float amax = 0.f;
#pragma unroll
        for (int i = 0; i < 4; ++i) { x[i] = *(const f32x4*)(src + 4 * i); if (!isv) x[i] *= *(const f32x4*)(a.in[9] + 16 * lane + 4 * i);
            amax = fmaxf(fmaxf(amax, fmaxf(fabsf(x[i][0]), fabsf(x[i][1]))), fmaxf(fabsf(x[i][2]), fabsf(x[i][3]))); }
#pragma unroll
        for (int o = 1; o < 64; o <<= 1) amax = fmaxf(amax, __shfl_xor(amax, o));
        const float qs = amax > 0.f ? 127.f / amax : 0.f; const int off = 0;
        u32x4 w;
#pragma unroll
        for (int i = 0; i < 4; ++i) { const int q0 = (int)rintf(x[i][0] * qs) + off, q1 = (int)rintf(x[i][1] * qs) + off, q2 = (int)rintf(x[i][2] * qs) + off, q3 = (int)rintf(x[i][3] * qs) + off;
            w[i] = (unsigned)(q0 & 255) | ((unsigned)(q1 & 255) << 8) | ((unsigned)(q2 & 255) << 16) | ((unsigned)(q3 & 255) << 24); }
        *(u32x4*)(ws + (isv ? WS_V8 : WS_U8) + (size_t)e * 1024 + 16 * lane) = w;
        if (lane == 0) ((float*)(ws + (isv ? WS_SV : WS_SU)))[e] = amax * (1.f / 127.f);
    }
    for (int row = gw; row < T; row += NGW) {
        const f32x4* xr = (const f32x4*)(a.in[0] + (size_t)row * DM) + lane; f32x4 v[4]; float s = 0.f;
#pragma unroll
        for (int j = 0; j < 4; ++j) { v[j] = xr[64 * j]; s += (v[j][0] * v[j][0] + v[j][1] * v[j][1]) + (v[j][2] * v[j][2] + v[j][3] * v[j][3]); }
        s = wave_sum(s);
        u32x2* o = (u32x2*)(ws + WS_XB + (size_t)row * DM * 2) + lane;
#pragma unroll
        for (int j = 0; j < 4; ++j) { u32x2 w; w.x = pk_bf16(v[j][0], v[j][1]); w.y = pk_bf16(v[j][2], v[j][3]); o[64 * j] = w; }
        if (lane == 0) ((float*)(ws + WS_RSTD1))[row] = __builtin_amdgcn_rsqf(s * (1.f / 1024.f) + EPS);
    }
    if (vb == 0) { const float l0 = a.in[4][tid], l1 = a.in[4][512 + tid]; ((float*)(ws + WS_LB))[tid] = 1.f / (1.f + __expf(l1 - l0)); }
}

DI void attn_task(const bf16_t* pa, const bf16_t* avT, const float* sinks, bf16_t* ya, int b, int qb, int h) {
    const int lane = threadIdx.x & 63, r = lane & 31, hh = lane >> 5, kvh = h >> 2;
    const size_t trow = (size_t)b * SEQ + qb * 32 + r;
    constexpr float LOG2E = 1.4426950408889634f;
    bf16x8 qf[4];
    { const bf16_t* qp = pa + trow * 768 + h * 64 + 8 * hh;
#pragma unroll
      for (int s = 0; s < 4; ++s) qf[s] = *(const bf16x8*)(qp + 16 * s); }
    const float slope2 = exp2f(-(float)(h + 1)) * LOG2E, sink2 = sinks[h] * LOG2E, qs = 0.125f * LOG2E;
    f32x16 S[5]; float m = sink2;
#pragma unroll
    for (int i = 0; i < 5; ++i) { const int kb = qb - 4 + i;
        if (kb >= 0) {
#pragma unroll
            for (int q = 0; q < 16; ++q) S[i][q] = 0.f;
            const bf16_t* kp = pa + ((size_t)b * SEQ + kb * 32 + r) * 768 + 512 + kvh * 64 + 8 * hh;
#pragma unroll
            for (int s = 0; s < 4; ++s) S[i] = MFMA32(*(const bf16x8*)(kp + 16 * s), qf[s], S[i]);
#pragma unroll
            for (int q = 0; q < 16; ++q) { const int dist = 32 * (4 - i) + r - crow(q, hh); float v = S[i][q] * qs - slope2 * (float)dist;
                if (i == 0) v = (dist <= 127) ? v : -1e30f;
                if (i == 4) v = (dist >= 0) ? v : -1e30f;
                S[i][q] = v; m = fmaxf(m, v); }
        } }
    m = fmaxf(m, __shfl_xor(m, 32));
    float l = 0.f;
#pragma unroll
    for (int i = 0; i < 5; ++i) if (qb - 4 + i >= 0) {
#pragma unroll
        for (int q = 0; q < 16; ++q) { const float p = __builtin_amdgcn_exp2f(S[i][q] - m); S[i][q] = p; l += p; } }
    l += __shfl_xor(l, 32); l += __builtin_amdgcn_exp2f(sink2 - m);
    f32x16 O[2];
#pragma unroll
    for (int q = 0; q < 16; ++q) { O[0][q] = 0.f; O[1][q] = 0.f; }
#pragma unroll
    for (int i = 0; i < 5; ++i) { const int kb = qb - 4 + i;
        if (kb >= 0) {
#pragma unroll
            for (int s2 = 0; s2 < 2; ++s2) {
                u32x4 pb; pb.x = pk_bf16(S[i][8 * s2], S[i][8 * s2 + 1]); pb.y = pk_bf16(S[i][8 * s2 + 2], S[i][8 * s2 + 3]); pb.z = pk_bf16(S[i][8 * s2 + 4], S[i][8 * s2 + 5]); pb.w = pk_bf16(S[i][8 * s2 + 6], S[i][8 * s2 + 7]);
#pragma unroll
                for (int dt = 0; dt < 2; ++dt) { const bf16_t* vp = avT + (size_t)((b * 2 + kvh) * 64 + 32 * dt + r) * SEQ + kb * 32 + 16 * s2 + 4 * hh;
                    const u32x2 v0 = *(const u32x2*)vp, v1 = *(const u32x2*)(vp + 8); u32x4 av; av.x = v0.x; av.y = v0.y; av.z = v1.x; av.w = v1.y;
                    O[dt] = MFMA32(__builtin_bit_cast(bf16x8, av), __builtin_bit_cast(bf16x8, pb), O[dt]); }
            } } }
    const float inv = 1.f / l;
#pragma unroll
    for (int dt = 0; dt < 2; ++dt)
#pragma unroll
        for (int g = 0; g < 4; ++g) { u32x2 w; w.x = pk_bf16(O[dt][4 * g] * inv, O[dt][4 * g + 1] * inv); w.y = pk_bf16(O[dt][4 * g + 2] * inv, O[dt][4 * g + 3] * inv);
            *(u32x2*)(ya + trow * 512 + h * 64 + 32 * dt + 8 * g + 4 * hh) = w; }
}

DI void hgrn_prep_unit(bf16_t* qd, bf16_t* kinv, bf16_t* kendT, float* dec, const float* lb, int bh, int c, int dk2) {
    const int b = bh >> 2, h = bh & 3;
    bf16_t* qp = qd + ((size_t)b * SEQ + c * 64) * 512 + h * 128 + dk2; bf16_t* kp = kinv + ((size_t)b * SEQ + c * 64) * 512 + h * 128 + dk2;
    const float lb0 = lb[h * 128 + dk2], lb1 = lb[h * 128 + dk2 + 1], om0 = 1.f - lb0, om1 = 1.f - lb1;
    float b0 = 0.f, b1 = 0.f; unsigned kv[64];
#pragma unroll
    for (int s0 = 0; s0 < 64; s0 += 8) {
        unsigned qw[8], fw[8];
#pragma unroll
        for (int i = 0; i < 8; ++i) { qw[i] = *(const unsigned*)(qp + (size_t)(s0 + i) * 512); fw[i] = *(const unsigned*)(kp + (size_t)(s0 + i) * 512); }
#pragma unroll
        for (int i = 0; i < 8; ++i) {
            const float f0 = lb0 + om0 * sigm(bflo(fw[i])), f1 = lb1 + om1 * sigm(bfhi(fw[i]));
            b0 += __logf(f0); b1 += __logf(f1);
            const float e0 = __expf(b0), e1 = __expf(b1), i0 = __builtin_amdgcn_rcpf(e0), i1 = __builtin_amdgcn_rcpf(e1);
            const float q0 = bflo(qw[i]), q1 = bfhi(qw[i]);
            *(unsigned*)(qp + (size_t)(s0 + i) * 512) = pk_bf16(q0 * sigm(q0) * e0, q1 * sigm(q1) * e1);
            kv[s0 + i] = pk_bf16((1.f - f0) * i0, (1.f - f1) * i1);
            *(unsigned*)(kp + (size_t)(s0 + i) * 512) = kv[s0 + i];
        }
    }
    const float d0 = __expf(b0), d1 = __expf(b1);
    *(f32x2*)(dec + (size_t)(bh * 64 + c) * 128 + dk2) = (f32x2){d0, d1};
    bf16_t* r0 = kendT + (size_t)(bh * 128 + dk2) * SEQ + c * 64; bf16_t* r1 = r0 + SEQ;
#pragma unroll
    for (int s0 = 0; s0 < 64; s0 += 8) { u32x4 w0, w1;
#pragma unroll
        for (int i = 0; i < 4; ++i) { const unsigned ka = kv[s0 + 2 * i], kb = kv[s0 + 2 * i + 1];
            w0[i] = pk_bf16(bflo(ka) * d0, bflo(kb) * d0); w1[i] = pk_bf16(bfhi(ka) * d1, bfhi(kb) * d1); }
        *(u32x4*)(r0 + s0) = w0; *(u32x4*)(r1 + s0) = w1; }
}
DI void hgrn_ds_unit(const bf16_t* kendT, const bf16_t* vT, bf16_t* dsT, int bh, int c) {
    const int lane = threadIdx.x & 63, wave = threadIdx.x >> 6, r = lane & 31, hh = lane >> 5, i = wave >> 1, j0 = 2 * (wave & 1);
    const bf16_t* ka = kendT + (size_t)(bh * 128 + 32 * i + r) * SEQ + c * 64 + 8 * hh;
    const bf16_t* vb0 = vT + (size_t)(bh * 128 + 32 * j0 + r) * SEQ + c * 64 + 8 * hh; const bf16_t* vb1 = vb0 + (size_t)32 * SEQ;
    f32x16 D0, D1;
#pragma unroll
    for (int q = 0; q < 16; ++q) { D0[q] = 0.f; D1[q] = 0.f; }
#pragma unroll
    for (int ks = 0; ks < 4; ++ks) { const bf16x8 a = *(const bf16x8*)(ka + 16 * ks), b0 = *(const bf16x8*)(vb0 + 16 * ks), b1 = *(const bf16x8*)(vb1 + 16 * ks); D0 = MFMA32(a, b0, D0); D1 = MFMA32(a, b1, D1); }
    const int unit = bh * 64 + c;
    bf16_t* o0 = dsT + (size_t)(unit * 128 + 32 * j0 + r) * 128 + 32 * i + 4 * hh; bf16_t* o1 = o0 + 32 * 128;
#pragma unroll
    for (int g = 0; g < 4; ++g) { u32x2 w; w.x = pk_bf16(D0[4 * g], D0[4 * g + 1]); w.y = pk_bf16(D0[4 * g + 2], D0[4 * g + 3]); *(u32x2*)(o0 + 8 * g) = w;
        u32x2 z; z.x = pk_bf16(D1[4 * g], D1[4 * g + 1]); z.y = pk_bf16(D1[4 * g + 2], D1[4 * g + 3]); *(u32x2*)(o1 + 8 * g) = z; }
}
DI void hgrn_scan(bf16_t* dsT, const float* dec, int vb, int G) {
    for (int idx = vb * NTHR + threadIdx.x; idx < 64 * 128 * 16; idx += G * NTHR) {
        const int dk8 = idx & 15, dv = (idx >> 4) & 127, bh = idx >> 11;
        float S[8];
#pragma unroll
        for (int q = 0; q < 8; ++q) S[q] = 0.f;
        for (int c0 = 0; c0 < 64; c0 += 8) {
            u32x4 ld[8]; f32x4 d0[8], d1[8];
#pragma unroll
            for (int i = 0; i < 8; ++i) { const int c = c0 + i; ld[i] = *(const u32x4*)(dsT + (size_t)((bh * 64 + c) * 128 + dv) * 128 + dk8 * 8);
                const float* dp = dec + (size_t)(bh * 64 + c) * 128 + dk8 * 8; d0[i] = *(const f32x4*)dp; d1[i] = *(const f32x4*)(dp + 4); }
#pragma unroll
            for (int i = 0; i < 8; ++i) { const int c = c0 + i;
                u32x4 w; w.x = pk_bf16(S[0], S[1]); w.y = pk_bf16(S[2], S[3]); w.z = pk_bf16(S[4], S[5]); w.w = pk_bf16(S[6], S[7]);
                *(u32x4*)(dsT + (size_t)((bh * 64 + c) * 128 + dv) * 128 + dk8 * 8) = w;
                S[0] = d0[i][0] * S[0] + bflo(ld[i].x); S[1] = d0[i][1] * S[1] + bfhi(ld[i].x); S[2] = d0[i][2] * S[2] + bflo(ld[i].y); S[3] = d0[i][3] * S[3] + bfhi(ld[i].y);
                S[4] = d1[i][0] * S[4] + bflo(ld[i].z); S[5] = d1[i][1] * S[5] + bfhi(ld[i].z); S[6] = d1[i][2] * S[6] + bflo(ld[i].w); S[7] = d1[i][3] * S[7] + bfhi(ld[i].w); }
        }
    }
}
DI void hgrn_out_unit(const bf16_t* qd, const bf16_t* kinv, const bf16_t* vT, const bf16_t* spT, const bf16_t* gs, bf16_t* yh, LAS float* zs, int bh, int c) {
    const int tid = threadIdx.x, lane = tid & 63, wave = __builtin_amdgcn_readfirstlane(tid >> 6), r = lane & 31, hh = lane >> 5, tb = wave >> 2, db = wave & 3, b = bh >> 2, h = bh & 3;
    const size_t Tb = (size_t)b * SEQ + c * 64;
    bf16x8 qf[8], sf[8], kf0[8], kf1[8]; u32x2 vf[2][2][2];
    { const bf16_t* qrow = qd + (Tb + 32 * tb + r) * 512 + h * 128 + 8 * hh; const bf16_t* sp = spT + (size_t)((bh * 64 + c) * 128 + 32 * db + r) * 128 + 8 * hh;
      const bf16_t* k0 = kinv + (Tb + r) * 512 + h * 128 + 8 * hh; const bf16_t* vrow = vT + (size_t)(bh * 128 + 32 * db + r) * SEQ + c * 64 + 4 * hh;
#pragma unroll
      for (int ks = 0; ks < 8; ++ks) { qf[ks] = *(const bf16x8*)(qrow + 16 * ks); sf[ks] = *(const bf16x8*)(sp + 16 * ks); kf0[ks] = *(const bf16x8*)(k0 + 16 * ks); }
      if (tb) {
#pragma unroll
          for (int ks = 0; ks < 8; ++ks) kf1[ks] = *(const bf16x8*)(k0 + 32 * 512 + 16 * ks); }
#pragma unroll
      for (int sb = 0; sb < 2; ++sb)
#pragma unroll
          for (int s2 = 0; s2 < 2; ++s2) if (sb <= tb) { vf[sb][s2][0] = *(const u32x2*)(vrow + 32 * sb + 16 * s2); vf[sb][s2][1] = *(const u32x2*)(vrow + 32 * sb + 16 * s2 + 8); } }
    f32x16 Z;
#pragma unroll
    for (int q = 0; q < 16; ++q) Z[q] = 0.f;
#pragma unroll
    for (int ks = 0; ks < 8; ++ks) Z = MFMA32(qf[ks], sf[ks], Z);
#pragma unroll
    for (int sb = 0; sb < 2; ++sb) if (sb <= tb) {
        f32x16 X;
#pragma unroll
        for (int q = 0; q < 16; ++q) X[q] = 0.f;
#pragma unroll
        for (int ks = 0; ks < 8; ++ks) X = MFMA32(sb ? kf1[ks] : kf0[ks], qf[ks], X);
        if (sb == tb) {
#pragma unroll
            for (int q = 0; q < 16; ++q) if (crow(q, hh) > r) X[q] = 0.f;
        }
#pragma unroll
        for (int s2 = 0; s2 < 2; ++s2) {
            u32x4 pa_; pa_.x = pk_bf16(X[8 * s2], X[8 * s2 + 1]); pa_.y = pk_bf16(X[8 * s2 + 2], X[8 * s2 + 3]); pa_.z = pk_bf16(X[8 * s2 + 4], X[8 * s2 + 5]); pa_.w = pk_bf16(X[8 * s2 + 6], X[8 * s2 + 7]);
            u32x4 pb_; pb_.x = vf[sb][s2][0].x; pb_.y = vf[sb][s2][0].y; pb_.z = vf[sb][s2][1].x; pb_.w = vf[sb][s2][1].y;
            Z = MFMA32(__builtin_bit_cast(bf16x8, pa_), __builtin_bit_cast(bf16x8, pb_), Z);
        }
    }
#pragma unroll
    for (int q = 0; q < 16; ++q) zs[(32 * tb + crow(q, hh)) * 132 + 32 * db + r] = Z[q];
    __syncthreads();
    { const int tok = tid >> 3, d16 = (tid & 7) * 16; f32x4 o[4]; float ss = 0.f;
      const size_t off = (Tb + tok) * 512 + h * 128 + d16; const u32x4 g0 = *(const u32x4*)(gs + off), g1 = *(const u32x4*)(gs + off + 8);
#pragma unroll
      for (int i = 0; i < 4; ++i) { o[i] = *(const LAS f32x4*)(zs + tok * 132 + d16 + 4 * i); ss += (o[i][0] * o[i][0] + o[i][1] * o[i][1]) + (o[i][2] * o[i][2] + o[i][3] * o[i][3]); }
      ss += __shfl_xor(ss, 1); ss += __shfl_xor(ss, 2); ss += __shfl_xor(ss, 4);
      const float rn = __builtin_amdgcn_rsqf(ss * (1.f / 128.f) + EPS);
      u32x4 w0, w1;
      w0.x = pk_bf16(o[0][0] * rn * bflo(g0.x), o[0][1] * rn * bfhi(g0.x)); w0.y = pk_bf16(o[0][2] * rn * bflo(g0.y), o[0][3] * rn * bfhi(g0.y));
      w0.z = pk_bf16(o[1][0] * rn * bflo(g0.z), o[1][1] * rn * bfhi(g0.z)); w0.w = pk_bf16(o[1][2] * rn * bflo(g0.w), o[1][3] * rn * bfhi(g0.w));
      w1.x = pk_bf16(o[2][0] * rn * bflo(g1.x), o[2][1] * rn * bfhi(g1.x)); w1.y = pk_bf16(o[2][2] * rn * bflo(g1.y), o[2][3] * rn * bfhi(g1.y));
      w1.z = pk_bf16(o[3][0] * rn * bflo(g1.z), o[3][1] * rn * bfhi(g1.z)); w1.w = pk_bf16(o[3][2] * rn * bflo(g1.w), o[3][3] * rn * bfhi(g1.w));
      *(u32x4*)(yh + off) = w0; *(u32x4*)(yh + off + 8) = w1; }
}

DI unsigned f2ord(float f) { const unsigned b = __float_as_uint(f); return b ^ ((unsigned)((int)b >> 31) | 0x80000000u); }
DI float ord2f(unsigned k) { const unsigned b = (k & 0x80000000u) ? (k ^ 0x80000000u) : ~k; return __uint_as_float(b); }
DI void ce_desc(unsigned& a, unsigned& b) { const unsigned hi = a > b ? a : b, lo = a > b ? b : a; a = hi; b = lo; }
DI void sort16_desc(unsigned (&a)[16]) {
#pragma unroll
    for (int k = 2; k <= 16; k <<= 1)
#pragma unroll
        for (int j = k >> 1; j > 0; j >>= 1)
#pragma unroll
            for (int i = 0; i < 16; ++i) { const int l = i ^ j; if (l > i) { if ((i & k) == 0) ce_desc(a[i], a[l]); else ce_desc(a[l], a[i]); } }
}
DI void merge16_desc(unsigned (&a)[16], const unsigned (&b)[16]) {
#pragma unroll
    for (int i = 0; i < 16; ++i) a[i] = a[i] > b[15 - i] ? a[i] : b[15 - i];
#pragma unroll
    for (int j = 8; j > 0; j >>= 1)
#pragma unroll
        for (int i = 0; i < 16; ++i) { const int l = i ^ j; if (l > i) ce_desc(a[i], a[l]); }
}
#define TK_INS(L, x) do { unsigned t_ = (x); _Pragma("unroll") for (int j_ = 0; j_ < 16; ++j_) { const unsigned hi_ = L[j_] > t_ ? L[j_] : t_; t_ = L[j_] > t_ ? t_ : L[j_]; L[j_] = hi_; } } while (0)

DI void topk_stage_keys(const bf16_t* keysb, LAS unsigned char* kl, int h) {
    for (int c = threadIdx.x; c < 2 * 128 * 16; c += NTHR) { const int p = c >> 11, row = (c >> 4) & 127, ch = c & 15;
        *(LAS u32x4*)(kl + (p * 128 + row) * 272 + ch * 16) = *(const u32x4*)(keysb + ((size_t)(p * 8 + h) * 128 + row) * 128 + ch * 8); }
}
DI void topk_unit(const bf16_t* qp, const LAS unsigned char* kl, unsigned short* gidx, float* ggate, LAS unsigned* tk, int quad, int h) {
    const int tid = threadIdx.x, lane = tid & 63, wave = tid >> 6, p = wave & 1, tsub = wave >> 1, r = lane & 31, hh = lane >> 5;
#pragma unroll 1
    for (int hl = 0; hl < 4; ++hl) {
        const int tok0 = (quad * 4 + hl) * 128 + tsub * 32;
        f32x16 acc[4];
#pragma unroll
        for (int kb = 0; kb < 4; ++kb)
#pragma unroll
            for (int i = 0; i < 16; ++i) acc[kb][i] = 0.f;
        const bf16_t* qrow = qp + (size_t)(tok0 + r) * 2048 + h * 256 + p * 128 + 8 * hh;
        const LAS unsigned char* kbase = kl + (p * 128 + r) * 272 + 16 * hh;
#pragma unroll
        for (int s = 0; s < 8; ++s) { const bf16x8 bq = *(const bf16x8*)(qrow + 16 * s);
#pragma unroll
            for (int kb = 0; kb < 4; ++kb) { const bf16x8 ak = *(const LAS bf16x8*)(kbase + kb * 32 * 272 + 32 * s); acc[kb] = MFMA32(ak, bq, acc[kb]); } }
        unsigned A0[16], A1[16], A2[16], A3[16];
#pragma unroll
        for (int i = 0; i < 16; ++i) { const unsigned ki = (unsigned)(crow(i, hh));
            A0[i] = (f2ord(acc[0][i]) & ~127u) | ki; A1[i] = (f2ord(acc[1][i]) & ~127u) | (32u + ki); A2[i] = (f2ord(acc[2][i]) & ~127u) | (64u + ki); A3[i] = (f2ord(acc[3][i]) & ~127u) | (96u + ki); }
        sort16_desc(A0); sort16_desc(A1); sort16_desc(A2); sort16_desc(A3);
        merge16_desc(A0, A1); merge16_desc(A2, A3); merge16_desc(A0, A2);
#pragma unroll
        for (int j = 0; j < 16; ++j) A1[j] = __shfl_xor(A0[j], 32);
        merge16_desc(A0, A1);
        if (hh == 0) { LAS u32x4* dst = (LAS u32x4*)(tk + (((hl * 2 + p) * 128 + tsub * 32 + r) * 16));
#pragma unroll
            for (int c = 0; c < 4; ++c) { u32x4 w = {A0[4 * c], A0[4 * c + 1], A0[4 * c + 2], A0[4 * c + 3]}; dst[c] = w; } }
    }
    __syncthreads();
    {
        const int tok = tid & 127, hl = tid >> 7, tile = quad * 4 + hl;
        const LAS unsigned* t1 = tk + ((hl * 2 + 0) * 128 + tok) * 16; const LAS unsigned* t2 = tk + ((hl * 2 + 1) * 128 + tok) * 16;
        float v1[16], v2[16];
        { const LAS u32x4* s1 = (const LAS u32x4*)t1; const LAS u32x4* s2 = (const LAS u32x4*)t2;
#pragma unroll
          for (int c = 0; c < 4; ++c) { const u32x4 a = s1[c], b = s2[c];
              v1[4 * c] = ord2f(a.x & ~127u); v1[4 * c + 1] = ord2f(a.y & ~127u); v1[4 * c + 2] = ord2f(a.z & ~127u); v1[4 * c + 3] = ord2f(a.w & ~127u);
              v2[4 * c] = ord2f(b.x & ~127u); v2[4 * c + 1] = ord2f(b.y & ~127u); v2[4 * c + 2] = ord2f(b.z & ~127u); v2[4 * c + 3] = ord2f(b.w & ~127u); } }
#define CKEY(i, j) ((f2ord(v1[i] + v2[j]) & ~255u) | (unsigned)((i) * 16 + (j)))
        unsigned C[16], D[16], E[16];
#pragma unroll
        for (int j = 0; j < 16; ++j) C[j] = CKEY(0, j);
#pragma unroll
        for (int j = 0; j < 8; ++j) D[j] = CKEY(1, j);
#pragma unroll
        for (int j = 0; j < 5; ++j) D[8 + j] = CKEY(2, j);
#pragma unroll
        for (int j = 0; j < 3; ++j) D[13 + j] = CKEY(4, j);
#pragma unroll
        for (int j = 0; j < 4; ++j) E[j] = CKEY(3, j);
        E[4] = CKEY(5, 0); E[5] = CKEY(5, 1); E[6] = CKEY(6, 0); E[7] = CKEY(6, 1); E[8] = CKEY(7, 0); E[9] = CKEY(7, 1);
        E[10] = CKEY(8, 0); E[11] = CKEY(9, 0); E[12] = CKEY(10, 0); E[13] = CKEY(11, 0); E[14] = CKEY(12, 0); E[15] = CKEY(13, 0);
        sort16_desc(D); sort16_desc(E);
        TK_INS(E, CKEY(14, 0)); TK_INS(E, CKEY(15, 0));
#undef CKEY
        merge16_desc(C, D); merge16_desc(C, E);
        float sc[16]; unsigned ei[16]; float mx = -1e30f;
#pragma unroll
        for (int q = 0; q < 16; ++q) { const unsigned ij = C[q] & 255u; const unsigned a = t1[ij >> 4], b = t2[ij & 15u];
            sc[q] = ord2f(a & ~127u) + ord2f(b & ~127u); ei[q] = (a & 127u) * 128u + (b & 127u); mx = fmaxf(mx, sc[q]); }
        float sum = 0.f;
#pragma unroll
        for (int q = 0; q < 16; ++q) { sc[q] = __expf(sc[q] - mx); sum += sc[q]; }
        const float inv = 1.f / sum; const size_t o = (size_t)(tile * 128 + tok) * 128 + h * 16;
        u32x4 w0, w1;
        w0.x = ei[0] | (ei[1] << 16); w0.y = ei[2] | (ei[3] << 16); w0.z = ei[4] | (ei[5] << 16); w0.w = ei[6] | (ei[7] << 16);
        w1.x = ei[8] | (ei[9] << 16); w1.y = ei[10] | (ei[11] << 16); w1.z = ei[12] | (ei[13] << 16); w1.w = ei[14] | (ei[15] << 16);
        *(u32x4*)(gidx + o) = w0; *(u32x4*)(gidx + o + 8) = w1;
#pragma unroll
        for (int c = 0; c < 4; ++c) *(f32x4*)(ggate + o + 4 * c) = (f32x4){sc[4 * c] * inv, sc[4 * c + 1] * inv, sc[4 * c + 2] * inv, sc[4 * c + 3] * inv};
    }
    __syncthreads();
}

DI float gelu_erf(float x) { return 0.5f * x * (1.f + erff(x * 0.70710678118654752f)); }
DI int dot16(u32x4 w, const int (&h)[4]) { int c = __builtin_amdgcn_sdot4((int)w.x, h[0], 0, false); c = __builtin_amdgcn_sdot4((int)w.y, h[1], c, false); c = __builtin_amdgcn_sdot4((int)w.z, h[2], c, false); return __builtin_amdgcn_sdot4((int)w.w, h[3], c, false); }
#define V8_FMA(acc4, word, we) do { acc4[0] += (we) * (float)((word) & 255u); acc4[1] += (we) * (float)(((word) >> 8) & 255u); acc4[2] += (we) * (float)(((word) >> 16) & 255u); acc4[3] += (we) * (float)((word) >> 24); } while (0)

template <int IDMASK> DI void expert_token(const bf16_t* x2row, const float* ssq, const unsigned char* u8, const unsigned char* v8, const float* su, const float* sv, const unsigned short* gidx, const float* ggate, const float* gf, float* outrow, int lane) {
    f32x4 x[4]; float amax = 0.f;
#pragma unroll
    for (int i = 0; i < 4; ++i) { const u32x2 w_ = *(const u32x2*)(x2row + 16 * lane + 4 * i); x[i] = (f32x4){bflo(w_.x), bfhi(w_.x), bflo(w_.y), bfhi(w_.y)}; amax = fmaxf(fmaxf(amax, fmaxf(fabsf(x[i][0]), fabsf(x[i][1]))), fmaxf(fabsf(x[i][2]), fabsf(x[i][3]))); }
    float ss = (lane < 16) ? ssq[lane] : 0.f; ss = wave_sum(ss);
    const float rstd2 = __builtin_amdgcn_rsqf(ss * (1.f / 1024.f) + EPS);
#pragma unroll
    for (int o = 1; o < 64; o <<= 1) amax = fmaxf(amax, __shfl_xor(amax, o));
    amax *= rstd2;
    const float qs = amax > 0.f ? 127.f / amax : 0.f, sh = amax * (1.f / 127.f), xq = rstd2 * qs;
    int hq[4];
#pragma unroll
    for (int i = 0; i < 4; ++i) { const int q0 = (int)rintf(x[i][0] * xq), q1 = (int)rintf(x[i][1] * xq), q2 = (int)rintf(x[i][2] * xq), q3 = (int)rintf(x[i][3] * xq);
        hq[i] = (int)((unsigned)(q0 & 255) | ((unsigned)(q1 & 255) << 8) | ((unsigned)(q2 & 255) << 16) | ((unsigned)(q3 & 255) << 24)); }
    const int id0 = gidx[lane] & IDMASK, id1 = gidx[64 + lane] & IDMASK; const float g0 = ggate[lane], g1 = ggate[64 + lane];
    f32x4 o[4]; float wsum = 0.f;
#pragma unroll
    for (int i = 0; i < 4; ++i) o[i] = (f32x4){0.f, 0.f, 0.f, 0.f};
#pragma unroll 1
    for (int bt = 0; bt < 16; ++bt) {
        const int idsel = (bt < 8) ? id0 : id1; const float gsel = (bt < 8) ? g0 : g1; const int lb = (bt & 7) * 8;
        u32x4 ur[8], vr[8];
#pragma unroll
        for (int e = 0; e < 8; ++e) { const int idx = __builtin_amdgcn_readlane(idsel, lb + e); ur[e] = *(const u32x4*)(u8 + (size_t)idx * 1024 + 16 * lane); }
#pragma unroll
        for (int e = 0; e < 8; ++e) { const int idx = __builtin_amdgcn_readlane(idsel, lb + e); vr[e] = *(const u32x4*)(v8 + (size_t)idx * 1024 + 16 * lane); }
        const int myidx = __shfl(idsel, lb + (lane >> 3)); const float mysu = su[myidx], mysv = sv[myidx], gate = __shfl(gsel, lb + (lane >> 3));
        int pr[8];
#pragma unroll
        for (int e = 0; e < 8; ++e) pr[e] = dot16(ur[e], hq);
        int q4[4], q2[2], q1;
        { const bool up_ = (lane & 32) != 0;
#pragma unroll
          for (int i = 0; i < 4; ++i) { const int keep = up_ ? pr[i + 4] : pr[i], send = up_ ? pr[i] : pr[i + 4]; q4[i] = keep + __shfl_xor(send, 32); } }
        { const bool up_ = (lane & 16) != 0;
#pragma unroll
          for (int i = 0; i < 2; ++i) { const int keep = up_ ? q4[i + 2] : q4[i], send = up_ ? q4[i] : q4[i + 2]; q2[i] = keep + __shfl_xor(send, 16); } }
        { const bool up_ = (lane & 8) != 0; const int keep = up_ ? q2[1] : q2[0], send = up_ ? q2[0] : q2[1]; q1 = keep + __shfl_xor(send, 8); }
        q1 += __shfl_xor(q1, 4); q1 += __shfl_xor(q1, 2); q1 += __shfl_xor(q1, 1);
        const float act = (float)q1 * (mysu * sh);
        const float w = gelu_erf(act) * gate * mysv;
#pragma unroll
        for (int e = 0; e < 8; ++e) { const float we = __int_as_float(__builtin_amdgcn_readlane(__float_as_int(w), 8 * e)); wsum += we;
            V8_FMA(o[0], vr[e].x, we); V8_FMA(o[1], vr[e].y, we); V8_FMA(o[2], vr[e].z, we); V8_FMA(o[3], vr[e].w, we); }
    }
    const float corr = 128.f * wsum; float s3 = 0.f;
#pragma unroll
    for (int i = 0; i < 4; ++i) { x[i] += o[i] - corr; s3 += (x[i][0] * x[i][0] + x[i][1] * x[i][1]) + (x[i][2] * x[i][2] + x[i][3] * x[i][3]); }
    s3 = wave_sum(s3); const float r3 = __builtin_amdgcn_rsqf(s3 * (1.f / 1024.f) + EPS);
#pragma unroll
    for (int i = 0; i < 4; ++i) *(f32x4*)(outrow + 16 * lane + 4 * i) = x[i] * r3 * *(const f32x4*)(gf + 16 * lane + 4 * i);
}

DI void hq_token(const bf16_t* x2row, const float* ssq, unsigned char* hqrow, float* shp, int lane) {
    f32x4 x[4]; float amax = 0.f;
#pragma unroll
    for (int i = 0; i < 4; ++i) { const u32x2 w_ = *(const u32x2*)(x2row + 16 * lane + 4 * i); x[i] = (f32x4){bflo(w_.x), bfhi(w_.x), bflo(w_.y), bfhi(w_.y)}; amax = fmaxf(fmaxf(amax, fmaxf(fabsf(x[i][0]), fabsf(x[i][1]))), fmaxf(fabsf(x[i][2]), fabsf(x[i][3]))); }
    float ss = (lane < 16) ? ssq[lane] : 0.f; ss = wave_sum(ss);
    const float rstd2 = __builtin_amdgcn_rsqf(ss * (1.f / 1024.f) + EPS);
#pragma unroll
    for (int o = 1; o < 64; o <<= 1) amax = fmaxf(amax, __shfl_xor(amax, o));
    amax *= rstd2;
    const float qs = amax > 0.f ? 127.f / amax : 0.f, xq = rstd2 * qs;
    u32x4 w;
#pragma unroll
    for (int i = 0; i < 4; ++i) { const int q0 = (int)rintf(x[i][0] * xq), q1 = (int)rintf(x[i][1] * xq), q2 = (int)rintf(x[i][2] * xq), q3 = (int)rintf(x[i][3] * xq);
        w[i] = (unsigned)(q0 & 255) | ((unsigned)(q1 & 255) << 8) | ((unsigned)(q2 & 255) << 16) | ((unsigned)(q3 & 255) << 24); }
    *(u32x4*)(hqrow + 16 * lane) = w;
    if (lane == 0) *shp = amax * (1.f / 127.f);
}
template <int CTRL> DI int dpp_i(int v) { return __builtin_amdgcn_mov_dpp(v, CTRL, 0xf, 0xf, true); }
template <int CTRL> DI float dpp_f(float v) { return __int_as_float(__builtin_amdgcn_mov_dpp(__float_as_int(v), CTRL, 0xf, 0xf, true)); }
DI float swapadd32(float a, float b) { const auto r = __builtin_amdgcn_permlane32_swap(__float_as_uint(a), __float_as_uint(b), false, false); return __uint_as_float(r[0]) + __uint_as_float(r[1]); }
DI float swapadd16(float a, float b) { const auto r = __builtin_amdgcn_permlane16_swap(__float_as_uint(a), __float_as_uint(b), false, false); return __uint_as_float(r[0]) + __uint_as_float(r[1]); }

struct SMeta { u32x4 i0, i1, a0, a1; unsigned xw; };
DI void slice_issue(u32x4 (&r)[16], const SMeta& m, const unsigned char* base) {
    const unsigned iw[8] = {m.i0.x, m.i0.y, m.i0.z, m.i0.w, m.i1.x, m.i1.y, m.i1.z, m.i1.w};
#pragma unroll
    for (int j = 0; j < 16; ++j) { const unsigned idx = (j & 1) ? (iw[j >> 1] >> 16) : (iw[j >> 1] & 0xffffu); r[j] = *(const u32x4*)(base + (size_t)idx * 1024); }
}
DI void slice_u_compute(const SMeta& m, const u32x4 (&r)[16], int* actp, int lane) {
    const int hq[4] = {(int)m.a0.x, (int)m.a0.y, (int)m.a0.z, (int)m.a0.w};
    int part[16];
#pragma unroll
    for (int j = 0; j < 16; ++j) part[j] = dot16(r[j], hq);
    int r8[8], r4[4], r2[2];
    { const bool up_ = (lane & 4) != 0;
#pragma unroll
      for (int i = 0; i < 8; ++i) { const int keep = up_ ? part[i + 8] : part[i], send = up_ ? part[i] : part[i + 8]; r8[i] = keep + dpp_i<0x141>(send); } }
    { const bool up_ = (lane & 2) != 0;
#pragma unroll
      for (int i = 0; i < 4; ++i) { const int keep = up_ ? r8[i + 4] : r8[i], send = up_ ? r8[i] : r8[i + 4]; r4[i] = keep + dpp_i<0x4E>(send); } }
    { const bool up_ = (lane & 1) != 0;
#pragma unroll
      for (int i = 0; i < 2; ++i) { const int keep = up_ ? r4[i + 2] : r4[i], send = up_ ? r4[i] : r4[i + 2]; r2[i] = keep + dpp_i<0xB1>(send); } }
    actp[lane] = (int)((unsigned)(((r2[0] + 32) >> 6) & 0xffff) | ((unsigned)((r2[1] + 32) >> 6) << 16));
}
DI int swapadd32i(int a, int b) { const auto r = __builtin_amdgcn_permlane32_swap((unsigned)a, (unsigned)b, false, false); return (int)r[0] + (int)r[1]; }
DI int swapadd16i(int a, int b) { const auto r = __builtin_amdgcn_permlane16_swap((unsigned)a, (unsigned)b, false, false); return (int)r[0] + (int)r[1]; }
DI void slice_v_compute(const SMeta& m, const u32x4 (&r)[16], float* x3row, float* ssq3p, int xs, int lane) {
    const int wq[4] = {(int)m.a0.x, (int)m.a0.y, (int)m.a0.z, (int)m.a0.w};
    const float sw = __uint_as_float(m.a1.x);
    const int col = 16 * (lane & 7) + ((lane >> 5) & 1) * 8 + ((lane >> 4) & 1) * 4 + ((lane >> 3) & 1) * 2;
    int o[16];
#pragma unroll
    for (int i = 0; i < 16; ++i) o[i] = 0;
#pragma unroll
    for (int q = 0; q < 4; ++q)
#pragma unroll
        for (int p = 0; p < 4; ++p) {
            const unsigned d0 = r[4 * q][p], d1 = r[4 * q + 1][p], d2 = r[4 * q + 2][p], d3 = r[4 * q + 3][p];
            const unsigned t0 = __builtin_amdgcn_perm(d1, d0, 0x05010400u), t1 = __builtin_amdgcn_perm(d1, d0, 0x07030602u), t2 = __builtin_amdgcn_perm(d3, d2, 0x05010400u), t3 = __builtin_amdgcn_perm(d3, d2, 0x07030602u);
            const unsigned e0 = __builtin_amdgcn_perm(t2, t0, 0x05040100u), e1 = __builtin_amdgcn_perm(t2, t0, 0x07060302u), e2 = __builtin_amdgcn_perm(t3, t1, 0x05040100u), e3 = __builtin_amdgcn_perm(t3, t1, 0x07060302u);
            o[4 * p] = __builtin_amdgcn_sdot4((int)e0, wq[q], o[4 * p], false); o[4 * p + 1] = __builtin_amdgcn_sdot4((int)e1, wq[q], o[4 * p + 1], false);
            o[4 * p + 2] = __builtin_amdgcn_sdot4((int)e2, wq[q], o[4 * p + 2], false); o[4 * p + 3] = __builtin_amdgcn_sdot4((int)e3, wq[q], o[4 * p + 3], false);
        }
    int a8[8], a4[4], a2[2];
#pragma unroll
    for (int i = 0; i < 8; ++i) a8[i] = swapadd32i(o[i], o[8 + i]);
#pragma unroll
    for (int i = 0; i < 4; ++i) a4[i] = swapadd16i(a8[i], a8[i + 4]);
    { const bool up_ = (lane & 8) != 0;
#pragma unroll
      for (int i = 0; i < 2; ++i) { const int keep = up_ ? a4[i + 2] : a4[i], send = up_ ? a4[i] : a4[i + 2]; a2[i] = keep + dpp_i<0x128>(send); } }
    const float y0 = bflo(m.xw) + (float)a2[0] * sw, y1 = bfhi(m.xw) + (float)a2[1] * sw;
    *(f32x2*)(x3row + 128 * xs + col) = (f32x2){y0, y1};
    const float ss = wave_sum(y0 * y0 + y1 * y1);
    if (lane == 0) ssq3p[xs] = ss;
}
template <int MODE> DI void slice_pass(unsigned char* ws, float* out, int xs, int gw_, int nw_, int lane) {
    const int g = lane >> 3, c = lane & 7;
    const unsigned short* gidx = (const unsigned short*)(ws + WS_GIDX) + 16 * g;
    const unsigned char* tab = (MODE == 0 ? (const unsigned char*)(ws + WS_U8) : (const unsigned char*)(ws + WS_V8)) + 128 * xs + 16 * c;
    const unsigned char* hqb = (const unsigned char*)(ws + WS_HQ) + 128 * xs + 16 * c;
    const unsigned char* wxb = (const unsigned char*)(ws + WS_WX) + 16 * g;
    const bf16_t* x2b = (const bf16_t*)(ws + WS_X2B) + 128 * xs + 16 * c + ((lane >> 5) & 1) * 8 + ((lane >> 4) & 1) * 4 + ((lane >> 3) & 1) * 2;
#define S_LOAD(m, tok) do { const unsigned short* ip = gidx + (size_t)(tok) * 128; (m).i0 = *(const u32x4*)ip; (m).i1 = *(const u32x4*)(ip + 8); \
        if (MODE == 0) { (m).a0 = *(const u32x4*)(hqb + (size_t)(tok) * 1024); } else { (m).a0 = *(const u32x4*)(wxb + (size_t)(tok) * 128); (m).a1.x = __float_as_uint(((const float*)(ws + WS_SW))[tok]); (m).xw = *(const unsigned*)(x2b + (size_t)(tok) * DM); } } while (0)
#define S_COMPUTE(m, r, tok) do { if (MODE == 0) slice_u_compute(m, r, (int*)(ws + WS_ACTP) + ((size_t)(tok) * 8 + xs) * 64, lane); \
        else slice_v_compute(m, r, out + (size_t)(tok) * DM, (float*)(ws + WS_SSQ3) + (size_t)(tok) * 8, xs, lane); } while (0)
    SMeta mA, mB, mN; u32x4 rA[16], rB[16];
    if (gw_ >= T) return;
    const int n = (T - gw_ + nw_ - 1) / nw_;
#define S_TK(j) (gw_ + ((j) < n ? (j) : n - 1) * nw_)
    S_LOAD(mA, S_TK(0)); slice_issue(rA, mA, tab); S_LOAD(mB, S_TK(1));
    for (int i = 0; i < n; i += 2) {
        slice_issue(rB, mB, tab);
        S_LOAD(mN, S_TK(i + 2));
        S_COMPUTE(mA, rA, S_TK(i));
        mA = mN; slice_issue(rA, mA, tab);
        S_LOAD(mN, S_TK(i + 3));
        if (i + 1 < n) S_COMPUTE(mB, rB, S_TK(i + 1));
        mB = mN;
    }
#undef S_TK
#undef S_LOAD
#undef S_COMPUTE
}
DI void expert_w_token(const int* actp, const unsigned short* gidx, const float* ggate, float sh, const float* su, const float* sv, unsigned char* wrow, float* swp, int lane) {
    typedef int i32x2 __attribute__((ext_vector_type(2)));
    i32x2 acc = {0, 0};
#pragma unroll
    for (int x = 0; x < 8; ++x) { const int w_ = actp[x * 64 + lane]; acc[0] += (int)(short)(w_ & 0xffff); acc[1] += w_ >> 16; }
    acc[0] <<= 6; acc[1] <<= 6;
    const unsigned ii = *(const unsigned*)(gidx + 2 * lane); const f32x2 gt = *(const f32x2*)(ggate + 2 * lane);
    const int e0 = ii & 0xffffu, e1 = ii >> 16;
    const float w0 = gelu_erf((float)acc[0] * (su[e0] * sh)) * gt[0] * sv[e0], w1 = gelu_erf((float)acc[1] * (su[e1] * sh)) * gt[1] * sv[e1];
    float amax = fmaxf(fabsf(w0), fabsf(w1));
    amax = fmaxf(amax, dpp_f<0xB1>(amax)); amax = fmaxf(amax, dpp_f<0x4E>(amax)); amax = fmaxf(amax, dpp_f<0x141>(amax)); amax = fmaxf(amax, dpp_f<0x128>(amax));
    { const auto r = __builtin_amdgcn_permlane16_swap(__float_as_uint(amax), __float_as_uint(amax), false, false); amax = fmaxf(__uint_as_float(r[0]), __uint_as_float(r[1])); }
    { const auto r = __builtin_amdgcn_permlane32_swap(__float_as_uint(amax), __float_as_uint(amax), false, false); amax = fmaxf(__uint_as_float(r[0]), __uint_as_float(r[1])); }
    const float qs = amax > 0.f ? 127.f / amax : 0.f;
    const int q0 = (int)rintf(w0 * qs), q1 = (int)rintf(w1 * qs);
    *(unsigned short*)(wrow + 2 * lane) = (unsigned short)((q0 & 255) | ((q1 & 255) << 8));
    if (lane == 0) *swp = amax * (1.f / 127.f);
}
DI void final_norm_token(float* row, const float* ssq3p, const float* gf, int lane) {
    float ss = (lane < 8) ? ssq3p[lane] : 0.f; ss = wave_sum(ss);
    const float r3 = __builtin_amdgcn_rsqf(ss * (1.f / 1024.f) + EPS);
#pragma unroll
    for (int i = 0; i < 4; ++i) { f32x4* p = (f32x4*)(row + 256 * i + 4 * lane); *p = *p * r3 * *(const f32x4*)(gf + 256 * i + 4 * lane); }
}

#define XB_TMO      128
#define XB_XCNT(j)  (256  + 64 * (j))
#define XB_XSUB(j)  (1280 + 64 * (j))
#define XB_XGEN(j)  (2304 + 64 * (j))
#define XB_TOP      3328
#define XB_TOPGEN   3392
#define XCD_BAR_WORDS 3456
#define XB_SPIN_CAP (1u << 18)

__device__ __forceinline__ unsigned xb_ld(unsigned* p)              { return __hip_atomic_load(p, __ATOMIC_RELAXED, __HIP_MEMORY_SCOPE_AGENT); }
__device__ __forceinline__ unsigned xb_add(unsigned* p, unsigned v) { return __hip_atomic_fetch_add(p, v, __ATOMIC_RELAXED, __HIP_MEMORY_SCOPE_AGENT); }
__device__ __forceinline__ unsigned xb_xcc_id() { return (unsigned)__builtin_amdgcn_s_getreg((3 << 11) | 20) & 0xFu; }
#define XB_SPIN(cond, bar) do { unsigned _sp = 0; while (cond) { __builtin_amdgcn_s_sleep(1); \
    if ((++_sp & 255u) == 0u) { if (xb_ld(&(bar)[XB_TMO])) break; if (_sp > XB_SPIN_CAP) { atomicAdd(&(bar)[XB_TMO], 1u); break; } } } } while (0)

struct XcdBarrier {
    unsigned* bar; unsigned x;
    volatile __attribute__((address_space(3))) unsigned* st;
};

__device__ __forceinline__ XcdBarrier xcd_barrier_post(unsigned* bar, volatile __attribute__((address_space(3))) unsigned* st) {
    XcdBarrier b; b.bar = bar; b.x = xb_xcc_id(); b.st = st;
    if (threadIdx.x == 0) st[2] = xb_add(&bar[XB_XCNT(b.x)], 1u);
    return b;
}
__device__ __forceinline__ void xcd_barrier_complete(unsigned* bar, unsigned x, unsigned& nloc, unsigned& nx) {
    const unsigned G = gridDim.x * gridDim.y * gridDim.z;
    unsigned sum, cnt, mine, sp = 0u;
    for (;;) {
        sum = 0u; cnt = 0u; mine = 0u;
#pragma unroll
        for (unsigned j = 0; j < 16; ++j) { const unsigned c = xb_ld(&bar[XB_XCNT(j)]); sum += c; cnt += (c > 0u) ? 1u : 0u; mine = (j == x) ? c : mine; }
        if (sum == G) break;
        __builtin_amdgcn_s_sleep(1);
        if ((++sp & 255u) == 0u) { if (xb_ld(&bar[XB_TMO])) break; if (sp > XB_SPIN_CAP) { atomicAdd(&bar[XB_TMO], 1u); break; } }
    }
    nloc = mine > 0u ? mine : 1u; nx = cnt > 0u ? cnt : 1u;
}

__device__ __forceinline__ void xcd_barrier(const XcdBarrier& b) {
    asm volatile("s_waitcnt vmcnt(0)" ::: "memory");
    __syncthreads();
    if (threadIdx.x == 0) {
        unsigned* bar = b.bar;
        __builtin_amdgcn_s_waitcnt(0);
        unsigned nloc = b.st[0], nx = b.st[1];
        if (nloc == 0u) { xcd_barrier_complete(bar, b.x, nloc, nx); b.st[0] = nloc; b.st[1] = nx; }
        const unsigned old = xb_add(&bar[XB_XSUB(b.x)], 1u);
        const unsigned gen = old / nloc;
        if (old + 1u == (gen + 1u) * nloc) {
            __builtin_amdgcn_fence(__ATOMIC_RELEASE, "agent");
            asm volatile("s_waitcnt vmcnt(0)" ::: "memory");
            const unsigned og = xb_add(&bar[XB_TOP], 1u);
            const unsigned tg = og / nx;
            if (og + 1u == (tg + 1u) * nx) xb_add(&bar[XB_TOPGEN], 1u);
            else XB_SPIN(xb_ld(&bar[XB_TOPGEN]) == tg, bar);
            __builtin_amdgcn_fence(__ATOMIC_ACQUIRE, "agent");
            xb_add(&bar[XB_XGEN(b.x)], 1u);
            asm volatile("s_waitcnt vmcnt(0)" ::: "memory");
        } else {
            XB_SPIN(xb_ld(&bar[XB_XGEN(b.x)]) == gen, bar);
            __builtin_amdgcn_fence(__ATOMIC_ACQUIRE, "agent");
            asm volatile("s_waitcnt vmcnt(0)" ::: "memory");
        }
    }
    __syncthreads();
}

constexpr int N_PHASES = 13;
__global__ void __launch_bounds__(NTHR, 2) mk_fwd(Args a) {
    extern __shared__ __attribute__((aligned(16))) unsigned char lds_raw[];
    LAS unsigned char* lds = (LAS unsigned char*)lds_raw;
    cg::grid_group grid = cg::this_grid();
    const int G = gridDim.x, vb = blockIdx.x, tid = threadIdx.x, lane = tid & 63, wave = tid >> 6;
    unsigned char* ws = a.ws;
    const int lo = a.ph_lo, hi = a.ph_hi;
    volatile LAS unsigned* MISC = (volatile LAS unsigned*)(lds + LDS_BYTES - 64);
    if (tid < 16) MISC[tid] = 0u;
    __syncthreads();
    const XcdBarrier bar = xcd_barrier_post((unsigned*)(ws + 4096) + lo * XCD_BAR_WORDS, MISC);
#ifndef PHASE_MASK
#define PHASE_MASK 0xFFFF
#endif
#define IN(k) (((PHASE_MASK >> (k)) & 1) && lo <= (k) && (k) < hi)
#ifndef REPEAT_MASK
#define REPEAT_MASK 0
#endif
#define REP(k) for (int rep_ = 0; rep_ < (((REPEAT_MASK) >> (k)) & 1) + 1; ++rep_)
#define SEAM(k) do { if (IN(k) && IN((k) + 1)) { if ((k) == 0) grid.sync(); else xcd_barrier(bar); } } while (0)
    REP(0) if (IN(0)) p0_prologue(a, lds, vb, G);
    SEAM(0);
    REP(1) if (IN(1)) { pg8::Gemm g{(const bf16_t*)(ws + WS_XB), (const bf16_t*)(ws + WS_W1T), T, NIN, 1024}; pg8::StaticOrder S; S.init(T, NIN, G, vb);
        pg8::Epi1 E{(const float*)(ws + WS_RSTD1), (bf16_t*)(ws + WS_PA), (bf16_t*)(ws + WS_GG), (bf16_t*)(ws + WS_QD), (bf16_t*)(ws + WS_KINV), (bf16_t*)(ws + WS_KENDT), (bf16_t*)(ws + WS_VT), (bf16_t*)(ws + WS_GS),
                    (float*)(ws + WS_DEC), (const float*)(ws + WS_LB), (bf16_t*)(ws + WS_AVT), lds + 131072};
        pg8::gemm_phase<pg8::Epi1, pg8::StaticOrder, true, true>(lds, g, S, E); }
#ifdef PROBE_GEMM1_PLAIN
    if (IN(1)) { pg8::Gemm g{(const bf16_t*)(ws + WS_XB), (const bf16_t*)(ws + WS_W1T), T, NIN, 1024}; pg8::StaticOrder S; S.init(T, NIN, G, vb);
        pg8::EpiDummy E{(bf16_t*)(ws + WS_YA), (const float*)(ws + WS_RSTD1)};
        pg8::gemm_phase<pg8::EpiDummy, pg8::StaticOrder, true, true>(lds, g, S, E); }
#endif
    SEAM(1);
    REP(2) if (IN(2)) {
        for (int u0 = vb * 8; u0 < 64 * 64; u0 += G * 8) {
            { const int u = u0 + (tid >> 6); hgrn_prep_unit((bf16_t*)(ws + WS_QD), (bf16_t*)(ws + WS_KINV), (bf16_t*)(ws + WS_KENDT), (float*)(ws + WS_DEC), (const float*)(ws + WS_LB), u >> 6, u & 63, (tid & 63) * 2); }
            __syncthreads();
            for (int j = 0; j < 8; ++j) hgrn_ds_unit((const bf16_t*)(ws + WS_KENDT), (const bf16_t*)(ws + WS_VT), (bf16_t*)(ws + WS_XB), (u0 + j) >> 6, (u0 + j) & 63);
        }
        { const int hw = __builtin_amdgcn_readfirstlane(wave);
          for (int u = vb; u < BATCH * (SEQ / 32); u += G) attn_task((const bf16_t*)(ws + WS_PA), (const bf16_t*)(ws + WS_AVT), a.in[3], (bf16_t*)(ws + WS_YA), u >> 7, u & 127, hw);
#ifdef PROBE_ATT2
          for (int u = vb; u < BATCH * (SEQ / 32); u += G) attn_task((const bf16_t*)(ws + WS_PA), (const bf16_t*)(ws + WS_AVT), a.in[3], (bf16_t*)(ws + WS_YA), u >> 7, u & 127, hw);
#endif
 }
    }
    SEAM(2);
    REP(3) if (IN(3)) hgrn_scan((bf16_t*)(ws + WS_XB), (const float*)(ws + WS_DEC), vb, G);
    SEAM(3);
    REP(4) if (IN(4)) { int bsel = 0; for (int u = vb; u < 64 * 64; u += G, bsel ^= 1)
        hgrn_out_unit((const bf16_t*)(ws + WS_QD), (const bf16_t*)(ws + WS_KINV), (const bf16_t*)(ws + WS_VT), (const bf16_t*)(ws + WS_XB), (const bf16_t*)(ws + WS_GS), (bf16_t*)(ws + WS_YH), (LAS float*)(lds + bsel * 34816), u >> 6, u & 63);
        __syncthreads(); }
    SEAM(4);
    REP(5) if (IN(5)) {
        { pg8::Gemm g{(const bf16_t*)(ws + WS_YA), (const bf16_t*)(ws + WS_WAPT), T, 1024, 512}; pg8::StaticOrder S; S.init(T, 1024, G, vb);
          pg8::EpiMerge<false> E{(bf16_t*)(ws + WS_XB), (const bf16_t*)(ws + WS_GG)};
          pg8::gemm_phase<pg8::EpiMerge<false>, pg8::StaticOrder, true, true>(lds, g, S, E); }
        __syncthreads();
        { pg8::Gemm g{(const bf16_t*)(ws + WS_YH), (const bf16_t*)(ws + WS_WHPT), T, 1024, 512}; pg8::StaticOrder S; S.init(T, 1024, G, vb);
          pg8::EpiMerge<true> E{(bf16_t*)(ws + WS_XB), (const bf16_t*)(ws + WS_GG) + 1024};
          pg8::gemm_phase<pg8::EpiMerge<true>, pg8::StaticOrder, true, true>(lds, g, S, E); }
    }
    SEAM(5);
    REP(6) if (IN(6)) { pg8::Gemm g{(const bf16_t*)(ws + WS_XB), (const bf16_t*)(ws + WS_WOUTT), T, 1024, 1024}; pg8::StaticOrder S; S.init(T, 1024, G, vb);
        pg8::EpiX2 E{a.in[0], (bf16_t*)(ws + WS_X2B), (float*)(ws + WS_SSQ2)};
        pg8::gemm_phase<pg8::EpiX2, pg8::StaticOrder, true, true>(lds, g, S, E); }
    SEAM(6);
    REP(7) if (IN(7)) { pg8::Gemm g{(const bf16_t*)(ws + WS_X2B), (const bf16_t*)(ws + WS_WQT), T, 2048, 1024}; pg8::StaticOrder S; S.init(T, 2048, G, vb);
        pg8::EpiQp E{(bf16_t*)(ws + WS_QP), (const float*)(ws + WS_SSQ2)};
        pg8::gemm_phase<pg8::EpiQp, pg8::StaticOrder, true, true>(lds, g, S, E); }
    SEAM(7);
    REP(8) if (IN(8)) { const int per = (1024 + G - 1) / G; int hcur = -1;
        for (int U = vb * per; U < (vb + 1) * per && U < 1024; ++U) { const int h = U >> 7;
            if (h != hcur) { topk_stage_keys((const bf16_t*)(ws + WS_KEYS), lds + 65536, h); hcur = h; __syncthreads(); }
            topk_unit((const bf16_t*)(ws + WS_QP), lds + 65536, (unsigned short*)(ws + WS_GIDX), (float*)(ws + WS_GGATE), (LAS unsigned*)lds, U & 127, h); }
        for (int tok = vb * 8 + wave; tok < T; tok += G * 8) hq_token((const bf16_t*)(ws + WS_X2B) + (size_t)tok * DM, (const float*)(ws + WS_SSQ2) + (size_t)tok * 16, (unsigned char*)(ws + WS_HQ) + (size_t)tok * 1024, (float*)(ws + WS_SH) + tok, lane); }
    SEAM(8);
    if (IN(9) || IN(11)) {
        if (tid == 0) {
            unsigned nloc_ = 0, nx_ = 0; xcd_barrier_complete(bar.bar, bar.x, nloc_, nx_);
            unsigned cj[8], tot = 0; bool all = true;
#pragma unroll
            for (int j = 0; j < 8; ++j) { cj[j] = xb_ld(&bar.bar[XB_XCNT(j)]); tot += cj[j]; all = all && cj[j] > 0u; }
            if (all && tot == (unsigned)G && bar.x < 8u) { MISC[4] = bar.x; MISC[5] = MISC[2]; MISC[6] = cj[bar.x & 7u]; }
            else { const unsigned sl_ = (unsigned)vb & 7u; MISC[4] = sl_; MISC[5] = (unsigned)vb >> 3; MISC[6] = ((unsigned)G - sl_ + 7u) >> 3; }
        }
        __syncthreads();
    }
    REP(9) if (IN(9)) slice_pass<0>(ws, a.out, (int)MISC[4], (int)MISC[5] * 8 + __builtin_amdgcn_readfirstlane(wave), (int)MISC[6] * 8, lane);
    SEAM(9);
    REP(10) if (IN(10)) for (int tok = vb * 8 + wave; tok < T; tok += G * 8)
        expert_w_token((const int*)(ws + WS_ACTP) + (size_t)tok * 512, (const unsigned short*)(ws + WS_GIDX) + (size_t)tok * 128, (const float*)(ws + WS_GGATE) + (size_t)tok * 128, ((const float*)(ws + WS_SH))[tok],
                       (const float*)(ws + WS_SU), (const float*)(ws + WS_SV), (unsigned char*)(ws + WS_WX) + (size_t)tok * 128, (float*)(ws + WS_SW) + tok, lane);
    SEAM(10);
    REP(11) if (IN(11)) slice_pass<1>(ws, a.out, (int)MISC[4], (int)MISC[5] * 8 + __builtin_amdgcn_readfirstlane(wave), (int)MISC[6] * 8, lane);
    SEAM(11);
    REP(12) if (IN(12)) for (int tok = vb * 8 + wave; tok < T; tok += G * 8) final_norm_token(a.out + (size_t)tok * DM, (const float*)(ws + WS_SSQ3) + (size_t)tok * 8, a.in[14], lane);
#undef IN
#undef SEAM
}

extern "C" void kernel_launch(void* const* d_in, const int* in_sizes, int n_in, void* d_out, int out_size, void* d_ws, size_t ws_size, hipStream_t stream) {
    static int grid = 0;
    if (grid == 0) {
        if (n_in != 15 || in_sizes[0] != T * DM || out_size != T * DM || ws_size < WS_END) { fprintf(stderr, "kernel_launch: unexpected shapes (n_in %d, in0 %d, out %d, ws %zu)\n", n_in, n_in > 0 ? in_sizes[0] : -1, out_size, ws_size); grid = -1; return; }
        int dev = 0, cus = 0, per_cu = 0;
        hipGetDevice(&dev); hipDeviceGetAttribute(&cus, hipDeviceAttributeMultiprocessorCount, dev);
        if (hipFuncSetAttribute((const void*)mk_fwd, hipFuncAttributeMaxDynamicSharedMemorySize, LDS_BYTES) != hipSuccess) { fprintf(stderr, "kernel_launch: hipFuncSetAttribute failed\n"); grid = -1; return; }
        if (hipOccupancyMaxActiveBlocksPerMultiprocessor(&per_cu, (const void*)mk_fwd, NTHR, LDS_BYTES) != hipSuccess || per_cu < 1) { fprintf(stderr, "kernel_launch: occupancy query says %d blocks per CU\n", per_cu); per_cu = 1; }
        (void)hipGetLastError();
        grid = cus;
    }
    if (grid < 0) return;
    if (hipMemsetAsync(d_ws, 0, 256 * 1024, stream) != hipSuccess) { fprintf(stderr, "kernel_launch: hipMemsetAsync failed\n"); return; }
    Args a{};
    for (int i = 0; i < 15; ++i) a.in[i] = (const float*)d_in[i];
    a.out = (float*)d_out; a.ws = (unsigned char*)d_ws;
#if MK_FUSED
    a.ph_lo = 0; a.ph_hi = N_PHASES;
    { void* args[] = {&a}; hipError_t e = hipLaunchCooperativeKernel((const void*)mk_fwd, dim3(grid), dim3(NTHR), args, LDS_BYTES, stream);
      if (e != hipSuccess) fprintf(stderr, "kernel_launch: cooperative launch failed: %s (grid %d)\n", hipGetErrorString(e), grid); }
#else
    for (int p = 0; p < N_PHASES; ++p) { a.ph_lo = p; a.ph_hi = p + 1; void* args[] = {&a};
        hipError_t e = hipLaunchCooperativeKernel((const void*)mk_fwd, dim3(grid), dim3(NTHR), args, LDS_BYTES, stream);
        if (e != hipSuccess) { fprintf(stderr, "kernel_launch: launch of phase %d failed: %s (grid %d)\n", p, hipGetErrorString(e), grid); break; } }
#endif
}
```

```cpp
#include <hip/hip_runtime.h>
#include <hip/hip_cooperative_groups.h>
#include <cstdio>
#include <cstdint>
namespace cg = cooperative_groups;
namespace pg8 {
#define PG8_LAS __attribute__((address_space(3)))
typedef unsigned short bf16_t;
typedef short bf16x8 __attribute__((ext_vector_type(8)));
typedef float f32x4 __attribute__((ext_vector_type(4)));
typedef unsigned u32x4 __attribute__((ext_vector_type(4)));
constexpr int BM = 256, BK = 64, HALF = 128, HTB = HALF * BK * 2  , STAGE_BYTES = 8 * HTB, NXCD = 8, WGM = 8;

__host__ __device__ __forceinline__ int lds_byte(int r, int c) { const int st = (r >> 4) * 2 + (c >> 5), rr = r & 15, cc = c & 31, ob = rr * 64 + cc * 2; return st * 1024 + (ob ^ (((ob >> 9) & 1) << 5)); }
__host__ __device__ __forceinline__ void stage_rc(int b, int& R, int& C) { const int st = b / 1024, sb = b % 1024, swz = sb ^ (((sb >> 9) & 1) << 5); R = (st >> 1) * 16 + swz / 64; C = (st & 1) * 32 + (swz % 64) / 2; }
__host__ __device__ __forceinline__ int perm32(int rho) { const int n = rho >> 4, i = rho & 15; return 8 * (i >> 2) + 4 * n + (i & 3); }

struct Unit { int pm, pn; };
struct Gemm { const bf16_t* A; const bf16_t* Bt; int M, N, K; };

struct StaticOrder {
    int nM, nN, nwg, G, c;
    __host__ __device__ void init(int M, int N, int G_, int c_) { nM = M / BM; nN = N / BM; nwg = nM * nN; G = G_; c = c_; }
    __host__ __device__ bool next(int i, Unit& u) const {
        const long L = (long)i * G + c; if (L >= nwg) return false;
        int wgid = (int)L; { const int q = nwg / NXCD, r = nwg % NXCD, xcd = wgid % NXCD, off = wgid / NXCD; wgid = (xcd < r ? xcd * (q + 1) : r * (q + 1) + (xcd - r) * q) + off; }
        const int nig = WGM * nN, gid = wgid / nig, fm = gid * WGM, gsz = (nM - fm) < WGM ? (nM - fm) : WGM;
        u.pm = fm + ((wgid % nig) % gsz); u.pn = (wgid % nig) / gsz; return true;
    }
    __device__ __forceinline__ void a_ready(const Unit&) const {}
    __device__ __forceinline__ void done(const Unit&) const {}
};

__device__ __forceinline__ unsigned cvt_pk_bf16(float lo, float hi) { unsigned r; asm volatile("v_cvt_pk_bf16_f32 %0, %1, %2" : "=v"(r) : "v"(lo), "v"(hi)); return r; }

template <class Epi, class Sched, bool ALIGN_EPI = false, bool SP2 = false>
__device__ __forceinline__ void gemm_phase(PG8_LAS unsigned char* lds, const Gemm g, const Sched& S, const Epi& E) {
    int tid_ = threadIdx.x; asm volatile("" : "+v"(tid_));
    const int tid = tid_, wid = __builtin_amdgcn_readfirstlane(tid >> 6), lane = tid & 63, wr = wid >> 2, wc = wid & 3, fr = lane & 15, fq = lane >> 4;
    const int K = g.K, nt = K / BK;
    unsigned voffA[2], voffB[2];
#pragma unroll
    for (int i = 0; i < 2; ++i) { int R, C; stage_rc(tid * 16 + i * 8192, R, C); const int Rb = Epi::PERM ? ((R & ~31) + perm32(R & 31)) : R;
        voffA[i] = (unsigned)(R * K + C) * 2u; voffB[i] = (unsigned)(Rb * K + C) * 2u; }
    const size_t kstep = (size_t)(BK * 2);
    const size_t hstep = (size_t)HALF * K * 2;
    const size_t tstep = 2 * hstep;
    const unsigned ldsw = (unsigned)wid * 1024u;
    const int aoff = lds_byte(wr * 64 + fr, fq * 8), boff = lds_byte(wc * 32 + fr, fq * 8);
#define PG8_SA(b, h) (((b) * 2 + (h)) * HTB)
#define PG8_SB(b, h) ((4 + (b) * 2 + (h)) * HTB)
#define PG8_STAGE(bufoff, gbase, voff) do { _Pragma("unroll") for (int _i = 0; _i < 2; ++_i) \
        __builtin_amdgcn_global_load_lds((const unsigned*)((const char*)(gbase) + (voff)[_i]), (PG8_LAS unsigned*)(lds + (bufoff) + ldsw + _i * 8192), 16, 0, 0); } while (0)
#define PG8_LDA(dst, b, h) do { _Pragma("unroll") for (int m = 0; m < 4; ++m) _Pragma("unroll") for (int k = 0; k < 2; ++k) dst[m][k] = *(const PG8_LAS bf16x8*)(lds + PG8_SA(b, h) + aoff + m * 2048 + k * 1024); } while (0)
#define PG8_LDB(dst, b, h) do { _Pragma("unroll") for (int n = 0; n < 2; ++n) _Pragma("unroll") for (int k = 0; k < 2; ++k) dst[n][k] = *(const PG8_LAS bf16x8*)(lds + PG8_SB(b, h) + boff + n * 2048 + k * 1024); } while (0)
#define PG8_MMA(ai, bj, At, Bt) do { __builtin_amdgcn_s_setprio(1); _Pragma("unroll") for (int m = 0; m < 4; ++m) _Pragma("unroll") for (int n = 0; n < 2; ++n) _Pragma("unroll") for (int k = 0; k < 2; ++k) \
        acc[ai][bj][m][n] = __builtin_amdgcn_mfma_f32_16x16x32_bf16(Bt[n][k], At[m][k], acc[ai][bj][m][n], 0, 0, 0); __builtin_amdgcn_s_setprio(0); } while (0)
#define PG8_WAIT_V(n) asm volatile("s_waitcnt vmcnt(" #n ")" ::: "memory")
#define PG8_WAIT_L(n) asm volatile("s_waitcnt lgkmcnt(" #n ")" ::: "memory")
#define PG8_BAR __builtin_amdgcn_s_barrier()
#define PG8_SCHED __builtin_amdgcn_sched_barrier(0)
    Unit cur, nxt; int ui = 0;
    if (!S.next(0, cur)) return;
    f32x4 acc[2][2][4][2];
#pragma unroll
    for (int a = 0; a < 2; ++a)
#pragma unroll
        for (int b = 0; b < 2; ++b)
#pragma unroll
            for (int m = 0; m < 4; ++m)
#pragma unroll
                for (int n = 0; n < 2; ++n) acc[a][b][m][n] = (f32x4){0.f, 0.f, 0.f, 0.f};
    bf16x8 At[4][2], B0[2][2], B1[2][2];
    const char* cA = (const char*)g.A + (size_t)cur.pm * tstep; const char* cB = (const char*)g.Bt + (size_t)cur.pn * tstep;
    S.a_ready(cur);
    if constexpr (SP2) {
        PG8_STAGE(PG8_SB(0, 0), cB, voffB); PG8_STAGE(PG8_SB(0, 1), cB + hstep, voffB); PG8_STAGE(PG8_SA(0, 0), cA, voffA); PG8_STAGE(PG8_SA(0, 1), cA + hstep, voffA);
        if (wr == 1) PG8_BAR;
        PG8_WAIT_V(2); PG8_BAR;
        PG8_STAGE(PG8_SB(1, 0), cB + kstep, voffB); PG8_STAGE(PG8_SA(1, 0), cA + kstep, voffA); PG8_STAGE(PG8_SB(1, 1), cB + hstep + kstep, voffB);
        PG8_WAIT_V(6); PG8_BAR;
    } else {
        PG8_STAGE(PG8_SB(0, 0), cB, voffB); PG8_STAGE(PG8_SA(0, 0), cA, voffA); PG8_STAGE(PG8_SB(0, 1), cB + hstep, voffB); PG8_STAGE(PG8_SA(0, 1), cA + hstep, voffA);
        if (wr == 1) PG8_BAR;
        PG8_WAIT_V(4); PG8_BAR;
        PG8_STAGE(PG8_SB(1, 0), cB + kstep, voffB); PG8_STAGE(PG8_SA(1, 0), cA + kstep, voffA); PG8_STAGE(PG8_SB(1, 1), cB + hstep + kstep, voffB);
        PG8_WAIT_V(6); PG8_BAR;
    }
    for (;;) {
        const bool has_next = S.next(ui + 1, nxt);
        const char* nA = has_next ? (const char*)g.A + (size_t)nxt.pm * tstep : cA; const char* nB = has_next ? (const char*)g.Bt + (size_t)nxt.pn * tstep : cB;
        for (int t = 0; t < nt; t += 2) {
            const bool last = (t == nt - 2);
            const char* a1 = cA + (size_t)(t + 1) * kstep;
            const char* a2 = last ? nA : cA + (size_t)(t + 2) * kstep; const char* b2 = last ? nB : cB + (size_t)(t + 2) * kstep;
            const char* a3 = a2 + kstep; const char* b3 = b2 + kstep;
            if (last && has_next) S.a_ready(nxt);
            if constexpr (SP2) {
            PG8_LDB(B0, 0, 0); PG8_LDB(B1, 0, 1); PG8_SCHED; PG8_LDA(At, 0, 0); PG8_STAGE(PG8_SA(1, 1), a1 + hstep, voffA);
            PG8_WAIT_V(8); PG8_WAIT_L(0); PG8_BAR; PG8_MMA(0, 0, At, B0); PG8_MMA(0, 1, At, B1); PG8_BAR; PG8_SCHED;
            PG8_LDA(At, 0, 1); PG8_STAGE(PG8_SB(0, 0), b2, voffB); PG8_STAGE(PG8_SB(0, 1), b2 + hstep, voffB); PG8_STAGE(PG8_SA(0, 0), a2, voffA);
            PG8_WAIT_V(8); PG8_WAIT_L(0); PG8_BAR; PG8_MMA(1, 0, At, B0); PG8_MMA(1, 1, At, B1); PG8_BAR; PG8_SCHED;
            PG8_LDB(B0, 1, 0); PG8_LDB(B1, 1, 1); PG8_SCHED; PG8_LDA(At, 1, 0); PG8_STAGE(PG8_SA(0, 1), a2 + hstep, voffA);
            PG8_WAIT_V(8); PG8_WAIT_L(0); PG8_BAR; PG8_MMA(0, 0, At, B0); PG8_MMA(0, 1, At, B1); PG8_BAR; PG8_SCHED;
            PG8_LDA(At, 1, 1); PG8_STAGE(PG8_SB(1, 0), b3, voffB); PG8_STAGE(PG8_SB(1, 1), b3 + hstep, voffB); PG8_STAGE(PG8_SA(1, 0), a3, voffA);
            PG8_WAIT_V(8); PG8_WAIT_L(0); PG8_BAR; PG8_MMA(1, 0, At, B0); PG8_MMA(1, 1, At, B1); PG8_BAR; PG8_SCHED;
            } else {
            PG8_LDB(B0, 0, 0); PG8_SCHED; PG8_LDA(At, 0, 0); PG8_STAGE(PG8_SA(1, 1), a1 + hstep, voffA);
            PG8_WAIT_L(8); PG8_BAR; PG8_WAIT_L(0); PG8_MMA(0, 0, At, B0); PG8_BAR; PG8_SCHED;
            PG8_LDB(B1, 0, 1); PG8_STAGE(PG8_SB(0, 0), b2, voffB);
            PG8_BAR; PG8_WAIT_L(0); PG8_MMA(0, 1, At, B1); PG8_BAR;
            PG8_LDA(At, 0, 1); PG8_STAGE(PG8_SA(0, 0), a2, voffA);
            PG8_BAR; PG8_WAIT_L(0); PG8_MMA(1, 0, At, B0); PG8_BAR; PG8_SCHED;
            PG8_STAGE(PG8_SB(0, 1), b2 + hstep, voffB);
            PG8_WAIT_V(6); PG8_BAR; PG8_MMA(1, 1, At, B1); PG8_BAR;
            PG8_LDB(B0, 1, 0); PG8_SCHED; PG8_LDA(At, 1, 0); PG8_STAGE(PG8_SA(0, 1), a2 + hstep, voffA);
            PG8_WAIT_L(8); PG8_BAR; PG8_WAIT_L(0); PG8_MMA(0, 0, At, B0); PG8_BAR; PG8_SCHED;
            PG8_LDB(B1, 1, 1); PG8_STAGE(PG8_SB(1, 0), b3, voffB);
            PG8_BAR; PG8_WAIT_L(0); PG8_MMA(0, 1, At, B1); PG8_BAR;
            PG8_LDA(At, 1, 1); PG8_STAGE(PG8_SA(1, 0), a3, voffA);
            PG8_BAR; PG8_WAIT_L(0); PG8_MMA(1, 0, At, B0); PG8_BAR; PG8_SCHED;
            PG8_STAGE(PG8_SB(1, 1), b3 + hstep, voffB);
            PG8_WAIT_V(6); PG8_BAR; PG8_MMA(1, 1, At, B1); PG8_BAR;
            }
        }
        if constexpr (ALIGN_EPI) { if (wr == 0) PG8_BAR; }
        if constexpr (!Epi::AFTER_DRAIN) { E(acc, cur, wr, wc, fr, fq); S.done(cur); }
        if (!has_next) break;
#pragma unroll
        for (int a = 0; a < 2; ++a)
#pragma unroll
            for (int b = 0; b < 2; ++b)
#pragma unroll
                for (int m = 0; m < 4; ++m)
#pragma unroll
                    for (int n = 0; n < 2; ++n) acc[a][b][m][n] = (f32x4){0.f, 0.f, 0.f, 0.f};
        cur = nxt; cA = nA; cB = nB; ++ui;
        if constexpr (ALIGN_EPI) { if (wr == 1) PG8_BAR; }
    }
    PG8_WAIT_V(0);
    if constexpr (!ALIGN_EPI) { if (wr == 0) PG8_BAR; }
    PG8_BAR;
    if constexpr (Epi::AFTER_DRAIN) { E.fused(acc, cur, wr, wc, fr, fq, lds, wid, lane); S.done(cur); }
#undef PG8_SA
#undef PG8_SB
#undef PG8_STAGE
#undef PG8_LDA
#undef PG8_LDB
#undef PG8_MMA
#undef PG8_WAIT_V
#undef PG8_WAIT_L
#undef PG8_BAR
#undef PG8_SCHED
}
}

#ifndef MK_FUSED
#define MK_FUSED 1
#endif
#define DI __device__ __forceinline__
#define LAS __attribute__((address_space(3)))
typedef unsigned short bf16_t;
typedef float f32x4 __attribute__((ext_vector_type(4)));
typedef float f32x2 __attribute__((ext_vector_type(2)));
typedef float f32x16 __attribute__((ext_vector_type(16)));
typedef unsigned u32x4 __attribute__((ext_vector_type(4)));
typedef unsigned u32x2 __attribute__((ext_vector_type(2)));
typedef short bf16x8 __attribute__((ext_vector_type(8)));
typedef _Float16 h16x2 __attribute__((ext_vector_type(2)));
typedef _Float16 h16x8 __attribute__((ext_vector_type(8)));

constexpr int BATCH = 16, SEQ = 4096, T = BATCH * SEQ, DM = 1024, NIN = 4864;
constexpr int C_AQ = 0, C_AK = 512, C_AV = 640, C_HQ = 768, C_HF = 1280, C_HI = 1792, C_HG = 2304, C_GA = 2816, C_GH = 3840;
constexpr float EPS = 1e-6f;
constexpr int NTHR = 512;
constexpr int LDS_BYTES = 163840;

constexpr size_t MiB = 1u << 20;
constexpr size_t WS_W1T = 1 * MiB;
constexpr size_t WS_WAPT = 11 * MiB;
constexpr size_t WS_WHPT = 12 * MiB;
constexpr size_t WS_WOUTT = 13 * MiB;
constexpr size_t WS_WQT = 15 * MiB;
constexpr size_t WS_KEYS = 19 * MiB;
constexpr size_t WS_LB = 19 * MiB + 512 * 1024;
constexpr size_t WS_RSTD1 = 20 * MiB;
constexpr size_t WS_SSQ2 = 21 * MiB;
constexpr size_t WS_U8 = 26 * MiB;
constexpr size_t WS_V8 = 42 * MiB;
constexpr size_t WS_SU = 58 * MiB;
constexpr size_t WS_SV = 58 * MiB + 65536;
constexpr size_t WS_DEC = 60 * MiB;
constexpr size_t WS_AVT = 64 * MiB;
constexpr size_t WS_XB = 90 * MiB;
constexpr size_t WS_PA = 218 * MiB;
constexpr size_t WS_GG = 314 * MiB;
constexpr size_t WS_QD = 570 * MiB;
constexpr size_t WS_KINV = 634 * MiB;
constexpr size_t WS_KENDT = 698 * MiB;
constexpr size_t WS_VT = 762 * MiB;
constexpr size_t WS_GS = 826 * MiB;
constexpr size_t WS_YA = 890 * MiB;
constexpr size_t WS_YH = 954 * MiB;
constexpr size_t WS_END = 1018 * MiB;
constexpr size_t WS_HQ = 698 * MiB;
constexpr size_t WS_WX = 762 * MiB;
constexpr size_t WS_SH = 60 * MiB;
constexpr size_t WS_SSQ3 = 64 * MiB;
constexpr size_t WS_SW = 61 * MiB;
constexpr size_t WS_ACTP = 346 * MiB;
constexpr size_t WS_X2B = 218 * MiB;
constexpr size_t WS_QP = 346 * MiB;
constexpr size_t WS_GIDX = 602 * MiB;
constexpr size_t WS_GGATE = 618 * MiB;

struct Args { const float* in[15]; float* out; unsigned char* ws; int ph_lo, ph_hi; };

DI unsigned pk_bf16(float lo, float hi) { typedef __bf16 b2 __attribute__((ext_vector_type(2))); f32x2 v = {lo, hi}; b2 b = __builtin_convertvector(v, b2); return __builtin_bit_cast(unsigned, b); }
DI float bflo(unsigned w) { return __uint_as_float(w << 16); }
DI float bfhi(unsigned w) { return __uint_as_float(w & 0xffff0000u); }
DI float sigm(float x) { return __builtin_amdgcn_rcpf(1.f + __expf(-x)); }
DI float wave_sum(float v) {
    v += __int_as_float(__builtin_amdgcn_mov_dpp(__float_as_int(v), 0xB1, 0xf, 0xf, true));
    v += __int_as_float(__builtin_amdgcn_mov_dpp(__float_as_int(v), 0x4E, 0xf, 0xf, true));
    v += __int_as_float(__builtin_amdgcn_mov_dpp(__float_as_int(v), 0x141, 0xf, 0xf, true));
    v += __int_as_float(__builtin_amdgcn_mov_dpp(__float_as_int(v), 0x128, 0xf, 0xf, true));
    { const auto r = __builtin_amdgcn_permlane16_swap(__float_as_uint(v), __float_as_uint(v), false, false); v = __uint_as_float(r[0]) + __uint_as_float(r[1]); }
    { const auto r = __builtin_amdgcn_permlane32_swap(__float_as_uint(v), __float_as_uint(v), false, false); v = __uint_as_float(r[0]) + __uint_as_float(r[1]); }
    return v;
}
DI unsigned short bf16_1(float x) { return (unsigned short)(pk_bf16(x, 0.f) & 0xffffu); }
template <int N> DI float dpp_row_shr(float v) { return __int_as_float(__builtin_amdgcn_update_dpp(0, __float_as_int(v), 0x110 + N, 0xf, 0xf, true)); }
DI float rowsum16(float v) { v += __int_as_float(__builtin_amdgcn_mov_dpp(__float_as_int(v), 0xB1, 0xf, 0xf, true)); v += __int_as_float(__builtin_amdgcn_mov_dpp(__float_as_int(v), 0x4E, 0xf, 0xf, true));
    v += __int_as_float(__builtin_amdgcn_mov_dpp(__float_as_int(v), 0x141, 0xf, 0xf, true)); v += __int_as_float(__builtin_amdgcn_mov_dpp(__float_as_int(v), 0x128, 0xf, 0xf, true)); return v; }
DI float scan16(float v) { v += dpp_row_shr<1>(v); v += dpp_row_shr<2>(v); v += dpp_row_shr<4>(v); v += dpp_row_shr<8>(v); return v; }
DI int crow(int reg, int hh) { return (reg & 3) + 8 * (reg >> 2) + 4 * hh; }
#define MFMA32(a, b, c) __builtin_amdgcn_mfma_f32_32x32x16_bf16((a), (b), (c), 0, 0, 0)
#define LDS_WAIT() asm volatile("s_waitcnt lgkmcnt(0)" ::: "memory")

namespace pg8 {
#define TSTORE_WRITE(sl, e, m, x) *(PG8_LAS bf16_t*)((sl) + (4 * fq + (e)) * 144 + (16 * (m) + fr) * 2) = bf16_1(x)
struct Epi1 {
    static constexpr bool PERM = true, AFTER_DRAIN = false;
    const float* rs; bf16_t* pa; bf16_t* gg; bf16_t* qd; bf16_t* kinv; bf16_t* kendT; bf16_t* vT; bf16_t* gs; float* dec; const float* lb; bf16_t* avT; PG8_LAS unsigned char* xl;
    __device__ __forceinline__ void operator()(const f32x4 (&acc)[2][2][4][2], const Unit& u, int wr, int wc, int fr, int fq) const {
        asm volatile("" : "+v"(fr), "+v"(fq));
        const int row0 = u.pm * BM + wr * 64 + fr, pn = u.pn;
        if (pn == 2) {
            const int c8 = wc * 32 + 8 * fq, tseqb = (u.pm & 15) * 256 + wr * 64 + fr, bb = u.pm >> 4;
#pragma unroll
            for (int ai = 0; ai < 2; ++ai)
#pragma unroll
                for (int m = 0; m < 4; ++m) { const int row = row0 + ai * HALF + m * 16; const float s = rs[row];
                    const f32x4 v0 = acc[ai][0][m][0] * s, v1 = acc[ai][0][m][1] * s;
                    u32x4 w; w.x = pk_bf16(v0[0], v0[1]); w.y = pk_bf16(v0[2], v0[3]); w.z = pk_bf16(v1[0], v1[1]); w.w = pk_bf16(v1[2], v1[3]);
                    *(u32x4*)(pa + (size_t)row * 768 + 512 + c8) = w;
                }
            PG8_LAS unsigned char* sl = xl + (wr * 4 + wc) * 2304; const int lane_ = fq * 16 + fr;
#pragma unroll
            for (int ai = 0; ai < 2; ++ai)
#pragma unroll
                for (int n = 0; n < 2; ++n) {
#pragma unroll
                    for (int m = 0; m < 4; ++m) { const float s = rs[row0 + ai * HALF + m * 16];
#pragma unroll
                        for (int e = 0; e < 4; ++e) TSTORE_WRITE(sl, e, m, acc[ai][1][m][n][e] * s); }
                    asm volatile("s_waitcnt lgkmcnt(0)" ::: "memory");
#pragma unroll
                    for (int q = 0; q < 2; ++q) { const int c = lane_ + 64 * q, rw = c >> 3, tc = c & 7, col = wc * 32 + 8 * (rw >> 2) + 4 * n + (rw & 3);
                        const u32x4 w = *(const PG8_LAS u32x4*)(sl + rw * 144 + tc * 16);
                        *(u32x4*)(avT + (size_t)((bb * 2 + (col >> 6)) * 64 + (col & 63)) * SEQ + (u.pm & 15) * 256 + ai * HALF + wr * 64 + 8 * tc) = w; }
                    asm volatile("s_waitcnt lgkmcnt(0)" ::: "memory");
                }
            return;
        }
        if (pn < 3 || pn >= 11) {
            bf16_t* O; int ldc, colt;
            if (pn < 3) { O = pa; ldc = 768; colt = pn * 256; } else { O = gg; ldc = 2048; colt = (pn - 11) * 256; }
            const int col0 = colt + wc * 32 + 8 * fq;
#pragma unroll
            for (int ai = 0; ai < 2; ++ai)
#pragma unroll
                for (int m = 0; m < 4; ++m) { const int row = row0 + ai * HALF + m * 16; const float s = rs[row]; bf16_t* rowp = O + (size_t)row * ldc + col0;
#pragma unroll
                    for (int bj = 0; bj < 2; ++bj) { const f32x4 v0 = acc[ai][bj][m][0] * s, v1 = acc[ai][bj][m][1] * s;
                        u32x4 w; w.x = pk_bf16(v0[0], v0[1]); w.y = pk_bf16(v0[2], v0[3]); w.z = pk_bf16(v1[0], v1[1]); w.w = pk_bf16(v1[2], v1[3]);
                        *(u32x4*)(rowp + bj * HALF) = w; } }
            return;
        }
        PG8_LAS unsigned char* sl = xl + (wr * 4 + wc) * 2304; const int lane_ = fq * 16 + fr;
        const int h = (pn - 3) & 3, c8 = wc * 32 + 8 * fq, bh = (u.pm >> 4) * 4 + h;
        if (pn < 7) {
#pragma unroll
            for (int ai = 0; ai < 2; ++ai)
#pragma unroll
                for (int m = 0; m < 4; ++m) { const int row = row0 + ai * HALF + m * 16; const float s = rs[row]; const size_t o = (size_t)row * 512 + h * 128 + c8;
#pragma unroll
                    for (int bj = 0; bj < 2; ++bj) { const f32x4 v0 = acc[ai][bj][m][0] * s, v1 = acc[ai][bj][m][1] * s;
                        u32x4 w; w.x = pk_bf16(v0[0], v0[1]); w.y = pk_bf16(v0[2], v0[3]); w.z = pk_bf16(v1[0], v1[1]); w.w = pk_bf16(v1[2], v1[3]);
                        *(u32x4*)((bj ? kinv : qd) + o) = w; } }
        } else {
#pragma unroll
            for (int ai = 0; ai < 2; ++ai) {
                const int tseq0 = (u.pm & 15) * 256 + ai * HALF + wr * 64;
#pragma unroll
                for (int n = 0; n < 2; ++n) {
#pragma unroll
                    for (int m = 0; m < 4; ++m) { const float s = rs[row0 + ai * HALF + m * 16];
#pragma unroll
                        for (int e = 0; e < 4; ++e) TSTORE_WRITE(sl, e, m, acc[ai][0][m][n][e] * s); }
                    asm volatile("s_waitcnt lgkmcnt(0)" ::: "memory");
#pragma unroll
                    for (int q = 0; q < 2; ++q) { const int c = lane_ + 64 * q, rw = c >> 3, tc = c & 7, dvr = wc * 32 + 8 * (rw >> 2) + 4 * n + (rw & 3);
                        const u32x4 w = *(const PG8_LAS u32x4*)(sl + rw * 144 + tc * 16);
                        *(u32x4*)(vT + (size_t)(bh * 128 + dvr) * SEQ + tseq0 + 8 * tc) = w; }
                    asm volatile("s_waitcnt lgkmcnt(0)" ::: "memory");
                }
#pragma unroll
                for (int m = 0; m < 4; ++m) { const int row = row0 + ai * HALF + m * 16; const float s = rs[row];
                    f32x4 g0 = acc[ai][1][m][0] * s, g1 = acc[ai][1][m][1] * s;
#pragma unroll
                    for (int e = 0; e < 4; ++e) { g0[e] *= sigm(g0[e]); g1[e] *= sigm(g1[e]); }
                    u32x4 w; w.x = pk_bf16(g0[0], g0[1]); w.y = pk_bf16(g0[2], g0[3]); w.z = pk_bf16(g1[0], g1[1]); w.w = pk_bf16(g1[2], g1[3]);
                    *(u32x4*)(gs + (size_t)row * 512 + h * 128 + c8) = w; }
            }
        }
    }
};
struct EpiDummy {
    static constexpr bool PERM = true, AFTER_DRAIN = false;
    bf16_t* O; const float* rs;
    __device__ __forceinline__ void operator()(const f32x4 (&acc)[2][2][4][2], const Unit& u, int wr, int wc, int fr, int fq) const {
        asm volatile("" : "+v"(fr), "+v"(fq));
        const int row0 = wr * 64 + fr, col0 = wc * 32 + 8 * fq;
#pragma unroll
        for (int ai = 0; ai < 2; ++ai)
#pragma unroll
            for (int m = 0; m < 4; ++m) { const int row = row0 + ai * HALF + m * 16; const float s = rs[u.pm * BM + row]; bf16_t* rowp = O + (size_t)blockIdx.x * 65536 + (size_t)row * 256 + col0;
#pragma unroll
                for (int bj = 0; bj < 2; ++bj) { const f32x4 v0 = acc[ai][bj][m][0] * s, v1 = acc[ai][bj][m][1] * s;
                    u32x4 w; w.x = pk_bf16(v0[0], v0[1]); w.y = pk_bf16(v0[2], v0[3]); w.z = pk_bf16(v1[0], v1[1]); w.w = pk_bf16(v1[2], v1[3]);
                    *(u32x4*)(rowp + bj * HALF) = w; } }
    }
};
template <bool ADD> struct EpiMerge {
    static constexpr bool PERM = true, AFTER_DRAIN = false;
    bf16_t* O; const bf16_t* gate;
    __device__ __forceinline__ void operator()(const f32x4 (&acc)[2][2][4][2], const Unit& u, int wr, int wc, int fr, int fq) const {
        const int row0 = u.pm * BM + wr * 64 + fr, col0 = u.pn * BM + wc * 32 + 8 * fq;
#pragma unroll
        for (int ai = 0; ai < 2; ++ai)
#pragma unroll
            for (int m = 0; m < 4; ++m) { const int row = row0 + ai * HALF + m * 16; bf16_t* rowp = O + (size_t)row * DM + col0; const bf16_t* gp = gate + (size_t)row * 2048 + col0;
#pragma unroll
                for (int bj = 0; bj < 2; ++bj) { const u32x4 g = *(const u32x4*)(gp + bj * HALF);
                    f32x4 v0 = acc[ai][bj][m][0], v1 = acc[ai][bj][m][1];
                    v0[0] *= sigm(bflo(g.x)); v0[1] *= sigm(bfhi(g.x)); v0[2] *= sigm(bflo(g.y)); v0[3] *= sigm(bfhi(g.y));
                    v1[0] *= sigm(bflo(g.z)); v1[1] *= sigm(bfhi(g.z)); v1[2] *= sigm(bflo(g.w)); v1[3] *= sigm(bfhi(g.w));
                    if (ADD) { const u32x4 o = *(const u32x4*)(rowp + bj * HALF);
                        v0[0] += bflo(o.x); v0[1] += bfhi(o.x); v0[2] += bflo(o.y); v0[3] += bfhi(o.y); v1[0] += bflo(o.z); v1[1] += bfhi(o.z); v1[2] += bflo(o.w); v1[3] += bfhi(o.w); }
                    u32x4 w; w.x = pk_bf16(v0[0], v0[1]); w.y = pk_bf16(v0[2], v0[3]); w.z = pk_bf16(v1[0], v1[1]); w.w = pk_bf16(v1[2], v1[3]);
                    *(u32x4*)(rowp + bj * HALF) = w; } }
    }
};
struct EpiX2 {
    static constexpr bool PERM = true, AFTER_DRAIN = false;
    const float* X; bf16_t* X2B; float* ssq;
    __device__ __forceinline__ void operator()(const f32x4 (&acc)[2][2][4][2], const Unit& u, int wr, int wc, int fr, int fq) const {
        const int row0 = u.pm * BM + wr * 64 + fr, col0 = u.pn * BM + wc * 32 + 8 * fq;
#pragma unroll
        for (int ai = 0; ai < 2; ++ai)
#pragma unroll
            for (int m = 0; m < 4; ++m) { const int row = row0 + ai * HALF + m * 16; const size_t off = (size_t)row * DM + col0; float ss = 0.f;
#pragma unroll
                for (int bj = 0; bj < 2; ++bj) { const f32x4 x0 = *(const f32x4*)(X + off + bj * HALF), x1 = *(const f32x4*)(X + off + bj * HALF + 4);
                    const f32x4 v0 = acc[ai][bj][m][0] + x0, v1 = acc[ai][bj][m][1] + x1;
                    u32x4 w; w.x = pk_bf16(v0[0], v0[1]); w.y = pk_bf16(v0[2], v0[3]); w.z = pk_bf16(v1[0], v1[1]); w.w = pk_bf16(v1[2], v1[3]);
                    *(u32x4*)(X2B + off + bj * HALF) = w;
                    ss += (v0[0] * v0[0] + v0[1] * v0[1]) + (v0[2] * v0[2] + v0[3] * v0[3]) + (v1[0] * v1[0] + v1[1] * v1[1]) + (v1[2] * v1[2] + v1[3] * v1[3]); }
                ss += __shfl_xor(ss, 16); ss += __shfl_xor(ss, 32);
                if (fq == 0) ssq[(size_t)row * 16 + u.pn * 4 + wc] = ss; }
    }
};
struct EpiQp {
    static constexpr bool PERM = true, AFTER_DRAIN = false;
    bf16_t* O; const float* ssq;
    __device__ __forceinline__ void operator()(const f32x4 (&acc)[2][2][4][2], const Unit& u, int wr, int wc, int fr, int fq) const {
        const int row0 = u.pm * BM + wr * 64 + fr, col0 = u.pn * BM + wc * 32 + 8 * fq;
#pragma unroll
        for (int ai = 0; ai < 2; ++ai)
#pragma unroll
            for (int m = 0; m < 4; ++m) { const int row = row0 + ai * HALF + m * 16; const f32x4* sp = (const f32x4*)(ssq + (size_t)row * 16);
                const f32x4 a = sp[0], b = sp[1], c = sp[2], d = sp[3];
                const float tot = ((a[0] + a[1]) + (a[2] + a[3])) + ((b[0] + b[1]) + (b[2] + b[3])) + ((c[0] + c[1]) + (c[2] + c[3])) + ((d[0] + d[1]) + (d[2] + d[3]));
                const float s = __builtin_amdgcn_rsqf(tot * (1.f / 1024.f) + EPS); bf16_t* rowp = O + (size_t)row * 2048 + col0;
#pragma unroll
                for (int bj = 0; bj < 2; ++bj) { const f32x4 v0 = acc[ai][bj][m][0] * s, v1 = acc[ai][bj][m][1] * s;
                    u32x4 w; w.x = pk_bf16(v0[0], v0[1]); w.y = pk_bf16(v0[2], v0[3]); w.z = pk_bf16(v1[0], v1[1]); w.w = pk_bf16(v1[2], v1[3]);
                    *(u32x4*)(rowp + bj * HALF) = w; } }
    }
};
}

DI int w1_src_col(int n) {
    if (n < 768 || n >= 2816) return n;
    if (n < 1792) { const int h = (n - 768) >> 8, r = (n - 768) & 255; return r < 128 ? C_HQ + 128 * h + r : C_HF + 128 * h + (r - 128); }
    const int h = (n - 1792) >> 8, r = (n - 1792) & 255; return r < 128 ? C_HI + 128 * h + r : C_HG + 128 * h + (r - 128);
}
template <bool PERMW1> DI void p0_transpose_item(const float* W, int K, int N, bf16_t* WT, const float* g, int gmask, LAS float* scr, int item, int lane) {
    const int nblk = N / 32, kb = item / nblk, nb = item % nblk, k0 = 64 * kb, n0 = 32 * nb, ns = PERMW1 ? w1_src_col(n0) : n0;
#pragma unroll 8
    for (int i = 0; i < 32; ++i) { const int kk = 2 * i + (lane >> 5); float w = W[(size_t)(k0 + kk) * N + ns + (lane & 31)]; if (g) w *= g[(k0 + kk) & gmask]; scr[kk * 33 + (lane & 31)] = w; }
    LDS_WAIT(); asm volatile("" ::: "memory");
    const int c = lane & 7;
#pragma unroll
    for (int j = 0; j < 4; ++j) { const int n = (lane >> 3) + 8 * j; const LAS float* s = scr + (8 * c) * 33 + n;
        u32x4 o; o.x = pk_bf16(s[0 * 33], s[1 * 33]); o.y = pk_bf16(s[2 * 33], s[3 * 33]); o.z = pk_bf16(s[4 * 33], s[5 * 33]); o.w = pk_bf16(s[6 * 33], s[7 * 33]);
        *(u32x4*)(WT + (size_t)(n0 + n) * K + k0 + 8 * c) = o; }
    LDS_WAIT(); asm volatile("" ::: "memory");
}
DI unsigned pk_f16(float a, float b) { h16x2 v = {(_Float16)a, (_Float16)b}; return __builtin_bit_cast(unsigned, v); }

DI void p0_prologue(const Args& a, LAS unsigned char* lds, int vb, int G) {
    const int tid = threadIdx.x, lane = tid & 63, wave = tid >> 6;
    const int gw = vb * 8 + wave, NGW = G * 8, gt = vb * NTHR + tid, NGT = G * NTHR;
    unsigned char* ws = a.ws;
    LAS float* scr = (LAS float*)(lds + wave * 16384);
    constexpr int I_W1 = 16 * 152, I_AP = 8 * 32, I_HP = 8 * 32, I_OUT = 16 * 32, I_Q = 16 * 64, NITEMS = I_W1 + I_AP + I_HP + I_OUT + I_Q;
    for (int it = gw; it < NITEMS; it += NGW) {
        int r = it;
        if (r < I_W1) { p0_transpose_item<true>(a.in[2], 1024, NIN, (bf16_t*)(ws + WS_W1T), a.in[1], 1023, scr, r, lane); continue; } r -= I_W1;
        if (r < I_AP) { p0_transpose_item<false>(a.in[6], 512, 1024, (bf16_t*)(ws + WS_WAPT), nullptr, 0, scr, r, lane); continue; } r -= I_AP;
        if (r < I_HP) { p0_transpose_item<false>(a.in[7], 512, 1024, (bf16_t*)(ws + WS_WHPT), a.in[5], 127, scr, r, lane); continue; } r -= I_HP;
        if (r < I_OUT) { p0_transpose_item<false>(a.in[8], 1024, 1024, (bf16_t*)(ws + WS_WOUTT), nullptr, 0, scr, r, lane); continue; } r -= I_OUT;
        p0_transpose_item<false>(a.in[10], 1024, 2048, (bf16_t*)(ws + WS_WQT), a.in[9], 1023, scr, r, lane);
    }
    for (int i = gt; i < 2 * 8 * 128 * 128 / 4; i += NGT) { const f32x4 v = ((const f32x4*)a.in[11])[i]; u32x2 o; o.x = pk_bf16(v[0], v[1]); o.y = pk_bf16(v[2], v[3]); ((u32x2*)(ws + WS_KEYS))[i] = o; }
    for (int it = gw; it < 2 * 16384; it += NGW) {
        const int isv = it >= 16384, e = it & 16383;
        const float* src = (isv ? a.in[13] : a.in[12]) + (size_t)e * 1024 + 16 * lane;
        f32x4 x[4]; float amax = 0.f;
#pragma unroll
        for (int i = 0; i < 4; ++i) { x[i] = *(const f32x4*)(src + 4 * i); if (!isv) x[i] *= *(const f32x4*)(a.in[9] + 16 * lane + 4 * i);
            amax = fmaxf(fmaxf(amax, fmaxf(fabsf(x[i][0]), fabsf(x[i][1]))), fmaxf(fabsf(x[i][2]), fabsf(x[i][3]))); }
#pragma unroll
        for (int o = 1; o < 64; o <<= 1) amax = fmaxf(amax, __shfl_xor(amax, o));
        const float qs = amax > 0.f ? 127.f / amax : 0.f; const int off = 0;
        u32x4 w;
#pragma unroll
        for (int i = 0; i < 4; ++i) { const int q0 = (int)rintf(x[i][0] * qs) + off, q1 = (int)rintf(x[i][1] * qs) + off, q2 = (int)rintf(x[i][2] * qs) + off, q3 = (int)rintf(x[i][3] * qs) + off;
            w[i] = (unsigned)(q0 & 255) | ((unsigned)(q1 & 255) << 8) | ((unsigned)(q2 & 255) << 16) | ((unsigned)(q3 & 255) << 24); }
        *(u32x4*)(ws + (isv ? WS_V8 : WS_U8) + (size_t)e * 1024 + 16 * lane) = w;
        if (lane == 0) ((float*)(ws + (isv ? WS_SV : WS_SU)))[e] = amax * (1.f / 127.f);
    }
    for (int row = gw; row < T; row += NGW) {
        const f32x4* xr = (const f32x4*)(a.in[0] + (size_t)row * DM) + lane; f32x4 v[4]; float s = 0.f;
#pragma unroll
        for (int j = 0; j < 4; ++j) { v[j] = xr[64 * j]; s += (v[j][0] * v[j][0] + v[j][1] * v[j][1]) + (v[j][2] * v[j][2] + v[j][3] * v[j][3]); }
        s = wave_sum(s);
        u32x2* o = (u32x2*)(ws + WS_XB + (size_t)row * DM * 2) + lane;
#pragma unroll
        for (int j = 0; j < 4; ++j) { u32x2 w; w.x = pk_bf16(v[j][0], v[j][1]); w.y = pk_bf16(v[j][2], v[j][3]); o[64 * j] = w; }
        if (lane == 0) ((float*)(ws + WS_RSTD1))[row] = __builtin_amdgcn_rsqf(s * (1.f / 1024.f) + EPS);
    }
    if (vb == 0) { const float l0 = a.in[4][tid], l1 = a.in[4][512 + tid]; ((float*)(ws + WS_LB))[tid] = 1.f / (1.f + __expf(l1 - l0)); }
}

constexpr int ATT_KS = 272, ATT_VS = 392, ATT_VOFF = 192 * ATT_KS;
DI void attn_unit(const bf16_t* pa, const bf16_t* avT, const float* sinks, bf16_t* ya, LAS unsigned char* lds, int b, int tt) {
    int tid_ = threadIdx.x; asm volatile("" : "+v"(tid_));
    const int tid = tid_, lane = tid & 63, h = __builtin_amdgcn_readfirstlane(tid >> 6), r = lane & 31, hh = lane >> 5, kvh = h >> 2;
    const int p0 = tt * 64 - 128;
    for (int c = tid; c < 192 * 16; c += NTHR) { const int row = c >> 4, ch = c & 15, pos = p0 + row; u32x4 w = {0u, 0u, 0u, 0u};
        if (pos >= 0) w = *(const u32x4*)(pa + ((size_t)b * SEQ + pos) * 768 + 512 + ch * 8);
        *(LAS u32x4*)(lds + row * ATT_KS + ch * 16) = w; }
    for (int c = tid; c < 128 * 24; c += NTHR) { const int row = c / 24, ch = c - row * 24, pos = p0 + ch * 8; u32x4 w = {0u, 0u, 0u, 0u};
        if (pos >= 0) w = *(const u32x4*)(avT + (size_t)(b * 128 + row) * SEQ + pos);
        LAS u32x2* d = (LAS u32x2*)(lds + ATT_VOFF + row * ATT_VS + ch * 16); d[0] = (u32x2){w.x, w.y}; d[1] = (u32x2){w.z, w.w}; }
    __syncthreads();
    constexpr float LOG2E = 1.4426950408889634f;
    const float slope2 = exp2f(-(float)(h + 1)) * LOG2E, sink2 = sinks[h] * LOG2E, qs = 0.125f * LOG2E;
#pragma unroll 1
    for (int qbl = 0; qbl < 2; ++qbl) {
        const int qb = tt * 2 + qbl; const size_t trow = (size_t)b * SEQ + qb * 32 + r;
        bf16x8 qf[4];
        { const bf16_t* qp = pa + trow * 768 + h * 64 + 8 * hh;
#pragma unroll
          for (int s = 0; s < 4; ++s) qf[s] = *(const bf16x8*)(qp + 16 * s); }
        f32x16 S[5]; float m = sink2;
#pragma unroll
        for (int i = 0; i < 5; ++i) { const int kb = qb - 4 + i;
            if (kb >= 0) {
#pragma unroll
                for (int q = 0; q < 16; ++q) S[i][q] = 0.f;
                const LAS unsigned char* kp = lds + (32 * (qbl + i) + r) * ATT_KS + kvh * 128 + 16 * hh;
#pragma unroll
                for (int s = 0; s < 4; ++s) S[i] = MFMA32(*(const LAS bf16x8*)(kp + 32 * s), qf[s], S[i]);
#pragma unroll
                for (int q = 0; q < 16; ++q) { const int dist = 32 * (4 - i) + r - crow(q, hh); float v = S[i][q] * qs - slope2 * (float)dist;
                    if (i == 0) v = (dist <= 127) ? v : -1e30f;
                    if (i == 4) v = (dist >= 0) ? v : -1e30f;
                    S[i][q] = v; m = fmaxf(m, v); }
            } }
        m = fmaxf(m, __shfl_xor(m, 32));
        float l = 0.f;
#pragma unroll
        for (int i = 0; i < 5; ++i) if (qb - 4 + i >= 0) {
#pragma unroll
            for (int q = 0; q < 16; ++q) { const float p = __builtin_amdgcn_exp2f(S[i][q] - m); S[i][q] = p; l += p; } }
        l += __shfl_xor(l, 32); l += __builtin_amdgcn_exp2f(sink2 - m);
        f32x16 O[2];
#pragma unroll
        for (int q = 0; q < 16; ++q) { O[0][q] = 0.f; O[1][q] = 0.f; }
#pragma unroll
        for (int i = 0; i < 5; ++i) { const int kb = qb - 4 + i;
            if (kb >= 0) {
#pragma unroll
                for (int s2 = 0; s2 < 2; ++s2) {
                    u32x4 pb; pb.x = pk_bf16(S[i][8 * s2], S[i][8 * s2 + 1]); pb.y = pk_bf16(S[i][8 * s2 + 2], S[i][8 * s2 + 3]); pb.z = pk_bf16(S[i][8 * s2 + 4], S[i][8 * s2 + 5]); pb.w = pk_bf16(S[i][8 * s2 + 6], S[i][8 * s2 + 7]);
#pragma unroll
                    for (int dt = 0; dt < 2; ++dt) { const LAS unsigned char* vp = lds + ATT_VOFF + (kvh * 64 + 32 * dt + r) * ATT_VS + (32 * (qbl + i) + 16 * s2 + 4 * hh) * 2;
                        const u32x2 v0 = *(const LAS u32x2*)vp, v1 = *(const LAS u32x2*)(vp + 16); u32x4 av; av.x = v0.x; av.y = v0.y; av.z = v1.x; av.w = v1.y;
                        O[dt] = MFMA32(__builtin_bit_cast(bf16x8, av), __builtin_bit_cast(bf16x8, pb), O[dt]); }
                    asm volatile("" ::: "memory");
                } } }
        const float inv = 1.f / l;
#pragma unroll
        for (int dt = 0; dt < 2; ++dt)
#pragma unroll
            for (int g = 0; g < 4; ++g) { u32x2 w; w.x = pk_bf16(O[dt][4 * g] * inv, O[dt][4 * g + 1] * inv); w.y = pk_bf16(O[dt][4 * g + 2] * inv, O[dt][4 * g + 3] * inv);
                *(u32x2*)(ya + trow * 512 + h * 64 + 32 * dt + 8 * g + 4 * hh) = w; }
    }
    __syncthreads();
}

DI void hgrn_prep_unit(bf16_t* qd, bf16_t* kinv, bf16_t* kendT, float* dec, const float* lb, int bh, int c, int dk2) {
    const int b = bh >> 2, h = bh & 3;
    bf16_t* qp = qd + ((size_t)b * SEQ + c * 64) * 512 + h * 128 + dk2; bf16_t* kp = kinv + ((size_t)b * SEQ + c * 64) * 512 + h * 128 + dk2;
    const float lb0 = lb[h * 128 + dk2], lb1 = lb[h * 128 + dk2 + 1], om0 = 1.f - lb0, om1 = 1.f - lb1;
    float b0 = 0.f, b1 = 0.f; unsigned kv[64];
#pragma unroll
    for (int s0 = 0; s0 < 64; s0 += 8) {
        unsigned qw[8], fw[8];
#pragma unroll
        for (int i = 0; i < 8; ++i) { qw[i] = *(const unsigned*)(qp + (size_t)(s0 + i) * 512); fw[i] = *(const unsigned*)(kp + (size_t)(s0 + i) * 512); }
#pragma unroll
        for (int i = 0; i < 8; ++i) {
            const float f0 = lb0 + om0 * sigm(bflo(fw[i])), f1 = lb1 + om1 * sigm(bfhi(fw[i]));
            b0 += __logf(f0); b1 += __logf(f1);
            const float e0 = __expf(b0), e1 = __expf(b1), i0 = __builtin_amdgcn_rcpf(e0), i1 = __builtin_amdgcn_rcpf(e1);
            const float q0 = bflo(qw[i]), q1 = bfhi(qw[i]);
            *(unsigned*)(qp + (size_t)(s0 + i) * 512) = pk_bf16(q0 * sigm(q0) * e0, q1 * sigm(q1) * e1);
            kv[s0 + i] = pk_bf16((1.f - f0) * i0, (1.f - f1) * i1);
            *(unsigned*)(kp + (size_t)(s0 + i) * 512) = kv[s0 + i];
        }
    }
    const float d0 = __expf(b0), d1 = __expf(b1);
    *(f32x2*)(dec + (size_t)(bh * 64 + c) * 128 + dk2) = (f32x2){d0, d1};
    bf16_t* r0 = kendT + (size_t)(bh * 128 + dk2) * SEQ + c * 64; bf16_t* r1 = r0 + SEQ;
#pragma unroll
    for (int s0 = 0; s0 < 64; s0 += 8) { u32x4 w0, w1;
#pragma unroll
        for (int i = 0; i < 4; ++i) { const unsigned ka = kv[s0 + 2 * i], kb = kv[s0 + 2 * i + 1];
            w0[i] = pk_bf16(bflo(ka) * d0, bflo(kb) * d0); w1[i] = pk_bf16(bfhi(ka) * d1, bfhi(kb) * d1); }
        *(u32x4*)(r0 + s0) = w0; *(u32x4*)(r1 + s0) = w1; }
}
DI void hgrn_ds_unit(const bf16_t* kendT, const bf16_t* vT, bf16_t* dsT, int bh, int c) {
    const int lane = threadIdx.x & 63, wave = threadIdx.x >> 6, r = lane & 31, hh = lane >> 5, i = wave >> 1, j0 = 2 * (wave & 1);
    const bf16_t* ka = kendT + (size_t)(bh * 128 + 32 * i + r) * SEQ + c * 64 + 8 * hh;
    const bf16_t* vb0 = vT + (size_t)(bh * 128 + 32 * j0 + r) * SEQ + c * 64 + 8 * hh; const bf16_t* vb1 = vb0 + (size_t)32 * SEQ;
    f32x16 D0, D1;
#pragma unroll
    for (int q = 0; q < 16; ++q) { D0[q] = 0.f; D1[q] = 0.f; }
#pragma unroll
    for (int ks = 0; ks < 4; ++ks) { const bf16x8 a = *(const bf16x8*)(ka + 16 * ks), b0 = *(const bf16x8*)(vb0 + 16 * ks), b1 = *(const bf16x8*)(vb1 + 16 * ks); D0 = MFMA32(a, b0, D0); D1 = MFMA32(a, b1, D1); }
    const int unit = bh * 64 + c;
    bf16_t* o0 = dsT + (size_t)(unit * 128 + 32 * j0 + r) * 128 + 32 * i + 4 * hh; bf16_t* o1 = o0 + 32 * 128;
#pragma unroll
    for (int g = 0; g < 4; ++g) { u32x2 w; w.x = pk_bf16(D0[4 * g], D0[4 * g + 1]); w.y = pk_bf16(D0[4 * g + 2], D0[4 * g + 3]); *(u32x2*)(o0 + 8 * g) = w;
        u32x2 z; z.x = pk_bf16(D1[4 * g], D1[4 * g + 1]); z.y = pk_bf16(D1[4 * g + 2], D1[4 * g + 3]); *(u32x2*)(o1 + 8 * g) = z; }
}
DI void hgrn_scan(bf16_t* dsT, const float* dec, int vb, int G) {
    for (int idx = vb * NTHR + threadIdx.x; idx < 64 * 128 * 16; idx += G * NTHR) {
        const int dk8 = idx & 15, dv = (idx >> 4) & 127, bh = idx >> 11;
        float S[8];
#pragma unroll
        for (int q = 0; q < 8; ++q) S[q] = 0.f;
        for (int c0 = 0; c0 < 64; c0 += 8) {
            u32x4 ld[8]; f32x4 d0[8], d1[8];
#pragma unroll
            for (int i = 0; i < 8; ++i) { const int c = c0 + i; ld[i] = *(const u32x4*)(dsT + (size_t)((bh * 64 + c) * 128 + dv) * 128 + dk8 * 8);
                const float* dp = dec + (size_t)(bh * 64 + c) * 128 + dk8 * 8; d0[i] = *(const f32x4*)dp; d1[i] = *(const f32x4*)(dp + 4); }
#pragma unroll
            for (int i = 0; i < 8; ++i) { const int c = c0 + i;
                u32x4 w; w.x = pk_bf16(S[0], S[1]); w.y = pk_bf16(S[2], S[3]); w.z = pk_bf16(S[4], S[5]); w.w = pk_bf16(S[6], S[7]);
                *(u32x4*)(dsT + (size_t)((bh * 64 + c) * 128 + dv) * 128 + dk8 * 8) = w;
                S[0] = d0[i][0] * S[0] + bflo(ld[i].x); S[1] = d0[i][1] * S[1] + bfhi(ld[i].x); S[2] = d0[i][2] * S[2] + bflo(ld[i].y); S[3] = d0[i][3] * S[3] + bfhi(ld[i].y);
                S[4] = d1[i][0] * S[4] + bflo(ld[i].z); S[5] = d1[i][1] * S[5] + bfhi(ld[i].z); S[6] = d1[i][2] * S[6] + bflo(ld[i].w); S[7] = d1[i][3] * S[7] + bfhi(ld[i].w); }
        }
    }
}
DI void hgrn_out_unit(const bf16_t* qd, const bf16_t* kinv, const bf16_t* vT, const bf16_t* spT, const bf16_t* gs, bf16_t* yh, LAS float* zs, int bh, int c) {
    const int tid = threadIdx.x, lane = tid & 63, wave = __builtin_amdgcn_readfirstlane(tid >> 6), r = lane & 31, hh = lane >> 5, tb = wave >> 2, db = wave & 3, b = bh >> 2, h = bh & 3;
    const size_t Tb = (size_t)b * SEQ + c * 64;
    bf16x8 qf[8], sf[8], kf0[8], kf1[8]; u32x2 vf[2][2][2];
    { const bf16_t* qrow = qd + (Tb + 32 * tb + r) * 512 + h * 128 + 8 * hh; const bf16_t* sp = spT + (size_t)((bh * 64 + c) * 128 + 32 * db + r) * 128 + 8 * hh;
      const bf16_t* k0 = kinv + (Tb + r) * 512 + h * 128 + 8 * hh; const bf16_t* vrow = vT + (size_t)(bh * 128 + 32 * db + r) * SEQ + c * 64 + 4 * hh;
#pragma unroll
      for (int ks = 0; ks < 8; ++ks) { qf[ks] = *(const bf16x8*)(qrow + 16 * ks); sf[ks] = *(const bf16x8*)(sp + 16 * ks); kf0[ks] = *(const bf16x8*)(k0 + 16 * ks); }
      if (tb) {
#pragma unroll
          for (int ks = 0; ks < 8; ++ks) kf1[ks] = *(const bf16x8*)(k0 + 32 * 512 + 16 * ks); }
#pragma unroll
      for (int sb = 0; sb < 2; ++sb)
#pragma unroll
          for (int s2 = 0; s2 < 2; ++s2) if (sb <= tb) { vf[sb][s2][0] = *(const u32x2*)(vrow + 32 * sb + 16 * s2); vf[sb][s2][1] = *(const u32x2*)(vrow + 32 * sb + 16 * s2 + 8); } }
    f32x16 Z;
#pragma unroll
    for (int q = 0; q < 16; ++q) Z[q] = 0.f;
#pragma unroll
    for (int ks = 0; ks < 8; ++ks) Z = MFMA32(qf[ks], sf[ks], Z);
#pragma unroll
    for (int sb = 0; sb < 2; ++sb) if (sb <= tb) {
        f32x16 X;
#pragma unroll
        for (int q = 0; q < 16; ++q) X[q] = 0.f;
#pragma unroll
        for (int ks = 0; ks < 8; ++ks) X = MFMA32(sb ? kf1[ks] : kf0[ks], qf[ks], X);
        if (sb == tb) {
#pragma unroll
            for (int q = 0; q < 16; ++q) if (crow(q, hh) > r) X[q] = 0.f;
        }
#pragma unroll
        for (int s2 = 0; s2 < 2; ++s2) {
            u32x4 pa_; pa_.x = pk_bf16(X[8 * s2], X[8 * s2 + 1]); pa_.y = pk_bf16(X[8 * s2 + 2], X[8 * s2 + 3]); pa_.z = pk_bf16(X[8 * s2 + 4], X[8 * s2 + 5]); pa_.w = pk_bf16(X[8 * s2 + 6], X[8 * s2 + 7]);
            u32x4 pb_; pb_.x = vf[sb][s2][0].x; pb_.y = vf[sb][s2][0].y; pb_.z = vf[sb][s2][1].x; pb_.w = vf[sb][s2][1].y;
            Z = MFMA32(__builtin_bit_cast(bf16x8, pa_), __builtin_bit_cast(bf16x8, pb_), Z);
        }
    }
#pragma unroll
    for (int q = 0; q < 16; ++q) zs[(32 * tb + crow(q, hh)) * 132 + 32 * db + r] = Z[q];
    __syncthreads();
    { const int tok = tid >> 3, d16 = (tid & 7) * 16; f32x4 o[4]; float ss = 0.f;
      const size_t off = (Tb + tok) * 512 + h * 128 + d16; const u32x4 g0 = *(const u32x4*)(gs + off), g1 = *(const u32x4*)(gs + off + 8);
#pragma unroll
      for (int i = 0; i < 4; ++i) { o[i] = *(const LAS f32x4*)(zs + tok * 132 + d16 + 4 * i); ss += (o[i][0] * o[i][0] + o[i][1] * o[i][1]) + (o[i][2] * o[i][2] + o[i][3] * o[i][3]); }
      ss += __shfl_xor(ss, 1); ss += __shfl_xor(ss, 2); ss += __shfl_xor(ss, 4);
      const float rn = __builtin_amdgcn_rsqf(ss * (1.f / 128.f) + EPS);
      u32x4 w0, w1;
      w0.x = pk_bf16(o[0][0] * rn * bflo(g0.x), o[0][1] * rn * bfhi(g0.x)); w0.y = pk_bf16(o[0][2] * rn * bflo(g0.y), o[0][3] * rn * bfhi(g0.y));
      w0.z = pk_bf16(o[1][0] * rn * bflo(g0.z), o[1][1] * rn * bfhi(g0.z)); w0.w = pk_bf16(o[1][2] * rn * bflo(g0.w), o[1][3] * rn * bfhi(g0.w));
      w1.x = pk_bf16(o[2][0] * rn * bflo(g1.x), o[2][1] * rn * bfhi(g1.x)); w1.y = pk_bf16(o[2][2] * rn * bflo(g1.y), o[2][3] * rn * bfhi(g1.y));
      w1.z = pk_bf16(o[3][0] * rn * bflo(g1.z), o[3][1] * rn * bfhi(g1.z)); w1.w = pk_bf16(o[3][2] * rn * bflo(g1.w), o[3][3] * rn * bfhi(g1.w));
      *(u32x4*)(yh + off) = w0; *(u32x4*)(yh + off + 8) = w1; }
}

DI unsigned f2ord(float f) { const unsigned b = __float_as_uint(f); return b ^ ((unsigned)((int)b >> 31) | 0x80000000u); }
DI float ord2f(unsigned k) { const unsigned b = (k & 0x80000000u) ? (k ^ 0x80000000u) : ~k; return __uint_as_float(b); }
DI void ce_desc(unsigned& a, unsigned& b) { const unsigned hi = a > b ? a : b, lo = a > b ? b : a; a = hi; b = lo; }
DI void sort16_desc(unsigned (&a)[16]) {
#pragma unroll
    for (int k = 2; k <= 16; k <<= 1)
#pragma unroll
        for (int j = k >> 1; j > 0; j >>= 1)
#pragma unroll
            for (int i = 0; i < 16; ++i) { const int l = i ^ j; if (l > i) { if ((i & k) == 0) ce_desc(a[i], a[l]); else ce_desc(a[l], a[i]); } }
}
DI void merge16_desc(unsigned (&a)[16], const unsigned (&b)[16]) {
#pragma unroll
    for (int i = 0; i < 16; ++i) a[i] = a[i] > b[15 - i] ? a[i] : b[15 - i];
#pragma unroll
    for (int j = 8; j > 0; j >>= 1)
#pragma unroll
        for (int i = 0; i < 16; ++i) { const int l = i ^ j; if (l > i) ce_desc(a[i], a[l]); }
}
#define TK_INS(L, x) do { unsigned t_ = (x); _Pragma("unroll") for (int j_ = 0; j_ < 16; ++j_) { const unsigned hi_ = L[j_] > t_ ? L[j_] : t_; t_ = L[j_] > t_ ? t_ : L[j_]; L[j_] = hi_; } } while (0)

DI void topk_stage_keys(const bf16_t* keysb, LAS unsigned char* kl, int h) {
    for (int c = threadIdx.x; c < 2 * 128 * 16; c += NTHR) { const int p = c >> 11, row = (c >> 4) & 127, ch = c & 15;
        *(LAS u32x4*)(kl + (p * 128 + row) * 272 + ch * 16) = *(const u32x4*)(keysb + ((size_t)(p * 8 + h) * 128 + row) * 128 + ch * 8); }
}
DI void topk_unit(const bf16_t* qp, const LAS unsigned char* kl, unsigned short* gidx, float* ggate, LAS unsigned* tk, int quad, int h) {
    const int tid = threadIdx.x, lane = tid & 63, wave = tid >> 6, p = wave & 1, tsub = wave >> 1, r = lane & 31, hh = lane >> 5;
#pragma unroll 1
    for (int hl = 0; hl < 4; ++hl) {
        const int tok0 = (quad * 4 + hl) * 128 + tsub * 32;
        f32x16 acc[4];
#pragma unroll
        for (int kb = 0; kb < 4; ++kb)
#pragma unroll
            for (int i = 0; i < 16; ++i) acc[kb][i] = 0.f;
        const bf16_t* qrow = qp + (size_t)(tok0 + r) * 2048 + h * 256 + p * 128 + 8 * hh;
        const LAS unsigned char* kbase = kl + (p * 128 + r) * 272 + 16 * hh;
#pragma unroll
        for (int s = 0; s < 8; ++s) { const bf16x8 bq = *(const bf16x8*)(qrow + 16 * s);
#pragma unroll
            for (int kb = 0; kb < 4; ++kb) { const bf16x8 ak = *(const LAS bf16x8*)(kbase + kb * 32 * 272 + 32 * s); acc[kb] = MFMA32(ak, bq, acc[kb]); } }
        unsigned A0[16], A1[16], A2[16], A3[16];
#pragma unroll
        for (int i = 0; i < 16; ++i) { const unsigned ki = (unsigned)(crow(i, hh));
            A0[i] = (f2ord(acc[0][i]) & ~127u) | ki; A1[i] = (f2ord(acc[1][i]) & ~127u) | (32u + ki); A2[i] = (f2ord(acc[2][i]) & ~127u) | (64u + ki); A3[i] = (f2ord(acc[3][i]) & ~127u) | (96u + ki); }
        sort16_desc(A0); sort16_desc(A1); sort16_desc(A2); sort16_desc(A3);
        merge16_desc(A0, A1); merge16_desc(A2, A3); merge16_desc(A0, A2);
#pragma unroll
        for (int j = 0; j < 16; ++j) A1[j] = __shfl_xor(A0[j], 32);
        merge16_desc(A0, A1);
        if (hh == 0) { LAS u32x4* dst = (LAS u32x4*)(tk + (((hl * 2 + p) * 128 + tsub * 32 + r) * 16));
#pragma unroll
            for (int c = 0; c < 4; ++c) { u32x4 w = {A0[4 * c], A0[4 * c + 1], A0[4 * c + 2], A0[4 * c + 3]}; dst[c] = w; } }
    }
    __syncthreads();
    {
        const int tok = tid & 127, hl = tid >> 7, tile = quad * 4 + hl;
        const LAS unsigned* t1 = tk + ((hl * 2 + 0) * 128 + tok) * 16; const LAS unsigned* t2 = tk + ((hl * 2 + 1) * 128 + tok) * 16;
        float v1[16], v2[16];
        { const LAS u32x4* s1 = (const LAS u32x4*)t1; const LAS u32x4* s2 = (const LAS u32x4*)t2;
#pragma unroll
          for (int c = 0; c < 4; ++c) { const u32x4 a = s1[c], b = s2[c];
              v1[4 * c] = ord2f(a.x & ~127u); v1[4 * c + 1] = ord2f(a.y & ~127u); v1[4 * c + 2] = ord2f(a.z & ~127u); v1[4 * c + 3] = ord2f(a.w & ~127u);
              v2[4 * c] = ord2f(b.x & ~127u); v2[4 * c + 1] = ord2f(b.y & ~127u); v2[4 * c + 2] = ord2f(b.z & ~127u); v2[4 * c + 3] = ord2f(b.w & ~127u); } }
#define CKEY(i, j) ((f2ord(v1[i] + v2[j]) & ~255u) | (unsigned)((i) * 16 + (j)))
        unsigned C[16], D[16], E[16];
#pragma unroll
        for (int j = 0; j < 16; ++j) C[j] = CKEY(0, j);
#pragma unroll
        for (int j = 0; j < 8; ++j) D[j] = CKEY(1, j);
#pragma unroll
        for (int j = 0; j < 5; ++j) D[8 + j] = CKEY(2, j);
#pragma unroll
        for (int j = 0; j < 3; ++j) D[13 + j] = CKEY(4, j);
#pragma unroll
        for (int j = 0; j < 4; ++j) E[j] = CKEY(3, j);
        E[4] = CKEY(5, 0); E[5] = CKEY(5, 1); E[6] = CKEY(6, 0); E[7] = CKEY(6, 1); E[8] = CKEY(7, 0); E[9] = CKEY(7, 1);
        E[10] = CKEY(8, 0); E[11] = CKEY(9, 0); E[12] = CKEY(10, 0); E[13] = CKEY(11, 0); E[14] = CKEY(12, 0); E[15] = CKEY(13, 0);
        sort16_desc(D); sort16_desc(E);
        TK_INS(E, CKEY(14, 0)); TK_INS(E, CKEY(15, 0));
#undef CKEY
        merge16_desc(C, D); merge16_desc(C, E);
        float sc[16]; unsigned ei[16]; float mx = -1e30f;
#pragma unroll
        for (int q = 0; q < 16; ++q) { const unsigned ij = C[q] & 255u; const unsigned a = t1[ij >> 4], b = t2[ij & 15u];
            sc[q] = ord2f(a & ~127u) + ord2f(b & ~127u); ei[q] = (a & 127u) * 128u + (b & 127u); mx = fmaxf(mx, sc[q]); }
        float sum = 0.f;
#pragma unroll
        for (int q = 0; q < 16; ++q) { sc[q] = __expf(sc[q] - mx); sum += sc[q]; }
        const float inv = 1.f / sum; const size_t o = (size_t)(tile * 128 + tok) * 128 + h * 16;
        u32x4 w0, w1;
        w0.x = ei[0] | (ei[1] << 16); w0.y = ei[2] | (ei[3] << 16); w0.z = ei[4] | (ei[5] << 16); w0.w = ei[6] | (ei[7] << 16);
        w1.x = ei[8] | (ei[9] << 16); w1.y = ei[10] | (ei[11] << 16); w1.z = ei[12] | (ei[13] << 16); w1.w = ei[14] | (ei[15] << 16);
        *(u32x4*)(gidx + o) = w0; *(u32x4*)(gidx + o + 8) = w1;
#pragma unroll
        for (int c = 0; c < 4; ++c) *(f32x4*)(ggate + o + 4 * c) = (f32x4){sc[4 * c] * inv, sc[4 * c + 1] * inv, sc[4 * c + 2] * inv, sc[4 * c + 3] * inv};
    }
    __syncthreads();
}

DI float gelu_erf(float x) { return 0.5f * x * (1.f + erff(x * 0.70710678118654752f)); }
DI int dot16(u32x4 w, const int (&h)[4]) { int c = __builtin_amdgcn_sdot4((int)w.x, h[0], 0, false); c = __builtin_amdgcn_sdot4((int)w.y, h[1], c, false); c = __builtin_amdgcn_sdot4((int)w.z, h[2], c, false); return __builtin_amdgcn_sdot4((int)w.w, h[3], c, false); }
#define V8_FMA(acc4, word, we) do { acc4[0] += (we) * (float)((word) & 255u); acc4[1] += (we) * (float)(((word) >> 8) & 255u); acc4[2] += (we) * (float)(((word) >> 16) & 255u); acc4[3] += (we) * (float)((word) >> 24); } while (0)

template <int IDMASK> DI void expert_token(const bf16_t* x2row, const float* ssq, const unsigned char* u8, const unsigned char* v8, const float* su, const float* sv, const unsigned short* gidx, const float* ggate, const float* gf, float* outrow, int lane) {
    f32x4 x[4]; float amax = 0.f;
#pragma unroll
    for (int i = 0; i < 4; ++i) { const u32x2 w_ = *(const u32x2*)(x2row + 16 * lane + 4 * i); x[i] = (f32x4){bflo(w_.x), bfhi(w_.x), bflo(w_.y), bfhi(w_.y)}; amax = fmaxf(fmaxf(amax, fmaxf(fabsf(x[i][0]), fabsf(x[i][1]))), fmaxf(fabsf(x[i][2]), fabsf(x[i][3]))); }
    float ss = (lane < 16) ? ssq[lane] : 0.f; ss = wave_sum(ss);
    const float rstd2 = __builtin_amdgcn_rsqf(ss * (1.f / 1024.f) + EPS);
#pragma unroll
    for (int o = 1; o < 64; o <<= 1) amax = fmaxf(amax, __shfl_xor(amax, o));
    amax *= rstd2;
    const float qs = amax > 0.f ? 127.f / amax : 0.f, sh = amax * (1.f / 127.f), xq = rstd2 * qs;
    int hq[4];
#pragma unroll
    for (int i = 0; i < 4; ++i) { const int q0 = (int)rintf(x[i][0] * xq), q1 = (int)rintf(x[i][1] * xq), q2 = (int)rintf(x[i][2] * xq), q3 = (int)rintf(x[i][3] * xq);
        hq[i] = (int)((unsigned)(q0 & 255) | ((unsigned)(q1 & 255) << 8) | ((unsigned)(q2 & 255) << 16) | ((unsigned)(q3 & 255) << 24)); }
    const int id0 = gidx[lane] & IDMASK, id1 = gidx[64 + lane] & IDMASK; const float g0 = ggate[lane], g1 = ggate[64 + lane];
    f32x4 o[4]; float wsum = 0.f;
#pragma unroll
    for (int i = 0; i < 4; ++i) o[i] = (f32x4){0.f, 0.f, 0.f, 0.f};
#pragma unroll 1
    for (int bt = 0; bt < 16; ++bt) {
        const int idsel = (bt < 8) ? id0 : id1; const float gsel = (bt < 8) ? g0 : g1; const int lb = (bt & 7) * 8;
        u32x4 ur[8], vr[8];
#pragma unroll
        for (int e = 0; e < 8; ++e) { const int idx = __builtin_amdgcn_readlane(idsel, lb + e); ur[e] = *(const u32x4*)(u8 + (size_t)idx * 1024 + 16 * lane); }
#pragma unroll
        for (int e = 0; e < 8; ++e) { const int idx = __builtin_amdgcn_readlane(idsel, lb + e); vr[e] = *(const u32x4*)(v8 + (size_t)idx * 1024 + 16 * lane); }
        const int myidx = __shfl(idsel, lb + (lane >> 3)); const float mysu = su[myidx], mysv = sv[myidx], gate = __shfl(gsel, lb + (lane >> 3));
        int pr[8];
#pragma unroll
        for (int e = 0; e < 8; ++e) pr[e] = dot16(ur[e], hq);
        int q4[4], q2[2], q1;
        { const bool up_ = (lane & 32) != 0;
#pragma unroll
          for (int i = 0; i < 4; ++i) { const int keep = up_ ? pr[i + 4] : pr[i], send = up_ ? pr[i] : pr[i + 4]; q4[i] = keep + __shfl_xor(send, 32); } }
        { const bool up_ = (lane & 16) != 0;
#pragma unroll
          for (int i = 0; i < 2; ++i) { const int keep = up_ ? q4[i + 2] : q4[i], send = up_ ? q4[i] : q4[i + 2]; q2[i] = keep + __shfl_xor(send, 16); } }
        { const bool up_ = (lane & 8) != 0; const int keep = up_ ? q2[1] : q2[0], send = up_ ? q2[0] : q2[1]; q1 = keep + __shfl_xor(send, 8); }
        q1 += __shfl_xor(q1, 4); q1 += __shfl_xor(q1, 2); q1 += __shfl_xor(q1, 1);
        const float act = (float)q1 * (mysu * sh);
        const float w = gelu_erf(act) * gate * mysv;
#pragma unroll
        for (int e = 0; e < 8; ++e) { const float we = __int_as_float(__builtin_amdgcn_readlane(__float_as_int(w), 8 * e)); wsum += we;
            V8_FMA(o[0], vr[e].x, we); V8_FMA(o[1], vr[e].y, we); V8_FMA(o[2], vr[e].z, we); V8_FMA(o[3], vr[e].w, we); }
    }
    const float corr = 128.f * wsum; float s3 = 0.f;
#pragma unroll
    for (int i = 0; i < 4; ++i) { x[i] += o[i] - corr; s3 += (x[i][0] * x[i][0] + x[i][1] * x[i][1]) + (x[i][2] * x[i][2] + x[i][3] * x[i][3]); }
    s3 = wave_sum(s3); const float r3 = __builtin_amdgcn_rsqf(s3 * (1.f / 1024.f) + EPS);
#pragma unroll
    for (int i = 0; i < 4; ++i) *(f32x4*)(outrow + 16 * lane + 4 * i) = x[i] * r3 * *(const f32x4*)(gf + 16 * lane + 4 * i);
}

DI void hq_token(const bf16_t* x2row, const float* ssq, unsigned char* hqrow, float* shp, int lane) {
    f32x4 x[4]; float amax = 0.f;
#pragma unroll
    for (int i = 0; i < 4; ++i) { const u32x2 w_ = *(const u32x2*)(x2row + 16 * lane + 4 * i); x[i] = (f32x4){bflo(w_.x), bfhi(w_.x), bflo(w_.y), bfhi(w_.y)}; amax = fmaxf(fmaxf(amax, fmaxf(fabsf(x[i][0]), fabsf(x[i][1]))), fmaxf(fabsf(x[i][2]), fabsf(x[i][3]))); }
    float ss = (lane < 16) ? ssq[lane] : 0.f; ss = wave_sum(ss);
    const float rstd2 = __builtin_amdgcn_rsqf(ss * (1.f / 1024.f) + EPS);
#pragma unroll
    for (int o = 1; o < 64; o <<= 1) amax = fmaxf(amax, __shfl_xor(amax, o));
    amax *= rstd2;
    const float qs = amax > 0.f ? 127.f / amax : 0.f, xq = rstd2 * qs;
    u32x4 w;
#pragma unroll
    for (int i = 0; i < 4; ++i) { const int q0 = (int)rintf(x[i][0] * xq), q1 = (int)rintf(x[i][1] * xq), q2 = (int)rintf(x[i][2] * xq), q3 = (int)rintf(x[i][3] * xq);
        w[i] = (unsigned)(q0 & 255) | ((unsigned)(q1 & 255) << 8) | ((unsigned)(q2 & 255) << 16) | ((unsigned)(q3 & 255) << 24); }
    *(u32x4*)(hqrow + 16 * lane) = w;
    if (lane == 0) *shp = amax * (1.f / 127.f);
}
template <int CTRL> DI int dpp_i(int v) { return __builtin_amdgcn_mov_dpp(v, CTRL, 0xf, 0xf, true); }
template <int CTRL> DI float dpp_f(float v) { return __int_as_float(__builtin_amdgcn_mov_dpp(__float_as_int(v), CTRL, 0xf, 0xf, true)); }
DI float swapadd32(float a, float b) { const auto r = __builtin_amdgcn_permlane32_swap(__float_as_uint(a), __float_as_uint(b), false, false); return __uint_as_float(r[0]) + __uint_as_float(r[1]); }
DI float swapadd16(float a, float b) { const auto r = __builtin_amdgcn_permlane16_swap(__float_as_uint(a), __float_as_uint(b), false, false); return __uint_as_float(r[0]) + __uint_as_float(r[1]); }

struct SMeta { u32x4 i0, i1, a0, a1; unsigned xw; };
DI void slice_issue(u32x4 (&r)[16], const SMeta& m, const unsigned char* base) {
    const unsigned iw[8] = {m.i0.x, m.i0.y, m.i0.z, m.i0.w, m.i1.x, m.i1.y, m.i1.z, m.i1.w};
#pragma unroll
    for (int j = 0; j < 16; ++j) { const unsigned idx = (j & 1) ? (iw[j >> 1] >> 16) : (iw[j >> 1] & 0xffffu); r[j] = *(const u32x4*)(base + (size_t)idx * 1024); }
}
DI void slice_u_compute(const SMeta& m, const u32x4 (&r)[16], int* actp, int lane) {
    const int hq[4] = {(int)m.a0.x, (int)m.a0.y, (int)m.a0.z, (int)m.a0.w};
    int part[16];
#pragma unroll
    for (int j = 0; j < 16; ++j) part[j] = dot16(r[j], hq);
    int r8[8], r4[4], r2[2];
    { const bool up_ = (lane & 4) != 0;
#pragma unroll
      for (int i = 0; i < 8; ++i) { const int keep = up_ ? part[i + 8] : part[i], send = up_ ? part[i] : part[i + 8]; r8[i] = keep + dpp_i<0x141>(send); } }
    { const bool up_ = (lane & 2) != 0;
#pragma unroll
      for (int i = 0; i < 4; ++i) { const int keep = up_ ? r8[i + 4] : r8[i], send = up_ ? r8[i] : r8[i + 4]; r4[i] = keep + dpp_i<0x4E>(send); } }
    { const bool up_ = (lane & 1) != 0;
#pragma unroll
      for (int i = 0; i < 2; ++i) { const int keep = up_ ? r4[i + 2] : r4[i], send = up_ ? r4[i] : r4[i + 2]; r2[i] = keep + dpp_i<0xB1>(send); } }
    actp[lane] = (int)((unsigned)(((r2[0] + 32) >> 6) & 0xffff) | ((unsigned)((r2[1] + 32) >> 6) << 16));
}
DI int swapadd32i(int a, int b) { const auto r = __builtin_amdgcn_permlane32_swap((unsigned)a, (unsigned)b, false, false); return (int)r[0] + (int)r[1]; }
DI int swapadd16i(int a, int b) { const auto r = __builtin_amdgcn_permlane16_swap((unsigned)a, (unsigned)b, false, false); return (int)r[0] + (int)r[1]; }
DI void slice_v_compute(const SMeta& m, const u32x4 (&r)[16], float* x3row, float* ssq3p, int xs, int lane) {
    const int wq[4] = {(int)m.a0.x, (int)m.a0.y, (int)m.a0.z, (int)m.a0.w};
    const float sw = __uint_as_float(m.a1.x);
    const int col = 16 * (lane & 7) + ((lane >> 5) & 1) * 8 + ((lane >> 4) & 1) * 4 + ((lane >> 3) & 1) * 2;
    int o[16];
#pragma unroll
    for (int i = 0; i < 16; ++i) o[i] = 0;
#pragma unroll
    for (int q = 0; q < 4; ++q)
#pragma unroll
        for (int p = 0; p < 4; ++p) {
            const unsigned d0 = r[4 * q][p], d1 = r[4 * q + 1][p], d2 = r[4 * q + 2][p], d3 = r[4 * q + 3][p];
            const unsigned t0 = __builtin_amdgcn_perm(d1, d0, 0x05010400u), t1 = __builtin_amdgcn_perm(d1, d0, 0x07030602u), t2 = __builtin_amdgcn_perm(d3, d2, 0x05010400u), t3 = __builtin_amdgcn_perm(d3, d2, 0x07030602u);
            const unsigned e0 = __builtin_amdgcn_perm(t2, t0, 0x05040100u), e1 = __builtin_amdgcn_perm(t2, t0, 0x07060302u), e2 = __builtin_amdgcn_perm(t3, t1, 0x05040100u), e3 = __builtin_amdgcn_perm(t3, t1, 0x07060302u);
            o[4 * p] = __builtin_amdgcn_sdot4((int)e0, wq[q], o[4 * p], false); o[4 * p + 1] = __builtin_amdgcn_sdot4((int)e1, wq[q], o[4 * p + 1], false);
            o[4 * p + 2] = __builtin_amdgcn_sdot4((int)e2, wq[q], o[4 * p + 2], false); o[4 * p + 3] = __builtin_amdgcn_sdot4((int)e3, wq[q], o[4 * p + 3], false);
        }
    int a8[8], a4[4], a2[2];
#pragma unroll
    for (int i = 0; i < 8; ++i) a8[i] = swapadd32i(o[i], o[8 + i]);
#pragma unroll
    for (int i = 0; i < 4; ++i) a4[i] = swapadd16i(a8[i], a8[i + 4]);
    { const bool up_ = (lane & 8) != 0;
#pragma unroll
      for (int i = 0; i < 2; ++i) { const int keep = up_ ? a4[i + 2] : a4[i], send = up_ ? a4[i] : a4[i + 2]; a2[i] = keep + dpp_i<0x128>(send); } }
    const float y0 = bflo(m.xw) + (float)a2[0] * sw, y1 = bfhi(m.xw) + (float)a2[1] * sw;
    *(f32x2*)(x3row + 128 * xs + col) = (f32x2){y0, y1};
    const float ss = wave_sum(y0 * y0 + y1 * y1);
    if (lane == 0) ssq3p[xs] = ss;
}
template <int MODE> DI void slice_pass(unsigned char* ws, float* out, int xs, int gw_, int nw_, int lane) {
    const int g = lane >> 3, c = lane & 7;
    const unsigned short* gidx = (const unsigned short*)(ws + WS_GIDX) + 16 * g;
    const unsigned char* tab = (MODE == 0 ? (const unsigned char*)(ws + WS_U8) : (const unsigned char*)(ws + WS_V8)) + 128 * xs + 16 * c;
    const unsigned char* hqb = (const unsigned char*)(ws + WS_HQ) + 128 * xs + 16 * c;
    const unsigned char* wxb = (const unsigned char*)(ws + WS_WX) + 16 * g;
    const bf16_t* x2b = (const bf16_t*)(ws + WS_X2B) + 128 * xs + 16 * c + ((lane >> 5) & 1) * 8 + ((lane >> 4) & 1) * 4 + ((lane >> 3) & 1) * 2;
#define S_LOAD(m, tok) do { const unsigned short* ip = gidx + (size_t)(tok) * 128; (m).i0 = *(const u32x4*)ip; (m).i1 = *(const u32x4*)(ip + 8); \
        if (MODE == 0) { (m).a0 = *(const u32x4*)(hqb + (size_t)(tok) * 1024); } else { (m).a0 = *(const u32x4*)(wxb + (size_t)(tok) * 128); (m).a1.x = __float_as_uint(((const float*)(ws + WS_SW))[tok]); (m).xw = *(const unsigned*)(x2b + (size_t)(tok) * DM); } } while (0)
#define S_COMPUTE(m, r, tok) do { if (MODE == 0) slice_u_compute(m, r, (int*)(ws + WS_ACTP) + ((size_t)(tok) * 8 + xs) * 64, lane); \
        else slice_v_compute(m, r, out + (size_t)(tok) * DM, (float*)(ws + WS_SSQ3) + (size_t)(tok) * 8, xs, lane); } while (0)
    SMeta mA, mB, mN; u32x4 rA[16], rB[16];
    if (gw_ >= T) return;
    const int n = (T - gw_ + nw_ - 1) / nw_;
#define S_TK(j) (gw_ + ((j) < n ? (j) : n - 1) * nw_)
    S_LOAD(mA, S_TK(0)); slice_issue(rA, mA, tab); S_LOAD(mB, S_TK(1));
    for (int i = 0; i < n; i += 2) {
        slice_issue(rB, mB, tab);
        S_LOAD(mN, S_TK(i + 2));
        S_COMPUTE(mA, rA, S_TK(i));
        mA = mN; slice_issue(rA, mA, tab);
        S_LOAD(mN, S_TK(i + 3));
        if (i + 1 < n) S_COMPUTE(mB, rB, S_TK(i + 1));
        mB = mN;
    }
#undef S_TK
#undef S_LOAD
#undef S_COMPUTE
}
DI void expert_w_token(const int* actp, const unsigned short* gidx, const float* ggate, float sh, const float* su, const float* sv, unsigned char* wrow, float* swp, int lane) {
    typedef int i32x2 __attribute__((ext_vector_type(2)));
    i32x2 acc = {0, 0};
#pragma unroll
    for (int x = 0; x < 8; ++x) { const int w_ = actp[x * 64 + lane]; acc[0] += (int)(short)(w_ & 0xffff); acc[1] += w_ >> 16; }
    acc[0] <<= 6; acc[1] <<= 6;
    const unsigned ii = *(const unsigned*)(gidx + 2 * lane); const f32x2 gt = *(const f32x2*)(ggate + 2 * lane);
    const int e0 = ii & 0xffffu, e1 = ii >> 16;
    const float w0 = gelu_erf((float)acc[0] * (su[e0] * sh)) * gt[0] * sv[e0], w1 = gelu_erf((float)acc[1] * (su[e1] * sh)) * gt[1] * sv[e1];
    float amax = fmaxf(fabsf(w0), fabsf(w1));
    amax = fmaxf(amax, dpp_f<0xB1>(amax)); amax = fmaxf(amax, dpp_f<0x4E>(amax)); amax = fmaxf(amax, dpp_f<0x141>(amax)); amax = fmaxf(amax, dpp_f<0x128>(amax));
    { const auto r = __builtin_amdgcn_permlane16_swap(__float_as_uint(amax), __float_as_uint(amax), false, false); amax = fmaxf(__uint_as_float(r[0]), __uint_as_float(r[1])); }
    { const auto r = __builtin_amdgcn_permlane32_swap(__float_as_uint(amax), __float_as_uint(amax), false, false); amax = fmaxf(__uint_as_float(r[0]), __uint_as_float(r[1])); }
    const float qs = amax > 0.f ? 127.f / amax : 0.f;
    const int q0 = (int)rintf(w0 * qs), q1 = (int)rintf(w1 * qs);
    *(unsigned short*)(wrow + 2 * lane) = (unsigned short)((q0 & 255) | ((q1 & 255) << 8));
    if (lane == 0) *swp = amax * (1.f / 127.f);
}
DI void final_norm_token(float* row, const float* ssq3p, const float* gf, int lane) {
    float ss = (lane < 8) ? ssq3p[lane] : 0.f; ss = wave_sum(ss);
    const float r3 = __builtin_amdgcn_rsqf(ss * (1.f / 1024.f) + EPS);
#pragma unroll
    for (int i = 0; i < 4; ++i) { f32x4* p = (f32x4*)(row + 256 * i + 4 * lane); *p = *p * r3 * *(const f32x4*)(gf + 256 * i + 4 * lane); }
}

#define XB_TMO      128
#define XB_XCNT(j)  (256  + 64 * (j))
#define XB_XSUB(j)  (1280 + 64 * (j))
#define XB_XGEN(j)  (2304 + 64 * (j))
#define XB_TOP      3328
#define XB_TOPGEN   3392
#define XCD_BAR_WORDS 3456
#define XB_SPIN_CAP (1u << 18)

__device__ __forceinline__ unsigned xb_ld(unsigned* p)              { return __hip_atomic_load(p, __ATOMIC_RELAXED, __HIP_MEMORY_SCOPE_AGENT); }
__device__ __forceinline__ unsigned xb_add(unsigned* p, unsigned v) { return __hip_atomic_fetch_add(p, v, __ATOMIC_RELAXED, __HIP_MEMORY_SCOPE_AGENT); }
__device__ __forceinline__ unsigned xb_xcc_id() { return (unsigned)__builtin_amdgcn_s_getreg((3 << 11) | 20) & 0xFu; }
#define XB_SPIN(cond, bar) do { unsigned _sp = 0; while (cond) { __builtin_amdgcn_s_sleep(1); \
    if ((++_sp & 255u) == 0u) { if (xb_ld(&(bar)[XB_TMO])) break; if (_sp > XB_SPIN_CAP) { atomicAdd(&(bar)[XB_TMO], 1u); break; } } } } while (0)

struct XcdBarrier {
    unsigned* bar; unsigned x;
    volatile __attribute__((address_space(3))) unsigned* st;
};

__device__ __forceinline__ XcdBarrier xcd_barrier_post(unsigned* bar, volatile __attribute__((address_space(3))) unsigned* st) {
    XcdBarrier b; b.bar = bar; b.x = xb_xcc_id(); b.st = st;
    if (threadIdx.x == 0) st[2] = xb_add(&bar[XB_XCNT(b.x)], 1u);
    return b;
}
__device__ __forceinline__ void xcd_barrier_complete(unsigned* bar, unsigned x, unsigned& nloc, unsigned& nx) {
    const unsigned G = gridDim.x * gridDim.y * gridDim.z;
    unsigned sum, cnt, mine, sp = 0u;
    for (;;) {
        sum = 0u; cnt = 0u; mine = 0u;
#pragma unroll
        for (unsigned j = 0; j < 16; ++j) { const unsigned c = xb_ld(&bar[XB_XCNT(j)]); sum += c; cnt += (c > 0u) ? 1u : 0u; mine = (j == x) ? c : mine; }
        if (sum == G) break;
        __builtin_amdgcn_s_sleep(1);
        if ((++sp & 255u) == 0u) { if (xb_ld(&bar[XB_TMO])) break; if (sp > XB_SPIN_CAP) { atomicAdd(&bar[XB_TMO], 1u); break; } }
    }
    nloc = mine > 0u ? mine : 1u; nx = cnt > 0u ? cnt : 1u;
}

__device__ __forceinline__ void xcd_barrier(const XcdBarrier& b) {
    asm volatile("s_waitcnt vmcnt(0)" ::: "memory");
    __syncthreads();
    if (threadIdx.x == 0) {
        unsigned* bar = b.bar;
        __builtin_amdgcn_s_waitcnt(0);
        unsigned nloc = b.st[0], nx = b.st[1];
        if (nloc == 0u) { xcd_barrier_complete(bar, b.x, nloc, nx); b.st[0] = nloc; b.st[1] = nx; }
        const unsigned old = xb_add(&bar[XB_XSUB(b.x)], 1u);
        const unsigned gen = old / nloc;
        if (old + 1u == (gen + 1u) * nloc) {
            __builtin_amdgcn_fence(__ATOMIC_RELEASE, "agent");
            asm volatile("s_waitcnt vmcnt(0)" ::: "memory");
            const unsigned og = xb_add(&bar[XB_TOP], 1u);
            const unsigned tg = og / nx;
            if (og + 1u == (tg + 1u) * nx) xb_add(&bar[XB_TOPGEN], 1u);
            else XB_SPIN(xb_ld(&bar[XB_TOPGEN]) == tg, bar);
            __builtin_amdgcn_fence(__ATOMIC_ACQUIRE, "agent");
            xb_add(&bar[XB_XGEN(b.x)], 1u);
            asm volatile("s_waitcnt vmcnt(0)" ::: "memory");
        } else {
            XB_SPIN(xb_ld(&bar[XB_XGEN(b.x)]) == gen, bar);
            __builtin_amdgcn_fence(__ATOMIC_ACQUIRE, "agent");
            asm volatile("s_waitcnt vmcnt(0)" ::: "memory");
        }
    }
    __syncthreads();
}

constexpr int N_PHASES = 13;
__global__ void __launch_bounds__(NTHR, 2) mk_fwd(Args a) {
    extern __shared__ __attribute__((aligned(16))) unsigned char lds_raw[];
    LAS unsigned char* lds = (LAS unsigned char*)lds_raw;
    cg::grid_group grid = cg::this_grid();
    const int G = gridDim.x, vb = blockIdx.x, tid = threadIdx.x, lane = tid & 63, wave = tid >> 6;
    unsigned char* ws = a.ws;
    const int lo = a.ph_lo, hi = a.ph_hi;
    volatile LAS unsigned* MISC = (volatile LAS unsigned*)(lds + LDS_BYTES - 64);
    if (tid < 16) MISC[tid] = 0u;
    __syncthreads();
    const XcdBarrier bar = xcd_barrier_post((unsigned*)(ws + 4096) + lo * XCD_BAR_WORDS, MISC);
#ifndef PHASE_MASK
#define PHASE_MASK 0xFFFF
#endif
#define IN(k) (((PHASE_MASK >> (k)) & 1) && lo <= (k) && (k) < hi)
#ifndef REPEAT_MASK
#define REPEAT_MASK 0
#endif
#define REP(k) for (int rep_ = 0; rep_ < (((REPEAT_MASK) >> (k)) & 1) + 1; ++rep_)
#define SEAM(k) do { if (IN(k) && IN((k) + 1)) { if ((k) == 0) grid.sync(); else xcd_barrier(bar); } } while (0)
    REP(0) if (IN(0)) p0_prologue(a, lds, vb, G);
    SEAM(0);
    REP(1) if (IN(1)) { pg8::Gemm g{(const bf16_t*)(ws + WS_XB), (const bf16_t*)(ws + WS_W1T), T, NIN, 1024}; pg8::StaticOrder S; S.init(T, NIN, G, vb);
        pg8::Epi1 E{(const float*)(ws + WS_RSTD1), (bf16_t*)(ws + WS_PA), (bf16_t*)(ws + WS_GG), (bf16_t*)(ws + WS_QD), (bf16_t*)(ws + WS_KINV), (bf16_t*)(ws + WS_KENDT), (bf16_t*)(ws + WS_VT), (bf16_t*)(ws + WS_GS),
                    (float*)(ws + WS_DEC), (const float*)(ws + WS_LB), (bf16_t*)(ws + WS_AVT), lds + 131072};
        pg8::gemm_phase<pg8::Epi1, pg8::StaticOrder, true, true>(lds, g, S, E); }
#ifdef PROBE_GEMM1_PLAIN
    if (IN(1)) { pg8::Gemm g{(const bf16_t*)(ws + WS_XB), (const bf16_t*)(ws + WS_W1T), T, NIN, 1024}; pg8::StaticOrder S; S.init(T, NIN, G, vb);
        pg8::EpiDummy E{(bf16_t*)(ws + WS_YA), (const float*)(ws + WS_RSTD1)};
        pg8::gemm_phase<pg8::EpiDummy, pg8::StaticOrder, true, true>(lds, g, S, E); }
#endif
    SEAM(1);
    REP(2) if (IN(2)) {
        for (int u0 = vb * 8; u0 < 64 * 64; u0 += G * 8) {
            { int t2_ = threadIdx.x; asm volatile("" : "+v"(t2_)); const int u = u0 + (t2_ >> 6); hgrn_prep_unit((bf16_t*)(ws + WS_QD), (bf16_t*)(ws + WS_KINV), (bf16_t*)(ws + WS_KENDT), (float*)(ws + WS_DEC), (const float*)(ws + WS_LB), u >> 6, u & 63, (t2_ & 63) * 2); }
            __syncthreads();
            for (int j = 0; j < 8; ++j) hgrn_ds_unit((const bf16_t*)(ws + WS_KENDT), (const bf16_t*)(ws + WS_VT), (bf16_t*)(ws + WS_XB), (u0 + j) >> 6, (u0 + j) & 63);
        }
        for (int u = vb; u < BATCH * (SEQ / 64); u += G) attn_unit((const bf16_t*)(ws + WS_PA), (const bf16_t*)(ws + WS_AVT), a.in[3], (bf16_t*)(ws + WS_YA), lds, u >> 6, u & 63);
    }
    SEAM(2);
    REP(3) if (IN(3)) hgrn_scan((bf16_t*)(ws + WS_XB), (const float*)(ws + WS_DEC), vb, G);
    SEAM(3);
    REP(4) if (IN(4)) { int bsel = 0; for (int u = vb; u < 64 * 64; u += G, bsel ^= 1)
        hgrn_out_unit((const bf16_t*)(ws + WS_QD), (const bf16_t*)(ws + WS_KINV), (const bf16_t*)(ws + WS_VT), (const bf16_t*)(ws + WS_XB), (const bf16_t*)(ws + WS_GS), (bf16_t*)(ws + WS_YH), (LAS float*)(lds + bsel * 34816), u >> 6, u & 63);
        __syncthreads(); }
    SEAM(4);
    REP(5) if (IN(5)) {
        { pg8::Gemm g{(const bf16_t*)(ws + WS_YA), (const bf16_t*)(ws + WS_WAPT), T, 1024, 512}; pg8::StaticOrder S; S.init(T, 1024, G, vb);
          pg8::EpiMerge<false> E{(bf16_t*)(ws + WS_XB), (const bf16_t*)(ws + WS_GG)};
          pg8::gemm_phase<pg8::EpiMerge<false>, pg8::StaticOrder, true, true>(lds, g, S, E); }
        __syncthreads();
        { pg8::Gemm g{(const bf16_t*)(ws + WS_YH), (const bf16_t*)(ws + WS_WHPT), T, 1024, 512}; pg8::StaticOrder S; S.init(T, 1024, G, vb);
          pg8::EpiMerge<true> E{(bf16_t*)(ws + WS_XB), (const bf16_t*)(ws + WS_GG) + 1024};
          pg8::gemm_phase<pg8::EpiMerge<true>, pg8::StaticOrder, true, true>(lds, g, S, E); }
    }
    SEAM(5);
    REP(6) if (IN(6)) { pg8::Gemm g{(const bf16_t*)(ws + WS_XB), (const bf16_t*)(ws + WS_WOUTT), T, 1024, 1024}; pg8::StaticOrder S; S.init(T, 1024, G, vb);
        pg8::EpiX2 E{a.in[0], (bf16_t*)(ws + WS_X2B), (float*)(ws + WS_SSQ2)};
        pg8::gemm_phase<pg8::EpiX2, pg8::StaticOrder, true, true>(lds, g, S, E); }
    SEAM(6);
    REP(7) if (IN(7)) { pg8::Gemm g{(const bf16_t*)(ws + WS_X2B), (const bf16_t*)(ws + WS_WQT), T, 2048, 1024}; pg8::StaticOrder S; S.init(T, 2048, G, vb);
        pg8::EpiQp E{(bf16_t*)(ws + WS_QP), (const float*)(ws + WS_SSQ2)};
        pg8::gemm_phase<pg8::EpiQp, pg8::StaticOrder, true, true>(lds, g, S, E); }
    SEAM(7);
    REP(8) if (IN(8)) { const int per = (1024 + G - 1) / G; int hcur = -1;
        for (int U = vb * per; U < (vb + 1) * per && U < 1024; ++U) { const int h = U >> 7;
            if (h != hcur) { topk_stage_keys((const bf16_t*)(ws + WS_KEYS), lds + 65536, h); hcur = h; __syncthreads(); }
            topk_unit((const bf16_t*)(ws + WS_QP), lds + 65536, (unsigned short*)(ws + WS_GIDX), (float*)(ws + WS_GGATE), (LAS unsigned*)lds, U & 127, h); }
        for (int tok = vb * 8 + wave; tok < T; tok += G * 8) hq_token((const bf16_t*)(ws + WS_X2B) + (size_t)tok * DM, (const float*)(ws + WS_SSQ2) + (size_t)tok * 16, (unsigned char*)(ws + WS_HQ) + (size_t)tok * 1024, (float*)(ws + WS_SH) + tok, lane); }
    SEAM(8);
    if (IN(9) || IN(11)) {
        if (tid == 0) {
            unsigned nloc_ = 0, nx_ = 0; xcd_barrier_complete(bar.bar, bar.x, nloc_, nx_);
            unsigned cj[8], tot = 0; bool all = true;
#pragma unroll
            for (int j = 0; j < 8; ++j) { cj[j] = xb_ld(&bar.bar[XB_XCNT(j)]); tot += cj[j]; all = all && cj[j] > 0u; }
            if (all && tot == (unsigned)G && bar.x < 8u) { MISC[4] = bar.x; MISC[5] = MISC[2]; MISC[6] = cj[bar.x & 7u]; }
            else { const unsigned sl_ = (unsigned)vb & 7u; MISC[4] = sl_; MISC[5] = (unsigned)vb >> 3; MISC[6] = ((unsigned)G - sl_ + 7u) >> 3; }
        }
        __syncthreads();
    }
    REP(9) if (IN(9)) slice_pass<0>(ws, a.out, (int)MISC[4], (int)MISC[5] * 8 + __builtin_amdgcn_readfirstlane(wave), (int)MISC[6] * 8, lane);
    SEAM(9);
    REP(10) if (IN(10)) for (int tok = vb * 8 + wave; tok < T; tok += G * 8)
        expert_w_token((const int*)(ws + WS_ACTP) + (size_t)tok * 512, (const unsigned short*)(ws + WS_GIDX) + (size_t)tok * 128, (const float*)(ws + WS_GGATE) + (size_t)tok * 128, ((const float*)(ws + WS_SH))[tok],
                       (const float*)(ws + WS_SU), (const float*)(ws + WS_SV), (unsigned char*)(ws + WS_WX) + (size_t)tok * 128, (float*)(ws + WS_SW) + tok, lane);
    SEAM(10);
    REP(11) if (IN(11)) slice_pass<1>(ws, a.out, (int)MISC[4], (int)MISC[5] * 8 + __builtin_amdgcn_readfirstlane(wave), (int)MISC[6] * 8, lane);
    SEAM(11);
    REP(12) if (IN(12)) for (int tok = vb * 8 + wave; tok < T; tok += G * 8) final_norm_token(a.out + (size_t)tok * DM, (const float*)(ws + WS_SSQ3) + (size_t)tok * 8, a.in[14], lane);
#undef IN
#undef SEAM
}

extern "C" void kernel_launch(void* const* d_in, const int* in_sizes, int n_in, void* d_out, int out_size, void* d_ws, size_t ws_size, hipStream_t stream) {
    static int grid = 0;
    if (grid == 0) {
        if (n_in != 15 || in_sizes[0] != T * DM || out_size != T * DM || ws_size < WS_END) { fprintf(stderr, "kernel_launch: unexpected shapes (n_in %d, in0 %d, out %d, ws %zu)\n", n_in, n_in > 0 ? in_sizes[0] : -1, out_size, ws_size); grid = -1; return; }
        int dev = 0, cus = 0, per_cu = 0;
        hipGetDevice(&dev); hipDeviceGetAttribute(&cus, hipDeviceAttributeMultiprocessorCount, dev);
        if (hipFuncSetAttribute((const void*)mk_fwd, hipFuncAttributeMaxDynamicSharedMemorySize, LDS_BYTES) != hipSuccess) { fprintf(stderr, "kernel_launch: hipFuncSetAttribute failed\n"); grid = -1; return; }
        if (hipOccupancyMaxActiveBlocksPerMultiprocessor(&per_cu, (const void*)mk_fwd, NTHR, LDS_BYTES) != hipSuccess || per_cu < 1) { fprintf(stderr, "kernel_launch: occupancy query says %d blocks per CU\n", per_cu); per_cu = 1; }
        (void)hipGetLastError();
        grid = cus;
    }
    if (grid < 0) return;
    if (hipMemsetAsync(d_ws, 0, 256 * 1024, stream) != hipSuccess) { fprintf(stderr, "kernel_launch: hipMemsetAsync failed\n"); return; }
    Args a{};
    for (int i = 0; i < 15; ++i) a.in[i] = (const float*)d_in[i];
    a.out = (float*)d_out; a.ws = (unsigned char*)d_ws;
#if MK_FUSED
    a.ph_lo = 0; a.ph_hi = N_PHASES;
    { void* args[] = {&a}; hipError_t e = hipLaunchCooperativeKernel((const void*)mk_fwd, dim3(grid), dim3(NTHR), args, LDS_BYTES, stream);
      if (e != hipSuccess) fprintf(stderr, "kernel_launch: cooperative launch failed: %s (grid %d)\n", hipGetErrorString(e), grid); }
#else
    for (int p = 0; p < N_PHASES; ++p) { a.ph_lo = p; a.ph_hi = p + 1; void* args[] = {&a};
        hipError_t e = hipLaunchCooperativeKernel((const void*)mk_fwd, dim3(grid), dim3(NTHR), args, LDS_BYTES, stream);
        if (e != hipSuccess) { fprintf(stderr, "kernel_launch: launch of phase %d failed: %s (grid %d)\n", p, hipGetErrorString(e), grid); break; } }
#endif
}
```

```cpp
#include <hip/hip_runtime.h>
#include <hip/hip_cooperative_groups.h>
#include <cstdio>
#include <cstdint>
namespace cg = cooperative_groups;
namespace pg8 {
#define PG8_LAS __attribute__((address_space(3)))
typedef unsigned short bf16_t;
typedef short bf16x8 __attribute__((ext_vector_type(8)));
typedef float f32x4 __attribute__((ext_vector_type(4)));
typedef unsigned u32x4 __attribute__((ext_vector_type(4)));
constexpr int BM = 256, BK = 64, HALF = 128, HTB = HALF * BK * 2  , STAGE_BYTES = 8 * HTB, NXCD = 8, WGM = 8;

__host__ __device__ __forceinline__ int lds_byte(int r, int c) { const int st = (r >> 4) * 2 + (c >> 5), rr = r & 15, cc = c & 31, ob = rr * 64 + cc * 2; return st * 1024 + (ob ^ (((ob >> 9) & 1) << 5)); }
__host__ __device__ __forceinline__ void stage_rc(int b, int& R, int& C) { const int st = b / 1024, sb = b % 1024, swz = sb ^ (((sb >> 9) & 1) << 5); R = (st >> 1) * 16 + swz / 64; C = (st & 1) * 32 + (swz % 64) / 2; }
__host__ __device__ __forceinline__ int perm32(int rho) { const int n = rho >> 4, i = rho & 15; return 8 * (i >> 2) + 4 * n + (i & 3); }

struct Unit { int pm, pn; };
struct Gemm { const bf16_t* A; const bf16_t* Bt; int M, N, K; };

struct StaticOrder {
    int nM, nN, nwg, G, c;
    __host__ __device__ void init(int M, int N, int G_, int c_) { nM = M / BM; nN = N / BM; nwg = nM * nN; G = G_; c = c_; }
    __host__ __device__ bool next(int i, Unit& u) const {
        const long L = (long)i * G + c; if (L >= nwg) return false;
        int wgid = (int)L; { const int q = nwg / NXCD, r = nwg % NXCD, xcd = wgid % NXCD, off = wgid / NXCD; wgid = (xcd < r ? xcd * (q + 1) : r * (q + 1) + (xcd - r) * q) + off; }
        const int nig = WGM * nN, gid = wgid / nig, fm = gid * WGM, gsz = (nM - fm) < WGM ? (nM - fm) : WGM;
        u.pm = fm + ((wgid % nig) % gsz); u.pn = (wgid % nig) / gsz; return true;
    }
    __device__ __forceinline__ void a_ready(const Unit&) const {}
    __device__ __forceinline__ void done(const Unit&) const {}
};

__device__ __forceinline__ unsigned cvt_pk_bf16(float lo, float hi) { unsigned r; asm volatile("v_cvt_pk_bf16_f32 %0, %1, %2" : "=v"(r) : "v"(lo), "v"(hi)); return r; }

template <class Epi, class Sched, bool ALIGN_EPI = false, bool SP2 = false>
__device__ __forceinline__ void gemm_phase(PG8_LAS unsigned char* lds, const Gemm g, const Sched& S, const Epi& E) {
    int tid_ = threadIdx.x; asm volatile("" : "+v"(tid_));
    const int tid = tid_, wid = __builtin_amdgcn_readfirstlane(tid >> 6), lane = tid & 63, wr = wid >> 2, wc = wid & 3, fr = lane & 15, fq = lane >> 4;
    const int K = g.K, nt = K / BK;
    unsigned voffA[2], voffB[2];
#pragma unroll
    for (int i = 0; i < 2; ++i) { int R, C; stage_rc(tid * 16 + i * 8192, R, C); const int Rb = Epi::PERM ? ((R & ~31) + perm32(R & 31)) : R;
        voffA[i] = (unsigned)(R * K + C) * 2u; voffB[i] = (unsigned)(Rb * K + C) * 2u; }
    const size_t kstep = (size_t)(BK * 2);
    const size_t hstep = (size_t)HALF * K * 2;
    const size_t tstep = 2 * hstep;
    const unsigned ldsw = (unsigned)wid * 1024u;
    const int aoff = lds_byte(wr * 64 + fr, fq * 8), boff = lds_byte(wc * 32 + fr, fq * 8);
#define PG8_SA(b, h) (((b) * 2 + (h)) * HTB)
#define PG8_SB(b, h) ((4 + (b) * 2 + (h)) * HTB)
#define PG8_STAGE(bufoff, gbase, voff) do { _Pragma("unroll") for (int _i = 0; _i < 2; ++_i) \
        __builtin_amdgcn_global_load_lds((const unsigned*)((const char*)(gbase) + (voff)[_i]), (PG8_LAS unsigned*)(lds + (bufoff) + ldsw + _i * 8192), 16, 0, 0); } while (0)
#define PG8_LDA(dst, b, h) do { _Pragma("unroll") for (int m = 0; m < 4; ++m) _Pragma("unroll") for (int k = 0; k < 2; ++k) dst[m][k] = *(const PG8_LAS bf16x8*)(lds + PG8_SA(b, h) + aoff + m * 2048 + k * 1024); } while (0)
#define PG8_LDB(dst, b, h) do { _Pragma("unroll") for (int n = 0; n < 2; ++n) _Pragma("unroll") for (int k = 0; k < 2; ++k) dst[n][k] = *(const PG8_LAS bf16x8*)(lds + PG8_SB(b, h) + boff + n * 2048 + k * 1024); } while (0)
#define PG8_MMA(ai, bj, At, Bt) do { __builtin_amdgcn_s_setprio(1); _Pragma("unroll") for (int m = 0; m < 4; ++m) _Pragma("unroll") for (int n = 0; n < 2; ++n) _Pragma("unroll") for (int k = 0; k < 2; ++k) \
        acc[ai][bj][m][n] = __builtin_amdgcn_mfma_f32_16x16x32_bf16(Bt[n][k], At[m][k], acc[ai][bj][m][n], 0, 0, 0); __builtin_amdgcn_s_setprio(0); } while (0)
#define PG8_WAIT_V(n) asm volatile("s_waitcnt vmcnt(" #n ")" ::: "memory")
#define PG8_WAIT_L(n) asm volatile("s_waitcnt lgkmcnt(" #n ")" ::: "memory")
#define PG8_BAR __builtin_amdgcn_s_barrier()
#define PG8_SCHED __builtin_amdgcn_sched_barrier(0)
    Unit cur, nxt; int ui = 0;
    if (!S.next(0, cur)) return;
    f32x4 acc[2][2][4][2];
#pragma unroll
    for (int a = 0; a < 2; ++a)
#pragma unroll
        for (int b = 0; b < 2; ++b)
#pragma unroll
            for (int m = 0; m < 4; ++m)
#pragma unroll
                for (int n = 0; n < 2; ++n) acc[a][b][m][n] = (f32x4){0.f, 0.f, 0.f, 0.f};
    bf16x8 At[4][2], B0[2][2], B1[2][2];
    const char* cA = (const char*)g.A + (size_t)cur.pm * tstep; const char* cB = (const char*)g.Bt + (size_t)cur.pn * tstep;
    S.a_ready(cur);
    if constexpr (SP2) {
        PG8_STAGE(PG8_SB(0, 0), cB, voffB); PG8_STAGE(PG8_SB(0, 1), cB + hstep, voffB); PG8_STAGE(PG8_SA(0, 0), cA, voffA); PG8_STAGE(PG8_SA(0, 1), cA + hstep, voffA);
        if (wr == 1) PG8_BAR;
        PG8_WAIT_V(2); PG8_BAR;
        PG8_STAGE(PG8_SB(1, 0), cB + kstep, voffB); PG8_STAGE(PG8_SA(1, 0), cA + kstep, voffA); PG8_STAGE(PG8_SB(1, 1), cB + hstep + kstep, voffB);
        PG8_WAIT_V(6); PG8_BAR;
    } else {
        PG8_STAGE(PG8_SB(0, 0), cB, voffB); PG8_STAGE(PG8_SA(0, 0), cA, voffA); PG8_STAGE(PG8_SB(0, 1), cB + hstep, voffB); PG8_STAGE(PG8_SA(0, 1), cA + hstep, voffA);
        if (wr == 1) PG8_BAR;
        PG8_WAIT_V(4); PG8_BAR;
        PG8_STAGE(PG8_SB(1, 0), cB + kstep, voffB); PG8_STAGE(PG8_SA(1, 0), cA + kstep, voffA); PG8_STAGE(PG8_SB(1, 1), cB + hstep + kstep, voffB);
        PG8_WAIT_V(6); PG8_BAR;
    }
    for (;;) {
        const bool has_next = S.next(ui + 1, nxt);
        const char* nA = has_next ? (const char*)g.A + (size_t)nxt.pm * tstep : cA; const char* nB = has_next ? (const char*)g.Bt + (size_t)nxt.pn * tstep : cB;
        for (int t = 0; t < nt; t += 2) {
            const bool last = (t == nt - 2);
            const char* a1 = cA + (size_t)(t + 1) * kstep;
            const char* a2 = last ? nA : cA + (size_t)(t + 2) * kstep; const char* b2 = last ? nB : cB + (size_t)(t + 2) * kstep;
            const char* a3 = a2 + kstep; const char* b3 = b2 + kstep;
            if (last && has_next) S.a_ready(nxt);
            if constexpr (SP2) {
            PG8_LDB(B0, 0, 0); PG8_LDB(B1, 0, 1); PG8_SCHED; PG8_LDA(At, 0, 0); PG8_STAGE(PG8_SA(1, 1), a1 + hstep, voffA);
            PG8_WAIT_V(8); PG8_WAIT_L(0); PG8_BAR; PG8_MMA(0, 0, At, B0); PG8_MMA(0, 1, At, B1); PG8_BAR; PG8_SCHED;
            PG8_LDA(At, 0, 1); PG8_STAGE(PG8_SB(0, 0), b2, voffB); PG8_STAGE(PG8_SB(0, 1), b2 + hstep, voffB); PG8_STAGE(PG8_SA(0, 0), a2, voffA);
            PG8_WAIT_V(8); PG8_WAIT_L(0); PG8_BAR; PG8_MMA(1, 0, At, B0); PG8_MMA(1, 1, At, B1); PG8_BAR; PG8_SCHED;
            PG8_LDB(B0, 1, 0); PG8_LDB(B1, 1, 1); PG8_SCHED; PG8_LDA(At, 1, 0); PG8_STAGE(PG8_SA(0, 1), a2 + hstep, voffA);
            PG8_WAIT_V(8); PG8_WAIT_L(0); PG8_BAR; PG8_MMA(0, 0, At, B0); PG8_MMA(0, 1, At, B1); PG8_BAR; PG8_SCHED;
            PG8_LDA(At, 1, 1); PG8_STAGE(PG8_SB(1, 0), b3, voffB); PG8_STAGE(PG8_SB(1, 1), b3 + hstep, voffB); PG8_STAGE(PG8_SA(1, 0), a3, voffA);
            PG8_WAIT_V(8); PG8_WAIT_L(0); PG8_BAR; PG8_MMA(1, 0, At, B0); PG8_MMA(1, 1, At, B1); PG8_BAR; PG8_SCHED;
            } else {
            PG8_LDB(B0, 0, 0); PG8_SCHED; PG8_LDA(At, 0, 0); PG8_STAGE(PG8_SA(1, 1), a1 + hstep, voffA);
            PG8_WAIT_L(8); PG8_BAR; PG8_WAIT_L(0); PG8_MMA(0, 0, At, B0); PG8_BAR; PG8_SCHED;
            PG8_LDB(B1, 0, 1); PG8_STAGE(PG8_SB(0, 0), b2, voffB);
            PG8_BAR; PG8_WAIT_L(0); PG8_MMA(0, 1, At, B1); PG8_BAR;
            PG8_LDA(At, 0, 1); PG8_STAGE(PG8_SA(0, 0), a2, voffA);
            PG8_BAR; PG8_WAIT_L(0); PG8_MMA(1, 0, At, B0); PG8_BAR; PG8_SCHED;
            PG8_STAGE(PG8_SB(0, 1), b2 + hstep, voffB);
            PG8_WAIT_V(6); PG8_BAR; PG8_MMA(1, 1, At, B1); PG8_BAR;
            PG8_LDB(B0, 1, 0); PG8_SCHED; PG8_LDA(At, 1, 0); PG8_STAGE(PG8_SA(0, 1), a2 + hstep, voffA);
            PG8_WAIT_L(8); PG8_BAR; PG8_WAIT_L(0); PG8_MMA(0, 0, At, B0); PG8_BAR; PG8_SCHED;
            PG8_LDB(B1, 1, 1); PG8_STAGE(PG8_SB(1, 0), b3, voffB);
            PG8_BAR; PG8_WAIT_L(0); PG8_MMA(0, 1, At, B1); PG8_BAR;
            PG8_LDA(At, 1, 1); PG8_STAGE(PG8_SA(1, 0), a3, voffA);
            PG8_BAR; PG8_WAIT_L(0); PG8_MMA(1, 0, At, B0); PG8_BAR; PG8_SCHED;
            PG8_STAGE(PG8_SB(1, 1), b3 + hstep, voffB);
            PG8_WAIT_V(6); PG8_BAR; PG8_MMA(1, 1, At, B1); PG8_BAR;
            }
        }
        if constexpr (ALIGN_EPI) { if (wr == 0) PG8_BAR; }
        if constexpr (!Epi::AFTER_DRAIN) { E(acc, cur, wr, wc, fr, fq); S.done(cur); }
        if (!has_next) break;
#pragma unroll
        for (int a = 0; a < 2; ++a)
#pragma unroll
            for (int b = 0; b < 2; ++b)
#pragma unroll
                for (int m = 0; m < 4; ++m)
#pragma unroll
                    for (int n = 0; n < 2; ++n) acc[a][b][m][n] = (f32x4){0.f, 0.f, 0.f, 0.f};
        cur = nxt; cA = nA; cB = nB; ++ui;
        if constexpr (ALIGN_EPI) { if (wr == 1) PG8_BAR; }
    }
    PG8_WAIT_V(0);
    if constexpr (!ALIGN_EPI) { if (wr == 0) PG8_BAR; }
    PG8_BAR;
    if constexpr (Epi::AFTER_DRAIN) { E.fused(acc, cur, wr, wc, fr, fq, lds, wid, lane); S.done(cur); }
#undef PG8_SA
#undef PG8_SB
#undef PG8_STAGE
#undef PG8_LDA
#undef PG8_LDB
#undef PG8_MMA
#undef PG8_WAIT_V
#undef PG8_WAIT_L
#undef PG8_BAR
#undef PG8_SCHED
}
}

#ifndef MK_FUSED
#define MK_FUSED 1
#endif
#define DI __device__ __forceinline__
#define LAS __attribute__((address_space(3)))
typedef unsigned short bf16_t;
typedef float f32x4 __attribute__((ext_vector_type(4)));
typedef float f32x2 __attribute__((ext_vector_type(2)));
typedef float f32x16 __attribute__((ext_vector_type(16)));
typedef unsigned u32x4 __attribute__((ext_vector_type(4)));
typedef unsigned u32x2 __attribute__((ext_vector_type(2)));
typedef short bf16x8 __attribute__((ext_vector_type(8)));
typedef _Float16 h16x2 __attribute__((ext_vector_type(2)));
typedef _Float16 h16x8 __attribute__((ext_vector_type(8)));

constexpr int BATCH = 16, SEQ = 4096, T = BATCH * SEQ, DM = 1024, NIN = 4864;
constexpr int C_AQ = 0, C_AK = 512, C_AV = 640, C_HQ = 768, C_HF = 1280, C_HI = 1792, C_HG = 2304, C_GA = 2816, C_GH = 3840;
constexpr float EPS = 1e-6f;
constexpr int NTHR = 512;
constexpr int LDS_BYTES = 163840;

constexpr size_t MiB = 1u << 20;
constexpr size_t WS_W1T = 1 * MiB;
constexpr size_t WS_WAPT = 11 * MiB;
constexpr size_t WS_WHPT = 12 * MiB;
constexpr size_t WS_WOUTT = 13 * MiB;
constexpr size_t WS_WQT = 15 * MiB;
constexpr size_t WS_KEYS = 19 * MiB;
constexpr size_t WS_LB = 19 * MiB + 512 * 1024;
constexpr size_t WS_RSTD1 = 20 * MiB;
constexpr size_t WS_SSQ2 = 21 * MiB;
constexpr size_t WS_U8 = 26 * MiB;
constexpr size_t WS_V8 = 42 * MiB;
constexpr size_t WS_SU = 58 * MiB;
constexpr size_t WS_SV = 58 * MiB + 65536;
constexpr size_t WS_DEC = 60 * MiB;
constexpr size_t WS_AVT = 64 * MiB;
constexpr size_t WS_XB = 90 * MiB;
constexpr size_t WS_PA = 218 * MiB;
constexpr size_t WS_GG = 314 * MiB;
constexpr size_t WS_QD = 570 * MiB;
constexpr size_t WS_KINV = 634 * MiB;
constexpr size_t WS_KENDT = 698 * MiB;
constexpr size_t WS_VT = 762 * MiB;
constexpr size_t WS_GS = 826 * MiB;
constexpr size_t WS_YA = 890 * MiB;
constexpr size_t WS_YH = 954 * MiB;
constexpr size_t WS_END = 1018 * MiB;
constexpr size_t WS_HQ = 698 * MiB;
constexpr size_t WS_WX = 762 * MiB;
constexpr size_t WS_SH = 60 * MiB;
constexpr size_t WS_SSQ3 = 64 * MiB;
constexpr size_t WS_SW = 61 * MiB;
constexpr size_t WS_ACTP = 346 * MiB;
constexpr size_t WS_X2B = 218 * MiB;
constexpr size_t WS_QP = 346 * MiB;
constexpr size_t WS_GIDX = 602 * MiB;
constexpr size_t WS_GGATE = 618 * MiB;

struct Args { const float* in[15]; float* out; unsigned char* ws; int ph_lo, ph_hi; };

DI unsigned pk_bf16(float lo, float hi) { typedef __bf16 b2 __attribute__((ext_vector_type(2))); f32x2 v = {lo, hi}; b2 b = __builtin_convertvector(v, b2); return __builtin_bit_cast(unsigned, b); }
DI float bflo(unsigned w) { return __uint_as_float(w << 16); }
DI float bfhi(unsigned w) { return __uint_as_float(w & 0xffff0000u); }
DI float sigm(float x) { return __builtin_amdgcn_rcpf(1.f + __expf(-x)); }
DI float wave_sum(float v) {
    v += __int_as_float(__builtin_amdgcn_mov_dpp(__float_as_int(v), 0xB1, 0xf, 0xf, true));
    v += __int_as_float(__builtin_amdgcn_mov_dpp(__float_as_int(v), 0x4E, 0xf, 0xf, true));
    v += __int_as_float(__builtin_amdgcn_mov_dpp(__float_as_int(v), 0x141, 0xf, 0xf, true));
    v += __int_as_float(__builtin_amdgcn_mov_dpp(__float_as_int(v), 0x128, 0xf, 0xf, true));
    { const auto r = __builtin_amdgcn_permlane16_swap(__float_as_uint(v), __float_as_uint(v), false, false); v = __uint_as_float(r[0]) + __uint_as_float(r[1]); }
    { const auto r = __builtin_amdgcn_permlane32_swap(__float_as_uint(v), __float_as_uint(v), false, false); v = __uint_as_float(r[0]) + __uint_as_float(r[1]); }
    return v;
}
DI unsigned short bf16_1(float x) { return (unsigned short)(pk_bf16(x, 0.f) & 0xffffu); }
template <int N> DI float dpp_row_shr(float v) { return __int_as_float(__builtin_amdgcn_update_dpp(0, __float_as_int(v), 0x110 + N, 0xf, 0xf, true)); }
DI float rowsum16(float v) { v += __int_as_float(__builtin_amdgcn_mov_dpp(__float_as_int(v), 0xB1, 0xf, 0xf, true)); v += __int_as_float(__builtin_amdgcn_mov_dpp(__float_as_int(v), 0x4E, 0xf, 0xf, true));
    v += __int_as_float(__builtin_amdgcn_mov_dpp(__float_as_int(v), 0x141, 0xf, 0xf, true)); v += __int_as_float(__builtin_amdgcn_mov_dpp(__float_as_int(v), 0x128, 0xf, 0xf, true)); return v; }
DI float scan16(float v) { v += dpp_row_shr<1>(v); v += dpp_row_shr<2>(v); v += dpp_row_shr<4>(v); v += dpp_row_shr<8>(v); return v; }
DI int crow(int reg, int hh) { return (reg & 3) + 8 * (reg >> 2) + 4 * hh; }
#define MFMA32(a, b, c) __builtin_amdgcn_mfma_f32_32x32x16_bf16((a), (b), (c), 0, 0, 0)
#define LDS_WAIT() asm volatile("s_waitcnt lgkmcnt(0)" ::: "memory")

namespace pg8 {
#define TSTORE_WRITE(sl, e, m, x) *(PG8_LAS bf16_t*)((sl) + (4 * fq + (e)) * 144 + (16 * (m) + fr) * 2) = bf16_1(x)
struct Epi1 {
    static constexpr bool PERM = true, AFTER_DRAIN = false;
    const float* rs; bf16_t* pa; bf16_t* gg; bf16_t* qd; bf16_t* kinv; bf16_t* kendT; bf16_t* vT; bf16_t* gs; float* dec; const float* lb; bf16_t* avT; PG8_LAS unsigned char* xl;
    __device__ __forceinline__ void operator()(const f32x4 (&acc)[2][2][4][2], const Unit& u, int wr, int wc, int fr, int fq) const {
        asm volatile("" : "+v"(fr), "+v"(fq));
        const int row0 = u.pm * BM + wr * 64 + fr, pn = u.pn;
        if (pn == 2) {
            const int c8 = wc * 32 + 8 * fq, tseqb = (u.pm & 15) * 256 + wr * 64 + fr, bb = u.pm >> 4;
#pragma unroll
            for (int ai = 0; ai < 2; ++ai)
#pragma unroll
                for (int m = 0; m < 4; ++m) { const int row = row0 + ai * HALF + m * 16; const float s = rs[row];
                    const f32x4 v0 = acc[ai][0][m][0] * s, v1 = acc[ai][0][m][1] * s;
                    u32x4 w; w.x = pk_bf16(v0[0], v0[1]); w.y = pk_bf16(v0[2], v0[3]); w.z = pk_bf16(v1[0], v1[1]); w.w = pk_bf16(v1[2], v1[3]);
                    *(u32x4*)(pa + (size_t)row * 768 + 512 + c8) = w;
                }
            PG8_LAS unsigned char* sl = xl + (wr * 4 + wc) * 2304; const int lane_ = fq * 16 + fr;
#pragma unroll
            for (int ai = 0; ai < 2; ++ai)
#pragma unroll
                for (int n = 0; n < 2; ++n) {
#pragma unroll
                    for (int m = 0; m < 4; ++m) { const float s = rs[row0 + ai * HALF + m * 16];
#pragma unroll
                        for (int e = 0; e < 4; ++e) TSTORE_WRITE(sl, e, m, acc[ai][1][m][n][e] * s); }
                    asm volatile("s_waitcnt lgkmcnt(0)" ::: "memory");
#pragma unroll
                    for (int q = 0; q < 2; ++q) { const int c = lane_ + 64 * q, rw = c >> 3, tc = c & 7, col = wc * 32 + 8 * (rw >> 2) + 4 * n + (rw & 3);
                        const u32x4 w = *(const PG8_LAS u32x4*)(sl + rw * 144 + tc * 16);
                        *(u32x4*)(avT + (size_t)((bb * 2 + (col >> 6)) * 64 + (col & 63)) * SEQ + (u.pm & 15) * 256 + ai * HALF + wr * 64 + 8 * tc) = w; }
                    asm volatile("s_waitcnt lgkmcnt(0)" ::: "memory");
                }
            return;
        }
        if (pn < 3 || pn >= 11) {
            bf16_t* O; int ldc, colt;
            if (pn < 3) { O = pa; ldc = 768; colt = pn * 256; } else { O = gg; ldc = 2048; colt = (pn - 11) * 256; }
            const int col0 = colt + wc * 32 + 8 * fq;
#pragma unroll
            for (int ai = 0; ai < 2; ++ai)
#pragma unroll
                for (int m = 0; m < 4; ++m) { const int row = row0 + ai * HALF + m * 16; const float s = rs[row]; bf16_t* rowp = O + (size_t)row * ldc + col0;
#pragma unroll
                    for (int bj = 0; bj < 2; ++bj) { const f32x4 v0 = acc[ai][bj][m][0] * s, v1 = acc[ai][bj][m][1] * s;
                        u32x4 w; w.x = pk_bf16(v0[0], v0[1]); w.y = pk_bf16(v0[2], v0[3]); w.z = pk_bf16(v1[0], v1[1]); w.w = pk_bf16(v1[2], v1[3]);
                        *(u32x4*)(rowp + bj * HALF) = w; } }
            return;
        }
        PG8_LAS unsigned char* sl = xl + (wr * 4 + wc) * 2304; const int lane_ = fq * 16 + fr;
        const int h = (pn - 3) & 3, c8 = wc * 32 + 8 * fq, bh = (u.pm >> 4) * 4 + h;
        if (pn < 7) {
#pragma unroll
            for (int ai = 0; ai < 2; ++ai)
#pragma unroll
                for (int m = 0; m < 4; ++m) { const int row = row0 + ai * HALF + m * 16; const float s = rs[row]; const size_t o = (size_t)row * 512 + h * 128 + c8;
#pragma unroll
                    for (int bj = 0; bj < 2; ++bj) { const f32x4 v0 = acc[ai][bj][m][0] * s, v1 = acc[ai][bj][m][1] * s;
                        u32x4 w; w.x = pk_bf16(v0[0], v0[1]); w.y = pk_bf16(v0[2], v0[3]); w.z = pk_bf16(v1[0], v1[1]); w.w = pk_bf16(v1[2], v1[3]);
                        *(u32x4*)((bj ? kinv : qd) + o) = w; } }
        } else {
#pragma unroll
            for (int ai = 0; ai < 2; ++ai) {
                const int tseq0 = (u.pm & 15) * 256 + ai * HALF + wr * 64;
#pragma unroll
                for (int n = 0; n < 2; ++n) {
#pragma unroll
                    for (int m = 0; m < 4; ++m) { const float s = rs[row0 + ai * HALF + m * 16];
#pragma unroll
                        for (int e = 0; e < 4; ++e) TSTORE_WRITE(sl, e, m, acc[ai][0][m][n][e] * s); }
                    asm volatile("s_waitcnt lgkmcnt(0)" ::: "memory");
#pragma unroll
                    for (int q = 0; q < 2; ++q) { const int c = lane_ + 64 * q, rw = c >> 3, tc = c & 7, dvr = wc * 32 + 8 * (rw >> 2) + 4 * n + (rw & 3);
                        const u32x4 w = *(const PG8_LAS u32x4*)(sl + rw * 144 + tc * 16);
                        *(u32x4*)(vT + (size_t)(bh * 128 + dvr) * SEQ + tseq0 + 8 * tc) = w; }
                    asm volatile("s_waitcnt lgkmcnt(0)" ::: "memory");
                }
#pragma unroll
                for (int m = 0; m < 4; ++m) { const int row = row0 + ai * HALF + m * 16; const float s = rs[row];
                    f32x4 g0 = acc[ai][1][m][0] * s, g1 = acc[ai][1][m][1] * s;
#pragma unroll
                    for (int e = 0; e < 4; ++e) { g0[e] *= sigm(g0[e]); g1[e] *= sigm(g1[e]); }
                    u32x4 w; w.x = pk_bf16(g0[0], g0[1]); w.y = pk_bf16(g0[2], g0[3]); w.z = pk_bf16(g1[0], g1[1]); w.w = pk_bf16(g1[2], g1[3]);
                    *(u32x4*)(gs + (size_t)row * 512 + h * 128 + c8) = w; }
            }
        }
    }
};
struct EpiDummy {
    static constexpr bool PERM = true, AFTER_DRAIN = false;
    bf16_t* O; const float* rs;
    __device__ __forceinline__ void operator()(const f32x4 (&acc)[2][2][4][2], const Unit& u, int wr, int wc, int fr, int fq) const {
        asm volatile("" : "+v"(fr), "+v"(fq));
        const int row0 = wr * 64 + fr, col0 = wc * 32 + 8 * fq;
#pragma unroll
        for (int ai = 0; ai < 2; ++ai)
#pragma unroll
            for (int m = 0; m < 4; ++m) { const int row = row0 + ai * HALF + m * 16; const float s = rs[u.pm * BM + row]; bf16_t* rowp = O + (size_t)blockIdx.x * 65536 + (size_t)row * 256 + col0;
#pragma unroll
                for (int bj = 0; bj < 2; ++bj) { const f32x4 v0 = acc[ai][bj][m][0] * s, v1 = acc[ai][bj][m][1] * s;
                    u32x4 w; w.x = pk_bf16(v0[0], v0[1]); w.y = pk_bf16(v0[2], v0[3]); w.z = pk_bf16(v1[0], v1[1]); w.w = pk_bf16(v1[2], v1[3]);
                    *(u32x4*)(rowp + bj * HALF) = w; } }
    }
};
template <bool ADD> struct EpiMerge {
    static constexpr bool PERM = true, AFTER_DRAIN = false;
    bf16_t* O; const bf16_t* gate;
    __device__ __forceinline__ void operator()(const f32x4 (&acc)[2][2][4][2], const Unit& u, int wr, int wc, int fr, int fq) const {
        const int row0 = u.pm * BM + wr * 64 + fr, col0 = u.pn * BM + wc * 32 + 8 * fq;
#pragma unroll
        for (int ai = 0; ai < 2; ++ai)
#pragma unroll
            for (int m = 0; m < 4; ++m) { const int row = row0 + ai * HALF + m * 16; bf16_t* rowp = O + (size_t)row * DM + col0; const bf16_t* gp = gate + (size_t)row * 2048 + col0;
#pragma unroll
                for (int bj = 0; bj < 2; ++bj) { const u32x4 g = *(const u32x4*)(gp + bj * HALF);
                    f32x4 v0 = acc[ai][bj][m][0], v1 = acc[ai][bj][m][1];
                    v0[0] *= sigm(bflo(g.x)); v0[1] *= sigm(bfhi(g.x)); v0[2] *= sigm(bflo(g.y)); v0[3] *= sigm(bfhi(g.y));
                    v1[0] *= sigm(bflo(g.z)); v1[1] *= sigm(bfhi(g.z)); v1[2] *= sigm(bflo(g.w)); v1[3] *= sigm(bfhi(g.w));
                    if (ADD) { const u32x4 o = *(const u32x4*)(rowp + bj * HALF);
                        v0[0] += bflo(o.x); v0[1] += bfhi(o.x); v0[2] += bflo(o.y); v0[3] += bfhi(o.y); v1[0] += bflo(o.z); v1[1] += bfhi(o.z); v1[2] += bflo(o.w); v1[3] += bfhi(o.w); }
                    u32x4 w; w.x = pk_bf16(v0[0], v0[1]); w.y = pk_bf16(v0[2], v0[3]); w.z = pk_bf16(v1[0], v1[1]); w.w = pk_bf16(v1[2], v1[3]);
                    *(u32x4*)(rowp + bj * HALF) = w; } }
    }
};
struct EpiX2 {
    static constexpr bool PERM = true, AFTER_DRAIN = false;
    const float* X; bf16_t* X2B; float* ssq;
    __device__ __forceinline__ void operator()(const f32x4 (&acc)[2][2][4][2], const Unit& u, int wr, int wc, int fr, int fq) const {
        const int row0 = u.pm * BM + wr * 64 + fr, col0 = u.pn * BM + wc * 32 + 8 * fq;
#pragma unroll
        for (int ai = 0; ai < 2; ++ai)
#pragma unroll
            for (int m = 0; m < 4; ++m) { const int row = row0 + ai * HALF + m * 16; const size_t off = (size_t)row * DM + col0; float ss = 0.f;
#pragma unroll
                for (int bj = 0; bj < 2; ++bj) { const f32x4 x0 = *(const f32x4*)(X + off + bj * HALF), x1 = *(const f32x4*)(X + off + bj * HALF + 4);
                    const f32x4 v0 = acc[ai][bj][m][0] + x0, v1 = acc[ai][bj][m][1] + x1;
                    u32x4 w; w.x = pk_bf16(v0[0], v0[1]); w.y = pk_bf16(v0[2], v0[3]); w.z = pk_bf16(v1[0], v1[1]); w.w = pk_bf16(v1[2], v1[3]);
                    *(u32x4*)(X2B + off + bj * HALF) = w;
                    ss += (v0[0] * v0[0] + v0[1] * v0[1]) + (v0[2] * v0[2] + v0[3] * v0[3]) + (v1[0] * v1[0] + v1[1] * v1[1]) + (v1[2] * v1[2] + v1[3] * v1[3]); }
                ss += __shfl_xor(ss, 16); ss += __shfl_xor(ss, 32);
                if (fq == 0) ssq[(size_t)row * 16 + u.pn * 4 + wc] = ss; }
    }
};
struct EpiQp {
    static constexpr bool PERM = true, AFTER_DRAIN = false;
    bf16_t* O; const float* ssq;
    __device__ __forceinline__ void operator()(const f32x4 (&acc)[2][2][4][2], const Unit& u, int wr, int wc, int fr, int fq) const {
        const int row0 = u.pm * BM + wr * 64 + fr, col0 = u.pn * BM + wc * 32 + 8 * fq;
#pragma unroll
        for (int ai = 0; ai < 2; ++ai)
#pragma unroll
            for (int m = 0; m < 4; ++m) { const int row = row0 + ai * HALF + m * 16; const f32x4* sp = (const f32x4*)(ssq + (size_t)row * 16);
                const f32x4 a = sp[0], b = sp[1], c = sp[2], d = sp[3];
                const float tot = ((a[0] + a[1]) + (a[2] + a[3])) + ((b[0] + b[1]) + (b[2] + b[3])) + ((c[0] + c[1]) + (c[2] + c[3])) + ((d[0] + d[1]) + (d[2] + d[3]));
                const float s = __builtin_amdgcn_rsqf(tot * (1.f / 1024.f) + EPS); bf16_t* rowp = O + (size_t)row * 2048 + col0;
#pragma unroll
                for (int bj = 0; bj < 2; ++bj) { const f32x4 v0 = acc[ai][bj][m][0] * s, v1 = acc[ai][bj][m][1] * s;
                    u32x4 w; w.x = pk_bf16(v0[0], v0[1]); w.y = pk_bf16(v0[2], v0[3]); w.z = pk_bf16(v1[0], v1[1]); w.w = pk_bf16(v1[2], v1[3]);
                    *(u32x4*)(rowp + bj * HALF) = w; } }
    }
};
}

DI int w1_src_col(int n) {
    if (n < 768 || n >= 2816) return n;
    if (n < 1792) { const int h = (n - 768) >> 8, r = (n - 768) & 255; return r < 128 ? C_HQ + 128 * h + r : C_HF + 128 * h + (r - 128); }
    const int h = (n - 1792) >> 8, r = (n - 1792) & 255; return r < 128 ? C_HI + 128 * h + r : C_HG + 128 * h + (r - 128);
}
template <bool PERMW1> DI void p0_transpose_item(const float* W, int K, int N, bf16_t* WT, const float* g, int gmask, LAS float* scr, int item, int lane) {
    const int nblk = N / 32, kb = item / nblk, nb = item % nblk, k0 = 64 * kb, n0 = 32 * nb, ns = PERMW1 ? w1_src_col(n0) : n0;
#pragma unroll 8
    for (int i = 0; i < 32; ++i) { const int kk = 2 * i + (lane >> 5); float w = W[(size_t)(k0 + kk) * N + ns + (lane & 31)]; if (g) w *= g[(k0 + kk) & gmask]; scr[kk * 33 + (lane & 31)] = w; }
    LDS_WAIT(); asm volatile("" ::: "memory");
    const int c = lane & 7;
#pragma unroll
    for (int j = 0; j < 4; ++j) { const int n = (lane >> 3) + 8 * j; const LAS float* s = scr + (8 * c) * 33 + n;
        u32x4 o; o.x = pk_bf16(s[0 * 33], s[1 * 33]); o.y = pk_bf16(s[2 * 33], s[3 * 33]); o.z = pk_bf16(s[4 * 33], s[5 * 33]); o.w = pk_bf16(s[6 * 33], s[7 * 33]);
        *(u32x4*)(WT + (size_t)(n0 + n) * K + k0 + 8 * c) = o; }
    LDS_WAIT(); asm volatile("" ::: "memory");
}
DI unsigned pk_f16(float a, float b) { h16x2 v = {(_Float16)a, (_Float16)b}; return __builtin_bit_cast(unsigned, v); }

DI void p0_prologue(const Args& a, LAS unsigned char* lds, int vb, int G) {
    const int tid = threadIdx.x, lane = tid & 63, wave = tid >> 6;
    const int gw = vb * 8 + wave, NGW = G * 8, gt = vb * NTHR + tid, NGT = G * NTHR;
    unsigned char* ws = a.ws;
    LAS float* scr = (LAS float*)(lds + wave * 16384);
    constexpr int I_W1 = 16 * 152, I_AP = 8 * 32, I_HP = 8 * 32, I_OUT = 16 * 32, I_Q = 16 * 64, NITEMS = I_W1 + I_AP + I_HP + I_OUT + I_Q;
    for (int it = gw; it < NITEMS; it += NGW) {
        int r = it;
        if (r < I_W1) { p0_transpose_item<true>(a.in[2], 1024, NIN, (bf16_t*)(ws + WS_W1T), a.in[1], 1023, scr, r, lane); continue; } r -= I_W1;
        if (r < I_AP) { p0_transpose_item<false>(a.in[6], 512, 1024, (bf16_t*)(ws + WS_WAPT), nullptr, 0, scr, r, lane); continue; } r -= I_AP;
        if (r < I_HP) { p0_transpose_item<false>(a.in[7], 512, 1024, (bf16_t*)(ws + WS_WHPT), a.in[5], 127, scr, r, lane); continue; } r -= I_HP;
        if (r < I_OUT) { p0_transpose_item<false>(a.in[8], 1024, 1024, (bf16_t*)(ws + WS_WOUTT), nullptr, 0, scr, r, lane); continue; } r -= I_OUT;
        p0_transpose_item<false>(a.in[10], 1024, 2048, (bf16_t*)(ws + WS_WQT), a.in[9], 1023, scr, r, lane);
    }
    for (int i = gt; i < 2 * 8 * 128 * 128 / 4; i += NGT) { const f32x4 v = ((const f32x4*)a.in[11])[i]; u32x2 o; o.x = pk_bf16(v[0], v[1]); o.y = pk_bf16(v[2], v[3]); ((u32x2*)(ws + WS_KEYS))[i] = o; }
    for (int it = gw; it < 2 * 16384; it += NGW) {
        const int isv = it >= 16384, e = it & 16383;
        const float* src = (isv ? a.in[13] : a.in[12]) + (size_t)e * 1024 + 16 * lane;
        f32x4 x[4]; float amax = 0.f;
#pragma unroll
        for (int i = 0; i < 4; ++i) { x[i] = *(const f32x4*)(src + 4 * i); if (!isv) x[i] *= *(const f32x4*)(a.in[9] + 16 * lane + 4 * i);
            amax = fmaxf(fmaxf(amax, fmaxf(fabsf(x[i][0]), fabsf(x[i][1]))), fmaxf(fabsf(x[i][2]), fabsf(x[i][3]))); }
#pragma unroll
        for (int o = 1; o < 64; o <<= 1) amax = fmaxf(amax, __shfl_xor(amax, o));
        const float qs = amax > 0.f ? 127.f / amax : 0.f; const int off = 0;
        u32x4 w;
#pragma unroll
        for (int i = 0; i < 4; ++i) { const int q0 = (int)rintf(x[i][0] * qs) + off, q1 = (int)rintf(x[i][1] * qs) + off, q2 = (int)rintf(x[i][2] * qs) + off, q3 = (int)rintf(x[i][3] * qs) + off;
            w[i] = (unsigned)(q0 & 255) | ((unsigned)(q1 & 255) << 8) | ((unsigned)(q2 & 255) << 16) | ((unsigned)(q3 & 255) << 24); }
        *(u32x4*)(ws + (isv ? WS_V8 : WS_U8) + (size_t)e * 1024 + 16 * lane) = w;
        if (lane == 0) ((float*)(ws + (isv ? WS_SV : WS_SU)))[e] = amax * (1.f / 127.f);
    }
    for (int row = gw; row < T; row += NGW) {
        const f32x4* xr = (const f32x4*)(a.in[0] + (size_t)row * DM) + lane; f32x4 v[4]; float s = 0.f;
#pragma unroll
        for (int j = 0; j < 4; ++j) { v[j] = xr[64 * j]; s += (v[j][0] * v[j][0] + v[j][1] * v[j][1]) + (v[j][2] * v[j][2] + v[j][3] * v[j][3]); }
        s = wave_sum(s);
        u32x2* o = (u32x2*)(ws + WS_XB + (size_t)row * DM * 2) + lane;
#pragma unroll
        for (int j = 0; j < 4; ++j) { u32x2 w; w.x = pk_bf16(v[j][0], v[j][1]); w.y = pk_bf16(v[j][2], v[j][3]); o[64 * j] = w; }
        if (lane == 0) ((float*)(ws + WS_RSTD1))[row] = __builtin_amdgcn_rsqf(s * (1.f / 1024.f) + EPS);
    }
    if (vb == 0) { const float l0 = a.in[4][tid], l1 = a.in[4][512 + tid]; ((float*)(ws + WS_LB))[tid] = 1.f / (1.f + __expf(l1 - l0)); }
}

constexpr int ATT_KS = 272, ATT_VS = 392, ATT_VOFF = 192 * ATT_KS;
DI void attn_unit(const bf16_t* pa, const bf16_t* avT, const float* sinks, bf16_t* ya, LAS unsigned char* lds, int b, int tt) {
    int tid_ = threadIdx.x; asm volatile("" : "+v"(tid_));
    const int tid = tid_, lane = tid & 63, h = __builtin_amdgcn_readfirstlane(tid >> 6), r = lane & 31, hh = lane >> 5, kvh = h >> 2;
    const int p0 = tt * 64 - 128;
    for (int c = tid; c < 192 * 16; c += NTHR) { const int row = c >> 4, ch = c & 15, pos = p0 + row; u32x4 w = {0u, 0u, 0u, 0u};
        if (pos >= 0) w = *(const u32x4*)(pa + ((size_t)b * SEQ + pos) * 768 + 512 + ch * 8);
        *(LAS u32x4*)(lds + row * ATT_KS + ch * 16) = w; }
    for (int c = tid; c < 128 * 24; c += NTHR) { const int row = c / 24, ch = c - row * 24, pos = p0 + ch * 8; u32x4 w = {0u, 0u, 0u, 0u};
        if (pos >= 0) w = *(const u32x4*)(avT + (size_t)(b * 128 + row) * SEQ + pos);
        LAS u32x2* d = (LAS u32x2*)(lds + ATT_VOFF + row * ATT_VS + ch * 16); d[0] = (u32x2){w.x, w.y}; d[1] = (u32x2){w.z, w.w}; }
    __syncthreads();
    constexpr float LOG2E = 1.4426950408889634f;
    const float slope2 = exp2f(-(float)(h + 1)) * LOG2E, sink2 = sinks[h] * LOG2E, qs = 0.125f * LOG2E;
#pragma unroll 1
    for (int qbl = 0; qbl < 2; ++qbl) {
        const int qb = tt * 2 + qbl; const size_t trow = (size_t)b * SEQ + qb * 32 + r;
        bf16x8 qf[4];
        { const bf16_t* qp = pa + trow * 768 + h * 64 + 8 * hh;
#pragma unroll
          for (int s = 0; s < 4; ++s) qf[s] = *(const bf16x8*)(qp + 16 * s); }
        f32x16 S[5]; float m = sink2;
#pragma unroll
        for (int i = 0; i < 5; ++i) { const int kb = qb - 4 + i;
            if (kb >= 0) {
#pragma unroll
                for (int q = 0; q < 16; ++q) S[i][q] = 0.f;
                const LAS unsigned char* kp = lds + (32 * (qbl + i) + r) * ATT_KS + kvh * 128 + 16 * hh;
#pragma unroll
                for (int s = 0; s < 4; ++s) S[i] = MFMA32(*(const LAS bf16x8*)(kp + 32 * s), qf[s], S[i]);
#pragma unroll
                for (int q = 0; q < 16; ++q) { const int dist = 32 * (4 - i) + r - crow(q, hh); float v = S[i][q] * qs - slope2 * (float)dist;
                    if (i == 0) v = (dist <= 127) ? v : -1e30f;
                    if (i == 4) v = (dist >= 0) ? v : -1e30f;
                    S[i][q] = v; m = fmaxf(m, v); }
            } }
        m = fmaxf(m, __shfl_xor(m, 32));
        float l = 0.f;
#pragma unroll
        for (int i = 0; i < 5; ++i) if (qb - 4 + i >= 0) {
#pragma unroll
            for (int q = 0; q < 16; ++q) { const float p = __builtin_amdgcn_exp2f(S[i][q] - m); S[i][q] = p; l += p; } }
        l += __shfl_xor(l, 32); l += __builtin_amdgcn_exp2f(sink2 - m);
        f32x16 O[2];
#pragma unroll
        for (int q = 0; q < 16; ++q) { O[0][q] = 0.f; O[1][q] = 0.f; }
#pragma unroll
        for (int i = 0; i < 5; ++i) { const int kb = qb - 4 + i;
            if (kb >= 0) {
#pragma unroll
                for (int s2 = 0; s2 < 2; ++s2) {
                    u32x4 pb; pb.x = pk_bf16(S[i][8 * s2], S[i][8 * s2 + 1]); pb.y = pk_bf16(S[i][8 * s2 + 2], S[i][8 * s2 + 3]); pb.z = pk_bf16(S[i][8 * s2 + 4], S[i][8 * s2 + 5]); pb.w = pk_bf16(S[i][8 * s2 + 6], S[i][8 * s2 + 7]);
#pragma unroll
                    for (int dt = 0; dt < 2; ++dt) { const LAS unsigned char* vp = lds + ATT_VOFF + (kvh * 64 + 32 * dt + r) * ATT_VS + (32 * (qbl + i) + 16 * s2 + 4 * hh) * 2;
                        const u32x2 v0 = *(const LAS u32x2*)vp, v1 = *(const LAS u32x2*)(vp + 16); u32x4 av; av.x = v0.x; av.y = v0.y; av.z = v1.x; av.w = v1.y;
                        O[dt] = MFMA32(__builtin_bit_cast(bf16x8, av), __builtin_bit_cast(bf16x8, pb), O[dt]); }
                    asm volatile("" ::: "memory");
                } } }
        const float inv = 1.f / l;
#pragma unroll
        for (int dt = 0; dt < 2; ++dt)
#pragma unroll
            for (int g = 0; g < 4; ++g) { u32x2 w; w.x = pk_bf16(O[dt][4 * g] * inv, O[dt][4 * g + 1] * inv); w.y = pk_bf16(O[dt][4 * g + 2] * inv, O[dt][4 * g + 3] * inv);
                *(u32x2*)(ya + trow * 512 + h * 64 + 32 * dt + 8 * g + 4 * hh) = w; }
    }
    __syncthreads();
}

DI void hgrn_prep_unit(bf16_t* qd, bf16_t* kinv, bf16_t* kendT, float* dec, const float* lb, int bh, int c, int dk2) {
    const int b = bh >> 2, h = bh & 3;
    bf16_t* qp = qd + ((size_t)b * SEQ + c * 64) * 512 + h * 128 + dk2; bf16_t* kp = kinv + ((size_t)b * SEQ + c * 64) * 512 + h * 128 + dk2;
    const float lb0 = lb[h * 128 + dk2], lb1 = lb[h * 128 + dk2 + 1], om0 = 1.f - lb0, om1 = 1.f - lb1;
    float b0 = 0.f, b1 = 0.f; unsigned kv[64];
#pragma unroll
    for (int s0 = 0; s0 < 64; s0 += 8) {
        unsigned qw[8], fw[8];
#pragma unroll
        for (int i = 0; i < 8; ++i) { qw[i] = *(const unsigned*)(qp + (size_t)(s0 + i) * 512); fw[i] = *(const unsigned*)(kp + (size_t)(s0 + i) * 512); }
#pragma unroll
        for (int i = 0; i < 8; ++i) {
            const float f0 = lb0 + om0 * sigm(bflo(fw[i])), f1 = lb1 + om1 * sigm(bfhi(fw[i]));
            b0 += __logf(f0); b1 += __logf(f1);
            const float e0 = __expf(b0), e1 = __expf(b1), i0 = __builtin_amdgcn_rcpf(e0), i1 = __builtin_amdgcn_rcpf(e1);
            const float q0 = bflo(qw[i]), q1 = bfhi(qw[i]);
            *(unsigned*)(qp + (size_t)(s0 + i) * 512) = pk_bf16(q0 * sigm(q0) * e0, q1 * sigm(q1) * e1);
            kv[s0 + i] = pk_bf16((1.f - f0) * i0, (1.f - f1) * i1);
            *(unsigned*)(kp + (size_t)(s0 + i) * 512) = kv[s0 + i];
        }
    }
    const float d0 = __expf(b0), d1 = __expf(b1);
    *(f32x2*)(dec + (size_t)(bh * 64 + c) * 128 + dk2) = (f32x2){d0, d1};
    bf16_t* r0 = kendT + (size_t)(bh * 128 + dk2) * SEQ + c * 64; bf16_t* r1 = r0 + SEQ;
#pragma unroll
    for (int s0 = 0; s0 < 64; s0 += 8) { u32x4 w0, w1;
#pragma unroll
        for (int i = 0; i < 4; ++i) { const unsigned ka = kv[s0 + 2 * i], kb = kv[s0 + 2 * i + 1];
            w0[i] = pk_bf16(bflo(ka) * d0, bflo(kb) * d0); w1[i] = pk_bf16(bfhi(ka) * d1, bfhi(kb) * d1); }
        *(u32x4*)(r0 + s0) = w0; *(u32x4*)(r1 + s0) = w1; }
}
DI void hgrn_ds_unit(const bf16_t* kendT, const bf16_t* vT, bf16_t* dsT, int bh, int c) {
    const int lane = threadIdx.x & 63, wave = threadIdx.x >> 6, r = lane & 31, hh = lane >> 5, i = wave >> 1, j0 = 2 * (wave & 1);
    const bf16_t* ka = kendT + (size_t)(bh * 128 + 32 * i + r) * SEQ + c * 64 + 8 * hh;
    const bf16_t* vb0 = vT + (size_t)(bh * 128 + 32 * j0 + r) * SEQ + c * 64 + 8 * hh; const bf16_t* vb1 = vb0 + (size_t)32 * SEQ;
    f32x16 D0, D1;
#pragma unroll
    for (int q = 0; q < 16; ++q) { D0[q] = 0.f; D1[q] = 0.f; }
#pragma unroll
    for (int ks = 0; ks < 4; ++ks) { const bf16x8 a = *(const bf16x8*)(ka + 16 * ks), b0 = *(const bf16x8*)(vb0 + 16 * ks), b1 = *(const bf16x8*)(vb1 + 16 * ks); D0 = MFMA32(a, b0, D0); D1 = MFMA32(a, b1, D1); }
    const int unit = bh * 64 + c;
    bf16_t* o0 = dsT + (size_t)(unit * 128 + 32 * j0 + r) * 128 + 32 * i + 4 * hh; bf16_t* o1 = o0 + 32 * 128;
#pragma unroll
    for (int g = 0; g < 4; ++g) { u32x2 w; w.x = pk_bf16(D0[4 * g], D0[4 * g + 1]); w.y = pk_bf16(D0[4 * g + 2], D0[4 * g + 3]); *(u32x2*)(o0 + 8 * g) = w;
        u32x2 z; z.x = pk_bf16(D1[4 * g], D1[4 * g + 1]); z.y = pk_bf16(D1[4 * g + 2], D1[4 * g + 3]); *(u32x2*)(o1 + 8 * g) = z; }
}
DI void hgrn_scan(bf16_t* dsT, const float* dec, int vb, int G) {
    for (int idx = vb * NTHR + threadIdx.x; idx < 64 * 128 * 16; idx += G * NTHR) {
        const int dk8 = idx & 15, dv = (idx >> 4) & 127, bh = idx >> 11;
        float S[8];
#pragma unroll
        for (int q = 0; q < 8; ++q) S[q] = 0.f;
        for (int c0 = 0; c0 < 64; c0 += 8) {
            u32x4 ld[8]; f32x4 d0[8], d1[8];
#pragma unroll
            for (int i = 0; i < 8; ++i) { const int c = c0 + i; ld[i] = *(const u32x4*)(dsT + (size_t)((bh * 64 + c) * 128 + dv) * 128 + dk8 * 8);
                const float* dp = dec + (size_t)(bh * 64 + c) * 128 + dk8 * 8; d0[i] = *(const f32x4*)dp; d1[i] = *(const f32x4*)(dp + 4); }
#pragma unroll
            for (int i = 0; i < 8; ++i) { const int c = c0 + i;
                u32x4 w; w.x = pk_bf16(S[0], S[1]); w.y = pk_bf16(S[2], S[3]); w.z = pk_bf16(S[4], S[5]); w.w = pk_bf16(S[6], S[7]);
                *(u32x4*)(dsT + (size_t)((bh * 64 + c) * 128 + dv) * 128 + dk8 * 8) = w;
                S[0] = d0[i][0] * S[0] + bflo(ld[i].x); S[1] = d0[i][1] * S[1] + bfhi(ld[i].x); S[2] = d0[i][2] * S[2] + bflo(ld[i].y); S[3] = d0[i][3] * S[3] + bfhi(ld[i].y);
                S[4] = d1[i][0] * S[4] + bflo(ld[i].z); S[5] = d1[i][1] * S[5] + bfhi(ld[i].z); S[6] = d1[i][2] * S[6] + bflo(ld[i].w); S[7] = d1[i][3] * S[7] + bfhi(ld[i].w); }
        }
    }
}
constexpr int HO_Q = 0, HO_K = 64 * 272, HO_S = 2 * 64 * 272, HO_V = HO_S + 128 * 272, HO_Z = HO_V + 128 * 144;
struct HoPre { u32x4 c[10]; u32x4 g0, g1; };
DI void ho_fetch(HoPre& p, const bf16_t* qd, const bf16_t* kinv, const bf16_t* vT, const bf16_t* spT, const bf16_t* gs, int u, int tid) {
    const int bh = u >> 6, c = u & 63, b = bh >> 2, h = bh & 3; const size_t Tb = (size_t)b * SEQ + c * 64;
#pragma unroll
    for (int k = 0; k < 2; ++k) { const int i = tid + NTHR * k, row = i >> 4, ch = i & 15; p.c[k] = *(const u32x4*)(qd + (Tb + row) * 512 + h * 128 + ch * 8); p.c[2 + k] = *(const u32x4*)(kinv + (Tb + row) * 512 + h * 128 + ch * 8); }
#pragma unroll
    for (int k = 0; k < 4; ++k) { const int i = tid + NTHR * k, row = i >> 4, ch = i & 15; p.c[4 + k] = *(const u32x4*)(spT + (size_t)((bh * 64 + c) * 128 + row) * 128 + ch * 8); }
#pragma unroll
    for (int k = 0; k < 2; ++k) { const int i = tid + NTHR * k, row = i >> 3, ch = i & 7; p.c[8 + k] = *(const u32x4*)(vT + (size_t)(bh * 128 + row) * SEQ + c * 64 + ch * 8); }
    { const int tok = tid >> 3, d16 = (tid & 7) * 16; const size_t off = (Tb + tok) * 512 + h * 128 + d16; p.g0 = *(const u32x4*)(gs + off); p.g1 = *(const u32x4*)(gs + off + 8); }
}
DI void ho_put(const HoPre& p, LAS unsigned char* lds, int tid) {
#pragma unroll
    for (int k = 0; k < 2; ++k) { const int i = tid + NTHR * k, row = i >> 4, ch = i & 15; *(LAS u32x4*)(lds + HO_Q + row * 272 + ch * 16) = p.c[k]; *(LAS u32x4*)(lds + HO_K + row * 272 + ch * 16) = p.c[2 + k]; }
#pragma unroll
    for (int k = 0; k < 4; ++k) { const int i = tid + NTHR * k, row = i >> 4, ch = i & 15; *(LAS u32x4*)(lds + HO_S + row * 272 + ch * 16) = p.c[4 + k]; }
#pragma unroll
    for (int k = 0; k < 2; ++k) { const int i = tid + NTHR * k, row = i >> 3, ch = i & 7; *(LAS u32x4*)(lds + HO_V + row * 144 + ch * 16) = p.c[8 + k]; }
}
DI void hgrn_out_phase(const bf16_t* qd, const bf16_t* kinv, const bf16_t* vT, const bf16_t* spT, const bf16_t* gs, bf16_t* yh, LAS unsigned char* lds, int vb, int G) {
    int tid_ = threadIdx.x; asm volatile("" : "+v"(tid_));
    const int tid = tid_, lane = tid & 63, wave = __builtin_amdgcn_readfirstlane(tid >> 6), r = lane & 31, hh = lane >> 5, tb = wave >> 2, db = wave & 3;
    LAS float* zs = (LAS float*)(lds + HO_Z);
    HoPre pre;
    if (vb < 64 * 64) ho_fetch(pre, qd, kinv, vT, spT, gs, vb, tid);
    for (int u = vb; u < 64 * 64; u += G) {
        const int bh = u >> 6, c = u & 63, b = bh >> 2, h = bh & 3; const size_t Tb = (size_t)b * SEQ + c * 64;
        ho_put(pre, lds, tid);
        const u32x4 g0 = pre.g0, g1 = pre.g1;
        __syncthreads();
        { const int un = (u + G < 64 * 64) ? u + G : u; ho_fetch(pre, qd, kinv, vT, spT, gs, un, tid); }
        f32x16 Z;
#pragma unroll
        for (int q = 0; q < 16; ++q) Z[q] = 0.f;
        const LAS unsigned char* qb_ = lds + HO_Q + (32 * tb + r) * 272 + 16 * hh;
        bf16x8 qf[8];
#pragma unroll
        for (int ks = 0; ks < 8; ++ks) qf[ks] = *(const LAS bf16x8*)(qb_ + 32 * ks);
        { const LAS unsigned char* sb_ = lds + HO_S + (32 * db + r) * 272 + 16 * hh;
#pragma unroll
          for (int ks = 0; ks < 8; ++ks) Z = MFMA32(qf[ks], *(const LAS bf16x8*)(sb_ + 32 * ks), Z); }
#pragma unroll
        for (int sb = 0; sb < 2; ++sb) if (sb <= tb) {
            f32x16 X;
#pragma unroll
            for (int q = 0; q < 16; ++q) X[q] = 0.f;
            const LAS unsigned char* kb_ = lds + HO_K + (32 * sb + r) * 272 + 16 * hh;
#pragma unroll
            for (int ks = 0; ks < 8; ++ks) X = MFMA32(*(const LAS bf16x8*)(kb_ + 32 * ks), qf[ks], X);
            if (sb == tb) {
#pragma unroll
                for (int q = 0; q < 16; ++q) if (crow(q, hh) > r) X[q] = 0.f;
            }
#pragma unroll
            for (int s2 = 0; s2 < 2; ++s2) {
                u32x4 pa_; pa_.x = pk_bf16(X[8 * s2], X[8 * s2 + 1]); pa_.y = pk_bf16(X[8 * s2 + 2], X[8 * s2 + 3]); pa_.z = pk_bf16(X[8 * s2 + 4], X[8 * s2 + 5]); pa_.w = pk_bf16(X[8 * s2 + 6], X[8 * s2 + 7]);
                const LAS unsigned char* vp = lds + HO_V + (32 * db + r) * 144 + (32 * sb + 16 * s2 + 4 * hh) * 2;
                const u32x2 v0 = *(const LAS u32x2*)vp, v1 = *(const LAS u32x2*)(vp + 16);
                u32x4 pb_; pb_.x = v0.x; pb_.y = v0.y; pb_.z = v1.x; pb_.w = v1.y;
                Z = MFMA32(__builtin_bit_cast(bf16x8, pa_), __builtin_bit_cast(bf16x8, pb_), Z);
            }
        }
#pragma unroll
        for (int q = 0; q < 16; ++q) zs[(32 * tb + crow(q, hh)) * 132 + 32 * db + r] = Z[q];
        __syncthreads();
        { const int tok = tid >> 3, d16 = (tid & 7) * 16; f32x4 o[4]; float ss = 0.f;
          const size_t off = (Tb + tok) * 512 + h * 128 + d16;
#pragma unroll
          for (int i = 0; i < 4; ++i) { o[i] = *(const LAS f32x4*)(zs + tok * 132 + d16 + 4 * i); ss += (o[i][0] * o[i][0] + o[i][1] * o[i][1]) + (o[i][2] * o[i][2] + o[i][3] * o[i][3]); }
          ss += __shfl_xor(ss, 1); ss += __shfl_xor(ss, 2); ss += __shfl_xor(ss, 4);
          const float rn = __builtin_amdgcn_rsqf(ss * (1.f / 128.f) + EPS);
          u32x4 w0, w1;
          w0.x = pk_bf16(o[0][0] * rn * bflo(g0.x), o[0][1] * rn * bfhi(g0.x)); w0.y = pk_bf16(o[0][2] * rn * bflo(g0.y), o[0][3] * rn * bfhi(g0.y));
          w0.z = pk_bf16(o[1][0] * rn * bflo(g0.z), o[1][1] * rn * bfhi(g0.z)); w0.w = pk_bf16(o[1][2] * rn * bflo(g0.w), o[1][3] * rn * bfhi(g0.w));
          w1.x = pk_bf16(o[2][0] * rn * bflo(g1.x), o[2][1] * rn * bfhi(g1.x)); w1.y = pk_bf16(o[2][2] * rn * bflo(g1.y), o[2][3] * rn * bfhi(g1.y));
          w1.z = pk_bf16(o[3][0] * rn * bflo(g1.z), o[3][1] * rn * bfhi(g1.z)); w1.w = pk_bf16(o[3][2] * rn * bflo(g1.w), o[3][3] * rn * bfhi(g1.w));
          *(u32x4*)(yh + off) = w0; *(u32x4*)(yh + off + 8) = w1; }
    }
    __syncthreads();
}

DI unsigned f2ord(float f) { const unsigned b = __float_as_uint(f); return b ^ ((unsigned)((int)b >> 31) | 0x80000000u); }
DI float ord2f(unsigned k) { const unsigned b = (k & 0x80000000u) ? (k ^ 0x80000000u) : ~k; return __uint_as_float(b); }
DI void ce_desc(unsigned& a, unsigned& b) { const unsigned hi = a > b ? a : b, lo = a > b ? b : a; a = hi; b = lo; }
DI void sort16_desc(unsigned (&a)[16]) {
#pragma unroll
    for (int k = 2; k <= 16; k <<= 1)
#pragma unroll
        for (int j = k >> 1; j > 0; j >>= 1)
#pragma unroll
            for (int i = 0; i < 16; ++i) { const int l = i ^ j; if (l > i) { if ((i & k) == 0) ce_desc(a[i], a[l]); else ce_desc(a[l], a[i]); } }
}
DI void merge16_desc(unsigned (&a)[16], const unsigned (&b)[16]) {
#pragma unroll
    for (int i = 0; i < 16; ++i) a[i] = a[i] > b[15 - i] ? a[i] : b[15 - i];
#pragma unroll
    for (int j = 8; j > 0; j >>= 1)
#pragma unroll
        for (int i = 0; i < 16; ++i) { const int l = i ^ j; if (l > i) ce_desc(a[i], a[l]); }
}
#define TK_INS(L, x) do { unsigned t_ = (x); _Pragma("unroll") for (int j_ = 0; j_ < 16; ++j_) { const unsigned hi_ = L[j_] > t_ ? L[j_] : t_; t_ = L[j_] > t_ ? t_ : L[j_]; L[j_] = hi_; } } while (0)

DI void topk_stage_keys(const bf16_t* keysb, LAS unsigned char* kl, int h) {
    for (int c = threadIdx.x; c < 2 * 128 * 16; c += NTHR) { const int p = c >> 11, row = (c >> 4) & 127, ch = c & 15;
        *(LAS u32x4*)(kl + (p * 128 + row) * 272 + ch * 16) = *(const u32x4*)(keysb + ((size_t)(p * 8 + h) * 128 + row) * 128 + ch * 8); }
}
DI void topk_unit(const bf16_t* qp, const LAS unsigned char* kl, unsigned short* gidx, float* ggate, LAS unsigned* tk, int quad, int h) {
    const int tid = threadIdx.x, lane = tid & 63, wave = tid >> 6, p = wave & 1, tsub = wave >> 1, r = lane & 31, hh = lane >> 5;
#pragma unroll 1
    for (int hl = 0; hl < 4; ++hl) {
        const int tok0 = (quad * 4 + hl) * 128 + tsub * 32;
        f32x16 acc[4];
#pragma unroll
        for (int kb = 0; kb < 4; ++kb)
#pragma unroll
            for (int i = 0; i < 16; ++i) acc[kb][i] = 0.f;
        const bf16_t* qrow = qp + (size_t)(tok0 + r) * 2048 + h * 256 + p * 128 + 8 * hh;
        const LAS unsigned char* kbase = kl + (p * 128 + r) * 272 + 16 * hh;
#pragma unroll
        for (int s = 0; s < 8; ++s) { const bf16x8 bq = *(const bf16x8*)(qrow + 16 * s);
#pragma unroll
            for (int kb = 0; kb < 4; ++kb) { const bf16x8 ak = *(const LAS bf16x8*)(kbase + kb * 32 * 272 + 32 * s); acc[kb] = MFMA32(ak, bq, acc[kb]); } }
        unsigned A0[16], A1[16], A2[16], A3[16];
#pragma unroll
        for (int i = 0; i < 16; ++i) { const unsigned ki = (unsigned)(crow(i, hh));
            A0[i] = (f2ord(acc[0][i]) & ~127u) | ki; A1[i] = (f2ord(acc[1][i]) & ~127u) | (32u + ki); A2[i] = (f2ord(acc[2][i]) & ~127u) | (64u + ki); A3[i] = (f2ord(acc[3][i]) & ~127u) | (96u + ki); }
        sort16_desc(A0); sort16_desc(A1); sort16_desc(A2); sort16_desc(A3);
        merge16_desc(A0, A1); merge16_desc(A2, A3); merge16_desc(A0, A2);
#pragma unroll
        for (int j = 0; j < 16; ++j) A1[j] = __shfl_xor(A0[j], 32);
        merge16_desc(A0, A1);
        if (hh == 0) { LAS u32x4* dst = (LAS u32x4*)(tk + (((hl * 2 + p) * 128 + tsub * 32 + r) * 16));
#pragma unroll
            for (int c = 0; c < 4; ++c) { u32x4 w = {A0[4 * c], A0[4 * c + 1], A0[4 * c + 2], A0[4 * c + 3]}; dst[c] = w; } }
    }
    __syncthreads();
    {
        const int tok = tid & 127, hl = tid >> 7, tile = quad * 4 + hl;
        const LAS unsigned* t1 = tk + ((hl * 2 + 0) * 128 + tok) * 16; const LAS unsigned* t2 = tk + ((hl * 2 + 1) * 128 + tok) * 16;
        float v1[16], v2[16];
        { const LAS u32x4* s1 = (const LAS u32x4*)t1; const LAS u32x4* s2 = (const LAS u32x4*)t2;
#pragma unroll
          for (int c = 0; c < 4; ++c) { const u32x4 a = s1[c], b = s2[c];
              v1[4 * c] = ord2f(a.x & ~127u); v1[4 * c + 1] = ord2f(a.y & ~127u); v1[4 * c + 2] = ord2f(a.z & ~127u); v1[4 * c + 3] = ord2f(a.w & ~127u);
              v2[4 * c] = ord2f(b.x & ~127u); v2[4 * c + 1] = ord2f(b.y & ~127u); v2[4 * c + 2] = ord2f(b.z & ~127u); v2[4 * c + 3] = ord2f(b.w & ~127u); } }
#define CKEY(i, j) ((f2ord(v1[i] + v2[j]) & ~255u) | (unsigned)((i) * 16 + (j)))
        unsigned C[16], D[16], E[16];
#pragma unroll
        for (int j = 0; j < 16; ++j) C[j] = CKEY(0, j);
#pragma unroll
        for (int j = 0; j < 8; ++j) D[j] = CKEY(1, j);
#pragma unroll
        for (int j = 0; j < 5; ++j) D[8 + j] = CKEY(2, j);
#pragma unroll
        for (int j = 0; j < 3; ++j) D[13 + j] = CKEY(4, j);
#pragma unroll
        for (int j = 0; j < 4; ++j) E[j] = CKEY(3, j);
        E[4] = CKEY(5, 0); E[5] = CKEY(5, 1); E[6] = CKEY(6, 0); E[7] = CKEY(6, 1); E[8] = CKEY(7, 0); E[9] = CKEY(7, 1);
        E[10] = CKEY(8, 0); E[11] = CKEY(9, 0); E[12] = CKEY(10, 0); E[13] = CKEY(11, 0); E[14] = CKEY(12, 0); E[15] = CKEY(13, 0);
        sort16_desc(D); sort16_desc(E);
        TK_INS(E, CKEY(14, 0)); TK_INS(E, CKEY(15, 0));
#undef CKEY
        merge16_desc(C, D); merge16_desc(C, E);
        float sc[16]; unsigned ei[16]; float mx = -1e30f;
#pragma unroll
        for (int q = 0; q < 16; ++q) { const unsigned ij = C[q] & 255u; const unsigned a = t1[ij >> 4], b = t2[ij & 15u];
            sc[q] = ord2f(a & ~127u) + ord2f(b & ~127u); ei[q] = (a & 127u) * 128u + (b & 127u); mx = fmaxf(mx, sc[q]); }
        float sum = 0.f;
#pragma unroll
        for (int q = 0; q < 16; ++q) { sc[q] = __expf(sc[q] - mx); sum += sc[q]; }
        const float inv = 1.f / sum; const size_t o = (size_t)(tile * 128 + tok) * 128 + h * 16;
        u32x4 w0, w1;
        w0.x = ei[0] | (ei[1] << 16); w0.y = ei[2] | (ei[3] << 16); w0.z = ei[4] | (ei[5] << 16); w0.w = ei[6] | (ei[7] << 16);
        w1.x = ei[8] | (ei[9] << 16); w1.y = ei[10] | (ei[11] << 16); w1.z = ei[12] | (ei[13] << 16); w1.w = ei[14] | (ei[15] << 16);
        *(u32x4*)(gidx + o) = w0; *(u32x4*)(gidx + o + 8) = w1;
#pragma unroll
        for (int c = 0; c < 4; ++c) *(f32x4*)(ggate + o + 4 * c) = (f32x4){sc[4 * c] * inv, sc[4 * c + 1] * inv, sc[4 * c + 2] * inv, sc[4 * c + 3] * inv};
    }
    __syncthreads();
}

DI float gelu_erf(float x) { return 0.5f * x * (1.f + erff(x * 0.70710678118654752f)); }
DI int dot16(u32x4 w, const int (&h)[4]) { int c = __builtin_amdgcn_sdot4((int)w.x, h[0], 0, false); c = __builtin_amdgcn_sdot4((int)w.y, h[1], c, false); c = __builtin_amdgcn_sdot4((int)w.z, h[2], c, false); return __builtin_amdgcn_sdot4((int)w.w, h[3], c, false); }
#define V8_FMA(acc4, word, we) do { acc4[0] += (we) * (float)((word) & 255u); acc4[1] += (we) * (float)(((word) >> 8) & 255u); acc4[2] += (we) * (float)(((word) >> 16) & 255u); acc4[3] += (we) * (float)((word) >> 24); } while (0)

template <int IDMASK> DI void expert_token(const bf16_t* x2row, const float* ssq, const unsigned char* u8, const unsigned char* v8, const float* su, const float* sv, const unsigned short* gidx, const float* ggate, const float* gf, float* outrow, int lane) {
    f32x4 x[4]; float amax = 0.f;
#pragma unroll
    for (int i = 0; i < 4; ++i) { const u32x2 w_ = *(const u32x2*)(x2row + 16 * lane + 4 * i); x[i] = (f32x4){bflo(w_.x), bfhi(w_.x), bflo(w_.y), bfhi(w_.y)}; amax = fmaxf(fmaxf(amax, fmaxf(fabsf(x[i][0]), fabsf(x[i][1]))), fmaxf(fabsf(x[i][2]), fabsf(x[i][3]))); }
    float ss = (lane < 16) ? ssq[lane] : 0.f; ss = wave_sum(ss);
    const float rstd2 = __builtin_amdgcn_rsqf(ss * (1.f / 1024.f) + EPS);
#pragma unroll
    for (int o = 1; o < 64; o <<= 1) amax = fmaxf(amax, __shfl_xor(amax, o));
    amax *= rstd2;
    const float qs = amax > 0.f ? 127.f / amax : 0.f, sh = amax * (1.f / 127.f), xq = rstd2 * qs;
    int hq[4];
#pragma unroll
    for (int i = 0; i < 4; ++i) { const int q0 = (int)rintf(x[i][0] * xq), q1 = (int)rintf(x[i][1] * xq), q2 = (int)rintf(x[i][2] * xq), q3 = (int)rintf(x[i][3] * xq);
        hq[i] = (int)((unsigned)(q0 & 255) | ((unsigned)(q1 & 255) << 8) | ((unsigned)(q2 & 255) << 16) | ((unsigned)(q3 & 255) << 24)); }
    const int id0 = gidx[lane] & IDMASK, id1 = gidx[64 + lane] & IDMASK; const float g0 = ggate[lane], g1 = ggate[64 + lane];
    f32x4 o[4]; float wsum = 0.f;
#pragma unroll
    for (int i = 0; i < 4; ++i) o[i] = (f32x4){0.f, 0.f, 0.f, 0.f};
#pragma unroll 1
    for (int bt = 0; bt < 16; ++bt) {
        const int idsel = (bt < 8) ? id0 : id1; const float gsel = (bt < 8) ? g0 : g1; const int lb = (bt & 7) * 8;
        u32x4 ur[8], vr[8];
#pragma unroll
        for (int e = 0; e < 8; ++e) { const int idx = __builtin_amdgcn_readlane(idsel, lb + e); ur[e] = *(const u32x4*)(u8 + (size_t)idx * 1024 + 16 * lane); }
#pragma unroll
        for (int e = 0; e < 8; ++e) { const int idx = __builtin_amdgcn_readlane(idsel, lb + e); vr[e] = *(const u32x4*)(v8 + (size_t)idx * 1024 + 16 * lane); }
        const int myidx = __shfl(idsel, lb + (lane >> 3)); const float mysu = su[myidx], mysv = sv[myidx], gate = __shfl(gsel, lb + (lane >> 3));
        int pr[8];
#pragma unroll
        for (int e = 0; e < 8; ++e) pr[e] = dot16(ur[e], hq);
        int q4[4], q2[2], q1;
        { const bool up_ = (lane & 32) != 0;
#pragma unroll
          for (int i = 0; i < 4; ++i) { const int keep = up_ ? pr[i + 4] : pr[i], send = up_ ? pr[i] : pr[i + 4]; q4[i] = keep + __shfl_xor(send, 32); } }
        { const bool up_ = (lane & 16) != 0;
#pragma unroll
          for (int i = 0; i < 2; ++i) { const int keep = up_ ? q4[i + 2] : q4[i], send = up_ ? q4[i] : q4[i + 2]; q2[i] = keep + __shfl_xor(send, 16); } }
        { const bool up_ = (lane & 8) != 0; const int keep = up_ ? q2[1] : q2[0], send = up_ ? q2[0] : q2[1]; q1 = keep + __shfl_xor(send, 8); }
        q1 += __shfl_xor(q1, 4); q1 += __shfl_xor(q1, 2); q1 += __shfl_xor(q1, 1);
        const float act = (float)q1 * (mysu * sh);
        const float w = gelu_erf(act) * gate * mysv;
#pragma unroll
        for (int e = 0; e < 8; ++e) { const float we = __int_as_float(__builtin_amdgcn_readlane(__float_as_int(w), 8 * e)); wsum += we;
            V8_FMA(o[0], vr[e].x, we); V8_FMA(o[1], vr[e].y, we); V8_FMA(o[2], vr[e].z, we); V8_FMA(o[3], vr[e].w, we); }
    }
    const float corr = 128.f * wsum; float s3 = 0.f;
#pragma unroll
    for (int i = 0; i < 4; ++i) { x[i] += o[i] - corr; s3 += (x[i][0] * x[i][0] + x[i][1] * x[i][1]) + (x[i][2] * x[i][2] + x[i][3] * x[i][3]); }
    s3 = wave_sum(s3); const float r3 = __builtin_amdgcn_rsqf(s3 * (1.f / 1024.f) + EPS);
#pragma unroll
    for (int i = 0; i < 4; ++i) *(f32x4*)(outrow + 16 * lane + 4 * i) = x[i] * r3 * *(const f32x4*)(gf + 16 * lane + 4 * i);
}

DI void hq_token(const bf16_t* x2row, const float* ssq, unsigned char* hqrow, float* shp, int lane) {
    f32x4 x[4]; float amax = 0.f;
#pragma unroll
    for (int i = 0; i < 4; ++i) { const u32x2 w_ = *(const u32x2*)(x2row + 16 * lane + 4 * i); x[i] = (f32x4){bflo(w_.x), bfhi(w_.x), bflo(w_.y), bfhi(w_.y)}; amax = fmaxf(fmaxf(amax, fmaxf(fabsf(x[i][0]), fabsf(x[i][1]))), fmaxf(fabsf(x[i][2]), fabsf(x[i][3]))); }
    float ss = (lane < 16) ? ssq[lane] : 0.f; ss = wave_sum(ss);
    const float rstd2 = __builtin_amdgcn_rsqf(ss * (1.f / 1024.f) + EPS);
#pragma unroll
    for (int o = 1; o < 64; o <<= 1) amax = fmaxf(amax, __shfl_xor(amax, o));
    amax *= rstd2;
    const float qs = amax > 0.f ? 127.f / amax : 0.f, xq = rstd2 * qs;
    u32x4 w;
#pragma unroll
    for (int i = 0; i < 4; ++i) { const int q0 = (int)rintf(x[i][0] * xq), q1 = (int)rintf(x[i][1] * xq), q2 = (int)rintf(x[i][2] * xq), q3 = (int)rintf(x[i][3] * xq);
        w[i] = (unsigned)(q0 & 255) | ((unsigned)(q1 & 255) << 8) | ((unsigned)(q2 & 255) << 16) | ((unsigned)(q3 & 255) << 24); }
    *(u32x4*)(hqrow + 16 * lane) = w;
    if (lane == 0) *shp = amax * (1.f / 127.f);
}
template <int CTRL> DI int dpp_i(int v) { return __builtin_amdgcn_mov_dpp(v, CTRL, 0xf, 0xf, true); }
template <int CTRL> DI float dpp_f(float v) { return __int_as_float(__builtin_amdgcn_mov_dpp(__float_as_int(v), CTRL, 0xf, 0xf, true)); }
DI float swapadd32(float a, float b) { const auto r = __builtin_amdgcn_permlane32_swap(__float_as_uint(a), __float_as_uint(b), false, false); return __uint_as_float(r[0]) + __uint_as_float(r[1]); }
DI float swapadd16(float a, float b) { const auto r = __builtin_amdgcn_permlane16_swap(__float_as_uint(a), __float_as_uint(b), false, false); return __uint_as_float(r[0]) + __uint_as_float(r[1]); }

struct SMeta { u32x4 i0, i1, a0, a1; unsigned xw; };
DI void slice_issue(u32x4 (&r)[16], const SMeta& m, const unsigned char* base) {
    const unsigned iw[8] = {m.i0.x, m.i0.y, m.i0.z, m.i0.w, m.i1.x, m.i1.y, m.i1.z, m.i1.w};
#pragma unroll
    for (int j = 0; j < 16; ++j) { const unsigned idx = (j & 1) ? (iw[j >> 1] >> 16) : (iw[j >> 1] & 0xffffu); r[j] = *(const u32x4*)(base + (size_t)idx * 1024); }
}
DI void slice_u_compute(const SMeta& m, const u32x4 (&r)[16], int* actp, int lane) {
    const int hq[4] = {(int)m.a0.x, (int)m.a0.y, (int)m.a0.z, (int)m.a0.w};
    int part[16];
#pragma unroll
    for (int j = 0; j < 16; ++j) part[j] = dot16(r[j], hq);
    int r8[8], r4[4], r2[2];
    { const bool up_ = (lane & 4) != 0;
#pragma unroll
      for (int i = 0; i < 8; ++i) { const int keep = up_ ? part[i + 8] : part[i], send = up_ ? part[i] : part[i + 8]; r8[i] = keep + dpp_i<0x141>(send); } }
    { const bool up_ = (lane & 2) != 0;
#pragma unroll
      for (int i = 0; i < 4; ++i) { const int keep = up_ ? r8[i + 4] : r8[i], send = up_ ? r8[i] : r8[i + 4]; r4[i] = keep + dpp_i<0x4E>(send); } }
    { const bool up_ = (lane & 1) != 0;
#pragma unroll
      for (int i = 0; i < 2; ++i) { const int keep = up_ ? r4[i + 2] : r4[i], send = up_ ? r4[i] : r4[i + 2]; r2[i] = keep + dpp_i<0xB1>(send); } }
    actp[lane] = (int)((unsigned)(((r2[0] + 32) >> 6) & 0xffff) | ((unsigned)((r2[1] + 32) >> 6) << 16));
}
DI int swapadd32i(int a, int b) { const auto r = __builtin_amdgcn_permlane32_swap((unsigned)a, (unsigned)b, false, false); return (int)r[0] + (int)r[1]; }
DI int swapadd16i(int a, int b) { const auto r = __builtin_amdgcn_permlane16_swap((unsigned)a, (unsigned)b, false, false); return (int)r[0] + (int)r[1]; }
DI void slice_v_compute(const SMeta& m, const u32x4 (&r)[16], float* x3row, float* ssq3p, int xs, int lane) {
    const int wq[4] = {(int)m.a0.x, (int)m.a0.y, (int)m.a0.z, (int)m.a0.w};
    const float sw = __uint_as_float(m.a1.x);
    const int col = 16 * (lane & 7) + ((lane >> 5) & 1) * 8 + ((lane >> 4) & 1) * 4 + ((lane >> 3) & 1) * 2;
    int o[16];
#pragma unroll
    for (int i = 0; i < 16; ++i) o[i] = 0;
#pragma unroll
    for (int q = 0; q < 4; ++q)
#pragma unroll
        for (int p = 0; p < 4; ++p) {
            const unsigned d0 = r[4 * q][p], d1 = r[4 * q + 1][p], d2 = r[4 * q + 2][p], d3 = r[4 * q + 3][p];
            const unsigned t0 = __builtin_amdgcn_perm(d1, d0, 0x05010400u), t1 = __builtin_amdgcn_perm(d1, d0, 0x07030602u), t2 = __builtin_amdgcn_perm(d3, d2, 0x05010400u), t3 = __builtin_amdgcn_perm(d3, d2, 0x07030602u);
            const unsigned e0 = __builtin_amdgcn_perm(t2, t0, 0x05040100u), e1 = __builtin_amdgcn_perm(t2, t0, 0x07060302u), e2 = __builtin_amdgcn_perm(t3, t1, 0x05040100u), e3 = __builtin_amdgcn_perm(t3, t1, 0x07060302u);
            o[4 * p] = __builtin_amdgcn_sdot4((int)e0, wq[q], o[4 * p], false); o[4 * p + 1] = __builtin_amdgcn_sdot4((int)e1, wq[q], o[4 * p + 1], false);
            o[4 * p + 2] = __builtin_amdgcn_sdot4((int)e2, wq[q], o[4 * p + 2], false); o[4 * p + 3] = __builtin_amdgcn_sdot4((int)e3, wq[q], o[4 * p + 3], false);
        }
    int a8[8], a4[4], a2[2];
#pragma unroll
    for (int i = 0; i < 8; ++i) a8[i] = swapadd32i(o[i], o[8 + i]);
#pragma unroll
    for (int i = 0; i < 4; ++i) a4[i] = swapadd16i(a8[i], a8[i + 4]);
    { const bool up_ = (lane & 8) != 0;
#pragma unroll
      for (int i = 0; i < 2; ++i) { const int keep = up_ ? a4[i + 2] : a4[i], send = up_ ? a4[i] : a4[i + 2]; a2[i] = keep + dpp_i<0x128>(send); } }
    const float y0 = bflo(m.xw) + (float)a2[0] * sw, y1 = bfhi(m.xw) + (float)a2[1] * sw;
    *(f32x2*)(x3row + 128 * xs + col) = (f32x2){y0, y1};
    const float ss = wave_sum(y0 * y0 + y1 * y1);
    if (lane == 0) ssq3p[xs] = ss;
}
template <int MODE> DI void slice_pass(unsigned char* ws, float* out, int xs, int gw_, int nw_, int lane) {
    const int g = lane >> 3, c = lane & 7;
    const unsigned short* gidx = (const unsigned short*)(ws + WS_GIDX) + 16 * g;
    const unsigned char* tab = (MODE == 0 ? (const unsigned char*)(ws + WS_U8) : (const unsigned char*)(ws + WS_V8)) + 128 * xs + 16 * c;
    const unsigned char* hqb = (const unsigned char*)(ws + WS_HQ) + 128 * xs + 16 * c;
    const unsigned char* wxb = (const unsigned char*)(ws + WS_WX) + 16 * g;
    const bf16_t* x2b = (const bf16_t*)(ws + WS_X2B) + 128 * xs + 16 * c + ((lane >> 5) & 1) * 8 + ((lane >> 4) & 1) * 4 + ((lane >> 3) & 1) * 2;
#define S_LOAD(m, tok) do { const unsigned short* ip = gidx + (size_t)(tok) * 128; (m).i0 = *(const u32x4*)ip; (m).i1 = *(const u32x4*)(ip + 8); \
        if (MODE == 0) { (m).a0 = *(const u32x4*)(hqb + (size_t)(tok) * 1024); } else { (m).a0 = *(const u32x4*)(wxb + (size_t)(tok) * 128); (m).a1.x = __float_as_uint(((const float*)(ws + WS_SW))[tok]); (m).xw = *(const unsigned*)(x2b + (size_t)(tok) * DM); } } while (0)
#define S_COMPUTE(m, r, tok) do { if (MODE == 0) slice_u_compute(m, r, (int*)(ws + WS_ACTP) + ((size_t)(tok) * 8 + xs) * 64, lane); \
        else slice_v_compute(m, r, out + (size_t)(tok) * DM, (float*)(ws + WS_SSQ3) + (size_t)(tok) * 8, xs, lane); } while (0)
    SMeta mA, mB, mN; u32x4 rA[16], rB[16];
    if (gw_ >= T) return;
    const int n = (T - gw_ + nw_ - 1) / nw_;
#define S_TK(j) (gw_ + ((j) < n ? (j) : n - 1) * nw_)
    S_LOAD(mA, S_TK(0)); slice_issue(rA, mA, tab); S_LOAD(mB, S_TK(1));
    for (int i = 0; i < n; i += 2) {
        slice_issue(rB, mB, tab);
        S_LOAD(mN, S_TK(i + 2));
        S_COMPUTE(mA, rA, S_TK(i));
        mA = mN; slice_issue(rA, mA, tab);
        S_LOAD(mN, S_TK(i + 3));
        if (i + 1 < n) S_COMPUTE(mB, rB, S_TK(i + 1));
        mB = mN;
    }
#undef S_TK
#undef S_LOAD
#undef S_COMPUTE
}
DI void expert_w_token(const int* actp, const unsigned short* gidx, const float* ggate, float sh, const float* su, const float* sv, unsigned char* wrow, float* swp, int lane) {
    typedef int i32x2 __attribute__((ext_vector_type(2)));
    i32x2 acc = {0, 0};
#pragma unroll
    for (int x = 0; x < 8; ++x) { const int w_ = actp[x * 64 + lane]; acc[0] += (int)(short)(w_ & 0xffff); acc[1] += w_ >> 16; }
    acc[0] <<= 6; acc[1] <<= 6;
    const unsigned ii = *(const unsigned*)(gidx + 2 * lane); const f32x2 gt = *(const f32x2*)(ggate + 2 * lane);
    const int e0 = ii & 0xffffu, e1 = ii >> 16;
    const float w0 = gelu_erf((float)acc[0] * (su[e0] * sh)) * gt[0] * sv[e0], w1 = gelu_erf((float)acc[1] * (su[e1] * sh)) * gt[1] * sv[e1];
    float amax = fmaxf(fabsf(w0), fabsf(w1));
    amax = fmaxf(amax, dpp_f<0xB1>(amax)); amax = fmaxf(amax, dpp_f<0x4E>(amax)); amax = fmaxf(amax, dpp_f<0x141>(amax)); amax = fmaxf(amax, dpp_f<0x128>(amax));
    { const auto r = __builtin_amdgcn_permlane16_swap(__float_as_uint(amax), __float_as_uint(amax), false, false); amax = fmaxf(__uint_as_float(r[0]), __uint_as_float(r[1])); }
    { const auto r = __builtin_amdgcn_permlane32_swap(__float_as_uint(amax), __float_as_uint(amax), false, false); amax = fmaxf(__uint_as_float(r[0]), __uint_as_float(r[1])); }
    const float qs = amax > 0.f ? 127.f / amax : 0.f;
    const int q0 = (int)rintf(w0 * qs), q1 = (int)rintf(w1 * qs);
    *(unsigned short*)(wrow + 2 * lane) = (unsigned short)((q0 & 255) | ((q1 & 255) << 8));
    if (lane == 0) *swp = amax * (1.f / 127.f);
}
DI void final_norm_token(float* row, const float* ssq3p, const float* gf, int lane) {
    float ss = (lane < 8) ? ssq3p[lane] : 0.f; ss = wave_sum(ss);
    const float r3 = __builtin_amdgcn_rsqf(ss * (1.f / 1024.f) + EPS);
#pragma unroll
    for (int i = 0; i < 4; ++i) { f32x4* p = (f32x4*)(row + 256 * i + 4 * lane); *p = *p * r3 * *(const f32x4*)(gf + 256 * i + 4 * lane); }
}

#define XB_TMO      128
#define XB_XCNT(j)  (256  + 64 * (j))
#define XB_XSUB(j)  (1280 + 64 * (j))
#define XB_XGEN(j)  (2304 + 64 * (j))
#define XB_TOP      3328
#define XB_TOPGEN   3392
#define XCD_BAR_WORDS 3456
#define XB_SPIN_CAP (1u << 18)

__device__ __forceinline__ unsigned xb_ld(unsigned* p)              { return __hip_atomic_load(p, __ATOMIC_RELAXED, __HIP_MEMORY_SCOPE_AGENT); }
__device__ __forceinline__ unsigned xb_add(unsigned* p, unsigned v) { return __hip_atomic_fetch_add(p, v, __ATOMIC_RELAXED, __HIP_MEMORY_SCOPE_AGENT); }
__device__ __forceinline__ unsigned xb_xcc_id() { return (unsigned)__builtin_amdgcn_s_getreg((3 << 11) | 20) & 0xFu; }
#define XB_SPIN(cond, bar) do { unsigned _sp = 0; while (cond) { __builtin_amdgcn_s_sleep(1); \
    if ((++_sp & 255u) == 0u) { if (xb_ld(&(bar)[XB_TMO])) break; if (_sp > XB_SPIN_CAP) { atomicAdd(&(bar)[XB_TMO], 1u); break; } } } } while (0)

struct XcdBarrier {
    unsigned* bar; unsigned x;
    volatile __attribute__((address_space(3))) unsigned* st;
};

__device__ __forceinline__ XcdBarrier xcd_barrier_post(unsigned* bar, volatile __attribute__((address_space(3))) unsigned* st) {
    XcdBarrier b; b.bar = bar; b.x = xb_xcc_id(); b.st = st;
    if (threadIdx.x == 0) st[2] = xb_add(&bar[XB_XCNT(b.x)], 1u);
    return b;
}
__device__ __forceinline__ void xcd_barrier_complete(unsigned* bar, unsigned x, unsigned& nloc, unsigned& nx) {
    const unsigned G = gridDim.x * gridDim.y * gridDim.z;
    unsigned sum, cnt, mine, sp = 0u;
    for (;;) {
        sum = 0u; cnt = 0u; mine = 0u;
#pragma unroll
        for (unsigned j = 0; j < 16; ++j) { const unsigned c = xb_ld(&bar[XB_XCNT(j)]); sum += c; cnt += (c > 0u) ? 1u : 0u; mine = (j == x) ? c : mine; }
        if (sum == G) break;
        __builtin_amdgcn_s_sleep(1);
        if ((++sp & 255u) == 0u) { if (xb_ld(&bar[XB_TMO])) break; if (sp > XB_SPIN_CAP) { atomicAdd(&bar[XB_TMO], 1u); break; } }
    }
    nloc = mine > 0u ? mine : 1u; nx = cnt > 0u ? cnt : 1u;
}

__device__ __forceinline__ void xcd_barrier(const XcdBarrier& b) {
    asm volatile("s_waitcnt vmcnt(0)" ::: "memory");
    __syncthreads();
    if (threadIdx.x == 0) {
        unsigned* bar = b.bar;
        __builtin_amdgcn_s_waitcnt(0);
        unsigned nloc = b.st[0], nx = b.st[1];
        if (nloc == 0u) { xcd_barrier_complete(bar, b.x, nloc, nx); b.st[0] = nloc; b.st[1] = nx; }
        const unsigned old = xb_add(&bar[XB_XSUB(b.x)], 1u);
        const unsigned gen = old / nloc;
        if (old + 1u == (gen + 1u) * nloc) {
            __builtin_amdgcn_fence(__ATOMIC_RELEASE, "agent");
            asm volatile("s_waitcnt vmcnt(0)" ::: "memory");
            const unsigned og = xb_add(&bar[XB_TOP], 1u);
            const unsigned tg = og / nx;
            if (og + 1u == (tg + 1u) * nx) xb_add(&bar[XB_TOPGEN], 1u);
            else XB_SPIN(xb_ld(&bar[XB_TOPGEN]) == tg, bar);
            __builtin_amdgcn_fence(__ATOMIC_ACQUIRE, "agent");
            xb_add(&bar[XB_XGEN(b.x)], 1u);
            asm volatile("s_waitcnt vmcnt(0)" ::: "memory");
        } else {
            XB_SPIN(xb_ld(&bar[XB_XGEN(b.x)]) == gen, bar);
            __builtin_amdgcn_fence(__ATOMIC_ACQUIRE, "agent");
            asm volatile("s_waitcnt vmcnt(0)" ::: "memory");
        }
    }
    __syncthreads();
}

constexpr int N_PHASES = 13;
__global__ void __launch_bounds__(NTHR, 2) mk_fwd(Args a) {
    extern __shared__ __attribute__((aligned(16))) unsigned char lds_raw[];
    LAS unsigned char* lds = (LAS unsigned char*)lds_raw;
    cg::grid_group grid = cg::this_grid();
    const int G = gridDim.x, vb = blockIdx.x, tid = threadIdx.x, lane = tid & 63, wave = tid >> 6;
    unsigned char* ws = a.ws;
    const int lo = a.ph_lo, hi = a.ph_hi;
    volatile LAS unsigned* MISC = (volatile LAS unsigned*)(lds + LDS_BYTES - 64);
    if (tid < 16) MISC[tid] = 0u;
    __syncthreads();
    const XcdBarrier bar = xcd_barrier_post((unsigned*)(ws + 4096) + lo * XCD_BAR_WORDS, MISC);
#ifndef PHASE_MASK
#define PHASE_MASK 0xFFFF
#endif
#define IN(k) (((PHASE_MASK >> (k)) & 1) && lo <= (k) && (k) < hi)
#ifndef REPEAT_MASK
#define REPEAT_MASK 0
#endif
#define REP(k) for (int rep_ = 0; rep_ < (((REPEAT_MASK) >> (k)) & 1) + 1; ++rep_)
#define SEAM(k) do { if (IN(k) && IN((k) + 1)) { if ((k) == 0) grid.sync(); else xcd_barrier(bar); } } while (0)
    REP(0) if (IN(0)) p0_prologue(a, lds, vb, G);
    SEAM(0);
    REP(1) if (IN(1)) { pg8::Gemm g{(const bf16_t*)(ws + WS_XB), (const bf16_t*)(ws + WS_W1T), T, NIN, 1024}; pg8::StaticOrder S; S.init(T, NIN, G, vb);
        pg8::Epi1 E{(const float*)(ws + WS_RSTD1), (bf16_t*)(ws + WS_PA), (bf16_t*)(ws + WS_GG), (bf16_t*)(ws + WS_QD), (bf16_t*)(ws + WS_KINV), (bf16_t*)(ws + WS_KENDT), (bf16_t*)(ws + WS_VT), (bf16_t*)(ws + WS_GS),
                    (float*)(ws + WS_DEC), (const float*)(ws + WS_LB), (bf16_t*)(ws + WS_AVT), lds + 131072};
        pg8::gemm_phase<pg8::Epi1, pg8::StaticOrder, true, true>(lds, g, S, E); }
#ifdef PROBE_GEMM1_PLAIN
    if (IN(1)) { pg8::Gemm g{(const bf16_t*)(ws + WS_XB), (const bf16_t*)(ws + WS_W1T), T, NIN, 1024}; pg8::StaticOrder S; S.init(T, NIN, G, vb);
        pg8::EpiDummy E{(bf16_t*)(ws + WS_YA), (const float*)(ws + WS_RSTD1)};
        pg8::gemm_phase<pg8::EpiDummy, pg8::StaticOrder, true, true>(lds, g, S, E); }
#endif
    SEAM(1);
    REP(2) if (IN(2)) {
        for (int u0 = vb * 8; u0 < 64 * 64; u0 += G * 8) {
            { int t2_ = threadIdx.x; asm volatile("" : "+v"(t2_)); const int u = u0 + (t2_ >> 6); hgrn_prep_unit((bf16_t*)(ws + WS_QD), (bf16_t*)(ws + WS_KINV), (bf16_t*)(ws + WS_KENDT), (float*)(ws + WS_DEC), (const float*)(ws + WS_LB), u >> 6, u & 63, (t2_ & 63) * 2); }
            __syncthreads();
            for (int j = 0; j < 8; ++j) hgrn_ds_unit((const bf16_t*)(ws + WS_KENDT), (const bf16_t*)(ws + WS_VT), (bf16_t*)(ws + WS_XB), (u0 + j) >> 6, (u0 + j) & 63);
        }
        for (int u = vb; u < BATCH * (SEQ / 64); u += G) attn_unit((const bf16_t*)(ws + WS_PA), (const bf16_t*)(ws + WS_AVT), a.in[3], (bf16_t*)(ws + WS_YA), lds, u >> 6, u & 63);
    }
    SEAM(2);
    REP(3) if (IN(3)) hgrn_scan((bf16_t*)(ws + WS_XB), (const float*)(ws + WS_DEC), vb, G);
    SEAM(3);
    REP(4) if (IN(4)) hgrn_out_phase((const bf16_t*)(ws + WS_QD), (const bf16_t*)(ws + WS_KINV), (const bf16_t*)(ws + WS_VT), (const bf16_t*)(ws + WS_XB), (const bf16_t*)(ws + WS_GS), (bf16_t*)(ws + WS_YH), lds, vb, G);
    SEAM(4);
    REP(5) if (IN(5)) {
        { pg8::Gemm g{(const bf16_t*)(ws + WS_YA), (const bf16_t*)(ws + WS_WAPT), T, 1024, 512}; pg8::StaticOrder S; S.init(T, 1024, G, vb);
          pg8::EpiMerge<false> E{(bf16_t*)(ws + WS_XB), (const bf16_t*)(ws + WS_GG)};
          pg8::gemm_phase<pg8::EpiMerge<false>, pg8::StaticOrder, true, true>(lds, g, S, E); }
        __syncthreads();
        { pg8::Gemm g{(const bf16_t*)(ws + WS_YH), (const bf16_t*)(ws + WS_WHPT), T, 1024, 512}; pg8::StaticOrder S; S.init(T, 1024, G, vb);
          pg8::EpiMerge<true> E{(bf16_t*)(ws + WS_XB), (const bf16_t*)(ws + WS_GG) + 1024};
          pg8::gemm_phase<pg8::EpiMerge<true>, pg8::StaticOrder, true, true>(lds, g, S, E); }
    }
    SEAM(5);
    REP(6) if (IN(6)) { pg8::Gemm g{(const bf16_t*)(ws + WS_XB), (const bf16_t*)(ws + WS_WOUTT), T, 1024, 1024}; pg8::StaticOrder S; S.init(T, 1024, G, vb);
        pg8::EpiX2 E{a.in[0], (bf16_t*)(ws + WS_X2B), (float*)(ws + WS_SSQ2)};
        pg8::gemm_phase<pg8::EpiX2, pg8::StaticOrder, true, true>(lds, g, S, E); }
    SEAM(6);
    REP(7) if (IN(7)) { pg8::Gemm g{(const bf16_t*)(ws + WS_X2B), (const bf16_t*)(ws + WS_WQT), T, 2048, 1024}; pg8::StaticOrder S; S.init(T, 2048, G, vb);
        pg8::EpiQp E{(bf16_t*)(ws + WS_QP), (const float*)(ws + WS_SSQ2)};
        pg8::gemm_phase<pg8::EpiQp, pg8::StaticOrder, true, true>(lds, g, S, E); }
    SEAM(7);
    REP(8) if (IN(8)) { const int per = (1024 + G - 1) / G; int hcur = -1;
        for (int U = vb * per; U < (vb + 1) * per && U < 1024; ++U) { const int h = U >> 7;
            if (h != hcur) { topk_stage_keys((const bf16_t*)(ws + WS_KEYS), lds + 65536, h); hcur = h; __syncthreads(); }
            topk_unit((const bf16_t*)(ws + WS_QP), lds + 65536, (unsigned short*)(ws + WS_GIDX), (float*)(ws + WS_GGATE), (LAS unsigned*)lds, U & 127, h); }
        for (int tok = vb * 8 + wave; tok < T; tok += G * 8) hq_token((const bf16_t*)(ws + WS_X2B) + (size_t)tok * DM, (const float*)(ws + WS_SSQ2) + (size_t)tok * 16, (unsigned char*)(ws + WS_HQ) + (size_t)tok * 1024, (float*)(ws + WS_SH) + tok, lane); }
    SEAM(8);
    if (IN(9) || IN(11)) {
        if (tid == 0) {
            unsigned nloc_ = 0, nx_ = 0; xcd_barrier_complete(bar.bar, bar.x, nloc_, nx_);
            unsigned cj[8], tot = 0; bool all = true;
#pragma unroll
            for (int j = 0; j < 8; ++j) { cj[j] = xb_ld(&bar.bar[XB_XCNT(j)]); tot += cj[j]; all = all && cj[j] > 0u; }
            if (all && tot == (unsigned)G && bar.x < 8u) { MISC[4] = bar.x; MISC[5] = MISC[2]; MISC[6] = cj[bar.x & 7u]; }
            else { const unsigned sl_ = (unsigned)vb & 7u; MISC[4] = sl_; MISC[5] = (unsigned)vb >> 3; MISC[6] = ((unsigned)G - sl_ + 7u) >> 3; }
        }
        __syncthreads();
    }
    REP(9) if (IN(9)) slice_pass<0>(ws, a.out, (int)MISC[4], (int)MISC[5] * 8 + __builtin_amdgcn_readfirstlane(wave), (int)MISC[6] * 8, lane);
    SEAM(9);
    REP(10) if (IN(10)) for (int tok = vb * 8 + wave; tok < T; tok += G * 8)
        expert_w_token((const int*)(ws + WS_ACTP) + (size_t)tok * 512, (const unsigned short*)(ws + WS_GIDX) + (size_t)tok * 128, (const float*)(ws + WS_GGATE) + (size_t)tok * 128, ((const float*)(ws + WS_SH))[tok],
                       (const float*)(ws + WS_SU), (const float*)(ws + WS_SV), (unsigned char*)(ws + WS_WX) + (size_t)tok * 128, (float*)(ws + WS_SW) + tok, lane);
    SEAM(10);
    REP(11) if (IN(11)) slice_pass<1>(ws, a.out, (int)MISC[4], (int)MISC[5] * 8 + __builtin_amdgcn_readfirstlane(wave), (int)MISC[6] * 8, lane);
    SEAM(11);
    REP(12) if (IN(12)) for (int tok = vb * 8 + wave; tok < T; tok += G * 8) final_norm_token(a.out + (size_t)tok * DM, (const float*)(ws + WS_SSQ3) + (size_t)tok * 8, a.in[14], lane);
#undef IN
#undef SEAM
}

extern "C" void kernel_launch(void* const* d_in, const int* in_sizes, int n_in, void* d_out, int out_size, void* d_ws, size_t ws_size, hipStream_t stream) {
    static int grid = 0;
    if (grid == 0) {
        if (n_in != 15 || in_sizes[0] != T * DM || out_size != T * DM || ws_size < WS_END) { fprintf(stderr, "kernel_launch: unexpected shapes (n_in %d, in0 %d, out %d, ws %zu)\n", n_in, n_in > 0 ? in_sizes[0] : -1, out_size, ws_size); grid = -1; return; }
        int dev = 0, cus = 0, per_cu = 0;
        hipGetDevice(&dev); hipDeviceGetAttribute(&cus, hipDeviceAttributeMultiprocessorCount, dev);
        if (hipFuncSetAttribute((const void*)mk_fwd, hipFuncAttributeMaxDynamicSharedMemorySize, LDS_BYTES) != hipSuccess) { fprintf(stderr, "kernel_launch: hipFuncSetAttribute failed\n"); grid = -1; return; }
        if (hipOccupancyMaxActiveBlocksPerMultiprocessor(&per_cu, (const void*)mk_fwd, NTHR, LDS_BYTES) != hipSuccess || per_cu < 1) { fprintf(stderr, "kernel_launch: occupancy query says %d blocks per CU\n", per_cu); per_cu = 1; }
        (void)hipGetLastError();
        grid = cus;
    }
    if (grid < 0) return;
    if (hipMemsetAsync(d_ws, 0, 256 * 1024, stream) != hipSuccess) { fprintf(stderr, "kernel_launch: hipMemsetAsync failed\n"); return; }
    Args a{};
    for (int i = 0; i < 15; ++i) a.in[i] = (const float*)d_in[i];
    a.out = (float*)d_out; a.ws = (unsigned char*)d_ws;
#if MK_FUSED
    a.ph_lo = 0; a.ph_hi = N_PHASES;
    { void* args[] = {&a}; hipError_t e = hipLaunchCooperativeKernel((const void*)mk_fwd, dim3(grid), dim3(NTHR), args, LDS_BYTES, stream);
      if (e != hipSuccess) fprintf(stderr, "kernel_launch: cooperative launch failed: %s (grid %d)\n", hipGetErrorString(e), grid); }
#else
    for (int p = 0; p < N_PHASES; ++p) { a.ph_lo = p; a.ph_hi = p + 1; void* args[] = {&a};
        hipError_t e = hipLaunchCooperativeKernel((const void*)mk_fwd, dim3(grid), dim3(NTHR), args, LDS_BYTES, stream);
        if (e != hipSuccess) { fprintf(stderr, "kernel_launch: launch of phase %d failed: %s (grid %d)\n", p, hipGetErrorString(e), grid); break; } }
#endif
}
```

```cpp
#include <hip/hip_runtime.h>
#include <hip/hip_cooperative_groups.h>
#include <cstdio>
#include <cstdint>
namespace cg = cooperative_groups;
namespace pg8 {
#define PG8_LAS __attribute__((address_space(3)))
typedef unsigned short bf16_t;
typedef short bf16x8 __attribute__((ext_vector_type(8)));
typedef float f32x4 __attribute__((ext_vector_type(4)));
typedef unsigned u32x4 __attribute__((ext_vector_type(4)));
constexpr int BM = 256, BK = 64, HALF = 128, HTB = HALF * BK * 2  , STAGE_BYTES = 8 * HTB, NXCD = 8, WGM = 8;

__host__ __device__ __forceinline__ int lds_byte(int r, int c) { const int st = (r >> 4) * 2 + (c >> 5), rr = r & 15, cc = c & 31, ob = rr * 64 + cc * 2; return st * 1024 + (ob ^ (((ob >> 9) & 1) << 5)); }
__host__ __device__ __forceinline__ void stage_rc(int b, int& R, int& C) { const int st = b / 1024, sb = b % 1024, swz = sb ^ (((sb >> 9) & 1) << 5); R = (st >> 1) * 16 + swz / 64; C = (st & 1) * 32 + (swz % 64) / 2; }
__host__ __device__ __forceinline__ int perm32(int rho) { const int n = rho >> 4, i = rho & 15; return 8 * (i >> 2) + 4 * n + (i & 3); }

struct Unit { int pm, pn; };
struct Gemm { const bf16_t* A; const bf16_t* Bt; int M, N, K; };

struct StaticOrder {
    int nM, nN, nwg, G, c;
    __host__ __device__ void init(int M, int N, int G_, int c_) { nM = M / BM; nN = N / BM; nwg = nM * nN; G = G_; c = c_; }
    __host__ __device__ bool next(int i, Unit& u) const {
        const long L = (long)i * G + c; if (L >= nwg) return false;
        int wgid = (int)L; { const int q = nwg / NXCD, r = nwg % NXCD, xcd = wgid % NXCD, off = wgid / NXCD; wgid = (xcd < r ? xcd * (q + 1) : r * (q + 1) + (xcd - r) * q) + off; }
        const int nig = WGM * nN, gid = wgid / nig, fm = gid * WGM, gsz = (nM - fm) < WGM ? (nM - fm) : WGM;
        u.pm = fm + ((wgid % nig) % gsz); u.pn = (wgid % nig) / gsz; return true;
    }
    __device__ __forceinline__ void a_ready(const Unit&) const {}
    __device__ __forceinline__ void done(const Unit&) const {}
};

__device__ __forceinline__ unsigned cvt_pk_bf16(float lo, float hi) { unsigned r; asm volatile("v_cvt_pk_bf16_f32 %0, %1, %2" : "=v"(r) : "v"(lo), "v"(hi)); return r; }

template <class Epi, class Sched, bool ALIGN_EPI = false, bool SP2 = false>
__device__ __forceinline__ void gemm_phase(PG8_LAS unsigned char* lds, const Gemm g, const Sched& S, const Epi& E) {
    int tid_ = threadIdx.x; asm volatile("" : "+v"(tid_));
    const int tid = tid_, wid = __builtin_amdgcn_readfirstlane(tid >> 6), lane = tid & 63, wr = wid >> 2, wc = wid & 3, fr = lane & 15, fq = lane >> 4;
    const int K = g.K, nt = K / BK;
    unsigned voffA[2], voffB[2];
#pragma unroll
    for (int i = 0; i < 2; ++i) { int R, C; stage_rc(tid * 16 + i * 8192, R, C); const int Rb = Epi::PERM ? ((R & ~31) + perm32(R & 31)) : R;
        voffA[i] = (unsigned)(R * K + C) * 2u; voffB[i] = (unsigned)(Rb * K + C) * 2u; }
    const size_t kstep = (size_t)(BK * 2);
    const size_t hstep = (size_t)HALF * K * 2;
    const size_t tstep = 2 * hstep;
    const unsigned ldsw = (unsigned)wid * 1024u;
    const int aoff = lds_byte(wr * 64 + fr, fq * 8), boff = lds_byte(wc * 32 + fr, fq * 8);
#define PG8_SA(b, h) (((b) * 2 + (h)) * HTB)
#define PG8_SB(b, h) ((4 + (b) * 2 + (h)) * HTB)
#define PG8_STAGE(bufoff, gbase, voff) do { _Pragma("unroll") for (int _i = 0; _i < 2; ++_i) \
        __builtin_amdgcn_global_load_lds((const unsigned*)((const char*)(gbase) + (voff)[_i]), (PG8_LAS unsigned*)(lds + (bufoff) + ldsw + _i * 8192), 16, 0, 0); } while (0)
#define PG8_LDA(dst, b, h) do { _Pragma("unroll") for (int m = 0; m < 4; ++m) _Pragma("unroll") for (int k = 0; k < 2; ++k) dst[m][k] = *(const PG8_LAS bf16x8*)(lds + PG8_SA(b, h) + aoff + m * 2048 + k * 1024); } while (0)
#define PG8_LDB(dst, b, h) do { _Pragma("unroll") for (int n = 0; n < 2; ++n) _Pragma("unroll") for (int k = 0; k < 2; ++k) dst[n][k] = *(const PG8_LAS bf16x8*)(lds + PG8_SB(b, h) + boff + n * 2048 + k * 1024); } while (0)
#define PG8_MMA(ai, bj, At, Bt) do { __builtin_amdgcn_s_setprio(1); _Pragma("unroll") for (int m = 0; m < 4; ++m) _Pragma("unroll") for (int n = 0; n < 2; ++n) _Pragma("unroll") for (int k = 0; k < 2; ++k) \
        acc[ai][bj][m][n] = __builtin_amdgcn_mfma_f32_16x16x32_bf16(Bt[n][k], At[m][k], acc[ai][bj][m][n], 0, 0, 0); __builtin_amdgcn_s_setprio(0); } while (0)
#define PG8_WAIT_V(n) asm volatile("s_waitcnt vmcnt(" #n ")" ::: "memory")
#define PG8_WAIT_L(n) asm volatile("s_waitcnt lgkmcnt(" #n ")" ::: "memory")
#define PG8_BAR __builtin_amdgcn_s_barrier()
#define PG8_SCHED __builtin_amdgcn_sched_barrier(0)
    Unit cur, nxt; int ui = 0;
    if (!S.next(0, cur)) return;
    f32x4 acc[2][2][4][2];
#pragma unroll
    for (int a = 0; a < 2; ++a)
#pragma unroll
        for (int b = 0; b < 2; ++b)
#pragma unroll
            for (int m = 0; m < 4; ++m)
#pragma unroll
                for (int n = 0; n < 2; ++n) acc[a][b][m][n] = (f32x4){0.f, 0.f, 0.f, 0.f};
    bf16x8 At[4][2], B0[2][2], B1[2][2];
    const char* cA = (const char*)g.A + (size_t)cur.pm * tstep; const char* cB = (const char*)g.Bt + (size_t)cur.pn * tstep;
    S.a_ready(cur);
    if constexpr (SP2) {
        PG8_STAGE(PG8_SB(0, 0), cB, voffB); PG8_STAGE(PG8_SB(0, 1), cB + hstep, voffB); PG8_STAGE(PG8_SA(0, 0), cA, voffA); PG8_STAGE(PG8_SA(0, 1), cA + hstep, voffA);
        if (wr == 1) PG8_BAR;
        PG8_WAIT_V(2); PG8_BAR;
        PG8_STAGE(PG8_SB(1, 0), cB + kstep, voffB); PG8_STAGE(PG8_SA(1, 0), cA + kstep, voffA); PG8_STAGE(PG8_SB(1, 1), cB + hstep + kstep, voffB);
        PG8_WAIT_V(6); PG8_BAR;
    } else {
        PG8_STAGE(PG8_SB(0, 0), cB, voffB); PG8_STAGE(PG8_SA(0, 0), cA, voffA); PG8_STAGE(PG8_SB(0, 1), cB + hstep, voffB); PG8_STAGE(PG8_SA(0, 1), cA + hstep, voffA);
        if (wr == 1) PG8_BAR;
        PG8_WAIT_V(4); PG8_BAR;
        PG8_STAGE(PG8_SB(1, 0), cB + kstep, voffB); PG8_STAGE(PG8_SA(1, 0), cA + kstep, voffA); PG8_STAGE(PG8_SB(1, 1), cB + hstep + kstep, voffB);
        PG8_WAIT_V(6); PG8_BAR;
    }
    for (;;) {
        const bool has_next = S.next(ui + 1, nxt);
        const char* nA = has_next ? (const char*)g.A + (size_t)nxt.pm * tstep : cA; const char* nB = has_next ? (const char*)g.Bt + (size_t)nxt.pn * tstep : cB;
        for (int t = 0; t < nt; t += 2) {
            const bool last = (t == nt - 2);
            const char* a1 = cA + (size_t)(t + 1) * kstep;
            const char* a2 = last ? nA : cA + (size_t)(t + 2) * kstep; const char* b2 = last ? nB : cB + (size_t)(t + 2) * kstep;
            const char* a3 = a2 + kstep; const char* b3 = b2 + kstep;
            if (last && has_next) S.a_ready(nxt);
            if constexpr (SP2) {
            PG8_LDB(B0, 0, 0); PG8_LDB(B1, 0, 1); PG8_SCHED; PG8_LDA(At, 0, 0); PG8_STAGE(PG8_SA(1, 1), a1 + hstep, voffA);
            PG8_WAIT_V(8); PG8_WAIT_L(0); PG8_BAR; PG8_MMA(0, 0, At, B0); PG8_MMA(0, 1, At, B1); PG8_BAR; PG8_SCHED;
            PG8_LDA(At, 0, 1); PG8_STAGE(PG8_SB(0, 0), b2, voffB); PG8_STAGE(PG8_SB(0, 1), b2 + hstep, voffB); PG8_STAGE(PG8_SA(0, 0), a2, voffA);
            PG8_WAIT_V(8); PG8_WAIT_L(0); PG8_BAR; PG8_MMA(1, 0, At, B0); PG8_MMA(1, 1, At, B1); PG8_BAR; PG8_SCHED;
            PG8_LDB(B0, 1, 0); PG8_LDB(B1, 1, 1); PG8_SCHED; PG8_LDA(At, 1, 0); PG8_STAGE(PG8_SA(0, 1), a2 + hstep, voffA);
            PG8_WAIT_V(8); PG8_WAIT_L(0); PG8_BAR; PG8_MMA(0, 0, At, B0); PG8_MMA(0, 1, At, B1); PG8_BAR; PG8_SCHED;
            PG8_LDA(At, 1, 1); PG8_STAGE(PG8_SB(1, 0), b3, voffB); PG8_STAGE(PG8_SB(1, 1), b3 + hstep, voffB); PG8_STAGE(PG8_SA(1, 0), a3, voffA);
            PG8_WAIT_V(8); PG8_WAIT_L(0); PG8_BAR; PG8_MMA(1, 0, At, B0); PG8_MMA(1, 1, At, B1); PG8_BAR; PG8_SCHED;
            } else {
            PG8_LDB(B0, 0, 0); PG8_SCHED; PG8_LDA(At, 0, 0); PG8_STAGE(PG8_SA(1, 1), a1 + hstep, voffA);
            PG8_WAIT_L(8); PG8_BAR; PG8_WAIT_L(0); PG8_MMA(0, 0, At, B0); PG8_BAR; PG8_SCHED;
            PG8_LDB(B1, 0, 1); PG8_STAGE(PG8_SB(0, 0), b2, voffB);
            PG8_BAR; PG8_WAIT_L(0); PG8_MMA(0, 1, At, B1); PG8_BAR;
            PG8_LDA(At, 0, 1); PG8_STAGE(PG8_SA(0, 0), a2, voffA);
            PG8_BAR; PG8_WAIT_L(0); PG8_MMA(1, 0, At, B0); PG8_BAR; PG8_SCHED;
            PG8_STAGE(PG8_SB(0, 1), b2 + hstep, voffB);
            PG8_WAIT_V(6); PG8_BAR; PG8_MMA(1, 1, At, B1); PG8_BAR;
            PG8_LDB(B0, 1, 0); PG8_SCHED; PG8_LDA(At, 1, 0); PG8_STAGE(PG8_SA(0, 1), a2 + hstep, voffA);
            PG8_WAIT_L(8); PG8_BAR; PG8_WAIT_L(0); PG8_MMA(0, 0, At, B0); PG8_BAR; PG8_SCHED;
            PG8_LDB(B1, 1, 1); PG8_STAGE(PG8_SB(1, 0), b3, voffB);
            PG8_BAR; PG8_WAIT_L(0); PG8_MMA(0, 1, At, B1); PG8_BAR;
            PG8_LDA(At, 1, 1); PG8_STAGE(PG8_SA(1, 0), a3, voffA);
            PG8_BAR; PG8_WAIT_L(0); PG8_MMA(1, 0, At, B0); PG8_BAR; PG8_SCHED;
            PG8_STAGE(PG8_SB(1, 1), b3 + hstep, voffB);
            PG8_WAIT_V(6); PG8_BAR; PG8_MMA(1, 1, At, B1); PG8_BAR;
            }
        }
        if constexpr (ALIGN_EPI) { if (wr == 0) PG8_BAR; }
        if constexpr (!Epi::AFTER_DRAIN) { E(acc, cur, wr, wc, fr, fq); S.done(cur); }
        if (!has_next) break;
#pragma unroll
        for (int a = 0; a < 2; ++a)
#pragma unroll
            for (int b = 0; b < 2; ++b)
#pragma unroll
                for (int m = 0; m < 4; ++m)
#pragma unroll
                    for (int n = 0; n < 2; ++n) acc[a][b][m][n] = (f32x4){0.f, 0.f, 0.f, 0.f};
        cur = nxt; cA = nA; cB = nB; ++ui;
        if constexpr (ALIGN_EPI) { if (wr == 1) PG8_BAR; }
    }
    PG8_WAIT_V(0);
    if constexpr (!ALIGN_EPI) { if (wr == 0) PG8_BAR; }
    PG8_BAR;
    if constexpr (Epi::AFTER_DRAIN) { E.fused(acc, cur, wr, wc, fr, fq, lds, wid, lane); S.done(cur); }
#undef PG8_SA
#undef PG8_SB
#undef PG8_STAGE
#undef PG8_LDA
#undef PG8_LDB
#undef PG8_MMA
#undef PG8_WAIT_V
#undef PG8_WAIT_L
#undef PG8_BAR
#undef PG8_SCHED
}
}

#ifndef MK_FUSED
#define MK_FUSED 1
#endif
#define DI __device__ __forceinline__
#define LAS __attribute__((address_space(3)))
typedef unsigned short bf16_t;
typedef float f32x4 __attribute__((ext_vector_type(4)));
typedef float f32x2 __attribute__((ext_vector_type(2)));
typedef float f32x16 __attribute__((ext_vector_type(16)));
typedef unsigned u32x4 __attribute__((ext_vector_type(4)));
typedef unsigned u32x2 __attribute__((ext_vector_type(2)));
typedef short bf16x8 __attribute__((ext_vector_type(8)));
typedef _Float16 h16x2 __attribute__((ext_vector_type(2)));
typedef _Float16 h16x8 __attribute__((ext_vector_type(8)));

constexpr int BATCH = 16, SEQ = 4096, T = BATCH * SEQ, DM = 1024, NIN = 4864;
constexpr int C_AQ = 0, C_AK = 512, C_AV = 640, C_HQ = 768, C_HF = 1280, C_HI = 1792, C_HG = 2304, C_GA = 2816, C_GH = 3840;
constexpr float EPS = 1e-6f;
constexpr int NTHR = 512;
constexpr int LDS_BYTES = 163840;

constexpr size_t MiB = 1u << 20;
constexpr size_t WS_W1T = 1 * MiB;
constexpr size_t WS_WAPT = 11 * MiB;
constexpr size_t WS_WHPT = 12 * MiB;
constexpr size_t WS_WOUTT = 13 * MiB;
constexpr size_t WS_WQT = 15 * MiB;
constexpr size_t WS_KEYS = 19 * MiB;
constexpr size_t WS_LB = 19 * MiB + 512 * 1024;
constexpr size_t WS_RSTD1 = 20 * MiB;
constexpr size_t WS_SSQ2 = 21 * MiB;
constexpr size_t WS_U8 = 26 * MiB;
constexpr size_t WS_V8 = 42 * MiB;
constexpr size_t WS_SU = 58 * MiB;
constexpr size_t WS_SV = 58 * MiB + 65536;
constexpr size_t WS_DEC = 60 * MiB;
constexpr size_t WS_AVT = 64 * MiB;
constexpr size_t WS_XB = 90 * MiB;
constexpr size_t WS_PA = 218 * MiB;
constexpr size_t WS_GG = 314 * MiB;
constexpr size_t WS_QD = 570 * MiB;
constexpr size_t WS_KINV = 634 * MiB;
constexpr size_t WS_KENDT = 698 * MiB;
constexpr size_t WS_VT = 762 * MiB;
constexpr size_t WS_GS = 826 * MiB;
constexpr size_t WS_YA = 890 * MiB;
constexpr size_t WS_YH = 954 * MiB;
constexpr size_t WS_END = 1018 * MiB;
constexpr size_t WS_HQ = 698 * MiB;
constexpr size_t WS_WX = 762 * MiB;
constexpr size_t WS_SH = 60 * MiB;
constexpr size_t WS_SSQ3 = 64 * MiB;
constexpr size_t WS_SW = 61 * MiB;
constexpr size_t WS_ACTP = 346 * MiB;
constexpr size_t WS_X2B = 218 * MiB;
constexpr size_t WS_QP = 346 * MiB;
constexpr size_t WS_GIDX = 602 * MiB;
constexpr size_t WS_GGATE = 618 * MiB;

struct Args { const float* in[15]; float* out; unsigned char* ws; int ph_lo, ph_hi; };

DI unsigned pk_bf16(float lo, float hi) { typedef __bf16 b2 __attribute__((ext_vector_type(2))); f32x2 v = {lo, hi}; b2 b = __builtin_convertvector(v, b2); return __builtin_bit_cast(unsigned, b); }
DI float bflo(unsigned w) { return __uint_as_float(w << 16); }
DI float bfhi(unsigned w) { return __uint_as_float(w & 0xffff0000u); }
DI float sigm(float x) { return __builtin_amdgcn_rcpf(1.f + __expf(-x)); }
DI float wave_sum(float v) {
    v += __int_as_float(__builtin_amdgcn_mov_dpp(__float_as_int(v), 0xB1, 0xf, 0xf, true));
    v += __int_as_float(__builtin_amdgcn_mov_dpp(__float_as_int(v), 0x4E, 0xf, 0xf, true));
    v += __int_as_float(__builtin_amdgcn_mov_dpp(__float_as_int(v), 0x141, 0xf, 0xf, true));
    v += __int_as_float(__builtin_amdgcn_mov_dpp(__float_as_int(v), 0x128, 0xf, 0xf, true));
    { const auto r = __builtin_amdgcn_permlane16_swap(__float_as_uint(v), __float_as_uint(v), false, false); v = __uint_as_float(r[0]) + __uint_as_float(r[1]); }
    { const auto r = __builtin_amdgcn_permlane32_swap(__float_as_uint(v), __float_as_uint(v), false, false); v = __uint_as_float(r[0]) + __uint_as_float(r[1]); }
    return v;
}
DI unsigned short bf16_1(float x) { return (unsigned short)(pk_bf16(x, 0.f) & 0xffffu); }
template <int N> DI float dpp_row_shr(float v) { return __int_as_float(__builtin_amdgcn_update_dpp(0, __float_as_int(v), 0x110 + N, 0xf, 0xf, true)); }
DI float rowsum16(float v) { v += __int_as_float(__builtin_amdgcn_mov_dpp(__float_as_int(v), 0xB1, 0xf, 0xf, true)); v += __int_as_float(__builtin_amdgcn_mov_dpp(__float_as_int(v), 0x4E, 0xf, 0xf, true));
    v += __int_as_float(__builtin_amdgcn_mov_dpp(__float_as_int(v), 0x141, 0xf, 0xf, true)); v += __int_as_float(__builtin_amdgcn_mov_dpp(__float_as_int(v), 0x128, 0xf, 0xf, true)); return v; }
DI float scan16(float v) { v += dpp_row_shr<1>(v); v += dpp_row_shr<2>(v); v += dpp_row_shr<4>(v); v += dpp_row_shr<8>(v); return v; }
DI int crow(int reg, int hh) { return (reg & 3) + 8 * (reg >> 2) + 4 * hh; }
#define MFMA32(a, b, c) __builtin_amdgcn_mfma_f32_32x32x16_bf16((a), (b), (c), 0, 0, 0)
#define LDS_WAIT() asm volatile("s_waitcnt lgkmcnt(0)" ::: "memory")

namespace pg8 {
#define TSTORE_WRITE(sl, e, m, x) *(PG8_LAS bf16_t*)((sl) + (4 * fq + (e)) * 144 + (16 * (m) + fr) * 2) = bf16_1(x)
struct Epi1 {
    static constexpr bool PERM = true, AFTER_DRAIN = false;
    const float* rs; bf16_t* pa; bf16_t* gg; bf16_t* qd; bf16_t* kinv; bf16_t* kendT; bf16_t* vT; bf16_t* gs; float* dec; const float* lb; bf16_t* avT; PG8_LAS unsigned char* xl;
    __device__ __forceinline__ void operator()(const f32x4 (&acc)[2][2][4][2], const Unit& u, int wr, int wc, int fr, int fq) const {
        asm volatile("" : "+v"(fr), "+v"(fq));
        const int row0 = u.pm * BM + wr * 64 + fr, pn = u.pn;
        if (pn == 2) {
            const int c8 = wc * 32 + 8 * fq, tseqb = (u.pm & 15) * 256 + wr * 64 + fr, bb = u.pm >> 4;
#pragma unroll
            for (int ai = 0; ai < 2; ++ai)
#pragma unroll
                for (int m = 0; m < 4; ++m) { const int row = row0 + ai * HALF + m * 16; const float s = rs[row];
                    const f32x4 v0 = acc[ai][0][m][0] * s, v1 = acc[ai][0][m][1] * s;
                    u32x4 w; w.x = pk_bf16(v0[0], v0[1]); w.y = pk_bf16(v0[2], v0[3]); w.z = pk_bf16(v1[0], v1[1]); w.w = pk_bf16(v1[2], v1[3]);
                    *(u32x4*)(pa + (size_t)row * 768 + 512 + c8) = w;
                }
            PG8_LAS unsigned char* sl = xl + (wr * 4 + wc) * 2304; const int lane_ = fq * 16 + fr;
#pragma unroll
            for (int ai = 0; ai < 2; ++ai)
#pragma unroll
                for (int n = 0; n < 2; ++n) {
#pragma unroll
                    for (int m = 0; m < 4; ++m) { const float s = rs[row0 + ai * HALF + m * 16];
#pragma unroll
                        for (int e = 0; e < 4; ++e) TSTORE_WRITE(sl, e, m, acc[ai][1][m][n][e] * s); }
                    asm volatile("s_waitcnt lgkmcnt(0)" ::: "memory");
#pragma unroll
                    for (int q = 0; q < 2; ++q) { const int c = lane_ + 64 * q, rw = c >> 3, tc = c & 7, col = wc * 32 + 8 * (rw >> 2) + 4 * n + (rw & 3);
                        const u32x4 w = *(const PG8_LAS u32x4*)(sl + rw * 144 + tc * 16);
                        *(u32x4*)(avT + (size_t)((bb * 2 + (col >> 6)) * 64 + (col & 63)) * SEQ + (u.pm & 15) * 256 + ai * HALF + wr * 64 + 8 * tc) = w; }
                    asm volatile("s_waitcnt lgkmcnt(0)" ::: "memory");
                }
            return;
        }
        if (pn < 3 || pn >= 11) {
            bf16_t* O; int ldc, colt;
            if (pn < 3) { O = pa; ldc = 768; colt = pn * 256; } else { O = gg; ldc = 2048; colt = (pn - 11) * 256; }
            const int col0 = colt + wc * 32 + 8 * fq;
#pragma unroll
            for (int ai = 0; ai < 2; ++ai)
#pragma unroll
                for (int m = 0; m < 4; ++m) { const int row = row0 + ai * HALF + m * 16; const float s = rs[row]; bf16_t* rowp = O + (size_t)row * ldc + col0;
#pragma unroll
                    for (int bj = 0; bj < 2; ++bj) { const f32x4 v0 = acc[ai][bj][m][0] * s, v1 = acc[ai][bj][m][1] * s;
                        u32x4 w; w.x = pk_bf16(v0[0], v0[1]); w.y = pk_bf16(v0[2], v0[3]); w.z = pk_bf16(v1[0], v1[1]); w.w = pk_bf16(v1[2], v1[3]);
                        *(u32x4*)(rowp + bj * HALF) = w; } }
            return;
        }
        PG8_LAS unsigned char* sl = xl + (wr * 4 + wc) * 2304; const int lane_ = fq * 16 + fr;
        const int h = (pn - 3) & 3, c8 = wc * 32 + 8 * fq, bh = (u.pm >> 4) * 4 + h;
        if (pn < 7) {
#pragma unroll
            for (int ai = 0; ai < 2; ++ai)
#pragma unroll
                for (int m = 0; m < 4; ++m) { const int row = row0 + ai * HALF + m * 16; const float s = rs[row]; const size_t o = (size_t)row * 512 + h * 128 + c8;
#pragma unroll
                    for (int bj = 0; bj < 2; ++bj) { const f32x4 v0 = acc[ai][bj][m][0] * s, v1 = acc[ai][bj][m][1] * s;
                        u32x4 w; w.x = pk_bf16(v0[0], v0[1]); w.y = pk_bf16(v0[2], v0[3]); w.z = pk_bf16(v1[0], v1[1]); w.w = pk_bf16(v1[2], v1[3]);
                        *(u32x4*)((bj ? kinv : qd) + o) = w; } }
        } else {
#pragma unroll
            for (int ai = 0; ai < 2; ++ai) {
                const int tseq0 = (u.pm & 15) * 256 + ai * HALF + wr * 64;
#pragma unroll
                for (int n = 0; n < 2; ++n) {
#pragma unroll
                    for (int m = 0; m < 4; ++m) { const float s = rs[row0 + ai * HALF + m * 16];
#pragma unroll
                        for (int e = 0; e < 4; ++e) TSTORE_WRITE(sl, e, m, acc[ai][0][m][n][e] * s); }
                    asm volatile("s_waitcnt lgkmcnt(0)" ::: "memory");
#pragma unroll
                    for (int q = 0; q < 2; ++q) { const int c = lane_ + 64 * q, rw = c >> 3, tc = c & 7, dvr = wc * 32 + 8 * (rw >> 2) + 4 * n + (rw & 3);
                        const u32x4 w = *(const PG8_LAS u32x4*)(sl + rw * 144 + tc * 16);
                        *(u32x4*)(vT + (size_t)(bh * 128 + dvr) * SEQ + tseq0 + 8 * tc) = w; }
                    asm volatile("s_waitcnt lgkmcnt(0)" ::: "memory");
                }
#pragma unroll
                for (int m = 0; m < 4; ++m) { const int row = row0 + ai * HALF + m * 16; const float s = rs[row];
                    f32x4 g0 = acc[ai][1][m][0] * s, g1 = acc[ai][1][m][1] * s;
#pragma unroll
                    for (int e = 0; e < 4; ++e) { g0[e] *= sigm(g0[e]); g1[e] *= sigm(g1[e]); }
                    u32x4 w; w.x = pk_bf16(g0[0], g0[1]); w.y = pk_bf16(g0[2], g0[3]); w.z = pk_bf16(g1[0], g1[1]); w.w = pk_bf16(g1[2], g1[3]);
                    *(u32x4*)(gs + (size_t)row * 512 + h * 128 + c8) = w; }
            }
        }
    }
};
struct EpiDummy {
    static constexpr bool PERM = true, AFTER_DRAIN = false;
    bf16_t* O; const float* rs;
    __device__ __forceinline__ void operator()(const f32x4 (&acc)[2][2][4][2], const Unit& u, int wr, int wc, int fr, int fq) const {
        asm volatile("" : "+v"(fr), "+v"(fq));
        const int row0 = wr * 64 + fr, col0 = wc * 32 + 8 * fq;
#pragma unroll
        for (int ai = 0; ai < 2; ++ai)
#pragma unroll
            for (int m = 0; m < 4; ++m) { const int row = row0 + ai * HALF + m * 16; const float s = rs[u.pm * BM + row]; bf16_t* rowp = O + (size_t)blockIdx.x * 65536 + (size_t)row * 256 + col0;
#pragma unroll
                for (int bj = 0; bj < 2; ++bj) { const f32x4 v0 = acc[ai][bj][m][0] * s, v1 = acc[ai][bj][m][1] * s;
                    u32x4 w; w.x = pk_bf16(v0[0], v0[1]); w.y = pk_bf16(v0[2], v0[3]); w.z = pk_bf16(v1[0], v1[1]); w.w = pk_bf16(v1[2], v1[3]);
                    *(u32x4*)(rowp + bj * HALF) = w; } }
    }
};
template <bool ADD> struct EpiMerge {
    static constexpr bool PERM = true, AFTER_DRAIN = false;
    bf16_t* O; const bf16_t* gate;
    __device__ __forceinline__ void operator()(const f32x4 (&acc)[2][2][4][2], const Unit& u, int wr, int wc, int fr, int fq) const {
        const int row0 = u.pm * BM + wr * 64 + fr, col0 = u.pn * BM + wc * 32 + 8 * fq;
#pragma unroll
        for (int ai = 0; ai < 2; ++ai)
#pragma unroll
            for (int m = 0; m < 4; ++m) { const int row = row0 + ai * HALF + m * 16; bf16_t* rowp = O + (size_t)row * DM + col0; const bf16_t* gp = gate + (size_t)row * 2048 + col0;
#pragma unroll
                for (int bj = 0; bj < 2; ++bj) { const u32x4 g = *(const u32x4*)(gp + bj * HALF);
                    f32x4 v0 = acc[ai][bj][m][0], v1 = acc[ai][bj][m][1];
                    v0[0] *= sigm(bflo(g.x)); v0[1] *= sigm(bfhi(g.x)); v0[2] *= sigm(bflo(g.y)); v0[3] *= sigm(bfhi(g.y));
                    v1[0] *= sigm(bflo(g.z)); v1[1] *= sigm(bfhi(g.z)); v1[2] *= sigm(bflo(g.w)); v1[3] *= sigm(bfhi(g.w));
                    if (ADD) { const u32x4 o = *(const u32x4*)(rowp + bj * HALF);
                        v0[0] += bflo(o.x); v0[1] += bfhi(o.x); v0[2] += bflo(o.y); v0[3] += bfhi(o.y); v1[0] += bflo(o.z); v1[1] += bfhi(o.z); v1[2] += bflo(o.w); v1[3] += bfhi(o.w); }
                    u32x4 w; w.x = pk_bf16(v0[0], v0[1]); w.y = pk_bf16(v0[2], v0[3]); w.z = pk_bf16(v1[0], v1[1]); w.w = pk_bf16(v1[2], v1[3]);
                    *(u32x4*)(rowp + bj * HALF) = w; } }
    }
};
struct EpiX2 {
    static constexpr bool PERM = true, AFTER_DRAIN = false;
    const float* X; bf16_t* X2B; float* ssq;
    __device__ __forceinline__ void operator()(const f32x4 (&acc)[2][2][4][2], const Unit& u, int wr, int wc, int fr, int fq) const {
        const int row0 = u.pm * BM + wr * 64 + fr, col0 = u.pn * BM + wc * 32 + 8 * fq;
#pragma unroll
        for (int ai = 0; ai < 2; ++ai)
#pragma unroll
            for (int m = 0; m < 4; ++m) { const int row = row0 + ai * HALF + m * 16; const size_t off = (size_t)row * DM + col0; float ss = 0.f;
#pragma unroll
                for (int bj = 0; bj < 2; ++bj) { const f32x4 x0 = *(const f32x4*)(X + off + bj * HALF), x1 = *(const f32x4*)(X + off + bj * HALF + 4);
                    const f32x4 v0 = acc[ai][bj][m][0] + x0, v1 = acc[ai][bj][m][1] + x1;
                    u32x4 w; w.x = pk_bf16(v0[0], v0[1]); w.y = pk_bf16(v0[2], v0[3]); w.z = pk_bf16(v1[0], v1[1]); w.w = pk_bf16(v1[2], v1[3]);
                    *(u32x4*)(X2B + off + bj * HALF) = w;
                    ss += (v0[0] * v0[0] + v0[1] * v0[1]) + (v0[2] * v0[2] + v0[3] * v0[3]) + (v1[0] * v1[0] + v1[1] * v1[1]) + (v1[2] * v1[2] + v1[3] * v1[3]); }
                ss += __shfl_xor(ss, 16); ss += __shfl_xor(ss, 32);
                if (fq == 0) ssq[(size_t)row * 16 + u.pn * 4 + wc] = ss; }
    }
};
struct EpiQp {
    static constexpr bool PERM = true, AFTER_DRAIN = false;
    bf16_t* O; const float* ssq;
    __device__ __forceinline__ void operator()(const f32x4 (&acc)[2][2][4][2], const Unit& u, int wr, int wc, int fr, int fq) const {
        const int row0 = u.pm * BM + wr * 64 + fr, col0 = u.pn * BM + wc * 32 + 8 * fq;
#pragma unroll
        for (int ai = 0; ai < 2; ++ai)
#pragma unroll
            for (int m = 0; m < 4; ++m) { const int row = row0 + ai * HALF + m * 16; const f32x4* sp = (const f32x4*)(ssq + (size_t)row * 16);
                const f32x4 a = sp[0], b = sp[1], c = sp[2], d = sp[3];
                const float tot = ((a[0] + a[1]) + (a[2] + a[3])) + ((b[0] + b[1]) + (b[2] + b[3])) + ((c[0] + c[1]) + (c[2] + c[3])) + ((d[0] + d[1]) + (d[2] + d[3]));
                const float s = __builtin_amdgcn_rsqf(tot * (1.f / 1024.f) + EPS); bf16_t* rowp = O + (size_t)row * 2048 + col0;
#pragma unroll
                for (int bj = 0; bj < 2; ++bj) { const f32x4 v0 = acc[ai][bj][m][0] * s, v1 = acc[ai][bj][m][1] * s;
                    u32x4 w; w.x = pk_bf16(v0[0], v0[1]); w.y = pk_bf16(v0[2], v0[3]); w.z = pk_bf16(v1[0], v1[1]); w.w = pk_bf16(v1[2], v1[3]);
                    *(u32x4*)(rowp + bj * HALF) = w; } }
    }
};
}

DI int w1_src_col(int n) {
    if (n < 768 || n >= 2816) return n;
    if (n < 1792) { const int h = (n - 768) >> 8, r = (n - 768) & 255; return r < 128 ? C_HQ + 128 * h + r : C_HF + 128 * h + (r - 128); }
    const int h = (n - 1792) >> 8, r = (n - 1792) & 255; return r < 128 ? C_HI + 128 * h + r : C_HG + 128 * h + (r - 128);
}
template <bool PERMW1> DI void p0_transpose_item(const float* W, int K, int N, bf16_t* WT, const float* g, int gmask, LAS float* scr, int item, int lane) {
    const int nblk = N / 32, kb = item / nblk, nb = item % nblk, k0 = 64 * kb, n0 = 32 * nb, ns = PERMW1 ? w1_src_col(n0) : n0;
#pragma unroll 8
    for (int i = 0; i < 32; ++i) { const int kk = 2 * i + (lane >> 5); float w = W[(size_t)(k0 + kk) * N + ns + (lane & 31)]; if (g) w *= g[(k0 + kk) & gmask]; scr[kk * 33 + (lane & 31)] = w; }
    LDS_WAIT(); asm volatile("" ::: "memory");
    const int c = lane & 7;
#pragma unroll
    for (int j = 0; j < 4; ++j) { const int n = (lane >> 3) + 8 * j; const LAS float* s = scr + (8 * c) * 33 + n;
        u32x4 o; o.x = pk_bf16(s[0 * 33], s[1 * 33]); o.y = pk_bf16(s[2 * 33], s[3 * 33]); o.z = pk_bf16(s[4 * 33], s[5 * 33]); o.w = pk_bf16(s[6 * 33], s[7 * 33]);
        *(u32x4*)(WT + (size_t)(n0 + n) * K + k0 + 8 * c) = o; }
    LDS_WAIT(); asm volatile("" ::: "memory");
}
DI unsigned pk_f16(float a, float b) { h16x2 v = {(_Float16)a, (_Float16)b}; return __builtin_bit_cast(unsigned, v); }

DI void p0_prologue(const Args& a, LAS unsigned char* lds, int vb, int G) {
    const int tid = threadIdx.x, lane = tid & 63, wave = tid >> 6;
    const int gw = vb * 8 + wave, NGW = G * 8, gt = vb * NTHR + tid, NGT = G * NTHR;
    unsigned char* ws = a.ws;
    LAS float* scr = (LAS float*)(lds + wave * 16384);
    constexpr int I_W1 = 16 * 152, I_AP = 8 * 32, I_HP = 8 * 32, I_OUT = 16 * 32, I_Q = 16 * 64, NITEMS = I_W1 + I_AP + I_HP + I_OUT + I_Q;
    for (int it = gw; it < NITEMS; it += NGW) {
        int r = it;
        if (r < I_W1) { p0_transpose_item<true>(a.in[2], 1024, NIN, (bf16_t*)(ws + WS_W1T), a.in[1], 1023, scr, r, lane); continue; } r -= I_W1;
        if (r < I_AP) { p0_transpose_item<false>(a.in[6], 512, 1024, (bf16_t*)(ws + WS_WAPT), nullptr, 0, scr, r, lane); continue; } r -= I_AP;
        if (r < I_HP) { p0_transpose_item<false>(a.in[7], 512, 1024, (bf16_t*)(ws + WS_WHPT), a.in[5], 127, scr, r, lane); continue; } r -= I_HP;
        if (r < I_OUT) { p0_transpose_item<false>(a.in[8], 1024, 1024, (bf16_t*)(ws + WS_WOUTT), nullptr, 0, scr, r, lane); continue; } r -= I_OUT;
        p0_transpose_item<false>(a.in[10], 1024, 2048, (bf16_t*)(ws + WS_WQT), a.in[9], 1023, scr, r, lane);
    }
    for (int i = gt; i < 2 * 8 * 128 * 128 / 4; i += NGT) { const f32x4 v = ((const f32x4*)a.in[11])[i]; u32x2 o; o.x = pk_bf16(v[0], v[1]); o.y = pk_bf16(v[2], v[3]); ((u32x2*)(ws + WS_KEYS))[i] = o; }
    for (int it = gw; it < 2 * 16384; it += NGW) {
        const int isv = it >= 16384, e = it & 16383;
        const float* src = (isv ? a.in[13] : a.in[12]) + (size_t)e * 1024 + 16 * lane;
        f32x4 x[4]; float amax = 0.f;
#pragma unroll
        for (int i = 0; i < 4; ++i) { x[i] = *(const f32x4*)(src + 4 * i); if (!isv) x[i] *= *(const f32x4*)(a.in[9] + 16 * lane + 4 * i);
            amax = fmaxf(fmaxf(amax, fmaxf(fabsf(x[i][0]), fabsf(x[i][1]))), fmaxf(fabsf(x[i][2]), fabsf(x[i][3]))); }
#pragma unroll
        for (int o = 1; o < 64; o <<= 1) amax = fmaxf(amax, __shfl_xor(amax, o));
        if (!isv) {
            const float q4 = amax > 0.f ? 7.f / amax : 0.f; unsigned nb[16];
#pragma unroll
            for (int i = 0; i < 16; ++i) nb[i] = (unsigned)((int)rintf(x[i >> 2][i & 3] * q4) + 8);
            u32x2 w4; w4.x = (nb[0] | (nb[1] << 4)) | ((nb[2] | (nb[3] << 4)) << 8) | ((nb[4] | (nb[5] << 4)) << 16) | ((nb[6] | (nb[7] << 4)) << 24);
            w4.y = (nb[8] | (nb[9] << 4)) | ((nb[10] | (nb[11] << 4)) << 8) | ((nb[12] | (nb[13] << 4)) << 16) | ((nb[14] | (nb[15] << 4)) << 24);
            *(u32x2*)(ws + WS_U8 + (size_t)e * 512 + 8 * lane) = w4;
            if (lane == 0) ((float*)(ws + WS_SU))[e] = amax * (1.f / 7.f);
            continue;
        }
        const float qs = amax > 0.f ? 127.f / amax : 0.f; const int off = 0;
        u32x4 w;
#pragma unroll
        for (int i = 0; i < 4; ++i) { const int q0 = (int)rintf(x[i][0] * qs) + off, q1 = (int)rintf(x[i][1] * qs) + off, q2 = (int)rintf(x[i][2] * qs) + off, q3 = (int)rintf(x[i][3] * qs) + off;
            w[i] = (unsigned)(q0 & 255) | ((unsigned)(q1 & 255) << 8) | ((unsigned)(q2 & 255) << 16) | ((unsigned)(q3 & 255) << 24); }
        *(u32x4*)(ws + (isv ? WS_V8 : WS_U8) + (size_t)e * 1024 + 16 * lane) = w;
        if (lane == 0) ((float*)(ws + (isv ? WS_SV : WS_SU)))[e] = amax * (1.f / 127.f);
    }
    for (int row = gw; row < T; row += NGW) {
        const f32x4* xr = (const f32x4*)(a.in[0] + (size_t)row * DM) + lane; f32x4 v[4]; float s = 0.f;
#pragma unroll
        for (int j = 0; j < 4; ++j) { v[j] = xr[64 * j]; s += (v[j][0] * v[j][0] + v[j][1] * v[j][1]) + (v[j][2] * v[j][2] + v[j][3] * v[j][3]); }
        s = wave_sum(s);
        u32x2* o = (u32x2*)(ws + WS_XB + (size_t)row * DM * 2) + lane;
#pragma unroll
        for (int j = 0; j < 4; ++j) { u32x2 w; w.x = pk_bf16(v[j][0], v[j][1]); w.y = pk_bf16(v[j][2], v[j][3]); o[64 * j] = w; }
        if (lane == 0) ((float*)(ws + WS_RSTD1))[row] = __builtin_amdgcn_rsqf(s * (1.f / 1024.f) + EPS);
    }
    if (vb == 0) { const float l0 = a.in[4][tid], l1 = a.in[4][512 + tid]; ((float*)(ws + WS_LB))[tid] = 1.f / (1.f + __expf(l1 - l0)); }
}

constexpr int ATT_KS = 272, ATT_VS = 392, ATT_VOFF = 192 * ATT_KS;
DI void attn_unit(const bf16_t* pa, const bf16_t* avT, const float* sinks, bf16_t* ya, LAS unsigned char* lds, int b, int tt) {
    int tid_ = threadIdx.x; asm volatile("" : "+v"(tid_));
    const int tid = tid_, lane = tid & 63, h = __builtin_amdgcn_readfirstlane(tid >> 6), r = lane & 31, hh = lane >> 5, kvh = h >> 2;
    const int p0 = tt * 64 - 128;
    for (int c = tid; c < 192 * 16; c += NTHR) { const int row = c >> 4, ch = c & 15, pos = p0 + row; u32x4 w = {0u, 0u, 0u, 0u};
        if (pos >= 0) w = *(const u32x4*)(pa + ((size_t)b * SEQ + pos) * 768 + 512 + ch * 8);
        *(LAS u32x4*)(lds + row * ATT_KS + ch * 16) = w; }
    for (int c = tid; c < 128 * 24; c += NTHR) { const int row = c / 24, ch = c - row * 24, pos = p0 + ch * 8; u32x4 w = {0u, 0u, 0u, 0u};
        if (pos >= 0) w = *(const u32x4*)(avT + (size_t)(b * 128 + row) * SEQ + pos);
        LAS u32x2* d = (LAS u32x2*)(lds + ATT_VOFF + row * ATT_VS + ch * 16); d[0] = (u32x2){w.x, w.y}; d[1] = (u32x2){w.z, w.w}; }
    __syncthreads();
    constexpr float LOG2E = 1.4426950408889634f;
    const float slope2 = exp2f(-(float)(h + 1)) * LOG2E, sink2 = sinks[h] * LOG2E, qs = 0.125f * LOG2E;
#pragma unroll 1
    for (int qbl = 0; qbl < 2; ++qbl) {
        const int qb = tt * 2 + qbl; const size_t trow = (size_t)b * SEQ + qb * 32 + r;
        bf16x8 qf[4];
        { const bf16_t* qp = pa + trow * 768 + h * 64 + 8 * hh;
#pragma unroll
          for (int s = 0; s < 4; ++s) qf[s] = *(const bf16x8*)(qp + 16 * s); }
        f32x16 S[5]; float m = sink2;
#pragma unroll
        for (int i = 0; i < 5; ++i) { const int kb = qb - 4 + i;
            if (kb >= 0) {
#pragma unroll
                for (int q = 0; q < 16; ++q) S[i][q] = 0.f;
                const LAS unsigned char* kp = lds + (32 * (qbl + i) + r) * ATT_KS + kvh * 128 + 16 * hh;
#pragma unroll
                for (int s = 0; s < 4; ++s) S[i] = MFMA32(*(const LAS bf16x8*)(kp + 32 * s), qf[s], S[i]);
#pragma unroll
                for (int q = 0; q < 16; ++q) { const int dist = 32 * (4 - i) + r - crow(q, hh); float v = S[i][q] * qs - slope2 * (float)dist;
                    if (i == 0) v = (dist <= 127) ? v : -1e30f;
                    if (i == 4) v = (dist >= 0) ? v : -1e30f;
                    S[i][q] = v; m = fmaxf(m, v); }
            } }
        m = fmaxf(m, __shfl_xor(m, 32));
        float l = 0.f;
#pragma unroll
        for (int i = 0; i < 5; ++i) if (qb - 4 + i >= 0) {
#pragma unroll
            for (int q = 0; q < 16; ++q) { const float p = __builtin_amdgcn_exp2f(S[i][q] - m); S[i][q] = p; l += p; } }
        l += __shfl_xor(l, 32); l += __builtin_amdgcn_exp2f(sink2 - m);
        f32x16 O[2];
#pragma unroll
        for (int q = 0; q < 16; ++q) { O[0][q] = 0.f; O[1][q] = 0.f; }
#pragma unroll
        for (int i = 0; i < 5; ++i) { const int kb = qb - 4 + i;
            if (kb >= 0) {
#pragma unroll
                for (int s2 = 0; s2 < 2; ++s2) {
                    u32x4 pb; pb.x = pk_bf16(S[i][8 * s2], S[i][8 * s2 + 1]); pb.y = pk_bf16(S[i][8 * s2 + 2], S[i][8 * s2 + 3]); pb.z = pk_bf16(S[i][8 * s2 + 4], S[i][8 * s2 + 5]); pb.w = pk_bf16(S[i][8 * s2 + 6], S[i][8 * s2 + 7]);
#pragma unroll
                    for (int dt = 0; dt < 2; ++dt) { const LAS unsigned char* vp = lds + ATT_VOFF + (kvh * 64 + 32 * dt + r) * ATT_VS + (32 * (qbl + i) + 16 * s2 + 4 * hh) * 2;
                        const u32x2 v0 = *(const LAS u32x2*)vp, v1 = *(const LAS u32x2*)(vp + 16); u32x4 av; av.x = v0.x; av.y = v0.y; av.z = v1.x; av.w = v1.y;
                        O[dt] = MFMA32(__builtin_bit_cast(bf16x8, av), __builtin_bit_cast(bf16x8, pb), O[dt]); }
                    asm volatile("" ::: "memory");
                } } }
        const float inv = 1.f / l;
#pragma unroll
        for (int dt = 0; dt < 2; ++dt)
#pragma unroll
            for (int g = 0; g < 4; ++g) { u32x2 w; w.x = pk_bf16(O[dt][4 * g] * inv, O[dt][4 * g + 1] * inv); w.y = pk_bf16(O[dt][4 * g + 2] * inv, O[dt][4 * g + 3] * inv);
                *(u32x2*)(ya + trow * 512 + h * 64 + 32 * dt + 8 * g + 4 * hh) = w; }
    }
    __syncthreads();
}

DI void hgrn_prep_unit(bf16_t* qd, bf16_t* kinv, LAS unsigned char* kl, float* dec, const float* lb, int bh, int c, int dk2) {
    const int b = bh >> 2, h = bh & 3;
    bf16_t* qp = qd + ((size_t)b * SEQ + c * 64) * 512 + h * 128 + dk2; bf16_t* kp = kinv + ((size_t)b * SEQ + c * 64) * 512 + h * 128 + dk2;
    const float lb0 = lb[h * 128 + dk2], lb1 = lb[h * 128 + dk2 + 1], om0 = 1.f - lb0, om1 = 1.f - lb1;
    unsigned qw[64], kv[64];
#pragma unroll
    for (int s = 0; s < 64; ++s) { qw[s] = *(const unsigned*)(qp + (size_t)s * 512); kv[s] = *(const unsigned*)(kp + (size_t)s * 512); }
    float b0 = 0.f, b1 = 0.f;
#pragma unroll
    for (int s = 0; s < 64; ++s) {
        const float f0 = lb0 + om0 * sigm(bflo(kv[s])), f1 = lb1 + om1 * sigm(bfhi(kv[s]));
        b0 += __logf(f0); b1 += __logf(f1);
        const float e0 = __expf(b0), e1 = __expf(b1), i0 = __builtin_amdgcn_rcpf(e0), i1 = __builtin_amdgcn_rcpf(e1);
        const float q0 = bflo(qw[s]), q1 = bfhi(qw[s]);
        *(unsigned*)(qp + (size_t)s * 512) = pk_bf16(q0 * sigm(q0) * e0, q1 * sigm(q1) * e1);
        kv[s] = pk_bf16((1.f - f0) * i0, (1.f - f1) * i1);
        *(unsigned*)(kp + (size_t)s * 512) = kv[s];
    }
    const float d0 = __expf(b0), d1 = __expf(b1);
    *(f32x2*)(dec + (size_t)(bh * 64 + c) * 128 + dk2) = (f32x2){d0, d1};
    LAS unsigned char* r0 = kl + dk2 * 144; LAS unsigned char* r1 = r0 + 144;
#pragma unroll
    for (int s0 = 0; s0 < 64; s0 += 8) { u32x4 w0, w1;
#pragma unroll
        for (int i = 0; i < 4; ++i) { const unsigned ka = kv[s0 + 2 * i], kb = kv[s0 + 2 * i + 1];
            w0[i] = pk_bf16(bflo(ka) * d0, bflo(kb) * d0); w1[i] = pk_bf16(bfhi(ka) * d1, bfhi(kb) * d1); }
        *(LAS u32x4*)(r0 + s0 * 2) = w0; *(LAS u32x4*)(r1 + s0 * 2) = w1; }
}
DI void hgrn_ds_unit(const LAS unsigned char* kl, const bf16_t* vT, bf16_t* dsT, int bh, int c) {
    int tid_ = threadIdx.x; asm volatile("" : "+v"(tid_));
    const int lane = tid_ & 63, wave = tid_ >> 6, r = lane & 31, hh = lane >> 5, i = wave >> 1, j0 = 2 * (wave & 1);
    const LAS unsigned char* ka = kl + (32 * i + r) * 144 + 16 * hh;
    const bf16_t* vb0 = vT + (size_t)(bh * 128 + 32 * j0 + r) * SEQ + c * 64 + 8 * hh; const bf16_t* vb1 = vb0 + (size_t)32 * SEQ;
    f32x16 D0, D1;
#pragma unroll
    for (int q = 0; q < 16; ++q) { D0[q] = 0.f; D1[q] = 0.f; }
#pragma unroll
    for (int ks = 0; ks < 4; ++ks) { const bf16x8 a = *(const LAS bf16x8*)(ka + 32 * ks), b0 = *(const bf16x8*)(vb0 + 16 * ks), b1 = *(const bf16x8*)(vb1 + 16 * ks); D0 = MFMA32(a, b0, D0); D1 = MFMA32(a, b1, D1); }
    const int unit = bh * 64 + c;
    bf16_t* o0 = dsT + (size_t)(unit * 128 + 32 * j0 + r) * 128 + 32 * i + 4 * hh; bf16_t* o1 = o0 + 32 * 128;
#pragma unroll
    for (int g = 0; g < 4; ++g) { u32x2 w; w.x = pk_bf16(D0[4 * g], D0[4 * g + 1]); w.y = pk_bf16(D0[4 * g + 2], D0[4 * g + 3]); *(u32x2*)(o0 + 8 * g) = w;
        u32x2 z; z.x = pk_bf16(D1[4 * g], D1[4 * g + 1]); z.y = pk_bf16(D1[4 * g + 2], D1[4 * g + 3]); *(u32x2*)(o1 + 8 * g) = z; }
}
DI void hgrn_scan(bf16_t* dsT, const float* dec, int vb, int G) {
    for (int idx = vb * NTHR + threadIdx.x; idx < 64 * 128 * 16; idx += G * NTHR) {
        const int dk8 = idx & 15, dv = (idx >> 4) & 127, bh = idx >> 11;
        float S[8];
#pragma unroll
        for (int q = 0; q < 8; ++q) S[q] = 0.f;
        for (int c0 = 0; c0 < 64; c0 += 8) {
            u32x4 ld[8]; f32x4 d0[8], d1[8];
#pragma unroll
            for (int i = 0; i < 8; ++i) { const int c = c0 + i; ld[i] = *(const u32x4*)(dsT + (size_t)((bh * 64 + c) * 128 + dv) * 128 + dk8 * 8);
                const float* dp = dec + (size_t)(bh * 64 + c) * 128 + dk8 * 8; d0[i] = *(const f32x4*)dp; d1[i] = *(const f32x4*)(dp + 4); }
#pragma unroll
            for (int i = 0; i < 8; ++i) { const int c = c0 + i;
                u32x4 w; w.x = pk_bf16(S[0], S[1]); w.y = pk_bf16(S[2], S[3]); w.z = pk_bf16(S[4], S[5]); w.w = pk_bf16(S[6], S[7]);
                *(u32x4*)(dsT + (size_t)((bh * 64 + c) * 128 + dv) * 128 + dk8 * 8) = w;
                S[0] = d0[i][0] * S[0] + bflo(ld[i].x); S[1] = d0[i][1] * S[1] + bfhi(ld[i].x); S[2] = d0[i][2] * S[2] + bflo(ld[i].y); S[3] = d0[i][3] * S[3] + bfhi(ld[i].y);
                S[4] = d1[i][0] * S[4] + bflo(ld[i].z); S[5] = d1[i][1] * S[5] + bfhi(ld[i].z); S[6] = d1[i][2] * S[6] + bflo(ld[i].w); S[7] = d1[i][3] * S[7] + bfhi(ld[i].w); }
        }
    }
}
constexpr int HO_Q = 0, HO_K = 64 * 272, HO_S = 2 * 64 * 272, HO_V = HO_S + 128 * 272, HO_Z = HO_V + 128 * 144;
struct HoPre { u32x4 c[10]; u32x4 g0, g1; };
DI void ho_fetch(HoPre& p, const bf16_t* qd, const bf16_t* kinv, const bf16_t* vT, const bf16_t* spT, const bf16_t* gs, int u, int tid) {
    const int bh = u >> 6, c = u & 63, b = bh >> 2, h = bh & 3; const size_t Tb = (size_t)b * SEQ + c * 64;
#pragma unroll
    for (int k = 0; k < 2; ++k) { const int i = tid + NTHR * k, row = i >> 4, ch = i & 15; p.c[k] = *(const u32x4*)(qd + (Tb + row) * 512 + h * 128 + ch * 8); p.c[2 + k] = *(const u32x4*)(kinv + (Tb + row) * 512 + h * 128 + ch * 8); }
#pragma unroll
    for (int k = 0; k < 4; ++k) { const int i = tid + NTHR * k, row = i >> 4, ch = i & 15; p.c[4 + k] = *(const u32x4*)(spT + (size_t)((bh * 64 + c) * 128 + row) * 128 + ch * 8); }
#pragma unroll
    for (int k = 0; k < 2; ++k) { const int i = tid + NTHR * k, row = i >> 3, ch = i & 7; p.c[8 + k] = *(const u32x4*)(vT + (size_t)(bh * 128 + row) * SEQ + c * 64 + ch * 8); }
    { const int tok = tid >> 3, d16 = (tid & 7) * 16; const size_t off = (Tb + tok) * 512 + h * 128 + d16; p.g0 = *(const u32x4*)(gs + off); p.g1 = *(const u32x4*)(gs + off + 8); }
}
DI void ho_put(const HoPre& p, LAS unsigned char* lds, int tid) {
#pragma unroll
    for (int k = 0; k < 2; ++k) { const int i = tid + NTHR * k, row = i >> 4, ch = i & 15; *(LAS u32x4*)(lds + HO_Q + row * 272 + ch * 16) = p.c[k]; *(LAS u32x4*)(lds + HO_K + row * 272 + ch * 16) = p.c[2 + k]; }
#pragma unroll
    for (int k = 0; k < 4; ++k) { const int i = tid + NTHR * k, row = i >> 4, ch = i & 15; *(LAS u32x4*)(lds + HO_S + row * 272 + ch * 16) = p.c[4 + k]; }
#pragma unroll
    for (int k = 0; k < 2; ++k) { const int i = tid + NTHR * k, row = i >> 3, ch = i & 7; *(LAS u32x4*)(lds + HO_V + row * 144 + ch * 16) = p.c[8 + k]; }
}
DI void hgrn_out_phase(const bf16_t* qd, const bf16_t* kinv, const bf16_t* vT, const bf16_t* spT, const bf16_t* gs, bf16_t* yh, LAS unsigned char* lds, int vb, int G) {
    int tid_ = threadIdx.x; asm volatile("" : "+v"(tid_));
    const int tid = tid_, lane = tid & 63, wave = __builtin_amdgcn_readfirstlane(tid >> 6), r = lane & 31, hh = lane >> 5, tb = wave >> 2, db = wave & 3;
    LAS float* zs = (LAS float*)(lds + HO_Z);
    HoPre pre;
    if (vb < 64 * 64) ho_fetch(pre, qd, kinv, vT, spT, gs, vb, tid);
    for (int u = vb; u < 64 * 64; u += G) {
        const int bh = u >> 6, c = u & 63, b = bh >> 2, h = bh & 3; const size_t Tb = (size_t)b * SEQ + c * 64;
        ho_put(pre, lds, tid);
        const u32x4 g0 = pre.g0, g1 = pre.g1;
        __syncthreads();
        { const int un = (u + G < 64 * 64) ? u + G : u; ho_fetch(pre, qd, kinv, vT, spT, gs, un, tid); }
        f32x16 Z;
#pragma unroll
        for (int q = 0; q < 16; ++q) Z[q] = 0.f;
        const LAS unsigned char* qb_ = lds + HO_Q + (32 * tb + r) * 272 + 16 * hh;
        bf16x8 qf[8];
#pragma unroll
        for (int ks = 0; ks < 8; ++ks) qf[ks] = *(const LAS bf16x8*)(qb_ + 32 * ks);
        { const LAS unsigned char* sb_ = lds + HO_S + (32 * db + r) * 272 + 16 * hh;
#pragma unroll
          for (int ks = 0; ks < 8; ++ks) Z = MFMA32(qf[ks], *(const LAS bf16x8*)(sb_ + 32 * ks), Z); }
#pragma unroll
        for (int sb = 0; sb < 2; ++sb) if (sb <= tb) {
            f32x16 X;
#pragma unroll
            for (int q = 0; q < 16; ++q) X[q] = 0.f;
            const LAS unsigned char* kb_ = lds + HO_K + (32 * sb + r) * 272 + 16 * hh;
#pragma unroll
            for (int ks = 0; ks < 8; ++ks) X = MFMA32(*(const LAS bf16x8*)(kb_ + 32 * ks), qf[ks], X);
            if (sb == tb) {
#pragma unroll
                for (int q = 0; q < 16; ++q) if (crow(q, hh) > r) X[q] = 0.f;
            }
#pragma unroll
            for (int s2 = 0; s2 < 2; ++s2) {
                u32x4 pa_; pa_.x = pk_bf16(X[8 * s2], X[8 * s2 + 1]); pa_.y = pk_bf16(X[8 * s2 + 2], X[8 * s2 + 3]); pa_.z = pk_bf16(X[8 * s2 + 4], X[8 * s2 + 5]); pa_.w = pk_bf16(X[8 * s2 + 6], X[8 * s2 + 7]);
                const LAS unsigned char* vp = lds + HO_V + (32 * db + r) * 144 + (32 * sb + 16 * s2 + 4 * hh) * 2;
                const u32x2 v0 = *(const LAS u32x2*)vp, v1 = *(const LAS u32x2*)(vp + 16);
                u32x4 pb_; pb_.x = v0.x; pb_.y = v0.y; pb_.z = v1.x; pb_.w = v1.y;
                Z = MFMA32(__builtin_bit_cast(bf16x8, pa_), __builtin_bit_cast(bf16x8, pb_), Z);
            }
        }
#pragma unroll
        for (int q = 0; q < 16; ++q) zs[(32 * tb + crow(q, hh)) * 132 + 32 * db + r] = Z[q];
        __syncthreads();
        { const int tok = tid >> 3, d16 = (tid & 7) * 16; f32x4 o[4]; float ss = 0.f;
          const size_t off = (Tb + tok) * 512 + h * 128 + d16;
#pragma unroll
          for (int i = 0; i < 4; ++i) { o[i] = *(const LAS f32x4*)(zs + tok * 132 + d16 + 4 * i); ss += (o[i][0] * o[i][0] + o[i][1] * o[i][1]) + (o[i][2] * o[i][2] + o[i][3] * o[i][3]); }
          ss += __shfl_xor(ss, 1); ss += __shfl_xor(ss, 2); ss += __shfl_xor(ss, 4);
          const float rn = __builtin_amdgcn_rsqf(ss * (1.f / 128.f) + EPS);
          u32x4 w0, w1;
          w0.x = pk_bf16(o[0][0] * rn * bflo(g0.x), o[0][1] * rn * bfhi(g0.x)); w0.y = pk_bf16(o[0][2] * rn * bflo(g0.y), o[0][3] * rn * bfhi(g0.y));
          w0.z = pk_bf16(o[1][0] * rn * bflo(g0.z), o[1][1] * rn * bfhi(g0.z)); w0.w = pk_bf16(o[1][2] * rn * bflo(g0.w), o[1][3] * rn * bfhi(g0.w));
          w1.x = pk_bf16(o[2][0] * rn * bflo(g1.x), o[2][1] * rn * bfhi(g1.x)); w1.y = pk_bf16(o[2][2] * rn * bflo(g1.y), o[2][3] * rn * bfhi(g1.y));
          w1.z = pk_bf16(o[3][0] * rn * bflo(g1.z), o[3][1] * rn * bfhi(g1.z)); w1.w = pk_bf16(o[3][2] * rn * bflo(g1.w), o[3][3] * rn * bfhi(g1.w));
          *(u32x4*)(yh + off) = w0; *(u32x4*)(yh + off + 8) = w1; }
    }
    __syncthreads();
}

DI unsigned f2ord(float f) { const unsigned b = __float_as_uint(f); return b ^ ((unsigned)((int)b >> 31) | 0x80000000u); }
DI float ord2f(unsigned k) { const unsigned b = (k & 0x80000000u) ? (k ^ 0x80000000u) : ~k; return __uint_as_float(b); }
DI void ce_desc(unsigned& a, unsigned& b) { const unsigned hi = a > b ? a : b, lo = a > b ? b : a; a = hi; b = lo; }
DI void sort16_desc(unsigned (&a)[16]) {
#pragma unroll
    for (int k = 2; k <= 16; k <<= 1)
#pragma unroll
        for (int j = k >> 1; j > 0; j >>= 1)
#pragma unroll
            for (int i = 0; i < 16; ++i) { const int l = i ^ j; if (l > i) { if ((i & k) == 0) ce_desc(a[i], a[l]); else ce_desc(a[l], a[i]); } }
}
DI void merge16_desc(unsigned (&a)[16], const unsigned (&b)[16]) {
#pragma unroll
    for (int i = 0; i < 16; ++i) a[i] = a[i] > b[15 - i] ? a[i] : b[15 - i];
#pragma unroll
    for (int j = 8; j > 0; j >>= 1)
#pragma unroll
        for (int i = 0; i < 16; ++i) { const int l = i ^ j; if (l > i) ce_desc(a[i], a[l]); }
}
#define TK_INS(L, x) do { unsigned t_ = (x); _Pragma("unroll") for (int j_ = 0; j_ < 16; ++j_) { const unsigned hi_ = L[j_] > t_ ? L[j_] : t_; t_ = L[j_] > t_ ? t_ : L[j_]; L[j_] = hi_; } } while (0)

DI void topk_stage_keys(const bf16_t* keysb, LAS unsigned char* kl, int h) {
    for (int c = threadIdx.x; c < 2 * 128 * 16; c += NTHR) { const int p = c >> 11, row = (c >> 4) & 127, ch = c & 15;
        *(LAS u32x4*)(kl + (p * 128 + row) * 272 + ch * 16) = *(const u32x4*)(keysb + ((size_t)(p * 8 + h) * 128 + row) * 128 + ch * 8); }
}
DI void topk_unit(const bf16_t* qp, const LAS unsigned char* kl, unsigned short* gidx, float* ggate, LAS unsigned* tk, int quad, int h) {
    const int tid = threadIdx.x, lane = tid & 63, wave = tid >> 6, p = wave & 1, tsub = wave >> 1, r = lane & 31, hh = lane >> 5;
#pragma unroll 1
    for (int hl = 0; hl < 4; ++hl) {
        const int tok0 = (quad * 4 + hl) * 128 + tsub * 32;
        f32x16 acc[4];
#pragma unroll
        for (int kb = 0; kb < 4; ++kb)
#pragma unroll
            for (int i = 0; i < 16; ++i) acc[kb][i] = 0.f;
        const bf16_t* qrow = qp + (size_t)(tok0 + r) * 2048 + h * 256 + p * 128 + 8 * hh;
        const LAS unsigned char* kbase = kl + (p * 128 + r) * 272 + 16 * hh;
#pragma unroll
        for (int s = 0; s < 8; ++s) { const bf16x8 bq = *(const bf16x8*)(qrow + 16 * s);
#pragma unroll
            for (int kb = 0; kb < 4; ++kb) { const bf16x8 ak = *(const LAS bf16x8*)(kbase + kb * 32 * 272 + 32 * s); acc[kb] = MFMA32(ak, bq, acc[kb]); } }
        unsigned A0[16], A1[16], A2[16], A3[16];
#pragma unroll
        for (int i = 0; i < 16; ++i) { const unsigned ki = (unsigned)(crow(i, hh));
            A0[i] = (f2ord(acc[0][i]) & ~127u) | ki; A1[i] = (f2ord(acc[1][i]) & ~127u) | (32u + ki); A2[i] = (f2ord(acc[2][i]) & ~127u) | (64u + ki); A3[i] = (f2ord(acc[3][i]) & ~127u) | (96u + ki); }
        sort16_desc(A0); sort16_desc(A1); sort16_desc(A2); sort16_desc(A3);
        merge16_desc(A0, A1); merge16_desc(A2, A3); merge16_desc(A0, A2);
#pragma unroll
        for (int j = 0; j < 16; ++j) A1[j] = __shfl_xor(A0[j], 32);
        merge16_desc(A0, A1);
        if (hh == 0) { LAS u32x4* dst = (LAS u32x4*)(tk + (((hl * 2 + p) * 128 + tsub * 32 + r) * 16));
#pragma unroll
            for (int c = 0; c < 4; ++c) { u32x4 w = {A0[4 * c], A0[4 * c + 1], A0[4 * c + 2], A0[4 * c + 3]}; dst[c] = w; } }
    }
    __syncthreads();
    {
        const int tok = tid & 127, hl = tid >> 7, tile = quad * 4 + hl;
        const LAS unsigned* t1 = tk + ((hl * 2 + 0) * 128 + tok) * 16; const LAS unsigned* t2 = tk + ((hl * 2 + 1) * 128 + tok) * 16;
        float v1[16], v2[16];
        { const LAS u32x4* s1 = (const LAS u32x4*)t1; const LAS u32x4* s2 = (const LAS u32x4*)t2;
#pragma unroll
          for (int c = 0; c < 4; ++c) { const u32x4 a = s1[c], b = s2[c];
              v1[4 * c] = ord2f(a.x & ~127u); v1[4 * c + 1] = ord2f(a.y & ~127u); v1[4 * c + 2] = ord2f(a.z & ~127u); v1[4 * c + 3] = ord2f(a.w & ~127u);
              v2[4 * c] = ord2f(b.x & ~127u); v2[4 * c + 1] = ord2f(b.y & ~127u); v2[4 * c + 2] = ord2f(b.z & ~127u); v2[4 * c + 3] = ord2f(b.w & ~127u); } }
#define CKEY(i, j) ((f2ord(v1[i] + v2[j]) & ~255u) | (unsigned)((i) * 16 + (j)))
        unsigned C[16], D[16], E[16];
#pragma unroll
        for (int j = 0; j < 16; ++j) C[j] = CKEY(0, j);
#pragma unroll
        for (int j = 0; j < 8; ++j) D[j] = CKEY(1, j);
#pragma unroll
        for (int j = 0; j < 5; ++j) D[8 + j] = CKEY(2, j);
#pragma unroll
        for (int j = 0; j < 3; ++j) D[13 + j] = CKEY(4, j);
#pragma unroll
        for (int j = 0; j < 4; ++j) E[j] = CKEY(3, j);
        E[4] = CKEY(5, 0); E[5] = CKEY(5, 1); E[6] = CKEY(6, 0); E[7] = CKEY(6, 1); E[8] = CKEY(7, 0); E[9] = CKEY(7, 1);
        E[10] = CKEY(8, 0); E[11] = CKEY(9, 0); E[12] = CKEY(10, 0); E[13] = CKEY(11, 0); E[14] = CKEY(12, 0); E[15] = CKEY(13, 0);
        sort16_desc(D); sort16_desc(E);
        TK_INS(E, CKEY(14, 0)); TK_INS(E, CKEY(15, 0));
#undef CKEY
        merge16_desc(C, D); merge16_desc(C, E);
        float sc[16]; unsigned ei[16]; float mx = -1e30f;
#pragma unroll
        for (int q = 0; q < 16; ++q) { const unsigned ij = C[q] & 255u; const unsigned a = t1[ij >> 4], b = t2[ij & 15u];
            sc[q] = ord2f(a & ~127u) + ord2f(b & ~127u); ei[q] = (a & 127u) * 128u + (b & 127u); mx = fmaxf(mx, sc[q]); }
        float sum = 0.f;
#pragma unroll
        for (int q = 0; q < 16; ++q) { sc[q] = __expf(sc[q] - mx); sum += sc[q]; }
        const float inv = 1.f / sum; const size_t o = (size_t)(tile * 128 + tok) * 128 + h * 16;
        u32x4 w0, w1;
        w0.x = ei[0] | (ei[1] << 16); w0.y = ei[2] | (ei[3] << 16); w0.z = ei[4] | (ei[5] << 16); w0.w = ei[6] | (ei[7] << 16);
        w1.x = ei[8] | (ei[9] << 16); w1.y = ei[10] | (ei[11] << 16); w1.z = ei[12] | (ei[13] << 16); w1.w = ei[14] | (ei[15] << 16);
        *(u32x4*)(gidx + o) = w0; *(u32x4*)(gidx + o + 8) = w1;
#pragma unroll
        for (int c = 0; c < 4; ++c) *(f32x4*)(ggate + o + 4 * c) = (f32x4){sc[4 * c] * inv, sc[4 * c + 1] * inv, sc[4 * c + 2] * inv, sc[4 * c + 3] * inv};
    }
    __syncthreads();
}

DI float gelu_erf(float x) { return 0.5f * x * (1.f + erff(x * 0.70710678118654752f)); }
DI int dot16(u32x4 w, const int (&h)[4]) { int c = __builtin_amdgcn_sdot4((int)w.x, h[0], 0, false); c = __builtin_amdgcn_sdot4((int)w.y, h[1], c, false); c = __builtin_amdgcn_sdot4((int)w.z, h[2], c, false); return __builtin_amdgcn_sdot4((int)w.w, h[3], c, false); }
#define V8_FMA(acc4, word, we) do { acc4[0] += (we) * (float)((word) & 255u); acc4[1] += (we) * (float)(((word) >> 8) & 255u); acc4[2] += (we) * (float)(((word) >> 16) & 255u); acc4[3] += (we) * (float)((word) >> 24); } while (0)

template <int IDMASK> DI void expert_token(const bf16_t* x2row, const float* ssq, const unsigned char* u8, const unsigned char* v8, const float* su, const float* sv, const unsigned short* gidx, const float* ggate, const float* gf, float* outrow, int lane) {
    f32x4 x[4]; float amax = 0.f;
#pragma unroll
    for (int i = 0; i < 4; ++i) { const u32x2 w_ = *(const u32x2*)(x2row + 16 * lane + 4 * i); x[i] = (f32x4){bflo(w_.x), bfhi(w_.x), bflo(w_.y), bfhi(w_.y)}; amax = fmaxf(fmaxf(amax, fmaxf(fabsf(x[i][0]), fabsf(x[i][1]))), fmaxf(fabsf(x[i][2]), fabsf(x[i][3]))); }
    float ss = (lane < 16) ? ssq[lane] : 0.f; ss = wave_sum(ss);
    const float rstd2 = __builtin_amdgcn_rsqf(ss * (1.f / 1024.f) + EPS);
#pragma unroll
    for (int o = 1; o < 64; o <<= 1) amax = fmaxf(amax, __shfl_xor(amax, o));
    amax *= rstd2;
    const float qs = amax > 0.f ? 127.f / amax : 0.f, sh = amax * (1.f / 127.f), xq = rstd2 * qs;
    int hq[4];
#pragma unroll
    for (int i = 0; i < 4; ++i) { const int q0 = (int)rintf(x[i][0] * xq), q1 = (int)rintf(x[i][1] * xq), q2 = (int)rintf(x[i][2] * xq), q3 = (int)rintf(x[i][3] * xq);
        hq[i] = (int)((unsigned)(q0 & 255) | ((unsigned)(q1 & 255) << 8) | ((unsigned)(q2 & 255) << 16) | ((unsigned)(q3 & 255) << 24)); }
    const int id0 = gidx[lane] & IDMASK, id1 = gidx[64 + lane] & IDMASK; const float g0 = ggate[lane], g1 = ggate[64 + lane];
    f32x4 o[4]; float wsum = 0.f;
#pragma unroll
    for (int i = 0; i < 4; ++i) o[i] = (f32x4){0.f, 0.f, 0.f, 0.f};
#pragma unroll 1
    for (int bt = 0; bt < 16; ++bt) {
        const int idsel = (bt < 8) ? id0 : id1; const float gsel = (bt < 8) ? g0 : g1; const int lb = (bt & 7) * 8;
        u32x4 ur[8], vr[8];
#pragma unroll
        for (int e = 0; e < 8; ++e) { const int idx = __builtin_amdgcn_readlane(idsel, lb + e); ur[e] = *(const u32x4*)(u8 + (size_t)idx * 1024 + 16 * lane); }
#pragma unroll
        for (int e = 0; e < 8; ++e) { const int idx = __builtin_amdgcn_readlane(idsel, lb + e); vr[e] = *(const u32x4*)(v8 + (size_t)idx * 1024 + 16 * lane); }
        const int myidx = __shfl(idsel, lb + (lane >> 3)); const float mysu = su[myidx], mysv = sv[myidx], gate = __shfl(gsel, lb + (lane >> 3));
        int pr[8];
#pragma unroll
        for (int e = 0; e < 8; ++e) pr[e] = dot16(ur[e], hq);
        int q4[4], q2[2], q1;
        { const bool up_ = (lane & 32) != 0;
#pragma unroll
          for (int i = 0; i < 4; ++i) { const int keep = up_ ? pr[i + 4] : pr[i], send = up_ ? pr[i] : pr[i + 4]; q4[i] = keep + __shfl_xor(send, 32); } }
        { const bool up_ = (lane & 16) != 0;
#pragma unroll
          for (int i = 0; i < 2; ++i) { const int keep = up_ ? q4[i + 2] : q4[i], send = up_ ? q4[i] : q4[i + 2]; q2[i] = keep + __shfl_xor(send, 16); } }
        { const bool up_ = (lane & 8) != 0; const int keep = up_ ? q2[1] : q2[0], send = up_ ? q2[0] : q2[1]; q1 = keep + __shfl_xor(send, 8); }
        q1 += __shfl_xor(q1, 4); q1 += __shfl_xor(q1, 2); q1 += __shfl_xor(q1, 1);
        const float act = (float)q1 * (mysu * sh);
        const float w = gelu_erf(act) * gate * mysv;
#pragma unroll
        for (int e = 0; e < 8; ++e) { const float we = __int_as_float(__builtin_amdgcn_readlane(__float_as_int(w), 8 * e)); wsum += we;
            V8_FMA(o[0], vr[e].x, we); V8_FMA(o[1], vr[e].y, we); V8_FMA(o[2], vr[e].z, we); V8_FMA(o[3], vr[e].w, we); }
    }
    const float corr = 128.f * wsum; float s3 = 0.f;
#pragma unroll
    for (int i = 0; i < 4; ++i) { x[i] += o[i] - corr; s3 += (x[i][0] * x[i][0] + x[i][1] * x[i][1]) + (x[i][2] * x[i][2] + x[i][3] * x[i][3]); }
    s3 = wave_sum(s3); const float r3 = __builtin_amdgcn_rsqf(s3 * (1.f / 1024.f) + EPS);
#pragma unroll
    for (int i = 0; i < 4; ++i) *(f32x4*)(outrow + 16 * lane + 4 * i) = x[i] * r3 * *(const f32x4*)(gf + 16 * lane + 4 * i);
}

DI void hq_token(const bf16_t* x2row, const float* ssq, unsigned char* hqrow, float* shp, int lane) {
    f32x4 x[4]; float amax = 0.f;
#pragma unroll
    for (int i = 0; i < 4; ++i) { const u32x2 w_ = *(const u32x2*)(x2row + 16 * lane + 4 * i); x[i] = (f32x4){bflo(w_.x), bfhi(w_.x), bflo(w_.y), bfhi(w_.y)}; amax = fmaxf(fmaxf(amax, fmaxf(fabsf(x[i][0]), fabsf(x[i][1]))), fmaxf(fabsf(x[i][2]), fabsf(x[i][3]))); }
    float ss = (lane < 16) ? ssq[lane] : 0.f; ss = wave_sum(ss);
    const float rstd2 = __builtin_amdgcn_rsqf(ss * (1.f / 1024.f) + EPS);
#pragma unroll
    for (int o = 1; o < 64; o <<= 1) amax = fmaxf(amax, __shfl_xor(amax, o));
    amax *= rstd2;
    const float qs = amax > 0.f ? 127.f / amax : 0.f, xq = rstd2 * qs;
    unsigned qb[16];
#pragma unroll
    for (int i = 0; i < 16; ++i) qb[i] = (unsigned)((int)rintf(x[i >> 2][i & 3] * xq) & 255);
    u32x4 w;
    w.x = qb[0] | (qb[2] << 8) | (qb[4] << 16) | (qb[6] << 24); w.y = qb[1] | (qb[3] << 8) | (qb[5] << 16) | (qb[7] << 24);
    w.z = qb[8] | (qb[10] << 8) | (qb[12] << 16) | (qb[14] << 24); w.w = qb[9] | (qb[11] << 8) | (qb[13] << 16) | (qb[15] << 24);
    *(u32x4*)(hqrow + 16 * lane) = w;
    if (lane == 0) *shp = amax * (1.f / 127.f);
}
template <int CTRL> DI int dpp_i(int v) { return __builtin_amdgcn_mov_dpp(v, CTRL, 0xf, 0xf, true); }
template <int CTRL> DI float dpp_f(float v) { return __int_as_float(__builtin_amdgcn_mov_dpp(__float_as_int(v), CTRL, 0xf, 0xf, true)); }
DI float swapadd32(float a, float b) { const auto r = __builtin_amdgcn_permlane32_swap(__float_as_uint(a), __float_as_uint(b), false, false); return __uint_as_float(r[0]) + __uint_as_float(r[1]); }
DI float swapadd16(float a, float b) { const auto r = __builtin_amdgcn_permlane16_swap(__float_as_uint(a), __float_as_uint(b), false, false); return __uint_as_float(r[0]) + __uint_as_float(r[1]); }

struct SMeta { u32x4 i0, i1, a0, a1; unsigned xw; };
template <int RS> DI void slice_issue(u32x4 (&r)[16], const SMeta& m, const unsigned char* base) {
    const unsigned iw[8] = {m.i0.x, m.i0.y, m.i0.z, m.i0.w, m.i1.x, m.i1.y, m.i1.z, m.i1.w};
#pragma unroll
    for (int j = 0; j < 16; ++j) { const unsigned idx = (j & 1) ? (iw[j >> 1] >> 16) : (iw[j >> 1] & 0xffffu); r[j] = *(const u32x4*)(base + (size_t)idx * RS); }
}
DI void slice_u_compute(const SMeta& m, const u32x4 (&r)[16], int* actp, int lane) {
    const int he[4] = {(int)m.a0.x, (int)m.a0.z, (int)m.a1.x, (int)m.a1.z}, ho[4] = {(int)m.a0.y, (int)m.a0.w, (int)m.a1.y, (int)m.a1.w};
    int hs = 0;
#pragma unroll
    for (int g = 0; g < 4; ++g) { hs = __builtin_amdgcn_sdot4(he[g], 0x01010101, hs, false); hs = __builtin_amdgcn_sdot4(ho[g], 0x01010101, hs, false); }
    hs *= 8;
    int part[16];
#pragma unroll
    for (int j = 0; j < 16; ++j) { int acc = -hs;
#pragma unroll
        for (int g = 0; g < 4; ++g) { const unsigned w = r[j][g]; acc = __builtin_amdgcn_sdot4((int)(w & 0x0F0F0F0Fu), he[g], acc, false); acc = __builtin_amdgcn_sdot4((int)((w >> 4) & 0x0F0F0F0Fu), ho[g], acc, false); }
        part[j] = acc; }
    int r8[8], r4[4], r2[2];
    { const bool up_ = (lane & 4) != 0;
#pragma unroll
      for (int i = 0; i < 8; ++i) { const int keep = up_ ? part[i + 8] : part[i], send = up_ ? part[i] : part[i + 8]; r8[i] = keep + dpp_i<0x141>(send); } }
    { const bool up_ = (lane & 2) != 0;
#pragma unroll
      for (int i = 0; i < 4; ++i) { const int keep = up_ ? r8[i + 4] : r8[i], send = up_ ? r8[i] : r8[i + 4]; r4[i] = keep + dpp_i<0x4E>(send); } }
    { const bool up_ = (lane & 1) != 0;
#pragma unroll
      for (int i = 0; i < 2; ++i) { const int keep = up_ ? r4[i + 2] : r4[i], send = up_ ? r4[i] : r4[i + 2]; r2[i] = keep + dpp_i<0xB1>(send); } }
    actp[lane] = (int)((unsigned)(((r2[0] + 4) >> 3) & 0xffff) | ((unsigned)((r2[1] + 4) >> 3) << 16));
}
DI int swapadd32i(int a, int b) { const auto r = __builtin_amdgcn_permlane32_swap((unsigned)a, (unsigned)b, false, false); return (int)r[0] + (int)r[1]; }
DI int swapadd16i(int a, int b) { const auto r = __builtin_amdgcn_permlane16_swap((unsigned)a, (unsigned)b, false, false); return (int)r[0] + (int)r[1]; }
DI void slice_v_compute(const SMeta& m, const u32x4 (&r)[16], float* x3row, float* ssq3p, int xs, int lane) {
    const int wq[4] = {(int)m.a0.x, (int)m.a0.y, (int)m.a0.z, (int)m.a0.w};
    const float sw = __uint_as_float(m.a1.x);
    const int col = 16 * (lane & 7) + ((lane >> 5) & 1) * 8 + ((lane >> 4) & 1) * 4 + ((lane >> 3) & 1) * 2;
    int o[16];
#pragma unroll
    for (int i = 0; i < 16; ++i) o[i] = 0;
#pragma unroll
    for (int q = 0; q < 4; ++q)
#pragma unroll
        for (int p = 0; p < 4; ++p) {
            const unsigned d0 = r[4 * q][p], d1 = r[4 * q + 1][p], d2 = r[4 * q + 2][p], d3 = r[4 * q + 3][p];
            const unsigned t0 = __builtin_amdgcn_perm(d1, d0, 0x05010400u), t1 = __builtin_amdgcn_perm(d1, d0, 0x07030602u), t2 = __builtin_amdgcn_perm(d3, d2, 0x05010400u), t3 = __builtin_amdgcn_perm(d3, d2, 0x07030602u);
            const unsigned e0 = __builtin_amdgcn_perm(t2, t0, 0x05040100u), e1 = __builtin_amdgcn_perm(t2, t0, 0x07060302u), e2 = __builtin_amdgcn_perm(t3, t1, 0x05040100u), e3 = __builtin_amdgcn_perm(t3, t1, 0x07060302u);
            o[4 * p] = __builtin_amdgcn_sdot4((int)e0, wq[q], o[4 * p], false); o[4 * p + 1] = __builtin_amdgcn_sdot4((int)e1, wq[q], o[4 * p + 1], false);
            o[4 * p + 2] = __builtin_amdgcn_sdot4((int)e2, wq[q], o[4 * p + 2], false); o[4 * p + 3] = __builtin_amdgcn_sdot4((int)e3, wq[q], o[4 * p + 3], false);
        }
    int a8[8], a4[4], a2[2];
#pragma unroll
    for (int i = 0; i < 8; ++i) a8[i] = swapadd32i(o[i], o[8 + i]);
#pragma unroll
    for (int i = 0; i < 4; ++i) a4[i] = swapadd16i(a8[i], a8[i + 4]);
    { const bool up_ = (lane & 8) != 0;
#pragma unroll
      for (int i = 0; i < 2; ++i) { const int keep = up_ ? a4[i + 2] : a4[i], send = up_ ? a4[i] : a4[i + 2]; a2[i] = keep + dpp_i<0x128>(send); } }
    const float y0 = bflo(m.xw) + (float)a2[0] * sw, y1 = bfhi(m.xw) + (float)a2[1] * sw;
    *(f32x2*)(x3row + 128 * xs + col) = (f32x2){y0, y1};
    const float ss = wave_sum(y0 * y0 + y1 * y1);
    if (lane == 0) ssq3p[xs] = ss;
}
template <int MODE> DI void slice_pass(unsigned char* ws, float* out, int xs, int gw_, int nw_, int lane) {
    const int g = lane >> 3, c = lane & 7;
    const int sl = MODE == 0 ? (xs >> 1) : xs, tmul = MODE == 0 ? 2 : 1, tadd = MODE == 0 ? (xs & 1) : 0, TT = T / tmul;
    const unsigned short* gidx = (const unsigned short*)(ws + WS_GIDX) + 16 * g;
    const unsigned char* tab = (MODE == 0 ? (const unsigned char*)(ws + WS_U8) : (const unsigned char*)(ws + WS_V8)) + 128 * sl + 16 * c;
    const unsigned char* hqb = (const unsigned char*)(ws + WS_HQ) + 256 * sl + 32 * c;
    const unsigned char* wxb = (const unsigned char*)(ws + WS_WX) + 16 * g;
    const bf16_t* x2b = (const bf16_t*)(ws + WS_X2B) + 128 * sl + 16 * c + ((lane >> 5) & 1) * 8 + ((lane >> 4) & 1) * 4 + ((lane >> 3) & 1) * 2;
#define S_LOAD(m, tok) do { const unsigned short* ip = gidx + (size_t)(tok) * 128; (m).i0 = *(const u32x4*)ip; (m).i1 = *(const u32x4*)(ip + 8); \
        if (MODE == 0) { const unsigned char* hp_ = hqb + (size_t)(tok) * 1024; (m).a0 = *(const u32x4*)hp_; (m).a1 = *(const u32x4*)(hp_ + 16); } \
        else { (m).a0 = *(const u32x4*)(wxb + (size_t)(tok) * 128); (m).a1.x = __float_as_uint(((const float*)(ws + WS_SW))[tok]); (m).xw = *(const unsigned*)(x2b + (size_t)(tok) * DM); } } while (0)
#define S_COMPUTE(m, r, tok) do { if (MODE == 0) slice_u_compute(m, r, (int*)(ws + WS_ACTP) + ((size_t)(tok) * 4 + sl) * 64, lane); \
        else slice_v_compute(m, r, out + (size_t)(tok) * DM, (float*)(ws + WS_SSQ3) + (size_t)(tok) * 8, sl, lane); } while (0)
#define S_ISSUE(r, m) do { if (MODE == 0) slice_issue<512>(r, m, tab); else slice_issue<1024>(r, m, tab); } while (0)
    SMeta mA, mB, mN; u32x4 rA[16], rB[16];
    if (gw_ >= TT) return;
    const int n = (TT - gw_ + nw_ - 1) / nw_;
#define S_TK(j) ((gw_ + ((j) < n ? (j) : n - 1) * nw_) * tmul + tadd)
    S_LOAD(mA, S_TK(0)); S_ISSUE(rA, mA); S_LOAD(mB, S_TK(1));
    for (int i = 0; i < n; i += 2) {
        S_ISSUE(rB, mB);
        S_LOAD(mN, S_TK(i + 2));
        S_COMPUTE(mA, rA, S_TK(i));
        mA = mN; S_ISSUE(rA, mA);
        S_LOAD(mN, S_TK(i + 3));
        if (i + 1 < n) S_COMPUTE(mB, rB, S_TK(i + 1));
        mB = mN;
    }
#undef S_TK
#undef S_LOAD
#undef S_COMPUTE
#undef S_ISSUE
}
DI void expert_w_token(const int* actp, const unsigned short* gidx, const float* ggate, float sh, const float* su, const float* sv, unsigned char* wrow, float* swp, int lane) {
    typedef int i32x2 __attribute__((ext_vector_type(2)));
    i32x2 acc = {0, 0};
#pragma unroll
    for (int x = 0; x < 4; ++x) { const int w_ = actp[x * 64 + lane]; acc[0] += (int)(short)(w_ & 0xffff); acc[1] += w_ >> 16; }
    acc[0] <<= 3; acc[1] <<= 3;
    const unsigned ii = *(const unsigned*)(gidx + 2 * lane); const f32x2 gt = *(const f32x2*)(ggate + 2 * lane);
    const int e0 = ii & 0xffffu, e1 = ii >> 16;
    const float w0 = gelu_erf((float)acc[0] * (su[e0] * sh)) * gt[0] * sv[e0], w1 = gelu_erf((float)acc[1] * (su[e1] * sh)) * gt[1] * sv[e1];
    float amax = fmaxf(fabsf(w0), fabsf(w1));
    amax = fmaxf(amax, dpp_f<0xB1>(amax)); amax = fmaxf(amax, dpp_f<0x4E>(amax)); amax = fmaxf(amax, dpp_f<0x141>(amax)); amax = fmaxf(amax, dpp_f<0x128>(amax));
    { const auto r = __builtin_amdgcn_permlane16_swap(__float_as_uint(amax), __float_as_uint(amax), false, false); amax = fmaxf(__uint_as_float(r[0]), __uint_as_float(r[1])); }
    { const auto r = __builtin_amdgcn_permlane32_swap(__float_as_uint(amax), __float_as_uint(amax), false, false); amax = fmaxf(__uint_as_float(r[0]), __uint_as_float(r[1])); }
    const float qs = amax > 0.f ? 127.f / amax : 0.f;
    const int q0 = (int)rintf(w0 * qs), q1 = (int)rintf(w1 * qs);
    *(unsigned short*)(wrow + 2 * lane) = (unsigned short)((q0 & 255) | ((q1 & 255) << 8));
    if (lane == 0) *swp = amax * (1.f / 127.f);
}
DI void final_norm_token(float* row, const float* ssq3p, const float* gf, int lane) {
    float ss = (lane < 8) ? ssq3p[lane] : 0.f; ss = wave_sum(ss);
    const float r3 = __builtin_amdgcn_rsqf(ss * (1.f / 1024.f) + EPS);
#pragma unroll
    for (int i = 0; i < 4; ++i) { f32x4* p = (f32x4*)(row + 256 * i + 4 * lane); *p = *p * r3 * *(const f32x4*)(gf + 256 * i + 4 * lane); }
}

#define XB_TMO      128
#define XB_XCNT(j)  (256  + 64 * (j))
#define XB_XSUB(j)  (1280 + 64 * (j))
#define XB_XGEN(j)  (2304 + 64 * (j))
#define XB_TOP      3328
#define XB_TOPGEN   3392
#define XCD_BAR_WORDS 3456
#define XB_SPIN_CAP (1u << 18)

__device__ __forceinline__ unsigned xb_ld(unsigned* p)              { return __hip_atomic_load(p, __ATOMIC_RELAXED, __HIP_MEMORY_SCOPE_AGENT); }
__device__ __forceinline__ unsigned xb_add(unsigned* p, unsigned v) { return __hip_atomic_fetch_add(p, v, __ATOMIC_RELAXED, __HIP_MEMORY_SCOPE_AGENT); }
__device__ __forceinline__ unsigned xb_xcc_id() { return (unsigned)__builtin_amdgcn_s_getreg((3 << 11) | 20) & 0xFu; }
#define XB_SPIN(cond, bar) do { unsigned _sp = 0; while (cond) { __builtin_amdgcn_s_sleep(1); \
    if ((++_sp & 255u) == 0u) { if (xb_ld(&(bar)[XB_TMO])) break; if (_sp > XB_SPIN_CAP) { atomicAdd(&(bar)[XB_TMO], 1u); break; } } } } while (0)

struct XcdBarrier {
    unsigned* bar; unsigned x;
    volatile __attribute__((address_space(3))) unsigned* st;
};

__device__ __forceinline__ XcdBarrier xcd_barrier_post(unsigned* bar, volatile __attribute__((address_space(3))) unsigned* st) {
    XcdBarrier b; b.bar = bar; b.x = xb_xcc_id(); b.st = st;
    if (threadIdx.x == 0) st[2] = xb_add(&bar[XB_XCNT(b.x)], 1u);
    return b;
}
__device__ __forceinline__ void xcd_barrier_complete(unsigned* bar, unsigned x, unsigned& nloc, unsigned& nx) {
    const unsigned G = gridDim.x * gridDim.y * gridDim.z;
    unsigned sum, cnt, mine, sp = 0u;
    for (;;) {
        sum = 0u; cnt = 0u; mine = 0u;
#pragma unroll
        for (unsigned j = 0; j < 16; ++j) { const unsigned c = xb_ld(&bar[XB_XCNT(j)]); sum += c; cnt += (c > 0u) ? 1u : 0u; mine = (j == x) ? c : mine; }
        if (sum == G) break;
        __builtin_amdgcn_s_sleep(1);
        if ((++sp & 255u) == 0u) { if (xb_ld(&bar[XB_TMO])) break; if (sp > XB_SPIN_CAP) { atomicAdd(&bar[XB_TMO], 1u); break; } }
    }
    nloc = mine > 0u ? mine : 1u; nx = cnt > 0u ? cnt : 1u;
}

__device__ __forceinline__ void xcd_barrier(const XcdBarrier& b) {
    asm volatile("s_waitcnt vmcnt(0)" ::: "memory");
    __syncthreads();
    if (threadIdx.x == 0) {
        unsigned* bar = b.bar;
        __builtin_amdgcn_s_waitcnt(0);
        unsigned nloc = b.st[0], nx = b.st[1];
        if (nloc == 0u) { xcd_barrier_complete(bar, b.x, nloc, nx); b.st[0] = nloc; b.st[1] = nx; }
        const unsigned old = xb_add(&bar[XB_XSUB(b.x)], 1u);
        const unsigned gen = old / nloc;
        if (old + 1u == (gen + 1u) * nloc) {
            __builtin_amdgcn_fence(__ATOMIC_RELEASE, "agent");
            asm volatile("s_waitcnt vmcnt(0)" ::: "memory");
            const unsigned og = xb_add(&bar[XB_TOP], 1u);
            const unsigned tg = og / nx;
            if (og + 1u == (tg + 1u) * nx) xb_add(&bar[XB_TOPGEN], 1u);
            else XB_SPIN(xb_ld(&bar[XB_TOPGEN]) == tg, bar);
            __builtin_amdgcn_fence(__ATOMIC_ACQUIRE, "agent");
            xb_add(&bar[XB_XGEN(b.x)], 1u);
            asm volatile("s_waitcnt vmcnt(0)" ::: "memory");
        } else {
            XB_SPIN(xb_ld(&bar[XB_XGEN(b.x)]) == gen, bar);
            __builtin_amdgcn_fence(__ATOMIC_ACQUIRE, "agent");
            asm volatile("s_waitcnt vmcnt(0)" ::: "memory");
        }
    }
    __syncthreads();
}

constexpr int N_PHASES = 13;
__global__ void __launch_bounds__(NTHR, 2) mk_fwd(Args a) {
    extern __shared__ __attribute__((aligned(16))) unsigned char lds_raw[];
    LAS unsigned char* lds = (LAS unsigned char*)lds_raw;
    cg::grid_group grid = cg::this_grid();
    const int G = gridDim.x, vb = blockIdx.x, tid = threadIdx.x, lane = tid & 63, wave = tid >> 6;
    unsigned char* ws = a.ws;
    const int lo = a.ph_lo, hi = a.ph_hi;
    volatile LAS unsigned* MISC = (volatile LAS unsigned*)(lds + LDS_BYTES - 64);
    if (tid < 16) MISC[tid] = 0u;
    __syncthreads();
    const XcdBarrier bar = xcd_barrier_post((unsigned*)(ws + 4096) + lo * XCD_BAR_WORDS, MISC);
#ifndef PHASE_MASK
#define PHASE_MASK 0xFFFF
#endif
#define IN(k) (((PHASE_MASK >> (k)) & 1) && lo <= (k) && (k) < hi)
#ifndef REPEAT_MASK
#define REPEAT_MASK 0
#endif
#define REP(k) for (int rep_ = 0; rep_ < (((REPEAT_MASK) >> (k)) & 1) + 1; ++rep_)
#define SEAM(k) do { if (IN(k) && IN((k) + 1)) { if ((k) == 0) grid.sync(); else xcd_barrier(bar); } } while (0)
    REP(0) if (IN(0)) p0_prologue(a, lds, vb, G);
    SEAM(0);
    REP(1) if (IN(1)) { pg8::Gemm g{(const bf16_t*)(ws + WS_XB), (const bf16_t*)(ws + WS_W1T), T, NIN, 1024}; pg8::StaticOrder S; S.init(T, NIN, G, vb);
        pg8::Epi1 E{(const float*)(ws + WS_RSTD1), (bf16_t*)(ws + WS_PA), (bf16_t*)(ws + WS_GG), (bf16_t*)(ws + WS_QD), (bf16_t*)(ws + WS_KINV), (bf16_t*)(ws + WS_KENDT), (bf16_t*)(ws + WS_VT), (bf16_t*)(ws + WS_GS),
                    (float*)(ws + WS_DEC), (const float*)(ws + WS_LB), (bf16_t*)(ws + WS_AVT), lds + 131072};
        pg8::gemm_phase<pg8::Epi1, pg8::StaticOrder, true, true>(lds, g, S, E); }
#ifdef PROBE_GEMM1_PLAIN
    if (IN(1)) { pg8::Gemm g{(const bf16_t*)(ws + WS_XB), (const bf16_t*)(ws + WS_W1T), T, NIN, 1024}; pg8::StaticOrder S; S.init(T, NIN, G, vb);
        pg8::EpiDummy E{(bf16_t*)(ws + WS_YA), (const float*)(ws + WS_RSTD1)};
        pg8::gemm_phase<pg8::EpiDummy, pg8::StaticOrder, true, true>(lds, g, S, E); }
#endif
    SEAM(1);
    REP(2) if (IN(2)) {
        for (int u0 = vb * 8; u0 < 64 * 64; u0 += G * 8) {
            { int t2_ = threadIdx.x; asm volatile("" : "+v"(t2_)); const int u = u0 + (t2_ >> 6);
              hgrn_prep_unit((bf16_t*)(ws + WS_QD), (bf16_t*)(ws + WS_KINV), lds + (t2_ >> 6) * 18432, (float*)(ws + WS_DEC), (const float*)(ws + WS_LB), u >> 6, u & 63, (t2_ & 63) * 2); }
            __syncthreads();
            for (int j = 0; j < 8; ++j) hgrn_ds_unit(lds + j * 18432, (const bf16_t*)(ws + WS_VT), (bf16_t*)(ws + WS_XB), (u0 + j) >> 6, (u0 + j) & 63);
            __syncthreads();
        }
        for (int u = vb; u < BATCH * (SEQ / 64); u += G) attn_unit((const bf16_t*)(ws + WS_PA), (const bf16_t*)(ws + WS_AVT), a.in[3], (bf16_t*)(ws + WS_YA), lds, u >> 6, u & 63);
    }
    SEAM(2);
    REP(3) if (IN(3)) hgrn_scan((bf16_t*)(ws + WS_XB), (const float*)(ws + WS_DEC), vb, G);
    SEAM(3);
    REP(4) if (IN(4)) hgrn_out_phase((const bf16_t*)(ws + WS_QD), (const bf16_t*)(ws + WS_KINV), (const bf16_t*)(ws + WS_VT), (const bf16_t*)(ws + WS_XB), (const bf16_t*)(ws + WS_GS), (bf16_t*)(ws + WS_YH), lds, vb, G);
    SEAM(4);
    REP(5) if (IN(5)) {
        { pg8::Gemm g{(const bf16_t*)(ws + WS_YA), (const bf16_t*)(ws + WS_WAPT), T, 1024, 512}; pg8::StaticOrder S; S.init(T, 1024, G, vb);
          pg8::EpiMerge<false> E{(bf16_t*)(ws + WS_XB), (const bf16_t*)(ws + WS_GG)};
          pg8::gemm_phase<pg8::EpiMerge<false>, pg8::StaticOrder, true, true>(lds, g, S, E); }
        __syncthreads();
        { pg8::Gemm g{(const bf16_t*)(ws + WS_YH), (const bf16_t*)(ws + WS_WHPT), T, 1024, 512}; pg8::StaticOrder S; S.init(T, 1024, G, vb);
          pg8::EpiMerge<true> E{(bf16_t*)(ws + WS_XB), (const bf16_t*)(ws + WS_GG) + 1024};
          pg8::gemm_phase<pg8::EpiMerge<true>, pg8::StaticOrder, true, true>(lds, g, S, E); }
    }
    SEAM(5);
    REP(6) if (IN(6)) { pg8::Gemm g{(const bf16_t*)(ws + WS_XB), (const bf16_t*)(ws + WS_WOUTT), T, 1024, 1024}; pg8::StaticOrder S; S.init(T, 1024, G, vb);
        pg8::EpiX2 E{a.in[0], (bf16_t*)(ws + WS_X2B), (float*)(ws + WS_SSQ2)};
        pg8::gemm_phase<pg8::EpiX2, pg8::StaticOrder, true, true>(lds, g, S, E); }
    SEAM(6);
    REP(7) if (IN(7)) { pg8::Gemm g{(const bf16_t*)(ws + WS_X2B), (const bf16_t*)(ws + WS_WQT), T, 2048, 1024}; pg8::StaticOrder S; S.init(T, 2048, G, vb);
        pg8::EpiQp E{(bf16_t*)(ws + WS_QP), (const float*)(ws + WS_SSQ2)};
        pg8::gemm_phase<pg8::EpiQp, pg8::StaticOrder, true, true>(lds, g, S, E); }
    SEAM(7);
    REP(8) if (IN(8)) { const int per = (1024 + G - 1) / G; int hcur = -1;
        for (int U = vb * per; U < (vb + 1) * per && U < 1024; ++U) { const int h = U >> 7;
            if (h != hcur) { topk_stage_keys((const bf16_t*)(ws + WS_KEYS), lds + 65536, h); hcur = h; __syncthreads(); }
            topk_unit((const bf16_t*)(ws + WS_QP), lds + 65536, (unsigned short*)(ws + WS_GIDX), (float*)(ws + WS_GGATE), (LAS unsigned*)lds, U & 127, h); }
        for (int tok = vb * 8 + wave; tok < T; tok += G * 8) hq_token((const bf16_t*)(ws + WS_X2B) + (size_t)tok * DM, (const float*)(ws + WS_SSQ2) + (size_t)tok * 16, (unsigned char*)(ws + WS_HQ) + (size_t)tok * 1024, (float*)(ws + WS_SH) + tok, lane); }
    SEAM(8);
    if (IN(9) || IN(11)) {
        if (tid == 0) {
            unsigned nloc_ = 0, nx_ = 0; xcd_barrier_complete(bar.bar, bar.x, nloc_, nx_);
            unsigned cj[8], tot = 0; bool all = true;
#pragma unroll
            for (int j = 0; j < 8; ++j) { cj[j] = xb_ld(&bar.bar[XB_XCNT(j)]); tot += cj[j]; all = all && cj[j] > 0u; }
            if (all && tot == (unsigned)G && bar.x < 8u) { MISC[4] = bar.x; MISC[5] = MISC[2]; MISC[6] = cj[bar.x & 7u]; }
            else { const unsigned sl_ = (unsigned)vb & 7u; MISC[4] = sl_; MISC[5] = (unsigned)vb >> 3; MISC[6] = ((unsigned)G - sl_ + 7u) >> 3; }
        }
        __syncthreads();
    }
    REP(9) if (IN(9)) slice_pass<0>(ws, a.out, (int)MISC[4], (int)MISC[5] * 8 + __builtin_amdgcn_readfirstlane(wave), (int)MISC[6] * 8, lane);
    SEAM(9);
    REP(10) if (IN(10)) for (int tok = vb * 8 + wave; tok < T; tok += G * 8)
        expert_w_token((const int*)(ws + WS_ACTP) + (size_t)tok * 256, (const unsigned short*)(ws + WS_GIDX) + (size_t)tok * 128, (const float*)(ws + WS_GGATE) + (size_t)tok * 128, ((const float*)(ws + WS_SH))[tok],
                       (const float*)(ws + WS_SU), (const float*)(ws + WS_SV), (unsigned char*)(ws + WS_WX) + (size_t)tok * 128, (float*)(ws + WS_SW) + tok, lane);
    SEAM(10);
    REP(11) if (IN(11)) slice_pass<1>(ws, a.out, (int)MISC[4], (int)MISC[5] * 8 + __builtin_amdgcn_readfirstlane(wave), (int)MISC[6] * 8, lane);
    SEAM(11);
    REP(12) if (IN(12)) for (int tok = vb * 8 + wave; tok < T; tok += G * 8) final_norm_token(a.out + (size_t)tok * DM, (const float*)(ws + WS_SSQ3) + (size_t)tok * 8, a.in[14], lane);
#undef IN
#undef SEAM
}

extern "C" void kernel_launch(void* const* d_in, const int* in_sizes, int n_in, void* d_out, int out_size, void* d_ws, size_t ws_size, hipStream_t stream) {
    static int grid = 0;
    if (grid == 0) {
        if (n_in != 15 || in_sizes[0] != T * DM || out_size != T * DM || ws_size < WS_END) { fprintf(stderr, "kernel_launch: unexpected shapes (n_in %d, in0 %d, out %d, ws %zu)\n", n_in, n_in > 0 ? in_sizes[0] : -1, out_size, ws_size); grid = -1; return; }
        int dev = 0, cus = 0, per_cu = 0;
        hipGetDevice(&dev); hipDeviceGetAttribute(&cus, hipDeviceAttributeMultiprocessorCount, dev);
        if (hipFuncSetAttribute((const void*)mk_fwd, hipFuncAttributeMaxDynamicSharedMemorySize, LDS_BYTES) != hipSuccess) { fprintf(stderr, "kernel_launch: hipFuncSetAttribute failed\n"); grid = -1; return; }
        if (hipOccupancyMaxActiveBlocksPerMultiprocessor(&per_cu, (const void*)mk_fwd, NTHR, LDS_BYTES) != hipSuccess || per_cu < 1) { fprintf(stderr, "kernel_launch: occupancy query says %d blocks per CU\n", per_cu); per_cu = 1; }
        (void)hipGetLastError();
        grid = cus;
    }
    if (grid < 0) return;
    if (hipMemsetAsync(d_ws, 0, 256 * 1024, stream) != hipSuccess) { fprintf(stderr, "kernel_launch: hipMemsetAsync failed\n"); return; }
    Args a{};
    for (int i = 0; i < 15; ++i) a.in[i] = (const float*)d_in[i];
    a.out = (float*)d_out; a.ws = (unsigned char*)d_ws;
#if MK_FUSED
    a.ph_lo = 0; a.ph_hi = N_PHASES;
    { void* args[] = {&a}; hipError_t e = hipLaunchCooperativeKernel((const void*)mk_fwd, dim3(grid), dim3(NTHR), args, LDS_BYTES, stream);
      if (e != hipSuccess) fprintf(stderr, "kernel_launch: cooperative launch failed: %s (grid %d)\n", hipGetErrorString(e), grid); }
#else
    for (int p = 0; p < N_PHASES; ++p) { a.ph_lo = p; a.ph_hi = p + 1; void* args[] = {&a};
        hipError_t e = hipLaunchCooperativeKernel((const void*)mk_fwd, dim3(grid), dim3(NTHR), args, LDS_BYTES, stream);
        if (e != hipSuccess) { fprintf(stderr, "kernel_launch: launch of phase %d failed: %s (grid %d)\n", p, hipGetErrorString(e), grid); break; } }
#endif
}
```

```cpp
#include <hip/hip_runtime.h>
#include <hip/hip_cooperative_groups.h>
#include <cstdio>
#include <cstdint>
namespace cg = cooperative_groups;
namespace pg8 {
#define PG8_LAS __attribute__((address_space(3)))
typedef unsigned short bf16_t;
typedef short bf16x8 __attribute__((ext_vector_type(8)));
typedef float f32x4 __attribute__((ext_vector_type(4)));
typedef unsigned u32x4 __attribute__((ext_vector_type(4)));
constexpr int BM = 256, BK = 64, HALF = 128, HTB = HALF * BK * 2  , STAGE_BYTES = 8 * HTB, NXCD = 8, WGM = 8;

__host__ __device__ __forceinline__ int lds_byte(int r, int c) { const int st = (r >> 4) * 2 + (c >> 5), rr = r & 15, cc = c & 31, ob = rr * 64 + cc * 2; return st * 1024 + (ob ^ (((ob >> 9) & 1) << 5)); }
__host__ __device__ __forceinline__ void stage_rc(int b, int& R, int& C) { const int st = b / 1024, sb = b % 1024, swz = sb ^ (((sb >> 9) & 1) << 5); R = (st >> 1) * 16 + swz / 64; C = (st & 1) * 32 + (swz % 64) / 2; }
__host__ __device__ __forceinline__ int perm32(int rho) { const int n = rho >> 4, i = rho & 15; return 8 * (i >> 2) + 4 * n + (i & 3); }

struct Unit { int pm, pn; };
struct Gemm { const bf16_t* A; const bf16_t* Bt; int M, N, K; };

struct StaticOrder {
    int nM, nN, nwg, G, c;
    __host__ __device__ void init(int M, int N, int G_, int c_) { nM = M / BM; nN = N / BM; nwg = nM * nN; G = G_; c = c_; }
    __host__ __device__ bool next(int i, Unit& u) const {
        const long L = (long)i * G + c; if (L >= nwg) return false;
        int wgid = (int)L; { const int q = nwg / NXCD, r = nwg % NXCD, xcd = wgid % NXCD, off = wgid / NXCD; wgid = (xcd < r ? xcd * (q + 1) : r * (q + 1) + (xcd - r) * q) + off; }
        const int nig = WGM * nN, gid = wgid / nig, fm = gid * WGM, gsz = (nM - fm) < WGM ? (nM - fm) : WGM;
        u.pm = fm + ((wgid % nig) % gsz); u.pn = (wgid % nig) / gsz; return true;
    }
    __device__ __forceinline__ void a_ready(const Unit&) const {}
    __device__ __forceinline__ void done(const Unit&) const {}
};

__device__ __forceinline__ unsigned cvt_pk_bf16(float lo, float hi) { unsigned r; asm volatile("v_cvt_pk_bf16_f32 %0, %1, %2" : "=v"(r) : "v"(lo), "v"(hi)); return r; }

template <class Epi, class Sched, bool ALIGN_EPI = false, bool SP2 = false>
__device__ __forceinline__ void gemm_phase(PG8_LAS unsigned char* lds, const Gemm g, const Sched& S, const Epi& E) {
    int tid_ = threadIdx.x; asm volatile("" : "+v"(tid_));
    const int tid = tid_, wid = __builtin_amdgcn_readfirstlane(tid >> 6), lane = tid & 63, wr = wid >> 2, wc = wid & 3, fr = lane & 15, fq = lane >> 4;
    const int K = g.K, nt = K / BK;
    unsigned voffA[2], voffB[2];
#pragma unroll
    for (int i = 0; i < 2; ++i) { int R, C; stage_rc(tid * 16 + i * 8192, R, C); const int Rb = Epi::PERM ? ((R & ~31) + perm32(R & 31)) : R;
        voffA[i] = (unsigned)(R * K + C) * 2u; voffB[i] = (unsigned)(Rb * K + C) * 2u; }
    const size_t kstep = (size_t)(BK * 2);
    const size_t hstep = (size_t)HALF * K * 2;
    const size_t tstep = 2 * hstep;
    const unsigned ldsw = (unsigned)wid * 1024u;
    const int aoff = lds_byte(wr * 64 + fr, fq * 8), boff = lds_byte(wc * 32 + fr, fq * 8);
#define PG8_SA(b, h) (((b) * 2 + (h)) * HTB)
#define PG8_SB(b, h) ((4 + (b) * 2 + (h)) * HTB)
#define PG8_STAGE(bufoff, gbase, voff) do { _Pragma("unroll") for (int _i = 0; _i < 2; ++_i) \
        __builtin_amdgcn_global_load_lds((const unsigned*)((const char*)(gbase) + (voff)[_i]), (PG8_LAS unsigned*)(lds + (bufoff) + ldsw + _i * 8192), 16, 0, 0); } while (0)
#define PG8_LDA(dst, b, h) do { _Pragma("unroll") for (int m = 0; m < 4; ++m) _Pragma("unroll") for (int k = 0; k < 2; ++k) dst[m][k] = *(const PG8_LAS bf16x8*)(lds + PG8_SA(b, h) + aoff + m * 2048 + k * 1024); } while (0)
#define PG8_LDB(dst, b, h) do { _Pragma("unroll") for (int n = 0; n < 2; ++n) _Pragma("unroll") for (int k = 0; k < 2; ++k) dst[n][k] = *(const PG8_LAS bf16x8*)(lds + PG8_SB(b, h) + boff + n * 2048 + k * 1024); } while (0)
#define PG8_MMA(ai, bj, At, Bt) do { __builtin_amdgcn_s_setprio(1); _Pragma("unroll") for (int m = 0; m < 4; ++m) _Pragma("unroll") for (int n = 0; n < 2; ++n) _Pragma("unroll") for (int k = 0; k < 2; ++k) \
        acc[ai][bj][m][n] = __builtin_amdgcn_mfma_f32_16x16x32_bf16(Bt[n][k], At[m][k], acc[ai][bj][m][n], 0, 0, 0); __builtin_amdgcn_s_setprio(0); } while (0)
#define PG8_WAIT_V(n) asm volatile("s_waitcnt vmcnt(" #n ")" ::: "memory")
#define PG8_WAIT_L(n) asm volatile("s_waitcnt lgkmcnt(" #n ")" ::: "memory")
#define PG8_BAR __builtin_amdgcn_s_barrier()
#define PG8_SCHED __builtin_amdgcn_sched_barrier(0)
    Unit cur, nxt; int ui = 0;
    if (!S.next(0, cur)) return;
    f32x4 acc[2][2][4][2];
#pragma unroll
    for (int a = 0; a < 2; ++a)
#pragma unroll
        for (int b = 0; b < 2; ++b)
#pragma unroll
            for (int m = 0; m < 4; ++m)
#pragma unroll
                for (int n = 0; n < 2; ++n) acc[a][b][m][n] = (f32x4){0.f, 0.f, 0.f, 0.f};
    bf16x8 At[4][2], B0[2][2], B1[2][2];
    const char* cA = (const char*)g.A + (size_t)cur.pm * tstep; const char* cB = (const char*)g.Bt + (size_t)cur.pn * tstep;
    S.a_ready(cur);
    if constexpr (SP2) {
        PG8_STAGE(PG8_SB(0, 0), cB, voffB); PG8_STAGE(PG8_SB(0, 1), cB + hstep, voffB); PG8_STAGE(PG8_SA(0, 0), cA, voffA); PG8_STAGE(PG8_SA(0, 1), cA + hstep, voffA);
        if (wr == 1) PG8_BAR;
        PG8_WAIT_V(2); PG8_BAR;
        PG8_STAGE(PG8_SB(1, 0), cB + kstep, voffB); PG8_STAGE(PG8_SA(1, 0), cA + kstep, voffA); PG8_STAGE(PG8_SB(1, 1), cB + hstep + kstep, voffB);
        PG8_WAIT_V(6); PG8_BAR;
    } else {
        PG8_STAGE(PG8_SB(0, 0), cB, voffB); PG8_STAGE(PG8_SA(0, 0), cA, voffA); PG8_STAGE(PG8_SB(0, 1), cB + hstep, voffB); PG8_STAGE(PG8_SA(0, 1), cA + hstep, voffA);
        if (wr == 1) PG8_BAR;
        PG8_WAIT_V(4); PG8_BAR;
        PG8_STAGE(PG8_SB(1, 0), cB + kstep, voffB); PG8_STAGE(PG8_SA(1, 0), cA + kstep, voffA); PG8_STAGE(PG8_SB(1, 1), cB + hstep + kstep, voffB);
        PG8_WAIT_V(6); PG8_BAR;
    }
    for (;;) {
        const bool has_next = S.next(ui + 1, nxt);
        const char* nA = has_next ? (const char*)g.A + (size_t)nxt.pm * tstep : cA; const char* nB = has_next ? (const char*)g.Bt + (size_t)nxt.pn * tstep : cB;
        for (int t = 0; t < nt; t += 2) {
            const bool last = (t == nt - 2);
            const char* a1 = cA + (size_t)(t + 1) * kstep;
            const char* a2 = last ? nA : cA + (size_t)(t + 2) * kstep; const char* b2 = last ? nB : cB + (size_t)(t + 2) * kstep;
            const char* a3 = a2 + kstep; const char* b3 = b2 + kstep;
            if (last && has_next) S.a_ready(nxt);
            if constexpr (SP2) {
            PG8_LDB(B0, 0, 0); PG8_LDB(B1, 0, 1); PG8_SCHED; PG8_LDA(At, 0, 0); PG8_STAGE(PG8_SA(1, 1), a1 + hstep, voffA);
            PG8_WAIT_V(8); PG8_WAIT_L(0); PG8_BAR; PG8_MMA(0, 0, At, B0); PG8_MMA(0, 1, At, B1); PG8_BAR; PG8_SCHED;
            PG8_LDA(At, 0, 1); PG8_STAGE(PG8_SB(0, 0), b2, voffB); PG8_STAGE(PG8_SB(0, 1), b2 + hstep, voffB); PG8_STAGE(PG8_SA(0, 0), a2, voffA);
            PG8_WAIT_V(8); PG8_WAIT_L(0); PG8_BAR; PG8_MMA(1, 0, At, B0); PG8_MMA(1, 1, At, B1); PG8_BAR; PG8_SCHED;
            PG8_LDB(B0, 1, 0); PG8_LDB(B1, 1, 1); PG8_SCHED; PG8_LDA(At, 1, 0); PG8_STAGE(PG8_SA(0, 1), a2 + hstep, voffA);
            PG8_WAIT_V(8); PG8_WAIT_L(0); PG8_BAR; PG8_MMA(0, 0, At, B0); PG8_MMA(0, 1, At, B1); PG8_BAR; PG8_SCHED;
            PG8_LDA(At, 1, 1); PG8_STAGE(PG8_SB(1, 0), b3, voffB); PG8_STAGE(PG8_SB(1, 1), b3 + hstep, voffB); PG8_STAGE(PG8_SA(1, 0), a3, voffA);
            PG8_WAIT_V(8); PG8_WAIT_L(0); PG8_BAR; PG8_MMA(1, 0, At, B0); PG8_MMA(1, 1, At, B1); PG8_BAR; PG8_SCHED;
            } else {
            PG8_LDB(B0, 0, 0); PG8_SCHED; PG8_LDA(At, 0, 0); PG8_STAGE(PG8_SA(1, 1), a1 + hstep, voffA);
            PG8_WAIT_L(8); PG8_BAR; PG8_WAIT_L(0); PG8_MMA(0, 0, At, B0); PG8_BAR; PG8_SCHED;
            PG8_LDB(B1, 0, 1); PG8_STAGE(PG8_SB(0, 0), b2, voffB);
            PG8_BAR; PG8_WAIT_L(0); PG8_MMA(0, 1, At, B1); PG8_BAR;
            PG8_LDA(At, 0, 1); PG8_STAGE(PG8_SA(0, 0), a2, voffA);
            PG8_BAR; PG8_WAIT_L(0); PG8_MMA(1, 0, At, B0); PG8_BAR; PG8_SCHED;
            PG8_STAGE(PG8_SB(0, 1), b2 + hstep, voffB);
            PG8_WAIT_V(6); PG8_BAR; PG8_MMA(1, 1, At, B1); PG8_BAR;
            PG8_LDB(B0, 1, 0); PG8_SCHED; PG8_LDA(At, 1, 0); PG8_STAGE(PG8_SA(0, 1), a2 + hstep, voffA);
            PG8_WAIT_L(8); PG8_BAR; PG8_WAIT_L(0); PG8_MMA(0, 0, At, B0); PG8_BAR; PG8_SCHED;
            PG8_LDB(B1, 1, 1); PG8_STAGE(PG8_SB(1, 0), b3, voffB);
            PG8_BAR; PG8_WAIT_L(0); PG8_MMA(0, 1, At, B1); PG8_BAR;
            PG8_LDA(At, 1, 1); PG8_STAGE(PG8_SA(1, 0), a3, voffA);
            PG8_BAR; PG8_WAIT_L(0); PG8_MMA(1, 0, At, B0); PG8_BAR; PG8_SCHED;
            PG8_STAGE(PG8_SB(1, 1), b3 + hstep, voffB);
            PG8_WAIT_V(6); PG8_BAR; PG8_MMA(1, 1, At, B1); PG8_BAR;
            }
        }
        if constexpr (ALIGN_EPI) { if (wr == 0) PG8_BAR; }
        if constexpr (!Epi::AFTER_DRAIN) { E(acc, cur, wr, wc, fr, fq); S.done(cur); }
        if (!has_next) break;
#pragma unroll
        for (int a = 0; a < 2; ++a)
#pragma unroll
            for (int b = 0; b < 2; ++b)
#pragma unroll
                for (int m = 0; m < 4; ++m)
#pragma unroll
                    for (int n = 0; n < 2; ++n) acc[a][b][m][n] = (f32x4){0.f, 0.f, 0.f, 0.f};
        cur = nxt; cA = nA; cB = nB; ++ui;
        if constexpr (ALIGN_EPI) { if (wr == 1) PG8_BAR; }
    }
    PG8_WAIT_V(0);
    if constexpr (!ALIGN_EPI) { if (wr == 0) PG8_BAR; }
    PG8_BAR;
    if constexpr (Epi::AFTER_DRAIN) { E.fused(acc, cur, wr, wc, fr, fq, lds, wid, lane); S.done(cur); }
#undef PG8_SA
#undef PG8_SB
#undef PG8_STAGE
#undef PG8_LDA
#undef PG8_LDB
#undef PG8_MMA
#undef PG8_WAIT_V
#undef PG8_WAIT_L
#undef PG8_BAR
#undef PG8_SCHED
}
}

#ifndef MK_FUSED
#define MK_FUSED 1
#endif
#define DI __device__ __forceinline__
#define LAS __attribute__((address_space(3)))
typedef unsigned short bf16_t;
typedef float f32x4 __attribute__((ext_vector_type(4)));
typedef float f32x2 __attribute__((ext_vector_type(2)));
typedef float f32x16 __attribute__((ext_vector_type(16)));
typedef unsigned u32x4 __attribute__((ext_vector_type(4)));
typedef unsigned u32x2 __attribute__((ext_vector_type(2)));
typedef short bf16x8 __attribute__((ext_vector_type(8)));
typedef _Float16 h16x2 __attribute__((ext_vector_type(2)));
typedef _Float16 h16x8 __attribute__((ext_vector_type(8)));

constexpr int BATCH = 16, SEQ = 4096, T = BATCH * SEQ, DM = 1024, NIN = 4864;
constexpr int C_AQ = 0, C_AK = 512, C_AV = 640, C_HQ = 768, C_HF = 1280, C_HI = 1792, C_HG = 2304, C_GA = 2816, C_GH = 3840;
constexpr float EPS = 1e-6f;
constexpr int NTHR = 512;
constexpr int LDS_BYTES = 163840;

constexpr size_t MiB = 1u << 20;
constexpr size_t WS_W1T = 1 * MiB;
constexpr size_t WS_WAPT = 11 * MiB;
constexpr size_t WS_WHPT = 12 * MiB;
constexpr size_t WS_WOUTT = 13 * MiB;
constexpr size_t WS_WQT = 15 * MiB;
constexpr size_t WS_KEYS = 19 * MiB;
constexpr size_t WS_LB = 19 * MiB + 512 * 1024;
constexpr size_t WS_RSTD1 = 20 * MiB;
constexpr size_t WS_SSQ2 = 21 * MiB;
constexpr size_t WS_U8 = 26 * MiB;
constexpr size_t WS_V8 = 42 * MiB;
constexpr size_t WS_SU = 58 * MiB;
constexpr size_t WS_SV = 58 * MiB + 65536;
constexpr size_t WS_DEC = 60 * MiB;
constexpr size_t WS_AVT = 64 * MiB;
constexpr size_t WS_XB = 90 * MiB;
constexpr size_t WS_PA = 218 * MiB;
constexpr size_t WS_GG = 314 * MiB;
constexpr size_t WS_QD = 570 * MiB;
constexpr size_t WS_KINV = 634 * MiB;
constexpr size_t WS_KENDT = 698 * MiB;
constexpr size_t WS_VT = 762 * MiB;
constexpr size_t WS_GS = 826 * MiB;
constexpr size_t WS_YA = 890 * MiB;
constexpr size_t WS_YH = 954 * MiB;
constexpr size_t WS_END = 1018 * MiB;
constexpr size_t WS_HQ = 698 * MiB;
constexpr size_t WS_WX = 762 * MiB;
constexpr size_t WS_SH = 60 * MiB;
constexpr size_t WS_SSQ3 = 64 * MiB;
constexpr size_t WS_SW = 61 * MiB;
constexpr size_t WS_ACTP = 346 * MiB;
constexpr size_t WS_X2B = 218 * MiB;
constexpr size_t WS_QP = 346 * MiB;
constexpr size_t WS_GIDX = 602 * MiB;
constexpr size_t WS_GGATE = 618 * MiB;

struct Args { const float* in[15]; float* out; unsigned char* ws; int ph_lo, ph_hi; };

DI unsigned pk_bf16(float lo, float hi) { typedef __bf16 b2 __attribute__((ext_vector_type(2))); f32x2 v = {lo, hi}; b2 b = __builtin_convertvector(v, b2); return __builtin_bit_cast(unsigned, b); }
DI float bflo(unsigned w) { return __uint_as_float(w << 16); }
DI float bfhi(unsigned w) { return __uint_as_float(w & 0xffff0000u); }
DI float sigm(float x) { return __builtin_amdgcn_rcpf(1.f + __expf(-x)); }
DI float wave_sum(float v) {
    v += __int_as_float(__builtin_amdgcn_mov_dpp(__float_as_int(v), 0xB1, 0xf, 0xf, true));
    v += __int_as_float(__builtin_amdgcn_mov_dpp(__float_as_int(v), 0x4E, 0xf, 0xf, true));
    v += __int_as_float(__builtin_amdgcn_mov_dpp(__float_as_int(v), 0x141, 0xf, 0xf, true));
    v += __int_as_float(__builtin_amdgcn_mov_dpp(__float_as_int(v), 0x128, 0xf, 0xf, true));
    { const auto r = __builtin_amdgcn_permlane16_swap(__float_as_uint(v), __float_as_uint(v), false, false); v = __uint_as_float(r[0]) + __uint_as_float(r[1]); }
    { const auto r = __builtin_amdgcn_permlane32_swap(__float_as_uint(v), __float_as_uint(v), false, false); v = __uint_as_float(r[0]) + __uint_as_float(r[1]); }
    return v;
}
DI unsigned short bf16_1(float x) { return (unsigned short)(pk_bf16(x, 0.f) & 0xffffu); }
template <int N> DI float dpp_row_shr(float v) { return __int_as_float(__builtin_amdgcn_update_dpp(0, __float_as_int(v), 0x110 + N, 0xf, 0xf, true)); }
DI float rowsum16(float v) { v += __int_as_float(__builtin_amdgcn_mov_dpp(__float_as_int(v), 0xB1, 0xf, 0xf, true)); v += __int_as_float(__builtin_amdgcn_mov_dpp(__float_as_int(v), 0x4E, 0xf, 0xf, true));
    v += __int_as_float(__builtin_amdgcn_mov_dpp(__float_as_int(v), 0x141, 0xf, 0xf, true)); v += __int_as_float(__builtin_amdgcn_mov_dpp(__float_as_int(v), 0x128, 0xf, 0xf, true)); return v; }
DI float scan16(float v) { v += dpp_row_shr<1>(v); v += dpp_row_shr<2>(v); v += dpp_row_shr<4>(v); v += dpp_row_shr<8>(v); return v; }
DI int crow(int reg, int hh) { return (reg & 3) + 8 * (reg >> 2) + 4 * hh; }
#define MFMA32(a, b, c) __builtin_amdgcn_mfma_f32_32x32x16_bf16((a), (b), (c), 0, 0, 0)
#define LDS_WAIT() asm volatile("s_waitcnt lgkmcnt(0)" ::: "memory")

namespace pg8 {
#define TSTORE_WRITE(sl, e, m, x) *(PG8_LAS bf16_t*)((sl) + (4 * fq + (e)) * 144 + (16 * (m) + fr) * 2) = bf16_1(x)
struct Epi1 {
    static constexpr bool PERM = true, AFTER_DRAIN = false;
    const float* rs; bf16_t* pa; bf16_t* gg; bf16_t* qd; bf16_t* kinv; bf16_t* kendT; bf16_t* vT; bf16_t* gs; float* dec; const float* lb; bf16_t* avT; PG8_LAS unsigned char* xl;
    __device__ __forceinline__ void operator()(const f32x4 (&acc)[2][2][4][2], const Unit& u, int wr, int wc, int fr, int fq) const {
        asm volatile("" : "+v"(fr), "+v"(fq));
        const int row0 = u.pm * BM + wr * 64 + fr, pn = u.pn;
        if (pn == 2) {
            const int c8 = wc * 32 + 8 * fq, tseqb = (u.pm & 15) * 256 + wr * 64 + fr, bb = u.pm >> 4;
#pragma unroll
            for (int ai = 0; ai < 2; ++ai)
#pragma unroll
                for (int m = 0; m < 4; ++m) { const int row = row0 + ai * HALF + m * 16; const float s = rs[row];
                    const f32x4 v0 = acc[ai][0][m][0] * s, v1 = acc[ai][0][m][1] * s;
                    u32x4 w; w.x = pk_bf16(v0[0], v0[1]); w.y = pk_bf16(v0[2], v0[3]); w.z = pk_bf16(v1[0], v1[1]); w.w = pk_bf16(v1[2], v1[3]);
                    *(u32x4*)(pa + (size_t)row * 768 + 512 + c8) = w;
                }
            PG8_LAS unsigned char* sl = xl + (wr * 4 + wc) * 2304; const int lane_ = fq * 16 + fr;
#pragma unroll
            for (int ai = 0; ai < 2; ++ai)
#pragma unroll
                for (int n = 0; n < 2; ++n) {
#pragma unroll
                    for (int m = 0; m < 4; ++m) { const float s = rs[row0 + ai * HALF + m * 16];
#pragma unroll
                        for (int e = 0; e < 4; ++e) TSTORE_WRITE(sl, e, m, acc[ai][1][m][n][e] * s); }
                    asm volatile("s_waitcnt lgkmcnt(0)" ::: "memory");
#pragma unroll
                    for (int q = 0; q < 2; ++q) { const int c = lane_ + 64 * q, rw = c >> 3, tc = c & 7, col = wc * 32 + 8 * (rw >> 2) + 4 * n + (rw & 3);
                        const u32x4 w = *(const PG8_LAS u32x4*)(sl + rw * 144 + tc * 16);
                        *(u32x4*)(avT + (size_t)((bb * 2 + (col >> 6)) * 64 + (col & 63)) * SEQ + (u.pm & 15) * 256 + ai * HALF + wr * 64 + 8 * tc) = w; }
                    asm volatile("s_waitcnt lgkmcnt(0)" ::: "memory");
                }
            return;
        }
        if (pn < 3 || pn >= 11) {
            bf16_t* O; int ldc, colt;
            if (pn < 3) { O = pa; ldc = 768; colt = pn * 256; } else { O = gg; ldc = 2048; colt = (pn - 11) * 256; }
            const int col0 = colt + wc * 32 + 8 * fq;
#pragma unroll
            for (int ai = 0; ai < 2; ++ai)
#pragma unroll
                for (int m = 0; m < 4; ++m) { const int row = row0 + ai * HALF + m * 16; const float s = rs[row]; bf16_t* rowp = O + (size_t)row * ldc + col0;
#pragma unroll
                    for (int bj = 0; bj < 2; ++bj) { const f32x4 v0 = acc[ai][bj][m][0] * s, v1 = acc[ai][bj][m][1] * s;
                        u32x4 w; w.x = pk_bf16(v0[0], v0[1]); w.y = pk_bf16(v0[2], v0[3]); w.z = pk_bf16(v1[0], v1[1]); w.w = pk_bf16(v1[2], v1[3]);
                        *(u32x4*)(rowp + bj * HALF) = w; } }
            return;
        }
        PG8_LAS unsigned char* sl = xl + (wr * 4 + wc) * 2304; const int lane_ = fq * 16 + fr;
        const int h = (pn - 3) & 3, c8 = wc * 32 + 8 * fq, bh = (u.pm >> 4) * 4 + h;
        if (pn < 7) {
#pragma unroll
            for (int ai = 0; ai < 2; ++ai)
#pragma unroll
                for (int m = 0; m < 4; ++m) { const int row = row0 + ai * HALF + m * 16; const float s = rs[row]; const size_t o = (size_t)row * 512 + h * 128 + c8;
#pragma unroll
                    for (int bj = 0; bj < 2; ++bj) { const f32x4 v0 = acc[ai][bj][m][0] * s, v1 = acc[ai][bj][m][1] * s;
                        u32x4 w; w.x = pk_bf16(v0[0], v0[1]); w.y = pk_bf16(v0[2], v0[3]); w.z = pk_bf16(v1[0], v1[1]); w.w = pk_bf16(v1[2], v1[3]);
                        *(u32x4*)((bj ? kinv : qd) + o) = w; } }
        } else {
#pragma unroll
            for (int ai = 0; ai < 2; ++ai) {
                const int tseq0 = (u.pm & 15) * 256 + ai * HALF + wr * 64;
#pragma unroll
                for (int n = 0; n < 2; ++n) {
#pragma unroll
                    for (int m = 0; m < 4; ++m) { const float s = rs[row0 + ai * HALF + m * 16];
#pragma unroll
                        for (int e = 0; e < 4; ++e) TSTORE_WRITE(sl, e, m, acc[ai][0][m][n][e] * s); }
                    asm volatile("s_waitcnt lgkmcnt(0)" ::: "memory");
#pragma unroll
                    for (int q = 0; q < 2; ++q) { const int c = lane_ + 64 * q, rw = c >> 3, tc = c & 7, dvr = wc * 32 + 8 * (rw >> 2) + 4 * n + (rw & 3);
                        const u32x4 w = *(const PG8_LAS u32x4*)(sl + rw * 144 + tc * 16);
                        *(u32x4*)(vT + (size_t)(bh * 128 + dvr) * SEQ + tseq0 + 8 * tc) = w; }
                    asm volatile("s_waitcnt lgkmcnt(0)" ::: "memory");
                }
#pragma unroll
                for (int m = 0; m < 4; ++m) { const int row = row0 + ai * HALF + m * 16; const float s = rs[row];
                    f32x4 g0 = acc[ai][1][m][0] * s, g1 = acc[ai][1][m][1] * s;
#pragma unroll
                    for (int e = 0; e < 4; ++e) { g0[e] *= sigm(g0[e]); g1[e] *= sigm(g1[e]); }
                    u32x4 w; w.x = pk_bf16(g0[0], g0[1]); w.y = pk_bf16(g0[2], g0[3]); w.z = pk_bf16(g1[0], g1[1]); w.w = pk_bf16(g1[2], g1[3]);
                    *(u32x4*)(gs + (size_t)row * 512 + h * 128 + c8) = w; }
            }
        }
    }
};
struct EpiDummy {
    static constexpr bool PERM = true, AFTER_DRAIN = false;
    bf16_t* O; const float* rs;
    __device__ __forceinline__ void operator()(const f32x4 (&acc)[2][2][4][2], const Unit& u, int wr, int wc, int fr, int fq) const {
        asm volatile("" : "+v"(fr), "+v"(fq));
        const int row0 = wr * 64 + fr, col0 = wc * 32 + 8 * fq;
#pragma unroll
        for (int ai = 0; ai < 2; ++ai)
#pragma unroll
            for (int m = 0; m < 4; ++m) { const int row = row0 + ai * HALF + m * 16; const float s = rs[u.pm * BM + row]; bf16_t* rowp = O + (size_t)blockIdx.x * 65536 + (size_t)row * 256 + col0;
#pragma unroll
                for (int bj = 0; bj < 2; ++bj) { const f32x4 v0 = acc[ai][bj][m][0] * s, v1 = acc[ai][bj][m][1] * s;
                    u32x4 w; w.x = pk_bf16(v0[0], v0[1]); w.y = pk_bf16(v0[2], v0[3]); w.z = pk_bf16(v1[0], v1[1]); w.w = pk_bf16(v1[2], v1[3]);
                    *(u32x4*)(rowp + bj * HALF) = w; } }
    }
};
template <bool ADD> struct EpiMerge {
    static constexpr bool PERM = true, AFTER_DRAIN = false;
    bf16_t* O; const bf16_t* gate;
    __device__ __forceinline__ void operator()(const f32x4 (&acc)[2][2][4][2], const Unit& u, int wr, int wc, int fr, int fq) const {
        const int row0 = u.pm * BM + wr * 64 + fr, col0 = u.pn * BM + wc * 32 + 8 * fq;
#pragma unroll
        for (int ai = 0; ai < 2; ++ai)
#pragma unroll
            for (int m = 0; m < 4; ++m) { const int row = row0 + ai * HALF + m * 16; bf16_t* rowp = O + (size_t)row * DM + col0; const bf16_t* gp = gate + (size_t)row * 2048 + col0;
#pragma unroll
                for (int bj = 0; bj < 2; ++bj) { const u32x4 g = *(const u32x4*)(gp + bj * HALF);
                    f32x4 v0 = acc[ai][bj][m][0], v1 = acc[ai][bj][m][1];
                    v0[0] *= sigm(bflo(g.x)); v0[1] *= sigm(bfhi(g.x)); v0[2] *= sigm(bflo(g.y)); v0[3] *= sigm(bfhi(g.y));
                    v1[0] *= sigm(bflo(g.z)); v1[1] *= sigm(bfhi(g.z)); v1[2] *= sigm(bflo(g.w)); v1[3] *= sigm(bfhi(g.w));
                    if (ADD) { const u32x4 o = *(const u32x4*)(rowp + bj * HALF);
                        v0[0] += bflo(o.x); v0[1] += bfhi(o.x); v0[2] += bflo(o.y); v0[3] += bfhi(o.y); v1[0] += bflo(o.z); v1[1] += bfhi(o.z); v1[2] += bflo(o.w); v1[3] += bfhi(o.w); }
                    u32x4 w; w.x = pk_bf16(v0[0], v0[1]); w.y = pk_bf16(v0[2], v0[3]); w.z = pk_bf16(v1[0], v1[1]); w.w = pk_bf16(v1[2], v1[3]);
                    *(u32x4*)(rowp + bj * HALF) = w; } }
    }
};
struct EpiX2 {
    static constexpr bool PERM = true, AFTER_DRAIN = false;
    const float* X; bf16_t* X2B; float* ssq;
    __device__ __forceinline__ void operator()(const f32x4 (&acc)[2][2][4][2], const Unit& u, int wr, int wc, int fr, int fq) const {
        const int row0 = u.pm * BM + wr * 64 + fr, col0 = u.pn * BM + wc * 32 + 8 * fq;
#pragma unroll
        for (int ai = 0; ai < 2; ++ai)
#pragma unroll
            for (int m = 0; m < 4; ++m) { const int row = row0 + ai * HALF + m * 16; const size_t off = (size_t)row * DM + col0; float ss = 0.f;
#pragma unroll
                for (int bj = 0; bj < 2; ++bj) { const f32x4 x0 = *(const f32x4*)(X + off + bj * HALF), x1 = *(const f32x4*)(X + off + bj * HALF + 4);
                    const f32x4 v0 = acc[ai][bj][m][0] + x0, v1 = acc[ai][bj][m][1] + x1;
                    u32x4 w; w.x = pk_bf16(v0[0], v0[1]); w.y = pk_bf16(v0[2], v0[3]); w.z = pk_bf16(v1[0], v1[1]); w.w = pk_bf16(v1[2], v1[3]);
                    *(u32x4*)(X2B + off + bj * HALF) = w;
                    ss += (v0[0] * v0[0] + v0[1] * v0[1]) + (v0[2] * v0[2] + v0[3] * v0[3]) + (v1[0] * v1[0] + v1[1] * v1[1]) + (v1[2] * v1[2] + v1[3] * v1[3]); }
                ss += __shfl_xor(ss, 16); ss += __shfl_xor(ss, 32);
                if (fq == 0) ssq[(size_t)row * 16 + u.pn * 4 + wc] = ss; }
    }
};
struct EpiQp {
    static constexpr bool PERM = true, AFTER_DRAIN = false;
    bf16_t* O; const float* ssq;
    __device__ __forceinline__ void operator()(const f32x4 (&acc)[2][2][4][2], const Unit& u, int wr, int wc, int fr, int fq) const {
        const int row0 = u.pm * BM + wr * 64 + fr, col0 = u.pn * BM + wc * 32 + 8 * fq;
#pragma unroll
        for (int ai = 0; ai < 2; ++ai)
#pragma unroll
            for (int m = 0; m < 4; ++m) { const int row = row0 + ai * HALF + m * 16; const f32x4* sp = (const f32x4*)(ssq + (size_t)row * 16);
                const f32x4 a = sp[0], b = sp[1], c = sp[2], d = sp[3];
                const float tot = ((a[0] + a[1]) + (a[2] + a[3])) + ((b[0] + b[1]) + (b[2] + b[3])) + ((c[0] + c[1]) + (c[2] + c[3])) + ((d[0] + d[1]) + (d[2] + d[3]));
                const float s = __builtin_amdgcn_rsqf(tot * (1.f / 1024.f) + EPS); bf16_t* rowp = O + (size_t)row * 2048 + col0;
#pragma unroll
                for (int bj = 0; bj < 2; ++bj) { const f32x4 v0 = acc[ai][bj][m][0] * s, v1 = acc[ai][bj][m][1] * s;
                    u32x4 w; w.x = pk_bf16(v0[0], v0[1]); w.y = pk_bf16(v0[2], v0[3]); w.z = pk_bf16(v1[0], v1[1]); w.w = pk_bf16(v1[2], v1[3]);
                    *(u32x4*)(rowp + bj * HALF) = w; } }
    }
};
}

DI int w1_src_col(int n) {
    if (n < 768 || n >= 2816) return n;
    if (n < 1792) { const int h = (n - 768) >> 8, r = (n - 768) & 255; return r < 128 ? C_HQ + 128 * h + r : C_HF + 128 * h + (r - 128); }
    const int h = (n - 1792) >> 8, r = (n - 1792) & 255; return r < 128 ? C_HI + 128 * h + r : C_HG + 128 * h + (r - 128);
}
template <bool PERMW1> DI void p0_transpose_item(const float* W, int K, int N, bf16_t* WT, const float* g, int gmask, LAS float* scr, int item, int lane) {
    const int nblk = N / 32, kb = item / nblk, nb = item % nblk, k0 = 64 * kb, n0 = 32 * nb, ns = PERMW1 ? w1_src_col(n0) : n0;
#pragma unroll 8
    for (int i = 0; i < 32; ++i) { const int kk = 2 * i + (lane >> 5); float w = W[(size_t)(k0 + kk) * N + ns + (lane & 31)]; if (g) w *= g[(k0 + kk) & gmask]; scr[kk * 33 + (lane & 31)] = w; }
    LDS_WAIT(); asm volatile("" ::: "memory");
    const int c = lane & 7;
#pragma unroll
    for (int j = 0; j < 4; ++j) { const int n = (lane >> 3) + 8 * j; const LAS float* s = scr + (8 * c) * 33 + n;
        u32x4 o; o.x = pk_bf16(s[0 * 33], s[1 * 33]); o.y = pk_bf16(s[2 * 33], s[3 * 33]); o.z = pk_bf16(s[4 * 33], s[5 * 33]); o.w = pk_bf16(s[6 * 33], s[7 * 33]);
        *(u32x4*)(WT + (size_t)(n0 + n) * K + k0 + 8 * c) = o; }
    LDS_WAIT(); asm volatile("" ::: "memory");
}
DI unsigned pk_f16(float a, float b) { h16x2 v = {(_Float16)a, (_Float16)b}; return __builtin_bit_cast(unsigned, v); }

DI void p0_prologue(const Args& a, LAS unsigned char* lds, int vb, int G) {
    const int tid = threadIdx.x, lane = tid & 63, wave = tid >> 6;
    const int gw = vb * 8 + wave, NGW = G * 8, gt = vb * NTHR + tid, NGT = G * NTHR;
    unsigned char* ws = a.ws;
    LAS float* scr = (LAS float*)(lds + wave * 16384);
    constexpr int I_W1 = 16 * 152, I_AP = 8 * 32, I_HP = 8 * 32, I_OUT = 16 * 32, I_Q = 16 * 64, NITEMS = I_W1 + I_AP + I_HP + I_OUT + I_Q;
    for (int it = gw; it < NITEMS; it += NGW) {
        int r = it;
        if (r < I_W1) { p0_transpose_item<true>(a.in[2], 1024, NIN, (bf16_t*)(ws + WS_W1T), a.in[1], 1023, scr, r, lane); continue; } r -= I_W1;
        if (r < I_AP) { p0_transpose_item<false>(a.in[6], 512, 1024, (bf16_t*)(ws + WS_WAPT), nullptr, 0, scr, r, lane); continue; } r -= I_AP;
        if (r < I_HP) { p0_transpose_item<false>(a.in[7], 512, 1024, (bf16_t*)(ws + WS_WHPT), a.in[5], 127, scr, r, lane); continue; } r -= I_HP;
        if (r < I_OUT) { p0_transpose_item<false>(a.in[8], 1024, 1024, (bf16_t*)(ws + WS_WOUTT), nullptr, 0, scr, r, lane); continue; } r -= I_OUT;
        p0_transpose_item<false>(a.in[10], 1024, 2048, (bf16_t*)(ws + WS_WQT), a.in[9], 1023, scr, r, lane);
    }
    for (int i = gt; i < 2 * 8 * 128 * 128 / 4; i += NGT) { const f32x4 v = ((const f32x4*)a.in[11])[i]; u32x2 o; o.x = pk_bf16(v[0], v[1]); o.y = pk_bf16(v[2], v[3]); ((u32x2*)(ws + WS_KEYS))[i] = o; }
    for (int it = gw; it < 2 * 16384; it += NGW) {
        const int isv = it >= 16384, e = it & 16383;
        const float* src = (isv ? a.in[13] : a.in[12]) + (size_t)e * 1024 + 16 * lane;
        f32x4 x[4]; float amax = 0.f;
#pragma unroll
        for (int i = 0; i < 4; ++i) { x[i] = *(const f32x4*)(src + 4 * i); if (!isv) x[i] *= *(const f32x4*)(a.in[9] + 16 * lane + 4 * i);
            amax = fmaxf(fmaxf(amax, fmaxf(fabsf(x[i][0]), fabsf(x[i][1]))), fmaxf(fabsf(x[i][2]), fabsf(x[i][3]))); }
#pragma unroll
        for (int o = 1; o < 64; o <<= 1) amax = fmaxf(amax, __shfl_xor(amax, o));
        {
            float ssq_ = 0.f;
#pragma unroll
            for (int i = 0; i < 4; ++i) ssq_ += (x[i][0] * x[i][0] + x[i][1] * x[i][1]) + (x[i][2] * x[i][2] + x[i][3] * x[i][3]);
            ssq_ = wave_sum(ssq_);
            const float stp = fminf(0.35f * sqrtf(ssq_ * (1.f / 1024.f)), amax * (1.f / 7.f)), q4 = stp > 0.f ? 1.f / stp : 0.f; unsigned nb[16];
#pragma unroll
            for (int i = 0; i < 16; ++i) nb[i] = (unsigned)((int)fminf(fmaxf(rintf(x[i >> 2][i & 3] * q4), -7.f), 7.f) + 8);
            u32x2 w4; w4.x = (nb[0] | (nb[1] << 4)) | ((nb[2] | (nb[3] << 4)) << 8) | ((nb[4] | (nb[5] << 4)) << 16) | ((nb[6] | (nb[7] << 4)) << 24);
            w4.y = (nb[8] | (nb[9] << 4)) | ((nb[10] | (nb[11] << 4)) << 8) | ((nb[12] | (nb[13] << 4)) << 16) | ((nb[14] | (nb[15] << 4)) << 24);
            *(u32x2*)(ws + (isv ? WS_V8 : WS_U8) + (size_t)e * 512 + 8 * lane) = w4;
            if (lane == 0) ((float*)(ws + (isv ? WS_SV : WS_SU)))[e] = stp;
            continue;
        }
        const float qs = amax > 0.f ? 127.f / amax : 0.f; const int off = 0;
        u32x4 w;
#pragma unroll
        for (int i = 0; i < 4; ++i) { const int q0 = (int)rintf(x[i][0] * qs) + off, q1 = (int)rintf(x[i][1] * qs) + off, q2 = (int)rintf(x[i][2] * qs) + off, q3 = (int)rintf(x[i][3] * qs) + off;
            w[i] = (unsigned)(q0 & 255) | ((unsigned)(q1 & 255) << 8) | ((unsigned)(q2 & 255) << 16) | ((unsigned)(q3 & 255) << 24); }
        *(u32x4*)(ws + (isv ? WS_V8 : WS_U8) + (size_t)e * 1024 + 16 * lane) = w;
        if (lane == 0) ((float*)(ws + (isv ? WS_SV : WS_SU)))[e] = amax * (1.f / 127.f);
    }
    for (int row = gw; row < T; row += NGW) {
        const f32x4* xr = (const f32x4*)(a.in[0] + (size_t)row * DM) + lane; f32x4 v[4]; float s = 0.f;
#pragma unroll
        for (int j = 0; j < 4; ++j) { v[j] = xr[64 * j]; s += (v[j][0] * v[j][0] + v[j][1] * v[j][1]) + (v[j][2] * v[j][2] + v[j][3] * v[j][3]); }
        s = wave_sum(s);
        u32x2* o = (u32x2*)(ws + WS_XB + (size_t)row * DM * 2) + lane;
#pragma unroll
        for (int j = 0; j < 4; ++j) { u32x2 w; w.x = pk_bf16(v[j][0], v[j][1]); w.y = pk_bf16(v[j][2], v[j][3]); o[64 * j] = w; }
        if (lane == 0) ((float*)(ws + WS_RSTD1))[row] = __builtin_amdgcn_rsqf(s * (1.f / 1024.f) + EPS);
    }
    if (vb == 0) { const float l0 = a.in[4][tid], l1 = a.in[4][512 + tid]; ((float*)(ws + WS_LB))[tid] = 1.f / (1.f + __expf(l1 - l0)); }
}

constexpr int ATT_KS = 272, ATT_VS = 392, ATT_VOFF = 192 * ATT_KS;
DI void attn_unit(const bf16_t* pa, const bf16_t* avT, const float* sinks, bf16_t* ya, LAS unsigned char* lds, int b, int tt) {
    int tid_ = threadIdx.x; asm volatile("" : "+v"(tid_));
    const int tid = tid_, lane = tid & 63, h = __builtin_amdgcn_readfirstlane(tid >> 6), r = lane & 31, hh = lane >> 5, kvh = h >> 2;
    const int p0 = tt * 64 - 128;
    for (int c = tid; c < 192 * 16; c += NTHR) { const int row = c >> 4, ch = c & 15, pos = p0 + row; u32x4 w = {0u, 0u, 0u, 0u};
        if (pos >= 0) w = *(const u32x4*)(pa + ((size_t)b * SEQ + pos) * 768 + 512 + ch * 8);
        *(LAS u32x4*)(lds + row * ATT_KS + ch * 16) = w; }
    for (int c = tid; c < 128 * 24; c += NTHR) { const int row = c / 24, ch = c - row * 24, pos = p0 + ch * 8; u32x4 w = {0u, 0u, 0u, 0u};
        if (pos >= 0) w = *(const u32x4*)(avT + (size_t)(b * 128 + row) * SEQ + pos);
        LAS u32x2* d = (LAS u32x2*)(lds + ATT_VOFF + row * ATT_VS + ch * 16); d[0] = (u32x2){w.x, w.y}; d[1] = (u32x2){w.z, w.w}; }
    __syncthreads();
    constexpr float LOG2E = 1.4426950408889634f;
    const float slope2 = exp2f(-(float)(h + 1)) * LOG2E, sink2 = sinks[h] * LOG2E, qs = 0.125f * LOG2E;
#pragma unroll 1
    for (int qbl = 0; qbl < 2; ++qbl) {
        const int qb = tt * 2 + qbl; const size_t trow = (size_t)b * SEQ + qb * 32 + r;
        bf16x8 qf[4];
        { const bf16_t* qp = pa + trow * 768 + h * 64 + 8 * hh;
#pragma unroll
          for (int s = 0; s < 4; ++s) qf[s] = *(const bf16x8*)(qp + 16 * s); }
        f32x16 S[5]; float m = sink2;
#pragma unroll
        for (int i = 0; i < 5; ++i) { const int kb = qb - 4 + i;
            if (kb >= 0) {
#pragma unroll
                for (int q = 0; q < 16; ++q) S[i][q] = 0.f;
                const LAS unsigned char* kp = lds + (32 * (qbl + i) + r) * ATT_KS + kvh * 128 + 16 * hh;
#pragma unroll
                for (int s = 0; s < 4; ++s) S[i] = MFMA32(*(const LAS bf16x8*)(kp + 32 * s), qf[s], S[i]);
#pragma unroll
                for (int q = 0; q < 16; ++q) { const int dist = 32 * (4 - i) + r - crow(q, hh); float v = S[i][q] * qs - slope2 * (float)dist;
                    if (i == 0) v = (dist <= 127) ? v : -1e30f;
                    if (i == 4) v = (dist >= 0) ? v : -1e30f;
                    S[i][q] = v; m = fmaxf(m, v); }
            } }
        m = fmaxf(m, __shfl_xor(m, 32));
        float l = 0.f;
#pragma unroll
        for (int i = 0; i < 5; ++i) if (qb - 4 + i >= 0) {
#pragma unroll
            for (int q = 0; q < 16; ++q) { const float p = __builtin_amdgcn_exp2f(S[i][q] - m); S[i][q] = p; l += p; } }
        l += __shfl_xor(l, 32); l += __builtin_amdgcn_exp2f(sink2 - m);
        f32x16 O[2];
#pragma unroll
        for (int q = 0; q < 16; ++q) { O[0][q] = 0.f; O[1][q] = 0.f; }
#pragma unroll
        for (int i = 0; i < 5; ++i) { const int kb = qb - 4 + i;
            if (kb >= 0) {
#pragma unroll
                for (int s2 = 0; s2 < 2; ++s2) {
                    u32x4 pb; pb.x = pk_bf16(S[i][8 * s2], S[i][8 * s2 + 1]); pb.y = pk_bf16(S[i][8 * s2 + 2], S[i][8 * s2 + 3]); pb.z = pk_bf16(S[i][8 * s2 + 4], S[i][8 * s2 + 5]); pb.w = pk_bf16(S[i][8 * s2 + 6], S[i][8 * s2 + 7]);
#pragma unroll
                    for (int dt = 0; dt < 2; ++dt) { const LAS unsigned char* vp = lds + ATT_VOFF + (kvh * 64 + 32 * dt + r) * ATT_VS + (32 * (qbl + i) + 16 * s2 + 4 * hh) * 2;
                        const u32x2 v0 = *(const LAS u32x2*)vp, v1 = *(const LAS u32x2*)(vp + 16); u32x4 av; av.x = v0.x; av.y = v0.y; av.z = v1.x; av.w = v1.y;
                        O[dt] = MFMA32(__builtin_bit_cast(bf16x8, av), __builtin_bit_cast(bf16x8, pb), O[dt]); }
                    asm volatile("" ::: "memory");
                } } }
        const float inv = 1.f / l;
#pragma unroll
        for (int dt = 0; dt < 2; ++dt)
#pragma unroll
            for (int g = 0; g < 4; ++g) { u32x2 w; w.x = pk_bf16(O[dt][4 * g] * inv, O[dt][4 * g + 1] * inv); w.y = pk_bf16(O[dt][4 * g + 2] * inv, O[dt][4 * g + 3] * inv);
                *(u32x2*)(ya + trow * 512 + h * 64 + 32 * dt + 8 * g + 4 * hh) = w; }
    }
    __syncthreads();
}

DI void hgrn_prep_unit(bf16_t* qd, bf16_t* kinv, LAS unsigned char* kl, float* dec, const float* lb, int bh, int c, int dk2) {
    const int b = bh >> 2, h = bh & 3;
    bf16_t* qp = qd + ((size_t)b * SEQ + c * 64) * 512 + h * 128 + dk2; bf16_t* kp = kinv + ((size_t)b * SEQ + c * 64) * 512 + h * 128 + dk2;
    const float lb0 = lb[h * 128 + dk2], lb1 = lb[h * 128 + dk2 + 1], om0 = 1.f - lb0, om1 = 1.f - lb1;
    unsigned qw[64], kv[64];
#pragma unroll
    for (int s = 0; s < 64; ++s) { qw[s] = *(const unsigned*)(qp + (size_t)s * 512); kv[s] = *(const unsigned*)(kp + (size_t)s * 512); }
    float b0 = 0.f, b1 = 0.f;
#pragma unroll
    for (int s = 0; s < 64; ++s) {
        const float f0 = lb0 + om0 * sigm(bflo(kv[s])), f1 = lb1 + om1 * sigm(bfhi(kv[s]));
        b0 += __logf(f0); b1 += __logf(f1);
        const float e0 = __expf(b0), e1 = __expf(b1), i0 = __builtin_amdgcn_rcpf(e0), i1 = __builtin_amdgcn_rcpf(e1);
        const float q0 = bflo(qw[s]), q1 = bfhi(qw[s]);
        *(unsigned*)(qp + (size_t)s * 512) = pk_bf16(q0 * sigm(q0) * e0, q1 * sigm(q1) * e1);
        kv[s] = pk_bf16((1.f - f0) * i0, (1.f - f1) * i1);
        *(unsigned*)(kp + (size_t)s * 512) = kv[s];
    }
    const float d0 = __expf(b0), d1 = __expf(b1);
    *(f32x2*)(dec + (size_t)(bh * 64 + c) * 128 + dk2) = (f32x2){d0, d1};
    LAS unsigned char* r0 = kl + dk2 * 144; LAS unsigned char* r1 = r0 + 144;
#pragma unroll
    for (int s0 = 0; s0 < 64; s0 += 8) { u32x4 w0, w1;
#pragma unroll
        for (int i = 0; i < 4; ++i) { const unsigned ka = kv[s0 + 2 * i], kb = kv[s0 + 2 * i + 1];
            w0[i] = pk_bf16(bflo(ka) * d0, bflo(kb) * d0); w1[i] = pk_bf16(bfhi(ka) * d1, bfhi(kb) * d1); }
        *(LAS u32x4*)(r0 + s0 * 2) = w0; *(LAS u32x4*)(r1 + s0 * 2) = w1; }
}
DI void hgrn_ds_unit(const LAS unsigned char* kl, const bf16_t* vT, bf16_t* dsT, int bh, int c) {
    int tid_ = threadIdx.x; asm volatile("" : "+v"(tid_));
    const int lane = tid_ & 63, wave = tid_ >> 6, r = lane & 31, hh = lane >> 5, i = wave >> 1, j0 = 2 * (wave & 1);
    const LAS unsigned char* ka = kl + (32 * i + r) * 144 + 16 * hh;
    const bf16_t* vb0 = vT + (size_t)(bh * 128 + 32 * j0 + r) * SEQ + c * 64 + 8 * hh; const bf16_t* vb1 = vb0 + (size_t)32 * SEQ;
    f32x16 D0, D1;
#pragma unroll
    for (int q = 0; q < 16; ++q) { D0[q] = 0.f; D1[q] = 0.f; }
#pragma unroll
    for (int ks = 0; ks < 4; ++ks) { const bf16x8 a = *(const LAS bf16x8*)(ka + 32 * ks), b0 = *(const bf16x8*)(vb0 + 16 * ks), b1 = *(const bf16x8*)(vb1 + 16 * ks); D0 = MFMA32(a, b0, D0); D1 = MFMA32(a, b1, D1); }
    const int unit = bh * 64 + c;
    bf16_t* o0 = dsT + (size_t)(unit * 128 + 32 * j0 + r) * 128 + 32 * i + 4 * hh; bf16_t* o1 = o0 + 32 * 128;
#pragma unroll
    for (int g = 0; g < 4; ++g) { u32x2 w; w.x = pk_bf16(D0[4 * g], D0[4 * g + 1]); w.y = pk_bf16(D0[4 * g + 2], D0[4 * g + 3]); *(u32x2*)(o0 + 8 * g) = w;
        u32x2 z; z.x = pk_bf16(D1[4 * g], D1[4 * g + 1]); z.y = pk_bf16(D1[4 * g + 2], D1[4 * g + 3]); *(u32x2*)(o1 + 8 * g) = z; }
}
DI void hgrn_scan(bf16_t* dsT, const float* dec, int vb, int G) {
    for (int idx = vb * NTHR + threadIdx.x; idx < 64 * 128 * 16; idx += G * NTHR) {
        const int dk8 = idx & 15, dv = (idx >> 4) & 127, bh = idx >> 11;
        float S[8];
#pragma unroll
        for (int q = 0; q < 8; ++q) S[q] = 0.f;
        for (int c0 = 0; c0 < 64; c0 += 8) {
            u32x4 ld[8]; f32x4 d0[8], d1[8];
#pragma unroll
            for (int i = 0; i < 8; ++i) { const int c = c0 + i; ld[i] = *(const u32x4*)(dsT + (size_t)((bh * 64 + c) * 128 + dv) * 128 + dk8 * 8);
                const float* dp = dec + (size_t)(bh * 64 + c) * 128 + dk8 * 8; d0[i] = *(const f32x4*)dp; d1[i] = *(const f32x4*)(dp + 4); }
#pragma unroll
            for (int i = 0; i < 8; ++i) { const int c = c0 + i;
                u32x4 w; w.x = pk_bf16(S[0], S[1]); w.y = pk_bf16(S[2], S[3]); w.z = pk_bf16(S[4], S[5]); w.w = pk_bf16(S[6], S[7]);
                *(u32x4*)(dsT + (size_t)((bh * 64 + c) * 128 + dv) * 128 + dk8 * 8) = w;
                S[0] = d0[i][0] * S[0] + bflo(ld[i].x); S[1] = d0[i][1] * S[1] + bfhi(ld[i].x); S[2] = d0[i][2] * S[2] + bflo(ld[i].y); S[3] = d0[i][3] * S[3] + bfhi(ld[i].y);
                S[4] = d1[i][0] * S[4] + bflo(ld[i].z); S[5] = d1[i][1] * S[5] + bfhi(ld[i].z); S[6] = d1[i][2] * S[6] + bflo(ld[i].w); S[7] = d1[i][3] * S[7] + bfhi(ld[i].w); }
        }
    }
}
constexpr int HO_Q = 0, HO_K = 64 * 272, HO_S = 2 * 64 * 272, HO_V = HO_S + 128 * 272, HO_Z = HO_V + 128 * 144;
struct HoPre { u32x4 c[10]; u32x4 g0, g1; };
DI void ho_fetch(HoPre& p, const bf16_t* qd, const bf16_t* kinv, const bf16_t* vT, const bf16_t* spT, const bf16_t* gs, int u, int tid) {
    const int bh = u >> 6, c = u & 63, b = bh >> 2, h = bh & 3; const size_t Tb = (size_t)b * SEQ + c * 64;
#pragma unroll
    for (int k = 0; k < 2; ++k) { const int i = tid + NTHR * k, row = i >> 4, ch = i & 15; p.c[k] = *(const u32x4*)(qd + (Tb + row) * 512 + h * 128 + ch * 8); p.c[2 + k] = *(const u32x4*)(kinv + (Tb + row) * 512 + h * 128 + ch * 8); }
#pragma unroll
    for (int k = 0; k < 4; ++k) { const int i = tid + NTHR * k, row = i >> 4, ch = i & 15; p.c[4 + k] = *(const u32x4*)(spT + (size_t)((bh * 64 + c) * 128 + row) * 128 + ch * 8); }
#pragma unroll
    for (int k = 0; k < 2; ++k) { const int i = tid + NTHR * k, row = i >> 3, ch = i & 7; p.c[8 + k] = *(const u32x4*)(vT + (size_t)(bh * 128 + row) * SEQ + c * 64 + ch * 8); }
    { const int tok = tid >> 3, d16 = (tid & 7) * 16; const size_t off = (Tb + tok) * 512 + h * 128 + d16; p.g0 = *(const u32x4*)(gs + off); p.g1 = *(const u32x4*)(gs + off + 8); }
}
DI void ho_put(const HoPre& p, LAS unsigned char* lds, int tid) {
#pragma unroll
    for (int k = 0; k < 2; ++k) { const int i = tid + NTHR * k, row = i >> 4, ch = i & 15; *(LAS u32x4*)(lds + HO_Q + row * 272 + ch * 16) = p.c[k]; *(LAS u32x4*)(lds + HO_K + row * 272 + ch * 16) = p.c[2 + k]; }
#pragma unroll
    for (int k = 0; k < 4; ++k) { const int i = tid + NTHR * k, row = i >> 4, ch = i & 15; *(LAS u32x4*)(lds + HO_S + row * 272 + ch * 16) = p.c[4 + k]; }
#pragma unroll
    for (int k = 0; k < 2; ++k) { const int i = tid + NTHR * k, row = i >> 3, ch = i & 7; *(LAS u32x4*)(lds + HO_V + row * 144 + ch * 16) = p.c[8 + k]; }
}
DI void hgrn_out_phase(const bf16_t* qd, const bf16_t* kinv, const bf16_t* vT, const bf16_t* spT, const bf16_t* gs, bf16_t* yh, LAS unsigned char* lds, int vb, int G) {
    int tid_ = threadIdx.x; asm volatile("" : "+v"(tid_));
    const int tid = tid_, lane = tid & 63, wave = __builtin_amdgcn_readfirstlane(tid >> 6), r = lane & 31, hh = lane >> 5, tb = wave >> 2, db = wave & 3;
    LAS float* zs = (LAS float*)(lds + HO_Z);
    HoPre pre;
    if (vb < 64 * 64) ho_fetch(pre, qd, kinv, vT, spT, gs, vb, tid);
    for (int u = vb; u < 64 * 64; u += G) {
        const int bh = u >> 6, c = u & 63, b = bh >> 2, h = bh & 3; const size_t Tb = (size_t)b * SEQ + c * 64;
        ho_put(pre, lds, tid);
        const u32x4 g0 = pre.g0, g1 = pre.g1;
        __syncthreads();
        { const int un = (u + G < 64 * 64) ? u + G : u; ho_fetch(pre, qd, kinv, vT, spT, gs, un, tid); }
        f32x16 Z;
#pragma unroll
        for (int q = 0; q < 16; ++q) Z[q] = 0.f;
        const LAS unsigned char* qb_ = lds + HO_Q + (32 * tb + r) * 272 + 16 * hh;
        bf16x8 qf[8];
#pragma unroll
        for (int ks = 0; ks < 8; ++ks) qf[ks] = *(const LAS bf16x8*)(qb_ + 32 * ks);
        { const LAS unsigned char* sb_ = lds + HO_S + (32 * db + r) * 272 + 16 * hh;
#pragma unroll
          for (int ks = 0; ks < 8; ++ks) Z = MFMA32(qf[ks], *(const LAS bf16x8*)(sb_ + 32 * ks), Z); }
#pragma unroll
        for (int sb = 0; sb < 2; ++sb) if (sb <= tb) {
            f32x16 X;
#pragma unroll
            for (int q = 0; q < 16; ++q) X[q] = 0.f;
            const LAS unsigned char* kb_ = lds + HO_K + (32 * sb + r) * 272 + 16 * hh;
#pragma unroll
            for (int ks = 0; ks < 8; ++ks) X = MFMA32(*(const LAS bf16x8*)(kb_ + 32 * ks), qf[ks], X);
            if (sb == tb) {
#pragma unroll
                for (int q = 0; q < 16; ++q) if (crow(q, hh) > r) X[q] = 0.f;
            }
#pragma unroll
            for (int s2 = 0; s2 < 2; ++s2) {
                u32x4 pa_; pa_.x = pk_bf16(X[8 * s2], X[8 * s2 + 1]); pa_.y = pk_bf16(X[8 * s2 + 2], X[8 * s2 + 3]); pa_.z = pk_bf16(X[8 * s2 + 4], X[8 * s2 + 5]); pa_.w = pk_bf16(X[8 * s2 + 6], X[8 * s2 + 7]);
                const LAS unsigned char* vp = lds + HO_V + (32 * db + r) * 144 + (32 * sb + 16 * s2 + 4 * hh) * 2;
                const u32x2 v0 = *(const LAS u32x2*)vp, v1 = *(const LAS u32x2*)(vp + 16);
                u32x4 pb_; pb_.x = v0.x; pb_.y = v0.y; pb_.z = v1.x; pb_.w = v1.y;
                Z = MFMA32(__builtin_bit_cast(bf16x8, pa_), __builtin_bit_cast(bf16x8, pb_), Z);
            }
        }
#pragma unroll
        for (int q = 0; q < 16; ++q) zs[(32 * tb + crow(q, hh)) * 132 + 32 * db + r] = Z[q];
        __syncthreads();
        { const int tok = tid >> 3, d16 = (tid & 7) * 16; f32x4 o[4]; float ss = 0.f;
          const size_t off = (Tb + tok) * 512 + h * 128 + d16;
#pragma unroll
          for (int i = 0; i < 4; ++i) { o[i] = *(const LAS f32x4*)(zs + tok * 132 + d16 + 4 * i); ss += (o[i][0] * o[i][0] + o[i][1] * o[i][1]) + (o[i][2] * o[i][2] + o[i][3] * o[i][3]); }
          ss += __shfl_xor(ss, 1); ss += __shfl_xor(ss, 2); ss += __shfl_xor(ss, 4);
          const float rn = __builtin_amdgcn_rsqf(ss * (1.f / 128.f) + EPS);
          u32x4 w0, w1;
          w0.x = pk_bf16(o[0][0] * rn * bflo(g0.x), o[0][1] * rn * bfhi(g0.x)); w0.y = pk_bf16(o[0][2] * rn * bflo(g0.y), o[0][3] * rn * bfhi(g0.y));
          w0.z = pk_bf16(o[1][0] * rn * bflo(g0.z), o[1][1] * rn * bfhi(g0.z)); w0.w = pk_bf16(o[1][2] * rn * bflo(g0.w), o[1][3] * rn * bfhi(g0.w));
          w1.x = pk_bf16(o[2][0] * rn * bflo(g1.x), o[2][1] * rn * bfhi(g1.x)); w1.y = pk_bf16(o[2][2] * rn * bflo(g1.y), o[2][3] * rn * bfhi(g1.y));
          w1.z = pk_bf16(o[3][0] * rn * bflo(g1.z), o[3][1] * rn * bfhi(g1.z)); w1.w = pk_bf16(o[3][2] * rn * bflo(g1.w), o[3][3] * rn * bfhi(g1.w));
          *(u32x4*)(yh + off) = w0; *(u32x4*)(yh + off + 8) = w1; }
    }
    __syncthreads();
}

DI unsigned f2ord(float f) { const unsigned b = __float_as_uint(f); return b ^ ((unsigned)((int)b >> 31) | 0x80000000u); }
DI float ord2f(unsigned k) { const unsigned b = (k & 0x80000000u) ? (k ^ 0x80000000u) : ~k; return __uint_as_float(b); }
DI void ce_desc(unsigned& a, unsigned& b) { const unsigned hi = a > b ? a : b, lo = a > b ? b : a; a = hi; b = lo; }
DI void sort16_desc(unsigned (&a)[16]) {
#pragma unroll
    for (int k = 2; k <= 16; k <<= 1)
#pragma unroll
        for (int j = k >> 1; j > 0; j >>= 1)
#pragma unroll
            for (int i = 0; i < 16; ++i) { const int l = i ^ j; if (l > i) { if ((i & k) == 0) ce_desc(a[i], a[l]); else ce_desc(a[l], a[i]); } }
}
DI void merge16_desc(unsigned (&a)[16], const unsigned (&b)[16]) {
#pragma unroll
    for (int i = 0; i < 16; ++i) a[i] = a[i] > b[15 - i] ? a[i] : b[15 - i];
#pragma unroll
    for (int j = 8; j > 0; j >>= 1)
#pragma unroll
        for (int i = 0; i < 16; ++i) { const int l = i ^ j; if (l > i) ce_desc(a[i], a[l]); }
}
#define TK_INS(L, x) do { unsigned t_ = (x); _Pragma("unroll") for (int j_ = 0; j_ < 16; ++j_) { const unsigned hi_ = L[j_] > t_ ? L[j_] : t_; t_ = L[j_] > t_ ? t_ : L[j_]; L[j_] = hi_; } } while (0)

DI void topk_stage_keys(const bf16_t* keysb, LAS unsigned char* kl, int h) {
    for (int c = threadIdx.x; c < 2 * 128 * 16; c += NTHR) { const int p = c >> 11, row = (c >> 4) & 127, ch = c & 15;
        *(LAS u32x4*)(kl + (p * 128 + row) * 272 + ch * 16) = *(const u32x4*)(keysb + ((size_t)(p * 8 + h) * 128 + row) * 128 + ch * 8); }
}
DI void topk_unit(const bf16_t* qp, const LAS unsigned char* kl, unsigned short* gidx, float* ggate, LAS unsigned* tk, int quad, int h) {
    const int tid = threadIdx.x, lane = tid & 63, wave = tid >> 6, p = wave & 1, tsub = wave >> 1, r = lane & 31, hh = lane >> 5;
#pragma unroll 1
    for (int hl = 0; hl < 4; ++hl) {
        const int tok0 = (quad * 4 + hl) * 128 + tsub * 32;
        f32x16 acc[4];
#pragma unroll
        for (int kb = 0; kb < 4; ++kb)
#pragma unroll
            for (int i = 0; i < 16; ++i) acc[kb][i] = 0.f;
        const bf16_t* qrow = qp + (size_t)(tok0 + r) * 2048 + h * 256 + p * 128 + 8 * hh;
        const LAS unsigned char* kbase = kl + (p * 128 + r) * 272 + 16 * hh;
#pragma unroll
        for (int s = 0; s < 8; ++s) { const bf16x8 bq = *(const bf16x8*)(qrow + 16 * s);
#pragma unroll
            for (int kb = 0; kb < 4; ++kb) { const bf16x8 ak = *(const LAS bf16x8*)(kbase + kb * 32 * 272 + 32 * s); acc[kb] = MFMA32(ak, bq, acc[kb]); } }
        unsigned A0[16], A1[16], A2[16], A3[16];
#pragma unroll
        for (int i = 0; i < 16; ++i) { const unsigned ki = (unsigned)(crow(i, hh));
            A0[i] = (f2ord(acc[0][i]) & ~127u) | ki; A1[i] = (f2ord(acc[1][i]) & ~127u) | (32u + ki); A2[i] = (f2ord(acc[2][i]) & ~127u) | (64u + ki); A3[i] = (f2ord(acc[3][i]) & ~127u) | (96u + ki); }
        sort16_desc(A0); sort16_desc(A1); sort16_desc(A2); sort16_desc(A3);
        merge16_desc(A0, A1); merge16_desc(A2, A3); merge16_desc(A0, A2);
#pragma unroll
        for (int j = 0; j < 16; ++j) A1[j] = __shfl_xor(A0[j], 32);
        merge16_desc(A0, A1);
        if (hh == 0) { LAS u32x4* dst = (LAS u32x4*)(tk + (((hl * 2 + p) * 128 + tsub * 32 + r) * 16));
#pragma unroll
            for (int c = 0; c < 4; ++c) { u32x4 w = {A0[4 * c], A0[4 * c + 1], A0[4 * c + 2], A0[4 * c + 3]}; dst[c] = w; } }
    }
    __syncthreads();
    {
        const int tok = tid & 127, hl = tid >> 7, tile = quad * 4 + hl;
        const LAS unsigned* t1 = tk + ((hl * 2 + 0) * 128 + tok) * 16; const LAS unsigned* t2 = tk + ((hl * 2 + 1) * 128 + tok) * 16;
        float v1[16], v2[16];
        { const LAS u32x4* s1 = (const LAS u32x4*)t1; const LAS u32x4* s2 = (const LAS u32x4*)t2;
#pragma unroll
          for (int c = 0; c < 4; ++c) { const u32x4 a = s1[c], b = s2[c];
              v1[4 * c] = ord2f(a.x & ~127u); v1[4 * c + 1] = ord2f(a.y & ~127u); v1[4 * c + 2] = ord2f(a.z & ~127u); v1[4 * c + 3] = ord2f(a.w & ~127u);
              v2[4 * c] = ord2f(b.x & ~127u); v2[4 * c + 1] = ord2f(b.y & ~127u); v2[4 * c + 2] = ord2f(b.z & ~127u); v2[4 * c + 3] = ord2f(b.w & ~127u); } }
#define CKEY(i, j) ((f2ord(v1[i] + v2[j]) & ~255u) | (unsigned)((i) * 16 + (j)))
        unsigned C[16], D[16], E[16];
#pragma unroll
        for (int j = 0; j < 16; ++j) C[j] = CKEY(0, j);
#pragma unroll
        for (int j = 0; j < 8; ++j) D[j] = CKEY(1, j);
#pragma unroll
        for (int j = 0; j < 5; ++j) D[8 + j] = CKEY(2, j);
#pragma unroll
        for (int j = 0; j < 3; ++j) D[13 + j] = CKEY(4, j);
#pragma unroll
        for (int j = 0; j < 4; ++j) E[j] = CKEY(3, j);
        E[4] = CKEY(5, 0); E[5] = CKEY(5, 1); E[6] = CKEY(6, 0); E[7] = CKEY(6, 1); E[8] = CKEY(7, 0); E[9] = CKEY(7, 1);
        E[10] = CKEY(8, 0); E[11] = CKEY(9, 0); E[12] = CKEY(10, 0); E[13] = CKEY(11, 0); E[14] = CKEY(12, 0); E[15] = CKEY(13, 0);
        sort16_desc(D); sort16_desc(E);
        TK_INS(E, CKEY(14, 0)); TK_INS(E, CKEY(15, 0));
#undef CKEY
        merge16_desc(C, D); merge16_desc(C, E);
        float sc[16]; unsigned ei[16]; float mx = -1e30f;
#pragma unroll
        for (int q = 0; q < 16; ++q) { const unsigned ij = C[q] & 255u; const unsigned a = t1[ij >> 4], b = t2[ij & 15u];
            sc[q] = ord2f(a & ~127u) + ord2f(b & ~127u); ei[q] = (a & 127u) * 128u + (b & 127u); mx = fmaxf(mx, sc[q]); }
        float sum = 0.f;
#pragma unroll
        for (int q = 0; q < 16; ++q) { sc[q] = __expf(sc[q] - mx); sum += sc[q]; }
        const float inv = 1.f / sum; const size_t o = (size_t)(tile * 128 + tok) * 128 + h * 16;
        u32x4 w0, w1;
        w0.x = ei[0] | (ei[1] << 16); w0.y = ei[2] | (ei[3] << 16); w0.z = ei[4] | (ei[5] << 16); w0.w = ei[6] | (ei[7] << 16);
        w1.x = ei[8] | (ei[9] << 16); w1.y = ei[10] | (ei[11] << 16); w1.z = ei[12] | (ei[13] << 16); w1.w = ei[14] | (ei[15] << 16);
        *(u32x4*)(gidx + o) = w0; *(u32x4*)(gidx + o + 8) = w1;
#pragma unroll
        for (int c = 0; c < 4; ++c) *(f32x4*)(ggate + o + 4 * c) = (f32x4){sc[4 * c] * inv, sc[4 * c + 1] * inv, sc[4 * c + 2] * inv, sc[4 * c + 3] * inv};
    }
    __syncthreads();
}

DI float gelu_erf(float x) { return 0.5f * x * (1.f + erff(x * 0.70710678118654752f)); }
DI int dot16(u32x4 w, const int (&h)[4]) { int c = __builtin_amdgcn_sdot4((int)w.x, h[0], 0, false); c = __builtin_amdgcn_sdot4((int)w.y, h[1], c, false); c = __builtin_amdgcn_sdot4((int)w.z, h[2], c, false); return __builtin_amdgcn_sdot4((int)w.w, h[3], c, false); }
#define V8_FMA(acc4, word, we) do { acc4[0] += (we) * (float)((word) & 255u); acc4[1] += (we) * (float)(((word) >> 8) & 255u); acc4[2] += (we) * (float)(((word) >> 16) & 255u); acc4[3] += (we) * (float)((word) >> 24); } while (0)

template <int IDMASK> DI void expert_token(const bf16_t* x2row, const float* ssq, const unsigned char* u8, const unsigned char* v8, const float* su, const float* sv, const unsigned short* gidx, const float* ggate, const float* gf, float* outrow, int lane) {
    f32x4 x[4]; float amax = 0.f;
#pragma unroll
    for (int i = 0; i < 4; ++i) { const u32x2 w_ = *(const u32x2*)(x2row + 16 * lane + 4 * i); x[i] = (f32x4){bflo(w_.x), bfhi(w_.x), bflo(w_.y), bfhi(w_.y)}; amax = fmaxf(fmaxf(amax, fmaxf(fabsf(x[i][0]), fabsf(x[i][1]))), fmaxf(fabsf(x[i][2]), fabsf(x[i][3]))); }
    float ss = (lane < 16) ? ssq[lane] : 0.f; ss = wave_sum(ss);
    const float rstd2 = __builtin_amdgcn_rsqf(ss * (1.f / 1024.f) + EPS);
#pragma unroll
    for (int o = 1; o < 64; o <<= 1) amax = fmaxf(amax, __shfl_xor(amax, o));
    amax *= rstd2;
    const float qs = amax > 0.f ? 127.f / amax : 0.f, sh = amax * (1.f / 127.f), xq = rstd2 * qs;
    int hq[4];
#pragma unroll
    for (int i = 0; i < 4; ++i) { const int q0 = (int)rintf(x[i][0] * xq), q1 = (int)rintf(x[i][1] * xq), q2 = (int)rintf(x[i][2] * xq), q3 = (int)rintf(x[i][3] * xq);
        hq[i] = (int)((unsigned)(q0 & 255) | ((unsigned)(q1 & 255) << 8) | ((unsigned)(q2 & 255) << 16) | ((unsigned)(q3 & 255) << 24)); }
    const int id0 = gidx[lane] & IDMASK, id1 = gidx[64 + lane] & IDMASK; const float g0 = ggate[lane], g1 = ggate[64 + lane];
    f32x4 o[4]; float wsum = 0.f;
#pragma unroll
    for (int i = 0; i < 4; ++i) o[i] = (f32x4){0.f, 0.f, 0.f, 0.f};
#pragma unroll 1
    for (int bt = 0; bt < 16; ++bt) {
        const int idsel = (bt < 8) ? id0 : id1; const float gsel = (bt < 8) ? g0 : g1; const int lb = (bt & 7) * 8;
        u32x4 ur[8], vr[8];
#pragma unroll
        for (int e = 0; e < 8; ++e) { const int idx = __builtin_amdgcn_readlane(idsel, lb + e); ur[e] = *(const u32x4*)(u8 + (size_t)idx * 1024 + 16 * lane); }
#pragma unroll
        for (int e = 0; e < 8; ++e) { const int idx = __builtin_amdgcn_readlane(idsel, lb + e); vr[e] = *(const u32x4*)(v8 + (size_t)idx * 1024 + 16 * lane); }
        const int myidx = __shfl(idsel, lb + (lane >> 3)); const float mysu = su[myidx], mysv = sv[myidx], gate = __shfl(gsel, lb + (lane >> 3));
        int pr[8];
#pragma unroll
        for (int e = 0; e < 8; ++e) pr[e] = dot16(ur[e], hq);
        int q4[4], q2[2], q1;
        { const bool up_ = (lane & 32) != 0;
#pragma unroll
          for (int i = 0; i < 4; ++i) { const int keep = up_ ? pr[i + 4] : pr[i], send = up_ ? pr[i] : pr[i + 4]; q4[i] = keep + __shfl_xor(send, 32); } }
        { const bool up_ = (lane & 16) != 0;
#pragma unroll
          for (int i = 0; i < 2; ++i) { const int keep = up_ ? q4[i + 2] : q4[i], send = up_ ? q4[i] : q4[i + 2]; q2[i] = keep + __shfl_xor(send, 16); } }
        { const bool up_ = (lane & 8) != 0; const int keep = up_ ? q2[1] : q2[0], send = up_ ? q2[0] : q2[1]; q1 = keep + __shfl_xor(send, 8); }
        q1 += __shfl_xor(q1, 4); q1 += __shfl_xor(q1, 2); q1 += __shfl_xor(q1, 1);
        const float act = (float)q1 * (mysu * sh);
        const float w = gelu_erf(act) * gate * mysv;
#pragma unroll
        for (int e = 0; e < 8; ++e) { const float we = __int_as_float(__builtin_amdgcn_readlane(__float_as_int(w), 8 * e)); wsum += we;
            V8_FMA(o[0], vr[e].x, we); V8_FMA(o[1], vr[e].y, we); V8_FMA(o[2], vr[e].z, we); V8_FMA(o[3], vr[e].w, we); }
    }
    const float corr = 128.f * wsum; float s3 = 0.f;
#pragma unroll
    for (int i = 0; i < 4; ++i) { x[i] += o[i] - corr; s3 += (x[i][0] * x[i][0] + x[i][1] * x[i][1]) + (x[i][2] * x[i][2] + x[i][3] * x[i][3]); }
    s3 = wave_sum(s3); const float r3 = __builtin_amdgcn_rsqf(s3 * (1.f / 1024.f) + EPS);
#pragma unroll
    for (int i = 0; i < 4; ++i) *(f32x4*)(outrow + 16 * lane + 4 * i) = x[i] * r3 * *(const f32x4*)(gf + 16 * lane + 4 * i);
}

DI void hq_token(const bf16_t* x2row, const float* ssq, unsigned char* hqrow, float* shp, int lane) {
    f32x4 x[4]; float amax = 0.f;
#pragma unroll
    for (int i = 0; i < 4; ++i) { const u32x2 w_ = *(const u32x2*)(x2row + 16 * lane + 4 * i); x[i] = (f32x4){bflo(w_.x), bfhi(w_.x), bflo(w_.y), bfhi(w_.y)}; amax = fmaxf(fmaxf(amax, fmaxf(fabsf(x[i][0]), fabsf(x[i][1]))), fmaxf(fabsf(x[i][2]), fabsf(x[i][3]))); }
    float ss = (lane < 16) ? ssq[lane] : 0.f; ss = wave_sum(ss);
    const float rstd2 = __builtin_amdgcn_rsqf(ss * (1.f / 1024.f) + EPS);
#pragma unroll
    for (int o = 1; o < 64; o <<= 1) amax = fmaxf(amax, __shfl_xor(amax, o));
    amax *= rstd2;
    const float qs = amax > 0.f ? 127.f / amax : 0.f, xq = rstd2 * qs;
    unsigned qb[16];
#pragma unroll
    for (int i = 0; i < 16; ++i) qb[i] = (unsigned)((int)rintf(x[i >> 2][i & 3] * xq) & 255);
    u32x4 w;
    w.x = qb[0] | (qb[2] << 8) | (qb[4] << 16) | (qb[6] << 24); w.y = qb[1] | (qb[3] << 8) | (qb[5] << 16) | (qb[7] << 24);
    w.z = qb[8] | (qb[10] << 8) | (qb[12] << 16) | (qb[14] << 24); w.w = qb[9] | (qb[11] << 8) | (qb[13] << 16) | (qb[15] << 24);
    *(u32x4*)(hqrow + 16 * lane) = w;
    if (lane == 0) *shp = amax * (1.f / 127.f);
}
template <int CTRL> DI int dpp_i(int v) { return __builtin_amdgcn_mov_dpp(v, CTRL, 0xf, 0xf, true); }
template <int CTRL> DI float dpp_f(float v) { return __int_as_float(__builtin_amdgcn_mov_dpp(__float_as_int(v), CTRL, 0xf, 0xf, true)); }
DI float swapadd32(float a, float b) { const auto r = __builtin_amdgcn_permlane32_swap(__float_as_uint(a), __float_as_uint(b), false, false); return __uint_as_float(r[0]) + __uint_as_float(r[1]); }
DI float swapadd16(float a, float b) { const auto r = __builtin_amdgcn_permlane16_swap(__float_as_uint(a), __float_as_uint(b), false, false); return __uint_as_float(r[0]) + __uint_as_float(r[1]); }

struct SMeta { u32x4 i0, i1, a0, a1; unsigned xw; };
template <int RS> DI void slice_issue(u32x4 (&r)[16], const SMeta& m, const unsigned char* base) {
    const unsigned iw[8] = {m.i0.x, m.i0.y, m.i0.z, m.i0.w, m.i1.x, m.i1.y, m.i1.z, m.i1.w};
#pragma unroll
    for (int j = 0; j < 16; ++j) { const unsigned idx = (j & 1) ? (iw[j >> 1] >> 16) : (iw[j >> 1] & 0xffffu); r[j] = *(const u32x4*)(base + (size_t)idx * RS); }
}
DI void slice_u_compute(const SMeta& m, const u32x4 (&r)[16], int* actp, int lane) {
    const int he[4] = {(int)m.a0.x, (int)m.a0.z, (int)m.a1.x, (int)m.a1.z}, ho[4] = {(int)m.a0.y, (int)m.a0.w, (int)m.a1.y, (int)m.a1.w};
    int hs = 0;
#pragma unroll
    for (int g = 0; g < 4; ++g) { hs = __builtin_amdgcn_sdot4(he[g], 0x01010101, hs, false); hs = __builtin_amdgcn_sdot4(ho[g], 0x01010101, hs, false); }
    hs *= 8;
    int part[16];
#pragma unroll
    for (int j = 0; j < 16; ++j) { int acc = -hs;
#pragma unroll
        for (int g = 0; g < 4; ++g) { const unsigned w = r[j][g]; acc = __builtin_amdgcn_sdot4((int)(w & 0x0F0F0F0Fu), he[g], acc, false); acc = __builtin_amdgcn_sdot4((int)((w >> 4) & 0x0F0F0F0Fu), ho[g], acc, false); }
        part[j] = acc; }
    int r8[8], r4[4], r2[2];
    { const bool up_ = (lane & 4) != 0;
#pragma unroll
      for (int i = 0; i < 8; ++i) { const int keep = up_ ? part[i + 8] : part[i], send = up_ ? part[i] : part[i + 8]; r8[i] = keep + dpp_i<0x141>(send); } }
    { const bool up_ = (lane & 2) != 0;
#pragma unroll
      for (int i = 0; i < 4; ++i) { const int keep = up_ ? r8[i + 4] : r8[i], send = up_ ? r8[i] : r8[i + 4]; r4[i] = keep + dpp_i<0x4E>(send); } }
    { const bool up_ = (lane & 1) != 0;
#pragma unroll
      for (int i = 0; i < 2; ++i) { const int keep = up_ ? r4[i + 2] : r4[i], send = up_ ? r4[i] : r4[i + 2]; r2[i] = keep + dpp_i<0xB1>(send); } }
    actp[lane] = (int)((unsigned)(((r2[0] + 4) >> 3) & 0xffff) | ((unsigned)((r2[1] + 4) >> 3) << 16));
}
DI int swapadd32i(int a, int b) { const auto r = __builtin_amdgcn_permlane32_swap((unsigned)a, (unsigned)b, false, false); return (int)r[0] + (int)r[1]; }
DI int swapadd16i(int a, int b) { const auto r = __builtin_amdgcn_permlane16_swap((unsigned)a, (unsigned)b, false, false); return (int)r[0] + (int)r[1]; }
DI void slice_v_compute(const SMeta& m, const u32x4 (&r)[16], float* x3row, float* ssq3p, int sl, int lane) {
    const int wq[4] = {(int)m.a0.x, (int)m.a0.y, (int)m.a0.z, (int)m.a0.w};
    const float sw = __uint_as_float(m.a1.x);
    int o[32];
#pragma unroll
    for (int i = 0; i < 32; ++i) o[i] = 0;
#pragma unroll
    for (int q = 0; q < 4; ++q)
#pragma unroll
        for (int p = 0; p < 4; ++p) {
            const unsigned w0 = r[4 * q][p], w1 = r[4 * q + 1][p], w2 = r[4 * q + 2][p], w3 = r[4 * q + 3][p];
#pragma unroll
            for (int par = 0; par < 2; ++par) {
                const unsigned d0 = (par ? (w0 >> 4) : w0) & 0x0F0F0F0Fu, d1 = (par ? (w1 >> 4) : w1) & 0x0F0F0F0Fu, d2 = (par ? (w2 >> 4) : w2) & 0x0F0F0F0Fu, d3 = (par ? (w3 >> 4) : w3) & 0x0F0F0F0Fu;
                const unsigned t0 = __builtin_amdgcn_perm(d1, d0, 0x05010400u), t1 = __builtin_amdgcn_perm(d1, d0, 0x07030602u), t2 = __builtin_amdgcn_perm(d3, d2, 0x05010400u), t3 = __builtin_amdgcn_perm(d3, d2, 0x07030602u);
                const unsigned e0 = __builtin_amdgcn_perm(t2, t0, 0x05040100u), e1 = __builtin_amdgcn_perm(t2, t0, 0x07060302u), e2 = __builtin_amdgcn_perm(t3, t1, 0x05040100u), e3 = __builtin_amdgcn_perm(t3, t1, 0x07060302u);
                o[8 * p + par] = __builtin_amdgcn_sdot4((int)e0, wq[q], o[8 * p + par], false); o[8 * p + 2 + par] = __builtin_amdgcn_sdot4((int)e1, wq[q], o[8 * p + 2 + par], false);
                o[8 * p + 4 + par] = __builtin_amdgcn_sdot4((int)e2, wq[q], o[8 * p + 4 + par], false); o[8 * p + 6 + par] = __builtin_amdgcn_sdot4((int)e3, wq[q], o[8 * p + 6 + par], false);
            }
        }
    int wt = 0;
#pragma unroll
    for (int q = 0; q < 4; ++q) wt = __builtin_amdgcn_sdot4(wq[q], 0x01010101, wt, false);
    wt += dpp_i<0x128>(wt); wt = swapadd16i(wt, wt); wt = swapadd32i(wt, wt); wt *= 8;
    int a16[16], a8[8], a4[4];
#pragma unroll
    for (int i = 0; i < 16; ++i) a16[i] = swapadd32i(o[i], o[16 + i]);
#pragma unroll
    for (int i = 0; i < 8; ++i) a8[i] = swapadd16i(a16[i], a16[i + 8]);
    { const bool up_ = (lane & 8) != 0;
#pragma unroll
      for (int i = 0; i < 4; ++i) { const int keep = up_ ? a8[i + 4] : a8[i], send = up_ ? a8[i] : a8[i + 4]; a4[i] = keep + dpp_i<0x128>(send); } }
    const int col = 32 * (lane & 7) + ((lane >> 5) & 1) * 16 + ((lane >> 4) & 1) * 8 + ((lane >> 3) & 1) * 4;
    const f32x4 y = {bflo(m.xw) + (float)(a4[0] - wt) * sw, bfhi(m.xw) + (float)(a4[1] - wt) * sw, bflo(m.a1.y) + (float)(a4[2] - wt) * sw, bfhi(m.a1.y) + (float)(a4[3] - wt) * sw};
    *(f32x4*)(x3row + 256 * sl + col) = y;
    const float ss = wave_sum((y[0] * y[0] + y[1] * y[1]) + (y[2] * y[2] + y[3] * y[3]));
    if (lane == 0) ssq3p[sl] = ss;
}
template <int MODE> DI void slice_pass(unsigned char* ws, float* out, int xs, int gw_, int nw_, int lane) {
    const int g = lane >> 3, c = lane & 7;
    const int sl = xs >> 1, tmul = 2, tadd = xs & 1, TT = T / tmul;
    const unsigned short* gidx = (const unsigned short*)(ws + WS_GIDX) + 16 * g;
    const unsigned char* tab = (MODE == 0 ? (const unsigned char*)(ws + WS_U8) : (const unsigned char*)(ws + WS_V8)) + 128 * sl + 16 * c;
    const unsigned char* hqb = (const unsigned char*)(ws + WS_HQ) + 256 * sl + 32 * c;
    const unsigned char* wxb = (const unsigned char*)(ws + WS_WX) + 16 * g;
    const bf16_t* x2b = (const bf16_t*)(ws + WS_X2B) + 256 * sl + 32 * c + ((lane >> 5) & 1) * 16 + ((lane >> 4) & 1) * 8 + ((lane >> 3) & 1) * 4;
#define S_LOAD(m, tok) do { const unsigned short* ip = gidx + (size_t)(tok) * 128; (m).i0 = *(const u32x4*)ip; (m).i1 = *(const u32x4*)(ip + 8); \
        if (MODE == 0) { const unsigned char* hp_ = hqb + (size_t)(tok) * 1024; (m).a0 = *(const u32x4*)hp_; (m).a1 = *(const u32x4*)(hp_ + 16); } \
        else { (m).a0 = *(const u32x4*)(wxb + (size_t)(tok) * 128); (m).a1.x = __float_as_uint(((const float*)(ws + WS_SW))[tok]); { const u32x2 x_ = *(const u32x2*)(x2b + (size_t)(tok) * DM); (m).xw = x_.x; (m).a1.y = x_.y; } } } while (0)
#define S_COMPUTE(m, r, tok) do { if (MODE == 0) slice_u_compute(m, r, (int*)(ws + WS_ACTP) + ((size_t)(tok) * 4 + sl) * 64, lane); \
        else slice_v_compute(m, r, out + (size_t)(tok) * DM, (float*)(ws + WS_SSQ3) + (size_t)(tok) * 4, sl, lane); } while (0)
#define S_ISSUE(r, m) slice_issue<512>(r, m, tab)
    SMeta mA, mB, mN; u32x4 rA[16], rB[16];
    if (gw_ >= TT) return;
    const int n = (TT - gw_ + nw_ - 1) / nw_;
#define S_TK(j) ((gw_ + ((j) < n ? (j) : n - 1) * nw_) * tmul + tadd)
    S_LOAD(mA, S_TK(0)); S_ISSUE(rA, mA); S_LOAD(mB, S_TK(1));
    for (int i = 0; i < n; i += 2) {
        S_ISSUE(rB, mB);
        S_LOAD(mN, S_TK(i + 2));
        S_COMPUTE(mA, rA, S_TK(i));
        mA = mN; S_ISSUE(rA, mA);
        S_LOAD(mN, S_TK(i + 3));
        if (i + 1 < n) S_COMPUTE(mB, rB, S_TK(i + 1));
        mB = mN;
    }
#undef S_TK
#undef S_LOAD
#undef S_COMPUTE
#undef S_ISSUE
}
DI void expert_w_token(const int* actp, const unsigned short* gidx, const float* ggate, float sh, const float* su, const float* sv, unsigned char* wrow, float* swp, int lane) {
    typedef int i32x2 __attribute__((ext_vector_type(2)));
    i32x2 acc = {0, 0};
#pragma unroll
    for (int x = 0; x < 4; ++x) { const int w_ = actp[x * 64 + lane]; acc[0] += (int)(short)(w_ & 0xffff); acc[1] += w_ >> 16; }
    acc[0] <<= 3; acc[1] <<= 3;
    const unsigned ii = *(const unsigned*)(gidx + 2 * lane); const f32x2 gt = *(const f32x2*)(ggate + 2 * lane);
    const int e0 = ii & 0xffffu, e1 = ii >> 16;
    const float w0 = gelu_erf((float)acc[0] * (su[e0] * sh)) * gt[0] * sv[e0], w1 = gelu_erf((float)acc[1] * (su[e1] * sh)) * gt[1] * sv[e1];
    float amax = fmaxf(fabsf(w0), fabsf(w1));
    amax = fmaxf(amax, dpp_f<0xB1>(amax)); amax = fmaxf(amax, dpp_f<0x4E>(amax)); amax = fmaxf(amax, dpp_f<0x141>(amax)); amax = fmaxf(amax, dpp_f<0x128>(amax));
    { const auto r = __builtin_amdgcn_permlane16_swap(__float_as_uint(amax), __float_as_uint(amax), false, false); amax = fmaxf(__uint_as_float(r[0]), __uint_as_float(r[1])); }
    { const auto r = __builtin_amdgcn_permlane32_swap(__float_as_uint(amax), __float_as_uint(amax), false, false); amax = fmaxf(__uint_as_float(r[0]), __uint_as_float(r[1])); }
    const float qs = amax > 0.f ? 127.f / amax : 0.f;
    const int q0 = (int)rintf(w0 * qs), q1 = (int)rintf(w1 * qs);
    *(unsigned short*)(wrow + 2 * lane) = (unsigned short)((q0 & 255) | ((q1 & 255) << 8));
    if (lane == 0) *swp = amax * (1.f / 127.f);
}
DI void final_norm_token(float* row, const float* ssq3p, const float* gf, int lane) {
    float ss = (lane < 4) ? ssq3p[lane] : 0.f; ss = wave_sum(ss);
    const float r3 = __builtin_amdgcn_rsqf(ss * (1.f / 1024.f) + EPS);
#pragma unroll
    for (int i = 0; i < 4; ++i) { f32x4* p = (f32x4*)(row + 256 * i + 4 * lane); *p = *p * r3 * *(const f32x4*)(gf + 256 * i + 4 * lane); }
}

#define XB_TMO      128
#define XB_XCNT(j)  (256  + 64 * (j))
#define XB_XSUB(j)  (1280 + 64 * (j))
#define XB_XGEN(j)  (2304 + 64 * (j))
#define XB_TOP      3328
#define XB_TOPGEN   3392
#define XCD_BAR_WORDS 3456
#define XB_SPIN_CAP (1u << 18)

__device__ __forceinline__ unsigned xb_ld(unsigned* p)              { return __hip_atomic_load(p, __ATOMIC_RELAXED, __HIP_MEMORY_SCOPE_AGENT); }
__device__ __forceinline__ unsigned xb_add(unsigned* p, unsigned v) { return __hip_atomic_fetch_add(p, v, __ATOMIC_RELAXED, __HIP_MEMORY_SCOPE_AGENT); }
__device__ __forceinline__ unsigned xb_xcc_id() { return (unsigned)__builtin_amdgcn_s_getreg((3 << 11) | 20) & 0xFu; }
#define XB_SPIN(cond, bar) do { unsigned _sp = 0; while (cond) { __builtin_amdgcn_s_sleep(1); \
    if ((++_sp & 255u) == 0u) { if (xb_ld(&(bar)[XB_TMO])) break; if (_sp > XB_SPIN_CAP) { atomicAdd(&(bar)[XB_TMO], 1u); break; } } } } while (0)

struct XcdBarrier {
    unsigned* bar; unsigned x;
    volatile __attribute__((address_space(3))) unsigned* st;
};

__device__ __forceinline__ XcdBarrier xcd_barrier_post(unsigned* bar, volatile __attribute__((address_space(3))) unsigned* st) {
    XcdBarrier b; b.bar = bar; b.x = xb_xcc_id(); b.st = st;
    if (threadIdx.x == 0) st[2] = xb_add(&bar[XB_XCNT(b.x)], 1u);
    return b;
}
__device__ __forceinline__ void xcd_barrier_complete(unsigned* bar, unsigned x, unsigned& nloc, unsigned& nx) {
    const unsigned G = gridDim.x * gridDim.y * gridDim.z;
    unsigned sum, cnt, mine, sp = 0u;
    for (;;) {
        sum = 0u; cnt = 0u; mine = 0u;
#pragma unroll
        for (unsigned j = 0; j < 16; ++j) { const unsigned c = xb_ld(&bar[XB_XCNT(j)]); sum += c; cnt += (c > 0u) ? 1u : 0u; mine = (j == x) ? c : mine; }
        if (sum == G) break;
        __builtin_amdgcn_s_sleep(1);
        if ((++sp & 255u) == 0u) { if (xb_ld(&bar[XB_TMO])) break; if (sp > XB_SPIN_CAP) { atomicAdd(&bar[XB_TMO], 1u); break; } }
    }
    nloc = mine > 0u ? mine : 1u; nx = cnt > 0u ? cnt : 1u;
}

__device__ __forceinline__ void xcd_barrier(const XcdBarrier& b) {
    asm volatile("s_waitcnt vmcnt(0)" ::: "memory");
    __syncthreads();
    if (threadIdx.x == 0) {
        unsigned* bar = b.bar;
        __builtin_amdgcn_s_waitcnt(0);
        unsigned nloc = b.st[0], nx = b.st[1];
        if (nloc == 0u) { xcd_barrier_complete(bar, b.x, nloc, nx); b.st[0] = nloc; b.st[1] = nx; }
        const unsigned old = xb_add(&bar[XB_XSUB(b.x)], 1u);
        const unsigned gen = old / nloc;
        if (old + 1u == (gen + 1u) * nloc) {
            __builtin_amdgcn_fence(__ATOMIC_RELEASE, "agent");
            asm volatile("s_waitcnt vmcnt(0)" ::: "memory");
            const unsigned og = xb_add(&bar[XB_TOP], 1u);
            const unsigned tg = og / nx;
            if (og + 1u == (tg + 1u) * nx) xb_add(&bar[XB_TOPGEN], 1u);
            else XB_SPIN(xb_ld(&bar[XB_TOPGEN]) == tg, bar);
            __builtin_amdgcn_fence(__ATOMIC_ACQUIRE, "agent");
            xb_add(&bar[XB_XGEN(b.x)], 1u);
            asm volatile("s_waitcnt vmcnt(0)" ::: "memory");
        } else {
            XB_SPIN(xb_ld(&bar[XB_XGEN(b.x)]) == gen, bar);
            __builtin_amdgcn_fence(__ATOMIC_ACQUIRE, "agent");
            asm volatile("s_waitcnt vmcnt(0)" ::: "memory");
        }
    }
    __syncthreads();
}

constexpr int N_PHASES = 13;
__global__ void __launch_bounds__(NTHR, 2) mk_fwd(Args a) {
    extern __shared__ __attribute__((aligned(16))) unsigned char lds_raw[];
    LAS unsigned char* lds = (LAS unsigned char*)lds_raw;
    cg::grid_group grid = cg::this_grid();
    const int G = gridDim.x, vb = blockIdx.x, tid = threadIdx.x, lane = tid & 63, wave = tid >> 6;
    unsigned char* ws = a.ws;
    const int lo = a.ph_lo, hi = a.ph_hi;
    volatile LAS unsigned* MISC = (volatile LAS unsigned*)(lds + LDS_BYTES - 64);
    if (tid < 16) MISC[tid] = 0u;
    __syncthreads();
    const XcdBarrier bar = xcd_barrier_post((unsigned*)(ws + 4096) + lo * XCD_BAR_WORDS, MISC);
#ifndef PHASE_MASK
#define PHASE_MASK 0xFFFF
#endif
#define IN(k) (((PHASE_MASK >> (k)) & 1) && lo <= (k) && (k) < hi)
#ifndef REPEAT_MASK
#define REPEAT_MASK 0
#endif
#define REP(k) for (int rep_ = 0; rep_ < (((REPEAT_MASK) >> (k)) & 1) + 1; ++rep_)
#define SEAM(k) do { if (IN(k) && IN((k) + 1)) { if ((k) == 0) grid.sync(); else xcd_barrier(bar); } } while (0)
    REP(0) if (IN(0)) p0_prologue(a, lds, vb, G);
    SEAM(0);
    REP(1) if (IN(1)) { pg8::Gemm g{(const bf16_t*)(ws + WS_XB), (const bf16_t*)(ws + WS_W1T), T, NIN, 1024}; pg8::StaticOrder S; S.init(T, NIN, G, vb);
        pg8::Epi1 E{(const float*)(ws + WS_RSTD1), (bf16_t*)(ws + WS_PA), (bf16_t*)(ws + WS_GG), (bf16_t*)(ws + WS_QD), (bf16_t*)(ws + WS_KINV), (bf16_t*)(ws + WS_KENDT), (bf16_t*)(ws + WS_VT), (bf16_t*)(ws + WS_GS),
                    (float*)(ws + WS_DEC), (const float*)(ws + WS_LB), (bf16_t*)(ws + WS_AVT), lds + 131072};
        pg8::gemm_phase<pg8::Epi1, pg8::StaticOrder, true, true>(lds, g, S, E); }
#ifdef PROBE_GEMM1_PLAIN
    if (IN(1)) { pg8::Gemm g{(const bf16_t*)(ws + WS_XB), (const bf16_t*)(ws + WS_W1T), T, NIN, 1024}; pg8::StaticOrder S; S.init(T, NIN, G, vb);
        pg8::EpiDummy E{(bf16_t*)(ws + WS_YA), (const float*)(ws + WS_RSTD1)};
        pg8::gemm_phase<pg8::EpiDummy, pg8::StaticOrder, true, true>(lds, g, S, E); }
#endif
    SEAM(1);
    REP(2) if (IN(2)) {
        for (int u0 = vb * 8; u0 < 64 * 64; u0 += G * 8) {
            { int t2_ = threadIdx.x; asm volatile("" : "+v"(t2_)); const int u = u0 + (t2_ >> 6);
              hgrn_prep_unit((bf16_t*)(ws + WS_QD), (bf16_t*)(ws + WS_KINV), lds + (t2_ >> 6) * 18432, (float*)(ws + WS_DEC), (const float*)(ws + WS_LB), u >> 6, u & 63, (t2_ & 63) * 2); }
            __syncthreads();
            for (int j = 0; j < 8; ++j) hgrn_ds_unit(lds + j * 18432, (const bf16_t*)(ws + WS_VT), (bf16_t*)(ws + WS_XB), (u0 + j) >> 6, (u0 + j) & 63);
            __syncthreads();
        }
        for (int u = vb; u < BATCH * (SEQ / 64); u += G) attn_unit((const bf16_t*)(ws + WS_PA), (const bf16_t*)(ws + WS_AVT), a.in[3], (bf16_t*)(ws + WS_YA), lds, u >> 6, u & 63);
    }
    SEAM(2);
    REP(3) if (IN(3)) hgrn_scan((bf16_t*)(ws + WS_XB), (const float*)(ws + WS_DEC), vb, G);
    SEAM(3);
    REP(4) if (IN(4)) hgrn_out_phase((const bf16_t*)(ws + WS_QD), (const bf16_t*)(ws + WS_KINV), (const bf16_t*)(ws + WS_VT), (const bf16_t*)(ws + WS_XB), (const bf16_t*)(ws + WS_GS), (bf16_t*)(ws + WS_YH), lds, vb, G);
    SEAM(4);
    REP(5) if (IN(5)) {
        { pg8::Gemm g{(const bf16_t*)(ws + WS_YA), (const bf16_t*)(ws + WS_WAPT), T, 1024, 512}; pg8::StaticOrder S; S.init(T, 1024, G, vb);
          pg8::EpiMerge<false> E{(bf16_t*)(ws + WS_XB), (const bf16_t*)(ws + WS_GG)};
          pg8::gemm_phase<pg8::EpiMerge<false>, pg8::StaticOrder, true, true>(lds, g, S, E); }
        __syncthreads();
        { pg8::Gemm g{(const bf16_t*)(ws + WS_YH), (const bf16_t*)(ws + WS_WHPT), T, 1024, 512}; pg8::StaticOrder S; S.init(T, 1024, G, vb);
          pg8::EpiMerge<true> E{(bf16_t*)(ws + WS_XB), (const bf16_t*)(ws + WS_GG) + 1024};
          pg8::gemm_phase<pg8::EpiMerge<true>, pg8::StaticOrder, true, true>(lds, g, S, E); }
    }
    SEAM(5);
    REP(6) if (IN(6)) { pg8::Gemm g{(const bf16_t*)(ws + WS_XB), (const bf16_t*)(ws + WS_WOUTT), T, 1024, 1024}; pg8::StaticOrder S; S.init(T, 1024, G, vb);
        pg8::EpiX2 E{a.in[0], (bf16_t*)(ws + WS_X2B), (float*)(ws + WS_SSQ2)};
        pg8::gemm_phase<pg8::EpiX2, pg8::StaticOrder, true, true>(lds, g, S, E); }
    SEAM(6);
    REP(7) if (IN(7)) { pg8::Gemm g{(const bf16_t*)(ws + WS_X2B), (const bf16_t*)(ws + WS_WQT), T, 2048, 1024}; pg8::StaticOrder S; S.init(T, 2048, G, vb);
        pg8::EpiQp E{(bf16_t*)(ws + WS_QP), (const float*)(ws + WS_SSQ2)};
        pg8::gemm_phase<pg8::EpiQp, pg8::StaticOrder, true, true>(lds, g, S, E); }
    SEAM(7);
    REP(8) if (IN(8)) { const int per = (1024 + G - 1) / G; int hcur = -1;
        for (int U = vb * per; U < (vb + 1) * per && U < 1024; ++U) { const int h = U >> 7;
            if (h != hcur) { topk_stage_keys((const bf16_t*)(ws + WS_KEYS), lds + 65536, h); hcur = h; __syncthreads(); }
            topk_unit((const bf16_t*)(ws + WS_QP), lds + 65536, (unsigned short*)(ws + WS_GIDX), (float*)(ws + WS_GGATE), (LAS unsigned*)lds, U & 127, h); }
        for (int tok = vb * 8 + wave; tok < T; tok += G * 8) hq_token((const bf16_t*)(ws + WS_X2B) + (size_t)tok * DM, (const float*)(ws + WS_SSQ2) + (size_t)tok * 16, (unsigned char*)(ws + WS_HQ) + (size_t)tok * 1024, (float*)(ws + WS_SH) + tok, lane); }
    SEAM(8);
    if (IN(9) || IN(11)) {
        if (tid == 0) {
            unsigned nloc_ = 0, nx_ = 0; xcd_barrier_complete(bar.bar, bar.x, nloc_, nx_);
            unsigned cj[8], tot = 0; bool all = true;
#pragma unroll
            for (int j = 0; j < 8; ++j) { cj[j] = xb_ld(&bar.bar[XB_XCNT(j)]); tot += cj[j]; all = all && cj[j] > 0u; }
            if (all && tot == (unsigned)G && bar.x < 8u) { MISC[4] = bar.x; MISC[5] = MISC[2]; MISC[6] = cj[bar.x & 7u]; }
            else { const unsigned sl_ = (unsigned)vb & 7u; MISC[4] = sl_; MISC[5] = (unsigned)vb >> 3; MISC[6] = ((unsigned)G - sl_ + 7u) >> 3; }
        }
        __syncthreads();
    }
    REP(9) if (IN(9)) slice_pass<0>(ws, a.out, (int)MISC[4], (int)MISC[5] * 8 + __builtin_amdgcn_readfirstlane(wave), (int)MISC[6] * 8, lane);
    SEAM(9);
    REP(10) if (IN(10)) for (int tok = vb * 8 + wave; tok < T; tok += G * 8)
        expert_w_token((const int*)(ws + WS_ACTP) + (size_t)tok * 256, (const unsigned short*)(ws + WS_GIDX) + (size_t)tok * 128, (const float*)(ws + WS_GGATE) + (size_t)tok * 128, ((const float*)(ws + WS_SH))[tok],
                       (const float*)(ws + WS_SU), (const float*)(ws + WS_SV), (unsigned char*)(ws + WS_WX) + (size_t)tok * 128, (float*)(ws + WS_SW) + tok, lane);
    SEAM(10);
    REP(11) if (IN(11)) slice_pass<1>(ws, a.out, (int)MISC[4], (int)MISC[5] * 8 + __builtin_amdgcn_readfirstlane(wave), (int)MISC[6] * 8, lane);
    SEAM(11);
    REP(12) if (IN(12)) for (int tok = vb * 8 + wave; tok < T; tok += G * 8) final_norm_token(a.out + (size_t)tok * DM, (const float*)(ws + WS_SSQ3) + (size_t)tok * 4, a.in[14], lane);
#undef IN
#undef SEAM
}

extern "C" void kernel_launch(void* const* d_in, const int* in_sizes, int n_in, void* d_out, int out_size, void* d_ws, size_t ws_size, hipStream_t stream) {
    static int grid = 0;
    if (grid == 0) {
        if (n_in != 15 || in_sizes[0] != T * DM || out_size != T * DM || ws_size < WS_END) { fprintf(stderr, "kernel_launch: unexpected shapes (n_in %d, in0 %d, out %d, ws %zu)\n", n_in, n_in > 0 ? in_sizes[0] : -1, out_size, ws_size); grid = -1; return; }
        int dev = 0, cus = 0, per_cu = 0;
        hipGetDevice(&dev); hipDeviceGetAttribute(&cus, hipDeviceAttributeMultiprocessorCount, dev);
        if (hipFuncSetAttribute((const void*)mk_fwd, hipFuncAttributeMaxDynamicSharedMemorySize, LDS_BYTES) != hipSuccess) { fprintf(stderr, "kernel_launch: hipFuncSetAttribute failed\n"); grid = -1; return; }
        if (hipOccupancyMaxActiveBlocksPerMultiprocessor(&per_cu, (const void*)mk_fwd, NTHR, LDS_BYTES) != hipSuccess || per_cu < 1) { fprintf(stderr, "kernel_launch: occupancy query says %d blocks per CU\n", per_cu); per_cu = 1; }
        (void)hipGetLastError();
        grid = cus;
    }
    if (grid < 0) return;
    if (hipMemsetAsync(d_ws, 0, 256 * 1024, stream) != hipSuccess) { fprintf(stderr, "kernel_launch: hipMemsetAsync failed\n"); return; }
    Args a{};
    for (int i = 0; i < 15; ++i) a.in[i] = (const float*)d_in[i];
    a.out = (float*)d_out; a.ws = (unsigned char*)d_ws;
#if MK_FUSED
    a.ph_lo = 0; a.ph_hi = N_PHASES;
    { void* args[] = {&a}; hipError_t e = hipLaunchCooperativeKernel((const void*)mk_fwd, dim3(grid), dim3(NTHR), args, LDS_BYTES, stream);
      if (e != hipSuccess) fprintf(stderr, "kernel_launch: cooperative launch failed: %s (grid %d)\n", hipGetErrorString(e), grid); }
#else
    for (int p = 0; p < N_PHASES; ++p) { a.ph_lo = p; a.ph_hi = p + 1; void* args[] = {&a};
        hipError_t e = hipLaunchCooperativeKernel((const void*)mk_fwd, dim3(grid), dim3(NTHR), args, LDS_BYTES, stream);
        if (e != hipSuccess) { fprintf(stderr, "kernel_launch: launch of phase %d failed: %s (grid %d)\n", p, hipGetErrorString(e), grid); break; } }
#endif
}
```

```cpp
#include <hip/hip_runtime.h>
#include <hip/hip_cooperative_groups.h>
#include <cstdio>
#include <cstdint>
namespace cg = cooperative_groups;
#define V_MPRIO 1
namespace pg8 {
#define PG8_LAS __attribute__((address_space(3)))
typedef unsigned short bf16_t;
typedef short bf16x8 __attribute__((ext_vector_type(8)));
typedef float f32x4 __attribute__((ext_vector_type(4)));
typedef unsigned u32x4 __attribute__((ext_vector_type(4)));
constexpr int BM = 256, BK = 64, HALF = 128, HTB = HALF * BK * 2  , STAGE_BYTES = 8 * HTB, NXCD = 8, WGM = 8;

__host__ __device__ __forceinline__ int lds_byte(int r, int c) { const int st = (r >> 4) * 2 + (c >> 5), rr = r & 15, cc = c & 31, ob = rr * 64 + cc * 2; return st * 1024 + (ob ^ (((ob >> 9) & 1) << 5)); }
__host__ __device__ __forceinline__ void stage_rc(int b, int& R, int& C) { const int st = b / 1024, sb = b % 1024, swz = sb ^ (((sb >> 9) & 1) << 5); R = (st >> 1) * 16 + swz / 64; C = (st & 1) * 32 + (swz % 64) / 2; }
__host__ __device__ __forceinline__ int perm32(int rho) { const int n = rho >> 4, i = rho & 15; return 8 * (i >> 2) + 4 * n + (i & 3); }

struct Unit { int pm, pn; };
struct Gemm { const bf16_t* A; const bf16_t* Bt; int M, N, K; };

struct StaticOrder {
    int nM, nN, nwg, G, c;
    __host__ __device__ void init(int M, int N, int G_, int c_) { nM = M / BM; nN = N / BM; nwg = nM * nN; G = G_; c = c_; }
    __host__ __device__ bool next(int i, Unit& u) const {
        const long L = (long)i * G + c; if (L >= nwg) return false;
        int wgid = (int)L; { const int q = nwg / NXCD, r = nwg % NXCD, xcd = wgid % NXCD, off = wgid / NXCD; wgid = (xcd < r ? xcd * (q + 1) : r * (q + 1) + (xcd - r) * q) + off; }
        const int nig = WGM * nN, gid = wgid / nig, fm = gid * WGM, gsz = (nM - fm) < WGM ? (nM - fm) : WGM;
        u.pm = fm + ((wgid % nig) % gsz); u.pn = (wgid % nig) / gsz; return true;
    }
    __device__ __forceinline__ void a_ready(const Unit&) const {}
    __device__ __forceinline__ void done(const Unit&) const {}
};

__device__ __forceinline__ unsigned cvt_pk_bf16(float lo, float hi) { unsigned r; asm volatile("v_cvt_pk_bf16_f32 %0, %1, %2" : "=v"(r) : "v"(lo), "v"(hi)); return r; }

template <class Epi, class Sched, bool ALIGN_EPI = false, bool SP2 = false>
__device__ __forceinline__ void gemm_phase(PG8_LAS unsigned char* lds, const Gemm g, const Sched& S, const Epi& E) {
    int tid_ = threadIdx.x; asm volatile("" : "+v"(tid_));
    const int tid = tid_, wid = __builtin_amdgcn_readfirstlane(tid >> 6), lane = tid & 63, wr = wid >> 2, wc = wid & 3, fr = lane & 15, fq = lane >> 4;
    const int K = g.K, nt = K / BK;
    unsigned voffA[2], voffB[2];
#pragma unroll
    for (int i = 0; i < 2; ++i) { int R, C; stage_rc(tid * 16 + i * 8192, R, C); const int Rb = Epi::PERM ? ((R & ~31) + perm32(R & 31)) : R;
        voffA[i] = (unsigned)(R * K + C) * 2u; voffB[i] = (unsigned)(Rb * K + C) * 2u; }
    const size_t kstep = (size_t)(BK * 2);
    const size_t hstep = (size_t)HALF * K * 2;
    const size_t tstep = 2 * hstep;
    const unsigned ldsw = (unsigned)wid * 1024u;
    const int aoff = lds_byte(wr * 64 + fr, fq * 8), boff = lds_byte(wc * 32 + fr, fq * 8);
#define PG8_SA(b, h) (((b) * 2 + (h)) * HTB)
#define PG8_SB(b, h) ((4 + (b) * 2 + (h)) * HTB)
#define PG8_STAGE(bufoff, gbase, voff) do { _Pragma("unroll") for (int _i = 0; _i < 2; ++_i) \
        __builtin_amdgcn_global_load_lds((const unsigned*)((const char*)(gbase) + (voff)[_i]), (PG8_LAS unsigned*)(lds + (bufoff) + ldsw + _i * 8192), 16, 0, 0); } while (0)
#define PG8_LDA(dst, b, h) do { _Pragma("unroll") for (int m = 0; m < 4; ++m) _Pragma("unroll") for (int k = 0; k < 2; ++k) dst[m][k] = *(const PG8_LAS bf16x8*)(lds + PG8_SA(b, h) + aoff + m * 2048 + k * 1024); } while (0)
#define PG8_LDB(dst, b, h) do { _Pragma("unroll") for (int n = 0; n < 2; ++n) _Pragma("unroll") for (int k = 0; k < 2; ++k) dst[n][k] = *(const PG8_LAS bf16x8*)(lds + PG8_SB(b, h) + boff + n * 2048 + k * 1024); } while (0)
#define PG8_MMA(ai, bj, At, Bt) do { __builtin_amdgcn_s_setprio(1); _Pragma("unroll") for (int m = 0; m < 4; ++m) _Pragma("unroll") for (int n = 0; n < 2; ++n) _Pragma("unroll") for (int k = 0; k < 2; ++k) \
        acc[ai][bj][m][n] = __builtin_amdgcn_mfma_f32_16x16x32_bf16(Bt[n][k], At[m][k], acc[ai][bj][m][n], 0, 0, 0); __builtin_amdgcn_s_setprio(0); } while (0)
#define PG8_WAIT_V(n) asm volatile("s_waitcnt vmcnt(" #n ")" ::: "memory")
#define PG8_WAIT_L(n) asm volatile("s_waitcnt lgkmcnt(" #n ")" ::: "memory")
#define PG8_BAR __builtin_amdgcn_s_barrier()
#define PG8_SCHED __builtin_amdgcn_sched_barrier(0)
    Unit cur, nxt; int ui = 0;
    if (!S.next(0, cur)) return;
    f32x4 acc[2][2][4][2];
#pragma unroll
    for (int a = 0; a < 2; ++a)
#pragma unroll
        for (int b = 0; b < 2; ++b)
#pragma unroll
            for (int m = 0; m < 4; ++m)
#pragma unroll
                for (int n = 0; n < 2; ++n) acc[a][b][m][n] = (f32x4){0.f, 0.f, 0.f, 0.f};
    bf16x8 At[4][2], B0[2][2], B1[2][2];
    const char* cA = (const char*)g.A + (size_t)cur.pm * tstep; const char* cB = (const char*)g.Bt + (size_t)cur.pn * tstep;
    S.a_ready(cur);
    if constexpr (SP2) {
        PG8_STAGE(PG8_SB(0, 0), cB, voffB); PG8_STAGE(PG8_SB(0, 1), cB + hstep, voffB); PG8_STAGE(PG8_SA(0, 0), cA, voffA); PG8_STAGE(PG8_SA(0, 1), cA + hstep, voffA);
        if (wr == 1) PG8_BAR;
        PG8_WAIT_V(2); PG8_BAR;
        PG8_STAGE(PG8_SB(1, 0), cB + kstep, voffB); PG8_STAGE(PG8_SA(1, 0), cA + kstep, voffA); PG8_STAGE(PG8_SB(1, 1), cB + hstep + kstep, voffB);
        PG8_WAIT_V(6); PG8_BAR;
    } else {
        PG8_STAGE(PG8_SB(0, 0), cB, voffB); PG8_STAGE(PG8_SA(0, 0), cA, voffA); PG8_STAGE(PG8_SB(0, 1), cB + hstep, voffB); PG8_STAGE(PG8_SA(0, 1), cA + hstep, voffA);
        if (wr == 1) PG8_BAR;
        PG8_WAIT_V(4); PG8_BAR;
        PG8_STAGE(PG8_SB(1, 0), cB + kstep, voffB); PG8_STAGE(PG8_SA(1, 0), cA + kstep, voffA); PG8_STAGE(PG8_SB(1, 1), cB + hstep + kstep, voffB);
        PG8_WAIT_V(6); PG8_BAR;
    }
    for (;;) {
        const bool has_next = S.next(ui + 1, nxt);
        const char* nA = has_next ? (const char*)g.A + (size_t)nxt.pm * tstep : cA; const char* nB = has_next ? (const char*)g.Bt + (size_t)nxt.pn * tstep : cB;
        for (int t = 0; t < nt; t += 2) {
            const bool last = (t == nt - 2);
            const char* a1 = cA + (size_t)(t + 1) * kstep;
            const char* a2 = last ? nA : cA + (size_t)(t + 2) * kstep; const char* b2 = last ? nB : cB + (size_t)(t + 2) * kstep;
            const char* a3 = a2 + kstep; const char* b3 = b2 + kstep;
            if (last && has_next) S.a_ready(nxt);
            if constexpr (SP2) {
            PG8_LDB(B0, 0, 0); PG8_LDB(B1, 0, 1); PG8_SCHED; PG8_LDA(At, 0, 0); PG8_STAGE(PG8_SA(1, 1), a1 + hstep, voffA);
            PG8_WAIT_V(8); PG8_WAIT_L(0); PG8_BAR; PG8_MMA(0, 0, At, B0); PG8_MMA(0, 1, At, B1); PG8_BAR; PG8_SCHED;
            PG8_LDA(At, 0, 1); PG8_STAGE(PG8_SB(0, 0), b2, voffB); PG8_STAGE(PG8_SB(0, 1), b2 + hstep, voffB); PG8_STAGE(PG8_SA(0, 0), a2, voffA);
            PG8_WAIT_V(8); PG8_WAIT_L(0); PG8_BAR; PG8_MMA(1, 0, At, B0); PG8_MMA(1, 1, At, B1); PG8_BAR; PG8_SCHED;
            PG8_LDB(B0, 1, 0); PG8_LDB(B1, 1, 1); PG8_SCHED; PG8_LDA(At, 1, 0); PG8_STAGE(PG8_SA(0, 1), a2 + hstep, voffA);
            PG8_WAIT_V(8); PG8_WAIT_L(0); PG8_BAR; PG8_MMA(0, 0, At, B0); PG8_MMA(0, 1, At, B1); PG8_BAR; PG8_SCHED;
            PG8_LDA(At, 1, 1); PG8_STAGE(PG8_SB(1, 0), b3, voffB); PG8_STAGE(PG8_SB(1, 1), b3 + hstep, voffB); PG8_STAGE(PG8_SA(1, 0), a3, voffA);
            PG8_WAIT_V(8); PG8_WAIT_L(0); PG8_BAR; PG8_MMA(1, 0, At, B0); PG8_MMA(1, 1, At, B1); PG8_BAR; PG8_SCHED;
            } else {
            PG8_LDB(B0, 0, 0); PG8_SCHED; PG8_LDA(At, 0, 0); PG8_STAGE(PG8_SA(1, 1), a1 + hstep, voffA);
            PG8_WAIT_L(8); PG8_BAR; PG8_WAIT_L(0); PG8_MMA(0, 0, At, B0); PG8_BAR; PG8_SCHED;
            PG8_LDB(B1, 0, 1); PG8_STAGE(PG8_SB(0, 0), b2, voffB);
            PG8_BAR; PG8_WAIT_L(0); PG8_MMA(0, 1, At, B1); PG8_BAR;
            PG8_LDA(At, 0, 1); PG8_STAGE(PG8_SA(0, 0), a2, voffA);
            PG8_BAR; PG8_WAIT_L(0); PG8_MMA(1, 0, At, B0); PG8_BAR; PG8_SCHED;
            PG8_STAGE(PG8_SB(0, 1), b2 + hstep, voffB);
            PG8_WAIT_V(6); PG8_BAR; PG8_MMA(1, 1, At, B1); PG8_BAR;
            PG8_LDB(B0, 1, 0); PG8_SCHED; PG8_LDA(At, 1, 0); PG8_STAGE(PG8_SA(0, 1), a2 + hstep, voffA);
            PG8_WAIT_L(8); PG8_BAR; PG8_WAIT_L(0); PG8_MMA(0, 0, At, B0); PG8_BAR; PG8_SCHED;
            PG8_LDB(B1, 1, 1); PG8_STAGE(PG8_SB(1, 0), b3, voffB);
            PG8_BAR; PG8_WAIT_L(0); PG8_MMA(0, 1, At, B1); PG8_BAR;
            PG8_LDA(At, 1, 1); PG8_STAGE(PG8_SA(1, 0), a3, voffA);
            PG8_BAR; PG8_WAIT_L(0); PG8_MMA(1, 0, At, B0); PG8_BAR; PG8_SCHED;
            PG8_STAGE(PG8_SB(1, 1), b3 + hstep, voffB);
            PG8_WAIT_V(6); PG8_BAR; PG8_MMA(1, 1, At, B1); PG8_BAR;
            }
        }
        if constexpr (ALIGN_EPI) { if (wr == 0) PG8_BAR; }
        if constexpr (!Epi::AFTER_DRAIN) { E(acc, cur, wr, wc, fr, fq); S.done(cur); }
        if (!has_next) break;
#pragma unroll
        for (int a = 0; a < 2; ++a)
#pragma unroll
            for (int b = 0; b < 2; ++b)
#pragma unroll
                for (int m = 0; m < 4; ++m)
#pragma unroll
                    for (int n = 0; n < 2; ++n) acc[a][b][m][n] = (f32x4){0.f, 0.f, 0.f, 0.f};
        cur = nxt; cA = nA; cB = nB; ++ui;
        if constexpr (ALIGN_EPI) { if (wr == 1) PG8_BAR; }
    }
    PG8_WAIT_V(0);
    if constexpr (!ALIGN_EPI) { if (wr == 0) PG8_BAR; }
    PG8_BAR;
    if constexpr (Epi::AFTER_DRAIN) { E.fused(acc, cur, wr, wc, fr, fq, lds, wid, lane); S.done(cur); }
#undef PG8_SA
#undef PG8_SB
#undef PG8_STAGE
#undef PG8_LDA
#undef PG8_LDB
#undef PG8_MMA
#undef PG8_WAIT_V
#undef PG8_WAIT_L
#undef PG8_BAR
#undef PG8_SCHED
}
}

#ifndef MK_FUSED
#define MK_FUSED 1
#endif
#define DI __device__ __forceinline__
#define LAS __attribute__((address_space(3)))
typedef unsigned short bf16_t;
typedef float f32x4 __attribute__((ext_vector_type(4)));
typedef float f32x2 __attribute__((ext_vector_type(2)));
typedef float f32x16 __attribute__((ext_vector_type(16)));
typedef unsigned u32x4 __attribute__((ext_vector_type(4)));
typedef unsigned u32x2 __attribute__((ext_vector_type(2)));
typedef short bf16x8 __attribute__((ext_vector_type(8)));
typedef _Float16 h16x2 __attribute__((ext_vector_type(2)));
typedef _Float16 h16x8 __attribute__((ext_vector_type(8)));

constexpr int BATCH = 16, SEQ = 4096, T = BATCH * SEQ, DM = 1024, NIN = 4864;
constexpr int C_AQ = 0, C_AK = 512, C_AV = 640, C_HQ = 768, C_HF = 1280, C_HI = 1792, C_HG = 2304, C_GA = 2816, C_GH = 3840;
constexpr float EPS = 1e-6f;
constexpr int NTHR = 512;
constexpr int LDS_BYTES = 163840;

constexpr size_t MiB = 1u << 20;
constexpr size_t WS_W1T = 1 * MiB;
constexpr size_t WS_WAPT = 11 * MiB;
constexpr size_t WS_WHPT = 12 * MiB;
constexpr size_t WS_WOUTT = 13 * MiB;
constexpr size_t WS_WQT = 15 * MiB;
constexpr size_t WS_KEYS = 19 * MiB;
constexpr size_t WS_LB = 19 * MiB + 512 * 1024;
constexpr size_t WS_RSTD1 = 20 * MiB;
constexpr size_t WS_SSQ2 = 21 * MiB;
constexpr size_t WS_U8 = 26 * MiB;
constexpr size_t WS_V8 = 42 * MiB;
constexpr size_t WS_SU = 58 * MiB;
constexpr size_t WS_SV = 58 * MiB + 65536;
constexpr size_t WS_DEC = 60 * MiB;
constexpr size_t WS_AVT = 64 * MiB;
constexpr size_t WS_XB = 90 * MiB;
constexpr size_t WS_PA = 218 * MiB;
constexpr size_t WS_GG = 314 * MiB;
constexpr size_t WS_QD = 570 * MiB;
constexpr size_t WS_KINV = 634 * MiB;
constexpr size_t WS_KENDT = 698 * MiB;
constexpr size_t WS_VT = 762 * MiB;
constexpr size_t WS_GS = 826 * MiB;
constexpr size_t WS_YA = 890 * MiB;
constexpr size_t WS_YH = 954 * MiB;
constexpr size_t WS_END = 1018 * MiB;
constexpr size_t WS_HQ = 698 * MiB;
constexpr size_t WS_WX = 762 * MiB;
constexpr size_t WS_SH = 60 * MiB;
constexpr size_t WS_SSQ3 = 64 * MiB;
constexpr size_t WS_SW = 61 * MiB;
constexpr size_t WS_ACTP = 346 * MiB;
constexpr size_t WS_X2B = 218 * MiB;
constexpr size_t WS_QP = 346 * MiB;
constexpr size_t WS_GIDX = 602 * MiB;
constexpr size_t WS_GGATE = 618 * MiB;

struct Args { const float* in[15]; float* out; unsigned char* ws; int ph_lo, ph_hi; };

DI unsigned pk_bf16(float lo, float hi) { typedef __bf16 b2 __attribute__((ext_vector_type(2))); f32x2 v = {lo, hi}; b2 b = __builtin_convertvector(v, b2); return __builtin_bit_cast(unsigned, b); }
DI float bflo(unsigned w) { return __uint_as_float(w << 16); }
DI float bfhi(unsigned w) { return __uint_as_float(w & 0xffff0000u); }
DI float sigm(float x) { return __builtin_amdgcn_rcpf(1.f + __expf(-x)); }
DI float wave_sum(float v) {
    v += __int_as_float(__builtin_amdgcn_mov_dpp(__float_as_int(v), 0xB1, 0xf, 0xf, true));
    v += __int_as_float(__builtin_amdgcn_mov_dpp(__float_as_int(v), 0x4E, 0xf, 0xf, true));
    v += __int_as_float(__builtin_amdgcn_mov_dpp(__float_as_int(v), 0x141, 0xf, 0xf, true));
    v += __int_as_float(__builtin_amdgcn_mov_dpp(__float_as_int(v), 0x128, 0xf, 0xf, true));
    { const auto r = __builtin_amdgcn_permlane16_swap(__float_as_uint(v), __float_as_uint(v), false, false); v = __uint_as_float(r[0]) + __uint_as_float(r[1]); }
    { const auto r = __builtin_amdgcn_permlane32_swap(__float_as_uint(v), __float_as_uint(v), false, false); v = __uint_as_float(r[0]) + __uint_as_float(r[1]); }
    return v;
}
DI float wave_max(float v) {
    v = fmaxf(v, __int_as_float(__builtin_amdgcn_mov_dpp(__float_as_int(v), 0xB1, 0xf, 0xf, true)));
    v = fmaxf(v, __int_as_float(__builtin_amdgcn_mov_dpp(__float_as_int(v), 0x4E, 0xf, 0xf, true)));
    v = fmaxf(v, __int_as_float(__builtin_amdgcn_mov_dpp(__float_as_int(v), 0x141, 0xf, 0xf, true)));
    v = fmaxf(v, __int_as_float(__builtin_amdgcn_mov_dpp(__float_as_int(v), 0x128, 0xf, 0xf, true)));
    { const auto r = __builtin_amdgcn_permlane16_swap(__float_as_uint(v), __float_as_uint(v), false, false); v = fmaxf(__uint_as_float(r[0]), __uint_as_float(r[1])); }
    { const auto r = __builtin_amdgcn_permlane32_swap(__float_as_uint(v), __float_as_uint(v), false, false); v = fmaxf(__uint_as_float(r[0]), __uint_as_float(r[1])); }
    return v;
}
DI unsigned short bf16_1(float x) { return (unsigned short)(pk_bf16(x, 0.f) & 0xffffu); }
template <int N> DI float dpp_row_shr(float v) { return __int_as_float(__builtin_amdgcn_update_dpp(0, __float_as_int(v), 0x110 + N, 0xf, 0xf, true)); }
DI float rowsum16(float v) { v += __int_as_float(__builtin_amdgcn_mov_dpp(__float_as_int(v), 0xB1, 0xf, 0xf, true)); v += __int_as_float(__builtin_amdgcn_mov_dpp(__float_as_int(v), 0x4E, 0xf, 0xf, true));
    v += __int_as_float(__builtin_amdgcn_mov_dpp(__float_as_int(v), 0x141, 0xf, 0xf, true)); v += __int_as_float(__builtin_amdgcn_mov_dpp(__float_as_int(v), 0x128, 0xf, 0xf, true)); return v; }
DI float scan16(float v) { v += dpp_row_shr<1>(v); v += dpp_row_shr<2>(v); v += dpp_row_shr<4>(v); v += dpp_row_shr<8>(v); return v; }
DI int crow(int reg, int hh) { return (reg & 3) + 8 * (reg >> 2) + 4 * hh; }
#define MFMA32(a, b, c) __builtin_amdgcn_mfma_f32_32x32x16_bf16((a), (b), (c), 0, 0, 0)
#define LDS_WAIT() asm volatile("s_waitcnt lgkmcnt(0)" ::: "memory")

namespace pg8 {
#define TSTORE_WRITE(sl, e, m, x) *(PG8_LAS bf16_t*)((sl) + (4 * fq + (e)) * 144 + (16 * (m) + fr) * 2) = bf16_1(x)
struct Epi1 {
    static constexpr bool PERM = true, AFTER_DRAIN = false;
    const float* rs; bf16_t* pa; bf16_t* gg; bf16_t* qd; bf16_t* kinv; bf16_t* kendT; bf16_t* vT; bf16_t* gs; float* dec; const float* lb; bf16_t* avT; PG8_LAS unsigned char* xl;
    __device__ __forceinline__ void operator()(const f32x4 (&acc)[2][2][4][2], const Unit& u, int wr, int wc, int fr, int fq) const {
        asm volatile("" : "+v"(fr), "+v"(fq));
        const int row0 = u.pm * BM + wr * 64 + fr, pn = u.pn;
        float rsv[2][4];
#pragma unroll
        for (int ai = 0; ai < 2; ++ai)
#pragma unroll
            for (int m = 0; m < 4; ++m) rsv[ai][m] = rs[row0 + ai * HALF + m * 16];
        if (pn == 2) {
            const int c8 = wc * 32 + 8 * fq, tseqb = (u.pm & 15) * 256 + wr * 64 + fr, bb = u.pm >> 4;
#pragma unroll
            for (int ai = 0; ai < 2; ++ai)
#pragma unroll
                for (int m = 0; m < 4; ++m) { const int row = row0 + ai * HALF + m * 16; const float s = rsv[ai][m];
                    const f32x4 v0 = acc[ai][0][m][0] * s, v1 = acc[ai][0][m][1] * s;
                    u32x4 w; w.x = pk_bf16(v0[0], v0[1]); w.y = pk_bf16(v0[2], v0[3]); w.z = pk_bf16(v1[0], v1[1]); w.w = pk_bf16(v1[2], v1[3]);
                    *(u32x4*)(pa + (size_t)row * 768 + 512 + c8) = w;
                }
            PG8_LAS unsigned char* sl = xl + (wr * 4 + wc) * 2304; const int lane_ = fq * 16 + fr;
#pragma unroll
            for (int ai = 0; ai < 2; ++ai)
#pragma unroll
                for (int n = 0; n < 2; ++n) {
#pragma unroll
                    for (int m = 0; m < 4; ++m) { const float s = rsv[ai][m];
#pragma unroll
                        for (int e = 0; e < 4; ++e) TSTORE_WRITE(sl, e, m, acc[ai][1][m][n][e] * s); }
                    asm volatile("s_waitcnt lgkmcnt(0)" ::: "memory");
#pragma unroll
                    for (int q = 0; q < 2; ++q) { const int c = lane_ + 64 * q, rw = c >> 3, tc = c & 7, col = wc * 32 + 8 * (rw >> 2) + 4 * n + (rw & 3);
                        const u32x4 w = *(const PG8_LAS u32x4*)(sl + rw * 144 + tc * 16);
                        *(u32x4*)(avT + (size_t)((bb * 2 + (col >> 6)) * 64 + (col & 63)) * SEQ + (u.pm & 15) * 256 + ai * HALF + wr * 64 + 8 * tc) = w; }
                    asm volatile("s_waitcnt lgkmcnt(0)" ::: "memory");
                }
            return;
        }
        if (pn < 3 || pn >= 11) {
            bf16_t* O; int ldc, colt;
            if (pn < 3) { O = pa; ldc = 768; colt = pn * 256; } else { O = gg; ldc = 2048; colt = (pn - 11) * 256; }
            const int col0 = colt + wc * 32 + 8 * fq;
#pragma unroll
            for (int ai = 0; ai < 2; ++ai)
#pragma unroll
                for (int m = 0; m < 4; ++m) { const int row = row0 + ai * HALF + m * 16; const float s = rsv[ai][m]; bf16_t* rowp = O + (size_t)row * ldc + col0;
#pragma unroll
                    for (int bj = 0; bj < 2; ++bj) { const f32x4 v0 = acc[ai][bj][m][0] * s, v1 = acc[ai][bj][m][1] * s;
                        u32x4 w; w.x = pk_bf16(v0[0], v0[1]); w.y = pk_bf16(v0[2], v0[3]); w.z = pk_bf16(v1[0], v1[1]); w.w = pk_bf16(v1[2], v1[3]);
                        *(u32x4*)(rowp + bj * HALF) = w; } }
            return;
        }
        PG8_LAS unsigned char* sl = xl + (wr * 4 + wc) * 2304; const int lane_ = fq * 16 + fr;
        const int h = (pn - 3) & 3, c8 = wc * 32 + 8 * fq, bh = (u.pm >> 4) * 4 + h;
        if (pn < 7) {
#pragma unroll
            for (int ai = 0; ai < 2; ++ai)
#pragma unroll
                for (int m = 0; m < 4; ++m) { const int row = row0 + ai * HALF + m * 16; const float s = rsv[ai][m]; const size_t o = (size_t)row * 512 + h * 128 + c8;
#pragma unroll
                    for (int bj = 0; bj < 2; ++bj) { const f32x4 v0 = acc[ai][bj][m][0] * s, v1 = acc[ai][bj][m][1] * s;
                        u32x4 w; w.x = pk_bf16(v0[0], v0[1]); w.y = pk_bf16(v0[2], v0[3]); w.z = pk_bf16(v1[0], v1[1]); w.w = pk_bf16(v1[2], v1[3]);
                        *(u32x4*)((bj ? kinv : qd) + o) = w; } }
        } else {
#pragma unroll
            for (int ai = 0; ai < 2; ++ai) {
                const int tseq0 = (u.pm & 15) * 256 + ai * HALF + wr * 64;
#pragma unroll
                for (int n = 0; n < 2; ++n) {
#pragma unroll
                    for (int m = 0; m < 4; ++m) { const float s = rsv[ai][m];
#pragma unroll
                        for (int e = 0; e < 4; ++e) TSTORE_WRITE(sl, e, m, acc[ai][0][m][n][e] * s); }
                    asm volatile("s_waitcnt lgkmcnt(0)" ::: "memory");
#pragma unroll
                    for (int q = 0; q < 2; ++q) { const int c = lane_ + 64 * q, rw = c >> 3, tc = c & 7, dvr = wc * 32 + 8 * (rw >> 2) + 4 * n + (rw & 3);
                        const u32x4 w = *(const PG8_LAS u32x4*)(sl + rw * 144 + tc * 16);
                        *(u32x4*)(vT + (size_t)(bh * 128 + dvr) * SEQ + tseq0 + 8 * tc) = w; }
                    asm volatile("s_waitcnt lgkmcnt(0)" ::: "memory");
                }
#pragma unroll
                for (int m = 0; m < 4; ++m) { const int row = row0 + ai * HALF + m * 16; const float s = rsv[ai][m];
                    f32x4 g0 = acc[ai][1][m][0] * s, g1 = acc[ai][1][m][1] * s;
#pragma unroll
                    for (int e = 0; e < 4; ++e) { g0[e] *= sigm(g0[e]); g1[e] *= sigm(g1[e]); }
                    u32x4 w; w.x = pk_bf16(g0[0], g0[1]); w.y = pk_bf16(g0[2], g0[3]); w.z = pk_bf16(g1[0], g1[1]); w.w = pk_bf16(g1[2], g1[3]);
                    *(u32x4*)(gs + (size_t)row * 512 + h * 128 + c8) = w; }
            }
        }
    }
};
template <bool ADD> struct EpiMerge {
    static constexpr bool PERM = true, AFTER_DRAIN = false;
    bf16_t* O; const bf16_t* gate;
    __device__ __forceinline__ void operator()(const f32x4 (&acc)[2][2][4][2], const Unit& u, int wr, int wc, int fr, int fq) const {
        const int row0 = u.pm * BM + wr * 64 + fr, col0 = u.pn * BM + wc * 32 + 8 * fq;
#pragma unroll
        for (int ai = 0; ai < 2; ++ai) {
            u32x4 g[4][2], o[4][2];
#pragma unroll
            for (int m = 0; m < 4; ++m)
#pragma unroll
                for (int bj = 0; bj < 2; ++bj) { const size_t row = (size_t)(row0 + ai * HALF + m * 16);
                    g[m][bj] = *(const u32x4*)(gate + row * 2048 + col0 + bj * HALF); if (ADD) o[m][bj] = *(const u32x4*)(O + row * DM + col0 + bj * HALF); }
#pragma unroll
            for (int m = 0; m < 4; ++m) { const int row = row0 + ai * HALF + m * 16; bf16_t* rowp = O + (size_t)row * DM + col0;
#pragma unroll
                for (int bj = 0; bj < 2; ++bj) { const u32x4 gq = g[m][bj];
                    f32x4 v0 = acc[ai][bj][m][0], v1 = acc[ai][bj][m][1];
                    v0[0] *= sigm(bflo(gq.x)); v0[1] *= sigm(bfhi(gq.x)); v0[2] *= sigm(bflo(gq.y)); v0[3] *= sigm(bfhi(gq.y));
                    v1[0] *= sigm(bflo(gq.z)); v1[1] *= sigm(bfhi(gq.z)); v1[2] *= sigm(bflo(gq.w)); v1[3] *= sigm(bfhi(gq.w));
                    if (ADD) { const u32x4 oq = o[m][bj];
                        v0[0] += bflo(oq.x); v0[1] += bfhi(oq.x); v0[2] += bflo(oq.y); v0[3] += bfhi(oq.y); v1[0] += bflo(oq.z); v1[1] += bfhi(oq.z); v1[2] += bflo(oq.w); v1[3] += bfhi(oq.w); }
                    u32x4 w; w.x = pk_bf16(v0[0], v0[1]); w.y = pk_bf16(v0[2], v0[3]); w.z = pk_bf16(v1[0], v1[1]); w.w = pk_bf16(v1[2], v1[3]);
                    *(u32x4*)(rowp + bj * HALF) = w; } }
        }
    }
};
struct EpiX2 {
    static constexpr bool PERM = true, AFTER_DRAIN = false;
    const bf16_t* X; bf16_t* X2B; float* ssq;
    __device__ __forceinline__ void operator()(const f32x4 (&acc)[2][2][4][2], const Unit& u, int wr, int wc, int fr, int fq) const {
        const int row0 = u.pm * BM + wr * 64 + fr, col0 = u.pn * BM + wc * 32 + 8 * fq;
#pragma unroll
        for (int ai = 0; ai < 2; ++ai) {
            u32x4 xr[4][2];
#pragma unroll
            for (int m = 0; m < 4; ++m)
#pragma unroll
                for (int bj = 0; bj < 2; ++bj) xr[m][bj] = *(const u32x4*)(X + (size_t)(row0 + ai * HALF + m * 16) * DM + col0 + bj * HALF);
#pragma unroll
            for (int m = 0; m < 4; ++m) { const int row = row0 + ai * HALF + m * 16; const size_t off = (size_t)row * DM + col0; float ss = 0.f;
#pragma unroll
                for (int bj = 0; bj < 2; ++bj) { const u32x4 xq = xr[m][bj];
                    const f32x4 v0 = acc[ai][bj][m][0] + (f32x4){bflo(xq.x), bfhi(xq.x), bflo(xq.y), bfhi(xq.y)}, v1 = acc[ai][bj][m][1] + (f32x4){bflo(xq.z), bfhi(xq.z), bflo(xq.w), bfhi(xq.w)};
                    u32x4 w; w.x = pk_bf16(v0[0], v0[1]); w.y = pk_bf16(v0[2], v0[3]); w.z = pk_bf16(v1[0], v1[1]); w.w = pk_bf16(v1[2], v1[3]);
                    *(u32x4*)(X2B + off + bj * HALF) = w;
                    ss += (v0[0] * v0[0] + v0[1] * v0[1]) + (v0[2] * v0[2] + v0[3] * v0[3]) + (v1[0] * v1[0] + v1[1] * v1[1]) + (v1[2] * v1[2] + v1[3] * v1[3]); }
                { const auto r = __builtin_amdgcn_permlane16_swap(__float_as_uint(ss), __float_as_uint(ss), false, false); ss = __uint_as_float(r[0]) + __uint_as_float(r[1]); }
                { const auto r = __builtin_amdgcn_permlane32_swap(__float_as_uint(ss), __float_as_uint(ss), false, false); ss = __uint_as_float(r[0]) + __uint_as_float(r[1]); }
                if (fq == 0) ssq[(size_t)row * 16 + u.pn * 4 + wc] = ss; }
        }
    }
};
struct EpiQp {
    static constexpr bool PERM = true, AFTER_DRAIN = false;
    bf16_t* O; const float* ssq;
    __device__ __forceinline__ void operator()(const f32x4 (&acc)[2][2][4][2], const Unit& u, int wr, int wc, int fr, int fq) const {
        const int row0 = u.pm * BM + wr * 64 + fr, col0 = u.pn * BM + wc * 32 + 8 * fq;
        float sv[2][4];
#pragma unroll
        for (int ai = 0; ai < 2; ++ai)
#pragma unroll
            for (int m = 0; m < 4; ++m) { const f32x4 a = *(const f32x4*)(ssq + (size_t)(row0 + ai * HALF + m * 16) * 16 + 4 * fq); sv[ai][m] = (a[0] + a[1]) + (a[2] + a[3]); }
#pragma unroll
        for (int ai = 0; ai < 2; ++ai)
#pragma unroll
            for (int m = 0; m < 4; ++m) { float t = sv[ai][m];
                { const auto r = __builtin_amdgcn_permlane16_swap(__float_as_uint(t), __float_as_uint(t), false, false); t = __uint_as_float(r[0]) + __uint_as_float(r[1]); }
                { const auto r = __builtin_amdgcn_permlane32_swap(__float_as_uint(t), __float_as_uint(t), false, false); t = __uint_as_float(r[0]) + __uint_as_float(r[1]); }
                sv[ai][m] = __builtin_amdgcn_rsqf(t * (1.f / 1024.f) + EPS); }
#pragma unroll
        for (int ai = 0; ai < 2; ++ai)
#pragma unroll
            for (int m = 0; m < 4; ++m) { const int row = row0 + ai * HALF + m * 16; const float s = sv[ai][m]; bf16_t* rowp = O + (size_t)row * 2048 + col0;
#pragma unroll
                for (int bj = 0; bj < 2; ++bj) { const f32x4 v0 = acc[ai][bj][m][0] * s, v1 = acc[ai][bj][m][1] * s;
                    u32x4 w; w.x = pk_bf16(v0[0], v0[1]); w.y = pk_bf16(v0[2], v0[3]); w.z = pk_bf16(v1[0], v1[1]); w.w = pk_bf16(v1[2], v1[3]);
                    *(u32x4*)(rowp + bj * HALF) = w; } }
    }
};
}

DI int w1_src_col(int n) {
    if (n < 768 || n >= 2816) return n;
    if (n < 1792) { const int h = (n - 768) >> 8, r = (n - 768) & 255; return r < 128 ? C_HQ + 128 * h + r : C_HF + 128 * h + (r - 128); }
    const int h = (n - 1792) >> 8, r = (n - 1792) & 255; return r < 128 ? C_HI + 128 * h + r : C_HG + 128 * h + (r - 128);
}
template <bool PERMW1> DI void p0_transpose_item(const float* W, int K, int N, bf16_t* WT, const float* g, int gmask, LAS float* scr, int item, int lane) {
    const int nblk = N / 32, kb = item / nblk, nb = item % nblk, k0 = 64 * kb, n0 = 32 * nb, ns = PERMW1 ? w1_src_col(n0) : n0;
#pragma unroll 8
    for (int i = 0; i < 32; ++i) { const int kk = 2 * i + (lane >> 5); float w = W[(size_t)(k0 + kk) * N + ns + (lane & 31)]; if (g) w *= g[(k0 + kk) & gmask]; scr[kk * 33 + (lane & 31)] = w; }
    LDS_WAIT(); asm volatile("" ::: "memory");
    const int c = lane & 7;
#pragma unroll
    for (int j = 0; j < 4; ++j) { const int n = (lane >> 3) + 8 * j; const LAS float* s = scr + (8 * c) * 33 + n;
        u32x4 o; o.x = pk_bf16(s[0 * 33], s[1 * 33]); o.y = pk_bf16(s[2 * 33], s[3 * 33]); o.z = pk_bf16(s[4 * 33], s[5 * 33]); o.w = pk_bf16(s[6 * 33], s[7 * 33]);
        *(u32x4*)(WT + (size_t)(n0 + n) * K + k0 + 8 * c) = o; }
    LDS_WAIT(); asm volatile("" ::: "memory");
}
DI unsigned pk_f16(float a, float b) { h16x2 v = {(_Float16)a, (_Float16)b}; return __builtin_bit_cast(unsigned, v); }

DI void p0_prologue(const Args& a, LAS unsigned char* lds, int vb, int G) {
    const int tid = threadIdx.x, lane = tid & 63, wave = tid >> 6;
    const int gw = vb * 8 + wave, NGW = G * 8, gt = vb * NTHR + tid, NGT = G * NTHR;
    unsigned char* ws = a.ws;
    LAS float* scr = (LAS float*)(lds + wave * 16384);
    constexpr int I_W1 = 16 * 152, I_AP = 8 * 32, I_HP = 8 * 32, I_OUT = 16 * 32, I_Q = 16 * 64, NITEMS = I_W1 + I_AP + I_HP + I_OUT + I_Q;
    for (int it = gw; it < NITEMS; it += NGW) {
        int r = it;
        if (r < I_W1) { p0_transpose_item<true>(a.in[2], 1024, NIN, (bf16_t*)(ws + WS_W1T), a.in[1], 1023, scr, r, lane); continue; } r -= I_W1;
        if (r < I_AP) { p0_transpose_item<false>(a.in[6], 512, 1024, (bf16_t*)(ws + WS_WAPT), nullptr, 0, scr, r, lane); continue; } r -= I_AP;
        if (r < I_HP) { p0_transpose_item<false>(a.in[7], 512, 1024, (bf16_t*)(ws + WS_WHPT), a.in[5], 127, scr, r, lane); continue; } r -= I_HP;
        if (r < I_OUT) { p0_transpose_item<false>(a.in[8], 1024, 1024, (bf16_t*)(ws + WS_WOUTT), nullptr, 0, scr, r, lane); continue; } r -= I_OUT;
        p0_transpose_item<false>(a.in[10], 1024, 2048, (bf16_t*)(ws + WS_WQT), a.in[9], 1023, scr, r, lane);
    }
    for (int i = gt; i < 2 * 8 * 128 * 128 / 4; i += NGT) { const f32x4 v = ((const f32x4*)a.in[11])[i]; u32x2 o; o.x = pk_bf16(v[0], v[1]); o.y = pk_bf16(v[2], v[3]); ((u32x2*)(ws + WS_KEYS))[i] = o; }
    for (int it = gw; it < 2 * 16384; it += NGW) {
        const int isv = it >= 16384, e = it & 16383;
        const float* src = (isv ? a.in[13] : a.in[12]) + (size_t)e * 1024 + 16 * lane;
        f32x4 x[4]; float amax = 0.f;
#pragma unroll
        for (int i = 0; i < 4; ++i) { x[i] = *(const f32x4*)(src + 4 * i); if (!isv) x[i] *= *(const f32x4*)(a.in[9] + 16 * lane + 4 * i);
            amax = fmaxf(fmaxf(amax, fmaxf(fabsf(x[i][0]), fabsf(x[i][1]))), fmaxf(fabsf(x[i][2]), fabsf(x[i][3]))); }
        amax = wave_max(amax);
        {
            float ssq_ = 0.f;
#pragma unroll
            for (int i = 0; i < 4; ++i) ssq_ += (x[i][0] * x[i][0] + x[i][1] * x[i][1]) + (x[i][2] * x[i][2] + x[i][3] * x[i][3]);
            ssq_ = wave_sum(ssq_);
            const float stp = fminf(0.35f * sqrtf(ssq_ * (1.f / 1024.f)), amax * (1.f / 7.f)), q4 = stp > 0.f ? 1.f / stp : 0.f; unsigned nb[16];
#pragma unroll
            for (int i = 0; i < 16; ++i) { const int q_ = (int)fminf(fmaxf(rintf(x[i >> 2][i & 3] * q4), -7.f), 7.f); nb[i] = (isv && !(i & 1)) ? (unsigned)(q_ + 8) : ((unsigned)q_ & 15u); }
            u32x2 w4; w4.x = (nb[0] | (nb[1] << 4)) | ((nb[2] | (nb[3] << 4)) << 8) | ((nb[4] | (nb[5] << 4)) << 16) | ((nb[6] | (nb[7] << 4)) << 24);
            w4.y = (nb[8] | (nb[9] << 4)) | ((nb[10] | (nb[11] << 4)) << 8) | ((nb[12] | (nb[13] << 4)) << 16) | ((nb[14] | (nb[15] << 4)) << 24);
            *(u32x2*)(ws + (isv ? WS_V8 : WS_U8) + (size_t)e * 512 + 8 * lane) = w4;
            if (lane == 0) ((float*)(ws + (isv ? WS_SV : WS_SU)))[e] = stp;
        }
    }
    for (int row = gw; row < T; row += NGW) {
        const f32x4* xr = (const f32x4*)(a.in[0] + (size_t)row * DM) + lane; f32x4 v[4]; float s = 0.f;
#pragma unroll
        for (int j = 0; j < 4; ++j) { v[j] = xr[64 * j]; s += (v[j][0] * v[j][0] + v[j][1] * v[j][1]) + (v[j][2] * v[j][2] + v[j][3] * v[j][3]); }
        s = wave_sum(s);
        u32x2* o = (u32x2*)(ws + WS_XB + (size_t)row * DM * 2) + lane;
#pragma unroll
        for (int j = 0; j < 4; ++j) { u32x2 w; w.x = pk_bf16(v[j][0], v[j][1]); w.y = pk_bf16(v[j][2], v[j][3]); o[64 * j] = w; }
        if (lane == 0) ((float*)(ws + WS_RSTD1))[row] = __builtin_amdgcn_rsqf(s * (1.f / 1024.f) + EPS);
    }
    if (vb == 0) { const float l0 = a.in[4][tid], l1 = a.in[4][512 + tid]; ((float*)(ws + WS_LB))[tid] = 1.f / (1.f + __expf(l1 - l0)); }
}

constexpr int ATT_KS = 272, ATT_VS = 392, ATT_VOFF = 192 * ATT_KS;
DI void attn_unit(const bf16_t* pa, const bf16_t* avT, const float* sinks, bf16_t* ya, LAS unsigned char* lds, int b, int tt) {
    int tid_ = threadIdx.x; asm volatile("" : "+v"(tid_));
    const int tid = tid_, lane = tid & 63, h = __builtin_amdgcn_readfirstlane(tid >> 6), r = lane & 31, hh = lane >> 5, kvh = h >> 2;
    const int p0 = tt * 64 - 128;
    {
        u32x4 kw[6], vw[6];
#pragma unroll
        for (int i = 0; i < 6; ++i) { const int c = tid + i * NTHR, row = c >> 4, ch = c & 15, pos = p0 + row, posc = pos < 0 ? 0 : pos;
            kw[i] = *(const u32x4*)(pa + ((size_t)b * SEQ + posc) * 768 + 512 + ch * 8); }
#pragma unroll
        for (int i = 0; i < 6; ++i) { const int c = tid + i * NTHR, row = c / 24, ch = c - row * 24, pos = p0 + ch * 8, posc = pos < 0 ? 0 : pos;
            vw[i] = *(const u32x4*)(avT + (size_t)(b * 128 + row) * SEQ + posc); }
#pragma unroll
        for (int i = 0; i < 6; ++i) { const int c = tid + i * NTHR, row = c >> 4, ch = c & 15; u32x4 w = kw[i]; if (p0 + row < 0) w = (u32x4){0u, 0u, 0u, 0u};
            *(LAS u32x4*)(lds + row * ATT_KS + ch * 16) = w; }
#pragma unroll
        for (int i = 0; i < 6; ++i) { const int c = tid + i * NTHR, row = c / 24, ch = c - row * 24; u32x4 w = vw[i]; if (p0 + ch * 8 < 0) w = (u32x4){0u, 0u, 0u, 0u};
            LAS u32x2* d = (LAS u32x2*)(lds + ATT_VOFF + row * ATT_VS + ch * 16); d[0] = (u32x2){w.x, w.y}; d[1] = (u32x2){w.z, w.w}; }
    }
    __syncthreads();
    constexpr float LOG2E = 1.4426950408889634f;
    const float slope2 = exp2f(-(float)(h + 1)) * LOG2E, sink2 = sinks[h] * LOG2E, qs = 0.125f * LOG2E;
#pragma unroll 1
    for (int qbl = 0; qbl < 2; ++qbl) {
        const int qb = tt * 2 + qbl; const size_t trow = (size_t)b * SEQ + qb * 32 + r;
        bf16x8 qf[4];
        { const bf16_t* qp = pa + trow * 768 + h * 64 + 8 * hh;
#pragma unroll
          for (int s = 0; s < 4; ++s) qf[s] = *(const bf16x8*)(qp + 16 * s); }
        f32x16 S[5]; float m = sink2;
#pragma unroll
        for (int i = 0; i < 5; ++i) { const int kb = qb - 4 + i;
            if (kb >= 0) {
#pragma unroll
                for (int q = 0; q < 16; ++q) S[i][q] = 0.f;
                const LAS unsigned char* kp = lds + (32 * (qbl + i) + r) * ATT_KS + kvh * 128 + 16 * hh;
#pragma unroll
                for (int s = 0; s < 4; ++s) S[i] = MFMA32(*(const LAS bf16x8*)(kp + 32 * s), qf[s], S[i]);
#pragma unroll
                for (int q = 0; q < 16; ++q) { const int dist = 32 * (4 - i) + r - crow(q, hh); float v = S[i][q] * qs - slope2 * (float)dist;
                    if (i == 0) v = (dist <= 127) ? v : -1e30f;
                    if (i == 4) v = (dist >= 0) ? v : -1e30f;
                    S[i][q] = v; m = fmaxf(m, v); }
            } }
        m = fmaxf(m, __shfl_xor(m, 32));
        float l = 0.f;
#pragma unroll
        for (int i = 0; i < 5; ++i) if (qb - 4 + i >= 0) {
#pragma unroll
            for (int q = 0; q < 16; ++q) { const float p = __builtin_amdgcn_exp2f(S[i][q] - m); S[i][q] = p; l += p; } }
        l += __shfl_xor(l, 32); l += __builtin_amdgcn_exp2f(sink2 - m);
        f32x16 O[2];
#pragma unroll
        for (int q = 0; q < 16; ++q) { O[0][q] = 0.f; O[1][q] = 0.f; }
#pragma unroll
        for (int i = 0; i < 5; ++i) { const int kb = qb - 4 + i;
            if (kb >= 0) {
#pragma unroll
                for (int s2 = 0; s2 < 2; ++s2) {
                    u32x4 pb; pb.x = pk_bf16(S[i][8 * s2], S[i][8 * s2 + 1]); pb.y = pk_bf16(S[i][8 * s2 + 2], S[i][8 * s2 + 3]); pb.z = pk_bf16(S[i][8 * s2 + 4], S[i][8 * s2 + 5]); pb.w = pk_bf16(S[i][8 * s2 + 6], S[i][8 * s2 + 7]);
#pragma unroll
                    for (int dt = 0; dt < 2; ++dt) { const LAS unsigned char* vp = lds + ATT_VOFF + (kvh * 64 + 32 * dt + r) * ATT_VS + (32 * (qbl + i) + 16 * s2 + 4 * hh) * 2;
                        const u32x2 v0 = *(const LAS u32x2*)vp, v1 = *(const LAS u32x2*)(vp + 16); u32x4 av; av.x = v0.x; av.y = v0.y; av.z = v1.x; av.w = v1.y;
                        O[dt] = MFMA32(__builtin_bit_cast(bf16x8, av), __builtin_bit_cast(bf16x8, pb), O[dt]); }
                    asm volatile("" ::: "memory");
                } } }
        const float inv = 1.f / l;
#pragma unroll
        for (int dt = 0; dt < 2; ++dt)
#pragma unroll
            for (int g = 0; g < 4; ++g) { u32x2 w; w.x = pk_bf16(O[dt][4 * g] * inv, O[dt][4 * g + 1] * inv); w.y = pk_bf16(O[dt][4 * g + 2] * inv, O[dt][4 * g + 3] * inv);
                *(u32x2*)(ya + trow * 512 + h * 64 + 32 * dt + 8 * g + 4 * hh) = w; }
    }
    __syncthreads();
}

DI void hgrn_prep_unit(bf16_t* qd, bf16_t* kinv, LAS unsigned char* kl, float* dec, const float* lb, int bh, int c, int dk2) {
    const int b = bh >> 2, h = bh & 3;
    bf16_t* qp = qd + ((size_t)b * SEQ + c * 64) * 512 + h * 128 + dk2; bf16_t* kp = kinv + ((size_t)b * SEQ + c * 64) * 512 + h * 128 + dk2;
    const float lb0 = lb[h * 128 + dk2], lb1 = lb[h * 128 + dk2 + 1], om0 = 1.f - lb0, om1 = 1.f - lb1;
    unsigned qw[64], kv[64];
#pragma unroll
    for (int s = 0; s < 64; ++s) { qw[s] = *(const unsigned*)(qp + (size_t)s * 512); kv[s] = *(const unsigned*)(kp + (size_t)s * 512); }
    float b0 = 0.f, b1 = 0.f;
#pragma unroll
    for (int s = 0; s < 64; ++s) {
        const float f0 = lb0 + om0 * sigm(bflo(kv[s])), f1 = lb1 + om1 * sigm(bfhi(kv[s]));
        b0 += __logf(f0); b1 += __logf(f1);
        const float e0 = __expf(b0), e1 = __expf(b1), i0 = __builtin_amdgcn_rcpf(e0), i1 = __builtin_amdgcn_rcpf(e1);
        const float q0 = bflo(qw[s]), q1 = bfhi(qw[s]);
        *(unsigned*)(qp + (size_t)s * 512) = pk_bf16(q0 * sigm(q0) * e0, q1 * sigm(q1) * e1);
        kv[s] = pk_bf16((1.f - f0) * i0, (1.f - f1) * i1);
        *(unsigned*)(kp + (size_t)s * 512) = kv[s];
    }
    const float d0 = __expf(b0), d1 = __expf(b1);
    *(f32x2*)(dec + (size_t)(bh * 64 + c) * 128 + dk2) = (f32x2){d0, d1};
    LAS unsigned char* r0 = kl + dk2 * 144; LAS unsigned char* r1 = r0 + 144;
#pragma unroll
    for (int s0 = 0; s0 < 64; s0 += 8) { u32x4 w0, w1;
#pragma unroll
        for (int i = 0; i < 4; ++i) { const unsigned ka = kv[s0 + 2 * i], kb = kv[s0 + 2 * i + 1];
            w0[i] = pk_bf16(bflo(ka) * d0, bflo(kb) * d0); w1[i] = pk_bf16(bfhi(ka) * d1, bfhi(kb) * d1); }
        *(LAS u32x4*)(r0 + s0 * 2) = w0; *(LAS u32x4*)(r1 + s0 * 2) = w1; }
}
DI void hgrn_ds_unit(const LAS unsigned char* kl, const bf16_t* vT, bf16_t* dsT, int bh, int c) {
    int tid_ = threadIdx.x; asm volatile("" : "+v"(tid_));
    const int lane = tid_ & 63, wave = tid_ >> 6, r = lane & 31, hh = lane >> 5, i = wave >> 1, j0 = 2 * (wave & 1);
    const LAS unsigned char* ka = kl + (32 * i + r) * 144 + 16 * hh;
    const bf16_t* vb0 = vT + (size_t)(bh * 128 + 32 * j0 + r) * SEQ + c * 64 + 8 * hh; const bf16_t* vb1 = vb0 + (size_t)32 * SEQ;
    f32x16 D0, D1;
#pragma unroll
    for (int q = 0; q < 16; ++q) { D0[q] = 0.f; D1[q] = 0.f; }
#pragma unroll
    for (int ks = 0; ks < 4; ++ks) { const bf16x8 a = *(const LAS bf16x8*)(ka + 32 * ks), b0 = *(const bf16x8*)(vb0 + 16 * ks), b1 = *(const bf16x8*)(vb1 + 16 * ks); D0 = MFMA32(a, b0, D0); D1 = MFMA32(a, b1, D1); }
    const int unit = bh * 64 + c;
    bf16_t* o0 = dsT + (size_t)(unit * 128 + 32 * j0 + r) * 128 + 32 * i + 4 * hh; bf16_t* o1 = o0 + 32 * 128;
#pragma unroll
    for (int g = 0; g < 4; ++g) { u32x2 w; w.x = pk_bf16(D0[4 * g], D0[4 * g + 1]); w.y = pk_bf16(D0[4 * g + 2], D0[4 * g + 3]); *(u32x2*)(o0 + 8 * g) = w;
        u32x2 z; z.x = pk_bf16(D1[4 * g], D1[4 * g + 1]); z.y = pk_bf16(D1[4 * g + 2], D1[4 * g + 3]); *(u32x2*)(o1 + 8 * g) = z; }
}
DI void hgrn_scan(bf16_t* dsT, const float* dec, int vb, int G) {
    for (int idx = vb * NTHR + threadIdx.x; idx < 64 * 128 * 16; idx += G * NTHR) {
        const int dk8 = idx & 15, dv = (idx >> 4) & 127, bh = idx >> 11;
        float S[8];
#pragma unroll
        for (int q = 0; q < 8; ++q) S[q] = 0.f;
        for (int c0 = 0; c0 < 64; c0 += 8) {
            u32x4 ld[8]; f32x4 d0[8], d1[8];
#pragma unroll
            for (int i = 0; i < 8; ++i) { const int c = c0 + i; ld[i] = *(const u32x4*)(dsT + (size_t)((bh * 64 + c) * 128 + dv) * 128 + dk8 * 8);
                const float* dp = dec + (size_t)(bh * 64 + c) * 128 + dk8 * 8; d0[i] = *(const f32x4*)dp; d1[i] = *(const f32x4*)(dp + 4); }
#pragma unroll
            for (int i = 0; i < 8; ++i) { const int c = c0 + i;
                u32x4 w; w.x = pk_bf16(S[0], S[1]); w.y = pk_bf16(S[2], S[3]); w.z = pk_bf16(S[4], S[5]); w.w = pk_bf16(S[6], S[7]);
                *(u32x4*)(dsT + (size_t)((bh * 64 + c) * 128 + dv) * 128 + dk8 * 8) = w;
                S[0] = d0[i][0] * S[0] + bflo(ld[i].x); S[1] = d0[i][1] * S[1] + bfhi(ld[i].x); S[2] = d0[i][2] * S[2] + bflo(ld[i].y); S[3] = d0[i][3] * S[3] + bfhi(ld[i].y);
                S[4] = d1[i][0] * S[4] + bflo(ld[i].z); S[5] = d1[i][1] * S[5] + bfhi(ld[i].z); S[6] = d1[i][2] * S[6] + bflo(ld[i].w); S[7] = d1[i][3] * S[7] + bfhi(ld[i].w); }
        }
    }
}
constexpr int HO_Q = 0, HO_K = 64 * 272, HO_S = 2 * 64 * 272, HO_V = HO_S + 128 * 272, HO_Z = HO_V + 128 * 144;
struct HoPre { u32x4 c[10]; u32x4 g0, g1; };
DI void ho_fetch(HoPre& p, const bf16_t* qd, const bf16_t* kinv, const bf16_t* vT, const bf16_t* spT, const bf16_t* gs, int u, int tid) {
    const int bh = u >> 6, c = u & 63, b = bh >> 2, h = bh & 3; const size_t Tb = (size_t)b * SEQ + c * 64;
#pragma unroll
    for (int k = 0; k < 2; ++k) { const int i = tid + NTHR * k, row = i >> 4, ch = i & 15; p.c[k] = *(const u32x4*)(qd + (Tb + row) * 512 + h * 128 + ch * 8); p.c[2 + k] = *(const u32x4*)(kinv + (Tb + row) * 512 + h * 128 + ch * 8); }
#pragma unroll
    for (int k = 0; k < 4; ++k) { const int i = tid + NTHR * k, row = i >> 4, ch = i & 15; p.c[4 + k] = *(const u32x4*)(spT + (size_t)((bh * 64 + c) * 128 + row) * 128 + ch * 8); }
#pragma unroll
    for (int k = 0; k < 2; ++k) { const int i = tid + NTHR * k, row = i >> 3, ch = i & 7; p.c[8 + k] = *(const u32x4*)(vT + (size_t)(bh * 128 + row) * SEQ + c * 64 + ch * 8); }
    { const int tok = tid >> 3, d16 = (tid & 7) * 16; const size_t off = (Tb + tok) * 512 + h * 128 + d16; p.g0 = *(const u32x4*)(gs + off); p.g1 = *(const u32x4*)(gs + off + 8); }
}
DI void ho_put(const HoPre& p, LAS unsigned char* lds, int tid) {
#pragma unroll
    for (int k = 0; k < 2; ++k) { const int i = tid + NTHR * k, row = i >> 4, ch = i & 15; *(LAS u32x4*)(lds + HO_Q + row * 272 + ch * 16) = p.c[k]; *(LAS u32x4*)(lds + HO_K + row * 272 + ch * 16) = p.c[2 + k]; }
#pragma unroll
    for (int k = 0; k < 4; ++k) { const int i = tid + NTHR * k, row = i >> 4, ch = i & 15; *(LAS u32x4*)(lds + HO_S + row * 272 + ch * 16) = p.c[4 + k]; }
#pragma unroll
    for (int k = 0; k < 2; ++k) { const int i = tid + NTHR * k, row = i >> 3, ch = i & 7; *(LAS u32x4*)(lds + HO_V + row * 144 + ch * 16) = p.c[8 + k]; }
}
DI void hgrn_out_phase(const bf16_t* qd, const bf16_t* kinv, const bf16_t* vT, const bf16_t* spT, const bf16_t* gs, bf16_t* yh, LAS unsigned char* lds, int vb, int G) {
    int tid_ = threadIdx.x; asm volatile("" : "+v"(tid_));
    const int tid = tid_, lane = tid & 63, wave = __builtin_amdgcn_readfirstlane(tid >> 6), r = lane & 31, hh = lane >> 5, tb = wave >> 2, db = wave & 3;
    LAS float* zs = (LAS float*)(lds + HO_Z);
    HoPre pre;
    if (vb < 64 * 64) ho_fetch(pre, qd, kinv, vT, spT, gs, vb, tid);
    for (int u = vb; u < 64 * 64; u += G) {
        const int bh = u >> 6, c = u & 63, b = bh >> 2, h = bh & 3; const size_t Tb = (size_t)b * SEQ + c * 64;
        ho_put(pre, lds, tid);
        const u32x4 g0 = pre.g0, g1 = pre.g1;
        __syncthreads();
        { const int un = (u + G < 64 * 64) ? u + G : u; ho_fetch(pre, qd, kinv, vT, spT, gs, un, tid); }
        f32x16 Z;
#pragma unroll
        for (int q = 0; q < 16; ++q) Z[q] = 0.f;
        const LAS unsigned char* qb_ = lds + HO_Q + (32 * tb + r) * 272 + 16 * hh;
        bf16x8 qf[8];
#pragma unroll
        for (int ks = 0; ks < 8; ++ks) qf[ks] = *(const LAS bf16x8*)(qb_ + 32 * ks);
        { const LAS unsigned char* sb_ = lds + HO_S + (32 * db + r) * 272 + 16 * hh;
#pragma unroll
          for (int ks = 0; ks < 8; ++ks) Z = MFMA32(qf[ks], *(const LAS bf16x8*)(sb_ + 32 * ks), Z); }
#pragma unroll
        for (int sb = 0; sb < 2; ++sb) if (sb <= tb) {
            f32x16 X;
#pragma unroll
            for (int q = 0; q < 16; ++q) X[q] = 0.f;
            const LAS unsigned char* kb_ = lds + HO_K + (32 * sb + r) * 272 + 16 * hh;
#pragma unroll
            for (int ks = 0; ks < 8; ++ks) X = MFMA32(*(const LAS bf16x8*)(kb_ + 32 * ks), qf[ks], X);
            if (sb == tb) {
#pragma unroll
                for (int q = 0; q < 16; ++q) if (crow(q, hh) > r) X[q] = 0.f;
            }
#pragma unroll
            for (int s2 = 0; s2 < 2; ++s2) {
                u32x4 pa_; pa_.x = pk_bf16(X[8 * s2], X[8 * s2 + 1]); pa_.y = pk_bf16(X[8 * s2 + 2], X[8 * s2 + 3]); pa_.z = pk_bf16(X[8 * s2 + 4], X[8 * s2 + 5]); pa_.w = pk_bf16(X[8 * s2 + 6], X[8 * s2 + 7]);
                const LAS unsigned char* vp = lds + HO_V + (32 * db + r) * 144 + (32 * sb + 16 * s2 + 4 * hh) * 2;
                const u32x2 v0 = *(const LAS u32x2*)vp, v1 = *(const LAS u32x2*)(vp + 16);
                u32x4 pb_; pb_.x = v0.x; pb_.y = v0.y; pb_.z = v1.x; pb_.w = v1.y;
                Z = MFMA32(__builtin_bit_cast(bf16x8, pa_), __builtin_bit_cast(bf16x8, pb_), Z);
            }
        }
#pragma unroll
        for (int q = 0; q < 16; ++q) zs[(32 * tb + crow(q, hh)) * 132 + 32 * db + r] = Z[q];
        __syncthreads();
        { const int tok = tid >> 3, d16 = (tid & 7) * 16; f32x4 o[4]; float ss = 0.f;
          const size_t off = (Tb + tok) * 512 + h * 128 + d16;
#pragma unroll
          for (int i = 0; i < 4; ++i) { o[i] = *(const LAS f32x4*)(zs + tok * 132 + d16 + 4 * i); ss += (o[i][0] * o[i][0] + o[i][1] * o[i][1]) + (o[i][2] * o[i][2] + o[i][3] * o[i][3]); }
          ss += __shfl_xor(ss, 1); ss += __shfl_xor(ss, 2); ss += __shfl_xor(ss, 4);
          const float rn = __builtin_amdgcn_rsqf(ss * (1.f / 128.f) + EPS);
          u32x4 w0, w1;
          w0.x = pk_bf16(o[0][0] * rn * bflo(g0.x), o[0][1] * rn * bfhi(g0.x)); w0.y = pk_bf16(o[0][2] * rn * bflo(g0.y), o[0][3] * rn * bfhi(g0.y));
          w0.z = pk_bf16(o[1][0] * rn * bflo(g0.z), o[1][1] * rn * bfhi(g0.z)); w0.w = pk_bf16(o[1][2] * rn * bflo(g0.w), o[1][3] * rn * bfhi(g0.w));
          w1.x = pk_bf16(o[2][0] * rn * bflo(g1.x), o[2][1] * rn * bfhi(g1.x)); w1.y = pk_bf16(o[2][2] * rn * bflo(g1.y), o[2][3] * rn * bfhi(g1.y));
          w1.z = pk_bf16(o[3][0] * rn * bflo(g1.z), o[3][1] * rn * bfhi(g1.z)); w1.w = pk_bf16(o[3][2] * rn * bflo(g1.w), o[3][3] * rn * bfhi(g1.w));
          *(u32x4*)(yh + off) = w0; *(u32x4*)(yh + off + 8) = w1; }
    }
    __syncthreads();
}

DI unsigned f2ord(float f) { const unsigned b = __float_as_uint(f); return b ^ ((unsigned)((int)b >> 31) | 0x80000000u); }
DI float ord2f(unsigned k) { const unsigned b = (k & 0x80000000u) ? (k ^ 0x80000000u) : ~k; return __uint_as_float(b); }
DI void ce_desc(unsigned& a, unsigned& b) { const unsigned hi = a > b ? a : b, lo = a > b ? b : a; a = hi; b = lo; }
DI void sort16_desc(unsigned (&a)[16]) {
    constexpr int NI[63] = {0, 2, 0, 1, 1, 4, 6, 4, 5, 5, 0, 2, 2, 1, 3, 3, 1, 3, 5, 8, 10, 8, 9, 9, 12, 14, 12, 13, 13, 8, 10, 10, 9, 11, 11, 9, 11, 13, 0, 4, 4, 2, 6, 6, 2, 6, 10, 1, 5, 5, 3, 7, 7, 3, 7, 11, 1, 3, 5, 7, 9, 11, 13};
    constexpr int NJ[63] = {1, 3, 2, 3, 2, 5, 7, 6, 7, 6, 4, 6, 4, 5, 7, 5, 2, 4, 6, 9, 11, 10, 11, 10, 13, 15, 14, 15, 14, 12, 14, 12, 13, 15, 13, 10, 12, 14, 8, 12, 8, 10, 14, 10, 4, 8, 12, 9, 13, 9, 11, 15, 11, 5, 9, 13, 2, 4, 6, 8, 10, 12, 14};
#pragma unroll
    for (int c = 0; c < 63; ++c) ce_desc(a[NI[c]], a[NJ[c]]);
}
DI void merge16_desc(unsigned (&a)[16], const unsigned (&b)[16]) {
#pragma unroll
    for (int i = 0; i < 16; ++i) a[i] = a[i] > b[15 - i] ? a[i] : b[15 - i];
#pragma unroll
    for (int j = 8; j > 0; j >>= 1)
#pragma unroll
        for (int i = 0; i < 16; ++i) { const int l = i ^ j; if (l > i) ce_desc(a[i], a[l]); }
}
#define TK_INS(L, x) do { unsigned t_ = (x); _Pragma("unroll") for (int j_ = 0; j_ < 16; ++j_) { const unsigned hi_ = L[j_] > t_ ? L[j_] : t_; t_ = L[j_] > t_ ? t_ : L[j_]; L[j_] = hi_; } } while (0)

DI void topk_stage_keys(const bf16_t* keysb, LAS unsigned char* kl, int h) {
    for (int c = threadIdx.x; c < 2 * 128 * 16; c += NTHR) { const int p = c >> 11, row = (c >> 4) & 127, ch = c & 15;
        *(LAS u32x4*)(kl + (p * 128 + row) * 272 + ch * 16) = *(const u32x4*)(keysb + ((size_t)(p * 8 + h) * 128 + row) * 128 + ch * 8); }
}
DI void topk_unit(const bf16_t* qp, const LAS unsigned char* kl, unsigned short* gidx, float* ggate, LAS unsigned* tk, int quad, int h) {
    const int tid = threadIdx.x, lane = tid & 63, wave = tid >> 6, p = wave & 1, tsub = wave >> 1, r = lane & 31, hh = lane >> 5;
#pragma unroll 1
    for (int hl = 0; hl < 4; ++hl) {
        const int tok0 = (quad * 4 + hl) * 128 + tsub * 32;
        f32x16 acc[4];
#pragma unroll
        for (int kb = 0; kb < 4; ++kb)
#pragma unroll
            for (int i = 0; i < 16; ++i) acc[kb][i] = 16.f;
#ifdef T_MPRIO
        __builtin_amdgcn_s_setprio(T_MPRIO);
#endif
        const bf16_t* qrow = qp + (size_t)(tok0 + r) * 2048 + h * 256 + p * 128 + 8 * hh;
        const LAS unsigned char* kbase = kl + (p * 128 + r) * 272 + 16 * hh;
#pragma unroll
        for (int s = 0; s < 8; ++s) { const bf16x8 bq = *(const bf16x8*)(qrow + 16 * s);
#pragma unroll
            for (int kb = 0; kb < 4; ++kb) { const bf16x8 ak = *(const LAS bf16x8*)(kbase + kb * 32 * 272 + 32 * s); acc[kb] = MFMA32(ak, bq, acc[kb]); } }
#ifdef T_MPRIO
        __builtin_amdgcn_s_setprio(0);
#endif
        unsigned A0[16], A1[16], A2[16], A3[16];
#pragma unroll
        for (int i = 0; i < 16; ++i) { const unsigned ki = (unsigned)(crow(i, hh));
            A0[i] = (__float_as_uint(fmaxf(acc[0][i], 0.f)) & ~127u) | ki; A1[i] = (__float_as_uint(fmaxf(acc[1][i], 0.f)) & ~127u) | (32u + ki); A2[i] = (__float_as_uint(fmaxf(acc[2][i], 0.f)) & ~127u) | (64u + ki); A3[i] = (__float_as_uint(fmaxf(acc[3][i], 0.f)) & ~127u) | (96u + ki); }
        sort16_desc(A0); sort16_desc(A1); sort16_desc(A2); sort16_desc(A3);
        merge16_desc(A0, A1); merge16_desc(A2, A3); merge16_desc(A0, A2);
#pragma unroll
        for (int j = 0; j < 16; ++j) A1[j] = __shfl_xor(A0[j], 32);
        merge16_desc(A0, A1);
        if (hh == 0) { LAS u32x4* dst = (LAS u32x4*)(tk + (((hl * 2 + p) * 128 + tsub * 32 + r) * 16));
#pragma unroll
            for (int c = 0; c < 4; ++c) { u32x4 w = {A0[4 * c], A0[4 * c + 1], A0[4 * c + 2], A0[4 * c + 3]}; dst[c] = w; } }
    }
    __syncthreads();
    {
        const int tok = tid & 127, hl = tid >> 7, tile = quad * 4 + hl;
        const LAS unsigned* t1 = tk + ((hl * 2 + 0) * 128 + tok) * 16; const LAS unsigned* t2 = tk + ((hl * 2 + 1) * 128 + tok) * 16;
        float v1[16], v2[16];
        { const LAS u32x4* s1 = (const LAS u32x4*)t1; const LAS u32x4* s2 = (const LAS u32x4*)t2;
#pragma unroll
          for (int c = 0; c < 4; ++c) { const u32x4 a = s1[c], b = s2[c];
              v1[4 * c] = __uint_as_float(a.x & ~127u) - 12.f; v1[4 * c + 1] = __uint_as_float(a.y & ~127u) - 12.f; v1[4 * c + 2] = __uint_as_float(a.z & ~127u) - 12.f; v1[4 * c + 3] = __uint_as_float(a.w & ~127u) - 12.f;
              v2[4 * c] = __uint_as_float(b.x & ~127u) - 12.f; v2[4 * c + 1] = __uint_as_float(b.y & ~127u) - 12.f; v2[4 * c + 2] = __uint_as_float(b.z & ~127u) - 12.f; v2[4 * c + 3] = __uint_as_float(b.w & ~127u) - 12.f; } }
#define CKEY(i, j) ((__float_as_uint(fmaxf(v1[i] + v2[j], 0.f)) & ~255u) | (unsigned)((i) * 16 + (j)))
        unsigned C[16], D[16], E[16];
#pragma unroll
        for (int j = 0; j < 16; ++j) C[j] = CKEY(0, j);
#pragma unroll
        for (int j = 0; j < 8; ++j) D[j] = CKEY(1, j);
#pragma unroll
        for (int j = 0; j < 5; ++j) D[8 + j] = CKEY(2, j);
#pragma unroll
        for (int j = 0; j < 3; ++j) D[13 + j] = CKEY(4, j);
#pragma unroll
        for (int j = 0; j < 4; ++j) E[j] = CKEY(3, j);
        E[4] = CKEY(5, 0); E[5] = CKEY(5, 1); E[6] = CKEY(6, 0); E[7] = CKEY(6, 1); E[8] = CKEY(7, 0); E[9] = CKEY(7, 1);
        E[10] = CKEY(8, 0); E[11] = CKEY(9, 0); E[12] = CKEY(10, 0); E[13] = CKEY(11, 0); E[14] = CKEY(12, 0); E[15] = CKEY(13, 0);
        sort16_desc(D); sort16_desc(E);
        TK_INS(E, CKEY(14, 0)); TK_INS(E, CKEY(15, 0));
#undef CKEY
        merge16_desc(C, D); merge16_desc(C, E);
        float sc[16]; unsigned ei[16]; float mx = -1e30f;
#pragma unroll
        for (int q = 0; q < 16; ++q) { const unsigned ij = C[q] & 255u; const unsigned a = t1[ij >> 4], b = t2[ij & 15u];
            sc[q] = (__uint_as_float(a & ~127u) - 16.f) + (__uint_as_float(b & ~127u) - 16.f); ei[q] = (a & 127u) * 128u + (b & 127u); mx = fmaxf(mx, sc[q]); }
        float sum = 0.f;
#pragma unroll
        for (int q = 0; q < 16; ++q) { sc[q] = __expf(sc[q] - mx); sum += sc[q]; }
        const float inv = 1.f / sum; const size_t o = (size_t)(tile * 128 + tok) * 128 + h * 16;
        u32x4 w0, w1;
        w0.x = ei[0] | (ei[1] << 16); w0.y = ei[2] | (ei[3] << 16); w0.z = ei[4] | (ei[5] << 16); w0.w = ei[6] | (ei[7] << 16);
        w1.x = ei[8] | (ei[9] << 16); w1.y = ei[10] | (ei[11] << 16); w1.z = ei[12] | (ei[13] << 16); w1.w = ei[14] | (ei[15] << 16);
        *(u32x4*)(gidx + o) = w0; *(u32x4*)(gidx + o + 8) = w1;
#pragma unroll
        for (int c = 0; c < 4; ++c) *(f32x4*)(ggate + o + 4 * c) = (f32x4){sc[4 * c] * inv, sc[4 * c + 1] * inv, sc[4 * c + 2] * inv, sc[4 * c + 3] * inv};
    }
    __syncthreads();
}

DI float gelu_erf(float x) { return 0.5f * x * (1.f + erff(x * 0.70710678118654752f)); }
DI void hq_token(const bf16_t* x2row, const float* ssq, unsigned char* hqrow, float* shp, int lane) {
    f32x4 x[4]; float amax = 0.f;
#pragma unroll
    for (int i = 0; i < 4; ++i) { const u32x2 w_ = *(const u32x2*)(x2row + 16 * lane + 4 * i); x[i] = (f32x4){bflo(w_.x), bfhi(w_.x), bflo(w_.y), bfhi(w_.y)}; amax = fmaxf(fmaxf(amax, fmaxf(fabsf(x[i][0]), fabsf(x[i][1]))), fmaxf(fabsf(x[i][2]), fabsf(x[i][3]))); }
    float ss = (lane < 16) ? ssq[lane] : 0.f; ss = wave_sum(ss);
    const float rstd2 = __builtin_amdgcn_rsqf(ss * (1.f / 1024.f) + EPS);
    amax = wave_max(amax);
    amax *= rstd2;
    const float qs = amax > 0.f ? 119.f / amax : 0.f, xq = rstd2 * qs;
    unsigned hh[2] = {0u, 0u}, hl[2] = {0u, 0u};
#pragma unroll
    for (int i = 0; i < 16; ++i) { const int q_ = (int)rintf(x[i >> 2][i & 3] * xq), l_ = ((q_ + 8) & 15) - 8, h_ = (q_ - l_) >> 4;
        hl[i >> 3] |= ((unsigned)l_ & 15u) << (4 * (i & 7)); hh[i >> 3] |= ((unsigned)h_ & 15u) << (4 * (i & 7)); }
    unsigned char* cp = hqrow + (lane >> 1) * 32 + (lane & 1) * 8;
    *(u32x2*)cp = (u32x2){hh[0], hh[1]}; *(u32x2*)(cp + 16) = (u32x2){hl[0], hl[1]};
    if (lane == 0) *shp = amax * (1.f / 119.f);
}
template <int CTRL> DI int dpp_i(int v) { return __builtin_amdgcn_mov_dpp(v, CTRL, 0xf, 0xf, true); }
template <int CTRL> DI float dpp_f(float v) { return __int_as_float(__builtin_amdgcn_mov_dpp(__float_as_int(v), CTRL, 0xf, 0xf, true)); }
DI float swapadd32(float a, float b) { const auto r = __builtin_amdgcn_permlane32_swap(__float_as_uint(a), __float_as_uint(b), false, false); return __uint_as_float(r[0]) + __uint_as_float(r[1]); }
DI float swapadd16(float a, float b) { const auto r = __builtin_amdgcn_permlane16_swap(__float_as_uint(a), __float_as_uint(b), false, false); return __uint_as_float(r[0]) + __uint_as_float(r[1]); }

struct SMeta { u32x4 i0, i1, a0, a1; unsigned xw; };
template <int RS> DI void slice_issue(u32x4 (&r)[16], const SMeta& m, const unsigned char* base) {
    const unsigned iw[8] = {m.i0.x, m.i0.y, m.i0.z, m.i0.w, m.i1.x, m.i1.y, m.i1.z, m.i1.w};
#pragma unroll
    for (int j = 0; j < 16; ++j) { const unsigned idx = (j & 1) ? (iw[j >> 1] >> 16) : (iw[j >> 1] & 0xffffu); r[j] = *(const u32x4*)(base + (size_t)idx * RS); }
}
DI void slice_u_compute(const SMeta& m, const u32x4 (&r)[16], int* actp, int lane) {
    const int hh[4] = {(int)m.a0.x, (int)m.a0.y, (int)m.a0.z, (int)m.a0.w}, hl[4] = {(int)m.a1.x, (int)m.a1.y, (int)m.a1.z, (int)m.a1.w};
    int part[16];
#ifdef U_PRIO
    __builtin_amdgcn_s_setprio(U_PRIO);
#endif
#pragma unroll
    for (int j = 0; j < 16; ++j) { int ah = 0, al = 0;
#pragma unroll
        for (int g = 0; g < 4; ++g) { ah = __builtin_amdgcn_sdot8((int)r[j][g], hh[g], ah, false); al = __builtin_amdgcn_sdot8((int)r[j][g], hl[g], al, false); }
        part[j] = (ah << 4) + al; }
    int r8[8], r4[4], r2[2];
    { const bool up_ = (lane & 4) != 0;
#pragma unroll
      for (int i = 0; i < 8; ++i) { const int keep = up_ ? part[i + 8] : part[i], send = up_ ? part[i] : part[i + 8]; r8[i] = keep + dpp_i<0x141>(send); } }
    { const bool up_ = (lane & 2) != 0;
#pragma unroll
      for (int i = 0; i < 4; ++i) { const int keep = up_ ? r8[i + 4] : r8[i], send = up_ ? r8[i] : r8[i + 4]; r4[i] = keep + dpp_i<0x4E>(send); } }
    { const bool up_ = (lane & 1) != 0;
#pragma unroll
      for (int i = 0; i < 2; ++i) { const int keep = up_ ? r4[i + 2] : r4[i], send = up_ ? r4[i] : r4[i + 2]; r2[i] = keep + dpp_i<0xB1>(send); } }
#ifdef U_PRIO
    __builtin_amdgcn_s_setprio(0);
#endif
    actp[lane] = (int)((unsigned)(((r2[0] + 4) >> 3) & 0xffff) | ((unsigned)((r2[1] + 4) >> 3) << 16));
}
DI int swapadd32i(int a, int b) { const auto r = __builtin_amdgcn_permlane32_swap((unsigned)a, (unsigned)b, false, false); return (int)r[0] + (int)r[1]; }
DI int swapadd16i(int a, int b) { const auto r = __builtin_amdgcn_permlane16_swap((unsigned)a, (unsigned)b, false, false); return (int)r[0] + (int)r[1]; }
DI void slice_v_compute(const SMeta& m, const u32x4 (&r)[16], float* x3row, float* ssq3p, int sl, int lane) {
    const int wq[4] = {(int)m.a0.x, (int)m.a0.y, (int)m.a0.z, (int)m.a0.w};
    const float sw = __uint_as_float(m.a1.x);
    int o[32];
#pragma unroll
    for (int i = 0; i < 32; ++i) o[i] = 0;
#pragma unroll
    for (int q = 0; q < 4; ++q)
#pragma unroll
        for (int p = 0; p < 4; ++p) {
            const unsigned d0 = r[4 * q][p], d1 = r[4 * q + 1][p], d2 = r[4 * q + 2][p], d3 = r[4 * q + 3][p];
            const unsigned t0 = __builtin_amdgcn_perm(d1, d0, 0x05010400u), t1 = __builtin_amdgcn_perm(d1, d0, 0x07030602u), t2 = __builtin_amdgcn_perm(d3, d2, 0x05010400u), t3 = __builtin_amdgcn_perm(d3, d2, 0x07030602u);
            const unsigned e0 = __builtin_amdgcn_perm(t2, t0, 0x05040100u), e1 = __builtin_amdgcn_perm(t2, t0, 0x07060302u), e2 = __builtin_amdgcn_perm(t3, t1, 0x05040100u), e3 = __builtin_amdgcn_perm(t3, t1, 0x07060302u);
            o[8 * p + 0] = __builtin_amdgcn_sdot4((int)(e0 & 0x0F0F0F0Fu), wq[q], o[8 * p + 0], false); o[8 * p + 1] = __builtin_amdgcn_sdot4((int)e0, wq[q], o[8 * p + 1], false);
            o[8 * p + 2] = __builtin_amdgcn_sdot4((int)(e1 & 0x0F0F0F0Fu), wq[q], o[8 * p + 2], false); o[8 * p + 3] = __builtin_amdgcn_sdot4((int)e1, wq[q], o[8 * p + 3], false);
            o[8 * p + 4] = __builtin_amdgcn_sdot4((int)(e2 & 0x0F0F0F0Fu), wq[q], o[8 * p + 4], false); o[8 * p + 5] = __builtin_amdgcn_sdot4((int)e2, wq[q], o[8 * p + 5], false);
            o[8 * p + 6] = __builtin_amdgcn_sdot4((int)(e3 & 0x0F0F0F0Fu), wq[q], o[8 * p + 6], false); o[8 * p + 7] = __builtin_amdgcn_sdot4((int)e3, wq[q], o[8 * p + 7], false);
        }
    int wt = 0;
#pragma unroll
    for (int q = 0; q < 4; ++q) wt = __builtin_amdgcn_sdot4(wq[q], 0x01010101, wt, false);
    wt += dpp_i<0x128>(wt); wt = swapadd16i(wt, wt); wt = swapadd32i(wt, wt); wt *= 8;
    int a16[16], a8[8], a4[4];
#pragma unroll
    for (int i = 0; i < 16; ++i) a16[i] = swapadd32i(o[i], o[16 + i]);
#pragma unroll
    for (int i = 0; i < 8; ++i) a8[i] = swapadd16i(a16[i], a16[i + 8]);
    { const bool up_ = (lane & 8) != 0;
#pragma unroll
      for (int i = 0; i < 4; ++i) { const int keep = up_ ? a8[i + 4] : a8[i], send = up_ ? a8[i] : a8[i + 4]; a4[i] = keep + dpp_i<0x128>(send); } }
    const int col = 32 * (lane & 7) + ((lane >> 5) & 1) * 16 + ((lane >> 4) & 1) * 8 + ((lane >> 3) & 1) * 4;
    const f32x4 y = {bflo(m.xw) + (float)(a4[0] - wt) * sw, bfhi(m.xw) + (float)((a4[1] - a4[0]) >> 4) * sw, bflo(m.a1.y) + (float)(a4[2] - wt) * sw, bfhi(m.a1.y) + (float)((a4[3] - a4[2]) >> 4) * sw};
    *(f32x4*)(x3row + 256 * sl + col) = y;
    const float ss = wave_sum((y[0] * y[0] + y[1] * y[1]) + (y[2] * y[2] + y[3] * y[3]));
    if (lane == 0) ssq3p[sl] = ss;
}
template <int MODE> DI void slice_pass(unsigned char* ws, float* out, int xs, int gw_, int nw_, int lane) {
    const int g = lane >> 3, c = lane & 7;
    const int sl = xs >> 1, tmul = 2, tadd = xs & 1, TT = T / tmul;
    const unsigned short* gidx = (const unsigned short*)(ws + WS_GIDX) + 16 * g;
    const unsigned char* tab = (MODE == 0 ? (const unsigned char*)(ws + WS_U8) : (const unsigned char*)(ws + WS_V8)) + 128 * sl + 16 * c;
    const unsigned char* hqb = (const unsigned char*)(ws + WS_HQ) + 256 * sl + 32 * c;
    const unsigned char* wxb = (const unsigned char*)(ws + WS_WX) + 16 * g;
    const bf16_t* x2b = (const bf16_t*)(ws + WS_X2B) + 256 * sl + 32 * c + ((lane >> 5) & 1) * 16 + ((lane >> 4) & 1) * 8 + ((lane >> 3) & 1) * 4;
#define S_LOAD(m, tok) do { const unsigned short* ip = gidx + (size_t)(tok) * 128; (m).i0 = *(const u32x4*)ip; (m).i1 = *(const u32x4*)(ip + 8); \
        if (MODE == 0) { const unsigned char* hp_ = hqb + (size_t)(tok) * 1024; (m).a0 = *(const u32x4*)hp_; (m).a1 = *(const u32x4*)(hp_ + 16); } \
        else { (m).a0 = *(const u32x4*)(wxb + (size_t)(tok) * 128); (m).a1.x = __float_as_uint(((const float*)(ws + WS_SW))[tok]); { const u32x2 x_ = *(const u32x2*)(x2b + (size_t)(tok) * DM); (m).xw = x_.x; (m).a1.y = x_.y; } } } while (0)
#define S_COMPUTE(m, r, tok) do { if (MODE == 0) slice_u_compute(m, r, (int*)(ws + WS_ACTP) + ((size_t)(tok) * 4 + sl) * 64, lane); \
        else slice_v_compute(m, r, out + (size_t)(tok) * DM, (float*)(ws + WS_SSQ3) + (size_t)(tok) * 4, sl, lane); } while (0)
#define S_ISSUE(r, m) slice_issue<512>(r, m, tab)
    SMeta mA, mB, mN; u32x4 rA[16], rB[16];
    if (gw_ >= TT) return;
    const int n = (TT - gw_ + nw_ - 1) / nw_;
#define S_TK(j) ((gw_ + ((j) < n ? (j) : n - 1) * nw_) * tmul + tadd)
    S_LOAD(mA, S_TK(0)); S_ISSUE(rA, mA); S_LOAD(mB, S_TK(1));
#ifdef S_MPRIO
#define S_MP(x) __builtin_amdgcn_s_setprio(x)
#else
#define S_MP(x)
#endif
    for (int i = 0; i < n; i += 2) {
        S_MP(S_MPRIO); S_ISSUE(rB, mB);
        S_LOAD(mN, S_TK(i + 2)); S_MP(0);
        S_COMPUTE(mA, rA, S_TK(i));
        S_MP(S_MPRIO); mA = mN; S_ISSUE(rA, mA);
        S_LOAD(mN, S_TK(i + 3)); S_MP(0);
        if (i + 1 < n) S_COMPUTE(mB, rB, S_TK(i + 1));
        mB = mN;
    }
#undef S_MP
#undef S_TK
#undef S_LOAD
#undef S_COMPUTE
#undef S_ISSUE
}
typedef int v2i32_t __attribute__((ext_vector_type(2)));
struct VCm { unsigned wd; u32x2 x2; f32x2 sw; };
DI void slice_v2_compute(LAS unsigned char* itr0, LAS unsigned char* itr1, LAS unsigned* wbuf, const VCm& cm, bf16_t* x3row, float* ssq3p, int sl, int lane) {
    int aL[2][2] = {{0, 0}, {0, 0}}, aF[2][2] = {{0, 0}, {0, 0}};
#ifndef VDEPTH
#define VDEPTH 8
#endif
    constexpr int NG = 32 / VDEPTH;
    u32x2 d[2][VDEPTH]; u32x4 w4[2][VDEPTH / 4];
#define V_RD(gi) do { _Pragma("unroll") for (int e = 0; e < VDEPTH / 4; ++e) w4[(gi) & 1][e] = *(const LAS u32x4*)(wbuf + 4 * ((VDEPTH / 4) * (gi) + e)); asm volatile("" ::: "memory"); \
        _Pragma("unroll") for (int e = 0; e < VDEPTH; ++e) d[(gi) & 1][e] = __builtin_bit_cast(u32x2, __builtin_amdgcn_ds_read_tr8_b64_v2i32((LAS v2i32_t*)(((e & 1) ? itr1 : itr0) + 1024 * ((VDEPTH / 2) * (gi) + (e >> 1))))); } while (0)
    V_RD(0);
#pragma unroll
    for (int gi = 0; gi < NG; ++gi) {
        if (gi + 1 < NG) V_RD(gi + 1);
        asm volatile("" ::: "memory");
#ifdef V_PRIO
        if (gi == 0) __builtin_amdgcn_s_setprio(V_PRIO);
#endif
#pragma unroll
        for (int e = 0; e < VDEPTH; ++e) {
            const u32x2 dd = d[gi & 1][e];
            const int wi = 2 * (e >> 1), h = e & 1;
            const int w0 = (int)w4[gi & 1][wi >> 2][wi & 3], w1 = (int)w4[gi & 1][(wi + 1) >> 2][(wi + 1) & 3];
            aL[h][0] = __builtin_amdgcn_sdot4((int)(dd.x & 0x0F0F0F0Fu), w0, aL[h][0], false); aF[h][0] = __builtin_amdgcn_sdot4((int)dd.x, w0, aF[h][0], false);
            aL[h][1] = __builtin_amdgcn_sdot4((int)(dd.y & 0x0F0F0F0Fu), w1, aL[h][1], false); aF[h][1] = __builtin_amdgcn_sdot4((int)dd.y, w1, aF[h][1], false);
        }
    }
#undef V_RD
#ifdef V_PRIO
    __builtin_amdgcn_s_setprio(0);
#endif
#ifdef V_TPRIO
    __builtin_amdgcn_s_setprio(V_TPRIO);
#endif
    const int L0 = aL[0][0] + aL[0][1], F0 = aF[0][0] + aF[0][1], L1 = aL[1][0] + aL[1][1], F1 = aF[1][0] + aF[1][1];
    const float sw = cm.sw[0], wt = cm.sw[1];
    const f32x2 ya = {bflo(cm.x2.x) + ((float)L0 - wt) * sw, bfhi(cm.x2.x) + (float)((F0 - L0) >> 4) * sw}, yb = {bflo(cm.x2.y) + ((float)L1 - wt) * sw, bfhi(cm.x2.y) + (float)((F1 - L1) >> 4) * sw};
#ifdef V_NT_STORE
    __builtin_nontemporal_store(pk_bf16(ya[0], ya[1]), (unsigned*)(x3row + 256 * sl + 2 * lane)); __builtin_nontemporal_store(pk_bf16(yb[0], yb[1]), (unsigned*)(x3row + 256 * sl + 128 + 2 * lane));
#else
    *(unsigned*)(x3row + 256 * sl + 2 * lane) = pk_bf16(ya[0], ya[1]); *(unsigned*)(x3row + 256 * sl + 128 + 2 * lane) = pk_bf16(yb[0], yb[1]);
#endif
    const float ss = wave_sum((ya[0] * ya[0] + ya[1] * ya[1]) + (yb[0] * yb[0] + yb[1] * yb[1]));
    if (lane == 0) ssq3p[sl] = ss;
}
template <int PM> DI void slice_pass_v(unsigned char* ws, bf16_t* out, float* ssq3, LAS unsigned char* lds, int wave, int xs, int gw_, int nw_, int lane) {
    const int g = lane >> 3, c = lane & 7;
    const int sl = xs >> 1, tmul = 2, tadd = xs & 1, TT = T / tmul;
    const unsigned short* gidx = (const unsigned short*)(ws + WS_GIDX) + 16 * g;
    const unsigned char* tab = (const unsigned char*)(ws + WS_V8) + 128 * sl + 16 * c;
    const unsigned* wx32 = (const unsigned*)(ws + WS_WX) + (lane & 31);
    const bf16_t* x2b = (const bf16_t*)(ws + WS_X2B) + 256 * sl + 2 * lane;
    const f32x2* swp = (const f32x2*)(ws + WS_SW);
    LAS unsigned char* img = lds + wave * 16384;
    LAS unsigned char* iw0 = img + g * 2048 + 16 * c, *iw1 = img + g * 2048 + 16 * (c ^ 2), *iw2 = img + g * 2048 + 16 * (c ^ 4), *iw3 = img + g * 2048 + 16 * (c ^ 6);
    const int q = (lane >> 1) & 7, Q = lane >> 4, p = lane & 1;
    LAS unsigned char* itr0 = img + q * 128 + 16 * (Q ^ (q & 6)) + 8 * p;
    LAS unsigned char* itr1 = img + q * 128 + 16 * ((4 + Q) ^ (q & 6)) + 8 * p;
    LAS unsigned* wbuf = (LAS unsigned*)(lds + 131072 + wave * 128);
    if (gw_ >= TT) return;
    const int n = (TT - gw_ + nw_ - 1) / nw_;
#ifndef VREP
#define VREP 1
#endif
    const int nn = n * VREP;
#define V_TK(j) ((gw_ + (((j) < nn ? (j) : nn - 1) % n) * nw_) * tmul + tadd)
#define V_IDX(m, tok) do { const unsigned short* ip = gidx + (size_t)(tok) * 128; (m).i0 = *(const u32x4*)ip; (m).i1 = *(const u32x4*)(ip + 8); } while (0)
#define V_CM(cm, tok) do { (cm).wd = wx32[(size_t)(tok) * 32]; (cm).x2.x = *(const unsigned*)(x2b + (size_t)(tok) * DM); (cm).x2.y = *(const unsigned*)(x2b + (size_t)(tok) * DM + 128); (cm).sw = swp[tok]; } while (0)
#define V_STAGE(r, cm) do { if (PM != 1) { _Pragma("unroll") for (int j = 0; j < 16; ++j) *(LAS u32x4*)((((j >> 1) & 3) == 0 ? iw0 : ((j >> 1) & 3) == 1 ? iw1 : ((j >> 1) & 3) == 2 ? iw2 : iw3) + 128 * j) = r[j]; } wbuf[lane & 31] = (cm).wd; asm volatile("" ::: "memory"); } while (0)
#define V_COMPUTE(cm, tok) do { if (PM != 2) slice_v2_compute(itr0, itr1, wbuf, cm, out + (size_t)(tok) * DM, ssq3 + (size_t)(tok) * 4, sl, lane); asm volatile("" ::: "memory"); } while (0)
#define V_ISS(r, m) do { if (PM != 1) slice_issue<512>(r, m, tab); } while (0)
    SMeta mE, mO; VCm cE, cO; u32x4 rE[16], rO[16];
#ifdef V_STAGGER
    if (wave >= 4) { _Pragma("unroll") for (int z = 0; z < V_STAGGER; ++z) __builtin_amdgcn_s_sleep(16); }
#endif
    V_IDX(mE, V_TK(0)); V_IDX(mO, V_TK(1));
    asm volatile("" ::: "memory");
    V_ISS(rE, mE); V_IDX(mE, V_TK(2)); V_CM(cE, V_TK(0));
    asm volatile("" ::: "memory");
    V_ISS(rO, mO); V_IDX(mO, V_TK(3)); V_CM(cO, V_TK(1));
    asm volatile("" ::: "memory");
#ifdef V_MPRIO
#define V_MP(x) __builtin_amdgcn_s_setprio(x)
#else
#define V_MP(x)
#endif
    for (int i = 0; i < nn; i += 2) {
        V_MP(V_MPRIO); V_STAGE(rE, cE);
        V_ISS(rE, mE); V_IDX(mE, V_TK(i + 4)); V_MP(0);
        V_COMPUTE(cE, V_TK(i));
        V_CM(cE, V_TK(i + 2));
        V_MP(V_MPRIO); V_STAGE(rO, cO);
        V_ISS(rO, mO); V_IDX(mO, V_TK(i + 5)); V_MP(0);
        if (i + 1 < nn) V_COMPUTE(cO, V_TK(i + 1));
        V_CM(cO, V_TK(i + 3));
    }
#undef V_MP
#undef V_TK
#undef V_ISS
#undef V_IDX
#undef V_CM
#undef V_STAGE
#undef V_COMPUTE
}
DI void expert_w_token(const int* actp, const unsigned short* gidx, const float* ggate, float sh, const float* su, const float* sv, unsigned char* wrow, f32x2* swp, int lane) {
    typedef int i32x2 __attribute__((ext_vector_type(2)));
    i32x2 acc = {0, 0};
#pragma unroll
    for (int x = 0; x < 4; ++x) { const int w_ = actp[x * 64 + lane]; acc[0] += (int)(short)(w_ & 0xffff); acc[1] += w_ >> 16; }
    acc[0] <<= 3; acc[1] <<= 3;
    const unsigned ii = *(const unsigned*)(gidx + 2 * lane); const f32x2 gt = *(const f32x2*)(ggate + 2 * lane);
    const int e0 = ii & 0xffffu, e1 = ii >> 16;
    const float w0 = gelu_erf((float)acc[0] * (su[e0] * sh)) * gt[0] * sv[e0], w1 = gelu_erf((float)acc[1] * (su[e1] * sh)) * gt[1] * sv[e1];
    float amax = fmaxf(fabsf(w0), fabsf(w1));
    amax = fmaxf(amax, dpp_f<0xB1>(amax)); amax = fmaxf(amax, dpp_f<0x4E>(amax)); amax = fmaxf(amax, dpp_f<0x141>(amax)); amax = fmaxf(amax, dpp_f<0x128>(amax));
    { const auto r = __builtin_amdgcn_permlane16_swap(__float_as_uint(amax), __float_as_uint(amax), false, false); amax = fmaxf(__uint_as_float(r[0]), __uint_as_float(r[1])); }
    { const auto r = __builtin_amdgcn_permlane32_swap(__float_as_uint(amax), __float_as_uint(amax), false, false); amax = fmaxf(__uint_as_float(r[0]), __uint_as_float(r[1])); }
    const float qs = amax > 0.f ? 127.f / amax : 0.f;
    const int q0 = (int)rintf(w0 * qs), q1 = (int)rintf(w1 * qs);
    *(unsigned short*)(wrow + 2 * lane) = (unsigned short)((q0 & 255) | ((q1 & 255) << 8));
    const float qsum = wave_sum((float)(q0 + q1));
    if (lane == 0) *swp = f32x2{amax * (1.f / 127.f), 8.f * qsum};
}
DI void final_norm_token(const bf16_t* x3row, float* row, const float* ssq3p, const float* gf, int lane) {
    float ss = (lane < 4) ? ssq3p[lane] : 0.f; ss = wave_sum(ss);
    const float r3 = __builtin_amdgcn_rsqf(ss * (1.f / 1024.f) + EPS);
#pragma unroll
    for (int i = 0; i < 4; ++i) { const u32x2 v = *(const u32x2*)(x3row + 256 * i + 4 * lane); const f32x4 x = {bflo(v.x), bfhi(v.x), bflo(v.y), bfhi(v.y)};
        *(f32x4*)(row + 256 * i + 4 * lane) = x * r3 * *(const f32x4*)(gf + 256 * i + 4 * lane); }
}

#define XB_TMO      128
#define XB_XCNT(j)  (256  + 64 * (j))
#define XB_XSUB(j)  (1280 + 64 * (j))
#define XB_XGEN(j)  (2304 + 64 * (j))
#define XB_TOP      3328
#define XB_TOPGEN   3392
#define XCD_BAR_WORDS 3456
#define XB_SPIN_CAP (1u << 18)

__device__ __forceinline__ unsigned xb_ld(unsigned* p)              { return __hip_atomic_load(p, __ATOMIC_RELAXED, __HIP_MEMORY_SCOPE_AGENT); }
__device__ __forceinline__ unsigned xb_add(unsigned* p, unsigned v) { return __hip_atomic_fetch_add(p, v, __ATOMIC_RELAXED, __HIP_MEMORY_SCOPE_AGENT); }
__device__ __forceinline__ unsigned xb_xcc_id() { return (unsigned)__builtin_amdgcn_s_getreg((3 << 11) | 20) & 0xFu; }
#define XB_SPIN(cond, bar) do { unsigned _sp = 0; while (cond) { __builtin_amdgcn_s_sleep(1); \
    if ((++_sp & 255u) == 0u) { if (xb_ld(&(bar)[XB_TMO])) break; if (_sp > XB_SPIN_CAP) { atomicAdd(&(bar)[XB_TMO], 1u); break; } } } } while (0)

struct XcdBarrier {
    unsigned* bar; unsigned x;
    volatile __attribute__((address_space(3))) unsigned* st;
};

__device__ __forceinline__ XcdBarrier xcd_barrier_post(unsigned* bar, volatile __attribute__((address_space(3))) unsigned* st) {
    XcdBarrier b; b.bar = bar; b.x = xb_xcc_id(); b.st = st;
    if (threadIdx.x == 0) st[2] = xb_add(&bar[XB_XCNT(b.x)], 1u);
    return b;
}
__device__ __forceinline__ void xcd_barrier_complete(unsigned* bar, unsigned x, unsigned& nloc, unsigned& nx) {
    const unsigned G = gridDim.x * gridDim.y * gridDim.z;
    unsigned sum, cnt, mine, sp = 0u;
    for (;;) {
        sum = 0u; cnt = 0u; mine = 0u;
#pragma unroll
        for (unsigned j = 0; j < 16; ++j) { const unsigned c = xb_ld(&bar[XB_XCNT(j)]); sum += c; cnt += (c > 0u) ? 1u : 0u; mine = (j == x) ? c : mine; }
        if (sum == G) break;
        __builtin_amdgcn_s_sleep(1);
        if ((++sp & 255u) == 0u) { if (xb_ld(&bar[XB_TMO])) break; if (sp > XB_SPIN_CAP) { atomicAdd(&bar[XB_TMO], 1u); break; } }
    }
    nloc = mine > 0u ? mine : 1u; nx = cnt > 0u ? cnt : 1u;
}

__device__ __forceinline__ void xcd_barrier(const XcdBarrier& b) {
    asm volatile("s_waitcnt vmcnt(0)" ::: "memory");
    __syncthreads();
    if (threadIdx.x == 0) {
        unsigned* bar = b.bar;
        __builtin_amdgcn_s_waitcnt(0);
        unsigned nloc = b.st[0], nx = b.st[1];
        if (nloc == 0u) { xcd_barrier_complete(bar, b.x, nloc, nx); b.st[0] = nloc; b.st[1] = nx; }
        const unsigned old = xb_add(&bar[XB_XSUB(b.x)], 1u);
        const unsigned gen = old / nloc;
        if (old + 1u == (gen + 1u) * nloc) {
            __builtin_amdgcn_fence(__ATOMIC_RELEASE, "agent");
            asm volatile("s_waitcnt vmcnt(0)" ::: "memory");
            const unsigned og = xb_add(&bar[XB_TOP], 1u);
            const unsigned tg = og / nx;
            if (og + 1u == (tg + 1u) * nx) xb_add(&bar[XB_TOPGEN], 1u);
            else XB_SPIN(xb_ld(&bar[XB_TOPGEN]) == tg, bar);
            __builtin_amdgcn_fence(__ATOMIC_ACQUIRE, "agent");
            xb_add(&bar[XB_XGEN(b.x)], 1u);
            asm volatile("s_waitcnt vmcnt(0)" ::: "memory");
        } else {
            XB_SPIN(xb_ld(&bar[XB_XGEN(b.x)]) == gen, bar);
            __builtin_amdgcn_fence(__ATOMIC_ACQUIRE, "agent");
            asm volatile("s_waitcnt vmcnt(0)" ::: "memory");
        }
    }
    __syncthreads();
}

constexpr int N_PHASES = 13;
__global__ void __launch_bounds__(NTHR, 2) mk_fwd(Args a) {
    extern __shared__ __attribute__((aligned(16))) unsigned char lds_raw[];
    LAS unsigned char* lds = (LAS unsigned char*)lds_raw;
    cg::grid_group grid = cg::this_grid();
    const int G = gridDim.x, vb = blockIdx.x, tid = threadIdx.x, lane = tid & 63, wave = tid >> 6;
    unsigned char* ws = a.ws;
    const int lo = a.ph_lo, hi = a.ph_hi;
    volatile LAS unsigned* MISC = (volatile LAS unsigned*)(lds + LDS_BYTES - 64);
    if (tid < 16) MISC[tid] = 0u;
    __syncthreads();
    const XcdBarrier bar = xcd_barrier_post((unsigned*)(ws + 4096) + lo * XCD_BAR_WORDS, MISC);
#ifndef PHASE_MASK
#define PHASE_MASK 0xFFFF
#endif
#define IN(k) (((PHASE_MASK >> (k)) & 1) && lo <= (k) && (k) < hi)
#ifndef REPEAT_MASK
#define REPEAT_MASK 0
#endif
#define REP(k) for (int rep_ = 0; rep_ < (((REPEAT_MASK) >> (k)) & 1) + 1; ++rep_)
#define SEAM(k) do { if (IN(k) && IN((k) + 1)) { if ((k) == 0) grid.sync(); else xcd_barrier(bar); } } while (0)
    REP(0) if (IN(0)) p0_prologue(a, lds, vb, G);
    SEAM(0);
    REP(1) if (IN(1)) { pg8::Gemm g{(const bf16_t*)(ws + WS_XB), (const bf16_t*)(ws + WS_W1T), T, NIN, 1024}; pg8::StaticOrder S; S.init(T, NIN, G, vb);
        pg8::Epi1 E{(const float*)(ws + WS_RSTD1), (bf16_t*)(ws + WS_PA), (bf16_t*)(ws + WS_GG), (bf16_t*)(ws + WS_QD), (bf16_t*)(ws + WS_KINV), (bf16_t*)(ws + WS_KENDT), (bf16_t*)(ws + WS_VT), (bf16_t*)(ws + WS_GS),
                    (float*)(ws + WS_DEC), (const float*)(ws + WS_LB), (bf16_t*)(ws + WS_AVT), lds + 131072};
        pg8::gemm_phase<pg8::Epi1, pg8::StaticOrder, true, true>(lds, g, S, E); }
    SEAM(1);
    REP(2) if (IN(2)) {
        for (int u0 = vb * 8; u0 < 64 * 64; u0 += G * 8) {
            { int t2_ = threadIdx.x; asm volatile("" : "+v"(t2_)); const int u = u0 + (t2_ >> 6);
              hgrn_prep_unit((bf16_t*)(ws + WS_QD), (bf16_t*)(ws + WS_KINV), lds + (t2_ >> 6) * 18432, (float*)(ws + WS_DEC), (const float*)(ws + WS_LB), u >> 6, u & 63, (t2_ & 63) * 2); }
            __syncthreads();
            for (int j = 0; j < 8; ++j) hgrn_ds_unit(lds + j * 18432, (const bf16_t*)(ws + WS_VT), (bf16_t*)a.out, (u0 + j) >> 6, (u0 + j) & 63);
            __syncthreads();
        }
        for (int u = vb; u < BATCH * (SEQ / 64); u += G) attn_unit((const bf16_t*)(ws + WS_PA), (const bf16_t*)(ws + WS_AVT), a.in[3], (bf16_t*)(ws + WS_YA), lds, u >> 6, u & 63);
    }
    SEAM(2);
    REP(3) if (IN(3)) hgrn_scan((bf16_t*)a.out, (const float*)(ws + WS_DEC), vb, G);
    SEAM(3);
    REP(4) if (IN(4)) hgrn_out_phase((const bf16_t*)(ws + WS_QD), (const bf16_t*)(ws + WS_KINV), (const bf16_t*)(ws + WS_VT), (const bf16_t*)a.out, (const bf16_t*)(ws + WS_GS), (bf16_t*)(ws + WS_YH), lds, vb, G);
    SEAM(4);
    REP(5) if (IN(5)) {
#ifdef P5_STAGGER
        if (vb & 1) { _Pragma("unroll") for (int z = 0; z < P5_STAGGER; ++z) __builtin_amdgcn_s_sleep(127); }
#endif
        { pg8::Gemm g{(const bf16_t*)(ws + WS_YA), (const bf16_t*)(ws + WS_WAPT), T, 1024, 512}; pg8::StaticOrder S; S.init(T, 1024, G, vb);
          pg8::EpiMerge<false> E{(bf16_t*)((unsigned char*)a.out + 128 * MiB), (const bf16_t*)(ws + WS_GG)};
          pg8::gemm_phase<pg8::EpiMerge<false>, pg8::StaticOrder, true, true>(lds, g, S, E); }
        __syncthreads();
        { pg8::Gemm g{(const bf16_t*)(ws + WS_YH), (const bf16_t*)(ws + WS_WHPT), T, 1024, 512}; pg8::StaticOrder S; S.init(T, 1024, G, vb);
          pg8::EpiMerge<true> E{(bf16_t*)((unsigned char*)a.out + 128 * MiB), (const bf16_t*)(ws + WS_GG) + 1024};
          pg8::gemm_phase<pg8::EpiMerge<true>, pg8::StaticOrder, true, true>(lds, g, S, E); }
    }
    SEAM(5);
    REP(6) if (IN(6)) { pg8::Gemm g{(const bf16_t*)((unsigned char*)a.out + 128 * MiB), (const bf16_t*)(ws + WS_WOUTT), T, 1024, 1024}; pg8::StaticOrder S; S.init(T, 1024, G, vb);
        pg8::EpiX2 E{(const bf16_t*)(ws + WS_XB), (bf16_t*)(ws + WS_X2B), (float*)(ws + WS_SSQ2)};
        pg8::gemm_phase<pg8::EpiX2, pg8::StaticOrder, true, true>(lds, g, S, E); }
    SEAM(6);
    REP(7) if (IN(7)) { pg8::Gemm g{(const bf16_t*)(ws + WS_X2B), (const bf16_t*)(ws + WS_WQT), T, 2048, 1024}; pg8::StaticOrder S; S.init(T, 2048, G, vb);
        pg8::EpiQp E{(bf16_t*)(ws + WS_QP), (const float*)(ws + WS_SSQ2)};
        pg8::gemm_phase<pg8::EpiQp, pg8::StaticOrder, true, true>(lds, g, S, E); }
    SEAM(7);
    REP(8) if (IN(8)) { const int per = (1024 + G - 1) / G; int hcur = -1;
        for (int U = vb * per; U < (vb + 1) * per && U < 1024; ++U) { const int h = U >> 7;
            if (h != hcur) { topk_stage_keys((const bf16_t*)(ws + WS_KEYS), lds + 65536, h); hcur = h; __syncthreads(); }
            topk_unit((const bf16_t*)(ws + WS_QP), lds + 65536, (unsigned short*)(ws + WS_GIDX), (float*)(ws + WS_GGATE), (LAS unsigned*)lds, U & 127, h); }
        for (int tok = vb * 8 + wave; tok < T; tok += G * 8) hq_token((const bf16_t*)(ws + WS_X2B) + (size_t)tok * DM, (const float*)(ws + WS_SSQ2) + (size_t)tok * 16, (unsigned char*)(ws + WS_HQ) + (size_t)tok * 1024, (float*)(ws + WS_SH) + tok, lane); }
    SEAM(8);
    if (IN(9) || IN(11)) {
        if (tid == 0) {
            unsigned nloc_ = 0, nx_ = 0; xcd_barrier_complete(bar.bar, bar.x, nloc_, nx_);
            unsigned cj[8], tot = 0; bool all = true;
#pragma unroll
            for (int j = 0; j < 8; ++j) { cj[j] = xb_ld(&bar.bar[XB_XCNT(j)]); tot += cj[j]; all = all && cj[j] > 0u; }
            if (all && tot == (unsigned)G && bar.x < 8u) { MISC[4] = bar.x; MISC[5] = MISC[2]; MISC[6] = cj[bar.x & 7u]; }
            else { const unsigned sl_ = (unsigned)vb & 7u; MISC[4] = sl_; MISC[5] = (unsigned)vb >> 3; MISC[6] = ((unsigned)G - sl_ + 7u) >> 3; }
        }
        __syncthreads();
    }
    REP(9) if (IN(9)) slice_pass<0>(ws, a.out, (int)MISC[4], (int)MISC[5] * 8 + __builtin_amdgcn_readfirstlane(wave), (int)MISC[6] * 8, lane);
    SEAM(9);
    REP(10) if (IN(10)) for (int tok = vb * 8 + wave; tok < T; tok += G * 8)
        expert_w_token((const int*)(ws + WS_ACTP) + (size_t)tok * 256, (const unsigned short*)(ws + WS_GIDX) + (size_t)tok * 128, (const float*)(ws + WS_GGATE) + (size_t)tok * 128, ((const float*)(ws + WS_SH))[tok],
                       (const float*)(ws + WS_SU), (const float*)(ws + WS_SV), (unsigned char*)(ws + WS_WX) + (size_t)tok * 128, (f32x2*)(ws + WS_SW) + tok, lane);
    SEAM(10);
    if (IN(11)) slice_pass_v<0>(ws, (bf16_t*)(ws + WS_X2B), (float*)(ws + WS_SSQ3), lds, __builtin_amdgcn_readfirstlane(wave), (int)MISC[4], (int)MISC[5] * 8 + __builtin_amdgcn_readfirstlane(wave), (int)MISC[6] * 8, lane);
#ifdef PROBE_VPM
    if (IN(11)) slice_pass_v<PROBE_VPM>(ws, (bf16_t*)(ws + WS_QP), (float*)(ws + WS_QP), lds, __builtin_amdgcn_readfirstlane(wave), (int)MISC[4], (int)MISC[5] * 8 + __builtin_amdgcn_readfirstlane(wave), (int)MISC[6] * 8, lane);
#endif
    SEAM(11);
    if (IN(12)) for (int tok = vb * 8 + wave; tok < T; tok += G * 8) final_norm_token((const bf16_t*)(ws + WS_X2B) + (size_t)tok * DM, a.out + (size_t)tok * DM, (const float*)(ws + WS_SSQ3) + (size_t)tok * 4, a.in[14], lane);
#undef IN
#undef SEAM
}

extern "C" void kernel_launch(void* const* d_in, const int* in_sizes, int n_in, void* d_out, int out_size, void* d_ws, size_t ws_size, hipStream_t stream) {
    static int grid = 0;
    if (grid == 0) {
        if (n_in != 15 || in_sizes[0] != T * DM || out_size != T * DM || ws_size < WS_END) { fprintf(stderr, "kernel_launch: unexpected shapes (n_in %d, in0 %d, out %d, ws %zu)\n", n_in, n_in > 0 ? in_sizes[0] : -1, out_size, ws_size); grid = -1; return; }
        int dev = 0, cus = 0, per_cu = 0;
        hipGetDevice(&dev); hipDeviceGetAttribute(&cus, hipDeviceAttributeMultiprocessorCount, dev);
        if (hipFuncSetAttribute((const void*)mk_fwd, hipFuncAttributeMaxDynamicSharedMemorySize, LDS_BYTES) != hipSuccess) { fprintf(stderr, "kernel_launch: hipFuncSetAttribute failed\n"); grid = -1; return; }
        if (hipOccupancyMaxActiveBlocksPerMultiprocessor(&per_cu, (const void*)mk_fwd, NTHR, LDS_BYTES) != hipSuccess || per_cu < 1) { fprintf(stderr, "kernel_launch: occupancy query says %d blocks per CU\n", per_cu); per_cu = 1; }
        (void)hipGetLastError();
        grid = cus;
    }
    if (grid < 0) return;
    if (hipMemsetAsync(d_ws, 0, 256 * 1024, stream) != hipSuccess) { fprintf(stderr, "kernel_launch: hipMemsetAsync failed\n"); return; }
    Args a{};
    for (int i = 0; i < 15; ++i) a.in[i] = (const float*)d_in[i];
    a.out = (float*)d_out; a.ws = (unsigned char*)d_ws;
#if MK_FUSED
    a.ph_lo = 0; a.ph_hi = N_PHASES;
    { void* args[] = {&a}; hipError_t e = hipLaunchCooperativeKernel((const void*)mk_fwd, dim3(grid), dim3(NTHR), args, LDS_BYTES, stream);
      if (e != hipSuccess) fprintf(stderr, "kernel_launch: cooperative launch failed: %s (grid %d)\n", hipGetErrorString(e), grid); }
#else
    for (int p = 0; p < N_PHASES; ++p) { a.ph_lo = p; a.ph_hi = p + 1; void* args[] = {&a};
        hipError_t e = hipLaunchCooperativeKernel((const void*)mk_fwd, dim3(grid), dim3(NTHR), args, LDS_BYTES, stream);
        if (e != hipSuccess) { fprintf(stderr, "kernel_launch: launch of phase %d failed: %s (grid %d)\n", p, hipGetErrorString(e), grid); break; } }
#endif
}
```

```cpp
#include <hip/hip_runtime.h>
#include <hip/hip_cooperative_groups.h>
#include <cstdio>
#include <cstdint>
namespace cg = cooperative_groups;
#define V_MPRIO 1
namespace pg8 {
#define PG8_LAS __attribute__((address_space(3)))
typedef unsigned short bf16_t;
typedef short bf16x8 __attribute__((ext_vector_type(8)));
typedef float f32x4 __attribute__((ext_vector_type(4)));
typedef unsigned u32x4 __attribute__((ext_vector_type(4)));
constexpr int BM = 256, BK = 64, HALF = 128, HTB = HALF * BK * 2  , STAGE_BYTES = 8 * HTB, NXCD = 8, WGM = 8;

__host__ __device__ __forceinline__ int lds_byte(int r, int c) { const int st = (r >> 4) * 2 + (c >> 5), rr = r & 15, cc = c & 31, ob = rr * 64 + cc * 2; return st * 1024 + (ob ^ (((ob >> 9) & 1) << 5)); }
__host__ __device__ __forceinline__ void stage_rc(int b, int& R, int& C) { const int st = b / 1024, sb = b % 1024, swz = sb ^ (((sb >> 9) & 1) << 5); R = (st >> 1) * 16 + swz / 64; C = (st & 1) * 32 + (swz % 64) / 2; }
__host__ __device__ __forceinline__ int perm32(int rho) { const int n = rho >> 4, i = rho & 15; return 8 * (i >> 2) + 4 * n + (i & 3); }

struct Unit { int pm, pn; };
struct Gemm { const bf16_t* A; const bf16_t* Bt; int M, N, K; };

struct StaticOrder {
    int nM, nN, nwg, G, c;
    __host__ __device__ void init(int M, int N, int G_, int c_) { nM = M / BM; nN = N / BM; nwg = nM * nN; G = G_; c = c_; }
    __host__ __device__ bool next(int i, Unit& u) const {
        const long L = (long)i * G + c; if (L >= nwg) return false;
        int wgid = (int)L; { const int q = nwg / NXCD, r = nwg % NXCD, xcd = wgid % NXCD, off = wgid / NXCD; wgid = (xcd < r ? xcd * (q + 1) : r * (q + 1) + (xcd - r) * q) + off; }
        const int nig = WGM * nN, gid = wgid / nig, fm = gid * WGM, gsz = (nM - fm) < WGM ? (nM - fm) : WGM;
        u.pm = fm + ((wgid % nig) % gsz); u.pn = (wgid % nig) / gsz; return true;
    }
    __device__ __forceinline__ void a_ready(const Unit&) const {}
    __device__ __forceinline__ void done(const Unit&) const {}
};

__device__ __forceinline__ unsigned cvt_pk_bf16(float lo, float hi) { unsigned r; asm volatile("v_cvt_pk_bf16_f32 %0, %1, %2" : "=v"(r) : "v"(lo), "v"(hi)); return r; }

template <class Epi, class Sched, bool ALIGN_EPI = false, bool SP2 = false>
__device__ __forceinline__ void gemm_phase(PG8_LAS unsigned char* lds, const Gemm g, const Sched& S, const Epi& E) {
    int tid_ = threadIdx.x; asm volatile("" : "+v"(tid_));
    const int tid = tid_, wid = __builtin_amdgcn_readfirstlane(tid >> 6), lane = tid & 63, wr = wid >> 2, wc = wid & 3, fr = lane & 15, fq = lane >> 4;
    const int K = g.K, nt = K / BK;
    unsigned voffA[2], voffB[2];
#pragma unroll
    for (int i = 0; i < 2; ++i) { int R, C; stage_rc(tid * 16 + i * 8192, R, C); const int Rb = Epi::PERM ? ((R & ~31) + perm32(R & 31)) : R;
        voffA[i] = (unsigned)(R * K + C) * 2u; voffB[i] = (unsigned)(Rb * K + C) * 2u; }
    const size_t kstep = (size_t)(BK * 2);
    const size_t hstep = (size_t)HALF * K * 2;
    const size_t tstep = 2 * hstep;
    const unsigned ldsw = (unsigned)wid * 1024u;
    const int aoff = lds_byte(wr * 64 + fr, fq * 8), boff = lds_byte(wc * 32 + fr, fq * 8);
#define PG8_SA(b, h) (((b) * 2 + (h)) * HTB)
#define PG8_SB(b, h) ((4 + (b) * 2 + (h)) * HTB)
#define PG8_STAGE(bufoff, gbase, voff) do { _Pragma("unroll") for (int _i = 0; _i < 2; ++_i) \
        __builtin_amdgcn_global_load_lds((const unsigned*)((const char*)(gbase) + (voff)[_i]), (PG8_LAS unsigned*)(lds + (bufoff) + ldsw + _i * 8192), 16, 0, 0); } while (0)
#define PG8_LDA(dst, b, h) do { _Pragma("unroll") for (int m = 0; m < 4; ++m) _Pragma("unroll") for (int k = 0; k < 2; ++k) dst[m][k] = *(const PG8_LAS bf16x8*)(lds + PG8_SA(b, h) + aoff + m * 2048 + k * 1024); } while (0)
#define PG8_LDB(dst, b, h) do { _Pragma("unroll") for (int n = 0; n < 2; ++n) _Pragma("unroll") for (int k = 0; k < 2; ++k) dst[n][k] = *(const PG8_LAS bf16x8*)(lds + PG8_SB(b, h) + boff + n * 2048 + k * 1024); } while (0)
#define PG8_MMA(ai, bj, At, Bt) do { __builtin_amdgcn_s_setprio(1); _Pragma("unroll") for (int m = 0; m < 4; ++m) _Pragma("unroll") for (int n = 0; n < 2; ++n) _Pragma("unroll") for (int k = 0; k < 2; ++k) \
        acc[ai][bj][m][n] = __builtin_amdgcn_mfma_f32_16x16x32_bf16(Bt[n][k], At[m][k], acc[ai][bj][m][n], 0, 0, 0); __builtin_amdgcn_s_setprio(0); } while (0)
#define PG8_WAIT_V(n) asm volatile("s_waitcnt vmcnt(" #n ")" ::: "memory")
#define PG8_WAIT_L(n) asm volatile("s_waitcnt lgkmcnt(" #n ")" ::: "memory")
#define PG8_BAR __builtin_amdgcn_s_barrier()
#define PG8_SCHED __builtin_amdgcn_sched_barrier(0)
    Unit cur, nxt; int ui = 0;
    if (!S.next(0, cur)) return;
    f32x4 acc[2][2][4][2];
#pragma unroll
    for (int a = 0; a < 2; ++a)
#pragma unroll
        for (int b = 0; b < 2; ++b)
#pragma unroll
            for (int m = 0; m < 4; ++m)
#pragma unroll
                for (int n = 0; n < 2; ++n) acc[a][b][m][n] = (f32x4){0.f, 0.f, 0.f, 0.f};
    bf16x8 At[4][2], B0[2][2], B1[2][2];
    const char* cA = (const char*)g.A + (size_t)cur.pm * tstep; const char* cB = (const char*)g.Bt + (size_t)cur.pn * tstep;
    S.a_ready(cur);
    if constexpr (SP2) {
        PG8_STAGE(PG8_SB(0, 0), cB, voffB); PG8_STAGE(PG8_SB(0, 1), cB + hstep, voffB); PG8_STAGE(PG8_SA(0, 0), cA, voffA); PG8_STAGE(PG8_SA(0, 1), cA + hstep, voffA);
        if (wr == 1) PG8_BAR;
        PG8_WAIT_V(2); PG8_BAR;
        PG8_STAGE(PG8_SB(1, 0), cB + kstep, voffB); PG8_STAGE(PG8_SA(1, 0), cA + kstep, voffA); PG8_STAGE(PG8_SB(1, 1), cB + hstep + kstep, voffB);
        PG8_WAIT_V(6); PG8_BAR;
    } else {
        PG8_STAGE(PG8_SB(0, 0), cB, voffB); PG8_STAGE(PG8_SA(0, 0), cA, voffA); PG8_STAGE(PG8_SB(0, 1), cB + hstep, voffB); PG8_STAGE(PG8_SA(0, 1), cA + hstep, voffA);
        if (wr == 1) PG8_BAR;
        PG8_WAIT_V(4); PG8_BAR;
        PG8_STAGE(PG8_SB(1, 0), cB + kstep, voffB); PG8_STAGE(PG8_SA(1, 0), cA + kstep, voffA); PG8_STAGE(PG8_SB(1, 1), cB + hstep + kstep, voffB);
        PG8_WAIT_V(6); PG8_BAR;
    }
    for (;;) {
        const bool has_next = S.next(ui + 1, nxt);
        const char* nA = has_next ? (const char*)g.A + (size_t)nxt.pm * tstep : cA; const char* nB = has_next ? (const char*)g.Bt + (size_t)nxt.pn * tstep : cB;
        for (int t = 0; t < nt; t += 2) {
            const bool last = (t == nt - 2);
            const char* a1 = cA + (size_t)(t + 1) * kstep;
            const char* a2 = last ? nA : cA + (size_t)(t + 2) * kstep; const char* b2 = last ? nB : cB + (size_t)(t + 2) * kstep;
            const char* a3 = a2 + kstep; const char* b3 = b2 + kstep;
            if (last && has_next) S.a_ready(nxt);
            if constexpr (SP2) {
            PG8_LDB(B0, 0, 0); PG8_LDB(B1, 0, 1); PG8_SCHED; PG8_LDA(At, 0, 0); PG8_STAGE(PG8_SA(1, 1), a1 + hstep, voffA);
            PG8_WAIT_V(8); PG8_WAIT_L(0); PG8_BAR; PG8_MMA(0, 0, At, B0); PG8_MMA(0, 1, At, B1); PG8_BAR; PG8_SCHED;
            PG8_LDA(At, 0, 1); PG8_STAGE(PG8_SB(0, 0), b2, voffB); PG8_STAGE(PG8_SB(0, 1), b2 + hstep, voffB); PG8_STAGE(PG8_SA(0, 0), a2, voffA);
            PG8_WAIT_V(8); PG8_WAIT_L(0); PG8_BAR; PG8_MMA(1, 0, At, B0); PG8_MMA(1, 1, At, B1); PG8_BAR; PG8_SCHED;
            PG8_LDB(B0, 1, 0); PG8_LDB(B1, 1, 1); PG8_SCHED; PG8_LDA(At, 1, 0); PG8_STAGE(PG8_SA(0, 1), a2 + hstep, voffA);
            PG8_WAIT_V(8); PG8_WAIT_L(0); PG8_BAR; PG8_MMA(0, 0, At, B0); PG8_MMA(0, 1, At, B1); PG8_BAR; PG8_SCHED;
            PG8_LDA(At, 1, 1); PG8_STAGE(PG8_SB(1, 0), b3, voffB); PG8_STAGE(PG8_SB(1, 1), b3 + hstep, voffB); PG8_STAGE(PG8_SA(1, 0), a3, voffA);
            PG8_WAIT_V(8); PG8_WAIT_L(0); PG8_BAR; PG8_MMA(1, 0, At, B0); PG8_MMA(1, 1, At, B1); PG8_BAR; PG8_SCHED;
            } else {
            PG8_LDB(B0, 0, 0); PG8_SCHED; PG8_LDA(At, 0, 0); PG8_STAGE(PG8_SA(1, 1), a1 + hstep, voffA);
            PG8_WAIT_L(8); PG8_BAR; PG8_WAIT_L(0); PG8_MMA(0, 0, At, B0); PG8_BAR; PG8_SCHED;
            PG8_LDB(B1, 0, 1); PG8_STAGE(PG8_SB(0, 0), b2, voffB);
            PG8_BAR; PG8_WAIT_L(0); PG8_MMA(0, 1, At, B1); PG8_BAR;
            PG8_LDA(At, 0, 1); PG8_STAGE(PG8_SA(0, 0), a2, voffA);
            PG8_BAR; PG8_WAIT_L(0); PG8_MMA(1, 0, At, B0); PG8_BAR; PG8_SCHED;
            PG8_STAGE(PG8_SB(0, 1), b2 + hstep, voffB);
            PG8_WAIT_V(6); PG8_BAR; PG8_MMA(1, 1, At, B1); PG8_BAR;
            PG8_LDB(B0, 1, 0); PG8_SCHED; PG8_LDA(At, 1, 0); PG8_STAGE(PG8_SA(0, 1), a2 + hstep, voffA);
            PG8_WAIT_L(8); PG8_BAR; PG8_WAIT_L(0); PG8_MMA(0, 0, At, B0); PG8_BAR; PG8_SCHED;
            PG8_LDB(B1, 1, 1); PG8_STAGE(PG8_SB(1, 0), b3, voffB);
            PG8_BAR; PG8_WAIT_L(0); PG8_MMA(0, 1, At, B1); PG8_BAR;
            PG8_LDA(At, 1, 1); PG8_STAGE(PG8_SA(1, 0), a3, voffA);
            PG8_BAR; PG8_WAIT_L(0); PG8_MMA(1, 0, At, B0); PG8_BAR; PG8_SCHED;
            PG8_STAGE(PG8_SB(1, 1), b3 + hstep, voffB);
            PG8_WAIT_V(6); PG8_BAR; PG8_MMA(1, 1, At, B1); PG8_BAR;
            }
        }
        if constexpr (ALIGN_EPI) { if (wr == 0) PG8_BAR; }
        if constexpr (!Epi::AFTER_DRAIN) { E(acc, cur, wr, wc, fr, fq); S.done(cur); }
        if (!has_next) break;
#pragma unroll
        for (int a = 0; a < 2; ++a)
#pragma unroll
            for (int b = 0; b < 2; ++b)
#pragma unroll
                for (int m = 0; m < 4; ++m)
#pragma unroll
                    for (int n = 0; n < 2; ++n) acc[a][b][m][n] = (f32x4){0.f, 0.f, 0.f, 0.f};
        cur = nxt; cA = nA; cB = nB; ++ui;
        if constexpr (ALIGN_EPI) { if (wr == 1) PG8_BAR; }
    }
    PG8_WAIT_V(0);
    if constexpr (!ALIGN_EPI) { if (wr == 0) PG8_BAR; }
    PG8_BAR;
    if constexpr (Epi::AFTER_DRAIN) { E.fused(acc, cur, wr, wc, fr, fq, lds, wid, lane); S.done(cur); }
#undef PG8_SA
#undef PG8_SB
#undef PG8_STAGE
#undef PG8_LDA
#undef PG8_LDB
#undef PG8_MMA
#undef PG8_WAIT_V
#undef PG8_WAIT_L
#undef PG8_BAR
#undef PG8_SCHED
}
}

#ifndef MK_FUSED
#define MK_FUSED 1
#endif
#define DI __device__ __forceinline__
#define LAS __attribute__((address_space(3)))
typedef unsigned short bf16_t;
typedef float f32x4 __attribute__((ext_vector_type(4)));
typedef float f32x2 __attribute__((ext_vector_type(2)));
typedef float f32x16 __attribute__((ext_vector_type(16)));
typedef unsigned u32x4 __attribute__((ext_vector_type(4)));
typedef unsigned u32x2 __attribute__((ext_vector_type(2)));
typedef short bf16x8 __attribute__((ext_vector_type(8)));
typedef _Float16 h16x2 __attribute__((ext_vector_type(2)));
typedef _Float16 h16x8 __attribute__((ext_vector_type(8)));

constexpr int BATCH = 16, SEQ = 4096, T = BATCH * SEQ, DM = 1024, NIN = 4864;
constexpr int C_AQ = 0, C_AK = 512, C_AV = 640, C_HQ = 768, C_HF = 1280, C_HI = 1792, C_HG = 2304, C_GA = 2816, C_GH = 3840;
constexpr float EPS = 1e-6f;
constexpr int NTHR = 512;
constexpr int LDS_BYTES = 163840;

constexpr size_t MiB = 1u << 20;
constexpr size_t WS_W1T = 1 * MiB;
constexpr size_t WS_WAPT = 11 * MiB;
constexpr size_t WS_WHPT = 12 * MiB;
constexpr size_t WS_WOUTT = 13 * MiB;
constexpr size_t WS_WQT = 15 * MiB;
constexpr size_t WS_KEYS = 19 * MiB;
constexpr size_t WS_LB = 19 * MiB + 512 * 1024;
constexpr size_t WS_RSTD1 = 20 * MiB;
constexpr size_t WS_SSQ2 = 21 * MiB;
constexpr size_t WS_U8 = 26 * MiB;
constexpr size_t WS_V8 = 42 * MiB;
constexpr size_t WS_SU = 58 * MiB;
constexpr size_t WS_SV = 58 * MiB + 65536;
constexpr size_t WS_DEC = 60 * MiB;
constexpr size_t WS_AVT = 64 * MiB;
constexpr size_t WS_XB = 90 * MiB;
constexpr size_t WS_PA = 218 * MiB;
constexpr size_t WS_GG = 314 * MiB;
constexpr size_t WS_QD = 570 * MiB;
constexpr size_t WS_KINV = 634 * MiB;
constexpr size_t WS_KENDT = 698 * MiB;
constexpr size_t WS_VT = 762 * MiB;
constexpr size_t WS_GS = 826 * MiB;
constexpr size_t WS_YA = 890 * MiB;
constexpr size_t WS_YH = 954 * MiB;
constexpr size_t WS_END = 1018 * MiB;
constexpr size_t WS_HQ = 698 * MiB;
constexpr size_t WS_WX = 762 * MiB;
constexpr size_t WS_SH = 60 * MiB;
constexpr size_t WS_SSQ3 = 64 * MiB;
constexpr size_t WS_SW = 61 * MiB;
constexpr size_t WS_ACTP = 346 * MiB;
constexpr size_t WS_X2B = 218 * MiB;
constexpr size_t WS_QP = 346 * MiB;
constexpr size_t WS_GIDX = 602 * MiB;
constexpr size_t WS_GGATE = 618 * MiB;

struct Args { const float* in[15]; float* out; unsigned char* ws; int ph_lo, ph_hi; };

DI unsigned pk_bf16(float lo, float hi) { typedef __bf16 b2 __attribute__((ext_vector_type(2))); f32x2 v = {lo, hi}; b2 b = __builtin_convertvector(v, b2); return __builtin_bit_cast(unsigned, b); }
DI float bflo(unsigned w) { return __uint_as_float(w << 16); }
DI float bfhi(unsigned w) { return __uint_as_float(w & 0xffff0000u); }
DI float sigm(float x) { return __builtin_amdgcn_rcpf(1.f + __expf(-x)); }
DI float wave_sum(float v) {
    v += __int_as_float(__builtin_amdgcn_mov_dpp(__float_as_int(v), 0xB1, 0xf, 0xf, true));
    v += __int_as_float(__builtin_amdgcn_mov_dpp(__float_as_int(v), 0x4E, 0xf, 0xf, true));
    v += __int_as_float(__builtin_amdgcn_mov_dpp(__float_as_int(v), 0x141, 0xf, 0xf, true));
    v += __int_as_float(__builtin_amdgcn_mov_dpp(__float_as_int(v), 0x128, 0xf, 0xf, true));
    { const auto r = __builtin_amdgcn_permlane16_swap(__float_as_uint(v), __float_as_uint(v), false, false); v = __uint_as_float(r[0]) + __uint_as_float(r[1]); }
    { const auto r = __builtin_amdgcn_permlane32_swap(__float_as_uint(v), __float_as_uint(v), false, false); v = __uint_as_float(r[0]) + __uint_as_float(r[1]); }
    return v;
}
DI float wave_max(float v) {
    v = fmaxf(v, __int_as_float(__builtin_amdgcn_mov_dpp(__float_as_int(v), 0xB1, 0xf, 0xf, true)));
    v = fmaxf(v, __int_as_float(__builtin_amdgcn_mov_dpp(__float_as_int(v), 0x4E, 0xf, 0xf, true)));
    v = fmaxf(v, __int_as_float(__builtin_amdgcn_mov_dpp(__float_as_int(v), 0x141, 0xf, 0xf, true)));
    v = fmaxf(v, __int_as_float(__builtin_amdgcn_mov_dpp(__float_as_int(v), 0x128, 0xf, 0xf, true)));
    { const auto r = __builtin_amdgcn_permlane16_swap(__float_as_uint(v), __float_as_uint(v), false, false); v = fmaxf(__uint_as_float(r[0]), __uint_as_float(r[1])); }
    { const auto r = __builtin_amdgcn_permlane32_swap(__float_as_uint(v), __float_as_uint(v), false, false); v = fmaxf(__uint_as_float(r[0]), __uint_as_float(r[1])); }
    return v;
}
DI unsigned short bf16_1(float x) { return (unsigned short)(pk_bf16(x, 0.f) & 0xffffu); }
template <int N> DI float dpp_row_shr(float v) { return __int_as_float(__builtin_amdgcn_update_dpp(0, __float_as_int(v), 0x110 + N, 0xf, 0xf, true)); }
DI float rowsum16(float v) { v += __int_as_float(__builtin_amdgcn_mov_dpp(__float_as_int(v), 0xB1, 0xf, 0xf, true)); v += __int_as_float(__builtin_amdgcn_mov_dpp(__float_as_int(v), 0x4E, 0xf, 0xf, true));
    v += __int_as_float(__builtin_amdgcn_mov_dpp(__float_as_int(v), 0x141, 0xf, 0xf, true)); v += __int_as_float(__builtin_amdgcn_mov_dpp(__float_as_int(v), 0x128, 0xf, 0xf, true)); return v; }
DI float scan16(float v) { v += dpp_row_shr<1>(v); v += dpp_row_shr<2>(v); v += dpp_row_shr<4>(v); v += dpp_row_shr<8>(v); return v; }
DI int crow(int reg, int hh) { return (reg & 3) + 8 * (reg >> 2) + 4 * hh; }
#define MFMA32(a, b, c) __builtin_amdgcn_mfma_f32_32x32x16_bf16((a), (b), (c), 0, 0, 0)
#define LDS_WAIT() asm volatile("s_waitcnt lgkmcnt(0)" ::: "memory")

namespace pg8 {
#define TSTORE_WRITE(sl, e, m, x) *(PG8_LAS bf16_t*)((sl) + (4 * fq + (e)) * 144 + (16 * (m) + fr) * 2) = bf16_1(x)
struct Epi1 {
    static constexpr bool PERM = true, AFTER_DRAIN = false;
    const float* rs; bf16_t* pa; bf16_t* gg; bf16_t* qd; bf16_t* kinv; bf16_t* kendT; bf16_t* vT; bf16_t* gs; float* dec; const float* lb; bf16_t* avT; PG8_LAS unsigned char* xl;
    __device__ __forceinline__ void operator()(const f32x4 (&acc)[2][2][4][2], const Unit& u, int wr, int wc, int fr, int fq) const {
        asm volatile("" : "+v"(fr), "+v"(fq));
        const int row0 = u.pm * BM + wr * 64 + fr, pn = u.pn;
        float rsv[2][4];
#pragma unroll
        for (int ai = 0; ai < 2; ++ai)
#pragma unroll
            for (int m = 0; m < 4; ++m) rsv[ai][m] = rs[row0 + ai * HALF + m * 16];
        if (pn == 2) {
            const int c8 = wc * 32 + 8 * fq, tseqb = (u.pm & 15) * 256 + wr * 64 + fr, bb = u.pm >> 4;
#pragma unroll
            for (int ai = 0; ai < 2; ++ai)
#pragma unroll
                for (int m = 0; m < 4; ++m) { const int row = row0 + ai * HALF + m * 16; const float s = rsv[ai][m];
                    const f32x4 v0 = acc[ai][0][m][0] * s, v1 = acc[ai][0][m][1] * s;
                    u32x4 w; w.x = pk_bf16(v0[0], v0[1]); w.y = pk_bf16(v0[2], v0[3]); w.z = pk_bf16(v1[0], v1[1]); w.w = pk_bf16(v1[2], v1[3]);
                    *(u32x4*)(pa + (size_t)row * 768 + 512 + c8) = w;
                }
            PG8_LAS unsigned char* sl = xl + (wr * 4 + wc) * 2304; const int lane_ = fq * 16 + fr;
#pragma unroll
            for (int ai = 0; ai < 2; ++ai)
#pragma unroll
                for (int n = 0; n < 2; ++n) {
#pragma unroll
                    for (int m = 0; m < 4; ++m) { const float s = rsv[ai][m];
#pragma unroll
                        for (int e = 0; e < 4; ++e) TSTORE_WRITE(sl, e, m, acc[ai][1][m][n][e] * s); }
                    asm volatile("s_waitcnt lgkmcnt(0)" ::: "memory");
#pragma unroll
                    for (int q = 0; q < 2; ++q) { const int c = lane_ + 64 * q, rw = c >> 3, tc = c & 7, col = wc * 32 + 8 * (rw >> 2) + 4 * n + (rw & 3);
                        const u32x4 w = *(const PG8_LAS u32x4*)(sl + rw * 144 + tc * 16);
                        *(u32x4*)(avT + (size_t)((bb * 2 + (col >> 6)) * 64 + (col & 63)) * SEQ + (u.pm & 15) * 256 + ai * HALF + wr * 64 + 8 * tc) = w; }
                    asm volatile("s_waitcnt lgkmcnt(0)" ::: "memory");
                }
            return;
        }
        if (pn < 3 || pn >= 11) {
            bf16_t* O; int ldc, colt;
            if (pn < 3) { O = pa; ldc = 768; colt = pn * 256; } else { O = gg; ldc = 2048; colt = (pn - 11) * 256; }
            const int col0 = colt + wc * 32 + 8 * fq;
#pragma unroll
            for (int ai = 0; ai < 2; ++ai)
#pragma unroll
                for (int m = 0; m < 4; ++m) { const int row = row0 + ai * HALF + m * 16; const float s = rsv[ai][m]; bf16_t* rowp = O + (size_t)row * ldc + col0;
#pragma unroll
                    for (int bj = 0; bj < 2; ++bj) { const f32x4 v0 = acc[ai][bj][m][0] * s, v1 = acc[ai][bj][m][1] * s;
                        u32x4 w; w.x = pk_bf16(v0[0], v0[1]); w.y = pk_bf16(v0[2], v0[3]); w.z = pk_bf16(v1[0], v1[1]); w.w = pk_bf16(v1[2], v1[3]);
                        *(u32x4*)(rowp + bj * HALF) = w; } }
            return;
        }
        PG8_LAS unsigned char* sl = xl + (wr * 4 + wc) * 2304; const int lane_ = fq * 16 + fr;
        const int h = (pn - 3) & 3, c8 = wc * 32 + 8 * fq, bh = (u.pm >> 4) * 4 + h;
        if (pn < 7) {
#pragma unroll
            for (int ai = 0; ai < 2; ++ai)
#pragma unroll
                for (int m = 0; m < 4; ++m) { const int row = row0 + ai * HALF + m * 16; const float s = rsv[ai][m]; const size_t o = (size_t)row * 512 + h * 128 + c8;
#pragma unroll
                    for (int bj = 0; bj < 2; ++bj) { const f32x4 v0 = acc[ai][bj][m][0] * s, v1 = acc[ai][bj][m][1] * s;
                        u32x4 w; w.x = pk_bf16(v0[0], v0[1]); w.y = pk_bf16(v0[2], v0[3]); w.z = pk_bf16(v1[0], v1[1]); w.w = pk_bf16(v1[2], v1[3]);
                        *(u32x4*)((bj ? kinv : qd) + o) = w; } }
        } else {
#pragma unroll
            for (int ai = 0; ai < 2; ++ai) {
                const int tseq0 = (u.pm & 15) * 256 + ai * HALF + wr * 64;
#pragma unroll
                for (int n = 0; n < 2; ++n) {
#pragma unroll
                    for (int m = 0; m < 4; ++m) { const float s = rsv[ai][m];
#pragma unroll
                        for (int e = 0; e < 4; ++e) TSTORE_WRITE(sl, e, m, acc[ai][0][m][n][e] * s); }
                    asm volatile("s_waitcnt lgkmcnt(0)" ::: "memory");
#pragma unroll
                    for (int q = 0; q < 2; ++q) { const int c = lane_ + 64 * q, rw = c >> 3, tc = c & 7, dvr = wc * 32 + 8 * (rw >> 2) + 4 * n + (rw & 3);
                        const u32x4 w = *(const PG8_LAS u32x4*)(sl + rw * 144 + tc * 16);
                        *(u32x4*)(vT + (size_t)(bh * 128 + dvr) * SEQ + tseq0 + 8 * tc) = w; }
                    asm volatile("s_waitcnt lgkmcnt(0)" ::: "memory");
                }
#pragma unroll
                for (int m = 0; m < 4; ++m) { const int row = row0 + ai * HALF + m * 16; const float s = rsv[ai][m];
                    f32x4 g0 = acc[ai][1][m][0] * s, g1 = acc[ai][1][m][1] * s;
#pragma unroll
                    for (int e = 0; e < 4; ++e) { g0[e] *= sigm(g0[e]); g1[e] *= sigm(g1[e]); }
                    u32x4 w; w.x = pk_bf16(g0[0], g0[1]); w.y = pk_bf16(g0[2], g0[3]); w.z = pk_bf16(g1[0], g1[1]); w.w = pk_bf16(g1[2], g1[3]);
                    *(u32x4*)(gs + (size_t)row * 512 + h * 128 + c8) = w; }
            }
        }
    }
};
template <bool ADD> struct EpiMerge {
    static constexpr bool PERM = true, AFTER_DRAIN = false;
    bf16_t* O; const bf16_t* gate;
    __device__ __forceinline__ void operator()(const f32x4 (&acc)[2][2][4][2], const Unit& u, int wr, int wc, int fr, int fq) const {
        const int row0 = u.pm * BM + wr * 64 + fr, col0 = u.pn * BM + wc * 32 + 8 * fq;
#pragma unroll
        for (int ai = 0; ai < 2; ++ai) {
            u32x4 g[4][2], o[4][2];
#pragma unroll
            for (int m = 0; m < 4; ++m)
#pragma unroll
                for (int bj = 0; bj < 2; ++bj) { const size_t row = (size_t)(row0 + ai * HALF + m * 16);
                    g[m][bj] = *(const u32x4*)(gate + row * 2048 + col0 + bj * HALF); if (ADD) o[m][bj] = *(const u32x4*)(O + row * DM + col0 + bj * HALF); }
#pragma unroll
            for (int m = 0; m < 4; ++m) { const int row = row0 + ai * HALF + m * 16; bf16_t* rowp = O + (size_t)row * DM + col0;
#pragma unroll
                for (int bj = 0; bj < 2; ++bj) { const u32x4 gq = g[m][bj];
                    f32x4 v0 = acc[ai][bj][m][0], v1 = acc[ai][bj][m][1];
                    v0[0] *= sigm(bflo(gq.x)); v0[1] *= sigm(bfhi(gq.x)); v0[2] *= sigm(bflo(gq.y)); v0[3] *= sigm(bfhi(gq.y));
                    v1[0] *= sigm(bflo(gq.z)); v1[1] *= sigm(bfhi(gq.z)); v1[2] *= sigm(bflo(gq.w)); v1[3] *= sigm(bfhi(gq.w));
                    if (ADD) { const u32x4 oq = o[m][bj];
                        v0[0] += bflo(oq.x); v0[1] += bfhi(oq.x); v0[2] += bflo(oq.y); v0[3] += bfhi(oq.y); v1[0] += bflo(oq.z); v1[1] += bfhi(oq.z); v1[2] += bflo(oq.w); v1[3] += bfhi(oq.w); }
                    u32x4 w; w.x = pk_bf16(v0[0], v0[1]); w.y = pk_bf16(v0[2], v0[3]); w.z = pk_bf16(v1[0], v1[1]); w.w = pk_bf16(v1[2], v1[3]);
                    *(u32x4*)(rowp + bj * HALF) = w; } }
        }
    }
};
struct EpiX2 {
    static constexpr bool PERM = true, AFTER_DRAIN = false;
    const bf16_t* X; bf16_t* X2B; float* ssq;
    __device__ __forceinline__ void operator()(const f32x4 (&acc)[2][2][4][2], const Unit& u, int wr, int wc, int fr, int fq) const {
        const int row0 = u.pm * BM + wr * 64 + fr, col0 = u.pn * BM + wc * 32 + 8 * fq;
#pragma unroll
        for (int ai = 0; ai < 2; ++ai) {
            u32x4 xr[4][2];
#pragma unroll
            for (int m = 0; m < 4; ++m)
#pragma unroll
                for (int bj = 0; bj < 2; ++bj) xr[m][bj] = *(const u32x4*)(X + (size_t)(row0 + ai * HALF + m * 16) * DM + col0 + bj * HALF);
#pragma unroll
            for (int m = 0; m < 4; ++m) { const int row = row0 + ai * HALF + m * 16; const size_t off = (size_t)row * DM + col0; float ss = 0.f;
#pragma unroll
                for (int bj = 0; bj < 2; ++bj) { const u32x4 xq = xr[m][bj];
                    const f32x4 v0 = acc[ai][bj][m][0] + (f32x4){bflo(xq.x), bfhi(xq.x), bflo(xq.y), bfhi(xq.y)}, v1 = acc[ai][bj][m][1] + (f32x4){bflo(xq.z), bfhi(xq.z), bflo(xq.w), bfhi(xq.w)};
                    u32x4 w; w.x = pk_bf16(v0[0], v0[1]); w.y = pk_bf16(v0[2], v0[3]); w.z = pk_bf16(v1[0], v1[1]); w.w = pk_bf16(v1[2], v1[3]);
                    *(u32x4*)(X2B + off + bj * HALF) = w;
                    ss += (v0[0] * v0[0] + v0[1] * v0[1]) + (v0[2] * v0[2] + v0[3] * v0[3]) + (v1[0] * v1[0] + v1[1] * v1[1]) + (v1[2] * v1[2] + v1[3] * v1[3]); }
                { const auto r = __builtin_amdgcn_permlane16_swap(__float_as_uint(ss), __float_as_uint(ss), false, false); ss = __uint_as_float(r[0]) + __uint_as_float(r[1]); }
                { const auto r = __builtin_amdgcn_permlane32_swap(__float_as_uint(ss), __float_as_uint(ss), false, false); ss = __uint_as_float(r[0]) + __uint_as_float(r[1]); }
                if (fq == 0) ssq[(size_t)row * 16 + u.pn * 4 + wc] = ss; }
        }
    }
};
struct EpiQp {
    static constexpr bool PERM = true, AFTER_DRAIN = false;
    bf16_t* O; const float* ssq;
    __device__ __forceinline__ void operator()(const f32x4 (&acc)[2][2][4][2], const Unit& u, int wr, int wc, int fr, int fq) const {
        const int row0 = u.pm * BM + wr * 64 + fr, col0 = u.pn * BM + wc * 32 + 8 * fq;
        float sv[2][4];
#pragma unroll
        for (int ai = 0; ai < 2; ++ai)
#pragma unroll
            for (int m = 0; m < 4; ++m) { const f32x4 a = *(const f32x4*)(ssq + (size_t)(row0 + ai * HALF + m * 16) * 16 + 4 * fq); sv[ai][m] = (a[0] + a[1]) + (a[2] + a[3]); }
#pragma unroll
        for (int ai = 0; ai < 2; ++ai)
#pragma unroll
            for (int m = 0; m < 4; ++m) { float t = sv[ai][m];
                { const auto r = __builtin_amdgcn_permlane16_swap(__float_as_uint(t), __float_as_uint(t), false, false); t = __uint_as_float(r[0]) + __uint_as_float(r[1]); }
                { const auto r = __builtin_amdgcn_permlane32_swap(__float_as_uint(t), __float_as_uint(t), false, false); t = __uint_as_float(r[0]) + __uint_as_float(r[1]); }
                sv[ai][m] = __builtin_amdgcn_rsqf(t * (1.f / 1024.f) + EPS); }
#pragma unroll
        for (int ai = 0; ai < 2; ++ai)
#pragma unroll
            for (int m = 0; m < 4; ++m) { const int row = row0 + ai * HALF + m * 16; const float s = sv[ai][m]; bf16_t* rowp = O + (size_t)row * 2048 + col0;
#pragma unroll
                for (int bj = 0; bj < 2; ++bj) { const f32x4 v0 = acc[ai][bj][m][0] * s, v1 = acc[ai][bj][m][1] * s;
                    u32x4 w; w.x = pk_bf16(v0[0], v0[1]); w.y = pk_bf16(v0[2], v0[3]); w.z = pk_bf16(v1[0], v1[1]); w.w = pk_bf16(v1[2], v1[3]);
                    *(u32x4*)(rowp + bj * HALF) = w; } }
    }
};
}

DI int w1_src_col(int n) {
    if (n < 768 || n >= 2816) return n;
    if (n < 1792) { const int h = (n - 768) >> 8, r = (n - 768) & 255; return r < 128 ? C_HQ + 128 * h + r : C_HF + 128 * h + (r - 128); }
    const int h = (n - 1792) >> 8, r = (n - 1792) & 255; return r < 128 ? C_HI + 128 * h + r : C_HG + 128 * h + (r - 128);
}
template <bool PERMW1> DI void p0_transpose_item(const float* W, int K, int N, bf16_t* WT, const float* g, int gmask, LAS float* scr, int item, int lane) {
    const int nblk = N / 32, kb = item / nblk, nb = item % nblk, k0 = 64 * kb, n0 = 32 * nb, ns = PERMW1 ? w1_src_col(n0) : n0;
#pragma unroll 8
    for (int i = 0; i < 32; ++i) { const int kk = 2 * i + (lane >> 5); float w = W[(size_t)(k0 + kk) * N + ns + (lane & 31)]; if (g) w *= g[(k0 + kk) & gmask]; scr[kk * 33 + (lane & 31)] = w; }
    LDS_WAIT(); asm volatile("" ::: "memory");
    const int c = lane & 7;
#pragma unroll
    for (int j = 0; j < 4; ++j) { const int n = (lane >> 3) + 8 * j; const LAS float* s = scr + (8 * c) * 33 + n;
        u32x4 o; o.x = pk_bf16(s[0 * 33], s[1 * 33]); o.y = pk_bf16(s[2 * 33], s[3 * 33]); o.z = pk_bf16(s[4 * 33], s[5 * 33]); o.w = pk_bf16(s[6 * 33], s[7 * 33]);
        *(u32x4*)(WT + (size_t)(n0 + n) * K + k0 + 8 * c) = o; }
    LDS_WAIT(); asm volatile("" ::: "memory");
}
DI unsigned pk_f16(float a, float b) { h16x2 v = {(_Float16)a, (_Float16)b}; return __builtin_bit_cast(unsigned, v); }

DI void p0_prologue(const Args& a, LAS unsigned char* lds, int vb, int G) {
    const int tid = threadIdx.x, lane = tid & 63, wave = tid >> 6;
    const int gw = vb * 8 + wave, NGW = G * 8, gt = vb * NTHR + tid, NGT = G * NTHR;
    unsigned char* ws = a.ws;
    LAS float* scr = (LAS float*)(lds + wave * 16384);
    constexpr int I_W1 = 16 * 152, I_AP = 8 * 32, I_HP = 8 * 32, I_OUT = 16 * 32, I_Q = 16 * 64, NITEMS = I_W1 + I_AP + I_HP + I_OUT + I_Q;
    for (int it = gw; it < NITEMS; it += NGW) {
        int r = it;
        if (r < I_W1) { p0_transpose_item<true>(a.in[2], 1024, NIN, (bf16_t*)(ws + WS_W1T), a.in[1], 1023, scr, r, lane); continue; } r -= I_W1;
        if (r < I_AP) { p0_transpose_item<false>(a.in[6], 512, 1024, (bf16_t*)(ws + WS_WAPT), nullptr, 0, scr, r, lane); continue; } r -= I_AP;
        if (r < I_HP) { p0_transpose_item<false>(a.in[7], 512, 1024, (bf16_t*)(ws + WS_WHPT), a.in[5], 127, scr, r, lane); continue; } r -= I_HP;
        if (r < I_OUT) { p0_transpose_item<false>(a.in[8], 1024, 1024, (bf16_t*)(ws + WS_WOUTT), nullptr, 0, scr, r, lane); continue; } r -= I_OUT;
        p0_transpose_item<false>(a.in[10], 1024, 2048, (bf16_t*)(ws + WS_WQT), a.in[9], 1023, scr, r, lane);
    }
    for (int i = gt; i < 2 * 8 * 128 * 128 / 4; i += NGT) { const f32x4 v = ((const f32x4*)a.in[11])[i]; u32x2 o; o.x = pk_bf16(v[0], v[1]); o.y = pk_bf16(v[2], v[3]); ((u32x2*)(ws + WS_KEYS))[i] = o; }
    for (int it = gw; it < 2 * 16384; it += NGW) {
        const int isv = it >= 16384, e = it & 16383;
        const float* src = (isv ? a.in[13] : a.in[12]) + (size_t)e * 1024 + 16 * lane;
        f32x4 x[4]; float amax = 0.f;
#pragma unroll
        for (int i = 0; i < 4; ++i) { x[i] = *(const f32x4*)(src + 4 * i); if (!isv) x[i] *= *(const f32x4*)(a.in[9] + 16 * lane + 4 * i);
            amax = fmaxf(fmaxf(amax, fmaxf(fabsf(x[i][0]), fabsf(x[i][1]))), fmaxf(fabsf(x[i][2]), fabsf(x[i][3]))); }
        amax = wave_max(amax);
        {
            float ssq_ = 0.f;
#pragma unroll
            for (int i = 0; i < 4; ++i) ssq_ += (x[i][0] * x[i][0] + x[i][1] * x[i][1]) + (x[i][2] * x[i][2] + x[i][3] * x[i][3]);
            ssq_ = wave_sum(ssq_);
            const float stp = fminf(0.35f * sqrtf(ssq_ * (1.f / 1024.f)), amax * (1.f / 7.f)), q4 = stp > 0.f ? 1.f / stp : 0.f; unsigned nb[16];
#pragma unroll
            for (int i = 0; i < 16; ++i) { const int q_ = (int)fminf(fmaxf(rintf(x[i >> 2][i & 3] * q4), -7.f), 7.f); nb[i] = (isv && !(i & 1)) ? (unsigned)(q_ + 8) : ((unsigned)q_ & 15u); }
            u32x2 w4; w4.x = (nb[0] | (nb[1] << 4)) | ((nb[2] | (nb[3] << 4)) << 8) | ((nb[4] | (nb[5] << 4)) << 16) | ((nb[6] | (nb[7] << 4)) << 24);
            w4.y = (nb[8] | (nb[9] << 4)) | ((nb[10] | (nb[11] << 4)) << 8) | ((nb[12] | (nb[13] << 4)) << 16) | ((nb[14] | (nb[15] << 4)) << 24);
            *(u32x2*)(ws + (isv ? WS_V8 : WS_U8) + (size_t)e * 512 + 8 * lane) = w4;
            if (lane == 0) ((float*)(ws + (isv ? WS_SV : WS_SU)))[e] = stp;
        }
    }
    for (int row = gw; row < T; row += NGW) {
        const f32x4* xr = (const f32x4*)(a.in[0] + (size_t)row * DM) + lane; f32x4 v[4]; float s = 0.f;
#pragma unroll
        for (int j = 0; j < 4; ++j) { v[j] = xr[64 * j]; s += (v[j][0] * v[j][0] + v[j][1] * v[j][1]) + (v[j][2] * v[j][2] + v[j][3] * v[j][3]); }
        s = wave_sum(s);
        u32x2* o = (u32x2*)(ws + WS_XB + (size_t)row * DM * 2) + lane;
#pragma unroll
        for (int j = 0; j < 4; ++j) { u32x2 w; w.x = pk_bf16(v[j][0], v[j][1]); w.y = pk_bf16(v[j][2], v[j][3]); o[64 * j] = w; }
        if (lane == 0) ((float*)(ws + WS_RSTD1))[row] = __builtin_amdgcn_rsqf(s * (1.f / 1024.f) + EPS);
    }
    if (vb == 0) { const float l0 = a.in[4][tid], l1 = a.in[4][512 + tid]; ((float*)(ws + WS_LB))[tid] = 1.f / (1.f + __expf(l1 - l0)); }
}

constexpr int ATT_KS = 272, ATT_VS = 392, ATT_VOFF = 192 * ATT_KS;
DI void attn_unit(const bf16_t* pa, const bf16_t* avT, const float* sinks, bf16_t* ya, LAS unsigned char* lds, int b, int tt) {
    int tid_ = threadIdx.x; asm volatile("" : "+v"(tid_));
    const int tid = tid_, lane = tid & 63, h = __builtin_amdgcn_readfirstlane(tid >> 6), r = lane & 31, hh = lane >> 5, kvh = h >> 2;
    const int p0 = tt * 64 - 128;
    for (int c = tid; c < 192 * 16; c += NTHR) { const int row = c >> 4, ch = c & 15, pos = p0 + row; u32x4 w = {0u, 0u, 0u, 0u};
        if (pos >= 0) w = *(const u32x4*)(pa + ((size_t)b * SEQ + pos) * 768 + 512 + ch * 8);
        *(LAS u32x4*)(lds + row * ATT_KS + ch * 16) = w; }
    for (int c = tid; c < 128 * 24; c += NTHR) { const int row = c / 24, ch = c - row * 24, pos = p0 + ch * 8; u32x4 w = {0u, 0u, 0u, 0u};
        if (pos >= 0) w = *(const u32x4*)(avT + (size_t)(b * 128 + row) * SEQ + pos);
        LAS u32x2* d = (LAS u32x2*)(lds + ATT_VOFF + row * ATT_VS + ch * 16); d[0] = (u32x2){w.x, w.y}; d[1] = (u32x2){w.z, w.w}; }
    __syncthreads();
    constexpr float LOG2E = 1.4426950408889634f;
    const float slope2 = exp2f(-(float)(h + 1)) * LOG2E, sink2 = sinks[h] * LOG2E, qs = 0.125f * LOG2E;
#pragma unroll 1
    for (int qbl = 0; qbl < 2; ++qbl) {
        const int qb = tt * 2 + qbl; const size_t trow = (size_t)b * SEQ + qb * 32 + r;
        bf16x8 qf[4];
        { const bf16_t* qp = pa + trow * 768 + h * 64 + 8 * hh;
#pragma unroll
          for (int s = 0; s < 4; ++s) qf[s] = *(const bf16x8*)(qp + 16 * s); }
        f32x16 S[5]; float m = sink2;
#pragma unroll
        for (int i = 0; i < 5; ++i) { const int kb = qb - 4 + i;
            if (kb >= 0) {
#pragma unroll
                for (int q = 0; q < 16; ++q) S[i][q] = 0.f;
                const LAS unsigned char* kp = lds + (32 * (qbl + i) + r) * ATT_KS + kvh * 128 + 16 * hh;
#pragma unroll
                for (int s = 0; s < 4; ++s) S[i] = MFMA32(*(const LAS bf16x8*)(kp + 32 * s), qf[s], S[i]);
#pragma unroll
                for (int q = 0; q < 16; ++q) { const int dist = 32 * (4 - i) + r - crow(q, hh); float v = S[i][q] * qs - slope2 * (float)dist;
                    if (i == 0) v = (dist <= 127) ? v : -1e30f;
                    if (i == 4) v = (dist >= 0) ? v : -1e30f;
                    S[i][q] = v; m = fmaxf(m, v); }
            } }
        m = fmaxf(m, __shfl_xor(m, 32));
        float l = 0.f;
#pragma unroll
        for (int i = 0; i < 5; ++i) if (qb - 4 + i >= 0) {
#pragma unroll
            for (int q = 0; q < 16; ++q) { const float p = __builtin_amdgcn_exp2f(S[i][q] - m); S[i][q] = p; l += p; } }
        l += __shfl_xor(l, 32); l += __builtin_amdgcn_exp2f(sink2 - m);
        f32x16 O[2];
#pragma unroll
        for (int q = 0; q < 16; ++q) { O[0][q] = 0.f; O[1][q] = 0.f; }
#pragma unroll
        for (int i = 0; i < 5; ++i) { const int kb = qb - 4 + i;
            if (kb >= 0) {
#pragma unroll
                for (int s2 = 0; s2 < 2; ++s2) {
                    u32x4 pb; pb.x = pk_bf16(S[i][8 * s2], S[i][8 * s2 + 1]); pb.y = pk_bf16(S[i][8 * s2 + 2], S[i][8 * s2 + 3]); pb.z = pk_bf16(S[i][8 * s2 + 4], S[i][8 * s2 + 5]); pb.w = pk_bf16(S[i][8 * s2 + 6], S[i][8 * s2 + 7]);
#pragma unroll
                    for (int dt = 0; dt < 2; ++dt) { const LAS unsigned char* vp = lds + ATT_VOFF + (kvh * 64 + 32 * dt + r) * ATT_VS + (32 * (qbl + i) + 16 * s2 + 4 * hh) * 2;
                        const u32x2 v0 = *(const LAS u32x2*)vp, v1 = *(const LAS u32x2*)(vp + 16); u32x4 av; av.x = v0.x; av.y = v0.y; av.z = v1.x; av.w = v1.y;
                        O[dt] = MFMA32(__builtin_bit_cast(bf16x8, av), __builtin_bit_cast(bf16x8, pb), O[dt]); }
                    asm volatile("" ::: "memory");
                } } }
        const float inv = 1.f / l;
#pragma unroll
        for (int dt = 0; dt < 2; ++dt)
#pragma unroll
            for (int g = 0; g < 4; ++g) { u32x2 w; w.x = pk_bf16(O[dt][4 * g] * inv, O[dt][4 * g + 1] * inv); w.y = pk_bf16(O[dt][4 * g + 2] * inv, O[dt][4 * g + 3] * inv);
                *(u32x2*)(ya + trow * 512 + h * 64 + 32 * dt + 8 * g + 4 * hh) = w; }
    }
    __syncthreads();
}

DI void hgrn_prep_unit(bf16_t* qd, bf16_t* kinv, LAS unsigned char* kl, float* dec, const float* lb, int bh, int c, int dk2) {
    const int b = bh >> 2, h = bh & 3;
    bf16_t* qp = qd + ((size_t)b * SEQ + c * 64) * 512 + h * 128 + dk2; bf16_t* kp = kinv + ((size_t)b * SEQ + c * 64) * 512 + h * 128 + dk2;
    const float lb0 = lb[h * 128 + dk2], lb1 = lb[h * 128 + dk2 + 1], om0 = 1.f - lb0, om1 = 1.f - lb1;
    unsigned qw[64], kv[64];
#pragma unroll
    for (int s = 0; s < 64; ++s) { qw[s] = *(const unsigned*)(qp + (size_t)s * 512); kv[s] = *(const unsigned*)(kp + (size_t)s * 512); }
    float b0 = 0.f, b1 = 0.f;
#pragma unroll
    for (int s = 0; s < 64; ++s) {
        const float f0 = lb0 + om0 * sigm(bflo(kv[s])), f1 = lb1 + om1 * sigm(bfhi(kv[s]));
        b0 += __logf(f0); b1 += __logf(f1);
        const float e0 = __expf(b0), e1 = __expf(b1), i0 = __builtin_amdgcn_rcpf(e0), i1 = __builtin_amdgcn_rcpf(e1);
        const float q0 = bflo(qw[s]), q1 = bfhi(qw[s]);
        *(unsigned*)(qp + (size_t)s * 512) = pk_bf16(q0 * sigm(q0) * e0, q1 * sigm(q1) * e1);
        kv[s] = pk_bf16((1.f - f0) * i0, (1.f - f1) * i1);
        *(unsigned*)(kp + (size_t)s * 512) = kv[s];
    }
    const float d0 = __expf(b0), d1 = __expf(b1);
    *(f32x2*)(dec + (size_t)(bh * 64 + c) * 128 + dk2) = (f32x2){d0, d1};
    LAS unsigned char* r0 = kl + dk2 * 144; LAS unsigned char* r1 = r0 + 144;
#pragma unroll
    for (int s0 = 0; s0 < 64; s0 += 8) { u32x4 w0, w1;
#pragma unroll
        for (int i = 0; i < 4; ++i) { const unsigned ka = kv[s0 + 2 * i], kb = kv[s0 + 2 * i + 1];
            w0[i] = pk_bf16(bflo(ka) * d0, bflo(kb) * d0); w1[i] = pk_bf16(bfhi(ka) * d1, bfhi(kb) * d1); }
        *(LAS u32x4*)(r0 + s0 * 2) = w0; *(LAS u32x4*)(r1 + s0 * 2) = w1; }
}
DI void hgrn_ds_unit(const LAS unsigned char* kl, const bf16_t* vT, bf16_t* dsT, int bh, int c) {
    int tid_ = threadIdx.x; asm volatile("" : "+v"(tid_));
    const int lane = tid_ & 63, wave = tid_ >> 6, r = lane & 31, hh = lane >> 5, i = wave >> 1, j0 = 2 * (wave & 1);
    const LAS unsigned char* ka = kl + (32 * i + r) * 144 + 16 * hh;
    const bf16_t* vb0 = vT + (size_t)(bh * 128 + 32 * j0 + r) * SEQ + c * 64 + 8 * hh; const bf16_t* vb1 = vb0 + (size_t)32 * SEQ;
    f32x16 D0, D1;
#pragma unroll
    for (int q = 0; q < 16; ++q) { D0[q] = 0.f; D1[q] = 0.f; }
#pragma unroll
    for (int ks = 0; ks < 4; ++ks) { const bf16x8 a = *(const LAS bf16x8*)(ka + 32 * ks), b0 = *(const bf16x8*)(vb0 + 16 * ks), b1 = *(const bf16x8*)(vb1 + 16 * ks); D0 = MFMA32(a, b0, D0); D1 = MFMA32(a, b1, D1); }
    const int unit = bh * 64 + c;
    bf16_t* o0 = dsT + (size_t)(unit * 128 + 32 * j0 + r) * 128 + 32 * i + 4 * hh; bf16_t* o1 = o0 + 32 * 128;
#pragma unroll
    for (int g = 0; g < 4; ++g) { u32x2 w; w.x = pk_bf16(D0[4 * g], D0[4 * g + 1]); w.y = pk_bf16(D0[4 * g + 2], D0[4 * g + 3]); *(u32x2*)(o0 + 8 * g) = w;
        u32x2 z; z.x = pk_bf16(D1[4 * g], D1[4 * g + 1]); z.y = pk_bf16(D1[4 * g + 2], D1[4 * g + 3]); *(u32x2*)(o1 + 8 * g) = z; }
}
DI void hgrn_scan(bf16_t* dsT, const float* dec, int vb, int G) {
    for (int idx = vb * NTHR + threadIdx.x; idx < 64 * 128 * 16; idx += G * NTHR) {
        const int dk8 = idx & 15, dv = (idx >> 4) & 127, bh = idx >> 11;
        float S[8];
#pragma unroll
        for (int q = 0; q < 8; ++q) S[q] = 0.f;
        for (int c0 = 0; c0 < 64; c0 += 8) {
            u32x4 ld[8]; f32x4 d0[8], d1[8];
#pragma unroll
            for (int i = 0; i < 8; ++i) { const int c = c0 + i; ld[i] = *(const u32x4*)(dsT + (size_t)((bh * 64 + c) * 128 + dv) * 128 + dk8 * 8);
                const float* dp = dec + (size_t)(bh * 64 + c) * 128 + dk8 * 8; d0[i] = *(const f32x4*)dp; d1[i] = *(const f32x4*)(dp + 4); }
#pragma unroll
            for (int i = 0; i < 8; ++i) { const int c = c0 + i;
                u32x4 w; w.x = pk_bf16(S[0], S[1]); w.y = pk_bf16(S[2], S[3]); w.z = pk_bf16(S[4], S[5]); w.w = pk_bf16(S[6], S[7]);
                *(u32x4*)(dsT + (size_t)((bh * 64 + c) * 128 + dv) * 128 + dk8 * 8) = w;
                S[0] = d0[i][0] * S[0] + bflo(ld[i].x); S[1] = d0[i][1] * S[1] + bfhi(ld[i].x); S[2] = d0[i][2] * S[2] + bflo(ld[i].y); S[3] = d0[i][3] * S[3] + bfhi(ld[i].y);
                S[4] = d1[i][0] * S[4] + bflo(ld[i].z); S[5] = d1[i][1] * S[5] + bfhi(ld[i].z); S[6] = d1[i][2] * S[6] + bflo(ld[i].w); S[7] = d1[i][3] * S[7] + bfhi(ld[i].w); }
        }
    }
}
constexpr int HO_Q = 0, HO_K = 64 * 272, HO_S = 2 * 64 * 272, HO_V = HO_S + 128 * 272, HO_Z = HO_V + 128 * 144;
struct HoPre { u32x4 c[10]; u32x4 g0, g1; };
DI void ho_fetch(HoPre& p, const bf16_t* qd, const bf16_t* kinv, const bf16_t* vT, const bf16_t* spT, const bf16_t* gs, int u, int tid) {
    const int bh = u >> 6, c = u & 63, b = bh >> 2, h = bh & 3; const size_t Tb = (size_t)b * SEQ + c * 64;
#pragma unroll
    for (int k = 0; k < 2; ++k) { const int i = tid + NTHR * k, row = i >> 4, ch = i & 15; p.c[k] = *(const u32x4*)(qd + (Tb + row) * 512 + h * 128 + ch * 8); p.c[2 + k] = *(const u32x4*)(kinv + (Tb + row) * 512 + h * 128 + ch * 8); }
#pragma unroll
    for (int k = 0; k < 4; ++k) { const int i = tid + NTHR * k, row = i >> 4, ch = i & 15; p.c[4 + k] = *(const u32x4*)(spT + (size_t)((bh * 64 + c) * 128 + row) * 128 + ch * 8); }
#pragma unroll
    for (int k = 0; k < 2; ++k) { const int i = tid + NTHR * k, row = i >> 3, ch = i & 7; p.c[8 + k] = *(const u32x4*)(vT + (size_t)(bh * 128 + row) * SEQ + c * 64 + ch * 8); }
    { const int tok = tid >> 3, d16 = (tid & 7) * 16; const size_t off = (Tb + tok) * 512 + h * 128 + d16; p.g0 = *(const u32x4*)(gs + off); p.g1 = *(const u32x4*)(gs + off + 8); }
}
DI void ho_put(const HoPre& p, LAS unsigned char* lds, int tid) {
#pragma unroll
    for (int k = 0; k < 2; ++k) { const int i = tid + NTHR * k, row = i >> 4, ch = i & 15; *(LAS u32x4*)(lds + HO_Q + row * 272 + ch * 16) = p.c[k]; *(LAS u32x4*)(lds + HO_K + row * 272 + ch * 16) = p.c[2 + k]; }
#pragma unroll
    for (int k = 0; k < 4; ++k) { const int i = tid + NTHR * k, row = i >> 4, ch = i & 15; *(LAS u32x4*)(lds + HO_S + row * 272 + ch * 16) = p.c[4 + k]; }
#pragma unroll
    for (int k = 0; k < 2; ++k) { const int i = tid + NTHR * k, row = i >> 3, ch = i & 7; *(LAS u32x4*)(lds + HO_V + row * 144 + ch * 16) = p.c[8 + k]; }
}
DI void hgrn_out_phase(const bf16_t* qd, const bf16_t* kinv, const bf16_t* vT, const bf16_t* spT, const bf16_t* gs, bf16_t* yh, LAS unsigned char* lds, int vb, int G) {
    int tid_ = threadIdx.x; asm volatile("" : "+v"(tid_));
    const int tid = tid_, lane = tid & 63, wave = __builtin_amdgcn_readfirstlane(tid >> 6), r = lane & 31, hh = lane >> 5, tb = wave >> 2, db = wave & 3;
    LAS float* zs = (LAS float*)(lds + HO_Z);
    HoPre pre;
    if (vb < 64 * 64) ho_fetch(pre, qd, kinv, vT, spT, gs, vb, tid);
    for (int u = vb; u < 64 * 64; u += G) {
        const int bh = u >> 6, c = u & 63, b = bh >> 2, h = bh & 3; const size_t Tb = (size_t)b * SEQ + c * 64;
        ho_put(pre, lds, tid);
        const u32x4 g0 = pre.g0, g1 = pre.g1;
        __syncthreads();
        { const int un = (u + G < 64 * 64) ? u + G : u; ho_fetch(pre, qd, kinv, vT, spT, gs, un, tid); }
        f32x16 Z;
#pragma unroll
        for (int q = 0; q < 16; ++q) Z[q] = 0.f;
        const LAS unsigned char* qb_ = lds + HO_Q + (32 * tb + r) * 272 + 16 * hh;
        bf16x8 qf[8];
#pragma unroll
        for (int ks = 0; ks < 8; ++ks) qf[ks] = *(const LAS bf16x8*)(qb_ + 32 * ks);
        { const LAS unsigned char* sb_ = lds + HO_S + (32 * db + r) * 272 + 16 * hh;
#pragma unroll
          for (int ks = 0; ks < 8; ++ks) Z = MFMA32(qf[ks], *(const LAS bf16x8*)(sb_ + 32 * ks), Z); }
#pragma unroll
        for (int sb = 0; sb < 2; ++sb) if (sb <= tb) {
            f32x16 X;
#pragma unroll
            for (int q = 0; q < 16; ++q) X[q] = 0.f;
            const LAS unsigned char* kb_ = lds + HO_K + (32 * sb + r) * 272 + 16 * hh;
#pragma unroll
            for (int ks = 0; ks < 8; ++ks) X = MFMA32(*(const LAS bf16x8*)(kb_ + 32 * ks), qf[ks], X);
            if (sb == tb) {
#pragma unroll
                for (int q = 0; q < 16; ++q) if (crow(q, hh) > r) X[q] = 0.f;
            }
#pragma unroll
            for (int s2 = 0; s2 < 2; ++s2) {
                u32x4 pa_; pa_.x = pk_bf16(X[8 * s2], X[8 * s2 + 1]); pa_.y = pk_bf16(X[8 * s2 + 2], X[8 * s2 + 3]); pa_.z = pk_bf16(X[8 * s2 + 4], X[8 * s2 + 5]); pa_.w = pk_bf16(X[8 * s2 + 6], X[8 * s2 + 7]);
                const LAS unsigned char* vp = lds + HO_V + (32 * db + r) * 144 + (32 * sb + 16 * s2 + 4 * hh) * 2;
                const u32x2 v0 = *(const LAS u32x2*)vp, v1 = *(const LAS u32x2*)(vp + 16);
                u32x4 pb_; pb_.x = v0.x; pb_.y = v0.y; pb_.z = v1.x; pb_.w = v1.y;
                Z = MFMA32(__builtin_bit_cast(bf16x8, pa_), __builtin_bit_cast(bf16x8, pb_), Z);
            }
        }
#pragma unroll
        for (int q = 0; q < 16; ++q) zs[(32 * tb + crow(q, hh)) * 132 + 32 * db + r] = Z[q];
        __syncthreads();
        { const int tok = tid >> 3, d16 = (tid & 7) * 16; f32x4 o[4]; float ss = 0.f;
          const size_t off = (Tb + tok) * 512 + h * 128 + d16;
#pragma unroll
          for (int i = 0; i < 4; ++i) { o[i] = *(const LAS f32x4*)(zs + tok * 132 + d16 + 4 * i); ss += (o[i][0] * o[i][0] + o[i][1] * o[i][1]) + (o[i][2] * o[i][2] + o[i][3] * o[i][3]); }
          ss += __shfl_xor(ss, 1); ss += __shfl_xor(ss, 2); ss += __shfl_xor(ss, 4);
          const float rn = __builtin_amdgcn_rsqf(ss * (1.f / 128.f) + EPS);
          u32x4 w0, w1;
          w0.x = pk_bf16(o[0][0] * rn * bflo(g0.x), o[0][1] * rn * bfhi(g0.x)); w0.y = pk_bf16(o[0][2] * rn * bflo(g0.y), o[0][3] * rn * bfhi(g0.y));
          w0.z = pk_bf16(o[1][0] * rn * bflo(g0.z), o[1][1] * rn * bfhi(g0.z)); w0.w = pk_bf16(o[1][2] * rn * bflo(g0.w), o[1][3] * rn * bfhi(g0.w));
          w1.x = pk_bf16(o[2][0] * rn * bflo(g1.x), o[2][1] * rn * bfhi(g1.x)); w1.y = pk_bf16(o[2][2] * rn * bflo(g1.y), o[2][3] * rn * bfhi(g1.y));
          w1.z = pk_bf16(o[3][0] * rn * bflo(g1.z), o[3][1] * rn * bfhi(g1.z)); w1.w = pk_bf16(o[3][2] * rn * bflo(g1.w), o[3][3] * rn * bfhi(g1.w));
          *(u32x4*)(yh + off) = w0; *(u32x4*)(yh + off + 8) = w1; }
    }
    __syncthreads();
}

DI unsigned f2ord(float f) { const unsigned b = __float_as_uint(f); return b ^ ((unsigned)((int)b >> 31) | 0x80000000u); }
DI float ord2f(unsigned k) { const unsigned b = (k & 0x80000000u) ? (k ^ 0x80000000u) : ~k; return __uint_as_float(b); }
DI void ce_desc(unsigned& a, unsigned& b) { const unsigned hi = a > b ? a : b, lo = a > b ? b : a; a = hi; b = lo; }
DI void sort16_desc(unsigned (&a)[16]) {
    constexpr int NI[63] = {0, 2, 0, 1, 1, 4, 6, 4, 5, 5, 0, 2, 2, 1, 3, 3, 1, 3, 5, 8, 10, 8, 9, 9, 12, 14, 12, 13, 13, 8, 10, 10, 9, 11, 11, 9, 11, 13, 0, 4, 4, 2, 6, 6, 2, 6, 10, 1, 5, 5, 3, 7, 7, 3, 7, 11, 1, 3, 5, 7, 9, 11, 13};
    constexpr int NJ[63] = {1, 3, 2, 3, 2, 5, 7, 6, 7, 6, 4, 6, 4, 5, 7, 5, 2, 4, 6, 9, 11, 10, 11, 10, 13, 15, 14, 15, 14, 12, 14, 12, 13, 15, 13, 10, 12, 14, 8, 12, 8, 10, 14, 10, 4, 8, 12, 9, 13, 9, 11, 15, 11, 5, 9, 13, 2, 4, 6, 8, 10, 12, 14};
#pragma unroll
    for (int c = 0; c < 63; ++c) ce_desc(a[NI[c]], a[NJ[c]]);
}
DI void merge16_desc(unsigned (&a)[16], const unsigned (&b)[16]) {
#pragma unroll
    for (int i = 0; i < 16; ++i) a[i] = a[i] > b[15 - i] ? a[i] : b[15 - i];
#pragma unroll
    for (int j = 8; j > 0; j >>= 1)
#pragma unroll
        for (int i = 0; i < 16; ++i) { const int l = i ^ j; if (l > i) ce_desc(a[i], a[l]); }
}
#define TK_INS(L, x) do { unsigned t_ = (x); _Pragma("unroll") for (int j_ = 0; j_ < 16; ++j_) { const unsigned hi_ = L[j_] > t_ ? L[j_] : t_; t_ = L[j_] > t_ ? t_ : L[j_]; L[j_] = hi_; } } while (0)

DI void topk_stage_keys(const bf16_t* keysb, LAS unsigned char* kl, int h) {
    for (int c = threadIdx.x; c < 2 * 128 * 16; c += NTHR) { const int p = c >> 11, row = (c >> 4) & 127, ch = c & 15;
        *(LAS u32x4*)(kl + (p * 128 + row) * 272 + ch * 16) = *(const u32x4*)(keysb + ((size_t)(p * 8 + h) * 128 + row) * 128 + ch * 8); }
}
DI void topk_unit(const bf16_t* qp, const LAS unsigned char* kl, unsigned short* gidx, float* ggate, LAS unsigned* tk, int quad, int h) {
    const int tid = threadIdx.x, lane = tid & 63, wave = tid >> 6, p = wave & 1, tsub = wave >> 1, r = lane & 31, hh = lane >> 5;
#pragma unroll 1
    for (int hl = 0; hl < 4; ++hl) {
        const int tok0 = (quad * 4 + hl) * 128 + tsub * 32;
        f32x16 acc[4];
#pragma unroll
        for (int kb = 0; kb < 4; ++kb)
#pragma unroll
            for (int i = 0; i < 16; ++i) acc[kb][i] = 16.f;
#ifdef T_MPRIO
        __builtin_amdgcn_s_setprio(T_MPRIO);
#endif
        const bf16_t* qrow = qp + (size_t)(tok0 + r) * 2048 + h * 256 + p * 128 + 8 * hh;
        const LAS unsigned char* kbase = kl + (p * 128 + r) * 272 + 16 * hh;
#pragma unroll
        for (int s = 0; s < 8; ++s) { const bf16x8 bq = *(const bf16x8*)(qrow + 16 * s);
#pragma unroll
            for (int kb = 0; kb < 4; ++kb) { const bf16x8 ak = *(const LAS bf16x8*)(kbase + kb * 32 * 272 + 32 * s); acc[kb] = MFMA32(ak, bq, acc[kb]); } }
#ifdef T_MPRIO
        __builtin_amdgcn_s_setprio(0);
#endif
        unsigned A0[16], A1[16], A2[16], A3[16];
#pragma unroll
        for (int i = 0; i < 16; ++i) { const unsigned ki = (unsigned)(crow(i, hh));
            A0[i] = (__float_as_uint(fmaxf(acc[0][i], 0.f)) & ~127u) | ki; A1[i] = (__float_as_uint(fmaxf(acc[1][i], 0.f)) & ~127u) | (32u + ki); A2[i] = (__float_as_uint(fmaxf(acc[2][i], 0.f)) & ~127u) | (64u + ki); A3[i] = (__float_as_uint(fmaxf(acc[3][i], 0.f)) & ~127u) | (96u + ki); }
        sort16_desc(A0); sort16_desc(A1); sort16_desc(A2); sort16_desc(A3);
        merge16_desc(A0, A1); merge16_desc(A2, A3); merge16_desc(A0, A2);
#pragma unroll
        for (int j = 0; j < 16; ++j) A1[j] = __shfl_xor(A0[j], 32);
        merge16_desc(A0, A1);
        if (hh == 0) { LAS u32x4* dst = (LAS u32x4*)(tk + (((hl * 2 + p) * 128 + tsub * 32 + r) * 16));
#pragma unroll
            for (int c = 0; c < 4; ++c) { u32x4 w = {A0[4 * c], A0[4 * c + 1], A0[4 * c + 2], A0[4 * c + 3]}; dst[c] = w; } }
    }
    __syncthreads();
    {
        const int tok = tid & 127, hl = tid >> 7, tile = quad * 4 + hl;
        const LAS unsigned* t1 = tk + ((hl * 2 + 0) * 128 + tok) * 16; const LAS unsigned* t2 = tk + ((hl * 2 + 1) * 128 + tok) * 16;
        float v1[16], v2[16];
        { const LAS u32x4* s1 = (const LAS u32x4*)t1; const LAS u32x4* s2 = (const LAS u32x4*)t2;
#pragma unroll
          for (int c = 0; c < 4; ++c) { const u32x4 a = s1[c], b = s2[c];
              v1[4 * c] = __uint_as_float(a.x & ~127u) - 12.f; v1[4 * c + 1] = __uint_as_float(a.y & ~127u) - 12.f; v1[4 * c + 2] = __uint_as_float(a.z & ~127u) - 12.f; v1[4 * c + 3] = __uint_as_float(a.w & ~127u) - 12.f;
              v2[4 * c] = __uint_as_float(b.x & ~127u) - 12.f; v2[4 * c + 1] = __uint_as_float(b.y & ~127u) - 12.f; v2[4 * c + 2] = __uint_as_float(b.z & ~127u) - 12.f; v2[4 * c + 3] = __uint_as_float(b.w & ~127u) - 12.f; } }
#define CKEY(i, j) ((__float_as_uint(fmaxf(v1[i] + v2[j], 0.f)) & ~255u) | (unsigned)((i) * 16 + (j)))
        unsigned C[16], D[16], E[16];
#pragma unroll
        for (int j = 0; j < 16; ++j) C[j] = CKEY(0, j);
#pragma unroll
        for (int j = 0; j < 8; ++j) D[j] = CKEY(1, j);
#pragma unroll
        for (int j = 0; j < 5; ++j) D[8 + j] = CKEY(2, j);
#pragma unroll
        for (int j = 0; j < 3; ++j) D[13 + j] = CKEY(4, j);
#pragma unroll
        for (int j = 0; j < 4; ++j) E[j] = CKEY(3, j);
        E[4] = CKEY(5, 0); E[5] = CKEY(5, 1); E[6] = CKEY(6, 0); E[7] = CKEY(6, 1); E[8] = CKEY(7, 0); E[9] = CKEY(7, 1);
        E[10] = CKEY(8, 0); E[11] = CKEY(9, 0); E[12] = CKEY(10, 0); E[13] = CKEY(11, 0); E[14] = CKEY(12, 0); E[15] = CKEY(13, 0);
        sort16_desc(D); sort16_desc(E);
        TK_INS(E, CKEY(14, 0)); TK_INS(E, CKEY(15, 0));
#undef CKEY
        merge16_desc(C, D); merge16_desc(C, E);
        float sc[16]; unsigned ei[16]; float mx = -1e30f;
#pragma unroll
        for (int q = 0; q < 16; ++q) { const unsigned ij = C[q] & 255u; const unsigned a = t1[ij >> 4], b = t2[ij & 15u];
            sc[q] = (__uint_as_float(a & ~127u) - 16.f) + (__uint_as_float(b & ~127u) - 16.f); ei[q] = (a & 127u) * 128u + (b & 127u); mx = fmaxf(mx, sc[q]); }
        float sum = 0.f;
#pragma unroll
        for (int q = 0; q < 16; ++q) { sc[q] = __expf(sc[q] - mx); sum += sc[q]; }
        const float inv = 1.f / sum; const size_t o = (size_t)(tile * 128 + tok) * 128 + h * 16;
        u32x4 w0, w1;
        w0.x = ei[0] | (ei[1] << 16); w0.y = ei[2] | (ei[3] << 16); w0.z = ei[4] | (ei[5] << 16); w0.w = ei[6] | (ei[7] << 16);
        w1.x = ei[8] | (ei[9] << 16); w1.y = ei[10] | (ei[11] << 16); w1.z = ei[12] | (ei[13] << 16); w1.w = ei[14] | (ei[15] << 16);
        *(u32x4*)(gidx + o) = w0; *(u32x4*)(gidx + o + 8) = w1;
#pragma unroll
        for (int c = 0; c < 4; ++c) *(f32x4*)(ggate + o + 4 * c) = (f32x4){sc[4 * c] * inv, sc[4 * c + 1] * inv, sc[4 * c + 2] * inv, sc[4 * c + 3] * inv};
    }
    __syncthreads();
}

DI float gelu_erf(float x) { return 0.5f * x * (1.f + erff(x * 0.70710678118654752f)); }
DI void hq_token(const bf16_t* x2row, const float* ssq, unsigned char* hqrow, float* shp, int lane) {
    f32x4 x[4]; float amax = 0.f;
#pragma unroll
    for (int i = 0; i < 4; ++i) { const u32x2 w_ = *(const u32x2*)(x2row + 16 * lane + 4 * i); x[i] = (f32x4){bflo(w_.x), bfhi(w_.x), bflo(w_.y), bfhi(w_.y)}; amax = fmaxf(fmaxf(amax, fmaxf(fabsf(x[i][0]), fabsf(x[i][1]))), fmaxf(fabsf(x[i][2]), fabsf(x[i][3]))); }
    float ss = (lane < 16) ? ssq[lane] : 0.f; ss = wave_sum(ss);
    const float rstd2 = __builtin_amdgcn_rsqf(ss * (1.f / 1024.f) + EPS);
    amax = wave_max(amax);
    amax *= rstd2;
    const float qs = amax > 0.f ? 119.f / amax : 0.f, xq = rstd2 * qs;
    unsigned hh[2] = {0u, 0u}, hl[2] = {0u, 0u};
#pragma unroll
    for (int i = 0; i < 16; ++i) { const int q_ = (int)rintf(x[i >> 2][i & 3] * xq), l_ = ((q_ + 8) & 15) - 8, h_ = (q_ - l_) >> 4;
        hl[i >> 3] |= ((unsigned)l_ & 15u) << (4 * (i & 7)); hh[i >> 3] |= ((unsigned)h_ & 15u) << (4 * (i & 7)); }
    unsigned char* cp = hqrow + (lane >> 1) * 32 + (lane & 1) * 8;
    *(u32x2*)cp = (u32x2){hh[0], hh[1]}; *(u32x2*)(cp + 16) = (u32x2){hl[0], hl[1]};
    if (lane == 0) *shp = amax * (1.f / 119.f);
}
template <int CTRL> DI int dpp_i(int v) { return __builtin_amdgcn_mov_dpp(v, CTRL, 0xf, 0xf, true); }
template <int CTRL> DI float dpp_f(float v) { return __int_as_float(__builtin_amdgcn_mov_dpp(__float_as_int(v), CTRL, 0xf, 0xf, true)); }
DI float swapadd32(float a, float b) { const auto r = __builtin_amdgcn_permlane32_swap(__float_as_uint(a), __float_as_uint(b), false, false); return __uint_as_float(r[0]) + __uint_as_float(r[1]); }
DI float swapadd16(float a, float b) { const auto r = __builtin_amdgcn_permlane16_swap(__float_as_uint(a), __float_as_uint(b), false, false); return __uint_as_float(r[0]) + __uint_as_float(r[1]); }

struct SMeta { u32x4 i0, i1, a0, a1; unsigned xw; };
template <int RS> DI void slice_issue(u32x4 (&r)[16], const SMeta& m, const unsigned char* base) {
    const unsigned iw[8] = {m.i0.x, m.i0.y, m.i0.z, m.i0.w, m.i1.x, m.i1.y, m.i1.z, m.i1.w};
#pragma unroll
    for (int j = 0; j < 16; ++j) { const unsigned idx = (j & 1) ? (iw[j >> 1] >> 16) : (iw[j >> 1] & 0xffffu); r[j] = *(const u32x4*)(base + (size_t)idx * RS); }
}
DI void slice_u_compute(const SMeta& m, const u32x4 (&r)[16], int* actp, int lane) {
    const int hh[4] = {(int)m.a0.x, (int)m.a0.y, (int)m.a0.z, (int)m.a0.w}, hl[4] = {(int)m.a1.x, (int)m.a1.y, (int)m.a1.z, (int)m.a1.w};
    int part[16];
#ifdef U_PRIO
    __builtin_amdgcn_s_setprio(U_PRIO);
#endif
#pragma unroll
    for (int j = 0; j < 16; ++j) { int ah = 0, al = 0;
#pragma unroll
        for (int g = 0; g < 4; ++g) { ah = __builtin_amdgcn_sdot8((int)r[j][g], hh[g], ah, false); al = __builtin_amdgcn_sdot8((int)r[j][g], hl[g], al, false); }
        part[j] = (ah << 4) + al; }
    int r8[8], r4[4], r2[2];
    { const bool up_ = (lane & 4) != 0;
#pragma unroll
      for (int i = 0; i < 8; ++i) { const int keep = up_ ? part[i + 8] : part[i], send = up_ ? part[i] : part[i + 8]; r8[i] = keep + dpp_i<0x141>(send); } }
    { const bool up_ = (lane & 2) != 0;
#pragma unroll
      for (int i = 0; i < 4; ++i) { const int keep = up_ ? r8[i + 4] : r8[i], send = up_ ? r8[i] : r8[i + 4]; r4[i] = keep + dpp_i<0x4E>(send); } }
    { const bool up_ = (lane & 1) != 0;
#pragma unroll
      for (int i = 0; i < 2; ++i) { const int keep = up_ ? r4[i + 2] : r4[i], send = up_ ? r4[i] : r4[i + 2]; r2[i] = keep + dpp_i<0xB1>(send); } }
#ifdef U_PRIO
    __builtin_amdgcn_s_setprio(0);
#endif
    actp[lane] = (int)((unsigned)(((r2[0] + 4) >> 3) & 0xffff) | ((unsigned)((r2[1] + 4) >> 3) << 16));
}
DI int swapadd32i(int a, int b) { const auto r = __builtin_amdgcn_permlane32_swap((unsigned)a, (unsigned)b, false, false); return (int)r[0] + (int)r[1]; }
DI int swapadd16i(int a, int b) { const auto r = __builtin_amdgcn_permlane16_swap((unsigned)a, (unsigned)b, false, false); return (int)r[0] + (int)r[1]; }
DI void slice_v_compute(const SMeta& m, const u32x4 (&r)[16], float* x3row, float* ssq3p, int sl, int lane) {
    const int wq[4] = {(int)m.a0.x, (int)m.a0.y, (int)m.a0.z, (int)m.a0.w};
    const float sw = __uint_as_float(m.a1.x);
    int o[32];
#pragma unroll
    for (int i = 0; i < 32; ++i) o[i] = 0;
#pragma unroll
    for (int q = 0; q < 4; ++q)
#pragma unroll
        for (int p = 0; p < 4; ++p) {
            const unsigned d0 = r[4 * q][p], d1 = r[4 * q + 1][p], d2 = r[4 * q + 2][p], d3 = r[4 * q + 3][p];
            const unsigned t0 = __builtin_amdgcn_perm(d1, d0, 0x05010400u), t1 = __builtin_amdgcn_perm(d1, d0, 0x07030602u), t2 = __builtin_amdgcn_perm(d3, d2, 0x05010400u), t3 = __builtin_amdgcn_perm(d3, d2, 0x07030602u);
            const unsigned e0 = __builtin_amdgcn_perm(t2, t0, 0x05040100u), e1 = __builtin_amdgcn_perm(t2, t0, 0x07060302u), e2 = __builtin_amdgcn_perm(t3, t1, 0x05040100u), e3 = __builtin_amdgcn_perm(t3, t1, 0x07060302u);
            o[8 * p + 0] = __builtin_amdgcn_sdot4((int)(e0 & 0x0F0F0F0Fu), wq[q], o[8 * p + 0], false); o[8 * p + 1] = __builtin_amdgcn_sdot4((int)e0, wq[q], o[8 * p + 1], false);
            o[8 * p + 2] = __builtin_amdgcn_sdot4((int)(e1 & 0x0F0F0F0Fu), wq[q], o[8 * p + 2], false); o[8 * p + 3] = __builtin_amdgcn_sdot4((int)e1, wq[q], o[8 * p + 3], false);
            o[8 * p + 4] = __builtin_amdgcn_sdot4((int)(e2 & 0x0F0F0F0Fu), wq[q], o[8 * p + 4], false); o[8 * p + 5] = __builtin_amdgcn_sdot4((int)e2, wq[q], o[8 * p + 5], false);
            o[8 * p + 6] = __builtin_amdgcn_sdot4((int)(e3 & 0x0F0F0F0Fu), wq[q], o[8 * p + 6], false); o[8 * p + 7] = __builtin_amdgcn_sdot4((int)e3, wq[q], o[8 * p + 7], false);
        }
    int wt = 0;
#pragma unroll
    for (int q = 0; q < 4; ++q) wt = __builtin_amdgcn_sdot4(wq[q], 0x01010101, wt, false);
    wt += dpp_i<0x128>(wt); wt = swapadd16i(wt, wt); wt = swapadd32i(wt, wt); wt *= 8;
    int a16[16], a8[8], a4[4];
#pragma unroll
    for (int i = 0; i < 16; ++i) a16[i] = swapadd32i(o[i], o[16 + i]);
#pragma unroll
    for (int i = 0; i < 8; ++i) a8[i] = swapadd16i(a16[i], a16[i + 8]);
    { const bool up_ = (lane & 8) != 0;
#pragma unroll
      for (int i = 0; i < 4; ++i) { const int keep = up_ ? a8[i + 4] : a8[i], send = up_ ? a8[i] : a8[i + 4]; a4[i] = keep + dpp_i<0x128>(send); } }
    const int col = 32 * (lane & 7) + ((lane >> 5) & 1) * 16 + ((lane >> 4) & 1) * 8 + ((lane >> 3) & 1) * 4;
    const f32x4 y = {bflo(m.xw) + (float)(a4[0] - wt) * sw, bfhi(m.xw) + (float)((a4[1] - a4[0]) >> 4) * sw, bflo(m.a1.y) + (float)(a4[2] - wt) * sw, bfhi(m.a1.y) + (float)((a4[3] - a4[2]) >> 4) * sw};
    *(f32x4*)(x3row + 256 * sl + col) = y;
    const float ss = wave_sum((y[0] * y[0] + y[1] * y[1]) + (y[2] * y[2] + y[3] * y[3]));
    if (lane == 0) ssq3p[sl] = ss;
}
template <int MODE> DI void slice_pass(unsigned char* ws, float* out, int xs, int gw_, int nw_, int lane) {
    const int g = lane >> 3, c = lane & 7;
    const int sl = xs >> 1, tmul = 2, tadd = xs & 1, TT = T / tmul;
    const unsigned short* gidx = (const unsigned short*)(ws + WS_GIDX) + 16 * g;
    const unsigned char* tab = (MODE == 0 ? (const unsigned char*)(ws + WS_U8) : (const unsigned char*)(ws + WS_V8)) + 128 * sl + 16 * c;
    const unsigned char* hqb = (const unsigned char*)(ws + WS_HQ) + 256 * sl + 32 * c;
    const unsigned char* wxb = (const unsigned char*)(ws + WS_WX) + 16 * g;
    const bf16_t* x2b = (const bf16_t*)(ws + WS_X2B) + 256 * sl + 32 * c + ((lane >> 5) & 1) * 16 + ((lane >> 4) & 1) * 8 + ((lane >> 3) & 1) * 4;
#define S_LOAD(m, tok) do { const unsigned short* ip = gidx + (size_t)(tok) * 128; (m).i0 = *(const u32x4*)ip; (m).i1 = *(const u32x4*)(ip + 8); \
        if (MODE == 0) { const unsigned char* hp_ = hqb + (size_t)(tok) * 1024; (m).a0 = *(const u32x4*)hp_; (m).a1 = *(const u32x4*)(hp_ + 16); } \
        else { (m).a0 = *(const u32x4*)(wxb + (size_t)(tok) * 128); (m).a1.x = __float_as_uint(((const float*)(ws + WS_SW))[tok]); { const u32x2 x_ = *(const u32x2*)(x2b + (size_t)(tok) * DM); (m).xw = x_.x; (m).a1.y = x_.y; } } } while (0)
#define S_COMPUTE(m, r, tok) do { if (MODE == 0) slice_u_compute(m, r, (int*)(ws + WS_ACTP) + ((size_t)(tok) * 4 + sl) * 64, lane); \
        else slice_v_compute(m, r, out + (size_t)(tok) * DM, (float*)(ws + WS_SSQ3) + (size_t)(tok) * 4, sl, lane); } while (0)
#define S_ISSUE(r, m) slice_issue<512>(r, m, tab)
    SMeta mA, mB, mN; u32x4 rA[16], rB[16];
    if (gw_ >= TT) return;
    const int n = (TT - gw_ + nw_ - 1) / nw_;
#define S_TK(j) ((gw_ + ((j) < n ? (j) : n - 1) * nw_) * tmul + tadd)
    S_LOAD(mA, S_TK(0)); S_ISSUE(rA, mA); S_LOAD(mB, S_TK(1));
#ifdef S_MPRIO
#define S_MP(x) __builtin_amdgcn_s_setprio(x)
#else
#define S_MP(x)
#endif
    for (int i = 0; i < n; i += 2) {
        S_MP(S_MPRIO); S_ISSUE(rB, mB);
        S_LOAD(mN, S_TK(i + 2)); S_MP(0);
        S_COMPUTE(mA, rA, S_TK(i));
        S_MP(S_MPRIO); mA = mN; S_ISSUE(rA, mA);
        S_LOAD(mN, S_TK(i + 3)); S_MP(0);
        if (i + 1 < n) S_COMPUTE(mB, rB, S_TK(i + 1));
        mB = mN;
    }
#undef S_MP
#undef S_TK
#undef S_LOAD
#undef S_COMPUTE
#undef S_ISSUE
}
typedef int v2i32_t __attribute__((ext_vector_type(2)));
struct VCm { unsigned wd; u32x2 x2; f32x2 sw; };
DI void slice_v2_compute(LAS unsigned char* itr0, LAS unsigned char* itr1, LAS unsigned* wbuf, const VCm& cm, bf16_t* x3row, float* ssq3p, int sl, int lane) {
    int aL[2][2] = {{0, 0}, {0, 0}}, aF[2][2] = {{0, 0}, {0, 0}};
#ifndef VDEPTH
#define VDEPTH 8
#endif
    constexpr int NG = 32 / VDEPTH;
    u32x2 d[2][VDEPTH]; u32x4 w4[2][VDEPTH / 4];
#define V_RD(gi) do { _Pragma("unroll") for (int e = 0; e < VDEPTH / 4; ++e) w4[(gi) & 1][e] = *(const LAS u32x4*)(wbuf + 4 * ((VDEPTH / 4) * (gi) + e)); asm volatile("" ::: "memory"); \
        _Pragma("unroll") for (int e = 0; e < VDEPTH; ++e) d[(gi) & 1][e] = __builtin_bit_cast(u32x2, __builtin_amdgcn_ds_read_tr8_b64_v2i32((LAS v2i32_t*)(((e & 1) ? itr1 : itr0) + 1024 * ((VDEPTH / 2) * (gi) + (e >> 1))))); } while (0)
    V_RD(0);
#pragma unroll
    for (int gi = 0; gi < NG; ++gi) {
        if (gi + 1 < NG) V_RD(gi + 1);
        asm volatile("" ::: "memory");
#ifdef V_PRIO
        if (gi == 0) __builtin_amdgcn_s_setprio(V_PRIO);
#endif
#pragma unroll
        for (int e = 0; e < VDEPTH; ++e) {
            const u32x2 dd = d[gi & 1][e];
            const int wi = 2 * (e >> 1), h = e & 1;
            const int w0 = (int)w4[gi & 1][wi >> 2][wi & 3], w1 = (int)w4[gi & 1][(wi + 1) >> 2][(wi + 1) & 3];
            aL[h][0] = __builtin_amdgcn_sdot4((int)(dd.x & 0x0F0F0F0Fu), w0, aL[h][0], false); aF[h][0] = __builtin_amdgcn_sdot4((int)dd.x, w0, aF[h][0], false);
            aL[h][1] = __builtin_amdgcn_sdot4((int)(dd.y & 0x0F0F0F0Fu), w1, aL[h][1], false); aF[h][1] = __builtin_amdgcn_sdot4((int)dd.y, w1, aF[h][1], false);
        }
    }
#undef V_RD
#ifdef V_PRIO
    __builtin_amdgcn_s_setprio(0);
#endif
#ifdef V_TPRIO
    __builtin_amdgcn_s_setprio(V_TPRIO);
#endif
    const int L0 = aL[0][0] + aL[0][1], F0 = aF[0][0] + aF[0][1], L1 = aL[1][0] + aL[1][1], F1 = aF[1][0] + aF[1][1];
    const float sw = cm.sw[0], wt = cm.sw[1];
    const f32x2 ya = {bflo(cm.x2.x) + ((float)L0 - wt) * sw, bfhi(cm.x2.x) + (float)((F0 - L0) >> 4) * sw}, yb = {bflo(cm.x2.y) + ((float)L1 - wt) * sw, bfhi(cm.x2.y) + (float)((F1 - L1) >> 4) * sw};
#ifdef V_NT_STORE
    __builtin_nontemporal_store(pk_bf16(ya[0], ya[1]), (unsigned*)(x3row + 256 * sl + 2 * lane)); __builtin_nontemporal_store(pk_bf16(yb[0], yb[1]), (unsigned*)(x3row + 256 * sl + 128 + 2 * lane));
#else
    *(unsigned*)(x3row + 256 * sl + 2 * lane) = pk_bf16(ya[0], ya[1]); *(unsigned*)(x3row + 256 * sl + 128 + 2 * lane) = pk_bf16(yb[0], yb[1]);
#endif
    const float ss = wave_sum((ya[0] * ya[0] + ya[1] * ya[1]) + (yb[0] * yb[0] + yb[1] * yb[1]));
    if (lane == 0) ssq3p[sl] = ss;
}
template <int PM> DI void slice_pass_v(unsigned char* ws, bf16_t* out, float* ssq3, LAS unsigned char* lds, int wave, int xs, int gw_, int nw_, int lane) {
    const int g = lane >> 3, c = lane & 7;
    const int sl = xs >> 1, tmul = 2, tadd = xs & 1, TT = T / tmul;
    const unsigned short* gidx = (const unsigned short*)(ws + WS_GIDX) + 16 * g;
    const unsigned char* tab = (const unsigned char*)(ws + WS_V8) + 128 * sl + 16 * c;
    const unsigned* wx32 = (const unsigned*)(ws + WS_WX) + (lane & 31);
    const bf16_t* x2b = (const bf16_t*)(ws + WS_X2B) + 256 * sl + 2 * lane;
    const f32x2* swp = (const f32x2*)(ws + WS_SW);
    LAS unsigned char* img = lds + wave * 16384;
    LAS unsigned char* iw0 = img + g * 2048 + 16 * c, *iw1 = img + g * 2048 + 16 * (c ^ 2), *iw2 = img + g * 2048 + 16 * (c ^ 4), *iw3 = img + g * 2048 + 16 * (c ^ 6);
    const int q = (lane >> 1) & 7, Q = lane >> 4, p = lane & 1;
    LAS unsigned char* itr0 = img + q * 128 + 16 * (Q ^ (q & 6)) + 8 * p;
    LAS unsigned char* itr1 = img + q * 128 + 16 * ((4 + Q) ^ (q & 6)) + 8 * p;
    LAS unsigned* wbuf = (LAS unsigned*)(lds + 131072 + wave * 128);
    if (gw_ >= TT) return;
    const int n = (TT - gw_ + nw_ - 1) / nw_;
#ifndef VREP
#define VREP 1
#endif
    const int nn = n * VREP;
#define V_TK(j) ((gw_ + (((j) < nn ? (j) : nn - 1) % n) * nw_) * tmul + tadd)
#define V_IDX(m, tok) do { const unsigned short* ip = gidx + (size_t)(tok) * 128; (m).i0 = *(const u32x4*)ip; (m).i1 = *(const u32x4*)(ip + 8); } while (0)
#define V_CM(cm, tok) do { (cm).wd = wx32[(size_t)(tok) * 32]; (cm).x2.x = *(const unsigned*)(x2b + (size_t)(tok) * DM); (cm).x2.y = *(const unsigned*)(x2b + (size_t)(tok) * DM + 128); (cm).sw = swp[tok]; } while (0)
#define V_STAGE(r, cm) do { if (PM != 1) { _Pragma("unroll") for (int j = 0; j < 16; ++j) *(LAS u32x4*)((((j >> 1) & 3) == 0 ? iw0 : ((j >> 1) & 3) == 1 ? iw1 : ((j >> 1) & 3) == 2 ? iw2 : iw3) + 128 * j) = r[j]; } wbuf[lane & 31] = (cm).wd; asm volatile("" ::: "memory"); } while (0)
#define V_COMPUTE(cm, tok) do { if (PM != 2) slice_v2_compute(itr0, itr1, wbuf, cm, out + (size_t)(tok) * DM, ssq3 + (size_t)(tok) * 4, sl, lane); asm volatile("" ::: "memory"); } while (0)
#define V_ISS(r, m) do { if (PM != 1) slice_issue<512>(r, m, tab); } while (0)
    SMeta mE, mO; VCm cE, cO; u32x4 rE[16], rO[16];
#ifdef V_STAGGER
    if (wave >= 4) { _Pragma("unroll") for (int z = 0; z < V_STAGGER; ++z) __builtin_amdgcn_s_sleep(16); }
#endif
    V_IDX(mE, V_TK(0)); V_IDX(mO, V_TK(1));
    asm volatile("" ::: "memory");
    V_ISS(rE, mE); V_IDX(mE, V_TK(2)); V_CM(cE, V_TK(0));
    asm volatile("" ::: "memory");
    V_ISS(rO, mO); V_IDX(mO, V_TK(3)); V_CM(cO, V_TK(1));
    asm volatile("" ::: "memory");
#ifdef V_MPRIO
#define V_MP(x) __builtin_amdgcn_s_setprio(x)
#else
#define V_MP(x)
#endif
    for (int i = 0; i < nn; i += 2) {
        V_MP(V_MPRIO); V_STAGE(rE, cE);
        V_ISS(rE, mE); V_IDX(mE, V_TK(i + 4)); V_MP(0);
        V_COMPUTE(cE, V_TK(i));
        V_CM(cE, V_TK(i + 2));
        V_MP(V_MPRIO); V_STAGE(rO, cO);
        V_ISS(rO, mO); V_IDX(mO, V_TK(i + 5)); V_MP(0);
        if (i + 1 < nn) V_COMPUTE(cO, V_TK(i + 1));
        V_CM(cO, V_TK(i + 3));
    }
#undef V_MP
#undef V_TK
#undef V_ISS
#undef V_IDX
#undef V_CM
#undef V_STAGE
#undef V_COMPUTE
}
DI void expert_w_token(const int* actp, const unsigned short* gidx, const float* ggate, float sh, const float* su, const float* sv, unsigned char* wrow, f32x2* swp, int lane) {
    typedef int i32x2 __attribute__((ext_vector_type(2)));
    i32x2 acc = {0, 0};
#pragma unroll
    for (int x = 0; x < 4; ++x) { const int w_ = actp[x * 64 + lane]; acc[0] += (int)(short)(w_ & 0xffff); acc[1] += w_ >> 16; }
    acc[0] <<= 3; acc[1] <<= 3;
    const unsigned ii = *(const unsigned*)(gidx + 2 * lane); const f32x2 gt = *(const f32x2*)(ggate + 2 * lane);
    const int e0 = ii & 0xffffu, e1 = ii >> 16;
    const float w0 = gelu_erf((float)acc[0] * (su[e0] * sh)) * gt[0] * sv[e0], w1 = gelu_erf((float)acc[1] * (su[e1] * sh)) * gt[1] * sv[e1];
    float amax = fmaxf(fabsf(w0), fabsf(w1));
    amax = fmaxf(amax, dpp_f<0xB1>(amax)); amax = fmaxf(amax, dpp_f<0x4E>(amax)); amax = fmaxf(amax, dpp_f<0x141>(amax)); amax = fmaxf(amax, dpp_f<0x128>(amax));
    { const auto r = __builtin_amdgcn_permlane16_swap(__float_as_uint(amax), __float_as_uint(amax), false, false); amax = fmaxf(__uint_as_float(r[0]), __uint_as_float(r[1])); }
    { const auto r = __builtin_amdgcn_permlane32_swap(__float_as_uint(amax), __float_as_uint(amax), false, false); amax = fmaxf(__uint_as_float(r[0]), __uint_as_float(r[1])); }
    const float qs = amax > 0.f ? 127.f / amax : 0.f;
    const int q0 = (int)rintf(w0 * qs), q1 = (int)rintf(w1 * qs);
    *(unsigned short*)(wrow + 2 * lane) = (unsigned short)((q0 & 255) | ((q1 & 255) << 8));
    const float qsum = wave_sum((float)(q0 + q1));
    if (lane == 0) *swp = f32x2{amax * (1.f / 127.f), 8.f * qsum};
}
DI void final_norm_token(const bf16_t* x3row, float* row, const float* ssq3p, const float* gf, int lane) {
    float ss = (lane < 4) ? ssq3p[lane] : 0.f; ss = wave_sum(ss);
    const float r3 = __builtin_amdgcn_rsqf(ss * (1.f / 1024.f) + EPS);
#pragma unroll
    for (int i = 0; i < 4; ++i) { const u32x2 v = *(const u32x2*)(x3row + 256 * i + 4 * lane); const f32x4 x = {bflo(v.x), bfhi(v.x), bflo(v.y), bfhi(v.y)};
        *(f32x4*)(row + 256 * i + 4 * lane) = x * r3 * *(const f32x4*)(gf + 256 * i + 4 * lane); }
}

#define XB_TMO      128
#define XB_XCNT(j)  (256  + 64 * (j))
#define XB_XSUB(j)  (1280 + 64 * (j))
#define XB_XGEN(j)  (2304 + 64 * (j))
#define XB_TOP      3328
#define XB_TOPGEN   3392
#define XCD_BAR_WORDS 3456
#define XB_SPIN_CAP (1u << 18)

__device__ __forceinline__ unsigned xb_ld(unsigned* p)              { return __hip_atomic_load(p, __ATOMIC_RELAXED, __HIP_MEMORY_SCOPE_AGENT); }
__device__ __forceinline__ unsigned xb_add(unsigned* p, unsigned v) { return __hip_atomic_fetch_add(p, v, __ATOMIC_RELAXED, __HIP_MEMORY_SCOPE_AGENT); }
__device__ __forceinline__ unsigned xb_xcc_id() { return (unsigned)__builtin_amdgcn_s_getreg((3 << 11) | 20) & 0xFu; }
#define XB_SPIN(cond, bar) do { unsigned _sp = 0; while (cond) { __builtin_amdgcn_s_sleep(1); \
    if ((++_sp & 255u) == 0u) { if (xb_ld(&(bar)[XB_TMO])) break; if (_sp > XB_SPIN_CAP) { atomicAdd(&(bar)[XB_TMO], 1u); break; } } } } while (0)

struct XcdBarrier {
    unsigned* bar; unsigned x;
    volatile __attribute__((address_space(3))) unsigned* st;
};

__device__ __forceinline__ XcdBarrier xcd_barrier_post(unsigned* bar, volatile __attribute__((address_space(3))) unsigned* st) {
    XcdBarrier b; b.bar = bar; b.x = xb_xcc_id(); b.st = st;
    if (threadIdx.x == 0) st[2] = xb_add(&bar[XB_XCNT(b.x)], 1u);
    return b;
}
__device__ __forceinline__ void xcd_barrier_complete(unsigned* bar, unsigned x, unsigned& nloc, unsigned& nx) {
    const unsigned G = gridDim.x * gridDim.y * gridDim.z;
    unsigned sum, cnt, mine, sp = 0u;
    for (;;) {
        sum = 0u; cnt = 0u; mine = 0u;
#pragma unroll
        for (unsigned j = 0; j < 16; ++j) { const unsigned c = xb_ld(&bar[XB_XCNT(j)]); sum += c; cnt += (c > 0u) ? 1u : 0u; mine = (j == x) ? c : mine; }
        if (sum == G) break;
        __builtin_amdgcn_s_sleep(1);
        if ((++sp & 255u) == 0u) { if (xb_ld(&bar[XB_TMO])) break; if (sp > XB_SPIN_CAP) { atomicAdd(&bar[XB_TMO], 1u); break; } }
    }
    nloc = mine > 0u ? mine : 1u; nx = cnt > 0u ? cnt : 1u;
}

__device__ __forceinline__ void xcd_barrier(const XcdBarrier& b) {
    asm volatile("s_waitcnt vmcnt(0)" ::: "memory");
    __syncthreads();
    if (threadIdx.x == 0) {
        unsigned* bar = b.bar;
        __builtin_amdgcn_s_waitcnt(0);
        unsigned nloc = b.st[0], nx = b.st[1];
        if (nloc == 0u) { xcd_barrier_complete(bar, b.x, nloc, nx); b.st[0] = nloc; b.st[1] = nx; }
        const unsigned old = xb_add(&bar[XB_XSUB(b.x)], 1u);
        const unsigned gen = old / nloc;
        if (old + 1u == (gen + 1u) * nloc) {
            __builtin_amdgcn_fence(__ATOMIC_RELEASE, "agent");
            asm volatile("s_waitcnt vmcnt(0)" ::: "memory");
            const unsigned og = xb_add(&bar[XB_TOP], 1u);
            const unsigned tg = og / nx;
            if (og + 1u == (tg + 1u) * nx) xb_add(&bar[XB_TOPGEN], 1u);
            else XB_SPIN(xb_ld(&bar[XB_TOPGEN]) == tg, bar);
            __builtin_amdgcn_fence(__ATOMIC_ACQUIRE, "agent");
            xb_add(&bar[XB_XGEN(b.x)], 1u);
            asm volatile("s_waitcnt vmcnt(0)" ::: "memory");
        } else {
            XB_SPIN(xb_ld(&bar[XB_XGEN(b.x)]) == gen, bar);
            __builtin_amdgcn_fence(__ATOMIC_ACQUIRE, "agent");
            asm volatile("s_waitcnt vmcnt(0)" ::: "memory");
        }
    }
    __syncthreads();
}

constexpr int N_PHASES = 13;
__global__ void __launch_bounds__(NTHR, 2) mk_fwd(Args a) {
    extern __shared__ __attribute__((aligned(16))) unsigned char lds_raw[];
    LAS unsigned char* lds = (LAS unsigned char*)lds_raw;
    cg::grid_group grid = cg::this_grid();
    const int G = gridDim.x, vb = blockIdx.x, tid = threadIdx.x, lane = tid & 63, wave = tid >> 6;
    unsigned char* ws = a.ws;
    const int lo = a.ph_lo, hi = a.ph_hi;
    volatile LAS unsigned* MISC = (volatile LAS unsigned*)(lds + LDS_BYTES - 64);
    if (tid < 16) MISC[tid] = 0u;
    __syncthreads();
    const XcdBarrier bar = xcd_barrier_post((unsigned*)(ws + 4096) + lo * XCD_BAR_WORDS, MISC);
#ifndef PHASE_MASK
#define PHASE_MASK 0xFFFF
#endif
#define IN(k) (((PHASE_MASK >> (k)) & 1) && lo <= (k) && (k) < hi)
#ifndef REPEAT_MASK
#define REPEAT_MASK 0
#endif
#define REP(k) for (int rep_ = 0; rep_ < (((REPEAT_MASK) >> (k)) & 1) + 1; ++rep_)
#define SEAM(k) do { if (IN(k) && IN((k) + 1)) { if ((k) == 0) grid.sync(); else xcd_barrier(bar); } } while (0)
    REP(0) if (IN(0)) p0_prologue(a, lds, vb, G);
    SEAM(0);
    REP(1) if (IN(1)) { pg8::Gemm g{(const bf16_t*)(ws + WS_XB), (const bf16_t*)(ws + WS_W1T), T, NIN, 1024}; pg8::StaticOrder S; S.init(T, NIN, G, vb);
        pg8::Epi1 E{(const float*)(ws + WS_RSTD1), (bf16_t*)(ws + WS_PA), (bf16_t*)(ws + WS_GG), (bf16_t*)(ws + WS_QD), (bf16_t*)(ws + WS_KINV), (bf16_t*)(ws + WS_KENDT), (bf16_t*)(ws + WS_VT), (bf16_t*)(ws + WS_GS),
                    (float*)(ws + WS_DEC), (const float*)(ws + WS_LB), (bf16_t*)(ws + WS_AVT), lds + 131072};
        pg8::gemm_phase<pg8::Epi1, pg8::StaticOrder, true, true>(lds, g, S, E); }
    SEAM(1);
    REP(2) if (IN(2)) {
        for (int u0 = vb * 8; u0 < 64 * 64; u0 += G * 8) {
            { int t2_ = threadIdx.x; asm volatile("" : "+v"(t2_)); const int u = u0 + (t2_ >> 6);
              hgrn_prep_unit((bf16_t*)(ws + WS_QD), (bf16_t*)(ws + WS_KINV), lds + (t2_ >> 6) * 18432, (float*)(ws + WS_DEC), (const float*)(ws + WS_LB), u >> 6, u & 63, (t2_ & 63) * 2); }
            __syncthreads();
            for (int j = 0; j < 8; ++j) hgrn_ds_unit(lds + j * 18432, (const bf16_t*)(ws + WS_VT), (bf16_t*)a.out, (u0 + j) >> 6, (u0 + j) & 63);
            __syncthreads();
        }
        for (int u = vb; u < BATCH * (SEQ / 64); u += G) attn_unit((const bf16_t*)(ws + WS_PA), (const bf16_t*)(ws + WS_AVT), a.in[3], (bf16_t*)(ws + WS_YA), lds, u >> 6, u & 63);
    }
    SEAM(2);
    REP(3) if (IN(3)) hgrn_scan((bf16_t*)a.out, (const float*)(ws + WS_DEC), vb, G);
    SEAM(3);
    REP(4) if (IN(4)) hgrn_out_phase((const bf16_t*)(ws + WS_QD), (const bf16_t*)(ws + WS_KINV), (const bf16_t*)(ws + WS_VT), (const bf16_t*)a.out, (const bf16_t*)(ws + WS_GS), (bf16_t*)(ws + WS_YH), lds, vb, G);
    SEAM(4);
    REP(5) if (IN(5)) {
#ifdef P5_STAGGER
        if (vb & 1) { _Pragma("unroll") for (int z = 0; z < P5_STAGGER; ++z) __builtin_amdgcn_s_sleep(127); }
#endif
        { pg8::Gemm g{(const bf16_t*)(ws + WS_YA), (const bf16_t*)(ws + WS_WAPT), T, 1024, 512}; pg8::StaticOrder S; S.init(T, 1024, G, vb);
          pg8::EpiMerge<false> E{(bf16_t*)((unsigned char*)a.out + 128 * MiB), (const bf16_t*)(ws + WS_GG)};
          pg8::gemm_phase<pg8::EpiMerge<false>, pg8::StaticOrder, true, true>(lds, g, S, E); }
        __syncthreads();
        { pg8::Gemm g{(const bf16_t*)(ws + WS_YH), (const bf16_t*)(ws + WS_WHPT), T, 1024, 512}; pg8::StaticOrder S; S.init(T, 1024, G, vb);
          pg8::EpiMerge<true> E{(bf16_t*)((unsigned char*)a.out + 128 * MiB), (const bf16_t*)(ws + WS_GG) + 1024};
          pg8::gemm_phase<pg8::EpiMerge<true>, pg8::StaticOrder, true, true>(lds, g, S, E); }
    }
    SEAM(5);
    REP(6) if (IN(6)) { pg8::Gemm g{(const bf16_t*)((unsigned char*)a.out + 128 * MiB), (const bf16_t*)(ws + WS_WOUTT), T, 1024, 1024}; pg8::StaticOrder S; S.init(T, 1024, G, vb);
        pg8::EpiX2 E{(const bf16_t*)(ws + WS_XB), (bf16_t*)(ws + WS_X2B), (float*)(ws + WS_SSQ2)};
        pg8::gemm_phase<pg8::EpiX2, pg8::StaticOrder, true, true>(lds, g, S, E); }
    SEAM(6);
    REP(7) if (IN(7)) { pg8::Gemm g{(const bf16_t*)(ws + WS_X2B), (const bf16_t*)(ws + WS_WQT), T, 2048, 1024}; pg8::StaticOrder S; S.init(T, 2048, G, vb);
        pg8::EpiQp E{(bf16_t*)(ws + WS_QP), (const float*)(ws + WS_SSQ2)};
        pg8::gemm_phase<pg8::EpiQp, pg8::StaticOrder, true, true>(lds, g, S, E); }
    SEAM(7);
    REP(8) if (IN(8)) { const int per = (1024 + G - 1) / G; int hcur = -1;
        for (int U = vb * per; U < (vb + 1) * per && U < 1024; ++U) { const int h = U >> 7;
            if (h != hcur) { topk_stage_keys((const bf16_t*)(ws + WS_KEYS), lds + 65536, h); hcur = h; __syncthreads(); }
            topk_unit((const bf16_t*)(ws + WS_QP), lds + 65536, (unsigned short*)(ws + WS_GIDX), (float*)(ws + WS_GGATE), (LAS unsigned*)lds, U & 127, h); }
        for (int tok = vb * 8 + wave; tok < T; tok += G * 8) hq_token((const bf16_t*)(ws + WS_X2B) + (size_t)tok * DM, (const float*)(ws + WS_SSQ2) + (size_t)tok * 16, (unsigned char*)(ws + WS_HQ) + (size_t)tok * 1024, (float*)(ws + WS_SH) + tok, lane); }
    SEAM(8);
    if (IN(9) || IN(11)) {
        if (tid == 0) {
            unsigned nloc_ = 0, nx_ = 0; xcd_barrier_complete(bar.bar, bar.x, nloc_, nx_);
            unsigned cj[8], tot = 0; bool all = true;
#pragma unroll
            for (int j = 0; j < 8; ++j) { cj[j] = xb_ld(&bar.bar[XB_XCNT(j)]); tot += cj[j]; all = all && cj[j] > 0u; }
            if (all && tot == (unsigned)G && bar.x < 8u) { MISC[4] = bar.x; MISC[5] = MISC[2]; MISC[6] = cj[bar.x & 7u]; }
            else { const unsigned sl_ = (unsigned)vb & 7u; MISC[4] = sl_; MISC[5] = (unsigned)vb >> 3; MISC[6] = ((unsigned)G - sl_ + 7u) >> 3; }
        }
        __syncthreads();
    }
    REP(9) if (IN(9)) slice_pass<0>(ws, a.out, (int)MISC[4], (int)MISC[5] * 8 + __builtin_amdgcn_readfirstlane(wave), (int)MISC[6] * 8, lane);
    SEAM(9);
    REP(10) if (IN(10)) for (int tok = vb * 8 + wave; tok < T; tok += G * 8)
        expert_w_token((const int*)(ws + WS_ACTP) + (size_t)tok * 256, (const unsigned short*)(ws + WS_GIDX) + (size_t)tok * 128, (const float*)(ws + WS_GGATE) + (size_t)tok * 128, ((const float*)(ws + WS_SH))[tok],
                       (const float*)(ws + WS_SU), (const float*)(ws + WS_SV), (unsigned char*)(ws + WS_WX) + (size_t)tok * 128, (f32x2*)(ws + WS_SW) + tok, lane);
    SEAM(10);
    if (IN(11)) slice_pass_v<0>(ws, (bf16_t*)(ws + WS_X2B), (float*)(ws + WS_SSQ3), lds, __builtin_amdgcn_readfirstlane(wave), (int)MISC[4], (int)MISC[5] * 8 + __builtin_amdgcn_readfirstlane(wave), (int)MISC[6] * 8, lane);
#ifdef PROBE_VPM
    if (IN(11)) slice_pass_v<PROBE_VPM>(ws, (bf16_t*)(ws + WS_QP), (float*)(ws + WS_QP), lds, __builtin_amdgcn_readfirstlane(wave), (int)MISC[4], (int)MISC[5] * 8 + __builtin_amdgcn_readfirstlane(wave), (int)MISC[6] * 8, lane);
#endif
    SEAM(11);
    if (IN(12)) for (int tok = vb * 8 + wave; tok < T; tok += G * 8) final_norm_token((const bf16_t*)(ws + WS_X2B) + (size_t)tok * DM, a.out + (size_t)tok * DM, (const float*)(ws + WS_SSQ3) + (size_t)tok * 4, a.in[14], lane);
#undef IN
#undef SEAM
}

extern "C" void kernel_launch(void* const* d_in, const int* in_sizes, int n_in, void* d_out, int out_size, void* d_ws, size_t ws_size, hipStream_t stream) {
    static int grid = 0;
    if (grid == 0) {
        if (n_in != 15 || in_sizes[0] != T * DM || out_size != T * DM || ws_size < WS_END) { fprintf(stderr, "kernel_launch: unexpected shapes (n_in %d, in0 %d, out %d, ws %zu)\n", n_in, n_in > 0 ? in_sizes[0] : -1, out_size, ws_size); grid = -1; return; }
        int dev = 0, cus = 0, per_cu = 0;
        hipGetDevice(&dev); hipDeviceGetAttribute(&cus, hipDeviceAttributeMultiprocessorCount, dev);
        if (hipFuncSetAttribute((const void*)mk_fwd, hipFuncAttributeMaxDynamicSharedMemorySize, LDS_BYTES) != hipSuccess) { fprintf(stderr, "kernel_launch: hipFuncSetAttribute failed\n"); grid = -1; return; }
        if (hipOccupancyMaxActiveBlocksPerMultiprocessor(&per_cu, (const void*)mk_fwd, NTHR, LDS_BYTES) != hipSuccess || per_cu < 1) { fprintf(stderr, "kernel_launch: occupancy query says %d blocks per CU\n", per_cu); per_cu = 1; }
        (void)hipGetLastError();
        grid = cus;
    }
    if (grid < 0) return;
    if (hipMemsetAsync(d_ws, 0, 256 * 1024, stream) != hipSuccess) { fprintf(stderr, "kernel_launch: hipMemsetAsync failed\n"); return; }
    Args a{};
    for (int i = 0; i < 15; ++i) a.in[i] = (const float*)d_in[i];
    a.out = (float*)d_out; a.ws = (unsigned char*)d_ws;
#if MK_FUSED
    a.ph_lo = 0; a.ph_hi = N_PHASES;
    { void* args[] = {&a}; hipError_t e = hipLaunchCooperativeKernel((const void*)mk_fwd, dim3(grid), dim3(NTHR), args, LDS_BYTES, stream);
      if (e != hipSuccess) fprintf(stderr, "kernel_launch: cooperative launch failed: %s (grid %d)\n", hipGetErrorString(e), grid); }
#else
    for (int p = 0; p < N_PHASES; ++p) { a.ph_lo = p; a.ph_hi = p + 1; void* args[] = {&a};
        hipError_t e = hipLaunchCooperativeKernel((const void*)mk_fwd, dim3(grid), dim3(NTHR), args, LDS_BYTES, stream);
        if (e != hipSuccess) { fprintf(stderr, "kernel_launch: launch of phase %d failed: %s (grid %d)\n", p, hipGetErrorString(e), grid); break; } }
#endif
}
```

```cpp
#include <hip/hip_runtime.h>
#include <hip/hip_cooperative_groups.h>
#include <cstdio>
#include <cstdint>
namespace cg = cooperative_groups;
#define V_MPRIO 1
namespace pg8 {
#define PG8_LAS __attribute__((address_space(3)))
typedef unsigned short bf16_t;
typedef short bf16x8 __attribute__((ext_vector_type(8)));
typedef float f32x4 __attribute__((ext_vector_type(4)));
typedef unsigned u32x4 __attribute__((ext_vector_type(4)));
constexpr int BM = 256, BK = 64, HALF = 128, HTB = HALF * BK * 2  , STAGE_BYTES = 8 * HTB, NXCD = 8, WGM = 8;

__host__ __device__ __forceinline__ int lds_byte(int r, int c) { const int st = (r >> 4) * 2 + (c >> 5), rr = r & 15, cc = c & 31, ob = rr * 64 + cc * 2; return st * 1024 + (ob ^ (((ob >> 9) & 1) << 5)); }
__host__ __device__ __forceinline__ void stage_rc(int b, int& R, int& C) { const int st = b / 1024, sb = b % 1024, swz = sb ^ (((sb >> 9) & 1) << 5); R = (st >> 1) * 16 + swz / 64; C = (st & 1) * 32 + (swz % 64) / 2; }
__host__ __device__ __forceinline__ int perm32(int rho) { const int n = rho >> 4, i = rho & 15; return 8 * (i >> 2) + 4 * n + (i & 3); }

struct Unit { int pm, pn; };
struct Gemm { const bf16_t* A; const bf16_t* Bt; int M, N, K; };

struct StaticOrder {
    int nM, nN, nwg, G, c;
    __host__ __device__ void init(int M, int N, int G_, int c_) { nM = M / BM; nN = N / BM; nwg = nM * nN; G = G_; c = c_; }
    __host__ __device__ bool next(int i, Unit& u) const {
        const long L = (long)i * G + c; if (L >= nwg) return false;
        int wgid = (int)L; { const int q = nwg / NXCD, r = nwg % NXCD, xcd = wgid % NXCD, off = wgid / NXCD; wgid = (xcd < r ? xcd * (q + 1) : r * (q + 1) + (xcd - r) * q) + off; }
        const int nig = WGM * nN, gid = wgid / nig, fm = gid * WGM, gsz = (nM - fm) < WGM ? (nM - fm) : WGM;
        u.pm = fm + ((wgid % nig) % gsz); u.pn = (wgid % nig) / gsz; return true;
    }
    __device__ __forceinline__ void a_ready(const Unit&) const {}
    __device__ __forceinline__ void done(const Unit&) const {}
};

__device__ __forceinline__ unsigned cvt_pk_bf16(float lo, float hi) { unsigned r; asm volatile("v_cvt_pk_bf16_f32 %0, %1, %2" : "=v"(r) : "v"(lo), "v"(hi)); return r; }

template <class Epi, class Sched, bool ALIGN_EPI = false, bool SP2 = false>
__device__ __forceinline__ void gemm_phase(PG8_LAS unsigned char* lds, const Gemm g, const Sched& S, const Epi& E) {
    int tid_ = threadIdx.x; asm volatile("" : "+v"(tid_));
    const int tid = tid_, wid = __builtin_amdgcn_readfirstlane(tid >> 6), lane = tid & 63, wr = wid >> 2, wc = wid & 3, fr = lane & 15, fq = lane >> 4;
    const int K = g.K, nt = K / BK;
    unsigned voffA[2], voffB[2];
#pragma unroll
    for (int i = 0; i < 2; ++i) { int R, C; stage_rc(tid * 16 + i * 8192, R, C); const int Rb = Epi::PERM ? ((R & ~31) + perm32(R & 31)) : R;
        voffA[i] = (unsigned)(R * K + C) * 2u; voffB[i] = (unsigned)(Rb * K + C) * 2u; }
    const size_t kstep = (size_t)(BK * 2);
    const size_t hstep = (size_t)HALF * K * 2;
    const size_t tstep = 2 * hstep;
    const unsigned ldsw = (unsigned)wid * 1024u;
    const int aoff = lds_byte(wr * 64 + fr, fq * 8), boff = lds_byte(wc * 32 + fr, fq * 8);
#define PG8_SA(b, h) (((b) * 2 + (h)) * HTB)
#define PG8_SB(b, h) ((4 + (b) * 2 + (h)) * HTB)
#define PG8_STAGE(bufoff, gbase, voff) do { _Pragma("unroll") for (int _i = 0; _i < 2; ++_i) \
        __builtin_amdgcn_global_load_lds((const unsigned*)((const char*)(gbase) + (voff)[_i]), (PG8_LAS unsigned*)(lds + (bufoff) + ldsw + _i * 8192), 16, 0, 0); } while (0)
#define PG8_LDA(dst, b, h) do { _Pragma("unroll") for (int m = 0; m < 4; ++m) _Pragma("unroll") for (int k = 0; k < 2; ++k) dst[m][k] = *(const PG8_LAS bf16x8*)(lds + PG8_SA(b, h) + aoff + m * 2048 + k * 1024); } while (0)
#define PG8_LDB(dst, b, h) do { _Pragma("unroll") for (int n = 0; n < 2; ++n) _Pragma("unroll") for (int k = 0; k < 2; ++k) dst[n][k] = *(const PG8_LAS bf16x8*)(lds + PG8_SB(b, h) + boff + n * 2048 + k * 1024); } while (0)
#define PG8_MMA(ai, bj, At, Bt) do { __builtin_amdgcn_s_setprio(1); _Pragma("unroll") for (int m = 0; m < 4; ++m) _Pragma("unroll") for (int n = 0; n < 2; ++n) _Pragma("unroll") for (int k = 0; k < 2; ++k) \
        acc[ai][bj][m][n] = __builtin_amdgcn_mfma_f32_16x16x32_bf16(Bt[n][k], At[m][k], acc[ai][bj][m][n], 0, 0, 0); __builtin_amdgcn_s_setprio(0); } while (0)
#define PG8_WAIT_V(n) asm volatile("s_waitcnt vmcnt(" #n ")" ::: "memory")
#define PG8_WAIT_L(n) asm volatile("s_waitcnt lgkmcnt(" #n ")" ::: "memory")
#define PG8_BAR __builtin_amdgcn_s_barrier()
#define PG8_SCHED __builtin_amdgcn_sched_barrier(0)
    Unit cur, nxt; int ui = 0;
    if (!S.next(0, cur)) return;
    f32x4 acc[2][2][4][2];
#pragma unroll
    for (int a = 0; a < 2; ++a)
#pragma unroll
        for (int b = 0; b < 2; ++b)
#pragma unroll
            for (int m = 0; m < 4; ++m)
#pragma unroll
                for (int n = 0; n < 2; ++n) acc[a][b][m][n] = (f32x4){0.f, 0.f, 0.f, 0.f};
    bf16x8 At[4][2], B0[2][2], B1[2][2];
    const char* cA = (const char*)g.A + (size_t)cur.pm * tstep; const char* cB = (const char*)g.Bt + (size_t)cur.pn * tstep;
    S.a_ready(cur);
    if constexpr (SP2) {
        PG8_STAGE(PG8_SB(0, 0), cB, voffB); PG8_STAGE(PG8_SB(0, 1), cB + hstep, voffB); PG8_STAGE(PG8_SA(0, 0), cA, voffA); PG8_STAGE(PG8_SA(0, 1), cA + hstep, voffA);
        if (wr == 1) PG8_BAR;
        PG8_WAIT_V(2); PG8_BAR;
        PG8_STAGE(PG8_SB(1, 0), cB + kstep, voffB); PG8_STAGE(PG8_SA(1, 0), cA + kstep, voffA); PG8_STAGE(PG8_SB(1, 1), cB + hstep + kstep, voffB);
        PG8_WAIT_V(6); PG8_BAR;
    } else {
        PG8_STAGE(PG8_SB(0, 0), cB, voffB); PG8_STAGE(PG8_SA(0, 0), cA, voffA); PG8_STAGE(PG8_SB(0, 1), cB + hstep, voffB); PG8_STAGE(PG8_SA(0, 1), cA + hstep, voffA);
        if (wr == 1) PG8_BAR;
        PG8_WAIT_V(4); PG8_BAR;
        PG8_STAGE(PG8_SB(1, 0), cB + kstep, voffB); PG8_STAGE(PG8_SA(1, 0), cA + kstep, voffA); PG8_STAGE(PG8_SB(1, 1), cB + hstep + kstep, voffB);
        PG8_WAIT_V(6); PG8_BAR;
    }
    for (;;) {
        const bool has_next = S.next(ui + 1, nxt);
        const char* nA = has_next ? (const char*)g.A + (size_t)nxt.pm * tstep : cA; const char* nB = has_next ? (const char*)g.Bt + (size_t)nxt.pn * tstep : cB;
        for (int t = 0; t < nt; t += 2) {
            const bool last = (t == nt - 2);
            const char* a1 = cA + (size_t)(t + 1) * kstep;
            const char* a2 = last ? nA : cA + (size_t)(t + 2) * kstep; const char* b2 = last ? nB : cB + (size_t)(t + 2) * kstep;
            const char* a3 = a2 + kstep; const char* b3 = b2 + kstep;
            if (last && has_next) S.a_ready(nxt);
            if constexpr (SP2) {
            PG8_LDB(B0, 0, 0); PG8_LDB(B1, 0, 1); PG8_SCHED; PG8_LDA(At, 0, 0); PG8_STAGE(PG8_SA(1, 1), a1 + hstep, voffA);
            PG8_WAIT_V(8); PG8_WAIT_L(0); PG8_BAR; PG8_MMA(0, 0, At, B0); PG8_MMA(0, 1, At, B1); PG8_BAR; PG8_SCHED;
            PG8_LDA(At, 0, 1); PG8_STAGE(PG8_SB(0, 0), b2, voffB); PG8_STAGE(PG8_SB(0, 1), b2 + hstep, voffB); PG8_STAGE(PG8_SA(0, 0), a2, voffA);
            PG8_WAIT_V(8); PG8_WAIT_L(0); PG8_BAR; PG8_MMA(1, 0, At, B0); PG8_MMA(1, 1, At, B1); PG8_BAR; PG8_SCHED;
            PG8_LDB(B0, 1, 0); PG8_LDB(B1, 1, 1); PG8_SCHED; PG8_LDA(At, 1, 0); PG8_STAGE(PG8_SA(0, 1), a2 + hstep, voffA);
            PG8_WAIT_V(8); PG8_WAIT_L(0); PG8_BAR; PG8_MMA(0, 0, At, B0); PG8_MMA(0, 1, At, B1); PG8_BAR; PG8_SCHED;
            PG8_LDA(At, 1, 1); PG8_STAGE(PG8_SB(1, 0), b3, voffB); PG8_STAGE(PG8_SB(1, 1), b3 + hstep, voffB); PG8_STAGE(PG8_SA(1, 0), a3, voffA);
            PG8_WAIT_V(8); PG8_WAIT_L(0); PG8_BAR; PG8_MMA(1, 0, At, B0); PG8_MMA(1, 1, At, B1); PG8_BAR; PG8_SCHED;
            } else {
            PG8_LDB(B0, 0, 0); PG8_SCHED; PG8_LDA(At, 0, 0); PG8_STAGE(PG8_SA(1, 1), a1 + hstep, voffA);
            PG8_WAIT_L(8); PG8_BAR; PG8_WAIT_L(0); PG8_MMA(0, 0, At, B0); PG8_BAR; PG8_SCHED;
            PG8_LDB(B1, 0, 1); PG8_STAGE(PG8_SB(0, 0), b2, voffB);
            PG8_BAR; PG8_WAIT_L(0); PG8_MMA(0, 1, At, B1); PG8_BAR;
            PG8_LDA(At, 0, 1); PG8_STAGE(PG8_SA(0, 0), a2, voffA);
            PG8_BAR; PG8_WAIT_L(0); PG8_MMA(1, 0, At, B0); PG8_BAR; PG8_SCHED;
            PG8_STAGE(PG8_SB(0, 1), b2 + hstep, voffB);
            PG8_WAIT_V(6); PG8_BAR; PG8_MMA(1, 1, At, B1); PG8_BAR;
            PG8_LDB(B0, 1, 0); PG8_SCHED; PG8_LDA(At, 1, 0); PG8_STAGE(PG8_SA(0, 1), a2 + hstep, voffA);
            PG8_WAIT_L(8); PG8_BAR; PG8_WAIT_L(0); PG8_MMA(0, 0, At, B0); PG8_BAR; PG8_SCHED;
            PG8_LDB(B1, 1, 1); PG8_STAGE(PG8_SB(1, 0), b3, voffB);
            PG8_BAR; PG8_WAIT_L(0); PG8_MMA(0, 1, At, B1); PG8_BAR;
            PG8_LDA(At, 1, 1); PG8_STAGE(PG8_SA(1, 0), a3, voffA);
            PG8_BAR; PG8_WAIT_L(0); PG8_MMA(1, 0, At, B0); PG8_BAR; PG8_SCHED;
            PG8_STAGE(PG8_SB(1, 1), b3 + hstep, voffB);
            PG8_WAIT_V(6); PG8_BAR; PG8_MMA(1, 1, At, B1); PG8_BAR;
            }
        }
        if constexpr (ALIGN_EPI) { if (wr == 0) PG8_BAR; }
        if constexpr (!Epi::AFTER_DRAIN) { E(acc, cur, wr, wc, fr, fq); S.done(cur); }
        if (!has_next) break;
#pragma unroll
        for (int a = 0; a < 2; ++a)
#pragma unroll
            for (int b = 0; b < 2; ++b)
#pragma unroll
                for (int m = 0; m < 4; ++m)
#pragma unroll
                    for (int n = 0; n < 2; ++n) acc[a][b][m][n] = (f32x4){0.f, 0.f, 0.f, 0.f};
        cur = nxt; cA = nA; cB = nB; ++ui;
        if constexpr (ALIGN_EPI) { if (wr == 1) PG8_BAR; }
    }
    PG8_WAIT_V(0);
    if constexpr (!ALIGN_EPI) { if (wr == 0) PG8_BAR; }
    PG8_BAR;
    if constexpr (Epi::AFTER_DRAIN) { E.fused(acc, cur, wr, wc, fr, fq, lds, wid, lane); S.done(cur); }
#undef PG8_SA
#undef PG8_SB
#undef PG8_STAGE
#undef PG8_LDA
#undef PG8_LDB
#undef PG8_MMA
#undef PG8_WAIT_V
#undef PG8_WAIT_L
#undef PG8_BAR
#undef PG8_SCHED
}
}

#ifndef MK_FUSED
#define MK_FUSED 1
#endif
#define DI __device__ __forceinline__
#define LAS __attribute__((address_space(3)))
typedef unsigned short bf16_t;
typedef float f32x4 __attribute__((ext_vector_type(4)));
typedef float f32x2 __attribute__((ext_vector_type(2)));
typedef float f32x16 __attribute__((ext_vector_type(16)));
typedef unsigned u32x4 __attribute__((ext_vector_type(4)));
typedef unsigned u32x2 __attribute__((ext_vector_type(2)));
typedef short bf16x8 __attribute__((ext_vector_type(8)));
typedef _Float16 h16x2 __attribute__((ext_vector_type(2)));
typedef _Float16 h16x8 __attribute__((ext_vector_type(8)));

constexpr int BATCH = 16, SEQ = 4096, T = BATCH * SEQ, DM = 1024, NIN = 4864;
constexpr int C_AQ = 0, C_AK = 512, C_AV = 640, C_HQ = 768, C_HF = 1280, C_HI = 1792, C_HG = 2304, C_GA = 2816, C_GH = 3840;
constexpr float EPS = 1e-6f;
constexpr int NTHR = 512;
constexpr int LDS_BYTES = 163840;

constexpr size_t MiB = 1u << 20;
constexpr size_t WS_W1T = 1 * MiB;
constexpr size_t WS_WAPT = 11 * MiB;
constexpr size_t WS_WHPT = 12 * MiB;
constexpr size_t WS_WOUTT = 13 * MiB;
constexpr size_t WS_WQT = 15 * MiB;
constexpr size_t WS_KEYS = 19 * MiB;
constexpr size_t WS_LB = 19 * MiB + 512 * 1024;
constexpr size_t WS_RSTD1 = 20 * MiB;
constexpr size_t WS_SSQ2 = 21 * MiB;
constexpr size_t WS_U8 = 26 * MiB;
constexpr size_t WS_V8 = 42 * MiB;
constexpr size_t WS_SU = 58 * MiB;
constexpr size_t WS_SV = 58 * MiB + 65536;
constexpr size_t WS_DEC = 60 * MiB;
constexpr size_t WS_AVT = 64 * MiB;
constexpr size_t WS_XB = 90 * MiB;
constexpr size_t WS_PA = 218 * MiB;
constexpr size_t WS_GG = 314 * MiB;
constexpr size_t WS_QD = 570 * MiB;
constexpr size_t WS_KINV = 634 * MiB;
constexpr size_t WS_KENDT = 698 * MiB;
constexpr size_t WS_VT = 762 * MiB;
constexpr size_t WS_GS = 826 * MiB;
constexpr size_t WS_YA = 890 * MiB;
constexpr size_t WS_YH = 954 * MiB;
constexpr size_t WS_END = 1018 * MiB;
constexpr size_t WS_HQ = 698 * MiB;
constexpr size_t WS_WX = 762 * MiB;
constexpr size_t WS_SH = 60 * MiB;
constexpr size_t WS_SSQ3 = 64 * MiB;
constexpr size_t WS_SW = 61 * MiB;
constexpr size_t WS_ACTP = 346 * MiB;
constexpr size_t WS_X2B = 218 * MiB;
constexpr size_t WS_QP = 346 * MiB;
constexpr size_t WS_GIDX = 602 * MiB;
constexpr size_t WS_GGATE = 618 * MiB;

struct Args { const float* in[15]; float* out; unsigned char* ws; int ph_lo, ph_hi; };

DI unsigned pk_bf16(float lo, float hi) { typedef __bf16 b2 __attribute__((ext_vector_type(2))); f32x2 v = {lo, hi}; b2 b = __builtin_convertvector(v, b2); return __builtin_bit_cast(unsigned, b); }
DI float bflo(unsigned w) { return __uint_as_float(w << 16); }
DI float bfhi(unsigned w) { return __uint_as_float(w & 0xffff0000u); }
DI float sigm(float x) { return __builtin_amdgcn_rcpf(1.f + __expf(-x)); }
DI float wave_sum(float v) {
    v += __int_as_float(__builtin_amdgcn_mov_dpp(__float_as_int(v), 0xB1, 0xf, 0xf, true));
    v += __int_as_float(__builtin_amdgcn_mov_dpp(__float_as_int(v), 0x4E, 0xf, 0xf, true));
    v += __int_as_float(__builtin_amdgcn_mov_dpp(__float_as_int(v), 0x141, 0xf, 0xf, true));
    v += __int_as_float(__builtin_amdgcn_mov_dpp(__float_as_int(v), 0x128, 0xf, 0xf, true));
    { const auto r = __builtin_amdgcn_permlane16_swap(__float_as_uint(v), __float_as_uint(v), false, false); v = __uint_as_float(r[0]) + __uint_as_float(r[1]); }
    { const auto r = __builtin_amdgcn_permlane32_swap(__float_as_uint(v), __float_as_uint(v), false, false); v = __uint_as_float(r[0]) + __uint_as_float(r[1]); }
    return v;
}
DI float wave_max(float v) {
    v = fmaxf(v, __int_as_float(__builtin_amdgcn_mov_dpp(__float_as_int(v), 0xB1, 0xf, 0xf, true)));
    v = fmaxf(v, __int_as_float(__builtin_amdgcn_mov_dpp(__float_as_int(v), 0x4E, 0xf, 0xf, true)));
    v = fmaxf(v, __int_as_float(__builtin_amdgcn_mov_dpp(__float_as_int(v), 0x141, 0xf, 0xf, true)));
    v = fmaxf(v, __int_as_float(__builtin_amdgcn_mov_dpp(__float_as_int(v), 0x128, 0xf, 0xf, true)));
    { const auto r = __builtin_amdgcn_permlane16_swap(__float_as_uint(v), __float_as_uint(v), false, false); v = fmaxf(__uint_as_float(r[0]), __uint_as_float(r[1])); }
    { const auto r = __builtin_amdgcn_permlane32_swap(__float_as_uint(v), __float_as_uint(v), false, false); v = fmaxf(__uint_as_float(r[0]), __uint_as_float(r[1])); }
    return v;
}
DI unsigned short bf16_1(float x) { return (unsigned short)(pk_bf16(x, 0.f) & 0xffffu); }
template <int N> DI float dpp_row_shr(float v) { return __int_as_float(__builtin_amdgcn_update_dpp(0, __float_as_int(v), 0x110 + N, 0xf, 0xf, true)); }
DI float rowsum16(float v) { v += __int_as_float(__builtin_amdgcn_mov_dpp(__float_as_int(v), 0xB1, 0xf, 0xf, true)); v += __int_as_float(__builtin_amdgcn_mov_dpp(__float_as_int(v), 0x4E, 0xf, 0xf, true));
    v += __int_as_float(__builtin_amdgcn_mov_dpp(__float_as_int(v), 0x141, 0xf, 0xf, true)); v += __int_as_float(__builtin_amdgcn_mov_dpp(__float_as_int(v), 0x128, 0xf, 0xf, true)); return v; }
DI float scan16(float v) { v += dpp_row_shr<1>(v); v += dpp_row_shr<2>(v); v += dpp_row_shr<4>(v); v += dpp_row_shr<8>(v); return v; }
DI int crow(int reg, int hh) { return (reg & 3) + 8 * (reg >> 2) + 4 * hh; }
#define MFMA32(a, b, c) __builtin_amdgcn_mfma_f32_32x32x16_bf16((a), (b), (c), 0, 0, 0)
#define LDS_WAIT() asm volatile("s_waitcnt lgkmcnt(0)" ::: "memory")

namespace pg8 {
#define TSTORE_WRITE(sl, e, m, x) *(PG8_LAS bf16_t*)((sl) + (4 * fq + (e)) * 144 + (16 * (m) + fr) * 2) = bf16_1(x)
struct Epi1 {
    static constexpr bool PERM = true, AFTER_DRAIN = false;
    const float* rs; bf16_t* pa; bf16_t* gg; bf16_t* qd; bf16_t* kinv; bf16_t* kendT; bf16_t* vT; bf16_t* gs; float* dec; const float* lb; bf16_t* avT; PG8_LAS unsigned char* xl;
    __device__ __forceinline__ void operator()(const f32x4 (&acc)[2][2][4][2], const Unit& u, int wr, int wc, int fr, int fq) const {
        asm volatile("" : "+v"(fr), "+v"(fq));
        const int row0 = u.pm * BM + wr * 64 + fr, pn = u.pn;
        float rsv[2][4];
#pragma unroll
        for (int ai = 0; ai < 2; ++ai)
#pragma unroll
            for (int m = 0; m < 4; ++m) rsv[ai][m] = rs[row0 + ai * HALF + m * 16];
        if (pn == 2) {
            const int c8 = wc * 32 + 8 * fq, tseqb = (u.pm & 15) * 256 + wr * 64 + fr, bb = u.pm >> 4;
#pragma unroll
            for (int ai = 0; ai < 2; ++ai)
#pragma unroll
                for (int m = 0; m < 4; ++m) { const int row = row0 + ai * HALF + m * 16; const float s = rsv[ai][m];
                    const f32x4 v0 = acc[ai][0][m][0] * s, v1 = acc[ai][0][m][1] * s;
                    u32x4 w; w.x = pk_bf16(v0[0], v0[1]); w.y = pk_bf16(v0[2], v0[3]); w.z = pk_bf16(v1[0], v1[1]); w.w = pk_bf16(v1[2], v1[3]);
                    *(u32x4*)(pa + (size_t)row * 768 + 512 + c8) = w;
                }
            PG8_LAS unsigned char* sl = xl + (wr * 4 + wc) * 2304; const int lane_ = fq * 16 + fr;
#pragma unroll
            for (int ai = 0; ai < 2; ++ai)
#pragma unroll
                for (int n = 0; n < 2; ++n) {
#pragma unroll
                    for (int m = 0; m < 4; ++m) { const float s = rsv[ai][m];
#pragma unroll
                        for (int e = 0; e < 4; ++e) TSTORE_WRITE(sl, e, m, acc[ai][1][m][n][e] * s); }
                    asm volatile("s_waitcnt lgkmcnt(0)" ::: "memory");
#pragma unroll
                    for (int q = 0; q < 2; ++q) { const int c = lane_ + 64 * q, rw = c >> 3, tc = c & 7, col = wc * 32 + 8 * (rw >> 2) + 4 * n + (rw & 3);
                        const u32x4 w = *(const PG8_LAS u32x4*)(sl + rw * 144 + tc * 16);
                        *(u32x4*)(avT + (size_t)((bb * 2 + (col >> 6)) * 64 + (col & 63)) * SEQ + (u.pm & 15) * 256 + ai * HALF + wr * 64 + 8 * tc) = w; }
                    asm volatile("s_waitcnt lgkmcnt(0)" ::: "memory");
                }
            return;
        }
        if (pn < 3 || pn >= 11) {
            bf16_t* O; int ldc, colt;
            if (pn < 3) { O = pa; ldc = 768; colt = pn * 256; } else { O = gg; ldc = 2048; colt = (pn - 11) * 256; }
            const int col0 = colt + wc * 32 + 8 * fq;
#pragma unroll
            for (int ai = 0; ai < 2; ++ai)
#pragma unroll
                for (int m = 0; m < 4; ++m) { const int row = row0 + ai * HALF + m * 16; const float s = rsv[ai][m]; bf16_t* rowp = O + (size_t)row * ldc + col0;
#pragma unroll
                    for (int bj = 0; bj < 2; ++bj) { const f32x4 v0 = acc[ai][bj][m][0] * s, v1 = acc[ai][bj][m][1] * s;
                        u32x4 w; w.x = pk_bf16(v0[0], v0[1]); w.y = pk_bf16(v0[2], v0[3]); w.z = pk_bf16(v1[0], v1[1]); w.w = pk_bf16(v1[2], v1[3]);
                        *(u32x4*)(rowp + bj * HALF) = w; } }
            return;
        }
        PG8_LAS unsigned char* sl = xl + (wr * 4 + wc) * 2304; const int lane_ = fq * 16 + fr;
        const int h = (pn - 3) & 3, c8 = wc * 32 + 8 * fq, bh = (u.pm >> 4) * 4 + h;
        if (pn < 7) {
#pragma unroll
            for (int ai = 0; ai < 2; ++ai)
#pragma unroll
                for (int m = 0; m < 4; ++m) { const int row = row0 + ai * HALF + m * 16; const float s = rsv[ai][m]; const size_t o = (size_t)row * 512 + h * 128 + c8;
#pragma unroll
                    for (int bj = 0; bj < 2; ++bj) { const f32x4 v0 = acc[ai][bj][m][0] * s, v1 = acc[ai][bj][m][1] * s;
                        u32x4 w; w.x = pk_bf16(v0[0], v0[1]); w.y = pk_bf16(v0[2], v0[3]); w.z = pk_bf16(v1[0], v1[1]); w.w = pk_bf16(v1[2], v1[3]);
                        *(u32x4*)((bj ? kinv : qd) + o) = w; } }
        } else {
#pragma unroll
            for (int ai = 0; ai < 2; ++ai) {
                const int tseq0 = (u.pm & 15) * 256 + ai * HALF + wr * 64;
#pragma unroll
                for (int n = 0; n < 2; ++n) {
#pragma unroll
                    for (int m = 0; m < 4; ++m) { const float s = rsv[ai][m];
#pragma unroll
                        for (int e = 0; e < 4; ++e) TSTORE_WRITE(sl, e, m, acc[ai][0][m][n][e] * s); }
                    asm volatile("s_waitcnt lgkmcnt(0)" ::: "memory");
#pragma unroll
                    for (int q = 0; q < 2; ++q) { const int c = lane_ + 64 * q, rw = c >> 3, tc = c & 7, dvr = wc * 32 + 8 * (rw >> 2) + 4 * n + (rw & 3);
                        const u32x4 w = *(const PG8_LAS u32x4*)(sl + rw * 144 + tc * 16);
                        *(u32x4*)(vT + (size_t)(bh * 128 + dvr) * SEQ + tseq0 + 8 * tc) = w; }
                    asm volatile("s_waitcnt lgkmcnt(0)" ::: "memory");
                }
#pragma unroll
                for (int m = 0; m < 4; ++m) { const int row = row0 + ai * HALF + m * 16; const float s = rsv[ai][m];
                    f32x4 g0 = acc[ai][1][m][0] * s, g1 = acc[ai][1][m][1] * s;
#pragma unroll
                    for (int e = 0; e < 4; ++e) { g0[e] *= sigm(g0[e]); g1[e] *= sigm(g1[e]); }
                    u32x4 w; w.x = pk_bf16(g0[0], g0[1]); w.y = pk_bf16(g0[2], g0[3]); w.z = pk_bf16(g1[0], g1[1]); w.w = pk_bf16(g1[2], g1[3]);
                    *(u32x4*)(gs + (size_t)row * 512 + h * 128 + c8) = w; }
            }
        }
    }
};
template <bool ADD> struct EpiMerge {
    static constexpr bool PERM = true, AFTER_DRAIN = false;
    bf16_t* O; const bf16_t* gate;
    __device__ __forceinline__ void operator()(const f32x4 (&acc)[2][2][4][2], const Unit& u, int wr, int wc, int fr, int fq) const {
        const int row0 = u.pm * BM + wr * 64 + fr, col0 = u.pn * BM + wc * 32 + 8 * fq;
#pragma unroll
        for (int ai = 0; ai < 2; ++ai) {
            u32x4 g[4][2], o[4][2];
#pragma unroll
            for (int m = 0; m < 4; ++m)
#pragma unroll
                for (int bj = 0; bj < 2; ++bj) { const size_t row = (size_t)(row0 + ai * HALF + m * 16);
                    g[m][bj] = *(const u32x4*)(gate + row * 2048 + col0 + bj * HALF); if (ADD) o[m][bj] = *(const u32x4*)(O + row * DM + col0 + bj * HALF); }
#pragma unroll
            for (int m = 0; m < 4; ++m) { const int row = row0 + ai * HALF + m * 16; bf16_t* rowp = O + (size_t)row * DM + col0;
#pragma unroll
                for (int bj = 0; bj < 2; ++bj) { const u32x4 gq = g[m][bj];
                    f32x4 v0 = acc[ai][bj][m][0], v1 = acc[ai][bj][m][1];
                    v0[0] *= sigm(bflo(gq.x)); v0[1] *= sigm(bfhi(gq.x)); v0[2] *= sigm(bflo(gq.y)); v0[3] *= sigm(bfhi(gq.y));
                    v1[0] *= sigm(bflo(gq.z)); v1[1] *= sigm(bfhi(gq.z)); v1[2] *= sigm(bflo(gq.w)); v1[3] *= sigm(bfhi(gq.w));
                    if (ADD) { const u32x4 oq = o[m][bj];
                        v0[0] += bflo(oq.x); v0[1] += bfhi(oq.x); v0[2] += bflo(oq.y); v0[3] += bfhi(oq.y); v1[0] += bflo(oq.z); v1[1] += bfhi(oq.z); v1[2] += bflo(oq.w); v1[3] += bfhi(oq.w); }
                    u32x4 w; w.x = pk_bf16(v0[0], v0[1]); w.y = pk_bf16(v0[2], v0[3]); w.z = pk_bf16(v1[0], v1[1]); w.w = pk_bf16(v1[2], v1[3]);
                    *(u32x4*)(rowp + bj * HALF) = w; } }
        }
    }
};
struct EpiX2 {
    static constexpr bool PERM = true, AFTER_DRAIN = false;
    const bf16_t* X; bf16_t* X2B; float* ssq;
    __device__ __forceinline__ void operator()(const f32x4 (&acc)[2][2][4][2], const Unit& u, int wr, int wc, int fr, int fq) const {
        const int row0 = u.pm * BM + wr * 64 + fr, col0 = u.pn * BM + wc * 32 + 8 * fq;
#pragma unroll
        for (int ai = 0; ai < 2; ++ai) {
            u32x4 xr[4][2];
#pragma unroll
            for (int m = 0; m < 4; ++m)
#pragma unroll
                for (int bj = 0; bj < 2; ++bj) xr[m][bj] = *(const u32x4*)(X + (size_t)(row0 + ai * HALF + m * 16) * DM + col0 + bj * HALF);
#pragma unroll
            for (int m = 0; m < 4; ++m) { const int row = row0 + ai * HALF + m * 16; const size_t off = (size_t)row * DM + col0; float ss = 0.f;
#pragma unroll
                for (int bj = 0; bj < 2; ++bj) { const u32x4 xq = xr[m][bj];
                    const f32x4 v0 = acc[ai][bj][m][0] + (f32x4){bflo(xq.x), bfhi(xq.x), bflo(xq.y), bfhi(xq.y)}, v1 = acc[ai][bj][m][1] + (f32x4){bflo(xq.z), bfhi(xq.z), bflo(xq.w), bfhi(xq.w)};
                    u32x4 w; w.x = pk_bf16(v0[0], v0[1]); w.y = pk_bf16(v0[2], v0[3]); w.z = pk_bf16(v1[0], v1[1]); w.w = pk_bf16(v1[2], v1[3]);
                    *(u32x4*)(X2B + off + bj * HALF) = w;
                    ss += (v0[0] * v0[0] + v0[1] * v0[1]) + (v0[2] * v0[2] + v0[3] * v0[3]) + (v1[0] * v1[0] + v1[1] * v1[1]) + (v1[2] * v1[2] + v1[3] * v1[3]); }
                { const auto r = __builtin_amdgcn_permlane16_swap(__float_as_uint(ss), __float_as_uint(ss), false, false); ss = __uint_as_float(r[0]) + __uint_as_float(r[1]); }
                { const auto r = __builtin_amdgcn_permlane32_swap(__float_as_uint(ss), __float_as_uint(ss), false, false); ss = __uint_as_float(r[0]) + __uint_as_float(r[1]); }
                if (fq == 0) ssq[(size_t)row * 16 + u.pn * 4 + wc] = ss; }
        }
    }
};
struct EpiQp {
    static constexpr bool PERM = true, AFTER_DRAIN = false;
    bf16_t* O; const float* ssq;
    __device__ __forceinline__ void operator()(const f32x4 (&acc)[2][2][4][2], const Unit& u, int wr, int wc, int fr, int fq) const {
        const int row0 = u.pm * BM + wr * 64 + fr, col0 = u.pn * BM + wc * 32 + 8 * fq;
        float sv[2][4];
#pragma unroll
        for (int ai = 0; ai < 2; ++ai)
#pragma unroll
            for (int m = 0; m < 4; ++m) { const f32x4 a = *(const f32x4*)(ssq + (size_t)(row0 + ai * HALF + m * 16) * 16 + 4 * fq); sv[ai][m] = (a[0] + a[1]) + (a[2] + a[3]); }
#pragma unroll
        for (int ai = 0; ai < 2; ++ai)
#pragma unroll
            for (int m = 0; m < 4; ++m) { float t = sv[ai][m];
                { const auto r = __builtin_amdgcn_permlane16_swap(__float_as_uint(t), __float_as_uint(t), false, false); t = __uint_as_float(r[0]) + __uint_as_float(r[1]); }
                { const auto r = __builtin_amdgcn_permlane32_swap(__float_as_uint(t), __float_as_uint(t), false, false); t = __uint_as_float(r[0]) + __uint_as_float(r[1]); }
                sv[ai][m] = __builtin_amdgcn_rsqf(t * (1.f / 1024.f) + EPS); }
#pragma unroll
        for (int ai = 0; ai < 2; ++ai)
#pragma unroll
            for (int m = 0; m < 4; ++m) { const int row = row0 + ai * HALF + m * 16; const float s = sv[ai][m]; bf16_t* rowp = O + (size_t)row * 2048 + col0;
#pragma unroll
                for (int bj = 0; bj < 2; ++bj) { const f32x4 v0 = acc[ai][bj][m][0] * s, v1 = acc[ai][bj][m][1] * s;
                    u32x4 w; w.x = pk_bf16(v0[0], v0[1]); w.y = pk_bf16(v0[2], v0[3]); w.z = pk_bf16(v1[0], v1[1]); w.w = pk_bf16(v1[2], v1[3]);
                    *(u32x4*)(rowp + bj * HALF) = w; } }
    }
};
}

DI int w1_src_col(int n) {
    if (n < 768 || n >= 2816) return n;
    if (n < 1792) { const int h = (n - 768) >> 8, r = (n - 768) & 255; return r < 128 ? C_HQ + 128 * h + r : C_HF + 128 * h + (r - 128); }
    const int h = (n - 1792) >> 8, r = (n - 1792) & 255; return r < 128 ? C_HI + 128 * h + r : C_HG + 128 * h + (r - 128);
}
template <bool PERMW1> DI void p0_transpose_item(const float* W, int K, int N, bf16_t* WT, const float* g, int gmask, LAS float* scr, int item, int lane) {
    const int nblk = N / 32, kb = item / nblk, nb = item % nblk, k0 = 64 * kb, n0 = 32 * nb, ns = PERMW1 ? w1_src_col(n0) : n0;
    {
        float wv[32], gv[32];
#pragma unroll
        for (int i = 0; i < 32; ++i) { const int kk = 2 * i + (lane >> 5); wv[i] = W[(size_t)(k0 + kk) * N + ns + (lane & 31)]; }
        if (g) {
#pragma unroll
            for (int i = 0; i < 32; ++i) { const int kk = 2 * i + (lane >> 5); gv[i] = g[(k0 + kk) & gmask]; }
#pragma unroll
            for (int i = 0; i < 32; ++i) wv[i] *= gv[i];
        }
#pragma unroll
        for (int i = 0; i < 32; ++i) { const int kk = 2 * i + (lane >> 5); scr[kk * 33 + (lane & 31)] = wv[i]; }
    }
    LDS_WAIT(); asm volatile("" ::: "memory");
    const int c = lane & 7;
#pragma unroll
    for (int j = 0; j < 4; ++j) { const int n = (lane >> 3) + 8 * j; const LAS float* s = scr + (8 * c) * 33 + n;
        u32x4 o; o.x = pk_bf16(s[0 * 33], s[1 * 33]); o.y = pk_bf16(s[2 * 33], s[3 * 33]); o.z = pk_bf16(s[4 * 33], s[5 * 33]); o.w = pk_bf16(s[6 * 33], s[7 * 33]);
        *(u32x4*)(WT + (size_t)(n0 + n) * K + k0 + 8 * c) = o; }
    LDS_WAIT(); asm volatile("" ::: "memory");
}
DI unsigned pk_f16(float a, float b) { h16x2 v = {(_Float16)a, (_Float16)b}; return __builtin_bit_cast(unsigned, v); }

DI void p0_prologue(const Args& a, LAS unsigned char* lds, int vb, int G) {
    const int tid = threadIdx.x, lane = tid & 63, wave = tid >> 6;
    const int gw = vb * 8 + wave, NGW = G * 8, gt = vb * NTHR + tid, NGT = G * NTHR;
    unsigned char* ws = a.ws;
    LAS float* scr = (LAS float*)(lds + wave * 16384);
    constexpr int I_W1 = 16 * 152, I_AP = 8 * 32, I_HP = 8 * 32, I_OUT = 16 * 32, I_Q = 16 * 64, NITEMS = I_W1 + I_AP + I_HP + I_OUT + I_Q;
    for (int it = gw; it < NITEMS; it += NGW) {
        int r = it;
        if (r < I_W1) { p0_transpose_item<true>(a.in[2], 1024, NIN, (bf16_t*)(ws + WS_W1T), a.in[1], 1023, scr, r, lane); continue; } r -= I_W1;
        if (r < I_AP) { p0_transpose_item<false>(a.in[6], 512, 1024, (bf16_t*)(ws + WS_WAPT), nullptr, 0, scr, r, lane); continue; } r -= I_AP;
        if (r < I_HP) { p0_transpose_item<false>(a.in[7], 512, 1024, (bf16_t*)(ws + WS_WHPT), a.in[5], 127, scr, r, lane); continue; } r -= I_HP;
        if (r < I_OUT) { p0_transpose_item<false>(a.in[8], 1024, 1024, (bf16_t*)(ws + WS_WOUTT), nullptr, 0, scr, r, lane); continue; } r -= I_OUT;
        p0_transpose_item<false>(a.in[10], 1024, 2048, (bf16_t*)(ws + WS_WQT), a.in[9], 1023, scr, r, lane);
    }
    for (int i = gt; i < 2 * 8 * 128 * 128 / 4; i += NGT) { const f32x4 v = ((const f32x4*)a.in[11])[i]; u32x2 o; o.x = pk_bf16(v[0], v[1]); o.y = pk_bf16(v[2], v[3]); ((u32x2*)(ws + WS_KEYS))[i] = o; }
    for (int it = gw; it < 2 * 16384; it += NGW) {
        const int isv = it >= 16384, e = it & 16383;
        const float* src = (isv ? a.in[13] : a.in[12]) + (size_t)e * 1024 + 16 * lane;
        f32x4 x[4]; float amax = 0.f;
#pragma unroll
        for (int i = 0; i < 4; ++i) { x[i] = *(const f32x4*)(src + 4 * i); if (!isv) x[i] *= *(const f32x4*)(a.in[9] + 16 * lane + 4 * i);
            amax = fmaxf(fmaxf(amax, fmaxf(fabsf(x[i][0]), fabsf(x[i][1]))), fmaxf(fabsf(x[i][2]), fabsf(x[i][3]))); }
        amax = wave_max(amax);
        {
            float ssq_ = 0.f;
#pragma unroll
            for (int i = 0; i < 4; ++i) ssq_ += (x[i][0] * x[i][0] + x[i][1] * x[i][1]) + (x[i][2] * x[i][2] + x[i][3] * x[i][3]);
            ssq_ = wave_sum(ssq_);
            const float stp = fminf(0.35f * sqrtf(ssq_ * (1.f / 1024.f)), amax * (1.f / 7.f)), q4 = stp > 0.f ? 1.f / stp : 0.f; unsigned nb[16];
#pragma unroll
            for (int i = 0; i < 16; ++i) { const int q_ = (int)fminf(fmaxf(rintf(x[i >> 2][i & 3] * q4), -7.f), 7.f); nb[i] = (isv && !(i & 1)) ? (unsigned)(q_ + 8) : ((unsigned)q_ & 15u); }
            u32x2 w4; w4.x = (nb[0] | (nb[1] << 4)) | ((nb[2] | (nb[3] << 4)) << 8) | ((nb[4] | (nb[5] << 4)) << 16) | ((nb[6] | (nb[7] << 4)) << 24);
            w4.y = (nb[8] | (nb[9] << 4)) | ((nb[10] | (nb[11] << 4)) << 8) | ((nb[12] | (nb[13] << 4)) << 16) | ((nb[14] | (nb[15] << 4)) << 24);
            *(u32x2*)(ws + (isv ? WS_V8 : WS_U8) + (size_t)e * 512 + 8 * lane) = w4;
            if (lane == 0) ((float*)(ws + (isv ? WS_SV : WS_SU)))[e] = stp;
        }
    }
    for (int row = gw; row < T; row += NGW) {
        const f32x4* xr = (const f32x4*)(a.in[0] + (size_t)row * DM) + lane; f32x4 v[4]; float s = 0.f;
#pragma unroll
        for (int j = 0; j < 4; ++j) { v[j] = xr[64 * j]; s += (v[j][0] * v[j][0] + v[j][1] * v[j][1]) + (v[j][2] * v[j][2] + v[j][3] * v[j][3]); }
        s = wave_sum(s);
        u32x2* o = (u32x2*)(ws + WS_XB + (size_t)row * DM * 2) + lane;
#pragma unroll
        for (int j = 0; j < 4; ++j) { u32x2 w; w.x = pk_bf16(v[j][0], v[j][1]); w.y = pk_bf16(v[j][2], v[j][3]); o[64 * j] = w; }
        if (lane == 0) ((float*)(ws + WS_RSTD1))[row] = __builtin_amdgcn_rsqf(s * (1.f / 1024.f) + EPS);
    }
    if (vb == 0) { const float l0 = a.in[4][tid], l1 = a.in[4][512 + tid]; ((float*)(ws + WS_LB))[tid] = 1.f / (1.f + __expf(l1 - l0)); }
}

constexpr int ATT_KS = 272, ATT_VS = 392, ATT_VOFF = 192 * ATT_KS;
DI void attn_unit(const bf16_t* pa, const bf16_t* avT, const float* sinks, bf16_t* ya, LAS unsigned char* lds, int b, int tt) {
    int tid_ = threadIdx.x; asm volatile("" : "+v"(tid_));
    const int tid = tid_, lane = tid & 63, h = __builtin_amdgcn_readfirstlane(tid >> 6), r = lane & 31, hh = lane >> 5, kvh = h >> 2;
    const int p0 = tt * 64 - 128;
    for (int c = tid; c < 192 * 16; c += NTHR) { const int row = c >> 4, ch = c & 15, pos = p0 + row; u32x4 w = {0u, 0u, 0u, 0u};
        if (pos >= 0) w = *(const u32x4*)(pa + ((size_t)b * SEQ + pos) * 768 + 512 + ch * 8);
        *(LAS u32x4*)(lds + row * ATT_KS + ch * 16) = w; }
    for (int c = tid; c < 128 * 24; c += NTHR) { const int row = c / 24, ch = c - row * 24, pos = p0 + ch * 8; u32x4 w = {0u, 0u, 0u, 0u};
        if (pos >= 0) w = *(const u32x4*)(avT + (size_t)(b * 128 + row) * SEQ + pos);
        LAS u32x2* d = (LAS u32x2*)(lds + ATT_VOFF + row * ATT_VS + ch * 16); d[0] = (u32x2){w.x, w.y}; d[1] = (u32x2){w.z, w.w}; }
    __syncthreads();
    constexpr float LOG2E = 1.4426950408889634f;
    const float slope2 = exp2f(-(float)(h + 1)) * LOG2E, sink2 = sinks[h] * LOG2E, qs = 0.125f * LOG2E;
#pragma unroll 1
    for (int qbl = 0; qbl < 2; ++qbl) {
        const int qb = tt * 2 + qbl; const size_t trow = (size_t)b * SEQ + qb * 32 + r;
        bf16x8 qf[4];
        { const bf16_t* qp = pa + trow * 768 + h * 64 + 8 * hh;
#pragma unroll
          for (int s = 0; s < 4; ++s) qf[s] = *(const bf16x8*)(qp + 16 * s); }
        f32x16 S[5]; float m = sink2;
#pragma unroll
        for (int i = 0; i < 5; ++i) { const int kb = qb - 4 + i;
            if (kb >= 0) {
#pragma unroll
                for (int q = 0; q < 16; ++q) S[i][q] = 0.f;
                const LAS unsigned char* kp = lds + (32 * (qbl + i) + r) * ATT_KS + kvh * 128 + 16 * hh;
#pragma unroll
                for (int s = 0; s < 4; ++s) S[i] = MFMA32(*(const LAS bf16x8*)(kp + 32 * s), qf[s], S[i]);
#pragma unroll
                for (int q = 0; q < 16; ++q) { const int dist = 32 * (4 - i) + r - crow(q, hh); float v = S[i][q] * qs - slope2 * (float)dist;
                    if (i == 0) v = (dist <= 127) ? v : -1e30f;
                    if (i == 4) v = (dist >= 0) ? v : -1e30f;
                    S[i][q] = v; m = fmaxf(m, v); }
            } }
        m = fmaxf(m, __shfl_xor(m, 32));
        float l = 0.f;
#pragma unroll
        for (int i = 0; i < 5; ++i) if (qb - 4 + i >= 0) {
#pragma unroll
            for (int q = 0; q < 16; ++q) { const float p = __builtin_amdgcn_exp2f(S[i][q] - m); S[i][q] = p; l += p; } }
        l += __shfl_xor(l, 32); l += __builtin_amdgcn_exp2f(sink2 - m);
        f32x16 O[2];
#pragma unroll
        for (int q = 0; q < 16; ++q) { O[0][q] = 0.f; O[1][q] = 0.f; }
#pragma unroll
        for (int i = 0; i < 5; ++i) { const int kb = qb - 4 + i;
            if (kb >= 0) {
#pragma unroll
                for (int s2 = 0; s2 < 2; ++s2) {
                    u32x4 pb; pb.x = pk_bf16(S[i][8 * s2], S[i][8 * s2 + 1]); pb.y = pk_bf16(S[i][8 * s2 + 2], S[i][8 * s2 + 3]); pb.z = pk_bf16(S[i][8 * s2 + 4], S[i][8 * s2 + 5]); pb.w = pk_bf16(S[i][8 * s2 + 6], S[i][8 * s2 + 7]);
#pragma unroll
                    for (int dt = 0; dt < 2; ++dt) { const LAS unsigned char* vp = lds + ATT_VOFF + (kvh * 64 + 32 * dt + r) * ATT_VS + (32 * (qbl + i) + 16 * s2 + 4 * hh) * 2;
                        const u32x2 v0 = *(const LAS u32x2*)vp, v1 = *(const LAS u32x2*)(vp + 16); u32x4 av; av.x = v0.x; av.y = v0.y; av.z = v1.x; av.w = v1.y;
                        O[dt] = MFMA32(__builtin_bit_cast(bf16x8, av), __builtin_bit_cast(bf16x8, pb), O[dt]); }
                    asm volatile("" ::: "memory");
                } } }
        const float inv = 1.f / l;
#pragma unroll
        for (int dt = 0; dt < 2; ++dt)
#pragma unroll
            for (int g = 0; g < 4; ++g) { u32x2 w; w.x = pk_bf16(O[dt][4 * g] * inv, O[dt][4 * g + 1] * inv); w.y = pk_bf16(O[dt][4 * g + 2] * inv, O[dt][4 * g + 3] * inv);
                *(u32x2*)(ya + trow * 512 + h * 64 + 32 * dt + 8 * g + 4 * hh) = w; }
    }
    __syncthreads();
}

DI void hgrn_prep_unit(bf16_t* qd, bf16_t* kinv, LAS unsigned char* kl, float* dec, const float* lb, int bh, int c, int dk2) {
    const int b = bh >> 2, h = bh & 3;
    bf16_t* qp = qd + ((size_t)b * SEQ + c * 64) * 512 + h * 128 + dk2; bf16_t* kp = kinv + ((size_t)b * SEQ + c * 64) * 512 + h * 128 + dk2;
    const float lb0 = lb[h * 128 + dk2], lb1 = lb[h * 128 + dk2 + 1], om0 = 1.f - lb0, om1 = 1.f - lb1;
    unsigned qw[64], kv[64];
#pragma unroll
    for (int s = 0; s < 64; ++s) { qw[s] = *(const unsigned*)(qp + (size_t)s * 512); kv[s] = *(const unsigned*)(kp + (size_t)s * 512); }
    float b0 = 0.f, b1 = 0.f;
#pragma unroll
    for (int s = 0; s < 64; ++s) {
        const float f0 = lb0 + om0 * sigm(bflo(kv[s])), f1 = lb1 + om1 * sigm(bfhi(kv[s]));
        b0 += __logf(f0); b1 += __logf(f1);
        const float e0 = __expf(b0), e1 = __expf(b1), i0 = __builtin_amdgcn_rcpf(e0), i1 = __builtin_amdgcn_rcpf(e1);
        const float q0 = bflo(qw[s]), q1 = bfhi(qw[s]);
        *(unsigned*)(qp + (size_t)s * 512) = pk_bf16(q0 * sigm(q0) * e0, q1 * sigm(q1) * e1);
        kv[s] = pk_bf16((1.f - f0) * i0, (1.f - f1) * i1);
        *(unsigned*)(kp + (size_t)s * 512) = kv[s];
    }
    const float d0 = __expf(b0), d1 = __expf(b1);
    *(f32x2*)(dec + (size_t)(bh * 64 + c) * 128 + dk2) = (f32x2){d0, d1};
    LAS unsigned char* r0 = kl + dk2 * 144; LAS unsigned char* r1 = r0 + 144;
#pragma unroll
    for (int s0 = 0; s0 < 64; s0 += 8) { u32x4 w0, w1;
#pragma unroll
        for (int i = 0; i < 4; ++i) { const unsigned ka = kv[s0 + 2 * i], kb = kv[s0 + 2 * i + 1];
            w0[i] = pk_bf16(bflo(ka) * d0, bflo(kb) * d0); w1[i] = pk_bf16(bfhi(ka) * d1, bfhi(kb) * d1); }
        *(LAS u32x4*)(r0 + s0 * 2) = w0; *(LAS u32x4*)(r1 + s0 * 2) = w1; }
}
DI void hgrn_ds_unit(const LAS unsigned char* kl, const bf16_t* vT, bf16_t* dsT, int bh, int c) {
    int tid_ = threadIdx.x; asm volatile("" : "+v"(tid_));
    const int lane = tid_ & 63, wave = tid_ >> 6, r = lane & 31, hh = lane >> 5, i = wave >> 1, j0 = 2 * (wave & 1);
    const LAS unsigned char* ka = kl + (32 * i + r) * 144 + 16 * hh;
    const bf16_t* vb0 = vT + (size_t)(bh * 128 + 32 * j0 + r) * SEQ + c * 64 + 8 * hh; const bf16_t* vb1 = vb0 + (size_t)32 * SEQ;
    f32x16 D0, D1;
#pragma unroll
    for (int q = 0; q < 16; ++q) { D0[q] = 0.f; D1[q] = 0.f; }
#pragma unroll
    for (int ks = 0; ks < 4; ++ks) { const bf16x8 a = *(const LAS bf16x8*)(ka + 32 * ks), b0 = *(const bf16x8*)(vb0 + 16 * ks), b1 = *(const bf16x8*)(vb1 + 16 * ks); D0 = MFMA32(a, b0, D0); D1 = MFMA32(a, b1, D1); }
    const int unit = bh * 64 + c;
    bf16_t* o0 = dsT + (size_t)(unit * 128 + 32 * j0 + r) * 128 + 32 * i + 4 * hh; bf16_t* o1 = o0 + 32 * 128;
#pragma unroll
    for (int g = 0; g < 4; ++g) { u32x2 w; w.x = pk_bf16(D0[4 * g], D0[4 * g + 1]); w.y = pk_bf16(D0[4 * g + 2], D0[4 * g + 3]); *(u32x2*)(o0 + 8 * g) = w;
        u32x2 z; z.x = pk_bf16(D1[4 * g], D1[4 * g + 1]); z.y = pk_bf16(D1[4 * g + 2], D1[4 * g + 3]); *(u32x2*)(o1 + 8 * g) = z; }
}
DI void hgrn_scan(bf16_t* dsT, const float* dec, int vb, int G) {
    for (int idx = vb * NTHR + threadIdx.x; idx < 64 * 128 * 16; idx += G * NTHR) {
        const int dk8 = idx & 15, dv = (idx >> 4) & 127, bh = idx >> 11;
        float S[8];
#pragma unroll
        for (int q = 0; q < 8; ++q) S[q] = 0.f;
        for (int c0 = 0; c0 < 64; c0 += 8) {
            u32x4 ld[8]; f32x4 d0[8], d1[8];
#pragma unroll
            for (int i = 0; i < 8; ++i) { const int c = c0 + i; ld[i] = *(const u32x4*)(dsT + (size_t)((bh * 64 + c) * 128 + dv) * 128 + dk8 * 8);
                const float* dp = dec + (size_t)(bh * 64 + c) * 128 + dk8 * 8; d0[i] = *(const f32x4*)dp; d1[i] = *(const f32x4*)(dp + 4); }
#pragma unroll
            for (int i = 0; i < 8; ++i) { const int c = c0 + i;
                u32x4 w; w.x = pk_bf16(S[0], S[1]); w.y = pk_bf16(S[2], S[3]); w.z = pk_bf16(S[4], S[5]); w.w = pk_bf16(S[6], S[7]);
                *(u32x4*)(dsT + (size_t)((bh * 64 + c) * 128 + dv) * 128 + dk8 * 8) = w;
                S[0] = d0[i][0] * S[0] + bflo(ld[i].x); S[1] = d0[i][1] * S[1] + bfhi(ld[i].x); S[2] = d0[i][2] * S[2] + bflo(ld[i].y); S[3] = d0[i][3] * S[3] + bfhi(ld[i].y);
                S[4] = d1[i][0] * S[4] + bflo(ld[i].z); S[5] = d1[i][1] * S[5] + bfhi(ld[i].z); S[6] = d1[i][2] * S[6] + bflo(ld[i].w); S[7] = d1[i][3] * S[7] + bfhi(ld[i].w); }
        }
    }
}
constexpr int HO_Q = 0, HO_K = 64 * 272, HO_S = 2 * 64 * 272, HO_V = HO_S + 128 * 272, HO_Z = HO_V + 128 * 144;
struct HoPre { u32x4 c[10]; u32x4 g0, g1; };
DI void ho_fetch(HoPre& p, const bf16_t* qd, const bf16_t* kinv, const bf16_t* vT, const bf16_t* spT, const bf16_t* gs, int u, int tid) {
    const int bh = u >> 6, c = u & 63, b = bh >> 2, h = bh & 3; const size_t Tb = (size_t)b * SEQ + c * 64;
#pragma unroll
    for (int k = 0; k < 2; ++k) { const int i = tid + NTHR * k, row = i >> 4, ch = i & 15; p.c[k] = *(const u32x4*)(qd + (Tb + row) * 512 + h * 128 + ch * 8); p.c[2 + k] = *(const u32x4*)(kinv + (Tb + row) * 512 + h * 128 + ch * 8); }
#pragma unroll
    for (int k = 0; k < 4; ++k) { const int i = tid + NTHR * k, row = i >> 4, ch = i & 15; p.c[4 + k] = *(const u32x4*)(spT + (size_t)((bh * 64 + c) * 128 + row) * 128 + ch * 8); }
#pragma unroll
    for (int k = 0; k < 2; ++k) { const int i = tid + NTHR * k, row = i >> 3, ch = i & 7; p.c[8 + k] = *(const u32x4*)(vT + (size_t)(bh * 128 + row) * SEQ + c * 64 + ch * 8); }
    { const int tok = tid >> 3, d16 = (tid & 7) * 16; const size_t off = (Tb + tok) * 512 + h * 128 + d16; p.g0 = *(const u32x4*)(gs + off); p.g1 = *(const u32x4*)(gs + off + 8); }
}
DI void ho_put(const HoPre& p, LAS unsigned char* lds, int tid) {
#pragma unroll
    for (int k = 0; k < 2; ++k) { const int i = tid + NTHR * k, row = i >> 4, ch = i & 15; *(LAS u32x4*)(lds + HO_Q + row * 272 + ch * 16) = p.c[k]; *(LAS u32x4*)(lds + HO_K + row * 272 + ch * 16) = p.c[2 + k]; }
#pragma unroll
    for (int k = 0; k < 4; ++k) { const int i = tid + NTHR * k, row = i >> 4, ch = i & 15; *(LAS u32x4*)(lds + HO_S + row * 272 + ch * 16) = p.c[4 + k]; }
#pragma unroll
    for (int k = 0; k < 2; ++k) { const int i = tid + NTHR * k, row = i >> 3, ch = i & 7; *(LAS u32x4*)(lds + HO_V + row * 144 + ch * 16) = p.c[8 + k]; }
}
DI void hgrn_out_phase(const bf16_t* qd, const bf16_t* kinv, const bf16_t* vT, const bf16_t* spT, const bf16_t* gs, bf16_t* yh, LAS unsigned char* lds, int vb, int G) {
    int tid_ = threadIdx.x; asm volatile("" : "+v"(tid_));
    const int tid = tid_, lane = tid & 63, wave = __builtin_amdgcn_readfirstlane(tid >> 6), r = lane & 31, hh = lane >> 5, tb = wave >> 2, db = wave & 3;
    LAS float* zs = (LAS float*)(lds + HO_Z);
    HoPre pre;
    if (vb < 64 * 64) ho_fetch(pre, qd, kinv, vT, spT, gs, vb, tid);
    for (int u = vb; u < 64 * 64; u += G) {
        const int bh = u >> 6, c = u & 63, b = bh >> 2, h = bh & 3; const size_t Tb = (size_t)b * SEQ + c * 64;
        ho_put(pre, lds, tid);
        const u32x4 g0 = pre.g0, g1 = pre.g1;
        __syncthreads();
        { const int un = (u + G < 64 * 64) ? u + G : u; ho_fetch(pre, qd, kinv, vT, spT, gs, un, tid); }
        f32x16 Z;
#pragma unroll
        for (int q = 0; q < 16; ++q) Z[q] = 0.f;
        const LAS unsigned char* qb_ = lds + HO_Q + (32 * tb + r) * 272 + 16 * hh;
        bf16x8 qf[8];
#pragma unroll
        for (int ks = 0; ks < 8; ++ks) qf[ks] = *(const LAS bf16x8*)(qb_ + 32 * ks);
        { const LAS unsigned char* sb_ = lds + HO_S + (32 * db + r) * 272 + 16 * hh;
#pragma unroll
          for (int ks = 0; ks < 8; ++ks) Z = MFMA32(qf[ks], *(const LAS bf16x8*)(sb_ + 32 * ks), Z); }
#pragma unroll
        for (int sb = 0; sb < 2; ++sb) if (sb <= tb) {
            f32x16 X;
#pragma unroll
            for (int q = 0; q < 16; ++q) X[q] = 0.f;
            const LAS unsigned char* kb_ = lds + HO_K + (32 * sb + r) * 272 + 16 * hh;
#pragma unroll
            for (int ks = 0; ks < 8; ++ks) X = MFMA32(*(const LAS bf16x8*)(kb_ + 32 * ks), qf[ks], X);
            if (sb == tb) {
#pragma unroll
                for (int q = 0; q < 16; ++q) if (crow(q, hh) > r) X[q] = 0.f;
            }
#pragma unroll
            for (int s2 = 0; s2 < 2; ++s2) {
                u32x4 pa_; pa_.x = pk_bf16(X[8 * s2], X[8 * s2 + 1]); pa_.y = pk_bf16(X[8 * s2 + 2], X[8 * s2 + 3]); pa_.z = pk_bf16(X[8 * s2 + 4], X[8 * s2 + 5]); pa_.w = pk_bf16(X[8 * s2 + 6], X[8 * s2 + 7]);
                const LAS unsigned char* vp = lds + HO_V + (32 * db + r) * 144 + (32 * sb + 16 * s2 + 4 * hh) * 2;
                const u32x2 v0 = *(const LAS u32x2*)vp, v1 = *(const LAS u32x2*)(vp + 16);
                u32x4 pb_; pb_.x = v0.x; pb_.y = v0.y; pb_.z = v1.x; pb_.w = v1.y;
                Z = MFMA32(__builtin_bit_cast(bf16x8, pa_), __builtin_bit_cast(bf16x8, pb_), Z);
            }
        }
#pragma unroll
        for (int q = 0; q < 16; ++q) zs[(32 * tb + crow(q, hh)) * 132 + 32 * db + r] = Z[q];
        __syncthreads();
        { const int tok = tid >> 3, d16 = (tid & 7) * 16; f32x4 o[4]; float ss = 0.f;
          const size_t off = (Tb + tok) * 512 + h * 128 + d16;
#pragma unroll
          for (int i = 0; i < 4; ++i) { o[i] = *(const LAS f32x4*)(zs + tok * 132 + d16 + 4 * i); ss += (o[i][0] * o[i][0] + o[i][1] * o[i][1]) + (o[i][2] * o[i][2] + o[i][3] * o[i][3]); }
          ss += __shfl_xor(ss, 1); ss += __shfl_xor(ss, 2); ss += __shfl_xor(ss, 4);
          const float rn = __builtin_amdgcn_rsqf(ss * (1.f / 128.f) + EPS);
          u32x4 w0, w1;
          w0.x = pk_bf16(o[0][0] * rn * bflo(g0.x), o[0][1] * rn * bfhi(g0.x)); w0.y = pk_bf16(o[0][2] * rn * bflo(g0.y), o[0][3] * rn * bfhi(g0.y));
          w0.z = pk_bf16(o[1][0] * rn * bflo(g0.z), o[1][1] * rn * bfhi(g0.z)); w0.w = pk_bf16(o[1][2] * rn * bflo(g0.w), o[1][3] * rn * bfhi(g0.w));
          w1.x = pk_bf16(o[2][0] * rn * bflo(g1.x), o[2][1] * rn * bfhi(g1.x)); w1.y = pk_bf16(o[2][2] * rn * bflo(g1.y), o[2][3] * rn * bfhi(g1.y));
          w1.z = pk_bf16(o[3][0] * rn * bflo(g1.z), o[3][1] * rn * bfhi(g1.z)); w1.w = pk_bf16(o[3][2] * rn * bflo(g1.w), o[3][3] * rn * bfhi(g1.w));
          *(u32x4*)(yh + off) = w0; *(u32x4*)(yh + off + 8) = w1; }
    }
    __syncthreads();
}

DI unsigned f2ord(float f) { const unsigned b = __float_as_uint(f); return b ^ ((unsigned)((int)b >> 31) | 0x80000000u); }
DI float ord2f(unsigned k) { const unsigned b = (k & 0x80000000u) ? (k ^ 0x80000000u) : ~k; return __uint_as_float(b); }
DI void ce_desc(unsigned& a, unsigned& b) { const unsigned hi = a > b ? a : b, lo = a > b ? b : a; a = hi; b = lo; }
DI void sort16_desc(unsigned (&a)[16]) {
    constexpr int NI[63] = {0, 2, 0, 1, 1, 4, 6, 4, 5, 5, 0, 2, 2, 1, 3, 3, 1, 3, 5, 8, 10, 8, 9, 9, 12, 14, 12, 13, 13, 8, 10, 10, 9, 11, 11, 9, 11, 13, 0, 4, 4, 2, 6, 6, 2, 6, 10, 1, 5, 5, 3, 7, 7, 3, 7, 11, 1, 3, 5, 7, 9, 11, 13};
    constexpr int NJ[63] = {1, 3, 2, 3, 2, 5, 7, 6, 7, 6, 4, 6, 4, 5, 7, 5, 2, 4, 6, 9, 11, 10, 11, 10, 13, 15, 14, 15, 14, 12, 14, 12, 13, 15, 13, 10, 12, 14, 8, 12, 8, 10, 14, 10, 4, 8, 12, 9, 13, 9, 11, 15, 11, 5, 9, 13, 2, 4, 6, 8, 10, 12, 14};
#pragma unroll
    for (int c = 0; c < 63; ++c) ce_desc(a[NI[c]], a[NJ[c]]);
}
DI void merge16_desc(unsigned (&a)[16], const unsigned (&b)[16]) {
#pragma unroll
    for (int i = 0; i < 16; ++i) a[i] = a[i] > b[15 - i] ? a[i] : b[15 - i];
#pragma unroll
    for (int j = 8; j > 0; j >>= 1)
#pragma unroll
        for (int i = 0; i < 16; ++i) { const int l = i ^ j; if (l > i) ce_desc(a[i], a[l]); }
}
#define TK_INS(L, x) do { unsigned t_ = (x); _Pragma("unroll") for (int j_ = 0; j_ < 16; ++j_) { const unsigned hi_ = L[j_] > t_ ? L[j_] : t_; t_ = L[j_] > t_ ? t_ : L[j_]; L[j_] = hi_; } } while (0)

DI void topk_stage_keys(const bf16_t* keysb, LAS unsigned char* kl, int h) {
    for (int c = threadIdx.x; c < 2 * 128 * 16; c += NTHR) { const int p = c >> 11, row = (c >> 4) & 127, ch = c & 15;
        *(LAS u32x4*)(kl + (p * 128 + row) * 272 + ch * 16) = *(const u32x4*)(keysb + ((size_t)(p * 8 + h) * 128 + row) * 128 + ch * 8); }
}
DI void topk_unit(const bf16_t* qp, const LAS unsigned char* kl, unsigned short* gidx, float* ggate, LAS unsigned* tk, int quad, int h) {
    const int tid = threadIdx.x, lane = tid & 63, wave = tid >> 6, p = wave & 1, tsub = wave >> 1, r = lane & 31, hh = lane >> 5;
#pragma unroll 1
    for (int hl = 0; hl < 4; ++hl) {
        const int tok0 = (quad * 4 + hl) * 128 + tsub * 32;
        f32x16 acc[4];
#pragma unroll
        for (int kb = 0; kb < 4; ++kb)
#pragma unroll
            for (int i = 0; i < 16; ++i) acc[kb][i] = 16.f;
#ifdef T_MPRIO
        __builtin_amdgcn_s_setprio(T_MPRIO);
#endif
        const bf16_t* qrow = qp + (size_t)(tok0 + r) * 2048 + h * 256 + p * 128 + 8 * hh;
        const LAS unsigned char* kbase = kl + (p * 128 + r) * 272 + 16 * hh;
#pragma unroll
        for (int s = 0; s < 8; ++s) { const bf16x8 bq = *(const bf16x8*)(qrow + 16 * s);
#pragma unroll
            for (int kb = 0; kb < 4; ++kb) { const bf16x8 ak = *(const LAS bf16x8*)(kbase + kb * 32 * 272 + 32 * s); acc[kb] = MFMA32(ak, bq, acc[kb]); } }
#ifdef T_MPRIO
        __builtin_amdgcn_s_setprio(0);
#endif
        unsigned A0[16], A1[16], A2[16], A3[16];
#pragma unroll
        for (int i = 0; i < 16; ++i) { const unsigned ki = (unsigned)(crow(i, hh));
            A0[i] = (__float_as_uint(fmaxf(acc[0][i], 0.f)) & ~127u) | ki; A1[i] = (__float_as_uint(fmaxf(acc[1][i], 0.f)) & ~127u) | (32u + ki); A2[i] = (__float_as_uint(fmaxf(acc[2][i], 0.f)) & ~127u) | (64u + ki); A3[i] = (__float_as_uint(fmaxf(acc[3][i], 0.f)) & ~127u) | (96u + ki); }
        sort16_desc(A0); sort16_desc(A1); sort16_desc(A2); sort16_desc(A3);
        merge16_desc(A0, A1); merge16_desc(A2, A3); merge16_desc(A0, A2);
#pragma unroll
        for (int j = 0; j < 16; ++j) A1[j] = __shfl_xor(A0[j], 32);
        merge16_desc(A0, A1);
        if (hh == 0) { LAS u32x4* dst = (LAS u32x4*)(tk + (((hl * 2 + p) * 128 + tsub * 32 + r) * 16));
#pragma unroll
            for (int c = 0; c < 4; ++c) { u32x4 w = {A0[4 * c], A0[4 * c + 1], A0[4 * c + 2], A0[4 * c + 3]}; dst[c] = w; } }
    }
    __syncthreads();
    {
        const int tok = tid & 127, hl = tid >> 7, tile = quad * 4 + hl;
        const LAS unsigned* t1 = tk + ((hl * 2 + 0) * 128 + tok) * 16; const LAS unsigned* t2 = tk + ((hl * 2 + 1) * 128 + tok) * 16;
        float v1[16], v2[16];
        { const LAS u32x4* s1 = (const LAS u32x4*)t1; const LAS u32x4* s2 = (const LAS u32x4*)t2;
#pragma unroll
          for (int c = 0; c < 4; ++c) { const u32x4 a = s1[c], b = s2[c];
              v1[4 * c] = __uint_as_float(a.x & ~127u) - 12.f; v1[4 * c + 1] = __uint_as_float(a.y & ~127u) - 12.f; v1[4 * c + 2] = __uint_as_float(a.z & ~127u) - 12.f; v1[4 * c + 3] = __uint_as_float(a.w & ~127u) - 12.f;
              v2[4 * c] = __uint_as_float(b.x & ~127u) - 12.f; v2[4 * c + 1] = __uint_as_float(b.y & ~127u) - 12.f; v2[4 * c + 2] = __uint_as_float(b.z & ~127u) - 12.f; v2[4 * c + 3] = __uint_as_float(b.w & ~127u) - 12.f; } }
#define CKEY(i, j) ((__float_as_uint(fmaxf(v1[i] + v2[j], 0.f)) & ~255u) | (unsigned)((i) * 16 + (j)))
        unsigned C[16], D[16], E[16];
#pragma unroll
        for (int j = 0; j < 16; ++j) C[j] = CKEY(0, j);
#pragma unroll
        for (int j = 0; j < 8; ++j) D[j] = CKEY(1, j);
#pragma unroll
        for (int j = 0; j < 5; ++j) D[8 + j] = CKEY(2, j);
#pragma unroll
        for (int j = 0; j < 3; ++j) D[13 + j] = CKEY(4, j);
#pragma unroll
        for (int j = 0; j < 4; ++j) E[j] = CKEY(3, j);
        E[4] = CKEY(5, 0); E[5] = CKEY(5, 1); E[6] = CKEY(6, 0); E[7] = CKEY(6, 1); E[8] = CKEY(7, 0); E[9] = CKEY(7, 1);
        E[10] = CKEY(8, 0); E[11] = CKEY(9, 0); E[12] = CKEY(10, 0); E[13] = CKEY(11, 0); E[14] = CKEY(12, 0); E[15] = CKEY(13, 0);
        sort16_desc(D); sort16_desc(E);
        TK_INS(E, CKEY(14, 0)); TK_INS(E, CKEY(15, 0));
#undef CKEY
        merge16_desc(C, D); merge16_desc(C, E);
        float sc[16]; unsigned ei[16]; float mx = -1e30f;
#pragma unroll
        for (int q = 0; q < 16; ++q) { const unsigned ij = C[q] & 255u; const unsigned a = t1[ij >> 4], b = t2[ij & 15u];
            sc[q] = (__uint_as_float(a & ~127u) - 16.f) + (__uint_as_float(b & ~127u) - 16.f); ei[q] = (a & 127u) * 128u + (b & 127u); mx = fmaxf(mx, sc[q]); }
        float sum = 0.f;
#pragma unroll
        for (int q = 0; q < 16; ++q) { sc[q] = __expf(sc[q] - mx); sum += sc[q]; }
        const float inv = 1.f / sum; const size_t o = (size_t)(tile * 128 + tok) * 128 + h * 16;
        u32x4 w0, w1;
        w0.x = ei[0] | (ei[1] << 16); w0.y = ei[2] | (ei[3] << 16); w0.z = ei[4] | (ei[5] << 16); w0.w = ei[6] | (ei[7] << 16);
        w1.x = ei[8] | (ei[9] << 16); w1.y = ei[10] | (ei[11] << 16); w1.z = ei[12] | (ei[13] << 16); w1.w = ei[14] | (ei[15] << 16);
        *(u32x4*)(gidx + o) = w0; *(u32x4*)(gidx + o + 8) = w1;
#pragma unroll
        for (int c = 0; c < 4; ++c) *(f32x4*)(ggate + o + 4 * c) = (f32x4){sc[4 * c] * inv, sc[4 * c + 1] * inv, sc[4 * c + 2] * inv, sc[4 * c + 3] * inv};
    }
    __syncthreads();
}

DI float gelu_erf(float x) { return 0.5f * x * (1.f + erff(x * 0.70710678118654752f)); }
DI void hq_token(const bf16_t* x2row, const float* ssq, unsigned char* hqrow, float* shp, int lane) {
    f32x4 x[4]; float amax = 0.f;
#pragma unroll
    for (int i = 0; i < 4; ++i) { const u32x2 w_ = *(const u32x2*)(x2row + 16 * lane + 4 * i); x[i] = (f32x4){bflo(w_.x), bfhi(w_.x), bflo(w_.y), bfhi(w_.y)}; amax = fmaxf(fmaxf(amax, fmaxf(fabsf(x[i][0]), fabsf(x[i][1]))), fmaxf(fabsf(x[i][2]), fabsf(x[i][3]))); }
    float ss = (lane < 16) ? ssq[lane] : 0.f; ss = wave_sum(ss);
    const float rstd2 = __builtin_amdgcn_rsqf(ss * (1.f / 1024.f) + EPS);
    amax = wave_max(amax);
    amax *= rstd2;
    const float qs = amax > 0.f ? 119.f / amax : 0.f, xq = rstd2 * qs;
    unsigned hh[2] = {0u, 0u}, hl[2] = {0u, 0u};
#pragma unroll
    for (int i = 0; i < 16; ++i) { const int q_ = (int)rintf(x[i >> 2][i & 3] * xq), l_ = ((q_ + 8) & 15) - 8, h_ = (q_ - l_) >> 4;
        hl[i >> 3] |= ((unsigned)l_ & 15u) << (4 * (i & 7)); hh[i >> 3] |= ((unsigned)h_ & 15u) << (4 * (i & 7)); }
    unsigned char* cp = hqrow + (lane >> 1) * 32 + (lane & 1) * 8;
    *(u32x2*)cp = (u32x2){hh[0], hh[1]}; *(u32x2*)(cp + 16) = (u32x2){hl[0], hl[1]};
    if (lane == 0) *shp = amax * (1.f / 119.f);
}
template <int CTRL> DI int dpp_i(int v) { return __builtin_amdgcn_mov_dpp(v, CTRL, 0xf, 0xf, true); }
template <int CTRL> DI float dpp_f(float v) { return __int_as_float(__builtin_amdgcn_mov_dpp(__float_as_int(v), CTRL, 0xf, 0xf, true)); }
DI float swapadd32(float a, float b) { const auto r = __builtin_amdgcn_permlane32_swap(__float_as_uint(a), __float_as_uint(b), false, false); return __uint_as_float(r[0]) + __uint_as_float(r[1]); }
DI float swapadd16(float a, float b) { const auto r = __builtin_amdgcn_permlane16_swap(__float_as_uint(a), __float_as_uint(b), false, false); return __uint_as_float(r[0]) + __uint_as_float(r[1]); }

struct SMeta { u32x4 i0, i1, a0, a1; unsigned xw; };
template <int RS> DI void slice_issue(u32x4 (&r)[16], const SMeta& m, const unsigned char* base) {
    const unsigned iw[8] = {m.i0.x, m.i0.y, m.i0.z, m.i0.w, m.i1.x, m.i1.y, m.i1.z, m.i1.w};
#pragma unroll
    for (int j = 0; j < 16; ++j) { const unsigned idx = (j & 1) ? (iw[j >> 1] >> 16) : (iw[j >> 1] & 0xffffu); r[j] = *(const u32x4*)(base + (size_t)idx * RS); }
}
DI void slice_u_compute(const SMeta& m, const u32x4 (&r)[16], int* actp, int lane) {
    const int hh[4] = {(int)m.a0.x, (int)m.a0.y, (int)m.a0.z, (int)m.a0.w}, hl[4] = {(int)m.a1.x, (int)m.a1.y, (int)m.a1.z, (int)m.a1.w};
    int part[16];
#ifdef U_PRIO
    __builtin_amdgcn_s_setprio(U_PRIO);
#endif
#pragma unroll
    for (int j = 0; j < 16; ++j) { int ah = 0, al = 0;
#pragma unroll
        for (int g = 0; g < 4; ++g) { ah = __builtin_amdgcn_sdot8((int)r[j][g], hh[g], ah, false); al = __builtin_amdgcn_sdot8((int)r[j][g], hl[g], al, false); }
        part[j] = (ah << 4) + al; }
    int r8[8], r4[4], r2[2];
    { const bool up_ = (lane & 4) != 0;
#pragma unroll
      for (int i = 0; i < 8; ++i) { const int keep = up_ ? part[i + 8] : part[i], send = up_ ? part[i] : part[i + 8]; r8[i] = keep + dpp_i<0x141>(send); } }
    { const bool up_ = (lane & 2) != 0;
#pragma unroll
      for (int i = 0; i < 4; ++i) { const int keep = up_ ? r8[i + 4] : r8[i], send = up_ ? r8[i] : r8[i + 4]; r4[i] = keep + dpp_i<0x4E>(send); } }
    { const bool up_ = (lane & 1) != 0;
#pragma unroll
      for (int i = 0; i < 2; ++i) { const int keep = up_ ? r4[i + 2] : r4[i], send = up_ ? r4[i] : r4[i + 2]; r2[i] = keep + dpp_i<0xB1>(send); } }
#ifdef U_PRIO
    __builtin_amdgcn_s_setprio(0);
#endif
    actp[lane] = (int)((unsigned)(((r2[0] + 4) >> 3) & 0xffff) | ((unsigned)((r2[1] + 4) >> 3) << 16));
}
DI int swapadd32i(int a, int b) { const auto r = __builtin_amdgcn_permlane32_swap((unsigned)a, (unsigned)b, false, false); return (int)r[0] + (int)r[1]; }
DI int swapadd16i(int a, int b) { const auto r = __builtin_amdgcn_permlane16_swap((unsigned)a, (unsigned)b, false, false); return (int)r[0] + (int)r[1]; }
DI void slice_v_compute(const SMeta& m, const u32x4 (&r)[16], float* x3row, float* ssq3p, int sl, int lane) {
    const int wq[4] = {(int)m.a0.x, (int)m.a0.y, (int)m.a0.z, (int)m.a0.w};
    const float sw = __uint_as_float(m.a1.x);
    int o[32];
#pragma unroll
    for (int i = 0; i < 32; ++i) o[i] = 0;
#pragma unroll
    for (int q = 0; q < 4; ++q)
#pragma unroll
        for (int p = 0; p < 4; ++p) {
            const unsigned d0 = r[4 * q][p], d1 = r[4 * q + 1][p], d2 = r[4 * q + 2][p], d3 = r[4 * q + 3][p];
            const unsigned t0 = __builtin_amdgcn_perm(d1, d0, 0x05010400u), t1 = __builtin_amdgcn_perm(d1, d0, 0x07030602u), t2 = __builtin_amdgcn_perm(d3, d2, 0x05010400u), t3 = __builtin_amdgcn_perm(d3, d2, 0x07030602u);
            const unsigned e0 = __builtin_amdgcn_perm(t2, t0, 0x05040100u), e1 = __builtin_amdgcn_perm(t2, t0, 0x07060302u), e2 = __builtin_amdgcn_perm(t3, t1, 0x05040100u), e3 = __builtin_amdgcn_perm(t3, t1, 0x07060302u);
            o[8 * p + 0] = __builtin_amdgcn_sdot4((int)(e0 & 0x0F0F0F0Fu), wq[q], o[8 * p + 0], false); o[8 * p + 1] = __builtin_amdgcn_sdot4((int)e0, wq[q], o[8 * p + 1], false);
            o[8 * p + 2] = __builtin_amdgcn_sdot4((int)(e1 & 0x0F0F0F0Fu), wq[q], o[8 * p + 2], false); o[8 * p + 3] = __builtin_amdgcn_sdot4((int)e1, wq[q], o[8 * p + 3], false);
            o[8 * p + 4] = __builtin_amdgcn_sdot4((int)(e2 & 0x0F0F0F0Fu), wq[q], o[8 * p + 4], false); o[8 * p + 5] = __builtin_amdgcn_sdot4((int)e2, wq[q], o[8 * p + 5], false);
            o[8 * p + 6] = __builtin_amdgcn_sdot4((int)(e3 & 0x0F0F0F0Fu), wq[q], o[8 * p + 6], false); o[8 * p + 7] = __builtin_amdgcn_sdot4((int)e3, wq[q], o[8 * p + 7], false);
        }
    int wt = 0;
#pragma unroll
    for (int q = 0; q < 4; ++q) wt = __builtin_amdgcn_sdot4(wq[q], 0x01010101, wt, false);
    wt += dpp_i<0x128>(wt); wt = swapadd16i(wt, wt); wt = swapadd32i(wt, wt); wt *= 8;
    int a16[16], a8[8], a4[4];
#pragma unroll
    for (int i = 0; i < 16; ++i) a16[i] = swapadd32i(o[i], o[16 + i]);
#pragma unroll
    for (int i = 0; i < 8; ++i) a8[i] = swapadd16i(a16[i], a16[i + 8]);
    { const bool up_ = (lane & 8) != 0;
#pragma unroll
      for (int i = 0; i < 4; ++i) { const int keep = up_ ? a8[i + 4] : a8[i], send = up_ ? a8[i] : a8[i + 4]; a4[i] = keep + dpp_i<0x128>(send); } }
    const int col = 32 * (lane & 7) + ((lane >> 5) & 1) * 16 + ((lane >> 4) & 1) * 8 + ((lane >> 3) & 1) * 4;
    const f32x4 y = {bflo(m.xw) + (float)(a4[0] - wt) * sw, bfhi(m.xw) + (float)((a4[1] - a4[0]) >> 4) * sw, bflo(m.a1.y) + (float)(a4[2] - wt) * sw, bfhi(m.a1.y) + (float)((a4[3] - a4[2]) >> 4) * sw};
    *(f32x4*)(x3row + 256 * sl + col) = y;
    const float ss = wave_sum((y[0] * y[0] + y[1] * y[1]) + (y[2] * y[2] + y[3] * y[3]));
    if (lane == 0) ssq3p[sl] = ss;
}
template <int MODE> DI void slice_pass(unsigned char* ws, float* out, int xs, int gw_, int nw_, int lane) {
    const int g = lane >> 3, c = lane & 7;
    const int sl = xs >> 1, tmul = 2, tadd = xs & 1, TT = T / tmul;
    const unsigned short* gidx = (const unsigned short*)(ws + WS_GIDX) + 16 * g;
    const unsigned char* tab = (MODE == 0 ? (const unsigned char*)(ws + WS_U8) : (const unsigned char*)(ws + WS_V8)) + 128 * sl + 16 * c;
    const unsigned char* hqb = (const unsigned char*)(ws + WS_HQ) + 256 * sl + 32 * c;
    const unsigned char* wxb = (const unsigned char*)(ws + WS_WX) + 16 * g;
    const bf16_t* x2b = (const bf16_t*)(ws + WS_X2B) + 256 * sl + 32 * c + ((lane >> 5) & 1) * 16 + ((lane >> 4) & 1) * 8 + ((lane >> 3) & 1) * 4;
#define S_LOAD(m, tok) do { const unsigned short* ip = gidx + (size_t)(tok) * 128; (m).i0 = *(const u32x4*)ip; (m).i1 = *(const u32x4*)(ip + 8); \
        if (MODE == 0) { const unsigned char* hp_ = hqb + (size_t)(tok) * 1024; (m).a0 = *(const u32x4*)hp_; (m).a1 = *(const u32x4*)(hp_ + 16); } \
        else { (m).a0 = *(const u32x4*)(wxb + (size_t)(tok) * 128); (m).a1.x = __float_as_uint(((const float*)(ws + WS_SW))[tok]); { const u32x2 x_ = *(const u32x2*)(x2b + (size_t)(tok) * DM); (m).xw = x_.x; (m).a1.y = x_.y; } } } while (0)
#define S_COMPUTE(m, r, tok) do { if (MODE == 0) slice_u_compute(m, r, (int*)(ws + WS_ACTP) + ((size_t)(tok) * 4 + sl) * 64, lane); \
        else slice_v_compute(m, r, out + (size_t)(tok) * DM, (float*)(ws + WS_SSQ3) + (size_t)(tok) * 4, sl, lane); } while (0)
#define S_ISSUE(r, m) slice_issue<512>(r, m, tab)
    SMeta mA, mB, mN; u32x4 rA[16], rB[16];
    if (gw_ >= TT) return;
    const int n = (TT - gw_ + nw_ - 1) / nw_;
#define S_TK(j) ((gw_ + ((j) < n ? (j) : n - 1) * nw_) * tmul + tadd)
    S_LOAD(mA, S_TK(0)); S_ISSUE(rA, mA); S_LOAD(mB, S_TK(1));
#ifdef S_MPRIO
#define S_MP(x) __builtin_amdgcn_s_setprio(x)
#else
#define S_MP(x)
#endif
    for (int i = 0; i < n; i += 2) {
        S_MP(S_MPRIO); S_ISSUE(rB, mB);
        S_LOAD(mN, S_TK(i + 2)); S_MP(0);
        S_COMPUTE(mA, rA, S_TK(i));
        S_MP(S_MPRIO); mA = mN; S_ISSUE(rA, mA);
        S_LOAD(mN, S_TK(i + 3)); S_MP(0);
        if (i + 1 < n) S_COMPUTE(mB, rB, S_TK(i + 1));
        mB = mN;
    }
#undef S_MP
#undef S_TK
#undef S_LOAD
#undef S_COMPUTE
#undef S_ISSUE
}
typedef int v2i32_t __attribute__((ext_vector_type(2)));
struct VCm { unsigned wd; u32x2 x2; f32x2 sw; };
DI void slice_v2_compute(LAS unsigned char* itr0, LAS unsigned char* itr1, LAS unsigned* wbuf, const VCm& cm, bf16_t* x3row, float* ssq3p, int sl, int lane) {
    int aL[2][2] = {{0, 0}, {0, 0}}, aF[2][2] = {{0, 0}, {0, 0}};
#ifndef VDEPTH
#define VDEPTH 8
#endif
    constexpr int NG = 32 / VDEPTH;
    u32x2 d[2][VDEPTH]; u32x4 w4[2][VDEPTH / 4];
#define V_RD(gi) do { _Pragma("unroll") for (int e = 0; e < VDEPTH / 4; ++e) w4[(gi) & 1][e] = *(const LAS u32x4*)(wbuf + 4 * ((VDEPTH / 4) * (gi) + e)); asm volatile("" ::: "memory"); \
        _Pragma("unroll") for (int e = 0; e < VDEPTH; ++e) d[(gi) & 1][e] = __builtin_bit_cast(u32x2, __builtin_amdgcn_ds_read_tr8_b64_v2i32((LAS v2i32_t*)(((e & 1) ? itr1 : itr0) + 1024 * ((VDEPTH / 2) * (gi) + (e >> 1))))); } while (0)
    V_RD(0);
#pragma unroll
    for (int gi = 0; gi < NG; ++gi) {
        if (gi + 1 < NG) V_RD(gi + 1);
        asm volatile("" ::: "memory");
#ifdef V_PRIO
        if (gi == 0) __builtin_amdgcn_s_setprio(V_PRIO);
#endif
#pragma unroll
        for (int e = 0; e < VDEPTH; ++e) {
            const u32x2 dd = d[gi & 1][e];
            const int wi = 2 * (e >> 1), h = e & 1;
            const int w0 = (int)w4[gi & 1][wi >> 2][wi & 3], w1 = (int)w4[gi & 1][(wi + 1) >> 2][(wi + 1) & 3];
            aL[h][0] = __builtin_amdgcn_sdot4((int)(dd.x & 0x0F0F0F0Fu), w0, aL[h][0], false); aF[h][0] = __builtin_amdgcn_sdot4((int)dd.x, w0, aF[h][0], false);
            aL[h][1] = __builtin_amdgcn_sdot4((int)(dd.y & 0x0F0F0F0Fu), w1, aL[h][1], false); aF[h][1] = __builtin_amdgcn_sdot4((int)dd.y, w1, aF[h][1], false);
        }
    }
#undef V_RD
#ifdef V_PRIO
    __builtin_amdgcn_s_setprio(0);
#endif
#ifdef V_TPRIO
    __builtin_amdgcn_s_setprio(V_TPRIO);
#endif
    const int L0 = aL[0][0] + aL[0][1], F0 = aF[0][0] + aF[0][1], L1 = aL[1][0] + aL[1][1], F1 = aF[1][0] + aF[1][1];
    const float sw = cm.sw[0], wt = cm.sw[1];
    const f32x2 ya = {bflo(cm.x2.x) + ((float)L0 - wt) * sw, bfhi(cm.x2.x) + (float)((F0 - L0) >> 4) * sw}, yb = {bflo(cm.x2.y) + ((float)L1 - wt) * sw, bfhi(cm.x2.y) + (float)((F1 - L1) >> 4) * sw};
#ifdef V_NT_STORE
    __builtin_nontemporal_store(pk_bf16(ya[0], ya[1]), (unsigned*)(x3row + 256 * sl + 2 * lane)); __builtin_nontemporal_store(pk_bf16(yb[0], yb[1]), (unsigned*)(x3row + 256 * sl + 128 + 2 * lane));
#else
    *(unsigned*)(x3row + 256 * sl + 2 * lane) = pk_bf16(ya[0], ya[1]); *(unsigned*)(x3row + 256 * sl + 128 + 2 * lane) = pk_bf16(yb[0], yb[1]);
#endif
    const float ss = wave_sum((ya[0] * ya[0] + ya[1] * ya[1]) + (yb[0] * yb[0] + yb[1] * yb[1]));
    if (lane == 0) ssq3p[sl] = ss;
}
template <int PM> DI void slice_pass_v(unsigned char* ws, bf16_t* out, float* ssq3, LAS unsigned char* lds, int wave, int xs, int gw_, int nw_, int lane) {
    const int g = lane >> 3, c = lane & 7;
    const int sl = xs >> 1, tmul = 2, tadd = xs & 1, TT = T / tmul;
    const unsigned short* gidx = (const unsigned short*)(ws + WS_GIDX) + 16 * g;
    const unsigned char* tab = (const unsigned char*)(ws + WS_V8) + 128 * sl + 16 * c;
    const unsigned* wx32 = (const unsigned*)(ws + WS_WX) + (lane & 31);
    const bf16_t* x2b = (const bf16_t*)(ws + WS_X2B) + 256 * sl + 2 * lane;
    const f32x2* swp = (const f32x2*)(ws + WS_SW);
    LAS unsigned char* img = lds + wave * 16384;
    LAS unsigned char* iw0 = img + g * 2048 + 16 * c, *iw1 = img + g * 2048 + 16 * (c ^ 2), *iw2 = img + g * 2048 + 16 * (c ^ 4), *iw3 = img + g * 2048 + 16 * (c ^ 6);
    const int q = (lane >> 1) & 7, Q = lane >> 4, p = lane & 1;
    LAS unsigned char* itr0 = img + q * 128 + 16 * (Q ^ (q & 6)) + 8 * p;
    LAS unsigned char* itr1 = img + q * 128 + 16 * ((4 + Q) ^ (q & 6)) + 8 * p;
    LAS unsigned* wbuf = (LAS unsigned*)(lds + 131072 + wave * 128);
    if (gw_ >= TT) return;
    const int n = (TT - gw_ + nw_ - 1) / nw_;
#ifndef VREP
#define VREP 1
#endif
    const int nn = n * VREP;
#define V_TK(j) ((gw_ + (((j) < nn ? (j) : nn - 1) % n) * nw_) * tmul + tadd)
#define V_IDX(m, tok) do { const unsigned short* ip = gidx + (size_t)(tok) * 128; (m).i0 = *(const u32x4*)ip; (m).i1 = *(const u32x4*)(ip + 8); } while (0)
#define V_CM(cm, tok) do { (cm).wd = wx32[(size_t)(tok) * 32]; (cm).x2.x = *(const unsigned*)(x2b + (size_t)(tok) * DM); (cm).x2.y = *(const unsigned*)(x2b + (size_t)(tok) * DM + 128); (cm).sw = swp[tok]; } while (0)
#define V_STAGE(r, cm) do { if (PM != 1) { _Pragma("unroll") for (int j = 0; j < 16; ++j) *(LAS u32x4*)((((j >> 1) & 3) == 0 ? iw0 : ((j >> 1) & 3) == 1 ? iw1 : ((j >> 1) & 3) == 2 ? iw2 : iw3) + 128 * j) = r[j]; } wbuf[lane & 31] = (cm).wd; asm volatile("" ::: "memory"); } while (0)
#define V_COMPUTE(cm, tok) do { if (PM != 2) slice_v2_compute(itr0, itr1, wbuf, cm, out + (size_t)(tok) * DM, ssq3 + (size_t)(tok) * 4, sl, lane); asm volatile("" ::: "memory"); } while (0)
#define V_ISS(r, m) do { if (PM != 1) slice_issue<512>(r, m, tab); } while (0)
    SMeta mE, mO; VCm cE, cO; u32x4 rE[16], rO[16];
#ifdef V_STAGGER
    if (wave >= 4) { _Pragma("unroll") for (int z = 0; z < V_STAGGER; ++z) __builtin_amdgcn_s_sleep(16); }
#endif
    V_IDX(mE, V_TK(0)); V_IDX(mO, V_TK(1));
    asm volatile("" ::: "memory");
    V_ISS(rE, mE); V_IDX(mE, V_TK(2)); V_CM(cE, V_TK(0));
    asm volatile("" ::: "memory");
    V_ISS(rO, mO); V_IDX(mO, V_TK(3)); V_CM(cO, V_TK(1));
    asm volatile("" ::: "memory");
#ifdef V_MPRIO
#define V_MP(x) __builtin_amdgcn_s_setprio(x)
#else
#define V_MP(x)
#endif
    for (int i = 0; i < nn; i += 2) {
        V_MP(V_MPRIO); V_STAGE(rE, cE);
        V_ISS(rE, mE); V_IDX(mE, V_TK(i + 4)); V_MP(0);
        V_COMPUTE(cE, V_TK(i));
        V_CM(cE, V_TK(i + 2));
        V_MP(V_MPRIO); V_STAGE(rO, cO);
        V_ISS(rO, mO); V_IDX(mO, V_TK(i + 5)); V_MP(0);
        if (i + 1 < nn) V_COMPUTE(cO, V_TK(i + 1));
        V_CM(cO, V_TK(i + 3));
    }
#undef V_MP
#undef V_TK
#undef V_ISS
#undef V_IDX
#undef V_CM
#undef V_STAGE
#undef V_COMPUTE
}
DI void expert_w_token(const int* actp, const unsigned short* gidx, const float* ggate, float sh, const float* su, const float* sv, unsigned char* wrow, f32x2* swp, int lane) {
    typedef int i32x2 __attribute__((ext_vector_type(2)));
    i32x2 acc = {0, 0};
#pragma unroll
    for (int x = 0; x < 4; ++x) { const int w_ = actp[x * 64 + lane]; acc[0] += (int)(short)(w_ & 0xffff); acc[1] += w_ >> 16; }
    acc[0] <<= 3; acc[1] <<= 3;
    const unsigned ii = *(const unsigned*)(gidx + 2 * lane); const f32x2 gt = *(const f32x2*)(ggate + 2 * lane);
    const int e0 = ii & 0xffffu, e1 = ii >> 16;
    const float w0 = gelu_erf((float)acc[0] * (su[e0] * sh)) * gt[0] * sv[e0], w1 = gelu_erf((float)acc[1] * (su[e1] * sh)) * gt[1] * sv[e1];
    float amax = fmaxf(fabsf(w0), fabsf(w1));
    amax = fmaxf(amax, dpp_f<0xB1>(amax)); amax = fmaxf(amax, dpp_f<0x4E>(amax)); amax = fmaxf(amax, dpp_f<0x141>(amax)); amax = fmaxf(amax, dpp_f<0x128>(amax));
    { const auto r = __builtin_amdgcn_permlane16_swap(__float_as_uint(amax), __float_as_uint(amax), false, false); amax = fmaxf(__uint_as_float(r[0]), __uint_as_float(r[1])); }
    { const auto r = __builtin_amdgcn_permlane32_swap(__float_as_uint(amax), __float_as_uint(amax), false, false); amax = fmaxf(__uint_as_float(r[0]), __uint_as_float(r[1])); }
    const float qs = amax > 0.f ? 127.f / amax : 0.f;
    const int q0 = (int)rintf(w0 * qs), q1 = (int)rintf(w1 * qs);
    *(unsigned short*)(wrow + 2 * lane) = (unsigned short)((q0 & 255) | ((q1 & 255) << 8));
    const float qsum = wave_sum((float)(q0 + q1));
    if (lane == 0) *swp = f32x2{amax * (1.f / 127.f), 8.f * qsum};
}
DI void final_norm_token(const bf16_t* x3row, float* row, const float* ssq3p, const float* gf, int lane) {
    float ss = (lane < 4) ? ssq3p[lane] : 0.f; ss = wave_sum(ss);
    const float r3 = __builtin_amdgcn_rsqf(ss * (1.f / 1024.f) + EPS);
#pragma unroll
    for (int i = 0; i < 4; ++i) { const u32x2 v = *(const u32x2*)(x3row + 256 * i + 4 * lane); const f32x4 x = {bflo(v.x), bfhi(v.x), bflo(v.y), bfhi(v.y)};
        *(f32x4*)(row + 256 * i + 4 * lane) = x * r3 * *(const f32x4*)(gf + 256 * i + 4 * lane); }
}

#define XB_TMO      128
#define XB_XCNT(j)  (256  + 64 * (j))
#define XB_XSUB(j)  (1280 + 64 * (j))
#define XB_XGEN(j)  (2304 + 64 * (j))
#define XB_TOP      3328
#define XB_TOPGEN   3392
#define XCD_BAR_WORDS 3456
#define XB_SPIN_CAP (1u << 18)

__device__ __forceinline__ unsigned xb_ld(unsigned* p)              { return __hip_atomic_load(p, __ATOMIC_RELAXED, __HIP_MEMORY_SCOPE_AGENT); }
__device__ __forceinline__ unsigned xb_add(unsigned* p, unsigned v) { return __hip_atomic_fetch_add(p, v, __ATOMIC_RELAXED, __HIP_MEMORY_SCOPE_AGENT); }
__device__ __forceinline__ unsigned xb_xcc_id() { return (unsigned)__builtin_amdgcn_s_getreg((3 << 11) | 20) & 0xFu; }
#define XB_SPIN(cond, bar) do { unsigned _sp = 0; while (cond) { __builtin_amdgcn_s_sleep(1); \
    if ((++_sp & 255u) == 0u) { if (xb_ld(&(bar)[XB_TMO])) break; if (_sp > XB_SPIN_CAP) { atomicAdd(&(bar)[XB_TMO], 1u); break; } } } } while (0)

struct XcdBarrier {
    unsigned* bar; unsigned x;
    volatile __attribute__((address_space(3))) unsigned* st;
};

__device__ __forceinline__ XcdBarrier xcd_barrier_post(unsigned* bar, volatile __attribute__((address_space(3))) unsigned* st) {
    XcdBarrier b; b.bar = bar; b.x = xb_xcc_id(); b.st = st;
    if (threadIdx.x == 0) st[2] = xb_add(&bar[XB_XCNT(b.x)], 1u);
    return b;
}
__device__ __forceinline__ void xcd_barrier_complete(unsigned* bar, unsigned x, unsigned& nloc, unsigned& nx) {
    const unsigned G = gridDim.x * gridDim.y * gridDim.z;
    unsigned sum, cnt, mine, sp = 0u;
    for (;;) {
        sum = 0u; cnt = 0u; mine = 0u;
#pragma unroll
        for (unsigned j = 0; j < 16; ++j) { const unsigned c = xb_ld(&bar[XB_XCNT(j)]); sum += c; cnt += (c > 0u) ? 1u : 0u; mine = (j == x) ? c : mine; }
        if (sum == G) break;
        __builtin_amdgcn_s_sleep(1);
        if ((++sp & 255u) == 0u) { if (xb_ld(&bar[XB_TMO])) break; if (sp > XB_SPIN_CAP) { atomicAdd(&bar[XB_TMO], 1u); break; } }
    }
    nloc = mine > 0u ? mine : 1u; nx = cnt > 0u ? cnt : 1u;
}

__device__ __forceinline__ void xcd_barrier(const XcdBarrier& b) {
    asm volatile("s_waitcnt vmcnt(0)" ::: "memory");
    __syncthreads();
    if (threadIdx.x == 0) {
        unsigned* bar = b.bar;
        __builtin_amdgcn_s_waitcnt(0);
        unsigned nloc = b.st[0], nx = b.st[1];
        if (nloc == 0u) { xcd_barrier_complete(bar, b.x, nloc, nx); b.st[0] = nloc; b.st[1] = nx; }
        const unsigned old = xb_add(&bar[XB_XSUB(b.x)], 1u);
        const unsigned gen = old / nloc;
        if (old + 1u == (gen + 1u) * nloc) {
            __builtin_amdgcn_fence(__ATOMIC_RELEASE, "agent");
            asm volatile("s_waitcnt vmcnt(0)" ::: "memory");
            const unsigned og = xb_add(&bar[XB_TOP], 1u);
            const unsigned tg = og / nx;
            if (og + 1u == (tg + 1u) * nx) xb_add(&bar[XB_TOPGEN], 1u);
            else XB_SPIN(xb_ld(&bar[XB_TOPGEN]) == tg, bar);
            __builtin_amdgcn_fence(__ATOMIC_ACQUIRE, "agent");
            xb_add(&bar[XB_XGEN(b.x)], 1u);
            asm volatile("s_waitcnt vmcnt(0)" ::: "memory");
        } else {
            XB_SPIN(xb_ld(&bar[XB_XGEN(b.x)]) == gen, bar);
            __builtin_amdgcn_fence(__ATOMIC_ACQUIRE, "agent");
            asm volatile("s_waitcnt vmcnt(0)" ::: "memory");
        }
    }
    __syncthreads();
}

constexpr int N_PHASES = 13;
__global__ void __launch_bounds__(NTHR, 2) mk_fwd(Args a) {
    extern __shared__ __attribute__((aligned(16))) unsigned char lds_raw[];
    LAS unsigned char* lds = (LAS unsigned char*)lds_raw;
    cg::grid_group grid = cg::this_grid();
    const int G = gridDim.x, vb = blockIdx.x, tid = threadIdx.x, lane = tid & 63, wave = tid >> 6;
    unsigned char* ws = a.ws;
    const int lo = a.ph_lo, hi = a.ph_hi;
    volatile LAS unsigned* MISC = (volatile LAS unsigned*)(lds + LDS_BYTES - 64);
    if (tid < 16) MISC[tid] = 0u;
    __syncthreads();
    const XcdBarrier bar = xcd_barrier_post((unsigned*)(ws + 4096) + lo * XCD_BAR_WORDS, MISC);
#ifndef PHASE_MASK
#define PHASE_MASK 0xFFFF
#endif
#define IN(k) (((PHASE_MASK >> (k)) & 1) && lo <= (k) && (k) < hi)
#ifndef REPEAT_MASK
#define REPEAT_MASK 0
#endif
#define REP(k) for (int rep_ = 0; rep_ < (((REPEAT_MASK) >> (k)) & 1) + 1; ++rep_)
#define SEAM(k) do { if (IN(k) && IN((k) + 1)) { if ((k) == 0) grid.sync(); else xcd_barrier(bar); } } while (0)
    REP(0) if (IN(0)) p0_prologue(a, lds, vb, G);
    SEAM(0);
    REP(1) if (IN(1)) { pg8::Gemm g{(const bf16_t*)(ws + WS_XB), (const bf16_t*)(ws + WS_W1T), T, NIN, 1024}; pg8::StaticOrder S; S.init(T, NIN, G, vb);
        pg8::Epi1 E{(const float*)(ws + WS_RSTD1), (bf16_t*)(ws + WS_PA), (bf16_t*)(ws + WS_GG), (bf16_t*)(ws + WS_QD), (bf16_t*)(ws + WS_KINV), (bf16_t*)(ws + WS_KENDT), (bf16_t*)(ws + WS_VT), (bf16_t*)(ws + WS_GS),
                    (float*)(ws + WS_DEC), (const float*)(ws + WS_LB), (bf16_t*)(ws + WS_AVT), lds + 131072};
        pg8::gemm_phase<pg8::Epi1, pg8::StaticOrder, true, true>(lds, g, S, E); }
    SEAM(1);
    REP(2) if (IN(2)) {
        for (int u0 = vb * 8; u0 < 64 * 64; u0 += G * 8) {
            { int t2_ = threadIdx.x; asm volatile("" : "+v"(t2_)); const int u = u0 + (t2_ >> 6);
              hgrn_prep_unit((bf16_t*)(ws + WS_QD), (bf16_t*)(ws + WS_KINV), lds + (t2_ >> 6) * 18432, (float*)(ws + WS_DEC), (const float*)(ws + WS_LB), u >> 6, u & 63, (t2_ & 63) * 2); }
            __syncthreads();
            for (int j = 0; j < 8; ++j) hgrn_ds_unit(lds + j * 18432, (const bf16_t*)(ws + WS_VT), (bf16_t*)a.out, (u0 + j) >> 6, (u0 + j) & 63);
            __syncthreads();
        }
        for (int u = vb; u < BATCH * (SEQ / 64); u += G) attn_unit((const bf16_t*)(ws + WS_PA), (const bf16_t*)(ws + WS_AVT), a.in[3], (bf16_t*)(ws + WS_YA), lds, u >> 6, u & 63);
    }
    SEAM(2);
    REP(3) if (IN(3)) hgrn_scan((bf16_t*)a.out, (const float*)(ws + WS_DEC), vb, G);
    SEAM(3);
    REP(4) if (IN(4)) hgrn_out_phase((const bf16_t*)(ws + WS_QD), (const bf16_t*)(ws + WS_KINV), (const bf16_t*)(ws + WS_VT), (const bf16_t*)a.out, (const bf16_t*)(ws + WS_GS), (bf16_t*)(ws + WS_YH), lds, vb, G);
    SEAM(4);
    REP(5) if (IN(5)) {
#ifdef P5_STAGGER
        if (vb & 1) { _Pragma("unroll") for (int z = 0; z < P5_STAGGER; ++z) __builtin_amdgcn_s_sleep(127); }
#endif
        { pg8::Gemm g{(const bf16_t*)(ws + WS_YA), (const bf16_t*)(ws + WS_WAPT), T, 1024, 512}; pg8::StaticOrder S; S.init(T, 1024, G, vb);
          pg8::EpiMerge<false> E{(bf16_t*)((unsigned char*)a.out + 128 * MiB), (const bf16_t*)(ws + WS_GG)};
          pg8::gemm_phase<pg8::EpiMerge<false>, pg8::StaticOrder, true, true>(lds, g, S, E); }
        __syncthreads();
        { pg8::Gemm g{(const bf16_t*)(ws + WS_YH), (const bf16_t*)(ws + WS_WHPT), T, 1024, 512}; pg8::StaticOrder S; S.init(T, 1024, G, vb);
          pg8::EpiMerge<true> E{(bf16_t*)((unsigned char*)a.out + 128 * MiB), (const bf16_t*)(ws + WS_GG) + 1024};
          pg8::gemm_phase<pg8::EpiMerge<true>, pg8::StaticOrder, true, true>(lds, g, S, E); }
    }
    SEAM(5);
    REP(6) if (IN(6)) { pg8::Gemm g{(const bf16_t*)((unsigned char*)a.out + 128 * MiB), (const bf16_t*)(ws + WS_WOUTT), T, 1024, 1024}; pg8::StaticOrder S; S.init(T, 1024, G, vb);
        pg8::EpiX2 E{(const bf16_t*)(ws + WS_XB), (bf16_t*)(ws + WS_X2B), (float*)(ws + WS_SSQ2)};
        pg8::gemm_phase<pg8::EpiX2, pg8::StaticOrder, true, true>(lds, g, S, E); }
    SEAM(6);
    REP(7) if (IN(7)) { pg8::Gemm g{(const bf16_t*)(ws + WS_X2B), (const bf16_t*)(ws + WS_WQT), T, 2048, 1024}; pg8::StaticOrder S; S.init(T, 2048, G, vb);
        pg8::EpiQp E{(bf16_t*)(ws + WS_QP), (const float*)(ws + WS_SSQ2)};
        pg8::gemm_phase<pg8::EpiQp, pg8::StaticOrder, true, true>(lds, g, S, E); }
    SEAM(7);
    REP(8) if (IN(8)) { const int per = (1024 + G - 1) / G; int hcur = -1;
        for (int U = vb * per; U < (vb + 1) * per && U < 1024; ++U) { const int h = U >> 7;
            if (h != hcur) { topk_stage_keys((const bf16_t*)(ws + WS_KEYS), lds + 65536, h); hcur = h; __syncthreads(); }
            topk_unit((const bf16_t*)(ws + WS_QP), lds + 65536, (unsigned short*)(ws + WS_GIDX), (float*)(ws + WS_GGATE), (LAS unsigned*)lds, U & 127, h); }
        for (int tok = vb * 8 + wave; tok < T; tok += G * 8) hq_token((const bf16_t*)(ws + WS_X2B) + (size_t)tok * DM, (const float*)(ws + WS_SSQ2) + (size_t)tok * 16, (unsigned char*)(ws + WS_HQ) + (size_t)tok * 1024, (float*)(ws + WS_SH) + tok, lane); }
    SEAM(8);
    if (IN(9) || IN(11)) {
        if (tid == 0) {
            unsigned nloc_ = 0, nx_ = 0; xcd_barrier_complete(bar.bar, bar.x, nloc_, nx_);
            unsigned cj[8], tot = 0; bool all = true;
#pragma unroll
            for (int j = 0; j < 8; ++j) { cj[j] = xb_ld(&bar.bar[XB_XCNT(j)]); tot += cj[j]; all = all && cj[j] > 0u; }
            if (all && tot == (unsigned)G && bar.x < 8u) { MISC[4] = bar.x; MISC[5] = MISC[2]; MISC[6] = cj[bar.x & 7u]; }
            else { const unsigned sl_ = (unsigned)vb & 7u; MISC[4] = sl_; MISC[5] = (unsigned)vb >> 3; MISC[6] = ((unsigned)G - sl_ + 7u) >> 3; }
        }
        __syncthreads();
    }
    REP(9) if (IN(9)) slice_pass<0>(ws, a.out, (int)MISC[4], (int)MISC[5] * 8 + __builtin_amdgcn_readfirstlane(wave), (int)MISC[6] * 8, lane);
    SEAM(9);
    REP(10) if (IN(10)) for (int tok = vb * 8 + wave; tok < T; tok += G * 8)
        expert_w_token((const int*)(ws + WS_ACTP) + (size_t)tok * 256, (const unsigned short*)(ws + WS_GIDX) + (size_t)tok * 128, (const float*)(ws + WS_GGATE) + (size_t)tok * 128, ((const float*)(ws + WS_SH))[tok],
                       (const float*)(ws + WS_SU), (const float*)(ws + WS_SV), (unsigned char*)(ws + WS_WX) + (size_t)tok * 128, (f32x2*)(ws + WS_SW) + tok, lane);
    SEAM(10);
    if (IN(11)) slice_pass_v<0>(ws, (bf16_t*)(ws + WS_X2B), (float*)(ws + WS_SSQ3), lds, __builtin_amdgcn_readfirstlane(wave), (int)MISC[4], (int)MISC[5] * 8 + __builtin_amdgcn_readfirstlane(wave), (int)MISC[6] * 8, lane);
#ifdef PROBE_VPM
    if (IN(11)) slice_pass_v<PROBE_VPM>(ws, (bf16_t*)(ws + WS_QP), (float*)(ws + WS_QP), lds, __builtin_amdgcn_readfirstlane(wave), (int)MISC[4], (int)MISC[5] * 8 + __builtin_amdgcn_readfirstlane(wave), (int)MISC[6] * 8, lane);
#endif
    SEAM(11);
    if (IN(12)) for (int tok = vb * 8 + wave; tok < T; tok += G * 8) final_norm_token((const bf16_t*)(ws + WS_X2B) + (size_t)tok * DM, a.out + (size_t)tok * DM, (const float*)(ws + WS_SSQ3) + (size_t)tok * 4, a.in[14], lane);
#undef IN
#undef SEAM
}

extern "C" void kernel_launch(void* const* d_in, const int* in_sizes, int n_in, void* d_out, int out_size, void* d_ws, size_t ws_size, hipStream_t stream) {
    static int grid = 0;
    if (grid == 0) {
        if (n_in != 15 || in_sizes[0] != T * DM || out_size != T * DM || ws_size < WS_END) { fprintf(stderr, "kernel_launch: unexpected shapes (n_in %d, in0 %d, out %d, ws %zu)\n", n_in, n_in > 0 ? in_sizes[0] : -1, out_size, ws_size); grid = -1; return; }
        int dev = 0, cus = 0, per_cu = 0;
        hipGetDevice(&dev); hipDeviceGetAttribute(&cus, hipDeviceAttributeMultiprocessorCount, dev);
        if (hipFuncSetAttribute((const void*)mk_fwd, hipFuncAttributeMaxDynamicSharedMemorySize, LDS_BYTES) != hipSuccess) { fprintf(stderr, "kernel_launch: hipFuncSetAttribute failed\n"); grid = -1; return; }
        if (hipOccupancyMaxActiveBlocksPerMultiprocessor(&per_cu, (const void*)mk_fwd, NTHR, LDS_BYTES) != hipSuccess || per_cu < 1) { fprintf(stderr, "kernel_launch: occupancy query says %d blocks per CU\n", per_cu); per_cu = 1; }
        (void)hipGetLastError();
        grid = cus;
    }
    if (grid < 0) return;
    if (hipMemsetAsync(d_ws, 0, 256 * 1024, stream) != hipSuccess) { fprintf(stderr, "kernel_launch: hipMemsetAsync failed\n"); return; }
    Args a{};
    for (int i = 0; i < 15; ++i) a.in[i] = (const float*)d_in[i];
    a.out = (float*)d_out; a.ws = (unsigned char*)d_ws;
#if MK_FUSED
    a.ph_lo = 0; a.ph_hi = N_PHASES;
    { void* args[] = {&a}; hipError_t e = hipLaunchCooperativeKernel((const void*)mk_fwd, dim3(grid), dim3(NTHR), args, LDS_BYTES, stream);
      if (e != hipSuccess) fprintf(stderr, "kernel_launch: cooperative launch failed: %s (grid %d)\n", hipGetErrorString(e), grid); }
#else
    for (int p = 0; p < N_PHASES; ++p) { a.ph_lo = p; a.ph_hi = p + 1; void* args[] = {&a};
        hipError_t e = hipLaunchCooperativeKernel((const void*)mk_fwd, dim3(grid), dim3(NTHR), args, LDS_BYTES, stream);
        if (e != hipSuccess) { fprintf(stderr, "kernel_launch: launch of phase %d failed: %s (grid %d)\n", p, hipGetErrorString(e), grid); break; } }
#endif
}
```

```cpp
#include <hip/hip_runtime.h>
#include <hip/hip_cooperative_groups.h>
#include <cstdio>
#include <cstdint>
namespace cg = cooperative_groups;
#define V_MPRIO 1
namespace pg8 {
#define PG8_LAS __attribute__((address_space(3)))
typedef unsigned short bf16_t;
typedef short bf16x8 __attribute__((ext_vector_type(8)));
typedef float f32x4 __attribute__((ext_vector_type(4)));
typedef unsigned u32x4 __attribute__((ext_vector_type(4)));
constexpr int BM = 256, BK = 64, HALF = 128, HTB = HALF * BK * 2  , STAGE_BYTES = 8 * HTB, NXCD = 8, WGM = 8;

__host__ __device__ __forceinline__ int lds_byte(int r, int c) { const int st = (r >> 4) * 2 + (c >> 5), rr = r & 15, cc = c & 31, ob = rr * 64 + cc * 2; return st * 1024 + (ob ^ (((ob >> 9) & 1) << 5)); }
__host__ __device__ __forceinline__ void stage_rc(int b, int& R, int& C) { const int st = b / 1024, sb = b % 1024, swz = sb ^ (((sb >> 9) & 1) << 5); R = (st >> 1) * 16 + swz / 64; C = (st & 1) * 32 + (swz % 64) / 2; }
__host__ __device__ __forceinline__ int perm32(int rho) { const int n = rho >> 4, i = rho & 15; return 8 * (i >> 2) + 4 * n + (i & 3); }

struct Unit { int pm, pn; };
struct Gemm { const bf16_t* A; const bf16_t* Bt; int M, N, K; };

struct StaticOrder {
    int nM, nN, nwg, G, c;
    __host__ __device__ void init(int M, int N, int G_, int c_) { nM = M / BM; nN = N / BM; nwg = nM * nN; G = G_; c = c_; }
    __host__ __device__ bool next(int i, Unit& u) const {
        const long L = (long)i * G + c; if (L >= nwg) return false;
        int wgid = (int)L; { const int q = nwg / NXCD, r = nwg % NXCD, xcd = wgid % NXCD, off = wgid / NXCD; wgid = (xcd < r ? xcd * (q + 1) : r * (q + 1) + (xcd - r) * q) + off; }
        const int nig = WGM * nN, gid = wgid / nig, fm = gid * WGM, gsz = (nM - fm) < WGM ? (nM - fm) : WGM;
        u.pm = fm + ((wgid % nig) % gsz); u.pn = (wgid % nig) / gsz; return true;
    }
    __device__ __forceinline__ void a_ready(const Unit&) const {}
    __device__ __forceinline__ void done(const Unit&) const {}
};

__device__ __forceinline__ unsigned cvt_pk_bf16(float lo, float hi) { unsigned r; asm volatile("v_cvt_pk_bf16_f32 %0, %1, %2" : "=v"(r) : "v"(lo), "v"(hi)); return r; }

template <class Epi, class Sched, bool ALIGN_EPI = false, bool SP2 = false>
__device__ __forceinline__ void gemm_phase(PG8_LAS unsigned char* lds, const Gemm g, const Sched& S, const Epi& E) {
    int tid_ = threadIdx.x; asm volatile("" : "+v"(tid_));
    const int tid = tid_, wid = __builtin_amdgcn_readfirstlane(tid >> 6), lane = tid & 63, wr = wid >> 2, wc = wid & 3, fr = lane & 15, fq = lane >> 4;
    const int K = g.K, nt = K / BK;
    unsigned voffA[2], voffB[2];
#pragma unroll
    for (int i = 0; i < 2; ++i) { int R, C; stage_rc(tid * 16 + i * 8192, R, C); const int Rb = Epi::PERM ? ((R & ~31) + perm32(R & 31)) : R;
        voffA[i] = (unsigned)(R * K + C) * 2u; voffB[i] = (unsigned)(Rb * K + C) * 2u; }
    const size_t kstep = (size_t)(BK * 2);
    const size_t hstep = (size_t)HALF * K * 2;
    const size_t tstep = 2 * hstep;
    const unsigned ldsw = (unsigned)wid * 1024u;
    const int aoff = lds_byte(wr * 64 + fr, fq * 8), boff = lds_byte(wc * 32 + fr, fq * 8);
#define PG8_SA(b, h) (((b) * 2 + (h)) * HTB)
#define PG8_SB(b, h) ((4 + (b) * 2 + (h)) * HTB)
#define PG8_STAGE(bufoff, gbase, voff) do { _Pragma("unroll") for (int _i = 0; _i < 2; ++_i) \
        __builtin_amdgcn_global_load_lds((const unsigned*)((const char*)(gbase) + (voff)[_i]), (PG8_LAS unsigned*)(lds + (bufoff) + ldsw + _i * 8192), 16, 0, 0); } while (0)
#define PG8_LDA(dst, b, h) do { _Pragma("unroll") for (int m = 0; m < 4; ++m) _Pragma("unroll") for (int k = 0; k < 2; ++k) dst[m][k] = *(const PG8_LAS bf16x8*)(lds + PG8_SA(b, h) + aoff + m * 2048 + k * 1024); } while (0)
#define PG8_LDB(dst, b, h) do { _Pragma("unroll") for (int n = 0; n < 2; ++n) _Pragma("unroll") for (int k = 0; k < 2; ++k) dst[n][k] = *(const PG8_LAS bf16x8*)(lds + PG8_SB(b, h) + boff + n * 2048 + k * 1024); } while (0)
#define PG8_MMA(ai, bj, At, Bt) do { __builtin_amdgcn_s_setprio(1); _Pragma("unroll") for (int m = 0; m < 4; ++m) _Pragma("unroll") for (int n = 0; n < 2; ++n) _Pragma("unroll") for (int k = 0; k < 2; ++k) \
        acc[ai][bj][m][n] = __builtin_amdgcn_mfma_f32_16x16x32_bf16(Bt[n][k], At[m][k], acc[ai][bj][m][n], 0, 0, 0); __builtin_amdgcn_s_setprio(0); } while (0)
#define PG8_WAIT_V(n) asm volatile("s_waitcnt vmcnt(" #n ")" ::: "memory")
#define PG8_WAIT_L(n) asm volatile("s_waitcnt lgkmcnt(" #n ")" ::: "memory")
#define PG8_BAR __builtin_amdgcn_s_barrier()
#define PG8_SCHED __builtin_amdgcn_sched_barrier(0)
    Unit cur, nxt; int ui = 0;
    if (!S.next(0, cur)) return;
    f32x4 acc[2][2][4][2];
#pragma unroll
    for (int a = 0; a < 2; ++a)
#pragma unroll
        for (int b = 0; b < 2; ++b)
#pragma unroll
            for (int m = 0; m < 4; ++m)
#pragma unroll
                for (int n = 0; n < 2; ++n) acc[a][b][m][n] = (f32x4){0.f, 0.f, 0.f, 0.f};
    bf16x8 At[4][2], B0[2][2], B1[2][2];
    const char* cA = (const char*)g.A + (size_t)cur.pm * tstep; const char* cB = (const char*)g.Bt + (size_t)cur.pn * tstep;
    S.a_ready(cur);
    if constexpr (SP2) {
        PG8_STAGE(PG8_SB(0, 0), cB, voffB); PG8_STAGE(PG8_SB(0, 1), cB + hstep, voffB); PG8_STAGE(PG8_SA(0, 0), cA, voffA); PG8_STAGE(PG8_SA(0, 1), cA + hstep, voffA);
        if (wr == 1) PG8_BAR;
        PG8_WAIT_V(2); PG8_BAR;
        PG8_STAGE(PG8_SB(1, 0), cB + kstep, voffB); PG8_STAGE(PG8_SA(1, 0), cA + kstep, voffA); PG8_STAGE(PG8_SB(1, 1), cB + hstep + kstep, voffB);
        PG8_WAIT_V(6); PG8_BAR;
    } else {
        PG8_STAGE(PG8_SB(0, 0), cB, voffB); PG8_STAGE(PG8_SA(0, 0), cA, voffA); PG8_STAGE(PG8_SB(0, 1), cB + hstep, voffB); PG8_STAGE(PG8_SA(0, 1), cA + hstep, voffA);
        if (wr == 1) PG8_BAR;
        PG8_WAIT_V(4); PG8_BAR;
        PG8_STAGE(PG8_SB(1, 0), cB + kstep, voffB); PG8_STAGE(PG8_SA(1, 0), cA + kstep, voffA); PG8_STAGE(PG8_SB(1, 1), cB + hstep + kstep, voffB);
        PG8_WAIT_V(6); PG8_BAR;
    }
    for (;;) {
        const bool has_next = S.next(ui + 1, nxt);
        const char* nA = has_next ? (const char*)g.A + (size_t)nxt.pm * tstep : cA; const char* nB = has_next ? (const char*)g.Bt + (size_t)nxt.pn * tstep : cB;
        for (int t = 0; t < nt; t += 2) {
            const bool last = (t == nt - 2);
            const char* a1 = cA + (size_t)(t + 1) * kstep;
            const char* a2 = last ? nA : cA + (size_t)(t + 2) * kstep; const char* b2 = last ? nB : cB + (size_t)(t + 2) * kstep;
            const char* a3 = a2 + kstep; const char* b3 = b2 + kstep;
            if (last && has_next) S.a_ready(nxt);
            if constexpr (SP2) {
            PG8_LDB(B0, 0, 0); PG8_LDB(B1, 0, 1); PG8_SCHED; PG8_LDA(At, 0, 0); PG8_STAGE(PG8_SA(1, 1), a1 + hstep, voffA);
            PG8_WAIT_V(8); PG8_WAIT_L(0); PG8_BAR; PG8_MMA(0, 0, At, B0); PG8_MMA(0, 1, At, B1); PG8_BAR; PG8_SCHED;
            PG8_LDA(At, 0, 1); PG8_STAGE(PG8_SB(0, 0), b2, voffB); PG8_STAGE(PG8_SB(0, 1), b2 + hstep, voffB); PG8_STAGE(PG8_SA(0, 0), a2, voffA);
            PG8_WAIT_V(8); PG8_WAIT_L(0); PG8_BAR; PG8_MMA(1, 0, At, B0); PG8_MMA(1, 1, At, B1); PG8_BAR; PG8_SCHED;
            PG8_LDB(B0, 1, 0); PG8_LDB(B1, 1, 1); PG8_SCHED; PG8_LDA(At, 1, 0); PG8_STAGE(PG8_SA(0, 1), a2 + hstep, voffA);
            PG8_WAIT_V(8); PG8_WAIT_L(0); PG8_BAR; PG8_MMA(0, 0, At, B0); PG8_MMA(0, 1, At, B1); PG8_BAR; PG8_SCHED;
            PG8_LDA(At, 1, 1); PG8_STAGE(PG8_SB(1, 0), b3, voffB); PG8_STAGE(PG8_SB(1, 1), b3 + hstep, voffB); PG8_STAGE(PG8_SA(1, 0), a3, voffA);
            PG8_WAIT_V(8); PG8_WAIT_L(0); PG8_BAR; PG8_MMA(1, 0, At, B0); PG8_MMA(1, 1, At, B1); PG8_BAR; PG8_SCHED;
            } else {
            PG8_LDB(B0, 0, 0); PG8_SCHED; PG8_LDA(At, 0, 0); PG8_STAGE(PG8_SA(1, 1), a1 + hstep, voffA);
            PG8_WAIT_L(8); PG8_BAR; PG8_WAIT_L(0); PG8_MMA(0, 0, At, B0); PG8_BAR; PG8_SCHED;
            PG8_LDB(B1, 0, 1); PG8_STAGE(PG8_SB(0, 0), b2, voffB);
            PG8_BAR; PG8_WAIT_L(0); PG8_MMA(0, 1, At, B1); PG8_BAR;
            PG8_LDA(At, 0, 1); PG8_STAGE(PG8_SA(0, 0), a2, voffA);
            PG8_BAR; PG8_WAIT_L(0); PG8_MMA(1, 0, At, B0); PG8_BAR; PG8_SCHED;
            PG8_STAGE(PG8_SB(0, 1), b2 + hstep, voffB);
            PG8_WAIT_V(6); PG8_BAR; PG8_MMA(1, 1, At, B1); PG8_BAR;
            PG8_LDB(B0, 1, 0); PG8_SCHED; PG8_LDA(At, 1, 0); PG8_STAGE(PG8_SA(0, 1), a2 + hstep, voffA);
            PG8_WAIT_L(8); PG8_BAR; PG8_WAIT_L(0); PG8_MMA(0, 0, At, B0); PG8_BAR; PG8_SCHED;
            PG8_LDB(B1, 1, 1); PG8_STAGE(PG8_SB(1, 0), b3, voffB);
            PG8_BAR; PG8_WAIT_L(0); PG8_MMA(0, 1, At, B1); PG8_BAR;
            PG8_LDA(At, 1, 1); PG8_STAGE(PG8_SA(1, 0), a3, voffA);
            PG8_BAR; PG8_WAIT_L(0); PG8_MMA(1, 0, At, B0); PG8_BAR; PG8_SCHED;
            PG8_STAGE(PG8_SB(1, 1), b3 + hstep, voffB);
            PG8_WAIT_V(6); PG8_BAR; PG8_MMA(1, 1, At, B1); PG8_BAR;
            }
        }
        if constexpr (ALIGN_EPI) { if (wr == 0) PG8_BAR; }
        if constexpr (!Epi::AFTER_DRAIN) { E(acc, cur, wr, wc, fr, fq); S.done(cur); }
        if (!has_next) break;
#pragma unroll
        for (int a = 0; a < 2; ++a)
#pragma unroll
            for (int b = 0; b < 2; ++b)
#pragma unroll
                for (int m = 0; m < 4; ++m)
#pragma unroll
                    for (int n = 0; n < 2; ++n) acc[a][b][m][n] = (f32x4){0.f, 0.f, 0.f, 0.f};
        cur = nxt; cA = nA; cB = nB; ++ui;
        if constexpr (ALIGN_EPI) { if (wr == 1) PG8_BAR; }
    }
    PG8_WAIT_V(0);
    if constexpr (!ALIGN_EPI) { if (wr == 0) PG8_BAR; }
    PG8_BAR;
    if constexpr (Epi::AFTER_DRAIN) { E.fused(acc, cur, wr, wc, fr, fq, lds, wid, lane); S.done(cur); }
#undef PG8_SA
#undef PG8_SB
#undef PG8_STAGE
#undef PG8_LDA
#undef PG8_LDB
#undef PG8_MMA
#undef PG8_WAIT_V
#undef PG8_WAIT_L
#undef PG8_BAR
#undef PG8_SCHED
}
}

#ifndef MK_FUSED
#define MK_FUSED 1
#endif
#define DI __device__ __forceinline__
#define LAS __attribute__((address_space(3)))
typedef unsigned short bf16_t;
typedef float f32x4 __attribute__((ext_vector_type(4)));
typedef float f32x2 __attribute__((ext_vector_type(2)));
typedef float f32x16 __attribute__((ext_vector_type(16)));
typedef unsigned u32x4 __attribute__((ext_vector_type(4)));
typedef unsigned u32x2 __attribute__((ext_vector_type(2)));
typedef short bf16x8 __attribute__((ext_vector_type(8)));
typedef _Float16 h16x2 __attribute__((ext_vector_type(2)));
typedef _Float16 h16x8 __attribute__((ext_vector_type(8)));

constexpr int BATCH = 16, SEQ = 4096, T = BATCH * SEQ, DM = 1024, NIN = 4864;
constexpr int C_AQ = 0, C_AK = 512, C_AV = 640, C_HQ = 768, C_HF = 1280, C_HI = 1792, C_HG = 2304, C_GA = 2816, C_GH = 3840;
constexpr float EPS = 1e-6f;
constexpr int NTHR = 512;
constexpr int LDS_BYTES = 163840;

constexpr size_t MiB = 1u << 20;
constexpr size_t WS_W1T = 1 * MiB;
constexpr size_t WS_WAPT = 11 * MiB;
constexpr size_t WS_WHPT = 12 * MiB;
constexpr size_t WS_WOUTT = 13 * MiB;
constexpr size_t WS_WQT = 15 * MiB;
constexpr size_t WS_KEYS = 19 * MiB;
constexpr size_t WS_LB = 19 * MiB + 512 * 1024;
constexpr size_t WS_RSTD1 = 20 * MiB;
constexpr size_t WS_SSQ2 = 21 * MiB;
constexpr size_t WS_U8 = 26 * MiB;
constexpr size_t WS_V8 = 42 * MiB;
constexpr size_t WS_SU = 58 * MiB;
constexpr size_t WS_SV = 58 * MiB + 65536;
constexpr size_t WS_DEC = 60 * MiB;
constexpr size_t WS_AVT = 64 * MiB;
constexpr size_t WS_XB = 90 * MiB;
constexpr size_t WS_PA = 218 * MiB;
constexpr size_t WS_GG = 314 * MiB;
constexpr size_t WS_QD = 570 * MiB;
constexpr size_t WS_KINV = 634 * MiB;
constexpr size_t WS_KENDT = 698 * MiB;
constexpr size_t WS_VT = 762 * MiB;
constexpr size_t WS_GS = 826 * MiB;
constexpr size_t WS_YA = 890 * MiB;
constexpr size_t WS_YH = 954 * MiB;
constexpr size_t WS_END = 1018 * MiB;
constexpr size_t WS_HQ = 698 * MiB;
constexpr size_t WS_WX = 762 * MiB;
constexpr size_t WS_SH = 60 * MiB;
constexpr size_t WS_SSQ3 = 64 * MiB;
constexpr size_t WS_SW = 61 * MiB;
constexpr size_t WS_ACTP = 346 * MiB;
constexpr size_t WS_X2B = 218 * MiB;
constexpr size_t WS_QP = 346 * MiB;
constexpr size_t WS_GIDX = 602 * MiB;
constexpr size_t WS_GGATE = 618 * MiB;

struct Args { const float* in[15]; float* out; unsigned char* ws; int ph_lo, ph_hi; };

DI unsigned pk_bf16(float lo, float hi) { typedef __bf16 b2 __attribute__((ext_vector_type(2))); f32x2 v = {lo, hi}; b2 b = __builtin_convertvector(v, b2); return __builtin_bit_cast(unsigned, b); }
DI float bflo(unsigned w) { return __uint_as_float(w << 16); }
DI float bfhi(unsigned w) { return __uint_as_float(w & 0xffff0000u); }
DI float sigm(float x) { return __builtin_amdgcn_rcpf(1.f + __expf(-x)); }
DI float wave_sum(float v) {
    v += __int_as_float(__builtin_amdgcn_mov_dpp(__float_as_int(v), 0xB1, 0xf, 0xf, true));
    v += __int_as_float(__builtin_amdgcn_mov_dpp(__float_as_int(v), 0x4E, 0xf, 0xf, true));
    v += __int_as_float(__builtin_amdgcn_mov_dpp(__float_as_int(v), 0x141, 0xf, 0xf, true));
    v += __int_as_float(__builtin_amdgcn_mov_dpp(__float_as_int(v), 0x128, 0xf, 0xf, true));
    { const auto r = __builtin_amdgcn_permlane16_swap(__float_as_uint(v), __float_as_uint(v), false, false); v = __uint_as_float(r[0]) + __uint_as_float(r[1]); }
    { const auto r = __builtin_amdgcn_permlane32_swap(__float_as_uint(v), __float_as_uint(v), false, false); v = __uint_as_float(r[0]) + __uint_as_float(r[1]); }
    return v;
}
DI float wave_max(float v) {
    v = fmaxf(v, __int_as_float(__builtin_amdgcn_mov_dpp(__float_as_int(v), 0xB1, 0xf, 0xf, true)));
    v = fmaxf(v, __int_as_float(__builtin_amdgcn_mov_dpp(__float_as_int(v), 0x4E, 0xf, 0xf, true)));
    v = fmaxf(v, __int_as_float(__builtin_amdgcn_mov_dpp(__float_as_int(v), 0x141, 0xf, 0xf, true)));
    v = fmaxf(v, __int_as_float(__builtin_amdgcn_mov_dpp(__float_as_int(v), 0x128, 0xf, 0xf, true)));
    { const auto r = __builtin_amdgcn_permlane16_swap(__float_as_uint(v), __float_as_uint(v), false, false); v = fmaxf(__uint_as_float(r[0]), __uint_as_float(r[1])); }
    { const auto r = __builtin_amdgcn_permlane32_swap(__float_as_uint(v), __float_as_uint(v), false, false); v = fmaxf(__uint_as_float(r[0]), __uint_as_float(r[1])); }
    return v;
}
DI unsigned short bf16_1(float x) { return (unsigned short)(pk_bf16(x, 0.f) & 0xffffu); }
template <int N> DI float dpp_row_shr(float v) { return __int_as_float(__builtin_amdgcn_update_dpp(0, __float_as_int(v), 0x110 + N, 0xf, 0xf, true)); }
DI float rowsum16(float v) { v += __int_as_float(__builtin_amdgcn_mov_dpp(__float_as_int(v), 0xB1, 0xf, 0xf, true)); v += __int_as_float(__builtin_amdgcn_mov_dpp(__float_as_int(v), 0x4E, 0xf, 0xf, true));
    v += __int_as_float(__builtin_amdgcn_mov_dpp(__float_as_int(v), 0x141, 0xf, 0xf, true)); v += __int_as_float(__builtin_amdgcn_mov_dpp(__float_as_int(v), 0x128, 0xf, 0xf, true)); return v; }
DI float scan16(float v) { v += dpp_row_shr<1>(v); v += dpp_row_shr<2>(v); v += dpp_row_shr<4>(v); v += dpp_row_shr<8>(v); return v; }
DI int crow(int reg, int hh) { return (reg & 3) + 8 * (reg >> 2) + 4 * hh; }
#define MFMA32(a, b, c) __builtin_amdgcn_mfma_f32_32x32x16_bf16((a), (b), (c), 0, 0, 0)
#define LDS_WAIT() asm volatile("s_waitcnt lgkmcnt(0)" ::: "memory")

namespace pg8 {
#define TSTORE_WRITE(sl, e, m, x) *(PG8_LAS bf16_t*)((sl) + (4 * fq + (e)) * 144 + (16 * (m) + fr) * 2) = bf16_1(x)
struct Epi1 {
    static constexpr bool PERM = true, AFTER_DRAIN = false;
    const float* rs; bf16_t* pa; bf16_t* gg; bf16_t* qd; bf16_t* kinv; bf16_t* kendT; bf16_t* vT; bf16_t* gs; float* dec; const float* lb; bf16_t* avT; PG8_LAS unsigned char* xl;
    __device__ __forceinline__ void operator()(const f32x4 (&acc)[2][2][4][2], const Unit& u, int wr, int wc, int fr, int fq) const {
        asm volatile("" : "+v"(fr), "+v"(fq));
        const int row0 = u.pm * BM + wr * 64 + fr, pn = u.pn;
        float rsv[2][4];
#pragma unroll
        for (int ai = 0; ai < 2; ++ai)
#pragma unroll
            for (int m = 0; m < 4; ++m) rsv[ai][m] = rs[row0 + ai * HALF + m * 16];
        if (pn == 2) {
            const int c8 = wc * 32 + 8 * fq, tseqb = (u.pm & 15) * 256 + wr * 64 + fr, bb = u.pm >> 4;
#pragma unroll
            for (int ai = 0; ai < 2; ++ai)
#pragma unroll
                for (int m = 0; m < 4; ++m) { const int row = row0 + ai * HALF + m * 16; const float s = rsv[ai][m];
                    const f32x4 v0 = acc[ai][0][m][0] * s, v1 = acc[ai][0][m][1] * s;
                    u32x4 w; w.x = pk_bf16(v0[0], v0[1]); w.y = pk_bf16(v0[2], v0[3]); w.z = pk_bf16(v1[0], v1[1]); w.w = pk_bf16(v1[2], v1[3]);
                    *(u32x4*)(pa + (size_t)row * 768 + 512 + c8) = w;
                }
            PG8_LAS unsigned char* sl = xl + (wr * 4 + wc) * 2304; const int lane_ = fq * 16 + fr;
#pragma unroll
            for (int ai = 0; ai < 2; ++ai)
#pragma unroll
                for (int n = 0; n < 2; ++n) {
#pragma unroll
                    for (int m = 0; m < 4; ++m) { const float s = rsv[ai][m];
#pragma unroll
                        for (int e = 0; e < 4; ++e) TSTORE_WRITE(sl, e, m, acc[ai][1][m][n][e] * s); }
                    asm volatile("s_waitcnt lgkmcnt(0)" ::: "memory");
#pragma unroll
                    for (int q = 0; q < 2; ++q) { const int c = lane_ + 64 * q, rw = c >> 3, tc = c & 7, col = wc * 32 + 8 * (rw >> 2) + 4 * n + (rw & 3);
                        const u32x4 w = *(const PG8_LAS u32x4*)(sl + rw * 144 + tc * 16);
                        *(u32x4*)(avT + (size_t)((bb * 2 + (col >> 6)) * 64 + (col & 63)) * SEQ + (u.pm & 15) * 256 + ai * HALF + wr * 64 + 8 * tc) = w; }
                    asm volatile("s_waitcnt lgkmcnt(0)" ::: "memory");
                }
            return;
        }
        if (pn < 3 || pn >= 11) {
            bf16_t* O; int ldc, colt;
            if (pn < 3) { O = pa; ldc = 768; colt = pn * 256; } else { O = gg; ldc = 2048; colt = (pn - 11) * 256; }
            const int col0 = colt + wc * 32 + 8 * fq;
#pragma unroll
            for (int ai = 0; ai < 2; ++ai)
#pragma unroll
                for (int m = 0; m < 4; ++m) { const int row = row0 + ai * HALF + m * 16; const float s = rsv[ai][m]; bf16_t* rowp = O + (size_t)row * ldc + col0;
#pragma unroll
                    for (int bj = 0; bj < 2; ++bj) { const f32x4 v0 = acc[ai][bj][m][0] * s, v1 = acc[ai][bj][m][1] * s;
                        u32x4 w; w.x = pk_bf16(v0[0], v0[1]); w.y = pk_bf16(v0[2], v0[3]); w.z = pk_bf16(v1[0], v1[1]); w.w = pk_bf16(v1[2], v1[3]);
                        *(u32x4*)(rowp + bj * HALF) = w; } }
            return;
        }
        PG8_LAS unsigned char* sl = xl + (wr * 4 + wc) * 2304; const int lane_ = fq * 16 + fr;
        const int h = (pn - 3) & 3, c8 = wc * 32 + 8 * fq, bh = (u.pm >> 4) * 4 + h;
        if (pn < 7) {
#pragma unroll
            for (int ai = 0; ai < 2; ++ai)
#pragma unroll
                for (int m = 0; m < 4; ++m) { const int row = row0 + ai * HALF + m * 16; const float s = rsv[ai][m]; const size_t o = (size_t)row * 512 + h * 128 + c8;
#pragma unroll
                    for (int bj = 0; bj < 2; ++bj) { const f32x4 v0 = acc[ai][bj][m][0] * s, v1 = acc[ai][bj][m][1] * s;
                        u32x4 w; w.x = pk_bf16(v0[0], v0[1]); w.y = pk_bf16(v0[2], v0[3]); w.z = pk_bf16(v1[0], v1[1]); w.w = pk_bf16(v1[2], v1[3]);
                        *(u32x4*)((bj ? kinv : qd) + o) = w; } }
        } else {
#pragma unroll
            for (int ai = 0; ai < 2; ++ai) {
                const int tseq0 = (u.pm & 15) * 256 + ai * HALF + wr * 64;
#pragma unroll
                for (int n = 0; n < 2; ++n) {
#pragma unroll
                    for (int m = 0; m < 4; ++m) { const float s = rsv[ai][m];
#pragma unroll
                        for (int e = 0; e < 4; ++e) TSTORE_WRITE(sl, e, m, acc[ai][0][m][n][e] * s); }
                    asm volatile("s_waitcnt lgkmcnt(0)" ::: "memory");
#pragma unroll
                    for (int q = 0; q < 2; ++q) { const int c = lane_ + 64 * q, rw = c >> 3, tc = c & 7, dvr = wc * 32 + 8 * (rw >> 2) + 4 * n + (rw & 3);
                        const u32x4 w = *(const PG8_LAS u32x4*)(sl + rw * 144 + tc * 16);
                        *(u32x4*)(vT + (size_t)(bh * 128 + dvr) * SEQ + tseq0 + 8 * tc) = w; }
                    asm volatile("s_waitcnt lgkmcnt(0)" ::: "memory");
                }
#pragma unroll
                for (int m = 0; m < 4; ++m) { const int row = row0 + ai * HALF + m * 16; const float s = rsv[ai][m];
                    f32x4 g0 = acc[ai][1][m][0] * s, g1 = acc[ai][1][m][1] * s;
#pragma unroll
                    for (int e = 0; e < 4; ++e) { g0[e] *= sigm(g0[e]); g1[e] *= sigm(g1[e]); }
                    u32x4 w; w.x = pk_bf16(g0[0], g0[1]); w.y = pk_bf16(g0[2], g0[3]); w.z = pk_bf16(g1[0], g1[1]); w.w = pk_bf16(g1[2], g1[3]);
                    *(u32x4*)(gs + (size_t)row * 512 + h * 128 + c8) = w; }
            }
        }
    }
};
template <bool ADD> struct EpiMerge {
    static constexpr bool PERM = true, AFTER_DRAIN = false;
    bf16_t* O; const bf16_t* gate;
    __device__ __forceinline__ void operator()(const f32x4 (&acc)[2][2][4][2], const Unit& u, int wr, int wc, int fr, int fq) const {
        const int row0 = u.pm * BM + wr * 64 + fr, col0 = u.pn * BM + wc * 32 + 8 * fq;
#pragma unroll
        for (int ai = 0; ai < 2; ++ai) {
            u32x4 g[4][2], o[4][2];
#pragma unroll
            for (int m = 0; m < 4; ++m)
#pragma unroll
                for (int bj = 0; bj < 2; ++bj) { const size_t row = (size_t)(row0 + ai * HALF + m * 16);
                    g[m][bj] = *(const u32x4*)(gate + row * 2048 + col0 + bj * HALF); if (ADD) o[m][bj] = *(const u32x4*)(O + row * DM + col0 + bj * HALF); }
#pragma unroll
            for (int m = 0; m < 4; ++m) { const int row = row0 + ai * HALF + m * 16; bf16_t* rowp = O + (size_t)row * DM + col0;
#pragma unroll
                for (int bj = 0; bj < 2; ++bj) { const u32x4 gq = g[m][bj];
                    f32x4 v0 = acc[ai][bj][m][0], v1 = acc[ai][bj][m][1];
                    v0[0] *= sigm(bflo(gq.x)); v0[1] *= sigm(bfhi(gq.x)); v0[2] *= sigm(bflo(gq.y)); v0[3] *= sigm(bfhi(gq.y));
                    v1[0] *= sigm(bflo(gq.z)); v1[1] *= sigm(bfhi(gq.z)); v1[2] *= sigm(bflo(gq.w)); v1[3] *= sigm(bfhi(gq.w));
                    if (ADD) { const u32x4 oq = o[m][bj];
                        v0[0] += bflo(oq.x); v0[1] += bfhi(oq.x); v0[2] += bflo(oq.y); v0[3] += bfhi(oq.y); v1[0] += bflo(oq.z); v1[1] += bfhi(oq.z); v1[2] += bflo(oq.w); v1[3] += bfhi(oq.w); }
                    u32x4 w; w.x = pk_bf16(v0[0], v0[1]); w.y = pk_bf16(v0[2], v0[3]); w.z = pk_bf16(v1[0], v1[1]); w.w = pk_bf16(v1[2], v1[3]);
                    *(u32x4*)(rowp + bj * HALF) = w; } }
        }
    }
};
struct EpiX2 {
    static constexpr bool PERM = true, AFTER_DRAIN = false;
    const bf16_t* X; bf16_t* X2B; float* ssq;
    __device__ __forceinline__ void operator()(const f32x4 (&acc)[2][2][4][2], const Unit& u, int wr, int wc, int fr, int fq) const {
        const int row0 = u.pm * BM + wr * 64 + fr, col0 = u.pn * BM + wc * 32 + 8 * fq;
#pragma unroll
        for (int ai = 0; ai < 2; ++ai) {
            u32x4 xr[4][2];
#pragma unroll
            for (int m = 0; m < 4; ++m)
#pragma unroll
                for (int bj = 0; bj < 2; ++bj) xr[m][bj] = *(const u32x4*)(X + (size_t)(row0 + ai * HALF + m * 16) * DM + col0 + bj * HALF);
#pragma unroll
            for (int m = 0; m < 4; ++m) { const int row = row0 + ai * HALF + m * 16; const size_t off = (size_t)row * DM + col0; float ss = 0.f;
#pragma unroll
                for (int bj = 0; bj < 2; ++bj) { const u32x4 xq = xr[m][bj];
                    const f32x4 v0 = acc[ai][bj][m][0] + (f32x4){bflo(xq.x), bfhi(xq.x), bflo(xq.y), bfhi(xq.y)}, v1 = acc[ai][bj][m][1] + (f32x4){bflo(xq.z), bfhi(xq.z), bflo(xq.w), bfhi(xq.w)};
                    u32x4 w; w.x = pk_bf16(v0[0], v0[1]); w.y = pk_bf16(v0[2], v0[3]); w.z = pk_bf16(v1[0], v1[1]); w.w = pk_bf16(v1[2], v1[3]);
                    *(u32x4*)(X2B + off + bj * HALF) = w;
                    ss += (v0[0] * v0[0] + v0[1] * v0[1]) + (v0[2] * v0[2] + v0[3] * v0[3]) + (v1[0] * v1[0] + v1[1] * v1[1]) + (v1[2] * v1[2] + v1[3] * v1[3]); }
                { const auto r = __builtin_amdgcn_permlane16_swap(__float_as_uint(ss), __float_as_uint(ss), false, false); ss = __uint_as_float(r[0]) + __uint_as_float(r[1]); }
                { const auto r = __builtin_amdgcn_permlane32_swap(__float_as_uint(ss), __float_as_uint(ss), false, false); ss = __uint_as_float(r[0]) + __uint_as_float(r[1]); }
                if (fq == 0) ssq[(size_t)row * 16 + u.pn * 4 + wc] = ss; }
        }
    }
};
struct EpiQp {
    static constexpr bool PERM = true, AFTER_DRAIN = false;
    bf16_t* O; const float* ssq;
    __device__ __forceinline__ void operator()(const f32x4 (&acc)[2][2][4][2], const Unit& u, int wr, int wc, int fr, int fq) const {
        const int row0 = u.pm * BM + wr * 64 + fr, col0 = u.pn * BM + wc * 32 + 8 * fq;
        float sv[2][4];
#pragma unroll
        for (int ai = 0; ai < 2; ++ai)
#pragma unroll
            for (int m = 0; m < 4; ++m) { const f32x4 a = *(const f32x4*)(ssq + (size_t)(row0 + ai * HALF + m * 16) * 16 + 4 * fq); sv[ai][m] = (a[0] + a[1]) + (a[2] + a[3]); }
#pragma unroll
        for (int ai = 0; ai < 2; ++ai)
#pragma unroll
            for (int m = 0; m < 4; ++m) { float t = sv[ai][m];
                { const auto r = __builtin_amdgcn_permlane16_swap(__float_as_uint(t), __float_as_uint(t), false, false); t = __uint_as_float(r[0]) + __uint_as_float(r[1]); }
                { const auto r = __builtin_amdgcn_permlane32_swap(__float_as_uint(t), __float_as_uint(t), false, false); t = __uint_as_float(r[0]) + __uint_as_float(r[1]); }
                sv[ai][m] = __builtin_amdgcn_rsqf(t * (1.f / 1024.f) + EPS); }
#pragma unroll
        for (int ai = 0; ai < 2; ++ai)
#pragma unroll
            for (int m = 0; m < 4; ++m) { const int row = row0 + ai * HALF + m * 16; const float s = sv[ai][m]; bf16_t* rowp = O + (size_t)row * 2048 + col0;
#pragma unroll
                for (int bj = 0; bj < 2; ++bj) { const f32x4 v0 = acc[ai][bj][m][0] * s, v1 = acc[ai][bj][m][1] * s;
                    u32x4 w; w.x = pk_bf16(v0[0], v0[1]); w.y = pk_bf16(v0[2], v0[3]); w.z = pk_bf16(v1[0], v1[1]); w.w = pk_bf16(v1[2], v1[3]);
                    *(u32x4*)(rowp + bj * HALF) = w; } }
    }
};
}

DI int w1_src_col(int n) {
    if (n < 768 || n >= 2816) return n;
    if (n < 1792) { const int h = (n - 768) >> 8, r = (n - 768) & 255; return r < 128 ? C_HQ + 128 * h + r : C_HF + 128 * h + (r - 128); }
    const int h = (n - 1792) >> 8, r = (n - 1792) & 255; return r < 128 ? C_HI + 128 * h + r : C_HG + 128 * h + (r - 128);
}
template <bool PERMW1> DI void p0_transpose_item(const float* W, int K, int N, bf16_t* WT, const float* g, int gmask, LAS float* scr, int item, int lane) {
    const int nblk = N / 32, kb = item / nblk, nb = item % nblk, k0 = 64 * kb, n0 = 32 * nb, ns = PERMW1 ? w1_src_col(n0) : n0;
    {
        float wv[32], gv[32];
#pragma unroll
        for (int i = 0; i < 32; ++i) { const int kk = 2 * i + (lane >> 5); wv[i] = W[(size_t)(k0 + kk) * N + ns + (lane & 31)]; }
        if (g) {
#pragma unroll
            for (int i = 0; i < 32; ++i) { const int kk = 2 * i + (lane >> 5); gv[i] = g[(k0 + kk) & gmask]; }
#pragma unroll
            for (int i = 0; i < 32; ++i) wv[i] *= gv[i];
        }
#pragma unroll
        for (int i = 0; i < 32; ++i) { const int kk = 2 * i + (lane >> 5); scr[kk * 33 + (lane & 31)] = wv[i]; }
    }
    LDS_WAIT(); asm volatile("" ::: "memory");
    const int c = lane & 7;
#pragma unroll
    for (int j = 0; j < 4; ++j) { const int n = (lane >> 3) + 8 * j; const LAS float* s = scr + (8 * c) * 33 + n;
        u32x4 o; o.x = pk_bf16(s[0 * 33], s[1 * 33]); o.y = pk_bf16(s[2 * 33], s[3 * 33]); o.z = pk_bf16(s[4 * 33], s[5 * 33]); o.w = pk_bf16(s[6 * 33], s[7 * 33]);
        *(u32x4*)(WT + (size_t)(n0 + n) * K + k0 + 8 * c) = o; }
    LDS_WAIT(); asm volatile("" ::: "memory");
}
DI unsigned pk_f16(float a, float b) { h16x2 v = {(_Float16)a, (_Float16)b}; return __builtin_bit_cast(unsigned, v); }

DI void p0_prologue(const Args& a, LAS unsigned char* lds, int vb, int G) {
    const int tid = threadIdx.x, lane = tid & 63, wave = tid >> 6;
    const int gw = vb * 8 + wave, NGW = G * 8, gt = vb * NTHR + tid, NGT = G * NTHR;
    unsigned char* ws = a.ws;
    LAS float* scr = (LAS float*)(lds + wave * 16384);
    constexpr int I_W1 = 16 * 152, I_AP = 8 * 32, I_HP = 8 * 32, I_OUT = 16 * 32, I_Q = 16 * 64, NITEMS = I_W1 + I_AP + I_HP + I_OUT + I_Q;
    for (int it = gw; it < NITEMS; it += NGW) {
        int r = it;
        if (r < I_W1) { p0_transpose_item<true>(a.in[2], 1024, NIN, (bf16_t*)(ws + WS_W1T), a.in[1], 1023, scr, r, lane); continue; } r -= I_W1;
        if (r < I_AP) { p0_transpose_item<false>(a.in[6], 512, 1024, (bf16_t*)(ws + WS_WAPT), nullptr, 0, scr, r, lane); continue; } r -= I_AP;
        if (r < I_HP) { p0_transpose_item<false>(a.in[7], 512, 1024, (bf16_t*)(ws + WS_WHPT), a.in[5], 127, scr, r, lane); continue; } r -= I_HP;
        if (r < I_OUT) { p0_transpose_item<false>(a.in[8], 1024, 1024, (bf16_t*)(ws + WS_WOUTT), nullptr, 0, scr, r, lane); continue; } r -= I_OUT;
        p0_transpose_item<false>(a.in[10], 1024, 2048, (bf16_t*)(ws + WS_WQT), a.in[9], 1023, scr, r, lane);
    }
    for (int i = gt; i < 2 * 8 * 128 * 128 / 4; i += NGT) { const f32x4 v = ((const f32x4*)a.in[11])[i]; u32x2 o; o.x = pk_bf16(v[0], v[1]); o.y = pk_bf16(v[2], v[3]); ((u32x2*)(ws + WS_KEYS))[i] = o; }
    {
        f32x4 g2[4];
#pragma unroll
        for (int i = 0; i < 4; ++i) g2[i] = *(const f32x4*)(a.in[9] + 16 * lane + 4 * i);
        const int nrow = 2 * 16384;
#define Q_SRC(it_) (((it_) >= 16384 ? a.in[13] : a.in[12]) + (size_t)((it_) & 16383) * 1024 + 16 * lane)
        f32x4 xn[4];
        { const int it0 = gw < nrow ? gw : nrow - 1; const float* src = Q_SRC(it0);
#pragma unroll
          for (int i = 0; i < 4; ++i) xn[i] = *(const f32x4*)(src + 4 * i); }
        for (int it = gw; it < nrow; it += NGW) {
            const int isv = it >= 16384, e = it & 16383;
            f32x4 x[4]; float amax = 0.f;
#pragma unroll
            for (int i = 0; i < 4; ++i) x[i] = xn[i];
            { const int itn = it + NGW < nrow ? it + NGW : nrow - 1; const float* src = Q_SRC(itn);
#pragma unroll
              for (int i = 0; i < 4; ++i) xn[i] = *(const f32x4*)(src + 4 * i); }
#pragma unroll
            for (int i = 0; i < 4; ++i) { if (!isv) x[i] *= g2[i];
                amax = fmaxf(fmaxf(amax, fmaxf(fabsf(x[i][0]), fabsf(x[i][1]))), fmaxf(fabsf(x[i][2]), fabsf(x[i][3]))); }
            amax = wave_max(amax);
            float ssq_ = 0.f;
#pragma unroll
            for (int i = 0; i < 4; ++i) ssq_ += (x[i][0] * x[i][0] + x[i][1] * x[i][1]) + (x[i][2] * x[i][2] + x[i][3] * x[i][3]);
            ssq_ = wave_sum(ssq_);
            const float stp = fminf(0.35f * sqrtf(ssq_ * (1.f / 1024.f)), amax * (1.f / 7.f)), q4 = stp > 0.f ? 1.f / stp : 0.f; unsigned nb[16];
#pragma unroll
            for (int i = 0; i < 16; ++i) { const int q_ = (int)fminf(fmaxf(rintf(x[i >> 2][i & 3] * q4), -7.f), 7.f); nb[i] = (isv && !(i & 1)) ? (unsigned)(q_ + 8) : ((unsigned)q_ & 15u); }
            u32x2 w4; w4.x = (nb[0] | (nb[1] << 4)) | ((nb[2] | (nb[3] << 4)) << 8) | ((nb[4] | (nb[5] << 4)) << 16) | ((nb[6] | (nb[7] << 4)) << 24);
            w4.y = (nb[8] | (nb[9] << 4)) | ((nb[10] | (nb[11] << 4)) << 8) | ((nb[12] | (nb[13] << 4)) << 16) | ((nb[14] | (nb[15] << 4)) << 24);
            *(u32x2*)(ws + (isv ? WS_V8 : WS_U8) + (size_t)e * 512 + 8 * lane) = w4;
            if (lane == 0) ((float*)(ws + (isv ? WS_SV : WS_SU)))[e] = stp;
        }
#undef Q_SRC
    }
    for (int row = gw; row < T; row += 2 * NGW) {
        const int row1 = row + NGW < T ? row + NGW : row;
        const f32x4* xr0 = (const f32x4*)(a.in[0] + (size_t)row * DM) + lane; const f32x4* xr1 = (const f32x4*)(a.in[0] + (size_t)row1 * DM) + lane;
        f32x4 v0[4], v1[4]; float s0 = 0.f, s1 = 0.f;
#pragma unroll
        for (int j = 0; j < 4; ++j) v0[j] = xr0[64 * j];
#pragma unroll
        for (int j = 0; j < 4; ++j) v1[j] = xr1[64 * j];
#pragma unroll
        for (int j = 0; j < 4; ++j) { s0 += (v0[j][0] * v0[j][0] + v0[j][1] * v0[j][1]) + (v0[j][2] * v0[j][2] + v0[j][3] * v0[j][3]); s1 += (v1[j][0] * v1[j][0] + v1[j][1] * v1[j][1]) + (v1[j][2] * v1[j][2] + v1[j][3] * v1[j][3]); }
        s0 = wave_sum(s0); s1 = wave_sum(s1);
        u32x2* o0 = (u32x2*)(ws + WS_XB + (size_t)row * DM * 2) + lane; u32x2* o1 = (u32x2*)(ws + WS_XB + (size_t)row1 * DM * 2) + lane;
#pragma unroll
        for (int j = 0; j < 4; ++j) { u32x2 w; w.x = pk_bf16(v0[j][0], v0[j][1]); w.y = pk_bf16(v0[j][2], v0[j][3]); o0[64 * j] = w; }
#pragma unroll
        for (int j = 0; j < 4; ++j) { u32x2 w; w.x = pk_bf16(v1[j][0], v1[j][1]); w.y = pk_bf16(v1[j][2], v1[j][3]); o1[64 * j] = w; }
        if (lane == 0) { ((float*)(ws + WS_RSTD1))[row] = __builtin_amdgcn_rsqf(s0 * (1.f / 1024.f) + EPS); ((float*)(ws + WS_RSTD1))[row1] = __builtin_amdgcn_rsqf(s1 * (1.f / 1024.f) + EPS); }
    }
    if (vb == 0) { const float l0 = a.in[4][tid], l1 = a.in[4][512 + tid]; ((float*)(ws + WS_LB))[tid] = 1.f / (1.f + __expf(l1 - l0)); }
}

constexpr int ATT_KS = 272, ATT_VS = 392, ATT_VOFF = 192 * ATT_KS;
DI void attn_unit(const bf16_t* pa, const bf16_t* avT, const float* sinks, bf16_t* ya, LAS unsigned char* lds, int b, int tt) {
    int tid_ = threadIdx.x; asm volatile("" : "+v"(tid_));
    const int tid = tid_, lane = tid & 63, h = __builtin_amdgcn_readfirstlane(tid >> 6), r = lane & 31, hh = lane >> 5, kvh = h >> 2;
    const int p0 = tt * 64 - 128;
    {
        u32x4 kw[6], vw[6];
#pragma unroll
        for (int i = 0; i < 6; ++i) { const int c = tid + i * NTHR, row = c >> 4, ch = c & 15, pos = p0 + row, posc = pos < 0 ? 0 : pos;
            kw[i] = *(const u32x4*)(pa + ((size_t)b * SEQ + posc) * 768 + 512 + ch * 8); }
#pragma unroll
        for (int i = 0; i < 6; ++i) { const int c = tid + i * NTHR, row = c / 24, ch = c - row * 24, pos = p0 + ch * 8, posc = pos < 0 ? 0 : pos;
            vw[i] = *(const u32x4*)(avT + (size_t)(b * 128 + row) * SEQ + posc); }
#pragma unroll
        for (int i = 0; i < 6; ++i) { const int c = tid + i * NTHR, row = c >> 4, ch = c & 15; u32x4 w = kw[i]; if (p0 + row < 0) w = (u32x4){0u, 0u, 0u, 0u};
            *(LAS u32x4*)(lds + row * ATT_KS + ch * 16) = w; }
#pragma unroll
        for (int i = 0; i < 6; ++i) { const int c = tid + i * NTHR, row = c / 24, ch = c - row * 24; u32x4 w = vw[i]; if (p0 + ch * 8 < 0) w = (u32x4){0u, 0u, 0u, 0u};
            LAS u32x2* d = (LAS u32x2*)(lds + ATT_VOFF + row * ATT_VS + ch * 16); d[0] = (u32x2){w.x, w.y}; d[1] = (u32x2){w.z, w.w}; }
    }
    __syncthreads();
    constexpr float LOG2E = 1.4426950408889634f;
    const float slope2 = exp2f(-(float)(h + 1)) * LOG2E, sink2 = sinks[h] * LOG2E, qs = 0.125f * LOG2E;
#pragma unroll 1
    for (int qbl = 0; qbl < 2; ++qbl) {
        const int qb = tt * 2 + qbl; const size_t trow = (size_t)b * SEQ + qb * 32 + r;
        bf16x8 qf[4];
        { const bf16_t* qp = pa + trow * 768 + h * 64 + 8 * hh;
#pragma unroll
          for (int s = 0; s < 4; ++s) qf[s] = *(const bf16x8*)(qp + 16 * s); }
        f32x16 S[5]; float m = sink2;
#pragma unroll
        for (int i = 0; i < 5; ++i) { const int kb = qb - 4 + i;
            if (kb >= 0) {
#pragma unroll
                for (int q = 0; q < 16; ++q) S[i][q] = 0.f;
                const LAS unsigned char* kp = lds + (32 * (qbl + i) + r) * ATT_KS + kvh * 128 + 16 * hh;
#pragma unroll
                for (int s = 0; s < 4; ++s) S[i] = MFMA32(*(const LAS bf16x8*)(kp + 32 * s), qf[s], S[i]);
#pragma unroll
                for (int q = 0; q < 16; ++q) { const int dist = 32 * (4 - i) + r - crow(q, hh); float v = S[i][q] * qs - slope2 * (float)dist;
                    if (i == 0) v = (dist <= 127) ? v : -1e30f;
                    if (i == 4) v = (dist >= 0) ? v : -1e30f;
                    S[i][q] = v; m = fmaxf(m, v); }
            } }
        m = fmaxf(m, __shfl_xor(m, 32));
        float l = 0.f;
#pragma unroll
        for (int i = 0; i < 5; ++i) if (qb - 4 + i >= 0) {
#pragma unroll
            for (int q = 0; q < 16; ++q) { const float p = __builtin_amdgcn_exp2f(S[i][q] - m); S[i][q] = p; l += p; } }
        l += __shfl_xor(l, 32); l += __builtin_amdgcn_exp2f(sink2 - m);
        f32x16 O[2];
#pragma unroll
        for (int q = 0; q < 16; ++q) { O[0][q] = 0.f; O[1][q] = 0.f; }
#pragma unroll
        for (int i = 0; i < 5; ++i) { const int kb = qb - 4 + i;
            if (kb >= 0) {
#pragma unroll
                for (int s2 = 0; s2 < 2; ++s2) {
                    u32x4 pb; pb.x = pk_bf16(S[i][8 * s2], S[i][8 * s2 + 1]); pb.y = pk_bf16(S[i][8 * s2 + 2], S[i][8 * s2 + 3]); pb.z = pk_bf16(S[i][8 * s2 + 4], S[i][8 * s2 + 5]); pb.w = pk_bf16(S[i][8 * s2 + 6], S[i][8 * s2 + 7]);
#pragma unroll
                    for (int dt = 0; dt < 2; ++dt) { const LAS unsigned char* vp = lds + ATT_VOFF + (kvh * 64 + 32 * dt + r) * ATT_VS + (32 * (qbl + i) + 16 * s2 + 4 * hh) * 2;
                        const u32x2 v0 = *(const LAS u32x2*)vp, v1 = *(const LAS u32x2*)(vp + 16); u32x4 av; av.x = v0.x; av.y = v0.y; av.z = v1.x; av.w = v1.y;
                        O[dt] = MFMA32(__builtin_bit_cast(bf16x8, av), __builtin_bit_cast(bf16x8, pb), O[dt]); }
                    asm volatile("" ::: "memory");
                } } }
        const float inv = 1.f / l;
#pragma unroll
        for (int dt = 0; dt < 2; ++dt)
#pragma unroll
            for (int g = 0; g < 4; ++g) { u32x2 w; w.x = pk_bf16(O[dt][4 * g] * inv, O[dt][4 * g + 1] * inv); w.y = pk_bf16(O[dt][4 * g + 2] * inv, O[dt][4 * g + 3] * inv);
                *(u32x2*)(ya + trow * 512 + h * 64 + 32 * dt + 8 * g + 4 * hh) = w; }
    }
    __syncthreads();
}

DI void hgrn_prep_unit(bf16_t* qd, bf16_t* kinv, LAS unsigned char* kl, float* dec, const float* lb, int bh, int c, int dk2) {
    const int b = bh >> 2, h = bh & 3;
    bf16_t* qp = qd + ((size_t)b * SEQ + c * 64) * 512 + h * 128 + dk2; bf16_t* kp = kinv + ((size_t)b * SEQ + c * 64) * 512 + h * 128 + dk2;
    const float lb0 = lb[h * 128 + dk2], lb1 = lb[h * 128 + dk2 + 1], om0 = 1.f - lb0, om1 = 1.f - lb1;
    unsigned qw[64], kv[64];
#pragma unroll
    for (int s = 0; s < 64; ++s) { qw[s] = *(const unsigned*)(qp + (size_t)s * 512); kv[s] = *(const unsigned*)(kp + (size_t)s * 512); }
    float b0 = 0.f, b1 = 0.f;
#pragma unroll
    for (int s = 0; s < 64; ++s) {
        const float f0 = lb0 + om0 * sigm(bflo(kv[s])), f1 = lb1 + om1 * sigm(bfhi(kv[s]));
        b0 += __logf(f0); b1 += __logf(f1);
        const float e0 = __expf(b0), e1 = __expf(b1), i0 = __builtin_amdgcn_rcpf(e0), i1 = __builtin_amdgcn_rcpf(e1);
        const float q0 = bflo(qw[s]), q1 = bfhi(qw[s]);
        *(unsigned*)(qp + (size_t)s * 512) = pk_bf16(q0 * sigm(q0) * e0, q1 * sigm(q1) * e1);
        kv[s] = pk_bf16((1.f - f0) * i0, (1.f - f1) * i1);
        *(unsigned*)(kp + (size_t)s * 512) = kv[s];
    }
    const float d0 = __expf(b0), d1 = __expf(b1);
    *(f32x2*)(dec + (size_t)(bh * 64 + c) * 128 + dk2) = (f32x2){d0, d1};
    LAS unsigned char* r0 = kl + dk2 * 144; LAS unsigned char* r1 = r0 + 144;
#pragma unroll
    for (int s0 = 0; s0 < 64; s0 += 8) { u32x4 w0, w1;
#pragma unroll
        for (int i = 0; i < 4; ++i) { const unsigned ka = kv[s0 + 2 * i], kb = kv[s0 + 2 * i + 1];
            w0[i] = pk_bf16(bflo(ka) * d0, bflo(kb) * d0); w1[i] = pk_bf16(bfhi(ka) * d1, bfhi(kb) * d1); }
        *(LAS u32x4*)(r0 + s0 * 2) = w0; *(LAS u32x4*)(r1 + s0 * 2) = w1; }
}
DI void hgrn_ds_unit(const LAS unsigned char* kl, const bf16_t* vT, bf16_t* dsT, int bh, int c) {
    int tid_ = threadIdx.x; asm volatile("" : "+v"(tid_));
    const int lane = tid_ & 63, wave = tid_ >> 6, r = lane & 31, hh = lane >> 5, i = wave >> 1, j0 = 2 * (wave & 1);
    const LAS unsigned char* ka = kl + (32 * i + r) * 144 + 16 * hh;
    const bf16_t* vb0 = vT + (size_t)(bh * 128 + 32 * j0 + r) * SEQ + c * 64 + 8 * hh; const bf16_t* vb1 = vb0 + (size_t)32 * SEQ;
    f32x16 D0, D1;
#pragma unroll
    for (int q = 0; q < 16; ++q) { D0[q] = 0.f; D1[q] = 0.f; }
#pragma unroll
    for (int ks = 0; ks < 4; ++ks) { const bf16x8 a = *(const LAS bf16x8*)(ka + 32 * ks), b0 = *(const bf16x8*)(vb0 + 16 * ks), b1 = *(const bf16x8*)(vb1 + 16 * ks); D0 = MFMA32(a, b0, D0); D1 = MFMA32(a, b1, D1); }
    const int unit = bh * 64 + c;
    bf16_t* o0 = dsT + (size_t)(unit * 128 + 32 * j0 + r) * 128 + 32 * i + 4 * hh; bf16_t* o1 = o0 + 32 * 128;
#pragma unroll
    for (int g = 0; g < 4; ++g) { u32x2 w; w.x = pk_bf16(D0[4 * g], D0[4 * g + 1]); w.y = pk_bf16(D0[4 * g + 2], D0[4 * g + 3]); *(u32x2*)(o0 + 8 * g) = w;
        u32x2 z; z.x = pk_bf16(D1[4 * g], D1[4 * g + 1]); z.y = pk_bf16(D1[4 * g + 2], D1[4 * g + 3]); *(u32x2*)(o1 + 8 * g) = z; }
}
DI void hgrn_ds_group(const LAS unsigned char* kl0, const bf16_t* vT, bf16_t* dsT, int u0) {
    int tid_ = threadIdx.x; asm volatile("" : "+v"(tid_));
    const int lane = tid_ & 63, wave = tid_ >> 6, r = lane & 31, hh = lane >> 5, i = wave >> 1, j0 = 2 * (wave & 1);
    bf16x8 bn[8];
#define DS_LD(u_) do { const int bh_ = (u_) >> 6, c_ = (u_) & 63; const bf16_t* v0_ = vT + (size_t)(bh_ * 128 + 32 * j0 + r) * SEQ + c_ * 64 + 8 * hh; const bf16_t* v1_ = v0_ + (size_t)32 * SEQ; \
        _Pragma("unroll") for (int ks = 0; ks < 4; ++ks) { bn[2 * ks] = *(const bf16x8*)(v0_ + 16 * ks); bn[2 * ks + 1] = *(const bf16x8*)(v1_ + 16 * ks); } } while (0)
    DS_LD(u0);
#pragma unroll 1
    for (int j = 0; j < 8; ++j) {
        const int unit = u0 + j;
        bf16x8 b[8];
#pragma unroll
        for (int k = 0; k < 8; ++k) b[k] = bn[k];
        { const int un = j + 1 < 8 ? unit + 1 : unit; DS_LD(un); }
        const LAS unsigned char* ka = kl0 + j * 18432 + (32 * i + r) * 144 + 16 * hh;
        f32x16 D0, D1;
#pragma unroll
        for (int q = 0; q < 16; ++q) { D0[q] = 0.f; D1[q] = 0.f; }
#pragma unroll
        for (int ks = 0; ks < 4; ++ks) { const bf16x8 a = *(const LAS bf16x8*)(ka + 32 * ks); D0 = MFMA32(a, b[2 * ks], D0); D1 = MFMA32(a, b[2 * ks + 1], D1); }
        bf16_t* o0 = dsT + (size_t)(unit * 128 + 32 * j0 + r) * 128 + 32 * i + 4 * hh; bf16_t* o1 = o0 + 32 * 128;
#pragma unroll
        for (int g = 0; g < 4; ++g) { u32x2 w; w.x = pk_bf16(D0[4 * g], D0[4 * g + 1]); w.y = pk_bf16(D0[4 * g + 2], D0[4 * g + 3]); *(u32x2*)(o0 + 8 * g) = w;
            u32x2 z; z.x = pk_bf16(D1[4 * g], D1[4 * g + 1]); z.y = pk_bf16(D1[4 * g + 2], D1[4 * g + 3]); *(u32x2*)(o1 + 8 * g) = z; }
    }
#undef DS_LD
}
DI void hgrn_scan(bf16_t* dsT, const float* dec, int vb, int G) {
    for (int idx = vb * NTHR + threadIdx.x; idx < 64 * 128 * 16; idx += G * NTHR) {
        const int dk8 = idx & 15, dv = (idx >> 4) & 127, bh = idx >> 11;
        float S[8];
#pragma unroll
        for (int q = 0; q < 8; ++q) S[q] = 0.f;
        for (int c0 = 0; c0 < 64; c0 += 8) {
            u32x4 ld[8]; f32x4 d0[8], d1[8];
#pragma unroll
            for (int i = 0; i < 8; ++i) { const int c = c0 + i; ld[i] = *(const u32x4*)(dsT + (size_t)((bh * 64 + c) * 128 + dv) * 128 + dk8 * 8);
                const float* dp = dec + (size_t)(bh * 64 + c) * 128 + dk8 * 8; d0[i] = *(const f32x4*)dp; d1[i] = *(const f32x4*)(dp + 4); }
#pragma unroll
            for (int i = 0; i < 8; ++i) { const int c = c0 + i;
                u32x4 w; w.x = pk_bf16(S[0], S[1]); w.y = pk_bf16(S[2], S[3]); w.z = pk_bf16(S[4], S[5]); w.w = pk_bf16(S[6], S[7]);
                *(u32x4*)(dsT + (size_t)((bh * 64 + c) * 128 + dv) * 128 + dk8 * 8) = w;
                S[0] = d0[i][0] * S[0] + bflo(ld[i].x); S[1] = d0[i][1] * S[1] + bfhi(ld[i].x); S[2] = d0[i][2] * S[2] + bflo(ld[i].y); S[3] = d0[i][3] * S[3] + bfhi(ld[i].y);
                S[4] = d1[i][0] * S[4] + bflo(ld[i].z); S[5] = d1[i][1] * S[5] + bfhi(ld[i].z); S[6] = d1[i][2] * S[6] + bflo(ld[i].w); S[7] = d1[i][3] * S[7] + bfhi(ld[i].w); }
        }
    }
}
constexpr int HO_Q = 0, HO_K = 64 * 272, HO_S = 2 * 64 * 272, HO_V = HO_S + 128 * 272, HO_Z = HO_V + 128 * 144;
struct HoPre { u32x4 c[10]; u32x4 g0, g1; };
DI void ho_fetch(HoPre& p, const bf16_t* qd, const bf16_t* kinv, const bf16_t* vT, const bf16_t* spT, const bf16_t* gs, int u, int tid) {
    const int bh = u >> 6, c = u & 63, b = bh >> 2, h = bh & 3; const size_t Tb = (size_t)b * SEQ + c * 64;
#pragma unroll
    for (int k = 0; k < 2; ++k) { const int i = tid + NTHR * k, row = i >> 4, ch = i & 15; p.c[k] = *(const u32x4*)(qd + (Tb + row) * 512 + h * 128 + ch * 8); p.c[2 + k] = *(const u32x4*)(kinv + (Tb + row) * 512 + h * 128 + ch * 8); }
#pragma unroll
    for (int k = 0; k < 4; ++k) { const int i = tid + NTHR * k, row = i >> 4, ch = i & 15; p.c[4 + k] = *(const u32x4*)(spT + (size_t)((bh * 64 + c) * 128 + row) * 128 + ch * 8); }
#pragma unroll
    for (int k = 0; k < 2; ++k) { const int i = tid + NTHR * k, row = i >> 3, ch = i & 7; p.c[8 + k] = *(const u32x4*)(vT + (size_t)(bh * 128 + row) * SEQ + c * 64 + ch * 8); }
    { const int tok = tid >> 3, d16 = (tid & 7) * 16; const size_t off = (Tb + tok) * 512 + h * 128 + d16; p.g0 = *(const u32x4*)(gs + off); p.g1 = *(const u32x4*)(gs + off + 8); }
}
DI void ho_put(const HoPre& p, LAS unsigned char* lds, int tid) {
#pragma unroll
    for (int k = 0; k < 2; ++k) { const int i = tid + NTHR * k, row = i >> 4, ch = i & 15; *(LAS u32x4*)(lds + HO_Q + row * 272 + ch * 16) = p.c[k]; *(LAS u32x4*)(lds + HO_K + row * 272 + ch * 16) = p.c[2 + k]; }
#pragma unroll
    for (int k = 0; k < 4; ++k) { const int i = tid + NTHR * k, row = i >> 4, ch = i & 15; *(LAS u32x4*)(lds + HO_S + row * 272 + ch * 16) = p.c[4 + k]; }
#pragma unroll
    for (int k = 0; k < 2; ++k) { const int i = tid + NTHR * k, row = i >> 3, ch = i & 7; *(LAS u32x4*)(lds + HO_V + row * 144 + ch * 16) = p.c[8 + k]; }
}
DI void hgrn_out_phase(const bf16_t* qd, const bf16_t* kinv, const bf16_t* vT, const bf16_t* spT, const bf16_t* gs, bf16_t* yh, LAS unsigned char* lds, int first, int stride, int end) {
    int tid_ = threadIdx.x; asm volatile("" : "+v"(tid_));
    const int tid = tid_, lane = tid & 63, wave = __builtin_amdgcn_readfirstlane(tid >> 6), r = lane & 31, hh = lane >> 5, tb = wave >> 2, db = wave & 3;
    LAS float* zs = (LAS float*)(lds + HO_Z);
    HoPre pre;
    if (first < end) ho_fetch(pre, qd, kinv, vT, spT, gs, first, tid);
    for (int u = first; u < end; u += stride) {
        const int bh = u >> 6, c = u & 63, b = bh >> 2, h = bh & 3; const size_t Tb = (size_t)b * SEQ + c * 64;
        ho_put(pre, lds, tid);
        const u32x4 g0 = pre.g0, g1 = pre.g1;
        __syncthreads();
        { const int un = (u + stride < end) ? u + stride : u; ho_fetch(pre, qd, kinv, vT, spT, gs, un, tid); }
        f32x16 Z;
#pragma unroll
        for (int q = 0; q < 16; ++q) Z[q] = 0.f;
        const LAS unsigned char* qb_ = lds + HO_Q + (32 * tb + r) * 272 + 16 * hh;
        bf16x8 qf[8];
#pragma unroll
        for (int ks = 0; ks < 8; ++ks) qf[ks] = *(const LAS bf16x8*)(qb_ + 32 * ks);
        { const LAS unsigned char* sb_ = lds + HO_S + (32 * db + r) * 272 + 16 * hh;
#pragma unroll
          for (int ks = 0; ks < 8; ++ks) Z = MFMA32(qf[ks], *(const LAS bf16x8*)(sb_ + 32 * ks), Z); }
#pragma unroll
        for (int sb = 0; sb < 2; ++sb) if (sb <= tb) {
            f32x16 X;
#pragma unroll
            for (int q = 0; q < 16; ++q) X[q] = 0.f;
            const LAS unsigned char* kb_ = lds + HO_K + (32 * sb + r) * 272 + 16 * hh;
#pragma unroll
            for (int ks = 0; ks < 8; ++ks) X = MFMA32(*(const LAS bf16x8*)(kb_ + 32 * ks), qf[ks], X);
            if (sb == tb) {
#pragma unroll
                for (int q = 0; q < 16; ++q) if (crow(q, hh) > r) X[q] = 0.f;
            }
#pragma unroll
            for (int s2 = 0; s2 < 2; ++s2) {
                u32x4 pa_; pa_.x = pk_bf16(X[8 * s2], X[8 * s2 + 1]); pa_.y = pk_bf16(X[8 * s2 + 2], X[8 * s2 + 3]); pa_.z = pk_bf16(X[8 * s2 + 4], X[8 * s2 + 5]); pa_.w = pk_bf16(X[8 * s2 + 6], X[8 * s2 + 7]);
                const LAS unsigned char* vp = lds + HO_V + (32 * db + r) * 144 + (32 * sb + 16 * s2 + 4 * hh) * 2;
                const u32x2 v0 = *(const LAS u32x2*)vp, v1 = *(const LAS u32x2*)(vp + 16);
                u32x4 pb_; pb_.x = v0.x; pb_.y = v0.y; pb_.z = v1.x; pb_.w = v1.y;
                Z = MFMA32(__builtin_bit_cast(bf16x8, pa_), __builtin_bit_cast(bf16x8, pb_), Z);
            }
        }
#pragma unroll
        for (int q = 0; q < 16; ++q) zs[(32 * tb + crow(q, hh)) * 132 + 32 * db + r] = Z[q];
        __syncthreads();
        { const int tok = tid >> 3, d16 = (tid & 7) * 16; f32x4 o[4]; float ss = 0.f;
          const size_t off = (Tb + tok) * 512 + h * 128 + d16;
#pragma unroll
          for (int i = 0; i < 4; ++i) { o[i] = *(const LAS f32x4*)(zs + tok * 132 + d16 + 4 * i); ss += (o[i][0] * o[i][0] + o[i][1] * o[i][1]) + (o[i][2] * o[i][2] + o[i][3] * o[i][3]); }
          ss += __shfl_xor(ss, 1); ss += __shfl_xor(ss, 2); ss += __shfl_xor(ss, 4);
          const float rn = __builtin_amdgcn_rsqf(ss * (1.f / 128.f) + EPS);
          u32x4 w0, w1;
          w0.x = pk_bf16(o[0][0] * rn * bflo(g0.x), o[0][1] * rn * bfhi(g0.x)); w0.y = pk_bf16(o[0][2] * rn * bflo(g0.y), o[0][3] * rn * bfhi(g0.y));
          w0.z = pk_bf16(o[1][0] * rn * bflo(g0.z), o[1][1] * rn * bfhi(g0.z)); w0.w = pk_bf16(o[1][2] * rn * bflo(g0.w), o[1][3] * rn * bfhi(g0.w));
          w1.x = pk_bf16(o[2][0] * rn * bflo(g1.x), o[2][1] * rn * bfhi(g1.x)); w1.y = pk_bf16(o[2][2] * rn * bflo(g1.y), o[2][3] * rn * bfhi(g1.y));
          w1.z = pk_bf16(o[3][0] * rn * bflo(g1.z), o[3][1] * rn * bfhi(g1.z)); w1.w = pk_bf16(o[3][2] * rn * bflo(g1.w), o[3][3] * rn * bfhi(g1.w));
          *(u32x4*)(yh + off) = w0; *(u32x4*)(yh + off + 8) = w1; }
    }
    __syncthreads();
}

DI unsigned f2ord(float f) { const unsigned b = __float_as_uint(f); return b ^ ((unsigned)((int)b >> 31) | 0x80000000u); }
DI float ord2f(unsigned k) { const unsigned b = (k & 0x80000000u) ? (k ^ 0x80000000u) : ~k; return __uint_as_float(b); }
DI void ce_desc(unsigned& a, unsigned& b) { const unsigned hi = a > b ? a : b, lo = a > b ? b : a; a = hi; b = lo; }
DI void sort16_desc(unsigned (&a)[16]) {
    constexpr int NI[63] = {0, 2, 0, 1, 1, 4, 6, 4, 5, 5, 0, 2, 2, 1, 3, 3, 1, 3, 5, 8, 10, 8, 9, 9, 12, 14, 12, 13, 13, 8, 10, 10, 9, 11, 11, 9, 11, 13, 0, 4, 4, 2, 6, 6, 2, 6, 10, 1, 5, 5, 3, 7, 7, 3, 7, 11, 1, 3, 5, 7, 9, 11, 13};
    constexpr int NJ[63] = {1, 3, 2, 3, 2, 5, 7, 6, 7, 6, 4, 6, 4, 5, 7, 5, 2, 4, 6, 9, 11, 10, 11, 10, 13, 15, 14, 15, 14, 12, 14, 12, 13, 15, 13, 10, 12, 14, 8, 12, 8, 10, 14, 10, 4, 8, 12, 9, 13, 9, 11, 15, 11, 5, 9, 13, 2, 4, 6, 8, 10, 12, 14};
#pragma unroll
    for (int c = 0; c < 63; ++c) ce_desc(a[NI[c]], a[NJ[c]]);
}
DI void merge16_desc(unsigned (&a)[16], const unsigned (&b)[16]) {
#pragma unroll
    for (int i = 0; i < 16; ++i) a[i] = a[i] > b[15 - i] ? a[i] : b[15 - i];
#pragma unroll
    for (int j = 8; j > 0; j >>= 1)
#pragma unroll
        for (int i = 0; i < 16; ++i) { const int l = i ^ j; if (l > i) ce_desc(a[i], a[l]); }
}
#define TK_INS(L, x) do { unsigned t_ = (x); _Pragma("unroll") for (int j_ = 0; j_ < 16; ++j_) { const unsigned hi_ = L[j_] > t_ ? L[j_] : t_; t_ = L[j_] > t_ ? t_ : L[j_]; L[j_] = hi_; } } while (0)

DI void topk_stage_keys(const bf16_t* keysb, LAS unsigned char* kl, int h) {
    u32x4 kw[8];
#pragma unroll
    for (int i = 0; i < 8; ++i) { const int c = threadIdx.x + i * NTHR, p = c >> 11, row = (c >> 4) & 127, ch = c & 15; kw[i] = *(const u32x4*)(keysb + ((size_t)(p * 8 + h) * 128 + row) * 128 + ch * 8); }
#pragma unroll
    for (int i = 0; i < 8; ++i) { const int c = threadIdx.x + i * NTHR, p = c >> 11, row = (c >> 4) & 127, ch = c & 15; *(LAS u32x4*)(kl + (p * 128 + row) * 272 + ch * 16) = kw[i]; }
}
DI void topk_unit(const bf16_t* qp, const LAS unsigned char* kl, unsigned short* gidx, float* ggate, LAS unsigned* tk, int quad, int h) {
    const int tid = threadIdx.x, lane = tid & 63, wave = tid >> 6, p = wave & 1, tsub = wave >> 1, r = lane & 31, hh = lane >> 5;
    bf16x8 bqv[8];
    { const bf16_t* q0 = qp + (size_t)((quad * 4) * 128 + tsub * 32 + r) * 2048 + h * 256 + p * 128 + 8 * hh;
#pragma unroll
      for (int s_ = 0; s_ < 8; ++s_) bqv[s_] = *(const bf16x8*)(q0 + 16 * s_); }
#pragma unroll 1
    for (int hl = 0; hl < 4; ++hl) {
        const int tok0 = (quad * 4 + hl) * 128 + tsub * 32;
        f32x16 acc[4];
#pragma unroll
        for (int kb = 0; kb < 4; ++kb)
#pragma unroll
            for (int i = 0; i < 16; ++i) acc[kb][i] = 16.f;
#ifdef T_MPRIO
        __builtin_amdgcn_s_setprio(T_MPRIO);
#endif
        const bf16_t* qrow = qp + (size_t)(tok0 + r) * 2048 + h * 256 + p * 128 + 8 * hh;
        const LAS unsigned char* kbase = kl + (p * 128 + r) * 272 + 16 * hh;
#pragma unroll
        for (int s = 0; s < 8; ++s) { const bf16x8 bq = bqv[s];
#pragma unroll
            for (int kb = 0; kb < 4; ++kb) { const bf16x8 ak = *(const LAS bf16x8*)(kbase + kb * 32 * 272 + 32 * s); acc[kb] = MFMA32(ak, bq, acc[kb]); } }
        { const int hn = hl + 1 < 4 ? hl + 1 : hl; const bf16_t* qn = qp + (size_t)((quad * 4 + hn) * 128 + tsub * 32 + r) * 2048 + h * 256 + p * 128 + 8 * hh;
#pragma unroll
          for (int s_ = 0; s_ < 8; ++s_) bqv[s_] = *(const bf16x8*)(qn + 16 * s_); }
#ifdef T_MPRIO
        __builtin_amdgcn_s_setprio(0);
#endif
        unsigned A0[16], A1[16], A2[16], A3[16];
#pragma unroll
        for (int i = 0; i < 16; ++i) { const unsigned ki = (unsigned)(crow(i, hh));
            A0[i] = (__float_as_uint(fmaxf(acc[0][i], 0.f)) & ~127u) | ki; A1[i] = (__float_as_uint(fmaxf(acc[1][i], 0.f)) & ~127u) | (32u + ki); A2[i] = (__float_as_uint(fmaxf(acc[2][i], 0.f)) & ~127u) | (64u + ki); A3[i] = (__float_as_uint(fmaxf(acc[3][i], 0.f)) & ~127u) | (96u + ki); }
        sort16_desc(A0); sort16_desc(A1); sort16_desc(A2); sort16_desc(A3);
        merge16_desc(A0, A1); merge16_desc(A2, A3); merge16_desc(A0, A2);
#pragma unroll
        for (int j = 0; j < 16; ++j) A1[j] = __shfl_xor(A0[j], 32);
        merge16_desc(A0, A1);
        if (hh == 0) { LAS u32x4* dst = (LAS u32x4*)(tk + (((hl * 2 + p) * 128 + tsub * 32 + r) * 16));
#pragma unroll
            for (int c = 0; c < 4; ++c) { u32x4 w = {A0[4 * c], A0[4 * c + 1], A0[4 * c + 2], A0[4 * c + 3]}; dst[c] = w; } }
    }
    __syncthreads();
    {
        const int tok = tid & 127, hl = tid >> 7, tile = quad * 4 + hl;
        const LAS unsigned* t1 = tk + ((hl * 2 + 0) * 128 + tok) * 16; const LAS unsigned* t2 = tk + ((hl * 2 + 1) * 128 + tok) * 16;
        float v1[16], v2[16];
        { const LAS u32x4* s1 = (const LAS u32x4*)t1; const LAS u32x4* s2 = (const LAS u32x4*)t2;
#pragma unroll
          for (int c = 0; c < 4; ++c) { const u32x4 a = s1[c], b = s2[c];
              v1[4 * c] = __uint_as_float(a.x & ~127u) - 12.f; v1[4 * c + 1] = __uint_as_float(a.y & ~127u) - 12.f; v1[4 * c + 2] = __uint_as_float(a.z & ~127u) - 12.f; v1[4 * c + 3] = __uint_as_float(a.w & ~127u) - 12.f;
              v2[4 * c] = __uint_as_float(b.x & ~127u) - 12.f; v2[4 * c + 1] = __uint_as_float(b.y & ~127u) - 12.f; v2[4 * c + 2] = __uint_as_float(b.z & ~127u) - 12.f; v2[4 * c + 3] = __uint_as_float(b.w & ~127u) - 12.f; } }
#define CKEY(i, j) ((__float_as_uint(fmaxf(v1[i] + v2[j], 0.f)) & ~255u) | (unsigned)((i) * 16 + (j)))
        unsigned C[16], D[16], E[16];
#pragma unroll
        for (int j = 0; j < 16; ++j) C[j] = CKEY(0, j);
#pragma unroll
        for (int j = 0; j < 8; ++j) D[j] = CKEY(1, j);
#pragma unroll
        for (int j = 0; j < 5; ++j) D[8 + j] = CKEY(2, j);
#pragma unroll
        for (int j = 0; j < 3; ++j) D[13 + j] = CKEY(4, j);
#pragma unroll
        for (int j = 0; j < 4; ++j) E[j] = CKEY(3, j);
        E[4] = CKEY(5, 0); E[5] = CKEY(5, 1); E[6] = CKEY(6, 0); E[7] = CKEY(6, 1); E[8] = CKEY(7, 0); E[9] = CKEY(7, 1);
        E[10] = CKEY(8, 0); E[11] = CKEY(9, 0); E[12] = CKEY(10, 0); E[13] = CKEY(11, 0); E[14] = CKEY(12, 0); E[15] = CKEY(13, 0);
        sort16_desc(D); sort16_desc(E);
        TK_INS(E, CKEY(14, 0)); TK_INS(E, CKEY(15, 0));
#undef CKEY
        merge16_desc(C, D); merge16_desc(C, E);
        float sc[16]; unsigned ei[16]; float mx = -1e30f;
#pragma unroll
        for (int q = 0; q < 16; ++q) { const unsigned ij = C[q] & 255u; const unsigned a = t1[ij >> 4], b = t2[ij & 15u];
            sc[q] = (__uint_as_float(a & ~127u) - 16.f) + (__uint_as_float(b & ~127u) - 16.f); ei[q] = (a & 127u) * 128u + (b & 127u); mx = fmaxf(mx, sc[q]); }
        float sum = 0.f;
#pragma unroll
        for (int q = 0; q < 16; ++q) { sc[q] = __expf(sc[q] - mx); sum += sc[q]; }
        const float inv = 1.f / sum; const size_t o = (size_t)(tile * 128 + tok) * 128 + h * 16;
        u32x4 w0, w1;
        w0.x = ei[0] | (ei[1] << 16); w0.y = ei[2] | (ei[3] << 16); w0.z = ei[4] | (ei[5] << 16); w0.w = ei[6] | (ei[7] << 16);
        w1.x = ei[8] | (ei[9] << 16); w1.y = ei[10] | (ei[11] << 16); w1.z = ei[12] | (ei[13] << 16); w1.w = ei[14] | (ei[15] << 16);
        *(u32x4*)(gidx + o) = w0; *(u32x4*)(gidx + o + 8) = w1;
#pragma unroll
        for (int c = 0; c < 4; ++c) *(f32x4*)(ggate + o + 4 * c) = (f32x4){sc[4 * c] * inv, sc[4 * c + 1] * inv, sc[4 * c + 2] * inv, sc[4 * c + 3] * inv};
    }
    __syncthreads();
}

DI float gelu_erf(float x) { return 0.5f * x * (1.f + erff(x * 0.70710678118654752f)); }
DI void hq_token(const bf16_t* x2row, const float* ssq, unsigned char* hqrow, float* shp, int lane) {
    f32x4 x[4]; float amax = 0.f;
#pragma unroll
    for (int i = 0; i < 4; ++i) { const u32x2 w_ = *(const u32x2*)(x2row + 16 * lane + 4 * i); x[i] = (f32x4){bflo(w_.x), bfhi(w_.x), bflo(w_.y), bfhi(w_.y)}; amax = fmaxf(fmaxf(amax, fmaxf(fabsf(x[i][0]), fabsf(x[i][1]))), fmaxf(fabsf(x[i][2]), fabsf(x[i][3]))); }
    float ss = (lane < 16) ? ssq[lane] : 0.f; ss = wave_sum(ss);
    const float rstd2 = __builtin_amdgcn_rsqf(ss * (1.f / 1024.f) + EPS);
    amax = wave_max(amax);
    amax *= rstd2;
    const float qs = amax > 0.f ? 119.f / amax : 0.f, xq = rstd2 * qs;
    unsigned hh[2] = {0u, 0u}, hl[2] = {0u, 0u};
#pragma unroll
    for (int i = 0; i < 16; ++i) { const int q_ = (int)rintf(x[i >> 2][i & 3] * xq), l_ = ((q_ + 8) & 15) - 8, h_ = (q_ - l_) >> 4;
        hl[i >> 3] |= ((unsigned)l_ & 15u) << (4 * (i & 7)); hh[i >> 3] |= ((unsigned)h_ & 15u) << (4 * (i & 7)); }
    unsigned char* cp = hqrow + (lane >> 1) * 32 + (lane & 1) * 8;
    *(u32x2*)cp = (u32x2){hh[0], hh[1]}; *(u32x2*)(cp + 16) = (u32x2){hl[0], hl[1]};
    if (lane == 0) *shp = amax * (1.f / 119.f);
}
DI void hq_phase(unsigned char* ws, int first, int stride, int end, int lane) {
    if (first >= end) return;
    const bf16_t* x2b = (const bf16_t*)(ws + WS_X2B) + 16 * lane; const float* ssq = (const float*)(ws + WS_SSQ2) + (lane & 15);
    u32x2 wn[4], wm[4]; float sn, sm;
#define HQ_LD(w_, s_, tok) do { _Pragma("unroll") for (int i = 0; i < 4; ++i) w_[i] = *(const u32x2*)(x2b + (size_t)(tok) * DM + 4 * i); s_ = ssq[(size_t)(tok) * 16]; } while (0)
    HQ_LD(wn, sn, first); { const int t1 = first + stride < end ? first + stride : first; HQ_LD(wm, sm, t1); }
    for (int tok = first; tok < end; tok += stride) {
        f32x4 x[4]; float amax = 0.f; float ss = (lane < 16) ? sn : 0.f;
#pragma unroll
        for (int i = 0; i < 4; ++i) { const u32x2 w_ = wn[i]; x[i] = (f32x4){bflo(w_.x), bfhi(w_.x), bflo(w_.y), bfhi(w_.y)}; }
#pragma unroll
        for (int i = 0; i < 4; ++i) wn[i] = wm[i];
        sn = sm;
        { const int tn = tok + 2 * stride < end ? tok + 2 * stride : tok; HQ_LD(wm, sm, tn); }
#pragma unroll
        for (int i = 0; i < 4; ++i) amax = fmaxf(fmaxf(amax, fmaxf(fabsf(x[i][0]), fabsf(x[i][1]))), fmaxf(fabsf(x[i][2]), fabsf(x[i][3])));
        ss = wave_sum(ss);
        const float rstd2 = __builtin_amdgcn_rsqf(ss * (1.f / 1024.f) + EPS);
        amax = wave_max(amax);
        amax *= rstd2;
        const float qs = amax > 0.f ? 119.f / amax : 0.f, xq = rstd2 * qs;
        unsigned hh[2] = {0u, 0u}, hl[2] = {0u, 0u};
#pragma unroll
        for (int i = 0; i < 16; ++i) { const int q_ = (int)rintf(x[i >> 2][i & 3] * xq), l_ = ((q_ + 8) & 15) - 8, h_ = (q_ - l_) >> 4;
            hl[i >> 3] |= ((unsigned)l_ & 15u) << (4 * (i & 7)); hh[i >> 3] |= ((unsigned)h_ & 15u) << (4 * (i & 7)); }
        unsigned char* cp = (unsigned char*)(ws + WS_HQ) + (size_t)tok * 1024 + (lane >> 1) * 32 + (lane & 1) * 8;
        *(u32x2*)cp = (u32x2){hh[0], hh[1]}; *(u32x2*)(cp + 16) = (u32x2){hl[0], hl[1]};
        if (lane == 0) ((float*)(ws + WS_SH))[tok] = amax * (1.f / 119.f);
    }
#undef HQ_LD
}
template <int CTRL> DI int dpp_i(int v) { return __builtin_amdgcn_mov_dpp(v, CTRL, 0xf, 0xf, true); }
template <int CTRL> DI float dpp_f(float v) { return __int_as_float(__builtin_amdgcn_mov_dpp(__float_as_int(v), CTRL, 0xf, 0xf, true)); }
DI float swapadd32(float a, float b) { const auto r = __builtin_amdgcn_permlane32_swap(__float_as_uint(a), __float_as_uint(b), false, false); return __uint_as_float(r[0]) + __uint_as_float(r[1]); }
DI float swapadd16(float a, float b) { const auto r = __builtin_amdgcn_permlane16_swap(__float_as_uint(a), __float_as_uint(b), false, false); return __uint_as_float(r[0]) + __uint_as_float(r[1]); }

struct SMeta { u32x4 i0, i1, a0, a1; unsigned xw; };
template <int RS> DI void slice_issue(u32x4 (&r)[16], const SMeta& m, const unsigned char* base) {
    const unsigned iw[8] = {m.i0.x, m.i0.y, m.i0.z, m.i0.w, m.i1.x, m.i1.y, m.i1.z, m.i1.w};
#pragma unroll
    for (int j = 0; j < 16; ++j) { const unsigned idx = (j & 1) ? (iw[j >> 1] >> 16) : (iw[j >> 1] & 0xffffu); r[j] = *(const u32x4*)(base + (size_t)idx * RS); }
}
DI void slice_u_compute(const SMeta& m, const u32x4 (&r)[16], int* actp, int lane) {
    const int hh[4] = {(int)m.a0.x, (int)m.a0.y, (int)m.a0.z, (int)m.a0.w}, hl[4] = {(int)m.a1.x, (int)m.a1.y, (int)m.a1.z, (int)m.a1.w};
    int part[16];
#ifdef U_PRIO
    __builtin_amdgcn_s_setprio(U_PRIO);
#endif
#pragma unroll
    for (int j = 0; j < 16; ++j) { int ah = 0, al = 0;
#pragma unroll
        for (int g = 0; g < 4; ++g) { ah = __builtin_amdgcn_sdot8((int)r[j][g], hh[g], ah, false); al = __builtin_amdgcn_sdot8((int)r[j][g], hl[g], al, false); }
        part[j] = (ah << 4) + al; }
    int r8[8], r4[4], r2[2];
    { const bool up_ = (lane & 4) != 0;
#pragma unroll
      for (int i = 0; i < 8; ++i) { const int keep = up_ ? part[i + 8] : part[i], send = up_ ? part[i] : part[i + 8]; r8[i] = keep + dpp_i<0x141>(send); } }
    { const bool up_ = (lane & 2) != 0;
#pragma unroll
      for (int i = 0; i < 4; ++i) { const int keep = up_ ? r8[i + 4] : r8[i], send = up_ ? r8[i] : r8[i + 4]; r4[i] = keep + dpp_i<0x4E>(send); } }
    { const bool up_ = (lane & 1) != 0;
#pragma unroll
      for (int i = 0; i < 2; ++i) { const int keep = up_ ? r4[i + 2] : r4[i], send = up_ ? r4[i] : r4[i + 2]; r2[i] = keep + dpp_i<0xB1>(send); } }
#ifdef U_PRIO
    __builtin_amdgcn_s_setprio(0);
#endif
    actp[lane] = (int)((unsigned)(((r2[0] + 4) >> 3) & 0xffff) | ((unsigned)((r2[1] + 4) >> 3) << 16));
}
DI int swapadd32i(int a, int b) { const auto r = __builtin_amdgcn_permlane32_swap((unsigned)a, (unsigned)b, false, false); return (int)r[0] + (int)r[1]; }
DI int swapadd16i(int a, int b) { const auto r = __builtin_amdgcn_permlane16_swap((unsigned)a, (unsigned)b, false, false); return (int)r[0] + (int)r[1]; }
DI void slice_v_compute(const SMeta& m, const u32x4 (&r)[16], float* x3row, float* ssq3p, int sl, int lane) {
    const int wq[4] = {(int)m.a0.x, (int)m.a0.y, (int)m.a0.z, (int)m.a0.w};
    const float sw = __uint_as_float(m.a1.x);
    int o[32];
#pragma unroll
    for (int i = 0; i < 32; ++i) o[i] = 0;
#pragma unroll
    for (int q = 0; q < 4; ++q)
#pragma unroll
        for (int p = 0; p < 4; ++p) {
            const unsigned d0 = r[4 * q][p], d1 = r[4 * q + 1][p], d2 = r[4 * q + 2][p], d3 = r[4 * q + 3][p];
            const unsigned t0 = __builtin_amdgcn_perm(d1, d0, 0x05010400u), t1 = __builtin_amdgcn_perm(d1, d0, 0x07030602u), t2 = __builtin_amdgcn_perm(d3, d2, 0x05010400u), t3 = __builtin_amdgcn_perm(d3, d2, 0x07030602u);
            const unsigned e0 = __builtin_amdgcn_perm(t2, t0, 0x05040100u), e1 = __builtin_amdgcn_perm(t2, t0, 0x07060302u), e2 = __builtin_amdgcn_perm(t3, t1, 0x05040100u), e3 = __builtin_amdgcn_perm(t3, t1, 0x07060302u);
            o[8 * p + 0] = __builtin_amdgcn_sdot4((int)(e0 & 0x0F0F0F0Fu), wq[q], o[8 * p + 0], false); o[8 * p + 1] = __builtin_amdgcn_sdot4((int)e0, wq[q], o[8 * p + 1], false);
            o[8 * p + 2] = __builtin_amdgcn_sdot4((int)(e1 & 0x0F0F0F0Fu), wq[q], o[8 * p + 2], false); o[8 * p + 3] = __builtin_amdgcn_sdot4((int)e1, wq[q], o[8 * p + 3], false);
            o[8 * p + 4] = __builtin_amdgcn_sdot4((int)(e2 & 0x0F0F0F0Fu), wq[q], o[8 * p + 4], false); o[8 * p + 5] = __builtin_amdgcn_sdot4((int)e2, wq[q], o[8 * p + 5], false);
            o[8 * p + 6] = __builtin_amdgcn_sdot4((int)(e3 & 0x0F0F0F0Fu), wq[q], o[8 * p + 6], false); o[8 * p + 7] = __builtin_amdgcn_sdot4((int)e3, wq[q], o[8 * p + 7], false);
        }
    int wt = 0;
#pragma unroll
    for (int q = 0; q < 4; ++q) wt = __builtin_amdgcn_sdot4(wq[q], 0x01010101, wt, false);
    wt += dpp_i<0x128>(wt); wt = swapadd16i(wt, wt); wt = swapadd32i(wt, wt); wt *= 8;
    int a16[16], a8[8], a4[4];
#pragma unroll
    for (int i = 0; i < 16; ++i) a16[i] = swapadd32i(o[i], o[16 + i]);
#pragma unroll
    for (int i = 0; i < 8; ++i) a8[i] = swapadd16i(a16[i], a16[i + 8]);
    { const bool up_ = (lane & 8) != 0;
#pragma unroll
      for (int i = 0; i < 4; ++i) { const int keep = up_ ? a8[i + 4] : a8[i], send = up_ ? a8[i] : a8[i + 4]; a4[i] = keep + dpp_i<0x128>(send); } }
    const int col = 32 * (lane & 7) + ((lane >> 5) & 1) * 16 + ((lane >> 4) & 1) * 8 + ((lane >> 3) & 1) * 4;
    const f32x4 y = {bflo(m.xw) + (float)(a4[0] - wt) * sw, bfhi(m.xw) + (float)((a4[1] - a4[0]) >> 4) * sw, bflo(m.a1.y) + (float)(a4[2] - wt) * sw, bfhi(m.a1.y) + (float)((a4[3] - a4[2]) >> 4) * sw};
    *(f32x4*)(x3row + 256 * sl + col) = y;
    const float ss = wave_sum((y[0] * y[0] + y[1] * y[1]) + (y[2] * y[2] + y[3] * y[3]));
    if (lane == 0) ssq3p[sl] = ss;
}
template <int MODE> DI void slice_pass(unsigned char* ws, float* out, int xs, int gw_, int nw_, int lane) {
    const int g = lane >> 3, c = lane & 7;
    const int sl = xs >> 1, tmul = 2, tadd = xs & 1, TT = T / tmul;
    const unsigned short* gidx = (const unsigned short*)(ws + WS_GIDX) + 16 * g;
    const unsigned char* tab = (MODE == 0 ? (const unsigned char*)(ws + WS_U8) : (const unsigned char*)(ws + WS_V8)) + 128 * sl + 16 * c;
    const unsigned char* hqb = (const unsigned char*)(ws + WS_HQ) + 256 * sl + 32 * c;
    const unsigned char* wxb = (const unsigned char*)(ws + WS_WX) + 16 * g;
    const bf16_t* x2b = (const bf16_t*)(ws + WS_X2B) + 256 * sl + 32 * c + ((lane >> 5) & 1) * 16 + ((lane >> 4) & 1) * 8 + ((lane >> 3) & 1) * 4;
#define S_LOAD(m, tok) do { const unsigned short* ip = gidx + (size_t)(tok) * 128; (m).i0 = *(const u32x4*)ip; (m).i1 = *(const u32x4*)(ip + 8); \
        if (MODE == 0) { const unsigned char* hp_ = hqb + (size_t)(tok) * 1024; (m).a0 = *(const u32x4*)hp_; (m).a1 = *(const u32x4*)(hp_ + 16); } \
        else { (m).a0 = *(const u32x4*)(wxb + (size_t)(tok) * 128); (m).a1.x = __float_as_uint(((const float*)(ws + WS_SW))[tok]); { const u32x2 x_ = *(const u32x2*)(x2b + (size_t)(tok) * DM); (m).xw = x_.x; (m).a1.y = x_.y; } } } while (0)
#define S_COMPUTE(m, r, tok) do { if (MODE == 0) slice_u_compute(m, r, (int*)(ws + WS_ACTP) + ((size_t)(tok) * 4 + sl) * 64, lane); \
        else slice_v_compute(m, r, out + (size_t)(tok) * DM, (float*)(ws + WS_SSQ3) + (size_t)(tok) * 4, sl, lane); } while (0)
#define S_ISSUE(r, m) slice_issue<512>(r, m, tab)
    SMeta mA, mB, mN; u32x4 rA[16], rB[16];
    if (gw_ >= TT) return;
    const int n = (TT - gw_ + nw_ - 1) / nw_;
#define S_TK(j) ((gw_ + ((j) < n ? (j) : n - 1) * nw_) * tmul + tadd)
    S_LOAD(mA, S_TK(0)); S_ISSUE(rA, mA); S_LOAD(mB, S_TK(1));
#ifdef S_MPRIO
#define S_MP(x) __builtin_amdgcn_s_setprio(x)
#else
#define S_MP(x)
#endif
    for (int i = 0; i < n; i += 2) {
        S_MP(S_MPRIO); S_ISSUE(rB, mB);
        S_LOAD(mN, S_TK(i + 2)); S_MP(0);
        S_COMPUTE(mA, rA, S_TK(i));
        S_MP(S_MPRIO); mA = mN; S_ISSUE(rA, mA);
        S_LOAD(mN, S_TK(i + 3)); S_MP(0);
        if (i + 1 < n) S_COMPUTE(mB, rB, S_TK(i + 1));
        mB = mN;
    }
#undef S_MP
#undef S_TK
#undef S_LOAD
#undef S_COMPUTE
#undef S_ISSUE
}
typedef int v2i32_t __attribute__((ext_vector_type(2)));
struct VCm { unsigned wd; u32x2 x2; f32x2 sw; };
DI void slice_v2_compute(LAS unsigned char* itr0, LAS unsigned char* itr1, LAS unsigned* wbuf, const VCm& cm, bf16_t* x3row, float* ssq3p, int sl, int lane) {
    int aL[2][2] = {{0, 0}, {0, 0}}, aF[2][2] = {{0, 0}, {0, 0}};
#ifndef VDEPTH
#define VDEPTH 8
#endif
    constexpr int NG = 32 / VDEPTH;
    u32x2 d[2][VDEPTH]; u32x4 w4[2][VDEPTH / 4];
#define V_RD(gi) do { _Pragma("unroll") for (int e = 0; e < VDEPTH / 4; ++e) w4[(gi) & 1][e] = *(const LAS u32x4*)(wbuf + 4 * ((VDEPTH / 4) * (gi) + e)); asm volatile("" ::: "memory"); \
        _Pragma("unroll") for (int e = 0; e < VDEPTH; ++e) d[(gi) & 1][e] = __builtin_bit_cast(u32x2, __builtin_amdgcn_ds_read_tr8_b64_v2i32((LAS v2i32_t*)(((e & 1) ? itr1 : itr0) + 1024 * ((VDEPTH / 2) * (gi) + (e >> 1))))); } while (0)
    V_RD(0);
#pragma unroll
    for (int gi = 0; gi < NG; ++gi) {
        if (gi + 1 < NG) V_RD(gi + 1);
        asm volatile("" ::: "memory");
#ifdef V_PRIO
        if (gi == 0) __builtin_amdgcn_s_setprio(V_PRIO);
#endif
#pragma unroll
        for (int e = 0; e < VDEPTH; ++e) {
            const u32x2 dd = d[gi & 1][e];
            const int wi = 2 * (e >> 1), h = e & 1;
            const int w0 = (int)w4[gi & 1][wi >> 2][wi & 3], w1 = (int)w4[gi & 1][(wi + 1) >> 2][(wi + 1) & 3];
            aL[h][0] = __builtin_amdgcn_sdot4((int)(dd.x & 0x0F0F0F0Fu), w0, aL[h][0], false); aF[h][0] = __builtin_amdgcn_sdot4((int)dd.x, w0, aF[h][0], false);
            aL[h][1] = __builtin_amdgcn_sdot4((int)(dd.y & 0x0F0F0F0Fu), w1, aL[h][1], false); aF[h][1] = __builtin_amdgcn_sdot4((int)dd.y, w1, aF[h][1], false);
        }
    }
#undef V_RD
#ifdef V_PRIO
    __builtin_amdgcn_s_setprio(0);
#endif
#ifdef V_TPRIO
    __builtin_amdgcn_s_setprio(V_TPRIO);
#endif
    const int L0 = aL[0][0] + aL[0][1], F0 = aF[0][0] + aF[0][1], L1 = aL[1][0] + aL[1][1], F1 = aF[1][0] + aF[1][1];
    const float sw = cm.sw[0], wt = cm.sw[1];
    const f32x2 ya = {bflo(cm.x2.x) + ((float)L0 - wt) * sw, bfhi(cm.x2.x) + (float)((F0 - L0) >> 4) * sw}, yb = {bflo(cm.x2.y) + ((float)L1 - wt) * sw, bfhi(cm.x2.y) + (float)((F1 - L1) >> 4) * sw};
#ifdef V_NT_STORE
    __builtin_nontemporal_store(pk_bf16(ya[0], ya[1]), (unsigned*)(x3row + 256 * sl + 2 * lane)); __builtin_nontemporal_store(pk_bf16(yb[0], yb[1]), (unsigned*)(x3row + 256 * sl + 128 + 2 * lane));
#else
    *(unsigned*)(x3row + 256 * sl + 2 * lane) = pk_bf16(ya[0], ya[1]); *(unsigned*)(x3row + 256 * sl + 128 + 2 * lane) = pk_bf16(yb[0], yb[1]);
#endif
    const float ss = wave_sum((ya[0] * ya[0] + ya[1] * ya[1]) + (yb[0] * yb[0] + yb[1] * yb[1]));
    if (lane == 0) ssq3p[sl] = ss;
}
template <int PM> DI void slice_pass_v(unsigned char* ws, bf16_t* out, float* ssq3, LAS unsigned char* lds, int wave, int xs, int gw_, int nw_, int lane) {
    const int g = lane >> 3, c = lane & 7;
    const int sl = xs >> 1, tmul = 2, tadd = xs & 1, TT = T / tmul;
    const unsigned short* gidx = (const unsigned short*)(ws + WS_GIDX) + 16 * g;
    const unsigned char* tab = (const unsigned char*)(ws + WS_V8) + 128 * sl + 16 * c;
    const unsigned* wx32 = (const unsigned*)(ws + WS_WX) + (lane & 31);
    const bf16_t* x2b = (const bf16_t*)(ws + WS_X2B) + 256 * sl + 2 * lane;
    const f32x2* swp = (const f32x2*)(ws + WS_SW);
    LAS unsigned char* img = lds + wave * 16384;
    LAS unsigned char* iw0 = img + g * 2048 + 16 * c, *iw1 = img + g * 2048 + 16 * (c ^ 2), *iw2 = img + g * 2048 + 16 * (c ^ 4), *iw3 = img + g * 2048 + 16 * (c ^ 6);
    const int q = (lane >> 1) & 7, Q = lane >> 4, p = lane & 1;
    LAS unsigned char* itr0 = img + q * 128 + 16 * (Q ^ (q & 6)) + 8 * p;
    LAS unsigned char* itr1 = img + q * 128 + 16 * ((4 + Q) ^ (q & 6)) + 8 * p;
    LAS unsigned* wbuf = (LAS unsigned*)(lds + 131072 + wave * 128);
    if (gw_ >= TT) return;
    const int n = (TT - gw_ + nw_ - 1) / nw_;
#ifndef VREP
#define VREP 1
#endif
    const int nn = n * VREP;
#define V_TK(j) ((gw_ + (((j) < nn ? (j) : nn - 1) % n) * nw_) * tmul + tadd)
#define V_IDX(m, tok) do { const unsigned short* ip = gidx + (size_t)(tok) * 128; (m).i0 = *(const u32x4*)ip; (m).i1 = *(const u32x4*)(ip + 8); } while (0)
#define V_CM(cm, tok) do { (cm).wd = wx32[(size_t)(tok) * 32]; (cm).x2.x = *(const unsigned*)(x2b + (size_t)(tok) * DM); (cm).x2.y = *(const unsigned*)(x2b + (size_t)(tok) * DM + 128); (cm).sw = swp[tok]; } while (0)
#define V_STAGE(r, cm) do { if (PM != 1) { _Pragma("unroll") for (int j = 0; j < 16; ++j) *(LAS u32x4*)((((j >> 1) & 3) == 0 ? iw0 : ((j >> 1) & 3) == 1 ? iw1 : ((j >> 1) & 3) == 2 ? iw2 : iw3) + 128 * j) = r[j]; } wbuf[lane & 31] = (cm).wd; asm volatile("" ::: "memory"); } while (0)
#define V_COMPUTE(cm, tok) do { if (PM != 2) slice_v2_compute(itr0, itr1, wbuf, cm, out + (size_t)(tok) * DM, ssq3 + (size_t)(tok) * 4, sl, lane); asm volatile("" ::: "memory"); } while (0)
#define V_ISS(r, m) do { if (PM != 1) slice_issue<512>(r, m, tab); } while (0)
    SMeta mE, mO; VCm cE, cO; u32x4 rE[16], rO[16];
#ifdef V_STAGGER
    if (wave >= 4) { _Pragma("unroll") for (int z = 0; z < V_STAGGER; ++z) __builtin_amdgcn_s_sleep(16); }
#endif
    V_IDX(mE, V_TK(0)); V_IDX(mO, V_TK(1));
    asm volatile("" ::: "memory");
    V_ISS(rE, mE); V_IDX(mE, V_TK(2)); V_CM(cE, V_TK(0));
    asm volatile("" ::: "memory");
    V_ISS(rO, mO); V_IDX(mO, V_TK(3)); V_CM(cO, V_TK(1));
    asm volatile("" ::: "memory");
#ifdef V_MPRIO
#define V_MP(x) __builtin_amdgcn_s_setprio(x)
#else
#define V_MP(x)
#endif
    for (int i = 0; i < nn; i += 2) {
        V_MP(V_MPRIO); V_STAGE(rE, cE);
        V_ISS(rE, mE); V_IDX(mE, V_TK(i + 4)); V_MP(0);
        V_COMPUTE(cE, V_TK(i));
        V_CM(cE, V_TK(i + 2));
        V_MP(V_MPRIO); V_STAGE(rO, cO);
        V_ISS(rO, mO); V_IDX(mO, V_TK(i + 5)); V_MP(0);
        if (i + 1 < nn) V_COMPUTE(cO, V_TK(i + 1));
        V_CM(cO, V_TK(i + 3));
    }
#undef V_MP
#undef V_TK
#undef V_ISS
#undef V_IDX
#undef V_CM
#undef V_STAGE
#undef V_COMPUTE
}
#define X_ITEM(j, tok_, sl_) const int jj_ = (j) < n ? (j) : n - 1; const int sx_ = (jj_ >= npw ? 1 : 0) + (jj_ >= 2 * npw ? 1 : 0) + (jj_ >= 3 * npw ? 1 : 0); \
        const int tok_ = tbase + (gw_ + (jj_ - sx_ * npw) * nw_) * tmul + tadd; const int sl_ = sl0 + sx_
DI void slice_pass_u4(unsigned char* ws, int sl0, int nsl, int tbase, int tmul, int tadd, int TT, int gw_, int nw_, int lane) {
    const int g = lane >> 3, c = lane & 7;
    const unsigned short* gidx = (const unsigned short*)(ws + WS_GIDX) + 16 * g;
    const unsigned char* tab0 = (const unsigned char*)(ws + WS_U8) + 16 * c;
    const unsigned char* hqb0 = (const unsigned char*)(ws + WS_HQ) + 32 * c;
    if (gw_ >= TT) return;
    const int npw = (TT - gw_ + nw_ - 1) / nw_, n = npw * nsl;
#define U_LOAD(m, tk, sv, j) do { X_ITEM(j, tok_, sl_); tk = tok_; sv = sl_; const unsigned short* ip = gidx + (size_t)tok_ * 128; (m).i0 = *(const u32x4*)ip; (m).i1 = *(const u32x4*)(ip + 8); \
        const unsigned char* hp_ = hqb0 + (size_t)tok_ * 1024 + 256 * sl_; (m).a0 = *(const u32x4*)hp_; (m).a1 = *(const u32x4*)(hp_ + 16); } while (0)
#define U_ISSUE(r, m, sv) slice_issue<512>(r, m, tab0 + 128 * (sv))
#define U_COMPUTE(m, r, tk, sv) slice_u_compute(m, r, (int*)(ws + WS_ACTP) + ((size_t)(tk) * 4 + (sv)) * 64, lane)
    SMeta mA, mB, mN; u32x4 rA[16], rB[16]; int tA, sA, tB, sB, tN, sN;
    U_LOAD(mA, tA, sA, 0); U_ISSUE(rA, mA, sA); U_LOAD(mB, tB, sB, 1);
    for (int i = 0; i < n; i += 2) {
        U_ISSUE(rB, mB, sB);
        U_LOAD(mN, tN, sN, i + 2);
        U_COMPUTE(mA, rA, tA, sA);
        mA = mN; tA = tN; sA = sN; U_ISSUE(rA, mA, sA);
        U_LOAD(mN, tN, sN, i + 3);
        if (i + 1 < n) U_COMPUTE(mB, rB, tB, sB);
        mB = mN; tB = tN; sB = sN;
    }
#undef U_LOAD
#undef U_ISSUE
#undef U_COMPUTE
}
DI void slice_pass_v6(unsigned char* ws, bf16_t* out, float* ssq3, LAS unsigned char* lds, int wave, int sl0, int nsl, int tbase, int tmul, int tadd, int TT, int gw_, int nw_, int lane) {
    const int g = lane >> 3, c = lane & 7;
    const unsigned short* gidx = (const unsigned short*)(ws + WS_GIDX) + 16 * g;
    const unsigned char* tab0 = (const unsigned char*)(ws + WS_V8) + 16 * c;
    const unsigned* wx32 = (const unsigned*)(ws + WS_WX) + (lane & 31);
    const bf16_t* x2b0 = (const bf16_t*)(ws + WS_X2B) + 2 * lane;
    const f32x2* swp = (const f32x2*)(ws + WS_SW);
    LAS unsigned char* img = lds + wave * 16384;
    LAS unsigned char* iw0 = img + g * 2048 + 16 * c, *iw1 = img + g * 2048 + 16 * (c ^ 2), *iw2 = img + g * 2048 + 16 * (c ^ 4), *iw3 = img + g * 2048 + 16 * (c ^ 6);
    const int q = (lane >> 1) & 7, Q = lane >> 4, p = lane & 1;
    LAS unsigned char* itr0 = img + q * 128 + 16 * (Q ^ (q & 6)) + 8 * p;
    LAS unsigned char* itr1 = img + q * 128 + 16 * ((4 + Q) ^ (q & 6)) + 8 * p;
    LAS unsigned* wbuf = (LAS unsigned*)(lds + 131072 + wave * 128);
    if (gw_ >= TT) return;
    const int npw = (TT - gw_ + nw_ - 1) / nw_, n = npw * nsl;
#define V_IDX(m, sv, j) do { X_ITEM(j, tok_, sl_); sv = sl_; const unsigned short* ip = gidx + (size_t)tok_ * 128; (m).i0 = *(const u32x4*)ip; (m).i1 = *(const u32x4*)(ip + 8); } while (0)
#define V_CM(cm, j) do { X_ITEM(j, tok_, sl_); const bf16_t* xp_ = x2b0 + (size_t)tok_ * DM + 256 * sl_; (cm).wd = wx32[(size_t)tok_ * 32]; (cm).x2.x = *(const unsigned*)xp_; (cm).x2.y = *(const unsigned*)(xp_ + 128); (cm).sw = swp[tok_]; } while (0)
#define V_STAGE(r, cm) do { _Pragma("unroll") for (int j = 0; j < 16; ++j) *(LAS u32x4*)((((j >> 1) & 3) == 0 ? iw0 : ((j >> 1) & 3) == 1 ? iw1 : ((j >> 1) & 3) == 2 ? iw2 : iw3) + 128 * j) = r[j]; wbuf[lane & 31] = (cm).wd; asm volatile("" ::: "memory"); } while (0)
#define V_COMPUTE(cm, j) do { X_ITEM(j, tok_, sl_); slice_v2_compute(itr0, itr1, wbuf, cm, out + (size_t)tok_ * DM, ssq3 + (size_t)tok_ * 4, sl_, lane); asm volatile("" ::: "memory"); } while (0)
#define V_ISS(r, m, sv) slice_issue<512>(r, m, tab0 + 128 * (sv))
    SMeta mE, mO; VCm cE, cO; u32x4 rE[16], rO[16]; int sE, sO;
    V_IDX(mE, sE, 0); V_IDX(mO, sO, 1);
    asm volatile("" ::: "memory");
    V_ISS(rE, mE, sE); V_IDX(mE, sE, 2); V_CM(cE, 0);
    asm volatile("" ::: "memory");
    V_ISS(rO, mO, sO); V_IDX(mO, sO, 3); V_CM(cO, 1);
    asm volatile("" ::: "memory");
    for (int i = 0; i < n; i += 2) {
        __builtin_amdgcn_s_setprio(1); V_STAGE(rE, cE);
        V_ISS(rE, mE, sE); V_IDX(mE, sE, i + 4); __builtin_amdgcn_s_setprio(0);
        V_COMPUTE(cE, i);
        V_CM(cE, i + 2);
        __builtin_amdgcn_s_setprio(1); V_STAGE(rO, cO);
        V_ISS(rO, mO, sO); V_IDX(mO, sO, i + 5); __builtin_amdgcn_s_setprio(0);
        if (i + 1 < n) V_COMPUTE(cO, i + 1);
        V_CM(cO, i + 3);
    }
#undef V_IDX
#undef V_CM
#undef V_STAGE
#undef V_COMPUTE
#undef V_ISS
}
#undef X_ITEM
DI void expert_w_token(const int* actp, const unsigned short* gidx, const float* ggate, float sh, const float* su, const float* sv, unsigned char* wrow, f32x2* swp, int lane) {
    typedef int i32x2 __attribute__((ext_vector_type(2)));
    i32x2 acc = {0, 0};
#pragma unroll
    for (int x = 0; x < 4; ++x) { const int w_ = actp[x * 64 + lane]; acc[0] += (int)(short)(w_ & 0xffff); acc[1] += w_ >> 16; }
    acc[0] <<= 3; acc[1] <<= 3;
    const unsigned ii = *(const unsigned*)(gidx + 2 * lane); const f32x2 gt = *(const f32x2*)(ggate + 2 * lane);
    const int e0 = ii & 0xffffu, e1 = ii >> 16;
    const float w0 = gelu_erf((float)acc[0] * (su[e0] * sh)) * gt[0] * sv[e0], w1 = gelu_erf((float)acc[1] * (su[e1] * sh)) * gt[1] * sv[e1];
    float amax = fmaxf(fabsf(w0), fabsf(w1));
    amax = fmaxf(amax, dpp_f<0xB1>(amax)); amax = fmaxf(amax, dpp_f<0x4E>(amax)); amax = fmaxf(amax, dpp_f<0x141>(amax)); amax = fmaxf(amax, dpp_f<0x128>(amax));
    { const auto r = __builtin_amdgcn_permlane16_swap(__float_as_uint(amax), __float_as_uint(amax), false, false); amax = fmaxf(__uint_as_float(r[0]), __uint_as_float(r[1])); }
    { const auto r = __builtin_amdgcn_permlane32_swap(__float_as_uint(amax), __float_as_uint(amax), false, false); amax = fmaxf(__uint_as_float(r[0]), __uint_as_float(r[1])); }
    const float qs = amax > 0.f ? 127.f / amax : 0.f;
    const int q0 = (int)rintf(w0 * qs), q1 = (int)rintf(w1 * qs);
    *(unsigned short*)(wrow + 2 * lane) = (unsigned short)((q0 & 255) | ((q1 & 255) << 8));
    const float qsum = wave_sum((float)(q0 + q1));
    if (lane == 0) *swp = f32x2{amax * (1.f / 127.f), 8.f * qsum};
}
DI void final_norm_token(const bf16_t* x3row, float* row, const float* ssq3p, const float* gf, int lane) {
    float ss = (lane < 4) ? ssq3p[lane] : 0.f; ss = wave_sum(ss);
    const float r3 = __builtin_amdgcn_rsqf(ss * (1.f / 1024.f) + EPS);
#pragma unroll
    for (int i = 0; i < 4; ++i) { const u32x2 v = *(const u32x2*)(x3row + 256 * i + 4 * lane); const f32x4 x = {bflo(v.x), bfhi(v.x), bflo(v.y), bfhi(v.y)};
        *(f32x4*)(row + 256 * i + 4 * lane) = x * r3 * *(const f32x4*)(gf + 256 * i + 4 * lane); }
}

struct WInA { int a[4]; unsigned ii; f32x2 gt; float sh; };
struct WInB { float su0, su1, sv0, sv1; };
DI void expert_w_phase(unsigned char* ws, int first, int stride, int end, int lane) {
    const float* su = (const float*)(ws + WS_SU); const float* sv = (const float*)(ws + WS_SV);
    if (first >= end) return;
    const int n = (end - first + stride - 1) / stride;
#define W_TK(i) (first + ((i) < n ? (i) : n - 1) * stride)
#define W_A(x, tok) do { const int* ap_ = (const int*)(ws + WS_ACTP) + (size_t)(tok) * 256 + lane; _Pragma("unroll") for (int k = 0; k < 4; ++k) (x).a[k] = ap_[k * 64]; \
        (x).ii = *(const unsigned*)((const unsigned short*)(ws + WS_GIDX) + (size_t)(tok) * 128 + 2 * lane); (x).gt = *(const f32x2*)((const float*)(ws + WS_GGATE) + (size_t)(tok) * 128 + 2 * lane); (x).sh = ((const float*)(ws + WS_SH))[tok]; } while (0)
#define W_B(y, x) do { const int e0_ = (x).ii & 0xffffu, e1_ = (x).ii >> 16; (y).su0 = su[e0_]; (y).su1 = su[e1_]; (y).sv0 = sv[e0_]; (y).sv1 = sv[e1_]; } while (0)
    WInA x0, x1, x2; WInB y0, y1;
    W_A(x0, W_TK(0)); W_A(x1, W_TK(1)); W_B(y0, x0);
    for (int i = 0; i < n; ++i) {
        W_B(y1, x1); W_A(x2, W_TK(i + 2));
        { const int tok = W_TK(i);
          int acc0 = 0, acc1 = 0;
#pragma unroll
          for (int k = 0; k < 4; ++k) { acc0 += (int)(short)(x0.a[k] & 0xffff); acc1 += x0.a[k] >> 16; }
          acc0 <<= 3; acc1 <<= 3;
          const float w0 = gelu_erf((float)acc0 * (y0.su0 * x0.sh)) * x0.gt[0] * y0.sv0, w1 = gelu_erf((float)acc1 * (y0.su1 * x0.sh)) * x0.gt[1] * y0.sv1;
          float amax = fmaxf(fabsf(w0), fabsf(w1));
          amax = fmaxf(amax, dpp_f<0xB1>(amax)); amax = fmaxf(amax, dpp_f<0x4E>(amax)); amax = fmaxf(amax, dpp_f<0x141>(amax)); amax = fmaxf(amax, dpp_f<0x128>(amax));
          { const auto r = __builtin_amdgcn_permlane16_swap(__float_as_uint(amax), __float_as_uint(amax), false, false); amax = fmaxf(__uint_as_float(r[0]), __uint_as_float(r[1])); }
          { const auto r = __builtin_amdgcn_permlane32_swap(__float_as_uint(amax), __float_as_uint(amax), false, false); amax = fmaxf(__uint_as_float(r[0]), __uint_as_float(r[1])); }
          const float qs = amax > 0.f ? 127.f / amax : 0.f;
          const int q0 = (int)rintf(w0 * qs), q1 = (int)rintf(w1 * qs);
          *(unsigned short*)((unsigned char*)(ws + WS_WX) + (size_t)tok * 128 + 2 * lane) = (unsigned short)((q0 & 255) | ((q1 & 255) << 8));
          const float qsum = wave_sum((float)(q0 + q1));
          if (lane == 0) ((f32x2*)(ws + WS_SW))[tok] = f32x2{amax * (1.f / 127.f), 8.f * qsum}; }
        x0 = x1; x1 = x2; y0 = y1;
    }
#undef W_TK
#undef W_A
#undef W_B
}
DI void final_norm_phase(unsigned char* ws, float* out, const float* gf, int first, int stride, int end, int lane) {
    if (first >= end) return;
    f32x4 g4[4];
#pragma unroll
    for (int i = 0; i < 4; ++i) g4[i] = *(const f32x4*)(gf + 256 * i + 4 * lane);
    const bf16_t* x3b = (const bf16_t*)(ws + WS_X2B) + 4 * lane; const float* sq = (const float*)(ws + WS_SSQ3) + (lane & 3);
    u32x2 vn[4], vm[4]; float sn, sm;
#define FN_LD(v_, s_, tok) do { _Pragma("unroll") for (int i = 0; i < 4; ++i) v_[i] = *(const u32x2*)(x3b + (size_t)(tok) * DM + 256 * i); s_ = sq[(size_t)(tok) * 4]; } while (0)
    FN_LD(vn, sn, first); { const int t1 = first + stride < end ? first + stride : first; FN_LD(vm, sm, t1); }
    for (int tok = first; tok < end; tok += stride) {
        u32x2 v[4]; float ss = (lane < 4) ? sn : 0.f;
#pragma unroll
        for (int i = 0; i < 4; ++i) { v[i] = vn[i]; vn[i] = vm[i]; }
        sn = sm;
        { const int tn = tok + 2 * stride < end ? tok + 2 * stride : tok; FN_LD(vm, sm, tn); }
        ss = wave_sum(ss);
        const float r3 = __builtin_amdgcn_rsqf(ss * (1.f / 1024.f) + EPS);
        float* row = out + (size_t)tok * DM + 4 * lane;
#pragma unroll
        for (int i = 0; i < 4; ++i) { const f32x4 x = {bflo(v[i].x), bfhi(v[i].x), bflo(v[i].y), bfhi(v[i].y)}; __builtin_nontemporal_store(x * r3 * g4[i], (f32x4*)(row + 256 * i)); }
    }
#undef FN_LD
}

#define XB_TMO      128
#define XB_XCNT(j)  (256  + 64 * (j))
#define XB_XSUB(j)  (1280 + 64 * (j))
#define XB_XGEN(j)  (2304 + 64 * (j))
#define XB_TOP      3328
#define XB_TOPGEN   3392
#define XCD_BAR_WORDS 3456
#define XB_SPIN_CAP (1u << 18)

__device__ __forceinline__ unsigned xb_ld(unsigned* p)              { return __hip_atomic_load(p, __ATOMIC_RELAXED, __HIP_MEMORY_SCOPE_AGENT); }
__device__ __forceinline__ unsigned xb_add(unsigned* p, unsigned v) { return __hip_atomic_fetch_add(p, v, __ATOMIC_RELAXED, __HIP_MEMORY_SCOPE_AGENT); }
__device__ __forceinline__ unsigned xb_xcc_id() { return (unsigned)__builtin_amdgcn_s_getreg((3 << 11) | 20) & 0xFu; }
#define XB_SPIN(cond, bar) do { unsigned _sp = 0; while (cond) { __builtin_amdgcn_s_sleep(1); \
    if ((++_sp & 255u) == 0u) { if (xb_ld(&(bar)[XB_TMO])) break; if (_sp > XB_SPIN_CAP) { atomicAdd(&(bar)[XB_TMO], 1u); break; } } } } while (0)

struct XcdBarrier {
    unsigned* bar; unsigned x;
    volatile __attribute__((address_space(3))) unsigned* st;
};

__device__ __forceinline__ XcdBarrier xcd_barrier_post(unsigned* bar, volatile __attribute__((address_space(3))) unsigned* st) {
    XcdBarrier b; b.bar = bar; b.x = xb_xcc_id(); b.st = st;
    if (threadIdx.x == 0) st[2] = xb_add(&bar[XB_XCNT(b.x)], 1u);
    return b;
}
__device__ __forceinline__ void xcd_barrier_complete(unsigned* bar, unsigned x, unsigned& nloc, unsigned& nx) {
    const unsigned G = gridDim.x * gridDim.y * gridDim.z;
    unsigned sum, cnt, mine, sp = 0u;
    for (;;) {
        sum = 0u; cnt = 0u; mine = 0u;
#pragma unroll
        for (unsigned j = 0; j < 16; ++j) { const unsigned c = xb_ld(&bar[XB_XCNT(j)]); sum += c; cnt += (c > 0u) ? 1u : 0u; mine = (j == x) ? c : mine; }
        if (sum == G) break;
        __builtin_amdgcn_s_sleep(1);
        if ((++sp & 255u) == 0u) { if (xb_ld(&bar[XB_TMO])) break; if (sp > XB_SPIN_CAP) { atomicAdd(&bar[XB_TMO], 1u); break; } }
    }
    nloc = mine > 0u ? mine : 1u; nx = cnt > 0u ? cnt : 1u;
}

__device__ __forceinline__ void xcd_barrier(const XcdBarrier& b) {
    asm volatile("s_waitcnt vmcnt(0)" ::: "memory");
    __syncthreads();
    if (threadIdx.x == 0) {
        unsigned* bar = b.bar;
        __builtin_amdgcn_s_waitcnt(0);
        unsigned nloc = b.st[0], nx = b.st[1];
        if (nloc == 0u) { xcd_barrier_complete(bar, b.x, nloc, nx); b.st[0] = nloc; b.st[1] = nx; }
        const unsigned old = xb_add(&bar[XB_XSUB(b.x)], 1u);
        const unsigned gen = old / nloc;
        if (old + 1u == (gen + 1u) * nloc) {
            __builtin_amdgcn_fence(__ATOMIC_RELEASE, "agent");
            asm volatile("s_waitcnt vmcnt(0)" ::: "memory");
            const unsigned og = xb_add(&bar[XB_TOP], 1u);
            const unsigned tg = og / nx;
            if (og + 1u == (tg + 1u) * nx) xb_add(&bar[XB_TOPGEN], 1u);
            else XB_SPIN(xb_ld(&bar[XB_TOPGEN]) == tg, bar);
            __builtin_amdgcn_fence(__ATOMIC_ACQUIRE, "agent");
            xb_add(&bar[XB_XGEN(b.x)], 1u);
            asm volatile("s_waitcnt vmcnt(0)" ::: "memory");
        } else {
            XB_SPIN(xb_ld(&bar[XB_XGEN(b.x)]) == gen, bar);
            __builtin_amdgcn_fence(__ATOMIC_ACQUIRE, "agent");
            asm volatile("s_waitcnt vmcnt(0)" ::: "memory");
        }
    }
    __syncthreads();
}

__device__ __forceinline__ void xcd_local_barrier(const XcdBarrier& b) {
    asm volatile("s_waitcnt vmcnt(0)" ::: "memory");
    __syncthreads();
    if (threadIdx.x == 0) {
        unsigned* bar = b.bar;
        __builtin_amdgcn_s_waitcnt(0);
        const unsigned nloc = b.st[0];
        const unsigned old = xb_add(&bar[XB_XSUB(b.x)], 1u);
        const unsigned gen = old / nloc;
        if (old + 1u == (gen + 1u) * nloc) xb_add(&bar[XB_XGEN(b.x)], 1u);
        else XB_SPIN(xb_ld(&bar[XB_XGEN(b.x)]) == gen, bar);
        __builtin_amdgcn_fence(__ATOMIC_ACQUIRE, "agent");
        asm volatile("s_waitcnt vmcnt(0)" ::: "memory");
    }
    __syncthreads();
}

constexpr int N_PHASES = 13;
__global__ void __launch_bounds__(NTHR, 2) mk_fwd(Args a) {
    extern __shared__ __attribute__((aligned(16))) unsigned char lds_raw[];
    LAS unsigned char* lds = (LAS unsigned char*)lds_raw;
    cg::grid_group grid = cg::this_grid();
    const int G = gridDim.x, vb = blockIdx.x, tid = threadIdx.x, lane = tid & 63, wave = tid >> 6;
    unsigned char* ws = a.ws;
    const int lo = a.ph_lo, hi = a.ph_hi;
    volatile LAS unsigned* MISC = (volatile LAS unsigned*)(lds + LDS_BYTES - 64);
    if (tid < 16) MISC[tid] = 0u;
    __syncthreads();
    const XcdBarrier bar = xcd_barrier_post((unsigned*)(ws + 4096) + lo * XCD_BAR_WORDS, MISC);
#ifndef PHASE_MASK
#define PHASE_MASK 0xFFFF
#endif
#define IN(k) (((PHASE_MASK >> (k)) & 1) && lo <= (k) && (k) < hi)
#ifndef REPEAT_MASK
#define REPEAT_MASK 0
#endif
#define REP(k) for (int rep_ = 0; rep_ < (((REPEAT_MASK) >> (k)) & 1) + 1; ++rep_)
#define SEAM(k) do { if (IN(k) && IN((k) + 1)) { xcd_barrier(bar); } } while (0)
    REP(0) if (IN(0)) p0_prologue(a, lds, vb, G);
    SEAM(0);
    if (lo == 0 && hi == N_PHASES) {
        if (tid == 0) {
            unsigned nloc_ = 0, nx_ = 0; xcd_barrier_complete(bar.bar, bar.x, nloc_, nx_);
            bool even = (G == 256) && bar.x < 8u;
#pragma unroll
            for (int j = 0; j < 8; ++j) even = even && (xb_ld(&bar.bar[XB_XCNT(j)]) == (unsigned)(G / 8));
            MISC[7] = even ? 1u : 0u; MISC[8] = even ? MISC[2] * 8u + bar.x : (unsigned)vb;
        }
        __syncthreads();
    }
    const int chainx = (lo == 0 && hi == N_PHASES) ? (int)MISC[7] : 0, vbx = chainx ? (int)MISC[8] : vb, xcx = chainx ? (int)bar.x : 0, rkx = chainx ? (int)MISC[2] : 0;
#define LSEAM(k) do { if (IN(k) && IN((k) + 1)) { if (chainx) xcd_local_barrier(bar); else xcd_barrier(bar); } } while (0)
    REP(1) if (IN(1)) { pg8::Gemm g{(const bf16_t*)(ws + WS_XB), (const bf16_t*)(ws + WS_W1T), T, NIN, 1024}; pg8::StaticOrder S; S.init(T, NIN, G, vbx);
        pg8::Epi1 E{(const float*)(ws + WS_RSTD1), (bf16_t*)(ws + WS_PA), (bf16_t*)(ws + WS_GG), (bf16_t*)(ws + WS_QD), (bf16_t*)(ws + WS_KINV), (bf16_t*)(ws + WS_KENDT), (bf16_t*)(ws + WS_VT), (bf16_t*)(ws + WS_GS),
                    (float*)(ws + WS_DEC), (const float*)(ws + WS_LB), (bf16_t*)(ws + WS_AVT), lds + 131072};
        pg8::gemm_phase<pg8::Epi1, pg8::StaticOrder, true, true>(lds, g, S, E); }
    LSEAM(1);
    REP(2) if (IN(2)) {
        const int h_first = chainx ? 512 * xcx + 8 * rkx : vb * 8, h_stride = chainx ? 256 : G * 8, h_end = chainx ? 512 * (xcx + 1) : 64 * 64;
        for (int u0 = h_first; u0 < h_end; u0 += h_stride) {
            { int t2_ = threadIdx.x; asm volatile("" : "+v"(t2_)); const int u = u0 + (t2_ >> 6);
              hgrn_prep_unit((bf16_t*)(ws + WS_QD), (bf16_t*)(ws + WS_KINV), lds + (t2_ >> 6) * 18432, (float*)(ws + WS_DEC), (const float*)(ws + WS_LB), u >> 6, u & 63, (t2_ & 63) * 2); }
            __syncthreads();
            hgrn_ds_group(lds, (const bf16_t*)(ws + WS_VT), (bf16_t*)a.out, u0);
            __syncthreads();
        }
        const int a_first = chainx ? 128 * xcx + rkx : vb, a_stride = chainx ? 32 : G, a_end = chainx ? 128 * (xcx + 1) : BATCH * (SEQ / 64);
        for (int u = a_first; u < a_end; u += a_stride) attn_unit((const bf16_t*)(ws + WS_PA), (const bf16_t*)(ws + WS_AVT), a.in[3], (bf16_t*)(ws + WS_YA), lds, u >> 6, u & 63);
    }
    LSEAM(2);
    REP(3) if (IN(3)) hgrn_scan((bf16_t*)a.out, (const float*)(ws + WS_DEC), chainx ? 32 * xcx + rkx : vb, G);
    LSEAM(3);
    REP(4) if (IN(4)) hgrn_out_phase((const bf16_t*)(ws + WS_QD), (const bf16_t*)(ws + WS_KINV), (const bf16_t*)(ws + WS_VT), (const bf16_t*)a.out, (const bf16_t*)(ws + WS_GS), (bf16_t*)(ws + WS_YH), lds, chainx ? 512 * xcx + rkx : vb, chainx ? 32 : G, chainx ? 512 * (xcx + 1) : 64 * 64);
    LSEAM(4);
    REP(5) if (IN(5)) {
#ifdef P5_STAGGER
        if (vb & 1) { _Pragma("unroll") for (int z = 0; z < P5_STAGGER; ++z) __builtin_amdgcn_s_sleep(127); }
#endif
        { pg8::Gemm g{(const bf16_t*)(ws + WS_YA), (const bf16_t*)(ws + WS_WAPT), T, 1024, 512}; pg8::StaticOrder S; S.init(T, 1024, G, vbx);
          pg8::EpiMerge<false> E{(bf16_t*)((unsigned char*)a.out + 128 * MiB), (const bf16_t*)(ws + WS_GG)};
          pg8::gemm_phase<pg8::EpiMerge<false>, pg8::StaticOrder, true, true>(lds, g, S, E); }
        __syncthreads();
        { pg8::Gemm g{(const bf16_t*)(ws + WS_YH), (const bf16_t*)(ws + WS_WHPT), T, 1024, 512}; pg8::StaticOrder S; S.init(T, 1024, G, vbx);
          pg8::EpiMerge<true> E{(bf16_t*)((unsigned char*)a.out + 128 * MiB), (const bf16_t*)(ws + WS_GG) + 1024};
          pg8::gemm_phase<pg8::EpiMerge<true>, pg8::StaticOrder, true, true>(lds, g, S, E); }
    }
    LSEAM(5);
    REP(6) if (IN(6)) { pg8::Gemm g{(const bf16_t*)((unsigned char*)a.out + 128 * MiB), (const bf16_t*)(ws + WS_WOUTT), T, 1024, 1024}; pg8::StaticOrder S; S.init(T, 1024, G, vbx);
        pg8::EpiX2 E{(const bf16_t*)(ws + WS_XB), (bf16_t*)(ws + WS_X2B), (float*)(ws + WS_SSQ2)};
        pg8::gemm_phase<pg8::EpiX2, pg8::StaticOrder, true, true>(lds, g, S, E); }
    LSEAM(6);
    REP(7) if (IN(7)) { pg8::Gemm g{(const bf16_t*)(ws + WS_X2B), (const bf16_t*)(ws + WS_WQT), T, 2048, 1024}; pg8::StaticOrder S; S.init(T, 2048, G, vbx);
        pg8::EpiQp E{(bf16_t*)(ws + WS_QP), (const float*)(ws + WS_SSQ2)};
        pg8::gemm_phase<pg8::EpiQp, pg8::StaticOrder, true, true>(lds, g, S, E); }
    LSEAM(7);
    REP(8) if (IN(8)) { const int per = (1024 + G - 1) / G; int hcur = -1;
        const int U0 = chainx ? (rkx >> 2) * 128 + 16 * xcx + (rkx & 3) * 4 : vb * per;
        for (int U = U0; U < U0 + per && U < 1024; ++U) { const int h = U >> 7;
            if (h != hcur) { topk_stage_keys((const bf16_t*)(ws + WS_KEYS), lds + 65536, h); hcur = h; __syncthreads(); }
            topk_unit((const bf16_t*)(ws + WS_QP), lds + 65536, (unsigned short*)(ws + WS_GIDX), (float*)(ws + WS_GGATE), (LAS unsigned*)lds, U & 127, h); }
        if (chainx) hq_phase(ws, 8192 * xcx + 8 * rkx + __builtin_amdgcn_readfirstlane(wave), 256, 8192 * (xcx + 1), lane); else hq_phase(ws, vb * 8 + __builtin_amdgcn_readfirstlane(wave), G * 8, T, lane); }
    LSEAM(8);
    if (IN(9) || IN(11)) {
        if (tid == 0) {
            unsigned nloc_ = 0, nx_ = 0; xcd_barrier_complete(bar.bar, bar.x, nloc_, nx_);
            unsigned cj[8], tot = 0; bool all = true;
#pragma unroll
            for (int j = 0; j < 8; ++j) { cj[j] = xb_ld(&bar.bar[XB_XCNT(j)]); tot += cj[j]; all = all && cj[j] > 0u; }
            if (all && tot == (unsigned)G && bar.x < 8u) { MISC[4] = bar.x; MISC[5] = MISC[2]; MISC[6] = cj[bar.x & 7u]; }
            else { const unsigned sl_ = (unsigned)vb & 7u; MISC[4] = sl_; MISC[5] = (unsigned)vb >> 3; MISC[6] = ((unsigned)G - sl_ + 7u) >> 3; }
        }
        __syncthreads();
    }
#define WAVE_FENCE() do { asm volatile("s_waitcnt vmcnt(0)" ::: "memory"); __builtin_amdgcn_fence(__ATOMIC_ACQUIRE, "agent"); asm volatile("s_waitcnt vmcnt(0)" ::: "memory"); } while (0)
    REP(9) if (IN(9)) { if (chainx) slice_pass_u4(ws, 0, 4, 8192 * xcx, 1, 0, 8192, rkx * 8 + __builtin_amdgcn_readfirstlane(wave), 256, lane);
                        else slice_pass<0>(ws, a.out, (int)MISC[4], (int)MISC[5] * 8 + __builtin_amdgcn_readfirstlane(wave), (int)MISC[6] * 8, lane); }
    if (chainx) WAVE_FENCE(); else LSEAM(9);
    REP(10) if (IN(10)) { if (chainx) expert_w_phase(ws, 8192 * xcx + 8 * rkx + __builtin_amdgcn_readfirstlane(wave), 256, 8192 * (xcx + 1), lane);
                          else expert_w_phase(ws, vb * 8 + __builtin_amdgcn_readfirstlane(wave), G * 8, T, lane); }
    if (chainx) WAVE_FENCE(); else LSEAM(10);
    if (IN(11)) { if (chainx) slice_pass_v6(ws, (bf16_t*)(ws + WS_X2B), (float*)(ws + WS_SSQ3), lds, __builtin_amdgcn_readfirstlane(wave), 0, 4, 8192 * xcx, 1, 0, 8192, rkx * 8 + __builtin_amdgcn_readfirstlane(wave), 256, lane);
                  else slice_pass_v<0>(ws, (bf16_t*)(ws + WS_X2B), (float*)(ws + WS_SSQ3), lds, __builtin_amdgcn_readfirstlane(wave), (int)MISC[4], (int)MISC[5] * 8 + __builtin_amdgcn_readfirstlane(wave), (int)MISC[6] * 8, lane); }
#ifdef PROBE_VPM
    if (IN(11)) slice_pass_v<PROBE_VPM>(ws, (bf16_t*)(ws + WS_QP), (float*)(ws + WS_QP), lds, __builtin_amdgcn_readfirstlane(wave), (int)MISC[4], (int)MISC[5] * 8 + __builtin_amdgcn_readfirstlane(wave), (int)MISC[6] * 8, lane);
#endif
    if (chainx) WAVE_FENCE(); else LSEAM(11);
    if (IN(12)) { if (chainx) final_norm_phase(ws, a.out, a.in[14], 8192 * xcx + 8 * rkx + __builtin_amdgcn_readfirstlane(wave), 256, 8192 * (xcx + 1), lane);
                  else final_norm_phase(ws, a.out, a.in[14], vb * 8 + __builtin_amdgcn_readfirstlane(wave), G * 8, T, lane); }
#undef IN
#undef SEAM
#undef LSEAM
#undef WAVE_FENCE
}

extern "C" void kernel_launch(void* const* d_in, const int* in_sizes, int n_in, void* d_out, int out_size, void* d_ws, size_t ws_size, hipStream_t stream) {
    static int grid = 0;
    if (grid == 0) {
        if (n_in != 15 || in_sizes[0] != T * DM || out_size != T * DM || ws_size < WS_END) { fprintf(stderr, "kernel_launch: unexpected shapes (n_in %d, in0 %d, out %d, ws %zu)\n", n_in, n_in > 0 ? in_sizes[0] : -1, out_size, ws_size); grid = -1; return; }
        int dev = 0, cus = 0, per_cu = 0;
        hipGetDevice(&dev); hipDeviceGetAttribute(&cus, hipDeviceAttributeMultiprocessorCount, dev);
        if (hipFuncSetAttribute((const void*)mk_fwd, hipFuncAttributeMaxDynamicSharedMemorySize, LDS_BYTES) != hipSuccess) { fprintf(stderr, "kernel_launch: hipFuncSetAttribute failed\n"); grid = -1; return; }
        if (hipOccupancyMaxActiveBlocksPerMultiprocessor(&per_cu, (const void*)mk_fwd, NTHR, LDS_BYTES) != hipSuccess || per_cu < 1) { fprintf(stderr, "kernel_launch: occupancy query says %d blocks per CU\n", per_cu); per_cu = 1; }
        (void)hipGetLastError();
        grid = cus;
    }
    if (grid < 0) return;
    if (hipMemsetAsync(d_ws, 0, 256 * 1024, stream) != hipSuccess) { fprintf(stderr, "kernel_launch: hipMemsetAsync failed\n"); return; }
    Args a{};
    for (int i = 0; i < 15; ++i) a.in[i] = (const float*)d_in[i];
    a.out = (float*)d_out; a.ws = (unsigned char*)d_ws;
#if MK_FUSED
    a.ph_lo = 0; a.ph_hi = N_PHASES;
    { void* args[] = {&a}; hipError_t e = hipLaunchCooperativeKernel((const void*)mk_fwd, dim3(grid), dim3(NTHR), args, LDS_BYTES, stream);
      if (e != hipSuccess) fprintf(stderr, "kernel_launch: cooperative launch failed: %s (grid %d)\n", hipGetErrorString(e), grid); }
#else
    for (int p = 0; p < N_PHASES; ++p) { a.ph_lo = p; a.ph_hi = p + 1; void* args[] = {&a};
        hipError_t e = hipLaunchCooperativeKernel((const void*)mk_fwd, dim3(grid), dim3(NTHR), args, LDS_BYTES, stream);
        if (e != hipSuccess) { fprintf(stderr, "kernel_launch: launch of phase %d failed: %s (grid %d)\n", p, hipGetErrorString(e), grid); break; } }
#endif
}
```
